# Optimizing an MI355X kernel written in HIP

```python
import jax
import jax.numpy as jnp
from jax import lax
import numpy as np

D_MODEL = 1024
BATCH = 16
SEQ = 2048
DEPTH = 4

CTX_LEN = 256
GRID_W = 64
N_MOD = 6
EPS = 1e-6
MLA_W = D_MODEL // 2
V_HEAD = 64
N_MLA_HEADS = MLA_W // V_HEAD
QK_NOPE = 64
QK_ROPE = 32
QK_DIM = QK_NOPE + QK_ROPE
Q_LORA = 3 * D_MODEL // 8
KV_LORA = D_MODEL // 4
ROPE_BASE = 10000.0
Q_BLOCK = 128
HGRN_W = D_MODEL // 2
HGRN_K = 128
N_HGRN_HEADS = HGRN_W // HGRN_K
HGRN_V = HGRN_W // N_HGRN_HEADS
CHUNK = 64
IN_SPLITS = (Q_LORA, KV_LORA, QK_ROPE, HGRN_W, HGRN_W, HGRN_W, HGRN_W, HGRN_W)
IN_W = Q_LORA + KV_LORA + QK_ROPE + 5 * HGRN_W
MIX_W = MLA_W + HGRN_W
POOL_WINDOWS = (2, 4, 8, 16)
N_POOL = 4
POOL_C = D_MODEL // N_POOL
D_FF = ((8 * D_MODEL // 3 + 255) // 256) * 256
N_EXPERTS = 8
TOP_K = 2
D_FF_EXPERT = 7 * D_MODEL // 2
N_AB = (DEPTH + 1) // 2
N_C = DEPTH // 2

kernel_name = "hybrid_mla_hgrn2_pool_moe_dit"

F32 = jnp.float32


def rmsnorm(x, g):
    xf = x.astype(F32)
    y = xf * lax.rsqrt(jnp.mean(xf * xf, axis=-1, keepdims=True) + EPS) * g.astype(F32)
    return y.astype(x.dtype)


def modulate(x, shift, scale):
    return x * (1.0 + scale) + shift


def split_cols(p):
    out, start = [], 0
    for w in IN_SPLITS:
        out.append(p[..., start:start + w])
        start += w
    return out


def rope_tables(n_tok):
    rows = n_tok // GRID_W
    row = jnp.repeat(jnp.arange(rows, dtype=F32), GRID_W)
    col = jnp.tile(jnp.arange(GRID_W, dtype=F32), rows)
    half = QK_ROPE // 2
    inv = 1.0 / (ROPE_BASE ** (jnp.arange(0, half, 2, dtype=F32) / half))
    ar = row[:, None] * inv[None, :]
    ac = col[:, None] * inv[None, :]
    ang = jnp.concatenate([ar, ar, ac, ac], axis=-1)
    return jnp.cos(ang)[:, None, :], jnp.sin(ang)[:, None, :]


def rope2d(x, cos, sin):
    xs = x.reshape(x.shape[:-1] + (2, 2, QK_ROPE // 4))
    rot = jnp.stack([-xs[..., 1, :], xs[..., 0, :]], axis=-2).reshape(x.shape)
    return x * cos.astype(x.dtype) + rot * sin.astype(x.dtype)


def mla_q(cq, g_cq, w_uq, cos, sin):
    b, t, _ = cq.shape
    q = (rmsnorm(cq, g_cq) @ w_uq).reshape(b, t, N_MLA_HEADS, QK_DIM)
    q_nope, q_rope = q[..., :QK_NOPE], q[..., QK_NOPE:]
    if cos is not None:
        q_rope = rope2d(q_rope, cos, sin)
    return jnp.concatenate([q_nope, q_rope], axis=-1)


def mla_kv(ckv, kr, g_ckv, w_ukv, cos, sin):
    b, t, _ = ckv.shape
    kv = (rmsnorm(ckv, g_ckv) @ w_ukv).reshape(b, t, N_MLA_HEADS, QK_NOPE + V_HEAD)
    k_nope, v = kv[..., :QK_NOPE], kv[..., QK_NOPE:]
    kr = kr[:, :, None, :]
    if cos is not None:
        kr = rope2d(kr, cos, sin)
    k = jnp.concatenate([k_nope, jnp.broadcast_to(kr, (b, t, N_MLA_HEADS, QK_ROPE))], axis=-1)
    return k, v


def softmax_attend(q, k, v):
    s = jnp.einsum('bqhd,bkhd->bhqk', q, k).astype(F32) * (QK_DIM ** -0.5)
    p = jax.nn.softmax(s, axis=-1).astype(v.dtype)
    return jnp.einsum('bhqk,bkhd->bqhd', p, v)


def blocked_attend(q, k, v):
    b, t, h, dk = q.shape
    nb = t // Q_BLOCK
    qb = q.reshape(b, nb, Q_BLOCK, h, dk).transpose(1, 0, 2, 3, 4)
    o = lax.map(lambda qi: softmax_attend(qi, k, v), qb)
    return o.transpose(1, 0, 2, 3, 4).reshape(b, t, h, v.shape[-1])


def hgrn_heads(a):
    return a.reshape(a.shape[0], a.shape[1], N_HGRN_HEADS, -1)


def hgrn_gates(hf, lb):
    hf = hf.astype(F32)
    k_in = (1.0 - lb) * jax.nn.sigmoid(-hf)
    log_f = jnp.log1p(-k_in)
    return k_in, log_f


def gla_chunked(q, k, v, log_f, s0):
    b, t, h, dk = q.shape
    dv = v.shape[-1]
    n = t // CHUNK

    def to_chunks(a):
        return a.astype(F32).reshape(b, n, CHUNK, h, a.shape[-1]).transpose(1, 0, 3, 2, 4)

    qc, kc, vc, gc = to_chunks(q), to_chunks(k), to_chunks(v), to_chunks(log_f)
    lower = jnp.tril(jnp.ones((CHUNK, CHUNK), dtype=bool))[:, :, None]

    def step(state, inp):
        qi, ki, vi, gi = inp
        g_cum = jnp.cumsum(gi, axis=2)
        o_inter = jnp.einsum('bhlk,bhkv->bhlv', qi * jnp.exp(g_cum), state)
        diff = g_cum[:, :, :, None, :] - g_cum[:, :, None, :, :]
        decay = jnp.where(lower, jnp.exp(jnp.where(lower, diff, 0.0)), 0.0)
        attn = jnp.einsum('bhtk,bhsk,bhtsk->bhts', qi, ki, decay)
        o = o_inter + jnp.einsum('bhts,bhsv->bhtv', attn, vi)
        g_last = g_cum[:, :, -1:, :]
        new_state = (jnp.exp(g_last[:, :, 0, :])[..., None] * state
                     + jnp.einsum('bhlk,bhlv->bhkv', ki * jnp.exp(g_last - g_cum), vi))
        return new_state, o

    s_final, o = lax.scan(step, s0, (qc, kc, vc, gc))
    return o.transpose(1, 0, 3, 2, 4).reshape(b, t, h, dv), s_final


def final_state(k, v, log_f):
    g_cum = jnp.cumsum(log_f, axis=1)
    dec = jnp.exp(g_cum[:, -1:] - g_cum)
    return jnp.einsum('bthk,bthv->bhkv', k * dec, v.astype(F32))


def flip(a):
    return jnp.flip(a, axis=1)


def hgrn_readout(o, hg, g_norm):
    b, t = o.shape[0], o.shape[1]
    y = rmsnorm(o, g_norm) * jax.nn.silu(hgrn_heads(hg).astype(F32))
    return y.reshape(b, t, HGRN_W).astype(hg.dtype)


def mixer_ab(u, uc, w_in, g_cq, g_ckv, w_uq, w_ukv, lb, g_norm, w_out, cos, sin, need_ctx_out):
    b, s, _ = u.shape
    cq, ckv, kr, hq, hff, hfb, hi, hg = split_cols(u @ w_in)
    cq_c, ckv_c, kr_c, hq_c, hff_c, hfb_c, hi_c, hg_c = split_cols(uc @ w_in)

    q = mla_q(cq, g_cq, w_uq, cos, sin)
    k, v = mla_kv(ckv, kr, g_ckv, w_ukv, cos, sin)
    k_c, v_c = mla_kv(ckv_c, kr_c, g_ckv, w_ukv, None, None)
    a_lat = blocked_attend(q, jnp.concatenate([k, k_c], axis=1),
                           jnp.concatenate([v, v_c], axis=1)).reshape(b, s, MLA_W)

    qh = jax.nn.silu(hgrn_heads(hq).astype(F32))
    vh = hgrn_heads(hi).astype(F32)
    kf, lgf = hgrn_gates(hgrn_heads(hff), lb[0])
    kb, lgb = hgrn_gates(hgrn_heads(hfb), lb[1])
    qh_c = jax.nn.silu(hgrn_heads(hq_c).astype(F32))
    vh_c = hgrn_heads(hi_c).astype(F32)
    kf_c, lgf_c = hgrn_gates(hgrn_heads(hff_c), lb[0])
    kb_c, lgb_c = hgrn_gates(hgrn_heads(hfb_c), lb[1])
    zero = jnp.zeros((b, N_HGRN_HEADS, HGRN_K, HGRN_V), F32)
    if need_ctx_out:
        oc_f, sc_f = gla_chunked(qh_c, kf_c, vh_c, lgf_c, zero)
        oc_b, sc_b = gla_chunked(flip(qh_c), flip(kb_c), flip(vh_c), flip(lgb_c), zero)
        oc = oc_f + flip(oc_b)
    else:
        sc_f = final_state(kf_c, vh_c, lgf_c)
        sc_b = final_state(flip(kb_c), flip(vh_c), flip(lgb_c))
    ol_f, _ = gla_chunked(qh, kf, vh, lgf, sc_f)
    ol_b, _ = gla_chunked(flip(qh), flip(kb), flip(vh), flip(lgb), sc_b)
    b_lat = hgrn_readout(ol_f + flip(ol_b), hg, g_norm)

    y = jnp.concatenate([a_lat, b_lat], axis=-1) @ w_out
    yc = None
    if need_ctx_out:
        qc = mla_q(cq_c, g_cq, w_uq, None, None)
        a_ctx = softmax_attend(qc, k_c, v_c).reshape(uc.shape[0], uc.shape[1], MLA_W)
        b_ctx = hgrn_readout(oc, hg_c, g_norm)
        yc = jnp.concatenate([a_ctx, b_ctx], axis=-1) @ w_out
    return y, yc


def pool_mix(u, w, bias, scale):
    b, t, _ = u.shape
    uf = u.astype(F32)
    cs = jnp.pad(jnp.cumsum(uf, axis=1), ((0, 0), (1, 0), (0, 0))).reshape(b, t + 1, N_POOL, POOL_C)
    pos = jnp.arange(t)[:, None]
    win = jnp.array(POOL_WINDOWS, dtype=jnp.int32)[None, :]
    lo = jnp.clip(pos - win // 2, 0, t)
    hi = jnp.clip(pos - win // 2 + win, 0, t)
    grp = jnp.arange(N_POOL)[None, :]
    win_sum = cs[:, hi, grp] - cs[:, lo, grp]
    cnt = (hi - lo).astype(F32)[None, :, :, None]
    pooled = (win_sum / cnt - uf.reshape(b, t, N_POOL, POOL_C)).astype(u.dtype)
    y = jnp.einsum('btgc,gcd->btgd', pooled, w) + bias
    return y.reshape(b, t, D_MODEL) * scale


def swiglu(h, wg, wu, wd):
    return (jax.nn.silu(h @ wg) * (h @ wu)) @ wd


def moe(h, router, wg, wu, wd):
    logits = (h @ router).astype(F32)
    top_v, top_i = lax.top_k(logits, TOP_K)
    top_w = jax.nn.softmax(top_v, axis=-1)
    gates = jnp.sum(jax.nn.one_hot(top_i, N_EXPERTS, dtype=F32) * top_w[..., None], axis=-2)
    y = jnp.zeros_like(h)
    for e in range(N_EXPERTS):
        y = y + gates[..., e:e + 1].astype(h.dtype) * swiglu(h, wg[e], wu[e], wd[e])
    return y


def setup_inputs(seed: int = 0) -> dict:
    key = jax.random.key(seed)
    keys = iter(jax.random.split(key, 40))

    def nrm(shape, scale):
        return jax.random.normal(next(keys), shape, F32) * scale

    d = D_MODEL
    return {
        "x": nrm((BATCH, SEQ, d), 1.0),
        "c": nrm((BATCH, d), 1.0),
        "ctx": nrm((BATCH, CTX_LEN, d), 1.0),
        "c_ctx": nrm((d,), 1.0),
        "w_mod": nrm((DEPTH, d, N_MOD * d), 0.5 * d ** -0.5),
        "b_mod": nrm((DEPTH, N_MOD * d), 0.02),
        "norm_g": 1.0 + nrm((DEPTH, 2, d), 0.1),
        "final_g": 1.0 + nrm((d,), 0.1),
        "ab_w_in": nrm((N_AB, d, IN_W), d ** -0.5),
        "ab_g_cq": 1.0 + nrm((N_AB, Q_LORA), 0.1),
        "ab_g_ckv": 1.0 + nrm((N_AB, KV_LORA), 0.1),
        "ab_w_uq": nrm((N_AB, Q_LORA, N_MLA_HEADS * QK_DIM), Q_LORA ** -0.5),
        "ab_w_ukv": nrm((N_AB, KV_LORA, N_MLA_HEADS * (QK_NOPE + V_HEAD)), KV_LORA ** -0.5),
        "hgrn_lb_logits": nrm((N_AB, 2, HGRN_W), 0.5),
        "hgrn_g_norm": 1.0 + nrm((N_AB, HGRN_V), 0.1),
        "ab_w_out": nrm((N_AB, MIX_W, d), MIX_W ** -0.5),
        "ffn_w_gate": nrm((N_AB, d, D_FF), d ** -0.5),
        "ffn_w_up": nrm((N_AB, d, D_FF), d ** -0.5),
        "ffn_w_down": nrm((N_AB, D_FF, d), D_FF ** -0.5),
        "pool_w": nrm((N_C, N_POOL, POOL_C, POOL_C), POOL_C ** -0.5),
        "pool_b": nrm((N_C, N_POOL, POOL_C), 0.02),
        "pool_scale": 1.0 + nrm((N_C, d), 0.1),
        "moe_router": nrm((N_C, d, N_EXPERTS), d ** -0.5),
        "moe_w_gate": nrm((N_C, N_EXPERTS, d, D_FF_EXPERT), d ** -0.5),
        "moe_w_up": nrm((N_C, N_EXPERTS, d, D_FF_EXPERT), d ** -0.5),
        "moe_w_down": nrm((N_C, N_EXPERTS, D_FF_EXPERT, d), D_FF_EXPERT ** -0.5),
    }


def reference(x, c, ctx, c_ctx, w_mod, b_mod, norm_g, final_g, ab_w_in, ab_g_cq, ab_g_ckv,
              ab_w_uq, ab_w_ukv, hgrn_lb_logits, hgrn_g_norm, ab_w_out, ffn_w_gate, ffn_w_up,
              ffn_w_down, pool_w, pool_b, pool_scale, moe_router, moe_w_gate, moe_w_up, moe_w_down):
    seq = x.shape[1]
    cos, sin = rope_tables(seq)
    lb_p = jax.nn.softmax(hgrn_lb_logits.astype(F32), axis=0)
    lb_all = (jnp.cumsum(lb_p, axis=0) - lb_p[:1]).reshape(N_AB, 2, N_HGRN_HEADS, HGRN_K)
    silu_c = jax.nn.silu(c)
    silu_cc = jax.nn.silu(c_ctx)
    h, hc = x, ctx
    for l in range(DEPTH):
        j = l // 2
        even = l % 2 == 0
        ctx_later = any(m % 2 == 0 for m in range(l + 1, DEPTH))
        sh1, sc1, g1, sh2, sc2, g2 = jnp.split((silu_c @ w_mod[l] + b_mod[l])[:, None, :], N_MOD, axis=-1)
        u = modulate(rmsnorm(h, norm_g[l, 0]), sh1, sc1)
        uc = None
        if even or ctx_later:
            csh1, csc1, cg1, csh2, csc2, cg2 = jnp.split(
                (silu_cc @ w_mod[l] + b_mod[l])[None, None, :], N_MOD, axis=-1)
            uc = modulate(rmsnorm(hc, norm_g[l, 0]), csh1, csc1)
        if even:
            y, yc = mixer_ab(u, uc, ab_w_in[j], ab_g_cq[j], ab_g_ckv[j], ab_w_uq[j], ab_w_ukv[j],
                             lb_all[j], hgrn_g_norm[j], ab_w_out[j], cos, sin, ctx_later)
        else:
            y = pool_mix(u, pool_w[j], pool_b[j], pool_scale[j])
            yc = pool_mix(uc, pool_w[j], pool_b[j], pool_scale[j]) if ctx_later else None
        h = h + g1 * y
        v = modulate(rmsnorm(h, norm_g[l, 1]), sh2, sc2)
        if even:
            h = h + g2 * swiglu(v, ffn_w_gate[j], ffn_w_up[j], ffn_w_down[j])
        else:
            h = h + g2 * moe(v, moe_router[j], moe_w_gate[j], moe_w_up[j], moe_w_down[j])
        if ctx_later:
            hc = hc + cg1 * yc
            vc = modulate(rmsnorm(hc, norm_g[l, 1]), csh2, csc2)
            if even:
                hc = hc + cg2 * swiglu(vc, ffn_w_gate[j], ffn_w_up[j], ffn_w_down[j])
            else:
                hc = hc + cg2 * moe(vc, moe_router[j], moe_w_gate[j], moe_w_up[j], moe_w_down[j])
    return rmsnorm(h, final_g)
```

```cpp
#include <hip/hip_runtime.h>
#include <cstdio>
#include <cstdint>

namespace pg8 {
#define PG8_LAS __attribute__((address_space(3)))
typedef unsigned short bf16_t;
typedef short bf16x8 __attribute__((ext_vector_type(8)));
typedef float f32x4 __attribute__((ext_vector_type(4)));
typedef unsigned u32x4 __attribute__((ext_vector_type(4)));
constexpr int BM = 256, BK = 64, HALF = 128, HTB = HALF * BK * 2, STAGE_BYTES = 8 * HTB, NXCD = 8, WGM = 8;

__host__ __device__ __forceinline__ int lds_byte(int r, int c) { const int st = (r >> 4) * 2 + (c >> 5), rr = r & 15, cc = c & 31, ob = rr * 64 + cc * 2; return st * 1024 + (ob ^ (((ob >> 9) & 1) << 5)); }
__host__ __device__ __forceinline__ void stage_rc(int b, int& R, int& C) { const int st = b / 1024, sb = b % 1024, swz = sb ^ (((sb >> 9) & 1) << 5); R = (st >> 1) * 16 + swz / 64; C = (st & 1) * 32 + (swz % 64) / 2; }
__host__ __device__ __forceinline__ int perm32(int rho) { const int n = rho >> 4, i = rho & 15; return 8 * (i >> 2) + 4 * n + (i & 3); }

struct Unit { int pm, pn; };
struct Gemm { const bf16_t* A; const bf16_t* Bt; int lda, ldb, K; };

struct StaticOrder {
    int nM, nN, nwg, G, c;
    __device__ void init(int M, int N, int G_, int c_) { nM = M / BM; nN = N / BM; nwg = nM * nN; G = G_; c = c_; }
    __device__ bool next(int i, Unit& u) const {
        const long L = (long)i * G + c; if (L >= nwg) return false;
        int wgid = (int)L; { const int q = nwg / NXCD, r = nwg % NXCD, xcd = wgid % NXCD, off = wgid / NXCD; wgid = (xcd < r ? xcd * (q + 1) : r * (q + 1) + (xcd - r) * q) + off; }
        const int nig = WGM * nN, gid = wgid / nig, fm = gid * WGM, gsz = (nM - fm) < WGM ? (nM - fm) : WGM;
        u.pm = fm + ((wgid % nig) % gsz); u.pn = (wgid % nig) / gsz; return true;
    }
};
struct PoolOrder {
    int nrt, talloc, G, c;
    __device__ bool next(int i, Unit& u) const { const int L = i * G + c; if (L >= 4 * nrt) return false; const int g = L / nrt, rt = L - g * nrt; u.pm = g * talloc + rt; u.pn = g; return true; }
};
struct MoeOrder {
    int t0, nrt, nct, G, c; int ts1, ts2, ts3, ts4, ts5, ts6, ts7;
    __device__ bool next(int i, Unit& u) const {
        const int L = i * G + c; if (L >= nrt * nct) return false;
        const int ct = L / nrt, rt = t0 + (L - ct * nrt);
        const int e = (rt >= ts1) + (rt >= ts2) + (rt >= ts3) + (rt >= ts4) + (rt >= ts5) + (rt >= ts6) + (rt >= ts7);
        u.pm = rt; u.pn = e * nct + ct; return true;
    }
};

__device__ __forceinline__ unsigned cvt_pk_bf16(float lo, float hi) { unsigned r; asm volatile("v_cvt_pk_bf16_f32 %0, %1, %2" : "=v"(r) : "v"(lo), "v"(hi)); return r; }

template <class Epi, class Sched, bool ALIGN_EPI>
__device__ __forceinline__ void gemm_phase(PG8_LAS unsigned char* lds, const Gemm g, const Sched& S, const Epi& E) {
    int tid_ = threadIdx.x; asm volatile("" : "+v"(tid_));
    const int tid = tid_, wid = __builtin_amdgcn_readfirstlane(tid >> 6), lane = tid & 63, wr = wid >> 2, wc = wid & 3, fr = lane & 15, fq = lane >> 4;
    int K_ = g.K; asm volatile("" : "+s"(K_));
    const int K = K_, nt = K / BK;
    unsigned voffA[2], voffB[2];
#pragma unroll
    for (int i = 0; i < 2; ++i) { int R, C; stage_rc(tid * 16 + i * 8192, R, C); const int Rb = Epi::PERM ? ((R & ~31) + perm32(R & 31)) : R;
        voffA[i] = (unsigned)(R * g.lda + C) * 2u; voffB[i] = (unsigned)(Rb * g.ldb + C) * 2u; }
    const size_t kstep = (size_t)(BK * 2);
    const size_t hstepA = (size_t)HALF * g.lda * 2, hstepB = (size_t)HALF * g.ldb * 2;
    const size_t tstepA = 2 * hstepA, tstepB = 2 * hstepB;
    const unsigned ldsw = (unsigned)wid * 1024u;
    const int aoff = lds_byte(wr * 64 + fr, fq * 8), boff = lds_byte(wc * 32 + fr, fq * 8);
#define PG8_SA(b, h) (((b) * 2 + (h)) * HTB)
#define PG8_SB(b, h) ((4 + (b) * 2 + (h)) * HTB)
#define PG8_STAGE(bufoff, gbase, voff) do { _Pragma("unroll") for (int _i = 0; _i < 2; ++_i) \
        __builtin_amdgcn_global_load_lds((const unsigned*)((const char*)(gbase) + (voff)[_i]), (PG8_LAS unsigned*)(lds + (bufoff) + ldsw + _i * 8192), 16, 0, 0); } while (0)
#define PG8_LDA(dst, b, h) do { _Pragma("unroll") for (int m = 0; m < 4; ++m) _Pragma("unroll") for (int k = 0; k < 2; ++k) dst[m][k] = *(const PG8_LAS bf16x8*)(lds + PG8_SA(b, h) + aoff + m * 2048 + k * 1024); } while (0)
#define PG8_LDB(dst, b, h) do { _Pragma("unroll") for (int n = 0; n < 2; ++n) _Pragma("unroll") for (int k = 0; k < 2; ++k) dst[n][k] = *(const PG8_LAS bf16x8*)(lds + PG8_SB(b, h) + boff + n * 2048 + k * 1024); } while (0)
#define PG8_MMA(ai, bj, At, Bt) do { __builtin_amdgcn_s_setprio(1); _Pragma("unroll") for (int m = 0; m < 4; ++m) _Pragma("unroll") for (int n = 0; n < 2; ++n) _Pragma("unroll") for (int k = 0; k < 2; ++k) \
        acc[ai][bj][m][n] = __builtin_amdgcn_mfma_f32_16x16x32_bf16(Bt[n][k], At[m][k], acc[ai][bj][m][n], 0, 0, 0); __builtin_amdgcn_s_setprio(0); } while (0)
#define PG8_WAIT_V(n) asm volatile("s_waitcnt vmcnt(" #n ")" ::: "memory")
#define PG8_WAIT_L(n) asm volatile("s_waitcnt lgkmcnt(" #n ")" ::: "memory")
#define PG8_BAR __builtin_amdgcn_s_barrier()
#define PG8_SCHED __builtin_amdgcn_sched_barrier(0)
    Unit cur, nxt; int ui = 0;
    if (!S.next(0, cur)) return;
    f32x4 acc[2][2][4][2];
#pragma unroll
    for (int a = 0; a < 2; ++a)
#pragma unroll
        for (int b = 0; b < 2; ++b)
#pragma unroll
            for (int m = 0; m < 4; ++m)
#pragma unroll
                for (int n = 0; n < 2; ++n) acc[a][b][m][n] = (f32x4){0.f, 0.f, 0.f, 0.f};
    bf16x8 At[4][2], B0[2][2], B1[2][2];
    const char* cA = (const char*)g.A + (size_t)cur.pm * tstepA; const char* cB = (const char*)g.Bt + (size_t)cur.pn * tstepB;
    PG8_STAGE(PG8_SB(0, 0), cB, voffB); PG8_STAGE(PG8_SB(0, 1), cB + hstepB, voffB); PG8_STAGE(PG8_SA(0, 0), cA, voffA); PG8_STAGE(PG8_SA(0, 1), cA + hstepA, voffA);
    if (wr == 1) PG8_BAR;
    PG8_WAIT_V(2); PG8_BAR;
    PG8_STAGE(PG8_SB(1, 0), cB + kstep, voffB); PG8_STAGE(PG8_SA(1, 0), cA + kstep, voffA); PG8_STAGE(PG8_SB(1, 1), cB + hstepB + kstep, voffB);
    PG8_WAIT_V(6); PG8_BAR;
    for (;;) {
        const bool has_next = S.next(ui + 1, nxt);
        const char* nA = has_next ? (const char*)g.A + (size_t)nxt.pm * tstepA : cA; const char* nB = has_next ? (const char*)g.Bt + (size_t)nxt.pn * tstepB : cB;
#pragma unroll 1
        for (int t = 0; t < nt; t += 2) {
            const bool last = (t == nt - 2);
            const char* a1 = cA + (size_t)(t + 1) * kstep;
            const char* a2 = last ? nA : cA + (size_t)(t + 2) * kstep; const char* b2 = last ? nB : cB + (size_t)(t + 2) * kstep;
            const char* a3 = a2 + kstep; const char* b3 = b2 + kstep;
            PG8_LDB(B0, 0, 0); PG8_LDB(B1, 0, 1); PG8_SCHED; PG8_LDA(At, 0, 0); PG8_STAGE(PG8_SA(1, 1), a1 + hstepA, voffA);
            PG8_WAIT_V(8); PG8_WAIT_L(0); PG8_BAR; PG8_MMA(0, 0, At, B0); PG8_MMA(0, 1, At, B1); PG8_BAR; PG8_SCHED;
            PG8_LDA(At, 0, 1); PG8_STAGE(PG8_SB(0, 0), b2, voffB); PG8_STAGE(PG8_SB(0, 1), b2 + hstepB, voffB); PG8_STAGE(PG8_SA(0, 0), a2, voffA);
            PG8_WAIT_V(8); PG8_WAIT_L(0); PG8_BAR; PG8_MMA(1, 0, At, B0); PG8_MMA(1, 1, At, B1); PG8_BAR; PG8_SCHED;
            PG8_LDB(B0, 1, 0); PG8_LDB(B1, 1, 1); PG8_SCHED; PG8_LDA(At, 1, 0); PG8_STAGE(PG8_SA(0, 1), a2 + hstepA, voffA);
            PG8_WAIT_V(8); PG8_WAIT_L(0); PG8_BAR; PG8_MMA(0, 0, At, B0); PG8_MMA(0, 1, At, B1); PG8_BAR; PG8_SCHED;
            PG8_LDA(At, 1, 1); PG8_STAGE(PG8_SB(1, 0), b3, voffB); PG8_STAGE(PG8_SB(1, 1), b3 + hstepB, voffB); PG8_STAGE(PG8_SA(1, 0), a3, voffA);
            PG8_WAIT_V(8); PG8_WAIT_L(0); PG8_BAR; PG8_MMA(1, 0, At, B0); PG8_MMA(1, 1, At, B1); PG8_BAR; PG8_SCHED;
        }
        if constexpr (ALIGN_EPI) { if (wr == 0) PG8_BAR; }
        E(acc, cur, wr, wc, fr, fq);
        if (!has_next) break;
#pragma unroll
        for (int a = 0; a < 2; ++a)
#pragma unroll
            for (int b = 0; b < 2; ++b)
#pragma unroll
                for (int m = 0; m < 4; ++m)
#pragma unroll
                    for (int n = 0; n < 2; ++n) acc[a][b][m][n] = (f32x4){0.f, 0.f, 0.f, 0.f};
        cur = nxt; cA = nA; cB = nB; ++ui;
        if constexpr (ALIGN_EPI) { if (wr == 1) PG8_BAR; }
    }
    PG8_WAIT_V(0);
    if constexpr (!ALIGN_EPI) { if (wr == 0) PG8_BAR; }
    PG8_BAR;
#undef PG8_SA
#undef PG8_SB
#undef PG8_STAGE
#undef PG8_LDA
#undef PG8_LDB
#undef PG8_MMA
#undef PG8_WAIT_V
#undef PG8_WAIT_L
#undef PG8_BAR
#undef PG8_SCHED
}
}

constexpr int NWAVES = 8;
constexpr int DM = 1024, NB = 16, SEQ = 2048, CTXL = 256;
constexpr int M = NB * SEQ, MC = NB * CTXL, MT = M + MC;
constexpr int QL = 384, KVL = 256, ROPE = 32, HW = 512, NH = 8, QKD = 96, VD = 64;
constexpr int INW = 3232, INP = 3328;
constexpr int DFF = 2816, NE = 8, DFE = 3584, NMOD = 6 * DM;
constexpr int NHH = 4, HK = 128;
constexpr float EPS = 1e-6f;
constexpr int MAXT = 296;
constexpr int HALFT = 148;

constexpr size_t MiB = 1u << 20;
constexpr size_t WS_CTL = 0, CTL_ZERO_BYTES = 1 * MiB;
constexpr size_t WS_MODV = 1 * MiB;
constexpr size_t WS_ROPE = 3 * MiB;
constexpr size_t WS_CNT = 3 * MiB + 64 * 1024;
constexpr size_t WS_TST = 3 * MiB + 128 * 1024;
constexpr size_t WS_EIDX = 4 * MiB, WS_GATE = 4 * MiB + 512 * 1024, WS_POS = 5 * MiB;
constexpr size_t WS_RSQ = 6 * MiB, WS_RSKV = 6 * MiB + 256 * 1024;
constexpr size_t WS_HC = 8 * MiB;
constexpr size_t WS_WIN = 24 * MiB, WS_WUQ = 37 * MiB, WS_WUKV = 39 * MiB, WS_WOUT = 40 * MiB, WS_WGU = 44 * MiB, WS_WDN = 66 * MiB, WS_WPOOL = 77 * MiB;
constexpr size_t WS_U = 80 * MiB;
constexpr size_t WS_X = 152 * MiB;
constexpr size_t WS_CQ = WS_X, WS_CKV = 179 * MiB, WS_KR = 197 * MiB, WS_KRR = 200 * MiB, WS_HQ = 203 * MiB  ;
constexpr size_t WS_QB = 383 * MiB, WS_KN = 437 * MiB, WS_VV = 473 * MiB, WS_OF = 509 * MiB, WS_OB = 581 * MiB, WS_MIX = 653 * MiB, WS_HID = WS_X;
constexpr size_t WS_MWGU = WS_X, WS_MWDN = 264 * MiB, WS_POOLED = 320 * MiB, WS_VG = 392 * MiB, WS_HIDM = 540 * MiB, WS_END = 800 * MiB;
constexpr size_t HSEG = (size_t)MT * HW;
static_assert(WS_HQ + 5 * HSEG * 2 <= WS_QB && WS_MIX + (size_t)MT * DM * 2 <= WS_END && WS_HID + (size_t)MT * DFF * 2 <= WS_QB, "ws map even");
static_assert(WS_HIDM + (size_t)HALFT * 256 * DFE * 2 <= WS_END && WS_VG + (size_t)MAXT * 256 * DM * 2 <= WS_HIDM && WS_MWDN + (size_t)NE * DM * DFE * 2 <= WS_POOLED && WS_MWGU + (size_t)NE * 2 * DFE * DM * 2 <= WS_MWDN, "ws map odd");
constexpr int CW_BAR = 4096;

constexpr int RING_OFF = 0, RING_BYTES = 131072;
constexpr int LDSCTL_OFF = RING_BYTES, MISC_OFF = LDSCTL_OFF + 320;
constexpr int LDS_BYTES = 147456;

#define GAS __attribute__((address_space(1)))
#define LAS __attribute__((address_space(3)))
typedef unsigned short bf16;
typedef unsigned v4u __attribute__((ext_vector_type(4)));
typedef unsigned v2u __attribute__((ext_vector_type(2)));
typedef float f32x4 __attribute__((ext_vector_type(4)));
typedef GAS unsigned gu32;
#define RLX_AGENT __ATOMIC_RELAXED, __HIP_MEMORY_SCOPE_AGENT
#define LDS_WAIT() asm volatile("s_waitcnt lgkmcnt(0)" ::: "memory")
__device__ __forceinline__ unsigned f2bf(float f) { unsigned u = __builtin_bit_cast(unsigned, f); return (u + 0x7fffu + ((u >> 16) & 1u)) >> 16; }
__device__ __forceinline__ unsigned pk2(float lo, float hi) { return f2bf(lo) | (f2bf(hi) << 16); }
__device__ __forceinline__ float bf2f(unsigned short b) { return __uint_as_float((unsigned)b << 16); }
__device__ __forceinline__ float bflo(unsigned w) { return __uint_as_float(w << 16); }
__device__ __forceinline__ float bfhi(unsigned w) { return __uint_as_float(w & 0xffff0000u); }
__device__ __forceinline__ float sigmoidf_(float x) { return 1.0f / (1.0f + __expf(-x)); }
__device__ __forceinline__ float siluf_(float x) { return x / (1.0f + __expf(-x)); }

#define XB_TMO      128
#define XB_XCNT(j)  (256  + 64 * (j))
#define XB_XSUB(j)  (1280 + 64 * (j))
#define XB_XGEN(j)  (2304 + 64 * (j))
#define XB_TOP      3328
#define XB_TOPGEN   3392
#define XCD_BAR_WORDS 3456
#define XB_SPIN_CAP (1u << 22)
__device__ __forceinline__ unsigned xb_ld(unsigned* p)              { return __hip_atomic_load(p, __ATOMIC_RELAXED, __HIP_MEMORY_SCOPE_AGENT); }
__device__ __forceinline__ unsigned xb_add(unsigned* p, unsigned v) { return __hip_atomic_fetch_add(p, v, __ATOMIC_RELAXED, __HIP_MEMORY_SCOPE_AGENT); }
__device__ __forceinline__ unsigned xb_xcc_id() { return (unsigned)__builtin_amdgcn_s_getreg((3 << 11) | 20) & 0xFu; }
#define XB_SPIN(cond, bar) do { unsigned _sp = 0; while (cond) { __builtin_amdgcn_s_sleep(1); \
    if ((++_sp & 255u) == 0u) { if (xb_ld(&(bar)[XB_TMO])) break; if (_sp > XB_SPIN_CAP) { atomicAdd(&(bar)[XB_TMO], 1u); break; } } } } while (0)
struct XcdBarrier { unsigned* bar; unsigned x; volatile LAS unsigned* st; };
__device__ __forceinline__ XcdBarrier xcd_barrier_post(unsigned* bar, volatile LAS unsigned* st) {
    XcdBarrier b; b.bar = bar; b.x = xb_xcc_id(); b.st = st;
    if (threadIdx.x == 0) (void)xb_add(&bar[XB_XCNT(b.x)], 1u);
    return b;
}
__device__ __forceinline__ void xcd_barrier_complete(unsigned* bar, unsigned x, unsigned& nloc, unsigned& nx) {
    const unsigned G = gridDim.x * gridDim.y * gridDim.z;
    unsigned sum, cnt, mine, sp = 0u;
    for (;;) {
        sum = 0u; cnt = 0u; mine = 0u;
#pragma unroll
        for (unsigned j = 0; j < 16; ++j) { const unsigned c = xb_ld(&bar[XB_XCNT(j)]); sum += c; cnt += (c > 0u) ? 1u : 0u; mine = (j == x) ? c : mine; }
        if (sum == G) break;
        __builtin_amdgcn_s_sleep(1);
        if ((++sp & 255u) == 0u) { if (xb_ld(&bar[XB_TMO])) break; if (sp > XB_SPIN_CAP) { atomicAdd(&bar[XB_TMO], 1u); break; } }
    }
    nloc = mine > 0u ? mine : 1u; nx = cnt > 0u ? cnt : 1u;
}
__device__ __forceinline__ void xcd_barrier(const XcdBarrier& b) {
    asm volatile("s_waitcnt vmcnt(0)" ::: "memory");
    __syncthreads();
    if (threadIdx.x == 0) {
        unsigned* bar = b.bar;
        __builtin_amdgcn_s_waitcnt(0);
        unsigned nloc = b.st[0], nx = b.st[1];
        if (nloc == 0u) { xcd_barrier_complete(bar, b.x, nloc, nx); b.st[0] = nloc; b.st[1] = nx; }
        const unsigned old = xb_add(&bar[XB_XSUB(b.x)], 1u);
        const unsigned gen = old / nloc;
        if (old + 1u == (gen + 1u) * nloc) {
            __builtin_amdgcn_fence(__ATOMIC_RELEASE, "agent");
            asm volatile("s_waitcnt vmcnt(0)" ::: "memory");
            const unsigned og = xb_add(&bar[XB_TOP], 1u);
            const unsigned tg = og / nx;
            if (og + 1u == (tg + 1u) * nx) xb_add(&bar[XB_TOPGEN], 1u);
            else XB_SPIN(xb_ld(&bar[XB_TOPGEN]) == tg, bar);
            __builtin_amdgcn_fence(__ATOMIC_ACQUIRE, "agent");
            xb_add(&bar[XB_XGEN(b.x)], 1u);
            asm volatile("s_waitcnt vmcnt(0)" ::: "memory");
        } else {
            XB_SPIN(xb_ld(&bar[XB_XGEN(b.x)]) == gen, bar);
            __builtin_amdgcn_fence(__ATOMIC_ACQUIRE, "agent");
            asm volatile("s_waitcnt vmcnt(0)" ::: "memory");
        }
    }
    __syncthreads();
}

struct Args { const float* in[26]; float* out; unsigned char* ws; };
struct Frame {
    LAS unsigned char* lds;
    int tid, lane, wave, G, vcu;
    const float* const* in; float* out; unsigned char* ws;
};
__device__ __forceinline__ float wave_sum(float v) {
#pragma unroll
    for (int o = 1; o < 64; o <<= 1) v += __shfl_xor(v, o);
    return v;
}

__device__ __forceinline__ void fresh(Frame& F) { int t = threadIdx.x; asm volatile("" : "+v"(t)); F.tid = t; F.lane = t & 63; F.wave = __builtin_amdgcn_readfirstlane(t >> 6); }

__device__ __forceinline__ void conv_item(const float* W, int ldw, bf16* WT, int ldd, int k0, int n0, int drow0, const float* kscale, float gscale, LAS float* scr, int lane) {
#pragma unroll 8
    for (int i = 0; i < 32; ++i) { const int kk = 2 * i + (lane >> 5); float w = W[(size_t)(k0 + kk) * ldw + n0 + (lane & 31)]; if (kscale) w *= kscale[k0 + kk]; scr[kk * 33 + (lane & 31)] = w * gscale; }
    LDS_WAIT(); asm volatile("" ::: "memory");
    const int c = lane & 7;
#pragma unroll
    for (int j = 0; j < 4; ++j) { const int n = (lane >> 3) + 8 * j; const LAS float* s = scr + (8 * c) * 33 + n;
        v4u o; o.x = pk2(s[0 * 33], s[1 * 33]); o.y = pk2(s[2 * 33], s[3 * 33]); o.z = pk2(s[4 * 33], s[5 * 33]); o.w = pk2(s[6 * 33], s[7 * 33]);
        *(v4u*)(WT + (size_t)(drow0 + n) * ldd + k0 + 8 * c) = o; }
    LDS_WAIT(); asm volatile("" ::: "memory");
}
__device__ __forceinline__ int conv_rowmap(int mode, int n0, int off) {
    if (mode == 0) return n0 + off;
    if (mode == 1) { if (n0 < 384) return n0; if (n0 < 640) return 512 + (n0 - 384); if (n0 < 672) return 384; return 768 + (n0 - 672); }
    return 256 * (n0 >> 7) + (n0 & 127) + off;
}
__device__ __forceinline__ void conv_matrix(Frame& F, const float* W, int K, int N, bf16* WT, int ldd, int mode, int off, const float* kscale, float gscale) {
    LAS float* scr = (LAS float*)(F.lds + RING_OFF + F.wave * 16384);
    const int gw = F.vcu * NWAVES + F.wave, NGW = F.G * NWAVES;
    const int nblk = N / 32, nitems = (K / 64) * nblk;
    for (int it = gw; it < nitems; it += NGW) { const int kb = it / nblk, nb = it % nblk; conv_item(W, N, WT, ldd, 64 * kb, 32 * nb, conv_rowmap(mode, 32 * nb, off), kscale, gscale, scr, F.lane); }
}

__device__ __forceinline__ int row_bidx(int row) { return row < M ? row / SEQ : NB; }

struct RowArgs {
    const float* hin_l; const float* hin_c; float* hout_l; float* hout_c;
    const float* g;
    const float* modl;
    int shoff, scoff;
    bf16* U;
    const bf16* Y; const int* pos; const float* gate; const float* modprev;
    const float* router; int* eidx; float* gout; int* cnt;
};
template <bool COMBINE, int OUTMODE, bool ROUTER>
__device__ __forceinline__ void row_phase(Frame& F, const RowArgs& A, int nrows) {
    fresh(F);
    const int rpw = (nrows + F.G - 1) / F.G;
    LAS int* lcnt = (LAS int*)(F.lds + RING_OFF);
    if (ROUTER) { if (F.tid < 8) lcnt[F.tid] = 0; __syncthreads(); }
    for (int i = F.wave; i < rpw; i += NWAVES) {
        const int row = (int)blockIdx.x * rpw + i; if (row >= nrows) break;
        const bool lat = row < M; const int bidx = lat ? row / SEQ : NB;
        const float* hr = lat ? A.hin_l + (size_t)row * DM : A.hin_c + (size_t)(row - M) * DM;
        f32x4 v[4];
#pragma unroll
        for (int j = 0; j < 4; ++j) v[j] = *(const f32x4*)(hr + 4 * F.lane + 256 * j);
        if (COMBINE) {
            const int pa = A.pos[2 * row], pb = A.pos[2 * row + 1]; const float ga = A.gate[2 * row], gb = A.gate[2 * row + 1];
            const float* g2 = A.modprev + bidx * NMOD + 5 * DM;
#pragma unroll
            for (int j = 0; j < 4; ++j) { const int col = 4 * F.lane + 256 * j;
                const v2u ya = *(const v2u*)(A.Y + (size_t)pa * DM + col), yb = *(const v2u*)(A.Y + (size_t)pb * DM + col); const f32x4 gv = *(const f32x4*)(g2 + col);
                v[j].x += gv.x * (ga * bflo(ya.x) + gb * bflo(yb.x)); v[j].y += gv.y * (ga * bfhi(ya.x) + gb * bfhi(yb.x));
                v[j].z += gv.z * (ga * bflo(ya.y) + gb * bflo(yb.y)); v[j].w += gv.w * (ga * bfhi(ya.y) + gb * bfhi(yb.y)); }
            if (OUTMODE != 2) { float* ho = lat ? A.hout_l + (size_t)row * DM : A.hout_c + (size_t)(row - M) * DM;
#pragma unroll
                for (int j = 0; j < 4; ++j) *(f32x4*)(ho + 4 * F.lane + 256 * j) = v[j]; }
        }
        float s = 0.f;
#pragma unroll
        for (int j = 0; j < 4; ++j) s += (v[j].x * v[j].x + v[j].y * v[j].y) + (v[j].z * v[j].z + v[j].w * v[j].w);
        const float rstd = rsqrtf(wave_sum(s) * (1.0f / DM) + EPS);
        if (OUTMODE == 2) {
            float* ho = A.hout_l + (size_t)row * DM;
#pragma unroll
            for (int j = 0; j < 4; ++j) { const int col = 4 * F.lane + 256 * j; const f32x4 gv = *(const f32x4*)(A.g + col); *(f32x4*)(ho + col) = v[j] * rstd * gv; }
        } else {
            const float* sh = A.modl + bidx * NMOD + A.shoff; const float* sc = A.modl + bidx * NMOD + A.scoff;
            float lg[8];
            if (ROUTER) {
#pragma unroll
                for (int e = 0; e < 8; ++e) lg[e] = 0.f;
            }
#pragma unroll
            for (int j = 0; j < 4; ++j) { const int col = 4 * F.lane + 256 * j; const f32x4 gv = *(const f32x4*)(A.g + col), shv = *(const f32x4*)(sh + col), scv = *(const f32x4*)(sc + col);
                f32x4 y = v[j] * rstd * gv * (scv + 1.0f) + shv;
                v2u o; o.x = pk2(y.x, y.y); o.y = pk2(y.z, y.w); *(v2u*)(A.U + (size_t)row * DM + col) = o;
                if (ROUTER) {
#pragma unroll
                    for (int q = 0; q < 4; ++q) { const f32x4 r0 = *(const f32x4*)(A.router + (size_t)(col + q) * 8), r1 = *(const f32x4*)(A.router + (size_t)(col + q) * 8 + 4); const float yy = y[q];
                        lg[0] += yy * r0.x; lg[1] += yy * r0.y; lg[2] += yy * r0.z; lg[3] += yy * r0.w; lg[4] += yy * r1.x; lg[5] += yy * r1.y; lg[6] += yy * r1.z; lg[7] += yy * r1.w; } }
            }
            if (ROUTER) {
#pragma unroll
                for (int e = 0; e < 8; ++e) lg[e] = wave_sum(lg[e]);
                int i0 = 0; float v0 = lg[0];
#pragma unroll
                for (int e = 1; e < 8; ++e) if (lg[e] > v0) { v0 = lg[e]; i0 = e; }
                int i1 = -1; float v1 = -INFINITY;
#pragma unroll
                for (int e = 0; e < 8; ++e) if (e != i0 && lg[e] > v1) { v1 = lg[e]; i1 = e; }
                const float g0 = 1.0f / (1.0f + __expf(v1 - v0));
                if (F.lane == 0) { A.eidx[2 * row] = i0; A.eidx[2 * row + 1] = i1; A.gout[2 * row] = g0; A.gout[2 * row + 1] = 1.0f - g0; atomicAdd((int*)&lcnt[i0], 1); atomicAdd((int*)&lcnt[i1], 1); }
            }
        }
    }
    if (ROUTER) { __syncthreads(); if (F.tid < 8) A.cnt[blockIdx.x * 8 + F.tid] = lcnt[F.tid]; __syncthreads(); }
}

using pg8::Unit; using pg8::cvt_pk_bf16;
__device__ __forceinline__ v4u pack8(const f32x4& a, const f32x4& b) { v4u w; w.x = cvt_pk_bf16(a[0], a[1]); w.y = cvt_pk_bf16(a[2], a[3]); w.z = cvt_pk_bf16(b[0], b[1]); w.w = cvt_pk_bf16(b[2], b[3]); return w; }
struct EpiIn {
    static constexpr bool PERM = true;
    bf16 *CQ, *KR, *CKV, *H5;
    __device__ __forceinline__ void operator()(const f32x4 (&acc)[2][2][4][2], const Unit& u, int wr, int wc, int fr, int fq) const {
        const int row0 = u.pm * 256 + wr * 64 + fr;
#pragma unroll
        for (int bj = 0; bj < 2; ++bj) {
            const int col = u.pn * 256 + bj * 128 + wc * 32 + 8 * fq;
            bf16* base; int ld;
            if (col < 384) { base = CQ + col; ld = QL; }
            else if (col < 416) { base = KR + (col - 384); ld = ROPE; }
            else if (col < 512) { base = nullptr; ld = 0; }
            else if (col < 768) { base = CKV + (col - 512); ld = KVL; }
            else { const int c2 = col - 768; base = H5 + (size_t)(c2 >> 9) * HSEG + (c2 & 511); ld = HW; }
            if (base) {
#pragma unroll
                for (int ai = 0; ai < 2; ++ai)
#pragma unroll
                    for (int m = 0; m < 4; ++m) { const int row = row0 + ai * 128 + m * 16; *(v4u*)(base + (size_t)row * ld) = pack8(acc[ai][bj][m][0], acc[ai][bj][m][1]); }
            }
        }
    }
};
struct EpiQ {
    static constexpr bool PERM = true;
    bf16* O; const float* rs;
    __device__ __forceinline__ void operator()(const f32x4 (&acc)[2][2][4][2], const Unit& u, int wr, int wc, int fr, int fq) const {
        const int row0 = u.pm * 256 + wr * 64 + fr;
#pragma unroll
        for (int ai = 0; ai < 2; ++ai)
#pragma unroll
            for (int m = 0; m < 4; ++m) { const int row = row0 + ai * 128 + m * 16; const float sc = rs[row];
#pragma unroll
                for (int bj = 0; bj < 2; ++bj) { const int col = u.pn * 256 + bj * 128 + wc * 32 + 8 * fq; *(v4u*)(O + (size_t)row * 768 + col) = pack8(acc[ai][bj][m][0] * sc, acc[ai][bj][m][1] * sc); } }
    }
};
struct EpiKV {
    static constexpr bool PERM = true;
    bf16* KNp; bf16* VVp; const float* rs;
    __device__ __forceinline__ void operator()(const f32x4 (&acc)[2][2][4][2], const Unit& u, int wr, int wc, int fr, int fq) const {
        const int row0 = u.pm * 256 + wr * 64 + fr;
#pragma unroll
        for (int ai = 0; ai < 2; ++ai)
#pragma unroll
            for (int m = 0; m < 4; ++m) { const int row = row0 + ai * 128 + m * 16; const float sc = rs[row];
#pragma unroll
                for (int bj = 0; bj < 2; ++bj) { const int col = u.pn * 256 + bj * 128 + wc * 32 + 8 * fq; const int hh = col >> 7, w = col & 127;
                    bf16* dst = (w < 64) ? KNp + (size_t)row * HW + hh * 64 + w : VVp + (size_t)row * HW + hh * 64 + (w - 64);
                    *(v4u*)dst = pack8(acc[ai][bj][m][0] * sc, acc[ai][bj][m][1] * sc); } }
    }
};
struct EpiResid {
    static constexpr bool PERM = false;
    const float* hin_l; const float* hin_c; float* hout_l; float* hout_c; const float* modl; int goff;
    __device__ __forceinline__ void operator()(const f32x4 (&acc)[2][2][4][2], const Unit& u, int wr, int wc, int fr, int fq) const {
        const int rowt = u.pm * 256; const bool lat = rowt < M; const int bidx = lat ? rowt / SEQ : NB;
        const float* gate = modl + bidx * NMOD + goff;
        const float* hi = lat ? hin_l + (size_t)rowt * DM : hin_c + (size_t)(rowt - M) * DM;
        float* ho = lat ? hout_l + (size_t)rowt * DM : hout_c + (size_t)(rowt - M) * DM;
        const int col0 = u.pn * 256 + wc * 32 + 4 * fq;
#pragma unroll
        for (int bj = 0; bj < 2; ++bj)
#pragma unroll
            for (int n = 0; n < 2; ++n) { const f32x4 gv = *(const f32x4*)(gate + col0 + bj * 128 + n * 16);
#pragma unroll
                for (int ai = 0; ai < 2; ++ai)
#pragma unroll
                    for (int m = 0; m < 4; ++m) { const int r = ai * 128 + wr * 64 + m * 16 + fr; const size_t off = (size_t)r * DM + col0 + bj * 128 + n * 16; const f32x4 hv = *(const f32x4*)(hi + off); *(f32x4*)(ho + off) = hv + gv * acc[ai][bj][m][n]; }
                asm volatile("" ::: "memory"); }
    }
};
struct EpiPool {
    static constexpr bool PERM = false;
    float* h_l; float* h_c; const float* modl; const float* bias; const float* scale; int talloc;
    __device__ __forceinline__ void operator()(const f32x4 (&acc)[2][2][4][2], const Unit& u, int wr, int wc, int fr, int fq) const {
        const int g = u.pn, rowt = (u.pm - g * talloc) * 256; const bool lat = rowt < M; const int bidx = lat ? rowt / SEQ : NB;
        const float* gate = modl + bidx * NMOD + 2 * DM;
        float* ho = lat ? h_l + (size_t)rowt * DM : h_c + (size_t)(rowt - M) * DM;
        const int col0 = g * 256 + wc * 32 + 4 * fq;
#pragma unroll
        for (int bj = 0; bj < 2; ++bj)
#pragma unroll
            for (int n = 0; n < 2; ++n) { const int c = col0 + bj * 128 + n * 16; const f32x4 gm = *(const f32x4*)(gate + c) * *(const f32x4*)(scale + c); const f32x4 gb = gm * *(const f32x4*)(bias + c);
#pragma unroll
                for (int ai = 0; ai < 2; ++ai)
#pragma unroll
                    for (int m = 0; m < 4; ++m) { const int r = ai * 128 + wr * 64 + m * 16 + fr; const size_t off = (size_t)r * DM + c; const f32x4 hv = *(const f32x4*)(ho + off); *(f32x4*)(ho + off) = hv + gm * acc[ai][bj][m][n] + gb; }
                asm volatile("" ::: "memory"); }
    }
};
struct EpiGateUp {
    static constexpr bool PERM = true;
    bf16* H; int ldh, nct, rowsub;
    __device__ __forceinline__ void operator()(const f32x4 (&acc)[2][2][4][2], const Unit& u, int wr, int wc, int fr, int fq) const {
        const int row0 = u.pm * 256 + wr * 64 + fr - rowsub; const int ct = u.pn % nct; const int col = ct * 128 + wc * 32 + 8 * fq;
#pragma unroll
        for (int ai = 0; ai < 2; ++ai)
#pragma unroll
            for (int m = 0; m < 4; ++m) { const int row = row0 + ai * 128 + m * 16; f32x4 o[2];
#pragma unroll
                for (int n = 0; n < 2; ++n)
#pragma unroll
                    for (int q = 0; q < 4; ++q) { const float gv = acc[ai][0][m][n][q], uv = acc[ai][1][m][n][q]; o[n][q] = gv * uv / (1.0f + __expf(-gv)); }
                *(v4u*)(H + (size_t)row * ldh + col) = pack8(o[0], o[1]); }
    }
};
struct EpiY {
    static constexpr bool PERM = true;
    bf16* Y; int nct;
    __device__ __forceinline__ void operator()(const f32x4 (&acc)[2][2][4][2], const Unit& u, int wr, int wc, int fr, int fq) const {
        const int row0 = u.pm * 256 + wr * 64 + fr; const int ct = u.pn % nct;
#pragma unroll
        for (int ai = 0; ai < 2; ++ai)
#pragma unroll
            for (int m = 0; m < 4; ++m) { const int row = row0 + ai * 128 + m * 16;
#pragma unroll
                for (int bj = 0; bj < 2; ++bj) { const int col = ct * 256 + bj * 128 + wc * 32 + 8 * fq; *(v4u*)(Y + (size_t)row * DM + col) = pack8(acc[ai][bj][m][0], acc[ai][bj][m][1]); } }
    }
};

__device__ __forceinline__ void p0_prologue(Frame& F) {
    fresh(F);
    unsigned char* ws = F.ws;
    const float qscale = 0.10206207261596577f * 1.4426950408889634f;
    for (int j = 0; j < 2; ++j) {
        conv_matrix(F, F.in[8] + (size_t)j * DM * INW, DM, INW, (bf16*)(ws + WS_WIN) + (size_t)j * INP * DM, DM, 1, 0, nullptr, 1.f);
        conv_matrix(F, F.in[11] + (size_t)j * QL * 768, QL, 768, (bf16*)(ws + WS_WUQ) + (size_t)j * 768 * QL, QL, 0, 0, F.in[9] + j * QL, qscale);
        conv_matrix(F, F.in[12] + (size_t)j * KVL * 1024, KVL, 1024, (bf16*)(ws + WS_WUKV) + (size_t)j * 1024 * KVL, KVL, 0, 0, F.in[10] + j * KVL, 1.f);
        conv_matrix(F, F.in[15] + (size_t)j * DM * DM, DM, DM, (bf16*)(ws + WS_WOUT) + (size_t)j * DM * DM, DM, 0, 0, nullptr, 1.f);
        conv_matrix(F, F.in[16] + (size_t)j * DM * DFF, DM, DFF, (bf16*)(ws + WS_WGU) + (size_t)j * 2 * DFF * DM, DM, 2, 0, nullptr, 1.f);
        conv_matrix(F, F.in[17] + (size_t)j * DM * DFF, DM, DFF, (bf16*)(ws + WS_WGU) + (size_t)j * 2 * DFF * DM, DM, 2, 128, nullptr, 1.f);
        conv_matrix(F, F.in[18] + (size_t)j * DFF * DM, DFF, DM, (bf16*)(ws + WS_WDN) + (size_t)j * DM * DFF, DFF, 0, 0, nullptr, 1.f);
        for (int g = 0; g < 4; ++g)
            conv_matrix(F, F.in[19] + (size_t)(j * 4 + g) * 65536, 256, 256, (bf16*)(ws + WS_WPOOL) + (size_t)(j * 4 + g) * 65536, 256, 0, 0, nullptr, 1.f);
    }
    __syncthreads();
    if (blockIdx.x == 0 && F.tid < 8) {
        float* TC = (float*)(ws + WS_ROPE); float* TS = TC + 512;
        double th = 1.0; for (int i = 0; i < F.tid; ++i) th *= 0.31622776601683794;
        const double x2 = th * th; double s = th, c = 1.0, ts = th, tc = 1.0;
        for (int n = 1; n <= 12; ++n) { tc *= -x2 / (double)((2 * n - 1) * (2 * n)); c += tc; ts *= -x2 / (double)((2 * n) * (2 * n + 1)); s += ts; }
        double cp = 1.0, sp = 0.0;
        for (int p = 0; p < 64; ++p) { TC[p * 8 + F.tid] = (float)cp; TS[p * 8 + F.tid] = (float)sp; const double ncp = cp * c - sp * s; sp = sp * c + cp * s; cp = ncp; }
    }
    {
        LAS float* sc = (LAS float*)(F.lds + RING_OFF);
        LAS float* red = sc + 17 * 1024;
        const int nitems = 4 * (NMOD / 64);
        if ((int)blockIdx.x < nitems) {
            for (int e = F.tid; e < 17 * 1024; e += 512) { const int r = e >> 10, k = e & 1023; const float x = (r < 16) ? F.in[1][r * 1024 + k] : F.in[3][k]; sc[e] = siluf_(x); }
            __syncthreads();
            for (int it = blockIdx.x; it < nitems; it += F.G) {
                const int l = it / (NMOD / 64), c0 = (it % (NMOD / 64)) * 64;
                const float* W = F.in[4] + (size_t)l * DM * NMOD + c0 + F.lane;
                float acc[17];
#pragma unroll
                for (int r = 0; r < 17; ++r) acc[r] = 0.f;
                const int kb = F.wave * 128;
                for (int k = 0; k < 128; k += 4) {
                    const float w0 = W[(size_t)(kb + k) * NMOD], w1 = W[(size_t)(kb + k + 1) * NMOD], w2 = W[(size_t)(kb + k + 2) * NMOD], w3 = W[(size_t)(kb + k + 3) * NMOD];
#pragma unroll
                    for (int r = 0; r < 17; ++r) { const f32x4 s4 = *(const LAS f32x4*)(sc + r * 1024 + kb + k); acc[r] += s4.x * w0 + s4.y * w1 + s4.z * w2 + s4.w * w3; }
                }
#pragma unroll
                for (int r = 0; r < 17; ++r) red[(F.wave * 17 + r) * 64 + F.lane] = acc[r];
                __syncthreads();
                for (int o = F.tid; o < 17 * 64; o += 512) { const int r = o >> 6, cc = o & 63; float s = 0.f;
#pragma unroll
                    for (int w = 0; w < 8; ++w) s += red[(w * 17 + r) * 64 + cc];
                    ((float*)(ws + WS_MODV))[(size_t)(l * 17 + r) * NMOD + c0 + cc] = s + F.in[5][l * NMOD + c0 + cc]; }
                __syncthreads();
            }
        }
    }
}

__device__ __forceinline__ void e3_phase(Frame& F) {
    fresh(F);
    unsigned char* ws = F.ws;
    const bf16* CQ = (const bf16*)(ws + WS_CQ); const bf16* CKV = (const bf16*)(ws + WS_CKV); const bf16* KR = (const bf16*)(ws + WS_KR); bf16* KRR = (bf16*)(ws + WS_KRR);
    float* RSQ = (float*)(ws + WS_RSQ); float* RSKV = (float*)(ws + WS_RSKV); const float* TC = (const float*)(ws + WS_ROPE); const float* TS = TC + 512;
    const int rpw = (MT + F.G - 1) / F.G;
    for (int i = F.wave; i < rpw; i += NWAVES) {
        const int row = (int)blockIdx.x * rpw + i; if (row >= MT) break;
        float s = 0.f;
        if (F.lane < 48) { const v4u w = *(const v4u*)(CQ + (size_t)row * QL + F.lane * 8);
            s = bflo(w.x) * bflo(w.x) + bfhi(w.x) * bfhi(w.x) + bflo(w.y) * bflo(w.y) + bfhi(w.y) * bfhi(w.y) + bflo(w.z) * bflo(w.z) + bfhi(w.z) * bfhi(w.z) + bflo(w.w) * bflo(w.w) + bfhi(w.w) * bfhi(w.w); }
        s = wave_sum(s); if (F.lane == 0) RSQ[row] = rsqrtf(s * (1.0f / QL) + EPS);
        s = 0.f;
        if (F.lane < 32) { const v4u w = *(const v4u*)(CKV + (size_t)row * KVL + F.lane * 8);
            s = bflo(w.x) * bflo(w.x) + bfhi(w.x) * bfhi(w.x) + bflo(w.y) * bflo(w.y) + bfhi(w.y) * bfhi(w.y) + bflo(w.z) * bflo(w.z) + bfhi(w.z) * bfhi(w.z) + bflo(w.w) * bflo(w.w) + bfhi(w.w) * bfhi(w.w); }
        s = wave_sum(s); if (F.lane == 0) RSKV[row] = rsqrtf(s * (1.0f / KVL) + EPS);
        const float x = (F.lane < 32) ? bf2f(KR[(size_t)row * ROPE + F.lane]) : 0.f; const float pr = __shfl_xor(x, 8);
        float o = x;
        if (row < M) { const int t = row % SEQ; const int p = ((F.lane >> 4) & 1) ? (t & 63) : (t >> 6); const int j = F.lane & 7; const float c = TC[p * 8 + j], sn = TS[p * 8 + j];
            o = ((F.lane >> 3) & 1) ? x * c + pr * sn : x * c - pr * sn; }
        if (F.lane < 32) KRR[(size_t)row * ROPE + F.lane] = (bf16)f2bf(o);
    }
}

__device__ __forceinline__ void attn_item(Frame& F, int qrow0, int nq, int h, bool rope_q, int a_row0, int a_n, int b_row0, int b_n) {
    unsigned char* ws = F.ws;
    const bf16* QB = (const bf16*)(ws + WS_QB); const bf16* KN = (const bf16*)(ws + WS_KN); const bf16* KRR = (const bf16*)(ws + WS_KRR); const bf16* VV = (const bf16*)(ws + WS_VV);
    bf16* MIX = (bf16*)(ws + WS_MIX); const float* TC = (const float*)(ws + WS_ROPE); const float* TS = TC + 512;
    LAS float* sK = (LAS float*)(F.lds + RING_OFF);
    LAS float* sV = sK + 64 * 96;
    const bool active = F.wave * 64 < nq; const int qrow = qrow0 + F.wave * 64 + F.lane;
    float q[96], o[64]; float mx = -INFINITY, l = 0.f;
#pragma unroll
    for (int d = 0; d < 64; ++d) o[d] = 0.f;
    if (active) {
#pragma unroll
        for (int c = 0; c < 12; ++c) { const v4u w = *(const v4u*)(QB + (size_t)qrow * 768 + h * 96 + c * 8);
            q[c * 8 + 0] = bflo(w.x); q[c * 8 + 1] = bfhi(w.x); q[c * 8 + 2] = bflo(w.y); q[c * 8 + 3] = bfhi(w.y); q[c * 8 + 4] = bflo(w.z); q[c * 8 + 5] = bfhi(w.z); q[c * 8 + 6] = bflo(w.w); q[c * 8 + 7] = bfhi(w.w); }
        if (rope_q) { const int t = qrow % SEQ;
#pragma unroll
            for (int a = 0; a < 2; ++a) { const int p = a ? (t & 63) : (t >> 6);
#pragma unroll
                for (int j = 0; j < 8; ++j) { const float c = TC[p * 8 + j], sn = TS[p * 8 + j]; const float x0 = q[64 + 16 * a + j], x1 = q[64 + 16 * a + 8 + j]; q[64 + 16 * a + j] = x0 * c - x1 * sn; q[64 + 16 * a + 8 + j] = x1 * c + x0 * sn; } } }
    } else {
#pragma unroll
        for (int d = 0; d < 96; ++d) q[d] = 0.f;
    }
    const int ntA = a_n / 64, nt = ntA + b_n / 64;
    for (int tt = 0; tt < nt; ++tt) {
        const int r0 = tt < ntA ? a_row0 + tt * 64 : b_row0 + (tt - ntA) * 64;
        __syncthreads();
        { const int key = F.tid >> 3, ch = F.tid & 7;
          const v4u w = *(const v4u*)(KN + (size_t)(r0 + key) * HW + h * 64 + ch * 8); LAS float* d = sK + key * 96 + ch * 8;
          *(LAS f32x4*)d = (f32x4){bflo(w.x), bfhi(w.x), bflo(w.y), bfhi(w.y)}; *(LAS f32x4*)(d + 4) = (f32x4){bflo(w.z), bfhi(w.z), bflo(w.w), bfhi(w.w)};
          const v4u v = *(const v4u*)(VV + (size_t)(r0 + key) * HW + h * 64 + ch * 8); LAS float* dv = sV + key * 64 + ch * 8;
          *(LAS f32x4*)dv = (f32x4){bflo(v.x), bfhi(v.x), bflo(v.y), bfhi(v.y)}; *(LAS f32x4*)(dv + 4) = (f32x4){bflo(v.z), bfhi(v.z), bflo(v.w), bfhi(v.w)};
          if (F.tid < 256) { const int k2 = F.tid >> 2, c2 = F.tid & 3; const v4u r = *(const v4u*)(KRR + (size_t)(r0 + k2) * ROPE + c2 * 8); LAS float* dr = sK + k2 * 96 + 64 + c2 * 8;
              *(LAS f32x4*)dr = (f32x4){bflo(r.x), bfhi(r.x), bflo(r.y), bfhi(r.y)}; *(LAS f32x4*)(dr + 4) = (f32x4){bflo(r.z), bfhi(r.z), bflo(r.w), bfhi(r.w)}; } }
        __syncthreads();
        if (active) {
#pragma unroll 1
            for (int key = 0; key < 64; ++key) {
                const LAS float* kr = sK + key * 96; float a0 = 0.f, a1 = 0.f, a2 = 0.f, a3 = 0.f;
#pragma unroll
                for (int d = 0; d < 96; d += 4) { const f32x4 k4 = *(const LAS f32x4*)(kr + d); a0 += q[d] * k4.x; a1 += q[d + 1] * k4.y; a2 += q[d + 2] * k4.z; a3 += q[d + 3] * k4.w; }
                const float sc = (a0 + a1) + (a2 + a3);
                const float mn = fmaxf(mx, sc); const float alpha = exp2f(mx - mn), p = exp2f(sc - mn); mx = mn; l = l * alpha + p;
                const LAS float* vr = sV + key * 64;
#pragma unroll
                for (int d = 0; d < 64; d += 4) { const f32x4 v4 = *(const LAS f32x4*)(vr + d); o[d] = o[d] * alpha + p * v4.x; o[d + 1] = o[d + 1] * alpha + p * v4.y; o[d + 2] = o[d + 2] * alpha + p * v4.z; o[d + 3] = o[d + 3] * alpha + p * v4.w; }
            }
        }
    }
    if (active) { const float rl = 1.0f / l;
#pragma unroll
        for (int c = 0; c < 8; ++c) { v4u w; w.x = pk2(o[c * 8] * rl, o[c * 8 + 1] * rl); w.y = pk2(o[c * 8 + 2] * rl, o[c * 8 + 3] * rl); w.z = pk2(o[c * 8 + 4] * rl, o[c * 8 + 5] * rl); w.w = pk2(o[c * 8 + 6] * rl, o[c * 8 + 7] * rl);
            *(v4u*)(MIX + (size_t)qrow * DM + h * 64 + c * 8) = w; } }
}
__device__ __forceinline__ void attn_phase(Frame& F, bool ctx_out) {
    fresh(F);
    const int nlat = NB * NH * 4, nctx = ctx_out ? NB * NH : 0;
    for (int it = blockIdx.x; it < nlat + nctx; it += F.G) {
        if (it < nlat) { const int b = it >> 5, h = (it >> 2) & 7, qc = it & 3; attn_item(F, b * SEQ + qc * 512, 512, h, true, b * SEQ, SEQ, M + b * CTXL, CTXL); }
        else { const int i2 = it - nlat, b = i2 >> 3, h = i2 & 7; attn_item(F, M + b * CTXL, CTXL, h, false, 0, 0, M + b * CTXL, CTXL); }
    }
    __syncthreads();
}

__device__ __forceinline__ void hgrn_phase(Frame& F, int j) {
    fresh(F);
    unsigned char* ws = F.ws;
    const bf16* HQ = (const bf16*)(ws + WS_HQ); const bf16* HFF = HQ + HSEG; const bf16* HFB = HQ + 2 * HSEG; const bf16* HI = HQ + 3 * HSEG;
    float* OF = (float*)(ws + WS_OF); float* OB = (float*)(ws + WS_OB);
    LAS float* sq = (LAS float*)(F.lds + RING_OFF);
    LAS float* sk = sq + 16 * 128;
    LAS float* sv = sk + 16 * 128;
    LAS float* part = sv + 16 * 64;
    for (int it = blockIdx.x; it < NB * NHH * 2 * 2; it += F.G) {
        const int vh = it & 1, dir = (it >> 1) & 1, hh = (it >> 2) & 3, b = it >> 4;
        const bf16* HF = dir ? HFB : HFF; float* OO = dir ? OB : OF;
        const int ss = F.tid >> 5, sub = F.tid & 31;
        float oml[4];
#pragma unroll
        for (int q = 0; q < 4; ++q) { float lb = 0.f; if (j == 1) { const int ci = dir * HW + hh * HK + 4 * sub + q; const float l0 = F.in[13][ci], l1 = F.in[13][2 * HW + ci]; lb = 1.0f / (1.0f + __expf(l0 - l1)); } oml[q] = 1.0f - lb; }
        float S[16];
#pragma unroll
        for (int q = 0; q < 16; ++q) S[q] = 0.f;
        const int kg = F.wave * 16;
        for (int blk = 0; blk < (CTXL + SEQ) / 16; ++blk) {
            const int i0 = blk * 16;
            __syncthreads();
            { const int i = i0 + ss; const int row = (i < CTXL) ? (M + b * CTXL + (dir ? CTXL - 1 - i : i)) : (b * SEQ + (dir ? SEQ - 1 - (i - CTXL) : (i - CTXL)));
              const v2u wq = *(const v2u*)(HQ + (size_t)row * HW + hh * HK + 4 * sub); const v2u wf = *(const v2u*)(HF + (size_t)row * HW + hh * HK + 4 * sub);
              const unsigned wv = *(const unsigned*)(HI + (size_t)row * HW + hh * HK + vh * 64 + 2 * sub);
              *(LAS f32x4*)(sq + ss * 128 + 4 * sub) = (f32x4){siluf_(bflo(wq.x)), siluf_(bfhi(wq.x)), siluf_(bflo(wq.y)), siluf_(bfhi(wq.y))};
              *(LAS f32x4*)(sk + ss * 128 + 4 * sub) = (f32x4){oml[0] * sigmoidf_(-bflo(wf.x)), oml[1] * sigmoidf_(-bfhi(wf.x)), oml[2] * sigmoidf_(-bflo(wf.y)), oml[3] * sigmoidf_(-bfhi(wf.y))};
              sv[ss * 64 + 2 * sub] = bflo(wv); sv[ss * 64 + 2 * sub + 1] = bfhi(wv); }
            __syncthreads();
#pragma unroll 4
            for (int s = 0; s < 16; ++s) {
                const float vv = sv[s * 64 + F.lane]; float po = 0.f;
#pragma unroll
                for (int q4 = 0; q4 < 4; ++q4) { const f32x4 k4 = *(const LAS f32x4*)(sk + s * 128 + kg + 4 * q4), q4v = *(const LAS f32x4*)(sq + s * 128 + kg + 4 * q4);
                    S[4 * q4 + 0] = fmaf(k4.x, vv - S[4 * q4 + 0], S[4 * q4 + 0]); po = fmaf(S[4 * q4 + 0], q4v.x, po);
                    S[4 * q4 + 1] = fmaf(k4.y, vv - S[4 * q4 + 1], S[4 * q4 + 1]); po = fmaf(S[4 * q4 + 1], q4v.y, po);
                    S[4 * q4 + 2] = fmaf(k4.z, vv - S[4 * q4 + 2], S[4 * q4 + 2]); po = fmaf(S[4 * q4 + 2], q4v.z, po);
                    S[4 * q4 + 3] = fmaf(k4.w, vv - S[4 * q4 + 3], S[4 * q4 + 3]); po = fmaf(S[4 * q4 + 3], q4v.w, po); }
                part[(s * 8 + F.wave) * 64 + F.lane] = po;
            }
            __syncthreads();
#pragma unroll
            for (int r = 0; r < 2; ++r) { const int oi = F.tid + 512 * r; const int s = oi >> 6, v = oi & 63; float a = 0.f;
#pragma unroll
                for (int w = 0; w < 8; ++w) a += part[(s * 8 + w) * 64 + v];
                const int i = i0 + s; const int row = (i < CTXL) ? (M + b * CTXL + (dir ? CTXL - 1 - i : i)) : (b * SEQ + (dir ? SEQ - 1 - (i - CTXL) : (i - CTXL)));
                OO[(size_t)row * HW + hh * HK + vh * 64 + v] = a; }
        }
    }
    __syncthreads();
}

__device__ __forceinline__ void e8_phase(Frame& F, int j, int nrows) {
    fresh(F);
    unsigned char* ws = F.ws;
    const float* OF = (const float*)(ws + WS_OF); const float* OB = (const float*)(ws + WS_OB); const bf16* HG = (const bf16*)(ws + WS_HQ) + 4 * HSEG; bf16* MIX = (bf16*)(ws + WS_MIX);
    const float* gn = F.in[14] + j * HK;
    const int rpw = (nrows + F.G - 1) / F.G;
    for (int i = F.wave; i < rpw; i += NWAVES) {
        const int row = (int)blockIdx.x * rpw + i; if (row >= nrows) break;
        const int col = 8 * F.lane;
        const f32x4 a0 = *(const f32x4*)(OF + (size_t)row * HW + col), a1 = *(const f32x4*)(OF + (size_t)row * HW + col + 4), b0 = *(const f32x4*)(OB + (size_t)row * HW + col), b1 = *(const f32x4*)(OB + (size_t)row * HW + col + 4);
        f32x4 x0 = a0 + b0, x1 = a1 + b1;
        float s = (x0.x * x0.x + x0.y * x0.y) + (x0.z * x0.z + x0.w * x0.w) + (x1.x * x1.x + x1.y * x1.y) + (x1.z * x1.z + x1.w * x1.w);
        s += __shfl_xor(s, 1); s += __shfl_xor(s, 2); s += __shfl_xor(s, 4); s += __shfl_xor(s, 8);
        const float rstd = rsqrtf(s * (1.0f / HK) + EPS);
        const int vv = col & 127; const f32x4 g0 = *(const f32x4*)(gn + vv), g1 = *(const f32x4*)(gn + vv + 4);
        const v4u hg = *(const v4u*)(HG + (size_t)row * HW + col);
        x0 = x0 * rstd * g0; x1 = x1 * rstd * g1;
        v4u o; o.x = pk2(x0.x * siluf_(bflo(hg.x)), x0.y * siluf_(bfhi(hg.x))); o.y = pk2(x0.z * siluf_(bflo(hg.y)), x0.w * siluf_(bfhi(hg.y)));
        o.z = pk2(x1.x * siluf_(bflo(hg.z)), x1.y * siluf_(bfhi(hg.z))); o.w = pk2(x1.z * siluf_(bflo(hg.w)), x1.w * siluf_(bfhi(hg.w)));
        *(v4u*)(MIX + (size_t)row * DM + HW + col) = o;
    }
}

__device__ __forceinline__ void o2_phase(Frame& F, int nrows) {
    fresh(F);
    unsigned char* ws = F.ws;
    const bf16* U = (const bf16*)(ws + WS_U); bf16* P = (bf16*)(ws + WS_POOLED);
    const int rpw = (nrows + F.G - 1) / F.G;
    for (int i = F.wave; i < rpw; i += NWAVES) {
        const int row = (int)blockIdx.x * rpw + i; if (row >= nrows) break;
        const bool lat = row < M; const int T = lat ? SEQ : CTXL; const int t = lat ? row % SEQ : (row - M) % CTXL; const int rbase = row - t;
#pragma unroll
        for (int g = 0; g < 4; ++g) {
            const int w = 2 << g; int lo = t - w / 2; if (lo < 0) lo = 0; int hi = t + w / 2; if (hi > T) hi = T;
            const int col = 256 * g + 4 * F.lane;
            float s0 = 0.f, s1 = 0.f, s2 = 0.f, s3 = 0.f;
            for (int r = lo; r < hi; ++r) { const v2u x = *(const v2u*)(U + (size_t)(rbase + r) * DM + col); s0 += bflo(x.x); s1 += bfhi(x.x); s2 += bflo(x.y); s3 += bfhi(x.y); }
            const v2u xc = *(const v2u*)(U + (size_t)row * DM + col); const float ic = 1.0f / (float)(hi - lo);
            v2u o; o.x = pk2(s0 * ic - bflo(xc.x), s1 * ic - bfhi(xc.x)); o.y = pk2(s2 * ic - bflo(xc.y), s3 * ic - bfhi(xc.y));
            *(v2u*)(P + ((size_t)g * MT + row) * 256 + 4 * F.lane) = o;
        }
    }
}

__device__ __forceinline__ void o5_phase(Frame& F, int nrows) {
    fresh(F);
    unsigned char* ws = F.ws;
    const int* CNT = (const int*)(ws + WS_CNT); int* TST = (int*)(ws + WS_TST); const int* EIDX = (const int*)(ws + WS_EIDX); int* POS = (int*)(ws + WS_POS);
    const bf16* U = (const bf16*)(ws + WS_U); bf16* VG = (bf16*)(ws + WS_VG);
    LAS int* lc = (LAS int*)(F.lds + RING_OFF);
    LAS int* lbase = lc + 512 * 8;
    LAS int* lpos = lbase + 16;
    const int rpw = (nrows + F.G - 1) / F.G;
    for (int e = F.tid; e < F.G * 8; e += 512) lc[e] = CNT[e];
    __syncthreads();
    if (F.tid == 0) {
        int tot[8], pre[8];
        for (int e = 0; e < 8; ++e) { int s = 0, p = 0; for (int w = 0; w < F.G; ++w) { if (w == (int)blockIdx.x) p = s; s += lc[w * 8 + e]; } tot[e] = s; pre[e] = p; }
        int ts = 0;
        for (int e = 0; e < 8; ++e) { lbase[e] = ts * 256 + pre[e]; if (blockIdx.x == 0) TST[e] = ts; ts += (tot[e] + 255) >> 8; }
        if (blockIdx.x == 0) TST[8] = ts;
    }
    __syncthreads();
    if (F.wave == 0) {
        int run[8];
#pragma unroll
        for (int e = 0; e < 8; ++e) run[e] = lbase[e];
        const int npairs = 2 * rpw;
        for (int c0 = 0; c0 < npairs; c0 += 64) {
            const int pl = c0 + F.lane; const int row = (int)blockIdx.x * rpw + (pl >> 1); const bool ok = pl < npairs && row < nrows;
            const int e = ok ? EIDX[2 * row + (pl & 1)] : -1; int mypos = 0;
#pragma unroll
            for (int x = 0; x < 8; ++x) { const unsigned long long mk = __ballot(e == x); const int below = __popcll(mk & ((1ull << F.lane) - 1ull)); if (e == x) mypos = run[x] + below; run[x] += __popcll(mk); }
            if (ok) { lpos[pl] = mypos; POS[2 * row + (pl & 1)] = mypos; }
        }
    }
    __syncthreads();
    for (int pl = F.wave; pl < 2 * rpw; pl += NWAVES) {
        const int row = (int)blockIdx.x * rpw + (pl >> 1); if (row >= nrows) break;
        const int p = lpos[pl];
        const v4u a = *(const v4u*)(U + (size_t)row * DM + 8 * F.lane), b = *(const v4u*)(U + (size_t)row * DM + 512 + 8 * F.lane);
        *(v4u*)(VG + (size_t)p * DM + 8 * F.lane) = a; *(v4u*)(VG + (size_t)p * DM + 512 + 8 * F.lane) = b;
    }
    __syncthreads();
}

__global__ void __launch_bounds__(NWAVES * 64, 2) mega_fwd(Args args) {
    extern __shared__ __attribute__((aligned(16))) unsigned char lds[];
    Frame F;
    F.lds = (LAS unsigned char*)lds;
    F.tid = threadIdx.x; F.lane = F.tid & 63; F.wave = __builtin_amdgcn_readfirstlane(F.tid >> 6);
    F.G = gridDim.x; { const int bx = blockIdx.x; F.vcu = (F.G % 8 == 0) ? (bx % 8) * (F.G / 8) + bx / 8 : bx; }
    F.in = args.in; F.out = args.out; F.ws = args.ws;
    unsigned char* ws = args.ws;
    volatile LAS unsigned* MISC = (volatile LAS unsigned*)(F.lds + MISC_OFF);
    for (int u = F.tid; u < (LDS_BYTES - LDSCTL_OFF) / 4; u += NWAVES * 64) ((LAS unsigned*)(F.lds + LDSCTL_OFF))[u] = 0u;
    __syncthreads();
    XcdBarrier bar = xcd_barrier_post((unsigned*)(ws + WS_CTL) + CW_BAR, MISC + 8);
#define GRID_BAR() xcd_barrier(bar)
#ifndef ONLY
#define ONLY 0
#endif
#define PH(n) (ONLY == 0 || ONLY == (n))
    LAS unsigned char* ring = F.lds + RING_OFF;
    const float* MODV = (const float*)(ws + WS_MODV);
    float* HC = (float*)(ws + WS_HC);
    bf16* U = (bf16*)(ws + WS_U);

#if PH(20)
    p0_prologue(F);
#endif
    GRID_BAR();

    for (int lp = 0; lp < 2; ++lp) {
        const int le = 2 * lp, lo = 2 * lp + 1, j = lp;
        const bool ctx_out = (lp == 0);
        const int nro = ctx_out ? MT : M;
        const float* modE = MODV + (size_t)le * 17 * NMOD; const float* modO = MODV + (size_t)lo * 17 * NMOD;
        const float* hin_l = (lp == 0) ? args.in[0] : args.out; const float* hin_c = (lp == 0) ? args.in[2] : HC;
#if PH(1)
        {
            RowArgs A{}; A.hin_l = hin_l; A.hin_c = hin_c; A.hout_l = args.out; A.hout_c = HC; A.g = args.in[6] + (size_t)(le * 2 + 0) * DM; A.modl = modE; A.shoff = 0; A.scoff = DM; A.U = U;
            A.Y = (const bf16*)(ws + WS_VG); A.pos = (const int*)(ws + WS_POS); A.gate = (const float*)(ws + WS_GATE); A.modprev = MODV + (size_t)(le - 1) * 17 * NMOD;
            if (lp == 0) row_phase<false, 1, false>(F, A, MT); else row_phase<true, 1, false>(F, A, MT);
        }
#endif
        GRID_BAR();
#if PH(2)
        {
            pg8::Gemm g{U, (const bf16*)(ws + WS_WIN) + (size_t)j * INP * DM, DM, DM, DM}; pg8::StaticOrder S; S.init(MT, INP, F.G, (int)blockIdx.x);
            EpiIn E{(bf16*)(ws + WS_CQ), (bf16*)(ws + WS_KR), (bf16*)(ws + WS_CKV), (bf16*)(ws + WS_HQ)};
            pg8::gemm_phase<EpiIn, pg8::StaticOrder, true>(ring, g, S, E);
        }
#endif
        GRID_BAR();
#if PH(3)
        e3_phase(F);
#endif
        GRID_BAR();
#if PH(4)
        {
            pg8::Gemm g{(const bf16*)(ws + WS_CQ), (const bf16*)(ws + WS_WUQ) + (size_t)j * 768 * QL, QL, QL, QL}; pg8::StaticOrder S; S.init(nro, 768, F.G, (int)blockIdx.x);
            EpiQ E{(bf16*)(ws + WS_QB), (const float*)(ws + WS_RSQ)};
            pg8::gemm_phase<EpiQ, pg8::StaticOrder, true>(ring, g, S, E);
        }
        {
            pg8::Gemm g{(const bf16*)(ws + WS_CKV), (const bf16*)(ws + WS_WUKV) + (size_t)j * 1024 * KVL, KVL, KVL, KVL}; pg8::StaticOrder S; S.init(MT, 1024, F.G, (int)blockIdx.x);
            EpiKV E{(bf16*)(ws + WS_KN), (bf16*)(ws + WS_VV), (const float*)(ws + WS_RSKV)};
            pg8::gemm_phase<EpiKV, pg8::StaticOrder, true>(ring, g, S, E);
        }
#endif
        GRID_BAR();
#if PH(6)
#ifndef NO_HGRN
        hgrn_phase(F, j);
#endif
#ifndef NO_ATTN
        attn_phase(F, ctx_out);
#endif
#endif
        GRID_BAR();
#if PH(8)
        e8_phase(F, j, nro);
#endif
        GRID_BAR();
#if PH(9)
        {
            pg8::Gemm g{(const bf16*)(ws + WS_MIX), (const bf16*)(ws + WS_WOUT) + (size_t)j * DM * DM, DM, DM, DM}; pg8::StaticOrder S; S.init(nro, DM, F.G, (int)blockIdx.x);
            EpiResid E{hin_l, hin_c, args.out, HC, modE, 2 * DM};
            pg8::gemm_phase<EpiResid, pg8::StaticOrder, true>(ring, g, S, E);
        }
#endif
        GRID_BAR();
#if PH(10)
        {
            RowArgs A{}; A.hin_l = args.out; A.hin_c = HC; A.g = args.in[6] + (size_t)(le * 2 + 1) * DM; A.modl = modE; A.shoff = 3 * DM; A.scoff = 4 * DM; A.U = U;
            row_phase<false, 1, false>(F, A, nro);
        }
#endif
        GRID_BAR();
#if PH(11)
        {
            pg8::Gemm g{U, (const bf16*)(ws + WS_WGU) + (size_t)j * 2 * DFF * DM, DM, DM, DM}; pg8::StaticOrder S; S.init(nro, 2 * DFF, F.G, (int)blockIdx.x);
            EpiGateUp E{(bf16*)(ws + WS_HID), DFF, 2 * DFF / 256, 0};
            pg8::gemm_phase<EpiGateUp, pg8::StaticOrder, true>(ring, g, S, E);
        }
#endif
        GRID_BAR();
#if PH(12)
        {
            pg8::Gemm g{(const bf16*)(ws + WS_HID), (const bf16*)(ws + WS_WDN) + (size_t)j * DM * DFF, DFF, DFF, DFF}; pg8::StaticOrder S; S.init(nro, DM, F.G, (int)blockIdx.x);
            EpiResid E{args.out, HC, args.out, HC, modE, 5 * DM};
            pg8::gemm_phase<EpiResid, pg8::StaticOrder, true>(ring, g, S, E);
        }
#endif
        GRID_BAR();
#if PH(13)
        {
            RowArgs A{}; A.hin_l = args.out; A.hin_c = HC; A.g = args.in[6] + (size_t)(lo * 2 + 0) * DM; A.modl = modO; A.shoff = 0; A.scoff = DM; A.U = U;
            row_phase<false, 1, false>(F, A, nro);
            for (int e = 0; e < NE; ++e) {
                conv_matrix(F, args.in[23] + ((size_t)j * NE + e) * DM * DFE, DM, DFE, (bf16*)(ws + WS_MWGU) + (size_t)e * 2 * DFE * DM, DM, 2, 0, nullptr, 1.f);
                conv_matrix(F, args.in[24] + ((size_t)j * NE + e) * DM * DFE, DM, DFE, (bf16*)(ws + WS_MWGU) + (size_t)e * 2 * DFE * DM, DM, 2, 128, nullptr, 1.f);
                conv_matrix(F, args.in[25] + ((size_t)j * NE + e) * DFE * DM, DFE, DM, (bf16*)(ws + WS_MWDN) + (size_t)e * DM * DFE, DFE, 0, 0, nullptr, 1.f);
            }
        }
#endif
        GRID_BAR();
#if PH(14)
        o2_phase(F, nro);
#endif
        GRID_BAR();
#if PH(15)
        {
            pg8::Gemm g{(const bf16*)(ws + WS_POOLED), (const bf16*)(ws + WS_WPOOL) + (size_t)j * 4 * 65536, 256, 256, 256};
            pg8::PoolOrder S{nro / 256, MT / 256, F.G, (int)blockIdx.x};
            EpiPool E{args.out, HC, modO, args.in[20] + (size_t)j * DM, args.in[21] + (size_t)j * DM, MT / 256};
            pg8::gemm_phase<EpiPool, pg8::PoolOrder, true>(ring, g, S, E);
        }
#endif
        GRID_BAR();
#if PH(16)
        {
            RowArgs A{}; A.hin_l = args.out; A.hin_c = HC; A.g = args.in[6] + (size_t)(lo * 2 + 1) * DM; A.modl = modO; A.shoff = 3 * DM; A.scoff = 4 * DM; A.U = U;
            A.router = args.in[22] + (size_t)j * DM * NE; A.eidx = (int*)(ws + WS_EIDX); A.gout = (float*)(ws + WS_GATE); A.cnt = (int*)(ws + WS_CNT);
            row_phase<false, 1, true>(F, A, nro);
        }
#endif
        GRID_BAR();
#if PH(17)
        o5_phase(F, nro);
#endif
        GRID_BAR();
#if PH(18)
        {
            const int* TST = (const int*)(ws + WS_TST);
            const int ts1 = TST[1], ts2 = TST[2], ts3 = TST[3], ts4 = TST[4], ts5 = TST[5], ts6 = TST[6], ts7 = TST[7], nT = TST[8];
            const int h0 = (nT + 1) / 2;
            for (int c = 0; c < 2; ++c) {
                const int t0 = c ? h0 : 0, nrt = c ? nT - h0 : h0;
                {
                    pg8::Gemm g{(const bf16*)(ws + WS_VG), (const bf16*)(ws + WS_MWGU), DM, DM, DM};
                    pg8::MoeOrder S{t0, nrt, 2 * DFE / 256, F.G, (int)blockIdx.x, ts1, ts2, ts3, ts4, ts5, ts6, ts7};
                    EpiGateUp E{(bf16*)(ws + WS_HIDM), DFE, 2 * DFE / 256, t0 * 256};
                    pg8::gemm_phase<EpiGateUp, pg8::MoeOrder, true>(ring, g, S, E);
                }
                GRID_BAR();
                {
                    pg8::Gemm g{(const bf16*)(ws + WS_HIDM) - (size_t)t0 * 256 * DFE, (const bf16*)(ws + WS_MWDN), DFE, DFE, DFE};
                    pg8::MoeOrder S{t0, nrt, DM / 256, F.G, (int)blockIdx.x, ts1, ts2, ts3, ts4, ts5, ts6, ts7};
                    EpiY E{(bf16*)(ws + WS_VG), DM / 256};
                    pg8::gemm_phase<EpiY, pg8::MoeOrder, true>(ring, g, S, E);
                }
                GRID_BAR();
            }
        }
#endif
    }
#if PH(19)
    {
        RowArgs A{}; A.hin_l = args.out; A.hin_c = HC; A.hout_l = args.out; A.hout_c = HC; A.g = args.in[7];
        A.Y = (const bf16*)(ws + WS_VG); A.pos = (const int*)(ws + WS_POS); A.gate = (const float*)(ws + WS_GATE); A.modprev = MODV + (size_t)3 * 17 * NMOD;
        row_phase<true, 2, false>(F, A, M);
        if (xb_ld((unsigned*)(ws + WS_CTL) + CW_BAR + XB_TMO) != 0u) { __syncthreads(); const float qn = __builtin_nanf(""); for (int i = F.tid; i < 1024; i += 512) args.out[(size_t)blockIdx.x * 1024 + i] = qn; }
    }
#endif
}

extern "C" void kernel_launch(void* const* d_in, const int* in_sizes, int n_in, void* d_out, int out_size, void* d_ws, size_t ws_size, hipStream_t stream) {
    static int grid = 0;
    if (grid == 0) {
        if (n_in != 26 || out_size != M * DM || ws_size < WS_END) { fprintf(stderr, "kernel_launch: unexpected shapes (n_in %d out %d ws %zu)\n", n_in, out_size, ws_size); grid = -1; return; }
        int dev = 0, cus = 0, per_cu = 0;
        if (hipGetDevice(&dev) != hipSuccess || hipDeviceGetAttribute(&cus, hipDeviceAttributeMultiprocessorCount, dev) != hipSuccess) { grid = -1; return; }
        if (hipFuncSetAttribute((const void*)mega_fwd, hipFuncAttributeMaxDynamicSharedMemorySize, LDS_BYTES) != hipSuccess) { grid = -1; return; }
        if (hipOccupancyMaxActiveBlocksPerMultiprocessor(&per_cu, (const void*)mega_fwd, NWAVES * 64, LDS_BYTES) != hipSuccess || per_cu < 1) fprintf(stderr, "kernel_launch: occupancy query says %d\n", per_cu);
        (void)hipGetLastError();
        grid = cus > 256 ? 256 : cus;
    }
    if (grid < 0) return;
    if (hipMemsetAsync((char*)d_ws + WS_CTL, 0, CTL_ZERO_BYTES, stream) != hipSuccess) return;
    Args a{};
    for (int i = 0; i < 26; ++i) a.in[i] = (const float*)d_in[i];
    a.out = (float*)d_out; a.ws = (unsigned char*)d_ws;
    hipLaunchKernelGGL(mega_fwd, dim3(grid), dim3(NWAVES * 64), LDS_BYTES, stream, a);
}
```

```cpp
#include <hip/hip_runtime.h>
#include <cstdio>
#include <cstdint>

namespace pg8 {
#define PG8_LAS __attribute__((address_space(3)))
typedef unsigned short bf16_t;
typedef short bf16x8 __attribute__((ext_vector_type(8)));
typedef float f32x4 __attribute__((ext_vector_type(4)));
typedef unsigned u32x4 __attribute__((ext_vector_type(4)));
constexpr int BM = 256, BK = 64, HALF = 128, HTB = HALF * BK * 2, STAGE_BYTES = 8 * HTB, NXCD = 8, WGM = 8;

__host__ __device__ __forceinline__ int lds_byte(int r, int c) { const int st = (r >> 4) * 2 + (c >> 5), rr = r & 15, cc = c & 31, ob = rr * 64 + cc * 2; return st * 1024 + (ob ^ (((ob >> 9) & 1) << 5)); }
__host__ __device__ __forceinline__ void stage_rc(int b, int& R, int& C) { const int st = b / 1024, sb = b % 1024, swz = sb ^ (((sb >> 9) & 1) << 5); R = (st >> 1) * 16 + swz / 64; C = (st & 1) * 32 + (swz % 64) / 2; }
__host__ __device__ __forceinline__ int perm32(int rho) { const int n = rho >> 4, i = rho & 15; return 8 * (i >> 2) + 4 * n + (i & 3); }

struct Unit { int pm, pn; };
struct Gemm { const bf16_t* A; const bf16_t* Bt; int lda, ldb, K; };

struct StaticOrder {
    int nM, nN, nwg, G, c;
    __device__ void init(int M, int N, int G_, int c_) { nM = M / BM; nN = N / BM; nwg = nM * nN; G = G_; c = c_; }
    __device__ bool next(int i, Unit& u) const {
        const long L = (long)i * G + c; if (L >= nwg) return false;
        int wgid = (int)L; { const int q = nwg / NXCD, r = nwg % NXCD, xcd = wgid % NXCD, off = wgid / NXCD; wgid = (xcd < r ? xcd * (q + 1) : r * (q + 1) + (xcd - r) * q) + off; }
        const int nig = WGM * nN, gid = wgid / nig, fm = gid * WGM, gsz = (nM - fm) < WGM ? (nM - fm) : WGM;
        u.pm = fm + ((wgid % nig) % gsz); u.pn = (wgid % nig) / gsz; return true;
    }
};
struct PoolOrder {
    int nrt, talloc, G, c;
    __device__ bool next(int i, Unit& u) const { const int L = i * G + c; if (L >= 4 * nrt) return false; const int g = L / nrt, rt = L - g * nrt; u.pm = g * talloc + rt; u.pn = g; return true; }
};
struct MoeOrder {
    int t0, nrt, nct, G, c; int ts1, ts2, ts3, ts4, ts5, ts6, ts7;
    __device__ bool next(int i, Unit& u) const {
        const int nwg = nrt * nct; const int L = i * G + c; if (L >= nwg) return false;
        int wgid = L; { const int q = nwg / NXCD, r = nwg % NXCD, xcd = wgid % NXCD, off = wgid / NXCD; wgid = (xcd < r ? xcd * (q + 1) : r * (q + 1) + (xcd - r) * q) + off; }
        const int nig = WGM * nct, gid = wgid / nig, fm = gid * WGM, gsz = (nrt - fm) < WGM ? (nrt - fm) : WGM;
        const int rt = t0 + fm + ((wgid % nig) % gsz), ct = (wgid % nig) / gsz;
        const int e = (rt >= ts1) + (rt >= ts2) + (rt >= ts3) + (rt >= ts4) + (rt >= ts5) + (rt >= ts6) + (rt >= ts7);
        u.pm = rt; u.pn = e * nct + ct; return true;
    }
};

__device__ __forceinline__ unsigned cvt_pk_bf16(float lo, float hi) { unsigned r; asm volatile("v_cvt_pk_bf16_f32 %0, %1, %2" : "=v"(r) : "v"(lo), "v"(hi)); return r; }

template <class Epi, class Sched, bool ALIGN_EPI>
__device__ __forceinline__ void gemm_phase(PG8_LAS unsigned char* lds, const Gemm g, const Sched& S, const Epi& E) {
    int tid_ = threadIdx.x; asm volatile("" : "+v"(tid_));
    const int tid = tid_, wid = __builtin_amdgcn_readfirstlane(tid >> 6), lane = tid & 63, wr = wid >> 2, wc = wid & 3, fr = lane & 15, fq = lane >> 4;
    int K_ = g.K; asm volatile("" : "+s"(K_));
    const int K = K_, nt = K / BK;
    unsigned voffA[2], voffB[2];
#pragma unroll
    for (int i = 0; i < 2; ++i) { int R, C; stage_rc(tid * 16 + i * 8192, R, C); const int Rb = Epi::PERM ? ((R & ~31) + perm32(R & 31)) : R;
        voffA[i] = (unsigned)(R * g.lda + C) * 2u; voffB[i] = (unsigned)(Rb * g.ldb + C) * 2u; }
    const size_t kstep = (size_t)(BK * 2);
    const size_t hstepA = (size_t)HALF * g.lda * 2, hstepB = (size_t)HALF * g.ldb * 2;
    const size_t tstepA = 2 * hstepA, tstepB = 2 * hstepB;
    const unsigned ldsw = (unsigned)wid * 1024u;
    const int aoff = lds_byte(wr * 64 + fr, fq * 8), boff = lds_byte(wc * 32 + fr, fq * 8);
#define PG8_SA(b, h) (((b) * 2 + (h)) * HTB)
#define PG8_SB(b, h) ((4 + (b) * 2 + (h)) * HTB)
#define PG8_STAGE(bufoff, gbase, voff) do { _Pragma("unroll") for (int _i = 0; _i < 2; ++_i) \
        __builtin_amdgcn_global_load_lds((const unsigned*)((const char*)(gbase) + (voff)[_i]), (PG8_LAS unsigned*)(lds + (bufoff) + ldsw + _i * 8192), 16, 0, 0); } while (0)
#define PG8_LDA(dst, b, h) do { _Pragma("unroll") for (int m = 0; m < 4; ++m) _Pragma("unroll") for (int k = 0; k < 2; ++k) dst[m][k] = *(const PG8_LAS bf16x8*)(lds + PG8_SA(b, h) + aoff + m * 2048 + k * 1024); } while (0)
#define PG8_LDB(dst, b, h) do { _Pragma("unroll") for (int n = 0; n < 2; ++n) _Pragma("unroll") for (int k = 0; k < 2; ++k) dst[n][k] = *(const PG8_LAS bf16x8*)(lds + PG8_SB(b, h) + boff + n * 2048 + k * 1024); } while (0)
#define PG8_MMA(ai, bj, At, Bt) do { __builtin_amdgcn_s_setprio(1); _Pragma("unroll") for (int m = 0; m < 4; ++m) _Pragma("unroll") for (int n = 0; n < 2; ++n) _Pragma("unroll") for (int k = 0; k < 2; ++k) \
        acc[ai][bj][m][n] = __builtin_amdgcn_mfma_f32_16x16x32_bf16(Bt[n][k], At[m][k], acc[ai][bj][m][n], 0, 0, 0); __builtin_amdgcn_s_setprio(0); } while (0)
#define PG8_WAIT_V(n) asm volatile("s_waitcnt vmcnt(" #n ")" ::: "memory")
#define PG8_WAIT_L(n) asm volatile("s_waitcnt lgkmcnt(" #n ")" ::: "memory")
#define PG8_BAR __builtin_amdgcn_s_barrier()
#define PG8_SCHED __builtin_amdgcn_sched_barrier(0)
    Unit cur, nxt; int ui = 0;
    if (!S.next(0, cur)) return;
    f32x4 acc[2][2][4][2];
#pragma unroll
    for (int a = 0; a < 2; ++a)
#pragma unroll
        for (int b = 0; b < 2; ++b)
#pragma unroll
            for (int m = 0; m < 4; ++m)
#pragma unroll
                for (int n = 0; n < 2; ++n) acc[a][b][m][n] = (f32x4){0.f, 0.f, 0.f, 0.f};
    bf16x8 At[4][2], B0[2][2], B1[2][2];
    const char* cA = (const char*)g.A + (size_t)cur.pm * tstepA; const char* cB = (const char*)g.Bt + (size_t)cur.pn * tstepB;
    PG8_STAGE(PG8_SB(0, 0), cB, voffB); PG8_STAGE(PG8_SB(0, 1), cB + hstepB, voffB); PG8_STAGE(PG8_SA(0, 0), cA, voffA); PG8_STAGE(PG8_SA(0, 1), cA + hstepA, voffA);
    if (wr == 1) PG8_BAR;
    PG8_WAIT_V(2); PG8_BAR;
    PG8_STAGE(PG8_SB(1, 0), cB + kstep, voffB); PG8_STAGE(PG8_SA(1, 0), cA + kstep, voffA); PG8_STAGE(PG8_SB(1, 1), cB + hstepB + kstep, voffB);
    PG8_WAIT_V(6); PG8_BAR;
    for (;;) {
        const bool has_next = S.next(ui + 1, nxt);
        const char* nA = has_next ? (const char*)g.A + (size_t)nxt.pm * tstepA : cA; const char* nB = has_next ? (const char*)g.Bt + (size_t)nxt.pn * tstepB : cB;
#pragma unroll 1
        for (int t = 0; t < nt; t += 2) {
            const bool last = (t == nt - 2);
            const char* a1 = cA + (size_t)(t + 1) * kstep;
            const char* a2 = last ? nA : cA + (size_t)(t + 2) * kstep; const char* b2 = last ? nB : cB + (size_t)(t + 2) * kstep;
            const char* a3 = a2 + kstep; const char* b3 = b2 + kstep;
            PG8_LDB(B0, 0, 0); PG8_LDB(B1, 0, 1); PG8_SCHED; PG8_LDA(At, 0, 0); PG8_STAGE(PG8_SA(1, 1), a1 + hstepA, voffA);
            PG8_WAIT_V(8); PG8_WAIT_L(0); PG8_BAR; PG8_MMA(0, 0, At, B0); PG8_MMA(0, 1, At, B1); PG8_BAR; PG8_SCHED;
            PG8_LDA(At, 0, 1); PG8_STAGE(PG8_SB(0, 0), b2, voffB); PG8_STAGE(PG8_SB(0, 1), b2 + hstepB, voffB); PG8_STAGE(PG8_SA(0, 0), a2, voffA);
            PG8_WAIT_V(8); PG8_WAIT_L(0); PG8_BAR; PG8_MMA(1, 0, At, B0); PG8_MMA(1, 1, At, B1); PG8_BAR; PG8_SCHED;
            PG8_LDB(B0, 1, 0); PG8_LDB(B1, 1, 1); PG8_SCHED; PG8_LDA(At, 1, 0); PG8_STAGE(PG8_SA(0, 1), a2 + hstepA, voffA);
            PG8_WAIT_V(8); PG8_WAIT_L(0); PG8_BAR; PG8_MMA(0, 0, At, B0); PG8_MMA(0, 1, At, B1); PG8_BAR; PG8_SCHED;
            PG8_LDA(At, 1, 1); PG8_STAGE(PG8_SB(1, 0), b3, voffB); PG8_STAGE(PG8_SB(1, 1), b3 + hstepB, voffB); PG8_STAGE(PG8_SA(1, 0), a3, voffA);
            PG8_WAIT_V(8); PG8_WAIT_L(0); PG8_BAR; PG8_MMA(1, 0, At, B0); PG8_MMA(1, 1, At, B1); PG8_BAR; PG8_SCHED;
        }
        if constexpr (ALIGN_EPI) { if (wr == 0) PG8_BAR; }
        E(acc, cur, wr, wc, fr, fq);
        if (!has_next) break;
#pragma unroll
        for (int a = 0; a < 2; ++a)
#pragma unroll
            for (int b = 0; b < 2; ++b)
#pragma unroll
                for (int m = 0; m < 4; ++m)
#pragma unroll
                    for (int n = 0; n < 2; ++n) acc[a][b][m][n] = (f32x4){0.f, 0.f, 0.f, 0.f};
        cur = nxt; cA = nA; cB = nB; ++ui;
        if constexpr (ALIGN_EPI) { if (wr == 1) PG8_BAR; }
    }
    PG8_WAIT_V(0);
    if constexpr (!ALIGN_EPI) { if (wr == 0) PG8_BAR; }
    PG8_BAR;
#undef PG8_SA
#undef PG8_SB
#undef PG8_STAGE
#undef PG8_LDA
#undef PG8_LDB
#undef PG8_MMA
#undef PG8_WAIT_V
#undef PG8_WAIT_L
#undef PG8_BAR
#undef PG8_SCHED
}
}

constexpr int NWAVES = 8;
constexpr int DM = 1024, NB = 16, SEQ = 2048, CTXL = 256;
constexpr int M = NB * SEQ, MC = NB * CTXL, MT = M + MC;
constexpr int QL = 384, KVL = 256, ROPE = 32, HW = 512, NH = 8, QKD = 96, VD = 64;
constexpr int INW = 3232, INP = 3328;
constexpr int DFF = 2816, NE = 8, DFE = 3584, NMOD = 6 * DM;
constexpr int NHH = 4, HK = 128; constexpr int NKEY = SEQ + CTXL;
constexpr float EPS = 1e-6f;
constexpr int MAXT = 296;
constexpr int HALFT = 148;

constexpr size_t MiB = 1u << 20;
constexpr size_t WS_CTL = 0, CTL_ZERO_BYTES = 1 * MiB;
constexpr size_t WS_MODV = 1 * MiB;
constexpr size_t WS_ROPE = 3 * MiB;
constexpr size_t WS_CNT = 3 * MiB + 64 * 1024;
constexpr size_t WS_TST = 3 * MiB + 128 * 1024;
constexpr size_t WS_EIDX = 4 * MiB, WS_GATE = 4 * MiB + 512 * 1024, WS_POS = 5 * MiB;
constexpr size_t WS_RSQ = 6 * MiB, WS_RSKV = 6 * MiB + 256 * 1024;
constexpr size_t WS_HC = 8 * MiB;
constexpr size_t WS_WIN = 24 * MiB, WS_WUQ = 37 * MiB, WS_WUKV = 39 * MiB, WS_WOUT = 40 * MiB, WS_WGU = 44 * MiB, WS_WDN = 66 * MiB, WS_WPOOL = 77 * MiB;
constexpr size_t WS_U = 80 * MiB;
constexpr size_t WS_X = 152 * MiB;
constexpr size_t WS_CQ = WS_X, WS_CKV = 179 * MiB, WS_KR = 197 * MiB, WS_KRR = 200 * MiB, WS_HQ = 203 * MiB  ;
constexpr size_t WS_QB = 383 * MiB, WS_KN = 437 * MiB, WS_VV = 473 * MiB, WS_OF = 509 * MiB, WS_OB = 581 * MiB, WS_MIX = 653 * MiB, WS_HID = WS_X;
constexpr size_t WS_MWGU = WS_X, WS_MWDN = 264 * MiB, WS_POOLED = 320 * MiB, WS_VG = 392 * MiB, WS_HIDM = 540 * MiB, WS_END = 800 * MiB;
constexpr size_t HSEG = (size_t)MT * HW;
static_assert(WS_HQ + 5 * HSEG * 2 <= WS_QB && WS_MIX + (size_t)MT * DM * 2 <= WS_END && WS_HID + (size_t)MT * DFF * 2 <= WS_QB, "ws map even");
static_assert(WS_HIDM + (size_t)HALFT * 256 * DFE * 2 <= WS_END && WS_VG + (size_t)MAXT * 256 * DM * 2 <= WS_HIDM && WS_MWDN + (size_t)NE * DM * DFE * 2 <= WS_POOLED && WS_MWGU + (size_t)NE * 2 * DFE * DM * 2 <= WS_MWDN, "ws map odd");
constexpr int CW_BAR = 4096;

constexpr int RING_OFF = 0, RING_BYTES = 131072;
constexpr int LDSCTL_OFF = RING_BYTES, MISC_OFF = LDSCTL_OFF + 320;
constexpr int LDS_BYTES = 147456;

#define GAS __attribute__((address_space(1)))
#define LAS __attribute__((address_space(3)))
typedef unsigned short bf16;
typedef unsigned v4u __attribute__((ext_vector_type(4)));
typedef unsigned v2u __attribute__((ext_vector_type(2)));
typedef float f32x4 __attribute__((ext_vector_type(4)));
typedef GAS unsigned gu32;
#define RLX_AGENT __ATOMIC_RELAXED, __HIP_MEMORY_SCOPE_AGENT
#define LDS_WAIT() asm volatile("s_waitcnt lgkmcnt(0)" ::: "memory")
__device__ __forceinline__ unsigned f2bf(float f) { unsigned u = __builtin_bit_cast(unsigned, f); return (u + 0x7fffu + ((u >> 16) & 1u)) >> 16; }
__device__ __forceinline__ unsigned pk2(float lo, float hi) { return f2bf(lo) | (f2bf(hi) << 16); }
__device__ __forceinline__ float bf2f(unsigned short b) { return __uint_as_float((unsigned)b << 16); }
__device__ __forceinline__ float bflo(unsigned w) { return __uint_as_float(w << 16); }
__device__ __forceinline__ float bfhi(unsigned w) { return __uint_as_float(w & 0xffff0000u); }
__device__ __forceinline__ float sigmoidf_(float x) { return 1.0f / (1.0f + __expf(-x)); }
__device__ __forceinline__ float siluf_(float x) { return x / (1.0f + __expf(-x)); }

#define XB_TMO      128
#define XB_XCNT(j)  (256  + 64 * (j))
#define XB_XSUB(j)  (1280 + 64 * (j))
#define XB_XGEN(j)  (2304 + 64 * (j))
#define XB_TOP      3328
#define XB_TOPGEN   3392
#define XCD_BAR_WORDS 3456
#define XB_SPIN_CAP (1u << 22)
__device__ __forceinline__ unsigned xb_ld(unsigned* p)              { return __hip_atomic_load(p, __ATOMIC_RELAXED, __HIP_MEMORY_SCOPE_AGENT); }
__device__ __forceinline__ unsigned xb_add(unsigned* p, unsigned v) { return __hip_atomic_fetch_add(p, v, __ATOMIC_RELAXED, __HIP_MEMORY_SCOPE_AGENT); }
__device__ __forceinline__ unsigned xb_xcc_id() { return (unsigned)__builtin_amdgcn_s_getreg((3 << 11) | 20) & 0xFu; }
#define XB_SPIN(cond, bar) do { unsigned _sp = 0; while (cond) { __builtin_amdgcn_s_sleep(1); \
    if ((++_sp & 255u) == 0u) { if (xb_ld(&(bar)[XB_TMO])) break; if (_sp > XB_SPIN_CAP) { atomicAdd(&(bar)[XB_TMO], 1u); break; } } } } while (0)
struct XcdBarrier { unsigned* bar; unsigned x; volatile LAS unsigned* st; };
__device__ __forceinline__ XcdBarrier xcd_barrier_post(unsigned* bar, volatile LAS unsigned* st) {
    XcdBarrier b; b.bar = bar; b.x = xb_xcc_id(); b.st = st;
    if (threadIdx.x == 0) (void)xb_add(&bar[XB_XCNT(b.x)], 1u);
    return b;
}
__device__ __forceinline__ void xcd_barrier_complete(unsigned* bar, unsigned x, unsigned& nloc, unsigned& nx) {
    const unsigned G = gridDim.x * gridDim.y * gridDim.z;
    unsigned sum, cnt, mine, sp = 0u;
    for (;;) {
        sum = 0u; cnt = 0u; mine = 0u;
#pragma unroll
        for (unsigned j = 0; j < 16; ++j) { const unsigned c = xb_ld(&bar[XB_XCNT(j)]); sum += c; cnt += (c > 0u) ? 1u : 0u; mine = (j == x) ? c : mine; }
        if (sum == G) break;
        __builtin_amdgcn_s_sleep(1);
        if ((++sp & 255u) == 0u) { if (xb_ld(&bar[XB_TMO])) break; if (sp > XB_SPIN_CAP) { atomicAdd(&bar[XB_TMO], 1u); break; } }
    }
    nloc = mine > 0u ? mine : 1u; nx = cnt > 0u ? cnt : 1u;
}
__device__ __forceinline__ void xcd_barrier(const XcdBarrier& b) {
    asm volatile("s_waitcnt vmcnt(0)" ::: "memory");
    __syncthreads();
    if (threadIdx.x == 0) {
        unsigned* bar = b.bar;
        __builtin_amdgcn_s_waitcnt(0);
        unsigned nloc = b.st[0], nx = b.st[1];
        if (nloc == 0u) { xcd_barrier_complete(bar, b.x, nloc, nx); b.st[0] = nloc; b.st[1] = nx; }
        const unsigned old = xb_add(&bar[XB_XSUB(b.x)], 1u);
        const unsigned gen = old / nloc;
        if (old + 1u == (gen + 1u) * nloc) {
            __builtin_amdgcn_fence(__ATOMIC_RELEASE, "agent");
            asm volatile("s_waitcnt vmcnt(0)" ::: "memory");
            const unsigned og = xb_add(&bar[XB_TOP], 1u);
            const unsigned tg = og / nx;
            if (og + 1u == (tg + 1u) * nx) xb_add(&bar[XB_TOPGEN], 1u);
            else XB_SPIN(xb_ld(&bar[XB_TOPGEN]) == tg, bar);
            __builtin_amdgcn_fence(__ATOMIC_ACQUIRE, "agent");
            xb_add(&bar[XB_XGEN(b.x)], 1u);
            asm volatile("s_waitcnt vmcnt(0)" ::: "memory");
        } else {
            XB_SPIN(xb_ld(&bar[XB_XGEN(b.x)]) == gen, bar);
            __builtin_amdgcn_fence(__ATOMIC_ACQUIRE, "agent");
            asm volatile("s_waitcnt vmcnt(0)" ::: "memory");
        }
    }
    __syncthreads();
}

struct Args { const float* in[26]; float* out; unsigned char* ws; };
struct Frame {
    LAS unsigned char* lds;
    int tid, lane, wave, G, vcu;
    const float* const* in; float* out; unsigned char* ws;
};
__device__ __forceinline__ float wave_sum(float v) {
#pragma unroll
    for (int o = 1; o < 64; o <<= 1) v += __shfl_xor(v, o);
    return v;
}

__device__ __forceinline__ void fresh(Frame& F) { int t = threadIdx.x; asm volatile("" : "+v"(t)); F.tid = t; F.lane = t & 63; F.wave = __builtin_amdgcn_readfirstlane(t >> 6); }

__device__ __forceinline__ void conv_item(const float* W, int ldw, bf16* WT, int ldd, int k0, int n0, int drow0, const float* kscale, float gscale, LAS float* scr, int lane) {
#pragma unroll 8
    for (int i = 0; i < 32; ++i) { const int kk = 2 * i + (lane >> 5); float w = W[(size_t)(k0 + kk) * ldw + n0 + (lane & 31)]; if (kscale) w *= kscale[k0 + kk]; scr[kk * 33 + (lane & 31)] = w * gscale; }
    LDS_WAIT(); asm volatile("" ::: "memory");
    const int c = lane & 7;
#pragma unroll
    for (int j = 0; j < 4; ++j) { const int n = (lane >> 3) + 8 * j; const LAS float* s = scr + (8 * c) * 33 + n;
        v4u o; o.x = pk2(s[0 * 33], s[1 * 33]); o.y = pk2(s[2 * 33], s[3 * 33]); o.z = pk2(s[4 * 33], s[5 * 33]); o.w = pk2(s[6 * 33], s[7 * 33]);
        *(v4u*)(WT + (size_t)(drow0 + n) * ldd + k0 + 8 * c) = o; }
    LDS_WAIT(); asm volatile("" ::: "memory");
}
__device__ __forceinline__ int conv_rowmap(int mode, int n0, int off) {
    if (mode == 0) return n0 + off;
    if (mode == 1) { if (n0 < 384) return n0; if (n0 < 640) return 512 + (n0 - 384); if (n0 < 672) return 384; return 768 + (n0 - 672); }
    return 256 * (n0 >> 7) + (n0 & 127) + off;
}
__device__ __forceinline__ void conv_matrix(Frame& F, const float* W, int K, int N, bf16* WT, int ldd, int mode, int off, const float* kscale, float gscale) {
    LAS float* scr = (LAS float*)(F.lds + RING_OFF + F.wave * 16384);
    const int gw = F.vcu * NWAVES + F.wave, NGW = F.G * NWAVES;
    const int nblk = N / 32, nitems = (K / 64) * nblk;
    for (int it = gw; it < nitems; it += NGW) { const int kb = it / nblk, nb = it % nblk; conv_item(W, N, WT, ldd, 64 * kb, 32 * nb, conv_rowmap(mode, 32 * nb, off), kscale, gscale, scr, F.lane); }
}

__device__ __forceinline__ int row_bidx(int row) { return row < M ? row / SEQ : NB; }

struct RowArgs {
    const float* hin_l; const float* hin_c; float* hout_l; float* hout_c;
    const float* g;
    const float* modl;
    int shoff, scoff;
    bf16* U;
    const bf16* Y; const int* pos; const float* gate; const float* modprev;
    const float* router; int* eidx; float* gout; int* cnt;
};
template <bool COMBINE, int OUTMODE, bool ROUTER>
__device__ __forceinline__ void row_phase(Frame& F, const RowArgs& A, int nrows) {
    fresh(F);
    const int rpw = (nrows + F.G - 1) / F.G;
    LAS int* lcnt = (LAS int*)(F.lds + RING_OFF);
    if (ROUTER) { if (F.tid < 8) lcnt[F.tid] = 0; __syncthreads(); }
    for (int i = F.wave; i < rpw; i += NWAVES) {
        const int row = (int)blockIdx.x * rpw + i; if (row >= nrows) break;
        const bool lat = row < M; const int bidx = lat ? row / SEQ : NB;
        const float* hr = lat ? A.hin_l + (size_t)row * DM : A.hin_c + (size_t)(row - M) * DM;
        f32x4 v[4];
#pragma unroll
        for (int j = 0; j < 4; ++j) v[j] = *(const f32x4*)(hr + 4 * F.lane + 256 * j);
        if (COMBINE) {
            const int pa = A.pos[2 * row], pb = A.pos[2 * row + 1]; const float ga = A.gate[2 * row], gb = A.gate[2 * row + 1];
            const float* g2 = A.modprev + bidx * NMOD + 5 * DM;
#pragma unroll
            for (int j = 0; j < 4; ++j) { const int col = 4 * F.lane + 256 * j;
                const v2u ya = *(const v2u*)(A.Y + (size_t)pa * DM + col), yb = *(const v2u*)(A.Y + (size_t)pb * DM + col); const f32x4 gv = *(const f32x4*)(g2 + col);
                v[j].x += gv.x * (ga * bflo(ya.x) + gb * bflo(yb.x)); v[j].y += gv.y * (ga * bfhi(ya.x) + gb * bfhi(yb.x));
                v[j].z += gv.z * (ga * bflo(ya.y) + gb * bflo(yb.y)); v[j].w += gv.w * (ga * bfhi(ya.y) + gb * bfhi(yb.y)); }
            if (OUTMODE != 2) { float* ho = lat ? A.hout_l + (size_t)row * DM : A.hout_c + (size_t)(row - M) * DM;
#pragma unroll
                for (int j = 0; j < 4; ++j) *(f32x4*)(ho + 4 * F.lane + 256 * j) = v[j]; }
        }
        float s = 0.f;
#pragma unroll
        for (int j = 0; j < 4; ++j) s += (v[j].x * v[j].x + v[j].y * v[j].y) + (v[j].z * v[j].z + v[j].w * v[j].w);
        const float rstd = rsqrtf(wave_sum(s) * (1.0f / DM) + EPS);
        if (OUTMODE == 2) {
            float* ho = A.hout_l + (size_t)row * DM;
#pragma unroll
            for (int j = 0; j < 4; ++j) { const int col = 4 * F.lane + 256 * j; const f32x4 gv = *(const f32x4*)(A.g + col); *(f32x4*)(ho + col) = v[j] * rstd * gv; }
        } else {
            const float* sh = A.modl + bidx * NMOD + A.shoff; const float* sc = A.modl + bidx * NMOD + A.scoff;
            float lg[8];
            if (ROUTER) {
#pragma unroll
                for (int e = 0; e < 8; ++e) lg[e] = 0.f;
            }
#pragma unroll
            for (int j = 0; j < 4; ++j) { const int col = 4 * F.lane + 256 * j; const f32x4 gv = *(const f32x4*)(A.g + col), shv = *(const f32x4*)(sh + col), scv = *(const f32x4*)(sc + col);
                f32x4 y = v[j] * rstd * gv * (scv + 1.0f) + shv;
                v2u o; o.x = pk2(y.x, y.y); o.y = pk2(y.z, y.w); *(v2u*)(A.U + (size_t)row * DM + col) = o;
                if (ROUTER) {
#pragma unroll
                    for (int q = 0; q < 4; ++q) { const f32x4 r0 = *(const f32x4*)(A.router + (size_t)(col + q) * 8), r1 = *(const f32x4*)(A.router + (size_t)(col + q) * 8 + 4); const float yy = y[q];
                        lg[0] += yy * r0.x; lg[1] += yy * r0.y; lg[2] += yy * r0.z; lg[3] += yy * r0.w; lg[4] += yy * r1.x; lg[5] += yy * r1.y; lg[6] += yy * r1.z; lg[7] += yy * r1.w; } }
            }
            if (ROUTER) {
#pragma unroll
                for (int e = 0; e < 8; ++e) lg[e] = wave_sum(lg[e]);
                int i0 = 0; float v0 = lg[0];
#pragma unroll
                for (int e = 1; e < 8; ++e) if (lg[e] > v0) { v0 = lg[e]; i0 = e; }
                int i1 = -1; float v1 = -INFINITY;
#pragma unroll
                for (int e = 0; e < 8; ++e) if (e != i0 && lg[e] > v1) { v1 = lg[e]; i1 = e; }
                const float g0 = 1.0f / (1.0f + __expf(v1 - v0));
                if (F.lane == 0) { A.eidx[2 * row] = i0; A.eidx[2 * row + 1] = i1; A.gout[2 * row] = g0; A.gout[2 * row + 1] = 1.0f - g0; atomicAdd((int*)&lcnt[i0], 1); atomicAdd((int*)&lcnt[i1], 1); }
            }
        }
    }
    if (ROUTER) { __syncthreads(); if (F.tid < 8) A.cnt[blockIdx.x * 8 + F.tid] = lcnt[F.tid]; __syncthreads(); }
}

using pg8::Unit; using pg8::cvt_pk_bf16;
__device__ __forceinline__ v4u pack8(const f32x4& a, const f32x4& b) { v4u w; w.x = cvt_pk_bf16(a[0], a[1]); w.y = cvt_pk_bf16(a[2], a[3]); w.z = cvt_pk_bf16(b[0], b[1]); w.w = cvt_pk_bf16(b[2], b[3]); return w; }
struct EpiIn {
    static constexpr bool PERM = true;
    bf16 *CQ, *KR, *CKV, *H5;
    __device__ __forceinline__ void operator()(const f32x4 (&acc)[2][2][4][2], const Unit& u, int wr, int wc, int fr, int fq) const {
        const int row0 = u.pm * 256 + wr * 64 + fr;
#pragma unroll
        for (int bj = 0; bj < 2; ++bj) {
            const int col = u.pn * 256 + bj * 128 + wc * 32 + 8 * fq;
            bf16* base; int ld;
            if (col < 384) { base = CQ + col; ld = QL; }
            else if (col < 416) { base = KR + (col - 384); ld = ROPE; }
            else if (col < 512) { base = nullptr; ld = 0; }
            else if (col < 768) { base = CKV + (col - 512); ld = KVL; }
            else { const int c2 = col - 768; base = H5 + (size_t)(c2 >> 9) * HSEG + (c2 & 511); ld = HW; }
            if (base) {
#pragma unroll
                for (int ai = 0; ai < 2; ++ai)
#pragma unroll
                    for (int m = 0; m < 4; ++m) { const int row = row0 + ai * 128 + m * 16; *(v4u*)(base + (size_t)row * ld) = pack8(acc[ai][bj][m][0], acc[ai][bj][m][1]); }
            }
        }
    }
};
struct EpiQ {
    static constexpr bool PERM = true;
    bf16* O; const float* rs;
    __device__ __forceinline__ void operator()(const f32x4 (&acc)[2][2][4][2], const Unit& u, int wr, int wc, int fr, int fq) const {
        const int row0 = u.pm * 256 + wr * 64 + fr;
#pragma unroll
        for (int ai = 0; ai < 2; ++ai)
#pragma unroll
            for (int m = 0; m < 4; ++m) { const int row = row0 + ai * 128 + m * 16; const float sc = rs[row];
#pragma unroll
                for (int bj = 0; bj < 2; ++bj) { const int col = u.pn * 256 + bj * 128 + wc * 32 + 8 * fq; *(v4u*)(O + (size_t)row * 768 + col) = pack8(acc[ai][bj][m][0] * sc, acc[ai][bj][m][1] * sc); } }
    }
};
struct EpiKV {
    static constexpr bool PERM = true;
    bf16* KNp; bf16* VTp; const float* rs;
    __device__ __forceinline__ void operator()(const f32x4 (&acc)[2][2][4][2], const Unit& u, int wr, int wc, int fr, int fq) const {
        const int row0 = u.pm * 256 + wr * 64 + fr;
#pragma unroll
        for (int ai = 0; ai < 2; ++ai)
#pragma unroll
            for (int m = 0; m < 4; ++m) { const int row = row0 + ai * 128 + m * 16; const float sc = rs[row];
                const bool lat = row < M; const int b = lat ? row / SEQ : (row - M) / CTXL; const int key = lat ? row % SEQ : SEQ + (row - M) % CTXL;
                const int kpos = (key & ~12) | ((key & 4) << 1) | ((key & 8) >> 1);
#pragma unroll
                for (int bj = 0; bj < 2; ++bj) { const int col = u.pn * 256 + bj * 128 + wc * 32 + 8 * fq; const int hh = col >> 7, w = col & 127;
                    if (w < 64) { *(v4u*)(KNp + (size_t)row * HW + hh * 64 + w) = pack8(acc[ai][bj][m][0] * sc, acc[ai][bj][m][1] * sc); }
                    else { bf16* dst = VTp + ((size_t)((b * NH + hh) * VD + (w - 64))) * NKEY + kpos;
#pragma unroll
                        for (int n = 0; n < 2; ++n)
#pragma unroll
                            for (int q = 0; q < 4; ++q) dst[(size_t)(4 * n + q) * NKEY] = (bf16)f2bf(acc[ai][bj][m][n][q] * sc); } } }
    }
};
struct EpiResid {
    static constexpr bool PERM = false;
    const float* hin_l; const float* hin_c; float* hout_l; float* hout_c; const float* modl; int goff;
    __device__ __forceinline__ void operator()(const f32x4 (&acc)[2][2][4][2], const Unit& u, int wr, int wc, int fr, int fq) const {
        const int rowt = u.pm * 256; const bool lat = rowt < M; const int bidx = lat ? rowt / SEQ : NB;
        const float* gate = modl + bidx * NMOD + goff;
        const float* hi = lat ? hin_l + (size_t)rowt * DM : hin_c + (size_t)(rowt - M) * DM;
        float* ho = lat ? hout_l + (size_t)rowt * DM : hout_c + (size_t)(rowt - M) * DM;
        const int col0 = u.pn * 256 + wc * 32 + 4 * fq;
#pragma unroll
        for (int bj = 0; bj < 2; ++bj)
#pragma unroll
            for (int n = 0; n < 2; ++n) { const f32x4 gv = *(const f32x4*)(gate + col0 + bj * 128 + n * 16);
#pragma unroll
                for (int ai = 0; ai < 2; ++ai)
#pragma unroll
                    for (int m = 0; m < 4; ++m) { const int r = ai * 128 + wr * 64 + m * 16 + fr; const size_t off = (size_t)r * DM + col0 + bj * 128 + n * 16; const f32x4 hv = *(const f32x4*)(hi + off); *(f32x4*)(ho + off) = hv + gv * acc[ai][bj][m][n]; }
                asm volatile("" ::: "memory"); }
    }
};
struct EpiPool {
    static constexpr bool PERM = false;
    float* h_l; float* h_c; const float* modl; const float* bias; const float* scale; int talloc;
    __device__ __forceinline__ void operator()(const f32x4 (&acc)[2][2][4][2], const Unit& u, int wr, int wc, int fr, int fq) const {
        const int g = u.pn, rowt = (u.pm - g * talloc) * 256; const bool lat = rowt < M; const int bidx = lat ? rowt / SEQ : NB;
        const float* gate = modl + bidx * NMOD + 2 * DM;
        float* ho = lat ? h_l + (size_t)rowt * DM : h_c + (size_t)(rowt - M) * DM;
        const int col0 = g * 256 + wc * 32 + 4 * fq;
#pragma unroll
        for (int bj = 0; bj < 2; ++bj)
#pragma unroll
            for (int n = 0; n < 2; ++n) { const int c = col0 + bj * 128 + n * 16; const f32x4 gm = *(const f32x4*)(gate + c) * *(const f32x4*)(scale + c); const f32x4 gb = gm * *(const f32x4*)(bias + c);
#pragma unroll
                for (int ai = 0; ai < 2; ++ai)
#pragma unroll
                    for (int m = 0; m < 4; ++m) { const int r = ai * 128 + wr * 64 + m * 16 + fr; const size_t off = (size_t)r * DM + c; const f32x4 hv = *(const f32x4*)(ho + off); *(f32x4*)(ho + off) = hv + gm * acc[ai][bj][m][n] + gb; }
                asm volatile("" ::: "memory"); }
    }
};
struct EpiGateUp {
    static constexpr bool PERM = true;
    bf16* H; int ldh, nct, rowsub;
    __device__ __forceinline__ void operator()(const f32x4 (&acc)[2][2][4][2], const Unit& u, int wr, int wc, int fr, int fq) const {
        const int row0 = u.pm * 256 + wr * 64 + fr - rowsub; const int ct = u.pn % nct; const int col = ct * 128 + wc * 32 + 8 * fq;
#pragma unroll
        for (int ai = 0; ai < 2; ++ai)
#pragma unroll
            for (int m = 0; m < 4; ++m) { const int row = row0 + ai * 128 + m * 16; f32x4 o[2];
#pragma unroll
                for (int n = 0; n < 2; ++n)
#pragma unroll
                    for (int q = 0; q < 4; ++q) { const float gv = acc[ai][0][m][n][q], uv = acc[ai][1][m][n][q]; o[n][q] = gv * uv / (1.0f + __expf(-gv)); }
                *(v4u*)(H + (size_t)row * ldh + col) = pack8(o[0], o[1]); }
    }
};
struct EpiY {
    static constexpr bool PERM = true;
    bf16* Y; int nct;
    __device__ __forceinline__ void operator()(const f32x4 (&acc)[2][2][4][2], const Unit& u, int wr, int wc, int fr, int fq) const {
        const int row0 = u.pm * 256 + wr * 64 + fr; const int ct = u.pn % nct;
#pragma unroll
        for (int ai = 0; ai < 2; ++ai)
#pragma unroll
            for (int m = 0; m < 4; ++m) { const int row = row0 + ai * 128 + m * 16;
#pragma unroll
                for (int bj = 0; bj < 2; ++bj) { const int col = ct * 256 + bj * 128 + wc * 32 + 8 * fq; *(v4u*)(Y + (size_t)row * DM + col) = pack8(acc[ai][bj][m][0], acc[ai][bj][m][1]); } }
    }
};

__device__ __forceinline__ void p0_prologue(Frame& F) {
    fresh(F);
    unsigned char* ws = F.ws;
    const float qscale = 0.10206207261596577f * 1.4426950408889634f;
    for (int j = 0; j < 2; ++j) {
        conv_matrix(F, F.in[8] + (size_t)j * DM * INW, DM, INW, (bf16*)(ws + WS_WIN) + (size_t)j * INP * DM, DM, 1, 0, nullptr, 1.f);
        conv_matrix(F, F.in[11] + (size_t)j * QL * 768, QL, 768, (bf16*)(ws + WS_WUQ) + (size_t)j * 768 * QL, QL, 0, 0, F.in[9] + j * QL, qscale);
        conv_matrix(F, F.in[12] + (size_t)j * KVL * 1024, KVL, 1024, (bf16*)(ws + WS_WUKV) + (size_t)j * 1024 * KVL, KVL, 0, 0, F.in[10] + j * KVL, 1.f);
        conv_matrix(F, F.in[15] + (size_t)j * DM * DM, DM, DM, (bf16*)(ws + WS_WOUT) + (size_t)j * DM * DM, DM, 0, 0, nullptr, 1.f);
        conv_matrix(F, F.in[16] + (size_t)j * DM * DFF, DM, DFF, (bf16*)(ws + WS_WGU) + (size_t)j * 2 * DFF * DM, DM, 2, 0, nullptr, 1.f);
        conv_matrix(F, F.in[17] + (size_t)j * DM * DFF, DM, DFF, (bf16*)(ws + WS_WGU) + (size_t)j * 2 * DFF * DM, DM, 2, 128, nullptr, 1.f);
        conv_matrix(F, F.in[18] + (size_t)j * DFF * DM, DFF, DM, (bf16*)(ws + WS_WDN) + (size_t)j * DM * DFF, DFF, 0, 0, nullptr, 1.f);
        for (int g = 0; g < 4; ++g)
            conv_matrix(F, F.in[19] + (size_t)(j * 4 + g) * 65536, 256, 256, (bf16*)(ws + WS_WPOOL) + (size_t)(j * 4 + g) * 65536, 256, 0, 0, nullptr, 1.f);
    }
    __syncthreads();
    if (blockIdx.x == 0 && F.tid < 8) {
        float* TC = (float*)(ws + WS_ROPE); float* TS = TC + 512;
        double th = 1.0; for (int i = 0; i < F.tid; ++i) th *= 0.31622776601683794;
        const double x2 = th * th; double s = th, c = 1.0, ts = th, tc = 1.0;
        for (int n = 1; n <= 12; ++n) { tc *= -x2 / (double)((2 * n - 1) * (2 * n)); c += tc; ts *= -x2 / (double)((2 * n) * (2 * n + 1)); s += ts; }
        double cp = 1.0, sp = 0.0;
        for (int p = 0; p < 64; ++p) { TC[p * 8 + F.tid] = (float)cp; TS[p * 8 + F.tid] = (float)sp; const double ncp = cp * c - sp * s; sp = sp * c + cp * s; cp = ncp; }
    }
    {
        LAS float* sc = (LAS float*)(F.lds + RING_OFF);
        LAS float* red = sc + 17 * 1024;
        const int nitems = 4 * (NMOD / 64);
        if ((int)blockIdx.x < nitems) {
            for (int e = F.tid; e < 17 * 1024; e += 512) { const int r = e >> 10, k = e & 1023; const float x = (r < 16) ? F.in[1][r * 1024 + k] : F.in[3][k]; sc[e] = siluf_(x); }
            __syncthreads();
            for (int it = blockIdx.x; it < nitems; it += F.G) {
                const int l = it / (NMOD / 64), c0 = (it % (NMOD / 64)) * 64;
                const float* W = F.in[4] + (size_t)l * DM * NMOD + c0 + F.lane;
                float acc[17];
#pragma unroll
                for (int r = 0; r < 17; ++r) acc[r] = 0.f;
                const int kb = F.wave * 128;
                for (int k = 0; k < 128; k += 4) {
                    const float w0 = W[(size_t)(kb + k) * NMOD], w1 = W[(size_t)(kb + k + 1) * NMOD], w2 = W[(size_t)(kb + k + 2) * NMOD], w3 = W[(size_t)(kb + k + 3) * NMOD];
#pragma unroll
                    for (int r = 0; r < 17; ++r) { const f32x4 s4 = *(const LAS f32x4*)(sc + r * 1024 + kb + k); acc[r] += s4.x * w0 + s4.y * w1 + s4.z * w2 + s4.w * w3; }
                }
#pragma unroll
                for (int r = 0; r < 17; ++r) red[(F.wave * 17 + r) * 64 + F.lane] = acc[r];
                __syncthreads();
                for (int o = F.tid; o < 17 * 64; o += 512) { const int r = o >> 6, cc = o & 63; float s = 0.f;
#pragma unroll
                    for (int w = 0; w < 8; ++w) s += red[(w * 17 + r) * 64 + cc];
                    ((float*)(ws + WS_MODV))[(size_t)(l * 17 + r) * NMOD + c0 + cc] = s + F.in[5][l * NMOD + c0 + cc]; }
                __syncthreads();
            }
        }
    }
}

__device__ __forceinline__ void e3_phase(Frame& F) {
    fresh(F);
    unsigned char* ws = F.ws;
    const bf16* CQ = (const bf16*)(ws + WS_CQ); const bf16* CKV = (const bf16*)(ws + WS_CKV); const bf16* KR = (const bf16*)(ws + WS_KR); bf16* KRR = (bf16*)(ws + WS_KRR);
    float* RSQ = (float*)(ws + WS_RSQ); float* RSKV = (float*)(ws + WS_RSKV); const float* TC = (const float*)(ws + WS_ROPE); const float* TS = TC + 512;
    const int rpw = (MT + F.G - 1) / F.G;
    for (int i = F.wave; i < rpw; i += NWAVES) {
        const int row = (int)blockIdx.x * rpw + i; if (row >= MT) break;
        float s = 0.f;
        if (F.lane < 48) { const v4u w = *(const v4u*)(CQ + (size_t)row * QL + F.lane * 8);
            s = bflo(w.x) * bflo(w.x) + bfhi(w.x) * bfhi(w.x) + bflo(w.y) * bflo(w.y) + bfhi(w.y) * bfhi(w.y) + bflo(w.z) * bflo(w.z) + bfhi(w.z) * bfhi(w.z) + bflo(w.w) * bflo(w.w) + bfhi(w.w) * bfhi(w.w); }
        s = wave_sum(s); if (F.lane == 0) RSQ[row] = rsqrtf(s * (1.0f / QL) + EPS);
        s = 0.f;
        if (F.lane < 32) { const v4u w = *(const v4u*)(CKV + (size_t)row * KVL + F.lane * 8);
            s = bflo(w.x) * bflo(w.x) + bfhi(w.x) * bfhi(w.x) + bflo(w.y) * bflo(w.y) + bfhi(w.y) * bfhi(w.y) + bflo(w.z) * bflo(w.z) + bfhi(w.z) * bfhi(w.z) + bflo(w.w) * bflo(w.w) + bfhi(w.w) * bfhi(w.w); }
        s = wave_sum(s); if (F.lane == 0) RSKV[row] = rsqrtf(s * (1.0f / KVL) + EPS);
        const float x = (F.lane < 32) ? bf2f(KR[(size_t)row * ROPE + F.lane]) : 0.f; const float pr = __shfl_xor(x, 8);
        float o = x;
        if (row < M) { const int t = row % SEQ; const int p = ((F.lane >> 4) & 1) ? (t & 63) : (t >> 6); const int j = F.lane & 7; const float c = TC[p * 8 + j], sn = TS[p * 8 + j];
            o = ((F.lane >> 3) & 1) ? x * c + pr * sn : x * c - pr * sn; }
        if (F.lane < 32) KRR[(size_t)row * ROPE + F.lane] = (bf16)f2bf(o);
    }
}

typedef short bf16x8v __attribute__((ext_vector_type(8)));
typedef float f32x16 __attribute__((ext_vector_type(16)));
__device__ __forceinline__ void attn_unit(Frame& F, int b, int h, int qrow0, bool rope_q, int t_lo, int t_hi) {
    unsigned char* ws = F.ws;
    const bf16* QB = (const bf16*)(ws + WS_QB); const bf16* KN = (const bf16*)(ws + WS_KN); const bf16* KRR = (const bf16*)(ws + WS_KRR); const bf16* VT = (const bf16*)(ws + WS_VV);
    bf16* MIX = (bf16*)(ws + WS_MIX); const float* TC = (const float*)(ws + WS_ROPE); const float* TS = TC + 512;
    const int lane = F.lane, wave = F.wave, r32 = lane & 31, hi = lane >> 5;
    LAS unsigned char* ring = F.lds + RING_OFF;
    const int qrow = qrow0 + wave * 32 + r32;
    bf16x8v qr[6];
#pragma unroll
    for (int d0 = 0; d0 < 6; ++d0) qr[d0] = *(const bf16x8v*)(QB + (size_t)qrow * 768 + h * QKD + 16 * d0 + 8 * hi);
    if (rope_q) { const int t = qrow % SEQ;
#pragma unroll
        for (int a = 0; a < 2; ++a) { const int p = a ? (t & 63) : (t >> 6); const v4u w = __builtin_bit_cast(v4u, qr[4 + a]); float x[8], y[8];
            x[0] = bflo(w.x); x[1] = bfhi(w.x); x[2] = bflo(w.y); x[3] = bfhi(w.y); x[4] = bflo(w.z); x[5] = bfhi(w.z); x[6] = bflo(w.w); x[7] = bfhi(w.w);
#pragma unroll
            for (int jj = 0; jj < 8; ++jj) { const float pr = __shfl_xor(x[jj], 32); const float c = TC[p * 8 + jj], sn = TS[p * 8 + jj]; y[jj] = hi ? x[jj] * c + pr * sn : x[jj] * c - pr * sn; }
            v4u o; o.x = pk2(y[0], y[1]); o.y = pk2(y[2], y[3]); o.z = pk2(y[4], y[5]); o.w = pk2(y[6], y[7]); qr[4 + a] = __builtin_bit_cast(bf16x8v, o); } }
    const int bh = b * NH + h;
    const bf16* vsrc = VT + ((size_t)(bh * VD + lane)) * NKEY + 8 * wave;
#define ATT_DMA(t, buf) do { const int t_ = (t); const int r0_ = t_ < SEQ / 64 ? b * SEQ + 64 * t_ : M + b * CTXL + 64 * (t_ - SEQ / 64); \
        LAS unsigned char* kb_ = ring + (buf) * 12288; LAS unsigned char* vb_ = ring + 24576 + (buf) * 8192; \
        __builtin_amdgcn_global_load_lds((const unsigned*)(KN + (size_t)(r0_ + lane) * HW + h * 64 + 8 * wave), (LAS unsigned*)(kb_ + wave * 1024), 16, 0, 0); \
        if (wave < 4) __builtin_amdgcn_global_load_lds((const unsigned*)(KRR + (size_t)(r0_ + lane) * ROPE + 8 * wave), (LAS unsigned*)(kb_ + (8 + wave) * 1024), 16, 0, 0); \
        __builtin_amdgcn_global_load_lds((const unsigned*)(vsrc + 64 * t_), (LAS unsigned*)(vb_ + wave * 1024), 16, 0, 0); } while (0)
    f32x16 o0, o1;
#pragma unroll
    for (int r = 0; r < 16; ++r) { o0[r] = 0.f; o1[r] = 0.f; }
    float m_run = -INFINITY, l_run = 0.f;
    ATT_DMA(t_lo, 0);
    for (int t = t_lo; t < t_hi; ++t) {
        const int buf = (t - t_lo) & 1;
        asm volatile("s_waitcnt vmcnt(0)" ::: "memory"); __syncthreads();
        if (t + 1 < t_hi) ATT_DMA(t + 1, buf ^ 1);
        const LAS unsigned char* kb = ring + buf * 12288 + hi * 1024 + r32 * 16; const LAS unsigned char* vb = ring + 24576 + buf * 8192 + hi * 1024 + r32 * 16;
        f32x16 p0, p1;
#pragma unroll
        for (int r = 0; r < 16; ++r) { p0[r] = 0.f; p1[r] = 0.f; }
#pragma unroll
        for (int d0 = 0; d0 < 6; ++d0) { const bf16x8v k0 = *(const LAS bf16x8v*)(kb + d0 * 2048), k1 = *(const LAS bf16x8v*)(kb + d0 * 2048 + 512);
            p0 = __builtin_amdgcn_mfma_f32_32x32x16_bf16(k0, qr[d0], p0, 0, 0, 0); p1 = __builtin_amdgcn_mfma_f32_32x32x16_bf16(k1, qr[d0], p1, 0, 0, 0); }
        float mt = fmaxf(p0[0], p1[0]);
#pragma unroll
        for (int r = 1; r < 16; ++r) mt = fmaxf(mt, fmaxf(p0[r], p1[r]));
        mt = fmaxf(mt, __shfl_xor(mt, 32));
        const float mn = fmaxf(m_run, mt); const float alpha = __builtin_amdgcn_exp2f(m_run - mn); m_run = mn;
        float ps = 0.f;
#pragma unroll
        for (int r = 0; r < 16; ++r) { p0[r] = __builtin_amdgcn_exp2f(p0[r] - mn); p1[r] = __builtin_amdgcn_exp2f(p1[r] - mn); ps += p0[r] + p1[r]; }
        l_run = l_run * alpha + ps;
#pragma unroll
        for (int r = 0; r < 16; ++r) { o0[r] *= alpha; o1[r] *= alpha; }
        v4u pw[4];
#pragma unroll
        for (int q = 0; q < 4; ++q) { pw[0][q] = cvt_pk_bf16(p0[2 * q], p0[2 * q + 1]); pw[1][q] = cvt_pk_bf16(p0[8 + 2 * q], p0[8 + 2 * q + 1]); pw[2][q] = cvt_pk_bf16(p1[2 * q], p1[2 * q + 1]); pw[3][q] = cvt_pk_bf16(p1[8 + 2 * q], p1[8 + 2 * q + 1]); }
#pragma unroll
        for (int s4 = 0; s4 < 4; ++s4) { const bf16x8v pa = __builtin_bit_cast(bf16x8v, pw[s4]);
            const bf16x8v v0 = *(const LAS bf16x8v*)(vb + s4 * 2048), v1 = *(const LAS bf16x8v*)(vb + s4 * 2048 + 512);
            o0 = __builtin_amdgcn_mfma_f32_32x32x16_bf16(v0, pa, o0, 0, 0, 0); o1 = __builtin_amdgcn_mfma_f32_32x32x16_bf16(v1, pa, o1, 0, 0, 0); }
    }
    l_run += __shfl_xor(l_run, 32);
    const float rl = 1.0f / l_run;
    bf16* orow = MIX + (size_t)qrow * DM + h * VD;
#pragma unroll
    for (int g = 0; g < 4; ++g) { v2u a, c2; a.x = pk2(o0[4 * g] * rl, o0[4 * g + 1] * rl); a.y = pk2(o0[4 * g + 2] * rl, o0[4 * g + 3] * rl); c2.x = pk2(o1[4 * g] * rl, o1[4 * g + 1] * rl); c2.y = pk2(o1[4 * g + 2] * rl, o1[4 * g + 3] * rl);
        *(v2u*)(orow + 8 * g + 4 * hi) = a; *(v2u*)(orow + 32 + 8 * g + 4 * hi) = c2; }
    __syncthreads();
#undef ATT_DMA
}
__device__ __forceinline__ void attn_phase(Frame& F, bool ctx_out) {
    fresh(F);
    const int nlat = NB * NH * 8, nctx = ctx_out ? NB * NH : 0;
    const int per = (nlat + F.G - 1) / F.G;
    for (int i = 0; i < per; ++i) { const int it = F.vcu * per + i; if (it >= nlat) break; const int bh = it >> 3, qb = it & 7; attn_unit(F, bh >> 3, bh & 7, (bh >> 3) * SEQ + qb * 256, true, 0, NKEY / 64); }
    for (int it = F.vcu; it < nctx; it += F.G) attn_unit(F, it >> 3, it & 7, M + (it >> 3) * CTXL, false, SEQ / 64, NKEY / 64);
    __syncthreads();
}

__device__ __forceinline__ void hgrn_phase(Frame& F, int j) {
    fresh(F);
    unsigned char* ws = F.ws;
    const bf16* HQ = (const bf16*)(ws + WS_HQ); const bf16* HFF = HQ + HSEG; const bf16* HFB = HQ + 2 * HSEG; const bf16* HI = HQ + 3 * HSEG;
    float* OF = (float*)(ws + WS_OF); float* OB = (float*)(ws + WS_OB);
    LAS float* sq = (LAS float*)(F.lds + RING_OFF);
    LAS float* sk = sq + 16 * 128;
    LAS float* sv = sk + 16 * 128;
    LAS float* part = sv + 16 * 64;
    for (int it = blockIdx.x; it < NB * NHH * 2 * 2; it += F.G) {
        const int vh = it & 1, dir = (it >> 1) & 1, hh = (it >> 2) & 3, b = it >> 4;
        const bf16* HF = dir ? HFB : HFF; float* OO = dir ? OB : OF;
        const int ss = F.tid >> 5, sub = F.tid & 31;
        float oml[4];
#pragma unroll
        for (int q = 0; q < 4; ++q) { float lb = 0.f; if (j == 1) { const int ci = dir * HW + hh * HK + 4 * sub + q; const float l0 = F.in[13][ci], l1 = F.in[13][2 * HW + ci]; lb = 1.0f / (1.0f + __expf(l0 - l1)); } oml[q] = 1.0f - lb; }
        float S[16];
#pragma unroll
        for (int q = 0; q < 16; ++q) S[q] = 0.f;
        const int kg = F.wave * 16;
        for (int blk = 0; blk < (CTXL + SEQ) / 16; ++blk) {
            const int i0 = blk * 16;
            __syncthreads();
            { const int i = i0 + ss; const int row = (i < CTXL) ? (M + b * CTXL + (dir ? CTXL - 1 - i : i)) : (b * SEQ + (dir ? SEQ - 1 - (i - CTXL) : (i - CTXL)));
              const v2u wq = *(const v2u*)(HQ + (size_t)row * HW + hh * HK + 4 * sub); const v2u wf = *(const v2u*)(HF + (size_t)row * HW + hh * HK + 4 * sub);
              const unsigned wv = *(const unsigned*)(HI + (size_t)row * HW + hh * HK + vh * 64 + 2 * sub);
              *(LAS f32x4*)(sq + ss * 128 + 4 * sub) = (f32x4){siluf_(bflo(wq.x)), siluf_(bfhi(wq.x)), siluf_(bflo(wq.y)), siluf_(bfhi(wq.y))};
              *(LAS f32x4*)(sk + ss * 128 + 4 * sub) = (f32x4){oml[0] * sigmoidf_(-bflo(wf.x)), oml[1] * sigmoidf_(-bfhi(wf.x)), oml[2] * sigmoidf_(-bflo(wf.y)), oml[3] * sigmoidf_(-bfhi(wf.y))};
              sv[ss * 64 + 2 * sub] = bflo(wv); sv[ss * 64 + 2 * sub + 1] = bfhi(wv); }
            __syncthreads();
#pragma unroll 4
            for (int s = 0; s < 16; ++s) {
                const float vv = sv[s * 64 + F.lane]; float po = 0.f;
#pragma unroll
                for (int q4 = 0; q4 < 4; ++q4) { const f32x4 k4 = *(const LAS f32x4*)(sk + s * 128 + kg + 4 * q4), q4v = *(const LAS f32x4*)(sq + s * 128 + kg + 4 * q4);
                    S[4 * q4 + 0] = fmaf(k4.x, vv - S[4 * q4 + 0], S[4 * q4 + 0]); po = fmaf(S[4 * q4 + 0], q4v.x, po);
                    S[4 * q4 + 1] = fmaf(k4.y, vv - S[4 * q4 + 1], S[4 * q4 + 1]); po = fmaf(S[4 * q4 + 1], q4v.y, po);
                    S[4 * q4 + 2] = fmaf(k4.z, vv - S[4 * q4 + 2], S[4 * q4 + 2]); po = fmaf(S[4 * q4 + 2], q4v.z, po);
                    S[4 * q4 + 3] = fmaf(k4.w, vv - S[4 * q4 + 3], S[4 * q4 + 3]); po = fmaf(S[4 * q4 + 3], q4v.w, po); }
                part[(s * 8 + F.wave) * 64 + F.lane] = po;
            }
            __syncthreads();
#pragma unroll
            for (int r = 0; r < 2; ++r) { const int oi = F.tid + 512 * r; const int s = oi >> 6, v = oi & 63; float a = 0.f;
#pragma unroll
                for (int w = 0; w < 8; ++w) a += part[(s * 8 + w) * 64 + v];
                const int i = i0 + s; const int row = (i < CTXL) ? (M + b * CTXL + (dir ? CTXL - 1 - i : i)) : (b * SEQ + (dir ? SEQ - 1 - (i - CTXL) : (i - CTXL)));
                OO[(size_t)row * HW + hh * HK + vh * 64 + v] = a; }
        }
    }
    __syncthreads();
}

__device__ __forceinline__ void e8_phase(Frame& F, int j, int nrows) {
    fresh(F);
    unsigned char* ws = F.ws;
    const float* OF = (const float*)(ws + WS_OF); const float* OB = (const float*)(ws + WS_OB); const bf16* HG = (const bf16*)(ws + WS_HQ) + 4 * HSEG; bf16* MIX = (bf16*)(ws + WS_MIX);
    const float* gn = F.in[14] + j * HK;
    const int rpw = (nrows + F.G - 1) / F.G;
    for (int i = F.wave; i < rpw; i += NWAVES) {
        const int row = (int)blockIdx.x * rpw + i; if (row >= nrows) break;
        const int col = 8 * F.lane;
        const f32x4 a0 = *(const f32x4*)(OF + (size_t)row * HW + col), a1 = *(const f32x4*)(OF + (size_t)row * HW + col + 4), b0 = *(const f32x4*)(OB + (size_t)row * HW + col), b1 = *(const f32x4*)(OB + (size_t)row * HW + col + 4);
        f32x4 x0 = a0 + b0, x1 = a1 + b1;
        float s = (x0.x * x0.x + x0.y * x0.y) + (x0.z * x0.z + x0.w * x0.w) + (x1.x * x1.x + x1.y * x1.y) + (x1.z * x1.z + x1.w * x1.w);
        s += __shfl_xor(s, 1); s += __shfl_xor(s, 2); s += __shfl_xor(s, 4); s += __shfl_xor(s, 8);
        const float rstd = rsqrtf(s * (1.0f / HK) + EPS);
        const int vv = col & 127; const f32x4 g0 = *(const f32x4*)(gn + vv), g1 = *(const f32x4*)(gn + vv + 4);
        const v4u hg = *(const v4u*)(HG + (size_t)row * HW + col);
        x0 = x0 * rstd * g0; x1 = x1 * rstd * g1;
        v4u o; o.x = pk2(x0.x * siluf_(bflo(hg.x)), x0.y * siluf_(bfhi(hg.x))); o.y = pk2(x0.z * siluf_(bflo(hg.y)), x0.w * siluf_(bfhi(hg.y)));
        o.z = pk2(x1.x * siluf_(bflo(hg.z)), x1.y * siluf_(bfhi(hg.z))); o.w = pk2(x1.z * siluf_(bflo(hg.w)), x1.w * siluf_(bfhi(hg.w)));
        *(v4u*)(MIX + (size_t)row * DM + HW + col) = o;
    }
}

__device__ __forceinline__ void o2_phase(Frame& F, int nrows) {
    fresh(F);
    unsigned char* ws = F.ws;
    const bf16* U = (const bf16*)(ws + WS_U); bf16* P = (bf16*)(ws + WS_POOLED);
    const int rpw = (nrows + F.G - 1) / F.G;
    for (int i = F.wave; i < rpw; i += NWAVES) {
        const int row = (int)blockIdx.x * rpw + i; if (row >= nrows) break;
        const bool lat = row < M; const int T = lat ? SEQ : CTXL; const int t = lat ? row % SEQ : (row - M) % CTXL; const int rbase = row - t;
#pragma unroll
        for (int g = 0; g < 4; ++g) {
            const int w = 2 << g; int lo = t - w / 2; if (lo < 0) lo = 0; int hi = t + w / 2; if (hi > T) hi = T;
            const int col = 256 * g + 4 * F.lane;
            float s0 = 0.f, s1 = 0.f, s2 = 0.f, s3 = 0.f;
            for (int r = lo; r < hi; ++r) { const v2u x = *(const v2u*)(U + (size_t)(rbase + r) * DM + col); s0 += bflo(x.x); s1 += bfhi(x.x); s2 += bflo(x.y); s3 += bfhi(x.y); }
            const v2u xc = *(const v2u*)(U + (size_t)row * DM + col); const float ic = 1.0f / (float)(hi - lo);
            v2u o; o.x = pk2(s0 * ic - bflo(xc.x), s1 * ic - bfhi(xc.x)); o.y = pk2(s2 * ic - bflo(xc.y), s3 * ic - bfhi(xc.y));
            *(v2u*)(P + ((size_t)g * MT + row) * 256 + 4 * F.lane) = o;
        }
    }
}

__device__ __forceinline__ void o5_phase(Frame& F, int nrows) {
    fresh(F);
    unsigned char* ws = F.ws;
    const int* CNT = (const int*)(ws + WS_CNT); int* TST = (int*)(ws + WS_TST); const int* EIDX = (const int*)(ws + WS_EIDX); int* POS = (int*)(ws + WS_POS);
    const bf16* U = (const bf16*)(ws + WS_U); bf16* VG = (bf16*)(ws + WS_VG);
    LAS int* lc = (LAS int*)(F.lds + RING_OFF);
    LAS int* lbase = lc + 512 * 8;
    LAS int* lpos = lbase + 16;
    const int rpw = (nrows + F.G - 1) / F.G;
    for (int e = F.tid; e < F.G * 8; e += 512) lc[e] = CNT[e];
    __syncthreads();
    if (F.tid == 0) {
        int tot[8], pre[8];
        for (int e = 0; e < 8; ++e) { int s = 0, p = 0; for (int w = 0; w < F.G; ++w) { if (w == (int)blockIdx.x) p = s; s += lc[w * 8 + e]; } tot[e] = s; pre[e] = p; }
        int ts = 0;
        for (int e = 0; e < 8; ++e) { lbase[e] = ts * 256 + pre[e]; if (blockIdx.x == 0) TST[e] = ts; ts += (tot[e] + 255) >> 8; }
        if (blockIdx.x == 0) TST[8] = ts;
    }
    __syncthreads();
    if (F.wave == 0) {
        int run[8];
#pragma unroll
        for (int e = 0; e < 8; ++e) run[e] = lbase[e];
        const int npairs = 2 * rpw;
        for (int c0 = 0; c0 < npairs; c0 += 64) {
            const int pl = c0 + F.lane; const int row = (int)blockIdx.x * rpw + (pl >> 1); const bool ok = pl < npairs && row < nrows;
            const int e = ok ? EIDX[2 * row + (pl & 1)] : -1; int mypos = 0;
#pragma unroll
            for (int x = 0; x < 8; ++x) { const unsigned long long mk = __ballot(e == x); const int below = __popcll(mk & ((1ull << F.lane) - 1ull)); if (e == x) mypos = run[x] + below; run[x] += __popcll(mk); }
            if (ok) { lpos[pl] = mypos; POS[2 * row + (pl & 1)] = mypos; }
        }
    }
    __syncthreads();
    for (int pl = F.wave; pl < 2 * rpw; pl += NWAVES) {
        const int row = (int)blockIdx.x * rpw + (pl >> 1); if (row >= nrows) break;
        const int p = lpos[pl];
        const v4u a = *(const v4u*)(U + (size_t)row * DM + 8 * F.lane), b = *(const v4u*)(U + (size_t)row * DM + 512 + 8 * F.lane);
        *(v4u*)(VG + (size_t)p * DM + 8 * F.lane) = a; *(v4u*)(VG + (size_t)p * DM + 512 + 8 * F.lane) = b;
    }
    __syncthreads();
}

__global__ void __launch_bounds__(NWAVES * 64, 2) mega_fwd(Args args) {
    extern __shared__ __attribute__((aligned(16))) unsigned char lds[];
    Frame F;
    F.lds = (LAS unsigned char*)lds;
    F.tid = threadIdx.x; F.lane = F.tid & 63; F.wave = __builtin_amdgcn_readfirstlane(F.tid >> 6);
    F.G = gridDim.x; { const int bx = blockIdx.x; F.vcu = (F.G % 8 == 0) ? (bx % 8) * (F.G / 8) + bx / 8 : bx; }
    F.in = args.in; F.out = args.out; F.ws = args.ws;
    unsigned char* ws = args.ws;
    volatile LAS unsigned* MISC = (volatile LAS unsigned*)(F.lds + MISC_OFF);
    for (int u = F.tid; u < (LDS_BYTES - LDSCTL_OFF) / 4; u += NWAVES * 64) ((LAS unsigned*)(F.lds + LDSCTL_OFF))[u] = 0u;
    __syncthreads();
    XcdBarrier bar = xcd_barrier_post((unsigned*)(ws + WS_CTL) + CW_BAR, MISC + 8);
#define GRID_BAR() xcd_barrier(bar)
#ifndef ONLY
#define ONLY 0
#endif
#define PH(n) (ONLY == 0 || ONLY == (n))
    LAS unsigned char* ring = F.lds + RING_OFF;
    const float* MODV = (const float*)(ws + WS_MODV);
    float* HC = (float*)(ws + WS_HC);
    bf16* U = (bf16*)(ws + WS_U);

#if PH(20)
    p0_prologue(F);
#endif
    GRID_BAR();

    for (int lp = 0; lp < 2; ++lp) {
        const int le = 2 * lp, lo = 2 * lp + 1, j = lp;
        const bool ctx_out = (lp == 0);
        const int nro = ctx_out ? MT : M;
        const float* modE = MODV + (size_t)le * 17 * NMOD; const float* modO = MODV + (size_t)lo * 17 * NMOD;
        const float* hin_l = (lp == 0) ? args.in[0] : args.out; const float* hin_c = (lp == 0) ? args.in[2] : HC;
#if PH(1)
        {
            RowArgs A{}; A.hin_l = hin_l; A.hin_c = hin_c; A.hout_l = args.out; A.hout_c = HC; A.g = args.in[6] + (size_t)(le * 2 + 0) * DM; A.modl = modE; A.shoff = 0; A.scoff = DM; A.U = U;
            A.Y = (const bf16*)(ws + WS_VG); A.pos = (const int*)(ws + WS_POS); A.gate = (const float*)(ws + WS_GATE); A.modprev = MODV + (size_t)(le - 1) * 17 * NMOD;
            if (lp == 0) row_phase<false, 1, false>(F, A, MT); else row_phase<true, 1, false>(F, A, MT);
        }
#endif
        GRID_BAR();
#if PH(2)
        {
            pg8::Gemm g{U, (const bf16*)(ws + WS_WIN) + (size_t)j * INP * DM, DM, DM, DM}; pg8::StaticOrder S; S.init(MT, INP, F.G, (int)blockIdx.x);
            EpiIn E{(bf16*)(ws + WS_CQ), (bf16*)(ws + WS_KR), (bf16*)(ws + WS_CKV), (bf16*)(ws + WS_HQ)};
            pg8::gemm_phase<EpiIn, pg8::StaticOrder, true>(ring, g, S, E);
        }
#endif
        GRID_BAR();
#if PH(3)
        e3_phase(F);
#endif
        GRID_BAR();
#if PH(4)
        {
            pg8::Gemm g{(const bf16*)(ws + WS_CQ), (const bf16*)(ws + WS_WUQ) + (size_t)j * 768 * QL, QL, QL, QL}; pg8::StaticOrder S; S.init(nro, 768, F.G, (int)blockIdx.x);
            EpiQ E{(bf16*)(ws + WS_QB), (const float*)(ws + WS_RSQ)};
            pg8::gemm_phase<EpiQ, pg8::StaticOrder, true>(ring, g, S, E);
        }
        {
            pg8::Gemm g{(const bf16*)(ws + WS_CKV), (const bf16*)(ws + WS_WUKV) + (size_t)j * 1024 * KVL, KVL, KVL, KVL}; pg8::StaticOrder S; S.init(MT, 1024, F.G, (int)blockIdx.x);
            EpiKV E{(bf16*)(ws + WS_KN), (bf16*)(ws + WS_VV), (const float*)(ws + WS_RSKV)};
            pg8::gemm_phase<EpiKV, pg8::StaticOrder, true>(ring, g, S, E);
        }
#endif
        GRID_BAR();
#if PH(6)
#ifndef NO_HGRN
        hgrn_phase(F, j);
#endif
#ifndef NO_ATTN
        attn_phase(F, ctx_out);
#endif
#endif
        GRID_BAR();
#if PH(8)
        e8_phase(F, j, nro);
#endif
        GRID_BAR();
#if PH(9)
        {
            pg8::Gemm g{(const bf16*)(ws + WS_MIX), (const bf16*)(ws + WS_WOUT) + (size_t)j * DM * DM, DM, DM, DM}; pg8::StaticOrder S; S.init(nro, DM, F.G, (int)blockIdx.x);
            EpiResid E{hin_l, hin_c, args.out, HC, modE, 2 * DM};
            pg8::gemm_phase<EpiResid, pg8::StaticOrder, true>(ring, g, S, E);
        }
#endif
        GRID_BAR();
#if PH(10)
        {
            RowArgs A{}; A.hin_l = args.out; A.hin_c = HC; A.g = args.in[6] + (size_t)(le * 2 + 1) * DM; A.modl = modE; A.shoff = 3 * DM; A.scoff = 4 * DM; A.U = U;
            row_phase<false, 1, false>(F, A, nro);
        }
#endif
        GRID_BAR();
#if PH(11)
        {
            pg8::Gemm g{U, (const bf16*)(ws + WS_WGU) + (size_t)j * 2 * DFF * DM, DM, DM, DM}; pg8::StaticOrder S; S.init(nro, 2 * DFF, F.G, (int)blockIdx.x);
            EpiGateUp E{(bf16*)(ws + WS_HID), DFF, 2 * DFF / 256, 0};
            pg8::gemm_phase<EpiGateUp, pg8::StaticOrder, true>(ring, g, S, E);
        }
#endif
        GRID_BAR();
#if PH(12)
        {
            pg8::Gemm g{(const bf16*)(ws + WS_HID), (const bf16*)(ws + WS_WDN) + (size_t)j * DM * DFF, DFF, DFF, DFF}; pg8::StaticOrder S; S.init(nro, DM, F.G, (int)blockIdx.x);
            EpiResid E{args.out, HC, args.out, HC, modE, 5 * DM};
            pg8::gemm_phase<EpiResid, pg8::StaticOrder, true>(ring, g, S, E);
        }
#endif
        GRID_BAR();
#if PH(13)
        {
            RowArgs A{}; A.hin_l = args.out; A.hin_c = HC; A.g = args.in[6] + (size_t)(lo * 2 + 0) * DM; A.modl = modO; A.shoff = 0; A.scoff = DM; A.U = U;
            row_phase<false, 1, false>(F, A, nro);
            for (int e = 0; e < NE; ++e) {
                conv_matrix(F, args.in[23] + ((size_t)j * NE + e) * DM * DFE, DM, DFE, (bf16*)(ws + WS_MWGU) + (size_t)e * 2 * DFE * DM, DM, 2, 0, nullptr, 1.f);
                conv_matrix(F, args.in[24] + ((size_t)j * NE + e) * DM * DFE, DM, DFE, (bf16*)(ws + WS_MWGU) + (size_t)e * 2 * DFE * DM, DM, 2, 128, nullptr, 1.f);
                conv_matrix(F, args.in[25] + ((size_t)j * NE + e) * DFE * DM, DFE, DM, (bf16*)(ws + WS_MWDN) + (size_t)e * DM * DFE, DFE, 0, 0, nullptr, 1.f);
            }
        }
#endif
        GRID_BAR();
#if PH(14)
        o2_phase(F, nro);
#endif
        GRID_BAR();
#if PH(15)
        {
            pg8::Gemm g{(const bf16*)(ws + WS_POOLED), (const bf16*)(ws + WS_WPOOL) + (size_t)j * 4 * 65536, 256, 256, 256};
            pg8::PoolOrder S{nro / 256, MT / 256, F.G, (int)blockIdx.x};
            EpiPool E{args.out, HC, modO, args.in[20] + (size_t)j * DM, args.in[21] + (size_t)j * DM, MT / 256};
            pg8::gemm_phase<EpiPool, pg8::PoolOrder, true>(ring, g, S, E);
        }
#endif
        GRID_BAR();
#if PH(16)
        {
            RowArgs A{}; A.hin_l = args.out; A.hin_c = HC; A.g = args.in[6] + (size_t)(lo * 2 + 1) * DM; A.modl = modO; A.shoff = 3 * DM; A.scoff = 4 * DM; A.U = U;
            A.router = args.in[22] + (size_t)j * DM * NE; A.eidx = (int*)(ws + WS_EIDX); A.gout = (float*)(ws + WS_GATE); A.cnt = (int*)(ws + WS_CNT);
            row_phase<false, 1, true>(F, A, nro);
        }
#endif
        GRID_BAR();
#if PH(17)
        o5_phase(F, nro);
#endif
        GRID_BAR();
#if PH(18)
        {
            const int* TST = (const int*)(ws + WS_TST);
            const int ts1 = TST[1], ts2 = TST[2], ts3 = TST[3], ts4 = TST[4], ts5 = TST[5], ts6 = TST[6], ts7 = TST[7], nT = TST[8];
            const int h0 = (nT + 1) / 2;
            for (int c = 0; c < 2; ++c) {
                const int t0 = c ? h0 : 0, nrt = c ? nT - h0 : h0;
                {
                    pg8::Gemm g{(const bf16*)(ws + WS_VG), (const bf16*)(ws + WS_MWGU), DM, DM, DM};
                    pg8::MoeOrder S{t0, nrt, 2 * DFE / 256, F.G, (int)blockIdx.x, ts1, ts2, ts3, ts4, ts5, ts6, ts7};
                    EpiGateUp E{(bf16*)(ws + WS_HIDM), DFE, 2 * DFE / 256, t0 * 256};
                    pg8::gemm_phase<EpiGateUp, pg8::MoeOrder, true>(ring, g, S, E);
                }
                GRID_BAR();
                {
                    pg8::Gemm g{(const bf16*)(ws + WS_HIDM) - (size_t)t0 * 256 * DFE, (const bf16*)(ws + WS_MWDN), DFE, DFE, DFE};
                    pg8::MoeOrder S{t0, nrt, DM / 256, F.G, (int)blockIdx.x, ts1, ts2, ts3, ts4, ts5, ts6, ts7};
                    EpiY E{(bf16*)(ws + WS_VG), DM / 256};
                    pg8::gemm_phase<EpiY, pg8::MoeOrder, true>(ring, g, S, E);
                }
                GRID_BAR();
            }
        }
#endif
    }
#if PH(19)
    {
        RowArgs A{}; A.hin_l = args.out; A.hin_c = HC; A.hout_l = args.out; A.hout_c = HC; A.g = args.in[7];
        A.Y = (const bf16*)(ws + WS_VG); A.pos = (const int*)(ws + WS_POS); A.gate = (const float*)(ws + WS_GATE); A.modprev = MODV + (size_t)3 * 17 * NMOD;
        row_phase<true, 2, false>(F, A, M);
        if (xb_ld((unsigned*)(ws + WS_CTL) + CW_BAR + XB_TMO) != 0u) { __syncthreads(); const float qn = __builtin_nanf(""); for (int i = F.tid; i < 1024; i += 512) args.out[(size_t)blockIdx.x * 1024 + i] = qn; }
    }
#endif
}

extern "C" void kernel_launch(void* const* d_in, const int* in_sizes, int n_in, void* d_out, int out_size, void* d_ws, size_t ws_size, hipStream_t stream) {
    static int grid = 0;
    if (grid == 0) {
        if (n_in != 26 || out_size != M * DM || ws_size < WS_END) { fprintf(stderr, "kernel_launch: unexpected shapes (n_in %d out %d ws %zu)\n", n_in, out_size, ws_size); grid = -1; return; }
        int dev = 0, cus = 0, per_cu = 0;
        if (hipGetDevice(&dev) != hipSuccess || hipDeviceGetAttribute(&cus, hipDeviceAttributeMultiprocessorCount, dev) != hipSuccess) { grid = -1; return; }
        if (hipFuncSetAttribute((const void*)mega_fwd, hipFuncAttributeMaxDynamicSharedMemorySize, LDS_BYTES) != hipSuccess) { grid = -1; return; }
        if (hipOccupancyMaxActiveBlocksPerMultiprocessor(&per_cu, (const void*)mega_fwd, NWAVES * 64, LDS_BYTES) != hipSuccess || per_cu < 1) fprintf(stderr, "kernel_launch: occupancy query says %d\n", per_cu);
        (void)hipGetLastError();
        grid = cus > 256 ? 256 : cus;
    }
    if (grid < 0) return;
    if (hipMemsetAsync((char*)d_ws + WS_CTL, 0, CTL_ZERO_BYTES, stream) != hipSuccess) return;
    Args a{};
    for (int i = 0; i < 26; ++i) a.in[i] = (const float*)d_in[i];
    a.out = (float*)d_out; a.ws = (unsigned char*)d_ws;
    hipLaunchKernelGGL(mega_fwd, dim3(grid), dim3(NWAVES * 64), LDS_BYTES, stream, a);
}
```

```cpp
#include <hip/hip_runtime.h>
#include <cstdio>
#include <cstdint>

namespace pg8 {
#define PG8_LAS __attribute__((address_space(3)))
typedef unsigned short bf16_t;
typedef short bf16x8 __attribute__((ext_vector_type(8)));
typedef float f32x4 __attribute__((ext_vector_type(4)));
typedef unsigned u32x4 __attribute__((ext_vector_type(4)));
constexpr int BM = 256, BK = 64, HALF = 128, HTB = HALF * BK * 2, STAGE_BYTES = 8 * HTB, NXCD = 8, WGM = 8;

__host__ __device__ __forceinline__ int lds_byte(int r, int c) { const int st = (r >> 4) * 2 + (c >> 5), rr = r & 15, cc = c & 31, ob = rr * 64 + cc * 2; return st * 1024 + (ob ^ (((ob >> 9) & 1) << 5)); }
__host__ __device__ __forceinline__ void stage_rc(int b, int& R, int& C) { const int st = b / 1024, sb = b % 1024, swz = sb ^ (((sb >> 9) & 1) << 5); R = (st >> 1) * 16 + swz / 64; C = (st & 1) * 32 + (swz % 64) / 2; }
__host__ __device__ __forceinline__ int perm32(int rho) { const int n = rho >> 4, i = rho & 15; return 8 * (i >> 2) + 4 * n + (i & 3); }

struct Unit { int pm, pn; };
struct Gemm { const bf16_t* A; const bf16_t* Bt; int lda, ldb, K; };

struct StaticOrder {
    int nM, nN, nwg, G, c;
    __device__ void init(int M, int N, int G_, int c_) { nM = M / BM; nN = N / BM; nwg = nM * nN; G = G_; c = c_; }
    __device__ bool next(int i, Unit& u) const {
        const long L = (long)i * G + c; if (L >= nwg) return false;
        int wgid = (int)L; { const int q = nwg / NXCD, r = nwg % NXCD, xcd = wgid % NXCD, off = wgid / NXCD; wgid = (xcd < r ? xcd * (q + 1) : r * (q + 1) + (xcd - r) * q) + off; }
        const int nig = WGM * nN, gid = wgid / nig, fm = gid * WGM, gsz = (nM - fm) < WGM ? (nM - fm) : WGM;
        u.pm = fm + ((wgid % nig) % gsz); u.pn = (wgid % nig) / gsz; return true;
    }
};
struct PoolOrder {
    int nrt, talloc, G, c;
    __device__ bool next(int i, Unit& u) const { const int L = i * G + c; if (L >= 4 * nrt) return false; const int g = L / nrt, rt = L - g * nrt; u.pm = g * talloc + rt; u.pn = g; return true; }
};
struct MoeOrder {
    int t0, nrt, nct, G, c; int ts1, ts2, ts3, ts4, ts5, ts6, ts7;
    __device__ bool next(int i, Unit& u) const {
        const int nwg = nrt * nct; const int L = i * G + c; if (L >= nwg) return false;
        int wgid = L; { const int q = nwg / NXCD, r = nwg % NXCD, xcd = wgid % NXCD, off = wgid / NXCD; wgid = (xcd < r ? xcd * (q + 1) : r * (q + 1) + (xcd - r) * q) + off; }
        const int nig = WGM * nct, gid = wgid / nig, fm = gid * WGM, gsz = (nrt - fm) < WGM ? (nrt - fm) : WGM;
        const int rt = t0 + fm + ((wgid % nig) % gsz), ct = (wgid % nig) / gsz;
        const int e = (rt >= ts1) + (rt >= ts2) + (rt >= ts3) + (rt >= ts4) + (rt >= ts5) + (rt >= ts6) + (rt >= ts7);
        u.pm = rt; u.pn = e * nct + ct; return true;
    }
};

__device__ __forceinline__ unsigned cvt_pk_bf16(float lo, float hi) { unsigned r; asm volatile("v_cvt_pk_bf16_f32 %0, %1, %2" : "=v"(r) : "v"(lo), "v"(hi)); return r; }

template <class Epi, class Sched, bool ALIGN_EPI>
__device__ __forceinline__ void gemm_phase(PG8_LAS unsigned char* lds, const Gemm g, const Sched& S, const Epi& E) {
    int tid_ = threadIdx.x; asm volatile("" : "+v"(tid_));
    const int tid = tid_, wid = __builtin_amdgcn_readfirstlane(tid >> 6), lane = tid & 63, wr = wid >> 2, wc = wid & 3, fr = lane & 15, fq = lane >> 4;
    int K_ = g.K; asm volatile("" : "+s"(K_));
    const int K = K_, nt = K / BK;
    unsigned voffA[2], voffB[2];
#pragma unroll
    for (int i = 0; i < 2; ++i) { int R, C; stage_rc(tid * 16 + i * 8192, R, C); const int Rb = Epi::PERM ? ((R & ~31) + perm32(R & 31)) : R;
        voffA[i] = (unsigned)(R * g.lda + C) * 2u; voffB[i] = (unsigned)(Rb * g.ldb + C) * 2u; }
    const size_t kstep = (size_t)(BK * 2);
    const size_t hstepA = (size_t)HALF * g.lda * 2, hstepB = (size_t)HALF * g.ldb * 2;
    const size_t tstepA = 2 * hstepA, tstepB = 2 * hstepB;
    const unsigned ldsw = (unsigned)wid * 1024u;
    const int aoff = lds_byte(wr * 64 + fr, fq * 8), boff = lds_byte(wc * 32 + fr, fq * 8);
#define PG8_SA(b, h) (((b) * 2 + (h)) * HTB)
#define PG8_SB(b, h) ((4 + (b) * 2 + (h)) * HTB)
#define PG8_STAGE(bufoff, gbase, voff) do { _Pragma("unroll") for (int _i = 0; _i < 2; ++_i) \
        __builtin_amdgcn_global_load_lds((const unsigned*)((const char*)(gbase) + (voff)[_i]), (PG8_LAS unsigned*)(lds + (bufoff) + ldsw + _i * 8192), 16, 0, 0); } while (0)
#define PG8_LDA(dst, b, h) do { _Pragma("unroll") for (int m = 0; m < 4; ++m) _Pragma("unroll") for (int k = 0; k < 2; ++k) dst[m][k] = *(const PG8_LAS bf16x8*)(lds + PG8_SA(b, h) + aoff + m * 2048 + k * 1024); } while (0)
#define PG8_LDB(dst, b, h) do { _Pragma("unroll") for (int n = 0; n < 2; ++n) _Pragma("unroll") for (int k = 0; k < 2; ++k) dst[n][k] = *(const PG8_LAS bf16x8*)(lds + PG8_SB(b, h) + boff + n * 2048 + k * 1024); } while (0)
#define PG8_MMA(ai, bj, At, Bt) do { __builtin_amdgcn_s_setprio(1); _Pragma("unroll") for (int m = 0; m < 4; ++m) _Pragma("unroll") for (int n = 0; n < 2; ++n) _Pragma("unroll") for (int k = 0; k < 2; ++k) \
        acc[ai][bj][m][n] = __builtin_amdgcn_mfma_f32_16x16x32_bf16(Bt[n][k], At[m][k], acc[ai][bj][m][n], 0, 0, 0); __builtin_amdgcn_s_setprio(0); } while (0)
#define PG8_WAIT_V(n) asm volatile("s_waitcnt vmcnt(" #n ")" ::: "memory")
#define PG8_WAIT_L(n) asm volatile("s_waitcnt lgkmcnt(" #n ")" ::: "memory")
#define PG8_BAR __builtin_amdgcn_s_barrier()
#define PG8_SCHED __builtin_amdgcn_sched_barrier(0)
    Unit cur, nxt; int ui = 0;
    if (!S.next(0, cur)) return;
    f32x4 acc[2][2][4][2];
#pragma unroll
    for (int a = 0; a < 2; ++a)
#pragma unroll
        for (int b = 0; b < 2; ++b)
#pragma unroll
            for (int m = 0; m < 4; ++m)
#pragma unroll
                for (int n = 0; n < 2; ++n) acc[a][b][m][n] = (f32x4){0.f, 0.f, 0.f, 0.f};
    bf16x8 At[4][2], B0[2][2], B1[2][2];
    const char* cA = (const char*)g.A + (size_t)cur.pm * tstepA; const char* cB = (const char*)g.Bt + (size_t)cur.pn * tstepB;
    PG8_STAGE(PG8_SB(0, 0), cB, voffB); PG8_STAGE(PG8_SB(0, 1), cB + hstepB, voffB); PG8_STAGE(PG8_SA(0, 0), cA, voffA); PG8_STAGE(PG8_SA(0, 1), cA + hstepA, voffA);
    if (wr == 1) PG8_BAR;
    PG8_WAIT_V(2); PG8_BAR;
    PG8_STAGE(PG8_SB(1, 0), cB + kstep, voffB); PG8_STAGE(PG8_SA(1, 0), cA + kstep, voffA); PG8_STAGE(PG8_SB(1, 1), cB + hstepB + kstep, voffB);
    PG8_WAIT_V(6); PG8_BAR;
    for (;;) {
        const bool has_next = S.next(ui + 1, nxt);
        const char* nA = has_next ? (const char*)g.A + (size_t)nxt.pm * tstepA : cA; const char* nB = has_next ? (const char*)g.Bt + (size_t)nxt.pn * tstepB : cB;
#pragma unroll 1
        for (int t = 0; t < nt; t += 2) {
            const bool last = (t == nt - 2);
            const char* a1 = cA + (size_t)(t + 1) * kstep;
            const char* a2 = last ? nA : cA + (size_t)(t + 2) * kstep; const char* b2 = last ? nB : cB + (size_t)(t + 2) * kstep;
            const char* a3 = a2 + kstep; const char* b3 = b2 + kstep;
            PG8_LDB(B0, 0, 0); PG8_LDB(B1, 0, 1); PG8_SCHED; PG8_LDA(At, 0, 0); PG8_STAGE(PG8_SA(1, 1), a1 + hstepA, voffA);
            PG8_WAIT_V(8); PG8_WAIT_L(0); PG8_BAR; PG8_MMA(0, 0, At, B0); PG8_MMA(0, 1, At, B1); PG8_BAR; PG8_SCHED;
            PG8_LDA(At, 0, 1); PG8_STAGE(PG8_SB(0, 0), b2, voffB); PG8_STAGE(PG8_SB(0, 1), b2 + hstepB, voffB); PG8_STAGE(PG8_SA(0, 0), a2, voffA);
            PG8_WAIT_V(8); PG8_WAIT_L(0); PG8_BAR; PG8_MMA(1, 0, At, B0); PG8_MMA(1, 1, At, B1); PG8_BAR; PG8_SCHED;
            PG8_LDB(B0, 1, 0); PG8_LDB(B1, 1, 1); PG8_SCHED; PG8_LDA(At, 1, 0); PG8_STAGE(PG8_SA(0, 1), a2 + hstepA, voffA);
            PG8_WAIT_V(8); PG8_WAIT_L(0); PG8_BAR; PG8_MMA(0, 0, At, B0); PG8_MMA(0, 1, At, B1); PG8_BAR; PG8_SCHED;
            PG8_LDA(At, 1, 1); PG8_STAGE(PG8_SB(1, 0), b3, voffB); PG8_STAGE(PG8_SB(1, 1), b3 + hstepB, voffB); PG8_STAGE(PG8_SA(1, 0), a3, voffA);
            PG8_WAIT_V(8); PG8_WAIT_L(0); PG8_BAR; PG8_MMA(1, 0, At, B0); PG8_MMA(1, 1, At, B1); PG8_BAR; PG8_SCHED;
        }
        if constexpr (ALIGN_EPI) { if (wr == 0) PG8_BAR; }
        E(acc, cur, wr, wc, fr, fq);
        if (!has_next) break;
#pragma unroll
        for (int a = 0; a < 2; ++a)
#pragma unroll
            for (int b = 0; b < 2; ++b)
#pragma unroll
                for (int m = 0; m < 4; ++m)
#pragma unroll
                    for (int n = 0; n < 2; ++n) acc[a][b][m][n] = (f32x4){0.f, 0.f, 0.f, 0.f};
        cur = nxt; cA = nA; cB = nB; ++ui;
        if constexpr (ALIGN_EPI) { if (wr == 1) PG8_BAR; }
    }
    PG8_WAIT_V(0);
    if constexpr (!ALIGN_EPI) { if (wr == 0) PG8_BAR; }
    PG8_BAR;
#undef PG8_SA
#undef PG8_SB
#undef PG8_STAGE
#undef PG8_LDA
#undef PG8_LDB
#undef PG8_MMA
#undef PG8_WAIT_V
#undef PG8_WAIT_L
#undef PG8_BAR
#undef PG8_SCHED
}
}

constexpr int NWAVES = 8;
constexpr int DM = 1024, NB = 16, SEQ = 2048, CTXL = 256;
constexpr int M = NB * SEQ, MC = NB * CTXL, MT = M + MC;
constexpr int QL = 384, KVL = 256, ROPE = 32, HW = 512, NH = 8, QKD = 96, VD = 64;
constexpr int INW = 3232, INP = 3328;
constexpr int DFF = 2816, NE = 8, DFE = 3584, NMOD = 6 * DM;
constexpr int NHH = 4, HK = 128; constexpr int NKEY = SEQ + CTXL;
constexpr float EPS = 1e-6f;
constexpr int MAXT = 296;
constexpr int MOE_CH = 128;

constexpr size_t MiB = 1u << 20;
constexpr size_t WS_CTL = 0, CTL_ZERO_BYTES = 1 * MiB;
constexpr size_t WS_MODV = 1 * MiB;
constexpr size_t WS_ROPE = 3 * MiB;
constexpr size_t WS_CNT = 3 * MiB + 64 * 1024;
constexpr size_t WS_TST = 3 * MiB + 128 * 1024;
constexpr size_t WS_EIDX = 4 * MiB, WS_GATE = 4 * MiB + 512 * 1024, WS_POS = 5 * MiB;
constexpr size_t WS_RSQ = 6 * MiB, WS_RSKV = 6 * MiB + 256 * 1024;
constexpr size_t WS_HC = 8 * MiB;
constexpr size_t WS_WIN = 24 * MiB, WS_WUQ = 37 * MiB, WS_WUKV = 39 * MiB, WS_WOUT = 40 * MiB, WS_WGU = 44 * MiB, WS_WDN = 66 * MiB, WS_WPOOL = 77 * MiB;
constexpr size_t WS_U = 80 * MiB;
constexpr size_t WS_X = 152 * MiB;
constexpr size_t WS_CQ = WS_X, WS_CKV = 179 * MiB, WS_KR = 197 * MiB, WS_KRR = 200 * MiB, WS_HQ = 203 * MiB  ;
constexpr size_t WS_QB = 383 * MiB, WS_KN = 437 * MiB, WS_VV = 473 * MiB, WS_OF = 509 * MiB, WS_OB = 581 * MiB, WS_MIX = 653 * MiB, WS_HID = WS_X;
constexpr size_t WS_MWGU = WS_X, WS_MWDN = 264 * MiB, WS_POOLED = 320 * MiB, WS_VG = 392 * MiB, WS_HIDM = 540 * MiB, WS_END = 800 * MiB;
constexpr size_t HSEG = (size_t)MT * HW;
static_assert(WS_HQ + 5 * HSEG * 2 <= WS_QB && WS_MIX + (size_t)MT * DM * 2 <= WS_END && WS_HID + (size_t)MT * DFF * 2 <= WS_QB, "ws map even");
static_assert(WS_HIDM + (size_t)MOE_CH * 256 * DFE * 2 <= WS_END && WS_VG + (size_t)MAXT * 256 * DM * 2 <= WS_HIDM && WS_MWDN + (size_t)NE * DM * DFE * 2 <= WS_POOLED && WS_MWGU + (size_t)NE * 2 * DFE * DM * 2 <= WS_MWDN, "ws map odd");
constexpr int CW_BAR = 4096;

constexpr int RING_OFF = 0, RING_BYTES = 131072;
constexpr int LDSCTL_OFF = RING_BYTES, MISC_OFF = LDSCTL_OFF + 320;
constexpr int LDS_BYTES = 147456;

#define GAS __attribute__((address_space(1)))
#define LAS __attribute__((address_space(3)))
typedef unsigned short bf16;
typedef unsigned v4u __attribute__((ext_vector_type(4)));
typedef unsigned v2u __attribute__((ext_vector_type(2)));
typedef float f32x4 __attribute__((ext_vector_type(4)));
typedef GAS unsigned gu32;
#define RLX_AGENT __ATOMIC_RELAXED, __HIP_MEMORY_SCOPE_AGENT
#define LDS_WAIT() asm volatile("s_waitcnt lgkmcnt(0)" ::: "memory")
__device__ __forceinline__ unsigned f2bf(float f) { unsigned u = __builtin_bit_cast(unsigned, f); return (u + 0x7fffu + ((u >> 16) & 1u)) >> 16; }
__device__ __forceinline__ unsigned pk2(float lo, float hi) { return f2bf(lo) | (f2bf(hi) << 16); }
__device__ __forceinline__ float bf2f(unsigned short b) { return __uint_as_float((unsigned)b << 16); }
__device__ __forceinline__ float bflo(unsigned w) { return __uint_as_float(w << 16); }
__device__ __forceinline__ float bfhi(unsigned w) { return __uint_as_float(w & 0xffff0000u); }
__device__ __forceinline__ float sigmoidf_(float x) { return 1.0f / (1.0f + __expf(-x)); }
__device__ __forceinline__ float siluf_(float x) { return x / (1.0f + __expf(-x)); }

#define XB_TMO      128
#define XB_XCNT(j)  (256  + 64 * (j))
#define XB_XSUB(j)  (1280 + 64 * (j))
#define XB_XGEN(j)  (2304 + 64 * (j))
#define XB_TOP      3328
#define XB_TOPGEN   3392
#define XCD_BAR_WORDS 3456
#define XB_SPIN_CAP (1u << 22)
__device__ __forceinline__ unsigned xb_ld(unsigned* p)              { return __hip_atomic_load(p, __ATOMIC_RELAXED, __HIP_MEMORY_SCOPE_AGENT); }
__device__ __forceinline__ unsigned xb_add(unsigned* p, unsigned v) { return __hip_atomic_fetch_add(p, v, __ATOMIC_RELAXED, __HIP_MEMORY_SCOPE_AGENT); }
__device__ __forceinline__ unsigned xb_xcc_id() { return (unsigned)__builtin_amdgcn_s_getreg((3 << 11) | 20) & 0xFu; }
#define XB_SPIN(cond, bar) do { unsigned _sp = 0; while (cond) { __builtin_amdgcn_s_sleep(1); \
    if ((++_sp & 255u) == 0u) { if (xb_ld(&(bar)[XB_TMO])) break; if (_sp > XB_SPIN_CAP) { atomicAdd(&(bar)[XB_TMO], 1u); break; } } } } while (0)
struct XcdBarrier { unsigned* bar; unsigned x; volatile LAS unsigned* st; };
__device__ __forceinline__ XcdBarrier xcd_barrier_post(unsigned* bar, volatile LAS unsigned* st) {
    XcdBarrier b; b.bar = bar; b.x = xb_xcc_id(); b.st = st;
    if (threadIdx.x == 0) (void)xb_add(&bar[XB_XCNT(b.x)], 1u);
    return b;
}
__device__ __forceinline__ void xcd_barrier_complete(unsigned* bar, unsigned x, unsigned& nloc, unsigned& nx) {
    const unsigned G = gridDim.x * gridDim.y * gridDim.z;
    unsigned sum, cnt, mine, sp = 0u;
    for (;;) {
        sum = 0u; cnt = 0u; mine = 0u;
#pragma unroll
        for (unsigned j = 0; j < 16; ++j) { const unsigned c = xb_ld(&bar[XB_XCNT(j)]); sum += c; cnt += (c > 0u) ? 1u : 0u; mine = (j == x) ? c : mine; }
        if (sum == G) break;
        __builtin_amdgcn_s_sleep(1);
        if ((++sp & 255u) == 0u) { if (xb_ld(&bar[XB_TMO])) break; if (sp > XB_SPIN_CAP) { atomicAdd(&bar[XB_TMO], 1u); break; } }
    }
    nloc = mine > 0u ? mine : 1u; nx = cnt > 0u ? cnt : 1u;
}
__device__ __forceinline__ void xcd_barrier(const XcdBarrier& b) {
    asm volatile("s_waitcnt vmcnt(0)" ::: "memory");
    __syncthreads();
    if (threadIdx.x == 0) {
        unsigned* bar = b.bar;
        __builtin_amdgcn_s_waitcnt(0);
        unsigned nloc = b.st[0], nx = b.st[1];
        if (nloc == 0u) { xcd_barrier_complete(bar, b.x, nloc, nx); b.st[0] = nloc; b.st[1] = nx; }
        const unsigned old = xb_add(&bar[XB_XSUB(b.x)], 1u);
        const unsigned gen = old / nloc;
        if (old + 1u == (gen + 1u) * nloc) {
            __builtin_amdgcn_fence(__ATOMIC_RELEASE, "agent");
            asm volatile("s_waitcnt vmcnt(0)" ::: "memory");
            const unsigned og = xb_add(&bar[XB_TOP], 1u);
            const unsigned tg = og / nx;
            if (og + 1u == (tg + 1u) * nx) xb_add(&bar[XB_TOPGEN], 1u);
            else XB_SPIN(xb_ld(&bar[XB_TOPGEN]) == tg, bar);
            __builtin_amdgcn_fence(__ATOMIC_ACQUIRE, "agent");
            xb_add(&bar[XB_XGEN(b.x)], 1u);
            asm volatile("s_waitcnt vmcnt(0)" ::: "memory");
        } else {
            XB_SPIN(xb_ld(&bar[XB_XGEN(b.x)]) == gen, bar);
            __builtin_amdgcn_fence(__ATOMIC_ACQUIRE, "agent");
            asm volatile("s_waitcnt vmcnt(0)" ::: "memory");
        }
    }
    __syncthreads();
}

struct Args { const float* in[26]; float* out; unsigned char* ws; };
struct Frame {
    LAS unsigned char* lds;
    int tid, lane, wave, G, vcu;
    const float* const* in; float* out; unsigned char* ws;
};
__device__ __forceinline__ float wave_sum(float v) {
#pragma unroll
    for (int o = 1; o < 64; o <<= 1) v += __shfl_xor(v, o);
    return v;
}

__device__ __forceinline__ void fresh(Frame& F) { int t = threadIdx.x; asm volatile("" : "+v"(t)); F.tid = t; F.lane = t & 63; F.wave = __builtin_amdgcn_readfirstlane(t >> 6); }

__device__ __forceinline__ void conv_item(const float* W, int ldw, bf16* WT, int ldd, int k0, int n0, int drow0, const float* kscale, float gscale, LAS float* scr, int lane) {
#pragma unroll 8
    for (int i = 0; i < 32; ++i) { const int kk = 2 * i + (lane >> 5); float w = W[(size_t)(k0 + kk) * ldw + n0 + (lane & 31)]; if (kscale) w *= kscale[k0 + kk]; scr[kk * 33 + (lane & 31)] = w * gscale; }
    LDS_WAIT(); asm volatile("" ::: "memory");
    const int c = lane & 7;
#pragma unroll
    for (int j = 0; j < 4; ++j) { const int n = (lane >> 3) + 8 * j; const LAS float* s = scr + (8 * c) * 33 + n;
        v4u o; o.x = pk2(s[0 * 33], s[1 * 33]); o.y = pk2(s[2 * 33], s[3 * 33]); o.z = pk2(s[4 * 33], s[5 * 33]); o.w = pk2(s[6 * 33], s[7 * 33]);
        *(v4u*)(WT + (size_t)(drow0 + n) * ldd + k0 + 8 * c) = o; }
    LDS_WAIT(); asm volatile("" ::: "memory");
}
__device__ __forceinline__ int conv_rowmap(int mode, int n0, int off) {
    if (mode == 0) return n0 + off;
    if (mode == 1) { if (n0 < 384) return n0; if (n0 < 640) return 512 + (n0 - 384); if (n0 < 672) return 384; return 768 + (n0 - 672); }
    return 256 * (n0 >> 7) + (n0 & 127) + off;
}
__device__ __forceinline__ void conv_matrix(Frame& F, const float* W, int K, int N, bf16* WT, int ldd, int mode, int off, const float* kscale, float gscale) {
    LAS float* scr = (LAS float*)(F.lds + RING_OFF + F.wave * 16384);
    const int gw = F.vcu * NWAVES + F.wave, NGW = F.G * NWAVES;
    const int nblk = N / 32, nitems = (K / 64) * nblk;
    for (int it = gw; it < nitems; it += NGW) { const int kb = it / nblk, nb = it % nblk; conv_item(W, N, WT, ldd, 64 * kb, 32 * nb, conv_rowmap(mode, 32 * nb, off), kscale, gscale, scr, F.lane); }
}

__device__ __forceinline__ int row_bidx(int row) { return row < M ? row / SEQ : NB; }

struct RowArgs {
    const float* hin_l; const float* hin_c; float* hout_l; float* hout_c;
    const float* g;
    const float* modl;
    int shoff, scoff;
    bf16* U;
    const bf16* Y; const int* pos; const float* gate; const float* modprev;
    const float* router; int* eidx; float* gout; int* cnt;
};
template <bool COMBINE, int OUTMODE, bool ROUTER>
__device__ __forceinline__ void row_phase(Frame& F, const RowArgs& A, int nrows) {
    fresh(F);
    const int rpw = (nrows + F.G - 1) / F.G;
    LAS int* lcnt = (LAS int*)(F.lds + RING_OFF);
    if (ROUTER) { if (F.tid < 8) lcnt[F.tid] = 0; __syncthreads(); }
    for (int i = F.wave; i < rpw; i += NWAVES) {
        const int row = (int)blockIdx.x * rpw + i; if (row >= nrows) break;
        const bool lat = row < M; const int bidx = lat ? row / SEQ : NB;
        const float* hr = lat ? A.hin_l + (size_t)row * DM : A.hin_c + (size_t)(row - M) * DM;
        f32x4 v[4];
#pragma unroll
        for (int j = 0; j < 4; ++j) v[j] = *(const f32x4*)(hr + 4 * F.lane + 256 * j);
        if (COMBINE) {
            const int pa = A.pos[2 * row], pb = A.pos[2 * row + 1]; const float ga = A.gate[2 * row], gb = A.gate[2 * row + 1];
            const float* g2 = A.modprev + bidx * NMOD + 5 * DM;
#pragma unroll
            for (int j = 0; j < 4; ++j) { const int col = 4 * F.lane + 256 * j;
                const v2u ya = *(const v2u*)(A.Y + (size_t)pa * DM + col), yb = *(const v2u*)(A.Y + (size_t)pb * DM + col); const f32x4 gv = *(const f32x4*)(g2 + col);
                v[j].x += gv.x * (ga * bflo(ya.x) + gb * bflo(yb.x)); v[j].y += gv.y * (ga * bfhi(ya.x) + gb * bfhi(yb.x));
                v[j].z += gv.z * (ga * bflo(ya.y) + gb * bflo(yb.y)); v[j].w += gv.w * (ga * bfhi(ya.y) + gb * bfhi(yb.y)); }
            if (OUTMODE != 2) { float* ho = lat ? A.hout_l + (size_t)row * DM : A.hout_c + (size_t)(row - M) * DM;
#pragma unroll
                for (int j = 0; j < 4; ++j) *(f32x4*)(ho + 4 * F.lane + 256 * j) = v[j]; }
        }
        float s = 0.f;
#pragma unroll
        for (int j = 0; j < 4; ++j) s += (v[j].x * v[j].x + v[j].y * v[j].y) + (v[j].z * v[j].z + v[j].w * v[j].w);
        const float rstd = rsqrtf(wave_sum(s) * (1.0f / DM) + EPS);
        if (OUTMODE == 2) {
            float* ho = A.hout_l + (size_t)row * DM;
#pragma unroll
            for (int j = 0; j < 4; ++j) { const int col = 4 * F.lane + 256 * j; const f32x4 gv = *(const f32x4*)(A.g + col); *(f32x4*)(ho + col) = v[j] * rstd * gv; }
        } else {
            const float* sh = A.modl + bidx * NMOD + A.shoff; const float* sc = A.modl + bidx * NMOD + A.scoff;
            float lg[8];
            if (ROUTER) {
#pragma unroll
                for (int e = 0; e < 8; ++e) lg[e] = 0.f;
            }
#pragma unroll
            for (int j = 0; j < 4; ++j) { const int col = 4 * F.lane + 256 * j; const f32x4 gv = *(const f32x4*)(A.g + col), shv = *(const f32x4*)(sh + col), scv = *(const f32x4*)(sc + col);
                f32x4 y = v[j] * rstd * gv * (scv + 1.0f) + shv;
                v2u o; o.x = pk2(y.x, y.y); o.y = pk2(y.z, y.w); *(v2u*)(A.U + (size_t)row * DM + col) = o;
                if (ROUTER) {
#pragma unroll
                    for (int q = 0; q < 4; ++q) { const f32x4 r0 = *(const f32x4*)(A.router + (size_t)(col + q) * 8), r1 = *(const f32x4*)(A.router + (size_t)(col + q) * 8 + 4); const float yy = y[q];
                        lg[0] += yy * r0.x; lg[1] += yy * r0.y; lg[2] += yy * r0.z; lg[3] += yy * r0.w; lg[4] += yy * r1.x; lg[5] += yy * r1.y; lg[6] += yy * r1.z; lg[7] += yy * r1.w; } }
            }
            if (ROUTER) {
#pragma unroll
                for (int e = 0; e < 8; ++e) lg[e] = wave_sum(lg[e]);
                int i0 = 0; float v0 = lg[0];
#pragma unroll
                for (int e = 1; e < 8; ++e) if (lg[e] > v0) { v0 = lg[e]; i0 = e; }
                int i1 = -1; float v1 = -INFINITY;
#pragma unroll
                for (int e = 0; e < 8; ++e) if (e != i0 && lg[e] > v1) { v1 = lg[e]; i1 = e; }
                const float g0 = 1.0f / (1.0f + __expf(v1 - v0));
                if (F.lane == 0) { A.eidx[2 * row] = i0; A.eidx[2 * row + 1] = i1; A.gout[2 * row] = g0; A.gout[2 * row + 1] = 1.0f - g0; atomicAdd((int*)&lcnt[i0], 1); atomicAdd((int*)&lcnt[i1], 1); }
            }
        }
    }
    if (ROUTER) { __syncthreads(); if (F.tid < 8) A.cnt[blockIdx.x * 8 + F.tid] = lcnt[F.tid]; __syncthreads(); }
}

using pg8::Unit; using pg8::cvt_pk_bf16;
__device__ __forceinline__ v4u pack8(const f32x4& a, const f32x4& b) { v4u w; w.x = cvt_pk_bf16(a[0], a[1]); w.y = cvt_pk_bf16(a[2], a[3]); w.z = cvt_pk_bf16(b[0], b[1]); w.w = cvt_pk_bf16(b[2], b[3]); return w; }
struct EpiIn {
    static constexpr bool PERM = true;
    bf16 *CQ, *KR, *CKV, *H5;
    __device__ __forceinline__ void operator()(const f32x4 (&acc)[2][2][4][2], const Unit& u, int wr, int wc, int fr, int fq) const {
        const int row0 = u.pm * 256 + wr * 64 + fr;
#pragma unroll
        for (int bj = 0; bj < 2; ++bj) {
            const int col = u.pn * 256 + bj * 128 + wc * 32 + 8 * fq;
            bf16* base; int ld;
            if (col < 384) { base = CQ + col; ld = QL; }
            else if (col < 416) { base = KR + (col - 384); ld = ROPE; }
            else if (col < 512) { base = nullptr; ld = 0; }
            else if (col < 768) { base = CKV + (col - 512); ld = KVL; }
            else { const int c2 = col - 768; base = H5 + (size_t)(c2 >> 9) * HSEG + (c2 & 511); ld = HW; }
            if (base) {
#pragma unroll
                for (int ai = 0; ai < 2; ++ai)
#pragma unroll
                    for (int m = 0; m < 4; ++m) { const int row = row0 + ai * 128 + m * 16; *(v4u*)(base + (size_t)row * ld) = pack8(acc[ai][bj][m][0], acc[ai][bj][m][1]); }
            }
        }
    }
};
struct EpiQ {
    static constexpr bool PERM = true;
    bf16* O; const float* rs;
    __device__ __forceinline__ void operator()(const f32x4 (&acc)[2][2][4][2], const Unit& u, int wr, int wc, int fr, int fq) const {
        const int row0 = u.pm * 256 + wr * 64 + fr;
#pragma unroll
        for (int ai = 0; ai < 2; ++ai)
#pragma unroll
            for (int m = 0; m < 4; ++m) { const int row = row0 + ai * 128 + m * 16; const float sc = rs[row];
#pragma unroll
                for (int bj = 0; bj < 2; ++bj) { const int col = u.pn * 256 + bj * 128 + wc * 32 + 8 * fq; *(v4u*)(O + (size_t)row * 768 + col) = pack8(acc[ai][bj][m][0] * sc, acc[ai][bj][m][1] * sc); } }
    }
};
struct EpiKV {
    static constexpr bool PERM = true;
    bf16* KNp; bf16* VTp; const float* rs;
    __device__ __forceinline__ void operator()(const f32x4 (&acc)[2][2][4][2], const Unit& u, int wr, int wc, int fr, int fq) const {
        const int row0 = u.pm * 256 + wr * 64 + fr;
#pragma unroll
        for (int ai = 0; ai < 2; ++ai)
#pragma unroll
            for (int m = 0; m < 4; ++m) { const int row = row0 + ai * 128 + m * 16; const float sc = rs[row];
                const bool lat = row < M; const int b = lat ? row / SEQ : (row - M) / CTXL; const int key = lat ? row % SEQ : SEQ + (row - M) % CTXL;
                const int kpos = (key & ~12) | ((key & 4) << 1) | ((key & 8) >> 1);
#pragma unroll
                for (int bj = 0; bj < 2; ++bj) { const int col = u.pn * 256 + bj * 128 + wc * 32 + 8 * fq; const int hh = col >> 7, w = col & 127;
                    if (w < 64) { *(v4u*)(KNp + (size_t)row * HW + hh * 64 + w) = pack8(acc[ai][bj][m][0] * sc, acc[ai][bj][m][1] * sc); }
                    else { bf16* dst = VTp + ((size_t)((b * NH + hh) * VD + (w - 64))) * NKEY + kpos;
#pragma unroll
                        for (int n = 0; n < 2; ++n)
#pragma unroll
                            for (int q = 0; q < 4; ++q) dst[(size_t)(4 * n + q) * NKEY] = (bf16)f2bf(acc[ai][bj][m][n][q] * sc); } } }
    }
};
struct EpiResid {
    static constexpr bool PERM = false;
    const float* hin_l; const float* hin_c; float* hout_l; float* hout_c; const float* modl; int goff;
    __device__ __forceinline__ void operator()(const f32x4 (&acc)[2][2][4][2], const Unit& u, int wr, int wc, int fr, int fq) const {
        const int rowt = u.pm * 256; const bool lat = rowt < M; const int bidx = lat ? rowt / SEQ : NB;
        const float* gate = modl + bidx * NMOD + goff;
        const float* hi = lat ? hin_l + (size_t)rowt * DM : hin_c + (size_t)(rowt - M) * DM;
        float* ho = lat ? hout_l + (size_t)rowt * DM : hout_c + (size_t)(rowt - M) * DM;
        const int col0 = u.pn * 256 + wc * 32 + 4 * fq;
#pragma unroll
        for (int bj = 0; bj < 2; ++bj)
#pragma unroll
            for (int n = 0; n < 2; ++n) { const f32x4 gv = *(const f32x4*)(gate + col0 + bj * 128 + n * 16);
#pragma unroll
                for (int ai = 0; ai < 2; ++ai)
#pragma unroll
                    for (int m = 0; m < 4; ++m) { const int r = ai * 128 + wr * 64 + m * 16 + fr; const size_t off = (size_t)r * DM + col0 + bj * 128 + n * 16; const f32x4 hv = *(const f32x4*)(hi + off); *(f32x4*)(ho + off) = hv + gv * acc[ai][bj][m][n]; }
                asm volatile("" ::: "memory"); }
    }
};
struct EpiPool {
    static constexpr bool PERM = false;
    float* h_l; float* h_c; const float* modl; const float* bias; const float* scale; int talloc;
    __device__ __forceinline__ void operator()(const f32x4 (&acc)[2][2][4][2], const Unit& u, int wr, int wc, int fr, int fq) const {
        const int g = u.pn, rowt = (u.pm - g * talloc) * 256; const bool lat = rowt < M; const int bidx = lat ? rowt / SEQ : NB;
        const float* gate = modl + bidx * NMOD + 2 * DM;
        float* ho = lat ? h_l + (size_t)rowt * DM : h_c + (size_t)(rowt - M) * DM;
        const int col0 = g * 256 + wc * 32 + 4 * fq;
#pragma unroll
        for (int bj = 0; bj < 2; ++bj)
#pragma unroll
            for (int n = 0; n < 2; ++n) { const int c = col0 + bj * 128 + n * 16; const f32x4 gm = *(const f32x4*)(gate + c) * *(const f32x4*)(scale + c); const f32x4 gb = gm * *(const f32x4*)(bias + c);
#pragma unroll
                for (int ai = 0; ai < 2; ++ai)
#pragma unroll
                    for (int m = 0; m < 4; ++m) { const int r = ai * 128 + wr * 64 + m * 16 + fr; const size_t off = (size_t)r * DM + c; const f32x4 hv = *(const f32x4*)(ho + off); *(f32x4*)(ho + off) = hv + gm * acc[ai][bj][m][n] + gb; }
                asm volatile("" ::: "memory"); }
    }
};
struct EpiGateUp {
    static constexpr bool PERM = true;
    bf16* H; int ldh, nct, rowsub;
    __device__ __forceinline__ void operator()(const f32x4 (&acc)[2][2][4][2], const Unit& u, int wr, int wc, int fr, int fq) const {
        const int row0 = u.pm * 256 + wr * 64 + fr - rowsub; const int ct = u.pn % nct; const int col = ct * 128 + wc * 32 + 8 * fq;
#pragma unroll
        for (int ai = 0; ai < 2; ++ai)
#pragma unroll
            for (int m = 0; m < 4; ++m) { const int row = row0 + ai * 128 + m * 16; f32x4 o[2];
#pragma unroll
                for (int n = 0; n < 2; ++n)
#pragma unroll
                    for (int q = 0; q < 4; ++q) { const float gv = acc[ai][0][m][n][q], uv = acc[ai][1][m][n][q]; o[n][q] = gv * uv / (1.0f + __expf(-gv)); }
                *(v4u*)(H + (size_t)row * ldh + col) = pack8(o[0], o[1]); }
    }
};
struct EpiY {
    static constexpr bool PERM = true;
    bf16* Y; int nct;
    __device__ __forceinline__ void operator()(const f32x4 (&acc)[2][2][4][2], const Unit& u, int wr, int wc, int fr, int fq) const {
        const int row0 = u.pm * 256 + wr * 64 + fr; const int ct = u.pn % nct;
#pragma unroll
        for (int ai = 0; ai < 2; ++ai)
#pragma unroll
            for (int m = 0; m < 4; ++m) { const int row = row0 + ai * 128 + m * 16;
#pragma unroll
                for (int bj = 0; bj < 2; ++bj) { const int col = ct * 256 + bj * 128 + wc * 32 + 8 * fq; *(v4u*)(Y + (size_t)row * DM + col) = pack8(acc[ai][bj][m][0], acc[ai][bj][m][1]); } }
    }
};

__device__ __forceinline__ void p0_prologue(Frame& F) {
    fresh(F);
    unsigned char* ws = F.ws;
    const float qscale = 0.10206207261596577f * 1.4426950408889634f;
    for (int j = 0; j < 2; ++j) {
        conv_matrix(F, F.in[8] + (size_t)j * DM * INW, DM, INW, (bf16*)(ws + WS_WIN) + (size_t)j * INP * DM, DM, 1, 0, nullptr, 1.f);
        conv_matrix(F, F.in[11] + (size_t)j * QL * 768, QL, 768, (bf16*)(ws + WS_WUQ) + (size_t)j * 768 * QL, QL, 0, 0, F.in[9] + j * QL, qscale);
        conv_matrix(F, F.in[12] + (size_t)j * KVL * 1024, KVL, 1024, (bf16*)(ws + WS_WUKV) + (size_t)j * 1024 * KVL, KVL, 0, 0, F.in[10] + j * KVL, 1.f);
        conv_matrix(F, F.in[15] + (size_t)j * DM * DM, DM, DM, (bf16*)(ws + WS_WOUT) + (size_t)j * DM * DM, DM, 0, 0, nullptr, 1.f);
        conv_matrix(F, F.in[16] + (size_t)j * DM * DFF, DM, DFF, (bf16*)(ws + WS_WGU) + (size_t)j * 2 * DFF * DM, DM, 2, 0, nullptr, 1.f);
        conv_matrix(F, F.in[17] + (size_t)j * DM * DFF, DM, DFF, (bf16*)(ws + WS_WGU) + (size_t)j * 2 * DFF * DM, DM, 2, 128, nullptr, 1.f);
        conv_matrix(F, F.in[18] + (size_t)j * DFF * DM, DFF, DM, (bf16*)(ws + WS_WDN) + (size_t)j * DM * DFF, DFF, 0, 0, nullptr, 1.f);
        for (int g = 0; g < 4; ++g)
            conv_matrix(F, F.in[19] + (size_t)(j * 4 + g) * 65536, 256, 256, (bf16*)(ws + WS_WPOOL) + (size_t)(j * 4 + g) * 65536, 256, 0, 0, nullptr, 1.f);
    }
    __syncthreads();
    if (blockIdx.x == 0 && F.tid < 8) {
        float* TC = (float*)(ws + WS_ROPE); float* TS = TC + 512;
        double th = 1.0; for (int i = 0; i < F.tid; ++i) th *= 0.31622776601683794;
        const double x2 = th * th; double s = th, c = 1.0, ts = th, tc = 1.0;
        for (int n = 1; n <= 12; ++n) { tc *= -x2 / (double)((2 * n - 1) * (2 * n)); c += tc; ts *= -x2 / (double)((2 * n) * (2 * n + 1)); s += ts; }
        double cp = 1.0, sp = 0.0;
        for (int p = 0; p < 64; ++p) { TC[p * 8 + F.tid] = (float)cp; TS[p * 8 + F.tid] = (float)sp; const double ncp = cp * c - sp * s; sp = sp * c + cp * s; cp = ncp; }
    }
    {
        LAS float* sc = (LAS float*)(F.lds + RING_OFF);
        LAS float* red = sc + 17 * 1024;
        const int nitems = 4 * (NMOD / 64);
        if ((int)blockIdx.x < nitems) {
            for (int e = F.tid; e < 17 * 1024; e += 512) { const int r = e >> 10, k = e & 1023; const float x = (r < 16) ? F.in[1][r * 1024 + k] : F.in[3][k]; sc[e] = siluf_(x); }
            __syncthreads();
            for (int it = blockIdx.x; it < nitems; it += F.G) {
                const int l = it / (NMOD / 64), c0 = (it % (NMOD / 64)) * 64;
                const float* W = F.in[4] + (size_t)l * DM * NMOD + c0 + F.lane;
                float acc[17];
#pragma unroll
                for (int r = 0; r < 17; ++r) acc[r] = 0.f;
                const int kb = F.wave * 128;
                for (int k = 0; k < 128; k += 4) {
                    const float w0 = W[(size_t)(kb + k) * NMOD], w1 = W[(size_t)(kb + k + 1) * NMOD], w2 = W[(size_t)(kb + k + 2) * NMOD], w3 = W[(size_t)(kb + k + 3) * NMOD];
#pragma unroll
                    for (int r = 0; r < 17; ++r) { const f32x4 s4 = *(const LAS f32x4*)(sc + r * 1024 + kb + k); acc[r] += s4.x * w0 + s4.y * w1 + s4.z * w2 + s4.w * w3; }
                }
#pragma unroll
                for (int r = 0; r < 17; ++r) red[(F.wave * 17 + r) * 64 + F.lane] = acc[r];
                __syncthreads();
                for (int o = F.tid; o < 17 * 64; o += 512) { const int r = o >> 6, cc = o & 63; float s = 0.f;
#pragma unroll
                    for (int w = 0; w < 8; ++w) s += red[(w * 17 + r) * 64 + cc];
                    ((float*)(ws + WS_MODV))[(size_t)(l * 17 + r) * NMOD + c0 + cc] = s + F.in[5][l * NMOD + c0 + cc]; }
                __syncthreads();
            }
        }
    }
}

__device__ __forceinline__ void e3_phase(Frame& F) {
    fresh(F);
    unsigned char* ws = F.ws;
    const bf16* CQ = (const bf16*)(ws + WS_CQ); const bf16* CKV = (const bf16*)(ws + WS_CKV); const bf16* KR = (const bf16*)(ws + WS_KR); bf16* KRR = (bf16*)(ws + WS_KRR);
    float* RSQ = (float*)(ws + WS_RSQ); float* RSKV = (float*)(ws + WS_RSKV); const float* TC = (const float*)(ws + WS_ROPE); const float* TS = TC + 512;
    const int rpw = (MT + F.G - 1) / F.G;
    for (int i = F.wave; i < rpw; i += NWAVES) {
        const int row = (int)blockIdx.x * rpw + i; if (row >= MT) break;
        float s = 0.f;
        if (F.lane < 48) { const v4u w = *(const v4u*)(CQ + (size_t)row * QL + F.lane * 8);
            s = bflo(w.x) * bflo(w.x) + bfhi(w.x) * bfhi(w.x) + bflo(w.y) * bflo(w.y) + bfhi(w.y) * bfhi(w.y) + bflo(w.z) * bflo(w.z) + bfhi(w.z) * bfhi(w.z) + bflo(w.w) * bflo(w.w) + bfhi(w.w) * bfhi(w.w); }
        s = wave_sum(s); if (F.lane == 0) RSQ[row] = rsqrtf(s * (1.0f / QL) + EPS);
        s = 0.f;
        if (F.lane < 32) { const v4u w = *(const v4u*)(CKV + (size_t)row * KVL + F.lane * 8);
            s = bflo(w.x) * bflo(w.x) + bfhi(w.x) * bfhi(w.x) + bflo(w.y) * bflo(w.y) + bfhi(w.y) * bfhi(w.y) + bflo(w.z) * bflo(w.z) + bfhi(w.z) * bfhi(w.z) + bflo(w.w) * bflo(w.w) + bfhi(w.w) * bfhi(w.w); }
        s = wave_sum(s); if (F.lane == 0) RSKV[row] = rsqrtf(s * (1.0f / KVL) + EPS);
        const float x = (F.lane < 32) ? bf2f(KR[(size_t)row * ROPE + F.lane]) : 0.f; const float pr = __shfl_xor(x, 8);
        float o = x;
        if (row < M) { const int t = row % SEQ; const int p = ((F.lane >> 4) & 1) ? (t & 63) : (t >> 6); const int j = F.lane & 7; const float c = TC[p * 8 + j], sn = TS[p * 8 + j];
            o = ((F.lane >> 3) & 1) ? x * c + pr * sn : x * c - pr * sn; }
        if (F.lane < 32) KRR[(size_t)row * ROPE + F.lane] = (bf16)f2bf(o);
    }
}

typedef short bf16x8v __attribute__((ext_vector_type(8)));
typedef float f32x16 __attribute__((ext_vector_type(16)));
__device__ __forceinline__ void attn_unit(Frame& F, int b, int h, int qrow0, bool rope_q, int t_lo, int t_hi) {
    unsigned char* ws = F.ws;
    const bf16* QB = (const bf16*)(ws + WS_QB); const bf16* KN = (const bf16*)(ws + WS_KN); const bf16* KRR = (const bf16*)(ws + WS_KRR); const bf16* VT = (const bf16*)(ws + WS_VV);
    bf16* MIX = (bf16*)(ws + WS_MIX); const float* TC = (const float*)(ws + WS_ROPE); const float* TS = TC + 512;
    const int lane = F.lane, wave = F.wave, r32 = lane & 31, hi = lane >> 5;
    LAS unsigned char* ring = F.lds + RING_OFF;
    const int qrow = qrow0 + wave * 32 + r32;
    bf16x8v qr[6];
#pragma unroll
    for (int d0 = 0; d0 < 6; ++d0) qr[d0] = *(const bf16x8v*)(QB + (size_t)qrow * 768 + h * QKD + 16 * d0 + 8 * hi);
    if (rope_q) { const int t = qrow % SEQ;
#pragma unroll
        for (int a = 0; a < 2; ++a) { const int p = a ? (t & 63) : (t >> 6); const v4u w = __builtin_bit_cast(v4u, qr[4 + a]); float x[8], y[8];
            x[0] = bflo(w.x); x[1] = bfhi(w.x); x[2] = bflo(w.y); x[3] = bfhi(w.y); x[4] = bflo(w.z); x[5] = bfhi(w.z); x[6] = bflo(w.w); x[7] = bfhi(w.w);
#pragma unroll
            for (int jj = 0; jj < 8; ++jj) { const float pr = __shfl_xor(x[jj], 32); const float c = TC[p * 8 + jj], sn = TS[p * 8 + jj]; y[jj] = hi ? x[jj] * c + pr * sn : x[jj] * c - pr * sn; }
            v4u o; o.x = pk2(y[0], y[1]); o.y = pk2(y[2], y[3]); o.z = pk2(y[4], y[5]); o.w = pk2(y[6], y[7]); qr[4 + a] = __builtin_bit_cast(bf16x8v, o); } }
    const int bh = b * NH + h;
    const bf16* vsrc = VT + ((size_t)(bh * VD + lane)) * NKEY + 8 * wave;
#define ATT_DMA(t, buf) do { const int t_ = (t); const int r0_ = t_ < SEQ / 64 ? b * SEQ + 64 * t_ : M + b * CTXL + 64 * (t_ - SEQ / 64); \
        LAS unsigned char* kb_ = ring + (buf) * 12288; LAS unsigned char* vb_ = ring + 24576 + (buf) * 8192; \
        __builtin_amdgcn_global_load_lds((const unsigned*)(KN + (size_t)(r0_ + lane) * HW + h * 64 + 8 * wave), (LAS unsigned*)(kb_ + wave * 1024), 16, 0, 0); \
        if (wave < 4) __builtin_amdgcn_global_load_lds((const unsigned*)(KRR + (size_t)(r0_ + lane) * ROPE + 8 * wave), (LAS unsigned*)(kb_ + (8 + wave) * 1024), 16, 0, 0); \
        __builtin_amdgcn_global_load_lds((const unsigned*)(vsrc + 64 * t_), (LAS unsigned*)(vb_ + wave * 1024), 16, 0, 0); } while (0)
    f32x16 o0, o1;
#pragma unroll
    for (int r = 0; r < 16; ++r) { o0[r] = 0.f; o1[r] = 0.f; }
    float m_run = -INFINITY, l_run = 0.f;
    ATT_DMA(t_lo, 0);
    for (int t = t_lo; t < t_hi; ++t) {
        const int buf = (t - t_lo) & 1;
        asm volatile("s_waitcnt vmcnt(0)" ::: "memory"); __syncthreads();
        if (t + 1 < t_hi) ATT_DMA(t + 1, buf ^ 1);
        const LAS unsigned char* kb = ring + buf * 12288 + hi * 1024 + r32 * 16; const LAS unsigned char* vb = ring + 24576 + buf * 8192 + hi * 1024 + r32 * 16;
        f32x16 p0, p1;
#pragma unroll
        for (int r = 0; r < 16; ++r) { p0[r] = 0.f; p1[r] = 0.f; }
#pragma unroll
        for (int d0 = 0; d0 < 6; ++d0) { const bf16x8v k0 = *(const LAS bf16x8v*)(kb + d0 * 2048), k1 = *(const LAS bf16x8v*)(kb + d0 * 2048 + 512);
            p0 = __builtin_amdgcn_mfma_f32_32x32x16_bf16(k0, qr[d0], p0, 0, 0, 0); p1 = __builtin_amdgcn_mfma_f32_32x32x16_bf16(k1, qr[d0], p1, 0, 0, 0); }
        float mt = fmaxf(p0[0], p1[0]);
#pragma unroll
        for (int r = 1; r < 16; ++r) mt = fmaxf(mt, fmaxf(p0[r], p1[r]));
        mt = fmaxf(mt, __shfl_xor(mt, 32));
        const float mn = fmaxf(m_run, mt); const float alpha = __builtin_amdgcn_exp2f(m_run - mn); m_run = mn;
        float ps = 0.f;
#pragma unroll
        for (int r = 0; r < 16; ++r) { p0[r] = __builtin_amdgcn_exp2f(p0[r] - mn); p1[r] = __builtin_amdgcn_exp2f(p1[r] - mn); ps += p0[r] + p1[r]; }
        l_run = l_run * alpha + ps;
#pragma unroll
        for (int r = 0; r < 16; ++r) { o0[r] *= alpha; o1[r] *= alpha; }
        v4u pw[4];
#pragma unroll
        for (int q = 0; q < 4; ++q) { pw[0][q] = cvt_pk_bf16(p0[2 * q], p0[2 * q + 1]); pw[1][q] = cvt_pk_bf16(p0[8 + 2 * q], p0[8 + 2 * q + 1]); pw[2][q] = cvt_pk_bf16(p1[2 * q], p1[2 * q + 1]); pw[3][q] = cvt_pk_bf16(p1[8 + 2 * q], p1[8 + 2 * q + 1]); }
#pragma unroll
        for (int s4 = 0; s4 < 4; ++s4) { const bf16x8v pa = __builtin_bit_cast(bf16x8v, pw[s4]);
            const bf16x8v v0 = *(const LAS bf16x8v*)(vb + s4 * 2048), v1 = *(const LAS bf16x8v*)(vb + s4 * 2048 + 512);
            o0 = __builtin_amdgcn_mfma_f32_32x32x16_bf16(v0, pa, o0, 0, 0, 0); o1 = __builtin_amdgcn_mfma_f32_32x32x16_bf16(v1, pa, o1, 0, 0, 0); }
    }
    l_run += __shfl_xor(l_run, 32);
    const float rl = 1.0f / l_run;
    bf16* orow = MIX + (size_t)qrow * DM + h * VD;
#pragma unroll
    for (int g = 0; g < 4; ++g) { v2u a, c2; a.x = pk2(o0[4 * g] * rl, o0[4 * g + 1] * rl); a.y = pk2(o0[4 * g + 2] * rl, o0[4 * g + 3] * rl); c2.x = pk2(o1[4 * g] * rl, o1[4 * g + 1] * rl); c2.y = pk2(o1[4 * g + 2] * rl, o1[4 * g + 3] * rl);
        *(v2u*)(orow + 8 * g + 4 * hi) = a; *(v2u*)(orow + 32 + 8 * g + 4 * hi) = c2; }
    __syncthreads();
#undef ATT_DMA
}
__device__ __forceinline__ void attn_phase(Frame& F, bool ctx_out) {
    fresh(F);
    const int nlat = NB * NH * 8, nctx = ctx_out ? NB * NH : 0;
    const int per = (nlat + F.G - 1) / F.G;
    for (int i = 0; i < per; ++i) { const int it = F.vcu * per + i; if (it >= nlat) break; const int bh = it >> 3, qb = it & 7; attn_unit(F, bh >> 3, bh & 7, (bh >> 3) * SEQ + qb * 256, true, 0, NKEY / 64); }
    for (int it = F.vcu; it < nctx; it += F.G) attn_unit(F, it >> 3, it & 7, M + (it >> 3) * CTXL, false, SEQ / 64, NKEY / 64);
    __syncthreads();
}

__device__ __forceinline__ void hgrn_phase(Frame& F, int j) {
    fresh(F);
    unsigned char* ws = F.ws;
    const bf16* HQ = (const bf16*)(ws + WS_HQ); const bf16* HFF = HQ + HSEG; const bf16* HFB = HQ + 2 * HSEG; const bf16* HI = HQ + 3 * HSEG;
    float* OF = (float*)(ws + WS_OF); float* OB = (float*)(ws + WS_OB);
    LAS float* sq = (LAS float*)(F.lds + RING_OFF);
    LAS float* sk = sq + 16 * 128;
    LAS float* sv = sk + 16 * 128;
    LAS float* part = sv + 16 * 64;
    for (int it = blockIdx.x; it < NB * NHH * 2 * 2; it += F.G) {
        const int vh = it & 1, dir = (it >> 1) & 1, hh = (it >> 2) & 3, b = it >> 4;
        const bf16* HF = dir ? HFB : HFF; float* OO = dir ? OB : OF;
        const int ss = F.tid >> 5, sub = F.tid & 31;
        float oml[4];
#pragma unroll
        for (int q = 0; q < 4; ++q) { float lb = 0.f; if (j == 1) { const int ci = dir * HW + hh * HK + 4 * sub + q; const float l0 = F.in[13][ci], l1 = F.in[13][2 * HW + ci]; lb = 1.0f / (1.0f + __expf(l0 - l1)); } oml[q] = 1.0f - lb; }
        float S[16];
#pragma unroll
        for (int q = 0; q < 16; ++q) S[q] = 0.f;
        const int kg = F.wave * 16;
        for (int blk = 0; blk < (CTXL + SEQ) / 16; ++blk) {
            const int i0 = blk * 16;
            __syncthreads();
            { const int i = i0 + ss; const int row = (i < CTXL) ? (M + b * CTXL + (dir ? CTXL - 1 - i : i)) : (b * SEQ + (dir ? SEQ - 1 - (i - CTXL) : (i - CTXL)));
              const v2u wq = *(const v2u*)(HQ + (size_t)row * HW + hh * HK + 4 * sub); const v2u wf = *(const v2u*)(HF + (size_t)row * HW + hh * HK + 4 * sub);
              const unsigned wv = *(const unsigned*)(HI + (size_t)row * HW + hh * HK + vh * 64 + 2 * sub);
              *(LAS f32x4*)(sq + ss * 128 + 4 * sub) = (f32x4){siluf_(bflo(wq.x)), siluf_(bfhi(wq.x)), siluf_(bflo(wq.y)), siluf_(bfhi(wq.y))};
              *(LAS f32x4*)(sk + ss * 128 + 4 * sub) = (f32x4){oml[0] * sigmoidf_(-bflo(wf.x)), oml[1] * sigmoidf_(-bfhi(wf.x)), oml[2] * sigmoidf_(-bflo(wf.y)), oml[3] * sigmoidf_(-bfhi(wf.y))};
              sv[ss * 64 + 2 * sub] = bflo(wv); sv[ss * 64 + 2 * sub + 1] = bfhi(wv); }
            __syncthreads();
#pragma unroll 4
            for (int s = 0; s < 16; ++s) {
                const float vv = sv[s * 64 + F.lane]; float po = 0.f;
#pragma unroll
                for (int q4 = 0; q4 < 4; ++q4) { const f32x4 k4 = *(const LAS f32x4*)(sk + s * 128 + kg + 4 * q4), q4v = *(const LAS f32x4*)(sq + s * 128 + kg + 4 * q4);
                    S[4 * q4 + 0] = fmaf(k4.x, vv - S[4 * q4 + 0], S[4 * q4 + 0]); po = fmaf(S[4 * q4 + 0], q4v.x, po);
                    S[4 * q4 + 1] = fmaf(k4.y, vv - S[4 * q4 + 1], S[4 * q4 + 1]); po = fmaf(S[4 * q4 + 1], q4v.y, po);
                    S[4 * q4 + 2] = fmaf(k4.z, vv - S[4 * q4 + 2], S[4 * q4 + 2]); po = fmaf(S[4 * q4 + 2], q4v.z, po);
                    S[4 * q4 + 3] = fmaf(k4.w, vv - S[4 * q4 + 3], S[4 * q4 + 3]); po = fmaf(S[4 * q4 + 3], q4v.w, po); }
                part[(s * 8 + F.wave) * 64 + F.lane] = po;
            }
            __syncthreads();
#pragma unroll
            for (int r = 0; r < 2; ++r) { const int oi = F.tid + 512 * r; const int s = oi >> 6, v = oi & 63; float a = 0.f;
#pragma unroll
                for (int w = 0; w < 8; ++w) a += part[(s * 8 + w) * 64 + v];
                const int i = i0 + s; const int row = (i < CTXL) ? (M + b * CTXL + (dir ? CTXL - 1 - i : i)) : (b * SEQ + (dir ? SEQ - 1 - (i - CTXL) : (i - CTXL)));
                OO[(size_t)row * HW + hh * HK + vh * 64 + v] = a; }
        }
    }
    __syncthreads();
}

__device__ __forceinline__ void e8_phase(Frame& F, int j, int nrows) {
    fresh(F);
    unsigned char* ws = F.ws;
    const float* OF = (const float*)(ws + WS_OF); const float* OB = (const float*)(ws + WS_OB); const bf16* HG = (const bf16*)(ws + WS_HQ) + 4 * HSEG; bf16* MIX = (bf16*)(ws + WS_MIX);
    const float* gn = F.in[14] + j * HK;
    const int rpw = (nrows + F.G - 1) / F.G;
    for (int i = F.wave; i < rpw; i += NWAVES) {
        const int row = (int)blockIdx.x * rpw + i; if (row >= nrows) break;
        const int col = 8 * F.lane;
        const f32x4 a0 = *(const f32x4*)(OF + (size_t)row * HW + col), a1 = *(const f32x4*)(OF + (size_t)row * HW + col + 4), b0 = *(const f32x4*)(OB + (size_t)row * HW + col), b1 = *(const f32x4*)(OB + (size_t)row * HW + col + 4);
        f32x4 x0 = a0 + b0, x1 = a1 + b1;
        float s = (x0.x * x0.x + x0.y * x0.y) + (x0.z * x0.z + x0.w * x0.w) + (x1.x * x1.x + x1.y * x1.y) + (x1.z * x1.z + x1.w * x1.w);
        s += __shfl_xor(s, 1); s += __shfl_xor(s, 2); s += __shfl_xor(s, 4); s += __shfl_xor(s, 8);
        const float rstd = rsqrtf(s * (1.0f / HK) + EPS);
        const int vv = col & 127; const f32x4 g0 = *(const f32x4*)(gn + vv), g1 = *(const f32x4*)(gn + vv + 4);
        const v4u hg = *(const v4u*)(HG + (size_t)row * HW + col);
        x0 = x0 * rstd * g0; x1 = x1 * rstd * g1;
        v4u o; o.x = pk2(x0.x * siluf_(bflo(hg.x)), x0.y * siluf_(bfhi(hg.x))); o.y = pk2(x0.z * siluf_(bflo(hg.y)), x0.w * siluf_(bfhi(hg.y)));
        o.z = pk2(x1.x * siluf_(bflo(hg.z)), x1.y * siluf_(bfhi(hg.z))); o.w = pk2(x1.z * siluf_(bflo(hg.w)), x1.w * siluf_(bfhi(hg.w)));
        *(v4u*)(MIX + (size_t)row * DM + HW + col) = o;
    }
}

__device__ __forceinline__ void o2_phase(Frame& F, int nrows) {
    fresh(F);
    unsigned char* ws = F.ws;
    const bf16* U = (const bf16*)(ws + WS_U); bf16* P = (bf16*)(ws + WS_POOLED);
    const int rpw = (nrows + F.G - 1) / F.G;
    for (int i = F.wave; i < rpw; i += NWAVES) {
        const int row = (int)blockIdx.x * rpw + i; if (row >= nrows) break;
        const bool lat = row < M; const int T = lat ? SEQ : CTXL; const int t = lat ? row % SEQ : (row - M) % CTXL; const int rbase = row - t;
#pragma unroll
        for (int g = 0; g < 4; ++g) {
            const int w = 2 << g; int lo = t - w / 2; if (lo < 0) lo = 0; int hi = t + w / 2; if (hi > T) hi = T;
            const int col = 256 * g + 4 * F.lane;
            float s0 = 0.f, s1 = 0.f, s2 = 0.f, s3 = 0.f;
            for (int r = lo; r < hi; ++r) { const v2u x = *(const v2u*)(U + (size_t)(rbase + r) * DM + col); s0 += bflo(x.x); s1 += bfhi(x.x); s2 += bflo(x.y); s3 += bfhi(x.y); }
            const v2u xc = *(const v2u*)(U + (size_t)row * DM + col); const float ic = 1.0f / (float)(hi - lo);
            v2u o; o.x = pk2(s0 * ic - bflo(xc.x), s1 * ic - bfhi(xc.x)); o.y = pk2(s2 * ic - bflo(xc.y), s3 * ic - bfhi(xc.y));
            *(v2u*)(P + ((size_t)g * MT + row) * 256 + 4 * F.lane) = o;
        }
    }
}

__device__ __forceinline__ void o5_phase(Frame& F, int nrows) {
    fresh(F);
    unsigned char* ws = F.ws;
    const int* CNT = (const int*)(ws + WS_CNT); int* TST = (int*)(ws + WS_TST); const int* EIDX = (const int*)(ws + WS_EIDX); int* POS = (int*)(ws + WS_POS);
    const bf16* U = (const bf16*)(ws + WS_U); bf16* VG = (bf16*)(ws + WS_VG);
    LAS int* lc = (LAS int*)(F.lds + RING_OFF);
    LAS int* lbase = lc + 512 * 8;
    LAS int* lpos = lbase + 16;
    const int rpw = (nrows + F.G - 1) / F.G;
    for (int e = F.tid; e < F.G * 8; e += 512) lc[e] = CNT[e];
    __syncthreads();
    if (F.tid == 0) {
        int tot[8], pre[8];
        for (int e = 0; e < 8; ++e) { int s = 0, p = 0; for (int w = 0; w < F.G; ++w) { if (w == (int)blockIdx.x) p = s; s += lc[w * 8 + e]; } tot[e] = s; pre[e] = p; }
        int ts = 0;
        for (int e = 0; e < 8; ++e) { lbase[e] = ts * 256 + pre[e]; if (blockIdx.x == 0) TST[e] = ts; ts += (tot[e] + 255) >> 8; }
        if (blockIdx.x == 0) TST[8] = ts;
    }
    __syncthreads();
    if (F.wave == 0) {
        int run[8];
#pragma unroll
        for (int e = 0; e < 8; ++e) run[e] = lbase[e];
        const int npairs = 2 * rpw;
        for (int c0 = 0; c0 < npairs; c0 += 64) {
            const int pl = c0 + F.lane; const int row = (int)blockIdx.x * rpw + (pl >> 1); const bool ok = pl < npairs && row < nrows;
            const int e = ok ? EIDX[2 * row + (pl & 1)] : -1; int mypos = 0;
#pragma unroll
            for (int x = 0; x < 8; ++x) { const unsigned long long mk = __ballot(e == x); const int below = __popcll(mk & ((1ull << F.lane) - 1ull)); if (e == x) mypos = run[x] + below; run[x] += __popcll(mk); }
            if (ok) { lpos[pl] = mypos; POS[2 * row + (pl & 1)] = mypos; }
        }
    }
    __syncthreads();
    for (int pl = F.wave; pl < 2 * rpw; pl += NWAVES) {
        const int row = (int)blockIdx.x * rpw + (pl >> 1); if (row >= nrows) break;
        const int p = lpos[pl];
        const v4u a = *(const v4u*)(U + (size_t)row * DM + 8 * F.lane), b = *(const v4u*)(U + (size_t)row * DM + 512 + 8 * F.lane);
        *(v4u*)(VG + (size_t)p * DM + 8 * F.lane) = a; *(v4u*)(VG + (size_t)p * DM + 512 + 8 * F.lane) = b;
    }
    __syncthreads();
}

__global__ void __launch_bounds__(NWAVES * 64, 2) mega_fwd(Args args) {
    extern __shared__ __attribute__((aligned(16))) unsigned char lds[];
    Frame F;
    F.lds = (LAS unsigned char*)lds;
    F.tid = threadIdx.x; F.lane = F.tid & 63; F.wave = __builtin_amdgcn_readfirstlane(F.tid >> 6);
    F.G = gridDim.x; { const int bx = blockIdx.x; F.vcu = (F.G % 8 == 0) ? (bx % 8) * (F.G / 8) + bx / 8 : bx; }
    F.in = args.in; F.out = args.out; F.ws = args.ws;
    unsigned char* ws = args.ws;
    volatile LAS unsigned* MISC = (volatile LAS unsigned*)(F.lds + MISC_OFF);
    for (int u = F.tid; u < (LDS_BYTES - LDSCTL_OFF) / 4; u += NWAVES * 64) ((LAS unsigned*)(F.lds + LDSCTL_OFF))[u] = 0u;
    __syncthreads();
    XcdBarrier bar = xcd_barrier_post((unsigned*)(ws + WS_CTL) + CW_BAR, MISC + 8);
#define GRID_BAR() xcd_barrier(bar)
#ifndef ONLY
#define ONLY 0
#endif
#define PH(n) (ONLY == 0 || ONLY == (n))
#ifndef DUPMASK
#define DUPMASK 0
#endif
#define REP(bit) for (int rep_ = 0; rep_ < ((DUPMASK & (bit)) ? 2 : 1); ++rep_)
    LAS unsigned char* ring = F.lds + RING_OFF;
    const float* MODV = (const float*)(ws + WS_MODV);
    float* HC = (float*)(ws + WS_HC);
    bf16* U = (bf16*)(ws + WS_U);

#if PH(20)
    p0_prologue(F);
#endif
    GRID_BAR();

    for (int lp = 0; lp < 2; ++lp) {
        const int le = 2 * lp, lo = 2 * lp + 1, j = lp;
        const bool ctx_out = (lp == 0);
        const int nro = ctx_out ? MT : M;
        const float* modE = MODV + (size_t)le * 17 * NMOD; const float* modO = MODV + (size_t)lo * 17 * NMOD;
        const float* hin_l = (lp == 0) ? args.in[0] : args.out; const float* hin_c = (lp == 0) ? args.in[2] : HC;
#if PH(1)
        {
            RowArgs A{}; A.hin_l = hin_l; A.hin_c = hin_c; A.hout_l = args.out; A.hout_c = HC; A.g = args.in[6] + (size_t)(le * 2 + 0) * DM; A.modl = modE; A.shoff = 0; A.scoff = DM; A.U = U;
            A.Y = (const bf16*)(ws + WS_VG); A.pos = (const int*)(ws + WS_POS); A.gate = (const float*)(ws + WS_GATE); A.modprev = MODV + (size_t)(le - 1) * 17 * NMOD;
            if (lp == 0) row_phase<false, 1, false>(F, A, MT); else row_phase<true, 1, false>(F, A, MT);
        }
#endif
        GRID_BAR();
#if PH(2)
        {
            pg8::Gemm g{U, (const bf16*)(ws + WS_WIN) + (size_t)j * INP * DM, DM, DM, DM}; pg8::StaticOrder S; S.init(MT, INP, F.G, (int)blockIdx.x);
            EpiIn E{(bf16*)(ws + WS_CQ), (bf16*)(ws + WS_KR), (bf16*)(ws + WS_CKV), (bf16*)(ws + WS_HQ)};
            REP(8) pg8::gemm_phase<EpiIn, pg8::StaticOrder, true>(ring, g, S, E);
        }
#endif
        GRID_BAR();
#if PH(3)
        REP(4) e3_phase(F);
#endif
        GRID_BAR();
#if PH(4)
        {
            pg8::Gemm g{(const bf16*)(ws + WS_CQ), (const bf16*)(ws + WS_WUQ) + (size_t)j * 768 * QL, QL, QL, QL}; pg8::StaticOrder S; S.init(nro, 768, F.G, (int)blockIdx.x);
            EpiQ E{(bf16*)(ws + WS_QB), (const float*)(ws + WS_RSQ)};
            REP(8) pg8::gemm_phase<EpiQ, pg8::StaticOrder, true>(ring, g, S, E);
        }
        {
            pg8::Gemm g{(const bf16*)(ws + WS_CKV), (const bf16*)(ws + WS_WUKV) + (size_t)j * 1024 * KVL, KVL, KVL, KVL}; pg8::StaticOrder S; S.init(MT, 1024, F.G, (int)blockIdx.x);
            EpiKV E{(bf16*)(ws + WS_KN), (bf16*)(ws + WS_VV), (const float*)(ws + WS_RSKV)};
            REP(8) pg8::gemm_phase<EpiKV, pg8::StaticOrder, true>(ring, g, S, E);
        }
#endif
        GRID_BAR();
#if PH(6)
#ifndef NO_HGRN
        REP(1) hgrn_phase(F, j);
#endif
#ifndef NO_ATTN
        REP(2) attn_phase(F, ctx_out);
#endif
#endif
        GRID_BAR();
#if PH(8)
        REP(4) e8_phase(F, j, nro);
#endif
        GRID_BAR();
#if PH(9)
        {
            pg8::Gemm g{(const bf16*)(ws + WS_MIX), (const bf16*)(ws + WS_WOUT) + (size_t)j * DM * DM, DM, DM, DM}; pg8::StaticOrder S; S.init(nro, DM, F.G, (int)blockIdx.x);
            EpiResid E{hin_l, hin_c, args.out, HC, modE, 2 * DM};
            pg8::gemm_phase<EpiResid, pg8::StaticOrder, true>(ring, g, S, E);
        }
#endif
        GRID_BAR();
#if PH(10)
        {
            RowArgs A{}; A.hin_l = args.out; A.hin_c = HC; A.g = args.in[6] + (size_t)(le * 2 + 1) * DM; A.modl = modE; A.shoff = 3 * DM; A.scoff = 4 * DM; A.U = U;
            REP(4) row_phase<false, 1, false>(F, A, nro);
        }
#endif
        GRID_BAR();
#if PH(11)
        {
            pg8::Gemm g{U, (const bf16*)(ws + WS_WGU) + (size_t)j * 2 * DFF * DM, DM, DM, DM}; pg8::StaticOrder S; S.init(nro, 2 * DFF, F.G, (int)blockIdx.x);
            EpiGateUp E{(bf16*)(ws + WS_HID), DFF, 2 * DFF / 256, 0};
            REP(8) pg8::gemm_phase<EpiGateUp, pg8::StaticOrder, true>(ring, g, S, E);
        }
#endif
        GRID_BAR();
#if PH(12)
        {
            pg8::Gemm g{(const bf16*)(ws + WS_HID), (const bf16*)(ws + WS_WDN) + (size_t)j * DM * DFF, DFF, DFF, DFF}; pg8::StaticOrder S; S.init(nro, DM, F.G, (int)blockIdx.x);
            EpiResid E{args.out, HC, args.out, HC, modE, 5 * DM};
            pg8::gemm_phase<EpiResid, pg8::StaticOrder, true>(ring, g, S, E);
        }
#endif
        GRID_BAR();
#if PH(13)
        {
            RowArgs A{}; A.hin_l = args.out; A.hin_c = HC; A.g = args.in[6] + (size_t)(lo * 2 + 0) * DM; A.modl = modO; A.shoff = 0; A.scoff = DM; A.U = U;
            row_phase<false, 1, false>(F, A, nro);
            REP(16) for (int e = 0; e < NE; ++e) {
                conv_matrix(F, args.in[23] + ((size_t)j * NE + e) * DM * DFE, DM, DFE, (bf16*)(ws + WS_MWGU) + (size_t)e * 2 * DFE * DM, DM, 2, 0, nullptr, 1.f);
                conv_matrix(F, args.in[24] + ((size_t)j * NE + e) * DM * DFE, DM, DFE, (bf16*)(ws + WS_MWGU) + (size_t)e * 2 * DFE * DM, DM, 2, 128, nullptr, 1.f);
                conv_matrix(F, args.in[25] + ((size_t)j * NE + e) * DFE * DM, DFE, DM, (bf16*)(ws + WS_MWDN) + (size_t)e * DM * DFE, DFE, 0, 0, nullptr, 1.f);
            }
        }
#endif
        GRID_BAR();
#if PH(14)
        REP(4) o2_phase(F, nro);
#endif
        GRID_BAR();
#if PH(15)
        {
            pg8::Gemm g{(const bf16*)(ws + WS_POOLED), (const bf16*)(ws + WS_WPOOL) + (size_t)j * 4 * 65536, 256, 256, 256};
            pg8::PoolOrder S{nro / 256, MT / 256, F.G, (int)blockIdx.x};
            EpiPool E{args.out, HC, modO, args.in[20] + (size_t)j * DM, args.in[21] + (size_t)j * DM, MT / 256};
            pg8::gemm_phase<EpiPool, pg8::PoolOrder, true>(ring, g, S, E);
        }
#endif
        GRID_BAR();
#if PH(16)
        {
            RowArgs A{}; A.hin_l = args.out; A.hin_c = HC; A.g = args.in[6] + (size_t)(lo * 2 + 1) * DM; A.modl = modO; A.shoff = 3 * DM; A.scoff = 4 * DM; A.U = U;
            A.router = args.in[22] + (size_t)j * DM * NE; A.eidx = (int*)(ws + WS_EIDX); A.gout = (float*)(ws + WS_GATE); A.cnt = (int*)(ws + WS_CNT);
            REP(4) row_phase<false, 1, true>(F, A, nro);
        }
#endif
        GRID_BAR();
#if PH(17)
        REP(4) o5_phase(F, nro);
#endif
        GRID_BAR();
#if PH(18)
        {
            const int* TST = (const int*)(ws + WS_TST);
            const int ts1 = TST[1], ts2 = TST[2], ts3 = TST[3], ts4 = TST[4], ts5 = TST[5], ts6 = TST[6], ts7 = TST[7], nT = TST[8];
            for (int c = 0; c * MOE_CH < nT; ++c) {
                const int t0 = c * MOE_CH, nrt = (nT - t0) < MOE_CH ? (nT - t0) : MOE_CH;
                {
                    pg8::Gemm g{(const bf16*)(ws + WS_VG), (const bf16*)(ws + WS_MWGU), DM, DM, DM};
                    pg8::MoeOrder S{t0, nrt, 2 * DFE / 256, F.G, (int)blockIdx.x, ts1, ts2, ts3, ts4, ts5, ts6, ts7};
                    EpiGateUp E{(bf16*)(ws + WS_HIDM), DFE, 2 * DFE / 256, t0 * 256};
                    REP(8) pg8::gemm_phase<EpiGateUp, pg8::MoeOrder, true>(ring, g, S, E);
                }
                GRID_BAR();
                {
                    pg8::Gemm g{(const bf16*)(ws + WS_HIDM) - (size_t)t0 * 256 * DFE, (const bf16*)(ws + WS_MWDN), DFE, DFE, DFE};
                    pg8::MoeOrder S{t0, nrt, DM / 256, F.G, (int)blockIdx.x, ts1, ts2, ts3, ts4, ts5, ts6, ts7};
                    EpiY E{(bf16*)(ws + WS_VG), DM / 256};
                    REP(8) pg8::gemm_phase<EpiY, pg8::MoeOrder, true>(ring, g, S, E);
                }
                GRID_BAR();
            }
        }
#endif
    }
#if PH(19)
    {
        RowArgs A{}; A.hin_l = args.out; A.hin_c = HC; A.hout_l = args.out; A.hout_c = HC; A.g = args.in[7];
        A.Y = (const bf16*)(ws + WS_VG); A.pos = (const int*)(ws + WS_POS); A.gate = (const float*)(ws + WS_GATE); A.modprev = MODV + (size_t)3 * 17 * NMOD;
        row_phase<true, 2, false>(F, A, M);
        if (xb_ld((unsigned*)(ws + WS_CTL) + CW_BAR + XB_TMO) != 0u) { __syncthreads(); const float qn = __builtin_nanf(""); for (int i = F.tid; i < 1024; i += 512) args.out[(size_t)blockIdx.x * 1024 + i] = qn; }
    }
#endif
}

extern "C" void kernel_launch(void* const* d_in, const int* in_sizes, int n_in, void* d_out, int out_size, void* d_ws, size_t ws_size, hipStream_t stream) {
    static int grid = 0;
    if (grid == 0) {
        if (n_in != 26 || out_size != M * DM || ws_size < WS_END) { fprintf(stderr, "kernel_launch: unexpected shapes (n_in %d out %d ws %zu)\n", n_in, out_size, ws_size); grid = -1; return; }
        int dev = 0, cus = 0, per_cu = 0;
        if (hipGetDevice(&dev) != hipSuccess || hipDeviceGetAttribute(&cus, hipDeviceAttributeMultiprocessorCount, dev) != hipSuccess) { grid = -1; return; }
        if (hipFuncSetAttribute((const void*)mega_fwd, hipFuncAttributeMaxDynamicSharedMemorySize, LDS_BYTES) != hipSuccess) { grid = -1; return; }
        if (hipOccupancyMaxActiveBlocksPerMultiprocessor(&per_cu, (const void*)mega_fwd, NWAVES * 64, LDS_BYTES) != hipSuccess || per_cu < 1) fprintf(stderr, "kernel_launch: occupancy query says %d\n", per_cu);
        (void)hipGetLastError();
        grid = cus > 256 ? 256 : cus;
    }
    if (grid < 0) return;
    if (hipMemsetAsync((char*)d_ws + WS_CTL, 0, CTL_ZERO_BYTES, stream) != hipSuccess) return;
    Args a{};
    for (int i = 0; i < 26; ++i) a.in[i] = (const float*)d_in[i];
    a.out = (float*)d_out; a.ws = (unsigned char*)d_ws;
    hipLaunchKernelGGL(mega_fwd, dim3(grid), dim3(NWAVES * 64), LDS_BYTES, stream, a);
}
```

```cpp
#include <hip/hip_runtime.h>
#include <cstdio>
#include <cstdint>

namespace pg8 {
#define PG8_LAS __attribute__((address_space(3)))
typedef unsigned short bf16_t;
typedef short bf16x8 __attribute__((ext_vector_type(8)));
typedef float f32x4 __attribute__((ext_vector_type(4)));
typedef unsigned u32x4 __attribute__((ext_vector_type(4)));
constexpr int BM = 256, BK = 64, HALF = 128, HTB = HALF * BK * 2, STAGE_BYTES = 8 * HTB, NXCD = 8, WGM = 8;

__host__ __device__ __forceinline__ int lds_byte(int r, int c) { const int st = (r >> 4) * 2 + (c >> 5), rr = r & 15, cc = c & 31, ob = rr * 64 + cc * 2; return st * 1024 + (ob ^ (((ob >> 9) & 1) << 5)); }
__host__ __device__ __forceinline__ void stage_rc(int b, int& R, int& C) { const int st = b / 1024, sb = b % 1024, swz = sb ^ (((sb >> 9) & 1) << 5); R = (st >> 1) * 16 + swz / 64; C = (st & 1) * 32 + (swz % 64) / 2; }
__host__ __device__ __forceinline__ int perm32(int rho) { const int n = rho >> 4, i = rho & 15; return 8 * (i >> 2) + 4 * n + (i & 3); }

struct Unit { int pm, pn; };
struct Gemm { const bf16_t* A; const bf16_t* Bt; int lda, ldb, K; };

struct StaticOrder {
    int nM, nN, nwg, G, c;
    __device__ void init(int M, int N, int G_, int c_) { nM = M / BM; nN = N / BM; nwg = nM * nN; G = G_; c = c_; }
    __device__ bool next(int i, Unit& u) const {
        const long L = (long)i * G + c; if (L >= nwg) return false;
        int wgid = (int)L; { const int q = nwg / NXCD, r = nwg % NXCD, xcd = wgid % NXCD, off = wgid / NXCD; wgid = (xcd < r ? xcd * (q + 1) : r * (q + 1) + (xcd - r) * q) + off; }
        const int nig = WGM * nN, gid = wgid / nig, fm = gid * WGM, gsz = (nM - fm) < WGM ? (nM - fm) : WGM;
        u.pm = fm + ((wgid % nig) % gsz); u.pn = (wgid % nig) / gsz; return true;
    }
};
struct PoolOrder {
    int nrt, talloc, G, c;
    __device__ bool next(int i, Unit& u) const { const int L = i * G + c; if (L >= 4 * nrt) return false; const int g = L / nrt, rt = L - g * nrt; u.pm = g * talloc + rt; u.pn = g; return true; }
};
struct MoeOrder {
    int t0, nrt, nct, G, c; int ts1, ts2, ts3, ts4, ts5, ts6, ts7;
    __device__ bool next(int i, Unit& u) const {
        const int nwg = nrt * nct; const int L = i * G + c; if (L >= nwg) return false;
        int wgid = L; { const int q = nwg / NXCD, r = nwg % NXCD, xcd = wgid % NXCD, off = wgid / NXCD; wgid = (xcd < r ? xcd * (q + 1) : r * (q + 1) + (xcd - r) * q) + off; }
        const int nig = WGM * nct, gid = wgid / nig, fm = gid * WGM, gsz = (nrt - fm) < WGM ? (nrt - fm) : WGM;
        const int rt = t0 + fm + ((wgid % nig) % gsz), ct = (wgid % nig) / gsz;
        const int e = (rt >= ts1) + (rt >= ts2) + (rt >= ts3) + (rt >= ts4) + (rt >= ts5) + (rt >= ts6) + (rt >= ts7);
        u.pm = rt; u.pn = e * nct + ct; return true;
    }
};

__device__ __forceinline__ unsigned cvt_pk_bf16(float lo, float hi) { unsigned r; asm volatile("v_cvt_pk_bf16_f32 %0, %1, %2" : "=v"(r) : "v"(lo), "v"(hi)); return r; }

template <class Epi, class Sched, bool ALIGN_EPI>
__device__ __forceinline__ void gemm_phase(PG8_LAS unsigned char* lds, const Gemm g, const Sched& S, const Epi& E) {
    int tid_ = threadIdx.x; asm volatile("" : "+v"(tid_));
    const int tid = tid_, wid = __builtin_amdgcn_readfirstlane(tid >> 6), lane = tid & 63, wr = wid >> 2, wc = wid & 3, fr = lane & 15, fq = lane >> 4;
    int K_ = g.K; asm volatile("" : "+s"(K_));
    const int K = K_, nt = K / BK;
    unsigned voffA[2], voffB[2];
#pragma unroll
    for (int i = 0; i < 2; ++i) { int R, C; stage_rc(tid * 16 + i * 8192, R, C); const int Rb = Epi::PERM ? ((R & ~31) + perm32(R & 31)) : R;
        voffA[i] = (unsigned)(R * g.lda + C) * 2u; voffB[i] = (unsigned)(Rb * g.ldb + C) * 2u; }
    const size_t kstep = (size_t)(BK * 2);
    const size_t hstepA = (size_t)HALF * g.lda * 2, hstepB = (size_t)HALF * g.ldb * 2;
    const size_t tstepA = 2 * hstepA, tstepB = 2 * hstepB;
    const unsigned ldsw = (unsigned)wid * 1024u;
    const int aoff = lds_byte(wr * 64 + fr, fq * 8), boff = lds_byte(wc * 32 + fr, fq * 8);
#define PG8_SA(b, h) (((b) * 2 + (h)) * HTB)
#define PG8_SB(b, h) ((4 + (b) * 2 + (h)) * HTB)
#define PG8_STAGE(bufoff, gbase, voff) do { _Pragma("unroll") for (int _i = 0; _i < 2; ++_i) \
        __builtin_amdgcn_global_load_lds((const unsigned*)((const char*)(gbase) + (voff)[_i]), (PG8_LAS unsigned*)(lds + (bufoff) + ldsw + _i * 8192), 16, 0, 0); } while (0)
#define PG8_LDA(dst, b, h) do { _Pragma("unroll") for (int m = 0; m < 4; ++m) _Pragma("unroll") for (int k = 0; k < 2; ++k) dst[m][k] = *(const PG8_LAS bf16x8*)(lds + PG8_SA(b, h) + aoff + m * 2048 + k * 1024); } while (0)
#define PG8_LDB(dst, b, h) do { _Pragma("unroll") for (int n = 0; n < 2; ++n) _Pragma("unroll") for (int k = 0; k < 2; ++k) dst[n][k] = *(const PG8_LAS bf16x8*)(lds + PG8_SB(b, h) + boff + n * 2048 + k * 1024); } while (0)
#define PG8_MMA(ai, bj, At, Bt) do { __builtin_amdgcn_s_setprio(1); _Pragma("unroll") for (int m = 0; m < 4; ++m) _Pragma("unroll") for (int n = 0; n < 2; ++n) _Pragma("unroll") for (int k = 0; k < 2; ++k) \
        acc[ai][bj][m][n] = __builtin_amdgcn_mfma_f32_16x16x32_bf16(Bt[n][k], At[m][k], acc[ai][bj][m][n], 0, 0, 0); __builtin_amdgcn_s_setprio(0); } while (0)
#define PG8_WAIT_V(n) asm volatile("s_waitcnt vmcnt(" #n ")" ::: "memory")
#define PG8_WAIT_L(n) asm volatile("s_waitcnt lgkmcnt(" #n ")" ::: "memory")
#define PG8_BAR __builtin_amdgcn_s_barrier()
#define PG8_SCHED __builtin_amdgcn_sched_barrier(0)
    Unit cur, nxt; int ui = 0;
    if (!S.next(0, cur)) return;
    f32x4 acc[2][2][4][2];
#pragma unroll
    for (int a = 0; a < 2; ++a)
#pragma unroll
        for (int b = 0; b < 2; ++b)
#pragma unroll
            for (int m = 0; m < 4; ++m)
#pragma unroll
                for (int n = 0; n < 2; ++n) acc[a][b][m][n] = (f32x4){0.f, 0.f, 0.f, 0.f};
    bf16x8 At[4][2], B0[2][2], B1[2][2];
    const char* cA = (const char*)g.A + (size_t)cur.pm * tstepA; const char* cB = (const char*)g.Bt + (size_t)cur.pn * tstepB;
    PG8_STAGE(PG8_SB(0, 0), cB, voffB); PG8_STAGE(PG8_SB(0, 1), cB + hstepB, voffB); PG8_STAGE(PG8_SA(0, 0), cA, voffA); PG8_STAGE(PG8_SA(0, 1), cA + hstepA, voffA);
    if (wr == 1) PG8_BAR;
    PG8_WAIT_V(2); PG8_BAR;
    PG8_STAGE(PG8_SB(1, 0), cB + kstep, voffB); PG8_STAGE(PG8_SA(1, 0), cA + kstep, voffA); PG8_STAGE(PG8_SB(1, 1), cB + hstepB + kstep, voffB);
    PG8_WAIT_V(6); PG8_BAR;
    for (;;) {
        const bool has_next = S.next(ui + 1, nxt);
        const char* nA = has_next ? (const char*)g.A + (size_t)nxt.pm * tstepA : cA; const char* nB = has_next ? (const char*)g.Bt + (size_t)nxt.pn * tstepB : cB;
#pragma unroll 1
        for (int t = 0; t < nt; t += 2) {
            const bool last = (t == nt - 2);
            const char* a1 = cA + (size_t)(t + 1) * kstep;
            const char* a2 = last ? nA : cA + (size_t)(t + 2) * kstep; const char* b2 = last ? nB : cB + (size_t)(t + 2) * kstep;
            const char* a3 = a2 + kstep; const char* b3 = b2 + kstep;
            PG8_LDB(B0, 0, 0); PG8_LDB(B1, 0, 1); PG8_SCHED; PG8_LDA(At, 0, 0); PG8_STAGE(PG8_SA(1, 1), a1 + hstepA, voffA);
            PG8_WAIT_V(8); PG8_WAIT_L(0); PG8_BAR; PG8_MMA(0, 0, At, B0); PG8_MMA(0, 1, At, B1); PG8_BAR; PG8_SCHED;
            PG8_LDA(At, 0, 1); PG8_STAGE(PG8_SB(0, 0), b2, voffB); PG8_STAGE(PG8_SB(0, 1), b2 + hstepB, voffB); PG8_STAGE(PG8_SA(0, 0), a2, voffA);
            PG8_WAIT_V(8); PG8_WAIT_L(0); PG8_BAR; PG8_MMA(1, 0, At, B0); PG8_MMA(1, 1, At, B1); PG8_BAR; PG8_SCHED;
            PG8_LDB(B0, 1, 0); PG8_LDB(B1, 1, 1); PG8_SCHED; PG8_LDA(At, 1, 0); PG8_STAGE(PG8_SA(0, 1), a2 + hstepA, voffA);
            PG8_WAIT_V(8); PG8_WAIT_L(0); PG8_BAR; PG8_MMA(0, 0, At, B0); PG8_MMA(0, 1, At, B1); PG8_BAR; PG8_SCHED;
            PG8_LDA(At, 1, 1); PG8_STAGE(PG8_SB(1, 0), b3, voffB); PG8_STAGE(PG8_SB(1, 1), b3 + hstepB, voffB); PG8_STAGE(PG8_SA(1, 0), a3, voffA);
            PG8_WAIT_V(8); PG8_WAIT_L(0); PG8_BAR; PG8_MMA(1, 0, At, B0); PG8_MMA(1, 1, At, B1); PG8_BAR; PG8_SCHED;
        }
        if constexpr (ALIGN_EPI) { if (wr == 0) PG8_BAR; }
        E(acc, cur, wr, wc, fr, fq);
        if (!has_next) break;
#pragma unroll
        for (int a = 0; a < 2; ++a)
#pragma unroll
            for (int b = 0; b < 2; ++b)
#pragma unroll
                for (int m = 0; m < 4; ++m)
#pragma unroll
                    for (int n = 0; n < 2; ++n) acc[a][b][m][n] = (f32x4){0.f, 0.f, 0.f, 0.f};
        cur = nxt; cA = nA; cB = nB; ++ui;
        if constexpr (ALIGN_EPI) { if (wr == 1) PG8_BAR; }
    }
    PG8_WAIT_V(0);
    if constexpr (!ALIGN_EPI) { if (wr == 0) PG8_BAR; }
    PG8_BAR;
#undef PG8_SA
#undef PG8_SB
#undef PG8_STAGE
#undef PG8_LDA
#undef PG8_LDB
#undef PG8_MMA
#undef PG8_WAIT_V
#undef PG8_WAIT_L
#undef PG8_BAR
#undef PG8_SCHED
}
}

constexpr int NWAVES = 8;
constexpr int DM = 1024, NB = 16, SEQ = 2048, CTXL = 256;
constexpr int M = NB * SEQ, MC = NB * CTXL, MT = M + MC;
constexpr int QL = 384, KVL = 256, ROPE = 32, HW = 512, NH = 8, QKD = 96, VD = 64;
constexpr int INW = 3232, INP = 3328;
constexpr int DFF = 2816, NE = 8, DFE = 3584, NMOD = 6 * DM;
constexpr int NHH = 4, HK = 128; constexpr int NKEY = SEQ + CTXL;
constexpr float EPS = 1e-6f;
constexpr int MAXT = 296;
constexpr int MOE_CH = 128;

constexpr size_t MiB = 1u << 20;
constexpr size_t WS_CTL = 0, CTL_ZERO_BYTES = 1 * MiB;
constexpr size_t WS_MODV = 1 * MiB;
constexpr size_t WS_ROPE = 3 * MiB;
constexpr size_t WS_CNT = 3 * MiB + 64 * 1024;
constexpr size_t WS_TST = 3 * MiB + 128 * 1024;
constexpr size_t WS_EIDX = 4 * MiB, WS_GATE = 4 * MiB + 512 * 1024, WS_POS = 5 * MiB;
constexpr size_t WS_RSQ = 6 * MiB, WS_RSKV = 6 * MiB + 256 * 1024;
constexpr size_t WS_HC = 8 * MiB;
constexpr size_t WS_WIN = 24 * MiB, WS_WUQ = 37 * MiB, WS_WUKV = 39 * MiB, WS_WOUT = 40 * MiB, WS_WGU = 44 * MiB, WS_WDN = 66 * MiB, WS_WPOOL = 77 * MiB;
constexpr size_t WS_U = 80 * MiB;
constexpr size_t WS_X = 152 * MiB;
constexpr size_t WS_CQ = WS_X, WS_CKV = 179 * MiB, WS_KR = 197 * MiB, WS_KRR = 200 * MiB, WS_HQ = 203 * MiB  ;
constexpr size_t WS_QB = 383 * MiB, WS_KN = 437 * MiB, WS_VV = 473 * MiB, WS_OF = 509 * MiB, WS_OB = 581 * MiB, WS_MIX = 653 * MiB, WS_HID = WS_X;
constexpr size_t WS_MWGU = WS_X, WS_MWDN = 264 * MiB, WS_POOLED = 320 * MiB, WS_VG = 392 * MiB, WS_HIDM = 540 * MiB, WS_END = 800 * MiB;
constexpr size_t HSEG = (size_t)MT * HW;
static_assert(WS_HQ + 5 * HSEG * 2 <= WS_QB && WS_MIX + (size_t)MT * DM * 2 <= WS_END && WS_HID + (size_t)MT * DFF * 2 <= WS_QB, "ws map even");
static_assert(WS_HIDM + (size_t)MOE_CH * 256 * DFE * 2 <= WS_END && WS_VG + (size_t)MAXT * 256 * DM * 2 <= WS_HIDM && WS_MWDN + (size_t)NE * DM * DFE * 2 <= WS_POOLED && WS_MWGU + (size_t)NE * 2 * DFE * DM * 2 <= WS_MWDN, "ws map odd");
constexpr int CW_BAR = 4096;

constexpr int RING_OFF = 0, RING_BYTES = 131072;
constexpr int LDSCTL_OFF = RING_BYTES, MISC_OFF = LDSCTL_OFF + 320;
constexpr int LDS_BYTES = 147456;

#define GAS __attribute__((address_space(1)))
#define LAS __attribute__((address_space(3)))
typedef unsigned short bf16;
typedef unsigned v4u __attribute__((ext_vector_type(4)));
typedef unsigned v2u __attribute__((ext_vector_type(2)));
typedef float f32x4 __attribute__((ext_vector_type(4)));
typedef GAS unsigned gu32;
#define RLX_AGENT __ATOMIC_RELAXED, __HIP_MEMORY_SCOPE_AGENT
#define LDS_WAIT() asm volatile("s_waitcnt lgkmcnt(0)" ::: "memory")
__device__ __forceinline__ unsigned f2bf(float f) { unsigned u = __builtin_bit_cast(unsigned, f); return (u + 0x7fffu + ((u >> 16) & 1u)) >> 16; }
__device__ __forceinline__ unsigned pk2(float lo, float hi) { return f2bf(lo) | (f2bf(hi) << 16); }
__device__ __forceinline__ float bf2f(unsigned short b) { return __uint_as_float((unsigned)b << 16); }
__device__ __forceinline__ float bflo(unsigned w) { return __uint_as_float(w << 16); }
__device__ __forceinline__ float bfhi(unsigned w) { return __uint_as_float(w & 0xffff0000u); }
__device__ __forceinline__ float sigmoidf_(float x) { return 1.0f / (1.0f + __expf(-x)); }
__device__ __forceinline__ float siluf_(float x) { return x / (1.0f + __expf(-x)); }

#define XB_TMO      128
#define XB_XCNT(j)  (256  + 64 * (j))
#define XB_XSUB(j)  (1280 + 64 * (j))
#define XB_XGEN(j)  (2304 + 64 * (j))
#define XB_TOP      3328
#define XB_TOPGEN   3392
#define XCD_BAR_WORDS 3456
#define XB_SPIN_CAP (1u << 22)
__device__ __forceinline__ unsigned xb_ld(unsigned* p)              { return __hip_atomic_load(p, __ATOMIC_RELAXED, __HIP_MEMORY_SCOPE_AGENT); }
__device__ __forceinline__ unsigned xb_add(unsigned* p, unsigned v) { return __hip_atomic_fetch_add(p, v, __ATOMIC_RELAXED, __HIP_MEMORY_SCOPE_AGENT); }
__device__ __forceinline__ unsigned xb_xcc_id() { return (unsigned)__builtin_amdgcn_s_getreg((3 << 11) | 20) & 0xFu; }
#define XB_SPIN(cond, bar) do { unsigned _sp = 0; while (cond) { __builtin_amdgcn_s_sleep(1); \
    if ((++_sp & 255u) == 0u) { if (xb_ld(&(bar)[XB_TMO])) break; if (_sp > XB_SPIN_CAP) { atomicAdd(&(bar)[XB_TMO], 1u); break; } } } } while (0)
struct XcdBarrier { unsigned* bar; unsigned x; volatile LAS unsigned* st; };
__device__ __forceinline__ XcdBarrier xcd_barrier_post(unsigned* bar, volatile LAS unsigned* st) {
    XcdBarrier b; b.bar = bar; b.x = xb_xcc_id(); b.st = st;
    if (threadIdx.x == 0) (void)xb_add(&bar[XB_XCNT(b.x)], 1u);
    return b;
}
__device__ __forceinline__ void xcd_barrier_complete(unsigned* bar, unsigned x, unsigned& nloc, unsigned& nx) {
    const unsigned G = gridDim.x * gridDim.y * gridDim.z;
    unsigned sum, cnt, mine, sp = 0u;
    for (;;) {
        sum = 0u; cnt = 0u; mine = 0u;
#pragma unroll
        for (unsigned j = 0; j < 16; ++j) { const unsigned c = xb_ld(&bar[XB_XCNT(j)]); sum += c; cnt += (c > 0u) ? 1u : 0u; mine = (j == x) ? c : mine; }
        if (sum == G) break;
        __builtin_amdgcn_s_sleep(1);
        if ((++sp & 255u) == 0u) { if (xb_ld(&bar[XB_TMO])) break; if (sp > XB_SPIN_CAP) { atomicAdd(&bar[XB_TMO], 1u); break; } }
    }
    nloc = mine > 0u ? mine : 1u; nx = cnt > 0u ? cnt : 1u;
}
__device__ __forceinline__ void xcd_barrier(const XcdBarrier& b) {
    asm volatile("s_waitcnt vmcnt(0)" ::: "memory");
    __syncthreads();
    if (threadIdx.x == 0) {
        unsigned* bar = b.bar;
        __builtin_amdgcn_s_waitcnt(0);
        unsigned nloc = b.st[0], nx = b.st[1];
        if (nloc == 0u) { xcd_barrier_complete(bar, b.x, nloc, nx); b.st[0] = nloc; b.st[1] = nx; }
        const unsigned old = xb_add(&bar[XB_XSUB(b.x)], 1u);
        const unsigned gen = old / nloc;
        if (old + 1u == (gen + 1u) * nloc) {
            __builtin_amdgcn_fence(__ATOMIC_RELEASE, "agent");
            asm volatile("s_waitcnt vmcnt(0)" ::: "memory");
            const unsigned og = xb_add(&bar[XB_TOP], 1u);
            const unsigned tg = og / nx;
            if (og + 1u == (tg + 1u) * nx) xb_add(&bar[XB_TOPGEN], 1u);
            else XB_SPIN(xb_ld(&bar[XB_TOPGEN]) == tg, bar);
            __builtin_amdgcn_fence(__ATOMIC_ACQUIRE, "agent");
            xb_add(&bar[XB_XGEN(b.x)], 1u);
            asm volatile("s_waitcnt vmcnt(0)" ::: "memory");
        } else {
            XB_SPIN(xb_ld(&bar[XB_XGEN(b.x)]) == gen, bar);
            __builtin_amdgcn_fence(__ATOMIC_ACQUIRE, "agent");
            asm volatile("s_waitcnt vmcnt(0)" ::: "memory");
        }
    }
    __syncthreads();
}

struct Args { const float* in[26]; float* out; unsigned char* ws; };
struct Frame {
    LAS unsigned char* lds;
    int tid, lane, wave, G, vcu;
    const float* const* in; float* out; unsigned char* ws;
};
__device__ __forceinline__ float wave_sum(float v) {
#pragma unroll
    for (int o = 1; o < 64; o <<= 1) v += __shfl_xor(v, o);
    return v;
}

__device__ __forceinline__ void fresh(Frame& F) { int t = threadIdx.x; asm volatile("" : "+v"(t)); F.tid = t; F.lane = t & 63; F.wave = __builtin_amdgcn_readfirstlane(t >> 6); }

__device__ __forceinline__ void conv_item(const float* W, int ldw, bf16* WT, int ldd, int k0, int n0, int drow0, const float* kscale, float gscale, LAS float* scr, int lane) {
#pragma unroll 8
    for (int i = 0; i < 32; ++i) { const int kk = 2 * i + (lane >> 5); float w = W[(size_t)(k0 + kk) * ldw + n0 + (lane & 31)]; if (kscale) w *= kscale[k0 + kk]; scr[kk * 33 + (lane & 31)] = w * gscale; }
    LDS_WAIT(); asm volatile("" ::: "memory");
    const int c = lane & 7;
#pragma unroll
    for (int j = 0; j < 4; ++j) { const int n = (lane >> 3) + 8 * j; const LAS float* s = scr + (8 * c) * 33 + n;
        v4u o; o.x = pk2(s[0 * 33], s[1 * 33]); o.y = pk2(s[2 * 33], s[3 * 33]); o.z = pk2(s[4 * 33], s[5 * 33]); o.w = pk2(s[6 * 33], s[7 * 33]);
        *(v4u*)(WT + (size_t)(drow0 + n) * ldd + k0 + 8 * c) = o; }
    LDS_WAIT(); asm volatile("" ::: "memory");
}
__device__ __forceinline__ int conv_rowmap(int mode, int n0, int off) {
    if (mode == 0) return n0 + off;
    if (mode == 1) { if (n0 < 384) return n0; if (n0 < 640) return 512 + (n0 - 384); if (n0 < 672) return 384; return 768 + (n0 - 672); }
    return 256 * (n0 >> 7) + (n0 & 127) + off;
}
__device__ __forceinline__ void conv_matrix(Frame& F, const float* W, int K, int N, bf16* WT, int ldd, int mode, int off, const float* kscale, float gscale) {
    LAS float* scr = (LAS float*)(F.lds + RING_OFF + F.wave * 16384);
    const int gw = F.vcu * NWAVES + F.wave, NGW = F.G * NWAVES;
    const int nblk = N / 32, nitems = (K / 64) * nblk;
    for (int it = gw; it < nitems; it += NGW) { const int kb = it / nblk, nb = it % nblk; conv_item(W, N, WT, ldd, 64 * kb, 32 * nb, conv_rowmap(mode, 32 * nb, off), kscale, gscale, scr, F.lane); }
}

__device__ __forceinline__ int row_bidx(int row) { return row < M ? row / SEQ : NB; }

struct RowArgs {
    const float* hin_l; const float* hin_c; float* hout_l; float* hout_c;
    const float* g;
    const float* modl;
    int shoff, scoff;
    bf16* U;
    const bf16* Y; const int* pos; const float* gate; const float* modprev;
    const float* router; int* eidx; float* gout; int* cnt;
};
template <bool COMBINE, int OUTMODE, bool ROUTER>
__device__ __forceinline__ void row_phase(Frame& F, const RowArgs& A, int nrows) {
    fresh(F);
    const int rpw = (nrows + F.G - 1) / F.G;
    LAS int* lcnt = (LAS int*)(F.lds + RING_OFF);
    if (ROUTER) { if (F.tid < 8) lcnt[F.tid] = 0; __syncthreads(); }
    for (int i = F.wave; i < rpw; i += NWAVES) {
        const int row = (int)blockIdx.x * rpw + i; if (row >= nrows) break;
        const bool lat = row < M; const int bidx = lat ? row / SEQ : NB;
        const float* hr = lat ? A.hin_l + (size_t)row * DM : A.hin_c + (size_t)(row - M) * DM;
        f32x4 v[4];
#pragma unroll
        for (int j = 0; j < 4; ++j) v[j] = *(const f32x4*)(hr + 4 * F.lane + 256 * j);
        if (COMBINE) {
            const int pa = A.pos[2 * row], pb = A.pos[2 * row + 1]; const float ga = A.gate[2 * row], gb = A.gate[2 * row + 1];
            const float* g2 = A.modprev + bidx * NMOD + 5 * DM;
#pragma unroll
            for (int j = 0; j < 4; ++j) { const int col = 4 * F.lane + 256 * j;
                const v2u ya = *(const v2u*)(A.Y + (size_t)pa * DM + col), yb = *(const v2u*)(A.Y + (size_t)pb * DM + col); const f32x4 gv = *(const f32x4*)(g2 + col);
                v[j].x += gv.x * (ga * bflo(ya.x) + gb * bflo(yb.x)); v[j].y += gv.y * (ga * bfhi(ya.x) + gb * bfhi(yb.x));
                v[j].z += gv.z * (ga * bflo(ya.y) + gb * bflo(yb.y)); v[j].w += gv.w * (ga * bfhi(ya.y) + gb * bfhi(yb.y)); }
            if (OUTMODE != 2) { float* ho = lat ? A.hout_l + (size_t)row * DM : A.hout_c + (size_t)(row - M) * DM;
#pragma unroll
                for (int j = 0; j < 4; ++j) *(f32x4*)(ho + 4 * F.lane + 256 * j) = v[j]; }
        }
        float s = 0.f;
#pragma unroll
        for (int j = 0; j < 4; ++j) s += (v[j].x * v[j].x + v[j].y * v[j].y) + (v[j].z * v[j].z + v[j].w * v[j].w);
        const float rstd = rsqrtf(wave_sum(s) * (1.0f / DM) + EPS);
        if (OUTMODE == 2) {
            float* ho = A.hout_l + (size_t)row * DM;
#pragma unroll
            for (int j = 0; j < 4; ++j) { const int col = 4 * F.lane + 256 * j; const f32x4 gv = *(const f32x4*)(A.g + col); *(f32x4*)(ho + col) = v[j] * rstd * gv; }
        } else {
            const float* sh = A.modl + bidx * NMOD + A.shoff; const float* sc = A.modl + bidx * NMOD + A.scoff;
            float lg[8];
            if (ROUTER) {
#pragma unroll
                for (int e = 0; e < 8; ++e) lg[e] = 0.f;
            }
#pragma unroll
            for (int j = 0; j < 4; ++j) { const int col = 4 * F.lane + 256 * j; const f32x4 gv = *(const f32x4*)(A.g + col), shv = *(const f32x4*)(sh + col), scv = *(const f32x4*)(sc + col);
                f32x4 y = v[j] * rstd * gv * (scv + 1.0f) + shv;
                v2u o; o.x = pk2(y.x, y.y); o.y = pk2(y.z, y.w); *(v2u*)(A.U + (size_t)row * DM + col) = o;
                if (ROUTER) {
#pragma unroll
                    for (int q = 0; q < 4; ++q) { const f32x4 r0 = *(const f32x4*)(A.router + (size_t)(col + q) * 8), r1 = *(const f32x4*)(A.router + (size_t)(col + q) * 8 + 4); const float yy = y[q];
                        lg[0] += yy * r0.x; lg[1] += yy * r0.y; lg[2] += yy * r0.z; lg[3] += yy * r0.w; lg[4] += yy * r1.x; lg[5] += yy * r1.y; lg[6] += yy * r1.z; lg[7] += yy * r1.w; } }
            }
            if (ROUTER) {
#pragma unroll
                for (int e = 0; e < 8; ++e) lg[e] = wave_sum(lg[e]);
                int i0 = 0; float v0 = lg[0];
#pragma unroll
                for (int e = 1; e < 8; ++e) if (lg[e] > v0) { v0 = lg[e]; i0 = e; }
                int i1 = -1; float v1 = -INFINITY;
#pragma unroll
                for (int e = 0; e < 8; ++e) if (e != i0 && lg[e] > v1) { v1 = lg[e]; i1 = e; }
                const float g0 = 1.0f / (1.0f + __expf(v1 - v0));
                if (F.lane == 0) { A.eidx[2 * row] = i0; A.eidx[2 * row + 1] = i1; A.gout[2 * row] = g0; A.gout[2 * row + 1] = 1.0f - g0; atomicAdd((int*)&lcnt[i0], 1); atomicAdd((int*)&lcnt[i1], 1); }
            }
        }
    }
    if (ROUTER) { __syncthreads(); if (F.tid < 8) A.cnt[blockIdx.x * 8 + F.tid] = lcnt[F.tid]; __syncthreads(); }
}

using pg8::Unit; using pg8::cvt_pk_bf16;
__device__ __forceinline__ v4u pack8(const f32x4& a, const f32x4& b) { v4u w; w.x = cvt_pk_bf16(a[0], a[1]); w.y = cvt_pk_bf16(a[2], a[3]); w.z = cvt_pk_bf16(b[0], b[1]); w.w = cvt_pk_bf16(b[2], b[3]); return w; }
struct EpiIn {
    static constexpr bool PERM = true;
    bf16 *CQ, *KR, *CKV, *H5;
    __device__ __forceinline__ void operator()(const f32x4 (&acc)[2][2][4][2], const Unit& u, int wr, int wc, int fr, int fq) const {
        const int row0 = u.pm * 256 + wr * 64 + fr;
#pragma unroll
        for (int bj = 0; bj < 2; ++bj) {
            const int col = u.pn * 256 + bj * 128 + wc * 32 + 8 * fq;
            bf16* base; int ld;
            if (col < 384) { base = CQ + col; ld = QL; }
            else if (col < 416) { base = KR + (col - 384); ld = ROPE; }
            else if (col < 512) { base = nullptr; ld = 0; }
            else if (col < 768) { base = CKV + (col - 512); ld = KVL; }
            else { const int c2 = col - 768; base = H5 + (size_t)(c2 >> 9) * HSEG + (c2 & 511); ld = HW; }
            if (base) {
#pragma unroll
                for (int ai = 0; ai < 2; ++ai)
#pragma unroll
                    for (int m = 0; m < 4; ++m) { const int row = row0 + ai * 128 + m * 16; *(v4u*)(base + (size_t)row * ld) = pack8(acc[ai][bj][m][0], acc[ai][bj][m][1]); }
            }
        }
    }
};
struct EpiQ {
    static constexpr bool PERM = true;
    bf16* O; const float* rs;
    __device__ __forceinline__ void operator()(const f32x4 (&acc)[2][2][4][2], const Unit& u, int wr, int wc, int fr, int fq) const {
        const int row0 = u.pm * 256 + wr * 64 + fr;
#pragma unroll
        for (int ai = 0; ai < 2; ++ai)
#pragma unroll
            for (int m = 0; m < 4; ++m) { const int row = row0 + ai * 128 + m * 16; const float sc = rs[row];
#pragma unroll
                for (int bj = 0; bj < 2; ++bj) { const int col = u.pn * 256 + bj * 128 + wc * 32 + 8 * fq; *(v4u*)(O + (size_t)row * 768 + col) = pack8(acc[ai][bj][m][0] * sc, acc[ai][bj][m][1] * sc); } }
    }
};
struct EpiKV {
    static constexpr bool PERM = true;
    bf16* KNp; bf16* VTp; const float* rs;
    __device__ __forceinline__ void operator()(const f32x4 (&acc)[2][2][4][2], const Unit& u, int wr, int wc, int fr, int fq) const {
        const int row0 = u.pm * 256 + wr * 64 + fr;
#pragma unroll
        for (int ai = 0; ai < 2; ++ai)
#pragma unroll
            for (int m = 0; m < 4; ++m) { const int row = row0 + ai * 128 + m * 16; const float sc = rs[row];
                const bool lat = row < M; const int b = lat ? row / SEQ : (row - M) / CTXL; const int key = lat ? row % SEQ : SEQ + (row - M) % CTXL;
                const int kpos = (key & ~12) | ((key & 4) << 1) | ((key & 8) >> 1);
#pragma unroll
                for (int bj = 0; bj < 2; ++bj) { const int col = u.pn * 256 + bj * 128 + wc * 32 + 8 * fq; const int hh = col >> 7, w = col & 127;
                    if (w < 64) { *(v4u*)(KNp + (size_t)row * HW + hh * 64 + w) = pack8(acc[ai][bj][m][0] * sc, acc[ai][bj][m][1] * sc); }
                    else { bf16* dst = VTp + ((size_t)((b * NH + hh) * VD + (w - 64))) * NKEY + kpos;
#pragma unroll
                        for (int n = 0; n < 2; ++n)
#pragma unroll
                            for (int q = 0; q < 4; ++q) dst[(size_t)(4 * n + q) * NKEY] = (bf16)f2bf(acc[ai][bj][m][n][q] * sc); } } }
    }
};
struct EpiResid {
    static constexpr bool PERM = false;
    const float* hin_l; const float* hin_c; float* hout_l; float* hout_c; const float* modl; int goff;
    __device__ __forceinline__ void operator()(const f32x4 (&acc)[2][2][4][2], const Unit& u, int wr, int wc, int fr, int fq) const {
        const int rowt = u.pm * 256; const bool lat = rowt < M; const int bidx = lat ? rowt / SEQ : NB;
        const float* gate = modl + bidx * NMOD + goff;
        const float* hi = lat ? hin_l + (size_t)rowt * DM : hin_c + (size_t)(rowt - M) * DM;
        float* ho = lat ? hout_l + (size_t)rowt * DM : hout_c + (size_t)(rowt - M) * DM;
        const int col0 = u.pn * 256 + wc * 32 + 4 * fq;
#pragma unroll
        for (int bj = 0; bj < 2; ++bj)
#pragma unroll
            for (int n = 0; n < 2; ++n) { const f32x4 gv = *(const f32x4*)(gate + col0 + bj * 128 + n * 16);
#pragma unroll
                for (int ai = 0; ai < 2; ++ai)
#pragma unroll
                    for (int m = 0; m < 4; ++m) { const int r = ai * 128 + wr * 64 + m * 16 + fr; const size_t off = (size_t)r * DM + col0 + bj * 128 + n * 16; const f32x4 hv = *(const f32x4*)(hi + off); *(f32x4*)(ho + off) = hv + gv * acc[ai][bj][m][n]; }
                asm volatile("" ::: "memory"); }
    }
};
struct EpiPool {
    static constexpr bool PERM = false;
    float* h_l; float* h_c; const float* modl; const float* bias; const float* scale; int talloc;
    __device__ __forceinline__ void operator()(const f32x4 (&acc)[2][2][4][2], const Unit& u, int wr, int wc, int fr, int fq) const {
        const int g = u.pn, rowt = (u.pm - g * talloc) * 256; const bool lat = rowt < M; const int bidx = lat ? rowt / SEQ : NB;
        const float* gate = modl + bidx * NMOD + 2 * DM;
        float* ho = lat ? h_l + (size_t)rowt * DM : h_c + (size_t)(rowt - M) * DM;
        const int col0 = g * 256 + wc * 32 + 4 * fq;
#pragma unroll
        for (int bj = 0; bj < 2; ++bj)
#pragma unroll
            for (int n = 0; n < 2; ++n) { const int c = col0 + bj * 128 + n * 16; const f32x4 gm = *(const f32x4*)(gate + c) * *(const f32x4*)(scale + c); const f32x4 gb = gm * *(const f32x4*)(bias + c);
#pragma unroll
                for (int ai = 0; ai < 2; ++ai)
#pragma unroll
                    for (int m = 0; m < 4; ++m) { const int r = ai * 128 + wr * 64 + m * 16 + fr; const size_t off = (size_t)r * DM + c; const f32x4 hv = *(const f32x4*)(ho + off); *(f32x4*)(ho + off) = hv + gm * acc[ai][bj][m][n] + gb; }
                asm volatile("" ::: "memory"); }
    }
};
struct EpiGateUp {
    static constexpr bool PERM = true;
    bf16* H; int ldh, nct, rowsub;
    __device__ __forceinline__ void operator()(const f32x4 (&acc)[2][2][4][2], const Unit& u, int wr, int wc, int fr, int fq) const {
        const int row0 = u.pm * 256 + wr * 64 + fr - rowsub; const int ct = u.pn % nct; const int col = ct * 128 + wc * 32 + 8 * fq;
#pragma unroll
        for (int ai = 0; ai < 2; ++ai)
#pragma unroll
            for (int m = 0; m < 4; ++m) { const int row = row0 + ai * 128 + m * 16; f32x4 o[2];
#pragma unroll
                for (int n = 0; n < 2; ++n)
#pragma unroll
                    for (int q = 0; q < 4; ++q) { const float gv = acc[ai][0][m][n][q], uv = acc[ai][1][m][n][q]; o[n][q] = gv * uv / (1.0f + __expf(-gv)); }
                *(v4u*)(H + (size_t)row * ldh + col) = pack8(o[0], o[1]); }
    }
};
struct EpiY {
    static constexpr bool PERM = true;
    bf16* Y; int nct;
    __device__ __forceinline__ void operator()(const f32x4 (&acc)[2][2][4][2], const Unit& u, int wr, int wc, int fr, int fq) const {
        const int row0 = u.pm * 256 + wr * 64 + fr; const int ct = u.pn % nct;
#pragma unroll
        for (int ai = 0; ai < 2; ++ai)
#pragma unroll
            for (int m = 0; m < 4; ++m) { const int row = row0 + ai * 128 + m * 16;
#pragma unroll
                for (int bj = 0; bj < 2; ++bj) { const int col = ct * 256 + bj * 128 + wc * 32 + 8 * fq; *(v4u*)(Y + (size_t)row * DM + col) = pack8(acc[ai][bj][m][0], acc[ai][bj][m][1]); } }
    }
};

__device__ __forceinline__ void p0_prologue(Frame& F) {
    fresh(F);
    unsigned char* ws = F.ws;
    const float qscale = 0.10206207261596577f * 1.4426950408889634f;
    for (int j = 0; j < 2; ++j) {
        conv_matrix(F, F.in[8] + (size_t)j * DM * INW, DM, INW, (bf16*)(ws + WS_WIN) + (size_t)j * INP * DM, DM, 1, 0, nullptr, 1.f);
        conv_matrix(F, F.in[11] + (size_t)j * QL * 768, QL, 768, (bf16*)(ws + WS_WUQ) + (size_t)j * 768 * QL, QL, 0, 0, F.in[9] + j * QL, qscale);
        conv_matrix(F, F.in[12] + (size_t)j * KVL * 1024, KVL, 1024, (bf16*)(ws + WS_WUKV) + (size_t)j * 1024 * KVL, KVL, 0, 0, F.in[10] + j * KVL, 1.f);
        conv_matrix(F, F.in[15] + (size_t)j * DM * DM, DM, DM, (bf16*)(ws + WS_WOUT) + (size_t)j * DM * DM, DM, 0, 0, nullptr, 1.f);
        conv_matrix(F, F.in[16] + (size_t)j * DM * DFF, DM, DFF, (bf16*)(ws + WS_WGU) + (size_t)j * 2 * DFF * DM, DM, 2, 0, nullptr, 1.f);
        conv_matrix(F, F.in[17] + (size_t)j * DM * DFF, DM, DFF, (bf16*)(ws + WS_WGU) + (size_t)j * 2 * DFF * DM, DM, 2, 128, nullptr, 1.f);
        conv_matrix(F, F.in[18] + (size_t)j * DFF * DM, DFF, DM, (bf16*)(ws + WS_WDN) + (size_t)j * DM * DFF, DFF, 0, 0, nullptr, 1.f);
        for (int g = 0; g < 4; ++g)
            conv_matrix(F, F.in[19] + (size_t)(j * 4 + g) * 65536, 256, 256, (bf16*)(ws + WS_WPOOL) + (size_t)(j * 4 + g) * 65536, 256, 0, 0, nullptr, 1.f);
    }
    __syncthreads();
    if (blockIdx.x == 0 && F.tid < 8) {
        float* TC = (float*)(ws + WS_ROPE); float* TS = TC + 512;
        double th = 1.0; for (int i = 0; i < F.tid; ++i) th *= 0.31622776601683794;
        const double x2 = th * th; double s = th, c = 1.0, ts = th, tc = 1.0;
        for (int n = 1; n <= 12; ++n) { tc *= -x2 / (double)((2 * n - 1) * (2 * n)); c += tc; ts *= -x2 / (double)((2 * n) * (2 * n + 1)); s += ts; }
        double cp = 1.0, sp = 0.0;
        for (int p = 0; p < 64; ++p) { TC[p * 8 + F.tid] = (float)cp; TS[p * 8 + F.tid] = (float)sp; const double ncp = cp * c - sp * s; sp = sp * c + cp * s; cp = ncp; }
    }
    {
        LAS float* sc = (LAS float*)(F.lds + RING_OFF);
        LAS float* red = sc + 17 * 1024;
        const int nitems = 4 * (NMOD / 64);
        if ((int)blockIdx.x < nitems) {
            for (int e = F.tid; e < 17 * 1024; e += 512) { const int r = e >> 10, k = e & 1023; const float x = (r < 16) ? F.in[1][r * 1024 + k] : F.in[3][k]; sc[e] = siluf_(x); }
            __syncthreads();
            for (int it = blockIdx.x; it < nitems; it += F.G) {
                const int l = it / (NMOD / 64), c0 = (it % (NMOD / 64)) * 64;
                const float* W = F.in[4] + (size_t)l * DM * NMOD + c0 + F.lane;
                float acc[17];
#pragma unroll
                for (int r = 0; r < 17; ++r) acc[r] = 0.f;
                const int kb = F.wave * 128;
                for (int k = 0; k < 128; k += 4) {
                    const float w0 = W[(size_t)(kb + k) * NMOD], w1 = W[(size_t)(kb + k + 1) * NMOD], w2 = W[(size_t)(kb + k + 2) * NMOD], w3 = W[(size_t)(kb + k + 3) * NMOD];
#pragma unroll
                    for (int r = 0; r < 17; ++r) { const f32x4 s4 = *(const LAS f32x4*)(sc + r * 1024 + kb + k); acc[r] += s4.x * w0 + s4.y * w1 + s4.z * w2 + s4.w * w3; }
                }
#pragma unroll
                for (int r = 0; r < 17; ++r) red[(F.wave * 17 + r) * 64 + F.lane] = acc[r];
                __syncthreads();
                for (int o = F.tid; o < 17 * 64; o += 512) { const int r = o >> 6, cc = o & 63; float s = 0.f;
#pragma unroll
                    for (int w = 0; w < 8; ++w) s += red[(w * 17 + r) * 64 + cc];
                    ((float*)(ws + WS_MODV))[(size_t)(l * 17 + r) * NMOD + c0 + cc] = s + F.in[5][l * NMOD + c0 + cc]; }
                __syncthreads();
            }
        }
    }
}

__device__ __forceinline__ void e3_phase(Frame& F) {
    fresh(F);
    unsigned char* ws = F.ws;
    const bf16* CQ = (const bf16*)(ws + WS_CQ); const bf16* CKV = (const bf16*)(ws + WS_CKV); const bf16* KR = (const bf16*)(ws + WS_KR); bf16* KRR = (bf16*)(ws + WS_KRR);
    float* RSQ = (float*)(ws + WS_RSQ); float* RSKV = (float*)(ws + WS_RSKV); const float* TC = (const float*)(ws + WS_ROPE); const float* TS = TC + 512;
    const int rpw = (MT + F.G - 1) / F.G;
    for (int i = F.wave; i < rpw; i += NWAVES) {
        const int row = (int)blockIdx.x * rpw + i; if (row >= MT) break;
        float s = 0.f;
        if (F.lane < 48) { const v4u w = *(const v4u*)(CQ + (size_t)row * QL + F.lane * 8);
            s = bflo(w.x) * bflo(w.x) + bfhi(w.x) * bfhi(w.x) + bflo(w.y) * bflo(w.y) + bfhi(w.y) * bfhi(w.y) + bflo(w.z) * bflo(w.z) + bfhi(w.z) * bfhi(w.z) + bflo(w.w) * bflo(w.w) + bfhi(w.w) * bfhi(w.w); }
        s = wave_sum(s); if (F.lane == 0) RSQ[row] = rsqrtf(s * (1.0f / QL) + EPS);
        s = 0.f;
        if (F.lane < 32) { const v4u w = *(const v4u*)(CKV + (size_t)row * KVL + F.lane * 8);
            s = bflo(w.x) * bflo(w.x) + bfhi(w.x) * bfhi(w.x) + bflo(w.y) * bflo(w.y) + bfhi(w.y) * bfhi(w.y) + bflo(w.z) * bflo(w.z) + bfhi(w.z) * bfhi(w.z) + bflo(w.w) * bflo(w.w) + bfhi(w.w) * bfhi(w.w); }
        s = wave_sum(s); if (F.lane == 0) RSKV[row] = rsqrtf(s * (1.0f / KVL) + EPS);
        const float x = (F.lane < 32) ? bf2f(KR[(size_t)row * ROPE + F.lane]) : 0.f; const float pr = __shfl_xor(x, 8);
        float o = x;
        if (row < M) { const int t = row % SEQ; const int p = ((F.lane >> 4) & 1) ? (t & 63) : (t >> 6); const int j = F.lane & 7; const float c = TC[p * 8 + j], sn = TS[p * 8 + j];
            o = ((F.lane >> 3) & 1) ? x * c + pr * sn : x * c - pr * sn; }
        if (F.lane < 32) KRR[(size_t)row * ROPE + F.lane] = (bf16)f2bf(o);
    }
}

typedef short bf16x8v __attribute__((ext_vector_type(8)));
typedef float f32x16 __attribute__((ext_vector_type(16)));
__device__ __forceinline__ void attn_unit(Frame& F, int b, int h, int qrow0, bool rope_q, int t_lo, int t_hi) {
    unsigned char* ws = F.ws;
    const bf16* QB = (const bf16*)(ws + WS_QB); const bf16* KN = (const bf16*)(ws + WS_KN); const bf16* KRR = (const bf16*)(ws + WS_KRR); const bf16* VT = (const bf16*)(ws + WS_VV);
    bf16* MIX = (bf16*)(ws + WS_MIX); const float* TC = (const float*)(ws + WS_ROPE); const float* TS = TC + 512;
    const int lane = F.lane, wave = F.wave, r32 = lane & 31, hi = lane >> 5;
    LAS unsigned char* ring = F.lds + RING_OFF;
    const int qrow = qrow0 + wave * 32 + r32;
    bf16x8v qr[6];
#pragma unroll
    for (int d0 = 0; d0 < 6; ++d0) qr[d0] = *(const bf16x8v*)(QB + (size_t)qrow * 768 + h * QKD + 16 * d0 + 8 * hi);
    if (rope_q) { const int t = qrow % SEQ;
#pragma unroll
        for (int a = 0; a < 2; ++a) { const int p = a ? (t & 63) : (t >> 6); const v4u w = __builtin_bit_cast(v4u, qr[4 + a]); float x[8], y[8];
            x[0] = bflo(w.x); x[1] = bfhi(w.x); x[2] = bflo(w.y); x[3] = bfhi(w.y); x[4] = bflo(w.z); x[5] = bfhi(w.z); x[6] = bflo(w.w); x[7] = bfhi(w.w);
#pragma unroll
            for (int jj = 0; jj < 8; ++jj) { const float pr = __shfl_xor(x[jj], 32); const float c = TC[p * 8 + jj], sn = TS[p * 8 + jj]; y[jj] = hi ? x[jj] * c + pr * sn : x[jj] * c - pr * sn; }
            v4u o; o.x = pk2(y[0], y[1]); o.y = pk2(y[2], y[3]); o.z = pk2(y[4], y[5]); o.w = pk2(y[6], y[7]); qr[4 + a] = __builtin_bit_cast(bf16x8v, o); } }
    const int bh = b * NH + h;
    const bf16* vsrc = VT + ((size_t)(bh * VD + lane)) * NKEY + 8 * wave;
#define ATT_DMA(t, buf) do { const int t_ = (t); const int r0_ = t_ < SEQ / 64 ? b * SEQ + 64 * t_ : M + b * CTXL + 64 * (t_ - SEQ / 64); \
        LAS unsigned char* kb_ = ring + (buf) * 12288; LAS unsigned char* vb_ = ring + 24576 + (buf) * 8192; \
        __builtin_amdgcn_global_load_lds((const unsigned*)(KN + (size_t)(r0_ + lane) * HW + h * 64 + 8 * wave), (LAS unsigned*)(kb_ + wave * 1024), 16, 0, 0); \
        if (wave < 4) __builtin_amdgcn_global_load_lds((const unsigned*)(KRR + (size_t)(r0_ + lane) * ROPE + 8 * wave), (LAS unsigned*)(kb_ + (8 + wave) * 1024), 16, 0, 0); \
        __builtin_amdgcn_global_load_lds((const unsigned*)(vsrc + 64 * t_), (LAS unsigned*)(vb_ + wave * 1024), 16, 0, 0); } while (0)
    f32x16 o0, o1;
#pragma unroll
    for (int r = 0; r < 16; ++r) { o0[r] = 0.f; o1[r] = 0.f; }
    float m_run = -INFINITY, l_run = 0.f;
    ATT_DMA(t_lo, 0);
    for (int t = t_lo; t < t_hi; ++t) {
        const int buf = (t - t_lo) & 1;
        asm volatile("s_waitcnt vmcnt(0)" ::: "memory"); __syncthreads();
        if (t + 1 < t_hi) ATT_DMA(t + 1, buf ^ 1);
        const LAS unsigned char* kb = ring + buf * 12288 + hi * 1024 + r32 * 16; const LAS unsigned char* vb = ring + 24576 + buf * 8192 + hi * 1024 + r32 * 16;
        f32x16 p0, p1;
#pragma unroll
        for (int r = 0; r < 16; ++r) { p0[r] = 0.f; p1[r] = 0.f; }
#pragma unroll
        for (int d0 = 0; d0 < 6; ++d0) { const bf16x8v k0 = *(const LAS bf16x8v*)(kb + d0 * 2048), k1 = *(const LAS bf16x8v*)(kb + d0 * 2048 + 512);
            p0 = __builtin_amdgcn_mfma_f32_32x32x16_bf16(k0, qr[d0], p0, 0, 0, 0); p1 = __builtin_amdgcn_mfma_f32_32x32x16_bf16(k1, qr[d0], p1, 0, 0, 0); }
        float mt = fmaxf(p0[0], p1[0]);
#pragma unroll
        for (int r = 1; r < 16; ++r) mt = fmaxf(mt, fmaxf(p0[r], p1[r]));
        mt = fmaxf(mt, __shfl_xor(mt, 32));
        const float mn = fmaxf(m_run, mt); const float alpha = __builtin_amdgcn_exp2f(m_run - mn); m_run = mn;
        float ps = 0.f;
#pragma unroll
        for (int r = 0; r < 16; ++r) { p0[r] = __builtin_amdgcn_exp2f(p0[r] - mn); p1[r] = __builtin_amdgcn_exp2f(p1[r] - mn); ps += p0[r] + p1[r]; }
        l_run = l_run * alpha + ps;
#pragma unroll
        for (int r = 0; r < 16; ++r) { o0[r] *= alpha; o1[r] *= alpha; }
        v4u pw[4];
#pragma unroll
        for (int q = 0; q < 4; ++q) { pw[0][q] = cvt_pk_bf16(p0[2 * q], p0[2 * q + 1]); pw[1][q] = cvt_pk_bf16(p0[8 + 2 * q], p0[8 + 2 * q + 1]); pw[2][q] = cvt_pk_bf16(p1[2 * q], p1[2 * q + 1]); pw[3][q] = cvt_pk_bf16(p1[8 + 2 * q], p1[8 + 2 * q + 1]); }
#pragma unroll
        for (int s4 = 0; s4 < 4; ++s4) { const bf16x8v pa = __builtin_bit_cast(bf16x8v, pw[s4]);
            const bf16x8v v0 = *(const LAS bf16x8v*)(vb + s4 * 2048), v1 = *(const LAS bf16x8v*)(vb + s4 * 2048 + 512);
            o0 = __builtin_amdgcn_mfma_f32_32x32x16_bf16(v0, pa, o0, 0, 0, 0); o1 = __builtin_amdgcn_mfma_f32_32x32x16_bf16(v1, pa, o1, 0, 0, 0); }
    }
    l_run += __shfl_xor(l_run, 32);
    const float rl = 1.0f / l_run;
    bf16* orow = MIX + (size_t)qrow * DM + h * VD;
#pragma unroll
    for (int g = 0; g < 4; ++g) { v2u a, c2; a.x = pk2(o0[4 * g] * rl, o0[4 * g + 1] * rl); a.y = pk2(o0[4 * g + 2] * rl, o0[4 * g + 3] * rl); c2.x = pk2(o1[4 * g] * rl, o1[4 * g + 1] * rl); c2.y = pk2(o1[4 * g + 2] * rl, o1[4 * g + 3] * rl);
        *(v2u*)(orow + 8 * g + 4 * hi) = a; *(v2u*)(orow + 32 + 8 * g + 4 * hi) = c2; }
    __syncthreads();
#undef ATT_DMA
}
__device__ __forceinline__ void attn_phase(Frame& F, bool ctx_out) {
    fresh(F);
    const int nlat = NB * NH * 8, nctx = ctx_out ? NB * NH : 0;
    const int per = (nlat + F.G - 1) / F.G;
    for (int i = 0; i < per; ++i) { const int it = F.vcu * per + i; if (it >= nlat) break; const int bh = it >> 3, qb = it & 7; attn_unit(F, bh >> 3, bh & 7, (bh >> 3) * SEQ + qb * 256, true, 0, NKEY / 64); }
    for (int it = F.vcu; it < nctx; it += F.G) attn_unit(F, it >> 3, it & 7, M + (it >> 3) * CTXL, false, SEQ / 64, NKEY / 64);
    __syncthreads();
}

__device__ __forceinline__ int hgrn_row(int b, int dir, int ig) { return (ig < CTXL) ? (M + b * CTXL + (dir ? CTXL - 1 - ig : ig)) : (b * SEQ + (dir ? SEQ - 1 - (ig - CTXL) : (ig - CTXL))); }
__device__ __forceinline__ void hgrn_phase(Frame& F, int j) {
    fresh(F);
    unsigned char* ws = F.ws;
    const bf16* HQ = (const bf16*)(ws + WS_HQ); const bf16* HFF = HQ + HSEG; const bf16* HFB = HQ + 2 * HSEG; const bf16* HI = HQ + 3 * HSEG;
    float* OF = (float*)(ws + WS_OF); float* OB = (float*)(ws + WS_OB);
    LAS unsigned char* ring = F.lds + RING_OFF;
    LAS unsigned char* QN = ring; LAS unsigned char* KN = ring + 17408; LAS unsigned char* KT = ring + 34816; LAS unsigned char* VT = ring + 53248; LAS unsigned char* ST = ring + 62464;
    LAS float* TOT = (LAS float*)(ring + 79872); LAS float* ER = (LAS float*)(ring + 81920); LAS float* EG = (LAS float*)(ring + 82432);
    const int tid = F.tid, lane = F.lane, wave = F.wave, r32 = lane & 31, hi = lane >> 5;
    const int k = tid & 127, part = tid >> 7;
    const int kb = wave >> 1, vb = wave & 1;
    for (int it = blockIdx.x; it < NB * NHH * 2 * 2; it += F.G) {
        const int vh = it & 1, dir = (it >> 1) & 1, hh = (it >> 2) & 3, b = it >> 4;
        const bf16* HF = dir ? HFB : HFF; float* OO = dir ? OB : OF;
        float lb = 0.f; if (j == 1) { const int ci = dir * HW + hh * HK + k; const float l0 = F.in[13][ci], l1 = F.in[13][2 * HW + ci]; lb = 1.0f / (1.0f + __expf(l0 - l1)); }
        const float oml = 1.0f - lb;
        f32x16 S;
#pragma unroll
        for (int r = 0; r < 16; ++r) S[r] = 0.f;
        for (int ch = 0; ch < NKEY / 64; ++ch) {
            float qv[16], kin[16], cs[16]; float run = 0.f;
#pragma unroll
            for (int ii = 0; ii < 16; ++ii) { const int row = hgrn_row(b, dir, ch * 64 + 16 * part + ii);
                const float hq = bf2f(HQ[(size_t)row * HW + hh * HK + k]), hf = bf2f(HF[(size_t)row * HW + hh * HK + k]);
                qv[ii] = hq / (1.0f + __expf(-hq)); const float e = __expf(-hf), sg = 1.0f / (1.0f + e); kin[ii] = oml * e * sg; run += __logf(lb + oml * sg); cs[ii] = run; }
            TOT[part * 128 + k] = run;
            { const int row = hgrn_row(b, dir, ch * 64 + lane); const v4u w = *(const v4u*)(HI + (size_t)row * HW + hh * HK + vh * 64 + 8 * wave);
              const int pos = (lane & ~12) | ((lane & 4) << 1) | ((lane & 8) >> 1); LAS bf16* vt = (LAS bf16*)(VT + (8 * wave) * 144 + pos * 2);
              vt[0 * 72] = (bf16)(w.x & 0xffffu); vt[1 * 72] = (bf16)(w.x >> 16); vt[2 * 72] = (bf16)(w.y & 0xffffu); vt[3 * 72] = (bf16)(w.y >> 16);
              vt[4 * 72] = (bf16)(w.z & 0xffffu); vt[5 * 72] = (bf16)(w.z >> 16); vt[6 * 72] = (bf16)(w.w & 0xffffu); vt[7 * 72] = (bf16)(w.w >> 16); }
            __syncthreads();
            { const float t0 = TOT[k], t1 = TOT[128 + k], t2 = TOT[256 + k], t3 = TOT[384 + k];
              const float base = (part > 0 ? t0 : 0.f) + (part > 1 ? t1 : 0.f) + (part > 2 ? t2 : 0.f); const float rr = t0 + t1, glast = rr + t2 + t3;
              if (part == 0) { ER[k] = __expf(rr); EG[k] = __expf(glast - rr); }
              unsigned kt[8];
#pragma unroll
              for (int ii = 0; ii < 16; ii += 2) { float d0 = base + cs[ii] - rr, d1 = base + cs[ii + 1] - rr; d0 = fminf(fmaxf(d0, -80.f), 80.f); d1 = fminf(fmaxf(d1, -80.f), 80.f);
                  const float e0 = __expf(d0), e1 = __expf(d1); const float q0 = qv[ii] * e0, q1 = qv[ii + 1] * e1, k0 = kin[ii] / e0, k1 = kin[ii + 1] / e1;
                  *(LAS bf16*)(QN + (16 * part + ii) * 272 + k * 2) = (bf16)f2bf(q0); *(LAS bf16*)(QN + (16 * part + ii + 1) * 272 + k * 2) = (bf16)f2bf(q1);
                  *(LAS bf16*)(KN + (16 * part + ii) * 272 + k * 2) = (bf16)f2bf(k0); *(LAS bf16*)(KN + (16 * part + ii + 1) * 272 + k * 2) = (bf16)f2bf(k1);
                  kt[ii >> 1] = pk2(k0, k1); }
              *(LAS v4u*)(KT + k * 144 + part * 32) = (v4u){kt[0], kt[1], kt[4], kt[5]}; *(LAS v4u*)(KT + k * 144 + part * 32 + 16) = (v4u){kt[2], kt[3], kt[6], kt[7]}; }
            __syncthreads();
            f32x16 T;
#pragma unroll
            for (int g4 = 0; g4 < 4; ++g4) { const int kk = kb * 32 + 8 * g4 + 4 * hi; const f32x4 er = *(const LAS f32x4*)(ER + kk);
                T[4 * g4] = S[4 * g4] * er.x; T[4 * g4 + 1] = S[4 * g4 + 1] * er.y; T[4 * g4 + 2] = S[4 * g4 + 2] * er.z; T[4 * g4 + 3] = S[4 * g4 + 3] * er.w;
                v2u o; o.x = pk2(T[4 * g4], T[4 * g4 + 1]); o.y = pk2(T[4 * g4 + 2], T[4 * g4 + 3]); *(LAS v2u*)(ST + (vb * 32 + r32) * 272 + kk * 2) = o; }
            __syncthreads();
            if (wave < 4) {
                const int ib = kb;
                bf16x8v qf[8];
#pragma unroll
                for (int ks = 0; ks < 8; ++ks) qf[ks] = *(const LAS bf16x8v*)(QN + (ib * 32 + r32) * 272 + ks * 32 + hi * 16);
                f32x16 O;
#pragma unroll
                for (int r = 0; r < 16; ++r) O[r] = 0.f;
#pragma unroll
                for (int ks = 0; ks < 8; ++ks) { const bf16x8v sf = *(const LAS bf16x8v*)(ST + (vb * 32 + r32) * 272 + ks * 32 + hi * 16); O = __builtin_amdgcn_mfma_f32_32x32x16_bf16(qf[ks], sf, O, 0, 0, 0); }
                for (int sb = 0; sb <= ib; ++sb) {
                    f32x16 X;
#pragma unroll
                    for (int r = 0; r < 16; ++r) X[r] = 0.f;
#pragma unroll
                    for (int ks = 0; ks < 8; ++ks) { const bf16x8v kf = *(const LAS bf16x8v*)(KN + (sb * 32 + r32) * 272 + ks * 32 + hi * 16); X = __builtin_amdgcn_mfma_f32_32x32x16_bf16(kf, qf[ks], X, 0, 0, 0); }
                    if (sb == ib) {
#pragma unroll
                        for (int r = 0; r < 16; ++r) { const int srow = (r & 3) + 8 * (r >> 2) + 4 * hi; if (srow > r32) X[r] = 0.f; }
                    }
#pragma unroll
                    for (int st = 0; st < 2; ++st) { v4u pw;
#pragma unroll
                        for (int q = 0; q < 4; ++q) pw[q] = cvt_pk_bf16(X[8 * st + 2 * q], X[8 * st + 2 * q + 1]);
                        const bf16x8v vf = *(const LAS bf16x8v*)(VT + (vb * 32 + r32) * 144 + (sb * 32 + st * 16) * 2 + hi * 16);
                        O = __builtin_amdgcn_mfma_f32_32x32x16_bf16(__builtin_bit_cast(bf16x8v, pw), vf, O, 0, 0, 0); }
                }
#pragma unroll
                for (int r = 0; r < 16; ++r) { const int i = ib * 32 + (r & 3) + 8 * (r >> 2) + 4 * hi; const int row = hgrn_row(b, dir, ch * 64 + i); OO[(size_t)row * HW + hh * HK + vh * 64 + vb * 32 + r32] = O[r]; }
            }
#pragma unroll
            for (int st = 0; st < 4; ++st) { const bf16x8v kf = *(const LAS bf16x8v*)(KT + (kb * 32 + r32) * 144 + st * 32 + hi * 16), vf = *(const LAS bf16x8v*)(VT + (vb * 32 + r32) * 144 + st * 32 + hi * 16);
                T = __builtin_amdgcn_mfma_f32_32x32x16_bf16(kf, vf, T, 0, 0, 0); }
#pragma unroll
            for (int g4 = 0; g4 < 4; ++g4) { const int kk = kb * 32 + 8 * g4 + 4 * hi; const f32x4 eg = *(const LAS f32x4*)(EG + kk);
                S[4 * g4] = T[4 * g4] * eg.x; S[4 * g4 + 1] = T[4 * g4 + 1] * eg.y; S[4 * g4 + 2] = T[4 * g4 + 2] * eg.z; S[4 * g4 + 3] = T[4 * g4 + 3] * eg.w; }
            __syncthreads();
        }
    }
    __syncthreads();
}

__device__ __forceinline__ void e8_phase(Frame& F, int j, int nrows) {
    fresh(F);
    unsigned char* ws = F.ws;
    const float* OF = (const float*)(ws + WS_OF); const float* OB = (const float*)(ws + WS_OB); const bf16* HG = (const bf16*)(ws + WS_HQ) + 4 * HSEG; bf16* MIX = (bf16*)(ws + WS_MIX);
    const float* gn = F.in[14] + j * HK;
    const int rpw = (nrows + F.G - 1) / F.G;
    for (int i = F.wave; i < rpw; i += NWAVES) {
        const int row = (int)blockIdx.x * rpw + i; if (row >= nrows) break;
        const int col = 8 * F.lane;
        const f32x4 a0 = *(const f32x4*)(OF + (size_t)row * HW + col), a1 = *(const f32x4*)(OF + (size_t)row * HW + col + 4), b0 = *(const f32x4*)(OB + (size_t)row * HW + col), b1 = *(const f32x4*)(OB + (size_t)row * HW + col + 4);
        f32x4 x0 = a0 + b0, x1 = a1 + b1;
        float s = (x0.x * x0.x + x0.y * x0.y) + (x0.z * x0.z + x0.w * x0.w) + (x1.x * x1.x + x1.y * x1.y) + (x1.z * x1.z + x1.w * x1.w);
        s += __shfl_xor(s, 1); s += __shfl_xor(s, 2); s += __shfl_xor(s, 4); s += __shfl_xor(s, 8);
        const float rstd = rsqrtf(s * (1.0f / HK) + EPS);
        const int vv = col & 127; const f32x4 g0 = *(const f32x4*)(gn + vv), g1 = *(const f32x4*)(gn + vv + 4);
        const v4u hg = *(const v4u*)(HG + (size_t)row * HW + col);
        x0 = x0 * rstd * g0; x1 = x1 * rstd * g1;
        v4u o; o.x = pk2(x0.x * siluf_(bflo(hg.x)), x0.y * siluf_(bfhi(hg.x))); o.y = pk2(x0.z * siluf_(bflo(hg.y)), x0.w * siluf_(bfhi(hg.y)));
        o.z = pk2(x1.x * siluf_(bflo(hg.z)), x1.y * siluf_(bfhi(hg.z))); o.w = pk2(x1.z * siluf_(bflo(hg.w)), x1.w * siluf_(bfhi(hg.w)));
        *(v4u*)(MIX + (size_t)row * DM + HW + col) = o;
    }
}

__device__ __forceinline__ void o2_phase(Frame& F, int nrows) {
    fresh(F);
    unsigned char* ws = F.ws;
    const bf16* U = (const bf16*)(ws + WS_U); bf16* P = (bf16*)(ws + WS_POOLED);
    const int rpw = (nrows + F.G - 1) / F.G;
    for (int i = F.wave; i < rpw; i += NWAVES) {
        const int row = (int)blockIdx.x * rpw + i; if (row >= nrows) break;
        const bool lat = row < M; const int T = lat ? SEQ : CTXL; const int t = lat ? row % SEQ : (row - M) % CTXL; const int rbase = row - t;
#pragma unroll
        for (int g = 0; g < 4; ++g) {
            const int w = 2 << g; int lo = t - w / 2; if (lo < 0) lo = 0; int hi = t + w / 2; if (hi > T) hi = T;
            const int col = 256 * g + 4 * F.lane;
            float s0 = 0.f, s1 = 0.f, s2 = 0.f, s3 = 0.f;
            for (int r = lo; r < hi; ++r) { const v2u x = *(const v2u*)(U + (size_t)(rbase + r) * DM + col); s0 += bflo(x.x); s1 += bfhi(x.x); s2 += bflo(x.y); s3 += bfhi(x.y); }
            const v2u xc = *(const v2u*)(U + (size_t)row * DM + col); const float ic = 1.0f / (float)(hi - lo);
            v2u o; o.x = pk2(s0 * ic - bflo(xc.x), s1 * ic - bfhi(xc.x)); o.y = pk2(s2 * ic - bflo(xc.y), s3 * ic - bfhi(xc.y));
            *(v2u*)(P + ((size_t)g * MT + row) * 256 + 4 * F.lane) = o;
        }
    }
}

__device__ __forceinline__ void o5_phase(Frame& F, int nrows) {
    fresh(F);
    unsigned char* ws = F.ws;
    const int* CNT = (const int*)(ws + WS_CNT); int* TST = (int*)(ws + WS_TST); const int* EIDX = (const int*)(ws + WS_EIDX); int* POS = (int*)(ws + WS_POS);
    const bf16* U = (const bf16*)(ws + WS_U); bf16* VG = (bf16*)(ws + WS_VG);
    LAS int* lc = (LAS int*)(F.lds + RING_OFF);
    LAS int* lbase = lc + 512 * 8;
    LAS int* lpos = lbase + 16;
    const int rpw = (nrows + F.G - 1) / F.G;
    for (int e = F.tid; e < F.G * 8; e += 512) lc[e] = CNT[e];
    __syncthreads();
    if (F.tid == 0) {
        int tot[8], pre[8];
        for (int e = 0; e < 8; ++e) { int s = 0, p = 0; for (int w = 0; w < F.G; ++w) { if (w == (int)blockIdx.x) p = s; s += lc[w * 8 + e]; } tot[e] = s; pre[e] = p; }
        int ts = 0;
        for (int e = 0; e < 8; ++e) { lbase[e] = ts * 256 + pre[e]; if (blockIdx.x == 0) TST[e] = ts; ts += (tot[e] + 255) >> 8; }
        if (blockIdx.x == 0) TST[8] = ts;
    }
    __syncthreads();
    if (F.wave == 0) {
        int run[8];
#pragma unroll
        for (int e = 0; e < 8; ++e) run[e] = lbase[e];
        const int npairs = 2 * rpw;
        for (int c0 = 0; c0 < npairs; c0 += 64) {
            const int pl = c0 + F.lane; const int row = (int)blockIdx.x * rpw + (pl >> 1); const bool ok = pl < npairs && row < nrows;
            const int e = ok ? EIDX[2 * row + (pl & 1)] : -1; int mypos = 0;
#pragma unroll
            for (int x = 0; x < 8; ++x) { const unsigned long long mk = __ballot(e == x); const int below = __popcll(mk & ((1ull << F.lane) - 1ull)); if (e == x) mypos = run[x] + below; run[x] += __popcll(mk); }
            if (ok) { lpos[pl] = mypos; POS[2 * row + (pl & 1)] = mypos; }
        }
    }
    __syncthreads();
    for (int pl = F.wave; pl < 2 * rpw; pl += NWAVES) {
        const int row = (int)blockIdx.x * rpw + (pl >> 1); if (row >= nrows) break;
        const int p = lpos[pl];
        const v4u a = *(const v4u*)(U + (size_t)row * DM + 8 * F.lane), b = *(const v4u*)(U + (size_t)row * DM + 512 + 8 * F.lane);
        *(v4u*)(VG + (size_t)p * DM + 8 * F.lane) = a; *(v4u*)(VG + (size_t)p * DM + 512 + 8 * F.lane) = b;
    }
    __syncthreads();
}

__global__ void __launch_bounds__(NWAVES * 64, 2) mega_fwd(Args args) {
    extern __shared__ __attribute__((aligned(16))) unsigned char lds[];
    Frame F;
    F.lds = (LAS unsigned char*)lds;
    F.tid = threadIdx.x; F.lane = F.tid & 63; F.wave = __builtin_amdgcn_readfirstlane(F.tid >> 6);
    F.G = gridDim.x; { const int bx = blockIdx.x; F.vcu = (F.G % 8 == 0) ? (bx % 8) * (F.G / 8) + bx / 8 : bx; }
    F.in = args.in; F.out = args.out; F.ws = args.ws;
    unsigned char* ws = args.ws;
    volatile LAS unsigned* MISC = (volatile LAS unsigned*)(F.lds + MISC_OFF);
    for (int u = F.tid; u < (LDS_BYTES - LDSCTL_OFF) / 4; u += NWAVES * 64) ((LAS unsigned*)(F.lds + LDSCTL_OFF))[u] = 0u;
    __syncthreads();
    XcdBarrier bar = xcd_barrier_post((unsigned*)(ws + WS_CTL) + CW_BAR, MISC + 8);
#define GRID_BAR() xcd_barrier(bar)
#ifndef ONLY
#define ONLY 0
#endif
#define PH(n) (ONLY == 0 || ONLY == (n))
#ifndef DUPMASK
#define DUPMASK 0
#endif
#define REP(bit) for (int rep_ = 0; rep_ < ((DUPMASK & (bit)) ? 2 : 1); ++rep_)
    LAS unsigned char* ring = F.lds + RING_OFF;
    const float* MODV = (const float*)(ws + WS_MODV);
    float* HC = (float*)(ws + WS_HC);
    bf16* U = (bf16*)(ws + WS_U);

#if PH(20)
    p0_prologue(F);
#endif
    GRID_BAR();

    for (int lp = 0; lp < 2; ++lp) {
        const int le = 2 * lp, lo = 2 * lp + 1, j = lp;
        const bool ctx_out = (lp == 0);
        const int nro = ctx_out ? MT : M;
        const float* modE = MODV + (size_t)le * 17 * NMOD; const float* modO = MODV + (size_t)lo * 17 * NMOD;
        const float* hin_l = (lp == 0) ? args.in[0] : args.out; const float* hin_c = (lp == 0) ? args.in[2] : HC;
#if PH(1)
        {
            RowArgs A{}; A.hin_l = hin_l; A.hin_c = hin_c; A.hout_l = args.out; A.hout_c = HC; A.g = args.in[6] + (size_t)(le * 2 + 0) * DM; A.modl = modE; A.shoff = 0; A.scoff = DM; A.U = U;
            A.Y = (const bf16*)(ws + WS_VG); A.pos = (const int*)(ws + WS_POS); A.gate = (const float*)(ws + WS_GATE); A.modprev = MODV + (size_t)(le - 1) * 17 * NMOD;
            if (lp == 0) row_phase<false, 1, false>(F, A, MT); else row_phase<true, 1, false>(F, A, MT);
        }
#endif
        GRID_BAR();
#if PH(2)
        {
            pg8::Gemm g{U, (const bf16*)(ws + WS_WIN) + (size_t)j * INP * DM, DM, DM, DM}; pg8::StaticOrder S; S.init(MT, INP, F.G, (int)blockIdx.x);
            EpiIn E{(bf16*)(ws + WS_CQ), (bf16*)(ws + WS_KR), (bf16*)(ws + WS_CKV), (bf16*)(ws + WS_HQ)};
            REP(8) pg8::gemm_phase<EpiIn, pg8::StaticOrder, true>(ring, g, S, E);
        }
#endif
        GRID_BAR();
#if PH(3)
        REP(4) e3_phase(F);
#endif
        GRID_BAR();
#if PH(4)
        {
            pg8::Gemm g{(const bf16*)(ws + WS_CQ), (const bf16*)(ws + WS_WUQ) + (size_t)j * 768 * QL, QL, QL, QL}; pg8::StaticOrder S; S.init(nro, 768, F.G, (int)blockIdx.x);
            EpiQ E{(bf16*)(ws + WS_QB), (const float*)(ws + WS_RSQ)};
            REP(8) pg8::gemm_phase<EpiQ, pg8::StaticOrder, true>(ring, g, S, E);
        }
        {
            pg8::Gemm g{(const bf16*)(ws + WS_CKV), (const bf16*)(ws + WS_WUKV) + (size_t)j * 1024 * KVL, KVL, KVL, KVL}; pg8::StaticOrder S; S.init(MT, 1024, F.G, (int)blockIdx.x);
            EpiKV E{(bf16*)(ws + WS_KN), (bf16*)(ws + WS_VV), (const float*)(ws + WS_RSKV)};
            REP(8) pg8::gemm_phase<EpiKV, pg8::StaticOrder, true>(ring, g, S, E);
        }
#endif
        GRID_BAR();
#if PH(6)
#ifndef NO_HGRN
        REP(1) hgrn_phase(F, j);
#endif
#ifndef NO_ATTN
        REP(2) attn_phase(F, ctx_out);
#endif
#endif
        GRID_BAR();
#if PH(8)
        REP(4) e8_phase(F, j, nro);
#endif
        GRID_BAR();
#if PH(9)
        {
            pg8::Gemm g{(const bf16*)(ws + WS_MIX), (const bf16*)(ws + WS_WOUT) + (size_t)j * DM * DM, DM, DM, DM}; pg8::StaticOrder S; S.init(nro, DM, F.G, (int)blockIdx.x);
            EpiResid E{hin_l, hin_c, args.out, HC, modE, 2 * DM};
            pg8::gemm_phase<EpiResid, pg8::StaticOrder, true>(ring, g, S, E);
        }
#endif
        GRID_BAR();
#if PH(10)
        {
            RowArgs A{}; A.hin_l = args.out; A.hin_c = HC; A.g = args.in[6] + (size_t)(le * 2 + 1) * DM; A.modl = modE; A.shoff = 3 * DM; A.scoff = 4 * DM; A.U = U;
            REP(4) row_phase<false, 1, false>(F, A, nro);
        }
#endif
        GRID_BAR();
#if PH(11)
        {
            pg8::Gemm g{U, (const bf16*)(ws + WS_WGU) + (size_t)j * 2 * DFF * DM, DM, DM, DM}; pg8::StaticOrder S; S.init(nro, 2 * DFF, F.G, (int)blockIdx.x);
            EpiGateUp E{(bf16*)(ws + WS_HID), DFF, 2 * DFF / 256, 0};
            REP(8) pg8::gemm_phase<EpiGateUp, pg8::StaticOrder, true>(ring, g, S, E);
        }
#endif
        GRID_BAR();
#if PH(12)
        {
            pg8::Gemm g{(const bf16*)(ws + WS_HID), (const bf16*)(ws + WS_WDN) + (size_t)j * DM * DFF, DFF, DFF, DFF}; pg8::StaticOrder S; S.init(nro, DM, F.G, (int)blockIdx.x);
            EpiResid E{args.out, HC, args.out, HC, modE, 5 * DM};
            pg8::gemm_phase<EpiResid, pg8::StaticOrder, true>(ring, g, S, E);
        }
#endif
        GRID_BAR();
#if PH(13)
        {
            RowArgs A{}; A.hin_l = args.out; A.hin_c = HC; A.g = args.in[6] + (size_t)(lo * 2 + 0) * DM; A.modl = modO; A.shoff = 0; A.scoff = DM; A.U = U;
            row_phase<false, 1, false>(F, A, nro);
            REP(16) for (int e = 0; e < NE; ++e) {
                conv_matrix(F, args.in[23] + ((size_t)j * NE + e) * DM * DFE, DM, DFE, (bf16*)(ws + WS_MWGU) + (size_t)e * 2 * DFE * DM, DM, 2, 0, nullptr, 1.f);
                conv_matrix(F, args.in[24] + ((size_t)j * NE + e) * DM * DFE, DM, DFE, (bf16*)(ws + WS_MWGU) + (size_t)e * 2 * DFE * DM, DM, 2, 128, nullptr, 1.f);
                conv_matrix(F, args.in[25] + ((size_t)j * NE + e) * DFE * DM, DFE, DM, (bf16*)(ws + WS_MWDN) + (size_t)e * DM * DFE, DFE, 0, 0, nullptr, 1.f);
            }
        }
#endif
        GRID_BAR();
#if PH(14)
        REP(4) o2_phase(F, nro);
#endif
        GRID_BAR();
#if PH(15)
        {
            pg8::Gemm g{(const bf16*)(ws + WS_POOLED), (const bf16*)(ws + WS_WPOOL) + (size_t)j * 4 * 65536, 256, 256, 256};
            pg8::PoolOrder S{nro / 256, MT / 256, F.G, (int)blockIdx.x};
            EpiPool E{args.out, HC, modO, args.in[20] + (size_t)j * DM, args.in[21] + (size_t)j * DM, MT / 256};
            pg8::gemm_phase<EpiPool, pg8::PoolOrder, true>(ring, g, S, E);
        }
#endif
        GRID_BAR();
#if PH(16)
        {
            RowArgs A{}; A.hin_l = args.out; A.hin_c = HC; A.g = args.in[6] + (size_t)(lo * 2 + 1) * DM; A.modl = modO; A.shoff = 3 * DM; A.scoff = 4 * DM; A.U = U;
            A.router = args.in[22] + (size_t)j * DM * NE; A.eidx = (int*)(ws + WS_EIDX); A.gout = (float*)(ws + WS_GATE); A.cnt = (int*)(ws + WS_CNT);
            REP(4) row_phase<false, 1, true>(F, A, nro);
        }
#endif
        GRID_BAR();
#if PH(17)
        REP(4) o5_phase(F, nro);
#endif
        GRID_BAR();
#if PH(18)
        {
            const int* TST = (const int*)(ws + WS_TST);
            const int ts1 = TST[1], ts2 = TST[2], ts3 = TST[3], ts4 = TST[4], ts5 = TST[5], ts6 = TST[6], ts7 = TST[7], nT = TST[8];
            for (int c = 0; c * MOE_CH < nT; ++c) {
                const int t0 = c * MOE_CH, nrt = (nT - t0) < MOE_CH ? (nT - t0) : MOE_CH;
                {
                    pg8::Gemm g{(const bf16*)(ws + WS_VG), (const bf16*)(ws + WS_MWGU), DM, DM, DM};
                    pg8::MoeOrder S{t0, nrt, 2 * DFE / 256, F.G, (int)blockIdx.x, ts1, ts2, ts3, ts4, ts5, ts6, ts7};
                    EpiGateUp E{(bf16*)(ws + WS_HIDM), DFE, 2 * DFE / 256, t0 * 256};
                    REP(8) pg8::gemm_phase<EpiGateUp, pg8::MoeOrder, true>(ring, g, S, E);
                }
                GRID_BAR();
                {
                    pg8::Gemm g{(const bf16*)(ws + WS_HIDM) - (size_t)t0 * 256 * DFE, (const bf16*)(ws + WS_MWDN), DFE, DFE, DFE};
                    pg8::MoeOrder S{t0, nrt, DM / 256, F.G, (int)blockIdx.x, ts1, ts2, ts3, ts4, ts5, ts6, ts7};
                    EpiY E{(bf16*)(ws + WS_VG), DM / 256};
                    REP(8) pg8::gemm_phase<EpiY, pg8::MoeOrder, true>(ring, g, S, E);
                }
                GRID_BAR();
            }
        }
#endif
    }
#if PH(19)
    {
        RowArgs A{}; A.hin_l = args.out; A.hin_c = HC; A.hout_l = args.out; A.hout_c = HC; A.g = args.in[7];
        A.Y = (const bf16*)(ws + WS_VG); A.pos = (const int*)(ws + WS_POS); A.gate = (const float*)(ws + WS_GATE); A.modprev = MODV + (size_t)3 * 17 * NMOD;
        row_phase<true, 2, false>(F, A, M);
        if (xb_ld((unsigned*)(ws + WS_CTL) + CW_BAR + XB_TMO) != 0u) { __syncthreads(); const float qn = __builtin_nanf(""); for (int i = F.tid; i < 1024; i += 512) args.out[(size_t)blockIdx.x * 1024 + i] = qn; }
    }
#endif
}

extern "C" void kernel_launch(void* const* d_in, const int* in_sizes, int n_in, void* d_out, int out_size, void* d_ws, size_t ws_size, hipStream_t stream) {
    static int grid = 0;
    if (grid == 0) {
        if (n_in != 26 || out_size != M * DM || ws_size < WS_END) { fprintf(stderr, "kernel_launch: unexpected shapes (n_in %d out %d ws %zu)\n", n_in, out_size, ws_size); grid = -1; return; }
        int dev = 0, cus = 0, per_cu = 0;
        if (hipGetDevice(&dev) != hipSuccess || hipDeviceGetAttribute(&cus, hipDeviceAttributeMultiprocessorCount, dev) != hipSuccess) { grid = -1; return; }
        if (hipFuncSetAttribute((const void*)mega_fwd, hipFuncAttributeMaxDynamicSharedMemorySize, LDS_BYTES) != hipSuccess) { grid = -1; return; }
        if (hipOccupancyMaxActiveBlocksPerMultiprocessor(&per_cu, (const void*)mega_fwd, NWAVES * 64, LDS_BYTES) != hipSuccess || per_cu < 1) fprintf(stderr, "kernel_launch: occupancy query says %d\n", per_cu);
        (void)hipGetLastError();
        grid = cus > 256 ? 256 : cus;
    }
    if (grid < 0) return;
    if (hipMemsetAsync((char*)d_ws + WS_CTL, 0, CTL_ZERO_BYTES, stream) != hipSuccess) return;
    Args a{};
    for (int i = 0; i < 26; ++i) a.in[i] = (const float*)d_in[i];
    a.out = (float*)d_out; a.ws = (unsigned char*)d_ws;
    hipLaunchKernelGGL(mega_fwd, dim3(grid), dim3(NWAVES * 64), LDS_BYTES, stream, a);
}
```

```cpp
#include <hip/hip_runtime.h>
#include <cstdio>
#include <cstdint>

namespace pg8 {
#define PG8_LAS __attribute__((address_space(3)))
typedef unsigned short bf16_t;
typedef short bf16x8 __attribute__((ext_vector_type(8)));
typedef float f32x4 __attribute__((ext_vector_type(4)));
typedef unsigned u32x4 __attribute__((ext_vector_type(4)));
constexpr int BM = 256, BK = 64, HALF = 128, HTB = HALF * BK * 2, STAGE_BYTES = 8 * HTB, NXCD = 8, WGM = 8;

__host__ __device__ __forceinline__ int lds_byte(int r, int c) { const int st = (r >> 4) * 2 + (c >> 5), rr = r & 15, cc = c & 31, ob = rr * 64 + cc * 2; return st * 1024 + (ob ^ (((ob >> 9) & 1) << 5)); }
__host__ __device__ __forceinline__ void stage_rc(int b, int& R, int& C) { const int st = b / 1024, sb = b % 1024, swz = sb ^ (((sb >> 9) & 1) << 5); R = (st >> 1) * 16 + swz / 64; C = (st & 1) * 32 + (swz % 64) / 2; }
__host__ __device__ __forceinline__ int perm32(int rho) { const int n = rho >> 4, i = rho & 15; return 8 * (i >> 2) + 4 * n + (i & 3); }

struct Unit { int pm, pn; };
struct Gemm { const bf16_t* A; const bf16_t* Bt; int lda, ldb, K; };

struct StaticOrder {
    int nM, nN, nwg, G, c;
    __device__ void init(int M, int N, int G_, int c_) { nM = M / BM; nN = N / BM; nwg = nM * nN; G = G_; c = c_; }
    __device__ bool next(int i, Unit& u) const {
        const long L = (long)i * G + c; if (L >= nwg) return false;
        int wgid = (int)L; { const int q = nwg / NXCD, r = nwg % NXCD, xcd = wgid % NXCD, off = wgid / NXCD; wgid = (xcd < r ? xcd * (q + 1) : r * (q + 1) + (xcd - r) * q) + off; }
        const int nig = WGM * nN, gid = wgid / nig, fm = gid * WGM, gsz = (nM - fm) < WGM ? (nM - fm) : WGM;
        u.pm = fm + ((wgid % nig) % gsz); u.pn = (wgid % nig) / gsz; return true;
    }
};
struct PoolOrder {
    int nrt, talloc, G, c;
    __device__ bool next(int i, Unit& u) const { const int L = i * G + c; if (L >= 4 * nrt) return false; const int g = L / nrt, rt = L - g * nrt; u.pm = g * talloc + rt; u.pn = g; return true; }
};
struct MoeOrder {
    int t0, nrt, nct, G, c; int ts1, ts2, ts3, ts4, ts5, ts6, ts7;
    __device__ bool next(int i, Unit& u) const {
        const int nwg = nrt * nct; const int L = i * G + c; if (L >= nwg) return false;
        int wgid = L; { const int q = nwg / NXCD, r = nwg % NXCD, xcd = wgid % NXCD, off = wgid / NXCD; wgid = (xcd < r ? xcd * (q + 1) : r * (q + 1) + (xcd - r) * q) + off; }
        const int nig = WGM * nct, gid = wgid / nig, fm = gid * WGM, gsz = (nrt - fm) < WGM ? (nrt - fm) : WGM;
        const int rt = t0 + fm + ((wgid % nig) % gsz), ct = (wgid % nig) / gsz;
        const int e = (rt >= ts1) + (rt >= ts2) + (rt >= ts3) + (rt >= ts4) + (rt >= ts5) + (rt >= ts6) + (rt >= ts7);
        u.pm = rt; u.pn = e * nct + ct; return true;
    }
};

__device__ __forceinline__ unsigned cvt_pk_bf16(float lo, float hi) { unsigned r; asm volatile("v_cvt_pk_bf16_f32 %0, %1, %2" : "=v"(r) : "v"(lo), "v"(hi)); return r; }

template <class Epi, class Sched, bool ALIGN_EPI>
__device__ __forceinline__ void gemm_phase(PG8_LAS unsigned char* lds, const Gemm g, const Sched& S, const Epi& E) {
    int tid_ = threadIdx.x; asm volatile("" : "+v"(tid_));
    const int tid = tid_, wid = __builtin_amdgcn_readfirstlane(tid >> 6), lane = tid & 63, wr = wid >> 2, wc = wid & 3, fr = lane & 15, fq = lane >> 4;
    int K_ = g.K; asm volatile("" : "+s"(K_));
    const int K = K_, nt = K / BK;
    unsigned voffA[2], voffB[2];
#pragma unroll
    for (int i = 0; i < 2; ++i) { int R, C; stage_rc(tid * 16 + i * 8192, R, C); const int Rb = Epi::PERM ? ((R & ~31) + perm32(R & 31)) : R;
        voffA[i] = (unsigned)(R * g.lda + C) * 2u; voffB[i] = (unsigned)(Rb * g.ldb + C) * 2u; }
    const size_t kstep = (size_t)(BK * 2);
    const size_t hstepA = (size_t)HALF * g.lda * 2, hstepB = (size_t)HALF * g.ldb * 2;
    const size_t tstepA = 2 * hstepA, tstepB = 2 * hstepB;
    const unsigned ldsw = (unsigned)wid * 1024u;
    const int aoff = lds_byte(wr * 64 + fr, fq * 8), boff = lds_byte(wc * 32 + fr, fq * 8);
#define PG8_SA(b, h) (((b) * 2 + (h)) * HTB)
#define PG8_SB(b, h) ((4 + (b) * 2 + (h)) * HTB)
#define PG8_STAGE(bufoff, gbase, voff) do { _Pragma("unroll") for (int _i = 0; _i < 2; ++_i) \
        __builtin_amdgcn_global_load_lds((const unsigned*)((const char*)(gbase) + (voff)[_i]), (PG8_LAS unsigned*)(lds + (bufoff) + ldsw + _i * 8192), 16, 0, 0); } while (0)
#define PG8_LDA(dst, b, h) do { _Pragma("unroll") for (int m = 0; m < 4; ++m) _Pragma("unroll") for (int k = 0; k < 2; ++k) dst[m][k] = *(const PG8_LAS bf16x8*)(lds + PG8_SA(b, h) + aoff + m * 2048 + k * 1024); } while (0)
#define PG8_LDB(dst, b, h) do { _Pragma("unroll") for (int n = 0; n < 2; ++n) _Pragma("unroll") for (int k = 0; k < 2; ++k) dst[n][k] = *(const PG8_LAS bf16x8*)(lds + PG8_SB(b, h) + boff + n * 2048 + k * 1024); } while (0)
#define PG8_MMA(ai, bj, At, Bt) do { __builtin_amdgcn_s_setprio(1); _Pragma("unroll") for (int m = 0; m < 4; ++m) _Pragma("unroll") for (int n = 0; n < 2; ++n) _Pragma("unroll") for (int k = 0; k < 2; ++k) \
        acc[ai][bj][m][n] = __builtin_amdgcn_mfma_f32_16x16x32_bf16(Bt[n][k], At[m][k], acc[ai][bj][m][n], 0, 0, 0); __builtin_amdgcn_s_setprio(0); } while (0)
#define PG8_WAIT_V(n) asm volatile("s_waitcnt vmcnt(" #n ")" ::: "memory")
#define PG8_WAIT_L(n) asm volatile("s_waitcnt lgkmcnt(" #n ")" ::: "memory")
#define PG8_BAR __builtin_amdgcn_s_barrier()
#define PG8_SCHED __builtin_amdgcn_sched_barrier(0)
    Unit cur, nxt; int ui = 0;
    if (!S.next(0, cur)) return;
    f32x4 acc[2][2][4][2];
#pragma unroll
    for (int a = 0; a < 2; ++a)
#pragma unroll
        for (int b = 0; b < 2; ++b)
#pragma unroll
            for (int m = 0; m < 4; ++m)
#pragma unroll
                for (int n = 0; n < 2; ++n) acc[a][b][m][n] = (f32x4){0.f, 0.f, 0.f, 0.f};
    bf16x8 At[4][2], B0[2][2], B1[2][2];
    const char* cA = (const char*)g.A + (size_t)cur.pm * tstepA; const char* cB = (const char*)g.Bt + (size_t)cur.pn * tstepB;
    PG8_STAGE(PG8_SB(0, 0), cB, voffB); PG8_STAGE(PG8_SB(0, 1), cB + hstepB, voffB); PG8_STAGE(PG8_SA(0, 0), cA, voffA); PG8_STAGE(PG8_SA(0, 1), cA + hstepA, voffA);
    if (wr == 1) PG8_BAR;
    PG8_WAIT_V(2); PG8_BAR;
    PG8_STAGE(PG8_SB(1, 0), cB + kstep, voffB); PG8_STAGE(PG8_SA(1, 0), cA + kstep, voffA); PG8_STAGE(PG8_SB(1, 1), cB + hstepB + kstep, voffB);
    PG8_WAIT_V(6); PG8_BAR;
    for (;;) {
        const bool has_next = S.next(ui + 1, nxt);
        const char* nA = has_next ? (const char*)g.A + (size_t)nxt.pm * tstepA : cA; const char* nB = has_next ? (const char*)g.Bt + (size_t)nxt.pn * tstepB : cB;
#pragma unroll 1
        for (int t = 0; t < nt; t += 2) {
            const bool last = (t == nt - 2);
            const char* a1 = cA + (size_t)(t + 1) * kstep;
            const char* a2 = last ? nA : cA + (size_t)(t + 2) * kstep; const char* b2 = last ? nB : cB + (size_t)(t + 2) * kstep;
            const char* a3 = a2 + kstep; const char* b3 = b2 + kstep;
            PG8_LDB(B0, 0, 0); PG8_LDB(B1, 0, 1); PG8_SCHED; PG8_LDA(At, 0, 0); PG8_STAGE(PG8_SA(1, 1), a1 + hstepA, voffA);
            PG8_WAIT_V(8); PG8_WAIT_L(0); PG8_BAR; PG8_MMA(0, 0, At, B0); PG8_MMA(0, 1, At, B1); PG8_BAR; PG8_SCHED;
            PG8_LDA(At, 0, 1); PG8_STAGE(PG8_SB(0, 0), b2, voffB); PG8_STAGE(PG8_SB(0, 1), b2 + hstepB, voffB); PG8_STAGE(PG8_SA(0, 0), a2, voffA);
            PG8_WAIT_V(8); PG8_WAIT_L(0); PG8_BAR; PG8_MMA(1, 0, At, B0); PG8_MMA(1, 1, At, B1); PG8_BAR; PG8_SCHED;
            PG8_LDB(B0, 1, 0); PG8_LDB(B1, 1, 1); PG8_SCHED; PG8_LDA(At, 1, 0); PG8_STAGE(PG8_SA(0, 1), a2 + hstepA, voffA);
            PG8_WAIT_V(8); PG8_WAIT_L(0); PG8_BAR; PG8_MMA(0, 0, At, B0); PG8_MMA(0, 1, At, B1); PG8_BAR; PG8_SCHED;
            PG8_LDA(At, 1, 1); PG8_STAGE(PG8_SB(1, 0), b3, voffB); PG8_STAGE(PG8_SB(1, 1), b3 + hstepB, voffB); PG8_STAGE(PG8_SA(1, 0), a3, voffA);
            PG8_WAIT_V(8); PG8_WAIT_L(0); PG8_BAR; PG8_MMA(1, 0, At, B0); PG8_MMA(1, 1, At, B1); PG8_BAR; PG8_SCHED;
        }
        if constexpr (ALIGN_EPI) { if (wr == 0) PG8_BAR; }
        E(acc, cur, wr, wc, fr, fq);
        if (!has_next) break;
#pragma unroll
        for (int a = 0; a < 2; ++a)
#pragma unroll
            for (int b = 0; b < 2; ++b)
#pragma unroll
                for (int m = 0; m < 4; ++m)
#pragma unroll
                    for (int n = 0; n < 2; ++n) acc[a][b][m][n] = (f32x4){0.f, 0.f, 0.f, 0.f};
        cur = nxt; cA = nA; cB = nB; ++ui;
        if constexpr (ALIGN_EPI) { if (wr == 1) PG8_BAR; }
    }
    PG8_WAIT_V(0);
    if constexpr (!ALIGN_EPI) { if (wr == 0) PG8_BAR; }
    PG8_BAR;
#undef PG8_SA
#undef PG8_SB
#undef PG8_STAGE
#undef PG8_LDA
#undef PG8_LDB
#undef PG8_MMA
#undef PG8_WAIT_V
#undef PG8_WAIT_L
#undef PG8_BAR
#undef PG8_SCHED
}
}

constexpr int NWAVES = 8;
constexpr int DM = 1024, NB = 16, SEQ = 2048, CTXL = 256;
constexpr int M = NB * SEQ, MC = NB * CTXL, MT = M + MC;
constexpr int QL = 384, KVL = 256, ROPE = 32, HW = 512, NH = 8, QKD = 96, VD = 64;
constexpr int INW = 3232, INP = 3328;
constexpr int DFF = 2816, NE = 8, DFE = 3584, NMOD = 6 * DM;
constexpr int NHH = 4, HK = 128; constexpr int NKEY = SEQ + CTXL;
constexpr float EPS = 1e-6f;
constexpr int MAXT = 296;
constexpr int MOE_CH = 128;

constexpr size_t MiB = 1u << 20;
constexpr size_t WS_CTL = 0, CTL_ZERO_BYTES = 1 * MiB;
constexpr size_t WS_MODV = 1 * MiB;
constexpr size_t WS_ROPE = 3 * MiB;
constexpr size_t WS_CNT = 3 * MiB + 64 * 1024;
constexpr size_t WS_TST = 3 * MiB + 128 * 1024;
constexpr size_t WS_EIDX = 4 * MiB, WS_GATE = 4 * MiB + 512 * 1024, WS_POS = 5 * MiB;
constexpr size_t WS_RSQ = 6 * MiB, WS_RSKV = 6 * MiB + 256 * 1024;
constexpr size_t WS_HC = 8 * MiB;
constexpr size_t WS_WIN = 24 * MiB, WS_WUQ = 37 * MiB, WS_WUKV = 39 * MiB, WS_WOUT = 40 * MiB, WS_WGU = 44 * MiB, WS_WDN = 66 * MiB, WS_WPOOL = 77 * MiB;
constexpr size_t WS_U = 80 * MiB;
constexpr size_t WS_X = 152 * MiB;
constexpr size_t WS_CQ = WS_X, WS_CKV = 179 * MiB, WS_KR = 197 * MiB, WS_KRR = 200 * MiB, WS_HQ = 203 * MiB  ;
constexpr size_t WS_QB = 383 * MiB, WS_KN = 437 * MiB, WS_VV = 473 * MiB, WS_OF = 509 * MiB, WS_OB = 581 * MiB, WS_MIX = 653 * MiB, WS_HID = WS_X;
constexpr size_t WS_MWGU = WS_X, WS_MWDN = 264 * MiB, WS_POOLED = 320 * MiB, WS_VG = 392 * MiB, WS_HIDM = 540 * MiB, WS_END = 800 * MiB;
constexpr size_t HSEG = (size_t)MT * HW;
static_assert(WS_HQ + 5 * HSEG * 2 <= WS_QB && WS_MIX + (size_t)MT * DM * 2 <= WS_END && WS_HID + (size_t)MT * DFF * 2 <= WS_QB, "ws map even");
static_assert(WS_HIDM + (size_t)MOE_CH * 256 * DFE * 2 <= WS_END && WS_VG + (size_t)MAXT * 256 * DM * 2 <= WS_HIDM && WS_MWDN + (size_t)NE * DM * DFE * 2 <= WS_POOLED && WS_MWGU + (size_t)NE * 2 * DFE * DM * 2 <= WS_MWDN, "ws map odd");
constexpr int CW_BAR = 4096;

constexpr int RING_OFF = 0, RING_BYTES = 131072;
constexpr int LDSCTL_OFF = RING_BYTES, MISC_OFF = LDSCTL_OFF + 320;
constexpr int LDS_BYTES = 147456;

#define GAS __attribute__((address_space(1)))
#define LAS __attribute__((address_space(3)))
typedef unsigned short bf16;
typedef unsigned v4u __attribute__((ext_vector_type(4)));
typedef unsigned v2u __attribute__((ext_vector_type(2)));
typedef float f32x4 __attribute__((ext_vector_type(4)));
typedef GAS unsigned gu32;
#define RLX_AGENT __ATOMIC_RELAXED, __HIP_MEMORY_SCOPE_AGENT
#define LDS_WAIT() asm volatile("s_waitcnt lgkmcnt(0)" ::: "memory")
__device__ __forceinline__ unsigned f2bf(float f) { unsigned u = __builtin_bit_cast(unsigned, f); return (u + 0x7fffu + ((u >> 16) & 1u)) >> 16; }
__device__ __forceinline__ unsigned pk2(float lo, float hi) { return f2bf(lo) | (f2bf(hi) << 16); }
__device__ __forceinline__ float bf2f(unsigned short b) { return __uint_as_float((unsigned)b << 16); }
__device__ __forceinline__ float bflo(unsigned w) { return __uint_as_float(w << 16); }
__device__ __forceinline__ float bfhi(unsigned w) { return __uint_as_float(w & 0xffff0000u); }
__device__ __forceinline__ float sigmoidf_(float x) { return 1.0f / (1.0f + __expf(-x)); }
__device__ __forceinline__ float siluf_(float x) { return x / (1.0f + __expf(-x)); }

#define XB_TMO      128
#define XB_XCNT(j)  (256  + 64 * (j))
#define XB_XSUB(j)  (1280 + 64 * (j))
#define XB_XGEN(j)  (2304 + 64 * (j))
#define XB_TOP      3328
#define XB_TOPGEN   3392
#define XCD_BAR_WORDS 3456
#define XB_SPIN_CAP (1u << 22)
__device__ __forceinline__ unsigned xb_ld(unsigned* p)              { return __hip_atomic_load(p, __ATOMIC_RELAXED, __HIP_MEMORY_SCOPE_AGENT); }
__device__ __forceinline__ unsigned xb_add(unsigned* p, unsigned v) { return __hip_atomic_fetch_add(p, v, __ATOMIC_RELAXED, __HIP_MEMORY_SCOPE_AGENT); }
__device__ __forceinline__ unsigned xb_xcc_id() { return (unsigned)__builtin_amdgcn_s_getreg((3 << 11) | 20) & 0xFu; }
#define XB_SPIN(cond, bar) do { unsigned _sp = 0; while (cond) { __builtin_amdgcn_s_sleep(1); \
    if ((++_sp & 255u) == 0u) { if (xb_ld(&(bar)[XB_TMO])) break; if (_sp > XB_SPIN_CAP) { atomicAdd(&(bar)[XB_TMO], 1u); break; } } } } while (0)
struct XcdBarrier { unsigned* bar; unsigned x; volatile LAS unsigned* st; };
__device__ __forceinline__ XcdBarrier xcd_barrier_post(unsigned* bar, volatile LAS unsigned* st) {
    XcdBarrier b; b.bar = bar; b.x = xb_xcc_id(); b.st = st;
    if (threadIdx.x == 0) (void)xb_add(&bar[XB_XCNT(b.x)], 1u);
    return b;
}
__device__ __forceinline__ void xcd_barrier_complete(unsigned* bar, unsigned x, unsigned& nloc, unsigned& nx) {
    const unsigned G = gridDim.x * gridDim.y * gridDim.z;
    unsigned sum, cnt, mine, sp = 0u;
    for (;;) {
        sum = 0u; cnt = 0u; mine = 0u;
#pragma unroll
        for (unsigned j = 0; j < 16; ++j) { const unsigned c = xb_ld(&bar[XB_XCNT(j)]); sum += c; cnt += (c > 0u) ? 1u : 0u; mine = (j == x) ? c : mine; }
        if (sum == G) break;
        __builtin_amdgcn_s_sleep(1);
        if ((++sp & 255u) == 0u) { if (xb_ld(&bar[XB_TMO])) break; if (sp > XB_SPIN_CAP) { atomicAdd(&bar[XB_TMO], 1u); break; } }
    }
    nloc = mine > 0u ? mine : 1u; nx = cnt > 0u ? cnt : 1u;
}
__device__ __forceinline__ void xcd_barrier(const XcdBarrier& b) {
    asm volatile("s_waitcnt vmcnt(0)" ::: "memory");
    __syncthreads();
    if (threadIdx.x == 0) {
        unsigned* bar = b.bar;
        __builtin_amdgcn_s_waitcnt(0);
        unsigned nloc = b.st[0], nx = b.st[1];
        if (nloc == 0u) { xcd_barrier_complete(bar, b.x, nloc, nx); b.st[0] = nloc; b.st[1] = nx; }
        const unsigned old = xb_add(&bar[XB_XSUB(b.x)], 1u);
        const unsigned gen = old / nloc;
        if (old + 1u == (gen + 1u) * nloc) {
            __builtin_amdgcn_fence(__ATOMIC_RELEASE, "agent");
            asm volatile("s_waitcnt vmcnt(0)" ::: "memory");
            const unsigned og = xb_add(&bar[XB_TOP], 1u);
            const unsigned tg = og / nx;
            if (og + 1u == (tg + 1u) * nx) xb_add(&bar[XB_TOPGEN], 1u);
            else XB_SPIN(xb_ld(&bar[XB_TOPGEN]) == tg, bar);
            __builtin_amdgcn_fence(__ATOMIC_ACQUIRE, "agent");
            xb_add(&bar[XB_XGEN(b.x)], 1u);
            asm volatile("s_waitcnt vmcnt(0)" ::: "memory");
        } else {
            XB_SPIN(xb_ld(&bar[XB_XGEN(b.x)]) == gen, bar);
            __builtin_amdgcn_fence(__ATOMIC_ACQUIRE, "agent");
            asm volatile("s_waitcnt vmcnt(0)" ::: "memory");
        }
    }
    __syncthreads();
}

struct Args { const float* in[26]; float* out; unsigned char* ws; };
struct Frame {
    LAS unsigned char* lds;
    int tid, lane, wave, G, vcu;
    const float* const* in; float* out; unsigned char* ws;
};
__device__ __forceinline__ float wave_sum(float v) {
#pragma unroll
    for (int o = 1; o < 64; o <<= 1) v += __shfl_xor(v, o);
    return v;
}

__device__ __forceinline__ void fresh(Frame& F) { int t = threadIdx.x; asm volatile("" : "+v"(t)); F.tid = t; F.lane = t & 63; F.wave = __builtin_amdgcn_readfirstlane(t >> 6); }

__device__ __forceinline__ void conv_item(const float* W, int ldw, bf16* WT, int ldd, int k0, int n0, int drow0, const float* kscale, float gscale, LAS float* scr, int lane) {
#pragma unroll 8
    for (int i = 0; i < 32; ++i) { const int kk = 2 * i + (lane >> 5); float w = W[(size_t)(k0 + kk) * ldw + n0 + (lane & 31)]; if (kscale) w *= kscale[k0 + kk]; scr[kk * 33 + (lane & 31)] = w * gscale; }
    LDS_WAIT(); asm volatile("" ::: "memory");
    const int c = lane & 7;
#pragma unroll
    for (int j = 0; j < 4; ++j) { const int n = (lane >> 3) + 8 * j; const LAS float* s = scr + (8 * c) * 33 + n;
        v4u o; o.x = pk2(s[0 * 33], s[1 * 33]); o.y = pk2(s[2 * 33], s[3 * 33]); o.z = pk2(s[4 * 33], s[5 * 33]); o.w = pk2(s[6 * 33], s[7 * 33]);
        *(v4u*)(WT + (size_t)(drow0 + n) * ldd + k0 + 8 * c) = o; }
    LDS_WAIT(); asm volatile("" ::: "memory");
}
__device__ __forceinline__ int conv_rowmap(int mode, int n0, int off) {
    if (mode == 0) return n0 + off;
    if (mode == 1) { if (n0 < 384) return n0; if (n0 < 640) return 512 + (n0 - 384); if (n0 < 672) return 384; return 768 + (n0 - 672); }
    return 256 * (n0 >> 7) + (n0 & 127) + off;
}
__device__ __forceinline__ void conv_matrix(Frame& F, const float* W, int K, int N, bf16* WT, int ldd, int mode, int off, const float* kscale, float gscale) {
    LAS float* scr = (LAS float*)(F.lds + RING_OFF + F.wave * 16384);
    const int gw = F.vcu * NWAVES + F.wave, NGW = F.G * NWAVES;
    const int nblk = N / 32, nitems = (K / 64) * nblk;
    for (int it = gw; it < nitems; it += NGW) { const int kb = it / nblk, nb = it % nblk; conv_item(W, N, WT, ldd, 64 * kb, 32 * nb, conv_rowmap(mode, 32 * nb, off), kscale, gscale, scr, F.lane); }
}

__device__ __forceinline__ int row_bidx(int row) { return row < M ? row / SEQ : NB; }

struct RowArgs {
    const float* hin_l; const float* hin_c; float* hout_l; float* hout_c;
    const float* g;
    const float* modl;
    int shoff, scoff;
    bf16* U;
    const bf16* Y; const int* pos; const float* gate; const float* modprev;
    const float* router; int* eidx; float* gout; int* cnt;
};
template <bool COMBINE, int OUTMODE, bool ROUTER>
__device__ __forceinline__ void row_phase(Frame& F, const RowArgs& A, int nrows) {
    fresh(F);
    const int rpw = (nrows + F.G - 1) / F.G;
    LAS int* lcnt = (LAS int*)(F.lds + RING_OFF);
    if (ROUTER) { if (F.tid < 8) lcnt[F.tid] = 0; __syncthreads(); }
    for (int i = F.wave; i < rpw; i += NWAVES) {
        const int row = (int)blockIdx.x * rpw + i; if (row >= nrows) break;
        const bool lat = row < M; const int bidx = lat ? row / SEQ : NB;
        const float* hr = lat ? A.hin_l + (size_t)row * DM : A.hin_c + (size_t)(row - M) * DM;
        f32x4 v[4];
#pragma unroll
        for (int j = 0; j < 4; ++j) v[j] = *(const f32x4*)(hr + 4 * F.lane + 256 * j);
        if (COMBINE) {
            const int pa = A.pos[2 * row], pb = A.pos[2 * row + 1]; const float ga = A.gate[2 * row], gb = A.gate[2 * row + 1];
            const float* g2 = A.modprev + bidx * NMOD + 5 * DM;
#pragma unroll
            for (int j = 0; j < 4; ++j) { const int col = 4 * F.lane + 256 * j;
                const v2u ya = *(const v2u*)(A.Y + (size_t)pa * DM + col), yb = *(const v2u*)(A.Y + (size_t)pb * DM + col); const f32x4 gv = *(const f32x4*)(g2 + col);
                v[j].x += gv.x * (ga * bflo(ya.x) + gb * bflo(yb.x)); v[j].y += gv.y * (ga * bfhi(ya.x) + gb * bfhi(yb.x));
                v[j].z += gv.z * (ga * bflo(ya.y) + gb * bflo(yb.y)); v[j].w += gv.w * (ga * bfhi(ya.y) + gb * bfhi(yb.y)); }
            if (OUTMODE != 2) { float* ho = lat ? A.hout_l + (size_t)row * DM : A.hout_c + (size_t)(row - M) * DM;
#pragma unroll
                for (int j = 0; j < 4; ++j) *(f32x4*)(ho + 4 * F.lane + 256 * j) = v[j]; }
        }
        float s = 0.f;
#pragma unroll
        for (int j = 0; j < 4; ++j) s += (v[j].x * v[j].x + v[j].y * v[j].y) + (v[j].z * v[j].z + v[j].w * v[j].w);
        const float rstd = rsqrtf(wave_sum(s) * (1.0f / DM) + EPS);
        if (OUTMODE == 2) {
            float* ho = A.hout_l + (size_t)row * DM;
#pragma unroll
            for (int j = 0; j < 4; ++j) { const int col = 4 * F.lane + 256 * j; const f32x4 gv = *(const f32x4*)(A.g + col); *(f32x4*)(ho + col) = v[j] * rstd * gv; }
        } else {
            const float* sh = A.modl + bidx * NMOD + A.shoff; const float* sc = A.modl + bidx * NMOD + A.scoff;
            float lg[8];
            if (ROUTER) {
#pragma unroll
                for (int e = 0; e < 8; ++e) lg[e] = 0.f;
            }
#pragma unroll
            for (int j = 0; j < 4; ++j) { const int col = 4 * F.lane + 256 * j; const f32x4 gv = *(const f32x4*)(A.g + col), shv = *(const f32x4*)(sh + col), scv = *(const f32x4*)(sc + col);
                f32x4 y = v[j] * rstd * gv * (scv + 1.0f) + shv;
                v2u o; o.x = pk2(y.x, y.y); o.y = pk2(y.z, y.w); *(v2u*)(A.U + (size_t)row * DM + col) = o;
                if (ROUTER) {
#pragma unroll
                    for (int q = 0; q < 4; ++q) { const f32x4 r0 = *(const f32x4*)(A.router + (size_t)(col + q) * 8), r1 = *(const f32x4*)(A.router + (size_t)(col + q) * 8 + 4); const float yy = y[q];
                        lg[0] += yy * r0.x; lg[1] += yy * r0.y; lg[2] += yy * r0.z; lg[3] += yy * r0.w; lg[4] += yy * r1.x; lg[5] += yy * r1.y; lg[6] += yy * r1.z; lg[7] += yy * r1.w; } }
            }
            if (ROUTER) {
#pragma unroll
                for (int e = 0; e < 8; ++e) lg[e] = wave_sum(lg[e]);
                int i0 = 0; float v0 = lg[0];
#pragma unroll
                for (int e = 1; e < 8; ++e) if (lg[e] > v0) { v0 = lg[e]; i0 = e; }
                int i1 = -1; float v1 = -INFINITY;
#pragma unroll
                for (int e = 0; e < 8; ++e) if (e != i0 && lg[e] > v1) { v1 = lg[e]; i1 = e; }
                const float g0 = 1.0f / (1.0f + __expf(v1 - v0));
                if (F.lane == 0) { A.eidx[2 * row] = i0; A.eidx[2 * row + 1] = i1; A.gout[2 * row] = g0; A.gout[2 * row + 1] = 1.0f - g0; atomicAdd((int*)&lcnt[i0], 1); atomicAdd((int*)&lcnt[i1], 1); }
            }
        }
    }
    if (ROUTER) { __syncthreads(); if (F.tid < 8) A.cnt[blockIdx.x * 8 + F.tid] = lcnt[F.tid]; __syncthreads(); }
}

using pg8::Unit; using pg8::cvt_pk_bf16;
__device__ __forceinline__ v4u pack8(const f32x4& a, const f32x4& b) { v4u w; w.x = cvt_pk_bf16(a[0], a[1]); w.y = cvt_pk_bf16(a[2], a[3]); w.z = cvt_pk_bf16(b[0], b[1]); w.w = cvt_pk_bf16(b[2], b[3]); return w; }
struct EpiIn {
    static constexpr bool PERM = true;
    bf16 *CQ, *KR, *CKV, *H5;
    __device__ __forceinline__ void operator()(const f32x4 (&acc)[2][2][4][2], const Unit& u, int wr, int wc, int fr, int fq) const {
        const int row0 = u.pm * 256 + wr * 64 + fr;
#pragma unroll
        for (int bj = 0; bj < 2; ++bj) {
            const int col = u.pn * 256 + bj * 128 + wc * 32 + 8 * fq;
            bf16* base; int ld;
            if (col < 384) { base = CQ + col; ld = QL; }
            else if (col < 416) { base = KR + (col - 384); ld = ROPE; }
            else if (col < 512) { base = nullptr; ld = 0; }
            else if (col < 768) { base = CKV + (col - 512); ld = KVL; }
            else { const int c2 = col - 768; base = H5 + (size_t)(c2 >> 9) * HSEG + (c2 & 511); ld = HW; }
            if (base) {
#pragma unroll
                for (int ai = 0; ai < 2; ++ai)
#pragma unroll
                    for (int m = 0; m < 4; ++m) { const int row = row0 + ai * 128 + m * 16; *(v4u*)(base + (size_t)row * ld) = pack8(acc[ai][bj][m][0], acc[ai][bj][m][1]); }
            }
        }
    }
};
struct EpiQ {
    static constexpr bool PERM = true;
    bf16* O; const float* rs;
    __device__ __forceinline__ void operator()(const f32x4 (&acc)[2][2][4][2], const Unit& u, int wr, int wc, int fr, int fq) const {
        const int row0 = u.pm * 256 + wr * 64 + fr;
#pragma unroll
        for (int ai = 0; ai < 2; ++ai)
#pragma unroll
            for (int m = 0; m < 4; ++m) { const int row = row0 + ai * 128 + m * 16; const float sc = rs[row];
#pragma unroll
                for (int bj = 0; bj < 2; ++bj) { const int col = u.pn * 256 + bj * 128 + wc * 32 + 8 * fq; *(v4u*)(O + (size_t)row * 768 + col) = pack8(acc[ai][bj][m][0] * sc, acc[ai][bj][m][1] * sc); } }
    }
};
struct EpiKV {
    static constexpr bool PERM = true;
    bf16* KNp; bf16* VTp; const float* rs;
    __device__ __forceinline__ void operator()(const f32x4 (&acc)[2][2][4][2], const Unit& u, int wr, int wc, int fr, int fq) const {
        const int row0 = u.pm * 256 + wr * 64 + fr;
#pragma unroll
        for (int ai = 0; ai < 2; ++ai)
#pragma unroll
            for (int m = 0; m < 4; ++m) { const int row = row0 + ai * 128 + m * 16; const float sc = rs[row];
                const bool lat = row < M; const int b = lat ? row / SEQ : (row - M) / CTXL; const int key = lat ? row % SEQ : SEQ + (row - M) % CTXL;
                const int kpos = (key & ~12) | ((key & 4) << 1) | ((key & 8) >> 1);
#pragma unroll
                for (int bj = 0; bj < 2; ++bj) { const int col = u.pn * 256 + bj * 128 + wc * 32 + 8 * fq; const int hh = col >> 7, w = col & 127;
                    if (w < 64) { *(v4u*)(KNp + (size_t)row * HW + hh * 64 + w) = pack8(acc[ai][bj][m][0] * sc, acc[ai][bj][m][1] * sc); }
                    else { bf16* dst = VTp + ((size_t)((b * NH + hh) * VD + (w - 64))) * NKEY + kpos;
#pragma unroll
                        for (int n = 0; n < 2; ++n)
#pragma unroll
                            for (int q = 0; q < 4; ++q) dst[(size_t)(4 * n + q) * NKEY] = (bf16)f2bf(acc[ai][bj][m][n][q] * sc); } } }
    }
};
struct EpiResid {
    static constexpr bool PERM = false;
    const float* hin_l; const float* hin_c; float* hout_l; float* hout_c; const float* modl; int goff;
    __device__ __forceinline__ void operator()(const f32x4 (&acc)[2][2][4][2], const Unit& u, int wr, int wc, int fr, int fq) const {
        const int rowt = u.pm * 256; const bool lat = rowt < M; const int bidx = lat ? rowt / SEQ : NB;
        const float* gate = modl + bidx * NMOD + goff;
        const float* hi = lat ? hin_l + (size_t)rowt * DM : hin_c + (size_t)(rowt - M) * DM;
        float* ho = lat ? hout_l + (size_t)rowt * DM : hout_c + (size_t)(rowt - M) * DM;
        const int col0 = u.pn * 256 + wc * 32 + 4 * fq;
#pragma unroll
        for (int bj = 0; bj < 2; ++bj)
#pragma unroll
            for (int n = 0; n < 2; ++n) { const f32x4 gv = *(const f32x4*)(gate + col0 + bj * 128 + n * 16);
#pragma unroll
                for (int ai = 0; ai < 2; ++ai)
#pragma unroll
                    for (int m = 0; m < 4; ++m) { const int r = ai * 128 + wr * 64 + m * 16 + fr; const size_t off = (size_t)r * DM + col0 + bj * 128 + n * 16; const f32x4 hv = *(const f32x4*)(hi + off); *(f32x4*)(ho + off) = hv + gv * acc[ai][bj][m][n]; }
                asm volatile("" ::: "memory"); }
    }
};
struct EpiPool {
    static constexpr bool PERM = false;
    float* h_l; float* h_c; const float* modl; const float* bias; const float* scale; int talloc;
    __device__ __forceinline__ void operator()(const f32x4 (&acc)[2][2][4][2], const Unit& u, int wr, int wc, int fr, int fq) const {
        const int g = u.pn, rowt = (u.pm - g * talloc) * 256; const bool lat = rowt < M; const int bidx = lat ? rowt / SEQ : NB;
        const float* gate = modl + bidx * NMOD + 2 * DM;
        float* ho = lat ? h_l + (size_t)rowt * DM : h_c + (size_t)(rowt - M) * DM;
        const int col0 = g * 256 + wc * 32 + 4 * fq;
#pragma unroll
        for (int bj = 0; bj < 2; ++bj)
#pragma unroll
            for (int n = 0; n < 2; ++n) { const int c = col0 + bj * 128 + n * 16; const f32x4 gm = *(const f32x4*)(gate + c) * *(const f32x4*)(scale + c); const f32x4 gb = gm * *(const f32x4*)(bias + c);
#pragma unroll
                for (int ai = 0; ai < 2; ++ai)
#pragma unroll
                    for (int m = 0; m < 4; ++m) { const int r = ai * 128 + wr * 64 + m * 16 + fr; const size_t off = (size_t)r * DM + c; const f32x4 hv = *(const f32x4*)(ho + off); *(f32x4*)(ho + off) = hv + gm * acc[ai][bj][m][n] + gb; }
                asm volatile("" ::: "memory"); }
    }
};
struct EpiGateUp {
    static constexpr bool PERM = true;
    bf16* H; int ldh, nct, rowsub;
    __device__ __forceinline__ void operator()(const f32x4 (&acc)[2][2][4][2], const Unit& u, int wr, int wc, int fr, int fq) const {
        const int row0 = u.pm * 256 + wr * 64 + fr - rowsub; const int ct = u.pn % nct; const int col = ct * 128 + wc * 32 + 8 * fq;
#pragma unroll
        for (int ai = 0; ai < 2; ++ai)
#pragma unroll
            for (int m = 0; m < 4; ++m) { const int row = row0 + ai * 128 + m * 16; f32x4 o[2];
#pragma unroll
                for (int n = 0; n < 2; ++n)
#pragma unroll
                    for (int q = 0; q < 4; ++q) { const float gv = acc[ai][0][m][n][q], uv = acc[ai][1][m][n][q]; o[n][q] = gv * uv / (1.0f + __expf(-gv)); }
                *(v4u*)(H + (size_t)row * ldh + col) = pack8(o[0], o[1]); }
    }
};
struct EpiY {
    static constexpr bool PERM = true;
    bf16* Y; int nct;
    __device__ __forceinline__ void operator()(const f32x4 (&acc)[2][2][4][2], const Unit& u, int wr, int wc, int fr, int fq) const {
        const int row0 = u.pm * 256 + wr * 64 + fr; const int ct = u.pn % nct;
#pragma unroll
        for (int ai = 0; ai < 2; ++ai)
#pragma unroll
            for (int m = 0; m < 4; ++m) { const int row = row0 + ai * 128 + m * 16;
#pragma unroll
                for (int bj = 0; bj < 2; ++bj) { const int col = ct * 256 + bj * 128 + wc * 32 + 8 * fq; *(v4u*)(Y + (size_t)row * DM + col) = pack8(acc[ai][bj][m][0], acc[ai][bj][m][1]); } }
    }
};

__device__ __forceinline__ void p0_prologue(Frame& F) {
    fresh(F);
    unsigned char* ws = F.ws;
    const float qscale = 0.10206207261596577f * 1.4426950408889634f;
    for (int j = 0; j < 2; ++j) {
        conv_matrix(F, F.in[8] + (size_t)j * DM * INW, DM, INW, (bf16*)(ws + WS_WIN) + (size_t)j * INP * DM, DM, 1, 0, nullptr, 1.f);
        conv_matrix(F, F.in[11] + (size_t)j * QL * 768, QL, 768, (bf16*)(ws + WS_WUQ) + (size_t)j * 768 * QL, QL, 0, 0, F.in[9] + j * QL, qscale);
        conv_matrix(F, F.in[12] + (size_t)j * KVL * 1024, KVL, 1024, (bf16*)(ws + WS_WUKV) + (size_t)j * 1024 * KVL, KVL, 0, 0, F.in[10] + j * KVL, 1.f);
        conv_matrix(F, F.in[15] + (size_t)j * DM * DM, DM, DM, (bf16*)(ws + WS_WOUT) + (size_t)j * DM * DM, DM, 0, 0, nullptr, 1.f);
        conv_matrix(F, F.in[16] + (size_t)j * DM * DFF, DM, DFF, (bf16*)(ws + WS_WGU) + (size_t)j * 2 * DFF * DM, DM, 2, 0, nullptr, 1.f);
        conv_matrix(F, F.in[17] + (size_t)j * DM * DFF, DM, DFF, (bf16*)(ws + WS_WGU) + (size_t)j * 2 * DFF * DM, DM, 2, 128, nullptr, 1.f);
        conv_matrix(F, F.in[18] + (size_t)j * DFF * DM, DFF, DM, (bf16*)(ws + WS_WDN) + (size_t)j * DM * DFF, DFF, 0, 0, nullptr, 1.f);
        for (int g = 0; g < 4; ++g)
            conv_matrix(F, F.in[19] + (size_t)(j * 4 + g) * 65536, 256, 256, (bf16*)(ws + WS_WPOOL) + (size_t)(j * 4 + g) * 65536, 256, 0, 0, nullptr, 1.f);
    }
    __syncthreads();
    if (blockIdx.x == 0 && F.tid < 8) {
        float* TC = (float*)(ws + WS_ROPE); float* TS = TC + 512;
        double th = 1.0; for (int i = 0; i < F.tid; ++i) th *= 0.31622776601683794;
        const double x2 = th * th; double s = th, c = 1.0, ts = th, tc = 1.0;
        for (int n = 1; n <= 12; ++n) { tc *= -x2 / (double)((2 * n - 1) * (2 * n)); c += tc; ts *= -x2 / (double)((2 * n) * (2 * n + 1)); s += ts; }
        double cp = 1.0, sp = 0.0;
        for (int p = 0; p < 64; ++p) { TC[p * 8 + F.tid] = (float)cp; TS[p * 8 + F.tid] = (float)sp; const double ncp = cp * c - sp * s; sp = sp * c + cp * s; cp = ncp; }
    }
    {
        LAS float* sc = (LAS float*)(F.lds + RING_OFF);
        LAS float* red = sc + 17 * 1024;
        const int nitems = 4 * (NMOD / 64);
        if ((int)blockIdx.x < nitems) {
            for (int e = F.tid; e < 17 * 1024; e += 512) { const int r = e >> 10, k = e & 1023; const float x = (r < 16) ? F.in[1][r * 1024 + k] : F.in[3][k]; sc[e] = siluf_(x); }
            __syncthreads();
            for (int it = blockIdx.x; it < nitems; it += F.G) {
                const int l = it / (NMOD / 64), c0 = (it % (NMOD / 64)) * 64;
                const float* W = F.in[4] + (size_t)l * DM * NMOD + c0 + F.lane;
                float acc[17];
#pragma unroll
                for (int r = 0; r < 17; ++r) acc[r] = 0.f;
                const int kb = F.wave * 128;
                for (int k = 0; k < 128; k += 4) {
                    const float w0 = W[(size_t)(kb + k) * NMOD], w1 = W[(size_t)(kb + k + 1) * NMOD], w2 = W[(size_t)(kb + k + 2) * NMOD], w3 = W[(size_t)(kb + k + 3) * NMOD];
#pragma unroll
                    for (int r = 0; r < 17; ++r) { const f32x4 s4 = *(const LAS f32x4*)(sc + r * 1024 + kb + k); acc[r] += s4.x * w0 + s4.y * w1 + s4.z * w2 + s4.w * w3; }
                }
#pragma unroll
                for (int r = 0; r < 17; ++r) red[(F.wave * 17 + r) * 64 + F.lane] = acc[r];
                __syncthreads();
                for (int o = F.tid; o < 17 * 64; o += 512) { const int r = o >> 6, cc = o & 63; float s = 0.f;
#pragma unroll
                    for (int w = 0; w < 8; ++w) s += red[(w * 17 + r) * 64 + cc];
                    ((float*)(ws + WS_MODV))[(size_t)(l * 17 + r) * NMOD + c0 + cc] = s + F.in[5][l * NMOD + c0 + cc]; }
                __syncthreads();
            }
        }
    }
}

__device__ __forceinline__ void e3_phase(Frame& F) {
    fresh(F);
    unsigned char* ws = F.ws;
    const bf16* CQ = (const bf16*)(ws + WS_CQ); const bf16* CKV = (const bf16*)(ws + WS_CKV); const bf16* KR = (const bf16*)(ws + WS_KR); bf16* KRR = (bf16*)(ws + WS_KRR);
    float* RSQ = (float*)(ws + WS_RSQ); float* RSKV = (float*)(ws + WS_RSKV); const float* TC = (const float*)(ws + WS_ROPE); const float* TS = TC + 512;
    const int rpw = (MT + F.G - 1) / F.G;
    for (int i = F.wave; i < rpw; i += NWAVES) {
        const int row = (int)blockIdx.x * rpw + i; if (row >= MT) break;
        float s = 0.f;
        if (F.lane < 48) { const v4u w = *(const v4u*)(CQ + (size_t)row * QL + F.lane * 8);
            s = bflo(w.x) * bflo(w.x) + bfhi(w.x) * bfhi(w.x) + bflo(w.y) * bflo(w.y) + bfhi(w.y) * bfhi(w.y) + bflo(w.z) * bflo(w.z) + bfhi(w.z) * bfhi(w.z) + bflo(w.w) * bflo(w.w) + bfhi(w.w) * bfhi(w.w); }
        s = wave_sum(s); if (F.lane == 0) RSQ[row] = rsqrtf(s * (1.0f / QL) + EPS);
        s = 0.f;
        if (F.lane < 32) { const v4u w = *(const v4u*)(CKV + (size_t)row * KVL + F.lane * 8);
            s = bflo(w.x) * bflo(w.x) + bfhi(w.x) * bfhi(w.x) + bflo(w.y) * bflo(w.y) + bfhi(w.y) * bfhi(w.y) + bflo(w.z) * bflo(w.z) + bfhi(w.z) * bfhi(w.z) + bflo(w.w) * bflo(w.w) + bfhi(w.w) * bfhi(w.w); }
        s = wave_sum(s); if (F.lane == 0) RSKV[row] = rsqrtf(s * (1.0f / KVL) + EPS);
        const float x = (F.lane < 32) ? bf2f(KR[(size_t)row * ROPE + F.lane]) : 0.f; const float pr = __shfl_xor(x, 8);
        float o = x;
        if (row < M) { const int t = row % SEQ; const int p = ((F.lane >> 4) & 1) ? (t & 63) : (t >> 6); const int j = F.lane & 7; const float c = TC[p * 8 + j], sn = TS[p * 8 + j];
            o = ((F.lane >> 3) & 1) ? x * c + pr * sn : x * c - pr * sn; }
        if (F.lane < 32) KRR[(size_t)row * ROPE + F.lane] = (bf16)f2bf(o);
    }
}

typedef short bf16x8v __attribute__((ext_vector_type(8)));
typedef float f32x16 __attribute__((ext_vector_type(16)));
__device__ __forceinline__ void attn_unit(Frame& F, int b, int h, int qrow0, bool rope_q, int t_lo, int t_hi) {
    unsigned char* ws = F.ws;
    const bf16* QB = (const bf16*)(ws + WS_QB); const bf16* KN = (const bf16*)(ws + WS_KN); const bf16* KRR = (const bf16*)(ws + WS_KRR); const bf16* VT = (const bf16*)(ws + WS_VV);
    bf16* MIX = (bf16*)(ws + WS_MIX); const float* TC = (const float*)(ws + WS_ROPE); const float* TS = TC + 512;
    const int lane = F.lane, wave = F.wave, r32 = lane & 31, hi = lane >> 5;
    LAS unsigned char* ring = F.lds + RING_OFF;
    const int qrow = qrow0 + wave * 32 + r32;
    bf16x8v qr[6];
#pragma unroll
    for (int d0 = 0; d0 < 6; ++d0) qr[d0] = *(const bf16x8v*)(QB + (size_t)qrow * 768 + h * QKD + 16 * d0 + 8 * hi);
    if (rope_q) { const int t = qrow % SEQ;
#pragma unroll
        for (int a = 0; a < 2; ++a) { const int p = a ? (t & 63) : (t >> 6); const v4u w = __builtin_bit_cast(v4u, qr[4 + a]); float x[8], y[8];
            x[0] = bflo(w.x); x[1] = bfhi(w.x); x[2] = bflo(w.y); x[3] = bfhi(w.y); x[4] = bflo(w.z); x[5] = bfhi(w.z); x[6] = bflo(w.w); x[7] = bfhi(w.w);
#pragma unroll
            for (int jj = 0; jj < 8; ++jj) { const float pr = __shfl_xor(x[jj], 32); const float c = TC[p * 8 + jj], sn = TS[p * 8 + jj]; y[jj] = hi ? x[jj] * c + pr * sn : x[jj] * c - pr * sn; }
            v4u o; o.x = pk2(y[0], y[1]); o.y = pk2(y[2], y[3]); o.z = pk2(y[4], y[5]); o.w = pk2(y[6], y[7]); qr[4 + a] = __builtin_bit_cast(bf16x8v, o); } }
    const int bh = b * NH + h;
    const bf16* vsrc = VT + ((size_t)(bh * VD + lane)) * NKEY + 8 * wave;
#define ATT_DMA(t, buf) do { const int t_ = (t); const int r0_ = t_ < SEQ / 64 ? b * SEQ + 64 * t_ : M + b * CTXL + 64 * (t_ - SEQ / 64); \
        LAS unsigned char* kb_ = ring + (buf) * 12288; LAS unsigned char* vb_ = ring + 24576 + (buf) * 8192; \
        __builtin_amdgcn_global_load_lds((const unsigned*)(KN + (size_t)(r0_ + lane) * HW + h * 64 + 8 * wave), (LAS unsigned*)(kb_ + wave * 1024), 16, 0, 0); \
        if (wave < 4) __builtin_amdgcn_global_load_lds((const unsigned*)(KRR + (size_t)(r0_ + lane) * ROPE + 8 * wave), (LAS unsigned*)(kb_ + (8 + wave) * 1024), 16, 0, 0); \
        __builtin_amdgcn_global_load_lds((const unsigned*)(vsrc + 64 * t_), (LAS unsigned*)(vb_ + wave * 1024), 16, 0, 0); } while (0)
    f32x16 o0, o1;
#pragma unroll
    for (int r = 0; r < 16; ++r) { o0[r] = 0.f; o1[r] = 0.f; }
    float m_run = -INFINITY, l_run = 0.f;
    ATT_DMA(t_lo, 0);
    for (int t = t_lo; t < t_hi; ++t) {
        const int buf = (t - t_lo) & 1;
        asm volatile("s_waitcnt vmcnt(0)" ::: "memory"); __syncthreads();
        if (t + 1 < t_hi) ATT_DMA(t + 1, buf ^ 1);
        const LAS unsigned char* kb = ring + buf * 12288 + hi * 1024 + r32 * 16; const LAS unsigned char* vb = ring + 24576 + buf * 8192 + hi * 1024 + r32 * 16;
        f32x16 p0, p1;
#pragma unroll
        for (int r = 0; r < 16; ++r) { p0[r] = 0.f; p1[r] = 0.f; }
#pragma unroll
        for (int d0 = 0; d0 < 6; ++d0) { const bf16x8v k0 = *(const LAS bf16x8v*)(kb + d0 * 2048), k1 = *(const LAS bf16x8v*)(kb + d0 * 2048 + 512);
            p0 = __builtin_amdgcn_mfma_f32_32x32x16_bf16(k0, qr[d0], p0, 0, 0, 0); p1 = __builtin_amdgcn_mfma_f32_32x32x16_bf16(k1, qr[d0], p1, 0, 0, 0); }
        float mt = fmaxf(p0[0], p1[0]);
#pragma unroll
        for (int r = 1; r < 16; ++r) mt = fmaxf(mt, fmaxf(p0[r], p1[r]));
        mt = fmaxf(mt, __shfl_xor(mt, 32));
        const float mn = fmaxf(m_run, mt); const float alpha = __builtin_amdgcn_exp2f(m_run - mn); m_run = mn;
        float ps = 0.f;
#pragma unroll
        for (int r = 0; r < 16; ++r) { p0[r] = __builtin_amdgcn_exp2f(p0[r] - mn); p1[r] = __builtin_amdgcn_exp2f(p1[r] - mn); ps += p0[r] + p1[r]; }
        l_run = l_run * alpha + ps;
#pragma unroll
        for (int r = 0; r < 16; ++r) { o0[r] *= alpha; o1[r] *= alpha; }
        v4u pw[4];
#pragma unroll
        for (int q = 0; q < 4; ++q) { pw[0][q] = cvt_pk_bf16(p0[2 * q], p0[2 * q + 1]); pw[1][q] = cvt_pk_bf16(p0[8 + 2 * q], p0[8 + 2 * q + 1]); pw[2][q] = cvt_pk_bf16(p1[2 * q], p1[2 * q + 1]); pw[3][q] = cvt_pk_bf16(p1[8 + 2 * q], p1[8 + 2 * q + 1]); }
#pragma unroll
        for (int s4 = 0; s4 < 4; ++s4) { const bf16x8v pa = __builtin_bit_cast(bf16x8v, pw[s4]);
            const bf16x8v v0 = *(const LAS bf16x8v*)(vb + s4 * 2048), v1 = *(const LAS bf16x8v*)(vb + s4 * 2048 + 512);
            o0 = __builtin_amdgcn_mfma_f32_32x32x16_bf16(v0, pa, o0, 0, 0, 0); o1 = __builtin_amdgcn_mfma_f32_32x32x16_bf16(v1, pa, o1, 0, 0, 0); }
    }
    l_run += __shfl_xor(l_run, 32);
    const float rl = 1.0f / l_run;
    bf16* orow = MIX + (size_t)qrow * DM + h * VD;
#pragma unroll
    for (int g = 0; g < 4; ++g) { v2u a, c2; a.x = pk2(o0[4 * g] * rl, o0[4 * g + 1] * rl); a.y = pk2(o0[4 * g + 2] * rl, o0[4 * g + 3] * rl); c2.x = pk2(o1[4 * g] * rl, o1[4 * g + 1] * rl); c2.y = pk2(o1[4 * g + 2] * rl, o1[4 * g + 3] * rl);
        *(v2u*)(orow + 8 * g + 4 * hi) = a; *(v2u*)(orow + 32 + 8 * g + 4 * hi) = c2; }
    __syncthreads();
#undef ATT_DMA
}
__device__ __forceinline__ void attn_phase(Frame& F, bool ctx_out) {
    fresh(F);
    const int nlat = NB * NH * 8, nctx = ctx_out ? NB * NH : 0;
    const int per = (nlat + F.G - 1) / F.G;
    for (int i = 0; i < per; ++i) { const int it = F.vcu * per + i; if (it >= nlat) break; const int bh = it >> 3, qb = it & 7; attn_unit(F, bh >> 3, bh & 7, (bh >> 3) * SEQ + qb * 256, true, 0, NKEY / 64); }
    for (int it = F.vcu; it < nctx; it += F.G) attn_unit(F, it >> 3, it & 7, M + (it >> 3) * CTXL, false, SEQ / 64, NKEY / 64);
    __syncthreads();
}

__device__ __forceinline__ int hgrn_row(int b, int dir, int ig) { return (ig < CTXL) ? (M + b * CTXL + (dir ? CTXL - 1 - ig : ig)) : (b * SEQ + (dir ? SEQ - 1 - (ig - CTXL) : (ig - CTXL))); }
__device__ __forceinline__ void hgrn_phase(Frame& F, int j) {
    fresh(F);
    unsigned char* ws = F.ws;
    const bf16* HQ = (const bf16*)(ws + WS_HQ); const bf16* HFF = HQ + HSEG; const bf16* HFB = HQ + 2 * HSEG; const bf16* HI = HQ + 3 * HSEG;
    float* OF = (float*)(ws + WS_OF); float* OB = (float*)(ws + WS_OB);
    LAS unsigned char* ring = F.lds + RING_OFF;
    LAS unsigned char* QN = ring; LAS unsigned char* KN = ring + 17408; LAS unsigned char* KT = ring + 34816; LAS unsigned char* VT = ring + 53248; LAS unsigned char* ST = ring + 62464;
    LAS float* TOT = (LAS float*)(ring + 79872);
    LAS unsigned char* RQ = ring + 81920; LAS unsigned char* RF = ring + 98304; LAS unsigned char* RV = ring + 114688;
    const int tid = F.tid, lane = F.lane, wave = F.wave, r32 = lane & 31, hi = lane >> 5;
    const int k = tid & 127, part = tid >> 7;
    const int kb = wave >> 1, vb = wave & 1;
    for (int it = blockIdx.x; it < NB * NHH * 2 * 2; it += F.G) {
        const int vh = it & 1, dir = (it >> 1) & 1, hh = (it >> 2) & 3, b = it >> 4;
        const bf16* HF = dir ? HFB : HFF; float* OO = dir ? OB : OF;
        float lb = 0.f; if (j == 1) { const int ci = dir * HW + hh * HK + k; const float l0 = F.in[13][ci], l1 = F.in[13][2 * HW + ci]; lb = 1.0f / (1.0f + __expf(l0 - l1)); }
        const float oml = 1.0f - lb;
        f32x16 S;
#pragma unroll
        for (int r = 0; r < 16; ++r) S[r] = 0.f;
#define LBAR() do { asm volatile("s_waitcnt lgkmcnt(0)" ::: "memory"); __builtin_amdgcn_s_barrier(); asm volatile("" ::: "memory"); } while (0)
#define HG_BASE(c_) ((c_) < CTXL / 64 ? M + b * CTXL + (dir ? CTXL - 64 - 64 * (c_) : 64 * (c_)) : b * SEQ + (dir ? SEQ - 64 - 64 * ((c_) - CTXL / 64) : 64 * ((c_) - CTXL / 64)))
#define HG_DMA(c_) do { const int rb_ = HG_BASE(c_); \
            _Pragma("unroll") for (int p_ = 0; p_ < 2; ++p_) { const int pc_ = wave * 2 + p_; const size_t go_ = (size_t)(rb_ + 4 * pc_ + (lane >> 4)) * HW + hh * HK + 8 * (lane & 15); \
                __builtin_amdgcn_global_load_lds((const unsigned*)(HQ + go_), (LAS unsigned*)(RQ + pc_ * 1024), 16, 0, 0); __builtin_amdgcn_global_load_lds((const unsigned*)(HF + go_), (LAS unsigned*)(RF + pc_ * 1024), 16, 0, 0); } \
            __builtin_amdgcn_global_load_lds((const unsigned*)(HI + (size_t)(rb_ + 8 * wave + (lane >> 3)) * HW + hh * HK + vh * 64 + 8 * (lane & 7)), (LAS unsigned*)(RV + wave * 1024), 16, 0, 0); } while (0)
        HG_DMA(0);
        asm volatile("s_waitcnt vmcnt(0)" ::: "memory"); LBAR();
        for (int ch = 0; ch < NKEY / 64; ++ch) {
            float qv[16], kin[16], cs[16]; float run = 0.f;
#pragma unroll
            for (int ii = 0; ii < 16; ++ii) { const int i = 16 * part + ii, mr = dir ? 63 - i : i; const float hq = bf2f(*(const LAS bf16*)(RQ + mr * 256 + k * 2)), hf = bf2f(*(const LAS bf16*)(RF + mr * 256 + k * 2));
                qv[ii] = hq * __builtin_amdgcn_rcpf(1.0f + __expf(-hq)); const float e = __expf(-hf), sg = __builtin_amdgcn_rcpf(1.0f + e); kin[ii] = oml * e * sg; run += __logf(lb + oml * sg); cs[ii] = run; }
            TOT[part * 128 + k] = run;
            { const int mr = dir ? 63 - lane : lane; const v4u w = *(const LAS v4u*)(RV + mr * 128 + wave * 16); const int pos = (lane & ~12) | ((lane & 4) << 1) | ((lane & 8) >> 1); LAS bf16* vt = (LAS bf16*)(VT + (8 * wave) * 144 + pos * 2);
              vt[0 * 72] = (bf16)(w.x & 0xffffu); vt[1 * 72] = (bf16)(w.x >> 16); vt[2 * 72] = (bf16)(w.y & 0xffffu); vt[3 * 72] = (bf16)(w.y >> 16);
              vt[4 * 72] = (bf16)(w.z & 0xffffu); vt[5 * 72] = (bf16)(w.z >> 16); vt[6 * 72] = (bf16)(w.w & 0xffffu); vt[7 * 72] = (bf16)(w.w >> 16); }
            LBAR();
            if (ch + 1 < NKEY / 64) HG_DMA(ch + 1);
            { const float t0 = TOT[k], t1 = TOT[128 + k], t2 = TOT[256 + k];
              const float base = (part > 0 ? t0 : 0.f) + (part > 1 ? t1 : 0.f) + (part > 2 ? t2 : 0.f); const float rr = t0 + t1;
              unsigned kt[8];
#pragma unroll
              for (int ii = 0; ii < 16; ii += 2) { float d0 = base + cs[ii] - rr, d1 = base + cs[ii + 1] - rr; d0 = fminf(fmaxf(d0, -80.f), 80.f); d1 = fminf(fmaxf(d1, -80.f), 80.f);
                  const float e0 = __expf(d0), e1 = __expf(d1); const float q0 = qv[ii] * e0, q1 = qv[ii + 1] * e1, k0 = kin[ii] * __builtin_amdgcn_rcpf(e0), k1 = kin[ii + 1] * __builtin_amdgcn_rcpf(e1);
                  const unsigned qp = cvt_pk_bf16(q0, q1), kp = cvt_pk_bf16(k0, k1);
                  *(LAS bf16*)(QN + (16 * part + ii) * 272 + k * 2) = (bf16)(qp & 0xffffu); *(LAS bf16*)(QN + (16 * part + ii + 1) * 272 + k * 2) = (bf16)(qp >> 16);
                  *(LAS bf16*)(KN + (16 * part + ii) * 272 + k * 2) = (bf16)(kp & 0xffffu); *(LAS bf16*)(KN + (16 * part + ii + 1) * 272 + k * 2) = (bf16)(kp >> 16);
                  kt[ii >> 1] = kp; }
              *(LAS v4u*)(KT + k * 144 + part * 32) = (v4u){kt[0], kt[1], kt[4], kt[5]}; *(LAS v4u*)(KT + k * 144 + part * 32 + 16) = (v4u){kt[2], kt[3], kt[6], kt[7]}; }
            f32x16 T;
#pragma unroll
            for (int g4 = 0; g4 < 4; ++g4) { const int kk = kb * 32 + 8 * g4 + 4 * hi; const f32x4 ta = *(const LAS f32x4*)(TOT + kk), tb = *(const LAS f32x4*)(TOT + 128 + kk);
                T[4 * g4] = S[4 * g4] * __expf(ta.x + tb.x); T[4 * g4 + 1] = S[4 * g4 + 1] * __expf(ta.y + tb.y); T[4 * g4 + 2] = S[4 * g4 + 2] * __expf(ta.z + tb.z); T[4 * g4 + 3] = S[4 * g4 + 3] * __expf(ta.w + tb.w);
                v2u o; o.x = cvt_pk_bf16(T[4 * g4], T[4 * g4 + 1]); o.y = cvt_pk_bf16(T[4 * g4 + 2], T[4 * g4 + 3]); *(LAS v2u*)(ST + (vb * 32 + r32) * 272 + kk * 2) = o; }
            LBAR();
            if (wave < 4) {
                const int ib = kb;
                bf16x8v qf[8];
#pragma unroll
                for (int ks = 0; ks < 8; ++ks) qf[ks] = *(const LAS bf16x8v*)(QN + (ib * 32 + r32) * 272 + ks * 32 + hi * 16);
                f32x16 O;
#pragma unroll
                for (int r = 0; r < 16; ++r) O[r] = 0.f;
#pragma unroll
                for (int ks = 0; ks < 8; ++ks) { const bf16x8v sf = *(const LAS bf16x8v*)(ST + (vb * 32 + r32) * 272 + ks * 32 + hi * 16); O = __builtin_amdgcn_mfma_f32_32x32x16_bf16(qf[ks], sf, O, 0, 0, 0); }
                for (int sb = 0; sb <= ib; ++sb) {
                    f32x16 X;
#pragma unroll
                    for (int r = 0; r < 16; ++r) X[r] = 0.f;
#pragma unroll
                    for (int ks = 0; ks < 8; ++ks) { const bf16x8v kf = *(const LAS bf16x8v*)(KN + (sb * 32 + r32) * 272 + ks * 32 + hi * 16); X = __builtin_amdgcn_mfma_f32_32x32x16_bf16(kf, qf[ks], X, 0, 0, 0); }
                    if (sb == ib) {
#pragma unroll
                        for (int r = 0; r < 16; ++r) { const int srow = (r & 3) + 8 * (r >> 2) + 4 * hi; if (srow > r32) X[r] = 0.f; }
                    }
#pragma unroll
                    for (int st = 0; st < 2; ++st) { v4u pw;
#pragma unroll
                        for (int q = 0; q < 4; ++q) pw[q] = cvt_pk_bf16(X[8 * st + 2 * q], X[8 * st + 2 * q + 1]);
                        const bf16x8v vf = *(const LAS bf16x8v*)(VT + (vb * 32 + r32) * 144 + (sb * 32 + st * 16) * 2 + hi * 16);
                        O = __builtin_amdgcn_mfma_f32_32x32x16_bf16(__builtin_bit_cast(bf16x8v, pw), vf, O, 0, 0, 0); }
                }
#pragma unroll
                for (int r = 0; r < 16; ++r) { const int i = ib * 32 + (r & 3) + 8 * (r >> 2) + 4 * hi; const int row = hgrn_row(b, dir, ch * 64 + i); OO[(size_t)row * HW + hh * HK + vh * 64 + vb * 32 + r32] = O[r]; }
            }
#pragma unroll
            for (int st = 0; st < 4; ++st) { const bf16x8v kf = *(const LAS bf16x8v*)(KT + (kb * 32 + r32) * 144 + st * 32 + hi * 16), vf = *(const LAS bf16x8v*)(VT + (vb * 32 + r32) * 144 + st * 32 + hi * 16);
                T = __builtin_amdgcn_mfma_f32_32x32x16_bf16(kf, vf, T, 0, 0, 0); }
#pragma unroll
            for (int g4 = 0; g4 < 4; ++g4) { const int kk = kb * 32 + 8 * g4 + 4 * hi; const f32x4 ta = *(const LAS f32x4*)(TOT + 256 + kk), tb = *(const LAS f32x4*)(TOT + 384 + kk);
                S[4 * g4] = T[4 * g4] * __expf(ta.x + tb.x); S[4 * g4 + 1] = T[4 * g4 + 1] * __expf(ta.y + tb.y); S[4 * g4 + 2] = T[4 * g4 + 2] * __expf(ta.z + tb.z); S[4 * g4 + 3] = T[4 * g4 + 3] * __expf(ta.w + tb.w); }
            asm volatile("s_waitcnt vmcnt(0)" ::: "memory"); LBAR();
        }
#undef LBAR
#undef HG_DMA
#undef HG_BASE
    }
    __syncthreads();
}

__device__ __forceinline__ void e8_phase(Frame& F, int j, int nrows) {
    fresh(F);
    unsigned char* ws = F.ws;
    const float* OF = (const float*)(ws + WS_OF); const float* OB = (const float*)(ws + WS_OB); const bf16* HG = (const bf16*)(ws + WS_HQ) + 4 * HSEG; bf16* MIX = (bf16*)(ws + WS_MIX);
    const float* gn = F.in[14] + j * HK;
    const int rpw = (nrows + F.G - 1) / F.G;
    for (int i = F.wave; i < rpw; i += NWAVES) {
        const int row = (int)blockIdx.x * rpw + i; if (row >= nrows) break;
        const int col = 8 * F.lane;
        const f32x4 a0 = *(const f32x4*)(OF + (size_t)row * HW + col), a1 = *(const f32x4*)(OF + (size_t)row * HW + col + 4), b0 = *(const f32x4*)(OB + (size_t)row * HW + col), b1 = *(const f32x4*)(OB + (size_t)row * HW + col + 4);
        f32x4 x0 = a0 + b0, x1 = a1 + b1;
        float s = (x0.x * x0.x + x0.y * x0.y) + (x0.z * x0.z + x0.w * x0.w) + (x1.x * x1.x + x1.y * x1.y) + (x1.z * x1.z + x1.w * x1.w);
        s += __shfl_xor(s, 1); s += __shfl_xor(s, 2); s += __shfl_xor(s, 4); s += __shfl_xor(s, 8);
        const float rstd = rsqrtf(s * (1.0f / HK) + EPS);
        const int vv = col & 127; const f32x4 g0 = *(const f32x4*)(gn + vv), g1 = *(const f32x4*)(gn + vv + 4);
        const v4u hg = *(const v4u*)(HG + (size_t)row * HW + col);
        x0 = x0 * rstd * g0; x1 = x1 * rstd * g1;
        v4u o; o.x = pk2(x0.x * siluf_(bflo(hg.x)), x0.y * siluf_(bfhi(hg.x))); o.y = pk2(x0.z * siluf_(bflo(hg.y)), x0.w * siluf_(bfhi(hg.y)));
        o.z = pk2(x1.x * siluf_(bflo(hg.z)), x1.y * siluf_(bfhi(hg.z))); o.w = pk2(x1.z * siluf_(bflo(hg.w)), x1.w * siluf_(bfhi(hg.w)));
        *(v4u*)(MIX + (size_t)row * DM + HW + col) = o;
    }
}

__device__ __forceinline__ void o2_phase(Frame& F, int nrows) {
    fresh(F);
    unsigned char* ws = F.ws;
    const bf16* U = (const bf16*)(ws + WS_U); bf16* P = (bf16*)(ws + WS_POOLED);
    const int rpw = (nrows + F.G - 1) / F.G;
    for (int i = F.wave; i < rpw; i += NWAVES) {
        const int row = (int)blockIdx.x * rpw + i; if (row >= nrows) break;
        const bool lat = row < M; const int T = lat ? SEQ : CTXL; const int t = lat ? row % SEQ : (row - M) % CTXL; const int rbase = row - t;
#pragma unroll
        for (int g = 0; g < 4; ++g) {
            const int w = 2 << g; int lo = t - w / 2; if (lo < 0) lo = 0; int hi = t + w / 2; if (hi > T) hi = T;
            const int col = 256 * g + 4 * F.lane;
            float s0 = 0.f, s1 = 0.f, s2 = 0.f, s3 = 0.f;
            for (int r = lo; r < hi; ++r) { const v2u x = *(const v2u*)(U + (size_t)(rbase + r) * DM + col); s0 += bflo(x.x); s1 += bfhi(x.x); s2 += bflo(x.y); s3 += bfhi(x.y); }
            const v2u xc = *(const v2u*)(U + (size_t)row * DM + col); const float ic = 1.0f / (float)(hi - lo);
            v2u o; o.x = pk2(s0 * ic - bflo(xc.x), s1 * ic - bfhi(xc.x)); o.y = pk2(s2 * ic - bflo(xc.y), s3 * ic - bfhi(xc.y));
            *(v2u*)(P + ((size_t)g * MT + row) * 256 + 4 * F.lane) = o;
        }
    }
}

__device__ __forceinline__ void o5_phase(Frame& F, int nrows) {
    fresh(F);
    unsigned char* ws = F.ws;
    const int* CNT = (const int*)(ws + WS_CNT); int* TST = (int*)(ws + WS_TST); const int* EIDX = (const int*)(ws + WS_EIDX); int* POS = (int*)(ws + WS_POS);
    const bf16* U = (const bf16*)(ws + WS_U); bf16* VG = (bf16*)(ws + WS_VG);
    LAS int* lc = (LAS int*)(F.lds + RING_OFF);
    LAS int* lbase = lc + 512 * 8;
    LAS int* lpos = lbase + 16;
    const int rpw = (nrows + F.G - 1) / F.G;
    for (int e = F.tid; e < F.G * 8; e += 512) lc[e] = CNT[e];
    __syncthreads();
    if (F.tid == 0) {
        int tot[8], pre[8];
        for (int e = 0; e < 8; ++e) { int s = 0, p = 0; for (int w = 0; w < F.G; ++w) { if (w == (int)blockIdx.x) p = s; s += lc[w * 8 + e]; } tot[e] = s; pre[e] = p; }
        int ts = 0;
        for (int e = 0; e < 8; ++e) { lbase[e] = ts * 256 + pre[e]; if (blockIdx.x == 0) TST[e] = ts; ts += (tot[e] + 255) >> 8; }
        if (blockIdx.x == 0) TST[8] = ts;
    }
    __syncthreads();
    if (F.wave == 0) {
        int run[8];
#pragma unroll
        for (int e = 0; e < 8; ++e) run[e] = lbase[e];
        const int npairs = 2 * rpw;
        for (int c0 = 0; c0 < npairs; c0 += 64) {
            const int pl = c0 + F.lane; const int row = (int)blockIdx.x * rpw + (pl >> 1); const bool ok = pl < npairs && row < nrows;
            const int e = ok ? EIDX[2 * row + (pl & 1)] : -1; int mypos = 0;
#pragma unroll
            for (int x = 0; x < 8; ++x) { const unsigned long long mk = __ballot(e == x); const int below = __popcll(mk & ((1ull << F.lane) - 1ull)); if (e == x) mypos = run[x] + below; run[x] += __popcll(mk); }
            if (ok) { lpos[pl] = mypos; POS[2 * row + (pl & 1)] = mypos; }
        }
    }
    __syncthreads();
    for (int pl = F.wave; pl < 2 * rpw; pl += NWAVES) {
        const int row = (int)blockIdx.x * rpw + (pl >> 1); if (row >= nrows) break;
        const int p = lpos[pl];
        const v4u a = *(const v4u*)(U + (size_t)row * DM + 8 * F.lane), b = *(const v4u*)(U + (size_t)row * DM + 512 + 8 * F.lane);
        *(v4u*)(VG + (size_t)p * DM + 8 * F.lane) = a; *(v4u*)(VG + (size_t)p * DM + 512 + 8 * F.lane) = b;
    }
    __syncthreads();
}

__global__ void __launch_bounds__(NWAVES * 64, 2) mega_fwd(Args args) {
    extern __shared__ __attribute__((aligned(16))) unsigned char lds[];
    Frame F;
    F.lds = (LAS unsigned char*)lds;
    F.tid = threadIdx.x; F.lane = F.tid & 63; F.wave = __builtin_amdgcn_readfirstlane(F.tid >> 6);
    F.G = gridDim.x; { const int bx = blockIdx.x; F.vcu = (F.G % 8 == 0) ? (bx % 8) * (F.G / 8) + bx / 8 : bx; }
    F.in = args.in; F.out = args.out; F.ws = args.ws;
    unsigned char* ws = args.ws;
    volatile LAS unsigned* MISC = (volatile LAS unsigned*)(F.lds + MISC_OFF);
    for (int u = F.tid; u < (LDS_BYTES - LDSCTL_OFF) / 4; u += NWAVES * 64) ((LAS unsigned*)(F.lds + LDSCTL_OFF))[u] = 0u;
    __syncthreads();
    XcdBarrier bar = xcd_barrier_post((unsigned*)(ws + WS_CTL) + CW_BAR, MISC + 8);
#define GRID_BAR() xcd_barrier(bar)
#ifndef ONLY
#define ONLY 0
#endif
#define PH(n) (ONLY == 0 || ONLY == (n))
#ifndef DUPMASK
#define DUPMASK 0
#endif
#define REP(bit) for (int rep_ = 0; rep_ < ((DUPMASK & (bit)) ? 2 : 1); ++rep_)
    LAS unsigned char* ring = F.lds + RING_OFF;
    const float* MODV = (const float*)(ws + WS_MODV);
    float* HC = (float*)(ws + WS_HC);
    bf16* U = (bf16*)(ws + WS_U);

#if PH(20)
    p0_prologue(F);
#endif
    GRID_BAR();

    for (int lp = 0; lp < 2; ++lp) {
        const int le = 2 * lp, lo = 2 * lp + 1, j = lp;
        const bool ctx_out = (lp == 0);
        const int nro = ctx_out ? MT : M;
        const float* modE = MODV + (size_t)le * 17 * NMOD; const float* modO = MODV + (size_t)lo * 17 * NMOD;
        const float* hin_l = (lp == 0) ? args.in[0] : args.out; const float* hin_c = (lp == 0) ? args.in[2] : HC;
#if PH(1)
        {
            RowArgs A{}; A.hin_l = hin_l; A.hin_c = hin_c; A.hout_l = args.out; A.hout_c = HC; A.g = args.in[6] + (size_t)(le * 2 + 0) * DM; A.modl = modE; A.shoff = 0; A.scoff = DM; A.U = U;
            A.Y = (const bf16*)(ws + WS_VG); A.pos = (const int*)(ws + WS_POS); A.gate = (const float*)(ws + WS_GATE); A.modprev = MODV + (size_t)(le - 1) * 17 * NMOD;
            if (lp == 0) row_phase<false, 1, false>(F, A, MT); else row_phase<true, 1, false>(F, A, MT);
        }
#endif
        GRID_BAR();
#if PH(2)
        {
            pg8::Gemm g{U, (const bf16*)(ws + WS_WIN) + (size_t)j * INP * DM, DM, DM, DM}; pg8::StaticOrder S; S.init(MT, INP, F.G, (int)blockIdx.x);
            EpiIn E{(bf16*)(ws + WS_CQ), (bf16*)(ws + WS_KR), (bf16*)(ws + WS_CKV), (bf16*)(ws + WS_HQ)};
            REP(8) pg8::gemm_phase<EpiIn, pg8::StaticOrder, true>(ring, g, S, E);
        }
#endif
        GRID_BAR();
#if PH(3)
        REP(4) e3_phase(F);
#endif
        GRID_BAR();
#if PH(4)
        {
            pg8::Gemm g{(const bf16*)(ws + WS_CQ), (const bf16*)(ws + WS_WUQ) + (size_t)j * 768 * QL, QL, QL, QL}; pg8::StaticOrder S; S.init(nro, 768, F.G, (int)blockIdx.x);
            EpiQ E{(bf16*)(ws + WS_QB), (const float*)(ws + WS_RSQ)};
            REP(8) pg8::gemm_phase<EpiQ, pg8::StaticOrder, true>(ring, g, S, E);
        }
        {
            pg8::Gemm g{(const bf16*)(ws + WS_CKV), (const bf16*)(ws + WS_WUKV) + (size_t)j * 1024 * KVL, KVL, KVL, KVL}; pg8::StaticOrder S; S.init(MT, 1024, F.G, (int)blockIdx.x);
            EpiKV E{(bf16*)(ws + WS_KN), (bf16*)(ws + WS_VV), (const float*)(ws + WS_RSKV)};
            REP(8) pg8::gemm_phase<EpiKV, pg8::StaticOrder, true>(ring, g, S, E);
        }
#endif
        GRID_BAR();
#if PH(6)
#ifndef NO_HGRN
        REP(1) hgrn_phase(F, j);
#endif
#ifndef NO_ATTN
        REP(2) attn_phase(F, ctx_out);
#endif
#endif
        GRID_BAR();
#if PH(8)
        REP(4) e8_phase(F, j, nro);
#endif
        GRID_BAR();
#if PH(9)
        {
            pg8::Gemm g{(const bf16*)(ws + WS_MIX), (const bf16*)(ws + WS_WOUT) + (size_t)j * DM * DM, DM, DM, DM}; pg8::StaticOrder S; S.init(nro, DM, F.G, (int)blockIdx.x);
            EpiResid E{hin_l, hin_c, args.out, HC, modE, 2 * DM};
            pg8::gemm_phase<EpiResid, pg8::StaticOrder, true>(ring, g, S, E);
        }
#endif
        GRID_BAR();
#if PH(10)
        {
            RowArgs A{}; A.hin_l = args.out; A.hin_c = HC; A.g = args.in[6] + (size_t)(le * 2 + 1) * DM; A.modl = modE; A.shoff = 3 * DM; A.scoff = 4 * DM; A.U = U;
            REP(4) row_phase<false, 1, false>(F, A, nro);
        }
#endif
        GRID_BAR();
#if PH(11)
        {
            pg8::Gemm g{U, (const bf16*)(ws + WS_WGU) + (size_t)j * 2 * DFF * DM, DM, DM, DM}; pg8::StaticOrder S; S.init(nro, 2 * DFF, F.G, (int)blockIdx.x);
            EpiGateUp E{(bf16*)(ws + WS_HID), DFF, 2 * DFF / 256, 0};
            REP(8) pg8::gemm_phase<EpiGateUp, pg8::StaticOrder, true>(ring, g, S, E);
        }
#endif
        GRID_BAR();
#if PH(12)
        {
            pg8::Gemm g{(const bf16*)(ws + WS_HID), (const bf16*)(ws + WS_WDN) + (size_t)j * DM * DFF, DFF, DFF, DFF}; pg8::StaticOrder S; S.init(nro, DM, F.G, (int)blockIdx.x);
            EpiResid E{args.out, HC, args.out, HC, modE, 5 * DM};
            pg8::gemm_phase<EpiResid, pg8::StaticOrder, true>(ring, g, S, E);
        }
#endif
        GRID_BAR();
#if PH(13)
        {
            RowArgs A{}; A.hin_l = args.out; A.hin_c = HC; A.g = args.in[6] + (size_t)(lo * 2 + 0) * DM; A.modl = modO; A.shoff = 0; A.scoff = DM; A.U = U;
            row_phase<false, 1, false>(F, A, nro);
            REP(16) for (int e = 0; e < NE; ++e) {
                conv_matrix(F, args.in[23] + ((size_t)j * NE + e) * DM * DFE, DM, DFE, (bf16*)(ws + WS_MWGU) + (size_t)e * 2 * DFE * DM, DM, 2, 0, nullptr, 1.f);
                conv_matrix(F, args.in[24] + ((size_t)j * NE + e) * DM * DFE, DM, DFE, (bf16*)(ws + WS_MWGU) + (size_t)e * 2 * DFE * DM, DM, 2, 128, nullptr, 1.f);
                conv_matrix(F, args.in[25] + ((size_t)j * NE + e) * DFE * DM, DFE, DM, (bf16*)(ws + WS_MWDN) + (size_t)e * DM * DFE, DFE, 0, 0, nullptr, 1.f);
            }
        }
#endif
        GRID_BAR();
#if PH(14)
        REP(4) o2_phase(F, nro);
#endif
        GRID_BAR();
#if PH(15)
        {
            pg8::Gemm g{(const bf16*)(ws + WS_POOLED), (const bf16*)(ws + WS_WPOOL) + (size_t)j * 4 * 65536, 256, 256, 256};
            pg8::PoolOrder S{nro / 256, MT / 256, F.G, (int)blockIdx.x};
            EpiPool E{args.out, HC, modO, args.in[20] + (size_t)j * DM, args.in[21] + (size_t)j * DM, MT / 256};
            pg8::gemm_phase<EpiPool, pg8::PoolOrder, true>(ring, g, S, E);
        }
#endif
        GRID_BAR();
#if PH(16)
        {
            RowArgs A{}; A.hin_l = args.out; A.hin_c = HC; A.g = args.in[6] + (size_t)(lo * 2 + 1) * DM; A.modl = modO; A.shoff = 3 * DM; A.scoff = 4 * DM; A.U = U;
            A.router = args.in[22] + (size_t)j * DM * NE; A.eidx = (int*)(ws + WS_EIDX); A.gout = (float*)(ws + WS_GATE); A.cnt = (int*)(ws + WS_CNT);
            REP(4) row_phase<false, 1, true>(F, A, nro);
        }
#endif
        GRID_BAR();
#if PH(17)
        REP(4) o5_phase(F, nro);
#endif
        GRID_BAR();
#if PH(18)
        {
            const int* TST = (const int*)(ws + WS_TST);
            const int ts1 = TST[1], ts2 = TST[2], ts3 = TST[3], ts4 = TST[4], ts5 = TST[5], ts6 = TST[6], ts7 = TST[7], nT = TST[8];
            for (int c = 0; c * MOE_CH < nT; ++c) {
                const int t0 = c * MOE_CH, nrt = (nT - t0) < MOE_CH ? (nT - t0) : MOE_CH;
                {
                    pg8::Gemm g{(const bf16*)(ws + WS_VG), (const bf16*)(ws + WS_MWGU), DM, DM, DM};
                    pg8::MoeOrder S{t0, nrt, 2 * DFE / 256, F.G, (int)blockIdx.x, ts1, ts2, ts3, ts4, ts5, ts6, ts7};
                    EpiGateUp E{(bf16*)(ws + WS_HIDM), DFE, 2 * DFE / 256, t0 * 256};
                    REP(8) pg8::gemm_phase<EpiGateUp, pg8::MoeOrder, true>(ring, g, S, E);
                }
                GRID_BAR();
                {
                    pg8::Gemm g{(const bf16*)(ws + WS_HIDM) - (size_t)t0 * 256 * DFE, (const bf16*)(ws + WS_MWDN), DFE, DFE, DFE};
                    pg8::MoeOrder S{t0, nrt, DM / 256, F.G, (int)blockIdx.x, ts1, ts2, ts3, ts4, ts5, ts6, ts7};
                    EpiY E{(bf16*)(ws + WS_VG), DM / 256};
                    REP(8) pg8::gemm_phase<EpiY, pg8::MoeOrder, true>(ring, g, S, E);
                }
                GRID_BAR();
            }
        }
#endif
    }
#if PH(19)
    {
        RowArgs A{}; A.hin_l = args.out; A.hin_c = HC; A.hout_l = args.out; A.hout_c = HC; A.g = args.in[7];
        A.Y = (const bf16*)(ws + WS_VG); A.pos = (const int*)(ws + WS_POS); A.gate = (const float*)(ws + WS_GATE); A.modprev = MODV + (size_t)3 * 17 * NMOD;
        row_phase<true, 2, false>(F, A, M);
        if (xb_ld((unsigned*)(ws + WS_CTL) + CW_BAR + XB_TMO) != 0u) { __syncthreads(); const float qn = __builtin_nanf(""); for (int i = F.tid; i < 1024; i += 512) args.out[(size_t)blockIdx.x * 1024 + i] = qn; }
    }
#endif
}

extern "C" void kernel_launch(void* const* d_in, const int* in_sizes, int n_in, void* d_out, int out_size, void* d_ws, size_t ws_size, hipStream_t stream) {
    static int grid = 0;
    if (grid == 0) {
        if (n_in != 26 || out_size != M * DM || ws_size < WS_END) { fprintf(stderr, "kernel_launch: unexpected shapes (n_in %d out %d ws %zu)\n", n_in, out_size, ws_size); grid = -1; return; }
        int dev = 0, cus = 0, per_cu = 0;
        if (hipGetDevice(&dev) != hipSuccess || hipDeviceGetAttribute(&cus, hipDeviceAttributeMultiprocessorCount, dev) != hipSuccess) { grid = -1; return; }
        if (hipFuncSetAttribute((const void*)mega_fwd, hipFuncAttributeMaxDynamicSharedMemorySize, LDS_BYTES) != hipSuccess) { grid = -1; return; }
        if (hipOccupancyMaxActiveBlocksPerMultiprocessor(&per_cu, (const void*)mega_fwd, NWAVES * 64, LDS_BYTES) != hipSuccess || per_cu < 1) fprintf(stderr, "kernel_launch: occupancy query says %d\n", per_cu);
        (void)hipGetLastError();
        grid = cus > 256 ? 256 : cus;
    }
    if (grid < 0) return;
    if (hipMemsetAsync((char*)d_ws + WS_CTL, 0, CTL_ZERO_BYTES, stream) != hipSuccess) return;
    Args a{};
    for (int i = 0; i < 26; ++i) a.in[i] = (const float*)d_in[i];
    a.out = (float*)d_out; a.ws = (unsigned char*)d_ws;
    hipLaunchKernelGGL(mega_fwd, dim3(grid), dim3(NWAVES * 64), LDS_BYTES, stream, a);
}
```

```cpp
#include <hip/hip_runtime.h>
#include <cstdio>
#include <cstdint>

namespace pg8 {
#define PG8_LAS __attribute__((address_space(3)))
typedef unsigned short bf16_t;
typedef short bf16x8 __attribute__((ext_vector_type(8)));
typedef float f32x4 __attribute__((ext_vector_type(4)));
typedef unsigned u32x4 __attribute__((ext_vector_type(4)));
constexpr int BM = 256, BK = 64, HALF = 128, HTB = HALF * BK * 2, STAGE_BYTES = 8 * HTB, NXCD = 8, WGM = 8;

__host__ __device__ __forceinline__ int lds_byte(int r, int c) { const int st = (r >> 4) * 2 + (c >> 5), rr = r & 15, cc = c & 31, ob = rr * 64 + cc * 2; return st * 1024 + (ob ^ (((ob >> 9) & 1) << 5)); }
__host__ __device__ __forceinline__ void stage_rc(int b, int& R, int& C) { const int st = b / 1024, sb = b % 1024, swz = sb ^ (((sb >> 9) & 1) << 5); R = (st >> 1) * 16 + swz / 64; C = (st & 1) * 32 + (swz % 64) / 2; }
__host__ __device__ __forceinline__ int perm32(int rho) { const int n = rho >> 4, i = rho & 15; return 8 * (i >> 2) + 4 * n + (i & 3); }

struct Unit { int pm, pn; };
struct Gemm { const bf16_t* A; const bf16_t* Bt; int lda, ldb, K; };

struct StaticOrder {
    int nM, nN, nwg, G, c;
    __device__ void init(int M, int N, int G_, int c_) { nM = M / BM; nN = N / BM; nwg = nM * nN; G = G_; c = c_; }
    __device__ bool next(int i, Unit& u) const {
        const long L = (long)i * G + c; if (L >= nwg) return false;
        int wgid = (int)L; { const int q = nwg / NXCD, r = nwg % NXCD, xcd = wgid % NXCD, off = wgid / NXCD; wgid = (xcd < r ? xcd * (q + 1) : r * (q + 1) + (xcd - r) * q) + off; }
        const int nig = WGM * nN, gid = wgid / nig, fm = gid * WGM, gsz = (nM - fm) < WGM ? (nM - fm) : WGM;
        u.pm = fm + ((wgid % nig) % gsz); u.pn = (wgid % nig) / gsz; return true;
    }
};
struct PoolOrder {
    int nrt, talloc, G, c;
    __device__ bool next(int i, Unit& u) const { const int L = i * G + c; if (L >= 4 * nrt) return false; const int g = L / nrt, rt = L - g * nrt; u.pm = g * talloc + rt; u.pn = g; return true; }
};
struct MoeOrder {
    int t0, nrt, nct, G, c; int ts1, ts2, ts3, ts4, ts5, ts6, ts7;
    __device__ bool next(int i, Unit& u) const {
        const int nwg = nrt * nct; const int L = i * G + c; if (L >= nwg) return false;
        int wgid = L; { const int q = nwg / NXCD, r = nwg % NXCD, xcd = wgid % NXCD, off = wgid / NXCD; wgid = (xcd < r ? xcd * (q + 1) : r * (q + 1) + (xcd - r) * q) + off; }
        const int nig = WGM * nct, gid = wgid / nig, fm = gid * WGM, gsz = (nrt - fm) < WGM ? (nrt - fm) : WGM;
        const int rt = t0 + fm + ((wgid % nig) % gsz), ct = (wgid % nig) / gsz;
        const int e = (rt >= ts1) + (rt >= ts2) + (rt >= ts3) + (rt >= ts4) + (rt >= ts5) + (rt >= ts6) + (rt >= ts7);
        u.pm = rt; u.pn = e * nct + ct; return true;
    }
};

__device__ __forceinline__ unsigned cvt_pk_bf16(float lo, float hi) { unsigned r; asm volatile("v_cvt_pk_bf16_f32 %0, %1, %2" : "=v"(r) : "v"(lo), "v"(hi)); return r; }

template <class Epi, class Sched, bool ALIGN_EPI>
__device__ __forceinline__ void gemm_phase(PG8_LAS unsigned char* lds, const Gemm g, const Sched& S, const Epi& E, const int wid) {
    int lane_ = __builtin_amdgcn_mbcnt_hi(~0u, __builtin_amdgcn_mbcnt_lo(~0u, 0u)); asm volatile("" : "+v"(lane_));
    const int lane = lane_, tid = wid * 64 + lane, wr = wid >> 2, wc = wid & 3, fr = lane & 15, fq = lane >> 4;
    int K_ = g.K; asm volatile("" : "+s"(K_));
    const int K = K_, nt = K / BK;
    unsigned voffA[2], voffB[2];
#pragma unroll
    for (int i = 0; i < 2; ++i) { int R, C; stage_rc(tid * 16 + i * 8192, R, C); const int Rb = Epi::PERM ? ((R & ~31) + perm32(R & 31)) : R;
        voffA[i] = (unsigned)(R * g.lda + C) * 2u; voffB[i] = (unsigned)(Rb * g.ldb + C) * 2u; }
    const size_t kstep = (size_t)(BK * 2);
    const size_t hstepA = (size_t)HALF * g.lda * 2, hstepB = (size_t)HALF * g.ldb * 2;
    const size_t tstepA = 2 * hstepA, tstepB = 2 * hstepB;
    const unsigned ldsw = (unsigned)wid * 1024u;
    const int aoff = lds_byte(wr * 64 + fr, fq * 8), boff = lds_byte(wc * 32 + fr, fq * 8);
#define PG8_SA(b, h) (((b) * 2 + (h)) * HTB)
#define PG8_SB(b, h) ((4 + (b) * 2 + (h)) * HTB)
#define PG8_STAGE(bufoff, gbase, voff) do { _Pragma("unroll") for (int _i = 0; _i < 2; ++_i) \
        __builtin_amdgcn_global_load_lds((const unsigned*)((const char*)(gbase) + (voff)[_i]), (PG8_LAS unsigned*)(lds + (bufoff) + ldsw + _i * 8192), 16, 0, 0); } while (0)
#define PG8_LDA(dst, b, h) do { _Pragma("unroll") for (int m = 0; m < 4; ++m) _Pragma("unroll") for (int k = 0; k < 2; ++k) dst[m][k] = *(const PG8_LAS bf16x8*)(lds + PG8_SA(b, h) + aoff + m * 2048 + k * 1024); } while (0)
#define PG8_LDB(dst, b, h) do { _Pragma("unroll") for (int n = 0; n < 2; ++n) _Pragma("unroll") for (int k = 0; k < 2; ++k) dst[n][k] = *(const PG8_LAS bf16x8*)(lds + PG8_SB(b, h) + boff + n * 2048 + k * 1024); } while (0)
#define PG8_MMA(ai, bj, At, Bt) do { __builtin_amdgcn_s_setprio(1); _Pragma("unroll") for (int m = 0; m < 4; ++m) _Pragma("unroll") for (int n = 0; n < 2; ++n) _Pragma("unroll") for (int k = 0; k < 2; ++k) \
        acc[ai][bj][m][n] = __builtin_amdgcn_mfma_f32_16x16x32_bf16(Bt[n][k], At[m][k], acc[ai][bj][m][n], 0, 0, 0); __builtin_amdgcn_s_setprio(0); } while (0)
#define PG8_WAIT_V(n) asm volatile("s_waitcnt vmcnt(" #n ")" ::: "memory")
#define PG8_WAIT_L(n) asm volatile("s_waitcnt lgkmcnt(" #n ")" ::: "memory")
#define PG8_BAR __builtin_amdgcn_s_barrier()
#define PG8_SCHED __builtin_amdgcn_sched_barrier(0)
    Unit cur, nxt; int ui = 0;
    if (!S.next(0, cur)) return;
    f32x4 acc[2][2][4][2];
#pragma unroll
    for (int a = 0; a < 2; ++a)
#pragma unroll
        for (int b = 0; b < 2; ++b)
#pragma unroll
            for (int m = 0; m < 4; ++m)
#pragma unroll
                for (int n = 0; n < 2; ++n) acc[a][b][m][n] = (f32x4){0.f, 0.f, 0.f, 0.f};
    bf16x8 At[4][2], B0[2][2], B1[2][2];
    const char* cA = (const char*)g.A + (size_t)cur.pm * tstepA; const char* cB = (const char*)g.Bt + (size_t)cur.pn * tstepB;
    PG8_STAGE(PG8_SB(0, 0), cB, voffB); PG8_STAGE(PG8_SB(0, 1), cB + hstepB, voffB); PG8_STAGE(PG8_SA(0, 0), cA, voffA); PG8_STAGE(PG8_SA(0, 1), cA + hstepA, voffA);
    if (wr == 1) PG8_BAR;
    PG8_WAIT_V(2); PG8_BAR;
    PG8_STAGE(PG8_SB(1, 0), cB + kstep, voffB); PG8_STAGE(PG8_SA(1, 0), cA + kstep, voffA); PG8_STAGE(PG8_SB(1, 1), cB + hstepB + kstep, voffB);
    PG8_WAIT_V(6); PG8_BAR;
    for (;;) {
        const bool has_next = S.next(ui + 1, nxt);
        const char* nA = has_next ? (const char*)g.A + (size_t)nxt.pm * tstepA : cA; const char* nB = has_next ? (const char*)g.Bt + (size_t)nxt.pn * tstepB : cB;
#pragma unroll 1
        for (int t = 0; t < nt; t += 2) {
            const bool last = (t == nt - 2);
            const char* a1 = cA + (size_t)(t + 1) * kstep;
            const char* a2 = last ? nA : cA + (size_t)(t + 2) * kstep; const char* b2 = last ? nB : cB + (size_t)(t + 2) * kstep;
            const char* a3 = a2 + kstep; const char* b3 = b2 + kstep;
            PG8_LDB(B0, 0, 0); PG8_LDB(B1, 0, 1); PG8_SCHED; PG8_LDA(At, 0, 0); PG8_STAGE(PG8_SA(1, 1), a1 + hstepA, voffA);
            PG8_WAIT_V(8); PG8_WAIT_L(0); PG8_BAR; PG8_MMA(0, 0, At, B0); PG8_MMA(0, 1, At, B1); PG8_BAR; PG8_SCHED;
            PG8_LDA(At, 0, 1); PG8_STAGE(PG8_SB(0, 0), b2, voffB); PG8_STAGE(PG8_SB(0, 1), b2 + hstepB, voffB); PG8_STAGE(PG8_SA(0, 0), a2, voffA);
            PG8_WAIT_V(8); PG8_WAIT_L(0); PG8_BAR; PG8_MMA(1, 0, At, B0); PG8_MMA(1, 1, At, B1); PG8_BAR; PG8_SCHED;
            PG8_LDB(B0, 1, 0); PG8_LDB(B1, 1, 1); PG8_SCHED; PG8_LDA(At, 1, 0); PG8_STAGE(PG8_SA(0, 1), a2 + hstepA, voffA);
            PG8_WAIT_V(8); PG8_WAIT_L(0); PG8_BAR; PG8_MMA(0, 0, At, B0); PG8_MMA(0, 1, At, B1); PG8_BAR; PG8_SCHED;
            PG8_LDA(At, 1, 1); PG8_STAGE(PG8_SB(1, 0), b3, voffB); PG8_STAGE(PG8_SB(1, 1), b3 + hstepB, voffB); PG8_STAGE(PG8_SA(1, 0), a3, voffA);
            PG8_WAIT_V(8); PG8_WAIT_L(0); PG8_BAR; PG8_MMA(1, 0, At, B0); PG8_MMA(1, 1, At, B1); PG8_BAR; PG8_SCHED;
        }
        if constexpr (ALIGN_EPI) { if (wr == 0) PG8_BAR; }
        E(acc, cur, wr, wc, fr, fq);
        if (!has_next) break;
#pragma unroll
        for (int a = 0; a < 2; ++a)
#pragma unroll
            for (int b = 0; b < 2; ++b)
#pragma unroll
                for (int m = 0; m < 4; ++m)
#pragma unroll
                    for (int n = 0; n < 2; ++n) acc[a][b][m][n] = (f32x4){0.f, 0.f, 0.f, 0.f};
        cur = nxt; cA = nA; cB = nB; ++ui;
        if constexpr (ALIGN_EPI) { if (wr == 1) PG8_BAR; }
    }
    PG8_WAIT_V(0);
    if constexpr (!ALIGN_EPI) { if (wr == 0) PG8_BAR; }
    PG8_BAR;
#undef PG8_SA
#undef PG8_SB
#undef PG8_STAGE
#undef PG8_LDA
#undef PG8_LDB
#undef PG8_MMA
#undef PG8_WAIT_V
#undef PG8_WAIT_L
#undef PG8_BAR
#undef PG8_SCHED
}
}

constexpr int NWAVES = 8;
constexpr int DM = 1024, NB = 16, SEQ = 2048, CTXL = 256;
constexpr int M = NB * SEQ, MC = NB * CTXL, MT = M + MC;
constexpr int QL = 384, KVL = 256, ROPE = 32, HW = 512, NH = 8, QKD = 96, VD = 64;
constexpr int INW = 3232, INP = 3328;
constexpr int DFF = 2816, NE = 8, DFE = 3584, NMOD = 6 * DM;
constexpr int NHH = 4, HK = 128; constexpr int NKEY = SEQ + CTXL;
constexpr float EPS = 1e-6f;
constexpr int MAXT = 296;
constexpr int MOE_CH = 128;

constexpr size_t MiB = 1u << 20;
constexpr size_t WS_CTL = 0, CTL_ZERO_BYTES = 1 * MiB;
constexpr size_t WS_MODV = 1 * MiB;
constexpr size_t WS_ROPE = 3 * MiB;
constexpr size_t WS_CNT = 3 * MiB + 64 * 1024;
constexpr size_t WS_TST = 3 * MiB + 128 * 1024;
constexpr size_t WS_EIDX = 4 * MiB, WS_GATE = 4 * MiB + 512 * 1024, WS_POS = 5 * MiB;
constexpr size_t WS_RSQ = 6 * MiB, WS_RSKV = 6 * MiB + 256 * 1024;
constexpr size_t WS_HC = 8 * MiB;
constexpr size_t WS_WIN = 24 * MiB, WS_WUQ = 37 * MiB, WS_WUKV = 39 * MiB, WS_WOUT = 40 * MiB, WS_WGU = 44 * MiB, WS_WDN = 66 * MiB, WS_WPOOL = 77 * MiB;
constexpr size_t WS_U = 80 * MiB;
constexpr size_t WS_X = 152 * MiB;
constexpr size_t WS_CQ = WS_X, WS_CKV = 179 * MiB, WS_KR = 197 * MiB, WS_KRR = 200 * MiB, WS_HQ = 203 * MiB  ;
constexpr size_t WS_QB = 383 * MiB, WS_KN = 437 * MiB, WS_VV = 473 * MiB, WS_OF = 509 * MiB, WS_OB = 581 * MiB, WS_MIX = 653 * MiB, WS_HID = WS_X;
constexpr size_t WS_MWGU = WS_X, WS_MWDN = 264 * MiB, WS_POOLED = 320 * MiB, WS_VG = 392 * MiB, WS_HIDM = 540 * MiB, WS_END = 800 * MiB;
constexpr size_t HSEG = (size_t)MT * HW;
static_assert(WS_HQ + 5 * HSEG * 2 <= WS_QB && WS_MIX + (size_t)MT * DM * 2 <= WS_END && WS_HID + (size_t)MT * DFF * 2 <= WS_QB, "ws map even");
static_assert(WS_HIDM + (size_t)MOE_CH * 256 * DFE * 2 <= WS_END && WS_VG + (size_t)MAXT * 256 * DM * 2 <= WS_HIDM && WS_MWDN + (size_t)NE * DM * DFE * 2 <= WS_POOLED && WS_MWGU + (size_t)NE * 2 * DFE * DM * 2 <= WS_MWDN, "ws map odd");
constexpr int CW_BAR = 4096;

constexpr int RING_OFF = 0, RING_BYTES = 131072;
constexpr int LDSCTL_OFF = RING_BYTES, MISC_OFF = LDSCTL_OFF + 320;
constexpr int LDS_BYTES = 147456;

#define GAS __attribute__((address_space(1)))
#define LAS __attribute__((address_space(3)))
typedef unsigned short bf16;
typedef unsigned v4u __attribute__((ext_vector_type(4)));
typedef unsigned v2u __attribute__((ext_vector_type(2)));
typedef float f32x4 __attribute__((ext_vector_type(4)));
typedef GAS unsigned gu32;
#define RLX_AGENT __ATOMIC_RELAXED, __HIP_MEMORY_SCOPE_AGENT
#define LDS_WAIT() asm volatile("s_waitcnt lgkmcnt(0)" ::: "memory")
__device__ __forceinline__ unsigned f2bf(float f) { unsigned u = __builtin_bit_cast(unsigned, f); return (u + 0x7fffu + ((u >> 16) & 1u)) >> 16; }
__device__ __forceinline__ unsigned pk2(float lo, float hi) { return f2bf(lo) | (f2bf(hi) << 16); }
__device__ __forceinline__ float bf2f(unsigned short b) { return __uint_as_float((unsigned)b << 16); }
__device__ __forceinline__ float bflo(unsigned w) { return __uint_as_float(w << 16); }
__device__ __forceinline__ float bfhi(unsigned w) { return __uint_as_float(w & 0xffff0000u); }
__device__ __forceinline__ float sigmoidf_(float x) { return 1.0f / (1.0f + __expf(-x)); }
__device__ __forceinline__ float siluf_(float x) { return x / (1.0f + __expf(-x)); }

#define XB_TMO      128
#define XB_XCNT(j)  (256  + 64 * (j))
#define XB_XSUB(j)  (1280 + 64 * (j))
#define XB_XGEN(j)  (2304 + 64 * (j))
#define XB_TOP      3328
#define XB_TOPGEN   3392
#define XCD_BAR_WORDS 3456
#define XB_SPIN_CAP (1u << 22)
__device__ __forceinline__ unsigned xb_ld(unsigned* p)              { return __hip_atomic_load(p, __ATOMIC_RELAXED, __HIP_MEMORY_SCOPE_AGENT); }
__device__ __forceinline__ unsigned xb_add(unsigned* p, unsigned v) { return __hip_atomic_fetch_add(p, v, __ATOMIC_RELAXED, __HIP_MEMORY_SCOPE_AGENT); }
__device__ __forceinline__ unsigned xb_xcc_id() { return (unsigned)__builtin_amdgcn_s_getreg((3 << 11) | 20) & 0xFu; }
#define XB_SPIN(cond, bar) do { unsigned _sp = 0; while (cond) { __builtin_amdgcn_s_sleep(1); \
    if ((++_sp & 255u) == 0u) { if (xb_ld(&(bar)[XB_TMO])) break; if (_sp > XB_SPIN_CAP) { atomicAdd(&(bar)[XB_TMO], 1u); break; } } } } while (0)
struct XcdBarrier { unsigned* bar; unsigned x; volatile LAS unsigned* st; int wave; };
__device__ __forceinline__ bool xb_leader(int wave) { return wave == 0 && __builtin_amdgcn_mbcnt_hi(~0u, __builtin_amdgcn_mbcnt_lo(~0u, 0u)) == 0u; }
__device__ __forceinline__ XcdBarrier xcd_barrier_post(unsigned* bar, volatile LAS unsigned* st, int wave) {
    XcdBarrier b; b.bar = bar; b.x = xb_xcc_id(); b.st = st; b.wave = wave;
    if (xb_leader(wave)) (void)xb_add(&bar[XB_XCNT(b.x)], 1u);
    return b;
}
__device__ __forceinline__ void xcd_barrier_complete(unsigned* bar, unsigned x, unsigned& nloc, unsigned& nx) {
    const unsigned G = gridDim.x * gridDim.y * gridDim.z;
    unsigned sum, cnt, mine, sp = 0u;
    for (;;) {
        sum = 0u; cnt = 0u; mine = 0u;
#pragma unroll
        for (unsigned j = 0; j < 16; ++j) { const unsigned c = xb_ld(&bar[XB_XCNT(j)]); sum += c; cnt += (c > 0u) ? 1u : 0u; mine = (j == x) ? c : mine; }
        if (sum == G) break;
        __builtin_amdgcn_s_sleep(1);
        if ((++sp & 255u) == 0u) { if (xb_ld(&bar[XB_TMO])) break; if (sp > XB_SPIN_CAP) { atomicAdd(&bar[XB_TMO], 1u); break; } }
    }
    nloc = mine > 0u ? mine : 1u; nx = cnt > 0u ? cnt : 1u;
}
__device__ __forceinline__ void xcd_barrier(const XcdBarrier& b) {
    asm volatile("s_waitcnt vmcnt(0)" ::: "memory");
    __syncthreads();
    if (xb_leader(b.wave)) {
        unsigned* bar = b.bar;
        __builtin_amdgcn_s_waitcnt(0);
        unsigned nloc = b.st[0], nx = b.st[1];
        if (nloc == 0u) { xcd_barrier_complete(bar, b.x, nloc, nx); b.st[0] = nloc; b.st[1] = nx; }
        const unsigned old = xb_add(&bar[XB_XSUB(b.x)], 1u);
        const unsigned gen = old / nloc;
        if (old + 1u == (gen + 1u) * nloc) {
            __builtin_amdgcn_fence(__ATOMIC_RELEASE, "agent");
            asm volatile("s_waitcnt vmcnt(0)" ::: "memory");
            const unsigned og = xb_add(&bar[XB_TOP], 1u);
            const unsigned tg = og / nx;
            if (og + 1u == (tg + 1u) * nx) xb_add(&bar[XB_TOPGEN], 1u);
            else XB_SPIN(xb_ld(&bar[XB_TOPGEN]) == tg, bar);
            __builtin_amdgcn_fence(__ATOMIC_ACQUIRE, "agent");
            xb_add(&bar[XB_XGEN(b.x)], 1u);
            asm volatile("s_waitcnt vmcnt(0)" ::: "memory");
        } else {
            XB_SPIN(xb_ld(&bar[XB_XGEN(b.x)]) == gen, bar);
            __builtin_amdgcn_fence(__ATOMIC_ACQUIRE, "agent");
            asm volatile("s_waitcnt vmcnt(0)" ::: "memory");
        }
    }
    __syncthreads();
}

struct Args { const float* in[26]; float* out; unsigned char* ws; };
struct Frame {
    LAS unsigned char* lds;
    int tid, lane, wave, G, vcu;
    const float* const* in; float* out; unsigned char* ws;
};
__device__ __forceinline__ float shx(float v, int lane, int m) { return __int_as_float(__builtin_amdgcn_ds_bpermute((lane ^ m) << 2, __float_as_int(v))); }
__device__ __forceinline__ float wave_sum(float v, int lane) {
#pragma unroll
    for (int o = 1; o < 64; o <<= 1) v += shx(v, lane, o);
    return v;
}

__device__ __forceinline__ void fresh(Frame& F) { int l = __builtin_amdgcn_mbcnt_hi(~0u, __builtin_amdgcn_mbcnt_lo(~0u, 0u)); asm volatile("" : "+v"(l)); F.lane = l; F.tid = F.wave * 64 + l; }

__device__ __forceinline__ void conv_item(const float* W, int ldw, bf16* WT, int ldd, int k0, int n0, int drow0, const float* kscale, float gscale, LAS float* scr, int lane) {
    float wv[32];
#pragma unroll
    for (int i = 0; i < 32; ++i) { const int kk = 2 * i + (lane >> 5); wv[i] = W[(size_t)(k0 + kk) * ldw + n0 + (lane & 31)]; }
#pragma unroll
    for (int i = 0; i < 32; ++i) { const int kk = 2 * i + (lane >> 5); float w = wv[i]; if (kscale) w *= kscale[k0 + kk]; scr[kk * 33 + (lane & 31)] = w * gscale; }
    LDS_WAIT(); asm volatile("" ::: "memory");
    const int c = lane & 7;
#pragma unroll
    for (int j = 0; j < 4; ++j) { const int n = (lane >> 3) + 8 * j; const LAS float* s = scr + (8 * c) * 33 + n;
        v4u o; o.x = pk2(s[0 * 33], s[1 * 33]); o.y = pk2(s[2 * 33], s[3 * 33]); o.z = pk2(s[4 * 33], s[5 * 33]); o.w = pk2(s[6 * 33], s[7 * 33]);
        *(v4u*)(WT + (size_t)(drow0 + n) * ldd + k0 + 8 * c) = o; }
    LDS_WAIT(); asm volatile("" ::: "memory");
}
__device__ __forceinline__ int conv_rowmap(int mode, int n0, int off) {
    if (mode == 0) return n0 + off;
    if (mode == 1) { if (n0 < 384) return n0; if (n0 < 640) return 512 + (n0 - 384); if (n0 < 672) return 384; return 768 + (n0 - 672); }
    return 256 * (n0 >> 7) + (n0 & 127) + off;
}
__device__ __forceinline__ void conv_matrix(Frame& F, const float* W, int K, int N, bf16* WT, int ldd, int mode, int off, const float* kscale, float gscale) {
    LAS float* scr = (LAS float*)(F.lds + RING_OFF + F.wave * 16384);
    const int gw = F.vcu * NWAVES + F.wave, NGW = F.G * NWAVES;
    const int nblk = N / 32, nitems = (K / 64) * nblk;
    for (int it = gw; it < nitems; it += NGW) { const int kb = it / nblk, nb = it % nblk; conv_item(W, N, WT, ldd, 64 * kb, 32 * nb, conv_rowmap(mode, 32 * nb, off), kscale, gscale, scr, F.lane); }
}

__device__ __forceinline__ int row_bidx(int row) { return row < M ? row / SEQ : NB; }

struct RowArgs {
    const float* hin_l; const float* hin_c; float* hout_l; float* hout_c;
    const float* g;
    const float* modl;
    int shoff, scoff;
    bf16* U;
    const bf16* Y; const int* pos; const float* gate; const float* modprev;
    const float* router; int* eidx; float* gout; int* cnt;
};
template <bool COMBINE, int OUTMODE, bool ROUTER>
__device__ __forceinline__ void row_phase(Frame& F, const RowArgs& A, int nrows) {
    fresh(F);
    const int rpw = (nrows + F.G - 1) / F.G;
    LAS int* lcnt = (LAS int*)(F.lds + RING_OFF);
    if (ROUTER) { if (F.tid < 8) lcnt[F.tid] = 0; __syncthreads(); }
    for (int i = F.wave; i < rpw; i += NWAVES) {
        const int row = (int)blockIdx.x * rpw + i; if (row >= nrows) break;
        const bool lat = row < M; const int bidx = lat ? row / SEQ : NB;
        const float* hr = lat ? A.hin_l + (size_t)row * DM : A.hin_c + (size_t)(row - M) * DM;
        f32x4 v[4];
#pragma unroll
        for (int j = 0; j < 4; ++j) v[j] = *(const f32x4*)(hr + 4 * F.lane + 256 * j);
        if (COMBINE) {
            const int pa = A.pos[2 * row], pb = A.pos[2 * row + 1]; const float ga = A.gate[2 * row], gb = A.gate[2 * row + 1];
            const float* g2 = A.modprev + bidx * NMOD + 5 * DM;
#pragma unroll
            for (int j = 0; j < 4; ++j) { const int col = 4 * F.lane + 256 * j;
                const v2u ya = *(const v2u*)(A.Y + (size_t)pa * DM + col), yb = *(const v2u*)(A.Y + (size_t)pb * DM + col); const f32x4 gv = *(const f32x4*)(g2 + col);
                v[j].x += gv.x * (ga * bflo(ya.x) + gb * bflo(yb.x)); v[j].y += gv.y * (ga * bfhi(ya.x) + gb * bfhi(yb.x));
                v[j].z += gv.z * (ga * bflo(ya.y) + gb * bflo(yb.y)); v[j].w += gv.w * (ga * bfhi(ya.y) + gb * bfhi(yb.y)); }
            if (OUTMODE != 2) { float* ho = lat ? A.hout_l + (size_t)row * DM : A.hout_c + (size_t)(row - M) * DM;
#pragma unroll
                for (int j = 0; j < 4; ++j) *(f32x4*)(ho + 4 * F.lane + 256 * j) = v[j]; }
        }
        float s = 0.f;
#pragma unroll
        for (int j = 0; j < 4; ++j) s += (v[j].x * v[j].x + v[j].y * v[j].y) + (v[j].z * v[j].z + v[j].w * v[j].w);
        const float rstd = rsqrtf(wave_sum(s, F.lane) * (1.0f / DM) + EPS);
        if (OUTMODE == 2) {
            float* ho = A.hout_l + (size_t)row * DM;
#pragma unroll
            for (int j = 0; j < 4; ++j) { const int col = 4 * F.lane + 256 * j; const f32x4 gv = *(const f32x4*)(A.g + col); *(f32x4*)(ho + col) = v[j] * rstd * gv; }
        } else {
            const float* sh = A.modl + bidx * NMOD + A.shoff; const float* sc = A.modl + bidx * NMOD + A.scoff;
            float lg[8];
            if (ROUTER) {
#pragma unroll
                for (int e = 0; e < 8; ++e) lg[e] = 0.f;
            }
#pragma unroll
            for (int j = 0; j < 4; ++j) { const int col = 4 * F.lane + 256 * j; const f32x4 gv = *(const f32x4*)(A.g + col), shv = *(const f32x4*)(sh + col), scv = *(const f32x4*)(sc + col);
                f32x4 y = v[j] * rstd * gv * (scv + 1.0f) + shv;
                v2u o; o.x = pk2(y.x, y.y); o.y = pk2(y.z, y.w); *(v2u*)(A.U + (size_t)row * DM + col) = o;
                if (ROUTER) {
#pragma unroll
                    for (int q = 0; q < 4; ++q) { const f32x4 r0 = *(const f32x4*)(A.router + (size_t)(col + q) * 8), r1 = *(const f32x4*)(A.router + (size_t)(col + q) * 8 + 4); const float yy = y[q];
                        lg[0] += yy * r0.x; lg[1] += yy * r0.y; lg[2] += yy * r0.z; lg[3] += yy * r0.w; lg[4] += yy * r1.x; lg[5] += yy * r1.y; lg[6] += yy * r1.z; lg[7] += yy * r1.w; } }
            }
            if (ROUTER) {
#pragma unroll
                for (int e = 0; e < 8; ++e) lg[e] = wave_sum(lg[e], F.lane);
                int i0 = 0; float v0 = lg[0];
#pragma unroll
                for (int e = 1; e < 8; ++e) if (lg[e] > v0) { v0 = lg[e]; i0 = e; }
                int i1 = -1; float v1 = -INFINITY;
#pragma unroll
                for (int e = 0; e < 8; ++e) if (e != i0 && lg[e] > v1) { v1 = lg[e]; i1 = e; }
                const float g0 = 1.0f / (1.0f + __expf(v1 - v0));
                if (F.lane == 0) { A.eidx[2 * row] = i0; A.eidx[2 * row + 1] = i1; A.gout[2 * row] = g0; A.gout[2 * row + 1] = 1.0f - g0; atomicAdd((int*)&lcnt[i0], 1); atomicAdd((int*)&lcnt[i1], 1); }
            }
        }
    }
    if (ROUTER) { __syncthreads(); if (F.tid < 8) A.cnt[blockIdx.x * 8 + F.tid] = lcnt[F.tid]; __syncthreads(); }
}

using pg8::Unit; using pg8::cvt_pk_bf16;
__device__ __forceinline__ v4u pack8(const f32x4& a, const f32x4& b) { v4u w; w.x = cvt_pk_bf16(a[0], a[1]); w.y = cvt_pk_bf16(a[2], a[3]); w.z = cvt_pk_bf16(b[0], b[1]); w.w = cvt_pk_bf16(b[2], b[3]); return w; }
struct EpiIn {
    static constexpr bool PERM = true;
    bf16 *CQ, *KR, *CKV, *H5;
    __device__ __forceinline__ void operator()(const f32x4 (&acc)[2][2][4][2], const Unit& u, int wr, int wc, int fr, int fq) const {
        const int row0 = u.pm * 256 + wr * 64 + fr;
#pragma unroll
        for (int bj = 0; bj < 2; ++bj) {
            const int col = u.pn * 256 + bj * 128 + wc * 32 + 8 * fq;
            bf16* base; int ld;
            if (col < 384) { base = CQ + col; ld = QL; }
            else if (col < 416) { base = KR + (col - 384); ld = ROPE; }
            else if (col < 512) { base = nullptr; ld = 0; }
            else if (col < 768) { base = CKV + (col - 512); ld = KVL; }
            else { const int c2 = col - 768; base = H5 + (size_t)(c2 >> 9) * HSEG + (c2 & 511); ld = HW; }
            if (base) {
#pragma unroll
                for (int ai = 0; ai < 2; ++ai)
#pragma unroll
                    for (int m = 0; m < 4; ++m) { const int row = row0 + ai * 128 + m * 16; *(v4u*)(base + (size_t)row * ld) = pack8(acc[ai][bj][m][0], acc[ai][bj][m][1]); }
            }
        }
    }
};
struct EpiQ {
    static constexpr bool PERM = true;
    bf16* O; const float* rs;
    __device__ __forceinline__ void operator()(const f32x4 (&acc)[2][2][4][2], const Unit& u, int wr, int wc, int fr, int fq) const {
        const int row0 = u.pm * 256 + wr * 64 + fr;
#pragma unroll
        for (int ai = 0; ai < 2; ++ai)
#pragma unroll
            for (int m = 0; m < 4; ++m) { const int row = row0 + ai * 128 + m * 16; const float sc = rs[row];
#pragma unroll
                for (int bj = 0; bj < 2; ++bj) { const int col = u.pn * 256 + bj * 128 + wc * 32 + 8 * fq; *(v4u*)(O + (size_t)row * 768 + col) = pack8(acc[ai][bj][m][0] * sc, acc[ai][bj][m][1] * sc); } }
    }
};
struct EpiKV {
    static constexpr bool PERM = true;
    bf16* KNp; bf16* VTp; const float* rs;
    __device__ __forceinline__ void operator()(const f32x4 (&acc)[2][2][4][2], const Unit& u, int wr, int wc, int fr, int fq) const {
        const int row0 = u.pm * 256 + wr * 64 + fr;
#pragma unroll
        for (int ai = 0; ai < 2; ++ai)
#pragma unroll
            for (int m = 0; m < 4; ++m) { const int row = row0 + ai * 128 + m * 16; const float sc = rs[row];
                const bool lat = row < M; const int b = lat ? row / SEQ : (row - M) / CTXL; const int key = lat ? row % SEQ : SEQ + (row - M) % CTXL;
                const int kpos = (key & ~12) | ((key & 4) << 1) | ((key & 8) >> 1);
#pragma unroll
                for (int bj = 0; bj < 2; ++bj) { const int col = u.pn * 256 + bj * 128 + wc * 32 + 8 * fq; const int hh = col >> 7, w = col & 127;
                    if (w < 64) { *(v4u*)(KNp + (size_t)row * HW + hh * 64 + w) = pack8(acc[ai][bj][m][0] * sc, acc[ai][bj][m][1] * sc); }
                    else { bf16* dst = VTp + ((size_t)((b * NH + hh) * VD + (w - 64))) * NKEY + kpos;
#pragma unroll
                        for (int n = 0; n < 2; ++n)
#pragma unroll
                            for (int q = 0; q < 4; ++q) dst[(size_t)(4 * n + q) * NKEY] = (bf16)f2bf(acc[ai][bj][m][n][q] * sc); } } }
    }
};
struct EpiResid {
    static constexpr bool PERM = false;
    const float* hin_l; const float* hin_c; float* hout_l; float* hout_c; const float* modl; int goff;
    __device__ __forceinline__ void operator()(const f32x4 (&acc)[2][2][4][2], const Unit& u, int wr, int wc, int fr, int fq) const {
        const int rowt = u.pm * 256; const bool lat = rowt < M; const int bidx = lat ? rowt / SEQ : NB;
        const float* gate = modl + bidx * NMOD + goff;
        const float* hi = lat ? hin_l + (size_t)rowt * DM : hin_c + (size_t)(rowt - M) * DM;
        float* ho = lat ? hout_l + (size_t)rowt * DM : hout_c + (size_t)(rowt - M) * DM;
        const int col0 = u.pn * 256 + wc * 32 + 4 * fq;
#pragma unroll
        for (int bj = 0; bj < 2; ++bj)
#pragma unroll
            for (int n = 0; n < 2; ++n) { const f32x4 gv = *(const f32x4*)(gate + col0 + bj * 128 + n * 16);
#pragma unroll
                for (int ai = 0; ai < 2; ++ai)
#pragma unroll
                    for (int m = 0; m < 4; ++m) { const int r = ai * 128 + wr * 64 + m * 16 + fr; const size_t off = (size_t)r * DM + col0 + bj * 128 + n * 16; const f32x4 hv = *(const f32x4*)(hi + off); *(f32x4*)(ho + off) = hv + gv * acc[ai][bj][m][n]; }
                asm volatile("" ::: "memory"); }
    }
};
struct EpiPool {
    static constexpr bool PERM = false;
    float* h_l; float* h_c; const float* modl; const float* bias; const float* scale; int talloc;
    __device__ __forceinline__ void operator()(const f32x4 (&acc)[2][2][4][2], const Unit& u, int wr, int wc, int fr, int fq) const {
        const int g = u.pn, rowt = (u.pm - g * talloc) * 256; const bool lat = rowt < M; const int bidx = lat ? rowt / SEQ : NB;
        const float* gate = modl + bidx * NMOD + 2 * DM;
        float* ho = lat ? h_l + (size_t)rowt * DM : h_c + (size_t)(rowt - M) * DM;
        const int col0 = g * 256 + wc * 32 + 4 * fq;
#pragma unroll
        for (int bj = 0; bj < 2; ++bj)
#pragma unroll
            for (int n = 0; n < 2; ++n) { const int c = col0 + bj * 128 + n * 16; const f32x4 gm = *(const f32x4*)(gate + c) * *(const f32x4*)(scale + c); const f32x4 gb = gm * *(const f32x4*)(bias + c);
#pragma unroll
                for (int ai = 0; ai < 2; ++ai)
#pragma unroll
                    for (int m = 0; m < 4; ++m) { const int r = ai * 128 + wr * 64 + m * 16 + fr; const size_t off = (size_t)r * DM + c; const f32x4 hv = *(const f32x4*)(ho + off); *(f32x4*)(ho + off) = hv + gm * acc[ai][bj][m][n] + gb; }
                asm volatile("" ::: "memory"); }
    }
};
struct EpiGateUp {
    static constexpr bool PERM = true;
    bf16* H; int ldh, nct, rowsub;
    __device__ __forceinline__ void operator()(const f32x4 (&acc)[2][2][4][2], const Unit& u, int wr, int wc, int fr, int fq) const {
        const int row0 = u.pm * 256 + wr * 64 + fr - rowsub; const int ct = u.pn % nct; const int col = ct * 128 + wc * 32 + 8 * fq;
#pragma unroll
        for (int ai = 0; ai < 2; ++ai)
#pragma unroll
            for (int m = 0; m < 4; ++m) { const int row = row0 + ai * 128 + m * 16; f32x4 o[2];
#pragma unroll
                for (int n = 0; n < 2; ++n)
#pragma unroll
                    for (int q = 0; q < 4; ++q) { const float gv = acc[ai][0][m][n][q], uv = acc[ai][1][m][n][q]; o[n][q] = gv * uv / (1.0f + __expf(-gv)); }
                *(v4u*)(H + (size_t)row * ldh + col) = pack8(o[0], o[1]); }
    }
};
struct EpiY {
    static constexpr bool PERM = true;
    bf16* Y; int nct;
    __device__ __forceinline__ void operator()(const f32x4 (&acc)[2][2][4][2], const Unit& u, int wr, int wc, int fr, int fq) const {
        const int row0 = u.pm * 256 + wr * 64 + fr; const int ct = u.pn % nct;
#pragma unroll
        for (int ai = 0; ai < 2; ++ai)
#pragma unroll
            for (int m = 0; m < 4; ++m) { const int row = row0 + ai * 128 + m * 16;
#pragma unroll
                for (int bj = 0; bj < 2; ++bj) { const int col = ct * 256 + bj * 128 + wc * 32 + 8 * fq; *(v4u*)(Y + (size_t)row * DM + col) = pack8(acc[ai][bj][m][0], acc[ai][bj][m][1]); } }
    }
};

__device__ __forceinline__ void p0_prologue(Frame& F) {
    fresh(F);
    unsigned char* ws = F.ws;
    const float qscale = 0.10206207261596577f * 1.4426950408889634f;
    for (int j = 0; j < 2; ++j) {
        conv_matrix(F, F.in[8] + (size_t)j * DM * INW, DM, INW, (bf16*)(ws + WS_WIN) + (size_t)j * INP * DM, DM, 1, 0, nullptr, 1.f);
        conv_matrix(F, F.in[11] + (size_t)j * QL * 768, QL, 768, (bf16*)(ws + WS_WUQ) + (size_t)j * 768 * QL, QL, 0, 0, F.in[9] + j * QL, qscale);
        conv_matrix(F, F.in[12] + (size_t)j * KVL * 1024, KVL, 1024, (bf16*)(ws + WS_WUKV) + (size_t)j * 1024 * KVL, KVL, 0, 0, F.in[10] + j * KVL, 1.f);
        conv_matrix(F, F.in[15] + (size_t)j * DM * DM, DM, DM, (bf16*)(ws + WS_WOUT) + (size_t)j * DM * DM, DM, 0, 0, nullptr, 1.f);
        conv_matrix(F, F.in[16] + (size_t)j * DM * DFF, DM, DFF, (bf16*)(ws + WS_WGU) + (size_t)j * 2 * DFF * DM, DM, 2, 0, nullptr, 1.f);
        conv_matrix(F, F.in[17] + (size_t)j * DM * DFF, DM, DFF, (bf16*)(ws + WS_WGU) + (size_t)j * 2 * DFF * DM, DM, 2, 128, nullptr, 1.f);
        conv_matrix(F, F.in[18] + (size_t)j * DFF * DM, DFF, DM, (bf16*)(ws + WS_WDN) + (size_t)j * DM * DFF, DFF, 0, 0, nullptr, 1.f);
        for (int g = 0; g < 4; ++g)
            conv_matrix(F, F.in[19] + (size_t)(j * 4 + g) * 65536, 256, 256, (bf16*)(ws + WS_WPOOL) + (size_t)(j * 4 + g) * 65536, 256, 0, 0, nullptr, 1.f);
    }
    __syncthreads();
    if (blockIdx.x == 0 && F.tid < 8) {
        float* TC = (float*)(ws + WS_ROPE); float* TS = TC + 512;
        double th = 1.0; for (int i = 0; i < F.tid; ++i) th *= 0.31622776601683794;
        const double x2 = th * th; double s = th, c = 1.0, ts = th, tc = 1.0;
        for (int n = 1; n <= 12; ++n) { tc *= -x2 / (double)((2 * n - 1) * (2 * n)); c += tc; ts *= -x2 / (double)((2 * n) * (2 * n + 1)); s += ts; }
        double cp = 1.0, sp = 0.0;
        for (int p = 0; p < 64; ++p) { TC[p * 8 + F.tid] = (float)cp; TS[p * 8 + F.tid] = (float)sp; const double ncp = cp * c - sp * s; sp = sp * c + cp * s; cp = ncp; }
    }
    {
        LAS float* sc = (LAS float*)(F.lds + RING_OFF);
        LAS float* red = sc + 17 * 1024;
        const int nitems = 4 * (NMOD / 64);
        if ((int)blockIdx.x < nitems) {
            for (int e = F.tid; e < 17 * 1024; e += 512) { const int r = e >> 10, k = e & 1023; const float x = (r < 16) ? F.in[1][r * 1024 + k] : F.in[3][k]; sc[e] = siluf_(x); }
            __syncthreads();
            for (int it = blockIdx.x; it < nitems; it += F.G) {
                const int l = it / (NMOD / 64), c0 = (it % (NMOD / 64)) * 64;
                const float* W = F.in[4] + (size_t)l * DM * NMOD + c0 + F.lane;
                float acc[17];
#pragma unroll
                for (int r = 0; r < 17; ++r) acc[r] = 0.f;
                const int kb = F.wave * 128;
                for (int k = 0; k < 128; k += 4) {
                    const float w0 = W[(size_t)(kb + k) * NMOD], w1 = W[(size_t)(kb + k + 1) * NMOD], w2 = W[(size_t)(kb + k + 2) * NMOD], w3 = W[(size_t)(kb + k + 3) * NMOD];
#pragma unroll
                    for (int r = 0; r < 17; ++r) { const f32x4 s4 = *(const LAS f32x4*)(sc + r * 1024 + kb + k); acc[r] += s4.x * w0 + s4.y * w1 + s4.z * w2 + s4.w * w3; }
                }
#pragma unroll
                for (int r = 0; r < 17; ++r) red[(F.wave * 17 + r) * 64 + F.lane] = acc[r];
                __syncthreads();
                for (int o = F.tid; o < 17 * 64; o += 512) { const int r = o >> 6, cc = o & 63; float s = 0.f;
#pragma unroll
                    for (int w = 0; w < 8; ++w) s += red[(w * 17 + r) * 64 + cc];
                    ((float*)(ws + WS_MODV))[(size_t)(l * 17 + r) * NMOD + c0 + cc] = s + F.in[5][l * NMOD + c0 + cc]; }
                __syncthreads();
            }
        }
    }
}

__device__ __forceinline__ void e3_phase(Frame& F) {
    fresh(F);
    unsigned char* ws = F.ws;
    const bf16* CQ = (const bf16*)(ws + WS_CQ); const bf16* CKV = (const bf16*)(ws + WS_CKV); const bf16* KR = (const bf16*)(ws + WS_KR); bf16* KRR = (bf16*)(ws + WS_KRR);
    float* RSQ = (float*)(ws + WS_RSQ); float* RSKV = (float*)(ws + WS_RSKV); const float* TC = (const float*)(ws + WS_ROPE); const float* TS = TC + 512;
    const int rpw = (MT + F.G - 1) / F.G;
    for (int i = F.wave; i < rpw; i += NWAVES) {
        const int row = (int)blockIdx.x * rpw + i; if (row >= MT) break;
        float s = 0.f;
        if (F.lane < 48) { const v4u w = *(const v4u*)(CQ + (size_t)row * QL + F.lane * 8);
            s = bflo(w.x) * bflo(w.x) + bfhi(w.x) * bfhi(w.x) + bflo(w.y) * bflo(w.y) + bfhi(w.y) * bfhi(w.y) + bflo(w.z) * bflo(w.z) + bfhi(w.z) * bfhi(w.z) + bflo(w.w) * bflo(w.w) + bfhi(w.w) * bfhi(w.w); }
        s = wave_sum(s, F.lane); if (F.lane == 0) RSQ[row] = rsqrtf(s * (1.0f / QL) + EPS);
        s = 0.f;
        if (F.lane < 32) { const v4u w = *(const v4u*)(CKV + (size_t)row * KVL + F.lane * 8);
            s = bflo(w.x) * bflo(w.x) + bfhi(w.x) * bfhi(w.x) + bflo(w.y) * bflo(w.y) + bfhi(w.y) * bfhi(w.y) + bflo(w.z) * bflo(w.z) + bfhi(w.z) * bfhi(w.z) + bflo(w.w) * bflo(w.w) + bfhi(w.w) * bfhi(w.w); }
        s = wave_sum(s, F.lane); if (F.lane == 0) RSKV[row] = rsqrtf(s * (1.0f / KVL) + EPS);
        const float x = (F.lane < 32) ? bf2f(KR[(size_t)row * ROPE + F.lane]) : 0.f; const float pr = shx(x, F.lane, 8);
        float o = x;
        if (row < M) { const int t = row % SEQ; const int p = ((F.lane >> 4) & 1) ? (t & 63) : (t >> 6); const int j = F.lane & 7; const float c = TC[p * 8 + j], sn = TS[p * 8 + j];
            o = ((F.lane >> 3) & 1) ? x * c + pr * sn : x * c - pr * sn; }
        if (F.lane < 32) KRR[(size_t)row * ROPE + F.lane] = (bf16)f2bf(o);
    }
}

typedef short bf16x8v __attribute__((ext_vector_type(8)));
typedef float f32x16 __attribute__((ext_vector_type(16)));
__device__ __forceinline__ void attn_unit(Frame& F, int b, int h, int qrow0, bool rope_q, int t_lo, int t_hi) {
    unsigned char* ws = F.ws;
    const bf16* QB = (const bf16*)(ws + WS_QB); const bf16* KN = (const bf16*)(ws + WS_KN); const bf16* KRR = (const bf16*)(ws + WS_KRR); const bf16* VT = (const bf16*)(ws + WS_VV);
    bf16* MIX = (bf16*)(ws + WS_MIX); const float* TC = (const float*)(ws + WS_ROPE); const float* TS = TC + 512;
    const int lane = F.lane, wave = F.wave, r32 = lane & 31, hi = lane >> 5;
    LAS unsigned char* ring = F.lds + RING_OFF;
    const int qrow = qrow0 + wave * 32 + r32;
    bf16x8v qr[6];
#pragma unroll
    for (int d0 = 0; d0 < 6; ++d0) qr[d0] = *(const bf16x8v*)(QB + (size_t)qrow * 768 + h * QKD + 16 * d0 + 8 * hi);
    if (rope_q) { const int t = qrow % SEQ;
#pragma unroll
        for (int a = 0; a < 2; ++a) { const int p = a ? (t & 63) : (t >> 6); const v4u w = __builtin_bit_cast(v4u, qr[4 + a]); float x[8], y[8];
            x[0] = bflo(w.x); x[1] = bfhi(w.x); x[2] = bflo(w.y); x[3] = bfhi(w.y); x[4] = bflo(w.z); x[5] = bfhi(w.z); x[6] = bflo(w.w); x[7] = bfhi(w.w);
#pragma unroll
            for (int jj = 0; jj < 8; ++jj) { const float pr = shx(x[jj], lane, 32); const float c = TC[p * 8 + jj], sn = TS[p * 8 + jj]; y[jj] = hi ? x[jj] * c + pr * sn : x[jj] * c - pr * sn; }
            v4u o; o.x = pk2(y[0], y[1]); o.y = pk2(y[2], y[3]); o.z = pk2(y[4], y[5]); o.w = pk2(y[6], y[7]); qr[4 + a] = __builtin_bit_cast(bf16x8v, o); } }
    const int bh = b * NH + h;
    const bf16* vsrc = VT + ((size_t)(bh * VD + lane)) * NKEY + 8 * wave;
#define ATT_DMA(t, buf) do { const int t_ = (t); const int r0_ = t_ < SEQ / 64 ? b * SEQ + 64 * t_ : M + b * CTXL + 64 * (t_ - SEQ / 64); \
        LAS unsigned char* kb_ = ring + (buf) * 12288; LAS unsigned char* vb_ = ring + 24576 + (buf) * 8192; \
        __builtin_amdgcn_global_load_lds((const unsigned*)(KN + (size_t)(r0_ + lane) * HW + h * 64 + 8 * wave), (LAS unsigned*)(kb_ + wave * 1024), 16, 0, 0); \
        if (wave < 4) __builtin_amdgcn_global_load_lds((const unsigned*)(KRR + (size_t)(r0_ + lane) * ROPE + 8 * wave), (LAS unsigned*)(kb_ + (8 + wave) * 1024), 16, 0, 0); \
        __builtin_amdgcn_global_load_lds((const unsigned*)(vsrc + 64 * t_), (LAS unsigned*)(vb_ + wave * 1024), 16, 0, 0); } while (0)
    f32x16 o0, o1;
#pragma unroll
    for (int r = 0; r < 16; ++r) { o0[r] = 0.f; o1[r] = 0.f; }
    float m_run = -INFINITY, l_run = 0.f;
    ATT_DMA(t_lo, 0);
    for (int t = t_lo; t < t_hi; ++t) {
        const int buf = (t - t_lo) & 1;
        asm volatile("s_waitcnt vmcnt(0)" ::: "memory"); __syncthreads();
        if (t + 1 < t_hi) ATT_DMA(t + 1, buf ^ 1);
        const LAS unsigned char* kb = ring + buf * 12288 + hi * 1024 + r32 * 16; const LAS unsigned char* vb = ring + 24576 + buf * 8192 + hi * 1024 + r32 * 16;
        f32x16 p0, p1;
#pragma unroll
        for (int r = 0; r < 16; ++r) { p0[r] = 0.f; p1[r] = 0.f; }
#pragma unroll
        for (int d0 = 0; d0 < 6; ++d0) { const bf16x8v k0 = *(const LAS bf16x8v*)(kb + d0 * 2048), k1 = *(const LAS bf16x8v*)(kb + d0 * 2048 + 512);
            p0 = __builtin_amdgcn_mfma_f32_32x32x16_bf16(k0, qr[d0], p0, 0, 0, 0); p1 = __builtin_amdgcn_mfma_f32_32x32x16_bf16(k1, qr[d0], p1, 0, 0, 0); }
        float mt = fmaxf(p0[0], p1[0]);
#pragma unroll
        for (int r = 1; r < 16; ++r) mt = fmaxf(mt, fmaxf(p0[r], p1[r]));
        mt = fmaxf(mt, shx(mt, lane, 32));
        const float mn = fmaxf(m_run, mt); const float alpha = __builtin_amdgcn_exp2f(m_run - mn); m_run = mn;
        float ps = 0.f;
#pragma unroll
        for (int r = 0; r < 16; ++r) { p0[r] = __builtin_amdgcn_exp2f(p0[r] - mn); p1[r] = __builtin_amdgcn_exp2f(p1[r] - mn); ps += p0[r] + p1[r]; }
        l_run = l_run * alpha + ps;
#pragma unroll
        for (int r = 0; r < 16; ++r) { o0[r] *= alpha; o1[r] *= alpha; }
        v4u pw[4];
#pragma unroll
        for (int q = 0; q < 4; ++q) { pw[0][q] = cvt_pk_bf16(p0[2 * q], p0[2 * q + 1]); pw[1][q] = cvt_pk_bf16(p0[8 + 2 * q], p0[8 + 2 * q + 1]); pw[2][q] = cvt_pk_bf16(p1[2 * q], p1[2 * q + 1]); pw[3][q] = cvt_pk_bf16(p1[8 + 2 * q], p1[8 + 2 * q + 1]); }
#pragma unroll
        for (int s4 = 0; s4 < 4; ++s4) { const bf16x8v pa = __builtin_bit_cast(bf16x8v, pw[s4]);
            const bf16x8v v0 = *(const LAS bf16x8v*)(vb + s4 * 2048), v1 = *(const LAS bf16x8v*)(vb + s4 * 2048 + 512);
            o0 = __builtin_amdgcn_mfma_f32_32x32x16_bf16(v0, pa, o0, 0, 0, 0); o1 = __builtin_amdgcn_mfma_f32_32x32x16_bf16(v1, pa, o1, 0, 0, 0); }
    }
    l_run += shx(l_run, lane, 32);
    const float rl = 1.0f / l_run;
    bf16* orow = MIX + (size_t)qrow * DM + h * VD;
#pragma unroll
    for (int g = 0; g < 4; ++g) { v2u a, c2; a.x = pk2(o0[4 * g] * rl, o0[4 * g + 1] * rl); a.y = pk2(o0[4 * g + 2] * rl, o0[4 * g + 3] * rl); c2.x = pk2(o1[4 * g] * rl, o1[4 * g + 1] * rl); c2.y = pk2(o1[4 * g + 2] * rl, o1[4 * g + 3] * rl);
        *(v2u*)(orow + 8 * g + 4 * hi) = a; *(v2u*)(orow + 32 + 8 * g + 4 * hi) = c2; }
    __syncthreads();
#undef ATT_DMA
}
__device__ __forceinline__ void attn_phase(Frame& F, bool ctx_out) {
    fresh(F);
    const int nlat = NB * NH * 8, nctx = ctx_out ? NB * NH : 0;
    const int per = (nlat + F.G - 1) / F.G;
    for (int i = 0; i < per; ++i) { const int it = F.vcu * per + i; if (it >= nlat) break; const int bh = it >> 3, qb = it & 7; attn_unit(F, bh >> 3, bh & 7, (bh >> 3) * SEQ + qb * 256, true, 0, NKEY / 64); }
    for (int it = F.vcu; it < nctx; it += F.G) attn_unit(F, it >> 3, it & 7, M + (it >> 3) * CTXL, false, SEQ / 64, NKEY / 64);
    __syncthreads();
}

__device__ __forceinline__ int hgrn_row(int b, int dir, int ig) { return (ig < CTXL) ? (M + b * CTXL + (dir ? CTXL - 1 - ig : ig)) : (b * SEQ + (dir ? SEQ - 1 - (ig - CTXL) : (ig - CTXL))); }
__device__ __forceinline__ void hgrn_phase(Frame& F, int j) {
    fresh(F);
    unsigned char* ws = F.ws;
    const bf16* HQ = (const bf16*)(ws + WS_HQ); const bf16* HFF = HQ + HSEG; const bf16* HFB = HQ + 2 * HSEG; const bf16* HI = HQ + 3 * HSEG;
    float* OF = (float*)(ws + WS_OF); float* OB = (float*)(ws + WS_OB);
    LAS unsigned char* ring = F.lds + RING_OFF;
    LAS unsigned char* QN = ring; LAS unsigned char* KN = ring + 17408; LAS unsigned char* KT = ring + 34816; LAS unsigned char* VT = ring + 53248; LAS unsigned char* ST = ring + 62464;
    LAS float* TOT = (LAS float*)(ring + 79872);
    LAS unsigned char* RQ = ring + 81920; LAS unsigned char* RF = ring + 98304; LAS unsigned char* RV = ring + 114688;
    const int tid = F.tid, lane = F.lane, wave = F.wave, r32 = lane & 31, hi = lane >> 5;
    const int k = tid & 127, part = tid >> 7;
    const int kb = wave >> 1, vb = wave & 1;
    for (int it = blockIdx.x; it < NB * NHH * 2 * 2; it += F.G) {
        const int vh = it & 1, dir = (it >> 1) & 1, hh = (it >> 2) & 3, b = it >> 4;
        const bf16* HF = dir ? HFB : HFF; float* OO = dir ? OB : OF;
        float lb = 0.f; if (j == 1) { const int ci = dir * HW + hh * HK + k; const float l0 = F.in[13][ci], l1 = F.in[13][2 * HW + ci]; lb = 1.0f / (1.0f + __expf(l0 - l1)); }
        const float oml = 1.0f - lb;
        f32x16 S;
#pragma unroll
        for (int r = 0; r < 16; ++r) S[r] = 0.f;
#define LBAR() do { asm volatile("s_waitcnt lgkmcnt(0)" ::: "memory"); __builtin_amdgcn_s_barrier(); asm volatile("" ::: "memory"); } while (0)
#define HG_BASE(c_) ((c_) < CTXL / 64 ? M + b * CTXL + (dir ? CTXL - 64 - 64 * (c_) : 64 * (c_)) : b * SEQ + (dir ? SEQ - 64 - 64 * ((c_) - CTXL / 64) : 64 * ((c_) - CTXL / 64)))
#define HG_DMA(c_) do { const int rb_ = HG_BASE(c_); \
            _Pragma("unroll") for (int p_ = 0; p_ < 2; ++p_) { const int pc_ = wave * 2 + p_; const size_t go_ = (size_t)(rb_ + 4 * pc_ + (lane >> 4)) * HW + hh * HK + 8 * (lane & 15); \
                __builtin_amdgcn_global_load_lds((const unsigned*)(HQ + go_), (LAS unsigned*)(RQ + pc_ * 1024), 16, 0, 0); __builtin_amdgcn_global_load_lds((const unsigned*)(HF + go_), (LAS unsigned*)(RF + pc_ * 1024), 16, 0, 0); } \
            __builtin_amdgcn_global_load_lds((const unsigned*)(HI + (size_t)(rb_ + 8 * wave + (lane >> 3)) * HW + hh * HK + vh * 64 + 8 * (lane & 7)), (LAS unsigned*)(RV + wave * 1024), 16, 0, 0); } while (0)
        HG_DMA(0);
        asm volatile("s_waitcnt vmcnt(0)" ::: "memory"); LBAR();
        for (int ch = 0; ch < NKEY / 64; ++ch) {
            float qv[16], kin[16], cs[16]; float run = 0.f;
#pragma unroll
            for (int ii = 0; ii < 16; ++ii) { const int i = 16 * part + ii, mr = dir ? 63 - i : i; const float hq = bf2f(*(const LAS bf16*)(RQ + mr * 256 + k * 2)), hf = bf2f(*(const LAS bf16*)(RF + mr * 256 + k * 2));
                qv[ii] = hq * __builtin_amdgcn_rcpf(1.0f + __expf(-hq)); const float e = __expf(-hf), sg = __builtin_amdgcn_rcpf(1.0f + e); kin[ii] = oml * e * sg; run += __logf(lb + oml * sg); cs[ii] = run; }
            TOT[part * 128 + k] = run;
            { const int mr = dir ? 63 - lane : lane; const v4u w = *(const LAS v4u*)(RV + mr * 128 + wave * 16); const int pos = (lane & ~12) | ((lane & 4) << 1) | ((lane & 8) >> 1); LAS bf16* vt = (LAS bf16*)(VT + (8 * wave) * 144 + pos * 2);
              vt[0 * 72] = (bf16)(w.x & 0xffffu); vt[1 * 72] = (bf16)(w.x >> 16); vt[2 * 72] = (bf16)(w.y & 0xffffu); vt[3 * 72] = (bf16)(w.y >> 16);
              vt[4 * 72] = (bf16)(w.z & 0xffffu); vt[5 * 72] = (bf16)(w.z >> 16); vt[6 * 72] = (bf16)(w.w & 0xffffu); vt[7 * 72] = (bf16)(w.w >> 16); }
            LBAR();
            if (ch + 1 < NKEY / 64) HG_DMA(ch + 1);
            { const float t0 = TOT[k], t1 = TOT[128 + k], t2 = TOT[256 + k];
              const float base = (part > 0 ? t0 : 0.f) + (part > 1 ? t1 : 0.f) + (part > 2 ? t2 : 0.f); const float rr = t0 + t1;
              unsigned kt[8];
#pragma unroll
              for (int ii = 0; ii < 16; ii += 2) { float d0 = base + cs[ii] - rr, d1 = base + cs[ii + 1] - rr; d0 = fminf(fmaxf(d0, -80.f), 80.f); d1 = fminf(fmaxf(d1, -80.f), 80.f);
                  const float e0 = __expf(d0), e1 = __expf(d1); const float q0 = qv[ii] * e0, q1 = qv[ii + 1] * e1, k0 = kin[ii] * __builtin_amdgcn_rcpf(e0), k1 = kin[ii + 1] * __builtin_amdgcn_rcpf(e1);
                  const unsigned qp = cvt_pk_bf16(q0, q1), kp = cvt_pk_bf16(k0, k1);
                  *(LAS bf16*)(QN + (16 * part + ii) * 272 + k * 2) = (bf16)(qp & 0xffffu); *(LAS bf16*)(QN + (16 * part + ii + 1) * 272 + k * 2) = (bf16)(qp >> 16);
                  *(LAS bf16*)(KN + (16 * part + ii) * 272 + k * 2) = (bf16)(kp & 0xffffu); *(LAS bf16*)(KN + (16 * part + ii + 1) * 272 + k * 2) = (bf16)(kp >> 16);
                  kt[ii >> 1] = kp; }
              *(LAS v4u*)(KT + k * 144 + part * 32) = (v4u){kt[0], kt[1], kt[4], kt[5]}; *(LAS v4u*)(KT + k * 144 + part * 32 + 16) = (v4u){kt[2], kt[3], kt[6], kt[7]}; }
            f32x16 T;
#pragma unroll
            for (int g4 = 0; g4 < 4; ++g4) { const int kk = kb * 32 + 8 * g4 + 4 * hi; const f32x4 ta = *(const LAS f32x4*)(TOT + kk), tb = *(const LAS f32x4*)(TOT + 128 + kk);
                T[4 * g4] = S[4 * g4] * __expf(ta.x + tb.x); T[4 * g4 + 1] = S[4 * g4 + 1] * __expf(ta.y + tb.y); T[4 * g4 + 2] = S[4 * g4 + 2] * __expf(ta.z + tb.z); T[4 * g4 + 3] = S[4 * g4 + 3] * __expf(ta.w + tb.w);
                v2u o; o.x = cvt_pk_bf16(T[4 * g4], T[4 * g4 + 1]); o.y = cvt_pk_bf16(T[4 * g4 + 2], T[4 * g4 + 3]); *(LAS v2u*)(ST + (vb * 32 + r32) * 272 + kk * 2) = o; }
            LBAR();
            if (wave < 4) {
                const int ib = kb;
                bf16x8v qf[8];
#pragma unroll
                for (int ks = 0; ks < 8; ++ks) qf[ks] = *(const LAS bf16x8v*)(QN + (ib * 32 + r32) * 272 + ks * 32 + hi * 16);
                f32x16 O;
#pragma unroll
                for (int r = 0; r < 16; ++r) O[r] = 0.f;
#pragma unroll
                for (int ks = 0; ks < 8; ++ks) { const bf16x8v sf = *(const LAS bf16x8v*)(ST + (vb * 32 + r32) * 272 + ks * 32 + hi * 16); O = __builtin_amdgcn_mfma_f32_32x32x16_bf16(qf[ks], sf, O, 0, 0, 0); }
                for (int sb = 0; sb <= ib; ++sb) {
                    f32x16 X;
#pragma unroll
                    for (int r = 0; r < 16; ++r) X[r] = 0.f;
#pragma unroll
                    for (int ks = 0; ks < 8; ++ks) { const bf16x8v kf = *(const LAS bf16x8v*)(KN + (sb * 32 + r32) * 272 + ks * 32 + hi * 16); X = __builtin_amdgcn_mfma_f32_32x32x16_bf16(kf, qf[ks], X, 0, 0, 0); }
                    if (sb == ib) {
#pragma unroll
                        for (int r = 0; r < 16; ++r) { const int srow = (r & 3) + 8 * (r >> 2) + 4 * hi; if (srow > r32) X[r] = 0.f; }
                    }
#pragma unroll
                    for (int st = 0; st < 2; ++st) { v4u pw;
#pragma unroll
                        for (int q = 0; q < 4; ++q) pw[q] = cvt_pk_bf16(X[8 * st + 2 * q], X[8 * st + 2 * q + 1]);
                        const bf16x8v vf = *(const LAS bf16x8v*)(VT + (vb * 32 + r32) * 144 + (sb * 32 + st * 16) * 2 + hi * 16);
                        O = __builtin_amdgcn_mfma_f32_32x32x16_bf16(__builtin_bit_cast(bf16x8v, pw), vf, O, 0, 0, 0); }
                }
#pragma unroll
                for (int r = 0; r < 16; ++r) { const int i = ib * 32 + (r & 3) + 8 * (r >> 2) + 4 * hi; const int row = hgrn_row(b, dir, ch * 64 + i); OO[(size_t)row * HW + hh * HK + vh * 64 + vb * 32 + r32] = O[r]; }
            }
#pragma unroll
            for (int st = 0; st < 4; ++st) { const bf16x8v kf = *(const LAS bf16x8v*)(KT + (kb * 32 + r32) * 144 + st * 32 + hi * 16), vf = *(const LAS bf16x8v*)(VT + (vb * 32 + r32) * 144 + st * 32 + hi * 16);
                T = __builtin_amdgcn_mfma_f32_32x32x16_bf16(kf, vf, T, 0, 0, 0); }
#pragma unroll
            for (int g4 = 0; g4 < 4; ++g4) { const int kk = kb * 32 + 8 * g4 + 4 * hi; const f32x4 ta = *(const LAS f32x4*)(TOT + 256 + kk), tb = *(const LAS f32x4*)(TOT + 384 + kk);
                S[4 * g4] = T[4 * g4] * __expf(ta.x + tb.x); S[4 * g4 + 1] = T[4 * g4 + 1] * __expf(ta.y + tb.y); S[4 * g4 + 2] = T[4 * g4 + 2] * __expf(ta.z + tb.z); S[4 * g4 + 3] = T[4 * g4 + 3] * __expf(ta.w + tb.w); }
            asm volatile("s_waitcnt vmcnt(0)" ::: "memory"); LBAR();
        }
#undef LBAR
#undef HG_DMA
#undef HG_BASE
    }
    __syncthreads();
}

__device__ __forceinline__ void e8_phase(Frame& F, int j, int nrows) {
    fresh(F);
    unsigned char* ws = F.ws;
    const float* OF = (const float*)(ws + WS_OF); const float* OB = (const float*)(ws + WS_OB); const bf16* HG = (const bf16*)(ws + WS_HQ) + 4 * HSEG; bf16* MIX = (bf16*)(ws + WS_MIX);
    const float* gn = F.in[14] + j * HK;
    const int rpw = (nrows + F.G - 1) / F.G;
    for (int i = F.wave; i < rpw; i += NWAVES) {
        const int row = (int)blockIdx.x * rpw + i; if (row >= nrows) break;
        const int col = 8 * F.lane;
        const f32x4 a0 = *(const f32x4*)(OF + (size_t)row * HW + col), a1 = *(const f32x4*)(OF + (size_t)row * HW + col + 4), b0 = *(const f32x4*)(OB + (size_t)row * HW + col), b1 = *(const f32x4*)(OB + (size_t)row * HW + col + 4);
        f32x4 x0 = a0 + b0, x1 = a1 + b1;
        float s = (x0.x * x0.x + x0.y * x0.y) + (x0.z * x0.z + x0.w * x0.w) + (x1.x * x1.x + x1.y * x1.y) + (x1.z * x1.z + x1.w * x1.w);
        s += shx(s, F.lane, 1); s += shx(s, F.lane, 2); s += shx(s, F.lane, 4); s += shx(s, F.lane, 8);
        const float rstd = rsqrtf(s * (1.0f / HK) + EPS);
        const int vv = col & 127; const f32x4 g0 = *(const f32x4*)(gn + vv), g1 = *(const f32x4*)(gn + vv + 4);
        const v4u hg = *(const v4u*)(HG + (size_t)row * HW + col);
        x0 = x0 * rstd * g0; x1 = x1 * rstd * g1;
        v4u o; o.x = pk2(x0.x * siluf_(bflo(hg.x)), x0.y * siluf_(bfhi(hg.x))); o.y = pk2(x0.z * siluf_(bflo(hg.y)), x0.w * siluf_(bfhi(hg.y)));
        o.z = pk2(x1.x * siluf_(bflo(hg.z)), x1.y * siluf_(bfhi(hg.z))); o.w = pk2(x1.z * siluf_(bflo(hg.w)), x1.w * siluf_(bfhi(hg.w)));
        *(v4u*)(MIX + (size_t)row * DM + HW + col) = o;
    }
}

__device__ __forceinline__ void o2_phase(Frame& F, int nrows) {
    fresh(F);
    unsigned char* ws = F.ws;
    const bf16* U = (const bf16*)(ws + WS_U); bf16* P = (bf16*)(ws + WS_POOLED);
    const int rpw = (nrows + F.G - 1) / F.G;
    for (int i = F.wave; i < rpw; i += NWAVES) {
        const int row = (int)blockIdx.x * rpw + i; if (row >= nrows) break;
        const bool lat = row < M; const int T = lat ? SEQ : CTXL; const int t = lat ? row % SEQ : (row - M) % CTXL; const int rbase = row - t;
#pragma unroll
        for (int g = 0; g < 4; ++g) {
            const int w = 2 << g; int lo = t - w / 2; if (lo < 0) lo = 0; int hi = t + w / 2; if (hi > T) hi = T;
            const int col = 256 * g + 4 * F.lane;
            float s0 = 0.f, s1 = 0.f, s2 = 0.f, s3 = 0.f;
            for (int r = lo; r < hi; ++r) { const v2u x = *(const v2u*)(U + (size_t)(rbase + r) * DM + col); s0 += bflo(x.x); s1 += bfhi(x.x); s2 += bflo(x.y); s3 += bfhi(x.y); }
            const v2u xc = *(const v2u*)(U + (size_t)row * DM + col); const float ic = 1.0f / (float)(hi - lo);
            v2u o; o.x = pk2(s0 * ic - bflo(xc.x), s1 * ic - bfhi(xc.x)); o.y = pk2(s2 * ic - bflo(xc.y), s3 * ic - bfhi(xc.y));
            *(v2u*)(P + ((size_t)g * MT + row) * 256 + 4 * F.lane) = o;
        }
    }
}

__device__ __forceinline__ void o5_phase(Frame& F, int nrows) {
    fresh(F);
    unsigned char* ws = F.ws;
    const int* CNT = (const int*)(ws + WS_CNT); int* TST = (int*)(ws + WS_TST); const int* EIDX = (const int*)(ws + WS_EIDX); int* POS = (int*)(ws + WS_POS);
    const bf16* U = (const bf16*)(ws + WS_U); bf16* VG = (bf16*)(ws + WS_VG);
    LAS int* lc = (LAS int*)(F.lds + RING_OFF);
    LAS int* lbase = lc + 512 * 8;
    LAS int* lpos = lbase + 32;
    const int rpw = (nrows + F.G - 1) / F.G;
    for (int e = F.tid; e < F.G * 8; e += 512) lc[e] = CNT[e];
    __syncthreads();
    {
        const int e = F.wave; int c4[4]; int sum = 0;
#pragma unroll
        for (int q = 0; q < 4; ++q) { const int w = 4 * F.lane + q; c4[q] = (w < F.G) ? lc[w * 8 + e] : 0; sum += c4[q]; }
        int incl = sum;
#pragma unroll
        for (int o = 1; o < 64; o <<= 1) { const int t = __builtin_amdgcn_ds_bpermute((F.lane >= o ? F.lane - o : F.lane) << 2, incl); if (F.lane >= o) incl += t; }
        const int total = __builtin_amdgcn_readlane(incl, 63); int excl = incl - sum;
        const int myq = (int)blockIdx.x & 3; int pre = excl;
#pragma unroll
        for (int q = 0; q < 3; ++q) if (q < myq) pre += c4[q];
        if (F.lane == ((int)blockIdx.x >> 2)) { lbase[e] = pre; lbase[8 + e] = total; }
    }
    __syncthreads();
    if (F.tid == 0) {
        int ts = 0;
        for (int e = 0; e < 8; ++e) { const int pre = lbase[e], tot = lbase[8 + e]; lbase[e] = ts * 256 + pre; if (blockIdx.x == 0) TST[e] = ts; ts += (tot + 255) >> 8; }
        if (blockIdx.x == 0) TST[8] = ts;
    }
    __syncthreads();
    if (F.wave == 0) {
        int run[8];
#pragma unroll
        for (int e = 0; e < 8; ++e) run[e] = lbase[e];
        const int npairs = 2 * rpw;
        for (int c0 = 0; c0 < npairs; c0 += 64) {
            const int pl = c0 + F.lane; const int row = (int)blockIdx.x * rpw + (pl >> 1); const bool ok = pl < npairs && row < nrows;
            const int e = ok ? EIDX[2 * row + (pl & 1)] : -1; int mypos = 0;
#pragma unroll
            for (int x = 0; x < 8; ++x) { const unsigned long long mk = __ballot(e == x); const int below = __popcll(mk & ((1ull << F.lane) - 1ull)); if (e == x) mypos = run[x] + below; run[x] += __popcll(mk); }
            if (ok) { lpos[pl] = mypos; POS[2 * row + (pl & 1)] = mypos; }
        }
    }
    __syncthreads();
    for (int pl = F.wave; pl < 2 * rpw; pl += NWAVES) {
        const int row = (int)blockIdx.x * rpw + (pl >> 1); if (row >= nrows) break;
        const int p = lpos[pl];
        const v4u a = *(const v4u*)(U + (size_t)row * DM + 8 * F.lane), b = *(const v4u*)(U + (size_t)row * DM + 512 + 8 * F.lane);
        *(v4u*)(VG + (size_t)p * DM + 8 * F.lane) = a; *(v4u*)(VG + (size_t)p * DM + 512 + 8 * F.lane) = b;
    }
    __syncthreads();
}

__global__ void __launch_bounds__(NWAVES * 64, 2) mega_fwd(Args args) {
    extern __shared__ __attribute__((aligned(16))) unsigned char lds[];
    Frame F;
    F.lds = (LAS unsigned char*)lds;
    F.wave = __builtin_amdgcn_readfirstlane((int)threadIdx.x >> 6); fresh(F);
    F.G = gridDim.x; { const int bx = blockIdx.x; F.vcu = (F.G % 8 == 0) ? (bx % 8) * (F.G / 8) + bx / 8 : bx; }
    F.in = args.in; F.out = args.out; F.ws = args.ws;
    unsigned char* ws = args.ws;
    volatile LAS unsigned* MISC = (volatile LAS unsigned*)(F.lds + MISC_OFF);
    for (int u = F.tid; u < (LDS_BYTES - LDSCTL_OFF) / 4; u += NWAVES * 64) ((LAS unsigned*)(F.lds + LDSCTL_OFF))[u] = 0u;
    __syncthreads();
    XcdBarrier bar = xcd_barrier_post((unsigned*)(ws + WS_CTL) + CW_BAR, MISC + 8, F.wave);
#define GRID_BAR() xcd_barrier(bar)
#ifndef ONLY
#define ONLY 0
#endif
#define PH(n) (ONLY == 0 || ONLY == (n))
#ifndef DUPMASK
#define DUPMASK 0
#endif
#define REP(bit) for (int rep_ = 0; rep_ < ((DUPMASK & (bit)) ? 2 : 1); ++rep_)
    LAS unsigned char* ring = F.lds + RING_OFF;
    const float* MODV = (const float*)(ws + WS_MODV);
    float* HC = (float*)(ws + WS_HC);
    bf16* U = (bf16*)(ws + WS_U);

#if PH(20)
    p0_prologue(F);
#endif
    GRID_BAR();

    for (int lp = 0; lp < 2; ++lp) {
        const int le = 2 * lp, lo = 2 * lp + 1, j = lp;
        const bool ctx_out = (lp == 0);
        const int nro = ctx_out ? MT : M;
        const float* modE = MODV + (size_t)le * 17 * NMOD; const float* modO = MODV + (size_t)lo * 17 * NMOD;
        const float* hin_l = (lp == 0) ? args.in[0] : args.out; const float* hin_c = (lp == 0) ? args.in[2] : HC;
#if PH(1)
        {
            RowArgs A{}; A.hin_l = hin_l; A.hin_c = hin_c; A.hout_l = args.out; A.hout_c = HC; A.g = args.in[6] + (size_t)(le * 2 + 0) * DM; A.modl = modE; A.shoff = 0; A.scoff = DM; A.U = U;
            A.Y = (const bf16*)(ws + WS_VG); A.pos = (const int*)(ws + WS_POS); A.gate = (const float*)(ws + WS_GATE); A.modprev = MODV + (size_t)(le - 1) * 17 * NMOD;
            if (lp == 0) row_phase<false, 1, false>(F, A, MT); else row_phase<true, 1, false>(F, A, MT);
        }
#endif
        GRID_BAR();
#if PH(2)
        {
            pg8::Gemm g{U, (const bf16*)(ws + WS_WIN) + (size_t)j * INP * DM, DM, DM, DM}; pg8::StaticOrder S; S.init(MT, INP, F.G, (int)blockIdx.x);
            EpiIn E{(bf16*)(ws + WS_CQ), (bf16*)(ws + WS_KR), (bf16*)(ws + WS_CKV), (bf16*)(ws + WS_HQ)};
            REP(8) pg8::gemm_phase<EpiIn, pg8::StaticOrder, true>(ring, g, S, E, F.wave);
        }
#endif
        GRID_BAR();
#if PH(3)
        REP(4) e3_phase(F);
#endif
        GRID_BAR();
#if PH(4)
        {
            pg8::Gemm g{(const bf16*)(ws + WS_CQ), (const bf16*)(ws + WS_WUQ) + (size_t)j * 768 * QL, QL, QL, QL}; pg8::StaticOrder S; S.init(nro, 768, F.G, (int)blockIdx.x);
            EpiQ E{(bf16*)(ws + WS_QB), (const float*)(ws + WS_RSQ)};
            REP(8) pg8::gemm_phase<EpiQ, pg8::StaticOrder, true>(ring, g, S, E, F.wave);
        }
        {
            pg8::Gemm g{(const bf16*)(ws + WS_CKV), (const bf16*)(ws + WS_WUKV) + (size_t)j * 1024 * KVL, KVL, KVL, KVL}; pg8::StaticOrder S; S.init(MT, 1024, F.G, (int)blockIdx.x);
            EpiKV E{(bf16*)(ws + WS_KN), (bf16*)(ws + WS_VV), (const float*)(ws + WS_RSKV)};
            REP(8) pg8::gemm_phase<EpiKV, pg8::StaticOrder, true>(ring, g, S, E, F.wave);
        }
#endif
        GRID_BAR();
#if PH(6)
#ifndef NO_HGRN
        REP(1) hgrn_phase(F, j);
#endif
#ifndef NO_ATTN
        REP(2) attn_phase(F, ctx_out);
#endif
#endif
        GRID_BAR();
#if PH(8)
        REP(4) e8_phase(F, j, nro);
#endif
        GRID_BAR();
#if PH(9)
        {
            pg8::Gemm g{(const bf16*)(ws + WS_MIX), (const bf16*)(ws + WS_WOUT) + (size_t)j * DM * DM, DM, DM, DM}; pg8::StaticOrder S; S.init(nro, DM, F.G, (int)blockIdx.x);
            EpiResid E{hin_l, hin_c, args.out, HC, modE, 2 * DM};
            pg8::gemm_phase<EpiResid, pg8::StaticOrder, true>(ring, g, S, E, F.wave);
        }
#endif
        GRID_BAR();
#if PH(10)
        {
            RowArgs A{}; A.hin_l = args.out; A.hin_c = HC; A.g = args.in[6] + (size_t)(le * 2 + 1) * DM; A.modl = modE; A.shoff = 3 * DM; A.scoff = 4 * DM; A.U = U;
            REP(4) row_phase<false, 1, false>(F, A, nro);
        }
#endif
        GRID_BAR();
#if PH(11)
        {
            pg8::Gemm g{U, (const bf16*)(ws + WS_WGU) + (size_t)j * 2 * DFF * DM, DM, DM, DM}; pg8::StaticOrder S; S.init(nro, 2 * DFF, F.G, (int)blockIdx.x);
            EpiGateUp E{(bf16*)(ws + WS_HID), DFF, 2 * DFF / 256, 0};
            REP(8) pg8::gemm_phase<EpiGateUp, pg8::StaticOrder, true>(ring, g, S, E, F.wave);
        }
#endif
        GRID_BAR();
#if PH(12)
        {
            pg8::Gemm g{(const bf16*)(ws + WS_HID), (const bf16*)(ws + WS_WDN) + (size_t)j * DM * DFF, DFF, DFF, DFF}; pg8::StaticOrder S; S.init(nro, DM, F.G, (int)blockIdx.x);
            EpiResid E{args.out, HC, args.out, HC, modE, 5 * DM};
            pg8::gemm_phase<EpiResid, pg8::StaticOrder, true>(ring, g, S, E, F.wave);
        }
#endif
        GRID_BAR();
#if PH(13)
        {
            RowArgs A{}; A.hin_l = args.out; A.hin_c = HC; A.g = args.in[6] + (size_t)(lo * 2 + 0) * DM; A.modl = modO; A.shoff = 0; A.scoff = DM; A.U = U;
            row_phase<false, 1, false>(F, A, nro);
            REP(16) for (int e = 0; e < NE; ++e) {
                conv_matrix(F, args.in[23] + ((size_t)j * NE + e) * DM * DFE, DM, DFE, (bf16*)(ws + WS_MWGU) + (size_t)e * 2 * DFE * DM, DM, 2, 0, nullptr, 1.f);
                conv_matrix(F, args.in[24] + ((size_t)j * NE + e) * DM * DFE, DM, DFE, (bf16*)(ws + WS_MWGU) + (size_t)e * 2 * DFE * DM, DM, 2, 128, nullptr, 1.f);
                conv_matrix(F, args.in[25] + ((size_t)j * NE + e) * DFE * DM, DFE, DM, (bf16*)(ws + WS_MWDN) + (size_t)e * DM * DFE, DFE, 0, 0, nullptr, 1.f);
            }
        }
#endif
        GRID_BAR();
#if PH(14)
        REP(4) o2_phase(F, nro);
#endif
        GRID_BAR();
#if PH(15)
        {
            pg8::Gemm g{(const bf16*)(ws + WS_POOLED), (const bf16*)(ws + WS_WPOOL) + (size_t)j * 4 * 65536, 256, 256, 256};
            pg8::PoolOrder S{nro / 256, MT / 256, F.G, (int)blockIdx.x};
            EpiPool E{args.out, HC, modO, args.in[20] + (size_t)j * DM, args.in[21] + (size_t)j * DM, MT / 256};
            pg8::gemm_phase<EpiPool, pg8::PoolOrder, true>(ring, g, S, E, F.wave);
        }
#endif
        GRID_BAR();
#if PH(16)
        {
            RowArgs A{}; A.hin_l = args.out; A.hin_c = HC; A.g = args.in[6] + (size_t)(lo * 2 + 1) * DM; A.modl = modO; A.shoff = 3 * DM; A.scoff = 4 * DM; A.U = U;
            A.router = args.in[22] + (size_t)j * DM * NE; A.eidx = (int*)(ws + WS_EIDX); A.gout = (float*)(ws + WS_GATE); A.cnt = (int*)(ws + WS_CNT);
            REP(4) row_phase<false, 1, true>(F, A, nro);
        }
#endif
        GRID_BAR();
#if PH(17)
        REP(4) o5_phase(F, nro);
#endif
        GRID_BAR();
#if PH(18)
        {
            const int* TST = (const int*)(ws + WS_TST);
            const int ts1 = TST[1], ts2 = TST[2], ts3 = TST[3], ts4 = TST[4], ts5 = TST[5], ts6 = TST[6], ts7 = TST[7], nT = TST[8];
            for (int c = 0; c * MOE_CH < nT; ++c) {
                const int t0 = c * MOE_CH, nrt = (nT - t0) < MOE_CH ? (nT - t0) : MOE_CH;
                {
                    pg8::Gemm g{(const bf16*)(ws + WS_VG), (const bf16*)(ws + WS_MWGU), DM, DM, DM};
                    pg8::MoeOrder S{t0, nrt, 2 * DFE / 256, F.G, (int)blockIdx.x, ts1, ts2, ts3, ts4, ts5, ts6, ts7};
                    EpiGateUp E{(bf16*)(ws + WS_HIDM), DFE, 2 * DFE / 256, t0 * 256};
                    REP(8) pg8::gemm_phase<EpiGateUp, pg8::MoeOrder, true>(ring, g, S, E, F.wave);
                }
                GRID_BAR();
                {
                    pg8::Gemm g{(const bf16*)(ws + WS_HIDM) - (size_t)t0 * 256 * DFE, (const bf16*)(ws + WS_MWDN), DFE, DFE, DFE};
                    pg8::MoeOrder S{t0, nrt, DM / 256, F.G, (int)blockIdx.x, ts1, ts2, ts3, ts4, ts5, ts6, ts7};
                    EpiY E{(bf16*)(ws + WS_VG), DM / 256};
                    REP(8) pg8::gemm_phase<EpiY, pg8::MoeOrder, true>(ring, g, S, E, F.wave);
                }
                GRID_BAR();
            }
        }
#endif
    }
#if PH(19)
    {
        RowArgs A{}; A.hin_l = args.out; A.hin_c = HC; A.hout_l = args.out; A.hout_c = HC; A.g = args.in[7];
        A.Y = (const bf16*)(ws + WS_VG); A.pos = (const int*)(ws + WS_POS); A.gate = (const float*)(ws + WS_GATE); A.modprev = MODV + (size_t)3 * 17 * NMOD;
        row_phase<true, 2, false>(F, A, M);
        if (xb_ld((unsigned*)(ws + WS_CTL) + CW_BAR + XB_TMO) != 0u) { __syncthreads(); const float qn = __builtin_nanf(""); for (int i = F.tid; i < 1024; i += 512) args.out[(size_t)blockIdx.x * 1024 + i] = qn; }
    }
#endif
}

extern "C" void kernel_launch(void* const* d_in, const int* in_sizes, int n_in, void* d_out, int out_size, void* d_ws, size_t ws_size, hipStream_t stream) {
    static int grid = 0;
    if (grid == 0) {
        if (n_in != 26 || out_size != M * DM || ws_size < WS_END) { fprintf(stderr, "kernel_launch: unexpected shapes (n_in %d out %d ws %zu)\n", n_in, out_size, ws_size); grid = -1; return; }
        int dev = 0, cus = 0, per_cu = 0;
        if (hipGetDevice(&dev) != hipSuccess || hipDeviceGetAttribute(&cus, hipDeviceAttributeMultiprocessorCount, dev) != hipSuccess) { grid = -1; return; }
        if (hipFuncSetAttribute((const void*)mega_fwd, hipFuncAttributeMaxDynamicSharedMemorySize, LDS_BYTES) != hipSuccess) { grid = -1; return; }
        if (hipOccupancyMaxActiveBlocksPerMultiprocessor(&per_cu, (const void*)mega_fwd, NWAVES * 64, LDS_BYTES) != hipSuccess || per_cu < 1) fprintf(stderr, "kernel_launch: occupancy query says %d\n", per_cu);
        (void)hipGetLastError();
        grid = cus > 256 ? 256 : cus;
    }
    if (grid < 0) return;
    if (hipMemsetAsync((char*)d_ws + WS_CTL, 0, CTL_ZERO_BYTES, stream) != hipSuccess) return;
    Args a{};
    for (int i = 0; i < 26; ++i) a.in[i] = (const float*)d_in[i];
    a.out = (float*)d_out; a.ws = (unsigned char*)d_ws;
    hipLaunchKernelGGL(mega_fwd, dim3(grid), dim3(NWAVES * 64), LDS_BYTES, stream, a);
}
```

```cpp
#include <hip/hip_runtime.h>
#ifndef DUPMASK
#define DUPMASK 0
#endif
#include <cstdio>
#include <cstdint>

__device__ __forceinline__ int lane_now() { int l; asm volatile("v_mbcnt_lo_u32_b32 %0, -1, 0\n\tv_mbcnt_hi_u32_b32 %0, -1, %0" : "=v"(l)); return l; }
namespace pg8 {
#define PG8_LAS __attribute__((address_space(3)))
typedef unsigned short bf16_t;
typedef short bf16x8 __attribute__((ext_vector_type(8)));
typedef float f32x4 __attribute__((ext_vector_type(4)));
typedef unsigned u32x4 __attribute__((ext_vector_type(4)));
constexpr int BM = 256, BK = 64, HALF = 128, HTB = HALF * BK * 2, STAGE_BYTES = 8 * HTB, NXCD = 8, WGM = 8;

__host__ __device__ __forceinline__ int lds_byte(int r, int c) { const int st = (r >> 4) * 2 + (c >> 5), rr = r & 15, cc = c & 31, ob = rr * 64 + cc * 2; return st * 1024 + (ob ^ (((ob >> 9) & 1) << 5)); }
__host__ __device__ __forceinline__ void stage_rc(int b, int& R, int& C) { const int st = b / 1024, sb = b % 1024, swz = sb ^ (((sb >> 9) & 1) << 5); R = (st >> 1) * 16 + swz / 64; C = (st & 1) * 32 + (swz % 64) / 2; }
__host__ __device__ __forceinline__ int perm32(int rho) { const int n = rho >> 4, i = rho & 15; return 8 * (i >> 2) + 4 * n + (i & 3); }

struct Unit { int pm, pn; };
struct Gemm { const bf16_t* A; const bf16_t* Bt; int lda, ldb, K; };

struct StaticOrder {
    int nM, nN, nwg, G, c;
    __device__ void init(int M, int N, int G_, int c_) { nM = M / BM; nN = N / BM; nwg = nM * nN; G = G_; c = c_; }
    __device__ bool next(int i, Unit& u) const {
        const long L = (long)i * G + c; if (L >= nwg) return false;
        int wgid = (int)L; { const int q = nwg / NXCD, r = nwg % NXCD, xcd = wgid % NXCD, off = wgid / NXCD; wgid = (xcd < r ? xcd * (q + 1) : r * (q + 1) + (xcd - r) * q) + off; }
        const int nig = WGM * nN, gid = wgid / nig, fm = gid * WGM, gsz = (nM - fm) < WGM ? (nM - fm) : WGM;
        u.pm = fm + ((wgid % nig) % gsz); u.pn = (wgid % nig) / gsz; return true;
    }
};
struct PoolOrder {
    int nrt, talloc, G, c;
    __device__ bool next(int i, Unit& u) const { const int L = i * G + c; if (L >= 4 * nrt) return false; const int g = L / nrt, rt = L - g * nrt; u.pm = g * talloc + rt; u.pn = g; return true; }
};
struct MoeOrder {
    int t0, nrt, nct, G, c; int ts1, ts2, ts3, ts4, ts5, ts6, ts7;
    __device__ bool next(int i, Unit& u) const {
        const int nwg = nrt * nct; const int L = i * G + c; if (L >= nwg) return false;
        int wgid = L; { const int q = nwg / NXCD, r = nwg % NXCD, xcd = wgid % NXCD, off = wgid / NXCD; wgid = (xcd < r ? xcd * (q + 1) : r * (q + 1) + (xcd - r) * q) + off; }
        const int nig = WGM * nct, gid = wgid / nig, fm = gid * WGM, gsz = (nrt - fm) < WGM ? (nrt - fm) : WGM;
        const int rt = t0 + fm + ((wgid % nig) % gsz), ct = (wgid % nig) / gsz;
        const int e = (rt >= ts1) + (rt >= ts2) + (rt >= ts3) + (rt >= ts4) + (rt >= ts5) + (rt >= ts6) + (rt >= ts7);
        u.pm = rt; u.pn = e * nct + ct; return true;
    }
};

__device__ __forceinline__ unsigned cvt_pk_bf16(float lo, float hi) { unsigned r; asm volatile("v_cvt_pk_bf16_f32 %0, %1, %2" : "=v"(r) : "v"(lo), "v"(hi)); return r; }

template <class Epi, class Sched, bool ALIGN_EPI>
__device__ __forceinline__ void gemm_phase(PG8_LAS unsigned char* lds, const Gemm g, const Sched& S, const Epi& E, const int wid) {
    const int lane_ = lane_now();
    const int lane = lane_, tid = wid * 64 + lane, wr = wid >> 2, wc = wid & 3, fr = lane & 15, fq = lane >> 4;
    int K_ = g.K; asm volatile("" : "+s"(K_));
    const int K = K_, nt = K / BK;
    unsigned voffA[2], voffB[2];
#pragma unroll
    for (int i = 0; i < 2; ++i) { int R, C; stage_rc(tid * 16 + i * 8192, R, C); const int Rb = Epi::PERM ? ((R & ~31) + perm32(R & 31)) : R;
        voffA[i] = (unsigned)(R * g.lda + C) * 2u; voffB[i] = (unsigned)(Rb * g.ldb + C) * 2u; }
    const size_t kstep = (size_t)(BK * 2);
    const size_t hstepA = (size_t)HALF * g.lda * 2, hstepB = (size_t)HALF * g.ldb * 2;
    const size_t tstepA = 2 * hstepA, tstepB = 2 * hstepB;
    const unsigned ldsw = (unsigned)wid * 1024u;
    const int aoff = lds_byte(wr * 64 + fr, fq * 8), boff = lds_byte(wc * 32 + fr, fq * 8);
#define PG8_SA(b, h) (((b) * 2 + (h)) * HTB)
#define PG8_SB(b, h) ((4 + (b) * 2 + (h)) * HTB)
#define PG8_STAGE(bufoff, gbase, voff) do { _Pragma("unroll") for (int _i = 0; _i < 2; ++_i) \
        __builtin_amdgcn_global_load_lds((const unsigned*)((const char*)(gbase) + (voff)[_i]), (PG8_LAS unsigned*)(lds + (bufoff) + ldsw + _i * 8192), 16, 0, 0); } while (0)
#define PG8_LDA(dst, b, h) do { _Pragma("unroll") for (int m = 0; m < 4; ++m) _Pragma("unroll") for (int k = 0; k < 2; ++k) dst[m][k] = *(const PG8_LAS bf16x8*)(lds + PG8_SA(b, h) + aoff + m * 2048 + k * 1024); } while (0)
#define PG8_LDB(dst, b, h) do { _Pragma("unroll") for (int n = 0; n < 2; ++n) _Pragma("unroll") for (int k = 0; k < 2; ++k) dst[n][k] = *(const PG8_LAS bf16x8*)(lds + PG8_SB(b, h) + boff + n * 2048 + k * 1024); } while (0)
#define PG8_MMA(ai, bj, At, Bt) do { __builtin_amdgcn_s_setprio(1); _Pragma("unroll") for (int m = 0; m < 4; ++m) _Pragma("unroll") for (int n = 0; n < 2; ++n) _Pragma("unroll") for (int k = 0; k < 2; ++k) \
        acc[ai][bj][m][n] = __builtin_amdgcn_mfma_f32_16x16x32_bf16(Bt[n][k], At[m][k], acc[ai][bj][m][n], 0, 0, 0); __builtin_amdgcn_s_setprio(0); } while (0)
#define PG8_WAIT_V(n) asm volatile("s_waitcnt vmcnt(" #n ")" ::: "memory")
#define PG8_WAIT_L(n) asm volatile("s_waitcnt lgkmcnt(" #n ")" ::: "memory")
#define PG8_BAR __builtin_amdgcn_s_barrier()
#define PG8_SCHED __builtin_amdgcn_sched_barrier(0)
    Unit cur, nxt; int ui = 0;
    if (!S.next(0, cur)) return;
    f32x4 acc[2][2][4][2];
#pragma unroll
    for (int a = 0; a < 2; ++a)
#pragma unroll
        for (int b = 0; b < 2; ++b)
#pragma unroll
            for (int m = 0; m < 4; ++m)
#pragma unroll
                for (int n = 0; n < 2; ++n) acc[a][b][m][n] = (f32x4){0.f, 0.f, 0.f, 0.f};
    bf16x8 At[4][2], B0[2][2], B1[2][2];
    const char* cA = (const char*)g.A + (size_t)cur.pm * tstepA; const char* cB = (const char*)g.Bt + (size_t)cur.pn * tstepB;
    PG8_STAGE(PG8_SB(0, 0), cB, voffB); PG8_STAGE(PG8_SB(0, 1), cB + hstepB, voffB); PG8_STAGE(PG8_SA(0, 0), cA, voffA); PG8_STAGE(PG8_SA(0, 1), cA + hstepA, voffA);
    if (wr == 1) PG8_BAR;
    PG8_WAIT_V(2); PG8_BAR;
    PG8_STAGE(PG8_SB(1, 0), cB + kstep, voffB); PG8_STAGE(PG8_SA(1, 0), cA + kstep, voffA); PG8_STAGE(PG8_SB(1, 1), cB + hstepB + kstep, voffB);
    PG8_WAIT_V(6); PG8_BAR;
    for (;;) {
        const bool has_next = S.next(ui + 1, nxt);
        const char* nA = has_next ? (const char*)g.A + (size_t)nxt.pm * tstepA : cA; const char* nB = has_next ? (const char*)g.Bt + (size_t)nxt.pn * tstepB : cB;
#pragma unroll 1
        for (int t = 0; t < nt; t += 2) {
            const bool last = (t == nt - 2);
            const char* a1 = cA + (size_t)(t + 1) * kstep;
            const char* a2 = last ? nA : cA + (size_t)(t + 2) * kstep; const char* b2 = last ? nB : cB + (size_t)(t + 2) * kstep;
            const char* a3 = a2 + kstep; const char* b3 = b2 + kstep;
            PG8_LDB(B0, 0, 0); PG8_LDB(B1, 0, 1); PG8_SCHED; PG8_LDA(At, 0, 0); PG8_STAGE(PG8_SA(1, 1), a1 + hstepA, voffA);
            PG8_WAIT_V(8); PG8_WAIT_L(0); PG8_BAR; PG8_MMA(0, 0, At, B0); PG8_MMA(0, 1, At, B1); PG8_BAR; PG8_SCHED;
            PG8_LDA(At, 0, 1); PG8_STAGE(PG8_SB(0, 0), b2, voffB); PG8_STAGE(PG8_SB(0, 1), b2 + hstepB, voffB); PG8_STAGE(PG8_SA(0, 0), a2, voffA);
            PG8_WAIT_V(8); PG8_WAIT_L(0); PG8_BAR; PG8_MMA(1, 0, At, B0); PG8_MMA(1, 1, At, B1); PG8_BAR; PG8_SCHED;
            PG8_LDB(B0, 1, 0); PG8_LDB(B1, 1, 1); PG8_SCHED; PG8_LDA(At, 1, 0); PG8_STAGE(PG8_SA(0, 1), a2 + hstepA, voffA);
            PG8_WAIT_V(8); PG8_WAIT_L(0); PG8_BAR; PG8_MMA(0, 0, At, B0); PG8_MMA(0, 1, At, B1); PG8_BAR; PG8_SCHED;
            PG8_LDA(At, 1, 1); PG8_STAGE(PG8_SB(1, 0), b3, voffB); PG8_STAGE(PG8_SB(1, 1), b3 + hstepB, voffB); PG8_STAGE(PG8_SA(1, 0), a3, voffA);
            PG8_WAIT_V(8); PG8_WAIT_L(0); PG8_BAR; PG8_MMA(1, 0, At, B0); PG8_MMA(1, 1, At, B1); PG8_BAR; PG8_SCHED;
        }
        if constexpr (ALIGN_EPI) { if (wr == 0) PG8_BAR; }
        E(acc, cur, wr, wc, fr, fq);
        if (!has_next) break;
#pragma unroll
        for (int a = 0; a < 2; ++a)
#pragma unroll
            for (int b = 0; b < 2; ++b)
#pragma unroll
                for (int m = 0; m < 4; ++m)
#pragma unroll
                    for (int n = 0; n < 2; ++n) acc[a][b][m][n] = (f32x4){0.f, 0.f, 0.f, 0.f};
        cur = nxt; cA = nA; cB = nB; ++ui;
        if constexpr (ALIGN_EPI) { if (wr == 1) PG8_BAR; }
    }
    PG8_WAIT_V(0);
    if constexpr (!ALIGN_EPI) { if (wr == 0) PG8_BAR; }
    PG8_BAR;
#undef PG8_SA
#undef PG8_SB
#undef PG8_STAGE
#undef PG8_LDA
#undef PG8_LDB
#undef PG8_MMA
#undef PG8_WAIT_V
#undef PG8_WAIT_L
#undef PG8_BAR
#undef PG8_SCHED
}
}

constexpr int NWAVES = 8;
constexpr int DM = 1024, NB = 16, SEQ = 2048, CTXL = 256;
constexpr int M = NB * SEQ, MC = NB * CTXL, MT = M + MC;
constexpr int QL = 384, KVL = 256, ROPE = 32, HW = 512, NH = 8, QKD = 96, VD = 64;
constexpr int INW = 3232, INP = 3328;
constexpr int DFF = 2816, NE = 8, DFE = 3584, NMOD = 6 * DM;
constexpr int NHH = 4, HK = 128; constexpr int NKEY = SEQ + CTXL;
constexpr float EPS = 1e-6f;
constexpr int MAXT = 296;
constexpr int MOE_CH = 128;

constexpr size_t MiB = 1u << 20;
constexpr size_t WS_CTL = 0, CTL_ZERO_BYTES = 1 * MiB;
constexpr size_t WS_MODV = 1 * MiB;
constexpr size_t WS_ROPE = 3 * MiB;
constexpr size_t WS_CNT = 3 * MiB + 64 * 1024;
constexpr size_t WS_TST = 3 * MiB + 128 * 1024;
constexpr size_t WS_EIDX = 4 * MiB, WS_GATE = 4 * MiB + 512 * 1024, WS_POS = 5 * MiB;
constexpr size_t WS_RSQ = 6 * MiB, WS_RSKV = 6 * MiB + 256 * 1024;
constexpr size_t WS_HC = 8 * MiB;
constexpr size_t WS_WIN = 24 * MiB, WS_WUQ = 37 * MiB, WS_WUKV = 39 * MiB, WS_WOUT = 40 * MiB, WS_WGU = 44 * MiB, WS_WDN = 66 * MiB, WS_WPOOL = 77 * MiB;
constexpr size_t WS_U = 80 * MiB;
constexpr size_t WS_X = 152 * MiB;
constexpr size_t WS_CQ = WS_X, WS_CKV = 179 * MiB, WS_KR = 197 * MiB, WS_KRR = 200 * MiB, WS_HQ = 203 * MiB  ;
constexpr size_t WS_QB = 383 * MiB, WS_KN = 437 * MiB, WS_VV = 473 * MiB, WS_OF = 509 * MiB, WS_OB = 581 * MiB, WS_MIX = 653 * MiB, WS_HID = WS_X;
constexpr size_t WS_MWGU = WS_X, WS_MWDN = 264 * MiB, WS_POOLED = 320 * MiB, WS_VG = 392 * MiB, WS_HIDM = 540 * MiB, WS_END = 800 * MiB;
constexpr size_t HSEG = (size_t)MT * HW;
static_assert(WS_HQ + 5 * HSEG * 2 <= WS_QB && WS_MIX + (size_t)MT * DM * 2 <= WS_END && WS_HID + (size_t)MT * DFF * 2 <= WS_QB, "ws map even");
static_assert(WS_HIDM + (size_t)MOE_CH * 256 * DFE * 2 <= WS_END && WS_VG + (size_t)MAXT * 256 * DM * 2 <= WS_HIDM && WS_MWDN + (size_t)NE * DM * DFE * 2 <= WS_POOLED && WS_MWGU + (size_t)NE * 2 * DFE * DM * 2 <= WS_MWDN, "ws map odd");
constexpr int CW_BAR = 4096;

constexpr int RING_OFF = 0, RING_BYTES = 131072;
constexpr int LDSCTL_OFF = RING_BYTES, MISC_OFF = LDSCTL_OFF + 320;
constexpr int LDS_BYTES = 147456;

#define GAS __attribute__((address_space(1)))
#define LAS __attribute__((address_space(3)))
typedef unsigned short bf16;
typedef unsigned v4u __attribute__((ext_vector_type(4)));
typedef unsigned v2u __attribute__((ext_vector_type(2)));
typedef float f32x4 __attribute__((ext_vector_type(4)));
typedef GAS unsigned gu32;
#define RLX_AGENT __ATOMIC_RELAXED, __HIP_MEMORY_SCOPE_AGENT
#define LDS_WAIT() asm volatile("s_waitcnt lgkmcnt(0)" ::: "memory")
__device__ __forceinline__ unsigned f2bf(float f) { unsigned u = __builtin_bit_cast(unsigned, f); return (u + 0x7fffu + ((u >> 16) & 1u)) >> 16; }
__device__ __forceinline__ unsigned pk2(float lo, float hi) { return f2bf(lo) | (f2bf(hi) << 16); }
__device__ __forceinline__ float bf2f(unsigned short b) { return __uint_as_float((unsigned)b << 16); }
__device__ __forceinline__ float bflo(unsigned w) { return __uint_as_float(w << 16); }
__device__ __forceinline__ float bfhi(unsigned w) { return __uint_as_float(w & 0xffff0000u); }
__device__ __forceinline__ float sigmoidf_(float x) { return 1.0f / (1.0f + __expf(-x)); }
__device__ __forceinline__ float siluf_(float x) { return x / (1.0f + __expf(-x)); }

#define XB_TMO      128
#define XB_XCNT(j)  (256  + 64 * (j))
#define XB_XSUB(j)  (1280 + 64 * (j))
#define XB_XGEN(j)  (2304 + 64 * (j))
#define XB_TOP      3328
#define XB_TOPGEN   3392
#define XCD_BAR_WORDS 3456
#define XB_SPIN_CAP (1u << 22)
__device__ __forceinline__ unsigned xb_ld(unsigned* p)              { return __hip_atomic_load(p, __ATOMIC_RELAXED, __HIP_MEMORY_SCOPE_AGENT); }
__device__ __forceinline__ unsigned xb_add(unsigned* p, unsigned v) { return __hip_atomic_fetch_add(p, v, __ATOMIC_RELAXED, __HIP_MEMORY_SCOPE_AGENT); }
__device__ __forceinline__ unsigned xb_xcc_id() { return (unsigned)__builtin_amdgcn_s_getreg((3 << 11) | 20) & 0xFu; }
#define XB_SPIN(cond, bar) do { unsigned _sp = 0; while (cond) { __builtin_amdgcn_s_sleep(1); \
    if ((++_sp & 255u) == 0u) { if (xb_ld(&(bar)[XB_TMO])) break; if (_sp > XB_SPIN_CAP) { atomicAdd(&(bar)[XB_TMO], 1u); break; } } } } while (0)
struct XcdBarrier { unsigned* bar; unsigned x; volatile LAS unsigned* st; int wave; };
__device__ __forceinline__ bool xb_leader(int wave) { return wave == 0 && lane_now() == 0; }
__device__ __forceinline__ XcdBarrier xcd_barrier_post(unsigned* bar, volatile LAS unsigned* st, int wave) {
    XcdBarrier b; b.bar = bar; b.x = xb_xcc_id(); b.st = st; b.wave = wave;
    if (xb_leader(wave)) (void)xb_add(&bar[XB_XCNT(b.x)], 1u);
    return b;
}
__device__ __forceinline__ void xcd_barrier_complete(unsigned* bar, unsigned x, unsigned& nloc, unsigned& nx) {
    const unsigned G = gridDim.x * gridDim.y * gridDim.z;
    unsigned sum, cnt, mine, sp = 0u;
    for (;;) {
        sum = 0u; cnt = 0u; mine = 0u;
#pragma unroll
        for (unsigned j = 0; j < 16; ++j) { const unsigned c = xb_ld(&bar[XB_XCNT(j)]); sum += c; cnt += (c > 0u) ? 1u : 0u; mine = (j == x) ? c : mine; }
        if (sum == G) break;
        __builtin_amdgcn_s_sleep(1);
        if ((++sp & 255u) == 0u) { if (xb_ld(&bar[XB_TMO])) break; if (sp > XB_SPIN_CAP) { atomicAdd(&bar[XB_TMO], 1u); break; } }
    }
    nloc = mine > 0u ? mine : 1u; nx = cnt > 0u ? cnt : 1u;
}
__device__ __forceinline__ void xcd_barrier(const XcdBarrier& b) {
    asm volatile("s_waitcnt vmcnt(0)" ::: "memory");
    __syncthreads();
    if (xb_leader(b.wave)) {
        unsigned* bar = b.bar; asm volatile("" : "+s"(bar));
        __builtin_amdgcn_s_waitcnt(0);
        unsigned nloc = b.st[0], nx = b.st[1];
        if (nloc == 0u) { xcd_barrier_complete(bar, b.x, nloc, nx); b.st[0] = nloc; b.st[1] = nx; }
        const unsigned old = xb_add(&bar[XB_XSUB(b.x)], 1u);
        const unsigned gen = old / nloc;
        if (old + 1u == (gen + 1u) * nloc) {
            __builtin_amdgcn_fence(__ATOMIC_RELEASE, "agent");
            asm volatile("s_waitcnt vmcnt(0)" ::: "memory");
            const unsigned og = xb_add(&bar[XB_TOP], 1u);
            const unsigned tg = og / nx;
            if (og + 1u == (tg + 1u) * nx) xb_add(&bar[XB_TOPGEN], 1u);
            else XB_SPIN(xb_ld(&bar[XB_TOPGEN]) == tg, bar);
            __builtin_amdgcn_fence(__ATOMIC_ACQUIRE, "agent");
            xb_add(&bar[XB_XGEN(b.x)], 1u);
            asm volatile("s_waitcnt vmcnt(0)" ::: "memory");
        } else {
            XB_SPIN(xb_ld(&bar[XB_XGEN(b.x)]) == gen, bar);
            __builtin_amdgcn_fence(__ATOMIC_ACQUIRE, "agent");
            asm volatile("s_waitcnt vmcnt(0)" ::: "memory");
        }
    }
    __syncthreads();
}

struct Args { const float* in[26]; float* out; unsigned char* ws; };
struct Frame {
    LAS unsigned char* lds;
    int tid, lane, wave, G, vcu;
    const float* const* in; float* out; unsigned char* ws;
};
__device__ __forceinline__ float shx(float v, int lane, int m) { return __int_as_float(__builtin_amdgcn_ds_bpermute((lane ^ m) << 2, __float_as_int(v))); }
__device__ __forceinline__ float wave_sum(float v, int lane) {
#pragma unroll
    for (int o = 1; o < 64; o <<= 1) v += shx(v, lane, o);
    return v;
}

__device__ __forceinline__ void fresh(Frame& F) { const int l = lane_now(); F.lane = l; F.tid = F.wave * 64 + l; }

__device__ __forceinline__ void conv_item(const float* W, int ldw, bf16* WT, int ldd, int k0, int n0, int drow0, const float* kscale, float gscale, LAS float* scr, int lane) {
    float wv[32];
#pragma unroll
    for (int i = 0; i < 32; ++i) { const int kk = 2 * i + (lane >> 5); wv[i] = W[(size_t)(k0 + kk) * ldw + n0 + (lane & 31)]; }
#pragma unroll
    for (int i = 0; i < 32; ++i) { const int kk = 2 * i + (lane >> 5); float w = wv[i]; if (kscale) w *= kscale[k0 + kk]; scr[kk * 33 + (lane & 31)] = w * gscale; }
    LDS_WAIT(); asm volatile("" ::: "memory");
    const int c = lane & 7;
#pragma unroll
    for (int j = 0; j < 4; ++j) { const int n = (lane >> 3) + 8 * j; const LAS float* s = scr + (8 * c) * 33 + n;
        v4u o; o.x = pk2(s[0 * 33], s[1 * 33]); o.y = pk2(s[2 * 33], s[3 * 33]); o.z = pk2(s[4 * 33], s[5 * 33]); o.w = pk2(s[6 * 33], s[7 * 33]);
        *(v4u*)(WT + (size_t)(drow0 + n) * ldd + k0 + 8 * c) = o; }
    LDS_WAIT(); asm volatile("" ::: "memory");
}
__device__ __forceinline__ int conv_rowmap(int mode, int n0, int off) {
    if (mode == 0) return n0 + off;
    if (mode == 1) { if (n0 < 384) return n0; if (n0 < 640) return 512 + (n0 - 384); if (n0 < 672) return 384; return 768 + (n0 - 672); }
    return 256 * (n0 >> 7) + (n0 & 127) + off;
}
__device__ __forceinline__ void conv_matrix(Frame& F, const float* W, int K, int N, bf16* WT, int ldd, int mode, int off, const float* kscale, float gscale) {
    LAS float* scr = (LAS float*)(F.lds + RING_OFF + F.wave * 16384);
    const int gw = F.vcu * NWAVES + F.wave, NGW = F.G * NWAVES;
    const int nblk = N / 32, nitems = (K / 64) * nblk;
    for (int it = gw; it < nitems; it += NGW) { const int kb = it / nblk, nb = it % nblk; conv_item(W, N, WT, ldd, 64 * kb, 32 * nb, conv_rowmap(mode, 32 * nb, off), kscale, gscale, scr, F.lane); }
}

__device__ __forceinline__ int row_bidx(int row) { return row < M ? row / SEQ : NB; }

struct RowArgs {
    const float* hin_l; const float* hin_c; float* hout_l; float* hout_c;
    const float* g;
    const float* modl;
    int shoff, scoff;
    bf16* U;
    const bf16* Y; const int* pos; const float* gate; const float* modprev;
    const float* router; int* eidx; float* gout; int* cnt;
};
template <bool COMBINE, int OUTMODE, bool ROUTER>
__device__ __forceinline__ void row_phase(Frame& F, const RowArgs& A, int nrows) {
    fresh(F);
    const int rpw = (nrows + F.G - 1) / F.G;
    LAS int* lcnt = (LAS int*)(F.lds + RING_OFF);
    if (ROUTER) { if (F.tid < 8) lcnt[F.tid] = 0; __syncthreads(); }
    const int rbase = (int)blockIdx.x * rpw, rend = (rbase + rpw < nrows) ? rbase + rpw : nrows;
#define ROWPTR(r_) (((r_) < M) ? A.hin_l + (size_t)(r_) * DM : A.hin_c + (size_t)((r_) - M) * DM)
    f32x4 rw[16][2];
    if (ROUTER) {
#pragma unroll
        for (int j = 0; j < 4; ++j)
#pragma unroll
            for (int q = 0; q < 4; ++q) { const int col = 4 * F.lane + 256 * j + q; rw[4 * j + q][0] = *(const f32x4*)(A.router + (size_t)col * 8); rw[4 * j + q][1] = *(const f32x4*)(A.router + (size_t)col * 8 + 4); }
    }
    int row = rbase + F.wave;
    f32x4 v[4], vn[4];
    if (row < rend) { const float* hr = ROWPTR(row);
#pragma unroll
        for (int j = 0; j < 4; ++j) v[j] = *(const f32x4*)(hr + 4 * F.lane + 256 * j); }
    for (; row < rend; row += NWAVES) {
        const bool lat = row < M; const int bidx = lat ? row / SEQ : NB;
        const int rnext = row + NWAVES;
        if (rnext < rend) { const float* hr = ROWPTR(rnext);
#pragma unroll
            for (int j = 0; j < 4; ++j) vn[j] = *(const f32x4*)(hr + 4 * F.lane + 256 * j); }
        if (COMBINE) {
            const int pa = A.pos[2 * row], pb = A.pos[2 * row + 1]; const float ga = A.gate[2 * row], gb = A.gate[2 * row + 1];
            const float* g2 = A.modprev + bidx * NMOD + 5 * DM;
#pragma unroll
            for (int j = 0; j < 4; ++j) { const int col = 4 * F.lane + 256 * j;
                const v2u ya = *(const v2u*)(A.Y + (size_t)pa * DM + col), yb = *(const v2u*)(A.Y + (size_t)pb * DM + col); const f32x4 gv = *(const f32x4*)(g2 + col);
                v[j].x += gv.x * (ga * bflo(ya.x) + gb * bflo(yb.x)); v[j].y += gv.y * (ga * bfhi(ya.x) + gb * bfhi(yb.x));
                v[j].z += gv.z * (ga * bflo(ya.y) + gb * bflo(yb.y)); v[j].w += gv.w * (ga * bfhi(ya.y) + gb * bfhi(yb.y)); }
            if (OUTMODE != 2) { float* ho = lat ? A.hout_l + (size_t)row * DM : A.hout_c + (size_t)(row - M) * DM;
#pragma unroll
                for (int j = 0; j < 4; ++j) *(f32x4*)(ho + 4 * F.lane + 256 * j) = v[j]; }
        }
        float s = 0.f;
#pragma unroll
        for (int j = 0; j < 4; ++j) s += (v[j].x * v[j].x + v[j].y * v[j].y) + (v[j].z * v[j].z + v[j].w * v[j].w);
        const float rstd = rsqrtf(wave_sum(s, F.lane) * (1.0f / DM) + EPS);
        if (OUTMODE == 2) {
            float* ho = A.hout_l + (size_t)row * DM;
#pragma unroll
            for (int j = 0; j < 4; ++j) { const int col = 4 * F.lane + 256 * j; const f32x4 gv = *(const f32x4*)(A.g + col); *(f32x4*)(ho + col) = v[j] * rstd * gv; }
        } else {
            const float* sh = A.modl + bidx * NMOD + A.shoff; const float* sc = A.modl + bidx * NMOD + A.scoff;
            float lg[8];
            if (ROUTER) {
#pragma unroll
                for (int e = 0; e < 8; ++e) lg[e] = 0.f;
            }
#pragma unroll
            for (int j = 0; j < 4; ++j) { const int col = 4 * F.lane + 256 * j; const f32x4 gv = *(const f32x4*)(A.g + col), shv = *(const f32x4*)(sh + col), scv = *(const f32x4*)(sc + col);
                f32x4 y = v[j] * rstd * gv * (scv + 1.0f) + shv;
                v2u o; o.x = pg8::cvt_pk_bf16(y.x, y.y); o.y = pg8::cvt_pk_bf16(y.z, y.w); *(v2u*)(A.U + (size_t)row * DM + col) = o;
                if (ROUTER) {
#pragma unroll
                    for (int q = 0; q < 4; ++q) { const f32x4 r0 = rw[4 * j + q][0], r1 = rw[4 * j + q][1]; const float yy = y[q];
                        lg[0] += yy * r0.x; lg[1] += yy * r0.y; lg[2] += yy * r0.z; lg[3] += yy * r0.w; lg[4] += yy * r1.x; lg[5] += yy * r1.y; lg[6] += yy * r1.z; lg[7] += yy * r1.w; } }
            }
            if (ROUTER) {
                const int b5 = F.lane >> 5, b4 = (F.lane >> 4) & 1, b3 = (F.lane >> 3) & 1; float a4[4], c2[2];
#pragma unroll
                for (int q = 0; q < 4; ++q) { const float mine = b5 ? lg[4 + q] : lg[q], oth = b5 ? lg[q] : lg[4 + q]; a4[q] = mine + shx(oth, F.lane, 32); }
#pragma unroll
                for (int q = 0; q < 2; ++q) { const float mine = b4 ? a4[2 + q] : a4[q], oth = b4 ? a4[q] : a4[2 + q]; c2[q] = mine + shx(oth, F.lane, 16); }
                float d1 = (b3 ? c2[1] : c2[0]) + shx(b3 ? c2[0] : c2[1], F.lane, 8);
                d1 += shx(d1, F.lane, 4); d1 += shx(d1, F.lane, 2); d1 += shx(d1, F.lane, 1);
#pragma unroll
                for (int e = 0; e < 8; ++e) lg[e] = __int_as_float(__builtin_amdgcn_readlane(__float_as_int(d1), 8 * e));
                int i0 = 0; float v0 = lg[0];
#pragma unroll
                for (int e = 1; e < 8; ++e) if (lg[e] > v0) { v0 = lg[e]; i0 = e; }
                int i1 = -1; float v1 = -INFINITY;
#pragma unroll
                for (int e = 0; e < 8; ++e) if (e != i0 && lg[e] > v1) { v1 = lg[e]; i1 = e; }
                const float g0 = 1.0f / (1.0f + __expf(v1 - v0));
                if (F.lane == 0) { A.eidx[2 * row] = i0; A.eidx[2 * row + 1] = i1; A.gout[2 * row] = g0; A.gout[2 * row + 1] = 1.0f - g0; atomicAdd((int*)&lcnt[i0], 1); atomicAdd((int*)&lcnt[i1], 1); }
            }
        }
#pragma unroll
        for (int j = 0; j < 4; ++j) v[j] = vn[j];
    }
#undef ROWPTR
    if (ROUTER) { __syncthreads(); if (F.tid < 8) A.cnt[blockIdx.x * 8 + F.tid] = lcnt[F.tid]; __syncthreads(); }
}

using pg8::Unit; using pg8::cvt_pk_bf16;
__device__ __forceinline__ v4u pack8(const f32x4& a, const f32x4& b) { v4u w; w.x = cvt_pk_bf16(a[0], a[1]); w.y = cvt_pk_bf16(a[2], a[3]); w.z = cvt_pk_bf16(b[0], b[1]); w.w = cvt_pk_bf16(b[2], b[3]); return w; }
struct EpiIn {
    static constexpr bool PERM = true;
    bf16 *CQ, *KR, *CKV, *H5;
    __device__ __forceinline__ void operator()(const f32x4 (&acc)[2][2][4][2], const Unit& u, int wr, int wc, int fr, int fq) const {
        const int row0 = u.pm * 256 + wr * 64 + fr;
#pragma unroll
        for (int bj = 0; bj < 2; ++bj) {
            const int col = u.pn * 256 + bj * 128 + wc * 32 + 8 * fq;
            bf16* base; int ld;
            if (col < 384) { base = CQ + col; ld = QL; }
            else if (col < 416) { base = KR + (col - 384); ld = ROPE; }
            else if (col < 512) { base = nullptr; ld = 0; }
            else if (col < 768) { base = CKV + (col - 512); ld = KVL; }
            else { const int c2 = col - 768; base = H5 + (size_t)(c2 >> 9) * HSEG + (c2 & 511); ld = HW; }
            if (base) {
#pragma unroll
                for (int ai = 0; ai < 2; ++ai)
#pragma unroll
                    for (int m = 0; m < 4; ++m) { const int row = row0 + ai * 128 + m * 16; *(v4u*)(base + (size_t)row * ld) = pack8(acc[ai][bj][m][0], acc[ai][bj][m][1]); }
            }
        }
    }
};
struct EpiQ {
    static constexpr bool PERM = true;
    bf16* O; const float* rs;
    __device__ __forceinline__ void operator()(const f32x4 (&acc)[2][2][4][2], const Unit& u, int wr, int wc, int fr, int fq) const {
        const int row0 = u.pm * 256 + wr * 64 + fr;
#pragma unroll
        for (int ai = 0; ai < 2; ++ai)
#pragma unroll
            for (int m = 0; m < 4; ++m) { const int row = row0 + ai * 128 + m * 16; const float sc = rs[row];
#pragma unroll
                for (int bj = 0; bj < 2; ++bj) { const int col = u.pn * 256 + bj * 128 + wc * 32 + 8 * fq; *(v4u*)(O + (size_t)row * 768 + col) = pack8(acc[ai][bj][m][0] * sc, acc[ai][bj][m][1] * sc); } }
    }
};
struct EpiKV {
    static constexpr bool PERM = true;
    bf16* KNp; bf16* VTp; const float* rs;
    __device__ __forceinline__ void operator()(const f32x4 (&acc)[2][2][4][2], const Unit& u, int wr, int wc, int fr, int fq) const {
        const int row0 = u.pm * 256 + wr * 64 + fr;
#pragma unroll
        for (int ai = 0; ai < 2; ++ai)
#pragma unroll
            for (int m = 0; m < 4; ++m) { const int row = row0 + ai * 128 + m * 16; const float sc = rs[row];
                const bool lat = row < M; const int b = lat ? row / SEQ : (row - M) / CTXL; const int key = lat ? row % SEQ : SEQ + (row - M) % CTXL;
                const int kpos = (key & ~12) | ((key & 4) << 1) | ((key & 8) >> 1);
#pragma unroll
                for (int bj = 0; bj < 2; ++bj) { const int col = u.pn * 256 + bj * 128 + wc * 32 + 8 * fq; const int hh = col >> 7, w = col & 127;
                    if (w < 64) { *(v4u*)(KNp + (size_t)row * HW + hh * 64 + w) = pack8(acc[ai][bj][m][0] * sc, acc[ai][bj][m][1] * sc); }
                    else { bf16* dst = VTp + ((size_t)((b * NH + hh) * VD + (w - 64))) * NKEY + kpos;
#pragma unroll
                        for (int n = 0; n < 2; ++n)
#pragma unroll
                            for (int q = 0; q < 4; ++q) dst[(size_t)(4 * n + q) * NKEY] = (bf16)f2bf(acc[ai][bj][m][n][q] * sc); } } }
    }
};
struct EpiResid {
    static constexpr bool PERM = false;
    const float* hin_l; const float* hin_c; float* hout_l; float* hout_c; const float* modl; int goff;
    __device__ __forceinline__ void operator()(const f32x4 (&acc)[2][2][4][2], const Unit& u, int wr, int wc, int fr, int fq) const {
        const int rowt = u.pm * 256; const bool lat = rowt < M; const int bidx = lat ? rowt / SEQ : NB;
        const float* gate = modl + bidx * NMOD + goff;
        const float* hi = lat ? hin_l + (size_t)rowt * DM : hin_c + (size_t)(rowt - M) * DM;
        float* ho = lat ? hout_l + (size_t)rowt * DM : hout_c + (size_t)(rowt - M) * DM;
        const int col0 = u.pn * 256 + wc * 32 + 4 * fq;
#pragma unroll
        for (int bj = 0; bj < 2; ++bj) {
            f32x4 hv[2][2][4];
#pragma unroll
            for (int n = 0; n < 2; ++n)
#pragma unroll
                for (int ai = 0; ai < 2; ++ai)
#pragma unroll
                    for (int m = 0; m < 4; ++m) hv[n][ai][m] = *(const f32x4*)(hi + (size_t)(ai * 128 + wr * 64 + m * 16 + fr) * DM + col0 + bj * 128 + n * 16);
#pragma unroll
            for (int n = 0; n < 2; ++n) { const f32x4 gv = *(const f32x4*)(gate + col0 + bj * 128 + n * 16);
#pragma unroll
                for (int ai = 0; ai < 2; ++ai)
#pragma unroll
                    for (int m = 0; m < 4; ++m) *(f32x4*)(ho + (size_t)(ai * 128 + wr * 64 + m * 16 + fr) * DM + col0 + bj * 128 + n * 16) = hv[n][ai][m] + gv * acc[ai][bj][m][n]; }
            asm volatile("" ::: "memory"); }
    }
};
struct EpiPool {
    static constexpr bool PERM = false;
    float* h_l; float* h_c; const float* modl; const float* bias; const float* scale; int talloc;
    __device__ __forceinline__ void operator()(const f32x4 (&acc)[2][2][4][2], const Unit& u, int wr, int wc, int fr, int fq) const {
        const int g = u.pn, rowt = (u.pm - g * talloc) * 256; const bool lat = rowt < M; const int bidx = lat ? rowt / SEQ : NB;
        const float* gate = modl + bidx * NMOD + 2 * DM;
        float* ho = lat ? h_l + (size_t)rowt * DM : h_c + (size_t)(rowt - M) * DM;
        const int col0 = g * 256 + wc * 32 + 4 * fq;
#pragma unroll
        for (int bj = 0; bj < 2; ++bj)
#pragma unroll
            for (int n = 0; n < 2; ++n) { const int c = col0 + bj * 128 + n * 16; const f32x4 gm = *(const f32x4*)(gate + c) * *(const f32x4*)(scale + c); const f32x4 gb = gm * *(const f32x4*)(bias + c);
#pragma unroll
                for (int ai = 0; ai < 2; ++ai)
#pragma unroll
                    for (int m = 0; m < 4; ++m) { const int r = ai * 128 + wr * 64 + m * 16 + fr; const size_t off = (size_t)r * DM + c; const f32x4 hv = *(const f32x4*)(ho + off); *(f32x4*)(ho + off) = hv + gm * acc[ai][bj][m][n] + gb; }
                asm volatile("" ::: "memory"); }
    }
};
struct EpiGateUp {
    static constexpr bool PERM = true;
    bf16* H; int ldh, nct, rowsub;
    __device__ __forceinline__ void operator()(const f32x4 (&acc)[2][2][4][2], const Unit& u, int wr, int wc, int fr, int fq) const {
        const int row0 = u.pm * 256 + wr * 64 + fr - rowsub; const int ct = u.pn % nct; const int col = ct * 128 + wc * 32 + 8 * fq;
#pragma unroll
        for (int ai = 0; ai < 2; ++ai)
#pragma unroll
            for (int m = 0; m < 4; ++m) { const int row = row0 + ai * 128 + m * 16; f32x4 o[2];
#pragma unroll
                for (int n = 0; n < 2; ++n)
#pragma unroll
                    for (int q = 0; q < 4; ++q) { const float gv = acc[ai][0][m][n][q], uv = acc[ai][1][m][n][q]; o[n][q] = gv * uv / (1.0f + __expf(-gv)); }
                *(v4u*)(H + (size_t)row * ldh + col) = pack8(o[0], o[1]); }
    }
};
struct EpiY {
    static constexpr bool PERM = true;
    bf16* Y; int nct;
    __device__ __forceinline__ void operator()(const f32x4 (&acc)[2][2][4][2], const Unit& u, int wr, int wc, int fr, int fq) const {
        const int row0 = u.pm * 256 + wr * 64 + fr; const int ct = u.pn % nct;
#pragma unroll
        for (int ai = 0; ai < 2; ++ai)
#pragma unroll
            for (int m = 0; m < 4; ++m) { const int row = row0 + ai * 128 + m * 16;
#pragma unroll
                for (int bj = 0; bj < 2; ++bj) { const int col = ct * 256 + bj * 128 + wc * 32 + 8 * fq; *(v4u*)(Y + (size_t)row * DM + col) = pack8(acc[ai][bj][m][0], acc[ai][bj][m][1]); } }
    }
};

__device__ __forceinline__ void p0_prologue(Frame& F) {
    fresh(F);
    unsigned char* ws = F.ws;
    const float qscale = 0.10206207261596577f * 1.4426950408889634f;
    for (int j = 0; j < 2; ++j) {
        conv_matrix(F, F.in[8] + (size_t)j * DM * INW, DM, INW, (bf16*)(ws + WS_WIN) + (size_t)j * INP * DM, DM, 1, 0, nullptr, 1.f);
        conv_matrix(F, F.in[11] + (size_t)j * QL * 768, QL, 768, (bf16*)(ws + WS_WUQ) + (size_t)j * 768 * QL, QL, 0, 0, F.in[9] + j * QL, qscale);
        conv_matrix(F, F.in[12] + (size_t)j * KVL * 1024, KVL, 1024, (bf16*)(ws + WS_WUKV) + (size_t)j * 1024 * KVL, KVL, 0, 0, F.in[10] + j * KVL, 1.f);
        conv_matrix(F, F.in[15] + (size_t)j * DM * DM, DM, DM, (bf16*)(ws + WS_WOUT) + (size_t)j * DM * DM, DM, 0, 0, nullptr, 1.f);
        conv_matrix(F, F.in[16] + (size_t)j * DM * DFF, DM, DFF, (bf16*)(ws + WS_WGU) + (size_t)j * 2 * DFF * DM, DM, 2, 0, nullptr, 1.f);
        conv_matrix(F, F.in[17] + (size_t)j * DM * DFF, DM, DFF, (bf16*)(ws + WS_WGU) + (size_t)j * 2 * DFF * DM, DM, 2, 128, nullptr, 1.f);
        conv_matrix(F, F.in[18] + (size_t)j * DFF * DM, DFF, DM, (bf16*)(ws + WS_WDN) + (size_t)j * DM * DFF, DFF, 0, 0, nullptr, 1.f);
        for (int g = 0; g < 4; ++g)
            conv_matrix(F, F.in[19] + (size_t)(j * 4 + g) * 65536, 256, 256, (bf16*)(ws + WS_WPOOL) + (size_t)(j * 4 + g) * 65536, 256, 0, 0, nullptr, 1.f);
    }
    __syncthreads();
    if (blockIdx.x == 0 && F.tid < 8) {
        float* TC = (float*)(ws + WS_ROPE); float* TS = TC + 512;
        double th = 1.0; for (int i = 0; i < F.tid; ++i) th *= 0.31622776601683794;
        const double x2 = th * th; double s = th, c = 1.0, ts = th, tc = 1.0;
        for (int n = 1; n <= 12; ++n) { tc *= -x2 / (double)((2 * n - 1) * (2 * n)); c += tc; ts *= -x2 / (double)((2 * n) * (2 * n + 1)); s += ts; }
        double cp = 1.0, sp = 0.0;
        for (int p = 0; p < 64; ++p) { TC[p * 8 + F.tid] = (float)cp; TS[p * 8 + F.tid] = (float)sp; const double ncp = cp * c - sp * s; sp = sp * c + cp * s; cp = ncp; }
    }
    {
        LAS float* sc = (LAS float*)(F.lds + RING_OFF);
        LAS float* red = sc + 17 * 1024;
        const int nitems = 4 * (NMOD / 64);
        if ((int)blockIdx.x < nitems) {
            for (int e = F.tid; e < 17 * 1024; e += 512) { const int r = e >> 10, k = e & 1023; const float x = (r < 16) ? F.in[1][r * 1024 + k] : F.in[3][k]; sc[e] = siluf_(x); }
            __syncthreads();
            for (int it = blockIdx.x; it < nitems; it += F.G) {
                const int l = it / (NMOD / 64), c0 = (it % (NMOD / 64)) * 64;
                const float* W = F.in[4] + (size_t)l * DM * NMOD + c0 + F.lane;
                float acc[17];
#pragma unroll
                for (int r = 0; r < 17; ++r) acc[r] = 0.f;
                const int kb = F.wave * 128;
                for (int k = 0; k < 128; k += 4) {
                    const float w0 = W[(size_t)(kb + k) * NMOD], w1 = W[(size_t)(kb + k + 1) * NMOD], w2 = W[(size_t)(kb + k + 2) * NMOD], w3 = W[(size_t)(kb + k + 3) * NMOD];
#pragma unroll
                    for (int r = 0; r < 17; ++r) { const f32x4 s4 = *(const LAS f32x4*)(sc + r * 1024 + kb + k); acc[r] += s4.x * w0 + s4.y * w1 + s4.z * w2 + s4.w * w3; }
                }
#pragma unroll
                for (int r = 0; r < 17; ++r) red[(F.wave * 17 + r) * 64 + F.lane] = acc[r];
                __syncthreads();
                for (int o = F.tid; o < 17 * 64; o += 512) { const int r = o >> 6, cc = o & 63; float s = 0.f;
#pragma unroll
                    for (int w = 0; w < 8; ++w) s += red[(w * 17 + r) * 64 + cc];
                    ((float*)(ws + WS_MODV))[(size_t)(l * 17 + r) * NMOD + c0 + cc] = s + F.in[5][l * NMOD + c0 + cc]; }
                __syncthreads();
            }
        }
    }
}

__device__ __forceinline__ void e3_phase(Frame& F) {
    fresh(F);
    unsigned char* ws = F.ws;
    const bf16* CQ = (const bf16*)(ws + WS_CQ); const bf16* CKV = (const bf16*)(ws + WS_CKV); const bf16* KR = (const bf16*)(ws + WS_KR); bf16* KRR = (bf16*)(ws + WS_KRR);
    float* RSQ = (float*)(ws + WS_RSQ); float* RSKV = (float*)(ws + WS_RSKV); const float* TC = (const float*)(ws + WS_ROPE); const float* TS = TC + 512;
    const int rpw = (MT + F.G - 1) / F.G;
    for (int i = F.wave; i < rpw; i += NWAVES) {
        const int row = (int)blockIdx.x * rpw + i; if (row >= MT) break;
        float s = 0.f;
        if (F.lane < 48) { const v4u w = *(const v4u*)(CQ + (size_t)row * QL + F.lane * 8);
            s = bflo(w.x) * bflo(w.x) + bfhi(w.x) * bfhi(w.x) + bflo(w.y) * bflo(w.y) + bfhi(w.y) * bfhi(w.y) + bflo(w.z) * bflo(w.z) + bfhi(w.z) * bfhi(w.z) + bflo(w.w) * bflo(w.w) + bfhi(w.w) * bfhi(w.w); }
        s = wave_sum(s, F.lane); if (F.lane == 0) RSQ[row] = rsqrtf(s * (1.0f / QL) + EPS);
        s = 0.f;
        if (F.lane < 32) { const v4u w = *(const v4u*)(CKV + (size_t)row * KVL + F.lane * 8);
            s = bflo(w.x) * bflo(w.x) + bfhi(w.x) * bfhi(w.x) + bflo(w.y) * bflo(w.y) + bfhi(w.y) * bfhi(w.y) + bflo(w.z) * bflo(w.z) + bfhi(w.z) * bfhi(w.z) + bflo(w.w) * bflo(w.w) + bfhi(w.w) * bfhi(w.w); }
        s = wave_sum(s, F.lane); if (F.lane == 0) RSKV[row] = rsqrtf(s * (1.0f / KVL) + EPS);
        const float x = (F.lane < 32) ? bf2f(KR[(size_t)row * ROPE + F.lane]) : 0.f; const float pr = shx(x, F.lane, 8);
        float o = x;
        if (row < M) { const int t = row % SEQ; const int p = ((F.lane >> 4) & 1) ? (t & 63) : (t >> 6); const int j = F.lane & 7; const float c = TC[p * 8 + j], sn = TS[p * 8 + j];
            o = ((F.lane >> 3) & 1) ? x * c + pr * sn : x * c - pr * sn; }
        if (F.lane < 32) KRR[(size_t)row * ROPE + F.lane] = (bf16)f2bf(o);
    }
}

typedef short bf16x8v __attribute__((ext_vector_type(8)));
typedef float f32x16 __attribute__((ext_vector_type(16)));
__device__ __forceinline__ void attn_unit(Frame& F, int b, int h, int qrow0, bool rope_q, int t_lo, int t_hi) {
    unsigned char* ws = F.ws;
    const bf16* QB = (const bf16*)(ws + WS_QB); const bf16* KN = (const bf16*)(ws + WS_KN); const bf16* KRR = (const bf16*)(ws + WS_KRR); const bf16* VT = (const bf16*)(ws + WS_VV);
    bf16* MIX = (bf16*)(ws + WS_MIX); const float* TC = (const float*)(ws + WS_ROPE); const float* TS = TC + 512;
    const int lane = F.lane, wave = F.wave, r32 = lane & 31, hi = lane >> 5;
    LAS unsigned char* ring = F.lds + RING_OFF;
    const int qrow = qrow0 + wave * 32 + r32;
    bf16x8v qr[6];
#pragma unroll
    for (int d0 = 0; d0 < 6; ++d0) qr[d0] = *(const bf16x8v*)(QB + (size_t)qrow * 768 + h * QKD + 16 * d0 + 8 * hi);
    if (rope_q) { const int t = qrow % SEQ;
#pragma unroll
        for (int a = 0; a < 2; ++a) { const int p = a ? (t & 63) : (t >> 6); const v4u w = __builtin_bit_cast(v4u, qr[4 + a]); float x[8], y[8];
            x[0] = bflo(w.x); x[1] = bfhi(w.x); x[2] = bflo(w.y); x[3] = bfhi(w.y); x[4] = bflo(w.z); x[5] = bfhi(w.z); x[6] = bflo(w.w); x[7] = bfhi(w.w);
#pragma unroll
            for (int jj = 0; jj < 8; ++jj) { const float pr = shx(x[jj], lane, 32); const float c = TC[p * 8 + jj], sn = TS[p * 8 + jj]; y[jj] = hi ? x[jj] * c + pr * sn : x[jj] * c - pr * sn; }
            v4u o; o.x = pk2(y[0], y[1]); o.y = pk2(y[2], y[3]); o.z = pk2(y[4], y[5]); o.w = pk2(y[6], y[7]); qr[4 + a] = __builtin_bit_cast(bf16x8v, o); } }
    const int bh = b * NH + h;
    const bf16* vsrc = VT + ((size_t)(bh * VD + lane)) * NKEY + 8 * wave;
#define ATT_DMA(t, buf) do { const int t_ = (t); const int r0_ = t_ < SEQ / 64 ? b * SEQ + 64 * t_ : M + b * CTXL + 64 * (t_ - SEQ / 64); \
        LAS unsigned char* kb_ = ring + (buf) * 12288; LAS unsigned char* vb_ = ring + 24576 + (buf) * 8192; \
        __builtin_amdgcn_global_load_lds((const unsigned*)(KN + (size_t)(r0_ + lane) * HW + h * 64 + 8 * wave), (LAS unsigned*)(kb_ + wave * 1024), 16, 0, 0); \
        if (wave < 4) __builtin_amdgcn_global_load_lds((const unsigned*)(KRR + (size_t)(r0_ + lane) * ROPE + 8 * wave), (LAS unsigned*)(kb_ + (8 + wave) * 1024), 16, 0, 0); \
        __builtin_amdgcn_global_load_lds((const unsigned*)(vsrc + 64 * t_), (LAS unsigned*)(vb_ + wave * 1024), 16, 0, 0); } while (0)
    f32x16 o0, o1;
#pragma unroll
    for (int r = 0; r < 16; ++r) { o0[r] = 0.f; o1[r] = 0.f; }
    float m_run = -INFINITY, l_run = 0.f;
    ATT_DMA(t_lo, 0);
    for (int t = t_lo; t < t_hi; ++t) {
        const int buf = (t - t_lo) & 1;
        asm volatile("s_waitcnt vmcnt(0)" ::: "memory"); __syncthreads();
        if (t + 1 < t_hi) ATT_DMA(t + 1, buf ^ 1);
        const LAS unsigned char* kb = ring + buf * 12288 + hi * 1024 + r32 * 16; const LAS unsigned char* vb = ring + 24576 + buf * 8192 + hi * 1024 + r32 * 16;
        f32x16 p0, p1;
#pragma unroll
        for (int r = 0; r < 16; ++r) { p0[r] = 0.f; p1[r] = 0.f; }
#pragma unroll
        for (int d0 = 0; d0 < 6; ++d0) { const bf16x8v k0 = *(const LAS bf16x8v*)(kb + d0 * 2048), k1 = *(const LAS bf16x8v*)(kb + d0 * 2048 + 512);
            p0 = __builtin_amdgcn_mfma_f32_32x32x16_bf16(k0, qr[d0], p0, 0, 0, 0); p1 = __builtin_amdgcn_mfma_f32_32x32x16_bf16(k1, qr[d0], p1, 0, 0, 0); }
        float mt = fmaxf(p0[0], p1[0]);
#pragma unroll
        for (int r = 1; r < 16; ++r) mt = fmaxf(mt, fmaxf(p0[r], p1[r]));
        mt = fmaxf(mt, shx(mt, lane, 32));
        const float mn = fmaxf(m_run, mt); const float alpha = __builtin_amdgcn_exp2f(m_run - mn); m_run = mn;
        float ps = 0.f;
#pragma unroll
        for (int r = 0; r < 16; ++r) { p0[r] = __builtin_amdgcn_exp2f(p0[r] - mn); p1[r] = __builtin_amdgcn_exp2f(p1[r] - mn); ps += p0[r] + p1[r]; }
        l_run = l_run * alpha + ps;
#pragma unroll
        for (int r = 0; r < 16; ++r) { o0[r] *= alpha; o1[r] *= alpha; }
        v4u pw[4];
#pragma unroll
        for (int q = 0; q < 4; ++q) { pw[0][q] = cvt_pk_bf16(p0[2 * q], p0[2 * q + 1]); pw[1][q] = cvt_pk_bf16(p0[8 + 2 * q], p0[8 + 2 * q + 1]); pw[2][q] = cvt_pk_bf16(p1[2 * q], p1[2 * q + 1]); pw[3][q] = cvt_pk_bf16(p1[8 + 2 * q], p1[8 + 2 * q + 1]); }
#pragma unroll
        for (int s4 = 0; s4 < 4; ++s4) { const bf16x8v pa = __builtin_bit_cast(bf16x8v, pw[s4]);
            const bf16x8v v0 = *(const LAS bf16x8v*)(vb + s4 * 2048), v1 = *(const LAS bf16x8v*)(vb + s4 * 2048 + 512);
            o0 = __builtin_amdgcn_mfma_f32_32x32x16_bf16(v0, pa, o0, 0, 0, 0); o1 = __builtin_amdgcn_mfma_f32_32x32x16_bf16(v1, pa, o1, 0, 0, 0); }
    }
    l_run += shx(l_run, lane, 32);
    const float rl = 1.0f / l_run;
    bf16* orow = MIX + (size_t)qrow * DM + h * VD;
#pragma unroll
    for (int g = 0; g < 4; ++g) { v2u a, c2; a.x = pk2(o0[4 * g] * rl, o0[4 * g + 1] * rl); a.y = pk2(o0[4 * g + 2] * rl, o0[4 * g + 3] * rl); c2.x = pk2(o1[4 * g] * rl, o1[4 * g + 1] * rl); c2.y = pk2(o1[4 * g + 2] * rl, o1[4 * g + 3] * rl);
        *(v2u*)(orow + 8 * g + 4 * hi) = a; *(v2u*)(orow + 32 + 8 * g + 4 * hi) = c2; }
    __syncthreads();
#undef ATT_DMA
}
__device__ __forceinline__ void attn_phase(Frame& F, bool ctx_out) {
    fresh(F);
    const int nlat = NB * NH * 8, nctx = ctx_out ? NB * NH : 0;
    const int per = (nlat + F.G - 1) / F.G;
    for (int i = 0; i < per; ++i) { const int it = F.vcu * per + i; if (it >= nlat) break; const int bh = it >> 3, qb = it & 7; attn_unit(F, bh >> 3, bh & 7, (bh >> 3) * SEQ + qb * 256, true, 0, NKEY / 64); }
    for (int it = F.vcu; it < nctx; it += F.G) attn_unit(F, it >> 3, it & 7, M + (it >> 3) * CTXL, false, SEQ / 64, NKEY / 64);
    __syncthreads();
}

__device__ __forceinline__ int hgrn_row(int b, int dir, int ig) { return (ig < CTXL) ? (M + b * CTXL + (dir ? CTXL - 1 - ig : ig)) : (b * SEQ + (dir ? SEQ - 1 - (ig - CTXL) : (ig - CTXL))); }
__device__ __forceinline__ void hgrn_phase(Frame& F, int j) {
    fresh(F);
    unsigned char* ws = F.ws;
    const bf16* HQ = (const bf16*)(ws + WS_HQ); const bf16* HFF = HQ + HSEG; const bf16* HFB = HQ + 2 * HSEG; const bf16* HI = HQ + 3 * HSEG;
    float* OF = (float*)(ws + WS_OF); float* OB = (float*)(ws + WS_OB);
    LAS unsigned char* ring = F.lds + RING_OFF;
    LAS unsigned char* QN = ring; LAS unsigned char* KN = ring + 17408; LAS unsigned char* KT = ring + 34816; LAS unsigned char* VT = ring + 53248; LAS unsigned char* ST = ring + 62464;
    LAS float* TOT = (LAS float*)(ring + 79872);
    LAS unsigned char* RQ = ring + 81920; LAS unsigned char* RF = ring + 98304; LAS unsigned char* RV = ring + 114688;
    const int tid = F.tid, lane = F.lane, wave = F.wave, r32 = lane & 31, hi = lane >> 5;
    const int k = tid & 127, part = tid >> 7;
    const int kb = wave >> 1, vb = wave & 1;
    for (int it = blockIdx.x; it < NB * NHH * 2 * 2; it += F.G) {
        const int vh = it & 1, dir = (it >> 1) & 1, hh = (it >> 2) & 3, b = it >> 4;
        const bf16* HF = dir ? HFB : HFF; float* OO = dir ? OB : OF;
        float lb = 0.f; if (j == 1) { const int ci = dir * HW + hh * HK + k; const float l0 = F.in[13][ci], l1 = F.in[13][2 * HW + ci]; lb = 1.0f / (1.0f + __expf(l0 - l1)); }
        const float oml = 1.0f - lb;
        f32x16 S;
#pragma unroll
        for (int r = 0; r < 16; ++r) S[r] = 0.f;
#define LBAR() do { asm volatile("s_waitcnt lgkmcnt(0)" ::: "memory"); __builtin_amdgcn_s_barrier(); asm volatile("" ::: "memory"); } while (0)
#define HG_BASE(c_) ((c_) < CTXL / 64 ? M + b * CTXL + (dir ? CTXL - 64 - 64 * (c_) : 64 * (c_)) : b * SEQ + (dir ? SEQ - 64 - 64 * ((c_) - CTXL / 64) : 64 * ((c_) - CTXL / 64)))
#define HG_DMA(c_) do { const int rb_ = HG_BASE(c_); \
            _Pragma("unroll") for (int p_ = 0; p_ < 2; ++p_) { const int pc_ = wave * 2 + p_; const size_t go_ = (size_t)(rb_ + 4 * pc_ + (lane >> 4)) * HW + hh * HK + 8 * (lane & 15); \
                __builtin_amdgcn_global_load_lds((const unsigned*)(HQ + go_), (LAS unsigned*)(RQ + pc_ * 1024), 16, 0, 0); __builtin_amdgcn_global_load_lds((const unsigned*)(HF + go_), (LAS unsigned*)(RF + pc_ * 1024), 16, 0, 0); } \
            __builtin_amdgcn_global_load_lds((const unsigned*)(HI + (size_t)(rb_ + 8 * wave + (lane >> 3)) * HW + hh * HK + vh * 64 + 8 * (lane & 7)), (LAS unsigned*)(RV + wave * 1024), 16, 0, 0); } while (0)
        HG_DMA(0);
        asm volatile("s_waitcnt vmcnt(0)" ::: "memory"); LBAR();
        for (int ch = 0; ch < NKEY / 64; ++ch) {
            float qv[16], kin[16], cs[16]; float run = 0.f;
#pragma unroll
            for (int ii = 0; ii < 16; ++ii) { const int i = 16 * part + ii, mr = dir ? 63 - i : i; const float hq = bf2f(*(const LAS bf16*)(RQ + mr * 256 + k * 2)), hf = bf2f(*(const LAS bf16*)(RF + mr * 256 + k * 2));
                qv[ii] = hq * __builtin_amdgcn_rcpf(1.0f + __expf(-hq)); const float e = __expf(-hf), sg = __builtin_amdgcn_rcpf(1.0f + e); kin[ii] = oml * e * sg; run += __logf(lb + oml * sg); cs[ii] = run; }
            TOT[part * 128 + k] = run;
            { const int mr = dir ? 63 - lane : lane; const v4u w = *(const LAS v4u*)(RV + mr * 128 + wave * 16); const int pos = (lane & ~12) | ((lane & 4) << 1) | ((lane & 8) >> 1); LAS bf16* vt = (LAS bf16*)(VT + (8 * wave) * 144 + pos * 2);
              vt[0 * 72] = (bf16)(w.x & 0xffffu); vt[1 * 72] = (bf16)(w.x >> 16); vt[2 * 72] = (bf16)(w.y & 0xffffu); vt[3 * 72] = (bf16)(w.y >> 16);
              vt[4 * 72] = (bf16)(w.z & 0xffffu); vt[5 * 72] = (bf16)(w.z >> 16); vt[6 * 72] = (bf16)(w.w & 0xffffu); vt[7 * 72] = (bf16)(w.w >> 16); }
            LBAR();
            if (ch + 1 < NKEY / 64) HG_DMA(ch + 1);
            { const float t0 = TOT[k], t1 = TOT[128 + k], t2 = TOT[256 + k];
              const float base = (part > 0 ? t0 : 0.f) + (part > 1 ? t1 : 0.f) + (part > 2 ? t2 : 0.f); const float rr = t0 + t1;
              unsigned kt[8];
#pragma unroll
              for (int ii = 0; ii < 16; ii += 2) { float d0 = base + cs[ii] - rr, d1 = base + cs[ii + 1] - rr; d0 = fminf(fmaxf(d0, -80.f), 80.f); d1 = fminf(fmaxf(d1, -80.f), 80.f);
                  const float e0 = __expf(d0), e1 = __expf(d1); const float q0 = qv[ii] * e0, q1 = qv[ii + 1] * e1, k0 = kin[ii] * __builtin_amdgcn_rcpf(e0), k1 = kin[ii + 1] * __builtin_amdgcn_rcpf(e1);
                  const unsigned qp = cvt_pk_bf16(q0, q1), kp = cvt_pk_bf16(k0, k1);
                  *(LAS bf16*)(QN + (16 * part + ii) * 272 + k * 2) = (bf16)(qp & 0xffffu); *(LAS bf16*)(QN + (16 * part + ii + 1) * 272 + k * 2) = (bf16)(qp >> 16);
                  *(LAS bf16*)(KN + (16 * part + ii) * 272 + k * 2) = (bf16)(kp & 0xffffu); *(LAS bf16*)(KN + (16 * part + ii + 1) * 272 + k * 2) = (bf16)(kp >> 16);
                  kt[ii >> 1] = kp; }
              *(LAS v4u*)(KT + k * 144 + part * 32) = (v4u){kt[0], kt[1], kt[4], kt[5]}; *(LAS v4u*)(KT + k * 144 + part * 32 + 16) = (v4u){kt[2], kt[3], kt[6], kt[7]}; }
            f32x16 T;
#pragma unroll
            for (int g4 = 0; g4 < 4; ++g4) { const int kk = kb * 32 + 8 * g4 + 4 * hi; const f32x4 ta = *(const LAS f32x4*)(TOT + kk), tb = *(const LAS f32x4*)(TOT + 128 + kk);
                T[4 * g4] = S[4 * g4] * __expf(ta.x + tb.x); T[4 * g4 + 1] = S[4 * g4 + 1] * __expf(ta.y + tb.y); T[4 * g4 + 2] = S[4 * g4 + 2] * __expf(ta.z + tb.z); T[4 * g4 + 3] = S[4 * g4 + 3] * __expf(ta.w + tb.w);
                v2u o; o.x = cvt_pk_bf16(T[4 * g4], T[4 * g4 + 1]); o.y = cvt_pk_bf16(T[4 * g4 + 2], T[4 * g4 + 3]); *(LAS v2u*)(ST + (vb * 32 + r32) * 272 + kk * 2) = o; }
            LBAR();
            if (wave < 4) {
                const int ib = kb;
                bf16x8v qf[8];
#pragma unroll
                for (int ks = 0; ks < 8; ++ks) qf[ks] = *(const LAS bf16x8v*)(QN + (ib * 32 + r32) * 272 + ks * 32 + hi * 16);
                f32x16 O;
#pragma unroll
                for (int r = 0; r < 16; ++r) O[r] = 0.f;
#pragma unroll
                for (int ks = 0; ks < 8; ++ks) { const bf16x8v sf = *(const LAS bf16x8v*)(ST + (vb * 32 + r32) * 272 + ks * 32 + hi * 16); O = __builtin_amdgcn_mfma_f32_32x32x16_bf16(qf[ks], sf, O, 0, 0, 0); }
                for (int sb = 0; sb <= ib; ++sb) {
                    f32x16 X;
#pragma unroll
                    for (int r = 0; r < 16; ++r) X[r] = 0.f;
#pragma unroll
                    for (int ks = 0; ks < 8; ++ks) { const bf16x8v kf = *(const LAS bf16x8v*)(KN + (sb * 32 + r32) * 272 + ks * 32 + hi * 16); X = __builtin_amdgcn_mfma_f32_32x32x16_bf16(kf, qf[ks], X, 0, 0, 0); }
                    if (sb == ib) {
#pragma unroll
                        for (int r = 0; r < 16; ++r) { const int srow = (r & 3) + 8 * (r >> 2) + 4 * hi; if (srow > r32) X[r] = 0.f; }
                    }
#pragma unroll
                    for (int st = 0; st < 2; ++st) { v4u pw;
#pragma unroll
                        for (int q = 0; q < 4; ++q) pw[q] = cvt_pk_bf16(X[8 * st + 2 * q], X[8 * st + 2 * q + 1]);
                        const bf16x8v vf = *(const LAS bf16x8v*)(VT + (vb * 32 + r32) * 144 + (sb * 32 + st * 16) * 2 + hi * 16);
                        O = __builtin_amdgcn_mfma_f32_32x32x16_bf16(__builtin_bit_cast(bf16x8v, pw), vf, O, 0, 0, 0); }
                }
#pragma unroll
                for (int r = 0; r < 16; ++r) { const int i = ib * 32 + (r & 3) + 8 * (r >> 2) + 4 * hi; const int row = hgrn_row(b, dir, ch * 64 + i); OO[(size_t)row * HW + hh * HK + vh * 64 + vb * 32 + r32] = O[r]; }
            }
#pragma unroll
            for (int st = 0; st < 4; ++st) { const bf16x8v kf = *(const LAS bf16x8v*)(KT + (kb * 32 + r32) * 144 + st * 32 + hi * 16), vf = *(const LAS bf16x8v*)(VT + (vb * 32 + r32) * 144 + st * 32 + hi * 16);
                T = __builtin_amdgcn_mfma_f32_32x32x16_bf16(kf, vf, T, 0, 0, 0); }
#pragma unroll
            for (int g4 = 0; g4 < 4; ++g4) { const int kk = kb * 32 + 8 * g4 + 4 * hi; const f32x4 ta = *(const LAS f32x4*)(TOT + 256 + kk), tb = *(const LAS f32x4*)(TOT + 384 + kk);
                S[4 * g4] = T[4 * g4] * __expf(ta.x + tb.x); S[4 * g4 + 1] = T[4 * g4 + 1] * __expf(ta.y + tb.y); S[4 * g4 + 2] = T[4 * g4 + 2] * __expf(ta.z + tb.z); S[4 * g4 + 3] = T[4 * g4 + 3] * __expf(ta.w + tb.w); }
            asm volatile("s_waitcnt vmcnt(0)" ::: "memory"); LBAR();
        }
#undef LBAR
#undef HG_DMA
#undef HG_BASE
    }
    __syncthreads();
}

__device__ __forceinline__ void e8_phase(Frame& F, int j, int nrows) {
    fresh(F);
    unsigned char* ws = F.ws;
    const float* OF = (const float*)(ws + WS_OF); const float* OB = (const float*)(ws + WS_OB); const bf16* HG = (const bf16*)(ws + WS_HQ) + 4 * HSEG; bf16* MIX = (bf16*)(ws + WS_MIX);
    const float* gn = F.in[14] + j * HK;
    const int rpw = (nrows + F.G - 1) / F.G;
    for (int i = F.wave; i < rpw; i += NWAVES) {
        const int row = (int)blockIdx.x * rpw + i; if (row >= nrows) break;
        const int col = 8 * F.lane;
        const f32x4 a0 = *(const f32x4*)(OF + (size_t)row * HW + col), a1 = *(const f32x4*)(OF + (size_t)row * HW + col + 4), b0 = *(const f32x4*)(OB + (size_t)row * HW + col), b1 = *(const f32x4*)(OB + (size_t)row * HW + col + 4);
        f32x4 x0 = a0 + b0, x1 = a1 + b1;
        float s = (x0.x * x0.x + x0.y * x0.y) + (x0.z * x0.z + x0.w * x0.w) + (x1.x * x1.x + x1.y * x1.y) + (x1.z * x1.z + x1.w * x1.w);
        s += shx(s, F.lane, 1); s += shx(s, F.lane, 2); s += shx(s, F.lane, 4); s += shx(s, F.lane, 8);
        const float rstd = rsqrtf(s * (1.0f / HK) + EPS);
        const int vv = col & 127; const f32x4 g0 = *(const f32x4*)(gn + vv), g1 = *(const f32x4*)(gn + vv + 4);
        const v4u hg = *(const v4u*)(HG + (size_t)row * HW + col);
        x0 = x0 * rstd * g0; x1 = x1 * rstd * g1;
        v4u o; o.x = pk2(x0.x * siluf_(bflo(hg.x)), x0.y * siluf_(bfhi(hg.x))); o.y = pk2(x0.z * siluf_(bflo(hg.y)), x0.w * siluf_(bfhi(hg.y)));
        o.z = pk2(x1.x * siluf_(bflo(hg.z)), x1.y * siluf_(bfhi(hg.z))); o.w = pk2(x1.z * siluf_(bflo(hg.w)), x1.w * siluf_(bfhi(hg.w)));
        *(v4u*)(MIX + (size_t)row * DM + HW + col) = o;
    }
}

__device__ __forceinline__ void o12_phase(Frame& F, int nrows, const float* hl, const float* hc, const float* gn, const float* modl) {
    fresh(F);
    bf16* P = (bf16*)(F.ws + WS_POOLED);
    LAS unsigned char* XN = F.lds + RING_OFF;
    const int rpw = (nrows + F.G - 1) / F.G, rbase = (int)blockIdx.x * rpw, rend = (rbase + rpw < nrows) ? rbase + rpw : nrows;
    for (int r0 = rbase; r0 < rend; r0 += 32) {
        for (int sl = F.wave; sl < 48; sl += NWAVES) {
            const int row = r0 - 8 + sl; if (row < 0 || row >= nrows) continue;
            const float* hr = (row < M) ? hl + (size_t)row * DM : hc + (size_t)(row - M) * DM;
            f32x4 v[4]; float s = 0.f;
#pragma unroll
            for (int j = 0; j < 4; ++j) { v[j] = *(const f32x4*)(hr + 4 * F.lane + 256 * j); s += (v[j].x * v[j].x + v[j].y * v[j].y) + (v[j].z * v[j].z + v[j].w * v[j].w); }
            const float rstd = rsqrtf(wave_sum(s, F.lane) * (1.0f / DM) + EPS);
#pragma unroll
            for (int j = 0; j < 4; ++j) { v2u o; o.x = pg8::cvt_pk_bf16(v[j].x * rstd, v[j].y * rstd); o.y = pg8::cvt_pk_bf16(v[j].z * rstd, v[j].w * rstd); *(LAS v2u*)(XN + sl * 2048 + (4 * F.lane + 256 * j) * 2) = o; }
        }
        __syncthreads();
#pragma unroll 1
        for (int q = 0; q < 4; ++q) {
            const int t = r0 + F.wave * 4 + q; if (t >= rend) break;
            const bool lat = t < M; const int T = lat ? SEQ : CTXL; const int tt = lat ? t % SEQ : (t - M) % CTXL; const int bidx = lat ? t / SEQ : NB;
            const int sc0 = t - r0 + 8;
            const float* scp = modl + bidx * NMOD + DM;
#pragma unroll
            for (int g = 0; g < 4; ++g) {
                const int hw = 1 << g, col = 256 * g + 4 * F.lane;
                float s0 = 0.f, s1 = 0.f, s2 = 0.f, s3 = 0.f; int cnt = 0;
#pragma unroll
                for (int d = -hw; d < hw; ++d) { const bool ok = (tt + d >= 0) && (tt + d < T); const v2u x = *(const LAS v2u*)(XN + (sc0 + d) * 2048 + col * 2);
                    s0 += ok ? bflo(x.x) : 0.f; s1 += ok ? bfhi(x.x) : 0.f; s2 += ok ? bflo(x.y) : 0.f; s3 += ok ? bfhi(x.y) : 0.f; cnt += ok ? 1 : 0; }
                const v2u xc = *(const LAS v2u*)(XN + sc0 * 2048 + col * 2); const float ic = 1.0f / (float)cnt;
                const f32x4 gv = *(const f32x4*)(gn + col), sv = *(const f32x4*)(scp + col);
                v2u o; o.x = pg8::cvt_pk_bf16(gv.x * (sv.x + 1.0f) * (s0 * ic - bflo(xc.x)), gv.y * (sv.y + 1.0f) * (s1 * ic - bfhi(xc.x)));
                o.y = pg8::cvt_pk_bf16(gv.z * (sv.z + 1.0f) * (s2 * ic - bflo(xc.y)), gv.w * (sv.w + 1.0f) * (s3 * ic - bfhi(xc.y)));
                *(v2u*)(P + ((size_t)g * MT + t) * 256 + 4 * F.lane) = o;
            }
        }
        __syncthreads();
    }
}

__device__ __forceinline__ void o5_phase(Frame& F, int nrows) {
    fresh(F);
    unsigned char* ws = F.ws;
    const int* CNT = (const int*)(ws + WS_CNT); int* TST = (int*)(ws + WS_TST); const int* EIDX = (const int*)(ws + WS_EIDX); int* POS = (int*)(ws + WS_POS);
    const bf16* U = (const bf16*)(ws + WS_U); bf16* VG = (bf16*)(ws + WS_VG);
    LAS int* lc = (LAS int*)(F.lds + RING_OFF);
    LAS int* lbase = lc + 512 * 8;
    LAS int* lpos = lbase + 32;
    const int rpw = (nrows + F.G - 1) / F.G;
    for (int e = F.tid; e < F.G * 8; e += 512) lc[e] = CNT[e];
    __syncthreads();
    {
        const int e = F.wave; int c4[4]; int sum = 0;
#pragma unroll
        for (int q = 0; q < 4; ++q) { const int w = 4 * F.lane + q; c4[q] = (w < F.G) ? lc[w * 8 + e] : 0; sum += c4[q]; }
        int incl = sum;
#pragma unroll
        for (int o = 1; o < 64; o <<= 1) { const int t = __builtin_amdgcn_ds_bpermute((F.lane >= o ? F.lane - o : F.lane) << 2, incl); if (F.lane >= o) incl += t; }
        const int total = __builtin_amdgcn_readlane(incl, 63); int excl = incl - sum;
        const int myq = (int)blockIdx.x & 3; int pre = excl;
#pragma unroll
        for (int q = 0; q < 3; ++q) if (q < myq) pre += c4[q];
        if (F.lane == ((int)blockIdx.x >> 2)) { lbase[e] = pre; lbase[8 + e] = total; }
    }
    __syncthreads();
    if (F.tid == 0) {
        int ts = 0;
        for (int e = 0; e < 8; ++e) { const int pre = lbase[e], tot = lbase[8 + e]; lbase[e] = ts * 256 + pre; if (blockIdx.x == 0) TST[e] = ts; ts += (tot + 255) >> 8; }
        if (blockIdx.x == 0) TST[8] = ts;
    }
    __syncthreads();
    if (F.wave == 0) {
        int run[8];
#pragma unroll
        for (int e = 0; e < 8; ++e) run[e] = lbase[e];
        const int npairs = 2 * rpw;
        for (int c0 = 0; c0 < npairs; c0 += 64) {
            const int pl = c0 + F.lane; const int row = (int)blockIdx.x * rpw + (pl >> 1); const bool ok = pl < npairs && row < nrows;
            const int e = ok ? EIDX[2 * row + (pl & 1)] : -1; int mypos = 0;
#pragma unroll
            for (int x = 0; x < 8; ++x) { const unsigned long long mk = __ballot(e == x); const int below = __popcll(mk & ((1ull << F.lane) - 1ull)); if (e == x) mypos = run[x] + below; run[x] += __popcll(mk); }
            if (ok) { lpos[pl] = mypos; POS[2 * row + (pl & 1)] = mypos; }
        }
    }
    __syncthreads();
    for (int pl = F.wave; pl < 2 * rpw; pl += NWAVES) {
        const int row = (int)blockIdx.x * rpw + (pl >> 1); if (row >= nrows) break;
        const int p = lpos[pl];
        const v4u a = *(const v4u*)(U + (size_t)row * DM + 8 * F.lane), b = *(const v4u*)(U + (size_t)row * DM + 512 + 8 * F.lane);
        *(v4u*)(VG + (size_t)p * DM + 8 * F.lane) = a; *(v4u*)(VG + (size_t)p * DM + 512 + 8 * F.lane) = b;
    }
    __syncthreads();
}

__global__ void __launch_bounds__(NWAVES * 64, 2) mega_fwd(Args args) {
    extern __shared__ __attribute__((aligned(16))) unsigned char lds[];
    Frame F;
    F.lds = (LAS unsigned char*)lds;
    F.wave = __builtin_amdgcn_readfirstlane((int)threadIdx.x >> 6); fresh(F);
    F.G = gridDim.x; { const int bx = blockIdx.x; F.vcu = (F.G % 8 == 0) ? (bx % 8) * (F.G / 8) + bx / 8 : bx; }
    F.in = args.in; F.out = args.out; F.ws = args.ws;
    unsigned char* ws = args.ws;
    volatile LAS unsigned* MISC = (volatile LAS unsigned*)(F.lds + MISC_OFF);
    for (int u = F.tid; u < (LDS_BYTES - LDSCTL_OFF) / 4; u += NWAVES * 64) ((LAS unsigned*)(F.lds + LDSCTL_OFF))[u] = 0u;
    __syncthreads();
    XcdBarrier bar = xcd_barrier_post((unsigned*)(ws + WS_CTL) + CW_BAR, MISC + 8, F.wave);
#define GRID_BAR() do { xcd_barrier(bar); if (DUPMASK & 4096) xcd_barrier(bar); } while (0)
#ifndef ONLY
#define ONLY 0
#endif
#define PH(n) (ONLY == 0 || ONLY == (n))
#define REP(bit) for (int rep_ = 0; rep_ < ((DUPMASK & (bit)) ? 2 : 1); ++rep_)
    LAS unsigned char* ring = F.lds + RING_OFF;
    const float* MODV = (const float*)(ws + WS_MODV);
    float* HC = (float*)(ws + WS_HC);
    bf16* U = (bf16*)(ws + WS_U);

#if PH(20)
    REP(8192) p0_prologue(F);
#endif
    GRID_BAR();

    for (int lp = 0; lp < 2; ++lp) {
        const int le = 2 * lp, lo = 2 * lp + 1, j = lp;
        const bool ctx_out = (lp == 0);
        const int nro = ctx_out ? MT : M;
        const float* modE = MODV + (size_t)le * 17 * NMOD; const float* modO = MODV + (size_t)lo * 17 * NMOD;
        const float* hin_l = (lp == 0) ? args.in[0] : args.out; const float* hin_c = (lp == 0) ? args.in[2] : HC;
#if PH(1)
        {
            RowArgs A{}; A.hin_l = hin_l; A.hin_c = hin_c; A.hout_l = args.out; A.hout_c = HC; A.g = args.in[6] + (size_t)(le * 2 + 0) * DM; A.modl = modE; A.shoff = 0; A.scoff = DM; A.U = U;
            A.Y = (const bf16*)(ws + WS_VG); A.pos = (const int*)(ws + WS_POS); A.gate = (const float*)(ws + WS_GATE); A.modprev = MODV + (size_t)(le - 1) * 17 * NMOD;
            if (lp == 0) row_phase<false, 1, false>(F, A, MT); else row_phase<true, 1, false>(F, A, MT);
        }
#endif
        GRID_BAR();
#if PH(2)
        {
            pg8::Gemm g{U, (const bf16*)(ws + WS_WIN) + (size_t)j * INP * DM, DM, DM, DM}; pg8::StaticOrder S; S.init(MT, INP, F.G, (int)blockIdx.x);
            EpiIn E{(bf16*)(ws + WS_CQ), (bf16*)(ws + WS_KR), (bf16*)(ws + WS_CKV), (bf16*)(ws + WS_HQ)};
            REP(8) pg8::gemm_phase<EpiIn, pg8::StaticOrder, true>(ring, g, S, E, F.wave);
        }
#endif
        GRID_BAR();
#if PH(3)
        REP(4 | 32) e3_phase(F);
#endif
        GRID_BAR();
#if PH(4)
        {
            pg8::Gemm g{(const bf16*)(ws + WS_CQ), (const bf16*)(ws + WS_WUQ) + (size_t)j * 768 * QL, QL, QL, QL}; pg8::StaticOrder S; S.init(nro, 768, F.G, (int)blockIdx.x);
            EpiQ E{(bf16*)(ws + WS_QB), (const float*)(ws + WS_RSQ)};
            REP(8) pg8::gemm_phase<EpiQ, pg8::StaticOrder, true>(ring, g, S, E, F.wave);
        }
        {
            pg8::Gemm g{(const bf16*)(ws + WS_CKV), (const bf16*)(ws + WS_WUKV) + (size_t)j * 1024 * KVL, KVL, KVL, KVL}; pg8::StaticOrder S; S.init(MT, 1024, F.G, (int)blockIdx.x);
            EpiKV E{(bf16*)(ws + WS_KN), (bf16*)(ws + WS_VV), (const float*)(ws + WS_RSKV)};
            REP(8) pg8::gemm_phase<EpiKV, pg8::StaticOrder, true>(ring, g, S, E, F.wave);
        }
#endif
        GRID_BAR();
#if PH(6)
#ifndef NO_HGRN
        REP(1) hgrn_phase(F, j);
#endif
#ifndef NO_ATTN
        REP(2) attn_phase(F, ctx_out);
#endif
#endif
        GRID_BAR();
#if PH(8)
        REP(4 | 64) e8_phase(F, j, nro);
#endif
        GRID_BAR();
#if PH(9)
        {
            pg8::Gemm g{(const bf16*)(ws + WS_MIX), (const bf16*)(ws + WS_WOUT) + (size_t)j * DM * DM, DM, DM, DM}; pg8::StaticOrder S; S.init(nro, DM, F.G, (int)blockIdx.x);
            EpiResid E{hin_l, hin_c, args.out, HC, modE, 2 * DM};
            pg8::gemm_phase<EpiResid, pg8::StaticOrder, true>(ring, g, S, E, F.wave);
        }
#endif
        GRID_BAR();
#if PH(10)
        {
            RowArgs A{}; A.hin_l = args.out; A.hin_c = HC; A.g = args.in[6] + (size_t)(le * 2 + 1) * DM; A.modl = modE; A.shoff = 3 * DM; A.scoff = 4 * DM; A.U = U;
            REP(4 | 128) row_phase<false, 1, false>(F, A, nro);
        }
#endif
        GRID_BAR();
#if PH(11)
        {
            pg8::Gemm g{U, (const bf16*)(ws + WS_WGU) + (size_t)j * 2 * DFF * DM, DM, DM, DM}; pg8::StaticOrder S; S.init(nro, 2 * DFF, F.G, (int)blockIdx.x);
            EpiGateUp E{(bf16*)(ws + WS_HID), DFF, 2 * DFF / 256, 0};
            REP(8) pg8::gemm_phase<EpiGateUp, pg8::StaticOrder, true>(ring, g, S, E, F.wave);
        }
#endif
        GRID_BAR();
#if PH(12)
        {
            pg8::Gemm g{(const bf16*)(ws + WS_HID), (const bf16*)(ws + WS_WDN) + (size_t)j * DM * DFF, DFF, DFF, DFF}; pg8::StaticOrder S; S.init(nro, DM, F.G, (int)blockIdx.x);
            EpiResid E{args.out, HC, args.out, HC, modE, 5 * DM};
            pg8::gemm_phase<EpiResid, pg8::StaticOrder, true>(ring, g, S, E, F.wave);
        }
#endif
        GRID_BAR();
#if PH(13)
        {
            RowArgs A{}; A.hin_l = args.out; A.hin_c = HC; A.g = args.in[6] + (size_t)(lo * 2 + 0) * DM; A.modl = modO; A.shoff = 0; A.scoff = DM; A.U = U;
            REP(2048) o12_phase(F, nro, args.out, HC, A.g, modO);
            REP(16) for (int e = 0; e < NE; ++e) {
                conv_matrix(F, args.in[23] + ((size_t)j * NE + e) * DM * DFE, DM, DFE, (bf16*)(ws + WS_MWGU) + (size_t)e * 2 * DFE * DM, DM, 2, 0, nullptr, 1.f);
                conv_matrix(F, args.in[24] + ((size_t)j * NE + e) * DM * DFE, DM, DFE, (bf16*)(ws + WS_MWGU) + (size_t)e * 2 * DFE * DM, DM, 2, 128, nullptr, 1.f);
                conv_matrix(F, args.in[25] + ((size_t)j * NE + e) * DFE * DM, DFE, DM, (bf16*)(ws + WS_MWDN) + (size_t)e * DM * DFE, DFE, 0, 0, nullptr, 1.f);
            }
        }
#endif
        GRID_BAR();
#if PH(15)
        {
            pg8::Gemm g{(const bf16*)(ws + WS_POOLED), (const bf16*)(ws + WS_WPOOL) + (size_t)j * 4 * 65536, 256, 256, 256};
            pg8::PoolOrder S{nro / 256, MT / 256, F.G, (int)blockIdx.x};
            EpiPool E{args.out, HC, modO, args.in[20] + (size_t)j * DM, args.in[21] + (size_t)j * DM, MT / 256};
            pg8::gemm_phase<EpiPool, pg8::PoolOrder, true>(ring, g, S, E, F.wave);
        }
#endif
        GRID_BAR();
#if PH(16)
        {
            RowArgs A{}; A.hin_l = args.out; A.hin_c = HC; A.g = args.in[6] + (size_t)(lo * 2 + 1) * DM; A.modl = modO; A.shoff = 3 * DM; A.scoff = 4 * DM; A.U = U;
            A.router = args.in[22] + (size_t)j * DM * NE; A.eidx = (int*)(ws + WS_EIDX); A.gout = (float*)(ws + WS_GATE); A.cnt = (int*)(ws + WS_CNT);
            REP(4 | 512) row_phase<false, 1, true>(F, A, nro);
        }
#endif
        GRID_BAR();
#if PH(17)
        REP(4 | 1024) o5_phase(F, nro);
#endif
        GRID_BAR();
#if PH(18)
        {
            const int* TST = (const int*)(ws + WS_TST);
            const int ts1 = TST[1], ts2 = TST[2], ts3 = TST[3], ts4 = TST[4], ts5 = TST[5], ts6 = TST[6], ts7 = TST[7], nT = TST[8];
            for (int c = 0; c * MOE_CH < nT; ++c) {
                const int t0 = c * MOE_CH, nrt = (nT - t0) < MOE_CH ? (nT - t0) : MOE_CH;
                {
                    pg8::Gemm g{(const bf16*)(ws + WS_VG), (const bf16*)(ws + WS_MWGU), DM, DM, DM};
                    pg8::MoeOrder S{t0, nrt, 2 * DFE / 256, F.G, (int)blockIdx.x, ts1, ts2, ts3, ts4, ts5, ts6, ts7};
                    EpiGateUp E{(bf16*)(ws + WS_HIDM), DFE, 2 * DFE / 256, t0 * 256};
                    REP(8) pg8::gemm_phase<EpiGateUp, pg8::MoeOrder, true>(ring, g, S, E, F.wave);
                }
                GRID_BAR();
                {
                    pg8::Gemm g{(const bf16*)(ws + WS_HIDM) - (size_t)t0 * 256 * DFE, (const bf16*)(ws + WS_MWDN), DFE, DFE, DFE};
                    pg8::MoeOrder S{t0, nrt, DM / 256, F.G, (int)blockIdx.x, ts1, ts2, ts3, ts4, ts5, ts6, ts7};
                    EpiY E{(bf16*)(ws + WS_VG), DM / 256};
                    REP(8) pg8::gemm_phase<EpiY, pg8::MoeOrder, true>(ring, g, S, E, F.wave);
                }
                GRID_BAR();
            }
        }
#endif
    }
#if PH(19)
    {
        RowArgs A{}; A.hin_l = args.out; A.hin_c = HC; A.hout_l = args.out; A.hout_c = HC; A.g = args.in[7];
        A.Y = (const bf16*)(ws + WS_VG); A.pos = (const int*)(ws + WS_POS); A.gate = (const float*)(ws + WS_GATE); A.modprev = MODV + (size_t)3 * 17 * NMOD;
        row_phase<true, 2, false>(F, A, M);
        if (xb_ld((unsigned*)(ws + WS_CTL) + CW_BAR + XB_TMO) != 0u) { __syncthreads(); const float qn = __builtin_nanf(""); for (int i = F.tid; i < 1024; i += 512) args.out[(size_t)blockIdx.x * 1024 + i] = qn; }
    }
#endif
}

extern "C" void kernel_launch(void* const* d_in, const int* in_sizes, int n_in, void* d_out, int out_size, void* d_ws, size_t ws_size, hipStream_t stream) {
    static int grid = 0;
    if (grid == 0) {
        if (n_in != 26 || out_size != M * DM || ws_size < WS_END) { fprintf(stderr, "kernel_launch: unexpected shapes (n_in %d out %d ws %zu)\n", n_in, out_size, ws_size); grid = -1; return; }
        int dev = 0, cus = 0, per_cu = 0;
        if (hipGetDevice(&dev) != hipSuccess || hipDeviceGetAttribute(&cus, hipDeviceAttributeMultiprocessorCount, dev) != hipSuccess) { grid = -1; return; }
        if (hipFuncSetAttribute((const void*)mega_fwd, hipFuncAttributeMaxDynamicSharedMemorySize, LDS_BYTES) != hipSuccess) { grid = -1; return; }
        if (hipOccupancyMaxActiveBlocksPerMultiprocessor(&per_cu, (const void*)mega_fwd, NWAVES * 64, LDS_BYTES) != hipSuccess || per_cu < 1) fprintf(stderr, "kernel_launch: occupancy query says %d\n", per_cu);
        (void)hipGetLastError();
        grid = cus > 256 ? 256 : cus;
    }
    if (grid < 0) return;
    if (hipMemsetAsync((char*)d_ws + WS_CTL, 0, CTL_ZERO_BYTES, stream) != hipSuccess) return;
    Args a{};
    for (int i = 0; i < 26; ++i) a.in[i] = (const float*)d_in[i];
    a.out = (float*)d_out; a.ws = (unsigned char*)d_ws;
    hipLaunchKernelGGL(mega_fwd, dim3(grid), dim3(NWAVES * 64), LDS_BYTES, stream, a);
}
```

```cpp
#include <hip/hip_runtime.h>
#ifndef DUPMASK
#define DUPMASK 0
#endif
#include <cstdio>
#include <cstdint>

__device__ __forceinline__ int lane_now() { int l; asm volatile("v_mbcnt_lo_u32_b32 %0, -1, 0\n\tv_mbcnt_hi_u32_b32 %0, -1, %0" : "=v"(l)); return l; }
namespace pg8 {
#define PG8_LAS __attribute__((address_space(3)))
typedef unsigned short bf16_t;
typedef short bf16x8 __attribute__((ext_vector_type(8)));
typedef float f32x4 __attribute__((ext_vector_type(4)));
typedef unsigned u32x4 __attribute__((ext_vector_type(4)));
constexpr int BM = 256, BK = 64, HALF = 128, HTB = HALF * BK * 2, STAGE_BYTES = 8 * HTB, NXCD = 8, WGM = 8;

__host__ __device__ __forceinline__ int lds_byte(int r, int c) { const int st = (r >> 4) * 2 + (c >> 5), rr = r & 15, cc = c & 31, ob = rr * 64 + cc * 2; return st * 1024 + (ob ^ (((ob >> 9) & 1) << 5)); }
__host__ __device__ __forceinline__ void stage_rc(int b, int& R, int& C) { const int st = b / 1024, sb = b % 1024, swz = sb ^ (((sb >> 9) & 1) << 5); R = (st >> 1) * 16 + swz / 64; C = (st & 1) * 32 + (swz % 64) / 2; }
__host__ __device__ __forceinline__ int perm32(int rho) { const int n = rho >> 4, i = rho & 15; return 8 * (i >> 2) + 4 * n + (i & 3); }

struct Unit { int pm, pn; };
struct Gemm { const bf16_t* A; const bf16_t* Bt; int lda, ldb, K; };

struct StaticOrder {
    int nM, nN, nwg, G, c;
    __device__ void init(int M, int N, int G_, int c_) { nM = M / BM; nN = N / BM; nwg = nM * nN; G = G_; c = c_; }
    __device__ bool next(int i, Unit& u) const {
        const long L = (long)i * G + c; if (L >= nwg) return false;
        int wgid = (int)L; { const int q = nwg / NXCD, r = nwg % NXCD, xcd = wgid % NXCD, off = wgid / NXCD; wgid = (xcd < r ? xcd * (q + 1) : r * (q + 1) + (xcd - r) * q) + off; }
        const int nig = WGM * nN, gid = wgid / nig, fm = gid * WGM, gsz = (nM - fm) < WGM ? (nM - fm) : WGM;
        u.pm = fm + ((wgid % nig) % gsz); u.pn = (wgid % nig) / gsz; return true;
    }
};
struct PoolOrder {
    int nrt, talloc, G, c;
    __device__ bool next(int i, Unit& u) const { const int L = i * G + c; if (L >= 4 * nrt) return false; const int g = L / nrt, rt = L - g * nrt; u.pm = g * talloc + rt; u.pn = g; return true; }
};
struct MoeOrder {
    int t0, nrt, nct, G, c; int ts1, ts2, ts3, ts4, ts5, ts6, ts7;
    __device__ bool next(int i, Unit& u) const {
        const int nwg = nrt * nct; const int L = i * G + c; if (L >= nwg) return false;
        int wgid = L; { const int q = nwg / NXCD, r = nwg % NXCD, xcd = wgid % NXCD, off = wgid / NXCD; wgid = (xcd < r ? xcd * (q + 1) : r * (q + 1) + (xcd - r) * q) + off; }
        const int nig = WGM * nct, gid = wgid / nig, fm = gid * WGM, gsz = (nrt - fm) < WGM ? (nrt - fm) : WGM;
        const int rt = t0 + fm + ((wgid % nig) % gsz), ct = (wgid % nig) / gsz;
        const int e = (rt >= ts1) + (rt >= ts2) + (rt >= ts3) + (rt >= ts4) + (rt >= ts5) + (rt >= ts6) + (rt >= ts7);
        u.pm = rt; u.pn = e * nct + ct; return true;
    }
};

__device__ __forceinline__ unsigned cvt_pk_bf16(float lo, float hi) { unsigned r; asm volatile("v_cvt_pk_bf16_f32 %0, %1, %2" : "=v"(r) : "v"(lo), "v"(hi)); return r; }

template <class Epi, class Sched, bool ALIGN_EPI>
__device__ __forceinline__ void gemm_phase(PG8_LAS unsigned char* lds, const Gemm g, const Sched& S, const Epi& E, const int wid) {
    const int lane_ = lane_now();
    const int lane = lane_, tid = wid * 64 + lane, wr = wid >> 2, wc = wid & 3, fr = lane & 15, fq = lane >> 4;
    int K_ = g.K; asm volatile("" : "+s"(K_));
    const int K = K_, nt = K / BK;
    unsigned voffA[2], voffB[2];
#pragma unroll
    for (int i = 0; i < 2; ++i) { int R, C; stage_rc(tid * 16 + i * 8192, R, C); const int Rb = Epi::PERM ? ((R & ~31) + perm32(R & 31)) : R;
        voffA[i] = (unsigned)(R * g.lda + C) * 2u; voffB[i] = (unsigned)(Rb * g.ldb + C) * 2u; }
    const size_t kstep = (size_t)(BK * 2);
    const size_t hstepA = (size_t)HALF * g.lda * 2, hstepB = (size_t)HALF * g.ldb * 2;
    const size_t tstepA = 2 * hstepA, tstepB = 2 * hstepB;
    const unsigned ldsw = (unsigned)wid * 1024u;
    const int aoff = lds_byte(wr * 64 + fr, fq * 8), boff = lds_byte(wc * 32 + fr, fq * 8);
#define PG8_SA(b, h) (((b) * 2 + (h)) * HTB)
#define PG8_SB(b, h) ((4 + (b) * 2 + (h)) * HTB)
#define PG8_STAGE(bufoff, gbase, voff) do { _Pragma("unroll") for (int _i = 0; _i < 2; ++_i) \
        __builtin_amdgcn_global_load_lds((const unsigned*)((const char*)(gbase) + (voff)[_i]), (PG8_LAS unsigned*)(lds + (bufoff) + ldsw + _i * 8192), 16, 0, 0); } while (0)
#define PG8_LDA(dst, b, h) do { _Pragma("unroll") for (int m = 0; m < 4; ++m) _Pragma("unroll") for (int k = 0; k < 2; ++k) dst[m][k] = *(const PG8_LAS bf16x8*)(lds + PG8_SA(b, h) + aoff + m * 2048 + k * 1024); } while (0)
#define PG8_LDB(dst, b, h) do { _Pragma("unroll") for (int n = 0; n < 2; ++n) _Pragma("unroll") for (int k = 0; k < 2; ++k) dst[n][k] = *(const PG8_LAS bf16x8*)(lds + PG8_SB(b, h) + boff + n * 2048 + k * 1024); } while (0)
#define PG8_MMA(ai, bj, At, Bt) do { __builtin_amdgcn_s_setprio(1); _Pragma("unroll") for (int m = 0; m < 4; ++m) _Pragma("unroll") for (int n = 0; n < 2; ++n) _Pragma("unroll") for (int k = 0; k < 2; ++k) \
        acc[ai][bj][m][n] = __builtin_amdgcn_mfma_f32_16x16x32_bf16(Bt[n][k], At[m][k], acc[ai][bj][m][n], 0, 0, 0); __builtin_amdgcn_s_setprio(0); } while (0)
#define PG8_WAIT_V(n) asm volatile("s_waitcnt vmcnt(" #n ")" ::: "memory")
#define PG8_WAIT_L(n) asm volatile("s_waitcnt lgkmcnt(" #n ")" ::: "memory")
#define PG8_BAR __builtin_amdgcn_s_barrier()
#define PG8_SCHED __builtin_amdgcn_sched_barrier(0)
    Unit cur, nxt; int ui = 0;
    if (!S.next(0, cur)) return;
    f32x4 acc[2][2][4][2];
#pragma unroll
    for (int a = 0; a < 2; ++a)
#pragma unroll
        for (int b = 0; b < 2; ++b)
#pragma unroll
            for (int m = 0; m < 4; ++m)
#pragma unroll
                for (int n = 0; n < 2; ++n) acc[a][b][m][n] = (f32x4){0.f, 0.f, 0.f, 0.f};
    bf16x8 At[4][2], B0[2][2], B1[2][2];
    const char* cA = (const char*)g.A + (size_t)cur.pm * tstepA; const char* cB = (const char*)g.Bt + (size_t)cur.pn * tstepB;
    PG8_STAGE(PG8_SB(0, 0), cB, voffB); PG8_STAGE(PG8_SB(0, 1), cB + hstepB, voffB); PG8_STAGE(PG8_SA(0, 0), cA, voffA); PG8_STAGE(PG8_SA(0, 1), cA + hstepA, voffA);
    if (wr == 1) PG8_BAR;
    PG8_WAIT_V(2); PG8_BAR;
    PG8_STAGE(PG8_SB(1, 0), cB + kstep, voffB); PG8_STAGE(PG8_SA(1, 0), cA + kstep, voffA); PG8_STAGE(PG8_SB(1, 1), cB + hstepB + kstep, voffB);
    PG8_WAIT_V(6); PG8_BAR;
    for (;;) {
        const bool has_next = S.next(ui + 1, nxt);
        const char* nA = has_next ? (const char*)g.A + (size_t)nxt.pm * tstepA : cA; const char* nB = has_next ? (const char*)g.Bt + (size_t)nxt.pn * tstepB : cB;
#pragma unroll 1
        for (int t = 0; t < nt; t += 2) {
            const bool last = (t == nt - 2);
            const char* a1 = cA + (size_t)(t + 1) * kstep;
            const char* a2 = last ? nA : cA + (size_t)(t + 2) * kstep; const char* b2 = last ? nB : cB + (size_t)(t + 2) * kstep;
            const char* a3 = a2 + kstep; const char* b3 = b2 + kstep;
            PG8_LDB(B0, 0, 0); PG8_LDB(B1, 0, 1); PG8_SCHED; PG8_LDA(At, 0, 0); PG8_STAGE(PG8_SA(1, 1), a1 + hstepA, voffA);
            PG8_WAIT_V(8); PG8_WAIT_L(0); PG8_BAR; PG8_MMA(0, 0, At, B0); PG8_MMA(0, 1, At, B1); PG8_BAR; PG8_SCHED;
            PG8_LDA(At, 0, 1); PG8_STAGE(PG8_SB(0, 0), b2, voffB); PG8_STAGE(PG8_SB(0, 1), b2 + hstepB, voffB); PG8_STAGE(PG8_SA(0, 0), a2, voffA);
            PG8_WAIT_V(8); PG8_WAIT_L(0); PG8_BAR; PG8_MMA(1, 0, At, B0); PG8_MMA(1, 1, At, B1); PG8_BAR; PG8_SCHED;
            PG8_LDB(B0, 1, 0); PG8_LDB(B1, 1, 1); PG8_SCHED; PG8_LDA(At, 1, 0); PG8_STAGE(PG8_SA(0, 1), a2 + hstepA, voffA);
            PG8_WAIT_V(8); PG8_WAIT_L(0); PG8_BAR; PG8_MMA(0, 0, At, B0); PG8_MMA(0, 1, At, B1); PG8_BAR; PG8_SCHED;
            PG8_LDA(At, 1, 1); PG8_STAGE(PG8_SB(1, 0), b3, voffB); PG8_STAGE(PG8_SB(1, 1), b3 + hstepB, voffB); PG8_STAGE(PG8_SA(1, 0), a3, voffA);
            PG8_WAIT_V(8); PG8_WAIT_L(0); PG8_BAR; PG8_MMA(1, 0, At, B0); PG8_MMA(1, 1, At, B1); PG8_BAR; PG8_SCHED;
        }
        if constexpr (ALIGN_EPI) { if (wr == 0) PG8_BAR; }
        E(acc, cur, wr, wc, fr, fq);
        if (!has_next) break;
#pragma unroll
        for (int a = 0; a < 2; ++a)
#pragma unroll
            for (int b = 0; b < 2; ++b)
#pragma unroll
                for (int m = 0; m < 4; ++m)
#pragma unroll
                    for (int n = 0; n < 2; ++n) acc[a][b][m][n] = (f32x4){0.f, 0.f, 0.f, 0.f};
        cur = nxt; cA = nA; cB = nB; ++ui;
        if constexpr (ALIGN_EPI) { if (wr == 1) PG8_BAR; }
    }
    PG8_WAIT_V(0);
    if constexpr (!ALIGN_EPI) { if (wr == 0) PG8_BAR; }
    PG8_BAR;
#undef PG8_SA
#undef PG8_SB
#undef PG8_STAGE
#undef PG8_LDA
#undef PG8_LDB
#undef PG8_MMA
#undef PG8_WAIT_V
#undef PG8_WAIT_L
#undef PG8_BAR
#undef PG8_SCHED
}
}

constexpr int NWAVES = 8;
constexpr int DM = 1024, NB = 16, SEQ = 2048, CTXL = 256;
constexpr int M = NB * SEQ, MC = NB * CTXL, MT = M + MC;
constexpr int QL = 384, KVL = 256, ROPE = 32, HW = 512, NH = 8, QKD = 96, VD = 64;
constexpr int INW = 3232, INP = 3328;
constexpr int DFF = 2816, NE = 8, DFE = 3584, NMOD = 6 * DM;
constexpr int NHH = 4, HK = 128; constexpr int NKEY = SEQ + CTXL;
constexpr float EPS = 1e-6f;
constexpr int MAXT = 296;
constexpr int MOE_CH = 128;

constexpr size_t MiB = 1u << 20;
constexpr size_t WS_CTL = 0, CTL_ZERO_BYTES = 1 * MiB;
constexpr size_t WS_MODV = 1 * MiB;
constexpr size_t WS_ROPE = 3 * MiB;
constexpr size_t WS_CNT = 3 * MiB + 64 * 1024;
constexpr size_t WS_TST = 3 * MiB + 128 * 1024;
constexpr size_t WS_EIDX = 4 * MiB, WS_GATE = 4 * MiB + 512 * 1024, WS_POS = 5 * MiB;
constexpr size_t WS_RSQ = 6 * MiB, WS_RSKV = 6 * MiB + 256 * 1024;
constexpr size_t WS_HC = 8 * MiB;
constexpr size_t WS_WIN = 24 * MiB, WS_WUQ = 37 * MiB, WS_WUKV = 39 * MiB, WS_WOUT = 40 * MiB, WS_WGU = 44 * MiB, WS_WDN = 66 * MiB, WS_WPOOL = 77 * MiB;
constexpr size_t WS_U = 80 * MiB;
constexpr size_t WS_X = 152 * MiB;
constexpr size_t WS_CQ = WS_X, WS_CKV = 179 * MiB, WS_KR = 197 * MiB, WS_KRR = 200 * MiB, WS_HQ = 203 * MiB  ;
constexpr size_t WS_QB = 383 * MiB, WS_KN = 437 * MiB, WS_VV = 473 * MiB, WS_OF = 509 * MiB, WS_OB = 581 * MiB, WS_MIX = 653 * MiB, WS_HID = WS_X;
constexpr size_t WS_MWGU = WS_X, WS_MWDN = 264 * MiB, WS_POOLED = 320 * MiB, WS_VG = 392 * MiB, WS_HIDM = 540 * MiB, WS_END = 800 * MiB;
constexpr size_t HSEG = (size_t)MT * HW;
static_assert(WS_HQ + 5 * HSEG * 2 <= WS_QB && WS_MIX + (size_t)MT * DM * 2 <= WS_END && WS_HID + (size_t)MT * DFF * 2 <= WS_QB, "ws map even");
static_assert(WS_HIDM + (size_t)MOE_CH * 256 * DFE * 2 <= WS_END && WS_VG + (size_t)MAXT * 256 * DM * 2 <= WS_HIDM && WS_MWDN + (size_t)NE * DM * DFE * 2 <= WS_POOLED && WS_MWGU + (size_t)NE * 2 * DFE * DM * 2 <= WS_MWDN, "ws map odd");
constexpr int CW_BAR = 4096;

constexpr int RING_OFF = 0, RING_BYTES = 131072;
constexpr int LDSCTL_OFF = RING_BYTES, MISC_OFF = LDSCTL_OFF + 320;
constexpr int LDS_BYTES = 147456;

#define GAS __attribute__((address_space(1)))
#define LAS __attribute__((address_space(3)))
typedef unsigned short bf16;
typedef unsigned v4u __attribute__((ext_vector_type(4)));
typedef unsigned v2u __attribute__((ext_vector_type(2)));
typedef float f32x4 __attribute__((ext_vector_type(4)));
typedef GAS unsigned gu32;
#define RLX_AGENT __ATOMIC_RELAXED, __HIP_MEMORY_SCOPE_AGENT
#define LDS_WAIT() asm volatile("s_waitcnt lgkmcnt(0)" ::: "memory")
__device__ __forceinline__ unsigned f2bf(float f) { unsigned u = __builtin_bit_cast(unsigned, f); return (u + 0x7fffu + ((u >> 16) & 1u)) >> 16; }
__device__ __forceinline__ unsigned pk2(float lo, float hi) { return f2bf(lo) | (f2bf(hi) << 16); }
__device__ __forceinline__ float bf2f(unsigned short b) { return __uint_as_float((unsigned)b << 16); }
__device__ __forceinline__ float bflo(unsigned w) { return __uint_as_float(w << 16); }
__device__ __forceinline__ float bfhi(unsigned w) { return __uint_as_float(w & 0xffff0000u); }
__device__ __forceinline__ float sigmoidf_(float x) { return 1.0f / (1.0f + __expf(-x)); }
__device__ __forceinline__ float siluf_(float x) { return x / (1.0f + __expf(-x)); }

#define XB_TMO      128
#define XB_XCNT(j)  (256  + 64 * (j))
#define XB_XSUB(j)  (1280 + 64 * (j))
#define XB_XGEN(j)  (2304 + 64 * (j))
#define XB_TOP      3328
#define XB_TOPGEN   3392
#define XCD_BAR_WORDS 3456
#define XB_SPIN_CAP (1u << 22)
__device__ __forceinline__ unsigned xb_ld(unsigned* p)              { return __hip_atomic_load(p, __ATOMIC_RELAXED, __HIP_MEMORY_SCOPE_AGENT); }
__device__ __forceinline__ unsigned xb_add(unsigned* p, unsigned v) { return __hip_atomic_fetch_add(p, v, __ATOMIC_RELAXED, __HIP_MEMORY_SCOPE_AGENT); }
__device__ __forceinline__ unsigned xb_xcc_id() { return (unsigned)__builtin_amdgcn_s_getreg((3 << 11) | 20) & 0xFu; }
#define XB_SPIN(cond, bar) do { unsigned _sp = 0; while (cond) { __builtin_amdgcn_s_sleep(1); \
    if ((++_sp & 255u) == 0u) { if (xb_ld(&(bar)[XB_TMO])) break; if (_sp > XB_SPIN_CAP) { atomicAdd(&(bar)[XB_TMO], 1u); break; } } } } while (0)
struct XcdBarrier { unsigned* bar; unsigned x; volatile LAS unsigned* st; int wave; };
__device__ __forceinline__ bool xb_leader(int wave) { return wave == 0 && lane_now() == 0; }
__device__ __forceinline__ XcdBarrier xcd_barrier_post(unsigned* bar, volatile LAS unsigned* st, int wave) {
    XcdBarrier b; b.bar = bar; b.x = xb_xcc_id(); b.st = st; b.wave = wave;
    if (xb_leader(wave)) (void)xb_add(&bar[XB_XCNT(b.x)], 1u);
    return b;
}
__device__ __forceinline__ void xcd_barrier_complete(unsigned* bar, unsigned x, unsigned& nloc, unsigned& nx) {
    const unsigned G = gridDim.x * gridDim.y * gridDim.z;
    unsigned sum, cnt, mine, sp = 0u;
    for (;;) {
        sum = 0u; cnt = 0u; mine = 0u;
#pragma unroll
        for (unsigned j = 0; j < 16; ++j) { const unsigned c = xb_ld(&bar[XB_XCNT(j)]); sum += c; cnt += (c > 0u) ? 1u : 0u; mine = (j == x) ? c : mine; }
        if (sum == G) break;
        __builtin_amdgcn_s_sleep(1);
        if ((++sp & 255u) == 0u) { if (xb_ld(&bar[XB_TMO])) break; if (sp > XB_SPIN_CAP) { atomicAdd(&bar[XB_TMO], 1u); break; } }
    }
    nloc = mine > 0u ? mine : 1u; nx = cnt > 0u ? cnt : 1u;
}
__device__ __forceinline__ void xcd_barrier(const XcdBarrier& b) {
    asm volatile("s_waitcnt vmcnt(0)" ::: "memory");
    __syncthreads();
    if (xb_leader(b.wave)) {
        unsigned* bar = b.bar; asm volatile("" : "+s"(bar));
        __builtin_amdgcn_s_waitcnt(0);
        unsigned nloc = b.st[0], nx = b.st[1];
        if (nloc == 0u) { xcd_barrier_complete(bar, b.x, nloc, nx); b.st[0] = nloc; b.st[1] = nx; }
        const unsigned old = xb_add(&bar[XB_XSUB(b.x)], 1u);
        const unsigned gen = old / nloc;
        if (old + 1u == (gen + 1u) * nloc) {
            __builtin_amdgcn_fence(__ATOMIC_RELEASE, "agent");
            asm volatile("s_waitcnt vmcnt(0)" ::: "memory");
            const unsigned og = xb_add(&bar[XB_TOP], 1u);
            const unsigned tg = og / nx;
            if (og + 1u == (tg + 1u) * nx) xb_add(&bar[XB_TOPGEN], 1u);
            else XB_SPIN(xb_ld(&bar[XB_TOPGEN]) == tg, bar);
            __builtin_amdgcn_fence(__ATOMIC_ACQUIRE, "agent");
            xb_add(&bar[XB_XGEN(b.x)], 1u);
            asm volatile("s_waitcnt vmcnt(0)" ::: "memory");
        } else {
            XB_SPIN(xb_ld(&bar[XB_XGEN(b.x)]) == gen, bar);
            __builtin_amdgcn_fence(__ATOMIC_ACQUIRE, "agent");
            asm volatile("s_waitcnt vmcnt(0)" ::: "memory");
        }
    }
    __syncthreads();
}

struct Args { const float* in[26]; float* out; unsigned char* ws; };
struct Frame {
    LAS unsigned char* lds;
    int tid, lane, wave, G, vcu;
    const float* const* in; float* out; unsigned char* ws;
};
__device__ __forceinline__ float shx(float v, int lane, int m) { return __int_as_float(__builtin_amdgcn_ds_bpermute((lane ^ m) << 2, __float_as_int(v))); }
__device__ __forceinline__ float wave_sum(float v, int lane) {
#pragma unroll
    for (int o = 1; o < 64; o <<= 1) v += shx(v, lane, o);
    return v;
}

__device__ __forceinline__ void fresh(Frame& F) { const int l = lane_now(); F.lane = l; F.tid = F.wave * 64 + l; }

__device__ __forceinline__ void conv_item(const float* W, int ldw, bf16* WT, int ldd, int k0, int n0, int drow0, const float* kscale, float gscale, LAS float* scr, int lane) {
    float wv[32];
#pragma unroll
    for (int i = 0; i < 32; ++i) { const int kk = 2 * i + (lane >> 5); wv[i] = W[(size_t)(k0 + kk) * ldw + n0 + (lane & 31)]; }
#pragma unroll
    for (int i = 0; i < 32; ++i) { const int kk = 2 * i + (lane >> 5); float w = wv[i]; if (kscale) w *= kscale[k0 + kk]; scr[kk * 33 + (lane & 31)] = w * gscale; }
    LDS_WAIT(); asm volatile("" ::: "memory");
    const int c = lane & 7;
#pragma unroll
    for (int j = 0; j < 4; ++j) { const int n = (lane >> 3) + 8 * j; const LAS float* s = scr + (8 * c) * 33 + n;
        v4u o; o.x = pk2(s[0 * 33], s[1 * 33]); o.y = pk2(s[2 * 33], s[3 * 33]); o.z = pk2(s[4 * 33], s[5 * 33]); o.w = pk2(s[6 * 33], s[7 * 33]);
        *(v4u*)(WT + (size_t)(drow0 + n) * ldd + k0 + 8 * c) = o; }
    LDS_WAIT(); asm volatile("" ::: "memory");
}
__device__ __forceinline__ int conv_rowmap(int mode, int n0, int off) {
    if (mode == 0) return n0 + off;
    if (mode == 1) { if (n0 < 384) return n0; if (n0 < 640) return 512 + (n0 - 384); if (n0 < 672) return 384; return 768 + (n0 - 672); }
    return 256 * (n0 >> 7) + (n0 & 127) + off;
}
__device__ __forceinline__ void conv_matrix(Frame& F, const float* W, int K, int N, bf16* WT, int ldd, int mode, int off, const float* kscale, float gscale) {
    LAS float* scr = (LAS float*)(F.lds + RING_OFF + F.wave * 16384);
    const int gw = F.vcu * NWAVES + F.wave, NGW = F.G * NWAVES;
    const int nblk = N / 32, nitems = (K / 64) * nblk;
    for (int it = gw; it < nitems; it += NGW) { const int kb = it / nblk, nb = it % nblk; conv_item(W, N, WT, ldd, 64 * kb, 32 * nb, conv_rowmap(mode, 32 * nb, off), kscale, gscale, scr, F.lane); }
}

__device__ __forceinline__ int row_bidx(int row) { return row < M ? row / SEQ : NB; }

struct RowArgs {
    const float* hin_l; const float* hin_c; float* hout_l; float* hout_c;
    const float* g;
    const float* modl;
    int shoff, scoff;
    bf16* U;
    const bf16* Y; const int* pos; const float* gate; const float* modprev;
    const float* router; int* eidx; float* gout; int* cnt;
};
template <bool COMBINE, int OUTMODE, bool ROUTER>
__device__ __forceinline__ void row_phase(Frame& F, const RowArgs& A, int nrows) {
    fresh(F);
    const int rpw = (nrows + F.G - 1) / F.G;
    LAS int* lcnt = (LAS int*)(F.lds + RING_OFF);
    if (ROUTER) { if (F.tid < 8) lcnt[F.tid] = 0; __syncthreads(); }
    const int rbase = (int)blockIdx.x * rpw, rend = (rbase + rpw < nrows) ? rbase + rpw : nrows;
#define ROWPTR(r_) (((r_) < M) ? A.hin_l + (size_t)(r_) * DM : A.hin_c + (size_t)((r_) - M) * DM)
    f32x4 rw[16][2];
    if (ROUTER) {
#pragma unroll
        for (int j = 0; j < 4; ++j)
#pragma unroll
            for (int q = 0; q < 4; ++q) { const int col = 4 * F.lane + 256 * j + q; rw[4 * j + q][0] = *(const f32x4*)(A.router + (size_t)col * 8); rw[4 * j + q][1] = *(const f32x4*)(A.router + (size_t)col * 8 + 4); }
    }
    int row = rbase + F.wave;
    f32x4 v[4], vn[4];
    if (row < rend) { const float* hr = ROWPTR(row);
#pragma unroll
        for (int j = 0; j < 4; ++j) v[j] = *(const f32x4*)(hr + 4 * F.lane + 256 * j); }
    for (; row < rend; row += NWAVES) {
        const bool lat = row < M; const int bidx = lat ? row / SEQ : NB;
        const int rnext = row + NWAVES;
        if (rnext < rend) { const float* hr = ROWPTR(rnext);
#pragma unroll
            for (int j = 0; j < 4; ++j) vn[j] = *(const f32x4*)(hr + 4 * F.lane + 256 * j); }
        if (COMBINE) {
            const int pa = A.pos[2 * row], pb = A.pos[2 * row + 1]; const float ga = A.gate[2 * row], gb = A.gate[2 * row + 1];
            const float* g2 = A.modprev + bidx * NMOD + 5 * DM;
#pragma unroll
            for (int j = 0; j < 4; ++j) { const int col = 4 * F.lane + 256 * j;
                const v2u ya = *(const v2u*)(A.Y + (size_t)pa * DM + col), yb = *(const v2u*)(A.Y + (size_t)pb * DM + col); const f32x4 gv = *(const f32x4*)(g2 + col);
                v[j].x += gv.x * (ga * bflo(ya.x) + gb * bflo(yb.x)); v[j].y += gv.y * (ga * bfhi(ya.x) + gb * bfhi(yb.x));
                v[j].z += gv.z * (ga * bflo(ya.y) + gb * bflo(yb.y)); v[j].w += gv.w * (ga * bfhi(ya.y) + gb * bfhi(yb.y)); }
            if (OUTMODE != 2) { float* ho = lat ? A.hout_l + (size_t)row * DM : A.hout_c + (size_t)(row - M) * DM;
#pragma unroll
                for (int j = 0; j < 4; ++j) *(f32x4*)(ho + 4 * F.lane + 256 * j) = v[j]; }
        }
        float s = 0.f;
#pragma unroll
        for (int j = 0; j < 4; ++j) s += (v[j].x * v[j].x + v[j].y * v[j].y) + (v[j].z * v[j].z + v[j].w * v[j].w);
        const float rstd = rsqrtf(wave_sum(s, F.lane) * (1.0f / DM) + EPS);
        if (OUTMODE == 2) {
            float* ho = A.hout_l + (size_t)row * DM;
#pragma unroll
            for (int j = 0; j < 4; ++j) { const int col = 4 * F.lane + 256 * j; const f32x4 gv = *(const f32x4*)(A.g + col); *(f32x4*)(ho + col) = v[j] * rstd * gv; }
        } else {
            const float* sh = A.modl + bidx * NMOD + A.shoff; const float* sc = A.modl + bidx * NMOD + A.scoff;
            float lg[8];
            if (ROUTER) {
#pragma unroll
                for (int e = 0; e < 8; ++e) lg[e] = 0.f;
            }
#pragma unroll
            for (int j = 0; j < 4; ++j) { const int col = 4 * F.lane + 256 * j; const f32x4 gv = *(const f32x4*)(A.g + col), shv = *(const f32x4*)(sh + col), scv = *(const f32x4*)(sc + col);
                f32x4 y = v[j] * rstd * gv * (scv + 1.0f) + shv;
                v2u o; o.x = pg8::cvt_pk_bf16(y.x, y.y); o.y = pg8::cvt_pk_bf16(y.z, y.w); *(v2u*)(A.U + (size_t)row * DM + col) = o;
                if (ROUTER) {
#pragma unroll
                    for (int q = 0; q < 4; ++q) { const f32x4 r0 = rw[4 * j + q][0], r1 = rw[4 * j + q][1]; const float yy = y[q];
                        lg[0] += yy * r0.x; lg[1] += yy * r0.y; lg[2] += yy * r0.z; lg[3] += yy * r0.w; lg[4] += yy * r1.x; lg[5] += yy * r1.y; lg[6] += yy * r1.z; lg[7] += yy * r1.w; } }
            }
            if (ROUTER) {
                const int b5 = F.lane >> 5, b4 = (F.lane >> 4) & 1, b3 = (F.lane >> 3) & 1; float a4[4], c2[2];
#pragma unroll
                for (int q = 0; q < 4; ++q) { const float mine = b5 ? lg[4 + q] : lg[q], oth = b5 ? lg[q] : lg[4 + q]; a4[q] = mine + shx(oth, F.lane, 32); }
#pragma unroll
                for (int q = 0; q < 2; ++q) { const float mine = b4 ? a4[2 + q] : a4[q], oth = b4 ? a4[q] : a4[2 + q]; c2[q] = mine + shx(oth, F.lane, 16); }
                float d1 = (b3 ? c2[1] : c2[0]) + shx(b3 ? c2[0] : c2[1], F.lane, 8);
                d1 += shx(d1, F.lane, 4); d1 += shx(d1, F.lane, 2); d1 += shx(d1, F.lane, 1);
#pragma unroll
                for (int e = 0; e < 8; ++e) lg[e] = __int_as_float(__builtin_amdgcn_readlane(__float_as_int(d1), 8 * e));
                int i0 = 0; float v0 = lg[0];
#pragma unroll
                for (int e = 1; e < 8; ++e) if (lg[e] > v0) { v0 = lg[e]; i0 = e; }
                int i1 = -1; float v1 = -INFINITY;
#pragma unroll
                for (int e = 0; e < 8; ++e) if (e != i0 && lg[e] > v1) { v1 = lg[e]; i1 = e; }
                const float g0 = 1.0f / (1.0f + __expf(v1 - v0));
                if (F.lane == 0) { A.eidx[2 * row] = i0; A.eidx[2 * row + 1] = i1; A.gout[2 * row] = g0; A.gout[2 * row + 1] = 1.0f - g0; atomicAdd((int*)&lcnt[i0], 1); atomicAdd((int*)&lcnt[i1], 1); }
            }
        }
#pragma unroll
        for (int j = 0; j < 4; ++j) v[j] = vn[j];
    }
#undef ROWPTR
    if (ROUTER) { __syncthreads(); if (F.tid < 8) A.cnt[blockIdx.x * 8 + F.tid] = lcnt[F.tid]; __syncthreads(); }
}

using pg8::Unit; using pg8::cvt_pk_bf16;
__device__ __forceinline__ v4u pack8(const f32x4& a, const f32x4& b) { v4u w; w.x = cvt_pk_bf16(a[0], a[1]); w.y = cvt_pk_bf16(a[2], a[3]); w.z = cvt_pk_bf16(b[0], b[1]); w.w = cvt_pk_bf16(b[2], b[3]); return w; }
struct EpiIn {
    static constexpr bool PERM = true;
    bf16 *CQ, *KR, *CKV, *H5;
    __device__ __forceinline__ void operator()(const f32x4 (&acc)[2][2][4][2], const Unit& u, int wr, int wc, int fr, int fq) const {
        const int row0 = u.pm * 256 + wr * 64 + fr;
#pragma unroll
        for (int bj = 0; bj < 2; ++bj) {
            const int col = u.pn * 256 + bj * 128 + wc * 32 + 8 * fq;
            bf16* base; int ld;
            if (col < 384) { base = CQ + col; ld = QL; }
            else if (col < 416) { base = KR + (col - 384); ld = ROPE; }
            else if (col < 512) { base = nullptr; ld = 0; }
            else if (col < 768) { base = CKV + (col - 512); ld = KVL; }
            else { const int c2 = col - 768; base = H5 + (size_t)(c2 >> 9) * HSEG + (c2 & 511); ld = HW; }
            if (base) {
#pragma unroll
                for (int ai = 0; ai < 2; ++ai)
#pragma unroll
                    for (int m = 0; m < 4; ++m) { const int row = row0 + ai * 128 + m * 16; *(v4u*)(base + (size_t)row * ld) = pack8(acc[ai][bj][m][0], acc[ai][bj][m][1]); }
            }
        }
    }
};
struct EpiQ {
    static constexpr bool PERM = true;
    bf16* O; const float* rs;
    __device__ __forceinline__ void operator()(const f32x4 (&acc)[2][2][4][2], const Unit& u, int wr, int wc, int fr, int fq) const {
        const int row0 = u.pm * 256 + wr * 64 + fr;
#pragma unroll
        for (int ai = 0; ai < 2; ++ai)
#pragma unroll
            for (int m = 0; m < 4; ++m) { const int row = row0 + ai * 128 + m * 16; const float sc = rs[row];
#pragma unroll
                for (int bj = 0; bj < 2; ++bj) { const int col = u.pn * 256 + bj * 128 + wc * 32 + 8 * fq; *(v4u*)(O + (size_t)row * 768 + col) = pack8(acc[ai][bj][m][0] * sc, acc[ai][bj][m][1] * sc); } }
    }
};
struct EpiKV {
    static constexpr bool PERM = true;
    bf16* KNp; bf16* VTp; const float* rs;
    __device__ __forceinline__ void operator()(const f32x4 (&acc)[2][2][4][2], const Unit& u, int wr, int wc, int fr, int fq) const {
        const int row0 = u.pm * 256 + wr * 64 + fr;
#pragma unroll
        for (int ai = 0; ai < 2; ++ai)
#pragma unroll
            for (int m = 0; m < 4; ++m) { const int row = row0 + ai * 128 + m * 16; const float sc = rs[row];
                const bool lat = row < M; const int b = lat ? row / SEQ : (row - M) / CTXL; const int key = lat ? row % SEQ : SEQ + (row - M) % CTXL;
                const int kpos = (key & ~12) | ((key & 4) << 1) | ((key & 8) >> 1);
#pragma unroll
                for (int bj = 0; bj < 2; ++bj) { const int col = u.pn * 256 + bj * 128 + wc * 32 + 8 * fq; const int hh = col >> 7, w = col & 127;
                    if (w < 64) { *(v4u*)(KNp + (size_t)row * HW + hh * 64 + w) = pack8(acc[ai][bj][m][0] * sc, acc[ai][bj][m][1] * sc); }
                    else { bf16* dst = VTp + ((size_t)((b * NH + hh) * VD + (w - 64))) * NKEY + kpos;
#pragma unroll
                        for (int n = 0; n < 2; ++n)
#pragma unroll
                            for (int q = 0; q < 4; ++q) dst[(size_t)(4 * n + q) * NKEY] = (bf16)f2bf(acc[ai][bj][m][n][q] * sc); } } }
    }
};
struct EpiResid {
    static constexpr bool PERM = false;
    const float* hin_l; const float* hin_c; float* hout_l; float* hout_c; const float* modl; int goff;
    __device__ __forceinline__ void operator()(const f32x4 (&acc)[2][2][4][2], const Unit& u, int wr, int wc, int fr, int fq) const {
        const int rowt = u.pm * 256; const bool lat = rowt < M; const int bidx = lat ? rowt / SEQ : NB;
        const float* gate = modl + bidx * NMOD + goff;
        const float* hi = lat ? hin_l + (size_t)rowt * DM : hin_c + (size_t)(rowt - M) * DM;
        float* ho = lat ? hout_l + (size_t)rowt * DM : hout_c + (size_t)(rowt - M) * DM;
        const int col0 = u.pn * 256 + wc * 32 + 4 * fq;
#pragma unroll
        for (int bj = 0; bj < 2; ++bj) {
            f32x4 hv[2][2][4];
#pragma unroll
            for (int n = 0; n < 2; ++n)
#pragma unroll
                for (int ai = 0; ai < 2; ++ai)
#pragma unroll
                    for (int m = 0; m < 4; ++m) hv[n][ai][m] = *(const f32x4*)(hi + (size_t)(ai * 128 + wr * 64 + m * 16 + fr) * DM + col0 + bj * 128 + n * 16);
#pragma unroll
            for (int n = 0; n < 2; ++n) { const f32x4 gv = *(const f32x4*)(gate + col0 + bj * 128 + n * 16);
#pragma unroll
                for (int ai = 0; ai < 2; ++ai)
#pragma unroll
                    for (int m = 0; m < 4; ++m) *(f32x4*)(ho + (size_t)(ai * 128 + wr * 64 + m * 16 + fr) * DM + col0 + bj * 128 + n * 16) = hv[n][ai][m] + gv * acc[ai][bj][m][n]; }
            asm volatile("" ::: "memory"); }
    }
};
struct EpiPool {
    static constexpr bool PERM = false;
    float* h_l; float* h_c; const float* modl; const float* bias; const float* scale; int talloc;
    __device__ __forceinline__ void operator()(const f32x4 (&acc)[2][2][4][2], const Unit& u, int wr, int wc, int fr, int fq) const {
        const int g = u.pn, rowt = (u.pm - g * talloc) * 256; const bool lat = rowt < M; const int bidx = lat ? rowt / SEQ : NB;
        const float* gate = modl + bidx * NMOD + 2 * DM;
        float* ho = lat ? h_l + (size_t)rowt * DM : h_c + (size_t)(rowt - M) * DM;
        const int col0 = g * 256 + wc * 32 + 4 * fq;
#pragma unroll
        for (int bj = 0; bj < 2; ++bj)
#pragma unroll
            for (int n = 0; n < 2; ++n) { const int c = col0 + bj * 128 + n * 16; const f32x4 gm = *(const f32x4*)(gate + c) * *(const f32x4*)(scale + c); const f32x4 gb = gm * *(const f32x4*)(bias + c);
#pragma unroll
                for (int ai = 0; ai < 2; ++ai)
#pragma unroll
                    for (int m = 0; m < 4; ++m) { const int r = ai * 128 + wr * 64 + m * 16 + fr; const size_t off = (size_t)r * DM + c; const f32x4 hv = *(const f32x4*)(ho + off); *(f32x4*)(ho + off) = hv + gm * acc[ai][bj][m][n] + gb; }
                asm volatile("" ::: "memory"); }
    }
};
struct EpiGateUp {
    static constexpr bool PERM = true;
    bf16* H; int ldh, nct, rowsub;
    __device__ __forceinline__ void operator()(const f32x4 (&acc)[2][2][4][2], const Unit& u, int wr, int wc, int fr, int fq) const {
        const int row0 = u.pm * 256 + wr * 64 + fr - rowsub; const int ct = u.pn % nct; const int col = ct * 128 + wc * 32 + 8 * fq;
#pragma unroll
        for (int ai = 0; ai < 2; ++ai)
#pragma unroll
            for (int m = 0; m < 4; ++m) { const int row = row0 + ai * 128 + m * 16; f32x4 o[2];
#pragma unroll
                for (int n = 0; n < 2; ++n)
#pragma unroll
                    for (int q = 0; q < 4; ++q) { const float gv = acc[ai][0][m][n][q], uv = acc[ai][1][m][n][q]; o[n][q] = gv * uv / (1.0f + __expf(-gv)); }
                *(v4u*)(H + (size_t)row * ldh + col) = pack8(o[0], o[1]); }
    }
};
struct EpiY {
    static constexpr bool PERM = true;
    bf16* Y; int nct;
    __device__ __forceinline__ void operator()(const f32x4 (&acc)[2][2][4][2], const Unit& u, int wr, int wc, int fr, int fq) const {
        const int row0 = u.pm * 256 + wr * 64 + fr; const int ct = u.pn % nct;
#pragma unroll
        for (int ai = 0; ai < 2; ++ai)
#pragma unroll
            for (int m = 0; m < 4; ++m) { const int row = row0 + ai * 128 + m * 16;
#pragma unroll
                for (int bj = 0; bj < 2; ++bj) { const int col = ct * 256 + bj * 128 + wc * 32 + 8 * fq; *(v4u*)(Y + (size_t)row * DM + col) = pack8(acc[ai][bj][m][0], acc[ai][bj][m][1]); } }
    }
};

__device__ __forceinline__ void p0_prologue(Frame& F) {
    fresh(F);
    unsigned char* ws = F.ws;
    const float qscale = 0.10206207261596577f * 1.4426950408889634f;
    for (int j = 0; j < 2; ++j) {
        conv_matrix(F, F.in[8] + (size_t)j * DM * INW, DM, INW, (bf16*)(ws + WS_WIN) + (size_t)j * INP * DM, DM, 1, 0, nullptr, 1.f);
        conv_matrix(F, F.in[11] + (size_t)j * QL * 768, QL, 768, (bf16*)(ws + WS_WUQ) + (size_t)j * 768 * QL, QL, 0, 0, F.in[9] + j * QL, qscale);
        conv_matrix(F, F.in[12] + (size_t)j * KVL * 1024, KVL, 1024, (bf16*)(ws + WS_WUKV) + (size_t)j * 1024 * KVL, KVL, 0, 0, F.in[10] + j * KVL, 1.f);
        conv_matrix(F, F.in[15] + (size_t)j * DM * DM, DM, DM, (bf16*)(ws + WS_WOUT) + (size_t)j * DM * DM, DM, 0, 0, nullptr, 1.f);
        conv_matrix(F, F.in[16] + (size_t)j * DM * DFF, DM, DFF, (bf16*)(ws + WS_WGU) + (size_t)j * 2 * DFF * DM, DM, 2, 0, nullptr, 1.f);
        conv_matrix(F, F.in[17] + (size_t)j * DM * DFF, DM, DFF, (bf16*)(ws + WS_WGU) + (size_t)j * 2 * DFF * DM, DM, 2, 128, nullptr, 1.f);
        conv_matrix(F, F.in[18] + (size_t)j * DFF * DM, DFF, DM, (bf16*)(ws + WS_WDN) + (size_t)j * DM * DFF, DFF, 0, 0, nullptr, 1.f);
        for (int g = 0; g < 4; ++g)
            conv_matrix(F, F.in[19] + (size_t)(j * 4 + g) * 65536, 256, 256, (bf16*)(ws + WS_WPOOL) + (size_t)(j * 4 + g) * 65536, 256, 0, 0, nullptr, 1.f);
    }
    __syncthreads();
    if (blockIdx.x == 0 && F.tid < 8) {
        float* TC = (float*)(ws + WS_ROPE); float* TS = TC + 512;
        double th = 1.0; for (int i = 0; i < F.tid; ++i) th *= 0.31622776601683794;
        const double x2 = th * th; double s = th, c = 1.0, ts = th, tc = 1.0;
        for (int n = 1; n <= 12; ++n) { tc *= -x2 / (double)((2 * n - 1) * (2 * n)); c += tc; ts *= -x2 / (double)((2 * n) * (2 * n + 1)); s += ts; }
        double cp = 1.0, sp = 0.0;
        for (int p = 0; p < 64; ++p) { TC[p * 8 + F.tid] = (float)cp; TS[p * 8 + F.tid] = (float)sp; const double ncp = cp * c - sp * s; sp = sp * c + cp * s; cp = ncp; }
    }
    {
        LAS float* sc = (LAS float*)(F.lds + RING_OFF);
        LAS float* red = sc + 17 * 1024;
        const int nitems = 4 * (NMOD / 64);
        if ((int)blockIdx.x < nitems) {
            for (int e = F.tid; e < 17 * 1024; e += 512) { const int r = e >> 10, k = e & 1023; const float x = (r < 16) ? F.in[1][r * 1024 + k] : F.in[3][k]; sc[e] = siluf_(x); }
            __syncthreads();
            for (int it = blockIdx.x; it < nitems; it += F.G) {
                const int l = it / (NMOD / 64), c0 = (it % (NMOD / 64)) * 64;
                const float* W = F.in[4] + (size_t)l * DM * NMOD + c0 + F.lane;
                float acc[17];
#pragma unroll
                for (int r = 0; r < 17; ++r) acc[r] = 0.f;
                const int kb = F.wave * 128;
                for (int k = 0; k < 128; k += 4) {
                    const float w0 = W[(size_t)(kb + k) * NMOD], w1 = W[(size_t)(kb + k + 1) * NMOD], w2 = W[(size_t)(kb + k + 2) * NMOD], w3 = W[(size_t)(kb + k + 3) * NMOD];
#pragma unroll
                    for (int r = 0; r < 17; ++r) { const f32x4 s4 = *(const LAS f32x4*)(sc + r * 1024 + kb + k); acc[r] += s4.x * w0 + s4.y * w1 + s4.z * w2 + s4.w * w3; }
                }
#pragma unroll
                for (int r = 0; r < 17; ++r) red[(F.wave * 17 + r) * 64 + F.lane] = acc[r];
                __syncthreads();
                for (int o = F.tid; o < 17 * 64; o += 512) { const int r = o >> 6, cc = o & 63; float s = 0.f;
#pragma unroll
                    for (int w = 0; w < 8; ++w) s += red[(w * 17 + r) * 64 + cc];
                    ((float*)(ws + WS_MODV))[(size_t)(l * 17 + r) * NMOD + c0 + cc] = s + F.in[5][l * NMOD + c0 + cc]; }
                __syncthreads();
            }
        }
    }
}

__device__ __forceinline__ void e3_phase(Frame& F) {
    fresh(F);
    unsigned char* ws = F.ws;
    const bf16* CQ = (const bf16*)(ws + WS_CQ); const bf16* CKV = (const bf16*)(ws + WS_CKV); const bf16* KR = (const bf16*)(ws + WS_KR); bf16* KRR = (bf16*)(ws + WS_KRR);
    float* RSQ = (float*)(ws + WS_RSQ); float* RSKV = (float*)(ws + WS_RSKV); const float* TC = (const float*)(ws + WS_ROPE); const float* TS = TC + 512;
    const int rpw = (MT + F.G - 1) / F.G;
    for (int i = F.wave; i < rpw; i += NWAVES) {
        const int row = (int)blockIdx.x * rpw + i; if (row >= MT) break;
        float s = 0.f;
        if (F.lane < 48) { const v4u w = *(const v4u*)(CQ + (size_t)row * QL + F.lane * 8);
            s = bflo(w.x) * bflo(w.x) + bfhi(w.x) * bfhi(w.x) + bflo(w.y) * bflo(w.y) + bfhi(w.y) * bfhi(w.y) + bflo(w.z) * bflo(w.z) + bfhi(w.z) * bfhi(w.z) + bflo(w.w) * bflo(w.w) + bfhi(w.w) * bfhi(w.w); }
        s = wave_sum(s, F.lane); if (F.lane == 0) RSQ[row] = rsqrtf(s * (1.0f / QL) + EPS);
        s = 0.f;
        if (F.lane < 32) { const v4u w = *(const v4u*)(CKV + (size_t)row * KVL + F.lane * 8);
            s = bflo(w.x) * bflo(w.x) + bfhi(w.x) * bfhi(w.x) + bflo(w.y) * bflo(w.y) + bfhi(w.y) * bfhi(w.y) + bflo(w.z) * bflo(w.z) + bfhi(w.z) * bfhi(w.z) + bflo(w.w) * bflo(w.w) + bfhi(w.w) * bfhi(w.w); }
        s = wave_sum(s, F.lane); if (F.lane == 0) RSKV[row] = rsqrtf(s * (1.0f / KVL) + EPS);
        const float x = (F.lane < 32) ? bf2f(KR[(size_t)row * ROPE + F.lane]) : 0.f; const float pr = shx(x, F.lane, 8);
        float o = x;
        if (row < M) { const int t = row % SEQ; const int p = ((F.lane >> 4) & 1) ? (t & 63) : (t >> 6); const int j = F.lane & 7; const float c = TC[p * 8 + j], sn = TS[p * 8 + j];
            o = ((F.lane >> 3) & 1) ? x * c + pr * sn : x * c - pr * sn; }
        if (F.lane < 32) KRR[(size_t)row * ROPE + F.lane] = (bf16)f2bf(o);
    }
}

typedef short bf16x8v __attribute__((ext_vector_type(8)));
typedef float f32x16 __attribute__((ext_vector_type(16)));
__device__ __forceinline__ void attn_unit(Frame& F, int b, int h, int qrow0, bool rope_q, int t_lo, int t_hi) {
    unsigned char* ws = F.ws;
    const bf16* QB = (const bf16*)(ws + WS_QB); const bf16* KN = (const bf16*)(ws + WS_KN); const bf16* KRR = (const bf16*)(ws + WS_KRR); const bf16* VT = (const bf16*)(ws + WS_VV);
    bf16* MIX = (bf16*)(ws + WS_MIX); const float* TC = (const float*)(ws + WS_ROPE); const float* TS = TC + 512;
    const int lane = F.lane, wave = F.wave, r32 = lane & 31, hi = lane >> 5;
    LAS unsigned char* ring = F.lds + RING_OFF;
    const int qrow = qrow0 + wave * 32 + r32;
    bf16x8v qr[6];
#pragma unroll
    for (int d0 = 0; d0 < 6; ++d0) qr[d0] = *(const bf16x8v*)(QB + (size_t)qrow * 768 + h * QKD + 16 * d0 + 8 * hi);
    if (rope_q) { const int t = qrow % SEQ;
#pragma unroll
        for (int a = 0; a < 2; ++a) { const int p = a ? (t & 63) : (t >> 6); const v4u w = __builtin_bit_cast(v4u, qr[4 + a]); float x[8], y[8];
            x[0] = bflo(w.x); x[1] = bfhi(w.x); x[2] = bflo(w.y); x[3] = bfhi(w.y); x[4] = bflo(w.z); x[5] = bfhi(w.z); x[6] = bflo(w.w); x[7] = bfhi(w.w);
#pragma unroll
            for (int jj = 0; jj < 8; ++jj) { const float pr = shx(x[jj], lane, 32); const float c = TC[p * 8 + jj], sn = TS[p * 8 + jj]; y[jj] = hi ? x[jj] * c + pr * sn : x[jj] * c - pr * sn; }
            v4u o; o.x = pk2(y[0], y[1]); o.y = pk2(y[2], y[3]); o.z = pk2(y[4], y[5]); o.w = pk2(y[6], y[7]); qr[4 + a] = __builtin_bit_cast(bf16x8v, o); } }
    const int bh = b * NH + h;
    const bf16* vsrc = VT + ((size_t)(bh * VD + lane)) * NKEY + 8 * wave;
#define ATT_DMA(t, buf) do { const int t_ = (t); const int r0_ = t_ < SEQ / 64 ? b * SEQ + 64 * t_ : M + b * CTXL + 64 * (t_ - SEQ / 64); \
        LAS unsigned char* kb_ = ring + (buf) * 20480; LAS unsigned char* vb_ = kb_ + 12288; \
        __builtin_amdgcn_global_load_lds((const unsigned*)(KN + (size_t)(r0_ + lane) * HW + h * 64 + 8 * wave), (LAS unsigned*)(kb_ + wave * 1024), 16, 0, 0); \
        __builtin_amdgcn_global_load_lds((const unsigned*)(KRR + (size_t)(r0_ + lane) * ROPE + 8 * (wave & 3)), (LAS unsigned*)(kb_ + (8 + (wave & 3)) * 1024), 16, 0, 0);     \
        __builtin_amdgcn_global_load_lds((const unsigned*)(vsrc + 64 * t_), (LAS unsigned*)(vb_ + wave * 1024), 16, 0, 0); } while (0)
    f32x16 o0, o1;
#pragma unroll
    for (int r = 0; r < 16; ++r) { o0[r] = 0.f; o1[r] = 0.f; }
    constexpr float ATT_THR = 8.0f;
    float m_run = 0.f, l_run = 0.f;
    asm volatile("s_waitcnt vmcnt(0)" ::: "memory");
    ATT_DMA(t_lo, 0); if (t_lo + 1 < t_hi) ATT_DMA(t_lo + 1, 1); if (t_lo + 2 < t_hi) ATT_DMA(t_lo + 2, 2);
    for (int t = t_lo; t < t_hi; ++t) {
        const int buf = (t - t_lo) & 3; const int rem = t_hi - 1 - t;
        if (rem >= 2) asm volatile("s_waitcnt vmcnt(6)" ::: "memory"); else if (rem == 1) asm volatile("s_waitcnt vmcnt(3)" ::: "memory"); else asm volatile("s_waitcnt vmcnt(0)" ::: "memory");
        asm volatile("s_waitcnt lgkmcnt(0)" ::: "memory"); __builtin_amdgcn_s_barrier(); asm volatile("" ::: "memory");
        if (t + 3 < t_hi) ATT_DMA(t + 3, (buf + 3) & 3);
        const LAS unsigned char* kb = ring + buf * 20480 + hi * 1024 + r32 * 16; const LAS unsigned char* vb = ring + buf * 20480 + 12288 + hi * 1024 + r32 * 16;
        bf16x8v kf[12], vf[8];
#pragma unroll
        for (int d0 = 0; d0 < 6; ++d0) { kf[2 * d0] = *(const LAS bf16x8v*)(kb + d0 * 2048); kf[2 * d0 + 1] = *(const LAS bf16x8v*)(kb + d0 * 2048 + 512); }
#pragma unroll
        for (int s4 = 0; s4 < 4; ++s4) { vf[2 * s4] = *(const LAS bf16x8v*)(vb + s4 * 2048); vf[2 * s4 + 1] = *(const LAS bf16x8v*)(vb + s4 * 2048 + 512); }
        f32x16 p0, p1; const float negm = -m_run;
#pragma unroll
        for (int r = 0; r < 16; ++r) { p0[r] = negm; p1[r] = negm; }
#pragma unroll
        for (int d0 = 0; d0 < 6; ++d0) { p0 = __builtin_amdgcn_mfma_f32_32x32x16_bf16(kf[2 * d0], qr[d0], p0, 0, 0, 0); p1 = __builtin_amdgcn_mfma_f32_32x32x16_bf16(kf[2 * d0 + 1], qr[d0], p1, 0, 0, 0); }
        float ma = __builtin_fmaxf(__builtin_fmaxf(p0[0], p0[1]), p1[0]), mb = __builtin_fmaxf(__builtin_fmaxf(p0[2], p0[3]), p1[1]); ma = __builtin_fmaxf(__builtin_fmaxf(ma, p1[2]), p1[3]);
#pragma unroll
        for (int r = 4; r < 16; r += 4) { ma = __builtin_fmaxf(__builtin_fmaxf(ma, p0[r]), p0[r + 1]); mb = __builtin_fmaxf(__builtin_fmaxf(mb, p0[r + 2]), p0[r + 3]); ma = __builtin_fmaxf(__builtin_fmaxf(ma, p1[r]), p1[r + 1]); mb = __builtin_fmaxf(__builtin_fmaxf(mb, p1[r + 2]), p1[r + 3]); }
        float mt = __builtin_fmaxf(ma, mb);
        { auto rr = __builtin_amdgcn_permlane32_swap(__float_as_uint(mt), __float_as_uint(mt), false, false); mt = __builtin_fmaxf(__uint_as_float(rr[0]), __uint_as_float(rr[1])); }
        const bool first = (t == t_lo);
        if (first || __any(mt > ATT_THR)) {
            const float dl = first ? mt : __builtin_fmaxf(mt, 0.f); m_run += dl; const float alpha = __builtin_amdgcn_exp2f(-dl); l_run *= alpha;
#pragma unroll
            for (int r = 0; r < 16; ++r) { p0[r] -= dl; p1[r] -= dl; o0[r] *= alpha; o1[r] *= alpha; }
        }
        float ps0 = 0.f, ps1 = 0.f;
#pragma unroll
        for (int r = 0; r < 16; ++r) { p0[r] = __builtin_amdgcn_exp2f(p0[r]); p1[r] = __builtin_amdgcn_exp2f(p1[r]); ps0 += p0[r]; ps1 += p1[r]; }
        l_run += ps0 + ps1;
        v4u pw[4];
#pragma unroll
        for (int q = 0; q < 4; ++q) { pw[0][q] = cvt_pk_bf16(p0[2 * q], p0[2 * q + 1]); pw[1][q] = cvt_pk_bf16(p0[8 + 2 * q], p0[8 + 2 * q + 1]); pw[2][q] = cvt_pk_bf16(p1[2 * q], p1[2 * q + 1]); pw[3][q] = cvt_pk_bf16(p1[8 + 2 * q], p1[8 + 2 * q + 1]); }
#pragma unroll
        for (int s4 = 0; s4 < 4; ++s4) { const bf16x8v pa = __builtin_bit_cast(bf16x8v, pw[s4]);
            o0 = __builtin_amdgcn_mfma_f32_32x32x16_bf16(vf[2 * s4], pa, o0, 0, 0, 0); o1 = __builtin_amdgcn_mfma_f32_32x32x16_bf16(vf[2 * s4 + 1], pa, o1, 0, 0, 0); }
    }
    { auto rr = __builtin_amdgcn_permlane32_swap(__float_as_uint(l_run), __float_as_uint(l_run), false, false); l_run = __uint_as_float(rr[0]) + __uint_as_float(rr[1]); }
    const float rl = 1.0f / l_run;
    bf16* orow = MIX + (size_t)qrow * DM + h * VD;
#pragma unroll
    for (int g = 0; g < 4; ++g) { v2u a, c2; a.x = pk2(o0[4 * g] * rl, o0[4 * g + 1] * rl); a.y = pk2(o0[4 * g + 2] * rl, o0[4 * g + 3] * rl); c2.x = pk2(o1[4 * g] * rl, o1[4 * g + 1] * rl); c2.y = pk2(o1[4 * g + 2] * rl, o1[4 * g + 3] * rl);
        *(v2u*)(orow + 8 * g + 4 * hi) = a; *(v2u*)(orow + 32 + 8 * g + 4 * hi) = c2; }
    asm volatile("s_waitcnt vmcnt(0) lgkmcnt(0)" ::: "memory"); __builtin_amdgcn_s_barrier(); asm volatile("" ::: "memory");
#undef ATT_DMA
}
__device__ __forceinline__ void attn_phase(Frame& F, bool ctx_out) {
    fresh(F);
    const int nlat = NB * NH * 8, nctx = ctx_out ? NB * NH : 0;
    const int per = (nlat + F.G - 1) / F.G;
    for (int i = 0; i < per; ++i) { const int it = F.vcu * per + i; if (it >= nlat) break; const int bh = it >> 3, qb = it & 7; attn_unit(F, bh >> 3, bh & 7, (bh >> 3) * SEQ + qb * 256, true, 0, NKEY / 64); }
    for (int it = F.vcu; it < nctx; it += F.G) attn_unit(F, it >> 3, it & 7, M + (it >> 3) * CTXL, false, SEQ / 64, NKEY / 64);
    __syncthreads();
}

__device__ __forceinline__ int hgrn_row(int b, int dir, int ig) { return (ig < CTXL) ? (M + b * CTXL + (dir ? CTXL - 1 - ig : ig)) : (b * SEQ + (dir ? SEQ - 1 - (ig - CTXL) : (ig - CTXL))); }
__device__ __forceinline__ void hgrn_phase(Frame& F, int j) {
    fresh(F);
    unsigned char* ws = F.ws;
    const bf16* HQ = (const bf16*)(ws + WS_HQ); const bf16* HFF = HQ + HSEG; const bf16* HFB = HQ + 2 * HSEG; const bf16* HI = HQ + 3 * HSEG;
    float* OF = (float*)(ws + WS_OF); float* OB = (float*)(ws + WS_OB);
    LAS unsigned char* ring = F.lds + RING_OFF;
    LAS unsigned char* QN = ring; LAS unsigned char* KN = ring + 17408; LAS unsigned char* KT = ring + 34816; LAS unsigned char* VT = ring + 53248; LAS unsigned char* ST = ring + 62464;
    LAS float* TOT = (LAS float*)(ring + 79872);
    LAS unsigned char* RQ = ring + 81920; LAS unsigned char* RF = ring + 98304; LAS unsigned char* RV = ring + 114688;
    const int tid = F.tid, lane = F.lane, wave = F.wave, r32 = lane & 31, hi = lane >> 5;
    const int k = tid & 127, part = tid >> 7;
    const int kb = wave >> 1, vb = wave & 1;
    for (int it = blockIdx.x; it < NB * NHH * 2 * 2; it += F.G) {
        const int vh = it & 1, dir = (it >> 1) & 1, hh = (it >> 2) & 3, b = it >> 4;
        const bf16* HF = dir ? HFB : HFF; float* OO = dir ? OB : OF;
        float lb = 0.f; if (j == 1) { const int ci = dir * HW + hh * HK + k; const float l0 = F.in[13][ci], l1 = F.in[13][2 * HW + ci]; lb = 1.0f / (1.0f + __expf(l0 - l1)); }
        const float oml = 1.0f - lb;
        f32x16 S;
#pragma unroll
        for (int r = 0; r < 16; ++r) S[r] = 0.f;
#define LBAR() do { asm volatile("s_waitcnt lgkmcnt(0)" ::: "memory"); __builtin_amdgcn_s_barrier(); asm volatile("" ::: "memory"); } while (0)
#define HG_BASE(c_) ((c_) < CTXL / 64 ? M + b * CTXL + (dir ? CTXL - 64 - 64 * (c_) : 64 * (c_)) : b * SEQ + (dir ? SEQ - 64 - 64 * ((c_) - CTXL / 64) : 64 * ((c_) - CTXL / 64)))
#define HG_DMA(c_) do { const int rb_ = HG_BASE(c_); \
            _Pragma("unroll") for (int p_ = 0; p_ < 2; ++p_) { const int pc_ = wave * 2 + p_; const size_t go_ = (size_t)(rb_ + 4 * pc_ + (lane >> 4)) * HW + hh * HK + 8 * (lane & 15); \
                __builtin_amdgcn_global_load_lds((const unsigned*)(HQ + go_), (LAS unsigned*)(RQ + pc_ * 1024), 16, 0, 0); __builtin_amdgcn_global_load_lds((const unsigned*)(HF + go_), (LAS unsigned*)(RF + pc_ * 1024), 16, 0, 0); } \
            __builtin_amdgcn_global_load_lds((const unsigned*)(HI + (size_t)(rb_ + 8 * wave + (lane >> 3)) * HW + hh * HK + vh * 64 + 8 * (lane & 7)), (LAS unsigned*)(RV + wave * 1024), 16, 0, 0); } while (0)
        HG_DMA(0);
        asm volatile("s_waitcnt vmcnt(0)" ::: "memory"); LBAR();
        for (int ch = 0; ch < NKEY / 64; ++ch) {
            float qv[16], kin[16], cs[16]; float run = 0.f;
#pragma unroll
            for (int ii = 0; ii < 16; ++ii) { const int i = 16 * part + ii, mr = dir ? 63 - i : i; const float hq = bf2f(*(const LAS bf16*)(RQ + mr * 256 + k * 2)), hf = bf2f(*(const LAS bf16*)(RF + mr * 256 + k * 2));
                qv[ii] = hq * __builtin_amdgcn_rcpf(1.0f + __expf(-hq)); const float e = __expf(-hf), sg = __builtin_amdgcn_rcpf(1.0f + e); kin[ii] = oml * e * sg; run += __logf(lb + oml * sg); cs[ii] = run; }
            TOT[part * 128 + k] = run;
            { const int mr = dir ? 63 - lane : lane; const v4u w = *(const LAS v4u*)(RV + mr * 128 + wave * 16); const int pos = (lane & ~12) | ((lane & 4) << 1) | ((lane & 8) >> 1); LAS bf16* vt = (LAS bf16*)(VT + (8 * wave) * 144 + pos * 2);
              vt[0 * 72] = (bf16)(w.x & 0xffffu); vt[1 * 72] = (bf16)(w.x >> 16); vt[2 * 72] = (bf16)(w.y & 0xffffu); vt[3 * 72] = (bf16)(w.y >> 16);
              vt[4 * 72] = (bf16)(w.z & 0xffffu); vt[5 * 72] = (bf16)(w.z >> 16); vt[6 * 72] = (bf16)(w.w & 0xffffu); vt[7 * 72] = (bf16)(w.w >> 16); }
            LBAR();
            if (ch + 1 < NKEY / 64) HG_DMA(ch + 1);
            { const float t0 = TOT[k], t1 = TOT[128 + k], t2 = TOT[256 + k];
              const float base = (part > 0 ? t0 : 0.f) + (part > 1 ? t1 : 0.f) + (part > 2 ? t2 : 0.f); const float rr = t0 + t1;
              unsigned kt[8];
#pragma unroll
              for (int ii = 0; ii < 16; ii += 2) { float d0 = base + cs[ii] - rr, d1 = base + cs[ii + 1] - rr; d0 = fminf(fmaxf(d0, -80.f), 80.f); d1 = fminf(fmaxf(d1, -80.f), 80.f);
                  const float e0 = __expf(d0), e1 = __expf(d1); const float q0 = qv[ii] * e0, q1 = qv[ii + 1] * e1, k0 = kin[ii] * __builtin_amdgcn_rcpf(e0), k1 = kin[ii + 1] * __builtin_amdgcn_rcpf(e1);
                  const unsigned qp = cvt_pk_bf16(q0, q1), kp = cvt_pk_bf16(k0, k1);
                  *(LAS bf16*)(QN + (16 * part + ii) * 272 + k * 2) = (bf16)(qp & 0xffffu); *(LAS bf16*)(QN + (16 * part + ii + 1) * 272 + k * 2) = (bf16)(qp >> 16);
                  *(LAS bf16*)(KN + (16 * part + ii) * 272 + k * 2) = (bf16)(kp & 0xffffu); *(LAS bf16*)(KN + (16 * part + ii + 1) * 272 + k * 2) = (bf16)(kp >> 16);
                  kt[ii >> 1] = kp; }
              *(LAS v4u*)(KT + k * 144 + part * 32) = (v4u){kt[0], kt[1], kt[4], kt[5]}; *(LAS v4u*)(KT + k * 144 + part * 32 + 16) = (v4u){kt[2], kt[3], kt[6], kt[7]}; }
            f32x16 T;
#pragma unroll
            for (int g4 = 0; g4 < 4; ++g4) { const int kk = kb * 32 + 8 * g4 + 4 * hi; const f32x4 ta = *(const LAS f32x4*)(TOT + kk), tb = *(const LAS f32x4*)(TOT + 128 + kk);
                T[4 * g4] = S[4 * g4] * __expf(ta.x + tb.x); T[4 * g4 + 1] = S[4 * g4 + 1] * __expf(ta.y + tb.y); T[4 * g4 + 2] = S[4 * g4 + 2] * __expf(ta.z + tb.z); T[4 * g4 + 3] = S[4 * g4 + 3] * __expf(ta.w + tb.w);
                v2u o; o.x = cvt_pk_bf16(T[4 * g4], T[4 * g4 + 1]); o.y = cvt_pk_bf16(T[4 * g4 + 2], T[4 * g4 + 3]); *(LAS v2u*)(ST + (vb * 32 + r32) * 272 + kk * 2) = o; }
            LBAR();
            if (wave < 4) {
                const int ib = kb;
                bf16x8v qf[8];
#pragma unroll
                for (int ks = 0; ks < 8; ++ks) qf[ks] = *(const LAS bf16x8v*)(QN + (ib * 32 + r32) * 272 + ks * 32 + hi * 16);
                f32x16 O;
#pragma unroll
                for (int r = 0; r < 16; ++r) O[r] = 0.f;
#pragma unroll
                for (int ks = 0; ks < 8; ++ks) { const bf16x8v sf = *(const LAS bf16x8v*)(ST + (vb * 32 + r32) * 272 + ks * 32 + hi * 16); O = __builtin_amdgcn_mfma_f32_32x32x16_bf16(qf[ks], sf, O, 0, 0, 0); }
                for (int sb = 0; sb <= ib; ++sb) {
                    f32x16 X;
#pragma unroll
                    for (int r = 0; r < 16; ++r) X[r] = 0.f;
#pragma unroll
                    for (int ks = 0; ks < 8; ++ks) { const bf16x8v kf = *(const LAS bf16x8v*)(KN + (sb * 32 + r32) * 272 + ks * 32 + hi * 16); X = __builtin_amdgcn_mfma_f32_32x32x16_bf16(kf, qf[ks], X, 0, 0, 0); }
                    if (sb == ib) {
#pragma unroll
                        for (int r = 0; r < 16; ++r) { const int srow = (r & 3) + 8 * (r >> 2) + 4 * hi; if (srow > r32) X[r] = 0.f; }
                    }
#pragma unroll
                    for (int st = 0; st < 2; ++st) { v4u pw;
#pragma unroll
                        for (int q = 0; q < 4; ++q) pw[q] = cvt_pk_bf16(X[8 * st + 2 * q], X[8 * st + 2 * q + 1]);
                        const bf16x8v vf = *(const LAS bf16x8v*)(VT + (vb * 32 + r32) * 144 + (sb * 32 + st * 16) * 2 + hi * 16);
                        O = __builtin_amdgcn_mfma_f32_32x32x16_bf16(__builtin_bit_cast(bf16x8v, pw), vf, O, 0, 0, 0); }
                }
#pragma unroll
                for (int r = 0; r < 16; ++r) { const int i = ib * 32 + (r & 3) + 8 * (r >> 2) + 4 * hi; const int row = hgrn_row(b, dir, ch * 64 + i); OO[(size_t)row * HW + hh * HK + vh * 64 + vb * 32 + r32] = O[r]; }
            }
#pragma unroll
            for (int st = 0; st < 4; ++st) { const bf16x8v kf = *(const LAS bf16x8v*)(KT + (kb * 32 + r32) * 144 + st * 32 + hi * 16), vf = *(const LAS bf16x8v*)(VT + (vb * 32 + r32) * 144 + st * 32 + hi * 16);
                T = __builtin_amdgcn_mfma_f32_32x32x16_bf16(kf, vf, T, 0, 0, 0); }
#pragma unroll
            for (int g4 = 0; g4 < 4; ++g4) { const int kk = kb * 32 + 8 * g4 + 4 * hi; const f32x4 ta = *(const LAS f32x4*)(TOT + 256 + kk), tb = *(const LAS f32x4*)(TOT + 384 + kk);
                S[4 * g4] = T[4 * g4] * __expf(ta.x + tb.x); S[4 * g4 + 1] = T[4 * g4 + 1] * __expf(ta.y + tb.y); S[4 * g4 + 2] = T[4 * g4 + 2] * __expf(ta.z + tb.z); S[4 * g4 + 3] = T[4 * g4 + 3] * __expf(ta.w + tb.w); }
            asm volatile("s_waitcnt vmcnt(0)" ::: "memory"); LBAR();
        }
#undef LBAR
#undef HG_DMA
#undef HG_BASE
    }
    __syncthreads();
}

__device__ __forceinline__ void e8_phase(Frame& F, int j, int nrows) {
    fresh(F);
    unsigned char* ws = F.ws;
    const float* OF = (const float*)(ws + WS_OF); const float* OB = (const float*)(ws + WS_OB); const bf16* HG = (const bf16*)(ws + WS_HQ) + 4 * HSEG; bf16* MIX = (bf16*)(ws + WS_MIX);
    const float* gn = F.in[14] + j * HK;
    const int rpw = (nrows + F.G - 1) / F.G;
    for (int i = F.wave; i < rpw; i += NWAVES) {
        const int row = (int)blockIdx.x * rpw + i; if (row >= nrows) break;
        const int col = 8 * F.lane;
        const f32x4 a0 = *(const f32x4*)(OF + (size_t)row * HW + col), a1 = *(const f32x4*)(OF + (size_t)row * HW + col + 4), b0 = *(const f32x4*)(OB + (size_t)row * HW + col), b1 = *(const f32x4*)(OB + (size_t)row * HW + col + 4);
        f32x4 x0 = a0 + b0, x1 = a1 + b1;
        float s = (x0.x * x0.x + x0.y * x0.y) + (x0.z * x0.z + x0.w * x0.w) + (x1.x * x1.x + x1.y * x1.y) + (x1.z * x1.z + x1.w * x1.w);
        s += shx(s, F.lane, 1); s += shx(s, F.lane, 2); s += shx(s, F.lane, 4); s += shx(s, F.lane, 8);
        const float rstd = rsqrtf(s * (1.0f / HK) + EPS);
        const int vv = col & 127; const f32x4 g0 = *(const f32x4*)(gn + vv), g1 = *(const f32x4*)(gn + vv + 4);
        const v4u hg = *(const v4u*)(HG + (size_t)row * HW + col);
        x0 = x0 * rstd * g0; x1 = x1 * rstd * g1;
        v4u o; o.x = pk2(x0.x * siluf_(bflo(hg.x)), x0.y * siluf_(bfhi(hg.x))); o.y = pk2(x0.z * siluf_(bflo(hg.y)), x0.w * siluf_(bfhi(hg.y)));
        o.z = pk2(x1.x * siluf_(bflo(hg.z)), x1.y * siluf_(bfhi(hg.z))); o.w = pk2(x1.z * siluf_(bflo(hg.w)), x1.w * siluf_(bfhi(hg.w)));
        *(v4u*)(MIX + (size_t)row * DM + HW + col) = o;
    }
}

__device__ __forceinline__ void o12_phase(Frame& F, int nrows, const float* hl, const float* hc, const float* gn, const float* modl) {
    fresh(F);
    bf16* P = (bf16*)(F.ws + WS_POOLED);
    LAS unsigned char* XN = F.lds + RING_OFF;
    const int rpw = (nrows + F.G - 1) / F.G, rbase = (int)blockIdx.x * rpw, rend = (rbase + rpw < nrows) ? rbase + rpw : nrows;
    for (int r0 = rbase; r0 < rend; r0 += 32) {
        for (int sl = F.wave; sl < 48; sl += NWAVES) {
            const int row = r0 - 8 + sl; if (row < 0 || row >= nrows) continue;
            const float* hr = (row < M) ? hl + (size_t)row * DM : hc + (size_t)(row - M) * DM;
            f32x4 v[4]; float s = 0.f;
#pragma unroll
            for (int j = 0; j < 4; ++j) { v[j] = *(const f32x4*)(hr + 4 * F.lane + 256 * j); s += (v[j].x * v[j].x + v[j].y * v[j].y) + (v[j].z * v[j].z + v[j].w * v[j].w); }
            const float rstd = rsqrtf(wave_sum(s, F.lane) * (1.0f / DM) + EPS);
#pragma unroll
            for (int j = 0; j < 4; ++j) { v2u o; o.x = pg8::cvt_pk_bf16(v[j].x * rstd, v[j].y * rstd); o.y = pg8::cvt_pk_bf16(v[j].z * rstd, v[j].w * rstd); *(LAS v2u*)(XN + sl * 2048 + (4 * F.lane + 256 * j) * 2) = o; }
        }
        __syncthreads();
#pragma unroll 1
        for (int q = 0; q < 4; ++q) {
            const int t = r0 + F.wave * 4 + q; if (t >= rend) break;
            const bool lat = t < M; const int T = lat ? SEQ : CTXL; const int tt = lat ? t % SEQ : (t - M) % CTXL; const int bidx = lat ? t / SEQ : NB;
            const int sc0 = t - r0 + 8;
            const float* scp = modl + bidx * NMOD + DM;
#pragma unroll
            for (int g = 0; g < 4; ++g) {
                const int hw = 1 << g, col = 256 * g + 4 * F.lane;
                float s0 = 0.f, s1 = 0.f, s2 = 0.f, s3 = 0.f; int cnt = 0;
#pragma unroll
                for (int d = -hw; d < hw; ++d) { const bool ok = (tt + d >= 0) && (tt + d < T); const v2u x = *(const LAS v2u*)(XN + (sc0 + d) * 2048 + col * 2);
                    s0 += ok ? bflo(x.x) : 0.f; s1 += ok ? bfhi(x.x) : 0.f; s2 += ok ? bflo(x.y) : 0.f; s3 += ok ? bfhi(x.y) : 0.f; cnt += ok ? 1 : 0; }
                const v2u xc = *(const LAS v2u*)(XN + sc0 * 2048 + col * 2); const float ic = 1.0f / (float)cnt;
                const f32x4 gv = *(const f32x4*)(gn + col), sv = *(const f32x4*)(scp + col);
                v2u o; o.x = pg8::cvt_pk_bf16(gv.x * (sv.x + 1.0f) * (s0 * ic - bflo(xc.x)), gv.y * (sv.y + 1.0f) * (s1 * ic - bfhi(xc.x)));
                o.y = pg8::cvt_pk_bf16(gv.z * (sv.z + 1.0f) * (s2 * ic - bflo(xc.y)), gv.w * (sv.w + 1.0f) * (s3 * ic - bfhi(xc.y)));
                *(v2u*)(P + ((size_t)g * MT + t) * 256 + 4 * F.lane) = o;
            }
        }
        __syncthreads();
    }
}

__device__ __forceinline__ void o5_phase(Frame& F, int nrows) {
    fresh(F);
    unsigned char* ws = F.ws;
    const int* CNT = (const int*)(ws + WS_CNT); int* TST = (int*)(ws + WS_TST); const int* EIDX = (const int*)(ws + WS_EIDX); int* POS = (int*)(ws + WS_POS);
    const bf16* U = (const bf16*)(ws + WS_U); bf16* VG = (bf16*)(ws + WS_VG);
    LAS int* lc = (LAS int*)(F.lds + RING_OFF);
    LAS int* lbase = lc + 512 * 8;
    LAS int* lpos = lbase + 32;
    const int rpw = (nrows + F.G - 1) / F.G;
    for (int e = F.tid; e < F.G * 8; e += 512) lc[e] = CNT[e];
    __syncthreads();
    {
        const int e = F.wave; int c4[4]; int sum = 0;
#pragma unroll
        for (int q = 0; q < 4; ++q) { const int w = 4 * F.lane + q; c4[q] = (w < F.G) ? lc[w * 8 + e] : 0; sum += c4[q]; }
        int incl = sum;
#pragma unroll
        for (int o = 1; o < 64; o <<= 1) { const int t = __builtin_amdgcn_ds_bpermute((F.lane >= o ? F.lane - o : F.lane) << 2, incl); if (F.lane >= o) incl += t; }
        const int total = __builtin_amdgcn_readlane(incl, 63); int excl = incl - sum;
        const int myq = (int)blockIdx.x & 3; int pre = excl;
#pragma unroll
        for (int q = 0; q < 3; ++q) if (q < myq) pre += c4[q];
        if (F.lane == ((int)blockIdx.x >> 2)) { lbase[e] = pre; lbase[8 + e] = total; }
    }
    __syncthreads();
    if (F.tid == 0) {
        int ts = 0;
        for (int e = 0; e < 8; ++e) { const int pre = lbase[e], tot = lbase[8 + e]; lbase[e] = ts * 256 + pre; if (blockIdx.x == 0) TST[e] = ts; ts += (tot + 255) >> 8; }
        if (blockIdx.x == 0) TST[8] = ts;
    }
    __syncthreads();
    if (F.wave == 0) {
        int run[8];
#pragma unroll
        for (int e = 0; e < 8; ++e) run[e] = lbase[e];
        const int npairs = 2 * rpw;
        for (int c0 = 0; c0 < npairs; c0 += 64) {
            const int pl = c0 + F.lane; const int row = (int)blockIdx.x * rpw + (pl >> 1); const bool ok = pl < npairs && row < nrows;
            const int e = ok ? EIDX[2 * row + (pl & 1)] : -1; int mypos = 0;
#pragma unroll
            for (int x = 0; x < 8; ++x) { const unsigned long long mk = __ballot(e == x); const int below = __popcll(mk & ((1ull << F.lane) - 1ull)); if (e == x) mypos = run[x] + below; run[x] += __popcll(mk); }
            if (ok) { lpos[pl] = mypos; POS[2 * row + (pl & 1)] = mypos; }
        }
    }
    __syncthreads();
    for (int pl = F.wave; pl < 2 * rpw; pl += NWAVES) {
        const int row = (int)blockIdx.x * rpw + (pl >> 1); if (row >= nrows) break;
        const int p = lpos[pl];
        const v4u a = *(const v4u*)(U + (size_t)row * DM + 8 * F.lane), b = *(const v4u*)(U + (size_t)row * DM + 512 + 8 * F.lane);
        *(v4u*)(VG + (size_t)p * DM + 8 * F.lane) = a; *(v4u*)(VG + (size_t)p * DM + 512 + 8 * F.lane) = b;
    }
    __syncthreads();
}

__global__ void __launch_bounds__(NWAVES * 64, 2) mega_fwd(Args args) {
    extern __shared__ __attribute__((aligned(16))) unsigned char lds[];
    Frame F;
    F.lds = (LAS unsigned char*)lds;
    F.wave = __builtin_amdgcn_readfirstlane((int)threadIdx.x >> 6); fresh(F);
    F.G = gridDim.x; { const int bx = blockIdx.x; F.vcu = (F.G % 8 == 0) ? (bx % 8) * (F.G / 8) + bx / 8 : bx; }
    F.in = args.in; F.out = args.out; F.ws = args.ws;
    unsigned char* ws = args.ws;
    volatile LAS unsigned* MISC = (volatile LAS unsigned*)(F.lds + MISC_OFF);
    for (int u = F.tid; u < (LDS_BYTES - LDSCTL_OFF) / 4; u += NWAVES * 64) ((LAS unsigned*)(F.lds + LDSCTL_OFF))[u] = 0u;
    __syncthreads();
    XcdBarrier bar = xcd_barrier_post((unsigned*)(ws + WS_CTL) + CW_BAR, MISC + 8, F.wave);
#define GRID_BAR() do { xcd_barrier(bar); if (DUPMASK & 4096) xcd_barrier(bar); } while (0)
#ifndef ONLY
#define ONLY 0
#endif
#define PH(n) (ONLY == 0 || ONLY == (n))
#define REP(bit) for (int rep_ = 0; rep_ < ((DUPMASK & (bit)) ? 2 : 1); ++rep_)
    LAS unsigned char* ring = F.lds + RING_OFF;
    const float* MODV = (const float*)(ws + WS_MODV);
    float* HC = (float*)(ws + WS_HC);
    bf16* U = (bf16*)(ws + WS_U);

#if PH(20)
    REP(8192) p0_prologue(F);
#endif
    GRID_BAR();

    for (int lp = 0; lp < 2; ++lp) {
        const int le = 2 * lp, lo = 2 * lp + 1, j = lp;
        const bool ctx_out = (lp == 0);
        const int nro = ctx_out ? MT : M;
        const float* modE = MODV + (size_t)le * 17 * NMOD; const float* modO = MODV + (size_t)lo * 17 * NMOD;
        const float* hin_l = (lp == 0) ? args.in[0] : args.out; const float* hin_c = (lp == 0) ? args.in[2] : HC;
#if PH(1)
        {
            RowArgs A{}; A.hin_l = hin_l; A.hin_c = hin_c; A.hout_l = args.out; A.hout_c = HC; A.g = args.in[6] + (size_t)(le * 2 + 0) * DM; A.modl = modE; A.shoff = 0; A.scoff = DM; A.U = U;
            A.Y = (const bf16*)(ws + WS_VG); A.pos = (const int*)(ws + WS_POS); A.gate = (const float*)(ws + WS_GATE); A.modprev = MODV + (size_t)(le - 1) * 17 * NMOD;
            if (lp == 0) row_phase<false, 1, false>(F, A, MT); else row_phase<true, 1, false>(F, A, MT);
        }
#endif
        GRID_BAR();
#if PH(2)
        {
            pg8::Gemm g{U, (const bf16*)(ws + WS_WIN) + (size_t)j * INP * DM, DM, DM, DM}; pg8::StaticOrder S; S.init(MT, INP, F.G, (int)blockIdx.x);
            EpiIn E{(bf16*)(ws + WS_CQ), (bf16*)(ws + WS_KR), (bf16*)(ws + WS_CKV), (bf16*)(ws + WS_HQ)};
            REP(8) pg8::gemm_phase<EpiIn, pg8::StaticOrder, true>(ring, g, S, E, F.wave);
        }
#endif
        GRID_BAR();
#if PH(3)
        REP(4 | 32) e3_phase(F);
#endif
        GRID_BAR();
#if PH(4)
        {
            pg8::Gemm g{(const bf16*)(ws + WS_CQ), (const bf16*)(ws + WS_WUQ) + (size_t)j * 768 * QL, QL, QL, QL}; pg8::StaticOrder S; S.init(nro, 768, F.G, (int)blockIdx.x);
            EpiQ E{(bf16*)(ws + WS_QB), (const float*)(ws + WS_RSQ)};
            REP(8) pg8::gemm_phase<EpiQ, pg8::StaticOrder, true>(ring, g, S, E, F.wave);
        }
        {
            pg8::Gemm g{(const bf16*)(ws + WS_CKV), (const bf16*)(ws + WS_WUKV) + (size_t)j * 1024 * KVL, KVL, KVL, KVL}; pg8::StaticOrder S; S.init(MT, 1024, F.G, (int)blockIdx.x);
            EpiKV E{(bf16*)(ws + WS_KN), (bf16*)(ws + WS_VV), (const float*)(ws + WS_RSKV)};
            REP(8) pg8::gemm_phase<EpiKV, pg8::StaticOrder, true>(ring, g, S, E, F.wave);
        }
#endif
        GRID_BAR();
#if PH(6)
#ifndef NO_HGRN
        REP(1) hgrn_phase(F, j);
#endif
#ifndef NO_ATTN
        REP(2) attn_phase(F, ctx_out);
#endif
#endif
        GRID_BAR();
#if PH(8)
        REP(4 | 64) e8_phase(F, j, nro);
#endif
        GRID_BAR();
#if PH(9)
        {
            pg8::Gemm g{(const bf16*)(ws + WS_MIX), (const bf16*)(ws + WS_WOUT) + (size_t)j * DM * DM, DM, DM, DM}; pg8::StaticOrder S; S.init(nro, DM, F.G, (int)blockIdx.x);
            EpiResid E{hin_l, hin_c, args.out, HC, modE, 2 * DM};
            pg8::gemm_phase<EpiResid, pg8::StaticOrder, true>(ring, g, S, E, F.wave);
        }
#endif
        GRID_BAR();
#if PH(10)
        {
            RowArgs A{}; A.hin_l = args.out; A.hin_c = HC; A.g = args.in[6] + (size_t)(le * 2 + 1) * DM; A.modl = modE; A.shoff = 3 * DM; A.scoff = 4 * DM; A.U = U;
            REP(4 | 128) row_phase<false, 1, false>(F, A, nro);
        }
#endif
        GRID_BAR();
#if PH(11)
        {
            pg8::Gemm g{U, (const bf16*)(ws + WS_WGU) + (size_t)j * 2 * DFF * DM, DM, DM, DM}; pg8::StaticOrder S; S.init(nro, 2 * DFF, F.G, (int)blockIdx.x);
            EpiGateUp E{(bf16*)(ws + WS_HID), DFF, 2 * DFF / 256, 0};
            REP(8) pg8::gemm_phase<EpiGateUp, pg8::StaticOrder, true>(ring, g, S, E, F.wave);
        }
#endif
        GRID_BAR();
#if PH(12)
        {
            pg8::Gemm g{(const bf16*)(ws + WS_HID), (const bf16*)(ws + WS_WDN) + (size_t)j * DM * DFF, DFF, DFF, DFF}; pg8::StaticOrder S; S.init(nro, DM, F.G, (int)blockIdx.x);
            EpiResid E{args.out, HC, args.out, HC, modE, 5 * DM};
            pg8::gemm_phase<EpiResid, pg8::StaticOrder, true>(ring, g, S, E, F.wave);
        }
#endif
        GRID_BAR();
#if PH(13)
        {
            RowArgs A{}; A.hin_l = args.out; A.hin_c = HC; A.g = args.in[6] + (size_t)(lo * 2 + 0) * DM; A.modl = modO; A.shoff = 0; A.scoff = DM; A.U = U;
            REP(2048) o12_phase(F, nro, args.out, HC, A.g, modO);
            REP(16) for (int e = 0; e < NE; ++e) {
                conv_matrix(F, args.in[23] + ((size_t)j * NE + e) * DM * DFE, DM, DFE, (bf16*)(ws + WS_MWGU) + (size_t)e * 2 * DFE * DM, DM, 2, 0, nullptr, 1.f);
                conv_matrix(F, args.in[24] + ((size_t)j * NE + e) * DM * DFE, DM, DFE, (bf16*)(ws + WS_MWGU) + (size_t)e * 2 * DFE * DM, DM, 2, 128, nullptr, 1.f);
                conv_matrix(F, args.in[25] + ((size_t)j * NE + e) * DFE * DM, DFE, DM, (bf16*)(ws + WS_MWDN) + (size_t)e * DM * DFE, DFE, 0, 0, nullptr, 1.f);
            }
        }
#endif
        GRID_BAR();
#if PH(15)
        {
            pg8::Gemm g{(const bf16*)(ws + WS_POOLED), (const bf16*)(ws + WS_WPOOL) + (size_t)j * 4 * 65536, 256, 256, 256};
            pg8::PoolOrder S{nro / 256, MT / 256, F.G, (int)blockIdx.x};
            EpiPool E{args.out, HC, modO, args.in[20] + (size_t)j * DM, args.in[21] + (size_t)j * DM, MT / 256};
            pg8::gemm_phase<EpiPool, pg8::PoolOrder, true>(ring, g, S, E, F.wave);
        }
#endif
        GRID_BAR();
#if PH(16)
        {
            RowArgs A{}; A.hin_l = args.out; A.hin_c = HC; A.g = args.in[6] + (size_t)(lo * 2 + 1) * DM; A.modl = modO; A.shoff = 3 * DM; A.scoff = 4 * DM; A.U = U;
            A.router = args.in[22] + (size_t)j * DM * NE; A.eidx = (int*)(ws + WS_EIDX); A.gout = (float*)(ws + WS_GATE); A.cnt = (int*)(ws + WS_CNT);
            REP(4 | 512) row_phase<false, 1, true>(F, A, nro);
        }
#endif
        GRID_BAR();
#if PH(17)
        REP(4 | 1024) o5_phase(F, nro);
#endif
        GRID_BAR();
#if PH(18)
        {
            const int* TST = (const int*)(ws + WS_TST);
            const int ts1 = TST[1], ts2 = TST[2], ts3 = TST[3], ts4 = TST[4], ts5 = TST[5], ts6 = TST[6], ts7 = TST[7], nT = TST[8];
            for (int c = 0; c * MOE_CH < nT; ++c) {
                const int t0 = c * MOE_CH, nrt = (nT - t0) < MOE_CH ? (nT - t0) : MOE_CH;
                {
                    pg8::Gemm g{(const bf16*)(ws + WS_VG), (const bf16*)(ws + WS_MWGU), DM, DM, DM};
                    pg8::MoeOrder S{t0, nrt, 2 * DFE / 256, F.G, (int)blockIdx.x, ts1, ts2, ts3, ts4, ts5, ts6, ts7};
                    EpiGateUp E{(bf16*)(ws + WS_HIDM), DFE, 2 * DFE / 256, t0 * 256};
                    REP(8) pg8::gemm_phase<EpiGateUp, pg8::MoeOrder, true>(ring, g, S, E, F.wave);
                }
                GRID_BAR();
                {
                    pg8::Gemm g{(const bf16*)(ws + WS_HIDM) - (size_t)t0 * 256 * DFE, (const bf16*)(ws + WS_MWDN), DFE, DFE, DFE};
                    pg8::MoeOrder S{t0, nrt, DM / 256, F.G, (int)blockIdx.x, ts1, ts2, ts3, ts4, ts5, ts6, ts7};
                    EpiY E{(bf16*)(ws + WS_VG), DM / 256};
                    REP(8) pg8::gemm_phase<EpiY, pg8::MoeOrder, true>(ring, g, S, E, F.wave);
                }
                GRID_BAR();
            }
        }
#endif
    }
#if PH(19)
    {
        RowArgs A{}; A.hin_l = args.out; A.hin_c = HC; A.hout_l = args.out; A.hout_c = HC; A.g = args.in[7];
        A.Y = (const bf16*)(ws + WS_VG); A.pos = (const int*)(ws + WS_POS); A.gate = (const float*)(ws + WS_GATE); A.modprev = MODV + (size_t)3 * 17 * NMOD;
        row_phase<true, 2, false>(F, A, M);
        if (xb_ld((unsigned*)(ws + WS_CTL) + CW_BAR + XB_TMO) != 0u) { __syncthreads(); const float qn = __builtin_nanf(""); for (int i = F.tid; i < 1024; i += 512) args.out[(size_t)blockIdx.x * 1024 + i] = qn; }
    }
#endif
}

extern "C" void kernel_launch(void* const* d_in, const int* in_sizes, int n_in, void* d_out, int out_size, void* d_ws, size_t ws_size, hipStream_t stream) {
    static int grid = 0;
    if (grid == 0) {
        if (n_in != 26 || out_size != M * DM || ws_size < WS_END) { fprintf(stderr, "kernel_launch: unexpected shapes (n_in %d out %d ws %zu)\n", n_in, out_size, ws_size); grid = -1; return; }
        int dev = 0, cus = 0, per_cu = 0;
        if (hipGetDevice(&dev) != hipSuccess || hipDeviceGetAttribute(&cus, hipDeviceAttributeMultiprocessorCount, dev) != hipSuccess) { grid = -1; return; }
        if (hipFuncSetAttribute((const void*)mega_fwd, hipFuncAttributeMaxDynamicSharedMemorySize, LDS_BYTES) != hipSuccess) { grid = -1; return; }
        if (hipOccupancyMaxActiveBlocksPerMultiprocessor(&per_cu, (const void*)mega_fwd, NWAVES * 64, LDS_BYTES) != hipSuccess || per_cu < 1) fprintf(stderr, "kernel_launch: occupancy query says %d\n", per_cu);
        (void)hipGetLastError();
        grid = cus > 256 ? 256 : cus;
    }
    if (grid < 0) return;
    if (hipMemsetAsync((char*)d_ws + WS_CTL, 0, CTL_ZERO_BYTES, stream) != hipSuccess) return;
    Args a{};
    for (int i = 0; i < 26; ++i) a.in[i] = (const float*)d_in[i];
    a.out = (float*)d_out; a.ws = (unsigned char*)d_ws;
    hipLaunchKernelGGL(mega_fwd, dim3(grid), dim3(NWAVES * 64), LDS_BYTES, stream, a);
}
```

```cpp
#include <hip/hip_runtime.h>
#ifndef DUPMASK
#define DUPMASK 0
#endif
#include <cstdio>
#include <cstdint>

__device__ __forceinline__ int lane_now() { int l; asm volatile("v_mbcnt_lo_u32_b32 %0, -1, 0\n\tv_mbcnt_hi_u32_b32 %0, -1, %0" : "=v"(l)); return l; }
namespace pg8 {
#define PG8_LAS __attribute__((address_space(3)))
typedef unsigned short bf16_t;
typedef short bf16x8 __attribute__((ext_vector_type(8)));
typedef float f32x4 __attribute__((ext_vector_type(4)));
typedef unsigned u32x4 __attribute__((ext_vector_type(4)));
constexpr int BM = 256, BK = 64, HALF = 128, HTB = HALF * BK * 2, STAGE_BYTES = 8 * HTB, NXCD = 8, WGM = 8;

__host__ __device__ __forceinline__ int lds_byte(int r, int c) { const int st = (r >> 4) * 2 + (c >> 5), rr = r & 15, cc = c & 31, ob = rr * 64 + cc * 2; return st * 1024 + (ob ^ (((ob >> 9) & 1) << 5)); }
__host__ __device__ __forceinline__ void stage_rc(int b, int& R, int& C) { const int st = b / 1024, sb = b % 1024, swz = sb ^ (((sb >> 9) & 1) << 5); R = (st >> 1) * 16 + swz / 64; C = (st & 1) * 32 + (swz % 64) / 2; }
__host__ __device__ __forceinline__ int perm32(int rho) { const int n = rho >> 4, i = rho & 15; return 8 * (i >> 2) + 4 * n + (i & 3); }

struct Unit { int pm, pn; };
struct Gemm { const bf16_t* A; const bf16_t* Bt; int lda, ldb, K; };

struct StaticOrder {
    int nM, nN, nwg, G, c;
    __device__ void init(int M, int N, int G_, int c_) { nM = M / BM; nN = N / BM; nwg = nM * nN; G = G_; c = c_; }
    __device__ bool next(int i, Unit& u) const {
        const long L = (long)i * G + c; if (L >= nwg) return false;
        int wgid = (int)L; { const int q = nwg / NXCD, r = nwg % NXCD, xcd = wgid % NXCD, off = wgid / NXCD; wgid = (xcd < r ? xcd * (q + 1) : r * (q + 1) + (xcd - r) * q) + off; }
        const int nig = WGM * nN, gid = wgid / nig, fm = gid * WGM, gsz = (nM - fm) < WGM ? (nM - fm) : WGM;
        u.pm = fm + ((wgid % nig) % gsz); u.pn = (wgid % nig) / gsz; return true;
    }
};
struct PoolOrder {
    int nrt, talloc, G, c;
    __device__ bool next(int i, Unit& u) const { const int L = i * G + c; if (L >= 4 * nrt) return false; const int g = L / nrt, rt = L - g * nrt; u.pm = g * talloc + rt; u.pn = g; return true; }
};
struct MoeOrder {
    int t0, nrt, nct, G, c; int ts1, ts2, ts3, ts4, ts5, ts6, ts7;
    __device__ bool next(int i, Unit& u) const {
        const int nwg = nrt * nct; const int L = i * G + c; if (L >= nwg) return false;
        int wgid = L; { const int q = nwg / NXCD, r = nwg % NXCD, xcd = wgid % NXCD, off = wgid / NXCD; wgid = (xcd < r ? xcd * (q + 1) : r * (q + 1) + (xcd - r) * q) + off; }
        const int nig = WGM * nct, gid = wgid / nig, fm = gid * WGM, gsz = (nrt - fm) < WGM ? (nrt - fm) : WGM;
        const int rt = t0 + fm + ((wgid % nig) % gsz), ct = (wgid % nig) / gsz;
        const int e = (rt >= ts1) + (rt >= ts2) + (rt >= ts3) + (rt >= ts4) + (rt >= ts5) + (rt >= ts6) + (rt >= ts7);
        u.pm = rt; u.pn = e * nct + ct; return true;
    }
};

__device__ __forceinline__ unsigned cvt_pk_bf16(float lo, float hi) { unsigned r; asm volatile("v_cvt_pk_bf16_f32 %0, %1, %2" : "=v"(r) : "v"(lo), "v"(hi)); return r; }

template <class Epi, class Sched, bool ALIGN_EPI>
__device__ __forceinline__ void gemm_phase(PG8_LAS unsigned char* lds, const Gemm g, const Sched& S, const Epi& E, const int wid) {
    const int lane_ = lane_now();
    const int lane = lane_, tid = wid * 64 + lane, wr = wid >> 2, wc = wid & 3, fr = lane & 15, fq = lane >> 4;
    int K_ = g.K; asm volatile("" : "+s"(K_));
    const int K = K_, nt = K / BK;
    unsigned voffA[2], voffB[2];
#pragma unroll
    for (int i = 0; i < 2; ++i) { int R, C; stage_rc(tid * 16 + i * 8192, R, C); const int Rb = Epi::PERM ? ((R & ~31) + perm32(R & 31)) : R;
        voffA[i] = (unsigned)(R * g.lda + C) * 2u; voffB[i] = (unsigned)(Rb * g.ldb + C) * 2u; }
    const size_t kstep = (size_t)(BK * 2);
    const size_t hstepA = (size_t)HALF * g.lda * 2, hstepB = (size_t)HALF * g.ldb * 2;
    const size_t tstepA = 2 * hstepA, tstepB = 2 * hstepB;
    const unsigned ldsw = (unsigned)wid * 1024u;
    const int aoff = lds_byte(wr * 64 + fr, fq * 8), boff = lds_byte(wc * 32 + fr, fq * 8);
#define PG8_SA(b, h) (((b) * 2 + (h)) * HTB)
#define PG8_SB(b, h) ((4 + (b) * 2 + (h)) * HTB)
#define PG8_STAGE(bufoff, gbase, voff) do { _Pragma("unroll") for (int _i = 0; _i < 2; ++_i) \
        __builtin_amdgcn_global_load_lds((const unsigned*)((const char*)(gbase) + (voff)[_i]), (PG8_LAS unsigned*)(lds + (bufoff) + ldsw + _i * 8192), 16, 0, 0); } while (0)
#define PG8_LDA(dst, b, h) do { _Pragma("unroll") for (int m = 0; m < 4; ++m) _Pragma("unroll") for (int k = 0; k < 2; ++k) dst[m][k] = *(const PG8_LAS bf16x8*)(lds + PG8_SA(b, h) + aoff + m * 2048 + k * 1024); } while (0)
#define PG8_LDB(dst, b, h) do { _Pragma("unroll") for (int n = 0; n < 2; ++n) _Pragma("unroll") for (int k = 0; k < 2; ++k) dst[n][k] = *(const PG8_LAS bf16x8*)(lds + PG8_SB(b, h) + boff + n * 2048 + k * 1024); } while (0)
#define PG8_MMA(ai, bj, At, Bt) do { __builtin_amdgcn_s_setprio(1); _Pragma("unroll") for (int m = 0; m < 4; ++m) _Pragma("unroll") for (int n = 0; n < 2; ++n) _Pragma("unroll") for (int k = 0; k < 2; ++k) \
        acc[ai][bj][m][n] = __builtin_amdgcn_mfma_f32_16x16x32_bf16(Bt[n][k], At[m][k], acc[ai][bj][m][n], 0, 0, 0); __builtin_amdgcn_s_setprio(0); } while (0)
#define PG8_WAIT_V(n) asm volatile("s_waitcnt vmcnt(" #n ")" ::: "memory")
#define PG8_WAIT_L(n) asm volatile("s_waitcnt lgkmcnt(" #n ")" ::: "memory")
#define PG8_BAR __builtin_amdgcn_s_barrier()
#define PG8_SCHED __builtin_amdgcn_sched_barrier(0)
    Unit cur, nxt; int ui = 0;
    if (!S.next(0, cur)) return;
    f32x4 acc[2][2][4][2];
#pragma unroll
    for (int a = 0; a < 2; ++a)
#pragma unroll
        for (int b = 0; b < 2; ++b)
#pragma unroll
            for (int m = 0; m < 4; ++m)
#pragma unroll
                for (int n = 0; n < 2; ++n) acc[a][b][m][n] = (f32x4){0.f, 0.f, 0.f, 0.f};
    bf16x8 At[4][2], B0[2][2], B1[2][2];
    const char* cA = (const char*)g.A + (size_t)cur.pm * tstepA; const char* cB = (const char*)g.Bt + (size_t)cur.pn * tstepB;
    PG8_STAGE(PG8_SB(0, 0), cB, voffB); PG8_STAGE(PG8_SB(0, 1), cB + hstepB, voffB); PG8_STAGE(PG8_SA(0, 0), cA, voffA); PG8_STAGE(PG8_SA(0, 1), cA + hstepA, voffA);
    if (wr == 1) PG8_BAR;
    PG8_WAIT_V(2); PG8_BAR;
    PG8_STAGE(PG8_SB(1, 0), cB + kstep, voffB); PG8_STAGE(PG8_SA(1, 0), cA + kstep, voffA); PG8_STAGE(PG8_SB(1, 1), cB + hstepB + kstep, voffB);
    PG8_WAIT_V(6); PG8_BAR;
    for (;;) {
        const bool has_next = S.next(ui + 1, nxt);
        const char* nA = has_next ? (const char*)g.A + (size_t)nxt.pm * tstepA : cA; const char* nB = has_next ? (const char*)g.Bt + (size_t)nxt.pn * tstepB : cB;
#pragma unroll 1
        for (int t = 0; t < nt; t += 2) {
            const bool last = (t == nt - 2);
            const char* a1 = cA + (size_t)(t + 1) * kstep;
            const char* a2 = last ? nA : cA + (size_t)(t + 2) * kstep; const char* b2 = last ? nB : cB + (size_t)(t + 2) * kstep;
            const char* a3 = a2 + kstep; const char* b3 = b2 + kstep;
            PG8_LDB(B0, 0, 0); PG8_LDB(B1, 0, 1); PG8_SCHED; PG8_LDA(At, 0, 0); PG8_STAGE(PG8_SA(1, 1), a1 + hstepA, voffA);
            PG8_WAIT_V(8); PG8_WAIT_L(0); PG8_BAR; PG8_MMA(0, 0, At, B0); PG8_MMA(0, 1, At, B1); PG8_BAR; PG8_SCHED;
            PG8_LDA(At, 0, 1); PG8_STAGE(PG8_SB(0, 0), b2, voffB); PG8_STAGE(PG8_SB(0, 1), b2 + hstepB, voffB); PG8_STAGE(PG8_SA(0, 0), a2, voffA);
            PG8_WAIT_V(8); PG8_WAIT_L(0); PG8_BAR; PG8_MMA(1, 0, At, B0); PG8_MMA(1, 1, At, B1); PG8_BAR; PG8_SCHED;
            PG8_LDB(B0, 1, 0); PG8_LDB(B1, 1, 1); PG8_SCHED; PG8_LDA(At, 1, 0); PG8_STAGE(PG8_SA(0, 1), a2 + hstepA, voffA);
            PG8_WAIT_V(8); PG8_WAIT_L(0); PG8_BAR; PG8_MMA(0, 0, At, B0); PG8_MMA(0, 1, At, B1); PG8_BAR; PG8_SCHED;
            PG8_LDA(At, 1, 1); PG8_STAGE(PG8_SB(1, 0), b3, voffB); PG8_STAGE(PG8_SB(1, 1), b3 + hstepB, voffB); PG8_STAGE(PG8_SA(1, 0), a3, voffA);
            PG8_WAIT_V(8); PG8_WAIT_L(0); PG8_BAR; PG8_MMA(1, 0, At, B0); PG8_MMA(1, 1, At, B1); PG8_BAR; PG8_SCHED;
        }
        if constexpr (ALIGN_EPI) { if (wr == 0) PG8_BAR; }
        E(acc, cur, wr, wc, fr, fq);
        if (!has_next) break;
#pragma unroll
        for (int a = 0; a < 2; ++a)
#pragma unroll
            for (int b = 0; b < 2; ++b)
#pragma unroll
                for (int m = 0; m < 4; ++m)
#pragma unroll
                    for (int n = 0; n < 2; ++n) acc[a][b][m][n] = (f32x4){0.f, 0.f, 0.f, 0.f};
        cur = nxt; cA = nA; cB = nB; ++ui;
        if constexpr (ALIGN_EPI) { if (wr == 1) PG8_BAR; }
    }
    PG8_WAIT_V(0);
    if constexpr (!ALIGN_EPI) { if (wr == 0) PG8_BAR; }
    PG8_BAR;
#undef PG8_SA
#undef PG8_SB
#undef PG8_STAGE
#undef PG8_LDA
#undef PG8_LDB
#undef PG8_MMA
#undef PG8_WAIT_V
#undef PG8_WAIT_L
#undef PG8_BAR
#undef PG8_SCHED
}
}

constexpr int NWAVES = 8;
constexpr int DM = 1024, NB = 16, SEQ = 2048, CTXL = 256;
constexpr int M = NB * SEQ, MC = NB * CTXL, MT = M + MC;
constexpr int QL = 384, KVL = 256, ROPE = 32, HW = 512, NH = 8, QKD = 96, VD = 64;
constexpr int INW = 3232, INP = 3328;
constexpr int DFF = 2816, NE = 8, DFE = 3584, NMOD = 6 * DM;
constexpr int NHH = 4, HK = 128; constexpr int NKEY = SEQ + CTXL;
constexpr float EPS = 1e-6f;
constexpr int MAXT = 296;
constexpr int MOE_CH = 128;

constexpr size_t MiB = 1u << 20;
constexpr size_t WS_CTL = 0, CTL_ZERO_BYTES = 1 * MiB;
constexpr size_t WS_MODV = 1 * MiB;
constexpr size_t WS_ROPE = 3 * MiB;
constexpr size_t WS_CNT = 3 * MiB + 64 * 1024;
constexpr size_t WS_TST = 3 * MiB + 128 * 1024;
constexpr size_t WS_EIDX = 4 * MiB, WS_GATE = 4 * MiB + 512 * 1024, WS_POS = 5 * MiB;
constexpr size_t WS_RSQ = 6 * MiB, WS_RSKV = 6 * MiB + 256 * 1024;
constexpr size_t WS_HC = 8 * MiB;
constexpr size_t WS_WIN = 24 * MiB, WS_WUQ = 37 * MiB, WS_WUKV = 39 * MiB, WS_WOUT = 40 * MiB, WS_WGU = 44 * MiB, WS_WDN = 66 * MiB, WS_WPOOL = 77 * MiB;
constexpr size_t WS_U = 80 * MiB;
constexpr size_t WS_X = 152 * MiB;
constexpr size_t WS_CQ = WS_X, WS_CKV = 179 * MiB, WS_KR = 197 * MiB, WS_KRR = 200 * MiB, WS_HQ = 203 * MiB  ;
constexpr size_t WS_QB = 383 * MiB, WS_KN = 437 * MiB, WS_VV = 473 * MiB, WS_OF = 509 * MiB, WS_OB = 581 * MiB, WS_MIX = 653 * MiB, WS_HID = WS_X;
constexpr size_t WS_MWGU = WS_X, WS_MWDN = 264 * MiB, WS_POOLED = 320 * MiB, WS_VG = 392 * MiB, WS_HIDM = 540 * MiB, WS_END = 800 * MiB;
constexpr size_t HSEG = (size_t)MT * HW;
static_assert(WS_HQ + 5 * HSEG * 2 <= WS_QB && WS_MIX + (size_t)MT * DM * 2 <= WS_END && WS_HID + (size_t)MT * DFF * 2 <= WS_QB, "ws map even");
static_assert(WS_HIDM + (size_t)MOE_CH * 256 * DFE * 2 <= WS_END && WS_VG + (size_t)MAXT * 256 * DM * 2 <= WS_HIDM && WS_MWDN + (size_t)NE * DM * DFE * 2 <= WS_POOLED && WS_MWGU + (size_t)NE * 2 * DFE * DM * 2 <= WS_MWDN, "ws map odd");
constexpr int CW_BAR = 4096;

constexpr int RING_OFF = 0, RING_BYTES = 141312;
constexpr int LDSCTL_OFF = RING_BYTES, MISC_OFF = LDSCTL_OFF + 320;
constexpr int LDS_BYTES = 147456;

#define GAS __attribute__((address_space(1)))
#define LAS __attribute__((address_space(3)))
typedef unsigned short bf16;
typedef unsigned v4u __attribute__((ext_vector_type(4)));
typedef unsigned v2u __attribute__((ext_vector_type(2)));
typedef float f32x4 __attribute__((ext_vector_type(4)));
typedef GAS unsigned gu32;
#define RLX_AGENT __ATOMIC_RELAXED, __HIP_MEMORY_SCOPE_AGENT
#define LDS_WAIT() asm volatile("s_waitcnt lgkmcnt(0)" ::: "memory")
__device__ __forceinline__ unsigned f2bf(float f) { unsigned u = __builtin_bit_cast(unsigned, f); return (u + 0x7fffu + ((u >> 16) & 1u)) >> 16; }
__device__ __forceinline__ unsigned pk2(float lo, float hi) { return f2bf(lo) | (f2bf(hi) << 16); }
__device__ __forceinline__ float bf2f(unsigned short b) { return __uint_as_float((unsigned)b << 16); }
__device__ __forceinline__ float bflo(unsigned w) { return __uint_as_float(w << 16); }
__device__ __forceinline__ float bfhi(unsigned w) { return __uint_as_float(w & 0xffff0000u); }
__device__ __forceinline__ float sigmoidf_(float x) { return 1.0f / (1.0f + __expf(-x)); }
__device__ __forceinline__ float siluf_(float x) { return x / (1.0f + __expf(-x)); }

#define XB_TMO      128
#define XB_XCNT(j)  (256  + 64 * (j))
#define XB_XSUB(j)  (1280 + 64 * (j))
#define XB_XGEN(j)  (2304 + 64 * (j))
#define XB_TOP      3328
#define XB_TOPGEN   3392
#define XCD_BAR_WORDS 3456
#define XB_SPIN_CAP (1u << 22)
__device__ __forceinline__ unsigned xb_ld(unsigned* p)              { return __hip_atomic_load(p, __ATOMIC_RELAXED, __HIP_MEMORY_SCOPE_AGENT); }
__device__ __forceinline__ unsigned xb_add(unsigned* p, unsigned v) { return __hip_atomic_fetch_add(p, v, __ATOMIC_RELAXED, __HIP_MEMORY_SCOPE_AGENT); }
__device__ __forceinline__ unsigned xb_xcc_id() { return (unsigned)__builtin_amdgcn_s_getreg((3 << 11) | 20) & 0xFu; }
#define XB_SPIN(cond, bar) do { unsigned _sp = 0; while (cond) { __builtin_amdgcn_s_sleep(1); \
    if ((++_sp & 255u) == 0u) { if (xb_ld(&(bar)[XB_TMO])) break; if (_sp > XB_SPIN_CAP) { atomicAdd(&(bar)[XB_TMO], 1u); break; } } } } while (0)
struct XcdBarrier { unsigned* bar; unsigned x; volatile LAS unsigned* st; int wave; };
__device__ __forceinline__ bool xb_leader(int wave) { return wave == 0 && lane_now() == 0; }
__device__ __forceinline__ XcdBarrier xcd_barrier_post(unsigned* bar, volatile LAS unsigned* st, int wave) {
    XcdBarrier b; b.bar = bar; b.x = xb_xcc_id(); b.st = st; b.wave = wave;
    if (xb_leader(wave)) (void)xb_add(&bar[XB_XCNT(b.x)], 1u);
    return b;
}
__device__ __forceinline__ void xcd_barrier_complete(unsigned* bar, unsigned x, unsigned& nloc, unsigned& nx) {
    const unsigned G = gridDim.x * gridDim.y * gridDim.z;
    unsigned sum, cnt, mine, sp = 0u;
    for (;;) {
        sum = 0u; cnt = 0u; mine = 0u;
#pragma unroll
        for (unsigned j = 0; j < 16; ++j) { const unsigned c = xb_ld(&bar[XB_XCNT(j)]); sum += c; cnt += (c > 0u) ? 1u : 0u; mine = (j == x) ? c : mine; }
        if (sum == G) break;
        __builtin_amdgcn_s_sleep(1);
        if ((++sp & 255u) == 0u) { if (xb_ld(&bar[XB_TMO])) break; if (sp > XB_SPIN_CAP) { atomicAdd(&bar[XB_TMO], 1u); break; } }
    }
    nloc = mine > 0u ? mine : 1u; nx = cnt > 0u ? cnt : 1u;
}
__device__ __forceinline__ void xcd_barrier(const XcdBarrier& b) {
    asm volatile("s_waitcnt vmcnt(0)" ::: "memory");
    __syncthreads();
    if (xb_leader(b.wave)) {
        unsigned* bar = b.bar; asm volatile("" : "+s"(bar));
        __builtin_amdgcn_s_waitcnt(0);
        unsigned nloc = b.st[0], nx = b.st[1];
        if (nloc == 0u) { xcd_barrier_complete(bar, b.x, nloc, nx); b.st[0] = nloc; b.st[1] = nx; }
        const unsigned old = xb_add(&bar[XB_XSUB(b.x)], 1u);
        const unsigned gen = old / nloc;
        if (old + 1u == (gen + 1u) * nloc) {
            __builtin_amdgcn_fence(__ATOMIC_RELEASE, "agent");
            asm volatile("s_waitcnt vmcnt(0)" ::: "memory");
            const unsigned og = xb_add(&bar[XB_TOP], 1u);
            const unsigned tg = og / nx;
            if (og + 1u == (tg + 1u) * nx) xb_add(&bar[XB_TOPGEN], 1u);
            else XB_SPIN(xb_ld(&bar[XB_TOPGEN]) == tg, bar);
            __builtin_amdgcn_fence(__ATOMIC_ACQUIRE, "agent");
            xb_add(&bar[XB_XGEN(b.x)], 1u);
            asm volatile("s_waitcnt vmcnt(0)" ::: "memory");
        } else {
            XB_SPIN(xb_ld(&bar[XB_XGEN(b.x)]) == gen, bar);
            __builtin_amdgcn_fence(__ATOMIC_ACQUIRE, "agent");
            asm volatile("s_waitcnt vmcnt(0)" ::: "memory");
        }
    }
    __syncthreads();
}

struct Args { const float* in[26]; float* out; unsigned char* ws; };
struct Frame {
    LAS unsigned char* lds;
    int tid, lane, wave, G, vcu;
    const float* const* in; float* out; unsigned char* ws;
};
__device__ __forceinline__ float shx(float v, int lane, int m) { return __int_as_float(__builtin_amdgcn_ds_bpermute((lane ^ m) << 2, __float_as_int(v))); }
__device__ __forceinline__ float wave_sum(float v, int lane) {
#pragma unroll
    for (int o = 1; o < 64; o <<= 1) v += shx(v, lane, o);
    return v;
}

__device__ __forceinline__ void fresh(Frame& F) { const int l = lane_now(); F.lane = l; F.tid = F.wave * 64 + l; }

__device__ __forceinline__ void conv_item(const float* W, int ldw, bf16* WT, int ldd, int k0, int n0, int drow0, const float* kscale, float gscale, LAS float* scr, int lane) {
    float wv[32];
#pragma unroll
    for (int i = 0; i < 32; ++i) { const int kk = 2 * i + (lane >> 5); wv[i] = W[(size_t)(k0 + kk) * ldw + n0 + (lane & 31)]; }
#pragma unroll
    for (int i = 0; i < 32; ++i) { const int kk = 2 * i + (lane >> 5); float w = wv[i]; if (kscale) w *= kscale[k0 + kk]; scr[kk * 33 + (lane & 31)] = w * gscale; }
    LDS_WAIT(); asm volatile("" ::: "memory");
    const int c = lane & 7;
#pragma unroll
    for (int j = 0; j < 4; ++j) { const int n = (lane >> 3) + 8 * j; const LAS float* s = scr + (8 * c) * 33 + n;
        v4u o; o.x = pk2(s[0 * 33], s[1 * 33]); o.y = pk2(s[2 * 33], s[3 * 33]); o.z = pk2(s[4 * 33], s[5 * 33]); o.w = pk2(s[6 * 33], s[7 * 33]);
        *(v4u*)(WT + (size_t)(drow0 + n) * ldd + k0 + 8 * c) = o; }
    LDS_WAIT(); asm volatile("" ::: "memory");
}
__device__ __forceinline__ int conv_rowmap(int mode, int n0, int off) {
    if (mode == 0) return n0 + off;
    if (mode == 1) { if (n0 < 384) return n0; if (n0 < 640) return 512 + (n0 - 384); if (n0 < 672) return 384; return 768 + (n0 - 672); }
    return 256 * (n0 >> 7) + (n0 & 127) + off;
}
__device__ __forceinline__ void conv_matrix(Frame& F, const float* W, int K, int N, bf16* WT, int ldd, int mode, int off, const float* kscale, float gscale) {
    LAS float* scr = (LAS float*)(F.lds + RING_OFF + F.wave * 16384);
    const int gw = F.vcu * NWAVES + F.wave, NGW = F.G * NWAVES;
    const int nblk = N / 32, nitems = (K / 64) * nblk;
    for (int it = gw; it < nitems; it += NGW) { const int kb = it / nblk, nb = it % nblk; conv_item(W, N, WT, ldd, 64 * kb, 32 * nb, conv_rowmap(mode, 32 * nb, off), kscale, gscale, scr, F.lane); }
}

__device__ __forceinline__ int row_bidx(int row) { return row < M ? row / SEQ : NB; }

struct RowArgs {
    const float* hin_l; const float* hin_c; float* hout_l; float* hout_c;
    const float* g;
    const float* modl;
    int shoff, scoff;
    bf16* U;
    const bf16* Y; const int* pos; const float* gate; const float* modprev;
    const float* router; int* eidx; float* gout; int* cnt;
};
template <bool COMBINE, int OUTMODE, bool ROUTER>
__device__ __forceinline__ void row_phase(Frame& F, const RowArgs& A, int nrows) {
    fresh(F);
    const int rpw = (nrows + F.G - 1) / F.G;
    LAS int* lcnt = (LAS int*)(F.lds + RING_OFF);
    if (ROUTER) { if (F.tid < 8) lcnt[F.tid] = 0; __syncthreads(); }
    const int rbase = (int)blockIdx.x * rpw, rend = (rbase + rpw < nrows) ? rbase + rpw : nrows;
#define ROWPTR(r_) (((r_) < M) ? A.hin_l + (size_t)(r_) * DM : A.hin_c + (size_t)((r_) - M) * DM)
    f32x4 rw[16][2];
    if (ROUTER) {
#pragma unroll
        for (int j = 0; j < 4; ++j)
#pragma unroll
            for (int q = 0; q < 4; ++q) { const int col = 4 * F.lane + 256 * j + q; rw[4 * j + q][0] = *(const f32x4*)(A.router + (size_t)col * 8); rw[4 * j + q][1] = *(const f32x4*)(A.router + (size_t)col * 8 + 4); }
    }
    int row = rbase + F.wave;
    f32x4 v[4], vn[4];
    if (row < rend) { const float* hr = ROWPTR(row);
#pragma unroll
        for (int j = 0; j < 4; ++j) v[j] = *(const f32x4*)(hr + 4 * F.lane + 256 * j); }
    for (; row < rend; row += NWAVES) {
        const bool lat = row < M; const int bidx = lat ? row / SEQ : NB;
        const int rnext = row + NWAVES;
        if (rnext < rend) { const float* hr = ROWPTR(rnext);
#pragma unroll
            for (int j = 0; j < 4; ++j) vn[j] = *(const f32x4*)(hr + 4 * F.lane + 256 * j); }
        if (COMBINE) {
            const int pa = A.pos[2 * row], pb = A.pos[2 * row + 1]; const float ga = A.gate[2 * row], gb = A.gate[2 * row + 1];
            const float* g2 = A.modprev + bidx * NMOD + 5 * DM;
#pragma unroll
            for (int j = 0; j < 4; ++j) { const int col = 4 * F.lane + 256 * j;
                const v2u ya = *(const v2u*)(A.Y + (size_t)pa * DM + col), yb = *(const v2u*)(A.Y + (size_t)pb * DM + col); const f32x4 gv = *(const f32x4*)(g2 + col);
                v[j].x += gv.x * (ga * bflo(ya.x) + gb * bflo(yb.x)); v[j].y += gv.y * (ga * bfhi(ya.x) + gb * bfhi(yb.x));
                v[j].z += gv.z * (ga * bflo(ya.y) + gb * bflo(yb.y)); v[j].w += gv.w * (ga * bfhi(ya.y) + gb * bfhi(yb.y)); }
            if (OUTMODE != 2) { float* ho = lat ? A.hout_l + (size_t)row * DM : A.hout_c + (size_t)(row - M) * DM;
#pragma unroll
                for (int j = 0; j < 4; ++j) *(f32x4*)(ho + 4 * F.lane + 256 * j) = v[j]; }
        }
        float s = 0.f;
#pragma unroll
        for (int j = 0; j < 4; ++j) s += (v[j].x * v[j].x + v[j].y * v[j].y) + (v[j].z * v[j].z + v[j].w * v[j].w);
        const float rstd = rsqrtf(wave_sum(s, F.lane) * (1.0f / DM) + EPS);
        if (OUTMODE == 2) {
            float* ho = A.hout_l + (size_t)row * DM;
#pragma unroll
            for (int j = 0; j < 4; ++j) { const int col = 4 * F.lane + 256 * j; const f32x4 gv = *(const f32x4*)(A.g + col); *(f32x4*)(ho + col) = v[j] * rstd * gv; }
        } else {
            const float* sh = A.modl + bidx * NMOD + A.shoff; const float* sc = A.modl + bidx * NMOD + A.scoff;
            float lg[8];
            if (ROUTER) {
#pragma unroll
                for (int e = 0; e < 8; ++e) lg[e] = 0.f;
            }
#pragma unroll
            for (int j = 0; j < 4; ++j) { const int col = 4 * F.lane + 256 * j; const f32x4 gv = *(const f32x4*)(A.g + col), shv = *(const f32x4*)(sh + col), scv = *(const f32x4*)(sc + col);
                f32x4 y = v[j] * rstd * gv * (scv + 1.0f) + shv;
                v2u o; o.x = pg8::cvt_pk_bf16(y.x, y.y); o.y = pg8::cvt_pk_bf16(y.z, y.w); *(v2u*)(A.U + (size_t)row * DM + col) = o;
                if (ROUTER) {
#pragma unroll
                    for (int q = 0; q < 4; ++q) { const f32x4 r0 = rw[4 * j + q][0], r1 = rw[4 * j + q][1]; const float yy = y[q];
                        lg[0] += yy * r0.x; lg[1] += yy * r0.y; lg[2] += yy * r0.z; lg[3] += yy * r0.w; lg[4] += yy * r1.x; lg[5] += yy * r1.y; lg[6] += yy * r1.z; lg[7] += yy * r1.w; } }
            }
            if (ROUTER) {
                const int b5 = F.lane >> 5, b4 = (F.lane >> 4) & 1, b3 = (F.lane >> 3) & 1; float a4[4], c2[2];
#pragma unroll
                for (int q = 0; q < 4; ++q) { const float mine = b5 ? lg[4 + q] : lg[q], oth = b5 ? lg[q] : lg[4 + q]; a4[q] = mine + shx(oth, F.lane, 32); }
#pragma unroll
                for (int q = 0; q < 2; ++q) { const float mine = b4 ? a4[2 + q] : a4[q], oth = b4 ? a4[q] : a4[2 + q]; c2[q] = mine + shx(oth, F.lane, 16); }
                float d1 = (b3 ? c2[1] : c2[0]) + shx(b3 ? c2[0] : c2[1], F.lane, 8);
                d1 += shx(d1, F.lane, 4); d1 += shx(d1, F.lane, 2); d1 += shx(d1, F.lane, 1);
#pragma unroll
                for (int e = 0; e < 8; ++e) lg[e] = __int_as_float(__builtin_amdgcn_readlane(__float_as_int(d1), 8 * e));
                int i0 = 0; float v0 = lg[0];
#pragma unroll
                for (int e = 1; e < 8; ++e) if (lg[e] > v0) { v0 = lg[e]; i0 = e; }
                int i1 = -1; float v1 = -INFINITY;
#pragma unroll
                for (int e = 0; e < 8; ++e) if (e != i0 && lg[e] > v1) { v1 = lg[e]; i1 = e; }
                const float g0 = 1.0f / (1.0f + __expf(v1 - v0));
                if (F.lane == 0) { A.eidx[2 * row] = i0; A.eidx[2 * row + 1] = i1; A.gout[2 * row] = g0; A.gout[2 * row + 1] = 1.0f - g0; atomicAdd((int*)&lcnt[i0], 1); atomicAdd((int*)&lcnt[i1], 1); }
            }
        }
#pragma unroll
        for (int j = 0; j < 4; ++j) v[j] = vn[j];
    }
#undef ROWPTR
    if (ROUTER) { __syncthreads(); if (F.tid < 8) A.cnt[blockIdx.x * 8 + F.tid] = lcnt[F.tid]; __syncthreads(); }
}

using pg8::Unit; using pg8::cvt_pk_bf16;
__device__ __forceinline__ v4u pack8(const f32x4& a, const f32x4& b) { v4u w; w.x = cvt_pk_bf16(a[0], a[1]); w.y = cvt_pk_bf16(a[2], a[3]); w.z = cvt_pk_bf16(b[0], b[1]); w.w = cvt_pk_bf16(b[2], b[3]); return w; }
struct EpiIn {
    static constexpr bool PERM = true;
    bf16 *CQ, *KR, *CKV, *H5;
    __device__ __forceinline__ void operator()(const f32x4 (&acc)[2][2][4][2], const Unit& u, int wr, int wc, int fr, int fq) const {
        const int row0 = u.pm * 256 + wr * 64 + fr;
#pragma unroll
        for (int bj = 0; bj < 2; ++bj) {
            const int col = u.pn * 256 + bj * 128 + wc * 32 + 8 * fq;
            bf16* base; int ld;
            if (col < 384) { base = CQ + col; ld = QL; }
            else if (col < 416) { base = KR + (col - 384); ld = ROPE; }
            else if (col < 512) { base = nullptr; ld = 0; }
            else if (col < 768) { base = CKV + (col - 512); ld = KVL; }
            else { const int c2 = col - 768; base = H5 + (size_t)(c2 >> 9) * HSEG + (c2 & 511); ld = HW; }
            if (base) {
#pragma unroll
                for (int ai = 0; ai < 2; ++ai)
#pragma unroll
                    for (int m = 0; m < 4; ++m) { const int row = row0 + ai * 128 + m * 16; *(v4u*)(base + (size_t)row * ld) = pack8(acc[ai][bj][m][0], acc[ai][bj][m][1]); }
            }
        }
    }
};
struct EpiQ {
    static constexpr bool PERM = true;
    bf16* O; const float* rs;
    __device__ __forceinline__ void operator()(const f32x4 (&acc)[2][2][4][2], const Unit& u, int wr, int wc, int fr, int fq) const {
        const int row0 = u.pm * 256 + wr * 64 + fr;
#pragma unroll
        for (int ai = 0; ai < 2; ++ai)
#pragma unroll
            for (int m = 0; m < 4; ++m) { const int row = row0 + ai * 128 + m * 16; const float sc = rs[row];
#pragma unroll
                for (int bj = 0; bj < 2; ++bj) { const int col = u.pn * 256 + bj * 128 + wc * 32 + 8 * fq; *(v4u*)(O + (size_t)row * 768 + col) = pack8(acc[ai][bj][m][0] * sc, acc[ai][bj][m][1] * sc); } }
    }
};
struct EpiKV {
    static constexpr bool PERM = true;
    bf16* KNp; bf16* VTp; const float* rs;
    __device__ __forceinline__ void operator()(const f32x4 (&acc)[2][2][4][2], const Unit& u, int wr, int wc, int fr, int fq) const {
        const int row0 = u.pm * 256 + wr * 64 + fr;
#pragma unroll
        for (int ai = 0; ai < 2; ++ai)
#pragma unroll
            for (int m = 0; m < 4; ++m) { const int row = row0 + ai * 128 + m * 16; const float sc = rs[row];
                const bool lat = row < M; const int b = lat ? row / SEQ : (row - M) / CTXL; const int key = lat ? row % SEQ : SEQ + (row - M) % CTXL;
                const int kpos = (key & ~12) | ((key & 4) << 1) | ((key & 8) >> 1);
#pragma unroll
                for (int bj = 0; bj < 2; ++bj) { const int col = u.pn * 256 + bj * 128 + wc * 32 + 8 * fq; const int hh = col >> 7, w = col & 127;
                    if (w < 64) { *(v4u*)(KNp + (size_t)row * HW + hh * 64 + w) = pack8(acc[ai][bj][m][0] * sc, acc[ai][bj][m][1] * sc); }
                    else { bf16* dst = VTp + ((size_t)((b * NH + hh) * VD + (w - 64))) * NKEY + kpos;
#pragma unroll
                        for (int n = 0; n < 2; ++n)
#pragma unroll
                            for (int q = 0; q < 4; ++q) dst[(size_t)(4 * n + q) * NKEY] = (bf16)f2bf(acc[ai][bj][m][n][q] * sc); } } }
    }
};
struct EpiResid {
    static constexpr bool PERM = false;
    const float* hin_l; const float* hin_c; float* hout_l; float* hout_c; const float* modl; int goff;
    __device__ __forceinline__ void operator()(const f32x4 (&acc)[2][2][4][2], const Unit& u, int wr, int wc, int fr, int fq) const {
        const int rowt = u.pm * 256; const bool lat = rowt < M; const int bidx = lat ? rowt / SEQ : NB;
        const float* gate = modl + bidx * NMOD + goff;
        const float* hi = lat ? hin_l + (size_t)rowt * DM : hin_c + (size_t)(rowt - M) * DM;
        float* ho = lat ? hout_l + (size_t)rowt * DM : hout_c + (size_t)(rowt - M) * DM;
        const int col0 = u.pn * 256 + wc * 32 + 4 * fq;
#pragma unroll
        for (int bj = 0; bj < 2; ++bj) {
            f32x4 hv[2][2][4];
#pragma unroll
            for (int n = 0; n < 2; ++n)
#pragma unroll
                for (int ai = 0; ai < 2; ++ai)
#pragma unroll
                    for (int m = 0; m < 4; ++m) hv[n][ai][m] = *(const f32x4*)(hi + (size_t)(ai * 128 + wr * 64 + m * 16 + fr) * DM + col0 + bj * 128 + n * 16);
#pragma unroll
            for (int n = 0; n < 2; ++n) { const f32x4 gv = *(const f32x4*)(gate + col0 + bj * 128 + n * 16);
#pragma unroll
                for (int ai = 0; ai < 2; ++ai)
#pragma unroll
                    for (int m = 0; m < 4; ++m) *(f32x4*)(ho + (size_t)(ai * 128 + wr * 64 + m * 16 + fr) * DM + col0 + bj * 128 + n * 16) = hv[n][ai][m] + gv * acc[ai][bj][m][n]; }
            asm volatile("" ::: "memory"); }
    }
};
struct EpiPool {
    static constexpr bool PERM = false;
    float* h_l; float* h_c; const float* modl; const float* bias; const float* scale; int talloc;
    __device__ __forceinline__ void operator()(const f32x4 (&acc)[2][2][4][2], const Unit& u, int wr, int wc, int fr, int fq) const {
        const int g = u.pn, rowt = (u.pm - g * talloc) * 256; const bool lat = rowt < M; const int bidx = lat ? rowt / SEQ : NB;
        const float* gate = modl + bidx * NMOD + 2 * DM;
        float* ho = lat ? h_l + (size_t)rowt * DM : h_c + (size_t)(rowt - M) * DM;
        const int col0 = g * 256 + wc * 32 + 4 * fq;
#pragma unroll
        for (int bj = 0; bj < 2; ++bj)
#pragma unroll
            for (int n = 0; n < 2; ++n) { const int c = col0 + bj * 128 + n * 16; const f32x4 gm = *(const f32x4*)(gate + c) * *(const f32x4*)(scale + c); const f32x4 gb = gm * *(const f32x4*)(bias + c);
#pragma unroll
                for (int ai = 0; ai < 2; ++ai)
#pragma unroll
                    for (int m = 0; m < 4; ++m) { const int r = ai * 128 + wr * 64 + m * 16 + fr; const size_t off = (size_t)r * DM + c; const f32x4 hv = *(const f32x4*)(ho + off); *(f32x4*)(ho + off) = hv + gm * acc[ai][bj][m][n] + gb; }
                asm volatile("" ::: "memory"); }
    }
};
struct EpiGateUp {
    static constexpr bool PERM = true;
    bf16* H; int ldh, nct, rowsub;
    __device__ __forceinline__ void operator()(const f32x4 (&acc)[2][2][4][2], const Unit& u, int wr, int wc, int fr, int fq) const {
        const int row0 = u.pm * 256 + wr * 64 + fr - rowsub; const int ct = u.pn % nct; const int col = ct * 128 + wc * 32 + 8 * fq;
#pragma unroll
        for (int ai = 0; ai < 2; ++ai)
#pragma unroll
            for (int m = 0; m < 4; ++m) { const int row = row0 + ai * 128 + m * 16; f32x4 o[2];
#pragma unroll
                for (int n = 0; n < 2; ++n)
#pragma unroll
                    for (int q = 0; q < 4; ++q) { const float gv = acc[ai][0][m][n][q], uv = acc[ai][1][m][n][q]; o[n][q] = gv * uv / (1.0f + __expf(-gv)); }
                *(v4u*)(H + (size_t)row * ldh + col) = pack8(o[0], o[1]); }
    }
};
struct EpiY {
    static constexpr bool PERM = true;
    bf16* Y; int nct;
    __device__ __forceinline__ void operator()(const f32x4 (&acc)[2][2][4][2], const Unit& u, int wr, int wc, int fr, int fq) const {
        const int row0 = u.pm * 256 + wr * 64 + fr; const int ct = u.pn % nct;
#pragma unroll
        for (int ai = 0; ai < 2; ++ai)
#pragma unroll
            for (int m = 0; m < 4; ++m) { const int row = row0 + ai * 128 + m * 16;
#pragma unroll
                for (int bj = 0; bj < 2; ++bj) { const int col = ct * 256 + bj * 128 + wc * 32 + 8 * fq; *(v4u*)(Y + (size_t)row * DM + col) = pack8(acc[ai][bj][m][0], acc[ai][bj][m][1]); } }
    }
};

__device__ __forceinline__ void p0_prologue(Frame& F) {
    fresh(F);
    unsigned char* ws = F.ws;
    const float qscale = 0.10206207261596577f * 1.4426950408889634f;
    for (int j = 0; j < 2; ++j) {
        conv_matrix(F, F.in[8] + (size_t)j * DM * INW, DM, INW, (bf16*)(ws + WS_WIN) + (size_t)j * INP * DM, DM, 1, 0, nullptr, 1.f);
        conv_matrix(F, F.in[11] + (size_t)j * QL * 768, QL, 768, (bf16*)(ws + WS_WUQ) + (size_t)j * 768 * QL, QL, 0, 0, F.in[9] + j * QL, qscale);
        conv_matrix(F, F.in[12] + (size_t)j * KVL * 1024, KVL, 1024, (bf16*)(ws + WS_WUKV) + (size_t)j * 1024 * KVL, KVL, 0, 0, F.in[10] + j * KVL, 1.f);
        conv_matrix(F, F.in[15] + (size_t)j * DM * DM, DM, DM, (bf16*)(ws + WS_WOUT) + (size_t)j * DM * DM, DM, 0, 0, nullptr, 1.f);
        conv_matrix(F, F.in[16] + (size_t)j * DM * DFF, DM, DFF, (bf16*)(ws + WS_WGU) + (size_t)j * 2 * DFF * DM, DM, 2, 0, nullptr, 1.f);
        conv_matrix(F, F.in[17] + (size_t)j * DM * DFF, DM, DFF, (bf16*)(ws + WS_WGU) + (size_t)j * 2 * DFF * DM, DM, 2, 128, nullptr, 1.f);
        conv_matrix(F, F.in[18] + (size_t)j * DFF * DM, DFF, DM, (bf16*)(ws + WS_WDN) + (size_t)j * DM * DFF, DFF, 0, 0, nullptr, 1.f);
        for (int g = 0; g < 4; ++g)
            conv_matrix(F, F.in[19] + (size_t)(j * 4 + g) * 65536, 256, 256, (bf16*)(ws + WS_WPOOL) + (size_t)(j * 4 + g) * 65536, 256, 0, 0, nullptr, 1.f);
    }
    __syncthreads();
    if (blockIdx.x == 0 && F.tid < 8) {
        float* TC = (float*)(ws + WS_ROPE); float* TS = TC + 512;
        double th = 1.0; for (int i = 0; i < F.tid; ++i) th *= 0.31622776601683794;
        const double x2 = th * th; double s = th, c = 1.0, ts = th, tc = 1.0;
        for (int n = 1; n <= 12; ++n) { tc *= -x2 / (double)((2 * n - 1) * (2 * n)); c += tc; ts *= -x2 / (double)((2 * n) * (2 * n + 1)); s += ts; }
        double cp = 1.0, sp = 0.0;
        for (int p = 0; p < 64; ++p) { TC[p * 8 + F.tid] = (float)cp; TS[p * 8 + F.tid] = (float)sp; const double ncp = cp * c - sp * s; sp = sp * c + cp * s; cp = ncp; }
    }
    {
        LAS float* sc = (LAS float*)(F.lds + RING_OFF);
        LAS float* red = sc + 17 * 1024;
        const int nitems = 4 * (NMOD / 64);
        if ((int)blockIdx.x < nitems) {
            for (int e = F.tid; e < 17 * 1024; e += 512) { const int r = e >> 10, k = e & 1023; const float x = (r < 16) ? F.in[1][r * 1024 + k] : F.in[3][k]; sc[e] = siluf_(x); }
            __syncthreads();
            for (int it = blockIdx.x; it < nitems; it += F.G) {
                const int l = it / (NMOD / 64), c0 = (it % (NMOD / 64)) * 64;
                const float* W = F.in[4] + (size_t)l * DM * NMOD + c0 + F.lane;
                float acc[17];
#pragma unroll
                for (int r = 0; r < 17; ++r) acc[r] = 0.f;
                const int kb = F.wave * 128;
                for (int k = 0; k < 128; k += 4) {
                    const float w0 = W[(size_t)(kb + k) * NMOD], w1 = W[(size_t)(kb + k + 1) * NMOD], w2 = W[(size_t)(kb + k + 2) * NMOD], w3 = W[(size_t)(kb + k + 3) * NMOD];
#pragma unroll
                    for (int r = 0; r < 17; ++r) { const f32x4 s4 = *(const LAS f32x4*)(sc + r * 1024 + kb + k); acc[r] += s4.x * w0 + s4.y * w1 + s4.z * w2 + s4.w * w3; }
                }
#pragma unroll
                for (int r = 0; r < 17; ++r) red[(F.wave * 17 + r) * 64 + F.lane] = acc[r];
                __syncthreads();
                for (int o = F.tid; o < 17 * 64; o += 512) { const int r = o >> 6, cc = o & 63; float s = 0.f;
#pragma unroll
                    for (int w = 0; w < 8; ++w) s += red[(w * 17 + r) * 64 + cc];
                    ((float*)(ws + WS_MODV))[(size_t)(l * 17 + r) * NMOD + c0 + cc] = s + F.in[5][l * NMOD + c0 + cc]; }
                __syncthreads();
            }
        }
    }
}

__device__ __forceinline__ void e3_phase(Frame& F) {
    fresh(F);
    unsigned char* ws = F.ws;
    const bf16* CQ = (const bf16*)(ws + WS_CQ); const bf16* CKV = (const bf16*)(ws + WS_CKV); const bf16* KR = (const bf16*)(ws + WS_KR); bf16* KRR = (bf16*)(ws + WS_KRR);
    float* RSQ = (float*)(ws + WS_RSQ); float* RSKV = (float*)(ws + WS_RSKV); const float* TC = (const float*)(ws + WS_ROPE); const float* TS = TC + 512;
    const int rpw = (MT + F.G - 1) / F.G;
    for (int i = F.wave; i < rpw; i += NWAVES) {
        const int row = (int)blockIdx.x * rpw + i; if (row >= MT) break;
        float s = 0.f;
        if (F.lane < 48) { const v4u w = *(const v4u*)(CQ + (size_t)row * QL + F.lane * 8);
            s = bflo(w.x) * bflo(w.x) + bfhi(w.x) * bfhi(w.x) + bflo(w.y) * bflo(w.y) + bfhi(w.y) * bfhi(w.y) + bflo(w.z) * bflo(w.z) + bfhi(w.z) * bfhi(w.z) + bflo(w.w) * bflo(w.w) + bfhi(w.w) * bfhi(w.w); }
        s = wave_sum(s, F.lane); if (F.lane == 0) RSQ[row] = rsqrtf(s * (1.0f / QL) + EPS);
        s = 0.f;
        if (F.lane < 32) { const v4u w = *(const v4u*)(CKV + (size_t)row * KVL + F.lane * 8);
            s = bflo(w.x) * bflo(w.x) + bfhi(w.x) * bfhi(w.x) + bflo(w.y) * bflo(w.y) + bfhi(w.y) * bfhi(w.y) + bflo(w.z) * bflo(w.z) + bfhi(w.z) * bfhi(w.z) + bflo(w.w) * bflo(w.w) + bfhi(w.w) * bfhi(w.w); }
        s = wave_sum(s, F.lane); if (F.lane == 0) RSKV[row] = rsqrtf(s * (1.0f / KVL) + EPS);
        const float x = (F.lane < 32) ? bf2f(KR[(size_t)row * ROPE + F.lane]) : 0.f; const float pr = shx(x, F.lane, 8);
        float o = x;
        if (row < M) { const int t = row % SEQ; const int p = ((F.lane >> 4) & 1) ? (t & 63) : (t >> 6); const int j = F.lane & 7; const float c = TC[p * 8 + j], sn = TS[p * 8 + j];
            o = ((F.lane >> 3) & 1) ? x * c + pr * sn : x * c - pr * sn; }
        if (F.lane < 32) KRR[(size_t)row * ROPE + F.lane] = (bf16)f2bf(o);
    }
}

typedef short bf16x8v __attribute__((ext_vector_type(8)));
typedef float f32x16 __attribute__((ext_vector_type(16)));
__device__ __forceinline__ void attn_unit(Frame& F, int b, int h, int qrow0, bool rope_q, int t_lo, int t_hi) {
    unsigned char* ws = F.ws;
    const bf16* QB = (const bf16*)(ws + WS_QB); const bf16* KN = (const bf16*)(ws + WS_KN); const bf16* KRR = (const bf16*)(ws + WS_KRR); const bf16* VT = (const bf16*)(ws + WS_VV);
    bf16* MIX = (bf16*)(ws + WS_MIX); const float* TC = (const float*)(ws + WS_ROPE); const float* TS = TC + 512;
    const int lane = F.lane, wave = F.wave, r32 = lane & 31, hi = lane >> 5;
    LAS unsigned char* ring = F.lds + RING_OFF;
    const int qrow = qrow0 + wave * 32 + r32;
    bf16x8v qr[6];
#pragma unroll
    for (int d0 = 0; d0 < 6; ++d0) qr[d0] = *(const bf16x8v*)(QB + (size_t)qrow * 768 + h * QKD + 16 * d0 + 8 * hi);
    if (rope_q) { const int t = qrow % SEQ;
#pragma unroll
        for (int a = 0; a < 2; ++a) { const int p = a ? (t & 63) : (t >> 6); const v4u w = __builtin_bit_cast(v4u, qr[4 + a]); float x[8], y[8];
            x[0] = bflo(w.x); x[1] = bfhi(w.x); x[2] = bflo(w.y); x[3] = bfhi(w.y); x[4] = bflo(w.z); x[5] = bfhi(w.z); x[6] = bflo(w.w); x[7] = bfhi(w.w);
#pragma unroll
            for (int jj = 0; jj < 8; ++jj) { const float pr = shx(x[jj], lane, 32); const float c = TC[p * 8 + jj], sn = TS[p * 8 + jj]; y[jj] = hi ? x[jj] * c + pr * sn : x[jj] * c - pr * sn; }
            v4u o; o.x = pk2(y[0], y[1]); o.y = pk2(y[2], y[3]); o.z = pk2(y[4], y[5]); o.w = pk2(y[6], y[7]); qr[4 + a] = __builtin_bit_cast(bf16x8v, o); } }
    const int bh = b * NH + h;
    const bf16* vsrc = VT + ((size_t)(bh * VD + lane)) * NKEY + 8 * wave;
#define ATT_DMA(t, buf) do { const int t_ = (t); const int r0_ = t_ < SEQ / 64 ? b * SEQ + 64 * t_ : M + b * CTXL + 64 * (t_ - SEQ / 64); \
        LAS unsigned char* kb_ = ring + (buf) * 20480; LAS unsigned char* vb_ = kb_ + 12288; \
        __builtin_amdgcn_global_load_lds((const unsigned*)(KN + (size_t)(r0_ + lane) * HW + h * 64 + 8 * wave), (LAS unsigned*)(kb_ + wave * 1024), 16, 0, 0); \
        __builtin_amdgcn_global_load_lds((const unsigned*)(KRR + (size_t)(r0_ + lane) * ROPE + 8 * (wave & 3)), (LAS unsigned*)(kb_ + (8 + (wave & 3)) * 1024), 16, 0, 0);     \
        __builtin_amdgcn_global_load_lds((const unsigned*)(vsrc + 64 * t_), (LAS unsigned*)(vb_ + wave * 1024), 16, 0, 0); } while (0)
    f32x16 o0, o1;
#pragma unroll
    for (int r = 0; r < 16; ++r) { o0[r] = 0.f; o1[r] = 0.f; }
    constexpr float ATT_THR = 8.0f;
    float m_run = 0.f, l_run = 0.f;
    asm volatile("s_waitcnt vmcnt(0)" ::: "memory");
    ATT_DMA(t_lo, 0); if (t_lo + 1 < t_hi) ATT_DMA(t_lo + 1, 1); if (t_lo + 2 < t_hi) ATT_DMA(t_lo + 2, 2);
    for (int t = t_lo; t < t_hi; ++t) {
        const int buf = (t - t_lo) & 3; const int rem = t_hi - 1 - t;
        if (rem >= 2) asm volatile("s_waitcnt vmcnt(6)" ::: "memory"); else if (rem == 1) asm volatile("s_waitcnt vmcnt(3)" ::: "memory"); else asm volatile("s_waitcnt vmcnt(0)" ::: "memory");
        asm volatile("s_waitcnt lgkmcnt(0)" ::: "memory"); __builtin_amdgcn_s_barrier(); asm volatile("" ::: "memory");
        if (t + 3 < t_hi) ATT_DMA(t + 3, (buf + 3) & 3);
        const LAS unsigned char* kb = ring + buf * 20480 + hi * 1024 + r32 * 16; const LAS unsigned char* vb = ring + buf * 20480 + 12288 + hi * 1024 + r32 * 16;
        bf16x8v kf[12], vf[8];
#pragma unroll
        for (int d0 = 0; d0 < 6; ++d0) { kf[2 * d0] = *(const LAS bf16x8v*)(kb + d0 * 2048); kf[2 * d0 + 1] = *(const LAS bf16x8v*)(kb + d0 * 2048 + 512); }
#pragma unroll
        for (int s4 = 0; s4 < 4; ++s4) { vf[2 * s4] = *(const LAS bf16x8v*)(vb + s4 * 2048); vf[2 * s4 + 1] = *(const LAS bf16x8v*)(vb + s4 * 2048 + 512); }
        f32x16 p0, p1; const float negm = -m_run;
#pragma unroll
        for (int r = 0; r < 16; ++r) { p0[r] = negm; p1[r] = negm; }
#pragma unroll
        for (int d0 = 0; d0 < 6; ++d0) { p0 = __builtin_amdgcn_mfma_f32_32x32x16_bf16(kf[2 * d0], qr[d0], p0, 0, 0, 0); p1 = __builtin_amdgcn_mfma_f32_32x32x16_bf16(kf[2 * d0 + 1], qr[d0], p1, 0, 0, 0); }
        float ma = __builtin_fmaxf(__builtin_fmaxf(p0[0], p0[1]), p1[0]), mb = __builtin_fmaxf(__builtin_fmaxf(p0[2], p0[3]), p1[1]); ma = __builtin_fmaxf(__builtin_fmaxf(ma, p1[2]), p1[3]);
#pragma unroll
        for (int r = 4; r < 16; r += 4) { ma = __builtin_fmaxf(__builtin_fmaxf(ma, p0[r]), p0[r + 1]); mb = __builtin_fmaxf(__builtin_fmaxf(mb, p0[r + 2]), p0[r + 3]); ma = __builtin_fmaxf(__builtin_fmaxf(ma, p1[r]), p1[r + 1]); mb = __builtin_fmaxf(__builtin_fmaxf(mb, p1[r + 2]), p1[r + 3]); }
        float mt = __builtin_fmaxf(ma, mb);
        { auto rr = __builtin_amdgcn_permlane32_swap(__float_as_uint(mt), __float_as_uint(mt), false, false); mt = __builtin_fmaxf(__uint_as_float(rr[0]), __uint_as_float(rr[1])); }
        const bool first = (t == t_lo);
        if (first || __any(mt > ATT_THR)) {
            const float dl = first ? mt : __builtin_fmaxf(mt, 0.f); m_run += dl; const float alpha = __builtin_amdgcn_exp2f(-dl); l_run *= alpha;
#pragma unroll
            for (int r = 0; r < 16; ++r) { p0[r] -= dl; p1[r] -= dl; o0[r] *= alpha; o1[r] *= alpha; }
        }
        float ps0 = 0.f, ps1 = 0.f;
#pragma unroll
        for (int r = 0; r < 16; ++r) { p0[r] = __builtin_amdgcn_exp2f(p0[r]); p1[r] = __builtin_amdgcn_exp2f(p1[r]); ps0 += p0[r]; ps1 += p1[r]; }
        l_run += ps0 + ps1;
        v4u pw[4];
#pragma unroll
        for (int q = 0; q < 4; ++q) { pw[0][q] = cvt_pk_bf16(p0[2 * q], p0[2 * q + 1]); pw[1][q] = cvt_pk_bf16(p0[8 + 2 * q], p0[8 + 2 * q + 1]); pw[2][q] = cvt_pk_bf16(p1[2 * q], p1[2 * q + 1]); pw[3][q] = cvt_pk_bf16(p1[8 + 2 * q], p1[8 + 2 * q + 1]); }
#pragma unroll
        for (int s4 = 0; s4 < 4; ++s4) { const bf16x8v pa = __builtin_bit_cast(bf16x8v, pw[s4]);
            o0 = __builtin_amdgcn_mfma_f32_32x32x16_bf16(vf[2 * s4], pa, o0, 0, 0, 0); o1 = __builtin_amdgcn_mfma_f32_32x32x16_bf16(vf[2 * s4 + 1], pa, o1, 0, 0, 0); }
    }
    { auto rr = __builtin_amdgcn_permlane32_swap(__float_as_uint(l_run), __float_as_uint(l_run), false, false); l_run = __uint_as_float(rr[0]) + __uint_as_float(rr[1]); }
    const float rl = 1.0f / l_run;
    bf16* orow = MIX + (size_t)qrow * DM + h * VD;
#pragma unroll
    for (int g = 0; g < 4; ++g) { v2u a, c2; a.x = pk2(o0[4 * g] * rl, o0[4 * g + 1] * rl); a.y = pk2(o0[4 * g + 2] * rl, o0[4 * g + 3] * rl); c2.x = pk2(o1[4 * g] * rl, o1[4 * g + 1] * rl); c2.y = pk2(o1[4 * g + 2] * rl, o1[4 * g + 3] * rl);
        *(v2u*)(orow + 8 * g + 4 * hi) = a; *(v2u*)(orow + 32 + 8 * g + 4 * hi) = c2; }
    asm volatile("s_waitcnt vmcnt(0) lgkmcnt(0)" ::: "memory"); __builtin_amdgcn_s_barrier(); asm volatile("" ::: "memory");
#undef ATT_DMA
}
__device__ __forceinline__ void hgrn_item(Frame& F, int j, int it);
__device__ __forceinline__ void mix_phase(Frame& F, int j, bool ctx_out) {
    fresh(F);
    const int npair = F.G >> 1;
    for (int P = F.vcu >> 1; P < NB * NH; P += npair) {
        const int b = P >> 3, h = P & 7;
        if ((F.vcu & 1) == 0) {
            hgrn_item(F, j, P);
            for (int qb = 6; qb < 8; ++qb) attn_unit(F, b, h, b * SEQ + qb * 256, true, 0, NKEY / 64);
        } else {
            for (int qb = 0; qb < 6; ++qb) attn_unit(F, b, h, b * SEQ + qb * 256, true, 0, NKEY / 64);
            if (ctx_out) attn_unit(F, b, h, M + b * CTXL, false, SEQ / 64, NKEY / 64);
        }
    }
    __syncthreads();
}

__device__ __forceinline__ int hgrn_row(int b, int dir, int ig) { return (ig < CTXL) ? (M + b * CTXL + (dir ? CTXL - 1 - ig : ig)) : (b * SEQ + (dir ? SEQ - 1 - (ig - CTXL) : (ig - CTXL))); }
__device__ __forceinline__ void hgrn_item(Frame& F, int j, int it) {
    unsigned char* ws = F.ws;
    const bf16* HQ = (const bf16*)(ws + WS_HQ); const bf16* HFF = HQ + HSEG; const bf16* HFB = HQ + 2 * HSEG; const bf16* HI = HQ + 3 * HSEG;
    LAS unsigned char* ring = F.lds + RING_OFF;
    LAS unsigned char* QN = ring; LAS unsigned char* KN = ring + 17408; LAS unsigned char* KT = ring + 34816; LAS unsigned char* VT = ring + 53248; LAS unsigned char* ST = ring + 71680;
    LAS float* TOT = (LAS float*)(ring + 106496); LAS unsigned char* RQ = ring + 108544; LAS unsigned char* RF = ring + 124928;
    const int lane0 = F.lane, wave = F.wave;
    const int part = wave >> 1;
    const int kb = wave >> 1, vb0 = 2 * (wave & 1);
    const int ib = wave >> 2, vbo = wave & 3;
    const int dir = it & 1, hh = (it >> 1) & 3, b = it >> 3;
    const bf16* HF = dir ? HFB : HFF; float* OO = (float*)(ws + (dir ? WS_OB : WS_OF));
    float lb = 0.f; if (j == 1) { const int ci = dir * HW + hh * HK + (wave & 1) * 64 + lane0; const float l0 = F.in[13][ci], l1 = F.in[13][2 * HW + ci]; lb = 1.0f / (1.0f + __expf(l0 - l1)); }
    const float oml = 1.0f - lb;
    f32x16 S0, S1;
#pragma unroll
    for (int r = 0; r < 16; ++r) { S0[r] = 0.f; S1[r] = 0.f; }
#define LBAR() do { asm volatile("s_waitcnt lgkmcnt(0)" ::: "memory"); __builtin_amdgcn_s_barrier(); asm volatile("" ::: "memory"); } while (0)
#define HG_BASE(c_) ((c_) < CTXL / 64 ? M + b * CTXL + (dir ? CTXL - 64 - 64 * (c_) : 64 * (c_)) : b * SEQ + (dir ? SEQ - 64 - 64 * ((c_) - CTXL / 64) : 64 * ((c_) - CTXL / 64)))
#define HG_DMA(c_) do { const int rb_ = HG_BASE(c_); \
        _Pragma("unroll") for (int p_ = 0; p_ < 2; ++p_) { const int pc_ = wave * 2 + p_; const size_t go_ = (size_t)(rb_ + 4 * pc_ + (lane >> 4)) * HW + hh * HK + 8 * (lane & 15); \
            __builtin_amdgcn_global_load_lds((const unsigned*)(HQ + go_), (LAS unsigned*)(RQ + pc_ * 1024), 16, 0, 0); __builtin_amdgcn_global_load_lds((const unsigned*)(HF + go_), (LAS unsigned*)(RF + pc_ * 1024), 16, 0, 0); } } while (0)
#define HG_VLD(c_) do { const size_t go_ = (size_t)(HG_BASE(c_) + (dir ? 63 - lane : lane)) * HW + hh * HK + 16 * wave; rv0 = *(const v4u*)(HI + go_); rv1 = *(const v4u*)(HI + go_ + 8); } while (0)
    v4u rv0, rv1;
    { const int lane = lane0; HG_DMA(0); HG_VLD(0); }
    asm volatile("s_waitcnt vmcnt(0)" ::: "memory"); LBAR();
    for (int ch = 0; ch < NKEY / 64; ++ch) {
        int lane_ = lane0; asm volatile("" : "+v"(lane_));
        const int lane = lane_, r32 = lane & 31, hi = lane >> 5, k = (wave & 1) * 64 + lane;
        const int pos = (lane & ~12) | ((lane & 4) << 1) | ((lane & 8) >> 1);
        float qv[16], kin[16], cs[16]; float run = 0.f;
#pragma unroll
        for (int ii = 0; ii < 16; ++ii) { const int i = 16 * part + ii, mr = dir ? 63 - i : i; const float hq = bf2f(*(const LAS bf16*)(RQ + mr * 256 + k * 2)), hf = bf2f(*(const LAS bf16*)(RF + mr * 256 + k * 2));
            qv[ii] = hq * __builtin_amdgcn_rcpf(1.0f + __expf(-hq)); const float e = __expf(-hf), sg = __builtin_amdgcn_rcpf(1.0f + e); kin[ii] = oml * e * sg; run += __logf(lb + oml * sg); cs[ii] = run; }
        TOT[part * 128 + k] = run;
        { LAS bf16* vt = (LAS bf16*)(VT + (16 * wave) * 144 + pos * 2);
          vt[0 * 72] = (bf16)(rv0.x & 0xffffu); vt[1 * 72] = (bf16)(rv0.x >> 16); vt[2 * 72] = (bf16)(rv0.y & 0xffffu); vt[3 * 72] = (bf16)(rv0.y >> 16);
          vt[4 * 72] = (bf16)(rv0.z & 0xffffu); vt[5 * 72] = (bf16)(rv0.z >> 16); vt[6 * 72] = (bf16)(rv0.w & 0xffffu); vt[7 * 72] = (bf16)(rv0.w >> 16);
          vt[8 * 72] = (bf16)(rv1.x & 0xffffu); vt[9 * 72] = (bf16)(rv1.x >> 16); vt[10 * 72] = (bf16)(rv1.y & 0xffffu); vt[11 * 72] = (bf16)(rv1.y >> 16);
          vt[12 * 72] = (bf16)(rv1.z & 0xffffu); vt[13 * 72] = (bf16)(rv1.z >> 16); vt[14 * 72] = (bf16)(rv1.w & 0xffffu); vt[15 * 72] = (bf16)(rv1.w >> 16); }
        LBAR();
        if (ch + 1 < NKEY / 64) { HG_DMA(ch + 1); HG_VLD(ch + 1); }
        { const float t0 = TOT[k], t1 = TOT[128 + k], t2 = TOT[256 + k];
          const float base = (part > 0 ? t0 : 0.f) + (part > 1 ? t1 : 0.f) + (part > 2 ? t2 : 0.f); const float rr = t0 + t1;
          unsigned kt[8];
#pragma unroll
          for (int ii = 0; ii < 16; ii += 2) { float d0 = base + cs[ii] - rr, d1 = base + cs[ii + 1] - rr; d0 = fminf(fmaxf(d0, -80.f), 80.f); d1 = fminf(fmaxf(d1, -80.f), 80.f);
              const float e0 = __expf(d0), e1 = __expf(d1); const float q0 = qv[ii] * e0, q1 = qv[ii + 1] * e1, k0 = kin[ii] * __builtin_amdgcn_rcpf(e0), k1 = kin[ii + 1] * __builtin_amdgcn_rcpf(e1);
              const unsigned qp = cvt_pk_bf16(q0, q1), kp = cvt_pk_bf16(k0, k1);
              *(LAS bf16*)(QN + (16 * part + ii) * 272 + k * 2) = (bf16)(qp & 0xffffu); *(LAS bf16*)(QN + (16 * part + ii + 1) * 272 + k * 2) = (bf16)(qp >> 16);
              *(LAS bf16*)(KN + (16 * part + ii) * 272 + k * 2) = (bf16)(kp & 0xffffu); *(LAS bf16*)(KN + (16 * part + ii + 1) * 272 + k * 2) = (bf16)(kp >> 16);
              kt[ii >> 1] = kp; }
          *(LAS v4u*)(KT + k * 144 + part * 32) = (v4u){kt[0], kt[1], kt[4], kt[5]}; *(LAS v4u*)(KT + k * 144 + part * 32 + 16) = (v4u){kt[2], kt[3], kt[6], kt[7]}; }
        f32x16 T0, T1;
#pragma unroll
        for (int g4 = 0; g4 < 4; ++g4) { const int kk = kb * 32 + 8 * g4 + 4 * hi; const f32x4 ta = *(const LAS f32x4*)(TOT + kk), tb = *(const LAS f32x4*)(TOT + 128 + kk);
            const float e0 = __expf(ta.x + tb.x), e1 = __expf(ta.y + tb.y), e2 = __expf(ta.z + tb.z), e3 = __expf(ta.w + tb.w);
            T0[4 * g4] = S0[4 * g4] * e0; T0[4 * g4 + 1] = S0[4 * g4 + 1] * e1; T0[4 * g4 + 2] = S0[4 * g4 + 2] * e2; T0[4 * g4 + 3] = S0[4 * g4 + 3] * e3;
            T1[4 * g4] = S1[4 * g4] * e0; T1[4 * g4 + 1] = S1[4 * g4 + 1] * e1; T1[4 * g4 + 2] = S1[4 * g4 + 2] * e2; T1[4 * g4 + 3] = S1[4 * g4 + 3] * e3;
            v2u o; o.x = cvt_pk_bf16(T0[4 * g4], T0[4 * g4 + 1]); o.y = cvt_pk_bf16(T0[4 * g4 + 2], T0[4 * g4 + 3]); *(LAS v2u*)(ST + (vb0 * 32 + r32) * 272 + kk * 2) = o;
            o.x = cvt_pk_bf16(T1[4 * g4], T1[4 * g4 + 1]); o.y = cvt_pk_bf16(T1[4 * g4 + 2], T1[4 * g4 + 3]); *(LAS v2u*)(ST + (vb0 * 32 + 32 + r32) * 272 + kk * 2) = o; }
        LBAR();
#pragma unroll
        for (int st = 0; st < 4; ++st) { const bf16x8v kf = *(const LAS bf16x8v*)(KT + (kb * 32 + r32) * 144 + st * 32 + hi * 16);
            const bf16x8v va = *(const LAS bf16x8v*)(VT + (vb0 * 32 + r32) * 144 + st * 32 + hi * 16), vc = *(const LAS bf16x8v*)(VT + (vb0 * 32 + 32 + r32) * 144 + st * 32 + hi * 16);
            T0 = __builtin_amdgcn_mfma_f32_32x32x16_bf16(kf, va, T0, 0, 0, 0); T1 = __builtin_amdgcn_mfma_f32_32x32x16_bf16(kf, vc, T1, 0, 0, 0); }
#pragma unroll
        for (int g4 = 0; g4 < 4; ++g4) { const int kk = kb * 32 + 8 * g4 + 4 * hi; const f32x4 ta = *(const LAS f32x4*)(TOT + 256 + kk), tb = *(const LAS f32x4*)(TOT + 384 + kk);
            const float e0 = __expf(ta.x + tb.x), e1 = __expf(ta.y + tb.y), e2 = __expf(ta.z + tb.z), e3 = __expf(ta.w + tb.w);
            S0[4 * g4] = T0[4 * g4] * e0; S0[4 * g4 + 1] = T0[4 * g4 + 1] * e1; S0[4 * g4 + 2] = T0[4 * g4 + 2] * e2; S0[4 * g4 + 3] = T0[4 * g4 + 3] * e3;
            S1[4 * g4] = T1[4 * g4] * e0; S1[4 * g4 + 1] = T1[4 * g4 + 1] * e1; S1[4 * g4 + 2] = T1[4 * g4 + 2] * e2; S1[4 * g4 + 3] = T1[4 * g4 + 3] * e3; }
        asm volatile("" ::: "memory");
        {
            bf16x8v qf[8];
#pragma unroll
            for (int ks = 0; ks < 8; ++ks) qf[ks] = *(const LAS bf16x8v*)(QN + (ib * 32 + r32) * 272 + ks * 32 + hi * 16);
            asm volatile("" ::: "memory");
            f32x16 O;
#pragma unroll
            for (int r = 0; r < 16; ++r) O[r] = 0.f;
#pragma unroll
            for (int ks = 0; ks < 8; ++ks) { const bf16x8v sf = *(const LAS bf16x8v*)(ST + (vbo * 32 + r32) * 272 + ks * 32 + hi * 16); O = __builtin_amdgcn_mfma_f32_32x32x16_bf16(qf[ks], sf, O, 0, 0, 0); }
            asm volatile("" ::: "memory");
#pragma unroll 1
            for (int sb = 0; sb <= ib; ++sb) {
                f32x16 X;
#pragma unroll
                for (int r = 0; r < 16; ++r) X[r] = 0.f;
#pragma unroll
                for (int ks = 0; ks < 8; ++ks) { const bf16x8v kf = *(const LAS bf16x8v*)(KN + (sb * 32 + r32) * 272 + ks * 32 + hi * 16); X = __builtin_amdgcn_mfma_f32_32x32x16_bf16(kf, qf[ks], X, 0, 0, 0); }
                if (sb == ib) {
#pragma unroll
                    for (int r = 0; r < 16; ++r) { const int srow = (r & 3) + 8 * (r >> 2) + 4 * hi; if (srow > r32) X[r] = 0.f; }
                }
                asm volatile("" ::: "memory");
#pragma unroll
                for (int st = 0; st < 2; ++st) { v4u pw;
#pragma unroll
                    for (int q = 0; q < 4; ++q) pw[q] = cvt_pk_bf16(X[8 * st + 2 * q], X[8 * st + 2 * q + 1]);
                    const bf16x8v vf = *(const LAS bf16x8v*)(VT + (vbo * 32 + r32) * 144 + (sb * 32 + st * 16) * 2 + hi * 16);
                    O = __builtin_amdgcn_mfma_f32_32x32x16_bf16(__builtin_bit_cast(bf16x8v, pw), vf, O, 0, 0, 0); }
                asm volatile("" ::: "memory");
            }
            const int rb = HG_BASE(ch); float* op = OO + (size_t)rb * HW + hh * HK + vbo * 32 + r32;
#pragma unroll
            for (int r = 0; r < 16; ++r) { const int i = ib * 32 + (r & 3) + 8 * (r >> 2) + 4 * hi; op[(size_t)(dir ? 63 - i : i) * HW] = O[r]; }
        }
        asm volatile("s_waitcnt vmcnt(0)" ::: "memory"); LBAR();
    }
#undef LBAR
#undef HG_DMA
#undef HG_VLD
#undef HG_BASE
}

__device__ __forceinline__ void e8_phase(Frame& F, int j, int nrows) {
    fresh(F);
    unsigned char* ws = F.ws;
    const float* OF = (const float*)(ws + WS_OF); const float* OB = (const float*)(ws + WS_OB); const bf16* HG = (const bf16*)(ws + WS_HQ) + 4 * HSEG; bf16* MIX = (bf16*)(ws + WS_MIX);
    const float* gn = F.in[14] + j * HK;
    const int rpw = (nrows + F.G - 1) / F.G;
    for (int i = F.wave; i < rpw; i += NWAVES) {
        const int row = (int)blockIdx.x * rpw + i; if (row >= nrows) break;
        const int col = 8 * F.lane;
        const f32x4 a0 = *(const f32x4*)(OF + (size_t)row * HW + col), a1 = *(const f32x4*)(OF + (size_t)row * HW + col + 4), b0 = *(const f32x4*)(OB + (size_t)row * HW + col), b1 = *(const f32x4*)(OB + (size_t)row * HW + col + 4);
        f32x4 x0 = a0 + b0, x1 = a1 + b1;
        float s = (x0.x * x0.x + x0.y * x0.y) + (x0.z * x0.z + x0.w * x0.w) + (x1.x * x1.x + x1.y * x1.y) + (x1.z * x1.z + x1.w * x1.w);
        s += shx(s, F.lane, 1); s += shx(s, F.lane, 2); s += shx(s, F.lane, 4); s += shx(s, F.lane, 8);
        const float rstd = rsqrtf(s * (1.0f / HK) + EPS);
        const int vv = col & 127; const f32x4 g0 = *(const f32x4*)(gn + vv), g1 = *(const f32x4*)(gn + vv + 4);
        const v4u hg = *(const v4u*)(HG + (size_t)row * HW + col);
        x0 = x0 * rstd * g0; x1 = x1 * rstd * g1;
        v4u o; o.x = pk2(x0.x * siluf_(bflo(hg.x)), x0.y * siluf_(bfhi(hg.x))); o.y = pk2(x0.z * siluf_(bflo(hg.y)), x0.w * siluf_(bfhi(hg.y)));
        o.z = pk2(x1.x * siluf_(bflo(hg.z)), x1.y * siluf_(bfhi(hg.z))); o.w = pk2(x1.z * siluf_(bflo(hg.w)), x1.w * siluf_(bfhi(hg.w)));
        *(v4u*)(MIX + (size_t)row * DM + HW + col) = o;
    }
}

__device__ __forceinline__ void o12_phase(Frame& F, int nrows, const float* hl, const float* hc, const float* gn, const float* modl) {
    fresh(F);
    bf16* P = (bf16*)(F.ws + WS_POOLED);
    LAS unsigned char* XN = F.lds + RING_OFF;
    const int rpw = (nrows + F.G - 1) / F.G, rbase = (int)blockIdx.x * rpw, rend = (rbase + rpw < nrows) ? rbase + rpw : nrows;
    for (int r0 = rbase; r0 < rend; r0 += 32) {
        for (int sl = F.wave; sl < 48; sl += NWAVES) {
            const int row = r0 - 8 + sl; if (row < 0 || row >= nrows) continue;
            const float* hr = (row < M) ? hl + (size_t)row * DM : hc + (size_t)(row - M) * DM;
            f32x4 v[4]; float s = 0.f;
#pragma unroll
            for (int j = 0; j < 4; ++j) { v[j] = *(const f32x4*)(hr + 4 * F.lane + 256 * j); s += (v[j].x * v[j].x + v[j].y * v[j].y) + (v[j].z * v[j].z + v[j].w * v[j].w); }
            const float rstd = rsqrtf(wave_sum(s, F.lane) * (1.0f / DM) + EPS);
#pragma unroll
            for (int j = 0; j < 4; ++j) { v2u o; o.x = pg8::cvt_pk_bf16(v[j].x * rstd, v[j].y * rstd); o.y = pg8::cvt_pk_bf16(v[j].z * rstd, v[j].w * rstd); *(LAS v2u*)(XN + sl * 2048 + (4 * F.lane + 256 * j) * 2) = o; }
        }
        __syncthreads();
#pragma unroll 1
        for (int q = 0; q < 4; ++q) {
            const int t = r0 + F.wave * 4 + q; if (t >= rend) break;
            const bool lat = t < M; const int T = lat ? SEQ : CTXL; const int tt = lat ? t % SEQ : (t - M) % CTXL; const int bidx = lat ? t / SEQ : NB;
            const int sc0 = t - r0 + 8;
            const float* scp = modl + bidx * NMOD + DM;
#pragma unroll
            for (int g = 0; g < 4; ++g) {
                const int hw = 1 << g, col = 256 * g + 4 * F.lane;
                float s0 = 0.f, s1 = 0.f, s2 = 0.f, s3 = 0.f; int cnt = 0;
#pragma unroll
                for (int d = -hw; d < hw; ++d) { const bool ok = (tt + d >= 0) && (tt + d < T); const v2u x = *(const LAS v2u*)(XN + (sc0 + d) * 2048 + col * 2);
                    s0 += ok ? bflo(x.x) : 0.f; s1 += ok ? bfhi(x.x) : 0.f; s2 += ok ? bflo(x.y) : 0.f; s3 += ok ? bfhi(x.y) : 0.f; cnt += ok ? 1 : 0; }
                const v2u xc = *(const LAS v2u*)(XN + sc0 * 2048 + col * 2); const float ic = 1.0f / (float)cnt;
                const f32x4 gv = *(const f32x4*)(gn + col), sv = *(const f32x4*)(scp + col);
                v2u o; o.x = pg8::cvt_pk_bf16(gv.x * (sv.x + 1.0f) * (s0 * ic - bflo(xc.x)), gv.y * (sv.y + 1.0f) * (s1 * ic - bfhi(xc.x)));
                o.y = pg8::cvt_pk_bf16(gv.z * (sv.z + 1.0f) * (s2 * ic - bflo(xc.y)), gv.w * (sv.w + 1.0f) * (s3 * ic - bfhi(xc.y)));
                *(v2u*)(P + ((size_t)g * MT + t) * 256 + 4 * F.lane) = o;
            }
        }
        __syncthreads();
    }
}

__device__ __forceinline__ void o5_phase(Frame& F, int nrows) {
    fresh(F);
    unsigned char* ws = F.ws;
    const int* CNT = (const int*)(ws + WS_CNT); int* TST = (int*)(ws + WS_TST); const int* EIDX = (const int*)(ws + WS_EIDX); int* POS = (int*)(ws + WS_POS);
    const bf16* U = (const bf16*)(ws + WS_U); bf16* VG = (bf16*)(ws + WS_VG);
    LAS int* lc = (LAS int*)(F.lds + RING_OFF);
    LAS int* lbase = lc + 512 * 8;
    LAS int* lpos = lbase + 32;
    const int rpw = (nrows + F.G - 1) / F.G;
    for (int e = F.tid; e < F.G * 8; e += 512) lc[e] = CNT[e];
    __syncthreads();
    {
        const int e = F.wave; int c4[4]; int sum = 0;
#pragma unroll
        for (int q = 0; q < 4; ++q) { const int w = 4 * F.lane + q; c4[q] = (w < F.G) ? lc[w * 8 + e] : 0; sum += c4[q]; }
        int incl = sum;
#pragma unroll
        for (int o = 1; o < 64; o <<= 1) { const int t = __builtin_amdgcn_ds_bpermute((F.lane >= o ? F.lane - o : F.lane) << 2, incl); if (F.lane >= o) incl += t; }
        const int total = __builtin_amdgcn_readlane(incl, 63); int excl = incl - sum;
        const int myq = (int)blockIdx.x & 3; int pre = excl;
#pragma unroll
        for (int q = 0; q < 3; ++q) if (q < myq) pre += c4[q];
        if (F.lane == ((int)blockIdx.x >> 2)) { lbase[e] = pre; lbase[8 + e] = total; }
    }
    __syncthreads();
    if (F.tid == 0) {
        int ts = 0;
        for (int e = 0; e < 8; ++e) { const int pre = lbase[e], tot = lbase[8 + e]; lbase[e] = ts * 256 + pre; if (blockIdx.x == 0) TST[e] = ts; ts += (tot + 255) >> 8; }
        if (blockIdx.x == 0) TST[8] = ts;
    }
    __syncthreads();
    if (F.wave == 0) {
        int run[8];
#pragma unroll
        for (int e = 0; e < 8; ++e) run[e] = lbase[e];
        const int npairs = 2 * rpw;
        for (int c0 = 0; c0 < npairs; c0 += 64) {
            const int pl = c0 + F.lane; const int row = (int)blockIdx.x * rpw + (pl >> 1); const bool ok = pl < npairs && row < nrows;
            const int e = ok ? EIDX[2 * row + (pl & 1)] : -1; int mypos = 0;
#pragma unroll
            for (int x = 0; x < 8; ++x) { const unsigned long long mk = __ballot(e == x); const int below = __popcll(mk & ((1ull << F.lane) - 1ull)); if (e == x) mypos = run[x] + below; run[x] += __popcll(mk); }
            if (ok) { lpos[pl] = mypos; POS[2 * row + (pl & 1)] = mypos; }
        }
    }
    __syncthreads();
    for (int pl = F.wave; pl < 2 * rpw; pl += NWAVES) {
        const int row = (int)blockIdx.x * rpw + (pl >> 1); if (row >= nrows) break;
        const int p = lpos[pl];
        const v4u a = *(const v4u*)(U + (size_t)row * DM + 8 * F.lane), b = *(const v4u*)(U + (size_t)row * DM + 512 + 8 * F.lane);
        *(v4u*)(VG + (size_t)p * DM + 8 * F.lane) = a; *(v4u*)(VG + (size_t)p * DM + 512 + 8 * F.lane) = b;
    }
    __syncthreads();
}

__global__ void __launch_bounds__(NWAVES * 64, 2) mega_fwd(Args args) {
    extern __shared__ __attribute__((aligned(16))) unsigned char lds[];
    Frame F;
    F.lds = (LAS unsigned char*)lds;
    F.wave = __builtin_amdgcn_readfirstlane((int)threadIdx.x >> 6); fresh(F);
    F.G = gridDim.x; { const int bx = blockIdx.x; F.vcu = (F.G % 8 == 0) ? (bx % 8) * (F.G / 8) + bx / 8 : bx; }
    F.in = args.in; F.out = args.out; F.ws = args.ws;
    unsigned char* ws = args.ws;
    volatile LAS unsigned* MISC = (volatile LAS unsigned*)(F.lds + MISC_OFF);
    for (int u = F.tid; u < (LDS_BYTES - LDSCTL_OFF) / 4; u += NWAVES * 64) ((LAS unsigned*)(F.lds + LDSCTL_OFF))[u] = 0u;
    __syncthreads();
    XcdBarrier bar = xcd_barrier_post((unsigned*)(ws + WS_CTL) + CW_BAR, MISC + 8, F.wave);
#define GRID_BAR() do { xcd_barrier(bar); if (DUPMASK & 4096) xcd_barrier(bar); } while (0)
#ifndef ONLY
#define ONLY 0
#endif
#define PH(n) (ONLY == 0 || ONLY == (n))
#define REP(bit) for (int rep_ = 0; rep_ < ((DUPMASK & (bit)) ? 2 : 1); ++rep_)
    LAS unsigned char* ring = F.lds + RING_OFF;
    const float* MODV = (const float*)(ws + WS_MODV);
    float* HC = (float*)(ws + WS_HC);
    bf16* U = (bf16*)(ws + WS_U);

#if PH(20)
    REP(8192) p0_prologue(F);
#endif
    GRID_BAR();

    for (int lp = 0; lp < 2; ++lp) {
        const int le = 2 * lp, lo = 2 * lp + 1, j = lp;
        const bool ctx_out = (lp == 0);
        const int nro = ctx_out ? MT : M;
        const float* modE = MODV + (size_t)le * 17 * NMOD; const float* modO = MODV + (size_t)lo * 17 * NMOD;
        const float* hin_l = (lp == 0) ? args.in[0] : args.out; const float* hin_c = (lp == 0) ? args.in[2] : HC;
#if PH(1)
        {
            RowArgs A{}; A.hin_l = hin_l; A.hin_c = hin_c; A.hout_l = args.out; A.hout_c = HC; A.g = args.in[6] + (size_t)(le * 2 + 0) * DM; A.modl = modE; A.shoff = 0; A.scoff = DM; A.U = U;
            A.Y = (const bf16*)(ws + WS_VG); A.pos = (const int*)(ws + WS_POS); A.gate = (const float*)(ws + WS_GATE); A.modprev = MODV + (size_t)(le - 1) * 17 * NMOD;
            if (lp == 0) row_phase<false, 1, false>(F, A, MT); else row_phase<true, 1, false>(F, A, MT);
        }
#endif
        GRID_BAR();
#if PH(2)
        {
            pg8::Gemm g{U, (const bf16*)(ws + WS_WIN) + (size_t)j * INP * DM, DM, DM, DM}; pg8::StaticOrder S; S.init(MT, INP, F.G, (int)blockIdx.x);
            EpiIn E{(bf16*)(ws + WS_CQ), (bf16*)(ws + WS_KR), (bf16*)(ws + WS_CKV), (bf16*)(ws + WS_HQ)};
            REP(8) pg8::gemm_phase<EpiIn, pg8::StaticOrder, true>(ring, g, S, E, F.wave);
        }
#endif
        GRID_BAR();
#if PH(3)
        REP(4 | 32) e3_phase(F);
#endif
        GRID_BAR();
#if PH(4)
        {
            pg8::Gemm g{(const bf16*)(ws + WS_CQ), (const bf16*)(ws + WS_WUQ) + (size_t)j * 768 * QL, QL, QL, QL}; pg8::StaticOrder S; S.init(nro, 768, F.G, (int)blockIdx.x);
            EpiQ E{(bf16*)(ws + WS_QB), (const float*)(ws + WS_RSQ)};
            REP(8) pg8::gemm_phase<EpiQ, pg8::StaticOrder, true>(ring, g, S, E, F.wave);
        }
        {
            pg8::Gemm g{(const bf16*)(ws + WS_CKV), (const bf16*)(ws + WS_WUKV) + (size_t)j * 1024 * KVL, KVL, KVL, KVL}; pg8::StaticOrder S; S.init(MT, 1024, F.G, (int)blockIdx.x);
            EpiKV E{(bf16*)(ws + WS_KN), (bf16*)(ws + WS_VV), (const float*)(ws + WS_RSKV)};
            REP(8) pg8::gemm_phase<EpiKV, pg8::StaticOrder, true>(ring, g, S, E, F.wave);
        }
#endif
        GRID_BAR();
#if PH(6)
        REP(3) mix_phase(F, j, ctx_out);
#endif
        GRID_BAR();
#if PH(8)
        REP(4 | 64) e8_phase(F, j, nro);
#endif
        GRID_BAR();
#if PH(9)
        {
            pg8::Gemm g{(const bf16*)(ws + WS_MIX), (const bf16*)(ws + WS_WOUT) + (size_t)j * DM * DM, DM, DM, DM}; pg8::StaticOrder S; S.init(nro, DM, F.G, (int)blockIdx.x);
            EpiResid E{hin_l, hin_c, args.out, HC, modE, 2 * DM};
            pg8::gemm_phase<EpiResid, pg8::StaticOrder, true>(ring, g, S, E, F.wave);
        }
#endif
        GRID_BAR();
#if PH(10)
        {
            RowArgs A{}; A.hin_l = args.out; A.hin_c = HC; A.g = args.in[6] + (size_t)(le * 2 + 1) * DM; A.modl = modE; A.shoff = 3 * DM; A.scoff = 4 * DM; A.U = U;
            REP(4 | 128) row_phase<false, 1, false>(F, A, nro);
        }
#endif
        GRID_BAR();
#if PH(11)
        {
            pg8::Gemm g{U, (const bf16*)(ws + WS_WGU) + (size_t)j * 2 * DFF * DM, DM, DM, DM}; pg8::StaticOrder S; S.init(nro, 2 * DFF, F.G, (int)blockIdx.x);
            EpiGateUp E{(bf16*)(ws + WS_HID), DFF, 2 * DFF / 256, 0};
            REP(8) pg8::gemm_phase<EpiGateUp, pg8::StaticOrder, true>(ring, g, S, E, F.wave);
        }
#endif
        GRID_BAR();
#if PH(12)
        {
            pg8::Gemm g{(const bf16*)(ws + WS_HID), (const bf16*)(ws + WS_WDN) + (size_t)j * DM * DFF, DFF, DFF, DFF}; pg8::StaticOrder S; S.init(nro, DM, F.G, (int)blockIdx.x);
            EpiResid E{args.out, HC, args.out, HC, modE, 5 * DM};
            pg8::gemm_phase<EpiResid, pg8::StaticOrder, true>(ring, g, S, E, F.wave);
        }
#endif
        GRID_BAR();
#if PH(13)
        {
            RowArgs A{}; A.hin_l = args.out; A.hin_c = HC; A.g = args.in[6] + (size_t)(lo * 2 + 0) * DM; A.modl = modO; A.shoff = 0; A.scoff = DM; A.U = U;
            REP(2048) o12_phase(F, nro, args.out, HC, A.g, modO);
            REP(16) for (int e = 0; e < NE; ++e) {
                conv_matrix(F, args.in[23] + ((size_t)j * NE + e) * DM * DFE, DM, DFE, (bf16*)(ws + WS_MWGU) + (size_t)e * 2 * DFE * DM, DM, 2, 0, nullptr, 1.f);
                conv_matrix(F, args.in[24] + ((size_t)j * NE + e) * DM * DFE, DM, DFE, (bf16*)(ws + WS_MWGU) + (size_t)e * 2 * DFE * DM, DM, 2, 128, nullptr, 1.f);
                conv_matrix(F, args.in[25] + ((size_t)j * NE + e) * DFE * DM, DFE, DM, (bf16*)(ws + WS_MWDN) + (size_t)e * DM * DFE, DFE, 0, 0, nullptr, 1.f);
            }
        }
#endif
        GRID_BAR();
#if PH(15)
        {
            pg8::Gemm g{(const bf16*)(ws + WS_POOLED), (const bf16*)(ws + WS_WPOOL) + (size_t)j * 4 * 65536, 256, 256, 256};
            pg8::PoolOrder S{nro / 256, MT / 256, F.G, (int)blockIdx.x};
            EpiPool E{args.out, HC, modO, args.in[20] + (size_t)j * DM, args.in[21] + (size_t)j * DM, MT / 256};
            pg8::gemm_phase<EpiPool, pg8::PoolOrder, true>(ring, g, S, E, F.wave);
        }
#endif
        GRID_BAR();
#if PH(16)
        {
            RowArgs A{}; A.hin_l = args.out; A.hin_c = HC; A.g = args.in[6] + (size_t)(lo * 2 + 1) * DM; A.modl = modO; A.shoff = 3 * DM; A.scoff = 4 * DM; A.U = U;
            A.router = args.in[22] + (size_t)j * DM * NE; A.eidx = (int*)(ws + WS_EIDX); A.gout = (float*)(ws + WS_GATE); A.cnt = (int*)(ws + WS_CNT);
            REP(4 | 512) row_phase<false, 1, true>(F, A, nro);
        }
#endif
        GRID_BAR();
#if PH(17)
        REP(4 | 1024) o5_phase(F, nro);
#endif
        GRID_BAR();
#if PH(18)
        {
            const int* TST = (const int*)(ws + WS_TST);
            const int ts1 = TST[1], ts2 = TST[2], ts3 = TST[3], ts4 = TST[4], ts5 = TST[5], ts6 = TST[6], ts7 = TST[7], nT = TST[8];
            for (int c = 0; c * MOE_CH < nT; ++c) {
                const int t0 = c * MOE_CH, nrt = (nT - t0) < MOE_CH ? (nT - t0) : MOE_CH;
                {
                    pg8::Gemm g{(const bf16*)(ws + WS_VG), (const bf16*)(ws + WS_MWGU), DM, DM, DM};
                    pg8::MoeOrder S{t0, nrt, 2 * DFE / 256, F.G, (int)blockIdx.x, ts1, ts2, ts3, ts4, ts5, ts6, ts7};
                    EpiGateUp E{(bf16*)(ws + WS_HIDM), DFE, 2 * DFE / 256, t0 * 256};
                    REP(8) pg8::gemm_phase<EpiGateUp, pg8::MoeOrder, true>(ring, g, S, E, F.wave);
                }
                GRID_BAR();
                {
                    pg8::Gemm g{(const bf16*)(ws + WS_HIDM) - (size_t)t0 * 256 * DFE, (const bf16*)(ws + WS_MWDN), DFE, DFE, DFE};
                    pg8::MoeOrder S{t0, nrt, DM / 256, F.G, (int)blockIdx.x, ts1, ts2, ts3, ts4, ts5, ts6, ts7};
                    EpiY E{(bf16*)(ws + WS_VG), DM / 256};
                    REP(8) pg8::gemm_phase<EpiY, pg8::MoeOrder, true>(ring, g, S, E, F.wave);
                }
                GRID_BAR();
            }
        }
#endif
    }
#if PH(19)
    {
        RowArgs A{}; A.hin_l = args.out; A.hin_c = HC; A.hout_l = args.out; A.hout_c = HC; A.g = args.in[7];
        A.Y = (const bf16*)(ws + WS_VG); A.pos = (const int*)(ws + WS_POS); A.gate = (const float*)(ws + WS_GATE); A.modprev = MODV + (size_t)3 * 17 * NMOD;
        row_phase<true, 2, false>(F, A, M);
        if (xb_ld((unsigned*)(ws + WS_CTL) + CW_BAR + XB_TMO) != 0u) { __syncthreads(); const float qn = __builtin_nanf(""); for (int i = F.tid; i < 1024; i += 512) args.out[(size_t)blockIdx.x * 1024 + i] = qn; }
    }
#endif
}

extern "C" void kernel_launch(void* const* d_in, const int* in_sizes, int n_in, void* d_out, int out_size, void* d_ws, size_t ws_size, hipStream_t stream) {
    static int grid = 0;
    if (grid == 0) {
        if (n_in != 26 || out_size != M * DM || ws_size < WS_END) { fprintf(stderr, "kernel_launch: unexpected shapes (n_in %d out %d ws %zu)\n", n_in, out_size, ws_size); grid = -1; return; }
        int dev = 0, cus = 0, per_cu = 0;
        if (hipGetDevice(&dev) != hipSuccess || hipDeviceGetAttribute(&cus, hipDeviceAttributeMultiprocessorCount, dev) != hipSuccess) { grid = -1; return; }
        if (hipFuncSetAttribute((const void*)mega_fwd, hipFuncAttributeMaxDynamicSharedMemorySize, LDS_BYTES) != hipSuccess) { grid = -1; return; }
        if (hipOccupancyMaxActiveBlocksPerMultiprocessor(&per_cu, (const void*)mega_fwd, NWAVES * 64, LDS_BYTES) != hipSuccess || per_cu < 1) fprintf(stderr, "kernel_launch: occupancy query says %d\n", per_cu);
        (void)hipGetLastError();
        grid = cus > 256 ? 256 : cus;
    }
    if (grid < 0) return;
    if (hipMemsetAsync((char*)d_ws + WS_CTL, 0, CTL_ZERO_BYTES, stream) != hipSuccess) return;
    Args a{};
    for (int i = 0; i < 26; ++i) a.in[i] = (const float*)d_in[i];
    a.out = (float*)d_out; a.ws = (unsigned char*)d_ws;
    hipLaunchKernelGGL(mega_fwd, dim3(grid), dim3(NWAVES * 64), LDS_BYTES, stream, a);
}
```

```cpp
#include <hip/hip_runtime.h>
#ifndef DUPMASK
#define DUPMASK 0
#endif
#include <cstdio>
#include <cstdint>

__device__ __forceinline__ int lane_now() { int l; asm volatile("v_mbcnt_lo_u32_b32 %0, -1, 0\n\tv_mbcnt_hi_u32_b32 %0, -1, %0" : "=v"(l)); return l; }
namespace pg8 {
#define PG8_LAS __attribute__((address_space(3)))
typedef unsigned short bf16_t;
typedef short bf16x8 __attribute__((ext_vector_type(8)));
typedef float f32x4 __attribute__((ext_vector_type(4)));
typedef unsigned u32x4 __attribute__((ext_vector_type(4)));
constexpr int BM = 256, BK = 64, HALF = 128, HTB = HALF * BK * 2, STAGE_BYTES = 8 * HTB, NXCD = 8, WGM = 8;

__host__ __device__ __forceinline__ int lds_byte(int r, int c) { const int st = (r >> 4) * 2 + (c >> 5), rr = r & 15, cc = c & 31, ob = rr * 64 + cc * 2; return st * 1024 + (ob ^ (((ob >> 9) & 1) << 5)); }
__host__ __device__ __forceinline__ void stage_rc(int b, int& R, int& C) { const int st = b / 1024, sb = b % 1024, swz = sb ^ (((sb >> 9) & 1) << 5); R = (st >> 1) * 16 + swz / 64; C = (st & 1) * 32 + (swz % 64) / 2; }
__host__ __device__ __forceinline__ int perm32(int rho) { const int n = rho >> 4, i = rho & 15; return 8 * (i >> 2) + 4 * n + (i & 3); }

struct Unit { int pm, pn; };
struct Gemm { const bf16_t* A; const bf16_t* Bt; int lda, ldb, K; };

struct StaticOrder {
    int nM, nN, nwg, G, c;
    __device__ void init(int M, int N, int G_, int c_) { nM = M / BM; nN = N / BM; nwg = nM * nN; G = G_; c = c_; }
    __device__ bool next(int i, Unit& u) const {
        const long L = (long)i * G + c; if (L >= nwg) return false;
        int wgid = (int)L; { const int q = nwg / NXCD, r = nwg % NXCD, xcd = wgid % NXCD, off = wgid / NXCD; wgid = (xcd < r ? xcd * (q + 1) : r * (q + 1) + (xcd - r) * q) + off; }
        const int nig = WGM * nN, gid = wgid / nig, fm = gid * WGM, gsz = (nM - fm) < WGM ? (nM - fm) : WGM;
        u.pm = fm + ((wgid % nig) % gsz); u.pn = (wgid % nig) / gsz; return true;
    }
};
struct InOrder {
    StaticOrder lat; int nlat, nctx_ct, G, c;
    __device__ void init(bool full, int G_, int c_) { lat.init(32768, 3328, G_, c_); nlat = lat.nwg; nctx_ct = full ? 13 : 8; G = G_; c = c_; }
    __device__ bool next(int i, Unit& u) const {
        const int L = i * G + c; if (L < nlat) return lat.next(i, u);
        const int x = L - nlat; if (x >= 16 * nctx_ct) return false;
        const int rt = (nctx_ct == 13) ? x / 13 : x >> 3, q = x - rt * nctx_ct; u.pm = 128 + rt; u.pn = (nctx_ct == 13) ? q : (q < 2 ? q + 1 : q + 3); return true;
    }
};
struct PoolOrder {
    int nrt, talloc, G, c;
    __device__ bool next(int i, Unit& u) const { const int L = i * G + c; if (L >= 4 * nrt) return false; const int g = L / nrt, rt = L - g * nrt; u.pm = g * talloc + rt; u.pn = g; return true; }
};
struct MoeOrder {
    int t0, nrt, nct, G, c; int ts1, ts2, ts3, ts4, ts5, ts6, ts7;
    __device__ bool next(int i, Unit& u) const {
        const int nwg = nrt * nct; const int L = i * G + c; if (L >= nwg) return false;
        int wgid = L; { const int q = nwg / NXCD, r = nwg % NXCD, xcd = wgid % NXCD, off = wgid / NXCD; wgid = (xcd < r ? xcd * (q + 1) : r * (q + 1) + (xcd - r) * q) + off; }
        const int nig = WGM * nct, gid = wgid / nig, fm = gid * WGM, gsz = (nrt - fm) < WGM ? (nrt - fm) : WGM;
        const int rt = t0 + fm + ((wgid % nig) % gsz), ct = (wgid % nig) / gsz;
        const int e = (rt >= ts1) + (rt >= ts2) + (rt >= ts3) + (rt >= ts4) + (rt >= ts5) + (rt >= ts6) + (rt >= ts7);
        u.pm = rt; u.pn = e * nct + ct; return true;
    }
};

__device__ __forceinline__ unsigned cvt_pk_bf16(float lo, float hi) { unsigned r; asm volatile("v_cvt_pk_bf16_f32 %0, %1, %2" : "=v"(r) : "v"(lo), "v"(hi)); return r; }

template <class Epi, class Sched, bool ALIGN_EPI>
__device__ __forceinline__ void gemm_phase(PG8_LAS unsigned char* lds, const Gemm g, const Sched& S, const Epi& E, const int wid) {
    const int lane_ = lane_now();
    const int lane = lane_, tid = wid * 64 + lane, wr = wid >> 2, wc = wid & 3, fr = lane & 15, fq = lane >> 4;
    int K_ = g.K; asm volatile("" : "+s"(K_));
    const int K = K_, nt = K / BK;
    unsigned voffA[2], voffB[2];
#pragma unroll
    for (int i = 0; i < 2; ++i) { int R, C; stage_rc(tid * 16 + i * 8192, R, C); const int Rb = Epi::PERM ? ((R & ~31) + perm32(R & 31)) : R;
        voffA[i] = (unsigned)(R * g.lda + C) * 2u; voffB[i] = (unsigned)(Rb * g.ldb + C) * 2u; }
    const size_t kstep = (size_t)(BK * 2);
    const size_t hstepA = (size_t)HALF * g.lda * 2, hstepB = (size_t)HALF * g.ldb * 2;
    const size_t tstepA = 2 * hstepA, tstepB = 2 * hstepB;
    const unsigned ldsw = (unsigned)wid * 1024u;
    const int aoff = lds_byte(wr * 64 + fr, fq * 8), boff = lds_byte(wc * 32 + fr, fq * 8);
#define PG8_SA(b, h) (((b) * 2 + (h)) * HTB)
#define PG8_SB(b, h) ((4 + (b) * 2 + (h)) * HTB)
#define PG8_STAGE(bufoff, gbase, voff) do { _Pragma("unroll") for (int _i = 0; _i < 2; ++_i) \
        __builtin_amdgcn_global_load_lds((const unsigned*)((const char*)(gbase) + (voff)[_i]), (PG8_LAS unsigned*)(lds + (bufoff) + ldsw + _i * 8192), 16, 0, 0); } while (0)
#define PG8_LDA(dst, b, h) do { _Pragma("unroll") for (int m = 0; m < 4; ++m) _Pragma("unroll") for (int k = 0; k < 2; ++k) dst[m][k] = *(const PG8_LAS bf16x8*)(lds + PG8_SA(b, h) + aoff + m * 2048 + k * 1024); } while (0)
#define PG8_LDB(dst, b, h) do { _Pragma("unroll") for (int n = 0; n < 2; ++n) _Pragma("unroll") for (int k = 0; k < 2; ++k) dst[n][k] = *(const PG8_LAS bf16x8*)(lds + PG8_SB(b, h) + boff + n * 2048 + k * 1024); } while (0)
#define PG8_MMA(ai, bj, At, Bt) do { __builtin_amdgcn_s_setprio(1); _Pragma("unroll") for (int m = 0; m < 4; ++m) _Pragma("unroll") for (int n = 0; n < 2; ++n) _Pragma("unroll") for (int k = 0; k < 2; ++k) \
        acc[ai][bj][m][n] = __builtin_amdgcn_mfma_f32_16x16x32_bf16(Bt[n][k], At[m][k], acc[ai][bj][m][n], 0, 0, 0); __builtin_amdgcn_s_setprio(0); } while (0)
#define PG8_WAIT_V(n) asm volatile("s_waitcnt vmcnt(" #n ")" ::: "memory")
#define PG8_WAIT_L(n) asm volatile("s_waitcnt lgkmcnt(" #n ")" ::: "memory")
#define PG8_BAR __builtin_amdgcn_s_barrier()
#define PG8_SCHED __builtin_amdgcn_sched_barrier(0)
    Unit cur, nxt; int ui = 0;
    if (!S.next(0, cur)) return;
    f32x4 acc[2][2][4][2];
#pragma unroll
    for (int a = 0; a < 2; ++a)
#pragma unroll
        for (int b = 0; b < 2; ++b)
#pragma unroll
            for (int m = 0; m < 4; ++m)
#pragma unroll
                for (int n = 0; n < 2; ++n) acc[a][b][m][n] = (f32x4){0.f, 0.f, 0.f, 0.f};
    bf16x8 At[4][2], B0[2][2], B1[2][2];
    const char* cA = (const char*)g.A + (size_t)cur.pm * tstepA; const char* cB = (const char*)g.Bt + (size_t)cur.pn * tstepB;
    PG8_STAGE(PG8_SB(0, 0), cB, voffB); PG8_STAGE(PG8_SB(0, 1), cB + hstepB, voffB); PG8_STAGE(PG8_SA(0, 0), cA, voffA); PG8_STAGE(PG8_SA(0, 1), cA + hstepA, voffA);
    if (wr == 1) PG8_BAR;
    PG8_WAIT_V(2); PG8_BAR;
    PG8_STAGE(PG8_SB(1, 0), cB + kstep, voffB); PG8_STAGE(PG8_SA(1, 0), cA + kstep, voffA); PG8_STAGE(PG8_SB(1, 1), cB + hstepB + kstep, voffB);
    PG8_WAIT_V(6); PG8_BAR;
    for (;;) {
        const bool has_next = S.next(ui + 1, nxt);
        const char* nA = has_next ? (const char*)g.A + (size_t)nxt.pm * tstepA : cA; const char* nB = has_next ? (const char*)g.Bt + (size_t)nxt.pn * tstepB : cB;
#pragma unroll 1
        for (int t = 0; t < nt; t += 2) {
            const bool last = (t == nt - 2);
            const char* a1 = cA + (size_t)(t + 1) * kstep;
            const char* a2 = last ? nA : cA + (size_t)(t + 2) * kstep; const char* b2 = last ? nB : cB + (size_t)(t + 2) * kstep;
            const char* a3 = a2 + kstep; const char* b3 = b2 + kstep;
            PG8_LDB(B0, 0, 0); PG8_LDB(B1, 0, 1); PG8_SCHED; PG8_LDA(At, 0, 0); PG8_STAGE(PG8_SA(1, 1), a1 + hstepA, voffA);
            PG8_WAIT_V(8); PG8_WAIT_L(0); PG8_BAR; PG8_MMA(0, 0, At, B0); PG8_MMA(0, 1, At, B1); PG8_BAR; PG8_SCHED;
            PG8_LDA(At, 0, 1); PG8_STAGE(PG8_SB(0, 0), b2, voffB); PG8_STAGE(PG8_SB(0, 1), b2 + hstepB, voffB); PG8_STAGE(PG8_SA(0, 0), a2, voffA);
            PG8_WAIT_V(8); PG8_WAIT_L(0); PG8_BAR; PG8_MMA(1, 0, At, B0); PG8_MMA(1, 1, At, B1); PG8_BAR; PG8_SCHED;
            PG8_LDB(B0, 1, 0); PG8_LDB(B1, 1, 1); PG8_SCHED; PG8_LDA(At, 1, 0); PG8_STAGE(PG8_SA(0, 1), a2 + hstepA, voffA);
            PG8_WAIT_V(8); PG8_WAIT_L(0); PG8_BAR; PG8_MMA(0, 0, At, B0); PG8_MMA(0, 1, At, B1); PG8_BAR; PG8_SCHED;
            PG8_LDA(At, 1, 1); PG8_STAGE(PG8_SB(1, 0), b3, voffB); PG8_STAGE(PG8_SB(1, 1), b3 + hstepB, voffB); PG8_STAGE(PG8_SA(1, 0), a3, voffA);
            PG8_WAIT_V(8); PG8_WAIT_L(0); PG8_BAR; PG8_MMA(1, 0, At, B0); PG8_MMA(1, 1, At, B1); PG8_BAR; PG8_SCHED;
        }
        if constexpr (ALIGN_EPI) { if (wr == 0) PG8_BAR; }
        E(acc, cur, wr, wc, fr, fq);
        if (!has_next) break;
#pragma unroll
        for (int a = 0; a < 2; ++a)
#pragma unroll
            for (int b = 0; b < 2; ++b)
#pragma unroll
                for (int m = 0; m < 4; ++m)
#pragma unroll
                    for (int n = 0; n < 2; ++n) acc[a][b][m][n] = (f32x4){0.f, 0.f, 0.f, 0.f};
        cur = nxt; cA = nA; cB = nB; ++ui;
        if constexpr (ALIGN_EPI) { if (wr == 1) PG8_BAR; }
    }
    PG8_WAIT_V(0);
    if constexpr (!ALIGN_EPI) { if (wr == 0) PG8_BAR; }
    PG8_BAR;
#undef PG8_SA
#undef PG8_SB
#undef PG8_STAGE
#undef PG8_LDA
#undef PG8_LDB
#undef PG8_MMA
#undef PG8_WAIT_V
#undef PG8_WAIT_L
#undef PG8_BAR
#undef PG8_SCHED
}
}

constexpr int NWAVES = 8;
constexpr int DM = 1024, NB = 16, SEQ = 2048, CTXL = 256;
constexpr int M = NB * SEQ, MC = NB * CTXL, MT = M + MC;
constexpr int QL = 384, KVL = 256, ROPE = 32, HW = 512, NH = 8, QKD = 96, VD = 64;
constexpr int INW = 3232, INP = 3328;
constexpr int DFF = 2816, NE = 8, DFE = 3584, NMOD = 6 * DM;
constexpr int NHH = 4, HK = 128; constexpr int NKEY = SEQ + CTXL;
constexpr float EPS = 1e-6f;
constexpr int MAXT = 296;
constexpr int MOE_CH = 128;

constexpr size_t MiB = 1u << 20;
constexpr size_t WS_CTL = 0, CTL_ZERO_BYTES = 1 * MiB;
constexpr size_t WS_MODV = 1 * MiB;
constexpr size_t WS_ROPE = 3 * MiB;
constexpr size_t WS_CNT = 3 * MiB + 64 * 1024;
constexpr size_t WS_TST = 3 * MiB + 128 * 1024;
constexpr size_t WS_EIDX = 4 * MiB, WS_GATE = 4 * MiB + 512 * 1024, WS_POS = 5 * MiB;
constexpr size_t WS_RSQ = 6 * MiB, WS_RSKV = 6 * MiB + 256 * 1024;
constexpr size_t WS_HC = 8 * MiB;
constexpr size_t WS_WIN = 24 * MiB, WS_WUQ = 37 * MiB, WS_WUKV = 39 * MiB, WS_WOUT = 40 * MiB, WS_WGU = 44 * MiB, WS_WDN = 66 * MiB, WS_WPOOL = 77 * MiB;
constexpr size_t WS_U = 80 * MiB;
constexpr size_t WS_X = 152 * MiB;
constexpr size_t WS_CQ = WS_X, WS_CKV = 179 * MiB, WS_KR = 197 * MiB, WS_KRR = 200 * MiB, WS_HQ = 203 * MiB  ;
constexpr size_t WS_QB = 383 * MiB, WS_KN = 437 * MiB, WS_VV = 473 * MiB, WS_OF = 509 * MiB, WS_OB = 581 * MiB, WS_MIX = 653 * MiB, WS_HID = WS_X;
constexpr size_t WS_MWGU = WS_X, WS_MWDN = 264 * MiB, WS_POOLED = 320 * MiB, WS_VG = 392 * MiB, WS_HIDM = 540 * MiB, WS_END = 800 * MiB;
constexpr size_t HSEG = (size_t)MT * HW;
static_assert(WS_HQ + 5 * HSEG * 2 <= WS_QB && WS_MIX + (size_t)MT * DM * 2 <= WS_END && WS_HID + (size_t)MT * DFF * 2 <= WS_QB, "ws map even");
static_assert(WS_HIDM + (size_t)MOE_CH * 256 * DFE * 2 <= WS_END && WS_VG + (size_t)MAXT * 256 * DM * 2 <= WS_HIDM && WS_MWDN + (size_t)NE * DM * DFE * 2 <= WS_POOLED && WS_MWGU + (size_t)NE * 2 * DFE * DM * 2 <= WS_MWDN, "ws map odd");
constexpr int CW_BAR = 4096;

constexpr int RING_OFF = 0, RING_BYTES = 141312;
constexpr int LDSCTL_OFF = RING_BYTES, MISC_OFF = LDSCTL_OFF + 320;
constexpr int LDS_BYTES = 147456;

#define GAS __attribute__((address_space(1)))
#define LAS __attribute__((address_space(3)))
typedef unsigned short bf16;
typedef unsigned v4u __attribute__((ext_vector_type(4)));
typedef unsigned v2u __attribute__((ext_vector_type(2)));
typedef float f32x4 __attribute__((ext_vector_type(4)));
typedef GAS unsigned gu32;
#define RLX_AGENT __ATOMIC_RELAXED, __HIP_MEMORY_SCOPE_AGENT
#define LDS_WAIT() asm volatile("s_waitcnt lgkmcnt(0)" ::: "memory")
__device__ __forceinline__ unsigned f2bf(float f) { unsigned u = __builtin_bit_cast(unsigned, f); return (u + 0x7fffu + ((u >> 16) & 1u)) >> 16; }
__device__ __forceinline__ unsigned pk2(float lo, float hi) { return f2bf(lo) | (f2bf(hi) << 16); }
__device__ __forceinline__ float bf2f(unsigned short b) { return __uint_as_float((unsigned)b << 16); }
__device__ __forceinline__ float bflo(unsigned w) { return __uint_as_float(w << 16); }
__device__ __forceinline__ float bfhi(unsigned w) { return __uint_as_float(w & 0xffff0000u); }
__device__ __forceinline__ float sigmoidf_(float x) { return 1.0f / (1.0f + __expf(-x)); }
__device__ __forceinline__ float siluf_(float x) { return x * __builtin_amdgcn_rcpf(1.0f + __expf(-x)); }

#define XB_TMO      128
#define XB_XCNT(j)  (256  + 64 * (j))
#define XB_XSUB(j)  (1280 + 64 * (j))
#define XB_XGEN(j)  (2304 + 64 * (j))
#define XB_TOP      3328
#define XB_TOPGEN   3392
#define XCD_BAR_WORDS 3456
#define XB_SPIN_CAP (1u << 22)
__device__ __forceinline__ unsigned xb_ld(unsigned* p)              { return __hip_atomic_load(p, __ATOMIC_RELAXED, __HIP_MEMORY_SCOPE_AGENT); }
__device__ __forceinline__ unsigned xb_add(unsigned* p, unsigned v) { return __hip_atomic_fetch_add(p, v, __ATOMIC_RELAXED, __HIP_MEMORY_SCOPE_AGENT); }
__device__ __forceinline__ unsigned xb_xcc_id() { return (unsigned)__builtin_amdgcn_s_getreg((3 << 11) | 20) & 0xFu; }
#define XB_SPIN(cond, bar) do { unsigned _sp = 0; while (cond) { __builtin_amdgcn_s_sleep(1); \
    if ((++_sp & 255u) == 0u) { if (xb_ld(&(bar)[XB_TMO])) break; if (_sp > XB_SPIN_CAP) { atomicAdd(&(bar)[XB_TMO], 1u); break; } } } } while (0)
struct XcdBarrier { unsigned* bar; unsigned x; volatile LAS unsigned* st; int wave; };
__device__ __forceinline__ bool xb_leader(int wave) { return wave == 0 && lane_now() == 0; }
__device__ __forceinline__ XcdBarrier xcd_barrier_post(unsigned* bar, volatile LAS unsigned* st, int wave) {
    XcdBarrier b; b.bar = bar; b.x = xb_xcc_id(); b.st = st; b.wave = wave;
    if (xb_leader(wave)) (void)xb_add(&bar[XB_XCNT(b.x)], 1u);
    return b;
}
__device__ __forceinline__ void xcd_barrier_complete(unsigned* bar, unsigned x, unsigned& nloc, unsigned& nx) {
    const unsigned G = gridDim.x * gridDim.y * gridDim.z;
    unsigned sum, cnt, mine, sp = 0u;
    for (;;) {
        sum = 0u; cnt = 0u; mine = 0u;
#pragma unroll
        for (unsigned j = 0; j < 16; ++j) { const unsigned c = xb_ld(&bar[XB_XCNT(j)]); sum += c; cnt += (c > 0u) ? 1u : 0u; mine = (j == x) ? c : mine; }
        if (sum == G) break;
        __builtin_amdgcn_s_sleep(1);
        if ((++sp & 255u) == 0u) { if (xb_ld(&bar[XB_TMO])) break; if (sp > XB_SPIN_CAP) { atomicAdd(&bar[XB_TMO], 1u); break; } }
    }
    nloc = mine > 0u ? mine : 1u; nx = cnt > 0u ? cnt : 1u;
}
__device__ __forceinline__ void xcd_barrier(const XcdBarrier& b) {
    asm volatile("s_waitcnt vmcnt(0)" ::: "memory");
    __syncthreads();
    if (xb_leader(b.wave)) {
        unsigned* bar = b.bar; asm volatile("" : "+s"(bar));
        __builtin_amdgcn_s_waitcnt(0);
        unsigned nloc = b.st[0], nx = b.st[1];
        if (nloc == 0u) { xcd_barrier_complete(bar, b.x, nloc, nx); b.st[0] = nloc; b.st[1] = nx; }
        const unsigned old = xb_add(&bar[XB_XSUB(b.x)], 1u);
        const unsigned gen = old / nloc;
        if (old + 1u == (gen + 1u) * nloc) {
            __builtin_amdgcn_fence(__ATOMIC_RELEASE, "agent");
            asm volatile("s_waitcnt vmcnt(0)" ::: "memory");
            const unsigned og = xb_add(&bar[XB_TOP], 1u);
            const unsigned tg = og / nx;
            if (og + 1u == (tg + 1u) * nx) xb_add(&bar[XB_TOPGEN], 1u);
            else XB_SPIN(xb_ld(&bar[XB_TOPGEN]) == tg, bar);
            __builtin_amdgcn_fence(__ATOMIC_ACQUIRE, "agent");
            xb_add(&bar[XB_XGEN(b.x)], 1u);
            asm volatile("s_waitcnt vmcnt(0)" ::: "memory");
        } else {
            XB_SPIN(xb_ld(&bar[XB_XGEN(b.x)]) == gen, bar);
            __builtin_amdgcn_fence(__ATOMIC_ACQUIRE, "agent");
            asm volatile("s_waitcnt vmcnt(0)" ::: "memory");
        }
    }
    __syncthreads();
}

struct Args { const float* in[26]; float* out; unsigned char* ws; };
struct Frame {
    LAS unsigned char* lds;
    int tid, lane, wave, G, vcu;
    const float* const* in; float* out; unsigned char* ws;
};
__device__ __forceinline__ float shx(float v, int lane, int m) { return __int_as_float(__builtin_amdgcn_ds_bpermute((lane ^ m) << 2, __float_as_int(v))); }
__device__ __forceinline__ float wave_sum(float v, int lane) {
#pragma unroll
    for (int o = 1; o < 64; o <<= 1) v += shx(v, lane, o);
    return v;
}

__device__ __forceinline__ void fresh(Frame& F) { const int l = lane_now(); F.lane = l; F.tid = F.wave * 64 + l; }

__device__ __forceinline__ void conv_item(const float* W, int ldw, bf16* WT, int ldd, int k0, int n0, int drow0, const float* kscale, float gscale, LAS float* scr, int lane) {
    float wv[32];
#pragma unroll
    for (int i = 0; i < 32; ++i) { const int kk = 2 * i + (lane >> 5); wv[i] = W[(size_t)(k0 + kk) * ldw + n0 + (lane & 31)]; }
#pragma unroll
    for (int i = 0; i < 32; ++i) { const int kk = 2 * i + (lane >> 5); float w = wv[i]; if (kscale) w *= kscale[k0 + kk]; scr[kk * 33 + (lane & 31)] = w * gscale; }
    LDS_WAIT(); asm volatile("" ::: "memory");
    const int c = lane & 7;
#pragma unroll
    for (int j = 0; j < 4; ++j) { const int n = (lane >> 3) + 8 * j; const LAS float* s = scr + (8 * c) * 33 + n;
        v4u o; o.x = pk2(s[0 * 33], s[1 * 33]); o.y = pk2(s[2 * 33], s[3 * 33]); o.z = pk2(s[4 * 33], s[5 * 33]); o.w = pk2(s[6 * 33], s[7 * 33]);
        *(v4u*)(WT + (size_t)(drow0 + n) * ldd + k0 + 8 * c) = o; }
    LDS_WAIT(); asm volatile("" ::: "memory");
}
__device__ __forceinline__ int conv_rowmap(int mode, int n0, int off) {
    if (mode == 0) return n0 + off;
    if (mode == 1) { if (n0 < 384) return n0; if (n0 < 640) return 512 + (n0 - 384); if (n0 < 672) return 384; return 768 + (n0 - 672); }
    return 256 * (n0 >> 7) + (n0 & 127) + off;
}
__device__ __forceinline__ void conv_matrix(Frame& F, const float* W, int K, int N, bf16* WT, int ldd, int mode, int off, const float* kscale, float gscale) {
    LAS float* scr = (LAS float*)(F.lds + RING_OFF + F.wave * 16384);
    const int gw = F.vcu * NWAVES + F.wave, NGW = F.G * NWAVES;
    const int nblk = N / 32, nitems = (K / 64) * nblk;
    for (int it = gw; it < nitems; it += NGW) { const int kb = it / nblk, nb = it % nblk; conv_item(W, N, WT, ldd, 64 * kb, 32 * nb, conv_rowmap(mode, 32 * nb, off), kscale, gscale, scr, F.lane); }
}

__device__ __forceinline__ int row_bidx(int row) { return row < M ? row / SEQ : NB; }

struct RowArgs {
    const float* hin_l; const float* hin_c; float* hout_l; float* hout_c;
    const float* g;
    const float* modl;
    int shoff, scoff;
    bf16* U;
    const bf16* Y; const int* pos; const float* gate; const float* modprev;
    const float* router; int* eidx; float* gout; int* cnt;
};
template <bool COMBINE, int OUTMODE, bool ROUTER>
__device__ __forceinline__ void row_phase(Frame& F, const RowArgs& A, int nrows) {
    fresh(F);
    const int rpw = (nrows + F.G - 1) / F.G;
    LAS int* lcnt = (LAS int*)(F.lds + RING_OFF);
    if (ROUTER) { if (F.tid < 8) lcnt[F.tid] = 0; __syncthreads(); }
    const int rbase = (int)blockIdx.x * rpw, rend = (rbase + rpw < nrows) ? rbase + rpw : nrows;
#define ROWPTR(r_) (((r_) < M) ? A.hin_l + (size_t)(r_) * DM : A.hin_c + (size_t)((r_) - M) * DM)
    f32x4 rw[16][2];
    if (ROUTER) {
#pragma unroll
        for (int j = 0; j < 4; ++j)
#pragma unroll
            for (int q = 0; q < 4; ++q) { const int col = 4 * F.lane + 256 * j + q; rw[4 * j + q][0] = *(const f32x4*)(A.router + (size_t)col * 8); rw[4 * j + q][1] = *(const f32x4*)(A.router + (size_t)col * 8 + 4); }
    }
    int row = rbase + F.wave;
    f32x4 v[4], vn[4];
    if (row < rend) { const float* hr = ROWPTR(row);
#pragma unroll
        for (int j = 0; j < 4; ++j) v[j] = *(const f32x4*)(hr + 4 * F.lane + 256 * j); }
    for (; row < rend; row += NWAVES) {
        const bool lat = row < M; const int bidx = lat ? row / SEQ : NB;
        const int rnext = row + NWAVES;
        if (rnext < rend) { const float* hr = ROWPTR(rnext);
#pragma unroll
            for (int j = 0; j < 4; ++j) vn[j] = *(const f32x4*)(hr + 4 * F.lane + 256 * j); }
        if (COMBINE) {
            const int pa = A.pos[2 * row], pb = A.pos[2 * row + 1]; const float ga = A.gate[2 * row], gb = A.gate[2 * row + 1];
            const float* g2 = A.modprev + bidx * NMOD + 5 * DM;
#pragma unroll
            for (int j = 0; j < 4; ++j) { const int col = 4 * F.lane + 256 * j;
                const v2u ya = *(const v2u*)(A.Y + (size_t)pa * DM + col), yb = *(const v2u*)(A.Y + (size_t)pb * DM + col); const f32x4 gv = *(const f32x4*)(g2 + col);
                v[j].x += gv.x * (ga * bflo(ya.x) + gb * bflo(yb.x)); v[j].y += gv.y * (ga * bfhi(ya.x) + gb * bfhi(yb.x));
                v[j].z += gv.z * (ga * bflo(ya.y) + gb * bflo(yb.y)); v[j].w += gv.w * (ga * bfhi(ya.y) + gb * bfhi(yb.y)); }
            if (OUTMODE != 2) { float* ho = lat ? A.hout_l + (size_t)row * DM : A.hout_c + (size_t)(row - M) * DM;
#pragma unroll
                for (int j = 0; j < 4; ++j) *(f32x4*)(ho + 4 * F.lane + 256 * j) = v[j]; }
        }
        float s = 0.f;
#pragma unroll
        for (int j = 0; j < 4; ++j) s += (v[j].x * v[j].x + v[j].y * v[j].y) + (v[j].z * v[j].z + v[j].w * v[j].w);
        const float rstd = rsqrtf(wave_sum(s, F.lane) * (1.0f / DM) + EPS);
        if (OUTMODE == 2) {
            float* ho = A.hout_l + (size_t)row * DM;
#pragma unroll
            for (int j = 0; j < 4; ++j) { const int col = 4 * F.lane + 256 * j; const f32x4 gv = *(const f32x4*)(A.g + col); *(f32x4*)(ho + col) = v[j] * rstd * gv; }
        } else {
            const float* sh = A.modl + bidx * NMOD + A.shoff; const float* sc = A.modl + bidx * NMOD + A.scoff;
            float lg[8];
            if (ROUTER) {
#pragma unroll
                for (int e = 0; e < 8; ++e) lg[e] = 0.f;
            }
#pragma unroll
            for (int j = 0; j < 4; ++j) { const int col = 4 * F.lane + 256 * j; const f32x4 gv = *(const f32x4*)(A.g + col), shv = *(const f32x4*)(sh + col), scv = *(const f32x4*)(sc + col);
                f32x4 y = v[j] * rstd * gv * (scv + 1.0f) + shv;
                v2u o; o.x = pg8::cvt_pk_bf16(y.x, y.y); o.y = pg8::cvt_pk_bf16(y.z, y.w); *(v2u*)(A.U + (size_t)row * DM + col) = o;
                if (ROUTER) {
#pragma unroll
                    for (int q = 0; q < 4; ++q) { const f32x4 r0 = rw[4 * j + q][0], r1 = rw[4 * j + q][1]; const float yy = y[q];
                        lg[0] += yy * r0.x; lg[1] += yy * r0.y; lg[2] += yy * r0.z; lg[3] += yy * r0.w; lg[4] += yy * r1.x; lg[5] += yy * r1.y; lg[6] += yy * r1.z; lg[7] += yy * r1.w; } }
            }
            if (ROUTER) {
                const int b5 = F.lane >> 5, b4 = (F.lane >> 4) & 1, b3 = (F.lane >> 3) & 1; float a4[4], c2[2];
#pragma unroll
                for (int q = 0; q < 4; ++q) { const float mine = b5 ? lg[4 + q] : lg[q], oth = b5 ? lg[q] : lg[4 + q]; a4[q] = mine + shx(oth, F.lane, 32); }
#pragma unroll
                for (int q = 0; q < 2; ++q) { const float mine = b4 ? a4[2 + q] : a4[q], oth = b4 ? a4[q] : a4[2 + q]; c2[q] = mine + shx(oth, F.lane, 16); }
                float d1 = (b3 ? c2[1] : c2[0]) + shx(b3 ? c2[0] : c2[1], F.lane, 8);
                d1 += shx(d1, F.lane, 4); d1 += shx(d1, F.lane, 2); d1 += shx(d1, F.lane, 1);
#pragma unroll
                for (int e = 0; e < 8; ++e) lg[e] = __int_as_float(__builtin_amdgcn_readlane(__float_as_int(d1), 8 * e));
                int i0 = 0; float v0 = lg[0];
#pragma unroll
                for (int e = 1; e < 8; ++e) if (lg[e] > v0) { v0 = lg[e]; i0 = e; }
                int i1 = -1; float v1 = -INFINITY;
#pragma unroll
                for (int e = 0; e < 8; ++e) if (e != i0 && lg[e] > v1) { v1 = lg[e]; i1 = e; }
                const float g0 = 1.0f / (1.0f + __expf(v1 - v0));
                if (F.lane == 0) { A.eidx[2 * row] = i0; A.eidx[2 * row + 1] = i1; A.gout[2 * row] = g0; A.gout[2 * row + 1] = 1.0f - g0; atomicAdd((int*)&lcnt[i0], 1); atomicAdd((int*)&lcnt[i1], 1); }
            }
        }
#pragma unroll
        for (int j = 0; j < 4; ++j) v[j] = vn[j];
    }
#undef ROWPTR
    if (ROUTER) { __syncthreads(); if (F.tid < 8) A.cnt[blockIdx.x * 8 + F.tid] = lcnt[F.tid]; __syncthreads(); }
}

using pg8::Unit; using pg8::cvt_pk_bf16;
__device__ __forceinline__ v4u pack8(const f32x4& a, const f32x4& b) { v4u w; w.x = cvt_pk_bf16(a[0], a[1]); w.y = cvt_pk_bf16(a[2], a[3]); w.z = cvt_pk_bf16(b[0], b[1]); w.w = cvt_pk_bf16(b[2], b[3]); return w; }
struct EpiIn {
    static constexpr bool PERM = true;
    bf16 *CQ, *KR, *CKV, *H5;
    __device__ __forceinline__ void operator()(const f32x4 (&acc)[2][2][4][2], const Unit& u, int wr, int wc, int fr, int fq) const {
        const int row0 = u.pm * 256 + wr * 64 + fr;
#pragma unroll
        for (int bj = 0; bj < 2; ++bj) {
            const int col = u.pn * 256 + bj * 128 + wc * 32 + 8 * fq;
            bf16* base; int ld;
            if (col < 384) { base = CQ + col; ld = QL; }
            else if (col < 416) { base = KR + (col - 384); ld = ROPE; }
            else if (col < 512) { base = nullptr; ld = 0; }
            else if (col < 768) { base = CKV + (col - 512); ld = KVL; }
            else { const int c2 = col - 768; base = H5 + (size_t)(c2 >> 9) * HSEG + (c2 & 511); ld = HW; }
            if (base) {
#pragma unroll
                for (int ai = 0; ai < 2; ++ai)
#pragma unroll
                    for (int m = 0; m < 4; ++m) { const int row = row0 + ai * 128 + m * 16; *(v4u*)(base + (size_t)row * ld) = pack8(acc[ai][bj][m][0], acc[ai][bj][m][1]); }
            }
        }
    }
};
struct EpiQ {
    static constexpr bool PERM = true;
    bf16* O; const float* rs;
    __device__ __forceinline__ void operator()(const f32x4 (&acc)[2][2][4][2], const Unit& u, int wr, int wc, int fr, int fq) const {
        const int row0 = u.pm * 256 + wr * 64 + fr;
#pragma unroll
        for (int ai = 0; ai < 2; ++ai)
#pragma unroll
            for (int m = 0; m < 4; ++m) { const int row = row0 + ai * 128 + m * 16; const float sc = rs[row];
#pragma unroll
                for (int bj = 0; bj < 2; ++bj) { const int col = u.pn * 256 + bj * 128 + wc * 32 + 8 * fq; *(v4u*)(O + (size_t)row * 768 + col) = pack8(acc[ai][bj][m][0] * sc, acc[ai][bj][m][1] * sc); } }
    }
};
struct EpiKV {
    static constexpr bool PERM = true;
    bf16* KNp; bf16* VTp; const float* rs;
    __device__ __forceinline__ void operator()(const f32x4 (&acc)[2][2][4][2], const Unit& u, int wr, int wc, int fr, int fq) const {
        const int row0 = u.pm * 256 + wr * 64 + fr;
#pragma unroll
        for (int ai = 0; ai < 2; ++ai)
#pragma unroll
            for (int m = 0; m < 4; ++m) { const int row = row0 + ai * 128 + m * 16; const float sc = rs[row];
                const bool lat = row < M; const int b = lat ? row / SEQ : (row - M) / CTXL; const int key = lat ? row % SEQ : SEQ + (row - M) % CTXL;
                const int kpos = (key & ~12) | ((key & 4) << 1) | ((key & 8) >> 1);
#pragma unroll
                for (int bj = 0; bj < 2; ++bj) { const int col = u.pn * 256 + bj * 128 + wc * 32 + 8 * fq; const int hh = col >> 7, w = col & 127;
                    if (w < 64) { *(v4u*)(KNp + (size_t)row * HW + hh * 64 + w) = pack8(acc[ai][bj][m][0] * sc, acc[ai][bj][m][1] * sc); }
                    else { bf16* dst = VTp + ((size_t)((b * NH + hh) * VD + (w - 64))) * NKEY + kpos;
#pragma unroll
                        for (int n = 0; n < 2; ++n)
#pragma unroll
                            for (int q = 0; q < 4; ++q) dst[(size_t)(4 * n + q) * NKEY] = (bf16)f2bf(acc[ai][bj][m][n][q] * sc); } } }
    }
};
struct EpiResid {
    static constexpr bool PERM = false;
    const float* hin_l; const float* hin_c; float* hout_l; float* hout_c; const float* modl; int goff;
    __device__ __forceinline__ void operator()(const f32x4 (&acc)[2][2][4][2], const Unit& u, int wr, int wc, int fr, int fq) const {
        const int rowt = u.pm * 256; const bool lat = rowt < M; const int bidx = lat ? rowt / SEQ : NB;
        const float* gate = modl + bidx * NMOD + goff;
        const float* hi = lat ? hin_l + (size_t)rowt * DM : hin_c + (size_t)(rowt - M) * DM;
        float* ho = lat ? hout_l + (size_t)rowt * DM : hout_c + (size_t)(rowt - M) * DM;
        const int col0 = u.pn * 256 + wc * 32 + 4 * fq;
#pragma unroll
        for (int bj = 0; bj < 2; ++bj) {
            f32x4 hv[2][2][4];
#pragma unroll
            for (int n = 0; n < 2; ++n)
#pragma unroll
                for (int ai = 0; ai < 2; ++ai)
#pragma unroll
                    for (int m = 0; m < 4; ++m) hv[n][ai][m] = *(const f32x4*)(hi + (size_t)(ai * 128 + wr * 64 + m * 16 + fr) * DM + col0 + bj * 128 + n * 16);
#pragma unroll
            for (int n = 0; n < 2; ++n) { const f32x4 gv = *(const f32x4*)(gate + col0 + bj * 128 + n * 16);
#pragma unroll
                for (int ai = 0; ai < 2; ++ai)
#pragma unroll
                    for (int m = 0; m < 4; ++m) *(f32x4*)(ho + (size_t)(ai * 128 + wr * 64 + m * 16 + fr) * DM + col0 + bj * 128 + n * 16) = hv[n][ai][m] + gv * acc[ai][bj][m][n]; }
            asm volatile("" ::: "memory"); }
    }
};
struct EpiPool {
    static constexpr bool PERM = false;
    float* h_l; float* h_c; const float* modl; const float* bias; const float* scale; int talloc;
    __device__ __forceinline__ void operator()(const f32x4 (&acc)[2][2][4][2], const Unit& u, int wr, int wc, int fr, int fq) const {
        const int g = u.pn, rowt = (u.pm - g * talloc) * 256; const bool lat = rowt < M; const int bidx = lat ? rowt / SEQ : NB;
        const float* gate = modl + bidx * NMOD + 2 * DM;
        float* ho = lat ? h_l + (size_t)rowt * DM : h_c + (size_t)(rowt - M) * DM;
        const int col0 = g * 256 + wc * 32 + 4 * fq;
#pragma unroll
        for (int bj = 0; bj < 2; ++bj)
#pragma unroll
            for (int n = 0; n < 2; ++n) { const int c = col0 + bj * 128 + n * 16; const f32x4 gm = *(const f32x4*)(gate + c) * *(const f32x4*)(scale + c); const f32x4 gb = gm * *(const f32x4*)(bias + c);
#pragma unroll
                for (int ai = 0; ai < 2; ++ai)
#pragma unroll
                    for (int m = 0; m < 4; ++m) { const int r = ai * 128 + wr * 64 + m * 16 + fr; const size_t off = (size_t)r * DM + c; const f32x4 hv = *(const f32x4*)(ho + off); *(f32x4*)(ho + off) = hv + gm * acc[ai][bj][m][n] + gb; }
                asm volatile("" ::: "memory"); }
    }
};
struct EpiGateUp {
    static constexpr bool PERM = true;
    bf16* H; int ldh, nct, rowsub;
    __device__ __forceinline__ void operator()(const f32x4 (&acc)[2][2][4][2], const Unit& u, int wr, int wc, int fr, int fq) const {
        const int row0 = u.pm * 256 + wr * 64 + fr - rowsub; const int ct = u.pn % nct; const int col = ct * 128 + wc * 32 + 8 * fq;
#pragma unroll
        for (int ai = 0; ai < 2; ++ai)
#pragma unroll
            for (int m = 0; m < 4; ++m) { const int row = row0 + ai * 128 + m * 16; f32x4 o[2];
#pragma unroll
                for (int n = 0; n < 2; ++n)
#pragma unroll
                    for (int q = 0; q < 4; ++q) { const float gv = acc[ai][0][m][n][q], uv = acc[ai][1][m][n][q]; o[n][q] = gv * uv * __builtin_amdgcn_rcpf(1.0f + __expf(-gv)); }
                *(v4u*)(H + (size_t)row * ldh + col) = pack8(o[0], o[1]); }
    }
};
struct EpiY {
    static constexpr bool PERM = true;
    bf16* Y; int nct;
    __device__ __forceinline__ void operator()(const f32x4 (&acc)[2][2][4][2], const Unit& u, int wr, int wc, int fr, int fq) const {
        const int row0 = u.pm * 256 + wr * 64 + fr; const int ct = u.pn % nct;
#pragma unroll
        for (int ai = 0; ai < 2; ++ai)
#pragma unroll
            for (int m = 0; m < 4; ++m) { const int row = row0 + ai * 128 + m * 16;
#pragma unroll
                for (int bj = 0; bj < 2; ++bj) { const int col = ct * 256 + bj * 128 + wc * 32 + 8 * fq; *(v4u*)(Y + (size_t)row * DM + col) = pack8(acc[ai][bj][m][0], acc[ai][bj][m][1]); } }
    }
};

__device__ __forceinline__ void p0_prologue(Frame& F) {
    fresh(F);
    unsigned char* ws = F.ws;
    const float qscale = 0.10206207261596577f * 1.4426950408889634f;
    for (int j = 0; j < 2; ++j) {
        conv_matrix(F, F.in[8] + (size_t)j * DM * INW, DM, INW, (bf16*)(ws + WS_WIN) + (size_t)j * INP * DM, DM, 1, 0, nullptr, 1.f);
        conv_matrix(F, F.in[11] + (size_t)j * QL * 768, QL, 768, (bf16*)(ws + WS_WUQ) + (size_t)j * 768 * QL, QL, 0, 0, F.in[9] + j * QL, qscale);
        conv_matrix(F, F.in[12] + (size_t)j * KVL * 1024, KVL, 1024, (bf16*)(ws + WS_WUKV) + (size_t)j * 1024 * KVL, KVL, 0, 0, F.in[10] + j * KVL, 1.f);
        conv_matrix(F, F.in[15] + (size_t)j * DM * DM, DM, DM, (bf16*)(ws + WS_WOUT) + (size_t)j * DM * DM, DM, 0, 0, nullptr, 1.f);
        conv_matrix(F, F.in[16] + (size_t)j * DM * DFF, DM, DFF, (bf16*)(ws + WS_WGU) + (size_t)j * 2 * DFF * DM, DM, 2, 0, nullptr, 1.f);
        conv_matrix(F, F.in[17] + (size_t)j * DM * DFF, DM, DFF, (bf16*)(ws + WS_WGU) + (size_t)j * 2 * DFF * DM, DM, 2, 128, nullptr, 1.f);
        conv_matrix(F, F.in[18] + (size_t)j * DFF * DM, DFF, DM, (bf16*)(ws + WS_WDN) + (size_t)j * DM * DFF, DFF, 0, 0, nullptr, 1.f);
        for (int g = 0; g < 4; ++g)
            conv_matrix(F, F.in[19] + (size_t)(j * 4 + g) * 65536, 256, 256, (bf16*)(ws + WS_WPOOL) + (size_t)(j * 4 + g) * 65536, 256, 0, 0, nullptr, 1.f);
    }
    __syncthreads();
    if (blockIdx.x == 0 && F.tid < 8) {
        float* TC = (float*)(ws + WS_ROPE); float* TS = TC + 512;
        double th = 1.0; for (int i = 0; i < F.tid; ++i) th *= 0.31622776601683794;
        const double x2 = th * th; double s = th, c = 1.0, ts = th, tc = 1.0;
        for (int n = 1; n <= 12; ++n) { tc *= -x2 / (double)((2 * n - 1) * (2 * n)); c += tc; ts *= -x2 / (double)((2 * n) * (2 * n + 1)); s += ts; }
        double cp = 1.0, sp = 0.0;
        for (int p = 0; p < 64; ++p) { TC[p * 8 + F.tid] = (float)cp; TS[p * 8 + F.tid] = (float)sp; const double ncp = cp * c - sp * s; sp = sp * c + cp * s; cp = ncp; }
    }
    {
        LAS float* sc = (LAS float*)(F.lds + RING_OFF);
        LAS float* red = sc + 17 * 1024;
        const int nitems = 4 * (NMOD / 64);
        if ((int)blockIdx.x < nitems) {
            for (int e = F.tid; e < 17 * 1024; e += 512) { const int r = e >> 10, k = e & 1023; const float x = (r < 16) ? F.in[1][r * 1024 + k] : F.in[3][k]; sc[e] = siluf_(x); }
            __syncthreads();
            for (int it = blockIdx.x; it < nitems; it += F.G) {
                const int l = it / (NMOD / 64), c0 = (it % (NMOD / 64)) * 64;
                const float* W = F.in[4] + (size_t)l * DM * NMOD + c0 + F.lane;
                float acc[17];
#pragma unroll
                for (int r = 0; r < 17; ++r) acc[r] = 0.f;
                const int kb = F.wave * 128;
                for (int k = 0; k < 128; k += 4) {
                    const float w0 = W[(size_t)(kb + k) * NMOD], w1 = W[(size_t)(kb + k + 1) * NMOD], w2 = W[(size_t)(kb + k + 2) * NMOD], w3 = W[(size_t)(kb + k + 3) * NMOD];
#pragma unroll
                    for (int r = 0; r < 17; ++r) { const f32x4 s4 = *(const LAS f32x4*)(sc + r * 1024 + kb + k); acc[r] += s4.x * w0 + s4.y * w1 + s4.z * w2 + s4.w * w3; }
                }
#pragma unroll
                for (int r = 0; r < 17; ++r) red[(F.wave * 17 + r) * 64 + F.lane] = acc[r];
                __syncthreads();
                for (int o = F.tid; o < 17 * 64; o += 512) { const int r = o >> 6, cc = o & 63; float s = 0.f;
#pragma unroll
                    for (int w = 0; w < 8; ++w) s += red[(w * 17 + r) * 64 + cc];
                    ((float*)(ws + WS_MODV))[(size_t)(l * 17 + r) * NMOD + c0 + cc] = s + F.in[5][l * NMOD + c0 + cc]; }
                __syncthreads();
            }
        }
    }
}

__device__ __forceinline__ void e3_phase(Frame& F) {
    fresh(F);
    unsigned char* ws = F.ws;
    const bf16* CQ = (const bf16*)(ws + WS_CQ); const bf16* CKV = (const bf16*)(ws + WS_CKV); const bf16* KR = (const bf16*)(ws + WS_KR); bf16* KRR = (bf16*)(ws + WS_KRR);
    float* RSQ = (float*)(ws + WS_RSQ); float* RSKV = (float*)(ws + WS_RSKV); const float* TC = (const float*)(ws + WS_ROPE); const float* TS = TC + 512;
    const int rpw = (MT + F.G - 1) / F.G;
    for (int i = F.wave; i < rpw; i += NWAVES) {
        const int row = (int)blockIdx.x * rpw + i; if (row >= MT) break;
        float s = 0.f;
        if (F.lane < 48) { const v4u w = *(const v4u*)(CQ + (size_t)row * QL + F.lane * 8);
            s = bflo(w.x) * bflo(w.x) + bfhi(w.x) * bfhi(w.x) + bflo(w.y) * bflo(w.y) + bfhi(w.y) * bfhi(w.y) + bflo(w.z) * bflo(w.z) + bfhi(w.z) * bfhi(w.z) + bflo(w.w) * bflo(w.w) + bfhi(w.w) * bfhi(w.w); }
        s = wave_sum(s, F.lane); if (F.lane == 0) RSQ[row] = rsqrtf(s * (1.0f / QL) + EPS);
        s = 0.f;
        if (F.lane < 32) { const v4u w = *(const v4u*)(CKV + (size_t)row * KVL + F.lane * 8);
            s = bflo(w.x) * bflo(w.x) + bfhi(w.x) * bfhi(w.x) + bflo(w.y) * bflo(w.y) + bfhi(w.y) * bfhi(w.y) + bflo(w.z) * bflo(w.z) + bfhi(w.z) * bfhi(w.z) + bflo(w.w) * bflo(w.w) + bfhi(w.w) * bfhi(w.w); }
        s = wave_sum(s, F.lane); if (F.lane == 0) RSKV[row] = rsqrtf(s * (1.0f / KVL) + EPS);
        const float x = (F.lane < 32) ? bf2f(KR[(size_t)row * ROPE + F.lane]) : 0.f; const float pr = shx(x, F.lane, 8);
        float o = x;
        if (row < M) { const int t = row % SEQ; const int p = ((F.lane >> 4) & 1) ? (t & 63) : (t >> 6); const int j = F.lane & 7; const float c = TC[p * 8 + j], sn = TS[p * 8 + j];
            o = ((F.lane >> 3) & 1) ? x * c + pr * sn : x * c - pr * sn; }
        if (F.lane < 32) KRR[(size_t)row * ROPE + F.lane] = (bf16)f2bf(o);
    }
}

typedef short bf16x8v __attribute__((ext_vector_type(8)));
typedef float f32x16 __attribute__((ext_vector_type(16)));
__device__ __forceinline__ void attn_unit(Frame& F, int b, int h, int qrow0, bool rope_q, int t_lo, int t_hi) {
    unsigned char* ws = F.ws;
    const bf16* QB = (const bf16*)(ws + WS_QB); const bf16* KN = (const bf16*)(ws + WS_KN); const bf16* KRR = (const bf16*)(ws + WS_KRR); const bf16* VT = (const bf16*)(ws + WS_VV);
    bf16* MIX = (bf16*)(ws + WS_MIX); const float* TC = (const float*)(ws + WS_ROPE); const float* TS = TC + 512;
    const int lane = F.lane, wave = F.wave, r32 = lane & 31, hi = lane >> 5;
    LAS unsigned char* ring = F.lds + RING_OFF;
    const int qrow = qrow0 + wave * 32 + r32;
    bf16x8v qr[6];
#pragma unroll
    for (int d0 = 0; d0 < 6; ++d0) qr[d0] = *(const bf16x8v*)(QB + (size_t)qrow * 768 + h * QKD + 16 * d0 + 8 * hi);
    if (rope_q) { const int t = qrow % SEQ;
#pragma unroll
        for (int a = 0; a < 2; ++a) { const int p = a ? (t & 63) : (t >> 6); const v4u w = __builtin_bit_cast(v4u, qr[4 + a]); float x[8], y[8];
            x[0] = bflo(w.x); x[1] = bfhi(w.x); x[2] = bflo(w.y); x[3] = bfhi(w.y); x[4] = bflo(w.z); x[5] = bfhi(w.z); x[6] = bflo(w.w); x[7] = bfhi(w.w);
#pragma unroll
            for (int jj = 0; jj < 8; ++jj) { const float pr = shx(x[jj], lane, 32); const float c = TC[p * 8 + jj], sn = TS[p * 8 + jj]; y[jj] = hi ? x[jj] * c + pr * sn : x[jj] * c - pr * sn; }
            v4u o; o.x = pk2(y[0], y[1]); o.y = pk2(y[2], y[3]); o.z = pk2(y[4], y[5]); o.w = pk2(y[6], y[7]); qr[4 + a] = __builtin_bit_cast(bf16x8v, o); } }
    const int bh = b * NH + h;
    const bf16* vsrc = VT + ((size_t)(bh * VD + lane)) * NKEY + 8 * wave;
#define ATT_DMA(t, buf) do { const int t_ = (t); const int r0_ = t_ < SEQ / 64 ? b * SEQ + 64 * t_ : M + b * CTXL + 64 * (t_ - SEQ / 64); \
        LAS unsigned char* kb_ = ring + (buf) * 20480; LAS unsigned char* vb_ = kb_ + 12288; \
        __builtin_amdgcn_global_load_lds((const unsigned*)(KN + (size_t)(r0_ + lane) * HW + h * 64 + 8 * wave), (LAS unsigned*)(kb_ + wave * 1024), 16, 0, 0); \
        __builtin_amdgcn_global_load_lds((const unsigned*)(KRR + (size_t)(r0_ + lane) * ROPE + 8 * (wave & 3)), (LAS unsigned*)(kb_ + (8 + (wave & 3)) * 1024), 16, 0, 0);     \
        __builtin_amdgcn_global_load_lds((const unsigned*)(vsrc + 64 * t_), (LAS unsigned*)(vb_ + wave * 1024), 16, 0, 0); } while (0)
    f32x16 o0, o1;
#pragma unroll
    for (int r = 0; r < 16; ++r) { o0[r] = 0.f; o1[r] = 0.f; }
    constexpr float ATT_THR = 8.0f;
    float m_run = 0.f, l_run = 0.f;
    asm volatile("s_waitcnt vmcnt(0)" ::: "memory");
    ATT_DMA(t_lo, 0); if (t_lo + 1 < t_hi) ATT_DMA(t_lo + 1, 1); if (t_lo + 2 < t_hi) ATT_DMA(t_lo + 2, 2);
    for (int t = t_lo; t < t_hi; ++t) {
        const int buf = (t - t_lo) & 3; const int rem = t_hi - 1 - t;
        if (rem >= 2) asm volatile("s_waitcnt vmcnt(6)" ::: "memory"); else if (rem == 1) asm volatile("s_waitcnt vmcnt(3)" ::: "memory"); else asm volatile("s_waitcnt vmcnt(0)" ::: "memory");
        asm volatile("s_waitcnt lgkmcnt(0)" ::: "memory"); __builtin_amdgcn_s_barrier(); asm volatile("" ::: "memory");
        if (t + 3 < t_hi) ATT_DMA(t + 3, (buf + 3) & 3);
        const LAS unsigned char* kb = ring + buf * 20480 + hi * 1024 + r32 * 16; const LAS unsigned char* vb = ring + buf * 20480 + 12288 + hi * 1024 + r32 * 16;
        bf16x8v kf[12], vf[8];
#pragma unroll
        for (int d0 = 0; d0 < 6; ++d0) { kf[2 * d0] = *(const LAS bf16x8v*)(kb + d0 * 2048); kf[2 * d0 + 1] = *(const LAS bf16x8v*)(kb + d0 * 2048 + 512); }
#pragma unroll
        for (int s4 = 0; s4 < 4; ++s4) { vf[2 * s4] = *(const LAS bf16x8v*)(vb + s4 * 2048); vf[2 * s4 + 1] = *(const LAS bf16x8v*)(vb + s4 * 2048 + 512); }
        f32x16 p0, p1; const float negm = -m_run;
#pragma unroll
        for (int r = 0; r < 16; ++r) { p0[r] = negm; p1[r] = negm; }
#pragma unroll
        for (int d0 = 0; d0 < 6; ++d0) { p0 = __builtin_amdgcn_mfma_f32_32x32x16_bf16(kf[2 * d0], qr[d0], p0, 0, 0, 0); p1 = __builtin_amdgcn_mfma_f32_32x32x16_bf16(kf[2 * d0 + 1], qr[d0], p1, 0, 0, 0); }
        float ma = __builtin_fmaxf(__builtin_fmaxf(p0[0], p0[1]), p1[0]), mb = __builtin_fmaxf(__builtin_fmaxf(p0[2], p0[3]), p1[1]); ma = __builtin_fmaxf(__builtin_fmaxf(ma, p1[2]), p1[3]);
#pragma unroll
        for (int r = 4; r < 16; r += 4) { ma = __builtin_fmaxf(__builtin_fmaxf(ma, p0[r]), p0[r + 1]); mb = __builtin_fmaxf(__builtin_fmaxf(mb, p0[r + 2]), p0[r + 3]); ma = __builtin_fmaxf(__builtin_fmaxf(ma, p1[r]), p1[r + 1]); mb = __builtin_fmaxf(__builtin_fmaxf(mb, p1[r + 2]), p1[r + 3]); }
        float mt = __builtin_fmaxf(ma, mb);
        { auto rr = __builtin_amdgcn_permlane32_swap(__float_as_uint(mt), __float_as_uint(mt), false, false); mt = __builtin_fmaxf(__uint_as_float(rr[0]), __uint_as_float(rr[1])); }
        const bool first = (t == t_lo);
        if (first || __any(mt > ATT_THR)) {
            const float dl = first ? mt : __builtin_fmaxf(mt, 0.f); m_run += dl; const float alpha = __builtin_amdgcn_exp2f(-dl); l_run *= alpha;
#pragma unroll
            for (int r = 0; r < 16; ++r) { p0[r] -= dl; p1[r] -= dl; o0[r] *= alpha; o1[r] *= alpha; }
        }
        float ps0 = 0.f, ps1 = 0.f;
#pragma unroll
        for (int r = 0; r < 16; ++r) { p0[r] = __builtin_amdgcn_exp2f(p0[r]); p1[r] = __builtin_amdgcn_exp2f(p1[r]); ps0 += p0[r]; ps1 += p1[r]; }
        l_run += ps0 + ps1;
        v4u pw[4];
#pragma unroll
        for (int q = 0; q < 4; ++q) { pw[0][q] = cvt_pk_bf16(p0[2 * q], p0[2 * q + 1]); pw[1][q] = cvt_pk_bf16(p0[8 + 2 * q], p0[8 + 2 * q + 1]); pw[2][q] = cvt_pk_bf16(p1[2 * q], p1[2 * q + 1]); pw[3][q] = cvt_pk_bf16(p1[8 + 2 * q], p1[8 + 2 * q + 1]); }
#pragma unroll
        for (int s4 = 0; s4 < 4; ++s4) { const bf16x8v pa = __builtin_bit_cast(bf16x8v, pw[s4]);
            o0 = __builtin_amdgcn_mfma_f32_32x32x16_bf16(vf[2 * s4], pa, o0, 0, 0, 0); o1 = __builtin_amdgcn_mfma_f32_32x32x16_bf16(vf[2 * s4 + 1], pa, o1, 0, 0, 0); }
    }
    { auto rr = __builtin_amdgcn_permlane32_swap(__float_as_uint(l_run), __float_as_uint(l_run), false, false); l_run = __uint_as_float(rr[0]) + __uint_as_float(rr[1]); }
    const float rl = 1.0f / l_run;
    bf16* orow = MIX + (size_t)qrow * DM + h * VD;
#pragma unroll
    for (int g = 0; g < 4; ++g) { v2u a, c2; a.x = pk2(o0[4 * g] * rl, o0[4 * g + 1] * rl); a.y = pk2(o0[4 * g + 2] * rl, o0[4 * g + 3] * rl); c2.x = pk2(o1[4 * g] * rl, o1[4 * g + 1] * rl); c2.y = pk2(o1[4 * g + 2] * rl, o1[4 * g + 3] * rl);
        *(v2u*)(orow + 8 * g + 4 * hi) = a; *(v2u*)(orow + 32 + 8 * g + 4 * hi) = c2; }
    asm volatile("s_waitcnt vmcnt(0) lgkmcnt(0)" ::: "memory"); __builtin_amdgcn_s_barrier(); asm volatile("" ::: "memory");
#undef ATT_DMA
}
__device__ __forceinline__ void hgrn_item(Frame& F, int j, int it);
__device__ __forceinline__ void mix_phase(Frame& F, int j, bool ctx_out) {
    fresh(F);
    const int npair = F.G >> 1;
    for (int P = F.vcu >> 1; P < NB * NH; P += npair) {
        const int b = P >> 3, h = P & 7;
        if ((F.vcu & 1) == 0) {
            hgrn_item(F, j, P);
            for (int qb = 6; qb < 8; ++qb) attn_unit(F, b, h, b * SEQ + qb * 256, true, 0, NKEY / 64);
        } else {
            for (int qb = 0; qb < 6; ++qb) attn_unit(F, b, h, b * SEQ + qb * 256, true, 0, NKEY / 64);
            if (ctx_out) attn_unit(F, b, h, M + b * CTXL, false, SEQ / 64, NKEY / 64);
        }
    }
    __syncthreads();
}

__device__ __forceinline__ int hgrn_row(int b, int dir, int ig) { return (ig < CTXL) ? (M + b * CTXL + (dir ? CTXL - 1 - ig : ig)) : (b * SEQ + (dir ? SEQ - 1 - (ig - CTXL) : (ig - CTXL))); }
__device__ __forceinline__ void hgrn_item(Frame& F, int j, int it) {
    unsigned char* ws = F.ws;
    const bf16* HQ = (const bf16*)(ws + WS_HQ); const bf16* HFF = HQ + HSEG; const bf16* HFB = HQ + 2 * HSEG; const bf16* HI = HQ + 3 * HSEG;
    LAS unsigned char* ring = F.lds + RING_OFF;
    LAS unsigned char* QN = ring; LAS unsigned char* KN = ring + 17408; LAS unsigned char* KT = ring + 34816; LAS unsigned char* VT = ring + 53248; LAS unsigned char* ST = ring + 71680;
    LAS float* TOT = (LAS float*)(ring + 106496); LAS unsigned char* RQ = ring + 108544; LAS unsigned char* RF = ring + 124928;
    const int lane0 = F.lane, wave = F.wave;
    const int part = wave >> 1;
    const int kb = wave >> 1, vb0 = 2 * (wave & 1);
    const int ib = wave >> 2, vbo = wave & 3;
    const int dir = it & 1, hh = (it >> 1) & 3, b = it >> 3;
    const bf16* HF = dir ? HFB : HFF; float* OO = (float*)(ws + (dir ? WS_OB : WS_OF));
    float lb = 0.f; if (j == 1) { const int ci = dir * HW + hh * HK + (wave & 1) * 64 + lane0; const float l0 = F.in[13][ci], l1 = F.in[13][2 * HW + ci]; lb = 1.0f / (1.0f + __expf(l0 - l1)); }
    const float oml = 1.0f - lb;
    f32x16 S0, S1;
#pragma unroll
    for (int r = 0; r < 16; ++r) { S0[r] = 0.f; S1[r] = 0.f; }
#define LBAR() do { asm volatile("s_waitcnt lgkmcnt(0)" ::: "memory"); __builtin_amdgcn_s_barrier(); asm volatile("" ::: "memory"); } while (0)
#define HG_BASE(c_) ((c_) < CTXL / 64 ? M + b * CTXL + (dir ? CTXL - 64 - 64 * (c_) : 64 * (c_)) : b * SEQ + (dir ? SEQ - 64 - 64 * ((c_) - CTXL / 64) : 64 * ((c_) - CTXL / 64)))
#define HG_DMA(c_) do { const int rb_ = HG_BASE(c_); \
        _Pragma("unroll") for (int p_ = 0; p_ < 2; ++p_) { const int pc_ = wave * 2 + p_; const size_t go_ = (size_t)(rb_ + 4 * pc_ + (lane >> 4)) * HW + hh * HK + 8 * (lane & 15); \
            __builtin_amdgcn_global_load_lds((const unsigned*)(HQ + go_), (LAS unsigned*)(RQ + pc_ * 1024), 16, 0, 0); __builtin_amdgcn_global_load_lds((const unsigned*)(HF + go_), (LAS unsigned*)(RF + pc_ * 1024), 16, 0, 0); } } while (0)
#define HG_VLD(c_) do { const size_t go_ = (size_t)(HG_BASE(c_) + (dir ? 63 - lane : lane)) * HW + hh * HK + 16 * wave; rv0 = *(const v4u*)(HI + go_); rv1 = *(const v4u*)(HI + go_ + 8); } while (0)
    v4u rv0, rv1;
    { const int lane = lane0; HG_DMA(0); HG_VLD(0); }
    asm volatile("s_waitcnt vmcnt(0)" ::: "memory"); LBAR();
    for (int ch = 0; ch < NKEY / 64; ++ch) {
        int lane_ = lane0; asm volatile("" : "+v"(lane_));
        const int lane = lane_, r32 = lane & 31, hi = lane >> 5, k = (wave & 1) * 64 + lane;
        const int pos = (lane & ~12) | ((lane & 4) << 1) | ((lane & 8) >> 1);
        float qv[16], kin[16], cs[16]; float run = 0.f;
#pragma unroll
        for (int ii = 0; ii < 16; ++ii) { const int i = 16 * part + ii, mr = dir ? 63 - i : i; const float hq = bf2f(*(const LAS bf16*)(RQ + mr * 256 + k * 2)), hf = bf2f(*(const LAS bf16*)(RF + mr * 256 + k * 2));
            qv[ii] = hq * __builtin_amdgcn_rcpf(1.0f + __expf(-hq)); const float e = __expf(-hf), sg = __builtin_amdgcn_rcpf(1.0f + e); kin[ii] = oml * e * sg; run += __logf(lb + oml * sg); cs[ii] = run; }
        TOT[part * 128 + k] = run;
        { LAS bf16* vt = (LAS bf16*)(VT + (16 * wave) * 144 + pos * 2);
          vt[0 * 72] = (bf16)(rv0.x & 0xffffu); vt[1 * 72] = (bf16)(rv0.x >> 16); vt[2 * 72] = (bf16)(rv0.y & 0xffffu); vt[3 * 72] = (bf16)(rv0.y >> 16);
          vt[4 * 72] = (bf16)(rv0.z & 0xffffu); vt[5 * 72] = (bf16)(rv0.z >> 16); vt[6 * 72] = (bf16)(rv0.w & 0xffffu); vt[7 * 72] = (bf16)(rv0.w >> 16);
          vt[8 * 72] = (bf16)(rv1.x & 0xffffu); vt[9 * 72] = (bf16)(rv1.x >> 16); vt[10 * 72] = (bf16)(rv1.y & 0xffffu); vt[11 * 72] = (bf16)(rv1.y >> 16);
          vt[12 * 72] = (bf16)(rv1.z & 0xffffu); vt[13 * 72] = (bf16)(rv1.z >> 16); vt[14 * 72] = (bf16)(rv1.w & 0xffffu); vt[15 * 72] = (bf16)(rv1.w >> 16); }
        LBAR();
        if (ch + 1 < NKEY / 64) { HG_DMA(ch + 1); HG_VLD(ch + 1); }
        { const float t0 = TOT[k], t1 = TOT[128 + k], t2 = TOT[256 + k];
          const float base = (part > 0 ? t0 : 0.f) + (part > 1 ? t1 : 0.f) + (part > 2 ? t2 : 0.f); const float rr = t0 + t1;
          unsigned kt[8];
#pragma unroll
          for (int ii = 0; ii < 16; ii += 2) { float d0 = base + cs[ii] - rr, d1 = base + cs[ii + 1] - rr; d0 = fminf(fmaxf(d0, -80.f), 80.f); d1 = fminf(fmaxf(d1, -80.f), 80.f);
              const float e0 = __expf(d0), e1 = __expf(d1); const float q0 = qv[ii] * e0, q1 = qv[ii + 1] * e1, k0 = kin[ii] * __builtin_amdgcn_rcpf(e0), k1 = kin[ii + 1] * __builtin_amdgcn_rcpf(e1);
              const unsigned qp = cvt_pk_bf16(q0, q1), kp = cvt_pk_bf16(k0, k1);
              *(LAS bf16*)(QN + (16 * part + ii) * 272 + k * 2) = (bf16)(qp & 0xffffu); *(LAS bf16*)(QN + (16 * part + ii + 1) * 272 + k * 2) = (bf16)(qp >> 16);
              *(LAS bf16*)(KN + (16 * part + ii) * 272 + k * 2) = (bf16)(kp & 0xffffu); *(LAS bf16*)(KN + (16 * part + ii + 1) * 272 + k * 2) = (bf16)(kp >> 16);
              kt[ii >> 1] = kp; }
          *(LAS v4u*)(KT + k * 144 + part * 32) = (v4u){kt[0], kt[1], kt[4], kt[5]}; *(LAS v4u*)(KT + k * 144 + part * 32 + 16) = (v4u){kt[2], kt[3], kt[6], kt[7]}; }
        f32x16 T0, T1;
#pragma unroll
        for (int g4 = 0; g4 < 4; ++g4) { const int kk = kb * 32 + 8 * g4 + 4 * hi; const f32x4 ta = *(const LAS f32x4*)(TOT + kk), tb = *(const LAS f32x4*)(TOT + 128 + kk);
            const float e0 = __expf(ta.x + tb.x), e1 = __expf(ta.y + tb.y), e2 = __expf(ta.z + tb.z), e3 = __expf(ta.w + tb.w);
            T0[4 * g4] = S0[4 * g4] * e0; T0[4 * g4 + 1] = S0[4 * g4 + 1] * e1; T0[4 * g4 + 2] = S0[4 * g4 + 2] * e2; T0[4 * g4 + 3] = S0[4 * g4 + 3] * e3;
            T1[4 * g4] = S1[4 * g4] * e0; T1[4 * g4 + 1] = S1[4 * g4 + 1] * e1; T1[4 * g4 + 2] = S1[4 * g4 + 2] * e2; T1[4 * g4 + 3] = S1[4 * g4 + 3] * e3;
            v2u o; o.x = cvt_pk_bf16(T0[4 * g4], T0[4 * g4 + 1]); o.y = cvt_pk_bf16(T0[4 * g4 + 2], T0[4 * g4 + 3]); *(LAS v2u*)(ST + (vb0 * 32 + r32) * 272 + kk * 2) = o;
            o.x = cvt_pk_bf16(T1[4 * g4], T1[4 * g4 + 1]); o.y = cvt_pk_bf16(T1[4 * g4 + 2], T1[4 * g4 + 3]); *(LAS v2u*)(ST + (vb0 * 32 + 32 + r32) * 272 + kk * 2) = o; }
        LBAR();
#pragma unroll
        for (int st = 0; st < 4; ++st) { const bf16x8v kf = *(const LAS bf16x8v*)(KT + (kb * 32 + r32) * 144 + st * 32 + hi * 16);
            const bf16x8v va = *(const LAS bf16x8v*)(VT + (vb0 * 32 + r32) * 144 + st * 32 + hi * 16), vc = *(const LAS bf16x8v*)(VT + (vb0 * 32 + 32 + r32) * 144 + st * 32 + hi * 16);
            T0 = __builtin_amdgcn_mfma_f32_32x32x16_bf16(kf, va, T0, 0, 0, 0); T1 = __builtin_amdgcn_mfma_f32_32x32x16_bf16(kf, vc, T1, 0, 0, 0); }
#pragma unroll
        for (int g4 = 0; g4 < 4; ++g4) { const int kk = kb * 32 + 8 * g4 + 4 * hi; const f32x4 ta = *(const LAS f32x4*)(TOT + 256 + kk), tb = *(const LAS f32x4*)(TOT + 384 + kk);
            const float e0 = __expf(ta.x + tb.x), e1 = __expf(ta.y + tb.y), e2 = __expf(ta.z + tb.z), e3 = __expf(ta.w + tb.w);
            S0[4 * g4] = T0[4 * g4] * e0; S0[4 * g4 + 1] = T0[4 * g4 + 1] * e1; S0[4 * g4 + 2] = T0[4 * g4 + 2] * e2; S0[4 * g4 + 3] = T0[4 * g4 + 3] * e3;
            S1[4 * g4] = T1[4 * g4] * e0; S1[4 * g4 + 1] = T1[4 * g4 + 1] * e1; S1[4 * g4 + 2] = T1[4 * g4 + 2] * e2; S1[4 * g4 + 3] = T1[4 * g4 + 3] * e3; }
        asm volatile("" ::: "memory");
        {
            bf16x8v qf[8];
#pragma unroll
            for (int ks = 0; ks < 8; ++ks) qf[ks] = *(const LAS bf16x8v*)(QN + (ib * 32 + r32) * 272 + ks * 32 + hi * 16);
            asm volatile("" ::: "memory");
            f32x16 O;
#pragma unroll
            for (int r = 0; r < 16; ++r) O[r] = 0.f;
#pragma unroll
            for (int ks = 0; ks < 8; ++ks) { const bf16x8v sf = *(const LAS bf16x8v*)(ST + (vbo * 32 + r32) * 272 + ks * 32 + hi * 16); O = __builtin_amdgcn_mfma_f32_32x32x16_bf16(qf[ks], sf, O, 0, 0, 0); }
            asm volatile("" ::: "memory");
#pragma unroll 1
            for (int sb = 0; sb <= ib; ++sb) {
                f32x16 X;
#pragma unroll
                for (int r = 0; r < 16; ++r) X[r] = 0.f;
#pragma unroll
                for (int ks = 0; ks < 8; ++ks) { const bf16x8v kf = *(const LAS bf16x8v*)(KN + (sb * 32 + r32) * 272 + ks * 32 + hi * 16); X = __builtin_amdgcn_mfma_f32_32x32x16_bf16(kf, qf[ks], X, 0, 0, 0); }
                if (sb == ib) {
#pragma unroll
                    for (int r = 0; r < 16; ++r) { const int srow = (r & 3) + 8 * (r >> 2) + 4 * hi; if (srow > r32) X[r] = 0.f; }
                }
                asm volatile("" ::: "memory");
#pragma unroll
                for (int st = 0; st < 2; ++st) { v4u pw;
#pragma unroll
                    for (int q = 0; q < 4; ++q) pw[q] = cvt_pk_bf16(X[8 * st + 2 * q], X[8 * st + 2 * q + 1]);
                    const bf16x8v vf = *(const LAS bf16x8v*)(VT + (vbo * 32 + r32) * 144 + (sb * 32 + st * 16) * 2 + hi * 16);
                    O = __builtin_amdgcn_mfma_f32_32x32x16_bf16(__builtin_bit_cast(bf16x8v, pw), vf, O, 0, 0, 0); }
                asm volatile("" ::: "memory");
            }
            const int rb = HG_BASE(ch); float* op = OO + (size_t)rb * HW + hh * HK + vbo * 32 + r32;
#pragma unroll
            for (int r = 0; r < 16; ++r) { const int i = ib * 32 + (r & 3) + 8 * (r >> 2) + 4 * hi; op[(size_t)(dir ? 63 - i : i) * HW] = O[r]; }
        }
        asm volatile("s_waitcnt vmcnt(0)" ::: "memory"); LBAR();
    }
#undef LBAR
#undef HG_DMA
#undef HG_VLD
#undef HG_BASE
}

__device__ __forceinline__ void e8_phase(Frame& F, int j, int nrows) {
    fresh(F);
    unsigned char* ws = F.ws;
    const float* OF = (const float*)(ws + WS_OF); const float* OB = (const float*)(ws + WS_OB); const bf16* HG = (const bf16*)(ws + WS_HQ) + 4 * HSEG; bf16* MIX = (bf16*)(ws + WS_MIX);
    const float* gn = F.in[14] + j * HK;
    const int rpw = (nrows + F.G - 1) / F.G, rbase = (int)blockIdx.x * rpw, rend = (rbase + rpw < nrows) ? rbase + rpw : nrows;
    const int col = 8 * F.lane, vv = col & 127; const f32x4 g0 = *(const f32x4*)(gn + vv), g1 = *(const f32x4*)(gn + vv + 4);
    for (int r0 = rbase + F.wave; r0 < rend; r0 += 2 * NWAVES) {
        f32x4 a0[2], a1[2], b0[2], b1[2]; v4u hg[2];
#pragma unroll
        for (int q = 0; q < 2; ++q) { const int row = r0 + q * NWAVES; if (row < rend) {
            a0[q] = *(const f32x4*)(OF + (size_t)row * HW + col); a1[q] = *(const f32x4*)(OF + (size_t)row * HW + col + 4); b0[q] = *(const f32x4*)(OB + (size_t)row * HW + col); b1[q] = *(const f32x4*)(OB + (size_t)row * HW + col + 4);
            hg[q] = *(const v4u*)(HG + (size_t)row * HW + col); } }
#pragma unroll
        for (int q = 0; q < 2; ++q) { const int row = r0 + q * NWAVES; if (row < rend) {
            f32x4 x0 = a0[q] + b0[q], x1 = a1[q] + b1[q];
            float s = (x0.x * x0.x + x0.y * x0.y) + (x0.z * x0.z + x0.w * x0.w) + (x1.x * x1.x + x1.y * x1.y) + (x1.z * x1.z + x1.w * x1.w);
            s += shx(s, F.lane, 1); s += shx(s, F.lane, 2); s += shx(s, F.lane, 4); s += shx(s, F.lane, 8);
            const float rstd = rsqrtf(s * (1.0f / HK) + EPS);
            x0 = x0 * rstd * g0; x1 = x1 * rstd * g1; const v4u h = hg[q];
            v4u o; o.x = pg8::cvt_pk_bf16(x0.x * siluf_(bflo(h.x)), x0.y * siluf_(bfhi(h.x))); o.y = pg8::cvt_pk_bf16(x0.z * siluf_(bflo(h.y)), x0.w * siluf_(bfhi(h.y)));
            o.z = pg8::cvt_pk_bf16(x1.x * siluf_(bflo(h.z)), x1.y * siluf_(bfhi(h.z))); o.w = pg8::cvt_pk_bf16(x1.z * siluf_(bflo(h.w)), x1.w * siluf_(bfhi(h.w)));
            *(v4u*)(MIX + (size_t)row * DM + HW + col) = o; } }
    }
}

__device__ __forceinline__ void o12_phase(Frame& F, int nrows, const float* hl, const float* hc, const float* gn, const float* modl) {
    fresh(F);
    bf16* P = (bf16*)(F.ws + WS_POOLED);
    LAS unsigned char* XN = F.lds + RING_OFF;
    const int rpw = (nrows + F.G - 1) / F.G, rbase = (int)blockIdx.x * rpw, rend = (rbase + rpw < nrows) ? rbase + rpw : nrows;
    for (int r0 = rbase; r0 < rend; r0 += 32) {
        for (int sl = F.wave; sl < 48; sl += NWAVES) {
            const int row = r0 - 8 + sl; if (row < 0 || row >= nrows) continue;
            const float* hr = (row < M) ? hl + (size_t)row * DM : hc + (size_t)(row - M) * DM;
            f32x4 v[4]; float s = 0.f;
#pragma unroll
            for (int j = 0; j < 4; ++j) { v[j] = *(const f32x4*)(hr + 4 * F.lane + 256 * j); s += (v[j].x * v[j].x + v[j].y * v[j].y) + (v[j].z * v[j].z + v[j].w * v[j].w); }
            const float rstd = rsqrtf(wave_sum(s, F.lane) * (1.0f / DM) + EPS);
#pragma unroll
            for (int j = 0; j < 4; ++j) { v2u o; o.x = pg8::cvt_pk_bf16(v[j].x * rstd, v[j].y * rstd); o.y = pg8::cvt_pk_bf16(v[j].z * rstd, v[j].w * rstd); *(LAS v2u*)(XN + sl * 2048 + (4 * F.lane + 256 * j) * 2) = o; }
        }
        __syncthreads();
#pragma unroll 1
        for (int q = 0; q < 4; ++q) {
            const int t = r0 + F.wave * 4 + q; if (t >= rend) break;
            const bool lat = t < M; const int T = lat ? SEQ : CTXL; const int tt = lat ? t % SEQ : (t - M) % CTXL; const int bidx = lat ? t / SEQ : NB;
            const int sc0 = t - r0 + 8;
            const float* scp = modl + bidx * NMOD + DM;
#pragma unroll
            for (int g = 0; g < 4; ++g) {
                const int hw = 1 << g, col = 256 * g + 4 * F.lane;
                float s0 = 0.f, s1 = 0.f, s2 = 0.f, s3 = 0.f; int cnt = 0;
#pragma unroll
                for (int d = -hw; d < hw; ++d) { const bool ok = (tt + d >= 0) && (tt + d < T); const v2u x = *(const LAS v2u*)(XN + (sc0 + d) * 2048 + col * 2);
                    s0 += ok ? bflo(x.x) : 0.f; s1 += ok ? bfhi(x.x) : 0.f; s2 += ok ? bflo(x.y) : 0.f; s3 += ok ? bfhi(x.y) : 0.f; cnt += ok ? 1 : 0; }
                const v2u xc = *(const LAS v2u*)(XN + sc0 * 2048 + col * 2); const float ic = 1.0f / (float)cnt;
                const f32x4 gv = *(const f32x4*)(gn + col), sv = *(const f32x4*)(scp + col);
                v2u o; o.x = pg8::cvt_pk_bf16(gv.x * (sv.x + 1.0f) * (s0 * ic - bflo(xc.x)), gv.y * (sv.y + 1.0f) * (s1 * ic - bfhi(xc.x)));
                o.y = pg8::cvt_pk_bf16(gv.z * (sv.z + 1.0f) * (s2 * ic - bflo(xc.y)), gv.w * (sv.w + 1.0f) * (s3 * ic - bfhi(xc.y)));
                *(v2u*)(P + ((size_t)g * MT + t) * 256 + 4 * F.lane) = o;
            }
        }
        __syncthreads();
    }
}

__device__ __forceinline__ void o5_phase(Frame& F, int nrows) {
    fresh(F);
    unsigned char* ws = F.ws;
    const int* CNT = (const int*)(ws + WS_CNT); int* TST = (int*)(ws + WS_TST); const int* EIDX = (const int*)(ws + WS_EIDX); int* POS = (int*)(ws + WS_POS);
    const bf16* U = (const bf16*)(ws + WS_U); bf16* VG = (bf16*)(ws + WS_VG);
    LAS int* lc = (LAS int*)(F.lds + RING_OFF);
    LAS int* lbase = lc + 512 * 8;
    LAS int* lpos = lbase + 32;
    const int rpw = (nrows + F.G - 1) / F.G;
    for (int e = F.tid; e < F.G * 8; e += 512) lc[e] = CNT[e];
    __syncthreads();
    {
        const int e = F.wave; int c4[4]; int sum = 0;
#pragma unroll
        for (int q = 0; q < 4; ++q) { const int w = 4 * F.lane + q; c4[q] = (w < F.G) ? lc[w * 8 + e] : 0; sum += c4[q]; }
        int incl = sum;
#pragma unroll
        for (int o = 1; o < 64; o <<= 1) { const int t = __builtin_amdgcn_ds_bpermute((F.lane >= o ? F.lane - o : F.lane) << 2, incl); if (F.lane >= o) incl += t; }
        const int total = __builtin_amdgcn_readlane(incl, 63); int excl = incl - sum;
        const int myq = (int)blockIdx.x & 3; int pre = excl;
#pragma unroll
        for (int q = 0; q < 3; ++q) if (q < myq) pre += c4[q];
        if (F.lane == ((int)blockIdx.x >> 2)) { lbase[e] = pre; lbase[8 + e] = total; }
    }
    __syncthreads();
    if (F.tid == 0) {
        int ts = 0;
        for (int e = 0; e < 8; ++e) { const int pre = lbase[e], tot = lbase[8 + e]; lbase[e] = ts * 256 + pre; if (blockIdx.x == 0) TST[e] = ts; ts += (tot + 255) >> 8; }
        if (blockIdx.x == 0) TST[8] = ts;
    }
    __syncthreads();
    if (F.wave == 0) {
        int run[8];
#pragma unroll
        for (int e = 0; e < 8; ++e) run[e] = lbase[e];
        const int npairs = 2 * rpw;
        for (int c0 = 0; c0 < npairs; c0 += 64) {
            const int pl = c0 + F.lane; const int row = (int)blockIdx.x * rpw + (pl >> 1); const bool ok = pl < npairs && row < nrows;
            const int e = ok ? EIDX[2 * row + (pl & 1)] : -1; int mypos = 0;
#pragma unroll
            for (int x = 0; x < 8; ++x) { const unsigned long long mk = __ballot(e == x); const int below = __popcll(mk & ((1ull << F.lane) - 1ull)); if (e == x) mypos = run[x] + below; run[x] += __popcll(mk); }
            if (ok) { lpos[pl] = mypos; POS[2 * row + (pl & 1)] = mypos; }
        }
    }
    __syncthreads();
    for (int pl0 = F.wave * 4; pl0 < 2 * rpw; pl0 += NWAVES * 4) {
        v4u a[4], b[4]; int p[4];
#pragma unroll
        for (int q = 0; q < 4; ++q) { const int pl = pl0 + q; const int row = (int)blockIdx.x * rpw + (pl >> 1); p[q] = -1;
            if (pl < 2 * rpw && row < nrows) { p[q] = lpos[pl]; a[q] = *(const v4u*)(U + (size_t)row * DM + 8 * F.lane); b[q] = *(const v4u*)(U + (size_t)row * DM + 512 + 8 * F.lane); } }
#pragma unroll
        for (int q = 0; q < 4; ++q) if (p[q] >= 0) { *(v4u*)(VG + (size_t)p[q] * DM + 8 * F.lane) = a[q]; *(v4u*)(VG + (size_t)p[q] * DM + 512 + 8 * F.lane) = b[q]; }
    }
    __syncthreads();
}

__global__ void __launch_bounds__(NWAVES * 64, 2) mega_fwd(Args args) {
    extern __shared__ __attribute__((aligned(16))) unsigned char lds[];
    Frame F;
    F.lds = (LAS unsigned char*)lds;
    F.wave = __builtin_amdgcn_readfirstlane((int)threadIdx.x >> 6); fresh(F);
    F.G = gridDim.x; { const int bx = blockIdx.x; F.vcu = (F.G % 8 == 0) ? (bx % 8) * (F.G / 8) + bx / 8 : bx; }
    F.in = args.in; F.out = args.out; F.ws = args.ws;
    unsigned char* ws = args.ws;
    volatile LAS unsigned* MISC = (volatile LAS unsigned*)(F.lds + MISC_OFF);
    for (int u = F.tid; u < (LDS_BYTES - LDSCTL_OFF) / 4; u += NWAVES * 64) ((LAS unsigned*)(F.lds + LDSCTL_OFF))[u] = 0u;
    __syncthreads();
    XcdBarrier bar = xcd_barrier_post((unsigned*)(ws + WS_CTL) + CW_BAR, MISC + 8, F.wave);
#define GRID_BAR() do { xcd_barrier(bar); if (DUPMASK & 4096) xcd_barrier(bar); } while (0)
#ifndef ONLY
#define ONLY 0
#endif
#define PH(n) (ONLY == 0 || ONLY == (n))
#define REP(bit) for (int rep_ = 0; rep_ < ((DUPMASK & (bit)) ? 2 : 1); ++rep_)
    LAS unsigned char* ring = F.lds + RING_OFF;
    const float* MODV = (const float*)(ws + WS_MODV);
    float* HC = (float*)(ws + WS_HC);
    bf16* U = (bf16*)(ws + WS_U);

#if PH(20)
    REP(8192) p0_prologue(F);
#endif
    GRID_BAR();

    for (int lp = 0; lp < 2; ++lp) {
        const int le = 2 * lp, lo = 2 * lp + 1, j = lp;
        const bool ctx_out = (lp == 0);
        const int nro = ctx_out ? MT : M;
        const float* modE = MODV + (size_t)le * 17 * NMOD; const float* modO = MODV + (size_t)lo * 17 * NMOD;
        const float* hin_l = (lp == 0) ? args.in[0] : args.out; const float* hin_c = (lp == 0) ? args.in[2] : HC;
#if PH(1)
        {
            RowArgs A{}; A.hin_l = hin_l; A.hin_c = hin_c; A.hout_l = args.out; A.hout_c = HC; A.g = args.in[6] + (size_t)(le * 2 + 0) * DM; A.modl = modE; A.shoff = 0; A.scoff = DM; A.U = U;
            A.Y = (const bf16*)(ws + WS_VG); A.pos = (const int*)(ws + WS_POS); A.gate = (const float*)(ws + WS_GATE); A.modprev = MODV + (size_t)(le - 1) * 17 * NMOD;
            if (lp == 0) row_phase<false, 1, false>(F, A, MT); else row_phase<true, 1, false>(F, A, MT);
        }
#endif
        GRID_BAR();
#if PH(2)
        {
            pg8::Gemm g{U, (const bf16*)(ws + WS_WIN) + (size_t)j * INP * DM, DM, DM, DM}; pg8::InOrder S; S.init(ctx_out, F.G, (int)blockIdx.x);
            EpiIn E{(bf16*)(ws + WS_CQ), (bf16*)(ws + WS_KR), (bf16*)(ws + WS_CKV), (bf16*)(ws + WS_HQ)};
            REP(8) pg8::gemm_phase<EpiIn, pg8::InOrder, true>(ring, g, S, E, F.wave);
        }
#endif
        GRID_BAR();
#if PH(3)
        REP(4 | 32) e3_phase(F);
#endif
        GRID_BAR();
#if PH(4)
        {
            pg8::Gemm g{(const bf16*)(ws + WS_CQ), (const bf16*)(ws + WS_WUQ) + (size_t)j * 768 * QL, QL, QL, QL}; pg8::StaticOrder S; S.init(nro, 768, F.G, (int)blockIdx.x);
            EpiQ E{(bf16*)(ws + WS_QB), (const float*)(ws + WS_RSQ)};
            REP(8) pg8::gemm_phase<EpiQ, pg8::StaticOrder, true>(ring, g, S, E, F.wave);
        }
        {
            pg8::Gemm g{(const bf16*)(ws + WS_CKV), (const bf16*)(ws + WS_WUKV) + (size_t)j * 1024 * KVL, KVL, KVL, KVL}; pg8::StaticOrder S; S.init(MT, 1024, F.G, (int)blockIdx.x);
            EpiKV E{(bf16*)(ws + WS_KN), (bf16*)(ws + WS_VV), (const float*)(ws + WS_RSKV)};
            REP(8) pg8::gemm_phase<EpiKV, pg8::StaticOrder, true>(ring, g, S, E, F.wave);
        }
#endif
        GRID_BAR();
#if PH(6)
        REP(3) mix_phase(F, j, ctx_out);
#endif
        GRID_BAR();
#if PH(8)
        REP(4 | 64) e8_phase(F, j, nro);
#endif
        GRID_BAR();
#if PH(9)
        {
            pg8::Gemm g{(const bf16*)(ws + WS_MIX), (const bf16*)(ws + WS_WOUT) + (size_t)j * DM * DM, DM, DM, DM}; pg8::StaticOrder S; S.init(nro, DM, F.G, (int)blockIdx.x);
            EpiResid E{hin_l, hin_c, args.out, HC, modE, 2 * DM};
            pg8::gemm_phase<EpiResid, pg8::StaticOrder, true>(ring, g, S, E, F.wave);
        }
#endif
        GRID_BAR();
#if PH(10)
        {
            RowArgs A{}; A.hin_l = args.out; A.hin_c = HC; A.g = args.in[6] + (size_t)(le * 2 + 1) * DM; A.modl = modE; A.shoff = 3 * DM; A.scoff = 4 * DM; A.U = U;
            REP(4 | 128) row_phase<false, 1, false>(F, A, nro);
        }
#endif
        GRID_BAR();
#if PH(11)
        {
            pg8::Gemm g{U, (const bf16*)(ws + WS_WGU) + (size_t)j * 2 * DFF * DM, DM, DM, DM}; pg8::StaticOrder S; S.init(nro, 2 * DFF, F.G, (int)blockIdx.x);
            EpiGateUp E{(bf16*)(ws + WS_HID), DFF, 2 * DFF / 256, 0};
            REP(8) pg8::gemm_phase<EpiGateUp, pg8::StaticOrder, true>(ring, g, S, E, F.wave);
        }
#endif
        GRID_BAR();
#if PH(12)
        {
            pg8::Gemm g{(const bf16*)(ws + WS_HID), (const bf16*)(ws + WS_WDN) + (size_t)j * DM * DFF, DFF, DFF, DFF}; pg8::StaticOrder S; S.init(nro, DM, F.G, (int)blockIdx.x);
            EpiResid E{args.out, HC, args.out, HC, modE, 5 * DM};
            pg8::gemm_phase<EpiResid, pg8::StaticOrder, true>(ring, g, S, E, F.wave);
        }
#endif
        GRID_BAR();
#if PH(13)
        {
            RowArgs A{}; A.hin_l = args.out; A.hin_c = HC; A.g = args.in[6] + (size_t)(lo * 2 + 0) * DM; A.modl = modO; A.shoff = 0; A.scoff = DM; A.U = U;
            REP(2048) o12_phase(F, nro, args.out, HC, A.g, modO);
            REP(16) for (int e = 0; e < NE; ++e) {
                conv_matrix(F, args.in[23] + ((size_t)j * NE + e) * DM * DFE, DM, DFE, (bf16*)(ws + WS_MWGU) + (size_t)e * 2 * DFE * DM, DM, 2, 0, nullptr, 1.f);
                conv_matrix(F, args.in[24] + ((size_t)j * NE + e) * DM * DFE, DM, DFE, (bf16*)(ws + WS_MWGU) + (size_t)e * 2 * DFE * DM, DM, 2, 128, nullptr, 1.f);
                conv_matrix(F, args.in[25] + ((size_t)j * NE + e) * DFE * DM, DFE, DM, (bf16*)(ws + WS_MWDN) + (size_t)e * DM * DFE, DFE, 0, 0, nullptr, 1.f);
            }
        }
#endif
        GRID_BAR();
#if PH(15)
        {
            pg8::Gemm g{(const bf16*)(ws + WS_POOLED), (const bf16*)(ws + WS_WPOOL) + (size_t)j * 4 * 65536, 256, 256, 256};
            pg8::PoolOrder S{nro / 256, MT / 256, F.G, (int)blockIdx.x};
            EpiPool E{args.out, HC, modO, args.in[20] + (size_t)j * DM, args.in[21] + (size_t)j * DM, MT / 256};
            pg8::gemm_phase<EpiPool, pg8::PoolOrder, true>(ring, g, S, E, F.wave);
        }
#endif
        GRID_BAR();
#if PH(16)
        {
            RowArgs A{}; A.hin_l = args.out; A.hin_c = HC; A.g = args.in[6] + (size_t)(lo * 2 + 1) * DM; A.modl = modO; A.shoff = 3 * DM; A.scoff = 4 * DM; A.U = U;
            A.router = args.in[22] + (size_t)j * DM * NE; A.eidx = (int*)(ws + WS_EIDX); A.gout = (float*)(ws + WS_GATE); A.cnt = (int*)(ws + WS_CNT);
            REP(4 | 512) row_phase<false, 1, true>(F, A, nro);
        }
#endif
        GRID_BAR();
#if PH(17)
        REP(4 | 1024) o5_phase(F, nro);
#endif
        GRID_BAR();
#if PH(18)
        {
            const int* TST = (const int*)(ws + WS_TST);
            const int ts1 = TST[1], ts2 = TST[2], ts3 = TST[3], ts4 = TST[4], ts5 = TST[5], ts6 = TST[6], ts7 = TST[7], nT = TST[8];
            for (int c = 0; c * MOE_CH < nT; ++c) {
                const int t0 = c * MOE_CH, nrt = (nT - t0) < MOE_CH ? (nT - t0) : MOE_CH;
                {
                    pg8::Gemm g{(const bf16*)(ws + WS_VG), (const bf16*)(ws + WS_MWGU), DM, DM, DM};
                    pg8::MoeOrder S{t0, nrt, 2 * DFE / 256, F.G, (int)blockIdx.x, ts1, ts2, ts3, ts4, ts5, ts6, ts7};
                    EpiGateUp E{(bf16*)(ws + WS_HIDM), DFE, 2 * DFE / 256, t0 * 256};
                    REP(8) pg8::gemm_phase<EpiGateUp, pg8::MoeOrder, true>(ring, g, S, E, F.wave);
                }
                GRID_BAR();
                {
                    pg8::Gemm g{(const bf16*)(ws + WS_HIDM) - (size_t)t0 * 256 * DFE, (const bf16*)(ws + WS_MWDN), DFE, DFE, DFE};
                    pg8::MoeOrder S{t0, nrt, DM / 256, F.G, (int)blockIdx.x, ts1, ts2, ts3, ts4, ts5, ts6, ts7};
                    EpiY E{(bf16*)(ws + WS_VG), DM / 256};
                    REP(8) pg8::gemm_phase<EpiY, pg8::MoeOrder, true>(ring, g, S, E, F.wave);
                }
                GRID_BAR();
            }
        }
#endif
    }
#if PH(19)
    {
        RowArgs A{}; A.hin_l = args.out; A.hin_c = HC; A.hout_l = args.out; A.hout_c = HC; A.g = args.in[7];
        A.Y = (const bf16*)(ws + WS_VG); A.pos = (const int*)(ws + WS_POS); A.gate = (const float*)(ws + WS_GATE); A.modprev = MODV + (size_t)3 * 17 * NMOD;
        row_phase<true, 2, false>(F, A, M);
        if (xb_ld((unsigned*)(ws + WS_CTL) + CW_BAR + XB_TMO) != 0u) { __syncthreads(); const float qn = __builtin_nanf(""); for (int i = F.tid; i < 1024; i += 512) args.out[(size_t)blockIdx.x * 1024 + i] = qn; }
    }
#endif
}

extern "C" void kernel_launch(void* const* d_in, const int* in_sizes, int n_in, void* d_out, int out_size, void* d_ws, size_t ws_size, hipStream_t stream) {
    static int grid = 0;
    if (grid == 0) {
        if (n_in != 26 || out_size != M * DM || ws_size < WS_END) { fprintf(stderr, "kernel_launch: unexpected shapes (n_in %d out %d ws %zu)\n", n_in, out_size, ws_size); grid = -1; return; }
        int dev = 0, cus = 0, per_cu = 0;
        if (hipGetDevice(&dev) != hipSuccess || hipDeviceGetAttribute(&cus, hipDeviceAttributeMultiprocessorCount, dev) != hipSuccess) { grid = -1; return; }
        if (hipFuncSetAttribute((const void*)mega_fwd, hipFuncAttributeMaxDynamicSharedMemorySize, LDS_BYTES) != hipSuccess) { grid = -1; return; }
        if (hipOccupancyMaxActiveBlocksPerMultiprocessor(&per_cu, (const void*)mega_fwd, NWAVES * 64, LDS_BYTES) != hipSuccess || per_cu < 1) fprintf(stderr, "kernel_launch: occupancy query says %d\n", per_cu);
        (void)hipGetLastError();
        grid = cus > 256 ? 256 : cus;
    }
    if (grid < 0) return;
    if (hipMemsetAsync((char*)d_ws + WS_CTL, 0, CTL_ZERO_BYTES, stream) != hipSuccess) return;
    Args a{};
    for (int i = 0; i < 26; ++i) a.in[i] = (const float*)d_in[i];
    a.out = (float*)d_out; a.ws = (unsigned char*)d_ws;
    hipLaunchKernelGGL(mega_fwd, dim3(grid), dim3(NWAVES * 64), LDS_BYTES, stream, a);
}
```

```cpp
#include <hip/hip_runtime.h>
#ifndef DUPMASK
#define DUPMASK 0
#endif
#include <cstdio>
#include <cstdint>

__device__ __forceinline__ int lane_now() { int l; asm volatile("v_mbcnt_lo_u32_b32 %0, -1, 0\n\tv_mbcnt_hi_u32_b32 %0, -1, %0" : "=v"(l)); return l; }
namespace pg8 {
#define PG8_LAS __attribute__((address_space(3)))
typedef unsigned short bf16_t;
typedef short bf16x8 __attribute__((ext_vector_type(8)));
typedef float f32x4 __attribute__((ext_vector_type(4)));
typedef unsigned u32x4 __attribute__((ext_vector_type(4)));
constexpr int BM = 256, BK = 64, HALF = 128, HTB = HALF * BK * 2, STAGE_BYTES = 8 * HTB, NXCD = 8, WGM = 8;

__host__ __device__ __forceinline__ int lds_byte(int r, int c) { const int st = (r >> 4) * 2 + (c >> 5), rr = r & 15, cc = c & 31, ob = rr * 64 + cc * 2; return st * 1024 + (ob ^ (((ob >> 9) & 1) << 5)); }
__host__ __device__ __forceinline__ void stage_rc(int b, int& R, int& C) { const int st = b / 1024, sb = b % 1024, swz = sb ^ (((sb >> 9) & 1) << 5); R = (st >> 1) * 16 + swz / 64; C = (st & 1) * 32 + (swz % 64) / 2; }
__host__ __device__ __forceinline__ int perm32(int rho) { const int n = rho >> 4, i = rho & 15; return 8 * (i >> 2) + 4 * n + (i & 3); }

struct Unit { int pm, pn; };
struct Gemm { const bf16_t* A; const bf16_t* Bt; int lda, ldb, K; };

struct StaticOrder {
    int nM, nN, nwg, G, c;
    __device__ void init(int M, int N, int G_, int c_) { nM = M / BM; nN = N / BM; nwg = nM * nN; G = G_; c = c_; }
    __device__ bool next(int i, Unit& u) const {
        const long L = (long)i * G + c; if (L >= nwg) return false;
        int wgid = (int)L; { const int q = nwg / NXCD, r = nwg % NXCD, xcd = wgid % NXCD, off = wgid / NXCD; wgid = (xcd < r ? xcd * (q + 1) : r * (q + 1) + (xcd - r) * q) + off; }
        const int nig = WGM * nN, gid = wgid / nig, fm = gid * WGM, gsz = (nM - fm) < WGM ? (nM - fm) : WGM;
        u.pm = fm + ((wgid % nig) % gsz); u.pn = (wgid % nig) / gsz; return true;
    }
};
struct InOrder {
    StaticOrder lat; int nlat, nctx_ct, G, c;
    __device__ void init(bool full, int G_, int c_) { lat.init(32768, 3328, G_, c_); nlat = lat.nwg; nctx_ct = full ? 13 : 8; G = G_; c = c_; }
    __device__ bool next(int i, Unit& u) const {
        const int L = i * G + c; if (L < nlat) return lat.next(i, u);
        const int x = L - nlat; if (x >= 16 * nctx_ct) return false;
        const int rt = (nctx_ct == 13) ? x / 13 : x >> 3, q = x - rt * nctx_ct; u.pm = 128 + rt; u.pn = (nctx_ct == 13) ? q : (q < 2 ? q + 1 : q + 3); return true;
    }
};
struct PoolOrder {
    int nrt, talloc, G, c;
    __device__ bool next(int i, Unit& u) const { const int L = i * G + c; if (L >= 4 * nrt) return false; const int g = L / nrt, rt = L - g * nrt; u.pm = g * talloc + rt; u.pn = g; return true; }
};
struct MoeOrder {
    int t0, nrt, nct, G, c; int ts1, ts2, ts3, ts4, ts5, ts6, ts7;
    int skipw, skipr;
    __device__ bool next(int i, Unit& u) const {
        const int nwg = nrt * nct; const int r_ = i + (c < skipw ? skipr : 0);
        const int L = (r_ < skipr) ? r_ * (G - skipw) + (c - skipw) : skipr * (G - skipw) + (r_ - skipr) * G + c; if (L >= nwg) return false;
        int wgid = L; { const int q = nwg / NXCD, r = nwg % NXCD, xcd = wgid % NXCD, off = wgid / NXCD; wgid = (xcd < r ? xcd * (q + 1) : r * (q + 1) + (xcd - r) * q) + off; }
        const int nig = WGM * nct, gid = wgid / nig, fm = gid * WGM, gsz = (nrt - fm) < WGM ? (nrt - fm) : WGM;
        const int rt = t0 + fm + ((wgid % nig) % gsz), ct = (wgid % nig) / gsz;
        const int e = (rt >= ts1) + (rt >= ts2) + (rt >= ts3) + (rt >= ts4) + (rt >= ts5) + (rt >= ts6) + (rt >= ts7);
        u.pm = rt; u.pn = e * nct + ct; return true;
    }
};

__device__ __forceinline__ unsigned cvt_pk_bf16(float lo, float hi) { unsigned r; asm volatile("v_cvt_pk_bf16_f32 %0, %1, %2" : "=v"(r) : "v"(lo), "v"(hi)); return r; }

template <class Epi, class Sched, bool ALIGN_EPI>
__device__ __forceinline__ void gemm_phase(PG8_LAS unsigned char* lds, const Gemm g, const Sched& S, const Epi& E, const int wid) {
    const int lane_ = lane_now();
    const int lane = lane_, tid = wid * 64 + lane, wr = wid >> 2, wc = wid & 3, fr = lane & 15, fq = lane >> 4;
    int K_ = g.K; asm volatile("" : "+s"(K_));
    const int K = K_, nt = K / BK;
    unsigned voffA[2], voffB[2];
#pragma unroll
    for (int i = 0; i < 2; ++i) { int R, C; stage_rc(tid * 16 + i * 8192, R, C); const int Rb = Epi::PERM ? ((R & ~31) + perm32(R & 31)) : R;
        voffA[i] = (unsigned)(R * g.lda + C) * 2u; voffB[i] = (unsigned)(Rb * g.ldb + C) * 2u; }
    const size_t kstep = (size_t)(BK * 2);
    const size_t hstepA = (size_t)HALF * g.lda * 2, hstepB = (size_t)HALF * g.ldb * 2;
    const size_t tstepA = 2 * hstepA, tstepB = 2 * hstepB;
    const unsigned ldsw = (unsigned)wid * 1024u;
    const int aoff = lds_byte(wr * 64 + fr, fq * 8), boff = lds_byte(wc * 32 + fr, fq * 8);
#define PG8_SA(b, h) (((b) * 2 + (h)) * HTB)
#define PG8_SB(b, h) ((4 + (b) * 2 + (h)) * HTB)
#define PG8_STAGE(bufoff, gbase, voff) do { _Pragma("unroll") for (int _i = 0; _i < 2; ++_i) \
        __builtin_amdgcn_global_load_lds((const unsigned*)((const char*)(gbase) + (voff)[_i]), (PG8_LAS unsigned*)(lds + (bufoff) + ldsw + _i * 8192), 16, 0, 0); } while (0)
#define PG8_LDA(dst, b, h) do { _Pragma("unroll") for (int m = 0; m < 4; ++m) _Pragma("unroll") for (int k = 0; k < 2; ++k) dst[m][k] = *(const PG8_LAS bf16x8*)(lds + PG8_SA(b, h) + aoff + m * 2048 + k * 1024); } while (0)
#define PG8_LDB(dst, b, h) do { _Pragma("unroll") for (int n = 0; n < 2; ++n) _Pragma("unroll") for (int k = 0; k < 2; ++k) dst[n][k] = *(const PG8_LAS bf16x8*)(lds + PG8_SB(b, h) + boff + n * 2048 + k * 1024); } while (0)
#define PG8_MMA(ai, bj, At, Bt) do { __builtin_amdgcn_s_setprio(1); _Pragma("unroll") for (int m = 0; m < 4; ++m) _Pragma("unroll") for (int n = 0; n < 2; ++n) _Pragma("unroll") for (int k = 0; k < 2; ++k) \
        acc[ai][bj][m][n] = __builtin_amdgcn_mfma_f32_16x16x32_bf16(Bt[n][k], At[m][k], acc[ai][bj][m][n], 0, 0, 0); __builtin_amdgcn_s_setprio(0); } while (0)
#define PG8_WAIT_V(n) asm volatile("s_waitcnt vmcnt(" #n ")" ::: "memory")
#define PG8_WAIT_L(n) asm volatile("s_waitcnt lgkmcnt(" #n ")" ::: "memory")
#define PG8_BAR __builtin_amdgcn_s_barrier()
#define PG8_SCHED __builtin_amdgcn_sched_barrier(0)
    Unit cur, nxt; int ui = 0;
    if (!S.next(0, cur)) return;
    f32x4 acc[2][2][4][2];
#pragma unroll
    for (int a = 0; a < 2; ++a)
#pragma unroll
        for (int b = 0; b < 2; ++b)
#pragma unroll
            for (int m = 0; m < 4; ++m)
#pragma unroll
                for (int n = 0; n < 2; ++n) acc[a][b][m][n] = (f32x4){0.f, 0.f, 0.f, 0.f};
    bf16x8 At[4][2], B0[2][2], B1[2][2];
    const char* cA = (const char*)g.A + (size_t)cur.pm * tstepA; const char* cB = (const char*)g.Bt + (size_t)cur.pn * tstepB;
    PG8_STAGE(PG8_SB(0, 0), cB, voffB); PG8_STAGE(PG8_SB(0, 1), cB + hstepB, voffB); PG8_STAGE(PG8_SA(0, 0), cA, voffA); PG8_STAGE(PG8_SA(0, 1), cA + hstepA, voffA);
    if (wr == 1) PG8_BAR;
    PG8_WAIT_V(2); PG8_BAR;
    PG8_STAGE(PG8_SB(1, 0), cB + kstep, voffB); PG8_STAGE(PG8_SA(1, 0), cA + kstep, voffA); PG8_STAGE(PG8_SB(1, 1), cB + hstepB + kstep, voffB);
    PG8_WAIT_V(6); PG8_BAR;
    for (;;) {
        const bool has_next = S.next(ui + 1, nxt);
        const char* nA = has_next ? (const char*)g.A + (size_t)nxt.pm * tstepA : cA; const char* nB = has_next ? (const char*)g.Bt + (size_t)nxt.pn * tstepB : cB;
#pragma unroll 1
        for (int t = 0; t < nt; t += 2) {
            const bool last = (t == nt - 2);
            const char* a1 = cA + (size_t)(t + 1) * kstep;
            const char* a2 = last ? nA : cA + (size_t)(t + 2) * kstep; const char* b2 = last ? nB : cB + (size_t)(t + 2) * kstep;
            const char* a3 = a2 + kstep; const char* b3 = b2 + kstep;
            PG8_LDB(B0, 0, 0); PG8_LDB(B1, 0, 1); PG8_SCHED; PG8_LDA(At, 0, 0); PG8_STAGE(PG8_SA(1, 1), a1 + hstepA, voffA);
            PG8_WAIT_V(8); PG8_WAIT_L(0); PG8_BAR; PG8_MMA(0, 0, At, B0); PG8_MMA(0, 1, At, B1); PG8_BAR; PG8_SCHED;
            PG8_LDA(At, 0, 1); PG8_STAGE(PG8_SB(0, 0), b2, voffB); PG8_STAGE(PG8_SB(0, 1), b2 + hstepB, voffB); PG8_STAGE(PG8_SA(0, 0), a2, voffA);
            PG8_WAIT_V(8); PG8_WAIT_L(0); PG8_BAR; PG8_MMA(1, 0, At, B0); PG8_MMA(1, 1, At, B1); PG8_BAR; PG8_SCHED;
            PG8_LDB(B0, 1, 0); PG8_LDB(B1, 1, 1); PG8_SCHED; PG8_LDA(At, 1, 0); PG8_STAGE(PG8_SA(0, 1), a2 + hstepA, voffA);
            PG8_WAIT_V(8); PG8_WAIT_L(0); PG8_BAR; PG8_MMA(0, 0, At, B0); PG8_MMA(0, 1, At, B1); PG8_BAR; PG8_SCHED;
            PG8_LDA(At, 1, 1); PG8_STAGE(PG8_SB(1, 0), b3, voffB); PG8_STAGE(PG8_SB(1, 1), b3 + hstepB, voffB); PG8_STAGE(PG8_SA(1, 0), a3, voffA);
            PG8_WAIT_V(8); PG8_WAIT_L(0); PG8_BAR; PG8_MMA(1, 0, At, B0); PG8_MMA(1, 1, At, B1); PG8_BAR; PG8_SCHED;
        }
        if constexpr (ALIGN_EPI) { if (wr == 0) PG8_BAR; }
        E(acc, cur, wr, wc, fr, fq);
        if (!has_next) break;
#pragma unroll
        for (int a = 0; a < 2; ++a)
#pragma unroll
            for (int b = 0; b < 2; ++b)
#pragma unroll
                for (int m = 0; m < 4; ++m)
#pragma unroll
                    for (int n = 0; n < 2; ++n) acc[a][b][m][n] = (f32x4){0.f, 0.f, 0.f, 0.f};
        cur = nxt; cA = nA; cB = nB; ++ui;
        if constexpr (ALIGN_EPI) { if (wr == 1) PG8_BAR; }
    }
    PG8_WAIT_V(0);
    if constexpr (!ALIGN_EPI) { if (wr == 0) PG8_BAR; }
    PG8_BAR;
#undef PG8_SA
#undef PG8_SB
#undef PG8_STAGE
#undef PG8_LDA
#undef PG8_LDB
#undef PG8_MMA
#undef PG8_WAIT_V
#undef PG8_WAIT_L
#undef PG8_BAR
#undef PG8_SCHED
}
}

constexpr int NWAVES = 8;
constexpr int DM = 1024, NB = 16, SEQ = 2048, CTXL = 256;
constexpr int M = NB * SEQ, MC = NB * CTXL, MT = M + MC;
constexpr int QL = 384, KVL = 256, ROPE = 32, HW = 512, NH = 8, QKD = 96, VD = 64;
constexpr int INW = 3232, INP = 3328;
constexpr int DFF = 2816, NE = 8, DFE = 3584, NMOD = 6 * DM;
constexpr int NHH = 4, HK = 128; constexpr int NKEY = SEQ + CTXL;
constexpr float EPS = 1e-6f;
constexpr int MAXT = 296;
constexpr int MOE_CH = 128;

constexpr size_t MiB = 1u << 20;
constexpr size_t WS_CTL = 0, CTL_ZERO_BYTES = 1 * MiB;
constexpr size_t WS_MODV = 1 * MiB;
constexpr size_t WS_ROPE = 3 * MiB;
constexpr size_t WS_CNT = 3 * MiB + 64 * 1024;
constexpr size_t WS_TST = 3 * MiB + 128 * 1024;
constexpr size_t WS_EIDX = 4 * MiB, WS_GATE = 4 * MiB + 512 * 1024, WS_POS = 5 * MiB;
constexpr size_t WS_RSQ = 6 * MiB, WS_RSKV = 6 * MiB + 256 * 1024;
constexpr size_t WS_HC = 8 * MiB;
constexpr size_t WS_WIN = 24 * MiB, WS_WUQ = 37 * MiB, WS_WUKV = 39 * MiB, WS_WOUT = 40 * MiB, WS_WGU = 44 * MiB, WS_WDN = 66 * MiB, WS_WPOOL = 77 * MiB;
constexpr size_t WS_U = 80 * MiB;
constexpr size_t WS_X = 152 * MiB;
constexpr size_t WS_CQ = WS_X, WS_CKV = 179 * MiB, WS_KR = 197 * MiB, WS_KRR = 200 * MiB, WS_HQ = 203 * MiB  ;
constexpr size_t WS_QB = 383 * MiB, WS_KN = 437 * MiB, WS_VV = 473 * MiB, WS_OF = 509 * MiB, WS_OB = 581 * MiB, WS_MIX = 653 * MiB, WS_HID = WS_X;
constexpr size_t WS_MWGU = WS_X, WS_MWDN = 264 * MiB, WS_POOLED = 320 * MiB, WS_VG = 392 * MiB, WS_HIDM = 540 * MiB, WS_END = 988 * MiB;
constexpr size_t HSEG = (size_t)MT * HW;
static_assert(WS_HQ + 5 * HSEG * 2 <= WS_QB && WS_MIX + (size_t)MT * DM * 2 <= WS_END && WS_HID + (size_t)MT * DFF * 2 <= WS_QB, "ws map even");
static_assert(WS_HIDM + (size_t)2 * MOE_CH * 256 * DFE * 2 <= WS_END && WS_VG + (size_t)MAXT * 256 * DM * 2 <= WS_HIDM && WS_MWDN + (size_t)NE * DM * DFE * 2 <= WS_POOLED && WS_MWGU + (size_t)NE * 2 * DFE * DM * 2 <= WS_MWDN, "ws map odd");
constexpr int CW_BAR = 4096;

constexpr int RING_OFF = 0, RING_BYTES = 141312;
constexpr int LDSCTL_OFF = RING_BYTES, MISC_OFF = LDSCTL_OFF + 320;
constexpr int LDS_BYTES = 147456;

#define GAS __attribute__((address_space(1)))
#define LAS __attribute__((address_space(3)))
typedef unsigned short bf16;
typedef unsigned v4u __attribute__((ext_vector_type(4)));
typedef unsigned v2u __attribute__((ext_vector_type(2)));
typedef float f32x4 __attribute__((ext_vector_type(4)));
typedef GAS unsigned gu32;
#define RLX_AGENT __ATOMIC_RELAXED, __HIP_MEMORY_SCOPE_AGENT
#define LDS_WAIT() asm volatile("s_waitcnt lgkmcnt(0)" ::: "memory")
__device__ __forceinline__ unsigned f2bf(float f) { unsigned u = __builtin_bit_cast(unsigned, f); return (u + 0x7fffu + ((u >> 16) & 1u)) >> 16; }
__device__ __forceinline__ unsigned pk2(float lo, float hi) { return f2bf(lo) | (f2bf(hi) << 16); }
__device__ __forceinline__ float bf2f(unsigned short b) { return __uint_as_float((unsigned)b << 16); }
__device__ __forceinline__ float bflo(unsigned w) { return __uint_as_float(w << 16); }
__device__ __forceinline__ float bfhi(unsigned w) { return __uint_as_float(w & 0xffff0000u); }
__device__ __forceinline__ float sigmoidf_(float x) { return 1.0f / (1.0f + __expf(-x)); }
__device__ __forceinline__ float siluf_(float x) { return x * __builtin_amdgcn_rcpf(1.0f + __expf(-x)); }

#define XB_TMO      128
#define XB_XCNT(j)  (256  + 64 * (j))
#define XB_XSUB(j)  (1280 + 64 * (j))
#define XB_XGEN(j)  (2304 + 64 * (j))
#define XB_TOP      3328
#define XB_TOPGEN   3392
#define XCD_BAR_WORDS 3456
#define XB_SPIN_CAP (1u << 22)
__device__ __forceinline__ unsigned xb_ld(unsigned* p)              { return __hip_atomic_load(p, __ATOMIC_RELAXED, __HIP_MEMORY_SCOPE_AGENT); }
__device__ __forceinline__ unsigned xb_add(unsigned* p, unsigned v) { return __hip_atomic_fetch_add(p, v, __ATOMIC_RELAXED, __HIP_MEMORY_SCOPE_AGENT); }
__device__ __forceinline__ unsigned xb_xcc_id() { return (unsigned)__builtin_amdgcn_s_getreg((3 << 11) | 20) & 0xFu; }
#define XB_SPIN(cond, bar) do { unsigned _sp = 0; while (cond) { __builtin_amdgcn_s_sleep(1); \
    if ((++_sp & 255u) == 0u) { if (xb_ld(&(bar)[XB_TMO])) break; if (_sp > XB_SPIN_CAP) { atomicAdd(&(bar)[XB_TMO], 1u); break; } } } } while (0)
struct XcdBarrier { unsigned* bar; unsigned x; volatile LAS unsigned* st; int wave; };
__device__ __forceinline__ bool xb_leader(int wave) { return wave == 0 && lane_now() == 0; }
__device__ __forceinline__ XcdBarrier xcd_barrier_post(unsigned* bar, volatile LAS unsigned* st, int wave) {
    XcdBarrier b; b.bar = bar; b.x = xb_xcc_id(); b.st = st; b.wave = wave;
    if (xb_leader(wave)) (void)xb_add(&bar[XB_XCNT(b.x)], 1u);
    return b;
}
__device__ __forceinline__ void xcd_barrier_complete(unsigned* bar, unsigned x, unsigned& nloc, unsigned& nx) {
    const unsigned G = gridDim.x * gridDim.y * gridDim.z;
    unsigned sum, cnt, mine, sp = 0u;
    for (;;) {
        sum = 0u; cnt = 0u; mine = 0u;
#pragma unroll
        for (unsigned j = 0; j < 16; ++j) { const unsigned c = xb_ld(&bar[XB_XCNT(j)]); sum += c; cnt += (c > 0u) ? 1u : 0u; mine = (j == x) ? c : mine; }
        if (sum == G) break;
        __builtin_amdgcn_s_sleep(1);
        if ((++sp & 255u) == 0u) { if (xb_ld(&bar[XB_TMO])) break; if (sp > XB_SPIN_CAP) { atomicAdd(&bar[XB_TMO], 1u); break; } }
    }
    nloc = mine > 0u ? mine : 1u; nx = cnt > 0u ? cnt : 1u;
}
__device__ __forceinline__ void xcd_barrier(const XcdBarrier& b) {
    asm volatile("s_waitcnt vmcnt(0)" ::: "memory");
    __syncthreads();
    if (xb_leader(b.wave)) {
        unsigned* bar = b.bar; asm volatile("" : "+s"(bar));
        __builtin_amdgcn_s_waitcnt(0);
        unsigned nloc = b.st[0], nx = b.st[1];
        if (nloc == 0u) { xcd_barrier_complete(bar, b.x, nloc, nx); b.st[0] = nloc; b.st[1] = nx; }
        const unsigned old = xb_add(&bar[XB_XSUB(b.x)], 1u);
        const unsigned gen = old / nloc;
        if (old + 1u == (gen + 1u) * nloc) {
            __builtin_amdgcn_fence(__ATOMIC_RELEASE, "agent");
            asm volatile("s_waitcnt vmcnt(0)" ::: "memory");
            const unsigned og = xb_add(&bar[XB_TOP], 1u);
            const unsigned tg = og / nx;
            if (og + 1u == (tg + 1u) * nx) xb_add(&bar[XB_TOPGEN], 1u);
            else XB_SPIN(xb_ld(&bar[XB_TOPGEN]) == tg, bar);
            __builtin_amdgcn_fence(__ATOMIC_ACQUIRE, "agent");
            xb_add(&bar[XB_XGEN(b.x)], 1u);
            asm volatile("s_waitcnt vmcnt(0)" ::: "memory");
        } else {
            XB_SPIN(xb_ld(&bar[XB_XGEN(b.x)]) == gen, bar);
            __builtin_amdgcn_fence(__ATOMIC_ACQUIRE, "agent");
            asm volatile("s_waitcnt vmcnt(0)" ::: "memory");
        }
    }
    __syncthreads();
}

struct Args { const float* in[26]; float* out; unsigned char* ws; };
struct Frame {
    LAS unsigned char* lds;
    int tid, lane, wave, G, vcu;
    const float* const* in; float* out; unsigned char* ws;
};
__device__ __forceinline__ float shx(float v, int lane, int m) { return __int_as_float(__builtin_amdgcn_ds_bpermute((lane ^ m) << 2, __float_as_int(v))); }
__device__ __forceinline__ float wave_sum(float v, int lane) {
#pragma unroll
    for (int o = 1; o < 64; o <<= 1) v += shx(v, lane, o);
    return v;
}

__device__ __forceinline__ void fresh(Frame& F) { const int l = lane_now(); F.lane = l; F.tid = F.wave * 64 + l; }

__device__ __forceinline__ void conv_item(const float* W, int ldw, bf16* WT, int ldd, int k0, int n0, int drow0, const float* kscale, float gscale, LAS float* scr, int lane) {
    float wv[32];
#pragma unroll
    for (int i = 0; i < 32; ++i) { const int kk = 2 * i + (lane >> 5); wv[i] = W[(size_t)(k0 + kk) * ldw + n0 + (lane & 31)]; }
#pragma unroll
    for (int i = 0; i < 32; ++i) { const int kk = 2 * i + (lane >> 5); float w = wv[i]; if (kscale) w *= kscale[k0 + kk]; scr[kk * 33 + (lane & 31)] = w * gscale; }
    LDS_WAIT(); asm volatile("" ::: "memory");
    const int c = lane & 7;
#pragma unroll
    for (int j = 0; j < 4; ++j) { const int n = (lane >> 3) + 8 * j; const LAS float* s = scr + (8 * c) * 33 + n;
        v4u o; o.x = pk2(s[0 * 33], s[1 * 33]); o.y = pk2(s[2 * 33], s[3 * 33]); o.z = pk2(s[4 * 33], s[5 * 33]); o.w = pk2(s[6 * 33], s[7 * 33]);
        *(v4u*)(WT + (size_t)(drow0 + n) * ldd + k0 + 8 * c) = o; }
    LDS_WAIT(); asm volatile("" ::: "memory");
}
__device__ __forceinline__ int conv_rowmap(int mode, int n0, int off) {
    if (mode == 0) return n0 + off;
    if (mode == 1) { if (n0 < 384) return n0; if (n0 < 640) return 512 + (n0 - 384); if (n0 < 672) return 384; return 768 + (n0 - 672); }
    return 256 * (n0 >> 7) + (n0 & 127) + off;
}
__device__ __forceinline__ void conv_matrix(Frame& F, const float* W, int K, int N, bf16* WT, int ldd, int mode, int off, const float* kscale, float gscale) {
    LAS float* scr = (LAS float*)(F.lds + RING_OFF + F.wave * 16384);
    const int gw = F.vcu * NWAVES + F.wave, NGW = F.G * NWAVES;
    const int nblk = N / 32, nitems = (K / 64) * nblk;
    for (int it = gw; it < nitems; it += NGW) { const int kb = it / nblk, nb = it % nblk; conv_item(W, N, WT, ldd, 64 * kb, 32 * nb, conv_rowmap(mode, 32 * nb, off), kscale, gscale, scr, F.lane); }
}

__device__ __forceinline__ int row_bidx(int row) { return row < M ? row / SEQ : NB; }

struct RowArgs {
    const float* hin_l; const float* hin_c; float* hout_l; float* hout_c;
    const float* g;
    const float* modl;
    int shoff, scoff;
    bf16* U;
    const bf16* Y; const int* pos; const float* gate; const float* modprev;
    const float* router; int* eidx; float* gout; int* cnt;
};
template <bool COMBINE, int OUTMODE, bool ROUTER>
__device__ __forceinline__ void row_phase(Frame& F, const RowArgs& A, int nrows) {
    fresh(F);
    const int rpw = (nrows + F.G - 1) / F.G;
    LAS int* lcnt = (LAS int*)(F.lds + RING_OFF);
    if (ROUTER) { if (F.tid < 8) lcnt[F.tid] = 0; __syncthreads(); }
    const int rbase = (int)blockIdx.x * rpw, rend = (rbase + rpw < nrows) ? rbase + rpw : nrows;
#define ROWPTR(r_) (((r_) < M) ? A.hin_l + (size_t)(r_) * DM : A.hin_c + (size_t)((r_) - M) * DM)
    f32x4 rw[16][2];
    if (ROUTER) {
#pragma unroll
        for (int j = 0; j < 4; ++j)
#pragma unroll
            for (int q = 0; q < 4; ++q) { const int col = 4 * F.lane + 256 * j + q; rw[4 * j + q][0] = *(const f32x4*)(A.router + (size_t)col * 8); rw[4 * j + q][1] = *(const f32x4*)(A.router + (size_t)col * 8 + 4); }
    }
    int row = rbase + F.wave;
    f32x4 v[4], vn[4];
    if (row < rend) { const float* hr = ROWPTR(row);
#pragma unroll
        for (int j = 0; j < 4; ++j) v[j] = *(const f32x4*)(hr + 4 * F.lane + 256 * j); }
    for (; row < rend; row += NWAVES) {
        const bool lat = row < M; const int bidx = lat ? row / SEQ : NB;
        const int rnext = row + NWAVES;
        if (rnext < rend) { const float* hr = ROWPTR(rnext);
#pragma unroll
            for (int j = 0; j < 4; ++j) vn[j] = *(const f32x4*)(hr + 4 * F.lane + 256 * j); }
        if (COMBINE) {
            const int pa = A.pos[2 * row], pb = A.pos[2 * row + 1]; const float ga = A.gate[2 * row], gb = A.gate[2 * row + 1];
            const float* g2 = A.modprev + bidx * NMOD + 5 * DM;
#pragma unroll
            for (int j = 0; j < 4; ++j) { const int col = 4 * F.lane + 256 * j;
                const v2u ya = *(const v2u*)(A.Y + (size_t)pa * DM + col), yb = *(const v2u*)(A.Y + (size_t)pb * DM + col); const f32x4 gv = *(const f32x4*)(g2 + col);
                v[j].x += gv.x * (ga * bflo(ya.x) + gb * bflo(yb.x)); v[j].y += gv.y * (ga * bfhi(ya.x) + gb * bfhi(yb.x));
                v[j].z += gv.z * (ga * bflo(ya.y) + gb * bflo(yb.y)); v[j].w += gv.w * (ga * bfhi(ya.y) + gb * bfhi(yb.y)); }
            if (OUTMODE != 2) { float* ho = lat ? A.hout_l + (size_t)row * DM : A.hout_c + (size_t)(row - M) * DM;
#pragma unroll
                for (int j = 0; j < 4; ++j) *(f32x4*)(ho + 4 * F.lane + 256 * j) = v[j]; }
        }
        float s = 0.f;
#pragma unroll
        for (int j = 0; j < 4; ++j) s += (v[j].x * v[j].x + v[j].y * v[j].y) + (v[j].z * v[j].z + v[j].w * v[j].w);
        const float rstd = rsqrtf(wave_sum(s, F.lane) * (1.0f / DM) + EPS);
        if (OUTMODE == 2) {
            float* ho = A.hout_l + (size_t)row * DM;
#pragma unroll
            for (int j = 0; j < 4; ++j) { const int col = 4 * F.lane + 256 * j; const f32x4 gv = *(const f32x4*)(A.g + col); *(f32x4*)(ho + col) = v[j] * rstd * gv; }
        } else {
            const float* sh = A.modl + bidx * NMOD + A.shoff; const float* sc = A.modl + bidx * NMOD + A.scoff;
            float lg[8];
            if (ROUTER) {
#pragma unroll
                for (int e = 0; e < 8; ++e) lg[e] = 0.f;
            }
#pragma unroll
            for (int j = 0; j < 4; ++j) { const int col = 4 * F.lane + 256 * j; const f32x4 gv = *(const f32x4*)(A.g + col), shv = *(const f32x4*)(sh + col), scv = *(const f32x4*)(sc + col);
                f32x4 y = v[j] * rstd * gv * (scv + 1.0f) + shv;
                v2u o; o.x = pg8::cvt_pk_bf16(y.x, y.y); o.y = pg8::cvt_pk_bf16(y.z, y.w); *(v2u*)(A.U + (size_t)row * DM + col) = o;
                if (ROUTER) {
#pragma unroll
                    for (int q = 0; q < 4; ++q) { const f32x4 r0 = rw[4 * j + q][0], r1 = rw[4 * j + q][1]; const float yy = y[q];
                        lg[0] += yy * r0.x; lg[1] += yy * r0.y; lg[2] += yy * r0.z; lg[3] += yy * r0.w; lg[4] += yy * r1.x; lg[5] += yy * r1.y; lg[6] += yy * r1.z; lg[7] += yy * r1.w; } }
            }
            if (ROUTER) {
                const int b5 = F.lane >> 5, b4 = (F.lane >> 4) & 1, b3 = (F.lane >> 3) & 1; float a4[4], c2[2];
#pragma unroll
                for (int q = 0; q < 4; ++q) { const float mine = b5 ? lg[4 + q] : lg[q], oth = b5 ? lg[q] : lg[4 + q]; a4[q] = mine + shx(oth, F.lane, 32); }
#pragma unroll
                for (int q = 0; q < 2; ++q) { const float mine = b4 ? a4[2 + q] : a4[q], oth = b4 ? a4[q] : a4[2 + q]; c2[q] = mine + shx(oth, F.lane, 16); }
                float d1 = (b3 ? c2[1] : c2[0]) + shx(b3 ? c2[0] : c2[1], F.lane, 8);
                d1 += shx(d1, F.lane, 4); d1 += shx(d1, F.lane, 2); d1 += shx(d1, F.lane, 1);
#pragma unroll
                for (int e = 0; e < 8; ++e) lg[e] = __int_as_float(__builtin_amdgcn_readlane(__float_as_int(d1), 8 * e));
                int i0 = 0; float v0 = lg[0];
#pragma unroll
                for (int e = 1; e < 8; ++e) if (lg[e] > v0) { v0 = lg[e]; i0 = e; }
                int i1 = -1; float v1 = -INFINITY;
#pragma unroll
                for (int e = 0; e < 8; ++e) if (e != i0 && lg[e] > v1) { v1 = lg[e]; i1 = e; }
                const float g0 = 1.0f / (1.0f + __expf(v1 - v0));
                if (F.lane == 0) { A.eidx[2 * row] = i0; A.eidx[2 * row + 1] = i1; A.gout[2 * row] = g0; A.gout[2 * row + 1] = 1.0f - g0; atomicAdd((int*)&lcnt[i0], 1); atomicAdd((int*)&lcnt[i1], 1); }
            }
        }
#pragma unroll
        for (int j = 0; j < 4; ++j) v[j] = vn[j];
    }
#undef ROWPTR
    if (ROUTER) { __syncthreads(); if (F.tid < 8) A.cnt[blockIdx.x * 8 + F.tid] = lcnt[F.tid]; __syncthreads(); }
}

using pg8::Unit; using pg8::cvt_pk_bf16;
__device__ __forceinline__ v4u pack8(const f32x4& a, const f32x4& b) { v4u w; w.x = cvt_pk_bf16(a[0], a[1]); w.y = cvt_pk_bf16(a[2], a[3]); w.z = cvt_pk_bf16(b[0], b[1]); w.w = cvt_pk_bf16(b[2], b[3]); return w; }
struct EpiIn {
    static constexpr bool PERM = true;
    bf16 *CQ, *KR, *CKV, *H5;
    __device__ __forceinline__ void operator()(const f32x4 (&acc)[2][2][4][2], const Unit& u, int wr, int wc, int fr, int fq) const {
        const int row0 = u.pm * 256 + wr * 64 + fr;
#pragma unroll
        for (int bj = 0; bj < 2; ++bj) {
            const int col = u.pn * 256 + bj * 128 + wc * 32 + 8 * fq;
            bf16* base; int ld;
            if (col < 384) { base = CQ + col; ld = QL; }
            else if (col < 416) { base = KR + (col - 384); ld = ROPE; }
            else if (col < 512) { base = nullptr; ld = 0; }
            else if (col < 768) { base = CKV + (col - 512); ld = KVL; }
            else { const int c2 = col - 768; base = H5 + (size_t)(c2 >> 9) * HSEG + (c2 & 511); ld = HW; }
            if (base) {
#pragma unroll
                for (int ai = 0; ai < 2; ++ai)
#pragma unroll
                    for (int m = 0; m < 4; ++m) { const int row = row0 + ai * 128 + m * 16; *(v4u*)(base + (size_t)row * ld) = pack8(acc[ai][bj][m][0], acc[ai][bj][m][1]); }
            }
        }
    }
};
struct EpiQ {
    static constexpr bool PERM = true;
    bf16* O; const float* rs;
    __device__ __forceinline__ void operator()(const f32x4 (&acc)[2][2][4][2], const Unit& u, int wr, int wc, int fr, int fq) const {
        const int row0 = u.pm * 256 + wr * 64 + fr;
#pragma unroll
        for (int ai = 0; ai < 2; ++ai)
#pragma unroll
            for (int m = 0; m < 4; ++m) { const int row = row0 + ai * 128 + m * 16; const float sc = rs[row];
#pragma unroll
                for (int bj = 0; bj < 2; ++bj) { const int col = u.pn * 256 + bj * 128 + wc * 32 + 8 * fq; *(v4u*)(O + (size_t)row * 768 + col) = pack8(acc[ai][bj][m][0] * sc, acc[ai][bj][m][1] * sc); } }
    }
};
struct EpiKV {
    static constexpr bool PERM = true;
    bf16* KNp; bf16* VTp; const float* rs;
    __device__ __forceinline__ void operator()(const f32x4 (&acc)[2][2][4][2], const Unit& u, int wr, int wc, int fr, int fq) const {
        const int row0 = u.pm * 256 + wr * 64 + fr;
#pragma unroll
        for (int ai = 0; ai < 2; ++ai)
#pragma unroll
            for (int m = 0; m < 4; ++m) { const int row = row0 + ai * 128 + m * 16; const float sc = rs[row];
                const bool lat = row < M; const int b = lat ? row / SEQ : (row - M) / CTXL; const int key = lat ? row % SEQ : SEQ + (row - M) % CTXL;
                const int kpos = (key & ~12) | ((key & 4) << 1) | ((key & 8) >> 1);
#pragma unroll
                for (int bj = 0; bj < 2; ++bj) { const int col = u.pn * 256 + bj * 128 + wc * 32 + 8 * fq; const int hh = col >> 7, w = col & 127;
                    if (w < 64) { *(v4u*)(KNp + (size_t)row * HW + hh * 64 + w) = pack8(acc[ai][bj][m][0] * sc, acc[ai][bj][m][1] * sc); }
                    else { bf16* dst = VTp + ((size_t)((b * NH + hh) * VD + (w - 64))) * NKEY + kpos;
#pragma unroll
                        for (int n = 0; n < 2; ++n)
#pragma unroll
                            for (int q = 0; q < 4; ++q) dst[(size_t)(4 * n + q) * NKEY] = (bf16)f2bf(acc[ai][bj][m][n][q] * sc); } } }
    }
};
struct EpiResid {
    static constexpr bool PERM = false;
    const float* hin_l; const float* hin_c; float* hout_l; float* hout_c; const float* modl; int goff;
    __device__ __forceinline__ void operator()(const f32x4 (&acc)[2][2][4][2], const Unit& u, int wr, int wc, int fr, int fq) const {
        const int rowt = u.pm * 256; const bool lat = rowt < M; const int bidx = lat ? rowt / SEQ : NB;
        const float* gate = modl + bidx * NMOD + goff;
        const float* hi = lat ? hin_l + (size_t)rowt * DM : hin_c + (size_t)(rowt - M) * DM;
        float* ho = lat ? hout_l + (size_t)rowt * DM : hout_c + (size_t)(rowt - M) * DM;
        const int col0 = u.pn * 256 + wc * 32 + 4 * fq;
#pragma unroll
        for (int bj = 0; bj < 2; ++bj) {
            f32x4 hv[2][2][4];
#pragma unroll
            for (int n = 0; n < 2; ++n)
#pragma unroll
                for (int ai = 0; ai < 2; ++ai)
#pragma unroll
                    for (int m = 0; m < 4; ++m) hv[n][ai][m] = *(const f32x4*)(hi + (size_t)(ai * 128 + wr * 64 + m * 16 + fr) * DM + col0 + bj * 128 + n * 16);
#pragma unroll
            for (int n = 0; n < 2; ++n) { const f32x4 gv = *(const f32x4*)(gate + col0 + bj * 128 + n * 16);
#pragma unroll
                for (int ai = 0; ai < 2; ++ai)
#pragma unroll
                    for (int m = 0; m < 4; ++m) *(f32x4*)(ho + (size_t)(ai * 128 + wr * 64 + m * 16 + fr) * DM + col0 + bj * 128 + n * 16) = hv[n][ai][m] + gv * acc[ai][bj][m][n]; }
            asm volatile("" ::: "memory"); }
    }
};
struct EpiPool {
    static constexpr bool PERM = false;
    float* h_l; float* h_c; const float* modl; const float* bias; const float* scale; int talloc;
    __device__ __forceinline__ void operator()(const f32x4 (&acc)[2][2][4][2], const Unit& u, int wr, int wc, int fr, int fq) const {
        const int g = u.pn, rowt = (u.pm - g * talloc) * 256; const bool lat = rowt < M; const int bidx = lat ? rowt / SEQ : NB;
        const float* gate = modl + bidx * NMOD + 2 * DM;
        float* ho = lat ? h_l + (size_t)rowt * DM : h_c + (size_t)(rowt - M) * DM;
        const int col0 = g * 256 + wc * 32 + 4 * fq;
#pragma unroll
        for (int bj = 0; bj < 2; ++bj)
#pragma unroll
            for (int n = 0; n < 2; ++n) { const int c = col0 + bj * 128 + n * 16; const f32x4 gm = *(const f32x4*)(gate + c) * *(const f32x4*)(scale + c); const f32x4 gb = gm * *(const f32x4*)(bias + c);
#pragma unroll
                for (int ai = 0; ai < 2; ++ai)
#pragma unroll
                    for (int m = 0; m < 4; ++m) { const int r = ai * 128 + wr * 64 + m * 16 + fr; const size_t off = (size_t)r * DM + c; const f32x4 hv = *(const f32x4*)(ho + off); *(f32x4*)(ho + off) = hv + gm * acc[ai][bj][m][n] + gb; }
                asm volatile("" ::: "memory"); }
    }
};
struct EpiGateUp {
    static constexpr bool PERM = true;
    bf16* H; int ldh, nct, rowsub;
    __device__ __forceinline__ void operator()(const f32x4 (&acc)[2][2][4][2], const Unit& u, int wr, int wc, int fr, int fq) const {
        const int row0 = u.pm * 256 + wr * 64 + fr - rowsub; const int ct = u.pn % nct; const int col = ct * 128 + wc * 32 + 8 * fq;
#pragma unroll
        for (int ai = 0; ai < 2; ++ai)
#pragma unroll
            for (int m = 0; m < 4; ++m) { const int row = row0 + ai * 128 + m * 16; f32x4 o[2];
#pragma unroll
                for (int n = 0; n < 2; ++n)
#pragma unroll
                    for (int q = 0; q < 4; ++q) { const float gv = acc[ai][0][m][n][q], uv = acc[ai][1][m][n][q]; o[n][q] = gv * uv * __builtin_amdgcn_rcpf(1.0f + __expf(-gv)); }
                *(v4u*)(H + (size_t)row * ldh + col) = pack8(o[0], o[1]); }
    }
};
struct EpiY {
    static constexpr bool PERM = true;
    bf16* Y; int nct;
    __device__ __forceinline__ void operator()(const f32x4 (&acc)[2][2][4][2], const Unit& u, int wr, int wc, int fr, int fq) const {
        const int row0 = u.pm * 256 + wr * 64 + fr; const int ct = u.pn % nct;
#pragma unroll
        for (int ai = 0; ai < 2; ++ai)
#pragma unroll
            for (int m = 0; m < 4; ++m) { const int row = row0 + ai * 128 + m * 16;
#pragma unroll
                for (int bj = 0; bj < 2; ++bj) { const int col = ct * 256 + bj * 128 + wc * 32 + 8 * fq; *(v4u*)(Y + (size_t)row * DM + col) = pack8(acc[ai][bj][m][0], acc[ai][bj][m][1]); } }
    }
};

__device__ __forceinline__ void p0_prologue(Frame& F) {
    fresh(F);
    unsigned char* ws = F.ws;
    const float qscale = 0.10206207261596577f * 1.4426950408889634f;
    for (int j = 0; j < 2; ++j) {
        conv_matrix(F, F.in[8] + (size_t)j * DM * INW, DM, INW, (bf16*)(ws + WS_WIN) + (size_t)j * INP * DM, DM, 1, 0, nullptr, 1.f);
        conv_matrix(F, F.in[11] + (size_t)j * QL * 768, QL, 768, (bf16*)(ws + WS_WUQ) + (size_t)j * 768 * QL, QL, 0, 0, F.in[9] + j * QL, qscale);
        conv_matrix(F, F.in[12] + (size_t)j * KVL * 1024, KVL, 1024, (bf16*)(ws + WS_WUKV) + (size_t)j * 1024 * KVL, KVL, 0, 0, F.in[10] + j * KVL, 1.f);
        conv_matrix(F, F.in[15] + (size_t)j * DM * DM, DM, DM, (bf16*)(ws + WS_WOUT) + (size_t)j * DM * DM, DM, 0, 0, nullptr, 1.f);
        conv_matrix(F, F.in[16] + (size_t)j * DM * DFF, DM, DFF, (bf16*)(ws + WS_WGU) + (size_t)j * 2 * DFF * DM, DM, 2, 0, nullptr, 1.f);
        conv_matrix(F, F.in[17] + (size_t)j * DM * DFF, DM, DFF, (bf16*)(ws + WS_WGU) + (size_t)j * 2 * DFF * DM, DM, 2, 128, nullptr, 1.f);
        conv_matrix(F, F.in[18] + (size_t)j * DFF * DM, DFF, DM, (bf16*)(ws + WS_WDN) + (size_t)j * DM * DFF, DFF, 0, 0, nullptr, 1.f);
        for (int g = 0; g < 4; ++g)
            conv_matrix(F, F.in[19] + (size_t)(j * 4 + g) * 65536, 256, 256, (bf16*)(ws + WS_WPOOL) + (size_t)(j * 4 + g) * 65536, 256, 0, 0, nullptr, 1.f);
    }
    __syncthreads();
    if (blockIdx.x == 0 && F.tid < 8) {
        float* TC = (float*)(ws + WS_ROPE); float* TS = TC + 512;
        double th = 1.0; for (int i = 0; i < F.tid; ++i) th *= 0.31622776601683794;
        const double x2 = th * th; double s = th, c = 1.0, ts = th, tc = 1.0;
        for (int n = 1; n <= 12; ++n) { tc *= -x2 / (double)((2 * n - 1) * (2 * n)); c += tc; ts *= -x2 / (double)((2 * n) * (2 * n + 1)); s += ts; }
        double cp = 1.0, sp = 0.0;
        for (int p = 0; p < 64; ++p) { TC[p * 8 + F.tid] = (float)cp; TS[p * 8 + F.tid] = (float)sp; const double ncp = cp * c - sp * s; sp = sp * c + cp * s; cp = ncp; }
    }
    {
        LAS float* sc = (LAS float*)(F.lds + RING_OFF);
        LAS float* red = sc + 17 * 1024;
        const int nitems = 4 * (NMOD / 64);
        if ((int)blockIdx.x < nitems) {
            for (int e = F.tid; e < 17 * 1024; e += 512) { const int r = e >> 10, k = e & 1023; const float x = (r < 16) ? F.in[1][r * 1024 + k] : F.in[3][k]; sc[e] = siluf_(x); }
            __syncthreads();
            for (int it = blockIdx.x; it < nitems; it += F.G) {
                const int l = it / (NMOD / 64), c0 = (it % (NMOD / 64)) * 64;
                const float* W = F.in[4] + (size_t)l * DM * NMOD + c0 + F.lane;
                float acc[17];
#pragma unroll
                for (int r = 0; r < 17; ++r) acc[r] = 0.f;
                const int kb = F.wave * 128;
                for (int k = 0; k < 128; k += 4) {
                    const float w0 = W[(size_t)(kb + k) * NMOD], w1 = W[(size_t)(kb + k + 1) * NMOD], w2 = W[(size_t)(kb + k + 2) * NMOD], w3 = W[(size_t)(kb + k + 3) * NMOD];
#pragma unroll
                    for (int r = 0; r < 17; ++r) { const f32x4 s4 = *(const LAS f32x4*)(sc + r * 1024 + kb + k); acc[r] += s4.x * w0 + s4.y * w1 + s4.z * w2 + s4.w * w3; }
                }
#pragma unroll
                for (int r = 0; r < 17; ++r) red[(F.wave * 17 + r) * 64 + F.lane] = acc[r];
                __syncthreads();
                for (int o = F.tid; o < 17 * 64; o += 512) { const int r = o >> 6, cc = o & 63; float s = 0.f;
#pragma unroll
                    for (int w = 0; w < 8; ++w) s += red[(w * 17 + r) * 64 + cc];
                    ((float*)(ws + WS_MODV))[(size_t)(l * 17 + r) * NMOD + c0 + cc] = s + F.in[5][l * NMOD + c0 + cc]; }
                __syncthreads();
            }
        }
    }
}

__device__ __forceinline__ void e3_phase(Frame& F) {
    fresh(F);
    unsigned char* ws = F.ws;
    const bf16* CQ = (const bf16*)(ws + WS_CQ); const bf16* CKV = (const bf16*)(ws + WS_CKV); const bf16* KR = (const bf16*)(ws + WS_KR); bf16* KRR = (bf16*)(ws + WS_KRR);
    float* RSQ = (float*)(ws + WS_RSQ); float* RSKV = (float*)(ws + WS_RSKV); const float* TC = (const float*)(ws + WS_ROPE); const float* TS = TC + 512;
    const int rpw = (MT + F.G - 1) / F.G;
    for (int i = F.wave; i < rpw; i += NWAVES) {
        const int row = (int)blockIdx.x * rpw + i; if (row >= MT) break;
        float s = 0.f;
        if (F.lane < 48) { const v4u w = *(const v4u*)(CQ + (size_t)row * QL + F.lane * 8);
            s = bflo(w.x) * bflo(w.x) + bfhi(w.x) * bfhi(w.x) + bflo(w.y) * bflo(w.y) + bfhi(w.y) * bfhi(w.y) + bflo(w.z) * bflo(w.z) + bfhi(w.z) * bfhi(w.z) + bflo(w.w) * bflo(w.w) + bfhi(w.w) * bfhi(w.w); }
        s = wave_sum(s, F.lane); if (F.lane == 0) RSQ[row] = rsqrtf(s * (1.0f / QL) + EPS);
        s = 0.f;
        if (F.lane < 32) { const v4u w = *(const v4u*)(CKV + (size_t)row * KVL + F.lane * 8);
            s = bflo(w.x) * bflo(w.x) + bfhi(w.x) * bfhi(w.x) + bflo(w.y) * bflo(w.y) + bfhi(w.y) * bfhi(w.y) + bflo(w.z) * bflo(w.z) + bfhi(w.z) * bfhi(w.z) + bflo(w.w) * bflo(w.w) + bfhi(w.w) * bfhi(w.w); }
        s = wave_sum(s, F.lane); if (F.lane == 0) RSKV[row] = rsqrtf(s * (1.0f / KVL) + EPS);
        const float x = (F.lane < 32) ? bf2f(KR[(size_t)row * ROPE + F.lane]) : 0.f; const float pr = shx(x, F.lane, 8);
        float o = x;
        if (row < M) { const int t = row % SEQ; const int p = ((F.lane >> 4) & 1) ? (t & 63) : (t >> 6); const int j = F.lane & 7; const float c = TC[p * 8 + j], sn = TS[p * 8 + j];
            o = ((F.lane >> 3) & 1) ? x * c + pr * sn : x * c - pr * sn; }
        if (F.lane < 32) KRR[(size_t)row * ROPE + F.lane] = (bf16)f2bf(o);
    }
}

typedef short bf16x8v __attribute__((ext_vector_type(8)));
typedef float f32x16 __attribute__((ext_vector_type(16)));
__device__ __forceinline__ void attn_unit(Frame& F, int b, int h, int qrow0, bool rope_q, int t_lo, int t_hi) {
    unsigned char* ws = F.ws;
    const bf16* QB = (const bf16*)(ws + WS_QB); const bf16* KN = (const bf16*)(ws + WS_KN); const bf16* KRR = (const bf16*)(ws + WS_KRR); const bf16* VT = (const bf16*)(ws + WS_VV);
    bf16* MIX = (bf16*)(ws + WS_MIX); const float* TC = (const float*)(ws + WS_ROPE); const float* TS = TC + 512;
    const int lane = F.lane, wave = F.wave, r32 = lane & 31, hi = lane >> 5;
    LAS unsigned char* ring = F.lds + RING_OFF;
    const int qrow = qrow0 + wave * 32 + r32;
    bf16x8v qr[6];
#pragma unroll
    for (int d0 = 0; d0 < 6; ++d0) qr[d0] = *(const bf16x8v*)(QB + (size_t)qrow * 768 + h * QKD + 16 * d0 + 8 * hi);
    if (rope_q) { const int t = qrow % SEQ;
#pragma unroll
        for (int a = 0; a < 2; ++a) { const int p = a ? (t & 63) : (t >> 6); const v4u w = __builtin_bit_cast(v4u, qr[4 + a]); float x[8], y[8];
            x[0] = bflo(w.x); x[1] = bfhi(w.x); x[2] = bflo(w.y); x[3] = bfhi(w.y); x[4] = bflo(w.z); x[5] = bfhi(w.z); x[6] = bflo(w.w); x[7] = bfhi(w.w);
#pragma unroll
            for (int jj = 0; jj < 8; ++jj) { const float pr = shx(x[jj], lane, 32); const float c = TC[p * 8 + jj], sn = TS[p * 8 + jj]; y[jj] = hi ? x[jj] * c + pr * sn : x[jj] * c - pr * sn; }
            v4u o; o.x = pk2(y[0], y[1]); o.y = pk2(y[2], y[3]); o.z = pk2(y[4], y[5]); o.w = pk2(y[6], y[7]); qr[4 + a] = __builtin_bit_cast(bf16x8v, o); } }
    const int bh = b * NH + h;
    const bf16* vsrc = VT + ((size_t)(bh * VD + lane)) * NKEY + 8 * wave;
#define ATT_DMA(t, buf) do { const int t_ = (t); const int r0_ = t_ < SEQ / 64 ? b * SEQ + 64 * t_ : M + b * CTXL + 64 * (t_ - SEQ / 64); \
        LAS unsigned char* kb_ = ring + (buf) * 20480; LAS unsigned char* vb_ = kb_ + 12288; \
        __builtin_amdgcn_global_load_lds((const unsigned*)(KN + (size_t)(r0_ + lane) * HW + h * 64 + 8 * wave), (LAS unsigned*)(kb_ + wave * 1024), 16, 0, 0); \
        __builtin_amdgcn_global_load_lds((const unsigned*)(KRR + (size_t)(r0_ + lane) * ROPE + 8 * (wave & 3)), (LAS unsigned*)(kb_ + (8 + (wave & 3)) * 1024), 16, 0, 0);     \
        __builtin_amdgcn_global_load_lds((const unsigned*)(vsrc + 64 * t_), (LAS unsigned*)(vb_ + wave * 1024), 16, 0, 0); } while (0)
    f32x16 o0, o1;
#pragma unroll
    for (int r = 0; r < 16; ++r) { o0[r] = 0.f; o1[r] = 0.f; }
    constexpr float ATT_THR = 8.0f;
    float m_run = 0.f, l_run = 0.f;
    asm volatile("s_waitcnt vmcnt(0)" ::: "memory");
    ATT_DMA(t_lo, 0); if (t_lo + 1 < t_hi) ATT_DMA(t_lo + 1, 1); if (t_lo + 2 < t_hi) ATT_DMA(t_lo + 2, 2);
    for (int t = t_lo; t < t_hi; ++t) {
        const int buf = (t - t_lo) & 3; const int rem = t_hi - 1 - t;
        if (rem >= 2) asm volatile("s_waitcnt vmcnt(6)" ::: "memory"); else if (rem == 1) asm volatile("s_waitcnt vmcnt(3)" ::: "memory"); else asm volatile("s_waitcnt vmcnt(0)" ::: "memory");
        asm volatile("s_waitcnt lgkmcnt(0)" ::: "memory"); __builtin_amdgcn_s_barrier(); asm volatile("" ::: "memory");
        if (t + 3 < t_hi) ATT_DMA(t + 3, (buf + 3) & 3);
        const LAS unsigned char* kb = ring + buf * 20480 + hi * 1024 + r32 * 16; const LAS unsigned char* vb = ring + buf * 20480 + 12288 + hi * 1024 + r32 * 16;
        bf16x8v kf[12], vf[8];
#pragma unroll
        for (int d0 = 0; d0 < 6; ++d0) { kf[2 * d0] = *(const LAS bf16x8v*)(kb + d0 * 2048); kf[2 * d0 + 1] = *(const LAS bf16x8v*)(kb + d0 * 2048 + 512); }
#pragma unroll
        for (int s4 = 0; s4 < 4; ++s4) { vf[2 * s4] = *(const LAS bf16x8v*)(vb + s4 * 2048); vf[2 * s4 + 1] = *(const LAS bf16x8v*)(vb + s4 * 2048 + 512); }
        f32x16 p0, p1; const float negm = -m_run;
#pragma unroll
        for (int r = 0; r < 16; ++r) { p0[r] = negm; p1[r] = negm; }
#pragma unroll
        for (int d0 = 0; d0 < 6; ++d0) { p0 = __builtin_amdgcn_mfma_f32_32x32x16_bf16(kf[2 * d0], qr[d0], p0, 0, 0, 0); p1 = __builtin_amdgcn_mfma_f32_32x32x16_bf16(kf[2 * d0 + 1], qr[d0], p1, 0, 0, 0); }
        float ma = __builtin_fmaxf(__builtin_fmaxf(p0[0], p0[1]), p1[0]), mb = __builtin_fmaxf(__builtin_fmaxf(p0[2], p0[3]), p1[1]); ma = __builtin_fmaxf(__builtin_fmaxf(ma, p1[2]), p1[3]);
#pragma unroll
        for (int r = 4; r < 16; r += 4) { ma = __builtin_fmaxf(__builtin_fmaxf(ma, p0[r]), p0[r + 1]); mb = __builtin_fmaxf(__builtin_fmaxf(mb, p0[r + 2]), p0[r + 3]); ma = __builtin_fmaxf(__builtin_fmaxf(ma, p1[r]), p1[r + 1]); mb = __builtin_fmaxf(__builtin_fmaxf(mb, p1[r + 2]), p1[r + 3]); }
        float mt = __builtin_fmaxf(ma, mb);
        { auto rr = __builtin_amdgcn_permlane32_swap(__float_as_uint(mt), __float_as_uint(mt), false, false); mt = __builtin_fmaxf(__uint_as_float(rr[0]), __uint_as_float(rr[1])); }
        const bool first = (t == t_lo);
        if (first || __any(mt > ATT_THR)) {
            const float dl = first ? mt : __builtin_fmaxf(mt, 0.f); m_run += dl; const float alpha = __builtin_amdgcn_exp2f(-dl); l_run *= alpha;
#pragma unroll
            for (int r = 0; r < 16; ++r) { p0[r] -= dl; p1[r] -= dl; o0[r] *= alpha; o1[r] *= alpha; }
        }
        float ps0 = 0.f, ps1 = 0.f;
#pragma unroll
        for (int r = 0; r < 16; ++r) { p0[r] = __builtin_amdgcn_exp2f(p0[r]); p1[r] = __builtin_amdgcn_exp2f(p1[r]); ps0 += p0[r]; ps1 += p1[r]; }
        l_run += ps0 + ps1;
        v4u pw[4];
#pragma unroll
        for (int q = 0; q < 4; ++q) { pw[0][q] = cvt_pk_bf16(p0[2 * q], p0[2 * q + 1]); pw[1][q] = cvt_pk_bf16(p0[8 + 2 * q], p0[8 + 2 * q + 1]); pw[2][q] = cvt_pk_bf16(p1[2 * q], p1[2 * q + 1]); pw[3][q] = cvt_pk_bf16(p1[8 + 2 * q], p1[8 + 2 * q + 1]); }
#pragma unroll
        for (int s4 = 0; s4 < 4; ++s4) { const bf16x8v pa = __builtin_bit_cast(bf16x8v, pw[s4]);
            o0 = __builtin_amdgcn_mfma_f32_32x32x16_bf16(vf[2 * s4], pa, o0, 0, 0, 0); o1 = __builtin_amdgcn_mfma_f32_32x32x16_bf16(vf[2 * s4 + 1], pa, o1, 0, 0, 0); }
    }
    { auto rr = __builtin_amdgcn_permlane32_swap(__float_as_uint(l_run), __float_as_uint(l_run), false, false); l_run = __uint_as_float(rr[0]) + __uint_as_float(rr[1]); }
    const float rl = 1.0f / l_run;
    bf16* orow = MIX + (size_t)qrow * DM + h * VD;
#pragma unroll
    for (int g = 0; g < 4; ++g) { v2u a, c2; a.x = pk2(o0[4 * g] * rl, o0[4 * g + 1] * rl); a.y = pk2(o0[4 * g + 2] * rl, o0[4 * g + 3] * rl); c2.x = pk2(o1[4 * g] * rl, o1[4 * g + 1] * rl); c2.y = pk2(o1[4 * g + 2] * rl, o1[4 * g + 3] * rl);
        *(v2u*)(orow + 8 * g + 4 * hi) = a; *(v2u*)(orow + 32 + 8 * g + 4 * hi) = c2; }
    asm volatile("s_waitcnt vmcnt(0) lgkmcnt(0)" ::: "memory"); __builtin_amdgcn_s_barrier(); asm volatile("" ::: "memory");
#undef ATT_DMA
}
__device__ __forceinline__ void hgrn_item(Frame& F, int j, int it);
__device__ __forceinline__ void mix_phase(Frame& F, int j, bool ctx_out) {
    fresh(F);
    const int npair = F.G >> 1;
    for (int P = F.vcu >> 1; P < NB * NH; P += npair) {
        const int b = P >> 3, h = P & 7;
        if ((F.vcu & 1) == 0) {
            hgrn_item(F, j, P);
            for (int qb = 6; qb < 8; ++qb) attn_unit(F, b, h, b * SEQ + qb * 256, true, 0, NKEY / 64);
        } else {
            for (int qb = 0; qb < 6; ++qb) attn_unit(F, b, h, b * SEQ + qb * 256, true, 0, NKEY / 64);
            if (ctx_out) attn_unit(F, b, h, M + b * CTXL, false, SEQ / 64, NKEY / 64);
        }
    }
    __syncthreads();
}

__device__ __forceinline__ int hgrn_row(int b, int dir, int ig) { return (ig < CTXL) ? (M + b * CTXL + (dir ? CTXL - 1 - ig : ig)) : (b * SEQ + (dir ? SEQ - 1 - (ig - CTXL) : (ig - CTXL))); }
__device__ __forceinline__ void hgrn_item(Frame& F, int j, int it) {
    unsigned char* ws = F.ws;
    const bf16* HQ = (const bf16*)(ws + WS_HQ); const bf16* HFF = HQ + HSEG; const bf16* HFB = HQ + 2 * HSEG; const bf16* HI = HQ + 3 * HSEG;
    LAS unsigned char* ring = F.lds + RING_OFF;
    LAS unsigned char* QN = ring; LAS unsigned char* KN = ring + 17408; LAS unsigned char* KT = ring + 34816; LAS unsigned char* VT = ring + 53248; LAS unsigned char* ST = ring + 71680;
    LAS float* TOT = (LAS float*)(ring + 106496); LAS unsigned char* RQ = ring + 108544; LAS unsigned char* RF = ring + 124928;
    const int lane0 = F.lane, wave = F.wave;
    const int part = wave >> 1;
    const int kb = wave >> 1, vb0 = 2 * (wave & 1);
    const int ib = wave >> 2, vbo = wave & 3;
    const int dir = it & 1, hh = (it >> 1) & 3, b = it >> 3;
    const bf16* HF = dir ? HFB : HFF; float* OO = (float*)(ws + (dir ? WS_OB : WS_OF));
    float lb = 0.f; if (j == 1) { const int ci = dir * HW + hh * HK + (wave & 1) * 64 + lane0; const float l0 = F.in[13][ci], l1 = F.in[13][2 * HW + ci]; lb = 1.0f / (1.0f + __expf(l0 - l1)); }
    const float oml = 1.0f - lb;
    f32x16 S0, S1;
#pragma unroll
    for (int r = 0; r < 16; ++r) { S0[r] = 0.f; S1[r] = 0.f; }
#define LBAR() do { asm volatile("s_waitcnt lgkmcnt(0)" ::: "memory"); __builtin_amdgcn_s_barrier(); asm volatile("" ::: "memory"); } while (0)
#define HG_BASE(c_) ((c_) < CTXL / 64 ? M + b * CTXL + (dir ? CTXL - 64 - 64 * (c_) : 64 * (c_)) : b * SEQ + (dir ? SEQ - 64 - 64 * ((c_) - CTXL / 64) : 64 * ((c_) - CTXL / 64)))
#define HG_DMA(c_) do { const int rb_ = HG_BASE(c_); \
        _Pragma("unroll") for (int p_ = 0; p_ < 2; ++p_) { const int pc_ = wave * 2 + p_; const size_t go_ = (size_t)(rb_ + 4 * pc_ + (lane >> 4)) * HW + hh * HK + 8 * (lane & 15); \
            __builtin_amdgcn_global_load_lds((const unsigned*)(HQ + go_), (LAS unsigned*)(RQ + pc_ * 1024), 16, 0, 0); __builtin_amdgcn_global_load_lds((const unsigned*)(HF + go_), (LAS unsigned*)(RF + pc_ * 1024), 16, 0, 0); } } while (0)
#define HG_VLD(c_) do { const size_t go_ = (size_t)(HG_BASE(c_) + (dir ? 63 - lane : lane)) * HW + hh * HK + 16 * wave; rv0 = *(const v4u*)(HI + go_); rv1 = *(const v4u*)(HI + go_ + 8); } while (0)
    v4u rv0, rv1;
    { const int lane = lane0; HG_DMA(0); HG_VLD(0); }
    asm volatile("s_waitcnt vmcnt(0)" ::: "memory"); LBAR();
    for (int ch = 0; ch < NKEY / 64; ++ch) {
        int lane_ = lane0; asm volatile("" : "+v"(lane_));
        const int lane = lane_, r32 = lane & 31, hi = lane >> 5, k = (wave & 1) * 64 + lane;
        const int pos = (lane & ~12) | ((lane & 4) << 1) | ((lane & 8) >> 1);
        float qv[16], kin[16], cs[16]; float run = 0.f;
#pragma unroll
        for (int ii = 0; ii < 16; ++ii) { const int i = 16 * part + ii, mr = dir ? 63 - i : i; const float hq = bf2f(*(const LAS bf16*)(RQ + mr * 256 + k * 2)), hf = bf2f(*(const LAS bf16*)(RF + mr * 256 + k * 2));
            qv[ii] = hq * __builtin_amdgcn_rcpf(1.0f + __expf(-hq)); const float e = __expf(-hf), sg = __builtin_amdgcn_rcpf(1.0f + e); kin[ii] = oml * e * sg; run += __logf(lb + oml * sg); cs[ii] = run; }
        TOT[part * 128 + k] = run;
        { LAS bf16* vt = (LAS bf16*)(VT + (16 * wave) * 144 + pos * 2);
          vt[0 * 72] = (bf16)(rv0.x & 0xffffu); vt[1 * 72] = (bf16)(rv0.x >> 16); vt[2 * 72] = (bf16)(rv0.y & 0xffffu); vt[3 * 72] = (bf16)(rv0.y >> 16);
          vt[4 * 72] = (bf16)(rv0.z & 0xffffu); vt[5 * 72] = (bf16)(rv0.z >> 16); vt[6 * 72] = (bf16)(rv0.w & 0xffffu); vt[7 * 72] = (bf16)(rv0.w >> 16);
          vt[8 * 72] = (bf16)(rv1.x & 0xffffu); vt[9 * 72] = (bf16)(rv1.x >> 16); vt[10 * 72] = (bf16)(rv1.y & 0xffffu); vt[11 * 72] = (bf16)(rv1.y >> 16);
          vt[12 * 72] = (bf16)(rv1.z & 0xffffu); vt[13 * 72] = (bf16)(rv1.z >> 16); vt[14 * 72] = (bf16)(rv1.w & 0xffffu); vt[15 * 72] = (bf16)(rv1.w >> 16); }
        LBAR();
        if (ch + 1 < NKEY / 64) { HG_DMA(ch + 1); HG_VLD(ch + 1); }
        { const float t0 = TOT[k], t1 = TOT[128 + k], t2 = TOT[256 + k];
          const float base = (part > 0 ? t0 : 0.f) + (part > 1 ? t1 : 0.f) + (part > 2 ? t2 : 0.f); const float rr = t0 + t1;
          unsigned kt[8];
#pragma unroll
          for (int ii = 0; ii < 16; ii += 2) { float d0 = base + cs[ii] - rr, d1 = base + cs[ii + 1] - rr; d0 = fminf(fmaxf(d0, -80.f), 80.f); d1 = fminf(fmaxf(d1, -80.f), 80.f);
              const float e0 = __expf(d0), e1 = __expf(d1); const float q0 = qv[ii] * e0, q1 = qv[ii + 1] * e1, k0 = kin[ii] * __builtin_amdgcn_rcpf(e0), k1 = kin[ii + 1] * __builtin_amdgcn_rcpf(e1);
              const unsigned qp = cvt_pk_bf16(q0, q1), kp = cvt_pk_bf16(k0, k1);
              *(LAS bf16*)(QN + (16 * part + ii) * 272 + k * 2) = (bf16)(qp & 0xffffu); *(LAS bf16*)(QN + (16 * part + ii + 1) * 272 + k * 2) = (bf16)(qp >> 16);
              *(LAS bf16*)(KN + (16 * part + ii) * 272 + k * 2) = (bf16)(kp & 0xffffu); *(LAS bf16*)(KN + (16 * part + ii + 1) * 272 + k * 2) = (bf16)(kp >> 16);
              kt[ii >> 1] = kp; }
          *(LAS v4u*)(KT + k * 144 + part * 32) = (v4u){kt[0], kt[1], kt[4], kt[5]}; *(LAS v4u*)(KT + k * 144 + part * 32 + 16) = (v4u){kt[2], kt[3], kt[6], kt[7]}; }
        f32x16 T0, T1;
#pragma unroll
        for (int g4 = 0; g4 < 4; ++g4) { const int kk = kb * 32 + 8 * g4 + 4 * hi; const f32x4 ta = *(const LAS f32x4*)(TOT + kk), tb = *(const LAS f32x4*)(TOT + 128 + kk);
            const float e0 = __expf(ta.x + tb.x), e1 = __expf(ta.y + tb.y), e2 = __expf(ta.z + tb.z), e3 = __expf(ta.w + tb.w);
            T0[4 * g4] = S0[4 * g4] * e0; T0[4 * g4 + 1] = S0[4 * g4 + 1] * e1; T0[4 * g4 + 2] = S0[4 * g4 + 2] * e2; T0[4 * g4 + 3] = S0[4 * g4 + 3] * e3;
            T1[4 * g4] = S1[4 * g4] * e0; T1[4 * g4 + 1] = S1[4 * g4 + 1] * e1; T1[4 * g4 + 2] = S1[4 * g4 + 2] * e2; T1[4 * g4 + 3] = S1[4 * g4 + 3] * e3;
            v2u o; o.x = cvt_pk_bf16(T0[4 * g4], T0[4 * g4 + 1]); o.y = cvt_pk_bf16(T0[4 * g4 + 2], T0[4 * g4 + 3]); *(LAS v2u*)(ST + (vb0 * 32 + r32) * 272 + kk * 2) = o;
            o.x = cvt_pk_bf16(T1[4 * g4], T1[4 * g4 + 1]); o.y = cvt_pk_bf16(T1[4 * g4 + 2], T1[4 * g4 + 3]); *(LAS v2u*)(ST + (vb0 * 32 + 32 + r32) * 272 + kk * 2) = o; }
        LBAR();
#pragma unroll
        for (int st = 0; st < 4; ++st) { const bf16x8v kf = *(const LAS bf16x8v*)(KT + (kb * 32 + r32) * 144 + st * 32 + hi * 16);
            const bf16x8v va = *(const LAS bf16x8v*)(VT + (vb0 * 32 + r32) * 144 + st * 32 + hi * 16), vc = *(const LAS bf16x8v*)(VT + (vb0 * 32 + 32 + r32) * 144 + st * 32 + hi * 16);
            T0 = __builtin_amdgcn_mfma_f32_32x32x16_bf16(kf, va, T0, 0, 0, 0); T1 = __builtin_amdgcn_mfma_f32_32x32x16_bf16(kf, vc, T1, 0, 0, 0); }
#pragma unroll
        for (int g4 = 0; g4 < 4; ++g4) { const int kk = kb * 32 + 8 * g4 + 4 * hi; const f32x4 ta = *(const LAS f32x4*)(TOT + 256 + kk), tb = *(const LAS f32x4*)(TOT + 384 + kk);
            const float e0 = __expf(ta.x + tb.x), e1 = __expf(ta.y + tb.y), e2 = __expf(ta.z + tb.z), e3 = __expf(ta.w + tb.w);
            S0[4 * g4] = T0[4 * g4] * e0; S0[4 * g4 + 1] = T0[4 * g4 + 1] * e1; S0[4 * g4 + 2] = T0[4 * g4 + 2] * e2; S0[4 * g4 + 3] = T0[4 * g4 + 3] * e3;
            S1[4 * g4] = T1[4 * g4] * e0; S1[4 * g4 + 1] = T1[4 * g4 + 1] * e1; S1[4 * g4 + 2] = T1[4 * g4 + 2] * e2; S1[4 * g4 + 3] = T1[4 * g4 + 3] * e3; }
        asm volatile("" ::: "memory");
        {
            bf16x8v qf[8];
#pragma unroll
            for (int ks = 0; ks < 8; ++ks) qf[ks] = *(const LAS bf16x8v*)(QN + (ib * 32 + r32) * 272 + ks * 32 + hi * 16);
            asm volatile("" ::: "memory");
            f32x16 O;
#pragma unroll
            for (int r = 0; r < 16; ++r) O[r] = 0.f;
#pragma unroll
            for (int ks = 0; ks < 8; ++ks) { const bf16x8v sf = *(const LAS bf16x8v*)(ST + (vbo * 32 + r32) * 272 + ks * 32 + hi * 16); O = __builtin_amdgcn_mfma_f32_32x32x16_bf16(qf[ks], sf, O, 0, 0, 0); }
            asm volatile("" ::: "memory");
#pragma unroll 1
            for (int sb = 0; sb <= ib; ++sb) {
                f32x16 X;
#pragma unroll
                for (int r = 0; r < 16; ++r) X[r] = 0.f;
#pragma unroll
                for (int ks = 0; ks < 8; ++ks) { const bf16x8v kf = *(const LAS bf16x8v*)(KN + (sb * 32 + r32) * 272 + ks * 32 + hi * 16); X = __builtin_amdgcn_mfma_f32_32x32x16_bf16(kf, qf[ks], X, 0, 0, 0); }
                if (sb == ib) {
#pragma unroll
                    for (int r = 0; r < 16; ++r) { const int srow = (r & 3) + 8 * (r >> 2) + 4 * hi; if (srow > r32) X[r] = 0.f; }
                }
                asm volatile("" ::: "memory");
#pragma unroll
                for (int st = 0; st < 2; ++st) { v4u pw;
#pragma unroll
                    for (int q = 0; q < 4; ++q) pw[q] = cvt_pk_bf16(X[8 * st + 2 * q], X[8 * st + 2 * q + 1]);
                    const bf16x8v vf = *(const LAS bf16x8v*)(VT + (vbo * 32 + r32) * 144 + (sb * 32 + st * 16) * 2 + hi * 16);
                    O = __builtin_amdgcn_mfma_f32_32x32x16_bf16(__builtin_bit_cast(bf16x8v, pw), vf, O, 0, 0, 0); }
                asm volatile("" ::: "memory");
            }
            const int rb = HG_BASE(ch); float* op = OO + (size_t)rb * HW + hh * HK + vbo * 32 + r32;
#pragma unroll
            for (int r = 0; r < 16; ++r) { const int i = ib * 32 + (r & 3) + 8 * (r >> 2) + 4 * hi; op[(size_t)(dir ? 63 - i : i) * HW] = O[r]; }
        }
        asm volatile("s_waitcnt vmcnt(0)" ::: "memory"); LBAR();
    }
#undef LBAR
#undef HG_DMA
#undef HG_VLD
#undef HG_BASE
}

__device__ __forceinline__ void e8_phase(Frame& F, int j, int nrows) {
    fresh(F);
    unsigned char* ws = F.ws;
    const float* OF = (const float*)(ws + WS_OF); const float* OB = (const float*)(ws + WS_OB); const bf16* HG = (const bf16*)(ws + WS_HQ) + 4 * HSEG; bf16* MIX = (bf16*)(ws + WS_MIX);
    const float* gn = F.in[14] + j * HK;
    const int rpw = (nrows + F.G - 1) / F.G, rbase = (int)blockIdx.x * rpw, rend = (rbase + rpw < nrows) ? rbase + rpw : nrows;
    const int col = 8 * F.lane, vv = col & 127; const f32x4 g0 = *(const f32x4*)(gn + vv), g1 = *(const f32x4*)(gn + vv + 4);
    for (int r0 = rbase + F.wave; r0 < rend; r0 += 2 * NWAVES) {
        f32x4 a0[2], a1[2], b0[2], b1[2]; v4u hg[2];
#pragma unroll
        for (int q = 0; q < 2; ++q) { const int row = r0 + q * NWAVES; if (row < rend) {
            a0[q] = *(const f32x4*)(OF + (size_t)row * HW + col); a1[q] = *(const f32x4*)(OF + (size_t)row * HW + col + 4); b0[q] = *(const f32x4*)(OB + (size_t)row * HW + col); b1[q] = *(const f32x4*)(OB + (size_t)row * HW + col + 4);
            hg[q] = *(const v4u*)(HG + (size_t)row * HW + col); } }
#pragma unroll
        for (int q = 0; q < 2; ++q) { const int row = r0 + q * NWAVES; if (row < rend) {
            f32x4 x0 = a0[q] + b0[q], x1 = a1[q] + b1[q];
            float s = (x0.x * x0.x + x0.y * x0.y) + (x0.z * x0.z + x0.w * x0.w) + (x1.x * x1.x + x1.y * x1.y) + (x1.z * x1.z + x1.w * x1.w);
            s += shx(s, F.lane, 1); s += shx(s, F.lane, 2); s += shx(s, F.lane, 4); s += shx(s, F.lane, 8);
            const float rstd = rsqrtf(s * (1.0f / HK) + EPS);
            x0 = x0 * rstd * g0; x1 = x1 * rstd * g1; const v4u h = hg[q];
            v4u o; o.x = pg8::cvt_pk_bf16(x0.x * siluf_(bflo(h.x)), x0.y * siluf_(bfhi(h.x))); o.y = pg8::cvt_pk_bf16(x0.z * siluf_(bflo(h.y)), x0.w * siluf_(bfhi(h.y)));
            o.z = pg8::cvt_pk_bf16(x1.x * siluf_(bflo(h.z)), x1.y * siluf_(bfhi(h.z))); o.w = pg8::cvt_pk_bf16(x1.z * siluf_(bflo(h.w)), x1.w * siluf_(bfhi(h.w)));
            *(v4u*)(MIX + (size_t)row * DM + HW + col) = o; } }
    }
}

__device__ __forceinline__ void o12_phase(Frame& F, int nrows, const float* hl, const float* hc, const float* gn, const float* modl) {
    fresh(F);
    bf16* P = (bf16*)(F.ws + WS_POOLED);
    LAS unsigned char* XN = F.lds + RING_OFF;
    const int rpw = (nrows + F.G - 1) / F.G, rbase = (int)blockIdx.x * rpw, rend = (rbase + rpw < nrows) ? rbase + rpw : nrows;
    for (int r0 = rbase; r0 < rend; r0 += 32) {
        for (int sl = F.wave; sl < 48; sl += NWAVES) {
            const int row = r0 - 8 + sl; if (row < 0 || row >= nrows) continue;
            const float* hr = (row < M) ? hl + (size_t)row * DM : hc + (size_t)(row - M) * DM;
            f32x4 v[4]; float s = 0.f;
#pragma unroll
            for (int j = 0; j < 4; ++j) { v[j] = *(const f32x4*)(hr + 4 * F.lane + 256 * j); s += (v[j].x * v[j].x + v[j].y * v[j].y) + (v[j].z * v[j].z + v[j].w * v[j].w); }
            const float rstd = rsqrtf(wave_sum(s, F.lane) * (1.0f / DM) + EPS);
#pragma unroll
            for (int j = 0; j < 4; ++j) { v2u o; o.x = pg8::cvt_pk_bf16(v[j].x * rstd, v[j].y * rstd); o.y = pg8::cvt_pk_bf16(v[j].z * rstd, v[j].w * rstd); *(LAS v2u*)(XN + sl * 2048 + (4 * F.lane + 256 * j) * 2) = o; }
        }
        __syncthreads();
#pragma unroll 1
        for (int q = 0; q < 4; ++q) {
            const int t = r0 + F.wave * 4 + q; if (t >= rend) break;
            const bool lat = t < M; const int T = lat ? SEQ : CTXL; const int tt = lat ? t % SEQ : (t - M) % CTXL; const int bidx = lat ? t / SEQ : NB;
            const int sc0 = t - r0 + 8;
            const float* scp = modl + bidx * NMOD + DM;
#pragma unroll
            for (int g = 0; g < 4; ++g) {
                const int hw = 1 << g, col = 256 * g + 4 * F.lane;
                float s0 = 0.f, s1 = 0.f, s2 = 0.f, s3 = 0.f; int cnt = 0;
#pragma unroll
                for (int d = -hw; d < hw; ++d) { const bool ok = (tt + d >= 0) && (tt + d < T); const v2u x = *(const LAS v2u*)(XN + (sc0 + d) * 2048 + col * 2);
                    s0 += ok ? bflo(x.x) : 0.f; s1 += ok ? bfhi(x.x) : 0.f; s2 += ok ? bflo(x.y) : 0.f; s3 += ok ? bfhi(x.y) : 0.f; cnt += ok ? 1 : 0; }
                const v2u xc = *(const LAS v2u*)(XN + sc0 * 2048 + col * 2); const float ic = 1.0f / (float)cnt;
                const f32x4 gv = *(const f32x4*)(gn + col), sv = *(const f32x4*)(scp + col);
                v2u o; o.x = pg8::cvt_pk_bf16(gv.x * (sv.x + 1.0f) * (s0 * ic - bflo(xc.x)), gv.y * (sv.y + 1.0f) * (s1 * ic - bfhi(xc.x)));
                o.y = pg8::cvt_pk_bf16(gv.z * (sv.z + 1.0f) * (s2 * ic - bflo(xc.y)), gv.w * (sv.w + 1.0f) * (s3 * ic - bfhi(xc.y)));
                *(v2u*)(P + ((size_t)g * MT + t) * 256 + 4 * F.lane) = o;
            }
        }
        __syncthreads();
    }
}

__device__ __forceinline__ void o5_phase(Frame& F, int nrows) {
    fresh(F);
    unsigned char* ws = F.ws;
    const int* CNT = (const int*)(ws + WS_CNT); int* TST = (int*)(ws + WS_TST); const int* EIDX = (const int*)(ws + WS_EIDX); int* POS = (int*)(ws + WS_POS);
    const bf16* U = (const bf16*)(ws + WS_U); bf16* VG = (bf16*)(ws + WS_VG);
    LAS int* lc = (LAS int*)(F.lds + RING_OFF);
    LAS int* lbase = lc + 512 * 8;
    LAS int* lpos = lbase + 32;
    const int rpw = (nrows + F.G - 1) / F.G;
    for (int e = F.tid; e < F.G * 8; e += 512) lc[e] = CNT[e];
    __syncthreads();
    {
        const int e = F.wave; int c4[4]; int sum = 0;
#pragma unroll
        for (int q = 0; q < 4; ++q) { const int w = 4 * F.lane + q; c4[q] = (w < F.G) ? lc[w * 8 + e] : 0; sum += c4[q]; }
        int incl = sum;
#pragma unroll
        for (int o = 1; o < 64; o <<= 1) { const int t = __builtin_amdgcn_ds_bpermute((F.lane >= o ? F.lane - o : F.lane) << 2, incl); if (F.lane >= o) incl += t; }
        const int total = __builtin_amdgcn_readlane(incl, 63); int excl = incl - sum;
        const int myq = (int)blockIdx.x & 3; int pre = excl;
#pragma unroll
        for (int q = 0; q < 3; ++q) if (q < myq) pre += c4[q];
        if (F.lane == ((int)blockIdx.x >> 2)) { lbase[e] = pre; lbase[8 + e] = total; }
    }
    __syncthreads();
    if (F.tid == 0) {
        int ts = 0;
        for (int e = 0; e < 8; ++e) { const int pre = lbase[e], tot = lbase[8 + e]; lbase[e] = ts * 256 + pre; if (blockIdx.x == 0) TST[e] = ts; ts += (tot + 255) >> 8; }
        if (blockIdx.x == 0) TST[8] = ts;
    }
    __syncthreads();
    if (F.wave == 0) {
        int run[8];
#pragma unroll
        for (int e = 0; e < 8; ++e) run[e] = lbase[e];
        const int npairs = 2 * rpw;
        for (int c0 = 0; c0 < npairs; c0 += 64) {
            const int pl = c0 + F.lane; const int row = (int)blockIdx.x * rpw + (pl >> 1); const bool ok = pl < npairs && row < nrows;
            const int e = ok ? EIDX[2 * row + (pl & 1)] : -1; int mypos = 0;
#pragma unroll
            for (int x = 0; x < 8; ++x) { const unsigned long long mk = __ballot(e == x); const int below = __popcll(mk & ((1ull << F.lane) - 1ull)); if (e == x) mypos = run[x] + below; run[x] += __popcll(mk); }
            if (ok) { lpos[pl] = mypos; POS[2 * row + (pl & 1)] = mypos; }
        }
    }
    __syncthreads();
    for (int pl0 = F.wave * 4; pl0 < 2 * rpw; pl0 += NWAVES * 4) {
        v4u a[4], b[4]; int p[4];
#pragma unroll
        for (int q = 0; q < 4; ++q) { const int pl = pl0 + q; const int row = (int)blockIdx.x * rpw + (pl >> 1); p[q] = -1;
            if (pl < 2 * rpw && row < nrows) { p[q] = lpos[pl]; a[q] = *(const v4u*)(U + (size_t)row * DM + 8 * F.lane); b[q] = *(const v4u*)(U + (size_t)row * DM + 512 + 8 * F.lane); } }
#pragma unroll
        for (int q = 0; q < 4; ++q) if (p[q] >= 0) { *(v4u*)(VG + (size_t)p[q] * DM + 8 * F.lane) = a[q]; *(v4u*)(VG + (size_t)p[q] * DM + 512 + 8 * F.lane) = b[q]; }
    }
    __syncthreads();
}

__global__ void __launch_bounds__(NWAVES * 64, 2) mega_fwd(Args args) {
    extern __shared__ __attribute__((aligned(16))) unsigned char lds[];
    Frame F;
    F.lds = (LAS unsigned char*)lds;
    F.wave = __builtin_amdgcn_readfirstlane((int)threadIdx.x >> 6); fresh(F);
    F.G = gridDim.x; { const int bx = blockIdx.x; F.vcu = (F.G % 8 == 0) ? (bx % 8) * (F.G / 8) + bx / 8 : bx; }
    F.in = args.in; F.out = args.out; F.ws = args.ws;
    unsigned char* ws = args.ws;
    volatile LAS unsigned* MISC = (volatile LAS unsigned*)(F.lds + MISC_OFF);
    for (int u = F.tid; u < (LDS_BYTES - LDSCTL_OFF) / 4; u += NWAVES * 64) ((LAS unsigned*)(F.lds + LDSCTL_OFF))[u] = 0u;
    __syncthreads();
    XcdBarrier bar = xcd_barrier_post((unsigned*)(ws + WS_CTL) + CW_BAR, MISC + 8, F.wave);
#define GRID_BAR() do { xcd_barrier(bar); if (DUPMASK & 4096) xcd_barrier(bar); } while (0)
#ifndef ONLY
#define ONLY 0
#endif
#define PH(n) (ONLY == 0 || ONLY == (n))
#define REP(bit) for (int rep_ = 0; rep_ < ((DUPMASK & (bit)) ? 2 : 1); ++rep_)
    LAS unsigned char* ring = F.lds + RING_OFF;
    const float* MODV = (const float*)(ws + WS_MODV);
    float* HC = (float*)(ws + WS_HC);
    bf16* U = (bf16*)(ws + WS_U);

#if PH(20)
    REP(8192) p0_prologue(F);
#endif
    GRID_BAR();

    for (int lp = 0; lp < 2; ++lp) {
        const int le = 2 * lp, lo = 2 * lp + 1, j = lp;
        const bool ctx_out = (lp == 0);
        const int nro = ctx_out ? MT : M;
        const float* modE = MODV + (size_t)le * 17 * NMOD; const float* modO = MODV + (size_t)lo * 17 * NMOD;
        const float* hin_l = (lp == 0) ? args.in[0] : args.out; const float* hin_c = (lp == 0) ? args.in[2] : HC;
#if PH(1)
        {
            RowArgs A{}; A.hin_l = hin_l; A.hin_c = hin_c; A.hout_l = args.out; A.hout_c = HC; A.g = args.in[6] + (size_t)(le * 2 + 0) * DM; A.modl = modE; A.shoff = 0; A.scoff = DM; A.U = U;
            A.Y = (const bf16*)(ws + WS_VG); A.pos = (const int*)(ws + WS_POS); A.gate = (const float*)(ws + WS_GATE); A.modprev = MODV + (size_t)(le - 1) * 17 * NMOD;
            if (lp == 0) row_phase<false, 1, false>(F, A, MT); else row_phase<true, 1, false>(F, A, MT);
        }
#endif
        GRID_BAR();
#if PH(2)
        {
            pg8::Gemm g{U, (const bf16*)(ws + WS_WIN) + (size_t)j * INP * DM, DM, DM, DM}; pg8::InOrder S; S.init(ctx_out, F.G, (int)blockIdx.x);
            EpiIn E{(bf16*)(ws + WS_CQ), (bf16*)(ws + WS_KR), (bf16*)(ws + WS_CKV), (bf16*)(ws + WS_HQ)};
            REP(8) pg8::gemm_phase<EpiIn, pg8::InOrder, true>(ring, g, S, E, F.wave);
        }
#endif
        GRID_BAR();
#if PH(3)
        REP(4 | 32) e3_phase(F);
#endif
        GRID_BAR();
#if PH(4)
        {
            pg8::Gemm g{(const bf16*)(ws + WS_CQ), (const bf16*)(ws + WS_WUQ) + (size_t)j * 768 * QL, QL, QL, QL}; pg8::StaticOrder S; S.init(nro, 768, F.G, (int)blockIdx.x);
            EpiQ E{(bf16*)(ws + WS_QB), (const float*)(ws + WS_RSQ)};
            REP(8) pg8::gemm_phase<EpiQ, pg8::StaticOrder, true>(ring, g, S, E, F.wave);
        }
        {
            pg8::Gemm g{(const bf16*)(ws + WS_CKV), (const bf16*)(ws + WS_WUKV) + (size_t)j * 1024 * KVL, KVL, KVL, KVL}; pg8::StaticOrder S; S.init(MT, 1024, F.G, (int)blockIdx.x);
            EpiKV E{(bf16*)(ws + WS_KN), (bf16*)(ws + WS_VV), (const float*)(ws + WS_RSKV)};
            REP(8) pg8::gemm_phase<EpiKV, pg8::StaticOrder, true>(ring, g, S, E, F.wave);
        }
#endif
        GRID_BAR();
#if PH(6)
        REP(3) mix_phase(F, j, ctx_out);
#endif
        GRID_BAR();
#if PH(8)
        REP(4 | 64) e8_phase(F, j, nro);
#endif
        GRID_BAR();
#if PH(9)
        {
            pg8::Gemm g{(const bf16*)(ws + WS_MIX), (const bf16*)(ws + WS_WOUT) + (size_t)j * DM * DM, DM, DM, DM}; pg8::StaticOrder S; S.init(nro, DM, F.G, (int)blockIdx.x);
            EpiResid E{hin_l, hin_c, args.out, HC, modE, 2 * DM};
            pg8::gemm_phase<EpiResid, pg8::StaticOrder, true>(ring, g, S, E, F.wave);
        }
#endif
        GRID_BAR();
#if PH(10)
        {
            RowArgs A{}; A.hin_l = args.out; A.hin_c = HC; A.g = args.in[6] + (size_t)(le * 2 + 1) * DM; A.modl = modE; A.shoff = 3 * DM; A.scoff = 4 * DM; A.U = U;
            REP(4 | 128) row_phase<false, 1, false>(F, A, nro);
        }
#endif
        GRID_BAR();
#if PH(11)
        {
            pg8::Gemm g{U, (const bf16*)(ws + WS_WGU) + (size_t)j * 2 * DFF * DM, DM, DM, DM}; pg8::StaticOrder S; S.init(nro, 2 * DFF, F.G, (int)blockIdx.x);
            EpiGateUp E{(bf16*)(ws + WS_HID), DFF, 2 * DFF / 256, 0};
            REP(8) pg8::gemm_phase<EpiGateUp, pg8::StaticOrder, true>(ring, g, S, E, F.wave);
        }
#endif
        GRID_BAR();
#if PH(12)
        {
            pg8::Gemm g{(const bf16*)(ws + WS_HID), (const bf16*)(ws + WS_WDN) + (size_t)j * DM * DFF, DFF, DFF, DFF}; pg8::StaticOrder S; S.init(nro, DM, F.G, (int)blockIdx.x);
            EpiResid E{args.out, HC, args.out, HC, modE, 5 * DM};
            pg8::gemm_phase<EpiResid, pg8::StaticOrder, true>(ring, g, S, E, F.wave);
        }
#endif
        GRID_BAR();
#if PH(13)
        {
            RowArgs A{}; A.hin_l = args.out; A.hin_c = HC; A.g = args.in[6] + (size_t)(lo * 2 + 0) * DM; A.modl = modO; A.shoff = 0; A.scoff = DM; A.U = U;
            REP(2048) o12_phase(F, nro, args.out, HC, A.g, modO);
            REP(16) for (int e = 0; e < NE; ++e) {
                conv_matrix(F, args.in[23] + ((size_t)j * NE + e) * DM * DFE, DM, DFE, (bf16*)(ws + WS_MWGU) + (size_t)e * 2 * DFE * DM, DM, 2, 0, nullptr, 1.f);
                conv_matrix(F, args.in[24] + ((size_t)j * NE + e) * DM * DFE, DM, DFE, (bf16*)(ws + WS_MWGU) + (size_t)e * 2 * DFE * DM, DM, 2, 128, nullptr, 1.f);
                conv_matrix(F, args.in[25] + ((size_t)j * NE + e) * DFE * DM, DFE, DM, (bf16*)(ws + WS_MWDN) + (size_t)e * DM * DFE, DFE, 0, 0, nullptr, 1.f);
            }
        }
#endif
        GRID_BAR();
#if PH(15)
        {
            pg8::Gemm g{(const bf16*)(ws + WS_POOLED), (const bf16*)(ws + WS_WPOOL) + (size_t)j * 4 * 65536, 256, 256, 256};
            pg8::PoolOrder S{nro / 256, MT / 256, F.G, (int)blockIdx.x};
            EpiPool E{args.out, HC, modO, args.in[20] + (size_t)j * DM, args.in[21] + (size_t)j * DM, MT / 256};
            pg8::gemm_phase<EpiPool, pg8::PoolOrder, true>(ring, g, S, E, F.wave);
        }
#endif
        GRID_BAR();
#if PH(16)
        {
            RowArgs A{}; A.hin_l = args.out; A.hin_c = HC; A.g = args.in[6] + (size_t)(lo * 2 + 1) * DM; A.modl = modO; A.shoff = 3 * DM; A.scoff = 4 * DM; A.U = U;
            A.router = args.in[22] + (size_t)j * DM * NE; A.eidx = (int*)(ws + WS_EIDX); A.gout = (float*)(ws + WS_GATE); A.cnt = (int*)(ws + WS_CNT);
            REP(4 | 512) row_phase<false, 1, true>(F, A, nro);
        }
#endif
        GRID_BAR();
#if PH(17)
        REP(4 | 1024) o5_phase(F, nro);
#endif
        GRID_BAR();
#if PH(18)
        {
            const int* TST = (const int*)(ws + WS_TST);
            const int ts1 = TST[1], ts2 = TST[2], ts3 = TST[3], ts4 = TST[4], ts5 = TST[5], ts6 = TST[6], ts7 = TST[7], nT = TST[8];
            const int rem = nT % MOE_CH, nseg = nT / MOE_CH + 1;
            for (int p = 0; p <= nseg; ++p) {
                int n7 = 0;
                if (p >= 1) {
                    const int sg = p - 1; const int t0 = sg == 0 ? 0 : rem + (sg - 1) * MOE_CH, nrt = sg == 0 ? rem : MOE_CH; n7 = nrt * (DM / 256);
                    const bf16* hb = (const bf16*)(ws + WS_HIDM) + (size_t)((sg == 0 || ((sg - 1) & 1)) ? MOE_CH : 0) * 256 * DFE;
                    pg8::Gemm g{hb - (size_t)t0 * 256 * DFE, (const bf16*)(ws + WS_MWDN), DFE, DFE, DFE};
                    pg8::MoeOrder S{t0, nrt, DM / 256, F.G, (int)blockIdx.x, ts1, ts2, ts3, ts4, ts5, ts6, ts7, 0, 0};
                    EpiY E{(bf16*)(ws + WS_VG), DM / 256};
                    REP(8) pg8::gemm_phase<EpiY, pg8::MoeOrder, true>(ring, g, S, E, F.wave);
                }
                if (p < nseg) {
                    const int sg = p; const int t0 = sg == 0 ? 0 : rem + (sg - 1) * MOE_CH, nrt = sg == 0 ? rem : MOE_CH;
                    bf16* hb = (bf16*)(ws + WS_HIDM) + (size_t)((sg == 0 || ((sg - 1) & 1)) ? MOE_CH : 0) * 256 * DFE;
                    pg8::Gemm g{(const bf16*)(ws + WS_VG), (const bf16*)(ws + WS_MWGU), DM, DM, DM};
                    pg8::MoeOrder S{t0, nrt, 2 * DFE / 256, F.G, (int)blockIdx.x, ts1, ts2, ts3, ts4, ts5, ts6, ts7, n7 % F.G, 4};
                    EpiGateUp E{hb, DFE, 2 * DFE / 256, t0 * 256};
                    REP(8) pg8::gemm_phase<EpiGateUp, pg8::MoeOrder, true>(ring, g, S, E, F.wave);
                }
                GRID_BAR();
            }
        }
#endif
    }
#if PH(19)
    {
        RowArgs A{}; A.hin_l = args.out; A.hin_c = HC; A.hout_l = args.out; A.hout_c = HC; A.g = args.in[7];
        A.Y = (const bf16*)(ws + WS_VG); A.pos = (const int*)(ws + WS_POS); A.gate = (const float*)(ws + WS_GATE); A.modprev = MODV + (size_t)3 * 17 * NMOD;
        row_phase<true, 2, false>(F, A, M);
        if (xb_ld((unsigned*)(ws + WS_CTL) + CW_BAR + XB_TMO) != 0u) { __syncthreads(); const float qn = __builtin_nanf(""); for (int i = F.tid; i < 1024; i += 512) args.out[(size_t)blockIdx.x * 1024 + i] = qn; }
    }
#endif
}

extern "C" void kernel_launch(void* const* d_in, const int* in_sizes, int n_in, void* d_out, int out_size, void* d_ws, size_t ws_size, hipStream_t stream) {
    static int grid = 0;
    if (grid == 0) {
        if (n_in != 26 || out_size != M * DM || ws_size < WS_END) { fprintf(stderr, "kernel_launch: unexpected shapes (n_in %d out %d ws %zu)\n", n_in, out_size, ws_size); grid = -1; return; }
        int dev = 0, cus = 0, per_cu = 0;
        if (hipGetDevice(&dev) != hipSuccess || hipDeviceGetAttribute(&cus, hipDeviceAttributeMultiprocessorCount, dev) != hipSuccess) { grid = -1; return; }
        if (hipFuncSetAttribute((const void*)mega_fwd, hipFuncAttributeMaxDynamicSharedMemorySize, LDS_BYTES) != hipSuccess) { grid = -1; return; }
        if (hipOccupancyMaxActiveBlocksPerMultiprocessor(&per_cu, (const void*)mega_fwd, NWAVES * 64, LDS_BYTES) != hipSuccess || per_cu < 1) fprintf(stderr, "kernel_launch: occupancy query says %d\n", per_cu);
        (void)hipGetLastError();
        grid = cus > 256 ? 256 : cus;
    }
    if (grid < 0) return;
    if (hipMemsetAsync((char*)d_ws + WS_CTL, 0, CTL_ZERO_BYTES, stream) != hipSuccess) return;
    Args a{};
    for (int i = 0; i < 26; ++i) a.in[i] = (const float*)d_in[i];
    a.out = (float*)d_out; a.ws = (unsigned char*)d_ws;
    hipLaunchKernelGGL(mega_fwd, dim3(grid), dim3(NWAVES * 64), LDS_BYTES, stream, a);
}
```

```cpp
#include <hip/hip_runtime.h>
#ifndef DUPMASK
#define DUPMASK 0
#endif
#include <cstdio>
#include <cstdint>

__device__ __forceinline__ int lane_now() { int l; asm volatile("v_mbcnt_lo_u32_b32 %0, -1, 0\n\tv_mbcnt_hi_u32_b32 %0, -1, %0" : "=v"(l)); return l; }
namespace pg8 {
#define PG8_LAS __attribute__((address_space(3)))
typedef unsigned short bf16_t;
typedef short bf16x8 __attribute__((ext_vector_type(8)));
typedef float f32x4 __attribute__((ext_vector_type(4)));
typedef unsigned u32x4 __attribute__((ext_vector_type(4)));
constexpr int BM = 256, BK = 64, HALF = 128, HTB = HALF * BK * 2, STAGE_BYTES = 8 * HTB, NXCD = 8, WGM = 8;

__host__ __device__ __forceinline__ int lds_byte(int r, int c) { const int st = (r >> 4) * 2 + (c >> 5), rr = r & 15, cc = c & 31, ob = rr * 64 + cc * 2; return st * 1024 + (ob ^ (((ob >> 9) & 1) << 5)); }
__host__ __device__ __forceinline__ void stage_rc(int b, int& R, int& C) { const int st = b / 1024, sb = b % 1024, swz = sb ^ (((sb >> 9) & 1) << 5); R = (st >> 1) * 16 + swz / 64; C = (st & 1) * 32 + (swz % 64) / 2; }
__host__ __device__ __forceinline__ int perm32(int rho) { const int n = rho >> 4, i = rho & 15; return 8 * (i >> 2) + 4 * n + (i & 3); }

struct Unit { int pm, pn; };
struct Gemm { const bf16_t* A; const bf16_t* Bt; int lda, ldb, K; };

struct StaticOrder {
    int nM, nN, nwg, G, c;
    __device__ void init(int M, int N, int G_, int c_) { nM = M / BM; nN = N / BM; nwg = nM * nN; G = G_; c = c_; }
    __device__ bool next(int i, Unit& u) const {
        const long L = (long)i * G + c; if (L >= nwg) return false;
        int wgid = (int)L; { const int q = nwg / NXCD, r = nwg % NXCD, xcd = wgid % NXCD, off = wgid / NXCD; wgid = (xcd < r ? xcd * (q + 1) : r * (q + 1) + (xcd - r) * q) + off; }
        const int nig = WGM * nN, gid = wgid / nig, fm = gid * WGM, gsz = (nM - fm) < WGM ? (nM - fm) : WGM;
        u.pm = fm + ((wgid % nig) % gsz); u.pn = (wgid % nig) / gsz; return true;
    }
};
struct InOrder {
    StaticOrder lat; int nlat, nctx_ct, G, c;
    __device__ void init(bool full, int G_, int c_) { lat.init(32768, 3328, G_, c_); nlat = lat.nwg; nctx_ct = full ? 13 : 8; G = G_; c = c_; }
    __device__ bool next(int i, Unit& u) const {
        const int L = i * G + c; if (L < nlat) return lat.next(i, u);
        const int x = L - nlat; if (x >= 16 * nctx_ct) return false;
        const int rt = (nctx_ct == 13) ? x / 13 : x >> 3, q = x - rt * nctx_ct; u.pm = 128 + rt; u.pn = (nctx_ct == 13) ? q : (q < 2 ? q + 1 : q + 3); return true;
    }
};
struct PoolOrder {
    int nrt, talloc, G, c;
    __device__ bool next(int i, Unit& u) const { const int L = i * G + c; if (L >= 4 * nrt) return false; const int g = L / nrt, rt = L - g * nrt; u.pm = g * talloc + rt; u.pn = g; return true; }
};
struct MoeOrder {
    int t0, nrt, nct, G, c; int ts1, ts2, ts3, ts4, ts5, ts6, ts7;
    int skipw, skipr;
    __device__ bool next(int i, Unit& u) const {
        const int nwg = nrt * nct; const int r_ = i + (c < skipw ? skipr : 0);
        const int L = (r_ < skipr) ? r_ * (G - skipw) + (c - skipw) : skipr * (G - skipw) + (r_ - skipr) * G + c; if (L >= nwg) return false;
        int wgid = L; { const int q = nwg / NXCD, r = nwg % NXCD, xcd = wgid % NXCD, off = wgid / NXCD; wgid = (xcd < r ? xcd * (q + 1) : r * (q + 1) + (xcd - r) * q) + off; }
        const int nig = WGM * nct, gid = wgid / nig, fm = gid * WGM, gsz = (nrt - fm) < WGM ? (nrt - fm) : WGM;
        const int rt = t0 + fm + ((wgid % nig) % gsz), ct = (wgid % nig) / gsz;
        const int e = (rt >= ts1) + (rt >= ts2) + (rt >= ts3) + (rt >= ts4) + (rt >= ts5) + (rt >= ts6) + (rt >= ts7);
        u.pm = rt; u.pn = e * nct + ct; return true;
    }
};

__device__ __forceinline__ unsigned cvt_pk_bf16(float lo, float hi) { unsigned r; asm volatile("v_cvt_pk_bf16_f32 %0, %1, %2" : "=v"(r) : "v"(lo), "v"(hi)); return r; }

template <class Epi, class Sched, bool ALIGN_EPI>
__device__ __forceinline__ void gemm_phase(PG8_LAS unsigned char* lds, const Gemm g, const Sched& S, const Epi& E, const int wid) {
    const int lane_ = lane_now();
    const int lane = lane_, tid = wid * 64 + lane, wr = wid >> 2, wc = wid & 3, fr = lane & 15, fq = lane >> 4;
    int K_ = g.K; asm volatile("" : "+s"(K_));
    const int K = K_, nt = K / BK;
    unsigned voffA[2], voffB[2];
#pragma unroll
    for (int i = 0; i < 2; ++i) { int R, C; stage_rc(tid * 16 + i * 8192, R, C); const int Rb = Epi::PERM ? ((R & ~31) + perm32(R & 31)) : R;
        voffA[i] = (unsigned)(R * g.lda + C) * 2u; voffB[i] = (unsigned)(Rb * g.ldb + C) * 2u; }
    const size_t kstep = (size_t)(BK * 2);
    const size_t hstepA = (size_t)HALF * g.lda * 2, hstepB = (size_t)HALF * g.ldb * 2;
    const size_t tstepA = 2 * hstepA, tstepB = 2 * hstepB;
    const unsigned ldsw = (unsigned)wid * 1024u;
    const int aoff = lds_byte(wr * 64 + fr, fq * 8), boff = lds_byte(wc * 32 + fr, fq * 8);
#define PG8_SA(b, h) (((b) * 2 + (h)) * HTB)
#define PG8_SB(b, h) ((4 + (b) * 2 + (h)) * HTB)
#define PG8_STAGE(bufoff, gbase, voff) do { _Pragma("unroll") for (int _i = 0; _i < 2; ++_i) \
        __builtin_amdgcn_global_load_lds((const unsigned*)((const char*)(gbase) + (voff)[_i]), (PG8_LAS unsigned*)(lds + (bufoff) + ldsw + _i * 8192), 16, 0, 0); } while (0)
#define PG8_LDA(dst, b, h) do { _Pragma("unroll") for (int m = 0; m < 4; ++m) _Pragma("unroll") for (int k = 0; k < 2; ++k) dst[m][k] = *(const PG8_LAS bf16x8*)(lds + PG8_SA(b, h) + aoff + m * 2048 + k * 1024); } while (0)
#define PG8_LDB(dst, b, h) do { _Pragma("unroll") for (int n = 0; n < 2; ++n) _Pragma("unroll") for (int k = 0; k < 2; ++k) dst[n][k] = *(const PG8_LAS bf16x8*)(lds + PG8_SB(b, h) + boff + n * 2048 + k * 1024); } while (0)
#define PG8_MMA(ai, bj, At, Bt) do { __builtin_amdgcn_s_setprio(1); _Pragma("unroll") for (int m = 0; m < 4; ++m) _Pragma("unroll") for (int n = 0; n < 2; ++n) _Pragma("unroll") for (int k = 0; k < 2; ++k) \
        acc[ai][bj][m][n] = __builtin_amdgcn_mfma_f32_16x16x32_bf16(Bt[n][k], At[m][k], acc[ai][bj][m][n], 0, 0, 0); __builtin_amdgcn_s_setprio(0); } while (0)
#define PG8_WAIT_V(n) asm volatile("s_waitcnt vmcnt(" #n ")" ::: "memory")
#define PG8_WAIT_L(n) asm volatile("s_waitcnt lgkmcnt(" #n ")" ::: "memory")
#define PG8_BAR __builtin_amdgcn_s_barrier()
#define PG8_SCHED __builtin_amdgcn_sched_barrier(0)
    Unit cur, nxt; int ui = 0;
    if (!S.next(0, cur)) return;
    f32x4 acc[2][2][4][2];
#pragma unroll
    for (int a = 0; a < 2; ++a)
#pragma unroll
        for (int b = 0; b < 2; ++b)
#pragma unroll
            for (int m = 0; m < 4; ++m)
#pragma unroll
                for (int n = 0; n < 2; ++n) acc[a][b][m][n] = (f32x4){0.f, 0.f, 0.f, 0.f};
    bf16x8 At[4][2], B0[2][2], B1[2][2];
    const char* cA = (const char*)g.A + (size_t)cur.pm * tstepA; const char* cB = (const char*)g.Bt + (size_t)cur.pn * tstepB;
    PG8_STAGE(PG8_SB(0, 0), cB, voffB); PG8_STAGE(PG8_SB(0, 1), cB + hstepB, voffB); PG8_STAGE(PG8_SA(0, 0), cA, voffA); PG8_STAGE(PG8_SA(0, 1), cA + hstepA, voffA);
    if (wr == 1) PG8_BAR;
    PG8_WAIT_V(2); PG8_BAR;
    PG8_STAGE(PG8_SB(1, 0), cB + kstep, voffB); PG8_STAGE(PG8_SA(1, 0), cA + kstep, voffA); PG8_STAGE(PG8_SB(1, 1), cB + hstepB + kstep, voffB);
    PG8_WAIT_V(6); PG8_BAR;
    for (;;) {
        const bool has_next = S.next(ui + 1, nxt);
        const char* nA = has_next ? (const char*)g.A + (size_t)nxt.pm * tstepA : cA; const char* nB = has_next ? (const char*)g.Bt + (size_t)nxt.pn * tstepB : cB;
#pragma unroll 1
        for (int t = 0; t < nt; t += 2) {
            const bool last = (t == nt - 2);
            const char* a1 = cA + (size_t)(t + 1) * kstep;
            const char* a2 = last ? nA : cA + (size_t)(t + 2) * kstep; const char* b2 = last ? nB : cB + (size_t)(t + 2) * kstep;
            const char* a3 = a2 + kstep; const char* b3 = b2 + kstep;
            PG8_LDB(B0, 0, 0); PG8_LDB(B1, 0, 1); PG8_SCHED; PG8_LDA(At, 0, 0); PG8_STAGE(PG8_SA(1, 1), a1 + hstepA, voffA);
            PG8_WAIT_V(8); PG8_WAIT_L(0); PG8_BAR; PG8_MMA(0, 0, At, B0); PG8_MMA(0, 1, At, B1); PG8_BAR; PG8_SCHED;
            PG8_LDA(At, 0, 1); PG8_STAGE(PG8_SB(0, 0), b2, voffB); PG8_STAGE(PG8_SB(0, 1), b2 + hstepB, voffB); PG8_STAGE(PG8_SA(0, 0), a2, voffA);
            PG8_WAIT_V(8); PG8_WAIT_L(0); PG8_BAR; PG8_MMA(1, 0, At, B0); PG8_MMA(1, 1, At, B1); PG8_BAR; PG8_SCHED;
            PG8_LDB(B0, 1, 0); PG8_LDB(B1, 1, 1); PG8_SCHED; PG8_LDA(At, 1, 0); PG8_STAGE(PG8_SA(0, 1), a2 + hstepA, voffA);
            PG8_WAIT_V(8); PG8_WAIT_L(0); PG8_BAR; PG8_MMA(0, 0, At, B0); PG8_MMA(0, 1, At, B1); PG8_BAR; PG8_SCHED;
            PG8_LDA(At, 1, 1); PG8_STAGE(PG8_SB(1, 0), b3, voffB); PG8_STAGE(PG8_SB(1, 1), b3 + hstepB, voffB); PG8_STAGE(PG8_SA(1, 0), a3, voffA);
            PG8_WAIT_V(8); PG8_WAIT_L(0); PG8_BAR; PG8_MMA(1, 0, At, B0); PG8_MMA(1, 1, At, B1); PG8_BAR; PG8_SCHED;
        }
        if constexpr (ALIGN_EPI) { if (wr == 0) PG8_BAR; }
        E(acc, cur, wr, wc, fr, fq);
        if (!has_next) break;
#pragma unroll
        for (int a = 0; a < 2; ++a)
#pragma unroll
            for (int b = 0; b < 2; ++b)
#pragma unroll
                for (int m = 0; m < 4; ++m)
#pragma unroll
                    for (int n = 0; n < 2; ++n) acc[a][b][m][n] = (f32x4){0.f, 0.f, 0.f, 0.f};
        cur = nxt; cA = nA; cB = nB; ++ui;
        if constexpr (ALIGN_EPI) { if (wr == 1) PG8_BAR; }
    }
    PG8_WAIT_V(0);
    if constexpr (!ALIGN_EPI) { if (wr == 0) PG8_BAR; }
    PG8_BAR;
#undef PG8_SA
#undef PG8_SB
#undef PG8_STAGE
#undef PG8_LDA
#undef PG8_LDB
#undef PG8_MMA
#undef PG8_WAIT_V
#undef PG8_WAIT_L
#undef PG8_BAR
#undef PG8_SCHED
}
}

constexpr int NWAVES = 8;
constexpr int DM = 1024, NB = 16, SEQ = 2048, CTXL = 256;
constexpr int M = NB * SEQ, MC = NB * CTXL, MT = M + MC;
constexpr int QL = 384, KVL = 256, ROPE = 32, HW = 512, NH = 8, QKD = 96, VD = 64;
constexpr int INW = 3232, INP = 3328;
constexpr int DFF = 2816, NE = 8, DFE = 3584, NMOD = 6 * DM;
constexpr int NHH = 4, HK = 128; constexpr int NKEY = SEQ + CTXL;
constexpr float EPS = 1e-6f;
constexpr int MAXT = 296;
constexpr int MOE_CH = 128;

constexpr size_t MiB = 1u << 20;
constexpr size_t WS_CTL = 0, CTL_ZERO_BYTES = 1 * MiB;
constexpr size_t WS_MODV = 1 * MiB;
constexpr size_t WS_ROPE = 3 * MiB;
constexpr size_t WS_CNT = 3 * MiB + 64 * 1024;
constexpr size_t WS_TST = 3 * MiB + 128 * 1024;
constexpr size_t WS_EIDX = 4 * MiB, WS_GATE = 4 * MiB + 512 * 1024, WS_POS = 5 * MiB;
constexpr size_t WS_RSQ = 6 * MiB, WS_RSKV = 7 * MiB + 256 * 1024;
constexpr size_t WS_HC = 8 * MiB;
constexpr size_t WS_WIN = 24 * MiB, WS_WUQ = 37 * MiB, WS_WUKV = 39 * MiB, WS_WOUT = 40 * MiB, WS_WGU = 44 * MiB, WS_WDN = 66 * MiB, WS_WPOOL = 77 * MiB;
constexpr size_t WS_U = 80 * MiB;
constexpr size_t WS_X = 152 * MiB;
constexpr size_t WS_CQ = WS_X, WS_CKV = 179 * MiB, WS_KR = 197 * MiB, WS_KRR = 200 * MiB, WS_HQ = 203 * MiB  ;
constexpr size_t WS_QB = 383 * MiB, WS_KN = 437 * MiB, WS_VV = 473 * MiB, WS_OF = 509 * MiB, WS_OB = 581 * MiB, WS_MIX = 653 * MiB, WS_HID = WS_X;
constexpr size_t WS_MWGU = WS_X, WS_MWDN = 264 * MiB, WS_POOLED = 320 * MiB, WS_VG = 392 * MiB, WS_HIDM = 540 * MiB, WS_END = 988 * MiB;
constexpr size_t HSEG = (size_t)MT * HW;
static_assert(WS_HQ + 5 * HSEG * 2 <= WS_QB && WS_MIX + (size_t)MT * DM * 2 <= WS_END && WS_HID + (size_t)MT * DFF * 2 <= WS_QB, "ws map even");
static_assert(WS_HIDM + (size_t)2 * MOE_CH * 256 * DFE * 2 <= WS_END && WS_VG + (size_t)MAXT * 256 * DM * 2 <= WS_HIDM && WS_MWDN + (size_t)NE * DM * DFE * 2 <= WS_POOLED && WS_MWGU + (size_t)NE * 2 * DFE * DM * 2 <= WS_MWDN, "ws map odd");
constexpr int CW_BAR = 4096;

constexpr int RING_OFF = 0, RING_BYTES = 141312;
constexpr int LDSCTL_OFF = RING_BYTES, MISC_OFF = LDSCTL_OFF + 320;
constexpr int LDS_BYTES = 147456;

#define GAS __attribute__((address_space(1)))
#define LAS __attribute__((address_space(3)))
typedef unsigned short bf16;
typedef unsigned v4u __attribute__((ext_vector_type(4)));
typedef unsigned v2u __attribute__((ext_vector_type(2)));
typedef float f32x4 __attribute__((ext_vector_type(4)));
typedef GAS unsigned gu32;
#define RLX_AGENT __ATOMIC_RELAXED, __HIP_MEMORY_SCOPE_AGENT
#define LDS_WAIT() asm volatile("s_waitcnt lgkmcnt(0)" ::: "memory")
__device__ __forceinline__ unsigned f2bf(float f) { unsigned u = __builtin_bit_cast(unsigned, f); return (u + 0x7fffu + ((u >> 16) & 1u)) >> 16; }
__device__ __forceinline__ unsigned pk2(float lo, float hi) { return f2bf(lo) | (f2bf(hi) << 16); }
__device__ __forceinline__ float bf2f(unsigned short b) { return __uint_as_float((unsigned)b << 16); }
__device__ __forceinline__ float bflo(unsigned w) { return __uint_as_float(w << 16); }
__device__ __forceinline__ float bfhi(unsigned w) { return __uint_as_float(w & 0xffff0000u); }
__device__ __forceinline__ float sigmoidf_(float x) { return 1.0f / (1.0f + __expf(-x)); }
__device__ __forceinline__ float siluf_(float x) { return x * __builtin_amdgcn_rcpf(1.0f + __expf(-x)); }

#define XB_TMO      128
#define XB_XCNT(j)  (256  + 64 * (j))
#define XB_XSUB(j)  (1280 + 64 * (j))
#define XB_XGEN(j)  (2304 + 64 * (j))
#define XB_TOP      3328
#define XB_TOPGEN   3392
#define XCD_BAR_WORDS 3456
#define XB_SPIN_CAP (1u << 22)
__device__ __forceinline__ unsigned xb_ld(unsigned* p)              { return __hip_atomic_load(p, __ATOMIC_RELAXED, __HIP_MEMORY_SCOPE_AGENT); }
__device__ __forceinline__ unsigned xb_add(unsigned* p, unsigned v) { return __hip_atomic_fetch_add(p, v, __ATOMIC_RELAXED, __HIP_MEMORY_SCOPE_AGENT); }
__device__ __forceinline__ unsigned xb_xcc_id() { return (unsigned)__builtin_amdgcn_s_getreg((3 << 11) | 20) & 0xFu; }
#define XB_SPIN(cond, bar) do { unsigned _sp = 0; while (cond) { __builtin_amdgcn_s_sleep(1); \
    if ((++_sp & 255u) == 0u) { if (xb_ld(&(bar)[XB_TMO])) break; if (_sp > XB_SPIN_CAP) { atomicAdd(&(bar)[XB_TMO], 1u); break; } } } } while (0)
struct XcdBarrier { unsigned* bar; unsigned x; volatile LAS unsigned* st; int wave; };
__device__ __forceinline__ bool xb_leader(int wave) { return wave == 0 && lane_now() == 0; }
__device__ __forceinline__ XcdBarrier xcd_barrier_post(unsigned* bar, volatile LAS unsigned* st, int wave) {
    XcdBarrier b; b.bar = bar; b.x = xb_xcc_id(); b.st = st; b.wave = wave;
    if (xb_leader(wave)) (void)xb_add(&bar[XB_XCNT(b.x)], 1u);
    return b;
}
__device__ __forceinline__ void xcd_barrier_complete(unsigned* bar, unsigned x, unsigned& nloc, unsigned& nx) {
    const unsigned G = gridDim.x * gridDim.y * gridDim.z;
    unsigned sum, cnt, mine, sp = 0u;
    for (;;) {
        sum = 0u; cnt = 0u; mine = 0u;
#pragma unroll
        for (unsigned j = 0; j < 16; ++j) { const unsigned c = xb_ld(&bar[XB_XCNT(j)]); sum += c; cnt += (c > 0u) ? 1u : 0u; mine = (j == x) ? c : mine; }
        if (sum == G) break;
        __builtin_amdgcn_s_sleep(1);
        if ((++sp & 255u) == 0u) { if (xb_ld(&bar[XB_TMO])) break; if (sp > XB_SPIN_CAP) { atomicAdd(&bar[XB_TMO], 1u); break; } }
    }
    nloc = mine > 0u ? mine : 1u; nx = cnt > 0u ? cnt : 1u;
}
__device__ __forceinline__ void xcd_barrier(const XcdBarrier& b) {
    asm volatile("s_waitcnt vmcnt(0)" ::: "memory");
    __syncthreads();
    if (xb_leader(b.wave)) {
        unsigned* bar = b.bar; asm volatile("" : "+s"(bar));
        __builtin_amdgcn_s_waitcnt(0);
        unsigned nloc = b.st[0], nx = b.st[1];
        if (nloc == 0u) { xcd_barrier_complete(bar, b.x, nloc, nx); b.st[0] = nloc; b.st[1] = nx; }
        const unsigned old = xb_add(&bar[XB_XSUB(b.x)], 1u);
        const unsigned gen = old / nloc;
        if (old + 1u == (gen + 1u) * nloc) {
            __builtin_amdgcn_fence(__ATOMIC_RELEASE, "agent");
            asm volatile("s_waitcnt vmcnt(0)" ::: "memory");
            const unsigned og = xb_add(&bar[XB_TOP], 1u);
            const unsigned tg = og / nx;
            if (og + 1u == (tg + 1u) * nx) xb_add(&bar[XB_TOPGEN], 1u);
            else XB_SPIN(xb_ld(&bar[XB_TOPGEN]) == tg, bar);
            __builtin_amdgcn_fence(__ATOMIC_ACQUIRE, "agent");
            xb_add(&bar[XB_XGEN(b.x)], 1u);
            asm volatile("s_waitcnt vmcnt(0)" ::: "memory");
        } else {
            XB_SPIN(xb_ld(&bar[XB_XGEN(b.x)]) == gen, bar);
            __builtin_amdgcn_fence(__ATOMIC_ACQUIRE, "agent");
            asm volatile("s_waitcnt vmcnt(0)" ::: "memory");
        }
    }
    __syncthreads();
}

struct Args { const float* in[26]; float* out; unsigned char* ws; };
struct Frame {
    LAS unsigned char* lds;
    int tid, lane, wave, G, vcu;
    const float* const* in; float* out; unsigned char* ws;
};
__device__ __forceinline__ float shx(float v, int lane, int m) { return __int_as_float(__builtin_amdgcn_ds_bpermute((lane ^ m) << 2, __float_as_int(v))); }
__device__ __forceinline__ float wave_sum(float v, int lane) {
#pragma unroll
    for (int o = 1; o < 64; o <<= 1) v += shx(v, lane, o);
    return v;
}

__device__ __forceinline__ void fresh(Frame& F) { const int l = lane_now(); F.lane = l; F.tid = F.wave * 64 + l; }

__device__ __forceinline__ void conv_item(const float* W, int ldw, bf16* WT, int ldd, int k0, int n0, int drow0, const float* kscale, float gscale, LAS float* scr, int lane) {
    float wv[32];
#pragma unroll
    for (int i = 0; i < 32; ++i) { const int kk = 2 * i + (lane >> 5); wv[i] = W[(size_t)(k0 + kk) * ldw + n0 + (lane & 31)]; }
#pragma unroll
    for (int i = 0; i < 32; ++i) { const int kk = 2 * i + (lane >> 5); float w = wv[i]; if (kscale) w *= kscale[k0 + kk]; scr[kk * 33 + (lane & 31)] = w * gscale; }
    LDS_WAIT(); asm volatile("" ::: "memory");
    const int c = lane & 7;
#pragma unroll
    for (int j = 0; j < 4; ++j) { const int n = (lane >> 3) + 8 * j; const LAS float* s = scr + (8 * c) * 33 + n;
        v4u o; o.x = pk2(s[0 * 33], s[1 * 33]); o.y = pk2(s[2 * 33], s[3 * 33]); o.z = pk2(s[4 * 33], s[5 * 33]); o.w = pk2(s[6 * 33], s[7 * 33]);
        *(v4u*)(WT + (size_t)(drow0 + n) * ldd + k0 + 8 * c) = o; }
    LDS_WAIT(); asm volatile("" ::: "memory");
}
__device__ __forceinline__ int conv_rowmap(int mode, int n0, int off) {
    if (mode == 0) return n0 + off;
    if (mode == 1) { if (n0 < 384) return n0; if (n0 < 640) return 512 + (n0 - 384); if (n0 < 672) return 384; return 768 + (n0 - 672); }
    return 256 * (n0 >> 7) + (n0 & 127) + off;
}
__device__ __forceinline__ void conv_matrix(Frame& F, const float* W, int K, int N, bf16* WT, int ldd, int mode, int off, const float* kscale, float gscale) {
    LAS float* scr = (LAS float*)(F.lds + RING_OFF + F.wave * 16384);
    const int gw = F.vcu * NWAVES + F.wave, NGW = F.G * NWAVES;
    const int nblk = N / 32, nitems = (K / 64) * nblk;
    for (int it = gw; it < nitems; it += NGW) { const int kb = it / nblk, nb = it % nblk; conv_item(W, N, WT, ldd, 64 * kb, 32 * nb, conv_rowmap(mode, 32 * nb, off), kscale, gscale, scr, F.lane); }
}

__device__ __forceinline__ int row_bidx(int row) { return row < M ? row / SEQ : NB; }

struct RowArgs {
    const float* hin_l; const float* hin_c; float* hout_l; float* hout_c;
    const float* g;
    const float* modl;
    int shoff, scoff;
    bf16* U;
    const bf16* Y; const int* pos; const float* gate; const float* modprev;
    const float* router; int* eidx; float* gout; int* cnt;
    float* zero_a; float* zero_b;
};
template <bool COMBINE, int OUTMODE, bool ROUTER>
__device__ __forceinline__ void row_phase(Frame& F, const RowArgs& A, int nrows) {
    fresh(F);
    const int rpw = (nrows + F.G - 1) / F.G;
    LAS int* lcnt = (LAS int*)(F.lds + RING_OFF);
    if (ROUTER) { if (F.tid < 8) lcnt[F.tid] = 0; __syncthreads(); }
    const int rbase = (int)blockIdx.x * rpw, rend = (rbase + rpw < nrows) ? rbase + rpw : nrows;
#define ROWPTR(r_) (((r_) < M) ? A.hin_l + (size_t)(r_) * DM : A.hin_c + (size_t)((r_) - M) * DM)
    f32x4 rw[16][2];
    if (ROUTER) {
#pragma unroll
        for (int j = 0; j < 4; ++j)
#pragma unroll
            for (int q = 0; q < 4; ++q) { const int col = 4 * F.lane + 256 * j + q; rw[4 * j + q][0] = *(const f32x4*)(A.router + (size_t)col * 8); rw[4 * j + q][1] = *(const f32x4*)(A.router + (size_t)col * 8 + 4); }
    }
    int row = rbase + F.wave;
    f32x4 v[4], vn[4];
    if (row < rend) { const float* hr = ROWPTR(row);
#pragma unroll
        for (int j = 0; j < 4; ++j) v[j] = *(const f32x4*)(hr + 4 * F.lane + 256 * j); }
    for (; row < rend; row += NWAVES) {
        const bool lat = row < M; const int bidx = lat ? row / SEQ : NB;
        const int rnext = row + NWAVES;
        if (rnext < rend) { const float* hr = ROWPTR(rnext);
#pragma unroll
            for (int j = 0; j < 4; ++j) vn[j] = *(const f32x4*)(hr + 4 * F.lane + 256 * j); }
        if (COMBINE) {
            const int pa = A.pos[2 * row], pb = A.pos[2 * row + 1]; const float ga = A.gate[2 * row], gb = A.gate[2 * row + 1];
            const float* g2 = A.modprev + bidx * NMOD + 5 * DM;
#pragma unroll
            for (int j = 0; j < 4; ++j) { const int col = 4 * F.lane + 256 * j;
                const v2u ya = *(const v2u*)(A.Y + (size_t)pa * DM + col), yb = *(const v2u*)(A.Y + (size_t)pb * DM + col); const f32x4 gv = *(const f32x4*)(g2 + col);
                v[j].x += gv.x * (ga * bflo(ya.x) + gb * bflo(yb.x)); v[j].y += gv.y * (ga * bfhi(ya.x) + gb * bfhi(yb.x));
                v[j].z += gv.z * (ga * bflo(ya.y) + gb * bflo(yb.y)); v[j].w += gv.w * (ga * bfhi(ya.y) + gb * bfhi(yb.y)); }
            if (OUTMODE != 2) { float* ho = lat ? A.hout_l + (size_t)row * DM : A.hout_c + (size_t)(row - M) * DM;
#pragma unroll
                for (int j = 0; j < 4; ++j) *(f32x4*)(ho + 4 * F.lane + 256 * j) = v[j]; }
        }
        float s = 0.f;
#pragma unroll
        for (int j = 0; j < 4; ++j) s += (v[j].x * v[j].x + v[j].y * v[j].y) + (v[j].z * v[j].z + v[j].w * v[j].w);
        const float rstd = rsqrtf(wave_sum(s, F.lane) * (1.0f / DM) + EPS);
        if (OUTMODE == 2) {
            float* ho = A.hout_l + (size_t)row * DM;
#pragma unroll
            for (int j = 0; j < 4; ++j) { const int col = 4 * F.lane + 256 * j; const f32x4 gv = *(const f32x4*)(A.g + col); *(f32x4*)(ho + col) = v[j] * rstd * gv; }
        } else {
            const float* sh = A.modl + bidx * NMOD + A.shoff; const float* sc = A.modl + bidx * NMOD + A.scoff;
            float lg[8];
            if (ROUTER) {
#pragma unroll
                for (int e = 0; e < 8; ++e) lg[e] = 0.f;
            }
#pragma unroll
            for (int j = 0; j < 4; ++j) { const int col = 4 * F.lane + 256 * j; const f32x4 gv = *(const f32x4*)(A.g + col), shv = *(const f32x4*)(sh + col), scv = *(const f32x4*)(sc + col);
                f32x4 y = v[j] * rstd * gv * (scv + 1.0f) + shv;
                v2u o; o.x = pg8::cvt_pk_bf16(y.x, y.y); o.y = pg8::cvt_pk_bf16(y.z, y.w); *(v2u*)(A.U + (size_t)row * DM + col) = o;
                if (ROUTER) {
#pragma unroll
                    for (int q = 0; q < 4; ++q) { const f32x4 r0 = rw[4 * j + q][0], r1 = rw[4 * j + q][1]; const float yy = y[q];
                        lg[0] += yy * r0.x; lg[1] += yy * r0.y; lg[2] += yy * r0.z; lg[3] += yy * r0.w; lg[4] += yy * r1.x; lg[5] += yy * r1.y; lg[6] += yy * r1.z; lg[7] += yy * r1.w; } }
            }
            if (ROUTER) {
                const int b5 = F.lane >> 5, b4 = (F.lane >> 4) & 1, b3 = (F.lane >> 3) & 1; float a4[4], c2[2];
#pragma unroll
                for (int q = 0; q < 4; ++q) { const float mine = b5 ? lg[4 + q] : lg[q], oth = b5 ? lg[q] : lg[4 + q]; a4[q] = mine + shx(oth, F.lane, 32); }
#pragma unroll
                for (int q = 0; q < 2; ++q) { const float mine = b4 ? a4[2 + q] : a4[q], oth = b4 ? a4[q] : a4[2 + q]; c2[q] = mine + shx(oth, F.lane, 16); }
                float d1 = (b3 ? c2[1] : c2[0]) + shx(b3 ? c2[0] : c2[1], F.lane, 8);
                d1 += shx(d1, F.lane, 4); d1 += shx(d1, F.lane, 2); d1 += shx(d1, F.lane, 1);
#pragma unroll
                for (int e = 0; e < 8; ++e) lg[e] = __int_as_float(__builtin_amdgcn_readlane(__float_as_int(d1), 8 * e));
                int i0 = 0; float v0 = lg[0];
#pragma unroll
                for (int e = 1; e < 8; ++e) if (lg[e] > v0) { v0 = lg[e]; i0 = e; }
                int i1 = -1; float v1 = -INFINITY;
#pragma unroll
                for (int e = 0; e < 8; ++e) if (e != i0 && lg[e] > v1) { v1 = lg[e]; i1 = e; }
                const float g0 = 1.0f / (1.0f + __expf(v1 - v0));
                if (F.lane == 0) { A.eidx[2 * row] = i0; A.eidx[2 * row + 1] = i1; A.gout[2 * row] = g0; A.gout[2 * row + 1] = 1.0f - g0; atomicAdd((int*)&lcnt[i0], 1); atomicAdd((int*)&lcnt[i1], 1); }
            }
        }
#pragma unroll
        for (int j = 0; j < 4; ++j) v[j] = vn[j];
    }
#undef ROWPTR
    if (ROUTER) { __syncthreads(); if (F.tid < 8) A.cnt[blockIdx.x * 8 + F.tid] = lcnt[F.tid]; __syncthreads(); }
}

using pg8::Unit; using pg8::cvt_pk_bf16;
__device__ __forceinline__ v4u pack8(const f32x4& a, const f32x4& b) { v4u w; w.x = cvt_pk_bf16(a[0], a[1]); w.y = cvt_pk_bf16(a[2], a[3]); w.z = cvt_pk_bf16(b[0], b[1]); w.w = cvt_pk_bf16(b[2], b[3]); return w; }
struct EpiIn {
    static constexpr bool PERM = true;
    bf16 *CQ, *KRR, *CKV, *H5; float* ssq_q; float* ssq_kv; const float* TC;
    __device__ __forceinline__ void operator()(const f32x4 (&acc)[2][2][4][2], const Unit& u, int wr, int wc, int fr, int fq) const {
        const int row0 = u.pm * 256 + wr * 64 + fr; const int lane = fr + 16 * fq;
#pragma unroll
        for (int bj = 0; bj < 2; ++bj) {
            const int col = u.pn * 256 + bj * 128 + wc * 32 + 8 * fq;
            bf16* base; int ld;
            if (col < 384) { base = CQ + col; ld = QL; }
            else if (col < 512) { base = nullptr; ld = 0; }
            else if (col < 768) { base = CKV + (col - 512); ld = KVL; }
            else { const int c2 = col - 768; base = H5 + (size_t)(c2 >> 9) * HSEG + (c2 & 511); ld = HW; }
            if (base) {
#pragma unroll
                for (int ai = 0; ai < 2; ++ai)
#pragma unroll
                    for (int m = 0; m < 4; ++m) { const int row = row0 + ai * 128 + m * 16; *(v4u*)(base + (size_t)row * ld) = pack8(acc[ai][bj][m][0], acc[ai][bj][m][1]); }
            }
        }
        if (u.pn <= 2) {
            const int nb = (u.pn == 1) ? 1 : 2; float* dst = (u.pn == 2) ? ssq_kv : ssq_q;
#pragma unroll
            for (int ai = 0; ai < 2; ++ai)
#pragma unroll
                for (int m = 0; m < 4; ++m) { float ss = 0.f;
#pragma unroll
                    for (int bj = 0; bj < 2; ++bj) if (bj < nb) {
#pragma unroll
                        for (int n = 0; n < 2; ++n) { const f32x4 x = acc[ai][bj][m][n]; ss += (x[0] * x[0] + x[1] * x[1]) + (x[2] * x[2] + x[3] * x[3]); } }
                    ss += shx(ss, lane, 16); ss += shx(ss, lane, 32);
                    if (fq == 0) { const int row = row0 + ai * 128 + m * 16; if (u.pn == 2) dst[row * 4 + wc] = ss; else dst[row * 8 + u.pn * 4 + wc] = ss; } }
            if (u.pn == 1 && wc == 0) {
                const int a = fq >> 1, half = fq & 1;
#pragma unroll
                for (int ai = 0; ai < 2; ++ai)
#pragma unroll
                    for (int m = 0; m < 4; ++m) { const int row = row0 + ai * 128 + m * 16; f32x4 o[2];
                        const bool lat = row < M; const int t = row % SEQ; const int p = a ? (t & 63) : (t >> 6);
#pragma unroll
                        for (int n = 0; n < 2; ++n)
#pragma unroll
                            for (int q = 0; q < 4; ++q) { const float x = acc[ai][1][m][n][q]; const float pr = shx(x, lane, 16); const float c = TC[p * 8 + 4 * n + q], sn = TC[512 + p * 8 + 4 * n + q];
                                o[n][q] = lat ? (half ? x * c + pr * sn : x * c - pr * sn) : x; }
                        *(v4u*)(KRR + (size_t)row * ROPE + 8 * fq) = pack8(o[0], o[1]); }
            }
        }
    }
};
struct EpiQ {
    static constexpr bool PERM = true;
    bf16* O; const float* rs;
    __device__ __forceinline__ void operator()(const f32x4 (&acc)[2][2][4][2], const Unit& u, int wr, int wc, int fr, int fq) const {
        const int row0 = u.pm * 256 + wr * 64 + fr;
#pragma unroll
        for (int ai = 0; ai < 2; ++ai)
#pragma unroll
            for (int m = 0; m < 4; ++m) { const int row = row0 + ai * 128 + m * 16; const f32x4 p0 = *(const f32x4*)(rs + (size_t)row * 8), p1 = *(const f32x4*)(rs + (size_t)row * 8 + 4); const float sc = rsqrtf((((p0.x + p0.y) + (p0.z + p0.w)) + ((p1.x + p1.y) + (p1.z + p1.w))) * (1.0f / QL) + EPS);
#pragma unroll
                for (int bj = 0; bj < 2; ++bj) { const int col = u.pn * 256 + bj * 128 + wc * 32 + 8 * fq; *(v4u*)(O + (size_t)row * 768 + col) = pack8(acc[ai][bj][m][0] * sc, acc[ai][bj][m][1] * sc); } }
    }
};
struct EpiKV {
    static constexpr bool PERM = true;
    bf16* KNp; bf16* VTp; const float* rs;
    __device__ __forceinline__ void operator()(const f32x4 (&acc)[2][2][4][2], const Unit& u, int wr, int wc, int fr, int fq) const {
        const int row0 = u.pm * 256 + wr * 64 + fr;
#pragma unroll
        for (int ai = 0; ai < 2; ++ai)
#pragma unroll
            for (int m = 0; m < 4; ++m) { const int row = row0 + ai * 128 + m * 16; const f32x4 p0 = *(const f32x4*)(rs + (size_t)row * 4); const float sc = rsqrtf(((p0.x + p0.y) + (p0.z + p0.w)) * (1.0f / KVL) + EPS);
                const bool lat = row < M; const int b = lat ? row / SEQ : (row - M) / CTXL; const int key = lat ? row % SEQ : SEQ + (row - M) % CTXL;
                const int kpos = (key & ~12) | ((key & 4) << 1) | ((key & 8) >> 1);
#pragma unroll
                for (int bj = 0; bj < 2; ++bj) { const int col = u.pn * 256 + bj * 128 + wc * 32 + 8 * fq; const int hh = col >> 7, w = col & 127;
                    if (w < 64) { *(v4u*)(KNp + (size_t)row * HW + hh * 64 + w) = pack8(acc[ai][bj][m][0] * sc, acc[ai][bj][m][1] * sc); }
                    else { bf16* dst = VTp + ((size_t)((b * NH + hh) * VD + (w - 64))) * NKEY + kpos;
#pragma unroll
                        for (int n = 0; n < 2; ++n)
#pragma unroll
                            for (int q = 0; q < 4; ++q) dst[(size_t)(4 * n + q) * NKEY] = (bf16)f2bf(acc[ai][bj][m][n][q] * sc); } } }
    }
};
struct EpiResid {
    static constexpr bool PERM = false;
    const float* hin_l; const float* hin_c; float* hout_l; float* hout_c; const float* modl; int goff;
    __device__ __forceinline__ void operator()(const f32x4 (&acc)[2][2][4][2], const Unit& u, int wr, int wc, int fr, int fq) const {
        const int rowt = u.pm * 256; const bool lat = rowt < M; const int bidx = lat ? rowt / SEQ : NB;
        const float* gate = modl + bidx * NMOD + goff;
        const float* hi = lat ? hin_l + (size_t)rowt * DM : hin_c + (size_t)(rowt - M) * DM;
        float* ho = lat ? hout_l + (size_t)rowt * DM : hout_c + (size_t)(rowt - M) * DM;
        const int col0 = u.pn * 256 + wc * 32 + 4 * fq;
#pragma unroll
        for (int bj = 0; bj < 2; ++bj) {
            f32x4 hv[2][2][4];
#pragma unroll
            for (int n = 0; n < 2; ++n)
#pragma unroll
                for (int ai = 0; ai < 2; ++ai)
#pragma unroll
                    for (int m = 0; m < 4; ++m) hv[n][ai][m] = *(const f32x4*)(hi + (size_t)(ai * 128 + wr * 64 + m * 16 + fr) * DM + col0 + bj * 128 + n * 16);
#pragma unroll
            for (int n = 0; n < 2; ++n) { const f32x4 gv = *(const f32x4*)(gate + col0 + bj * 128 + n * 16);
#pragma unroll
                for (int ai = 0; ai < 2; ++ai)
#pragma unroll
                    for (int m = 0; m < 4; ++m) *(f32x4*)(ho + (size_t)(ai * 128 + wr * 64 + m * 16 + fr) * DM + col0 + bj * 128 + n * 16) = hv[n][ai][m] + gv * acc[ai][bj][m][n]; }
            asm volatile("" ::: "memory"); }
    }
};
struct EpiPool {
    static constexpr bool PERM = false;
    float* h_l; float* h_c; const float* modl; const float* bias; const float* scale; int talloc;
    __device__ __forceinline__ void operator()(const f32x4 (&acc)[2][2][4][2], const Unit& u, int wr, int wc, int fr, int fq) const {
        const int g = u.pn, rowt = (u.pm - g * talloc) * 256; const bool lat = rowt < M; const int bidx = lat ? rowt / SEQ : NB;
        const float* gate = modl + bidx * NMOD + 2 * DM;
        float* ho = lat ? h_l + (size_t)rowt * DM : h_c + (size_t)(rowt - M) * DM;
        const int col0 = g * 256 + wc * 32 + 4 * fq;
#pragma unroll
        for (int bj = 0; bj < 2; ++bj)
#pragma unroll
            for (int n = 0; n < 2; ++n) { const int c = col0 + bj * 128 + n * 16; const f32x4 gm = *(const f32x4*)(gate + c) * *(const f32x4*)(scale + c); const f32x4 gb = gm * *(const f32x4*)(bias + c);
#pragma unroll
                for (int ai = 0; ai < 2; ++ai)
#pragma unroll
                    for (int m = 0; m < 4; ++m) { const int r = ai * 128 + wr * 64 + m * 16 + fr; const size_t off = (size_t)r * DM + c; const f32x4 hv = *(const f32x4*)(ho + off); *(f32x4*)(ho + off) = hv + gm * acc[ai][bj][m][n] + gb; }
                asm volatile("" ::: "memory"); }
    }
};
struct EpiGateUp {
    static constexpr bool PERM = true;
    bf16* H; int ldh, nct, rowsub;
    __device__ __forceinline__ void operator()(const f32x4 (&acc)[2][2][4][2], const Unit& u, int wr, int wc, int fr, int fq) const {
        const int row0 = u.pm * 256 + wr * 64 + fr - rowsub; const int ct = u.pn % nct; const int col = ct * 128 + wc * 32 + 8 * fq;
#pragma unroll
        for (int ai = 0; ai < 2; ++ai)
#pragma unroll
            for (int m = 0; m < 4; ++m) { const int row = row0 + ai * 128 + m * 16; f32x4 o[2];
#pragma unroll
                for (int n = 0; n < 2; ++n)
#pragma unroll
                    for (int q = 0; q < 4; ++q) { const float gv = acc[ai][0][m][n][q], uv = acc[ai][1][m][n][q]; o[n][q] = gv * uv * __builtin_amdgcn_rcpf(1.0f + __expf(-gv)); }
                *(v4u*)(H + (size_t)row * ldh + col) = pack8(o[0], o[1]); }
    }
};
struct EpiY {
    static constexpr bool PERM = true;
    bf16* Y; int nct;
    __device__ __forceinline__ void operator()(const f32x4 (&acc)[2][2][4][2], const Unit& u, int wr, int wc, int fr, int fq) const {
        const int row0 = u.pm * 256 + wr * 64 + fr; const int ct = u.pn % nct;
#pragma unroll
        for (int ai = 0; ai < 2; ++ai)
#pragma unroll
            for (int m = 0; m < 4; ++m) { const int row = row0 + ai * 128 + m * 16;
#pragma unroll
                for (int bj = 0; bj < 2; ++bj) { const int col = ct * 256 + bj * 128 + wc * 32 + 8 * fq; *(v4u*)(Y + (size_t)row * DM + col) = pack8(acc[ai][bj][m][0], acc[ai][bj][m][1]); } }
    }
};

__device__ __forceinline__ void p0_prologue(Frame& F) {
    fresh(F);
    unsigned char* ws = F.ws;
    const float qscale = 0.10206207261596577f * 1.4426950408889634f;
    for (int j = 0; j < 2; ++j) {
        conv_matrix(F, F.in[8] + (size_t)j * DM * INW, DM, INW, (bf16*)(ws + WS_WIN) + (size_t)j * INP * DM, DM, 1, 0, nullptr, 1.f);
        conv_matrix(F, F.in[11] + (size_t)j * QL * 768, QL, 768, (bf16*)(ws + WS_WUQ) + (size_t)j * 768 * QL, QL, 0, 0, F.in[9] + j * QL, qscale);
        conv_matrix(F, F.in[12] + (size_t)j * KVL * 1024, KVL, 1024, (bf16*)(ws + WS_WUKV) + (size_t)j * 1024 * KVL, KVL, 0, 0, F.in[10] + j * KVL, 1.f);
        conv_matrix(F, F.in[15] + (size_t)j * DM * DM, DM, DM, (bf16*)(ws + WS_WOUT) + (size_t)j * DM * DM, DM, 0, 0, nullptr, 1.f);
        conv_matrix(F, F.in[16] + (size_t)j * DM * DFF, DM, DFF, (bf16*)(ws + WS_WGU) + (size_t)j * 2 * DFF * DM, DM, 2, 0, nullptr, 1.f);
        conv_matrix(F, F.in[17] + (size_t)j * DM * DFF, DM, DFF, (bf16*)(ws + WS_WGU) + (size_t)j * 2 * DFF * DM, DM, 2, 128, nullptr, 1.f);
        conv_matrix(F, F.in[18] + (size_t)j * DFF * DM, DFF, DM, (bf16*)(ws + WS_WDN) + (size_t)j * DM * DFF, DFF, 0, 0, nullptr, 1.f);
        for (int g = 0; g < 4; ++g)
            conv_matrix(F, F.in[19] + (size_t)(j * 4 + g) * 65536, 256, 256, (bf16*)(ws + WS_WPOOL) + (size_t)(j * 4 + g) * 65536, 256, 0, 0, nullptr, 1.f);
    }
    __syncthreads();
    if (blockIdx.x == 0 && F.tid < 8) {
        float* TC = (float*)(ws + WS_ROPE); float* TS = TC + 512;
        double th = 1.0; for (int i = 0; i < F.tid; ++i) th *= 0.31622776601683794;
        const double x2 = th * th; double s = th, c = 1.0, ts = th, tc = 1.0;
        for (int n = 1; n <= 12; ++n) { tc *= -x2 / (double)((2 * n - 1) * (2 * n)); c += tc; ts *= -x2 / (double)((2 * n) * (2 * n + 1)); s += ts; }
        double cp = 1.0, sp = 0.0;
        for (int p = 0; p < 64; ++p) { TC[p * 8 + F.tid] = (float)cp; TS[p * 8 + F.tid] = (float)sp; const double ncp = cp * c - sp * s; sp = sp * c + cp * s; cp = ncp; }
    }
    {
        LAS float* sc = (LAS float*)(F.lds + RING_OFF);
        LAS float* red = sc + 17 * 1024;
        const int nitems = 4 * (NMOD / 64);
        if ((int)blockIdx.x < nitems) {
            for (int e = F.tid; e < 17 * 1024; e += 512) { const int r = e >> 10, k = e & 1023; const float x = (r < 16) ? F.in[1][r * 1024 + k] : F.in[3][k]; sc[e] = siluf_(x); }
            __syncthreads();
            for (int it = blockIdx.x; it < nitems; it += F.G) {
                const int l = it / (NMOD / 64), c0 = (it % (NMOD / 64)) * 64;
                const float* W = F.in[4] + (size_t)l * DM * NMOD + c0 + F.lane;
                float acc[17];
#pragma unroll
                for (int r = 0; r < 17; ++r) acc[r] = 0.f;
                const int kb = F.wave * 128;
                for (int k = 0; k < 128; k += 4) {
                    const float w0 = W[(size_t)(kb + k) * NMOD], w1 = W[(size_t)(kb + k + 1) * NMOD], w2 = W[(size_t)(kb + k + 2) * NMOD], w3 = W[(size_t)(kb + k + 3) * NMOD];
#pragma unroll
                    for (int r = 0; r < 17; ++r) { const f32x4 s4 = *(const LAS f32x4*)(sc + r * 1024 + kb + k); acc[r] += s4.x * w0 + s4.y * w1 + s4.z * w2 + s4.w * w3; }
                }
#pragma unroll
                for (int r = 0; r < 17; ++r) red[(F.wave * 17 + r) * 64 + F.lane] = acc[r];
                __syncthreads();
                for (int o = F.tid; o < 17 * 64; o += 512) { const int r = o >> 6, cc = o & 63; float s = 0.f;
#pragma unroll
                    for (int w = 0; w < 8; ++w) s += red[(w * 17 + r) * 64 + cc];
                    ((float*)(ws + WS_MODV))[(size_t)(l * 17 + r) * NMOD + c0 + cc] = s + F.in[5][l * NMOD + c0 + cc]; }
                __syncthreads();
            }
        }
    }
}

__device__ __forceinline__ void e3_phase(Frame& F) {
    fresh(F);
    unsigned char* ws = F.ws;
    const bf16* CQ = (const bf16*)(ws + WS_CQ); const bf16* CKV = (const bf16*)(ws + WS_CKV); const bf16* KR = (const bf16*)(ws + WS_KR); bf16* KRR = (bf16*)(ws + WS_KRR);
    float* RSQ = (float*)(ws + WS_RSQ); float* RSKV = (float*)(ws + WS_RSKV); const float* TC = (const float*)(ws + WS_ROPE); const float* TS = TC + 512;
    const int rpw = (MT + F.G - 1) / F.G;
    for (int i = F.wave; i < rpw; i += NWAVES) {
        const int row = (int)blockIdx.x * rpw + i; if (row >= MT) break;
        float s = 0.f;
        if (F.lane < 48) { const v4u w = *(const v4u*)(CQ + (size_t)row * QL + F.lane * 8);
            s = bflo(w.x) * bflo(w.x) + bfhi(w.x) * bfhi(w.x) + bflo(w.y) * bflo(w.y) + bfhi(w.y) * bfhi(w.y) + bflo(w.z) * bflo(w.z) + bfhi(w.z) * bfhi(w.z) + bflo(w.w) * bflo(w.w) + bfhi(w.w) * bfhi(w.w); }
        s = wave_sum(s, F.lane); if (F.lane == 0) RSQ[row] = rsqrtf(s * (1.0f / QL) + EPS);
        s = 0.f;
        if (F.lane < 32) { const v4u w = *(const v4u*)(CKV + (size_t)row * KVL + F.lane * 8);
            s = bflo(w.x) * bflo(w.x) + bfhi(w.x) * bfhi(w.x) + bflo(w.y) * bflo(w.y) + bfhi(w.y) * bfhi(w.y) + bflo(w.z) * bflo(w.z) + bfhi(w.z) * bfhi(w.z) + bflo(w.w) * bflo(w.w) + bfhi(w.w) * bfhi(w.w); }
        s = wave_sum(s, F.lane); if (F.lane == 0) RSKV[row] = rsqrtf(s * (1.0f / KVL) + EPS);
        const float x = (F.lane < 32) ? bf2f(KR[(size_t)row * ROPE + F.lane]) : 0.f; const float pr = shx(x, F.lane, 8);
        float o = x;
        if (row < M) { const int t = row % SEQ; const int p = ((F.lane >> 4) & 1) ? (t & 63) : (t >> 6); const int j = F.lane & 7; const float c = TC[p * 8 + j], sn = TS[p * 8 + j];
            o = ((F.lane >> 3) & 1) ? x * c + pr * sn : x * c - pr * sn; }
        if (F.lane < 32) KRR[(size_t)row * ROPE + F.lane] = (bf16)f2bf(o);
    }
}

typedef short bf16x8v __attribute__((ext_vector_type(8)));
typedef float f32x16 __attribute__((ext_vector_type(16)));
__device__ __forceinline__ void attn_unit(Frame& F, int b, int h, int qrow0, bool rope_q, int t_lo, int t_hi) {
    unsigned char* ws = F.ws;
    const bf16* QB = (const bf16*)(ws + WS_QB); const bf16* KN = (const bf16*)(ws + WS_KN); const bf16* KRR = (const bf16*)(ws + WS_KRR); const bf16* VT = (const bf16*)(ws + WS_VV);
    bf16* MIX = (bf16*)(ws + WS_MIX); const float* TC = (const float*)(ws + WS_ROPE); const float* TS = TC + 512;
    const int lane = F.lane, wave = F.wave, r32 = lane & 31, hi = lane >> 5;
    LAS unsigned char* ring = F.lds + RING_OFF;
    const int qrow = qrow0 + wave * 32 + r32;
    bf16x8v qr[6];
#pragma unroll
    for (int d0 = 0; d0 < 6; ++d0) qr[d0] = *(const bf16x8v*)(QB + (size_t)qrow * 768 + h * QKD + 16 * d0 + 8 * hi);
    if (rope_q) { const int t = qrow % SEQ;
#pragma unroll
        for (int a = 0; a < 2; ++a) { const int p = a ? (t & 63) : (t >> 6); const v4u w = __builtin_bit_cast(v4u, qr[4 + a]); float x[8], y[8];
            x[0] = bflo(w.x); x[1] = bfhi(w.x); x[2] = bflo(w.y); x[3] = bfhi(w.y); x[4] = bflo(w.z); x[5] = bfhi(w.z); x[6] = bflo(w.w); x[7] = bfhi(w.w);
#pragma unroll
            for (int jj = 0; jj < 8; ++jj) { const float pr = shx(x[jj], lane, 32); const float c = TC[p * 8 + jj], sn = TS[p * 8 + jj]; y[jj] = hi ? x[jj] * c + pr * sn : x[jj] * c - pr * sn; }
            v4u o; o.x = pk2(y[0], y[1]); o.y = pk2(y[2], y[3]); o.z = pk2(y[4], y[5]); o.w = pk2(y[6], y[7]); qr[4 + a] = __builtin_bit_cast(bf16x8v, o); } }
    const int bh = b * NH + h;
    const bf16* vsrc = VT + ((size_t)(bh * VD + lane)) * NKEY + 8 * wave;
#define ATT_DMA(t, buf) do { const int t_ = (t); const int r0_ = t_ < SEQ / 64 ? b * SEQ + 64 * t_ : M + b * CTXL + 64 * (t_ - SEQ / 64); \
        LAS unsigned char* kb_ = ring + (buf) * 20480; LAS unsigned char* vb_ = kb_ + 12288; \
        __builtin_amdgcn_global_load_lds((const unsigned*)(KN + (size_t)(r0_ + lane) * HW + h * 64 + 8 * wave), (LAS unsigned*)(kb_ + wave * 1024), 16, 0, 0); \
        __builtin_amdgcn_global_load_lds((const unsigned*)(KRR + (size_t)(r0_ + lane) * ROPE + 8 * (wave & 3)), (LAS unsigned*)(kb_ + (8 + (wave & 3)) * 1024), 16, 0, 0);     \
        __builtin_amdgcn_global_load_lds((const unsigned*)(vsrc + 64 * t_), (LAS unsigned*)(vb_ + wave * 1024), 16, 0, 0); } while (0)
    f32x16 o0, o1;
#pragma unroll
    for (int r = 0; r < 16; ++r) { o0[r] = 0.f; o1[r] = 0.f; }
    constexpr float ATT_THR = 8.0f;
    float m_run = 0.f, l_run = 0.f;
    asm volatile("s_waitcnt vmcnt(0)" ::: "memory");
    ATT_DMA(t_lo, 0); if (t_lo + 1 < t_hi) ATT_DMA(t_lo + 1, 1); if (t_lo + 2 < t_hi) ATT_DMA(t_lo + 2, 2);
    for (int t = t_lo; t < t_hi; ++t) {
        const int buf = (t - t_lo) & 3; const int rem = t_hi - 1 - t;
        if (rem >= 2) asm volatile("s_waitcnt vmcnt(6)" ::: "memory"); else if (rem == 1) asm volatile("s_waitcnt vmcnt(3)" ::: "memory"); else asm volatile("s_waitcnt vmcnt(0)" ::: "memory");
        asm volatile("s_waitcnt lgkmcnt(0)" ::: "memory"); __builtin_amdgcn_s_barrier(); asm volatile("" ::: "memory");
        if (t + 3 < t_hi) ATT_DMA(t + 3, (buf + 3) & 3);
        const LAS unsigned char* kb = ring + buf * 20480 + hi * 1024 + r32 * 16; const LAS unsigned char* vb = ring + buf * 20480 + 12288 + hi * 1024 + r32 * 16;
        bf16x8v kf[12], vf[8];
#pragma unroll
        for (int d0 = 0; d0 < 6; ++d0) { kf[2 * d0] = *(const LAS bf16x8v*)(kb + d0 * 2048); kf[2 * d0 + 1] = *(const LAS bf16x8v*)(kb + d0 * 2048 + 512); }
#pragma unroll
        for (int s4 = 0; s4 < 4; ++s4) { vf[2 * s4] = *(const LAS bf16x8v*)(vb + s4 * 2048); vf[2 * s4 + 1] = *(const LAS bf16x8v*)(vb + s4 * 2048 + 512); }
        f32x16 p0, p1; const float negm = -m_run;
#pragma unroll
        for (int r = 0; r < 16; ++r) { p0[r] = negm; p1[r] = negm; }
#pragma unroll
        for (int d0 = 0; d0 < 6; ++d0) { p0 = __builtin_amdgcn_mfma_f32_32x32x16_bf16(kf[2 * d0], qr[d0], p0, 0, 0, 0); p1 = __builtin_amdgcn_mfma_f32_32x32x16_bf16(kf[2 * d0 + 1], qr[d0], p1, 0, 0, 0); }
        float ma = __builtin_fmaxf(__builtin_fmaxf(p0[0], p0[1]), p1[0]), mb = __builtin_fmaxf(__builtin_fmaxf(p0[2], p0[3]), p1[1]); ma = __builtin_fmaxf(__builtin_fmaxf(ma, p1[2]), p1[3]);
#pragma unroll
        for (int r = 4; r < 16; r += 4) { ma = __builtin_fmaxf(__builtin_fmaxf(ma, p0[r]), p0[r + 1]); mb = __builtin_fmaxf(__builtin_fmaxf(mb, p0[r + 2]), p0[r + 3]); ma = __builtin_fmaxf(__builtin_fmaxf(ma, p1[r]), p1[r + 1]); mb = __builtin_fmaxf(__builtin_fmaxf(mb, p1[r + 2]), p1[r + 3]); }
        float mt = __builtin_fmaxf(ma, mb);
        { auto rr = __builtin_amdgcn_permlane32_swap(__float_as_uint(mt), __float_as_uint(mt), false, false); mt = __builtin_fmaxf(__uint_as_float(rr[0]), __uint_as_float(rr[1])); }
        const bool first = (t == t_lo);
        if (first || __any(mt > ATT_THR)) {
            const float dl = first ? mt : __builtin_fmaxf(mt, 0.f); m_run += dl; const float alpha = __builtin_amdgcn_exp2f(-dl); l_run *= alpha;
#pragma unroll
            for (int r = 0; r < 16; ++r) { p0[r] -= dl; p1[r] -= dl; o0[r] *= alpha; o1[r] *= alpha; }
        }
        float ps0 = 0.f, ps1 = 0.f;
#pragma unroll
        for (int r = 0; r < 16; ++r) { p0[r] = __builtin_amdgcn_exp2f(p0[r]); p1[r] = __builtin_amdgcn_exp2f(p1[r]); ps0 += p0[r]; ps1 += p1[r]; }
        l_run += ps0 + ps1;
        v4u pw[4];
#pragma unroll
        for (int q = 0; q < 4; ++q) { pw[0][q] = cvt_pk_bf16(p0[2 * q], p0[2 * q + 1]); pw[1][q] = cvt_pk_bf16(p0[8 + 2 * q], p0[8 + 2 * q + 1]); pw[2][q] = cvt_pk_bf16(p1[2 * q], p1[2 * q + 1]); pw[3][q] = cvt_pk_bf16(p1[8 + 2 * q], p1[8 + 2 * q + 1]); }
#pragma unroll
        for (int s4 = 0; s4 < 4; ++s4) { const bf16x8v pa = __builtin_bit_cast(bf16x8v, pw[s4]);
            o0 = __builtin_amdgcn_mfma_f32_32x32x16_bf16(vf[2 * s4], pa, o0, 0, 0, 0); o1 = __builtin_amdgcn_mfma_f32_32x32x16_bf16(vf[2 * s4 + 1], pa, o1, 0, 0, 0); }
    }
    { auto rr = __builtin_amdgcn_permlane32_swap(__float_as_uint(l_run), __float_as_uint(l_run), false, false); l_run = __uint_as_float(rr[0]) + __uint_as_float(rr[1]); }
    const float rl = 1.0f / l_run;
    bf16* orow = MIX + (size_t)qrow * DM + h * VD;
#pragma unroll
    for (int g = 0; g < 4; ++g) { v2u a, c2; a.x = pk2(o0[4 * g] * rl, o0[4 * g + 1] * rl); a.y = pk2(o0[4 * g + 2] * rl, o0[4 * g + 3] * rl); c2.x = pk2(o1[4 * g] * rl, o1[4 * g + 1] * rl); c2.y = pk2(o1[4 * g + 2] * rl, o1[4 * g + 3] * rl);
        *(v2u*)(orow + 8 * g + 4 * hi) = a; *(v2u*)(orow + 32 + 8 * g + 4 * hi) = c2; }
    asm volatile("s_waitcnt vmcnt(0) lgkmcnt(0)" ::: "memory"); __builtin_amdgcn_s_barrier(); asm volatile("" ::: "memory");
#undef ATT_DMA
}
__device__ __forceinline__ void hgrn_item(Frame& F, int j, int it);
__device__ __forceinline__ void mix_phase(Frame& F, int j, bool ctx_out) {
    fresh(F);
    const int npair = F.G >> 1;
    for (int P = F.vcu >> 1; P < NB * NH; P += npair) {
        const int b = P >> 3, h = P & 7;
        if ((F.vcu & 1) == 0) {
            hgrn_item(F, j, P);
            for (int qb = 6; qb < 8; ++qb) attn_unit(F, b, h, b * SEQ + qb * 256, true, 0, NKEY / 64);
        } else {
            for (int qb = 0; qb < 6; ++qb) attn_unit(F, b, h, b * SEQ + qb * 256, true, 0, NKEY / 64);
            if (ctx_out) attn_unit(F, b, h, M + b * CTXL, false, SEQ / 64, NKEY / 64);
        }
    }
    __syncthreads();
}

__device__ __forceinline__ int hgrn_row(int b, int dir, int ig) { return (ig < CTXL) ? (M + b * CTXL + (dir ? CTXL - 1 - ig : ig)) : (b * SEQ + (dir ? SEQ - 1 - (ig - CTXL) : (ig - CTXL))); }
__device__ __forceinline__ void hgrn_item(Frame& F, int j, int it) {
    unsigned char* ws = F.ws;
    const bf16* HQ = (const bf16*)(ws + WS_HQ); const bf16* HFF = HQ + HSEG; const bf16* HFB = HQ + 2 * HSEG; const bf16* HI = HQ + 3 * HSEG;
    LAS unsigned char* ring = F.lds + RING_OFF;
    LAS unsigned char* QN = ring; LAS unsigned char* KN = ring + 17408; LAS unsigned char* KT = ring + 34816; LAS unsigned char* VT = ring + 53248; LAS unsigned char* ST = ring + 71680;
    LAS float* TOT = (LAS float*)(ring + 106496); LAS unsigned char* RQ = ring + 108544; LAS unsigned char* RF = ring + 124928;
    const int lane0 = F.lane, wave = F.wave;
    const int part = wave >> 1;
    const int kb = wave >> 1, vb0 = 2 * (wave & 1);
    const int ib = wave >> 2, vbo = wave & 3;
    const int dir = it & 1, hh = (it >> 1) & 3, b = it >> 3;
    const bf16* HF = dir ? HFB : HFF; float* OO = (float*)(ws + (dir ? WS_OB : WS_OF));
    float lb = 0.f; if (j == 1) { const int ci = dir * HW + hh * HK + (wave & 1) * 64 + lane0; const float l0 = F.in[13][ci], l1 = F.in[13][2 * HW + ci]; lb = 1.0f / (1.0f + __expf(l0 - l1)); }
    const float oml = 1.0f - lb;
    f32x16 S0, S1;
#pragma unroll
    for (int r = 0; r < 16; ++r) { S0[r] = 0.f; S1[r] = 0.f; }
#define LBAR() do { asm volatile("s_waitcnt lgkmcnt(0)" ::: "memory"); __builtin_amdgcn_s_barrier(); asm volatile("" ::: "memory"); } while (0)
#define HG_BASE(c_) ((c_) < CTXL / 64 ? M + b * CTXL + (dir ? CTXL - 64 - 64 * (c_) : 64 * (c_)) : b * SEQ + (dir ? SEQ - 64 - 64 * ((c_) - CTXL / 64) : 64 * ((c_) - CTXL / 64)))
#define HG_DMA(c_) do { const int rb_ = HG_BASE(c_); \
        _Pragma("unroll") for (int p_ = 0; p_ < 2; ++p_) { const int pc_ = wave * 2 + p_; const size_t go_ = (size_t)(rb_ + 4 * pc_ + (lane >> 4)) * HW + hh * HK + 8 * (lane & 15); \
            __builtin_amdgcn_global_load_lds((const unsigned*)(HQ + go_), (LAS unsigned*)(RQ + pc_ * 1024), 16, 0, 0); __builtin_amdgcn_global_load_lds((const unsigned*)(HF + go_), (LAS unsigned*)(RF + pc_ * 1024), 16, 0, 0); } } while (0)
#define HG_VLD(c_) do { const size_t go_ = (size_t)(HG_BASE(c_) + (dir ? 63 - lane : lane)) * HW + hh * HK + 16 * wave; rv0 = *(const v4u*)(HI + go_); rv1 = *(const v4u*)(HI + go_ + 8); } while (0)
    v4u rv0, rv1;
    { const int lane = lane0; HG_DMA(0); HG_VLD(0); }
    asm volatile("s_waitcnt vmcnt(0)" ::: "memory"); LBAR();
    for (int ch = 0; ch < NKEY / 64; ++ch) {
        int lane_ = lane0; asm volatile("" : "+v"(lane_));
        const int lane = lane_, r32 = lane & 31, hi = lane >> 5, k = (wave & 1) * 64 + lane;
        const int pos = (lane & ~12) | ((lane & 4) << 1) | ((lane & 8) >> 1);
        float qv[16], kin[16], cs[16]; float run = 0.f;
#pragma unroll
        for (int ii = 0; ii < 16; ++ii) { const int i = 16 * part + ii, mr = dir ? 63 - i : i; const float hq = bf2f(*(const LAS bf16*)(RQ + mr * 256 + k * 2)), hf = bf2f(*(const LAS bf16*)(RF + mr * 256 + k * 2));
            qv[ii] = hq * __builtin_amdgcn_rcpf(1.0f + __expf(-hq)); const float e = __expf(-hf), sg = __builtin_amdgcn_rcpf(1.0f + e); kin[ii] = oml * e * sg; run += __logf(lb + oml * sg); cs[ii] = run; }
        TOT[part * 128 + k] = run;
        { LAS bf16* vt = (LAS bf16*)(VT + (16 * wave) * 144 + pos * 2);
          vt[0 * 72] = (bf16)(rv0.x & 0xffffu); vt[1 * 72] = (bf16)(rv0.x >> 16); vt[2 * 72] = (bf16)(rv0.y & 0xffffu); vt[3 * 72] = (bf16)(rv0.y >> 16);
          vt[4 * 72] = (bf16)(rv0.z & 0xffffu); vt[5 * 72] = (bf16)(rv0.z >> 16); vt[6 * 72] = (bf16)(rv0.w & 0xffffu); vt[7 * 72] = (bf16)(rv0.w >> 16);
          vt[8 * 72] = (bf16)(rv1.x & 0xffffu); vt[9 * 72] = (bf16)(rv1.x >> 16); vt[10 * 72] = (bf16)(rv1.y & 0xffffu); vt[11 * 72] = (bf16)(rv1.y >> 16);
          vt[12 * 72] = (bf16)(rv1.z & 0xffffu); vt[13 * 72] = (bf16)(rv1.z >> 16); vt[14 * 72] = (bf16)(rv1.w & 0xffffu); vt[15 * 72] = (bf16)(rv1.w >> 16); }
        LBAR();
        if (ch + 1 < NKEY / 64) { HG_DMA(ch + 1); HG_VLD(ch + 1); }
        { const float t0 = TOT[k], t1 = TOT[128 + k], t2 = TOT[256 + k];
          const float base = (part > 0 ? t0 : 0.f) + (part > 1 ? t1 : 0.f) + (part > 2 ? t2 : 0.f); const float rr = t0 + t1;
          unsigned kt[8];
#pragma unroll
          for (int ii = 0; ii < 16; ii += 2) { float d0 = base + cs[ii] - rr, d1 = base + cs[ii + 1] - rr; d0 = fminf(fmaxf(d0, -80.f), 80.f); d1 = fminf(fmaxf(d1, -80.f), 80.f);
              const float e0 = __expf(d0), e1 = __expf(d1); const float q0 = qv[ii] * e0, q1 = qv[ii + 1] * e1, k0 = kin[ii] * __builtin_amdgcn_rcpf(e0), k1 = kin[ii + 1] * __builtin_amdgcn_rcpf(e1);
              const unsigned qp = cvt_pk_bf16(q0, q1), kp = cvt_pk_bf16(k0, k1);
              *(LAS bf16*)(QN + (16 * part + ii) * 272 + k * 2) = (bf16)(qp & 0xffffu); *(LAS bf16*)(QN + (16 * part + ii + 1) * 272 + k * 2) = (bf16)(qp >> 16);
              *(LAS bf16*)(KN + (16 * part + ii) * 272 + k * 2) = (bf16)(kp & 0xffffu); *(LAS bf16*)(KN + (16 * part + ii + 1) * 272 + k * 2) = (bf16)(kp >> 16);
              kt[ii >> 1] = kp; }
          *(LAS v4u*)(KT + k * 144 + part * 32) = (v4u){kt[0], kt[1], kt[4], kt[5]}; *(LAS v4u*)(KT + k * 144 + part * 32 + 16) = (v4u){kt[2], kt[3], kt[6], kt[7]}; }
        f32x16 T0, T1;
#pragma unroll
        for (int g4 = 0; g4 < 4; ++g4) { const int kk = kb * 32 + 8 * g4 + 4 * hi; const f32x4 ta = *(const LAS f32x4*)(TOT + kk), tb = *(const LAS f32x4*)(TOT + 128 + kk);
            const float e0 = __expf(ta.x + tb.x), e1 = __expf(ta.y + tb.y), e2 = __expf(ta.z + tb.z), e3 = __expf(ta.w + tb.w);
            T0[4 * g4] = S0[4 * g4] * e0; T0[4 * g4 + 1] = S0[4 * g4 + 1] * e1; T0[4 * g4 + 2] = S0[4 * g4 + 2] * e2; T0[4 * g4 + 3] = S0[4 * g4 + 3] * e3;
            T1[4 * g4] = S1[4 * g4] * e0; T1[4 * g4 + 1] = S1[4 * g4 + 1] * e1; T1[4 * g4 + 2] = S1[4 * g4 + 2] * e2; T1[4 * g4 + 3] = S1[4 * g4 + 3] * e3;
            v2u o; o.x = cvt_pk_bf16(T0[4 * g4], T0[4 * g4 + 1]); o.y = cvt_pk_bf16(T0[4 * g4 + 2], T0[4 * g4 + 3]); *(LAS v2u*)(ST + (vb0 * 32 + r32) * 272 + kk * 2) = o;
            o.x = cvt_pk_bf16(T1[4 * g4], T1[4 * g4 + 1]); o.y = cvt_pk_bf16(T1[4 * g4 + 2], T1[4 * g4 + 3]); *(LAS v2u*)(ST + (vb0 * 32 + 32 + r32) * 272 + kk * 2) = o; }
        LBAR();
#pragma unroll
        for (int st = 0; st < 4; ++st) { const bf16x8v kf = *(const LAS bf16x8v*)(KT + (kb * 32 + r32) * 144 + st * 32 + hi * 16);
            const bf16x8v va = *(const LAS bf16x8v*)(VT + (vb0 * 32 + r32) * 144 + st * 32 + hi * 16), vc = *(const LAS bf16x8v*)(VT + (vb0 * 32 + 32 + r32) * 144 + st * 32 + hi * 16);
            T0 = __builtin_amdgcn_mfma_f32_32x32x16_bf16(kf, va, T0, 0, 0, 0); T1 = __builtin_amdgcn_mfma_f32_32x32x16_bf16(kf, vc, T1, 0, 0, 0); }
#pragma unroll
        for (int g4 = 0; g4 < 4; ++g4) { const int kk = kb * 32 + 8 * g4 + 4 * hi; const f32x4 ta = *(const LAS f32x4*)(TOT + 256 + kk), tb = *(const LAS f32x4*)(TOT + 384 + kk);
            const float e0 = __expf(ta.x + tb.x), e1 = __expf(ta.y + tb.y), e2 = __expf(ta.z + tb.z), e3 = __expf(ta.w + tb.w);
            S0[4 * g4] = T0[4 * g4] * e0; S0[4 * g4 + 1] = T0[4 * g4 + 1] * e1; S0[4 * g4 + 2] = T0[4 * g4 + 2] * e2; S0[4 * g4 + 3] = T0[4 * g4 + 3] * e3;
            S1[4 * g4] = T1[4 * g4] * e0; S1[4 * g4 + 1] = T1[4 * g4 + 1] * e1; S1[4 * g4 + 2] = T1[4 * g4 + 2] * e2; S1[4 * g4 + 3] = T1[4 * g4 + 3] * e3; }
        asm volatile("" ::: "memory");
        {
            bf16x8v qf[8];
#pragma unroll
            for (int ks = 0; ks < 8; ++ks) qf[ks] = *(const LAS bf16x8v*)(QN + (ib * 32 + r32) * 272 + ks * 32 + hi * 16);
            asm volatile("" ::: "memory");
            f32x16 O;
#pragma unroll
            for (int r = 0; r < 16; ++r) O[r] = 0.f;
#pragma unroll
            for (int ks = 0; ks < 8; ++ks) { const bf16x8v sf = *(const LAS bf16x8v*)(ST + (vbo * 32 + r32) * 272 + ks * 32 + hi * 16); O = __builtin_amdgcn_mfma_f32_32x32x16_bf16(qf[ks], sf, O, 0, 0, 0); }
            asm volatile("" ::: "memory");
#pragma unroll 1
            for (int sb = 0; sb <= ib; ++sb) {
                f32x16 X;
#pragma unroll
                for (int r = 0; r < 16; ++r) X[r] = 0.f;
#pragma unroll
                for (int ks = 0; ks < 8; ++ks) { const bf16x8v kf = *(const LAS bf16x8v*)(KN + (sb * 32 + r32) * 272 + ks * 32 + hi * 16); X = __builtin_amdgcn_mfma_f32_32x32x16_bf16(kf, qf[ks], X, 0, 0, 0); }
                if (sb == ib) {
#pragma unroll
                    for (int r = 0; r < 16; ++r) { const int srow = (r & 3) + 8 * (r >> 2) + 4 * hi; if (srow > r32) X[r] = 0.f; }
                }
                asm volatile("" ::: "memory");
#pragma unroll
                for (int st = 0; st < 2; ++st) { v4u pw;
#pragma unroll
                    for (int q = 0; q < 4; ++q) pw[q] = cvt_pk_bf16(X[8 * st + 2 * q], X[8 * st + 2 * q + 1]);
                    const bf16x8v vf = *(const LAS bf16x8v*)(VT + (vbo * 32 + r32) * 144 + (sb * 32 + st * 16) * 2 + hi * 16);
                    O = __builtin_amdgcn_mfma_f32_32x32x16_bf16(__builtin_bit_cast(bf16x8v, pw), vf, O, 0, 0, 0); }
                asm volatile("" ::: "memory");
            }
            const int rb = HG_BASE(ch); float* op = OO + (size_t)rb * HW + hh * HK + vbo * 32 + r32;
#pragma unroll
            for (int r = 0; r < 16; ++r) { const int i = ib * 32 + (r & 3) + 8 * (r >> 2) + 4 * hi; op[(size_t)(dir ? 63 - i : i) * HW] = O[r]; }
        }
        asm volatile("s_waitcnt vmcnt(0)" ::: "memory"); LBAR();
    }
#undef LBAR
#undef HG_DMA
#undef HG_VLD
#undef HG_BASE
}

__device__ __forceinline__ void e8_phase(Frame& F, int j, int nrows) {
    fresh(F);
    unsigned char* ws = F.ws;
    const float* OF = (const float*)(ws + WS_OF); const float* OB = (const float*)(ws + WS_OB); const bf16* HG = (const bf16*)(ws + WS_HQ) + 4 * HSEG; bf16* MIX = (bf16*)(ws + WS_MIX);
    const float* gn = F.in[14] + j * HK;
    const int rpw = (nrows + F.G - 1) / F.G, rbase = (int)blockIdx.x * rpw, rend = (rbase + rpw < nrows) ? rbase + rpw : nrows;
    const int col = 8 * F.lane, vv = col & 127; const f32x4 g0 = *(const f32x4*)(gn + vv), g1 = *(const f32x4*)(gn + vv + 4);
    for (int r0 = rbase + F.wave; r0 < rend; r0 += 2 * NWAVES) {
        f32x4 a0[2], a1[2], b0[2], b1[2]; v4u hg[2];
#pragma unroll
        for (int q = 0; q < 2; ++q) { const int row = r0 + q * NWAVES; if (row < rend) {
            a0[q] = *(const f32x4*)(OF + (size_t)row * HW + col); a1[q] = *(const f32x4*)(OF + (size_t)row * HW + col + 4); b0[q] = *(const f32x4*)(OB + (size_t)row * HW + col); b1[q] = *(const f32x4*)(OB + (size_t)row * HW + col + 4);
            hg[q] = *(const v4u*)(HG + (size_t)row * HW + col); } }
#pragma unroll
        for (int q = 0; q < 2; ++q) { const int row = r0 + q * NWAVES; if (row < rend) {
            f32x4 x0 = a0[q] + b0[q], x1 = a1[q] + b1[q];
            float s = (x0.x * x0.x + x0.y * x0.y) + (x0.z * x0.z + x0.w * x0.w) + (x1.x * x1.x + x1.y * x1.y) + (x1.z * x1.z + x1.w * x1.w);
            s += shx(s, F.lane, 1); s += shx(s, F.lane, 2); s += shx(s, F.lane, 4); s += shx(s, F.lane, 8);
            const float rstd = rsqrtf(s * (1.0f / HK) + EPS);
            x0 = x0 * rstd * g0; x1 = x1 * rstd * g1; const v4u h = hg[q];
            v4u o; o.x = pg8::cvt_pk_bf16(x0.x * siluf_(bflo(h.x)), x0.y * siluf_(bfhi(h.x))); o.y = pg8::cvt_pk_bf16(x0.z * siluf_(bflo(h.y)), x0.w * siluf_(bfhi(h.y)));
            o.z = pg8::cvt_pk_bf16(x1.x * siluf_(bflo(h.z)), x1.y * siluf_(bfhi(h.z))); o.w = pg8::cvt_pk_bf16(x1.z * siluf_(bflo(h.w)), x1.w * siluf_(bfhi(h.w)));
            *(v4u*)(MIX + (size_t)row * DM + HW + col) = o; } }
    }
}

__device__ __forceinline__ void o12_phase(Frame& F, int nrows, const float* hl, const float* hc, const float* gn, const float* modl) {
    fresh(F);
    bf16* P = (bf16*)(F.ws + WS_POOLED);
    LAS unsigned char* XN = F.lds + RING_OFF;
    const int rpw = (nrows + F.G - 1) / F.G, rbase = (int)blockIdx.x * rpw, rend = (rbase + rpw < nrows) ? rbase + rpw : nrows;
    for (int r0 = rbase; r0 < rend; r0 += 32) {
        for (int sl = F.wave; sl < 48; sl += NWAVES) {
            const int row = r0 - 8 + sl; if (row < 0 || row >= nrows) continue;
            const float* hr = (row < M) ? hl + (size_t)row * DM : hc + (size_t)(row - M) * DM;
            f32x4 v[4]; float s = 0.f;
#pragma unroll
            for (int j = 0; j < 4; ++j) { v[j] = *(const f32x4*)(hr + 4 * F.lane + 256 * j); s += (v[j].x * v[j].x + v[j].y * v[j].y) + (v[j].z * v[j].z + v[j].w * v[j].w); }
            const float rstd = rsqrtf(wave_sum(s, F.lane) * (1.0f / DM) + EPS);
#pragma unroll
            for (int j = 0; j < 4; ++j) { v2u o; o.x = pg8::cvt_pk_bf16(v[j].x * rstd, v[j].y * rstd); o.y = pg8::cvt_pk_bf16(v[j].z * rstd, v[j].w * rstd); *(LAS v2u*)(XN + sl * 2048 + (4 * F.lane + 256 * j) * 2) = o; }
        }
        __syncthreads();
#pragma unroll 1
        for (int q = 0; q < 4; ++q) {
            const int t = r0 + F.wave * 4 + q; if (t >= rend) break;
            const bool lat = t < M; const int T = lat ? SEQ : CTXL; const int tt = lat ? t % SEQ : (t - M) % CTXL; const int bidx = lat ? t / SEQ : NB;
            const int sc0 = t - r0 + 8;
            const float* scp = modl + bidx * NMOD + DM;
#pragma unroll
            for (int g = 0; g < 4; ++g) {
                const int hw = 1 << g, col = 256 * g + 4 * F.lane;
                float s0 = 0.f, s1 = 0.f, s2 = 0.f, s3 = 0.f; int cnt = 0;
#pragma unroll
                for (int d = -hw; d < hw; ++d) { const bool ok = (tt + d >= 0) && (tt + d < T); const v2u x = *(const LAS v2u*)(XN + (sc0 + d) * 2048 + col * 2);
                    s0 += ok ? bflo(x.x) : 0.f; s1 += ok ? bfhi(x.x) : 0.f; s2 += ok ? bflo(x.y) : 0.f; s3 += ok ? bfhi(x.y) : 0.f; cnt += ok ? 1 : 0; }
                const v2u xc = *(const LAS v2u*)(XN + sc0 * 2048 + col * 2); const float ic = 1.0f / (float)cnt;
                const f32x4 gv = *(const f32x4*)(gn + col), sv = *(const f32x4*)(scp + col);
                v2u o; o.x = pg8::cvt_pk_bf16(gv.x * (sv.x + 1.0f) * (s0 * ic - bflo(xc.x)), gv.y * (sv.y + 1.0f) * (s1 * ic - bfhi(xc.x)));
                o.y = pg8::cvt_pk_bf16(gv.z * (sv.z + 1.0f) * (s2 * ic - bflo(xc.y)), gv.w * (sv.w + 1.0f) * (s3 * ic - bfhi(xc.y)));
                *(v2u*)(P + ((size_t)g * MT + t) * 256 + 4 * F.lane) = o;
            }
        }
        __syncthreads();
    }
}

__device__ __forceinline__ void o5_phase(Frame& F, int nrows) {
    fresh(F);
    unsigned char* ws = F.ws;
    const int* CNT = (const int*)(ws + WS_CNT); int* TST = (int*)(ws + WS_TST); const int* EIDX = (const int*)(ws + WS_EIDX); int* POS = (int*)(ws + WS_POS);
    const bf16* U = (const bf16*)(ws + WS_U); bf16* VG = (bf16*)(ws + WS_VG);
    LAS int* lc = (LAS int*)(F.lds + RING_OFF);
    LAS int* lbase = lc + 512 * 8;
    LAS int* lpos = lbase + 32;
    const int rpw = (nrows + F.G - 1) / F.G;
    for (int e = F.tid; e < F.G * 8; e += 512) lc[e] = CNT[e];
    __syncthreads();
    {
        const int e = F.wave; int c4[4]; int sum = 0;
#pragma unroll
        for (int q = 0; q < 4; ++q) { const int w = 4 * F.lane + q; c4[q] = (w < F.G) ? lc[w * 8 + e] : 0; sum += c4[q]; }
        int incl = sum;
#pragma unroll
        for (int o = 1; o < 64; o <<= 1) { const int t = __builtin_amdgcn_ds_bpermute((F.lane >= o ? F.lane - o : F.lane) << 2, incl); if (F.lane >= o) incl += t; }
        const int total = __builtin_amdgcn_readlane(incl, 63); int excl = incl - sum;
        const int myq = (int)blockIdx.x & 3; int pre = excl;
#pragma unroll
        for (int q = 0; q < 3; ++q) if (q < myq) pre += c4[q];
        if (F.lane == ((int)blockIdx.x >> 2)) { lbase[e] = pre; lbase[8 + e] = total; }
    }
    __syncthreads();
    if (F.tid == 0) {
        int ts = 0;
        for (int e = 0; e < 8; ++e) { const int pre = lbase[e], tot = lbase[8 + e]; lbase[e] = ts * 256 + pre; if (blockIdx.x == 0) TST[e] = ts; ts += (tot + 255) >> 8; }
        if (blockIdx.x == 0) TST[8] = ts;
    }
    __syncthreads();
    if (F.wave == 0) {
        int run[8];
#pragma unroll
        for (int e = 0; e < 8; ++e) run[e] = lbase[e];
        const int npairs = 2 * rpw;
        for (int c0 = 0; c0 < npairs; c0 += 64) {
            const int pl = c0 + F.lane; const int row = (int)blockIdx.x * rpw + (pl >> 1); const bool ok = pl < npairs && row < nrows;
            const int e = ok ? EIDX[2 * row + (pl & 1)] : -1; int mypos = 0;
#pragma unroll
            for (int x = 0; x < 8; ++x) { const unsigned long long mk = __ballot(e == x); const int below = __popcll(mk & ((1ull << F.lane) - 1ull)); if (e == x) mypos = run[x] + below; run[x] += __popcll(mk); }
            if (ok) { lpos[pl] = mypos; POS[2 * row + (pl & 1)] = mypos; }
        }
    }
    __syncthreads();
    for (int pl0 = F.wave * 4; pl0 < 2 * rpw; pl0 += NWAVES * 4) {
        v4u a[4], b[4]; int p[4];
#pragma unroll
        for (int q = 0; q < 4; ++q) { const int pl = pl0 + q; const int row = (int)blockIdx.x * rpw + (pl >> 1); p[q] = -1;
            if (pl < 2 * rpw && row < nrows) { p[q] = lpos[pl]; a[q] = *(const v4u*)(U + (size_t)row * DM + 8 * F.lane); b[q] = *(const v4u*)(U + (size_t)row * DM + 512 + 8 * F.lane); } }
#pragma unroll
        for (int q = 0; q < 4; ++q) if (p[q] >= 0) { *(v4u*)(VG + (size_t)p[q] * DM + 8 * F.lane) = a[q]; *(v4u*)(VG + (size_t)p[q] * DM + 512 + 8 * F.lane) = b[q]; }
    }
    __syncthreads();
}

__global__ void __launch_bounds__(NWAVES * 64, 2) mega_fwd(Args args) {
    extern __shared__ __attribute__((aligned(16))) unsigned char lds[];
    Frame F;
    F.lds = (LAS unsigned char*)lds;
    F.wave = __builtin_amdgcn_readfirstlane((int)threadIdx.x >> 6); fresh(F);
    F.G = gridDim.x; { const int bx = blockIdx.x; F.vcu = (F.G % 8 == 0) ? (bx % 8) * (F.G / 8) + bx / 8 : bx; }
    F.in = args.in; F.out = args.out; F.ws = args.ws;
    unsigned char* ws = args.ws;
    volatile LAS unsigned* MISC = (volatile LAS unsigned*)(F.lds + MISC_OFF);
    for (int u = F.tid; u < (LDS_BYTES - LDSCTL_OFF) / 4; u += NWAVES * 64) ((LAS unsigned*)(F.lds + LDSCTL_OFF))[u] = 0u;
    __syncthreads();
    XcdBarrier bar = xcd_barrier_post((unsigned*)(ws + WS_CTL) + CW_BAR, MISC + 8, F.wave);
#define GRID_BAR() do { xcd_barrier(bar); if (DUPMASK & 4096) xcd_barrier(bar); } while (0)
#ifndef ONLY
#define ONLY 0
#endif
#define PH(n) (ONLY == 0 || ONLY == (n))
#define REP(bit) for (int rep_ = 0; rep_ < ((DUPMASK & (bit)) ? 2 : 1); ++rep_)
    LAS unsigned char* ring = F.lds + RING_OFF;
    const float* MODV = (const float*)(ws + WS_MODV);
    float* HC = (float*)(ws + WS_HC);
    bf16* U = (bf16*)(ws + WS_U);

#if PH(20)
    REP(8192) p0_prologue(F);
#endif
    GRID_BAR();

    for (int lp = 0; lp < 2; ++lp) {
        const int le = 2 * lp, lo = 2 * lp + 1, j = lp;
        const bool ctx_out = (lp == 0);
        const int nro = ctx_out ? MT : M;
        const float* modE = MODV + (size_t)le * 17 * NMOD; const float* modO = MODV + (size_t)lo * 17 * NMOD;
        const float* hin_l = (lp == 0) ? args.in[0] : args.out; const float* hin_c = (lp == 0) ? args.in[2] : HC;
#if PH(1)
        {
            RowArgs A{}; A.hin_l = hin_l; A.hin_c = hin_c; A.hout_l = args.out; A.hout_c = HC; A.g = args.in[6] + (size_t)(le * 2 + 0) * DM; A.modl = modE; A.shoff = 0; A.scoff = DM; A.U = U;
            A.Y = (const bf16*)(ws + WS_VG); A.pos = (const int*)(ws + WS_POS); A.gate = (const float*)(ws + WS_GATE); A.modprev = MODV + (size_t)(le - 1) * 17 * NMOD;
            if (lp == 0) row_phase<false, 1, false>(F, A, MT); else row_phase<true, 1, false>(F, A, MT);
        }
#endif
        GRID_BAR();
#if PH(2)
        {
            pg8::Gemm g{U, (const bf16*)(ws + WS_WIN) + (size_t)j * INP * DM, DM, DM, DM}; pg8::InOrder S; S.init(ctx_out, F.G, (int)blockIdx.x);
            EpiIn E{(bf16*)(ws + WS_CQ), (bf16*)(ws + WS_KRR), (bf16*)(ws + WS_CKV), (bf16*)(ws + WS_HQ), (float*)(ws + WS_RSQ), (float*)(ws + WS_RSKV), (const float*)(ws + WS_ROPE)};
            REP(8) pg8::gemm_phase<EpiIn, pg8::InOrder, true>(ring, g, S, E, F.wave);
        }
#endif
        GRID_BAR();
#if PH(4)
        {
            pg8::Gemm g{(const bf16*)(ws + WS_CQ), (const bf16*)(ws + WS_WUQ) + (size_t)j * 768 * QL, QL, QL, QL}; pg8::StaticOrder S; S.init(nro, 768, F.G, (int)blockIdx.x);
            EpiQ E{(bf16*)(ws + WS_QB), (const float*)(ws + WS_RSQ)};
            REP(8) pg8::gemm_phase<EpiQ, pg8::StaticOrder, true>(ring, g, S, E, F.wave);
        }
        {
            pg8::Gemm g{(const bf16*)(ws + WS_CKV), (const bf16*)(ws + WS_WUKV) + (size_t)j * 1024 * KVL, KVL, KVL, KVL}; pg8::StaticOrder S; S.init(MT, 1024, F.G, (int)blockIdx.x);
            EpiKV E{(bf16*)(ws + WS_KN), (bf16*)(ws + WS_VV), (const float*)(ws + WS_RSKV)};
            REP(8) pg8::gemm_phase<EpiKV, pg8::StaticOrder, true>(ring, g, S, E, F.wave);
        }
#endif
        GRID_BAR();
#if PH(6)
        REP(3) mix_phase(F, j, ctx_out);
#endif
        GRID_BAR();
#if PH(8)
        REP(4 | 64) e8_phase(F, j, nro);
#endif
        GRID_BAR();
#if PH(9)
        {
            pg8::Gemm g{(const bf16*)(ws + WS_MIX), (const bf16*)(ws + WS_WOUT) + (size_t)j * DM * DM, DM, DM, DM}; pg8::StaticOrder S; S.init(nro, DM, F.G, (int)blockIdx.x);
            EpiResid E{hin_l, hin_c, args.out, HC, modE, 2 * DM};
            pg8::gemm_phase<EpiResid, pg8::StaticOrder, true>(ring, g, S, E, F.wave);
        }
#endif
        GRID_BAR();
#if PH(10)
        {
            RowArgs A{}; A.hin_l = args.out; A.hin_c = HC; A.g = args.in[6] + (size_t)(le * 2 + 1) * DM; A.modl = modE; A.shoff = 3 * DM; A.scoff = 4 * DM; A.U = U;
            REP(4 | 128) row_phase<false, 1, false>(F, A, nro);
        }
#endif
        GRID_BAR();
#if PH(11)
        {
            pg8::Gemm g{U, (const bf16*)(ws + WS_WGU) + (size_t)j * 2 * DFF * DM, DM, DM, DM}; pg8::StaticOrder S; S.init(nro, 2 * DFF, F.G, (int)blockIdx.x);
            EpiGateUp E{(bf16*)(ws + WS_HID), DFF, 2 * DFF / 256, 0};
            REP(8) pg8::gemm_phase<EpiGateUp, pg8::StaticOrder, true>(ring, g, S, E, F.wave);
        }
#endif
        GRID_BAR();
#if PH(12)
        {
            pg8::Gemm g{(const bf16*)(ws + WS_HID), (const bf16*)(ws + WS_WDN) + (size_t)j * DM * DFF, DFF, DFF, DFF}; pg8::StaticOrder S; S.init(nro, DM, F.G, (int)blockIdx.x);
            EpiResid E{args.out, HC, args.out, HC, modE, 5 * DM};
            pg8::gemm_phase<EpiResid, pg8::StaticOrder, true>(ring, g, S, E, F.wave);
        }
#endif
        GRID_BAR();
#if PH(13)
        {
            RowArgs A{}; A.hin_l = args.out; A.hin_c = HC; A.g = args.in[6] + (size_t)(lo * 2 + 0) * DM; A.modl = modO; A.shoff = 0; A.scoff = DM; A.U = U;
            REP(2048) o12_phase(F, nro, args.out, HC, A.g, modO);
            REP(16) for (int e = 0; e < NE; ++e) {
                conv_matrix(F, args.in[23] + ((size_t)j * NE + e) * DM * DFE, DM, DFE, (bf16*)(ws + WS_MWGU) + (size_t)e * 2 * DFE * DM, DM, 2, 0, nullptr, 1.f);
                conv_matrix(F, args.in[24] + ((size_t)j * NE + e) * DM * DFE, DM, DFE, (bf16*)(ws + WS_MWGU) + (size_t)e * 2 * DFE * DM, DM, 2, 128, nullptr, 1.f);
                conv_matrix(F, args.in[25] + ((size_t)j * NE + e) * DFE * DM, DFE, DM, (bf16*)(ws + WS_MWDN) + (size_t)e * DM * DFE, DFE, 0, 0, nullptr, 1.f);
            }
        }
#endif
        GRID_BAR();
#if PH(15)
        {
            pg8::Gemm g{(const bf16*)(ws + WS_POOLED), (const bf16*)(ws + WS_WPOOL) + (size_t)j * 4 * 65536, 256, 256, 256};
            pg8::PoolOrder S{nro / 256, MT / 256, F.G, (int)blockIdx.x};
            EpiPool E{args.out, HC, modO, args.in[20] + (size_t)j * DM, args.in[21] + (size_t)j * DM, MT / 256};
            pg8::gemm_phase<EpiPool, pg8::PoolOrder, true>(ring, g, S, E, F.wave);
        }
#endif
        GRID_BAR();
#if PH(16)
        {
            RowArgs A{}; A.hin_l = args.out; A.hin_c = HC; A.g = args.in[6] + (size_t)(lo * 2 + 1) * DM; A.modl = modO; A.shoff = 3 * DM; A.scoff = 4 * DM; A.U = U;
            A.router = args.in[22] + (size_t)j * DM * NE; A.eidx = (int*)(ws + WS_EIDX); A.gout = (float*)(ws + WS_GATE); A.cnt = (int*)(ws + WS_CNT);
            REP(4 | 512) row_phase<false, 1, true>(F, A, nro);
        }
#endif
        GRID_BAR();
#if PH(17)
        REP(4 | 1024) o5_phase(F, nro);
#endif
        GRID_BAR();
#if PH(18)
        {
            const int* TST = (const int*)(ws + WS_TST);
            const int ts1 = TST[1], ts2 = TST[2], ts3 = TST[3], ts4 = TST[4], ts5 = TST[5], ts6 = TST[6], ts7 = TST[7], nT = TST[8];
            const int rem = nT % MOE_CH, nseg = nT / MOE_CH + 1;
            for (int p = 0; p <= nseg; ++p) {
                int n7 = 0;
                if (p >= 1) {
                    const int sg = p - 1; const int t0 = sg == 0 ? 0 : rem + (sg - 1) * MOE_CH, nrt = sg == 0 ? rem : MOE_CH; n7 = nrt * (DM / 256);
                    const bf16* hb = (const bf16*)(ws + WS_HIDM) + (size_t)((sg == 0 || ((sg - 1) & 1)) ? MOE_CH : 0) * 256 * DFE;
                    pg8::Gemm g{hb - (size_t)t0 * 256 * DFE, (const bf16*)(ws + WS_MWDN), DFE, DFE, DFE};
                    pg8::MoeOrder S{t0, nrt, DM / 256, F.G, (int)blockIdx.x, ts1, ts2, ts3, ts4, ts5, ts6, ts7, 0, 0};
                    EpiY E{(bf16*)(ws + WS_VG), DM / 256};
                    REP(8) pg8::gemm_phase<EpiY, pg8::MoeOrder, true>(ring, g, S, E, F.wave);
                }
                if (p < nseg) {
                    const int sg = p; const int t0 = sg == 0 ? 0 : rem + (sg - 1) * MOE_CH, nrt = sg == 0 ? rem : MOE_CH;
                    bf16* hb = (bf16*)(ws + WS_HIDM) + (size_t)((sg == 0 || ((sg - 1) & 1)) ? MOE_CH : 0) * 256 * DFE;
                    pg8::Gemm g{(const bf16*)(ws + WS_VG), (const bf16*)(ws + WS_MWGU), DM, DM, DM};
                    pg8::MoeOrder S{t0, nrt, 2 * DFE / 256, F.G, (int)blockIdx.x, ts1, ts2, ts3, ts4, ts5, ts6, ts7, n7 % F.G, 4};
                    EpiGateUp E{hb, DFE, 2 * DFE / 256, t0 * 256};
                    REP(8) pg8::gemm_phase<EpiGateUp, pg8::MoeOrder, true>(ring, g, S, E, F.wave);
                }
                GRID_BAR();
            }
        }
#endif
    }
#if PH(19)
    {
        RowArgs A{}; A.hin_l = args.out; A.hin_c = HC; A.hout_l = args.out; A.hout_c = HC; A.g = args.in[7];
        A.Y = (const bf16*)(ws + WS_VG); A.pos = (const int*)(ws + WS_POS); A.gate = (const float*)(ws + WS_GATE); A.modprev = MODV + (size_t)3 * 17 * NMOD;
        row_phase<true, 2, false>(F, A, M);
        if (xb_ld((unsigned*)(ws + WS_CTL) + CW_BAR + XB_TMO) != 0u) { __syncthreads(); const float qn = __builtin_nanf(""); for (int i = F.tid; i < 1024; i += 512) args.out[(size_t)blockIdx.x * 1024 + i] = qn; }
    }
#endif
}

extern "C" void kernel_launch(void* const* d_in, const int* in_sizes, int n_in, void* d_out, int out_size, void* d_ws, size_t ws_size, hipStream_t stream) {
    static int grid = 0;
    if (grid == 0) {
        if (n_in != 26 || out_size != M * DM || ws_size < WS_END) { fprintf(stderr, "kernel_launch: unexpected shapes (n_in %d out %d ws %zu)\n", n_in, out_size, ws_size); grid = -1; return; }
        int dev = 0, cus = 0, per_cu = 0;
        if (hipGetDevice(&dev) != hipSuccess || hipDeviceGetAttribute(&cus, hipDeviceAttributeMultiprocessorCount, dev) != hipSuccess) { grid = -1; return; }
        if (hipFuncSetAttribute((const void*)mega_fwd, hipFuncAttributeMaxDynamicSharedMemorySize, LDS_BYTES) != hipSuccess) { grid = -1; return; }
        if (hipOccupancyMaxActiveBlocksPerMultiprocessor(&per_cu, (const void*)mega_fwd, NWAVES * 64, LDS_BYTES) != hipSuccess || per_cu < 1) fprintf(stderr, "kernel_launch: occupancy query says %d\n", per_cu);
        (void)hipGetLastError();
        grid = cus > 256 ? 256 : cus;
    }
    if (grid < 0) return;
    if (hipMemsetAsync((char*)d_ws + WS_CTL, 0, CTL_ZERO_BYTES, stream) != hipSuccess) return;
    Args a{};
    for (int i = 0; i < 26; ++i) a.in[i] = (const float*)d_in[i];
    a.out = (float*)d_out; a.ws = (unsigned char*)d_ws;
    hipLaunchKernelGGL(mega_fwd, dim3(grid), dim3(NWAVES * 64), LDS_BYTES, stream, a);
}
```

```cpp
#include <hip/hip_runtime.h>
#ifndef DUPMASK
#define DUPMASK 0
#endif
#include <cstdio>
#include <cstdint>

__device__ __forceinline__ int lane_now() { int l; asm volatile("v_mbcnt_lo_u32_b32 %0, -1, 0\n\tv_mbcnt_hi_u32_b32 %0, -1, %0" : "=v"(l)); return l; }
namespace pg8 {
#define PG8_LAS __attribute__((address_space(3)))
typedef unsigned short bf16_t;
typedef short bf16x8 __attribute__((ext_vector_type(8)));
typedef float f32x4 __attribute__((ext_vector_type(4)));
typedef unsigned u32x4 __attribute__((ext_vector_type(4)));
constexpr int BM = 256, BK = 64, HALF = 128, HTB = HALF * BK * 2, STAGE_BYTES = 8 * HTB, NXCD = 8, WGM = 8;

__host__ __device__ __forceinline__ int lds_byte(int r, int c) { const int st = (r >> 4) * 2 + (c >> 5), rr = r & 15, cc = c & 31, ob = rr * 64 + cc * 2; return st * 1024 + (ob ^ (((ob >> 9) & 1) << 5)); }
__host__ __device__ __forceinline__ void stage_rc(int b, int& R, int& C) { const int st = b / 1024, sb = b % 1024, swz = sb ^ (((sb >> 9) & 1) << 5); R = (st >> 1) * 16 + swz / 64; C = (st & 1) * 32 + (swz % 64) / 2; }
__host__ __device__ __forceinline__ int perm32(int rho) { const int n = rho >> 4, i = rho & 15; return 8 * (i >> 2) + 4 * n + (i & 3); }

struct Unit { int pm, pn; };
struct Gemm { const bf16_t* A; const bf16_t* Bt; int lda, ldb, K; };

struct StaticOrder {
    int nM, nN, nwg, G, c;
    __device__ void init(int M, int N, int G_, int c_) { nM = M / BM; nN = N / BM; nwg = nM * nN; G = G_; c = c_; }
    __device__ bool next(int i, Unit& u) const {
        const long L = (long)i * G + c; if (L >= nwg) return false;
        int wgid = (int)L; { const int q = nwg / NXCD, r = nwg % NXCD, xcd = wgid % NXCD, off = wgid / NXCD; wgid = (xcd < r ? xcd * (q + 1) : r * (q + 1) + (xcd - r) * q) + off; }
        const int nig = WGM * nN, gid = wgid / nig, fm = gid * WGM, gsz = (nM - fm) < WGM ? (nM - fm) : WGM;
        u.pm = fm + ((wgid % nig) % gsz); u.pn = (wgid % nig) / gsz; return true;
    }
};
struct InOrder {
    StaticOrder lat; int nlat, nctx_ct, G, c;
    __device__ void init(bool full, int G_, int c_) { lat.init(32768, 3328, G_, c_); nlat = lat.nwg; nctx_ct = full ? 13 : 8; G = G_; c = c_; }
    __device__ bool next(int i, Unit& u) const {
        const int L = i * G + c; if (L < nlat) return lat.next(i, u);
        const int x = L - nlat; if (x >= 16 * nctx_ct) return false;
        const int rt = (nctx_ct == 13) ? x / 13 : x >> 3, q = x - rt * nctx_ct; u.pm = 128 + rt; u.pn = (nctx_ct == 13) ? q : (q < 2 ? q + 1 : q + 3); return true;
    }
};
struct PoolOrder {
    int nrt, talloc, G, c;
    __device__ bool next(int i, Unit& u) const { const int L = i * G + c; if (L >= 4 * nrt) return false; const int g = L / nrt, rt = L - g * nrt; u.pm = g * talloc + rt; u.pn = g; return true; }
};
struct MoeOrder {
    int t0, nrt, nct, G, c; int ts1, ts2, ts3, ts4, ts5, ts6, ts7;
    int skipw, skipr;
    __device__ bool next(int i, Unit& u) const {
        const int nwg = nrt * nct; const int r_ = i + (c < skipw ? skipr : 0);
        const int L = (r_ < skipr) ? r_ * (G - skipw) + (c - skipw) : skipr * (G - skipw) + (r_ - skipr) * G + c; if (L >= nwg) return false;
        int wgid = L; { const int q = nwg / NXCD, r = nwg % NXCD, xcd = wgid % NXCD, off = wgid / NXCD; wgid = (xcd < r ? xcd * (q + 1) : r * (q + 1) + (xcd - r) * q) + off; }
        const int nig = WGM * nct, gid = wgid / nig, fm = gid * WGM, gsz = (nrt - fm) < WGM ? (nrt - fm) : WGM;
        const int rt = t0 + fm + ((wgid % nig) % gsz), ct = (wgid % nig) / gsz;
        const int e = (rt >= ts1) + (rt >= ts2) + (rt >= ts3) + (rt >= ts4) + (rt >= ts5) + (rt >= ts6) + (rt >= ts7);
        u.pm = rt; u.pn = e * nct + ct; return true;
    }
};

__device__ __forceinline__ unsigned cvt_pk_bf16(float lo, float hi) { unsigned r; asm volatile("v_cvt_pk_bf16_f32 %0, %1, %2" : "=v"(r) : "v"(lo), "v"(hi)); return r; }

template <class Epi, class Sched, bool ALIGN_EPI>
__device__ __forceinline__ void gemm_phase(PG8_LAS unsigned char* lds, const Gemm g, const Sched& S, const Epi& E, const int wid) {
    const int lane_ = lane_now();
    const int lane = lane_, tid = wid * 64 + lane, wr = wid >> 2, wc = wid & 3, fr = lane & 15, fq = lane >> 4;
    int K_ = g.K; asm volatile("" : "+s"(K_));
    const int K = K_, nt = K / BK;
    unsigned voffA[2], voffB[2];
#pragma unroll
    for (int i = 0; i < 2; ++i) { int R, C; stage_rc(tid * 16 + i * 8192, R, C); const int Rb = Epi::PERM ? ((R & ~31) + perm32(R & 31)) : R;
        voffA[i] = (unsigned)(R * g.lda + C) * 2u; voffB[i] = (unsigned)(Rb * g.ldb + C) * 2u; }
    const size_t kstep = (size_t)(BK * 2);
    const size_t hstepA = (size_t)HALF * g.lda * 2, hstepB = (size_t)HALF * g.ldb * 2;
    const size_t tstepA = 2 * hstepA, tstepB = 2 * hstepB;
    const unsigned ldsw = (unsigned)wid * 1024u;
    const int aoff = lds_byte(wr * 64 + fr, fq * 8), boff = lds_byte(wc * 32 + fr, fq * 8);
#define PG8_SA(b, h) (((b) * 2 + (h)) * HTB)
#define PG8_SB(b, h) ((4 + (b) * 2 + (h)) * HTB)
#define PG8_STAGE(bufoff, gbase, voff) do { _Pragma("unroll") for (int _i = 0; _i < 2; ++_i) \
        __builtin_amdgcn_global_load_lds((const unsigned*)((const char*)(gbase) + (voff)[_i]), (PG8_LAS unsigned*)(lds + (bufoff) + ldsw + _i * 8192), 16, 0, 0); } while (0)
#define PG8_LDA(dst, b, h) do { _Pragma("unroll") for (int m = 0; m < 4; ++m) _Pragma("unroll") for (int k = 0; k < 2; ++k) dst[m][k] = *(const PG8_LAS bf16x8*)(lds + PG8_SA(b, h) + aoff + m * 2048 + k * 1024); } while (0)
#define PG8_LDB(dst, b, h) do { _Pragma("unroll") for (int n = 0; n < 2; ++n) _Pragma("unroll") for (int k = 0; k < 2; ++k) dst[n][k] = *(const PG8_LAS bf16x8*)(lds + PG8_SB(b, h) + boff + n * 2048 + k * 1024); } while (0)
#define PG8_MMA(ai, bj, At, Bt) do { __builtin_amdgcn_s_setprio(1); _Pragma("unroll") for (int m = 0; m < 4; ++m) _Pragma("unroll") for (int n = 0; n < 2; ++n) _Pragma("unroll") for (int k = 0; k < 2; ++k) \
        acc[ai][bj][m][n] = __builtin_amdgcn_mfma_f32_16x16x32_bf16(Bt[n][k], At[m][k], acc[ai][bj][m][n], 0, 0, 0); __builtin_amdgcn_s_setprio(0); } while (0)
#define PG8_WAIT_V(n) asm volatile("s_waitcnt vmcnt(" #n ")" ::: "memory")
#define PG8_WAIT_L(n) asm volatile("s_waitcnt lgkmcnt(" #n ")" ::: "memory")
#define PG8_BAR __builtin_amdgcn_s_barrier()
#define PG8_SCHED __builtin_amdgcn_sched_barrier(0)
    Unit cur, nxt; int ui = 0;
    if (!S.next(0, cur)) return;
    f32x4 acc[2][2][4][2];
#pragma unroll
    for (int a = 0; a < 2; ++a)
#pragma unroll
        for (int b = 0; b < 2; ++b)
#pragma unroll
            for (int m = 0; m < 4; ++m)
#pragma unroll
                for (int n = 0; n < 2; ++n) acc[a][b][m][n] = (f32x4){0.f, 0.f, 0.f, 0.f};
    bf16x8 At[4][2], B0[2][2], B1[2][2];
    const char* cA = (const char*)g.A + (size_t)cur.pm * tstepA; const char* cB = (const char*)g.Bt + (size_t)cur.pn * tstepB;
    PG8_STAGE(PG8_SB(0, 0), cB, voffB); PG8_STAGE(PG8_SB(0, 1), cB + hstepB, voffB); PG8_STAGE(PG8_SA(0, 0), cA, voffA); PG8_STAGE(PG8_SA(0, 1), cA + hstepA, voffA);
    if (wr == 1) PG8_BAR;
    PG8_WAIT_V(2); PG8_BAR;
    PG8_STAGE(PG8_SB(1, 0), cB + kstep, voffB); PG8_STAGE(PG8_SA(1, 0), cA + kstep, voffA); PG8_STAGE(PG8_SB(1, 1), cB + hstepB + kstep, voffB);
    PG8_WAIT_V(6); PG8_BAR;
    for (;;) {
        const bool has_next = S.next(ui + 1, nxt);
        const char* nA = has_next ? (const char*)g.A + (size_t)nxt.pm * tstepA : cA; const char* nB = has_next ? (const char*)g.Bt + (size_t)nxt.pn * tstepB : cB;
#pragma unroll 1
        for (int t = 0; t < nt; t += 2) {
            const bool last = (t == nt - 2);
            const char* a1 = cA + (size_t)(t + 1) * kstep;
            const char* a2 = last ? nA : cA + (size_t)(t + 2) * kstep; const char* b2 = last ? nB : cB + (size_t)(t + 2) * kstep;
            const char* a3 = a2 + kstep; const char* b3 = b2 + kstep;
            PG8_LDB(B0, 0, 0); PG8_LDB(B1, 0, 1); PG8_SCHED; PG8_LDA(At, 0, 0); PG8_STAGE(PG8_SA(1, 1), a1 + hstepA, voffA);
            PG8_WAIT_V(8); PG8_WAIT_L(0); PG8_BAR; PG8_MMA(0, 0, At, B0); PG8_MMA(0, 1, At, B1); PG8_BAR; PG8_SCHED;
            PG8_LDA(At, 0, 1); PG8_STAGE(PG8_SB(0, 0), b2, voffB); PG8_STAGE(PG8_SB(0, 1), b2 + hstepB, voffB); PG8_STAGE(PG8_SA(0, 0), a2, voffA);
            PG8_WAIT_V(8); PG8_WAIT_L(0); PG8_BAR; PG8_MMA(1, 0, At, B0); PG8_MMA(1, 1, At, B1); PG8_BAR; PG8_SCHED;
            PG8_LDB(B0, 1, 0); PG8_LDB(B1, 1, 1); PG8_SCHED; PG8_LDA(At, 1, 0); PG8_STAGE(PG8_SA(0, 1), a2 + hstepA, voffA);
            PG8_WAIT_V(8); PG8_WAIT_L(0); PG8_BAR; PG8_MMA(0, 0, At, B0); PG8_MMA(0, 1, At, B1); PG8_BAR; PG8_SCHED;
            PG8_LDA(At, 1, 1); PG8_STAGE(PG8_SB(1, 0), b3, voffB); PG8_STAGE(PG8_SB(1, 1), b3 + hstepB, voffB); PG8_STAGE(PG8_SA(1, 0), a3, voffA);
            PG8_WAIT_V(8); PG8_WAIT_L(0); PG8_BAR; PG8_MMA(1, 0, At, B0); PG8_MMA(1, 1, At, B1); PG8_BAR; PG8_SCHED;
        }
        if constexpr (ALIGN_EPI) { if (wr == 0) PG8_BAR; }
        E(acc, cur, wr, wc, fr, fq);
        if (!has_next) break;
#pragma unroll
        for (int a = 0; a < 2; ++a)
#pragma unroll
            for (int b = 0; b < 2; ++b)
#pragma unroll
                for (int m = 0; m < 4; ++m)
#pragma unroll
                    for (int n = 0; n < 2; ++n) acc[a][b][m][n] = (f32x4){0.f, 0.f, 0.f, 0.f};
        cur = nxt; cA = nA; cB = nB; ++ui;
        if constexpr (ALIGN_EPI) { if (wr == 1) PG8_BAR; }
    }
    PG8_WAIT_V(0);
    if constexpr (!ALIGN_EPI) { if (wr == 0) PG8_BAR; }
    PG8_BAR;
#undef PG8_SA
#undef PG8_SB
#undef PG8_STAGE
#undef PG8_LDA
#undef PG8_LDB
#undef PG8_MMA
#undef PG8_WAIT_V
#undef PG8_WAIT_L
#undef PG8_BAR
#undef PG8_SCHED
}
}

constexpr int NWAVES = 8;
constexpr int DM = 1024, NB = 16, SEQ = 2048, CTXL = 256;
constexpr int M = NB * SEQ, MC = NB * CTXL, MT = M + MC;
constexpr int QL = 384, KVL = 256, ROPE = 32, HW = 512, NH = 8, QKD = 96, VD = 64;
constexpr int INW = 3232, INP = 3328;
constexpr int DFF = 2816, NE = 8, DFE = 3584, NMOD = 6 * DM;
constexpr int NHH = 4, HK = 128; constexpr int NKEY = SEQ + CTXL;
constexpr float EPS = 1e-6f;
constexpr int MAXT = 296;
constexpr int MOE_CH = 128;

constexpr size_t MiB = 1u << 20;
constexpr size_t WS_CTL = 0, CTL_ZERO_BYTES = 1 * MiB;
constexpr size_t WS_MODV = 1 * MiB;
constexpr size_t WS_ROPE = 3 * MiB;
constexpr size_t WS_CNT = 3 * MiB + 64 * 1024;
constexpr size_t WS_TST = 3 * MiB + 128 * 1024;
constexpr size_t WS_EIDX = 4 * MiB, WS_GATE = 4 * MiB + 512 * 1024, WS_POS = 5 * MiB;
constexpr size_t WS_RSQ = 6 * MiB, WS_RSKV = 7 * MiB + 256 * 1024;
constexpr size_t WS_WIN = 8 * MiB, WS_WUQ = 21 * MiB, WS_WUKV = 23 * MiB, WS_WOUT = 24 * MiB, WS_WGU = 28 * MiB, WS_WDN = 50 * MiB, WS_WPOOL = 61 * MiB;
constexpr size_t WS_HB = 62 * MiB;
constexpr size_t WS_U = 134 * MiB;
constexpr size_t WS_X = 206 * MiB;
constexpr size_t WS_CQ = WS_X, WS_CKV = 233 * MiB, WS_KRR = 251 * MiB, WS_HQ = 254 * MiB  ;
constexpr size_t WS_QB = 434 * MiB, WS_KN = 488 * MiB, WS_VV = 524 * MiB, WS_OF = 560 * MiB, WS_OB = 632 * MiB, WS_MIX = 704 * MiB, WS_HID = WS_X;
constexpr size_t WS_MWGU = WS_X, WS_MWDN = 318 * MiB, WS_VG = 374 * MiB, WS_POOLED = WS_VG  , WS_HIDM = 522 * MiB, WS_END = 970 * MiB;
constexpr size_t HSEG = (size_t)MT * HW;
static_assert(WS_WPOOL + (size_t)2 * 4 * 65536 * 2 <= WS_HB && WS_HB + (size_t)MT * DM * 2 <= WS_U && WS_U + (size_t)MT * DM * 2 <= WS_X && WS_KRR + (size_t)MT * ROPE * 2 <= WS_HQ && WS_HQ + 5 * HSEG * 2 <= WS_QB && WS_MIX + (size_t)MT * DM * 2 <= WS_END && WS_HID + (size_t)MT * DFF * 2 <= WS_QB, "ws map even");
static_assert(WS_HIDM + (size_t)2 * MOE_CH * 256 * DFE * 2 <= WS_END && WS_VG + (size_t)MAXT * 256 * DM * 2 <= WS_HIDM && WS_MWDN + (size_t)NE * DM * DFE * 2 <= WS_VG && WS_MWGU + (size_t)NE * 2 * DFE * DM * 2 <= WS_MWDN, "ws map odd");
constexpr int CW_BAR = 4096;

constexpr int RING_OFF = 0, RING_BYTES = 141312;
constexpr int LDSCTL_OFF = RING_BYTES, MISC_OFF = LDSCTL_OFF + 320;
constexpr int LDS_BYTES = 147456;

#define GAS __attribute__((address_space(1)))
#define LAS __attribute__((address_space(3)))
typedef unsigned short bf16;
typedef unsigned v4u __attribute__((ext_vector_type(4)));
typedef unsigned v2u __attribute__((ext_vector_type(2)));
typedef float f32x4 __attribute__((ext_vector_type(4)));
typedef GAS unsigned gu32;
#define RLX_AGENT __ATOMIC_RELAXED, __HIP_MEMORY_SCOPE_AGENT
#define LDS_WAIT() asm volatile("s_waitcnt lgkmcnt(0)" ::: "memory")
__device__ __forceinline__ unsigned f2bf(float f) { unsigned u = __builtin_bit_cast(unsigned, f); return (u + 0x7fffu + ((u >> 16) & 1u)) >> 16; }
__device__ __forceinline__ unsigned pk2(float lo, float hi) { return f2bf(lo) | (f2bf(hi) << 16); }
__device__ __forceinline__ float bf2f(unsigned short b) { return __uint_as_float((unsigned)b << 16); }
__device__ __forceinline__ float bflo(unsigned w) { return __uint_as_float(w << 16); }
__device__ __forceinline__ float bfhi(unsigned w) { return __uint_as_float(w & 0xffff0000u); }
__device__ __forceinline__ float sigmoidf_(float x) { return 1.0f / (1.0f + __expf(-x)); }
__device__ __forceinline__ float siluf_(float x) { return x * __builtin_amdgcn_rcpf(1.0f + __expf(-x)); }

#define XB_TMO      128
#define XB_XCNT(j)  (256  + 64 * (j))
#define XB_XSUB(j)  (1280 + 64 * (j))
#define XB_XGEN(j)  (2304 + 64 * (j))
#define XB_TOP      3328
#define XB_TOPGEN   3392
#define XCD_BAR_WORDS 3456
#define XB_SPIN_CAP (1u << 22)
__device__ __forceinline__ unsigned xb_ld(unsigned* p)              { return __hip_atomic_load(p, __ATOMIC_RELAXED, __HIP_MEMORY_SCOPE_AGENT); }
__device__ __forceinline__ unsigned xb_add(unsigned* p, unsigned v) { return __hip_atomic_fetch_add(p, v, __ATOMIC_RELAXED, __HIP_MEMORY_SCOPE_AGENT); }
__device__ __forceinline__ unsigned xb_xcc_id() { return (unsigned)__builtin_amdgcn_s_getreg((3 << 11) | 20) & 0xFu; }
#define XB_SPIN(cond, bar) do { unsigned _sp = 0; while (cond) { __builtin_amdgcn_s_sleep(1); \
    if ((++_sp & 255u) == 0u) { if (xb_ld(&(bar)[XB_TMO])) break; if (_sp > XB_SPIN_CAP) { atomicAdd(&(bar)[XB_TMO], 1u); break; } } } } while (0)
struct XcdBarrier { unsigned* bar; unsigned x; volatile LAS unsigned* st; int wave; };
__device__ __forceinline__ bool xb_leader(int wave) { return wave == 0 && lane_now() == 0; }
__device__ __forceinline__ XcdBarrier xcd_barrier_post(unsigned* bar, volatile LAS unsigned* st, int wave) {
    XcdBarrier b; b.bar = bar; b.x = xb_xcc_id(); b.st = st; b.wave = wave;
    if (xb_leader(wave)) (void)xb_add(&bar[XB_XCNT(b.x)], 1u);
    return b;
}
__device__ __forceinline__ void xcd_barrier_complete(unsigned* bar, unsigned x, unsigned& nloc, unsigned& nx) {
    const unsigned G = gridDim.x * gridDim.y * gridDim.z;
    unsigned sum, cnt, mine, sp = 0u;
    for (;;) {
        sum = 0u; cnt = 0u; mine = 0u;
#pragma unroll
        for (unsigned j = 0; j < 16; ++j) { const unsigned c = xb_ld(&bar[XB_XCNT(j)]); sum += c; cnt += (c > 0u) ? 1u : 0u; mine = (j == x) ? c : mine; }
        if (sum == G) break;
        __builtin_amdgcn_s_sleep(1);
        if ((++sp & 255u) == 0u) { if (xb_ld(&bar[XB_TMO])) break; if (sp > XB_SPIN_CAP) { atomicAdd(&bar[XB_TMO], 1u); break; } }
    }
    nloc = mine > 0u ? mine : 1u; nx = cnt > 0u ? cnt : 1u;
}
__device__ __forceinline__ void xcd_barrier(const XcdBarrier& b) {
    asm volatile("s_waitcnt vmcnt(0)" ::: "memory");
    __syncthreads();
    if (xb_leader(b.wave)) {
        unsigned* bar = b.bar; asm volatile("" : "+s"(bar));
        __builtin_amdgcn_s_waitcnt(0);
        unsigned nloc = b.st[0], nx = b.st[1];
        if (nloc == 0u) { xcd_barrier_complete(bar, b.x, nloc, nx); b.st[0] = nloc; b.st[1] = nx; }
        const unsigned old = xb_add(&bar[XB_XSUB(b.x)], 1u);
        const unsigned gen = old / nloc;
        if (old + 1u == (gen + 1u) * nloc) {
            __builtin_amdgcn_fence(__ATOMIC_RELEASE, "agent");
            asm volatile("s_waitcnt vmcnt(0)" ::: "memory");
            const unsigned og = xb_add(&bar[XB_TOP], 1u);
            const unsigned tg = og / nx;
            if (og + 1u == (tg + 1u) * nx) xb_add(&bar[XB_TOPGEN], 1u);
            else XB_SPIN(xb_ld(&bar[XB_TOPGEN]) == tg, bar);
            __builtin_amdgcn_fence(__ATOMIC_ACQUIRE, "agent");
            xb_add(&bar[XB_XGEN(b.x)], 1u);
            asm volatile("s_waitcnt vmcnt(0)" ::: "memory");
        } else {
            XB_SPIN(xb_ld(&bar[XB_XGEN(b.x)]) == gen, bar);
            __builtin_amdgcn_fence(__ATOMIC_ACQUIRE, "agent");
            asm volatile("s_waitcnt vmcnt(0)" ::: "memory");
        }
    }
    __syncthreads();
}

struct Args { const float* in[26]; float* out; unsigned char* ws; };
struct Frame {
    LAS unsigned char* lds;
    int tid, lane, wave, G, vcu;
    const float* const* in; float* out; unsigned char* ws;
};
__device__ __forceinline__ float shx(float v, int lane, int m) { return __int_as_float(__builtin_amdgcn_ds_bpermute((lane ^ m) << 2, __float_as_int(v))); }
__device__ __forceinline__ float wave_sum(float v, int lane) {
#pragma unroll
    for (int o = 1; o < 64; o <<= 1) v += shx(v, lane, o);
    return v;
}

__device__ __forceinline__ void fresh(Frame& F) { const int l = lane_now(); F.lane = l; F.tid = F.wave * 64 + l; }

__device__ __forceinline__ void conv_item(const float* W, int ldw, bf16* WT, int ldd, int k0, int n0, int drow0, const float* kscale, float gscale, LAS float* scr, int lane) {
    float wv[32];
#pragma unroll
    for (int i = 0; i < 32; ++i) { const int kk = 2 * i + (lane >> 5); wv[i] = W[(size_t)(k0 + kk) * ldw + n0 + (lane & 31)]; }
#pragma unroll
    for (int i = 0; i < 32; ++i) { const int kk = 2 * i + (lane >> 5); float w = wv[i]; if (kscale) w *= kscale[k0 + kk]; scr[kk * 33 + (lane & 31)] = w * gscale; }
    LDS_WAIT(); asm volatile("" ::: "memory");
    const int c = lane & 7;
#pragma unroll
    for (int j = 0; j < 4; ++j) { const int n = (lane >> 3) + 8 * j; const LAS float* s = scr + (8 * c) * 33 + n;
        v4u o; o.x = pk2(s[0 * 33], s[1 * 33]); o.y = pk2(s[2 * 33], s[3 * 33]); o.z = pk2(s[4 * 33], s[5 * 33]); o.w = pk2(s[6 * 33], s[7 * 33]);
        *(v4u*)(WT + (size_t)(drow0 + n) * ldd + k0 + 8 * c) = o; }
    LDS_WAIT(); asm volatile("" ::: "memory");
}
__device__ __forceinline__ int conv_rowmap(int mode, int n0, int off) {
    if (mode == 0) return n0 + off;
    if (mode == 1) { if (n0 < 384) return n0; if (n0 < 640) return 512 + (n0 - 384); if (n0 < 672) return 384; return 768 + (n0 - 672); }
    return 256 * (n0 >> 7) + (n0 & 127) + off;
}
__device__ __forceinline__ void conv_matrix(Frame& F, const float* W, int K, int N, bf16* WT, int ldd, int mode, int off, const float* kscale, float gscale) {
    LAS float* scr = (LAS float*)(F.lds + RING_OFF + F.wave * 16384);
    const int gw = F.vcu * NWAVES + F.wave, NGW = F.G * NWAVES;
    const int nblk = N / 32, nitems = (K / 64) * nblk;
    for (int it = gw; it < nitems; it += NGW) { const int kb = it / nblk, nb = it % nblk; conv_item(W, N, WT, ldd, 64 * kb, 32 * nb, conv_rowmap(mode, 32 * nb, off), kscale, gscale, scr, F.lane); }
}

__device__ __forceinline__ int row_bidx(int row) { return row < M ? row / SEQ : NB; }

struct RowArgs {
    const float* xin_l; const float* xin_c;
    const bf16* hb; bf16* hbo;
    float* fout;
    const float* g;
    const float* modl;
    int shoff, scoff;
    bf16* U;
    const bf16* Y; const int* pos; const float* gate; const float* modprev;
    const float* router; int* eidx; float* gout; int* cnt;
};
template <bool COMBINE, int OUTMODE, bool ROUTER, bool INF32>
__device__ __forceinline__ void row_phase(Frame& F, const RowArgs& A, int nrows) {
    fresh(F);
    const int rpw = (nrows + F.G - 1) / F.G;
    LAS int* lcnt = (LAS int*)(F.lds + RING_OFF);
    if (ROUTER) { if (F.tid < 8) lcnt[F.tid] = 0; __syncthreads(); }
    const int rbase = (int)blockIdx.x * rpw, rend = (rbase + rpw < nrows) ? rbase + rpw : nrows;
#define ROWLOAD(dst, r_) do { if (INF32) { const float* hr_ = ((r_) < M) ? A.xin_l + (size_t)(r_) * DM : A.xin_c + (size_t)((r_) - M) * DM; \
            _Pragma("unroll") for (int j = 0; j < 4; ++j) dst[j] = *(const f32x4*)(hr_ + 4 * F.lane + 256 * j); } \
        else { _Pragma("unroll") for (int j = 0; j < 4; ++j) { const v2u w_ = *(const v2u*)(A.hb + (size_t)(r_) * DM + 4 * F.lane + 256 * j); dst[j] = (f32x4){bflo(w_.x), bfhi(w_.x), bflo(w_.y), bfhi(w_.y)}; } } } while (0)
    f32x4 rw[16][2];
    if (ROUTER) {
#pragma unroll
        for (int j = 0; j < 4; ++j)
#pragma unroll
            for (int q = 0; q < 4; ++q) { const int col = 4 * F.lane + 256 * j + q; rw[4 * j + q][0] = *(const f32x4*)(A.router + (size_t)col * 8); rw[4 * j + q][1] = *(const f32x4*)(A.router + (size_t)col * 8 + 4); }
    }
    int row = rbase + F.wave;
    f32x4 v[4], vn[4];
    if (row < rend) ROWLOAD(v, row);
    for (; row < rend; row += NWAVES) {
        const bool lat = row < M; const int bidx = lat ? row / SEQ : NB;
        const int rnext = row + NWAVES;
        if (rnext < rend) ROWLOAD(vn, rnext);
        if (COMBINE) {
            const int pa = A.pos[2 * row], pb = A.pos[2 * row + 1]; const float ga = A.gate[2 * row], gb = A.gate[2 * row + 1];
            const float* g2 = A.modprev + bidx * NMOD + 5 * DM;
#pragma unroll
            for (int j = 0; j < 4; ++j) { const int col = 4 * F.lane + 256 * j;
                const v2u ya = *(const v2u*)(A.Y + (size_t)pa * DM + col), yb = *(const v2u*)(A.Y + (size_t)pb * DM + col); const f32x4 gv = *(const f32x4*)(g2 + col);
                v[j].x += gv.x * (ga * bflo(ya.x) + gb * bflo(yb.x)); v[j].y += gv.y * (ga * bfhi(ya.x) + gb * bfhi(yb.x));
                v[j].z += gv.z * (ga * bflo(ya.y) + gb * bflo(yb.y)); v[j].w += gv.w * (ga * bfhi(ya.y) + gb * bfhi(yb.y)); }
            if (OUTMODE != 2) {
#pragma unroll
                for (int j = 0; j < 4; ++j) { v2u o; o.x = pg8::cvt_pk_bf16(v[j].x, v[j].y); o.y = pg8::cvt_pk_bf16(v[j].z, v[j].w); *(v2u*)(A.hbo + (size_t)row * DM + 4 * F.lane + 256 * j) = o;
                    v[j] = (f32x4){bflo(o.x), bfhi(o.x), bflo(o.y), bfhi(o.y)}; }
            }
        }
        float s = 0.f;
#pragma unroll
        for (int j = 0; j < 4; ++j) s += (v[j].x * v[j].x + v[j].y * v[j].y) + (v[j].z * v[j].z + v[j].w * v[j].w);
        const float rstd = rsqrtf(wave_sum(s, F.lane) * (1.0f / DM) + EPS);
        if (OUTMODE == 2) {
            float* ho = A.fout + (size_t)row * DM;
#pragma unroll
            for (int j = 0; j < 4; ++j) { const int col = 4 * F.lane + 256 * j; const f32x4 gv = *(const f32x4*)(A.g + col); *(f32x4*)(ho + col) = v[j] * rstd * gv; }
        } else {
            const float* sh = A.modl + bidx * NMOD + A.shoff; const float* sc = A.modl + bidx * NMOD + A.scoff;
            float lg[8];
            if (ROUTER) {
#pragma unroll
                for (int e = 0; e < 8; ++e) lg[e] = 0.f;
            }
#pragma unroll
            for (int j = 0; j < 4; ++j) { const int col = 4 * F.lane + 256 * j; const f32x4 gv = *(const f32x4*)(A.g + col), shv = *(const f32x4*)(sh + col), scv = *(const f32x4*)(sc + col);
                f32x4 y = v[j] * rstd * gv * (scv + 1.0f) + shv;
                v2u o; o.x = pg8::cvt_pk_bf16(y.x, y.y); o.y = pg8::cvt_pk_bf16(y.z, y.w); *(v2u*)(A.U + (size_t)row * DM + col) = o;
                if (ROUTER) {
#pragma unroll
                    for (int q = 0; q < 4; ++q) { const f32x4 r0 = rw[4 * j + q][0], r1 = rw[4 * j + q][1]; const float yy = y[q];
                        lg[0] += yy * r0.x; lg[1] += yy * r0.y; lg[2] += yy * r0.z; lg[3] += yy * r0.w; lg[4] += yy * r1.x; lg[5] += yy * r1.y; lg[6] += yy * r1.z; lg[7] += yy * r1.w; } }
            }
            if (ROUTER) {
                const int b5 = F.lane >> 5, b4 = (F.lane >> 4) & 1, b3 = (F.lane >> 3) & 1; float a4[4], c2[2];
#pragma unroll
                for (int q = 0; q < 4; ++q) { const float mine = b5 ? lg[4 + q] : lg[q], oth = b5 ? lg[q] : lg[4 + q]; a4[q] = mine + shx(oth, F.lane, 32); }
#pragma unroll
                for (int q = 0; q < 2; ++q) { const float mine = b4 ? a4[2 + q] : a4[q], oth = b4 ? a4[q] : a4[2 + q]; c2[q] = mine + shx(oth, F.lane, 16); }
                float d1 = (b3 ? c2[1] : c2[0]) + shx(b3 ? c2[0] : c2[1], F.lane, 8);
                d1 += shx(d1, F.lane, 4); d1 += shx(d1, F.lane, 2); d1 += shx(d1, F.lane, 1);
#pragma unroll
                for (int e = 0; e < 8; ++e) lg[e] = __int_as_float(__builtin_amdgcn_readlane(__float_as_int(d1), 8 * e));
                int i0 = 0; float v0 = lg[0];
#pragma unroll
                for (int e = 1; e < 8; ++e) if (lg[e] > v0) { v0 = lg[e]; i0 = e; }
                int i1 = -1; float v1 = -INFINITY;
#pragma unroll
                for (int e = 0; e < 8; ++e) if (e != i0 && lg[e] > v1) { v1 = lg[e]; i1 = e; }
                const float g0 = 1.0f / (1.0f + __expf(v1 - v0));
                if (F.lane == 0) { A.eidx[2 * row] = i0; A.eidx[2 * row + 1] = i1; A.gout[2 * row] = g0; A.gout[2 * row + 1] = 1.0f - g0; atomicAdd((int*)&lcnt[i0], 1); atomicAdd((int*)&lcnt[i1], 1); }
            }
        }
#pragma unroll
        for (int j = 0; j < 4; ++j) v[j] = vn[j];
    }
#undef ROWLOAD
    if (ROUTER) { __syncthreads(); if (F.tid < 8) A.cnt[blockIdx.x * 8 + F.tid] = lcnt[F.tid]; __syncthreads(); }
}

using pg8::Unit; using pg8::cvt_pk_bf16;
__device__ __forceinline__ v4u pack8(const f32x4& a, const f32x4& b) { v4u w; w.x = cvt_pk_bf16(a[0], a[1]); w.y = cvt_pk_bf16(a[2], a[3]); w.z = cvt_pk_bf16(b[0], b[1]); w.w = cvt_pk_bf16(b[2], b[3]); return w; }
struct EpiIn {
    static constexpr bool PERM = true;
    bf16 *CQ, *KRR, *CKV, *H5; float* ssq_q; float* ssq_kv; const float* TC;
    __device__ __forceinline__ void operator()(const f32x4 (&acc)[2][2][4][2], const Unit& u, int wr, int wc, int fr, int fq) const {
        const int row0 = u.pm * 256 + wr * 64 + fr; const int lane = fr + 16 * fq;
#pragma unroll
        for (int bj = 0; bj < 2; ++bj) {
            const int col = u.pn * 256 + bj * 128 + wc * 32 + 8 * fq;
            bf16* base; int ld;
            if (col < 384) { base = CQ + col; ld = QL; }
            else if (col < 512) { base = nullptr; ld = 0; }
            else if (col < 768) { base = CKV + (col - 512); ld = KVL; }
            else { const int c2 = col - 768; base = H5 + (size_t)(c2 >> 9) * HSEG + (c2 & 511); ld = HW; }
            if (base) {
#pragma unroll
                for (int ai = 0; ai < 2; ++ai)
#pragma unroll
                    for (int m = 0; m < 4; ++m) { const int row = row0 + ai * 128 + m * 16; *(v4u*)(base + (size_t)row * ld) = pack8(acc[ai][bj][m][0], acc[ai][bj][m][1]); }
            }
        }
        if (u.pn <= 2) {
            const int nb = (u.pn == 1) ? 1 : 2; float* dst = (u.pn == 2) ? ssq_kv : ssq_q;
#pragma unroll
            for (int ai = 0; ai < 2; ++ai)
#pragma unroll
                for (int m = 0; m < 4; ++m) { float ss = 0.f;
#pragma unroll
                    for (int bj = 0; bj < 2; ++bj) if (bj < nb) {
#pragma unroll
                        for (int n = 0; n < 2; ++n) { const f32x4 x = acc[ai][bj][m][n]; ss += (x[0] * x[0] + x[1] * x[1]) + (x[2] * x[2] + x[3] * x[3]); } }
                    ss += shx(ss, lane, 16); ss += shx(ss, lane, 32);
                    if (fq == 0) { const int row = row0 + ai * 128 + m * 16; if (u.pn == 2) dst[row * 4 + wc] = ss; else dst[row * 8 + u.pn * 4 + wc] = ss; } }
            if (u.pn == 1 && wc == 0) {
                const int a = fq >> 1, half = fq & 1;
#pragma unroll
                for (int ai = 0; ai < 2; ++ai)
#pragma unroll
                    for (int m = 0; m < 4; ++m) { const int row = row0 + ai * 128 + m * 16; f32x4 o[2];
                        const bool lat = row < M; const int t = row % SEQ; const int p = a ? (t & 63) : (t >> 6);
#pragma unroll
                        for (int n = 0; n < 2; ++n)
#pragma unroll
                            for (int q = 0; q < 4; ++q) { const float x = acc[ai][1][m][n][q]; const float pr = shx(x, lane, 16); const float c = TC[p * 8 + 4 * n + q], sn = TC[512 + p * 8 + 4 * n + q];
                                o[n][q] = lat ? (half ? x * c + pr * sn : x * c - pr * sn) : x; }
                        *(v4u*)(KRR + (size_t)row * ROPE + 8 * fq) = pack8(o[0], o[1]); }
            }
        }
    }
};
struct EpiQ {
    static constexpr bool PERM = true;
    bf16* O; const float* rs;
    __device__ __forceinline__ void operator()(const f32x4 (&acc)[2][2][4][2], const Unit& u, int wr, int wc, int fr, int fq) const {
        const int row0 = u.pm * 256 + wr * 64 + fr;
#pragma unroll
        for (int ai = 0; ai < 2; ++ai)
#pragma unroll
            for (int m = 0; m < 4; ++m) { const int row = row0 + ai * 128 + m * 16; const f32x4 p0 = *(const f32x4*)(rs + (size_t)row * 8), p1 = *(const f32x4*)(rs + (size_t)row * 8 + 4); const float sc = rsqrtf((((p0.x + p0.y) + (p0.z + p0.w)) + ((p1.x + p1.y) + (p1.z + p1.w))) * (1.0f / QL) + EPS);
#pragma unroll
                for (int bj = 0; bj < 2; ++bj) { const int col = u.pn * 256 + bj * 128 + wc * 32 + 8 * fq; *(v4u*)(O + (size_t)row * 768 + col) = pack8(acc[ai][bj][m][0] * sc, acc[ai][bj][m][1] * sc); } }
    }
};
struct EpiKV {
    static constexpr bool PERM = true;
    bf16* KNp; bf16* VTp; const float* rs;
    __device__ __forceinline__ void operator()(const f32x4 (&acc)[2][2][4][2], const Unit& u, int wr, int wc, int fr, int fq) const {
        const int row0 = u.pm * 256 + wr * 64 + fr;
#pragma unroll
        for (int ai = 0; ai < 2; ++ai)
#pragma unroll
            for (int m = 0; m < 4; ++m) { const int row = row0 + ai * 128 + m * 16; const f32x4 p0 = *(const f32x4*)(rs + (size_t)row * 4); const float sc = rsqrtf(((p0.x + p0.y) + (p0.z + p0.w)) * (1.0f / KVL) + EPS);
                const bool lat = row < M; const int b = lat ? row / SEQ : (row - M) / CTXL; const int key = lat ? row % SEQ : SEQ + (row - M) % CTXL;
                const int kpos = (key & ~12) | ((key & 4) << 1) | ((key & 8) >> 1);
#pragma unroll
                for (int bj = 0; bj < 2; ++bj) { const int col = u.pn * 256 + bj * 128 + wc * 32 + 8 * fq; const int hh = col >> 7, w = col & 127;
                    if (w < 64) { *(v4u*)(KNp + (size_t)row * HW + hh * 64 + w) = pack8(acc[ai][bj][m][0] * sc, acc[ai][bj][m][1] * sc); }
                    else { bf16* dst = VTp + ((size_t)((b * NH + hh) * VD + (w - 64))) * NKEY + kpos;
#pragma unroll
                        for (int n = 0; n < 2; ++n)
#pragma unroll
                            for (int q = 0; q < 4; ++q) dst[(size_t)(4 * n + q) * NKEY] = (bf16)f2bf(acc[ai][bj][m][n][q] * sc); } } }
    }
};
template <bool INF32>
struct EpiResid {
    static constexpr bool PERM = true;
    const float* xin_l; const float* xin_c; bf16* hb; const float* modl; int goff;
    __device__ __forceinline__ void operator()(const f32x4 (&acc)[2][2][4][2], const Unit& u, int wr, int wc, int fr, int fq) const {
        const int rowt = u.pm * 256; const bool lat = rowt < M; const int bidx = lat ? rowt / SEQ : NB;
        const float* gate = modl + bidx * NMOD + goff;
        const float* xi = lat ? xin_l + (size_t)rowt * DM : xin_c + (size_t)(rowt - M) * DM;
        bf16* ho = hb + (size_t)rowt * DM;
        const unsigned off0 = (unsigned)((wr * 64 + fr) * DM + u.pn * 256 + wc * 32 + 8 * fq);
#pragma unroll
        for (int bj = 0; bj < 2; ++bj) { const f32x4 g0 = *(const f32x4*)(gate + (off0 & 1023u) + bj * 128), g1 = *(const f32x4*)(gate + (off0 & 1023u) + bj * 128 + 4);
#pragma unroll
            for (int ai = 0; ai < 2; ++ai) {
                if (INF32) { f32x4 h0[4], h1[4];
#pragma unroll
                    for (int m = 0; m < 4; ++m) { const unsigned off = off0 + (unsigned)((ai * 128 + m * 16) * DM + bj * 128); h0[m] = *(const f32x4*)(xi + off); h1[m] = *(const f32x4*)(xi + off + 4); }
#pragma unroll
                    for (int m = 0; m < 4; ++m) { const unsigned off = off0 + (unsigned)((ai * 128 + m * 16) * DM + bj * 128); *(v4u*)(ho + off) = pack8(h0[m] + g0 * acc[ai][bj][m][0], h1[m] + g1 * acc[ai][bj][m][1]); }
                } else { v4u hv[4];
#pragma unroll
                    for (int m = 0; m < 4; ++m) { const unsigned off = off0 + (unsigned)((ai * 128 + m * 16) * DM + bj * 128); hv[m] = *(const v4u*)(ho + off); }
#pragma unroll
                    for (int m = 0; m < 4; ++m) { const unsigned off = off0 + (unsigned)((ai * 128 + m * 16) * DM + bj * 128); const v4u w = hv[m];
                        const f32x4 a0 = (f32x4){bflo(w.x), bfhi(w.x), bflo(w.y), bfhi(w.y)}, a1 = (f32x4){bflo(w.z), bfhi(w.z), bflo(w.w), bfhi(w.w)};
                        *(v4u*)(ho + off) = pack8(a0 + g0 * acc[ai][bj][m][0], a1 + g1 * acc[ai][bj][m][1]); }
                }
                asm volatile("" ::: "memory"); } }
    }
};
struct EpiPool {
    static constexpr bool PERM = true;
    bf16* hb; const float* modl; const float* bias; const float* scale; int talloc;
    __device__ __forceinline__ void operator()(const f32x4 (&acc)[2][2][4][2], const Unit& u, int wr, int wc, int fr, int fq) const {
        const int g = u.pn, rowt = (u.pm - g * talloc) * 256; const bool lat = rowt < M; const int bidx = lat ? rowt / SEQ : NB;
        const float* gate = modl + bidx * NMOD + 2 * DM;
        bf16* ho = hb + (size_t)rowt * DM;
        const int col0 = g * 256 + wc * 32 + 8 * fq;
#pragma unroll
        for (int bj = 0; bj < 2; ++bj) { const int c = col0 + bj * 128;
            v4u hv[2][4];
#pragma unroll
            for (int ai = 0; ai < 2; ++ai)
#pragma unroll
                for (int m = 0; m < 4; ++m) hv[ai][m] = *(const v4u*)(ho + (size_t)(ai * 128 + wr * 64 + m * 16 + fr) * DM + c);
            const f32x4 gm0 = *(const f32x4*)(gate + c) * *(const f32x4*)(scale + c), gm1 = *(const f32x4*)(gate + c + 4) * *(const f32x4*)(scale + c + 4);
            const f32x4 gb0 = gm0 * *(const f32x4*)(bias + c), gb1 = gm1 * *(const f32x4*)(bias + c + 4);
#pragma unroll
            for (int ai = 0; ai < 2; ++ai)
#pragma unroll
                for (int m = 0; m < 4; ++m) { const v4u w = hv[ai][m]; const f32x4 a0 = (f32x4){bflo(w.x), bfhi(w.x), bflo(w.y), bfhi(w.y)}, a1 = (f32x4){bflo(w.z), bfhi(w.z), bflo(w.w), bfhi(w.w)};
                    *(v4u*)(ho + (size_t)(ai * 128 + wr * 64 + m * 16 + fr) * DM + c) = pack8(a0 + gm0 * acc[ai][bj][m][0] + gb0, a1 + gm1 * acc[ai][bj][m][1] + gb1); }
            asm volatile("" ::: "memory"); }
    }
};
struct EpiGateUp {
    static constexpr bool PERM = true;
    bf16* H; int ldh, nct, rowsub;
    __device__ __forceinline__ void operator()(const f32x4 (&acc)[2][2][4][2], const Unit& u, int wr, int wc, int fr, int fq) const {
        const int row0 = u.pm * 256 + wr * 64 + fr - rowsub; const int ct = u.pn % nct; const int col = ct * 128 + wc * 32 + 8 * fq;
#pragma unroll
        for (int ai = 0; ai < 2; ++ai)
#pragma unroll
            for (int m = 0; m < 4; ++m) { const int row = row0 + ai * 128 + m * 16; f32x4 o[2];
#pragma unroll
                for (int n = 0; n < 2; ++n)
#pragma unroll
                    for (int q = 0; q < 4; ++q) { const float gv = acc[ai][0][m][n][q], uv = acc[ai][1][m][n][q]; o[n][q] = gv * uv * __builtin_amdgcn_rcpf(1.0f + __expf(-gv)); }
                *(v4u*)(H + (size_t)row * ldh + col) = pack8(o[0], o[1]); }
    }
};
struct EpiY {
    static constexpr bool PERM = true;
    bf16* Y; int nct;
    __device__ __forceinline__ void operator()(const f32x4 (&acc)[2][2][4][2], const Unit& u, int wr, int wc, int fr, int fq) const {
        const int row0 = u.pm * 256 + wr * 64 + fr; const int ct = u.pn % nct;
#pragma unroll
        for (int ai = 0; ai < 2; ++ai)
#pragma unroll
            for (int m = 0; m < 4; ++m) { const int row = row0 + ai * 128 + m * 16;
#pragma unroll
                for (int bj = 0; bj < 2; ++bj) { const int col = ct * 256 + bj * 128 + wc * 32 + 8 * fq; *(v4u*)(Y + (size_t)row * DM + col) = pack8(acc[ai][bj][m][0], acc[ai][bj][m][1]); } }
    }
};

__device__ __forceinline__ void p0_prologue(Frame& F) {
    fresh(F);
    unsigned char* ws = F.ws;
    const float qscale = 0.10206207261596577f * 1.4426950408889634f;
    for (int j = 0; j < 2; ++j) {
        conv_matrix(F, F.in[8] + (size_t)j * DM * INW, DM, INW, (bf16*)(ws + WS_WIN) + (size_t)j * INP * DM, DM, 1, 0, nullptr, 1.f);
        conv_matrix(F, F.in[11] + (size_t)j * QL * 768, QL, 768, (bf16*)(ws + WS_WUQ) + (size_t)j * 768 * QL, QL, 0, 0, F.in[9] + j * QL, qscale);
        conv_matrix(F, F.in[12] + (size_t)j * KVL * 1024, KVL, 1024, (bf16*)(ws + WS_WUKV) + (size_t)j * 1024 * KVL, KVL, 0, 0, F.in[10] + j * KVL, 1.f);
        conv_matrix(F, F.in[15] + (size_t)j * DM * DM, DM, DM, (bf16*)(ws + WS_WOUT) + (size_t)j * DM * DM, DM, 0, 0, nullptr, 1.f);
        conv_matrix(F, F.in[16] + (size_t)j * DM * DFF, DM, DFF, (bf16*)(ws + WS_WGU) + (size_t)j * 2 * DFF * DM, DM, 2, 0, nullptr, 1.f);
        conv_matrix(F, F.in[17] + (size_t)j * DM * DFF, DM, DFF, (bf16*)(ws + WS_WGU) + (size_t)j * 2 * DFF * DM, DM, 2, 128, nullptr, 1.f);
        conv_matrix(F, F.in[18] + (size_t)j * DFF * DM, DFF, DM, (bf16*)(ws + WS_WDN) + (size_t)j * DM * DFF, DFF, 0, 0, nullptr, 1.f);
        for (int g = 0; g < 4; ++g)
            conv_matrix(F, F.in[19] + (size_t)(j * 4 + g) * 65536, 256, 256, (bf16*)(ws + WS_WPOOL) + (size_t)(j * 4 + g) * 65536, 256, 0, 0, nullptr, 1.f);
    }
    __syncthreads();
    if (blockIdx.x == 0 && F.tid < 8) {
        float* TC = (float*)(ws + WS_ROPE); float* TS = TC + 512;
        double th = 1.0; for (int i = 0; i < F.tid; ++i) th *= 0.31622776601683794;
        const double x2 = th * th; double s = th, c = 1.0, ts = th, tc = 1.0;
        for (int n = 1; n <= 12; ++n) { tc *= -x2 / (double)((2 * n - 1) * (2 * n)); c += tc; ts *= -x2 / (double)((2 * n) * (2 * n + 1)); s += ts; }
        double cp = 1.0, sp = 0.0;
        for (int p = 0; p < 64; ++p) { TC[p * 8 + F.tid] = (float)cp; TS[p * 8 + F.tid] = (float)sp; const double ncp = cp * c - sp * s; sp = sp * c + cp * s; cp = ncp; }
    }
    {
        LAS float* sc = (LAS float*)(F.lds + RING_OFF);
        LAS float* red = sc + 17 * 1024;
        const int nitems = 4 * (NMOD / 64);
        if ((int)blockIdx.x < nitems) {
            for (int e = F.tid; e < 17 * 1024; e += 512) { const int r = e >> 10, k = e & 1023; const float x = (r < 16) ? F.in[1][r * 1024 + k] : F.in[3][k]; sc[e] = siluf_(x); }
            __syncthreads();
            for (int it = blockIdx.x; it < nitems; it += F.G) {
                const int l = it / (NMOD / 64), c0 = (it % (NMOD / 64)) * 64;
                const float* W = F.in[4] + (size_t)l * DM * NMOD + c0 + F.lane;
                float acc[17];
#pragma unroll
                for (int r = 0; r < 17; ++r) acc[r] = 0.f;
                const int kb = F.wave * 128;
                for (int k = 0; k < 128; k += 4) {
                    const float w0 = W[(size_t)(kb + k) * NMOD], w1 = W[(size_t)(kb + k + 1) * NMOD], w2 = W[(size_t)(kb + k + 2) * NMOD], w3 = W[(size_t)(kb + k + 3) * NMOD];
#pragma unroll
                    for (int r = 0; r < 17; ++r) { const f32x4 s4 = *(const LAS f32x4*)(sc + r * 1024 + kb + k); acc[r] += s4.x * w0 + s4.y * w1 + s4.z * w2 + s4.w * w3; }
                }
#pragma unroll
                for (int r = 0; r < 17; ++r) red[(F.wave * 17 + r) * 64 + F.lane] = acc[r];
                __syncthreads();
                for (int o = F.tid; o < 17 * 64; o += 512) { const int r = o >> 6, cc = o & 63; float s = 0.f;
#pragma unroll
                    for (int w = 0; w < 8; ++w) s += red[(w * 17 + r) * 64 + cc];
                    ((float*)(ws + WS_MODV))[(size_t)(l * 17 + r) * NMOD + c0 + cc] = s + F.in[5][l * NMOD + c0 + cc]; }
                __syncthreads();
            }
        }
    }
}

typedef short bf16x8v __attribute__((ext_vector_type(8)));
typedef float f32x16 __attribute__((ext_vector_type(16)));
__device__ __forceinline__ void attn_unit(Frame& F, int b, int h, int qrow0, bool rope_q, int t_lo, int t_hi) {
    unsigned char* ws = F.ws;
    const bf16* QB = (const bf16*)(ws + WS_QB); const bf16* KN = (const bf16*)(ws + WS_KN); const bf16* KRR = (const bf16*)(ws + WS_KRR); const bf16* VT = (const bf16*)(ws + WS_VV);
    bf16* MIX = (bf16*)(ws + WS_MIX); const float* TC = (const float*)(ws + WS_ROPE); const float* TS = TC + 512;
    const int lane = F.lane, wave = F.wave, r32 = lane & 31, hi = lane >> 5;
    LAS unsigned char* ring = F.lds + RING_OFF;
    const int qrow = qrow0 + wave * 32 + r32;
    bf16x8v qr[6];
#pragma unroll
    for (int d0 = 0; d0 < 6; ++d0) qr[d0] = *(const bf16x8v*)(QB + (size_t)qrow * 768 + h * QKD + 16 * d0 + 8 * hi);
    if (rope_q) { const int t = qrow % SEQ;
#pragma unroll
        for (int a = 0; a < 2; ++a) { const int p = a ? (t & 63) : (t >> 6); const v4u w = __builtin_bit_cast(v4u, qr[4 + a]); float x[8], y[8];
            x[0] = bflo(w.x); x[1] = bfhi(w.x); x[2] = bflo(w.y); x[3] = bfhi(w.y); x[4] = bflo(w.z); x[5] = bfhi(w.z); x[6] = bflo(w.w); x[7] = bfhi(w.w);
#pragma unroll
            for (int jj = 0; jj < 8; ++jj) { const float pr = shx(x[jj], lane, 32); const float c = TC[p * 8 + jj], sn = TS[p * 8 + jj]; y[jj] = hi ? x[jj] * c + pr * sn : x[jj] * c - pr * sn; }
            v4u o; o.x = pk2(y[0], y[1]); o.y = pk2(y[2], y[3]); o.z = pk2(y[4], y[5]); o.w = pk2(y[6], y[7]); qr[4 + a] = __builtin_bit_cast(bf16x8v, o); } }
    const int bh = b * NH + h;
    const bf16* vsrc = VT + ((size_t)(bh * VD + lane)) * NKEY + 8 * wave;
#define ATT_DMA(t, buf) do { const int t_ = (t); const int r0_ = t_ < SEQ / 64 ? b * SEQ + 64 * t_ : M + b * CTXL + 64 * (t_ - SEQ / 64); \
        LAS unsigned char* kb_ = ring + (buf) * 20480; LAS unsigned char* vb_ = kb_ + 12288; \
        __builtin_amdgcn_global_load_lds((const unsigned*)(KN + (size_t)(r0_ + lane) * HW + h * 64 + 8 * wave), (LAS unsigned*)(kb_ + wave * 1024), 16, 0, 0); \
        __builtin_amdgcn_global_load_lds((const unsigned*)(KRR + (size_t)(r0_ + lane) * ROPE + 8 * (wave & 3)), (LAS unsigned*)(kb_ + (8 + (wave & 3)) * 1024), 16, 0, 0);     \
        __builtin_amdgcn_global_load_lds((const unsigned*)(vsrc + 64 * t_), (LAS unsigned*)(vb_ + wave * 1024), 16, 0, 0); } while (0)
    f32x16 o0, o1;
#pragma unroll
    for (int r = 0; r < 16; ++r) { o0[r] = 0.f; o1[r] = 0.f; }
    constexpr float ATT_THR = 8.0f;
    float m_run = 0.f, l_run = 0.f;
    asm volatile("s_waitcnt vmcnt(0)" ::: "memory");
    ATT_DMA(t_lo, 0); if (t_lo + 1 < t_hi) ATT_DMA(t_lo + 1, 1); if (t_lo + 2 < t_hi) ATT_DMA(t_lo + 2, 2);
    for (int t = t_lo; t < t_hi; ++t) {
        const int buf = (t - t_lo) & 3; const int rem = t_hi - 1 - t;
        if (rem >= 2) asm volatile("s_waitcnt vmcnt(6)" ::: "memory"); else if (rem == 1) asm volatile("s_waitcnt vmcnt(3)" ::: "memory"); else asm volatile("s_waitcnt vmcnt(0)" ::: "memory");
        asm volatile("s_waitcnt lgkmcnt(0)" ::: "memory"); __builtin_amdgcn_s_barrier(); asm volatile("" ::: "memory");
        if (t + 3 < t_hi) ATT_DMA(t + 3, (buf + 3) & 3);
        const LAS unsigned char* kb = ring + buf * 20480 + hi * 1024 + r32 * 16; const LAS unsigned char* vb = ring + buf * 20480 + 12288 + hi * 1024 + r32 * 16;
        bf16x8v kf[12], vf[8];
#pragma unroll
        for (int d0 = 0; d0 < 6; ++d0) { kf[2 * d0] = *(const LAS bf16x8v*)(kb + d0 * 2048); kf[2 * d0 + 1] = *(const LAS bf16x8v*)(kb + d0 * 2048 + 512); }
#pragma unroll
        for (int s4 = 0; s4 < 4; ++s4) { vf[2 * s4] = *(const LAS bf16x8v*)(vb + s4 * 2048); vf[2 * s4 + 1] = *(const LAS bf16x8v*)(vb + s4 * 2048 + 512); }
        f32x16 p0, p1; const float negm = -m_run;
#pragma unroll
        for (int r = 0; r < 16; ++r) { p0[r] = negm; p1[r] = negm; }
#pragma unroll
        for (int d0 = 0; d0 < 6; ++d0) { p0 = __builtin_amdgcn_mfma_f32_32x32x16_bf16(kf[2 * d0], qr[d0], p0, 0, 0, 0); p1 = __builtin_amdgcn_mfma_f32_32x32x16_bf16(kf[2 * d0 + 1], qr[d0], p1, 0, 0, 0); }
        float ma = __builtin_fmaxf(__builtin_fmaxf(p0[0], p0[1]), p1[0]), mb = __builtin_fmaxf(__builtin_fmaxf(p0[2], p0[3]), p1[1]); ma = __builtin_fmaxf(__builtin_fmaxf(ma, p1[2]), p1[3]);
#pragma unroll
        for (int r = 4; r < 16; r += 4) { ma = __builtin_fmaxf(__builtin_fmaxf(ma, p0[r]), p0[r + 1]); mb = __builtin_fmaxf(__builtin_fmaxf(mb, p0[r + 2]), p0[r + 3]); ma = __builtin_fmaxf(__builtin_fmaxf(ma, p1[r]), p1[r + 1]); mb = __builtin_fmaxf(__builtin_fmaxf(mb, p1[r + 2]), p1[r + 3]); }
        float mt = __builtin_fmaxf(ma, mb);
        { auto rr = __builtin_amdgcn_permlane32_swap(__float_as_uint(mt), __float_as_uint(mt), false, false); mt = __builtin_fmaxf(__uint_as_float(rr[0]), __uint_as_float(rr[1])); }
        const bool first = (t == t_lo);
        if (first || __any(mt > ATT_THR)) {
            const float dl = first ? mt : __builtin_fmaxf(mt, 0.f); m_run += dl; const float alpha = __builtin_amdgcn_exp2f(-dl); l_run *= alpha;
#pragma unroll
            for (int r = 0; r < 16; ++r) { p0[r] -= dl; p1[r] -= dl; o0[r] *= alpha; o1[r] *= alpha; }
        }
        float ps0 = 0.f, ps1 = 0.f;
#pragma unroll
        for (int r = 0; r < 16; ++r) { p0[r] = __builtin_amdgcn_exp2f(p0[r]); p1[r] = __builtin_amdgcn_exp2f(p1[r]); ps0 += p0[r]; ps1 += p1[r]; }
        l_run += ps0 + ps1;
        v4u pw[4];
#pragma unroll
        for (int q = 0; q < 4; ++q) { pw[0][q] = cvt_pk_bf16(p0[2 * q], p0[2 * q + 1]); pw[1][q] = cvt_pk_bf16(p0[8 + 2 * q], p0[8 + 2 * q + 1]); pw[2][q] = cvt_pk_bf16(p1[2 * q], p1[2 * q + 1]); pw[3][q] = cvt_pk_bf16(p1[8 + 2 * q], p1[8 + 2 * q + 1]); }
#pragma unroll
        for (int s4 = 0; s4 < 4; ++s4) { const bf16x8v pa = __builtin_bit_cast(bf16x8v, pw[s4]);
            o0 = __builtin_amdgcn_mfma_f32_32x32x16_bf16(vf[2 * s4], pa, o0, 0, 0, 0); o1 = __builtin_amdgcn_mfma_f32_32x32x16_bf16(vf[2 * s4 + 1], pa, o1, 0, 0, 0); }
    }
    { auto rr = __builtin_amdgcn_permlane32_swap(__float_as_uint(l_run), __float_as_uint(l_run), false, false); l_run = __uint_as_float(rr[0]) + __uint_as_float(rr[1]); }
    const float rl = 1.0f / l_run;
    bf16* orow = MIX + (size_t)qrow * DM + h * VD;
#pragma unroll
    for (int g = 0; g < 4; ++g) { v2u a, c2; a.x = pk2(o0[4 * g] * rl, o0[4 * g + 1] * rl); a.y = pk2(o0[4 * g + 2] * rl, o0[4 * g + 3] * rl); c2.x = pk2(o1[4 * g] * rl, o1[4 * g + 1] * rl); c2.y = pk2(o1[4 * g + 2] * rl, o1[4 * g + 3] * rl);
        *(v2u*)(orow + 8 * g + 4 * hi) = a; *(v2u*)(orow + 32 + 8 * g + 4 * hi) = c2; }
    asm volatile("s_waitcnt vmcnt(0) lgkmcnt(0)" ::: "memory"); __builtin_amdgcn_s_barrier(); asm volatile("" ::: "memory");
#undef ATT_DMA
}
__device__ __forceinline__ void hgrn_item(Frame& F, int j, int it);
__device__ __forceinline__ void mix_phase(Frame& F, int j, bool ctx_out) {
    fresh(F);
    const int npair = F.G >> 1;
    for (int P = F.vcu >> 1; P < NB * NH; P += npair) {
        const int b = P >> 3, h = P & 7;
        if ((F.vcu & 1) == 0) {
            hgrn_item(F, j, P);
            for (int qb = 6; qb < 8; ++qb) attn_unit(F, b, h, b * SEQ + qb * 256, true, 0, NKEY / 64);
        } else {
            for (int qb = 0; qb < 6; ++qb) attn_unit(F, b, h, b * SEQ + qb * 256, true, 0, NKEY / 64);
            if (ctx_out) attn_unit(F, b, h, M + b * CTXL, false, SEQ / 64, NKEY / 64);
        }
    }
    __syncthreads();
}

__device__ __forceinline__ int hgrn_row(int b, int dir, int ig) { return (ig < CTXL) ? (M + b * CTXL + (dir ? CTXL - 1 - ig : ig)) : (b * SEQ + (dir ? SEQ - 1 - (ig - CTXL) : (ig - CTXL))); }
__device__ __forceinline__ void hgrn_item(Frame& F, int j, int it) {
    unsigned char* ws = F.ws;
    const bf16* HQ = (const bf16*)(ws + WS_HQ); const bf16* HFF = HQ + HSEG; const bf16* HFB = HQ + 2 * HSEG; const bf16* HI = HQ + 3 * HSEG;
    LAS unsigned char* ring = F.lds + RING_OFF;
    LAS unsigned char* QN = ring; LAS unsigned char* KN = ring + 17408; LAS unsigned char* KT = ring + 34816; LAS unsigned char* VT = ring + 53248; LAS unsigned char* ST = ring + 71680;
    LAS float* TOT = (LAS float*)(ring + 106496); LAS unsigned char* RQ = ring + 108544; LAS unsigned char* RF = ring + 124928;
    const int lane0 = F.lane, wave = F.wave;
    const int part = wave >> 1;
    const int kb = wave >> 1, vb0 = 2 * (wave & 1);
    const int ib = wave >> 2, vbo = wave & 3;
    const int dir = it & 1, hh = (it >> 1) & 3, b = it >> 3;
    const bf16* HF = dir ? HFB : HFF; float* OO = (float*)(ws + (dir ? WS_OB : WS_OF));
    float lb = 0.f; if (j == 1) { const int ci = dir * HW + hh * HK + (wave & 1) * 64 + lane0; const float l0 = F.in[13][ci], l1 = F.in[13][2 * HW + ci]; lb = 1.0f / (1.0f + __expf(l0 - l1)); }
    const float oml = 1.0f - lb;
    f32x16 S0, S1;
#pragma unroll
    for (int r = 0; r < 16; ++r) { S0[r] = 0.f; S1[r] = 0.f; }
#define LBAR() do { asm volatile("s_waitcnt lgkmcnt(0)" ::: "memory"); __builtin_amdgcn_s_barrier(); asm volatile("" ::: "memory"); } while (0)
#define HG_BASE(c_) ((c_) < CTXL / 64 ? M + b * CTXL + (dir ? CTXL - 64 - 64 * (c_) : 64 * (c_)) : b * SEQ + (dir ? SEQ - 64 - 64 * ((c_) - CTXL / 64) : 64 * ((c_) - CTXL / 64)))
#define HG_DMA(c_) do { const int rb_ = HG_BASE(c_); \
        _Pragma("unroll") for (int p_ = 0; p_ < 2; ++p_) { const int pc_ = wave * 2 + p_; const size_t go_ = (size_t)(rb_ + 4 * pc_ + (lane >> 4)) * HW + hh * HK + 8 * (lane & 15); \
            __builtin_amdgcn_global_load_lds((const unsigned*)(HQ + go_), (LAS unsigned*)(RQ + pc_ * 1024), 16, 0, 0); __builtin_amdgcn_global_load_lds((const unsigned*)(HF + go_), (LAS unsigned*)(RF + pc_ * 1024), 16, 0, 0); } } while (0)
#define HG_VLD(c_) do { const size_t go_ = (size_t)(HG_BASE(c_) + (dir ? 63 - lane : lane)) * HW + hh * HK + 16 * wave; rv0 = *(const v4u*)(HI + go_); rv1 = *(const v4u*)(HI + go_ + 8); } while (0)
    v4u rv0, rv1;
    { const int lane = lane0; HG_DMA(0); HG_VLD(0); }
    asm volatile("s_waitcnt vmcnt(0)" ::: "memory"); LBAR();
    for (int ch = 0; ch < NKEY / 64; ++ch) {
        int lane_ = lane0; asm volatile("" : "+v"(lane_));
        const int lane = lane_, r32 = lane & 31, hi = lane >> 5, k = (wave & 1) * 64 + lane;
        const int pos = (lane & ~12) | ((lane & 4) << 1) | ((lane & 8) >> 1);
        float qv[16], kin[16], cs[16]; float run = 0.f;
#pragma unroll
        for (int ii = 0; ii < 16; ++ii) { const int i = 16 * part + ii, mr = dir ? 63 - i : i; const float hq = bf2f(*(const LAS bf16*)(RQ + mr * 256 + k * 2)), hf = bf2f(*(const LAS bf16*)(RF + mr * 256 + k * 2));
            qv[ii] = hq * __builtin_amdgcn_rcpf(1.0f + __expf(-hq)); const float e = __expf(-hf), sg = __builtin_amdgcn_rcpf(1.0f + e); kin[ii] = oml * e * sg; run += __logf(lb + oml * sg); cs[ii] = run; }
        TOT[part * 128 + k] = run;
        { LAS bf16* vt = (LAS bf16*)(VT + (16 * wave) * 144 + pos * 2);
          vt[0 * 72] = (bf16)(rv0.x & 0xffffu); vt[1 * 72] = (bf16)(rv0.x >> 16); vt[2 * 72] = (bf16)(rv0.y & 0xffffu); vt[3 * 72] = (bf16)(rv0.y >> 16);
          vt[4 * 72] = (bf16)(rv0.z & 0xffffu); vt[5 * 72] = (bf16)(rv0.z >> 16); vt[6 * 72] = (bf16)(rv0.w & 0xffffu); vt[7 * 72] = (bf16)(rv0.w >> 16);
          vt[8 * 72] = (bf16)(rv1.x & 0xffffu); vt[9 * 72] = (bf16)(rv1.x >> 16); vt[10 * 72] = (bf16)(rv1.y & 0xffffu); vt[11 * 72] = (bf16)(rv1.y >> 16);
          vt[12 * 72] = (bf16)(rv1.z & 0xffffu); vt[13 * 72] = (bf16)(rv1.z >> 16); vt[14 * 72] = (bf16)(rv1.w & 0xffffu); vt[15 * 72] = (bf16)(rv1.w >> 16); }
        LBAR();
        if (ch + 1 < NKEY / 64) { HG_DMA(ch + 1); HG_VLD(ch + 1); }
        { const float t0 = TOT[k], t1 = TOT[128 + k], t2 = TOT[256 + k];
          const float base = (part > 0 ? t0 : 0.f) + (part > 1 ? t1 : 0.f) + (part > 2 ? t2 : 0.f); const float rr = t0 + t1;
          unsigned kt[8];
#pragma unroll
          for (int ii = 0; ii < 16; ii += 2) { float d0 = base + cs[ii] - rr, d1 = base + cs[ii + 1] - rr; d0 = fminf(fmaxf(d0, -80.f), 80.f); d1 = fminf(fmaxf(d1, -80.f), 80.f);
              const float e0 = __expf(d0), e1 = __expf(d1); const float q0 = qv[ii] * e0, q1 = qv[ii + 1] * e1, k0 = kin[ii] * __builtin_amdgcn_rcpf(e0), k1 = kin[ii + 1] * __builtin_amdgcn_rcpf(e1);
              const unsigned qp = cvt_pk_bf16(q0, q1), kp = cvt_pk_bf16(k0, k1);
              *(LAS bf16*)(QN + (16 * part + ii) * 272 + k * 2) = (bf16)(qp & 0xffffu); *(LAS bf16*)(QN + (16 * part + ii + 1) * 272 + k * 2) = (bf16)(qp >> 16);
              *(LAS bf16*)(KN + (16 * part + ii) * 272 + k * 2) = (bf16)(kp & 0xffffu); *(LAS bf16*)(KN + (16 * part + ii + 1) * 272 + k * 2) = (bf16)(kp >> 16);
              kt[ii >> 1] = kp; }
          *(LAS v4u*)(KT + k * 144 + part * 32) = (v4u){kt[0], kt[1], kt[4], kt[5]}; *(LAS v4u*)(KT + k * 144 + part * 32 + 16) = (v4u){kt[2], kt[3], kt[6], kt[7]}; }
        f32x16 T0, T1;
#pragma unroll
        for (int g4 = 0; g4 < 4; ++g4) { const int kk = kb * 32 + 8 * g4 + 4 * hi; const f32x4 ta = *(const LAS f32x4*)(TOT + kk), tb = *(const LAS f32x4*)(TOT + 128 + kk);
            const float e0 = __expf(ta.x + tb.x), e1 = __expf(ta.y + tb.y), e2 = __expf(ta.z + tb.z), e3 = __expf(ta.w + tb.w);
            T0[4 * g4] = S0[4 * g4] * e0; T0[4 * g4 + 1] = S0[4 * g4 + 1] * e1; T0[4 * g4 + 2] = S0[4 * g4 + 2] * e2; T0[4 * g4 + 3] = S0[4 * g4 + 3] * e3;
            T1[4 * g4] = S1[4 * g4] * e0; T1[4 * g4 + 1] = S1[4 * g4 + 1] * e1; T1[4 * g4 + 2] = S1[4 * g4 + 2] * e2; T1[4 * g4 + 3] = S1[4 * g4 + 3] * e3;
            v2u o; o.x = cvt_pk_bf16(T0[4 * g4], T0[4 * g4 + 1]); o.y = cvt_pk_bf16(T0[4 * g4 + 2], T0[4 * g4 + 3]); *(LAS v2u*)(ST + (vb0 * 32 + r32) * 272 + kk * 2) = o;
            o.x = cvt_pk_bf16(T1[4 * g4], T1[4 * g4 + 1]); o.y = cvt_pk_bf16(T1[4 * g4 + 2], T1[4 * g4 + 3]); *(LAS v2u*)(ST + (vb0 * 32 + 32 + r32) * 272 + kk * 2) = o; }
        LBAR();
#pragma unroll
        for (int st = 0; st < 4; ++st) { const bf16x8v kf = *(const LAS bf16x8v*)(KT + (kb * 32 + r32) * 144 + st * 32 + hi * 16);
            const bf16x8v va = *(const LAS bf16x8v*)(VT + (vb0 * 32 + r32) * 144 + st * 32 + hi * 16), vc = *(const LAS bf16x8v*)(VT + (vb0 * 32 + 32 + r32) * 144 + st * 32 + hi * 16);
            T0 = __builtin_amdgcn_mfma_f32_32x32x16_bf16(kf, va, T0, 0, 0, 0); T1 = __builtin_amdgcn_mfma_f32_32x32x16_bf16(kf, vc, T1, 0, 0, 0); }
#pragma unroll
        for (int g4 = 0; g4 < 4; ++g4) { const int kk = kb * 32 + 8 * g4 + 4 * hi; const f32x4 ta = *(const LAS f32x4*)(TOT + 256 + kk), tb = *(const LAS f32x4*)(TOT + 384 + kk);
            const float e0 = __expf(ta.x + tb.x), e1 = __expf(ta.y + tb.y), e2 = __expf(ta.z + tb.z), e3 = __expf(ta.w + tb.w);
            S0[4 * g4] = T0[4 * g4] * e0; S0[4 * g4 + 1] = T0[4 * g4 + 1] * e1; S0[4 * g4 + 2] = T0[4 * g4 + 2] * e2; S0[4 * g4 + 3] = T0[4 * g4 + 3] * e3;
            S1[4 * g4] = T1[4 * g4] * e0; S1[4 * g4 + 1] = T1[4 * g4 + 1] * e1; S1[4 * g4 + 2] = T1[4 * g4 + 2] * e2; S1[4 * g4 + 3] = T1[4 * g4 + 3] * e3; }
        asm volatile("" ::: "memory");
        {
            bf16x8v qf[8];
#pragma unroll
            for (int ks = 0; ks < 8; ++ks) qf[ks] = *(const LAS bf16x8v*)(QN + (ib * 32 + r32) * 272 + ks * 32 + hi * 16);
            asm volatile("" ::: "memory");
            f32x16 O;
#pragma unroll
            for (int r = 0; r < 16; ++r) O[r] = 0.f;
#pragma unroll
            for (int ks = 0; ks < 8; ++ks) { const bf16x8v sf = *(const LAS bf16x8v*)(ST + (vbo * 32 + r32) * 272 + ks * 32 + hi * 16); O = __builtin_amdgcn_mfma_f32_32x32x16_bf16(qf[ks], sf, O, 0, 0, 0); }
            asm volatile("" ::: "memory");
#pragma unroll 1
            for (int sb = 0; sb <= ib; ++sb) {
                f32x16 X;
#pragma unroll
                for (int r = 0; r < 16; ++r) X[r] = 0.f;
#pragma unroll
                for (int ks = 0; ks < 8; ++ks) { const bf16x8v kf = *(const LAS bf16x8v*)(KN + (sb * 32 + r32) * 272 + ks * 32 + hi * 16); X = __builtin_amdgcn_mfma_f32_32x32x16_bf16(kf, qf[ks], X, 0, 0, 0); }
                if (sb == ib) {
#pragma unroll
                    for (int r = 0; r < 16; ++r) { const int srow = (r & 3) + 8 * (r >> 2) + 4 * hi; if (srow > r32) X[r] = 0.f; }
                }
                asm volatile("" ::: "memory");
#pragma unroll
                for (int st = 0; st < 2; ++st) { v4u pw;
#pragma unroll
                    for (int q = 0; q < 4; ++q) pw[q] = cvt_pk_bf16(X[8 * st + 2 * q], X[8 * st + 2 * q + 1]);
                    const bf16x8v vf = *(const LAS bf16x8v*)(VT + (vbo * 32 + r32) * 144 + (sb * 32 + st * 16) * 2 + hi * 16);
                    O = __builtin_amdgcn_mfma_f32_32x32x16_bf16(__builtin_bit_cast(bf16x8v, pw), vf, O, 0, 0, 0); }
                asm volatile("" ::: "memory");
            }
            const int rb = HG_BASE(ch); float* op = OO + (size_t)rb * HW + hh * HK + vbo * 32 + r32;
#pragma unroll
            for (int r = 0; r < 16; ++r) { const int i = ib * 32 + (r & 3) + 8 * (r >> 2) + 4 * hi; op[(size_t)(dir ? 63 - i : i) * HW] = O[r]; }
        }
        asm volatile("s_waitcnt vmcnt(0)" ::: "memory"); LBAR();
    }
#undef LBAR
#undef HG_DMA
#undef HG_VLD
#undef HG_BASE
}

__device__ __forceinline__ void e8_phase(Frame& F, int j, int nrows) {
    fresh(F);
    unsigned char* ws = F.ws;
    const float* OF = (const float*)(ws + WS_OF); const float* OB = (const float*)(ws + WS_OB); const bf16* HG = (const bf16*)(ws + WS_HQ) + 4 * HSEG; bf16* MIX = (bf16*)(ws + WS_MIX);
    const float* gn = F.in[14] + j * HK;
    const int rpw = (nrows + F.G - 1) / F.G, rbase = (int)blockIdx.x * rpw, rend = (rbase + rpw < nrows) ? rbase + rpw : nrows;
    const int col = 8 * F.lane, vv = col & 127; const f32x4 g0 = *(const f32x4*)(gn + vv), g1 = *(const f32x4*)(gn + vv + 4);
    for (int r0 = rbase + F.wave; r0 < rend; r0 += 2 * NWAVES) {
        f32x4 a0[2], a1[2], b0[2], b1[2]; v4u hg[2];
#pragma unroll
        for (int q = 0; q < 2; ++q) { const int row = r0 + q * NWAVES; if (row < rend) {
            a0[q] = *(const f32x4*)(OF + (size_t)row * HW + col); a1[q] = *(const f32x4*)(OF + (size_t)row * HW + col + 4); b0[q] = *(const f32x4*)(OB + (size_t)row * HW + col); b1[q] = *(const f32x4*)(OB + (size_t)row * HW + col + 4);
            hg[q] = *(const v4u*)(HG + (size_t)row * HW + col); } }
#pragma unroll
        for (int q = 0; q < 2; ++q) { const int row = r0 + q * NWAVES; if (row < rend) {
            f32x4 x0 = a0[q] + b0[q], x1 = a1[q] + b1[q];
            float s = (x0.x * x0.x + x0.y * x0.y) + (x0.z * x0.z + x0.w * x0.w) + (x1.x * x1.x + x1.y * x1.y) + (x1.z * x1.z + x1.w * x1.w);
            s += shx(s, F.lane, 1); s += shx(s, F.lane, 2); s += shx(s, F.lane, 4); s += shx(s, F.lane, 8);
            const float rstd = rsqrtf(s * (1.0f / HK) + EPS);
            x0 = x0 * rstd * g0; x1 = x1 * rstd * g1; const v4u h = hg[q];
            v4u o; o.x = pg8::cvt_pk_bf16(x0.x * siluf_(bflo(h.x)), x0.y * siluf_(bfhi(h.x))); o.y = pg8::cvt_pk_bf16(x0.z * siluf_(bflo(h.y)), x0.w * siluf_(bfhi(h.y)));
            o.z = pg8::cvt_pk_bf16(x1.x * siluf_(bflo(h.z)), x1.y * siluf_(bfhi(h.z))); o.w = pg8::cvt_pk_bf16(x1.z * siluf_(bflo(h.w)), x1.w * siluf_(bfhi(h.w)));
            *(v4u*)(MIX + (size_t)row * DM + HW + col) = o; } }
    }
}

__device__ __forceinline__ void o12_phase(Frame& F, int nrows, const bf16* hb, const float* gn, const float* modl) {
    fresh(F);
    bf16* P = (bf16*)(F.ws + WS_POOLED);
    LAS unsigned char* XN = F.lds + RING_OFF;
    const int rpw = (nrows + F.G - 1) / F.G, rbase = (int)blockIdx.x * rpw, rend = (rbase + rpw < nrows) ? rbase + rpw : nrows;
    for (int r0 = rbase; r0 < rend; r0 += 32) {
        for (int sl = F.wave; sl < 48; sl += NWAVES) {
            const int row = r0 - 8 + sl; if (row < 0 || row >= nrows) continue;
            f32x4 v[4]; float s = 0.f;
#pragma unroll
            for (int j = 0; j < 4; ++j) { const v2u w = *(const v2u*)(hb + (size_t)row * DM + 4 * F.lane + 256 * j); v[j] = (f32x4){bflo(w.x), bfhi(w.x), bflo(w.y), bfhi(w.y)}; s += (v[j].x * v[j].x + v[j].y * v[j].y) + (v[j].z * v[j].z + v[j].w * v[j].w); }
            const float rstd = rsqrtf(wave_sum(s, F.lane) * (1.0f / DM) + EPS);
#pragma unroll
            for (int j = 0; j < 4; ++j) { v2u o; o.x = pg8::cvt_pk_bf16(v[j].x * rstd, v[j].y * rstd); o.y = pg8::cvt_pk_bf16(v[j].z * rstd, v[j].w * rstd); *(LAS v2u*)(XN + sl * 2048 + (4 * F.lane + 256 * j) * 2) = o; }
        }
        __syncthreads();
#pragma unroll 1
        for (int q = 0; q < 4; ++q) {
            const int t = r0 + F.wave * 4 + q; if (t >= rend) break;
            const bool lat = t < M; const int T = lat ? SEQ : CTXL; const int tt = lat ? t % SEQ : (t - M) % CTXL; const int bidx = lat ? t / SEQ : NB;
            const int sc0 = t - r0 + 8;
            const float* scp = modl + bidx * NMOD + DM;
#pragma unroll
            for (int g = 0; g < 4; ++g) {
                const int hw = 1 << g, col = 256 * g + 4 * F.lane;
                float s0 = 0.f, s1 = 0.f, s2 = 0.f, s3 = 0.f; int cnt = 0;
#pragma unroll
                for (int d = -hw; d < hw; ++d) { const bool ok = (tt + d >= 0) && (tt + d < T); const v2u x = *(const LAS v2u*)(XN + (sc0 + d) * 2048 + col * 2);
                    s0 += ok ? bflo(x.x) : 0.f; s1 += ok ? bfhi(x.x) : 0.f; s2 += ok ? bflo(x.y) : 0.f; s3 += ok ? bfhi(x.y) : 0.f; cnt += ok ? 1 : 0; }
                const v2u xc = *(const LAS v2u*)(XN + sc0 * 2048 + col * 2); const float ic = 1.0f / (float)cnt;
                const f32x4 gv = *(const f32x4*)(gn + col), sv = *(const f32x4*)(scp + col);
                v2u o; o.x = pg8::cvt_pk_bf16(gv.x * (sv.x + 1.0f) * (s0 * ic - bflo(xc.x)), gv.y * (sv.y + 1.0f) * (s1 * ic - bfhi(xc.x)));
                o.y = pg8::cvt_pk_bf16(gv.z * (sv.z + 1.0f) * (s2 * ic - bflo(xc.y)), gv.w * (sv.w + 1.0f) * (s3 * ic - bfhi(xc.y)));
                *(v2u*)(P + ((size_t)g * MT + t) * 256 + 4 * F.lane) = o;
            }
        }
        __syncthreads();
    }
}

__device__ __forceinline__ void o5_phase(Frame& F, int nrows) {
    fresh(F);
    unsigned char* ws = F.ws;
    const int* CNT = (const int*)(ws + WS_CNT); int* TST = (int*)(ws + WS_TST); const int* EIDX = (const int*)(ws + WS_EIDX); int* POS = (int*)(ws + WS_POS);
    const bf16* U = (const bf16*)(ws + WS_U); bf16* VG = (bf16*)(ws + WS_VG);
    LAS int* lc = (LAS int*)(F.lds + RING_OFF);
    LAS int* lbase = lc + 512 * 8;
    LAS int* lpos = lbase + 32;
    const int rpw = (nrows + F.G - 1) / F.G;
    for (int e = F.tid; e < F.G * 8; e += 512) lc[e] = CNT[e];
    __syncthreads();
    {
        const int e = F.wave; int c4[4]; int sum = 0;
#pragma unroll
        for (int q = 0; q < 4; ++q) { const int w = 4 * F.lane + q; c4[q] = (w < F.G) ? lc[w * 8 + e] : 0; sum += c4[q]; }
        int incl = sum;
#pragma unroll
        for (int o = 1; o < 64; o <<= 1) { const int t = __builtin_amdgcn_ds_bpermute((F.lane >= o ? F.lane - o : F.lane) << 2, incl); if (F.lane >= o) incl += t; }
        const int total = __builtin_amdgcn_readlane(incl, 63); int excl = incl - sum;
        const int myq = (int)blockIdx.x & 3; int pre = excl;
#pragma unroll
        for (int q = 0; q < 3; ++q) if (q < myq) pre += c4[q];
        if (F.lane == ((int)blockIdx.x >> 2)) { lbase[e] = pre; lbase[8 + e] = total; }
    }
    __syncthreads();
    if (F.tid == 0) {
        int ts = 0;
        for (int e = 0; e < 8; ++e) { const int pre = lbase[e], tot = lbase[8 + e]; lbase[e] = ts * 256 + pre; if (blockIdx.x == 0) TST[e] = ts; ts += (tot + 255) >> 8; }
        if (blockIdx.x == 0) TST[8] = ts;
    }
    __syncthreads();
    if (F.wave == 0) {
        int run[8];
#pragma unroll
        for (int e = 0; e < 8; ++e) run[e] = lbase[e];
        const int npairs = 2 * rpw;
        for (int c0 = 0; c0 < npairs; c0 += 64) {
            const int pl = c0 + F.lane; const int row = (int)blockIdx.x * rpw + (pl >> 1); const bool ok = pl < npairs && row < nrows;
            const int e = ok ? EIDX[2 * row + (pl & 1)] : -1; int mypos = 0;
#pragma unroll
            for (int x = 0; x < 8; ++x) { const unsigned long long mk = __ballot(e == x); const int below = __popcll(mk & ((1ull << F.lane) - 1ull)); if (e == x) mypos = run[x] + below; run[x] += __popcll(mk); }
            if (ok) { lpos[pl] = mypos; POS[2 * row + (pl & 1)] = mypos; }
        }
    }
    __syncthreads();
    for (int pl0 = F.wave * 4; pl0 < 2 * rpw; pl0 += NWAVES * 4) {
        v4u a[4], b[4]; int p[4];
#pragma unroll
        for (int q = 0; q < 4; ++q) { const int pl = pl0 + q; const int row = (int)blockIdx.x * rpw + (pl >> 1); p[q] = -1;
            if (pl < 2 * rpw && row < nrows) { p[q] = lpos[pl]; a[q] = *(const v4u*)(U + (size_t)row * DM + 8 * F.lane); b[q] = *(const v4u*)(U + (size_t)row * DM + 512 + 8 * F.lane); } }
#pragma unroll
        for (int q = 0; q < 4; ++q) if (p[q] >= 0) { *(v4u*)(VG + (size_t)p[q] * DM + 8 * F.lane) = a[q]; *(v4u*)(VG + (size_t)p[q] * DM + 512 + 8 * F.lane) = b[q]; }
    }
    __syncthreads();
}

__global__ void __launch_bounds__(NWAVES * 64, 2) mega_fwd(Args args) {
    extern __shared__ __attribute__((aligned(16))) unsigned char lds[];
    Frame F;
    F.lds = (LAS unsigned char*)lds;
    F.wave = __builtin_amdgcn_readfirstlane((int)threadIdx.x >> 6); fresh(F);
    F.G = gridDim.x; { const int bx = blockIdx.x; F.vcu = (F.G % 8 == 0) ? (bx % 8) * (F.G / 8) + bx / 8 : bx; }
    F.in = args.in; F.out = args.out; F.ws = args.ws;
    unsigned char* ws = args.ws;
    volatile LAS unsigned* MISC = (volatile LAS unsigned*)(F.lds + MISC_OFF);
    for (int u = F.tid; u < (LDS_BYTES - LDSCTL_OFF) / 4; u += NWAVES * 64) ((LAS unsigned*)(F.lds + LDSCTL_OFF))[u] = 0u;
    __syncthreads();
    XcdBarrier bar = xcd_barrier_post((unsigned*)(ws + WS_CTL) + CW_BAR, MISC + 8, F.wave);
#define GRID_BAR() do { xcd_barrier(bar); if (DUPMASK & 4096) xcd_barrier(bar); } while (0)
#ifndef ONLY
#define ONLY 0
#endif
#define PH(n) (ONLY == 0 || ONLY == (n))
#define REP(bit) for (int rep_ = 0; rep_ < ((DUPMASK & (bit)) ? 2 : 1); ++rep_)
    LAS unsigned char* ring = F.lds + RING_OFF;
    const float* MODV = (const float*)(ws + WS_MODV);
    bf16* HB = (bf16*)(ws + WS_HB);
    bf16* U = (bf16*)(ws + WS_U);

#if PH(20)
    REP(8192) p0_prologue(F);
#endif
    GRID_BAR();

    for (int lp = 0; lp < 2; ++lp) {
        const int le = 2 * lp, lo = 2 * lp + 1, j = lp;
        const bool ctx_out = (lp == 0);
        const int nro = ctx_out ? MT : M;
        const float* modE = MODV + (size_t)le * 17 * NMOD; const float* modO = MODV + (size_t)lo * 17 * NMOD;
#if PH(1)
        {
            RowArgs A{}; A.xin_l = args.in[0]; A.xin_c = args.in[2]; A.hb = HB; A.hbo = HB; A.g = args.in[6] + (size_t)(le * 2 + 0) * DM; A.modl = modE; A.shoff = 0; A.scoff = DM; A.U = U;
            A.Y = (const bf16*)(ws + WS_VG); A.pos = (const int*)(ws + WS_POS); A.gate = (const float*)(ws + WS_GATE); A.modprev = MODV + (size_t)(le - 1) * 17 * NMOD;
            if (lp == 0) row_phase<false, 1, false, true>(F, A, MT); else row_phase<true, 1, false, false>(F, A, MT);
        }
#endif
        GRID_BAR();
#if PH(2)
        {
            pg8::Gemm g{U, (const bf16*)(ws + WS_WIN) + (size_t)j * INP * DM, DM, DM, DM}; pg8::InOrder S; S.init(ctx_out, F.G, (int)blockIdx.x);
            EpiIn E{(bf16*)(ws + WS_CQ), (bf16*)(ws + WS_KRR), (bf16*)(ws + WS_CKV), (bf16*)(ws + WS_HQ), (float*)(ws + WS_RSQ), (float*)(ws + WS_RSKV), (const float*)(ws + WS_ROPE)};
            REP(8) pg8::gemm_phase<EpiIn, pg8::InOrder, true>(ring, g, S, E, F.wave);
        }
#endif
        GRID_BAR();
#if PH(4)
        {
            pg8::Gemm g{(const bf16*)(ws + WS_CQ), (const bf16*)(ws + WS_WUQ) + (size_t)j * 768 * QL, QL, QL, QL}; pg8::StaticOrder S; S.init(nro, 768, F.G, (int)blockIdx.x);
            EpiQ E{(bf16*)(ws + WS_QB), (const float*)(ws + WS_RSQ)};
            REP(8) pg8::gemm_phase<EpiQ, pg8::StaticOrder, true>(ring, g, S, E, F.wave);
        }
        {
            pg8::Gemm g{(const bf16*)(ws + WS_CKV), (const bf16*)(ws + WS_WUKV) + (size_t)j * 1024 * KVL, KVL, KVL, KVL}; pg8::StaticOrder S; S.init(MT, 1024, F.G, (int)blockIdx.x);
            EpiKV E{(bf16*)(ws + WS_KN), (bf16*)(ws + WS_VV), (const float*)(ws + WS_RSKV)};
            REP(8) pg8::gemm_phase<EpiKV, pg8::StaticOrder, true>(ring, g, S, E, F.wave);
        }
#endif
        GRID_BAR();
#if PH(6)
        REP(3) mix_phase(F, j, ctx_out);
#endif
        GRID_BAR();
#if PH(8)
        REP(4 | 64) e8_phase(F, j, nro);
#endif
        GRID_BAR();
#if PH(9)
        {
            pg8::Gemm g{(const bf16*)(ws + WS_MIX), (const bf16*)(ws + WS_WOUT) + (size_t)j * DM * DM, DM, DM, DM}; pg8::StaticOrder S; S.init(nro, DM, F.G, (int)blockIdx.x);
            if (lp == 0) { EpiResid<true> E{args.in[0], args.in[2], HB, modE, 2 * DM}; pg8::gemm_phase<EpiResid<true>, pg8::StaticOrder, true>(ring, g, S, E, F.wave); }
            else { EpiResid<false> E{nullptr, nullptr, HB, modE, 2 * DM}; pg8::gemm_phase<EpiResid<false>, pg8::StaticOrder, true>(ring, g, S, E, F.wave); }
        }
#endif
        GRID_BAR();
#if PH(10)
        {
            RowArgs A{}; A.hb = HB; A.g = args.in[6] + (size_t)(le * 2 + 1) * DM; A.modl = modE; A.shoff = 3 * DM; A.scoff = 4 * DM; A.U = U;
            REP(4 | 128) row_phase<false, 1, false, false>(F, A, nro);
        }
#endif
        GRID_BAR();
#if PH(11)
        {
            pg8::Gemm g{U, (const bf16*)(ws + WS_WGU) + (size_t)j * 2 * DFF * DM, DM, DM, DM}; pg8::StaticOrder S; S.init(nro, 2 * DFF, F.G, (int)blockIdx.x);
            EpiGateUp E{(bf16*)(ws + WS_HID), DFF, 2 * DFF / 256, 0};
            REP(8) pg8::gemm_phase<EpiGateUp, pg8::StaticOrder, true>(ring, g, S, E, F.wave);
        }
#endif
        GRID_BAR();
#if PH(12)
        {
            pg8::Gemm g{(const bf16*)(ws + WS_HID), (const bf16*)(ws + WS_WDN) + (size_t)j * DM * DFF, DFF, DFF, DFF}; pg8::StaticOrder S; S.init(nro, DM, F.G, (int)blockIdx.x);
            EpiResid<false> E{nullptr, nullptr, HB, modE, 5 * DM};
            pg8::gemm_phase<EpiResid<false>, pg8::StaticOrder, true>(ring, g, S, E, F.wave);
        }
#endif
        GRID_BAR();
#if PH(13)
        {
            REP(2048) o12_phase(F, nro, HB, args.in[6] + (size_t)(lo * 2 + 0) * DM, modO);
            REP(16) for (int e = 0; e < NE; ++e) {
                conv_matrix(F, args.in[23] + ((size_t)j * NE + e) * DM * DFE, DM, DFE, (bf16*)(ws + WS_MWGU) + (size_t)e * 2 * DFE * DM, DM, 2, 0, nullptr, 1.f);
                conv_matrix(F, args.in[24] + ((size_t)j * NE + e) * DM * DFE, DM, DFE, (bf16*)(ws + WS_MWGU) + (size_t)e * 2 * DFE * DM, DM, 2, 128, nullptr, 1.f);
                conv_matrix(F, args.in[25] + ((size_t)j * NE + e) * DFE * DM, DFE, DM, (bf16*)(ws + WS_MWDN) + (size_t)e * DM * DFE, DFE, 0, 0, nullptr, 1.f);
            }
        }
#endif
        GRID_BAR();
#if PH(15)
        {
            pg8::Gemm g{(const bf16*)(ws + WS_POOLED), (const bf16*)(ws + WS_WPOOL) + (size_t)j * 4 * 65536, 256, 256, 256};
            pg8::PoolOrder S{nro / 256, MT / 256, F.G, (int)blockIdx.x};
            EpiPool E{HB, modO, args.in[20] + (size_t)j * DM, args.in[21] + (size_t)j * DM, MT / 256};
            pg8::gemm_phase<EpiPool, pg8::PoolOrder, true>(ring, g, S, E, F.wave);
        }
#endif
        GRID_BAR();
#if PH(16)
        {
            RowArgs A{}; A.hb = HB; A.g = args.in[6] + (size_t)(lo * 2 + 1) * DM; A.modl = modO; A.shoff = 3 * DM; A.scoff = 4 * DM; A.U = U;
            A.router = args.in[22] + (size_t)j * DM * NE; A.eidx = (int*)(ws + WS_EIDX); A.gout = (float*)(ws + WS_GATE); A.cnt = (int*)(ws + WS_CNT);
            REP(4 | 512) row_phase<false, 1, true, false>(F, A, nro);
        }
#endif
        GRID_BAR();
#if PH(17)
        REP(4 | 1024) o5_phase(F, nro);
#endif
        GRID_BAR();
#if PH(18)
        {
            const int* TST = (const int*)(ws + WS_TST);
            const int ts1 = TST[1], ts2 = TST[2], ts3 = TST[3], ts4 = TST[4], ts5 = TST[5], ts6 = TST[6], ts7 = TST[7], nT = TST[8];
            const int rem = nT % MOE_CH, nseg = nT / MOE_CH + 1;
            for (int p = 0; p <= nseg; ++p) {
                int n7 = 0;
                if (p >= 1) {
                    const int sg = p - 1; const int t0 = sg == 0 ? 0 : rem + (sg - 1) * MOE_CH, nrt = sg == 0 ? rem : MOE_CH; n7 = nrt * (DM / 256);
                    const bf16* hb = (const bf16*)(ws + WS_HIDM) + (size_t)((sg == 0 || ((sg - 1) & 1)) ? MOE_CH : 0) * 256 * DFE;
                    pg8::Gemm g{hb - (size_t)t0 * 256 * DFE, (const bf16*)(ws + WS_MWDN), DFE, DFE, DFE};
                    pg8::MoeOrder S{t0, nrt, DM / 256, F.G, (int)blockIdx.x, ts1, ts2, ts3, ts4, ts5, ts6, ts7, 0, 0};
                    EpiY E{(bf16*)(ws + WS_VG), DM / 256};
                    REP(8) pg8::gemm_phase<EpiY, pg8::MoeOrder, true>(ring, g, S, E, F.wave);
                }
                if (p < nseg) {
                    const int sg = p; const int t0 = sg == 0 ? 0 : rem + (sg - 1) * MOE_CH, nrt = sg == 0 ? rem : MOE_CH;
                    bf16* hb = (bf16*)(ws + WS_HIDM) + (size_t)((sg == 0 || ((sg - 1) & 1)) ? MOE_CH : 0) * 256 * DFE;
                    pg8::Gemm g{(const bf16*)(ws + WS_VG), (const bf16*)(ws + WS_MWGU), DM, DM, DM};
                    pg8::MoeOrder S{t0, nrt, 2 * DFE / 256, F.G, (int)blockIdx.x, ts1, ts2, ts3, ts4, ts5, ts6, ts7, n7 % F.G, 4};
                    EpiGateUp E{hb, DFE, 2 * DFE / 256, t0 * 256};
                    REP(8) pg8::gemm_phase<EpiGateUp, pg8::MoeOrder, true>(ring, g, S, E, F.wave);
                }
                GRID_BAR();
            }
        }
#endif
    }
#if PH(19)
    {
        RowArgs A{}; A.hb = HB; A.fout = args.out; A.g = args.in[7];
        A.Y = (const bf16*)(ws + WS_VG); A.pos = (const int*)(ws + WS_POS); A.gate = (const float*)(ws + WS_GATE); A.modprev = MODV + (size_t)3 * 17 * NMOD;
        row_phase<true, 2, false, false>(F, A, M);
        if (xb_ld((unsigned*)(ws + WS_CTL) + CW_BAR + XB_TMO) != 0u) { __syncthreads(); const float qn = __builtin_nanf(""); for (int i = F.tid; i < 1024; i += 512) args.out[(size_t)blockIdx.x * 1024 + i] = qn; }
    }
#endif
}

extern "C" void kernel_launch(void* const* d_in, const int* in_sizes, int n_in, void* d_out, int out_size, void* d_ws, size_t ws_size, hipStream_t stream) {
    static int grid = 0;
    if (grid == 0) {
        if (n_in != 26 || out_size != M * DM || ws_size < WS_END) { fprintf(stderr, "kernel_launch: unexpected shapes (n_in %d out %d ws %zu)\n", n_in, out_size, ws_size); grid = -1; return; }
        int dev = 0, cus = 0, per_cu = 0;
        if (hipGetDevice(&dev) != hipSuccess || hipDeviceGetAttribute(&cus, hipDeviceAttributeMultiprocessorCount, dev) != hipSuccess) { grid = -1; return; }
        if (hipFuncSetAttribute((const void*)mega_fwd, hipFuncAttributeMaxDynamicSharedMemorySize, LDS_BYTES) != hipSuccess) { grid = -1; return; }
        if (hipOccupancyMaxActiveBlocksPerMultiprocessor(&per_cu, (const void*)mega_fwd, NWAVES * 64, LDS_BYTES) != hipSuccess || per_cu < 1) fprintf(stderr, "kernel_launch: occupancy query says %d\n", per_cu);
        (void)hipGetLastError();
        grid = cus > 256 ? 256 : cus;
    }
    if (grid < 0) return;
    if (hipMemsetAsync((char*)d_ws + WS_CTL, 0, CTL_ZERO_BYTES, stream) != hipSuccess) return;
    Args a{};
    for (int i = 0; i < 26; ++i) a.in[i] = (const float*)d_in[i];
    a.out = (float*)d_out; a.ws = (unsigned char*)d_ws;
    hipLaunchKernelGGL(mega_fwd, dim3(grid), dim3(NWAVES * 64), LDS_BYTES, stream, a);
}
```

```cpp
#include <hip/hip_runtime.h>
#ifndef DUPMASK
#define DUPMASK 0
#endif
#include <cstdio>
#include <cstdint>

__device__ __forceinline__ int lane_now() { int l; asm volatile("v_mbcnt_lo_u32_b32 %0, -1, 0\n\tv_mbcnt_hi_u32_b32 %0, -1, %0" : "=v"(l)); return l; }
namespace pg8 {
#define PG8_LAS __attribute__((address_space(3)))
typedef unsigned short bf16_t;
typedef short bf16x8 __attribute__((ext_vector_type(8)));
typedef float f32x4 __attribute__((ext_vector_type(4)));
typedef unsigned u32x4 __attribute__((ext_vector_type(4)));
constexpr int BM = 256, BK = 64, HALF = 128, HTB = HALF * BK * 2, STAGE_BYTES = 8 * HTB, NXCD = 8, WGM = 8;

__host__ __device__ __forceinline__ int lds_byte(int r, int c) { const int st = (r >> 4) * 2 + (c >> 5), rr = r & 15, cc = c & 31, ob = rr * 64 + cc * 2; return st * 1024 + (ob ^ (((ob >> 9) & 1) << 5)); }
__host__ __device__ __forceinline__ void stage_rc(int b, int& R, int& C) { const int st = b / 1024, sb = b % 1024, swz = sb ^ (((sb >> 9) & 1) << 5); R = (st >> 1) * 16 + swz / 64; C = (st & 1) * 32 + (swz % 64) / 2; }
__host__ __device__ __forceinline__ int perm32(int rho) { const int n = rho >> 4, i = rho & 15; return 8 * (i >> 2) + 4 * n + (i & 3); }

struct Unit { int pm, pn; };
struct Gemm { const bf16_t* A; const bf16_t* Bt; int lda, ldb, K; };

struct StaticOrder {
    int nM, nN, nwg, G, c;
    __device__ void init(int M, int N, int G_, int c_) { nM = M / BM; nN = N / BM; nwg = nM * nN; G = G_; c = c_; }
    __device__ bool next(int i, Unit& u) const {
        const long L = (long)i * G + c; if (L >= nwg) return false;
        int wgid = (int)L; { const int q = nwg / NXCD, r = nwg % NXCD, xcd = wgid % NXCD, off = wgid / NXCD; wgid = (xcd < r ? xcd * (q + 1) : r * (q + 1) + (xcd - r) * q) + off; }
        const int nig = WGM * nN, gid = wgid / nig, fm = gid * WGM, gsz = (nM - fm) < WGM ? (nM - fm) : WGM;
        u.pm = fm + ((wgid % nig) % gsz); u.pn = (wgid % nig) / gsz; return true;
    }
};
struct InOrder {
    StaticOrder lat; int nlat, nctx_ct, G, c;
    __device__ void init(bool full, int G_, int c_) { lat.init(32768, 3328, G_, c_); nlat = lat.nwg; nctx_ct = full ? 13 : 8; G = G_; c = c_; }
    __device__ bool next(int i, Unit& u) const {
        const int L = i * G + c; if (L < nlat) return lat.next(i, u);
        const int x = L - nlat; if (x >= 16 * nctx_ct) return false;
        const int rt = (nctx_ct == 13) ? x / 13 : x >> 3, q = x - rt * nctx_ct; u.pm = 128 + rt; u.pn = (nctx_ct == 13) ? q : (q < 2 ? q + 1 : q + 3); return true;
    }
};
struct PoolOrder {
    int nrt, talloc, G, c;
    __device__ bool next(int i, Unit& u) const { const int L = i * G + c; if (L >= 4 * nrt) return false; const int g = L / nrt, rt = L - g * nrt; u.pm = g * talloc + rt; u.pn = g; return true; }
};
struct MoeOrder {
    int t0, nrt, nct, G, c; int ts1, ts2, ts3, ts4, ts5, ts6, ts7;
    int skipw, skipr;
    __device__ bool next(int i, Unit& u) const {
        const int nwg = nrt * nct; const int r_ = i + (c < skipw ? skipr : 0);
        const int L = (r_ < skipr) ? r_ * (G - skipw) + (c - skipw) : skipr * (G - skipw) + (r_ - skipr) * G + c; if (L >= nwg) return false;
        int wgid = L; { const int q = nwg / NXCD, r = nwg % NXCD, xcd = wgid % NXCD, off = wgid / NXCD; wgid = (xcd < r ? xcd * (q + 1) : r * (q + 1) + (xcd - r) * q) + off; }
        const int nig = WGM * nct, gid = wgid / nig, fm = gid * WGM, gsz = (nrt - fm) < WGM ? (nrt - fm) : WGM;
        const int rt = t0 + fm + ((wgid % nig) % gsz), ct = (wgid % nig) / gsz;
        const int e = (rt >= ts1) + (rt >= ts2) + (rt >= ts3) + (rt >= ts4) + (rt >= ts5) + (rt >= ts6) + (rt >= ts7);
        u.pm = rt; u.pn = e * nct + ct; return true;
    }
};

__device__ __forceinline__ unsigned cvt_pk_bf16(float lo, float hi) { unsigned r; asm volatile("v_cvt_pk_bf16_f32 %0, %1, %2" : "=v"(r) : "v"(lo), "v"(hi)); return r; }

template <class Epi, class Sched, bool ALIGN_EPI>
__device__ __forceinline__ void gemm_phase(PG8_LAS unsigned char* lds, const Gemm g, const Sched& S, const Epi& E, const int wid) {
    const int lane_ = lane_now();
    const int lane = lane_, tid = wid * 64 + lane, wr = wid >> 2, wc = wid & 3, fr = lane & 15, fq = lane >> 4;
    int K_ = g.K; asm volatile("" : "+s"(K_));
    const int K = K_, nt = K / BK;
    unsigned voffA[2], voffB[2];
#pragma unroll
    for (int i = 0; i < 2; ++i) { int R, C; stage_rc(tid * 16 + i * 8192, R, C); const int Rb = Epi::PERM ? ((R & ~31) + perm32(R & 31)) : R;
        voffA[i] = (unsigned)(R * g.lda + C) * 2u; voffB[i] = (unsigned)(Rb * g.ldb + C) * 2u; }
    const size_t kstep = (size_t)(BK * 2);
    const size_t hstepA = (size_t)HALF * g.lda * 2, hstepB = (size_t)HALF * g.ldb * 2;
    const size_t tstepA = 2 * hstepA, tstepB = 2 * hstepB;
    const unsigned ldsw = (unsigned)wid * 1024u;
    const int aoff = lds_byte(wr * 64 + fr, fq * 8), boff = lds_byte(wc * 32 + fr, fq * 8);
#define PG8_SA(b, h) (((b) * 2 + (h)) * HTB)
#define PG8_SB(b, h) ((4 + (b) * 2 + (h)) * HTB)
#define PG8_STAGE(bufoff, gbase, voff) do { _Pragma("unroll") for (int _i = 0; _i < 2; ++_i) \
        __builtin_amdgcn_global_load_lds((const unsigned*)((const char*)(gbase) + (voff)[_i]), (PG8_LAS unsigned*)(lds + (bufoff) + ldsw + _i * 8192), 16, 0, 0); } while (0)
#define PG8_LDA(dst, b, h) do { _Pragma("unroll") for (int m = 0; m < 4; ++m) _Pragma("unroll") for (int k = 0; k < 2; ++k) dst[m][k] = *(const PG8_LAS bf16x8*)(lds + PG8_SA(b, h) + aoff + m * 2048 + k * 1024); } while (0)
#define PG8_LDB(dst, b, h) do { _Pragma("unroll") for (int n = 0; n < 2; ++n) _Pragma("unroll") for (int k = 0; k < 2; ++k) dst[n][k] = *(const PG8_LAS bf16x8*)(lds + PG8_SB(b, h) + boff + n * 2048 + k * 1024); } while (0)
#define PG8_MMA(ai, bj, At, Bt) do { __builtin_amdgcn_s_setprio(1); _Pragma("unroll") for (int m = 0; m < 4; ++m) _Pragma("unroll") for (int n = 0; n < 2; ++n) _Pragma("unroll") for (int k = 0; k < 2; ++k) \
        acc[ai][bj][m][n] = __builtin_amdgcn_mfma_f32_16x16x32_bf16(Bt[n][k], At[m][k], acc[ai][bj][m][n], 0, 0, 0); __builtin_amdgcn_s_setprio(0); } while (0)
#define PG8_WAIT_V(n) asm volatile("s_waitcnt vmcnt(" #n ")" ::: "memory")
#define PG8_WAIT_L(n) asm volatile("s_waitcnt lgkmcnt(" #n ")" ::: "memory")
#define PG8_BAR __builtin_amdgcn_s_barrier()
#define PG8_SCHED __builtin_amdgcn_sched_barrier(0)
    Unit cur, nxt; int ui = 0;
    if (!S.next(0, cur)) return;
    f32x4 acc[2][2][4][2];
#pragma unroll
    for (int a = 0; a < 2; ++a)
#pragma unroll
        for (int b = 0; b < 2; ++b)
#pragma unroll
            for (int m = 0; m < 4; ++m)
#pragma unroll
                for (int n = 0; n < 2; ++n) acc[a][b][m][n] = (f32x4){0.f, 0.f, 0.f, 0.f};
    bf16x8 At[4][2], B0[2][2], B1[2][2];
    const char* cA = (const char*)g.A + (size_t)cur.pm * tstepA; const char* cB = (const char*)g.Bt + (size_t)cur.pn * tstepB;
    PG8_STAGE(PG8_SB(0, 0), cB, voffB); PG8_STAGE(PG8_SB(0, 1), cB + hstepB, voffB); PG8_STAGE(PG8_SA(0, 0), cA, voffA); PG8_STAGE(PG8_SA(0, 1), cA + hstepA, voffA);
    if (wr == 1) PG8_BAR;
    PG8_WAIT_V(2); PG8_BAR;
    PG8_STAGE(PG8_SB(1, 0), cB + kstep, voffB); PG8_STAGE(PG8_SA(1, 0), cA + kstep, voffA); PG8_STAGE(PG8_SB(1, 1), cB + hstepB + kstep, voffB);
    PG8_WAIT_V(6); PG8_BAR;
    for (;;) {
        const bool has_next = S.next(ui + 1, nxt);
        const char* nA = has_next ? (const char*)g.A + (size_t)nxt.pm * tstepA : cA; const char* nB = has_next ? (const char*)g.Bt + (size_t)nxt.pn * tstepB : cB;
#pragma unroll 1
        for (int t = 0; t < nt; t += 2) {
            const bool last = (t == nt - 2);
            const char* a1 = cA + (size_t)(t + 1) * kstep;
            const char* a2 = last ? nA : cA + (size_t)(t + 2) * kstep; const char* b2 = last ? nB : cB + (size_t)(t + 2) * kstep;
            const char* a3 = a2 + kstep; const char* b3 = b2 + kstep;
            PG8_LDB(B0, 0, 0); PG8_LDB(B1, 0, 1); PG8_SCHED; PG8_LDA(At, 0, 0); PG8_STAGE(PG8_SA(1, 1), a1 + hstepA, voffA);
            PG8_WAIT_V(8); PG8_WAIT_L(0); PG8_BAR; PG8_MMA(0, 0, At, B0); PG8_MMA(0, 1, At, B1); PG8_BAR; PG8_SCHED;
            PG8_LDA(At, 0, 1); PG8_STAGE(PG8_SB(0, 0), b2, voffB); PG8_STAGE(PG8_SB(0, 1), b2 + hstepB, voffB); PG8_STAGE(PG8_SA(0, 0), a2, voffA);
            PG8_WAIT_V(8); PG8_WAIT_L(0); PG8_BAR; PG8_MMA(1, 0, At, B0); PG8_MMA(1, 1, At, B1); PG8_BAR; PG8_SCHED;
            PG8_LDB(B0, 1, 0); PG8_LDB(B1, 1, 1); PG8_SCHED; PG8_LDA(At, 1, 0); PG8_STAGE(PG8_SA(0, 1), a2 + hstepA, voffA);
            PG8_WAIT_V(8); PG8_WAIT_L(0); PG8_BAR; PG8_MMA(0, 0, At, B0); PG8_MMA(0, 1, At, B1); PG8_BAR; PG8_SCHED;
            PG8_LDA(At, 1, 1); PG8_STAGE(PG8_SB(1, 0), b3, voffB); PG8_STAGE(PG8_SB(1, 1), b3 + hstepB, voffB); PG8_STAGE(PG8_SA(1, 0), a3, voffA);
            PG8_WAIT_V(8); PG8_WAIT_L(0); PG8_BAR; PG8_MMA(1, 0, At, B0); PG8_MMA(1, 1, At, B1); PG8_BAR; PG8_SCHED;
        }
        if constexpr (ALIGN_EPI) { if (wr == 0) PG8_BAR; }
        E(acc, cur, wr, wc, fr, fq);
        if (!has_next) break;
#pragma unroll
        for (int a = 0; a < 2; ++a)
#pragma unroll
            for (int b = 0; b < 2; ++b)
#pragma unroll
                for (int m = 0; m < 4; ++m)
#pragma unroll
                    for (int n = 0; n < 2; ++n) acc[a][b][m][n] = (f32x4){0.f, 0.f, 0.f, 0.f};
        cur = nxt; cA = nA; cB = nB; ++ui;
        if constexpr (ALIGN_EPI) { if (wr == 1) PG8_BAR; }
    }
    PG8_WAIT_V(0);
    if constexpr (!ALIGN_EPI) { if (wr == 0) PG8_BAR; }
    PG8_BAR;
#undef PG8_SA
#undef PG8_SB
#undef PG8_STAGE
#undef PG8_LDA
#undef PG8_LDB
#undef PG8_MMA
#undef PG8_WAIT_V
#undef PG8_WAIT_L
#undef PG8_BAR
#undef PG8_SCHED
}
}

constexpr int NWAVES = 8;
constexpr int DM = 1024, NB = 16, SEQ = 2048, CTXL = 256;
constexpr int M = NB * SEQ, MC = NB * CTXL, MT = M + MC;
constexpr int QL = 384, KVL = 256, ROPE = 32, HW = 512, NH = 8, QKD = 96, VD = 64;
constexpr int INW = 3232, INP = 3328;
constexpr int DFF = 2816, NE = 8, DFE = 3584, NMOD = 6 * DM;
constexpr int NHH = 4, HK = 128; constexpr int NKEY = SEQ + CTXL;
constexpr float EPS = 1e-6f;
constexpr int MAXT = 296;
constexpr int MOE_CH = 128;

constexpr size_t MiB = 1u << 20;
constexpr size_t WS_CTL = 0, CTL_ZERO_BYTES = 1 * MiB;
constexpr size_t WS_MODV = 1 * MiB;
constexpr size_t WS_ROPE = 3 * MiB;
constexpr size_t WS_LB = 3 * MiB + 32 * 1024;
constexpr size_t WS_CNT = 3 * MiB + 64 * 1024;
constexpr size_t WS_TST = 3 * MiB + 128 * 1024;
constexpr size_t WS_EIDX = 4 * MiB, WS_GATE = 4 * MiB + 512 * 1024, WS_POS = 5 * MiB;
constexpr size_t WS_RSQ = 6 * MiB, WS_RSKV = 7 * MiB + 256 * 1024;
constexpr size_t WS_WIN = 8 * MiB, WS_WUQ = 21 * MiB, WS_WUKV = 23 * MiB, WS_WOUT = 24 * MiB, WS_WGU = 28 * MiB, WS_WDN = 50 * MiB, WS_WPOOL = 61 * MiB;
constexpr size_t WS_HB = 62 * MiB;
constexpr size_t WS_U = 134 * MiB;
constexpr size_t WS_X = 206 * MiB;
constexpr size_t WS_CQ = WS_X, WS_CKV = 233 * MiB, WS_KRR = 251 * MiB, WS_HQ = 254 * MiB  ;
constexpr size_t WS_QB = 434 * MiB, WS_KN = 488 * MiB, WS_VV = 524 * MiB, WS_OF = 560 * MiB, WS_OB = 632 * MiB, WS_MIX = 704 * MiB, WS_HID = WS_X;
constexpr size_t WS_MWGU = WS_X, WS_MWDN = 318 * MiB, WS_VG = 374 * MiB, WS_POOLED = WS_VG  , WS_HIDM = 522 * MiB, WS_END = 970 * MiB;
constexpr size_t HSEG = (size_t)MT * HW;
static_assert(WS_WPOOL + (size_t)2 * 4 * 65536 * 2 <= WS_HB && WS_HB + (size_t)MT * DM * 2 <= WS_U && WS_U + (size_t)MT * DM * 2 <= WS_X && WS_KRR + (size_t)MT * ROPE * 2 <= WS_HQ && WS_HQ + 5 * HSEG * 2 <= WS_QB && WS_MIX + (size_t)MT * DM * 2 <= WS_END && WS_HID + (size_t)MT * DFF * 2 <= WS_QB, "ws map even");
static_assert(WS_HIDM + (size_t)2 * MOE_CH * 256 * DFE * 2 <= WS_END && WS_VG + (size_t)MAXT * 256 * DM * 2 <= WS_HIDM && WS_MWDN + (size_t)NE * DM * DFE * 2 <= WS_VG && WS_MWGU + (size_t)NE * 2 * DFE * DM * 2 <= WS_MWDN, "ws map odd");
constexpr int CW_BAR = 4096;

constexpr int RING_OFF = 0, RING_BYTES = 143360;
constexpr int LDSCTL_OFF = RING_BYTES, MISC_OFF = LDSCTL_OFF + 320;
constexpr int LDS_BYTES = 147456;

#define GAS __attribute__((address_space(1)))
#define LAS __attribute__((address_space(3)))
typedef unsigned short bf16;
typedef unsigned v4u __attribute__((ext_vector_type(4)));
typedef unsigned v2u __attribute__((ext_vector_type(2)));
typedef float f32x4 __attribute__((ext_vector_type(4)));
typedef GAS unsigned gu32;
#define RLX_AGENT __ATOMIC_RELAXED, __HIP_MEMORY_SCOPE_AGENT
#define LDS_WAIT() asm volatile("s_waitcnt lgkmcnt(0)" ::: "memory")
__device__ __forceinline__ unsigned f2bf(float f) { unsigned u = __builtin_bit_cast(unsigned, f); return (u + 0x7fffu + ((u >> 16) & 1u)) >> 16; }
__device__ __forceinline__ unsigned pk2(float lo, float hi) { return f2bf(lo) | (f2bf(hi) << 16); }
__device__ __forceinline__ float bf2f(unsigned short b) { return __uint_as_float((unsigned)b << 16); }
__device__ __forceinline__ float bflo(unsigned w) { return __uint_as_float(w << 16); }
__device__ __forceinline__ float bfhi(unsigned w) { return __uint_as_float(w & 0xffff0000u); }
__device__ __forceinline__ float sigmoidf_(float x) { return 1.0f / (1.0f + __expf(-x)); }
__device__ __forceinline__ float siluf_(float x) { return x * __builtin_amdgcn_rcpf(1.0f + __expf(-x)); }

#define XB_TMO      128
#define XB_XCNT(j)  (256  + 64 * (j))
#define XB_XSUB(j)  (1280 + 64 * (j))
#define XB_XGEN(j)  (2304 + 64 * (j))
#define XB_TOP      3328
#define XB_TOPGEN   3392
#define XCD_BAR_WORDS 3456
#define XB_SPIN_CAP (1u << 22)
__device__ __forceinline__ unsigned xb_ld(unsigned* p)              { return __hip_atomic_load(p, __ATOMIC_RELAXED, __HIP_MEMORY_SCOPE_AGENT); }
__device__ __forceinline__ unsigned xb_add(unsigned* p, unsigned v) { return __hip_atomic_fetch_add(p, v, __ATOMIC_RELAXED, __HIP_MEMORY_SCOPE_AGENT); }
__device__ __forceinline__ unsigned xb_xcc_id() { return (unsigned)__builtin_amdgcn_s_getreg((3 << 11) | 20) & 0xFu; }
#define XB_SPIN(cond, bar) do { unsigned _sp = 0; while (cond) { __builtin_amdgcn_s_sleep(1); \
    if ((++_sp & 255u) == 0u) { if (xb_ld(&(bar)[XB_TMO])) break; if (_sp > XB_SPIN_CAP) { atomicAdd(&(bar)[XB_TMO], 1u); break; } } } } while (0)
struct XcdBarrier { unsigned* bar; unsigned x; volatile LAS unsigned* st; int wave; };
__device__ __forceinline__ bool xb_leader(int wave) { return wave == 0 && lane_now() == 0; }
__device__ __forceinline__ XcdBarrier xcd_barrier_post(unsigned* bar, volatile LAS unsigned* st, int wave) {
    XcdBarrier b; b.bar = bar; b.x = xb_xcc_id(); b.st = st; b.wave = wave;
    if (xb_leader(wave)) (void)xb_add(&bar[XB_XCNT(b.x)], 1u);
    return b;
}
__device__ __forceinline__ void xcd_barrier_complete(unsigned* bar, unsigned x, unsigned& nloc, unsigned& nx) {
    const unsigned G = gridDim.x * gridDim.y * gridDim.z;
    unsigned sum, cnt, mine, sp = 0u;
    for (;;) {
        sum = 0u; cnt = 0u; mine = 0u;
#pragma unroll
        for (unsigned j = 0; j < 16; ++j) { const unsigned c = xb_ld(&bar[XB_XCNT(j)]); sum += c; cnt += (c > 0u) ? 1u : 0u; mine = (j == x) ? c : mine; }
        if (sum == G) break;
        __builtin_amdgcn_s_sleep(1);
        if ((++sp & 255u) == 0u) { if (xb_ld(&bar[XB_TMO])) break; if (sp > XB_SPIN_CAP) { atomicAdd(&bar[XB_TMO], 1u); break; } }
    }
    nloc = mine > 0u ? mine : 1u; nx = cnt > 0u ? cnt : 1u;
}
__device__ __forceinline__ void xcd_barrier(const XcdBarrier& b) {
    asm volatile("s_waitcnt vmcnt(0)" ::: "memory");
    __syncthreads();
    if (xb_leader(b.wave)) {
        unsigned* bar = b.bar; asm volatile("" : "+s"(bar));
        __builtin_amdgcn_s_waitcnt(0);
        unsigned nloc = b.st[0], nx = b.st[1];
        if (nloc == 0u) { xcd_barrier_complete(bar, b.x, nloc, nx); b.st[0] = nloc; b.st[1] = nx; }
        const unsigned old = xb_add(&bar[XB_XSUB(b.x)], 1u);
        const unsigned gen = old / nloc;
        if (old + 1u == (gen + 1u) * nloc) {
            __builtin_amdgcn_fence(__ATOMIC_RELEASE, "agent");
            asm volatile("s_waitcnt vmcnt(0)" ::: "memory");
            const unsigned og = xb_add(&bar[XB_TOP], 1u);
            const unsigned tg = og / nx;
            if (og + 1u == (tg + 1u) * nx) xb_add(&bar[XB_TOPGEN], 1u);
            else XB_SPIN(xb_ld(&bar[XB_TOPGEN]) == tg, bar);
            __builtin_amdgcn_fence(__ATOMIC_ACQUIRE, "agent");
            xb_add(&bar[XB_XGEN(b.x)], 1u);
            asm volatile("s_waitcnt vmcnt(0)" ::: "memory");
        } else {
            XB_SPIN(xb_ld(&bar[XB_XGEN(b.x)]) == gen, bar);
            __builtin_amdgcn_fence(__ATOMIC_ACQUIRE, "agent");
            asm volatile("s_waitcnt vmcnt(0)" ::: "memory");
        }
    }
    __syncthreads();
}

struct Args { const float* in[26]; float* out; unsigned char* ws; };
struct Frame {
    LAS unsigned char* lds;
    int tid, lane, wave, G, vcu;
    const float* const* in; float* out; unsigned char* ws;
};
__device__ __forceinline__ float shx(float v, int lane, int m) { return __int_as_float(__builtin_amdgcn_ds_bpermute((lane ^ m) << 2, __float_as_int(v))); }
__device__ __forceinline__ float wave_sum(float v, int lane) {
#pragma unroll
    for (int o = 1; o < 64; o <<= 1) v += shx(v, lane, o);
    return v;
}

__device__ __forceinline__ void fresh(Frame& F) { const int l = lane_now(); F.lane = l; F.tid = F.wave * 64 + l; }

__device__ __forceinline__ void conv_item(const float* W, int ldw, bf16* WT, int ldd, int k0, int n0, int drow0, const float* kscale, float gscale, LAS float* scr, int lane) {
    float wv[32];
#pragma unroll
    for (int i = 0; i < 32; ++i) { const int kk = 2 * i + (lane >> 5); wv[i] = W[(size_t)(k0 + kk) * ldw + n0 + (lane & 31)]; }
#pragma unroll
    for (int i = 0; i < 32; ++i) { const int kk = 2 * i + (lane >> 5); float w = wv[i]; if (kscale) w *= kscale[k0 + kk]; scr[kk * 33 + (lane & 31)] = w * gscale; }
    LDS_WAIT(); asm volatile("" ::: "memory");
    const int c = lane & 7;
#pragma unroll
    for (int j = 0; j < 4; ++j) { const int n = (lane >> 3) + 8 * j; const LAS float* s = scr + (8 * c) * 33 + n;
        v4u o; o.x = pk2(s[0 * 33], s[1 * 33]); o.y = pk2(s[2 * 33], s[3 * 33]); o.z = pk2(s[4 * 33], s[5 * 33]); o.w = pk2(s[6 * 33], s[7 * 33]);
        *(v4u*)(WT + (size_t)(drow0 + n) * ldd + k0 + 8 * c) = o; }
    LDS_WAIT(); asm volatile("" ::: "memory");
}
__device__ __forceinline__ int conv_rowmap(int mode, int n0, int off) {
    if (mode == 0) return n0 + off;
    if (mode == 1) { if (n0 < 384) return n0; if (n0 < 640) return 512 + (n0 - 384); if (n0 < 672) return 384; return 768 + (n0 - 672); }
    return 256 * (n0 >> 7) + (n0 & 127) + off;
}
__device__ __forceinline__ void conv_matrix(Frame& F, const float* W, int K, int N, bf16* WT, int ldd, int mode, int off, const float* kscale, float gscale) {
    LAS float* scr = (LAS float*)(F.lds + RING_OFF + F.wave * 16384);
    const int gw = F.vcu * NWAVES + F.wave, NGW = F.G * NWAVES;
    const int nblk = N / 32, nitems = (K / 64) * nblk;
    for (int it = gw; it < nitems; it += NGW) { const int kb = it / nblk, nb = it % nblk; conv_item(W, N, WT, ldd, 64 * kb, 32 * nb, conv_rowmap(mode, 32 * nb, off), kscale, gscale, scr, F.lane); }
}

__device__ __forceinline__ int row_bidx(int row) { return row < M ? row / SEQ : NB; }

struct RowArgs {
    const float* xin_l; const float* xin_c;
    const bf16* hb; bf16* hbo;
    float* fout;
    const float* g;
    const float* modl;
    int shoff, scoff;
    bf16* U;
    const bf16* Y; const int* pos; const float* gate; const float* modprev;
    const float* router; int* eidx; float* gout; int* cnt;
};
template <bool COMBINE, int OUTMODE, bool ROUTER, bool INF32>
__device__ __forceinline__ void row_phase(Frame& F, const RowArgs& A, int nrows) {
    fresh(F);
    const int rpw = (nrows + F.G - 1) / F.G;
    LAS int* lcnt = (LAS int*)(F.lds + RING_OFF);
    if (ROUTER) { if (F.tid < 8) lcnt[F.tid] = 0; __syncthreads(); }
    const int rbase = (int)blockIdx.x * rpw, rend = (rbase + rpw < nrows) ? rbase + rpw : nrows;
#define ROWLOAD(dst, r_) do { if (INF32) { const float* hr_ = ((r_) < M) ? A.xin_l + (size_t)(r_) * DM : A.xin_c + (size_t)((r_) - M) * DM; \
            _Pragma("unroll") for (int j = 0; j < 4; ++j) dst[j] = *(const f32x4*)(hr_ + 4 * F.lane + 256 * j); } \
        else { _Pragma("unroll") for (int j = 0; j < 4; ++j) { const v2u w_ = *(const v2u*)(A.hb + (size_t)(r_) * DM + 4 * F.lane + 256 * j); dst[j] = (f32x4){bflo(w_.x), bfhi(w_.x), bflo(w_.y), bfhi(w_.y)}; } } } while (0)
    f32x4 rw[16][2];
    if (ROUTER) {
#pragma unroll
        for (int j = 0; j < 4; ++j)
#pragma unroll
            for (int q = 0; q < 4; ++q) { const int col = 4 * F.lane + 256 * j + q; rw[4 * j + q][0] = *(const f32x4*)(A.router + (size_t)col * 8); rw[4 * j + q][1] = *(const f32x4*)(A.router + (size_t)col * 8 + 4); }
    }
    int row = rbase + F.wave;
    f32x4 v[4], vn[4];
    if (row < rend) ROWLOAD(v, row);
    for (; row < rend; row += NWAVES) {
        const bool lat = row < M; const int bidx = lat ? row / SEQ : NB;
        const int rnext = row + NWAVES;
        if (rnext < rend) ROWLOAD(vn, rnext);
        if (COMBINE) {
            const int pa = A.pos[2 * row], pb = A.pos[2 * row + 1]; const float ga = A.gate[2 * row], gb = A.gate[2 * row + 1];
            const float* g2 = A.modprev + bidx * NMOD + 5 * DM;
#pragma unroll
            for (int j = 0; j < 4; ++j) { const int col = 4 * F.lane + 256 * j;
                const v2u ya = *(const v2u*)(A.Y + (size_t)pa * DM + col), yb = *(const v2u*)(A.Y + (size_t)pb * DM + col); const f32x4 gv = *(const f32x4*)(g2 + col);
                v[j].x += gv.x * (ga * bflo(ya.x) + gb * bflo(yb.x)); v[j].y += gv.y * (ga * bfhi(ya.x) + gb * bfhi(yb.x));
                v[j].z += gv.z * (ga * bflo(ya.y) + gb * bflo(yb.y)); v[j].w += gv.w * (ga * bfhi(ya.y) + gb * bfhi(yb.y)); }
            if (OUTMODE != 2) {
#pragma unroll
                for (int j = 0; j < 4; ++j) { v2u o; o.x = pg8::cvt_pk_bf16(v[j].x, v[j].y); o.y = pg8::cvt_pk_bf16(v[j].z, v[j].w); *(v2u*)(A.hbo + (size_t)row * DM + 4 * F.lane + 256 * j) = o;
                    v[j] = (f32x4){bflo(o.x), bfhi(o.x), bflo(o.y), bfhi(o.y)}; }
            }
        }
        float s = 0.f;
#pragma unroll
        for (int j = 0; j < 4; ++j) s += (v[j].x * v[j].x + v[j].y * v[j].y) + (v[j].z * v[j].z + v[j].w * v[j].w);
        const float rstd = rsqrtf(wave_sum(s, F.lane) * (1.0f / DM) + EPS);
        if (OUTMODE == 2) {
            float* ho = A.fout + (size_t)row * DM;
#pragma unroll
            for (int j = 0; j < 4; ++j) { const int col = 4 * F.lane + 256 * j; const f32x4 gv = *(const f32x4*)(A.g + col); *(f32x4*)(ho + col) = v[j] * rstd * gv; }
        } else {
            const float* sh = A.modl + bidx * NMOD + A.shoff; const float* sc = A.modl + bidx * NMOD + A.scoff;
            float lg[8];
            if (ROUTER) {
#pragma unroll
                for (int e = 0; e < 8; ++e) lg[e] = 0.f;
            }
#pragma unroll
            for (int j = 0; j < 4; ++j) { const int col = 4 * F.lane + 256 * j; const f32x4 gv = *(const f32x4*)(A.g + col), shv = *(const f32x4*)(sh + col), scv = *(const f32x4*)(sc + col);
                f32x4 y = v[j] * rstd * gv * (scv + 1.0f) + shv;
                v2u o; o.x = pg8::cvt_pk_bf16(y.x, y.y); o.y = pg8::cvt_pk_bf16(y.z, y.w); *(v2u*)(A.U + (size_t)row * DM + col) = o;
                if (ROUTER) {
#pragma unroll
                    for (int q = 0; q < 4; ++q) { const f32x4 r0 = rw[4 * j + q][0], r1 = rw[4 * j + q][1]; const float yy = y[q];
                        lg[0] += yy * r0.x; lg[1] += yy * r0.y; lg[2] += yy * r0.z; lg[3] += yy * r0.w; lg[4] += yy * r1.x; lg[5] += yy * r1.y; lg[6] += yy * r1.z; lg[7] += yy * r1.w; } }
            }
            if (ROUTER) {
                const int b5 = F.lane >> 5, b4 = (F.lane >> 4) & 1, b3 = (F.lane >> 3) & 1; float a4[4], c2[2];
#pragma unroll
                for (int q = 0; q < 4; ++q) { const float mine = b5 ? lg[4 + q] : lg[q], oth = b5 ? lg[q] : lg[4 + q]; a4[q] = mine + shx(oth, F.lane, 32); }
#pragma unroll
                for (int q = 0; q < 2; ++q) { const float mine = b4 ? a4[2 + q] : a4[q], oth = b4 ? a4[q] : a4[2 + q]; c2[q] = mine + shx(oth, F.lane, 16); }
                float d1 = (b3 ? c2[1] : c2[0]) + shx(b3 ? c2[0] : c2[1], F.lane, 8);
                d1 += shx(d1, F.lane, 4); d1 += shx(d1, F.lane, 2); d1 += shx(d1, F.lane, 1);
#pragma unroll
                for (int e = 0; e < 8; ++e) lg[e] = __int_as_float(__builtin_amdgcn_readlane(__float_as_int(d1), 8 * e));
                int i0 = 0; float v0 = lg[0];
#pragma unroll
                for (int e = 1; e < 8; ++e) if (lg[e] > v0) { v0 = lg[e]; i0 = e; }
                int i1 = -1; float v1 = -INFINITY;
#pragma unroll
                for (int e = 0; e < 8; ++e) if (e != i0 && lg[e] > v1) { v1 = lg[e]; i1 = e; }
                const float g0 = 1.0f / (1.0f + __expf(v1 - v0));
                if (F.lane == 0) { A.eidx[2 * row] = i0; A.eidx[2 * row + 1] = i1; A.gout[2 * row] = g0; A.gout[2 * row + 1] = 1.0f - g0; atomicAdd((int*)&lcnt[i0], 1); atomicAdd((int*)&lcnt[i1], 1); }
            }
        }
#pragma unroll
        for (int j = 0; j < 4; ++j) v[j] = vn[j];
    }
#undef ROWLOAD
    if (ROUTER) { __syncthreads(); if (F.tid < 8) A.cnt[blockIdx.x * 8 + F.tid] = lcnt[F.tid]; __syncthreads(); }
}

using pg8::Unit; using pg8::cvt_pk_bf16;
__device__ __forceinline__ v4u pack8(const f32x4& a, const f32x4& b) { v4u w; w.x = cvt_pk_bf16(a[0], a[1]); w.y = cvt_pk_bf16(a[2], a[3]); w.z = cvt_pk_bf16(b[0], b[1]); w.w = cvt_pk_bf16(b[2], b[3]); return w; }
struct EpiIn {
    static constexpr bool PERM = true;
    bf16 *CQ, *KRR, *CKV, *H5; float* ssq_q; float* ssq_kv; const float* TC; const float* LBj; int jlayer;
    __device__ __forceinline__ void operator()(const f32x4 (&acc)[2][2][4][2], const Unit& u, int wr, int wc, int fr, int fq) const {
        const int row0 = u.pm * 256 + wr * 64 + fr; const int lane = fr + 16 * fq;
#pragma unroll
        for (int bj = 0; bj < 2; ++bj) {
            const int col = u.pn * 256 + bj * 128 + wc * 32 + 8 * fq;
            bf16* base; int ld;
            if (col < 384) { base = CQ + col; ld = QL; }
            else if (col < 512) { base = nullptr; ld = 0; }
            else if (col < 768) { base = CKV + (col - 512); ld = KVL; }
            else { const int c2 = col - 768; base = H5 + (size_t)(c2 >> 9) * HSEG + (c2 & 511); ld = HW; }
            const int hsel = (col >= 768) ? ((col - 768) >> 9) : 3;
            if (hsel <= 2) {
                f32x4 lb0 = (f32x4){0.f, 0.f, 0.f, 0.f}, lb1 = lb0; if (hsel >= 1 && jlayer == 1) { const float* l0_ = LBj + (hsel - 1) * HW + ((col - 768) & 511); const float* l1_ = l0_ + 2 * HW; const f32x4 a0 = *(const f32x4*)l0_, a1 = *(const f32x4*)(l0_ + 4), b0 = *(const f32x4*)l1_, b1 = *(const f32x4*)(l1_ + 4);
#pragma unroll
                    for (int q = 0; q < 4; ++q) { lb0[q] = 1.0f / (1.0f + __expf(a0[q] - b0[q])); lb1[q] = 1.0f / (1.0f + __expf(a1[q] - b1[q])); } }
#pragma unroll
                for (int ai = 0; ai < 2; ++ai)
#pragma unroll
                    for (int m = 0; m < 4; ++m) { const int row = row0 + ai * 128 + m * 16; f32x4 o[2];
#pragma unroll
                        for (int n = 0; n < 2; ++n)
#pragma unroll
                            for (int q = 0; q < 4; ++q) { const float x = acc[ai][bj][m][n][q]; const float sg = __builtin_amdgcn_rcpf(1.0f + __expf(-x)); const float lbv = n ? lb1[q] : lb0[q];
                                o[n][q] = (hsel == 0) ? x * sg : __logf(lbv + (1.0f - lbv) * sg); }
                        *(v4u*)(base + (size_t)row * ld) = pack8(o[0], o[1]); }
            } else if (base) {
#pragma unroll
                for (int ai = 0; ai < 2; ++ai)
#pragma unroll
                    for (int m = 0; m < 4; ++m) { const int row = row0 + ai * 128 + m * 16; *(v4u*)(base + (size_t)row * ld) = pack8(acc[ai][bj][m][0], acc[ai][bj][m][1]); }
            }
        }
        if (u.pn <= 2) {
            const int nb = (u.pn == 1) ? 1 : 2; float* dst = (u.pn == 2) ? ssq_kv : ssq_q;
#pragma unroll
            for (int ai = 0; ai < 2; ++ai)
#pragma unroll
                for (int m = 0; m < 4; ++m) { float ss = 0.f;
#pragma unroll
                    for (int bj = 0; bj < 2; ++bj) if (bj < nb) {
#pragma unroll
                        for (int n = 0; n < 2; ++n) { const f32x4 x = acc[ai][bj][m][n]; ss += (x[0] * x[0] + x[1] * x[1]) + (x[2] * x[2] + x[3] * x[3]); } }
                    ss += shx(ss, lane, 16); ss += shx(ss, lane, 32);
                    if (fq == 0) { const int row = row0 + ai * 128 + m * 16; if (u.pn == 2) dst[row * 4 + wc] = ss; else dst[row * 8 + u.pn * 4 + wc] = ss; } }
            if (u.pn == 1 && wc == 0) {
                const int a = fq >> 1, half = fq & 1;
#pragma unroll
                for (int ai = 0; ai < 2; ++ai)
#pragma unroll
                    for (int m = 0; m < 4; ++m) { const int row = row0 + ai * 128 + m * 16; f32x4 o[2];
                        const bool lat = row < M; const int t = row % SEQ; const int p = a ? (t & 63) : (t >> 6);
#pragma unroll
                        for (int n = 0; n < 2; ++n)
#pragma unroll
                            for (int q = 0; q < 4; ++q) { const float x = acc[ai][1][m][n][q]; const float pr = shx(x, lane, 16); const float c = TC[p * 8 + 4 * n + q], sn = TC[512 + p * 8 + 4 * n + q];
                                o[n][q] = lat ? (half ? x * c + pr * sn : x * c - pr * sn) : x; }
                        *(v4u*)(KRR + (size_t)row * ROPE + 8 * fq) = pack8(o[0], o[1]); }
            }
        }
    }
};
struct EpiQ {
    static constexpr bool PERM = true;
    bf16* O; const float* rs;
    __device__ __forceinline__ void operator()(const f32x4 (&acc)[2][2][4][2], const Unit& u, int wr, int wc, int fr, int fq) const {
        const int row0 = u.pm * 256 + wr * 64 + fr;
#pragma unroll
        for (int ai = 0; ai < 2; ++ai)
#pragma unroll
            for (int m = 0; m < 4; ++m) { const int row = row0 + ai * 128 + m * 16; const f32x4 p0 = *(const f32x4*)(rs + (size_t)row * 8), p1 = *(const f32x4*)(rs + (size_t)row * 8 + 4); const float sc = rsqrtf((((p0.x + p0.y) + (p0.z + p0.w)) + ((p1.x + p1.y) + (p1.z + p1.w))) * (1.0f / QL) + EPS);
#pragma unroll
                for (int bj = 0; bj < 2; ++bj) { const int col = u.pn * 256 + bj * 128 + wc * 32 + 8 * fq; *(v4u*)(O + (size_t)row * 768 + col) = pack8(acc[ai][bj][m][0] * sc, acc[ai][bj][m][1] * sc); } }
    }
};
struct EpiKV {
    static constexpr bool PERM = true;
    bf16* KNp; bf16* VTp; const float* rs;
    __device__ __forceinline__ void operator()(const f32x4 (&acc)[2][2][4][2], const Unit& u, int wr, int wc, int fr, int fq) const {
        const int row0 = u.pm * 256 + wr * 64 + fr;
#pragma unroll
        for (int ai = 0; ai < 2; ++ai)
#pragma unroll
            for (int m = 0; m < 4; ++m) { const int row = row0 + ai * 128 + m * 16; const f32x4 p0 = *(const f32x4*)(rs + (size_t)row * 4); const float sc = rsqrtf(((p0.x + p0.y) + (p0.z + p0.w)) * (1.0f / KVL) + EPS);
                const bool lat = row < M; const int b = lat ? row / SEQ : (row - M) / CTXL; const int key = lat ? row % SEQ : SEQ + (row - M) % CTXL;
                const int kpos = (key & ~12) | ((key & 4) << 1) | ((key & 8) >> 1);
#pragma unroll
                for (int bj = 0; bj < 2; ++bj) { const int col = u.pn * 256 + bj * 128 + wc * 32 + 8 * fq; const int hh = col >> 7, w = col & 127;
                    if (w < 64) { *(v4u*)(KNp + (size_t)row * HW + hh * 64 + w) = pack8(acc[ai][bj][m][0] * sc, acc[ai][bj][m][1] * sc); }
                    else { bf16* dst = VTp + ((size_t)((b * NH + hh) * VD + (w - 64))) * NKEY + kpos;
#pragma unroll
                        for (int n = 0; n < 2; ++n)
#pragma unroll
                            for (int q = 0; q < 4; ++q) dst[(size_t)(4 * n + q) * NKEY] = (bf16)f2bf(acc[ai][bj][m][n][q] * sc); } } }
    }
};
template <bool INF32>
struct EpiResid {
    static constexpr bool PERM = true;
    const float* xin_l; const float* xin_c; bf16* hb; const float* modl; int goff;
    __device__ __forceinline__ void operator()(const f32x4 (&acc)[2][2][4][2], const Unit& u, int wr, int wc, int fr, int fq) const {
        const int rowt = u.pm * 256; const bool lat = rowt < M; const int bidx = lat ? rowt / SEQ : NB;
        const float* gate = modl + bidx * NMOD + goff;
        const float* xi = lat ? xin_l + (size_t)rowt * DM : xin_c + (size_t)(rowt - M) * DM;
        bf16* ho = hb + (size_t)rowt * DM;
        const unsigned off0 = (unsigned)((wr * 64 + fr) * DM + u.pn * 256 + wc * 32 + 8 * fq);
#pragma unroll
        for (int bj = 0; bj < 2; ++bj) { const f32x4 g0 = *(const f32x4*)(gate + (off0 & 1023u) + bj * 128), g1 = *(const f32x4*)(gate + (off0 & 1023u) + bj * 128 + 4);
#pragma unroll
            for (int ai = 0; ai < 2; ++ai) {
                if (INF32) { f32x4 h0[4], h1[4];
#pragma unroll
                    for (int m = 0; m < 4; ++m) { const unsigned off = off0 + (unsigned)((ai * 128 + m * 16) * DM + bj * 128); h0[m] = *(const f32x4*)(xi + off); h1[m] = *(const f32x4*)(xi + off + 4); }
#pragma unroll
                    for (int m = 0; m < 4; ++m) { const unsigned off = off0 + (unsigned)((ai * 128 + m * 16) * DM + bj * 128); *(v4u*)(ho + off) = pack8(h0[m] + g0 * acc[ai][bj][m][0], h1[m] + g1 * acc[ai][bj][m][1]); }
                } else { v4u hv[4];
#pragma unroll
                    for (int m = 0; m < 4; ++m) { const unsigned off = off0 + (unsigned)((ai * 128 + m * 16) * DM + bj * 128); hv[m] = *(const v4u*)(ho + off); }
#pragma unroll
                    for (int m = 0; m < 4; ++m) { const unsigned off = off0 + (unsigned)((ai * 128 + m * 16) * DM + bj * 128); const v4u w = hv[m];
                        const f32x4 a0 = (f32x4){bflo(w.x), bfhi(w.x), bflo(w.y), bfhi(w.y)}, a1 = (f32x4){bflo(w.z), bfhi(w.z), bflo(w.w), bfhi(w.w)};
                        *(v4u*)(ho + off) = pack8(a0 + g0 * acc[ai][bj][m][0], a1 + g1 * acc[ai][bj][m][1]); }
                }
                asm volatile("" ::: "memory"); } }
    }
};
struct EpiPool {
    static constexpr bool PERM = true;
    bf16* hb; const float* modl; const float* bias; const float* scale; int talloc;
    __device__ __forceinline__ void operator()(const f32x4 (&acc)[2][2][4][2], const Unit& u, int wr, int wc, int fr, int fq) const {
        const int g = u.pn, rowt = (u.pm - g * talloc) * 256; const bool lat = rowt < M; const int bidx = lat ? rowt / SEQ : NB;
        const float* gate = modl + bidx * NMOD + 2 * DM;
        bf16* ho = hb + (size_t)rowt * DM;
        const int col0 = g * 256 + wc * 32 + 8 * fq;
#pragma unroll
        for (int bj = 0; bj < 2; ++bj) { const int c = col0 + bj * 128;
            v4u hv[2][4];
#pragma unroll
            for (int ai = 0; ai < 2; ++ai)
#pragma unroll
                for (int m = 0; m < 4; ++m) hv[ai][m] = *(const v4u*)(ho + (size_t)(ai * 128 + wr * 64 + m * 16 + fr) * DM + c);
            const f32x4 gm0 = *(const f32x4*)(gate + c) * *(const f32x4*)(scale + c), gm1 = *(const f32x4*)(gate + c + 4) * *(const f32x4*)(scale + c + 4);
            const f32x4 gb0 = gm0 * *(const f32x4*)(bias + c), gb1 = gm1 * *(const f32x4*)(bias + c + 4);
#pragma unroll
            for (int ai = 0; ai < 2; ++ai)
#pragma unroll
                for (int m = 0; m < 4; ++m) { const v4u w = hv[ai][m]; const f32x4 a0 = (f32x4){bflo(w.x), bfhi(w.x), bflo(w.y), bfhi(w.y)}, a1 = (f32x4){bflo(w.z), bfhi(w.z), bflo(w.w), bfhi(w.w)};
                    *(v4u*)(ho + (size_t)(ai * 128 + wr * 64 + m * 16 + fr) * DM + c) = pack8(a0 + gm0 * acc[ai][bj][m][0] + gb0, a1 + gm1 * acc[ai][bj][m][1] + gb1); }
            asm volatile("" ::: "memory"); }
    }
};
struct EpiGateUp {
    static constexpr bool PERM = true;
    bf16* H; int ldh, nct, rowsub;
    __device__ __forceinline__ void operator()(const f32x4 (&acc)[2][2][4][2], const Unit& u, int wr, int wc, int fr, int fq) const {
        const int row0 = u.pm * 256 + wr * 64 + fr - rowsub; const int ct = u.pn % nct; const int col = ct * 128 + wc * 32 + 8 * fq;
#pragma unroll
        for (int ai = 0; ai < 2; ++ai)
#pragma unroll
            for (int m = 0; m < 4; ++m) { const int row = row0 + ai * 128 + m * 16; f32x4 o[2];
#pragma unroll
                for (int n = 0; n < 2; ++n)
#pragma unroll
                    for (int q = 0; q < 4; ++q) { const float gv = acc[ai][0][m][n][q], uv = acc[ai][1][m][n][q]; o[n][q] = gv * uv * __builtin_amdgcn_rcpf(1.0f + __expf(-gv)); }
                *(v4u*)(H + (size_t)row * ldh + col) = pack8(o[0], o[1]); }
    }
};
struct EpiY {
    static constexpr bool PERM = true;
    bf16* Y; int nct;
    __device__ __forceinline__ void operator()(const f32x4 (&acc)[2][2][4][2], const Unit& u, int wr, int wc, int fr, int fq) const {
        const int row0 = u.pm * 256 + wr * 64 + fr; const int ct = u.pn % nct;
#pragma unroll
        for (int ai = 0; ai < 2; ++ai)
#pragma unroll
            for (int m = 0; m < 4; ++m) { const int row = row0 + ai * 128 + m * 16;
#pragma unroll
                for (int bj = 0; bj < 2; ++bj) { const int col = ct * 256 + bj * 128 + wc * 32 + 8 * fq; *(v4u*)(Y + (size_t)row * DM + col) = pack8(acc[ai][bj][m][0], acc[ai][bj][m][1]); } }
    }
};

__device__ __forceinline__ void p0_prologue(Frame& F) {
    fresh(F);
    unsigned char* ws = F.ws;
    const float qscale = 0.10206207261596577f * 1.4426950408889634f;
    for (int j = 0; j < 2; ++j) {
        conv_matrix(F, F.in[8] + (size_t)j * DM * INW, DM, INW, (bf16*)(ws + WS_WIN) + (size_t)j * INP * DM, DM, 1, 0, nullptr, 1.f);
        conv_matrix(F, F.in[11] + (size_t)j * QL * 768, QL, 768, (bf16*)(ws + WS_WUQ) + (size_t)j * 768 * QL, QL, 0, 0, F.in[9] + j * QL, qscale);
        conv_matrix(F, F.in[12] + (size_t)j * KVL * 1024, KVL, 1024, (bf16*)(ws + WS_WUKV) + (size_t)j * 1024 * KVL, KVL, 0, 0, F.in[10] + j * KVL, 1.f);
        conv_matrix(F, F.in[15] + (size_t)j * DM * DM, DM, DM, (bf16*)(ws + WS_WOUT) + (size_t)j * DM * DM, DM, 0, 0, nullptr, 1.f);
        conv_matrix(F, F.in[16] + (size_t)j * DM * DFF, DM, DFF, (bf16*)(ws + WS_WGU) + (size_t)j * 2 * DFF * DM, DM, 2, 0, nullptr, 1.f);
        conv_matrix(F, F.in[17] + (size_t)j * DM * DFF, DM, DFF, (bf16*)(ws + WS_WGU) + (size_t)j * 2 * DFF * DM, DM, 2, 128, nullptr, 1.f);
        conv_matrix(F, F.in[18] + (size_t)j * DFF * DM, DFF, DM, (bf16*)(ws + WS_WDN) + (size_t)j * DM * DFF, DFF, 0, 0, nullptr, 1.f);
        for (int g = 0; g < 4; ++g)
            conv_matrix(F, F.in[19] + (size_t)(j * 4 + g) * 65536, 256, 256, (bf16*)(ws + WS_WPOOL) + (size_t)(j * 4 + g) * 65536, 256, 0, 0, nullptr, 1.f);
    }
    __syncthreads();
    if (blockIdx.x == 1) { float* LB = (float*)(ws + WS_LB); for (int i = F.tid; i < 2 * HW; i += 512) { const float l0 = F.in[13][i], l1 = F.in[13][2 * HW + i]; LB[i] = 0.f; LB[2 * HW + i] = 1.0f / (1.0f + __expf(l0 - l1)); } }
    if (blockIdx.x == 0 && F.tid < 8) {
        float* TC = (float*)(ws + WS_ROPE); float* TS = TC + 512;
        double th = 1.0; for (int i = 0; i < F.tid; ++i) th *= 0.31622776601683794;
        const double x2 = th * th; double s = th, c = 1.0, ts = th, tc = 1.0;
        for (int n = 1; n <= 12; ++n) { tc *= -x2 / (double)((2 * n - 1) * (2 * n)); c += tc; ts *= -x2 / (double)((2 * n) * (2 * n + 1)); s += ts; }
        double cp = 1.0, sp = 0.0;
        for (int p = 0; p < 64; ++p) { TC[p * 8 + F.tid] = (float)cp; TS[p * 8 + F.tid] = (float)sp; const double ncp = cp * c - sp * s; sp = sp * c + cp * s; cp = ncp; }
    }
    {
        LAS float* sc = (LAS float*)(F.lds + RING_OFF);
        LAS float* red = sc + 17 * 1024;
        const int nitems = 4 * (NMOD / 64);
        if ((int)blockIdx.x < nitems) {
            for (int e = F.tid; e < 17 * 1024; e += 512) { const int r = e >> 10, k = e & 1023; const float x = (r < 16) ? F.in[1][r * 1024 + k] : F.in[3][k]; sc[e] = siluf_(x); }
            __syncthreads();
            for (int it = blockIdx.x; it < nitems; it += F.G) {
                const int l = it / (NMOD / 64), c0 = (it % (NMOD / 64)) * 64;
                const float* W = F.in[4] + (size_t)l * DM * NMOD + c0 + F.lane;
                float acc[17];
#pragma unroll
                for (int r = 0; r < 17; ++r) acc[r] = 0.f;
                const int kb = F.wave * 128;
                for (int k = 0; k < 128; k += 4) {
                    const float w0 = W[(size_t)(kb + k) * NMOD], w1 = W[(size_t)(kb + k + 1) * NMOD], w2 = W[(size_t)(kb + k + 2) * NMOD], w3 = W[(size_t)(kb + k + 3) * NMOD];
#pragma unroll
                    for (int r = 0; r < 17; ++r) { const f32x4 s4 = *(const LAS f32x4*)(sc + r * 1024 + kb + k); acc[r] += s4.x * w0 + s4.y * w1 + s4.z * w2 + s4.w * w3; }
                }
#pragma unroll
                for (int r = 0; r < 17; ++r) red[(F.wave * 17 + r) * 64 + F.lane] = acc[r];
                __syncthreads();
                for (int o = F.tid; o < 17 * 64; o += 512) { const int r = o >> 6, cc = o & 63; float s = 0.f;
#pragma unroll
                    for (int w = 0; w < 8; ++w) s += red[(w * 17 + r) * 64 + cc];
                    ((float*)(ws + WS_MODV))[(size_t)(l * 17 + r) * NMOD + c0 + cc] = s + F.in[5][l * NMOD + c0 + cc]; }
                __syncthreads();
            }
        }
    }
}

typedef short bf16x8v __attribute__((ext_vector_type(8)));
typedef float f32x16 __attribute__((ext_vector_type(16)));
__device__ __forceinline__ void attn_unit(Frame& F, int b, int h, int qrow0, bool rope_q, int t_lo, int t_hi) {
    unsigned char* ws = F.ws;
    const bf16* QB = (const bf16*)(ws + WS_QB); const bf16* KN = (const bf16*)(ws + WS_KN); const bf16* KRR = (const bf16*)(ws + WS_KRR); const bf16* VT = (const bf16*)(ws + WS_VV);
    bf16* MIX = (bf16*)(ws + WS_MIX); const float* TC = (const float*)(ws + WS_ROPE); const float* TS = TC + 512;
    const int lane = F.lane, wave = F.wave, r32 = lane & 31, hi = lane >> 5;
    LAS unsigned char* ring = F.lds + RING_OFF;
    const int qrow = qrow0 + wave * 32 + r32;
    bf16x8v qr[6];
#pragma unroll
    for (int d0 = 0; d0 < 6; ++d0) qr[d0] = *(const bf16x8v*)(QB + (size_t)qrow * 768 + h * QKD + 16 * d0 + 8 * hi);
    if (rope_q) { const int t = qrow % SEQ;
#pragma unroll
        for (int a = 0; a < 2; ++a) { const int p = a ? (t & 63) : (t >> 6); const v4u w = __builtin_bit_cast(v4u, qr[4 + a]); float x[8], y[8];
            x[0] = bflo(w.x); x[1] = bfhi(w.x); x[2] = bflo(w.y); x[3] = bfhi(w.y); x[4] = bflo(w.z); x[5] = bfhi(w.z); x[6] = bflo(w.w); x[7] = bfhi(w.w);
#pragma unroll
            for (int jj = 0; jj < 8; ++jj) { const float pr = shx(x[jj], lane, 32); const float c = TC[p * 8 + jj], sn = TS[p * 8 + jj]; y[jj] = hi ? x[jj] * c + pr * sn : x[jj] * c - pr * sn; }
            v4u o; o.x = pk2(y[0], y[1]); o.y = pk2(y[2], y[3]); o.z = pk2(y[4], y[5]); o.w = pk2(y[6], y[7]); qr[4 + a] = __builtin_bit_cast(bf16x8v, o); } }
    const int bh = b * NH + h;
    const bf16* vsrc = VT + ((size_t)(bh * VD + lane)) * NKEY + 8 * wave;
#define ATT_DMA(t, buf) do { const int t_ = (t); const int r0_ = t_ < SEQ / 64 ? b * SEQ + 64 * t_ : M + b * CTXL + 64 * (t_ - SEQ / 64); \
        LAS unsigned char* kb_ = ring + (buf) * 20480; LAS unsigned char* vb_ = kb_ + 12288; \
        __builtin_amdgcn_global_load_lds((const unsigned*)(KN + (size_t)(r0_ + lane) * HW + h * 64 + 8 * wave), (LAS unsigned*)(kb_ + wave * 1024), 16, 0, 0); \
        __builtin_amdgcn_global_load_lds((const unsigned*)(KRR + (size_t)(r0_ + lane) * ROPE + 8 * (wave & 3)), (LAS unsigned*)(kb_ + (8 + (wave & 3)) * 1024), 16, 0, 0);     \
        __builtin_amdgcn_global_load_lds((const unsigned*)(vsrc + 64 * t_), (LAS unsigned*)(vb_ + wave * 1024), 16, 0, 0); } while (0)
    f32x16 o0, o1;
#pragma unroll
    for (int r = 0; r < 16; ++r) { o0[r] = 0.f; o1[r] = 0.f; }
    constexpr float ATT_THR = 8.0f;
    float m_run = 0.f, l_run = 0.f;
    asm volatile("s_waitcnt vmcnt(0)" ::: "memory");
    ATT_DMA(t_lo, 0); if (t_lo + 1 < t_hi) ATT_DMA(t_lo + 1, 1); if (t_lo + 2 < t_hi) ATT_DMA(t_lo + 2, 2);
    for (int t = t_lo; t < t_hi; ++t) {
        const int buf = (t - t_lo) & 3; const int rem = t_hi - 1 - t;
        if (rem >= 2) asm volatile("s_waitcnt vmcnt(6)" ::: "memory"); else if (rem == 1) asm volatile("s_waitcnt vmcnt(3)" ::: "memory"); else asm volatile("s_waitcnt vmcnt(0)" ::: "memory");
        asm volatile("s_waitcnt lgkmcnt(0)" ::: "memory"); __builtin_amdgcn_s_barrier(); asm volatile("" ::: "memory");
        if (t + 3 < t_hi) ATT_DMA(t + 3, (buf + 3) & 3);
        const LAS unsigned char* kb = ring + buf * 20480 + hi * 1024 + r32 * 16; const LAS unsigned char* vb = ring + buf * 20480 + 12288 + hi * 1024 + r32 * 16;
        bf16x8v kf[12], vf[8];
#pragma unroll
        for (int d0 = 0; d0 < 6; ++d0) { kf[2 * d0] = *(const LAS bf16x8v*)(kb + d0 * 2048); kf[2 * d0 + 1] = *(const LAS bf16x8v*)(kb + d0 * 2048 + 512); }
#pragma unroll
        for (int s4 = 0; s4 < 4; ++s4) { vf[2 * s4] = *(const LAS bf16x8v*)(vb + s4 * 2048); vf[2 * s4 + 1] = *(const LAS bf16x8v*)(vb + s4 * 2048 + 512); }
        f32x16 p0, p1; const float negm = -m_run;
#pragma unroll
        for (int r = 0; r < 16; ++r) { p0[r] = negm; p1[r] = negm; }
#pragma unroll
        for (int d0 = 0; d0 < 6; ++d0) { p0 = __builtin_amdgcn_mfma_f32_32x32x16_bf16(kf[2 * d0], qr[d0], p0, 0, 0, 0); p1 = __builtin_amdgcn_mfma_f32_32x32x16_bf16(kf[2 * d0 + 1], qr[d0], p1, 0, 0, 0); }
        float ma = __builtin_fmaxf(__builtin_fmaxf(p0[0], p0[1]), p1[0]), mb = __builtin_fmaxf(__builtin_fmaxf(p0[2], p0[3]), p1[1]); ma = __builtin_fmaxf(__builtin_fmaxf(ma, p1[2]), p1[3]);
#pragma unroll
        for (int r = 4; r < 16; r += 4) { ma = __builtin_fmaxf(__builtin_fmaxf(ma, p0[r]), p0[r + 1]); mb = __builtin_fmaxf(__builtin_fmaxf(mb, p0[r + 2]), p0[r + 3]); ma = __builtin_fmaxf(__builtin_fmaxf(ma, p1[r]), p1[r + 1]); mb = __builtin_fmaxf(__builtin_fmaxf(mb, p1[r + 2]), p1[r + 3]); }
        float mt = __builtin_fmaxf(ma, mb);
        { auto rr = __builtin_amdgcn_permlane32_swap(__float_as_uint(mt), __float_as_uint(mt), false, false); mt = __builtin_fmaxf(__uint_as_float(rr[0]), __uint_as_float(rr[1])); }
        const bool first = (t == t_lo);
        if (first || __any(mt > ATT_THR)) {
            const float dl = first ? mt : __builtin_fmaxf(mt, 0.f); m_run += dl; const float alpha = __builtin_amdgcn_exp2f(-dl); l_run *= alpha;
#pragma unroll
            for (int r = 0; r < 16; ++r) { p0[r] -= dl; p1[r] -= dl; o0[r] *= alpha; o1[r] *= alpha; }
        }
        float ps0 = 0.f, ps1 = 0.f;
#pragma unroll
        for (int r = 0; r < 16; ++r) { p0[r] = __builtin_amdgcn_exp2f(p0[r]); p1[r] = __builtin_amdgcn_exp2f(p1[r]); ps0 += p0[r]; ps1 += p1[r]; }
        l_run += ps0 + ps1;
        v4u pw[4];
#pragma unroll
        for (int q = 0; q < 4; ++q) { pw[0][q] = cvt_pk_bf16(p0[2 * q], p0[2 * q + 1]); pw[1][q] = cvt_pk_bf16(p0[8 + 2 * q], p0[8 + 2 * q + 1]); pw[2][q] = cvt_pk_bf16(p1[2 * q], p1[2 * q + 1]); pw[3][q] = cvt_pk_bf16(p1[8 + 2 * q], p1[8 + 2 * q + 1]); }
#pragma unroll
        for (int s4 = 0; s4 < 4; ++s4) { const bf16x8v pa = __builtin_bit_cast(bf16x8v, pw[s4]);
            o0 = __builtin_amdgcn_mfma_f32_32x32x16_bf16(vf[2 * s4], pa, o0, 0, 0, 0); o1 = __builtin_amdgcn_mfma_f32_32x32x16_bf16(vf[2 * s4 + 1], pa, o1, 0, 0, 0); }
    }
    { auto rr = __builtin_amdgcn_permlane32_swap(__float_as_uint(l_run), __float_as_uint(l_run), false, false); l_run = __uint_as_float(rr[0]) + __uint_as_float(rr[1]); }
    const float rl = 1.0f / l_run;
    bf16* orow = MIX + (size_t)qrow * DM + h * VD;
#pragma unroll
    for (int g = 0; g < 4; ++g) { v2u a, c2; a.x = pk2(o0[4 * g] * rl, o0[4 * g + 1] * rl); a.y = pk2(o0[4 * g + 2] * rl, o0[4 * g + 3] * rl); c2.x = pk2(o1[4 * g] * rl, o1[4 * g + 1] * rl); c2.y = pk2(o1[4 * g + 2] * rl, o1[4 * g + 3] * rl);
        *(v2u*)(orow + 8 * g + 4 * hi) = a; *(v2u*)(orow + 32 + 8 * g + 4 * hi) = c2; }
    asm volatile("s_waitcnt vmcnt(0) lgkmcnt(0)" ::: "memory"); __builtin_amdgcn_s_barrier(); asm volatile("" ::: "memory");
#undef ATT_DMA
}
__device__ __forceinline__ void hgrn_item(Frame& F, int j, int it);
__device__ __forceinline__ void mix_phase(Frame& F, int j, bool ctx_out) {
    fresh(F);
    const int npair = F.G >> 1;
    for (int P = F.vcu >> 1; P < NB * NH; P += npair) {
        const int b = P >> 3, h = P & 7;
        if ((F.vcu & 1) == 0) {
            hgrn_item(F, j, P);
            for (int qb = 6; qb < 8; ++qb) attn_unit(F, b, h, b * SEQ + qb * 256, true, 0, NKEY / 64);
        } else {
            for (int qb = 0; qb < 6; ++qb) attn_unit(F, b, h, b * SEQ + qb * 256, true, 0, NKEY / 64);
            if (ctx_out) attn_unit(F, b, h, M + b * CTXL, false, SEQ / 64, NKEY / 64);
        }
    }
    __syncthreads();
}

__device__ __forceinline__ int hgrn_row(int b, int dir, int ig) { return (ig < CTXL) ? (M + b * CTXL + (dir ? CTXL - 1 - ig : ig)) : (b * SEQ + (dir ? SEQ - 1 - (ig - CTXL) : (ig - CTXL))); }
__device__ __forceinline__ void hgrn_item(Frame& F, int j, int it) {
    unsigned char* ws = F.ws;
    const bf16* HQ = (const bf16*)(ws + WS_HQ); const bf16* HFF = HQ + HSEG; const bf16* HFB = HQ + 2 * HSEG; const bf16* HI = HQ + 3 * HSEG;
    LAS unsigned char* ring = F.lds + RING_OFF;
    LAS unsigned char* QN = ring; LAS unsigned char* KN = ring + 17408; LAS unsigned char* KT = ring + 34816; LAS unsigned char* VT = ring + 53248; LAS unsigned char* ST = ring + 71680;
    LAS float* TOT = (LAS float*)(ring + 106496); LAS unsigned char* RQ = ring + 108544; LAS unsigned char* RF = ring + 124928; LAS float* EW = (LAS float*)(ring + 141312);
    const int lane0 = F.lane, wave = F.wave;
    const int part = wave >> 1;
    const int kb = wave >> 1, vb0 = 2 * (wave & 1);
    const int ib = wave >> 2, vbo = wave & 3;
    const int dir = it & 1, hh = (it >> 1) & 3, b = it >> 3;
    const bf16* HF = dir ? HFB : HFF; float* OO = (float*)(ws + (dir ? WS_OB : WS_OF));
    f32x16 S0, S1;
#pragma unroll
    for (int r = 0; r < 16; ++r) { S0[r] = 0.f; S1[r] = 0.f; }
#define LBAR() do { asm volatile("s_waitcnt lgkmcnt(0)" ::: "memory"); __builtin_amdgcn_s_barrier(); asm volatile("" ::: "memory"); } while (0)
#define HG_BASE(c_) ((c_) < CTXL / 64 ? M + b * CTXL + (dir ? CTXL - 64 - 64 * (c_) : 64 * (c_)) : b * SEQ + (dir ? SEQ - 64 - 64 * ((c_) - CTXL / 64) : 64 * ((c_) - CTXL / 64)))
#define HG_DMA(c_) do { const int rb_ = HG_BASE(c_); \
        _Pragma("unroll") for (int p_ = 0; p_ < 2; ++p_) { const int pc_ = wave * 2 + p_; const size_t go_ = (size_t)(rb_ + 4 * pc_ + (lane >> 4)) * HW + hh * HK + 8 * (lane & 15); \
            __builtin_amdgcn_global_load_lds((const unsigned*)(HQ + go_), (LAS unsigned*)(RQ + pc_ * 1024), 16, 0, 0); __builtin_amdgcn_global_load_lds((const unsigned*)(HF + go_), (LAS unsigned*)(RF + pc_ * 1024), 16, 0, 0); } } while (0)
#define HG_VLD(c_) do { const size_t go_ = (size_t)(HG_BASE(c_) + (dir ? 63 - lane : lane)) * HW + hh * HK + 16 * wave; rv0 = *(const v4u*)(HI + go_); rv1 = *(const v4u*)(HI + go_ + 8); } while (0)
    v4u rv0, rv1;
    { const int lane = lane0; HG_DMA(0); HG_VLD(0); }
    asm volatile("s_waitcnt vmcnt(0)" ::: "memory"); LBAR();
    for (int ch = 0; ch < NKEY / 64; ++ch) {
        int lane_ = lane0; asm volatile("" : "+v"(lane_));
        const int lane = lane_, r32 = lane & 31, hi = lane >> 5, k = (wave & 1) * 64 + lane;
        const int pos = (lane & ~12) | ((lane & 4) << 1) | ((lane & 8) >> 1);
        float qv[16], kin[16], pf[16]; float run = 0.f, prod = 1.f;
#pragma unroll
        for (int ii = 0; ii < 16; ++ii) { const int i = 16 * part + ii, mr = dir ? 63 - i : i; qv[ii] = bf2f(*(const LAS bf16*)(RQ + mr * 256 + k * 2)); const float a = bf2f(*(const LAS bf16*)(RF + mr * 256 + k * 2));
            const float f = __expf(a); kin[ii] = 1.0f - f; prod *= f; pf[ii] = prod; run += a; }
        TOT[part * 128 + k] = run;
        { LAS bf16* vt = (LAS bf16*)(VT + (16 * wave) * 144 + pos * 2);
          vt[0 * 72] = (bf16)(rv0.x & 0xffffu); vt[1 * 72] = (bf16)(rv0.x >> 16); vt[2 * 72] = (bf16)(rv0.y & 0xffffu); vt[3 * 72] = (bf16)(rv0.y >> 16);
          vt[4 * 72] = (bf16)(rv0.z & 0xffffu); vt[5 * 72] = (bf16)(rv0.z >> 16); vt[6 * 72] = (bf16)(rv0.w & 0xffffu); vt[7 * 72] = (bf16)(rv0.w >> 16);
          vt[8 * 72] = (bf16)(rv1.x & 0xffffu); vt[9 * 72] = (bf16)(rv1.x >> 16); vt[10 * 72] = (bf16)(rv1.y & 0xffffu); vt[11 * 72] = (bf16)(rv1.y >> 16);
          vt[12 * 72] = (bf16)(rv1.z & 0xffffu); vt[13 * 72] = (bf16)(rv1.z >> 16); vt[14 * 72] = (bf16)(rv1.w & 0xffffu); vt[15 * 72] = (bf16)(rv1.w >> 16); }
        LBAR();
        if (ch + 1 < NKEY / 64) { HG_DMA(ch + 1); HG_VLD(ch + 1); }
        { const float t0 = TOT[k], t1 = TOT[128 + k], t2 = TOT[256 + k];
          const float base = (part > 0 ? t0 : 0.f) + (part > 1 ? t1 : 0.f) + (part > 2 ? t2 : 0.f); const float rr = t0 + t1;
          unsigned kt[8];
          const float E0 = __expf(base - rr);
#pragma unroll
          for (int ii = 0; ii < 16; ii += 2) { const float e0 = E0 * pf[ii], e1 = E0 * pf[ii + 1]; const float q0 = qv[ii] * e0, q1 = qv[ii + 1] * e1, k0 = kin[ii] * __builtin_amdgcn_rcpf(e0), k1 = kin[ii + 1] * __builtin_amdgcn_rcpf(e1);
              const unsigned qp = cvt_pk_bf16(q0, q1), kp = cvt_pk_bf16(k0, k1);
              *(LAS bf16*)(QN + (16 * part + ii) * 272 + k * 2) = (bf16)(qp & 0xffffu); *(LAS bf16*)(QN + (16 * part + ii + 1) * 272 + k * 2) = (bf16)(qp >> 16);
              *(LAS bf16*)(KN + (16 * part + ii) * 272 + k * 2) = (bf16)(kp & 0xffffu); *(LAS bf16*)(KN + (16 * part + ii + 1) * 272 + k * 2) = (bf16)(kp >> 16);
              kt[ii >> 1] = kp; }
          *(LAS v4u*)(KT + k * 144 + part * 32) = (v4u){kt[0], kt[1], kt[4], kt[5]}; *(LAS v4u*)(KT + k * 144 + part * 32 + 16) = (v4u){kt[2], kt[3], kt[6], kt[7]}; }
        { const int kx = kb * 32 + r32; const float v_ = hi ? (TOT[256 + kx] + TOT[384 + kx]) : (TOT[kx] + TOT[128 + kx]); EW[wave * 64 + lane] = __expf(v_); asm volatile("s_waitcnt lgkmcnt(0)" ::: "memory"); }
        f32x16 T0, T1;
#pragma unroll
        for (int g4 = 0; g4 < 4; ++g4) { const int kk = kb * 32 + 8 * g4 + 4 * hi; const f32x4 er = *(const LAS f32x4*)(EW + wave * 64 + 8 * g4 + 4 * hi);
            T0[4 * g4] = S0[4 * g4] * er.x; T0[4 * g4 + 1] = S0[4 * g4 + 1] * er.y; T0[4 * g4 + 2] = S0[4 * g4 + 2] * er.z; T0[4 * g4 + 3] = S0[4 * g4 + 3] * er.w;
            T1[4 * g4] = S1[4 * g4] * er.x; T1[4 * g4 + 1] = S1[4 * g4 + 1] * er.y; T1[4 * g4 + 2] = S1[4 * g4 + 2] * er.z; T1[4 * g4 + 3] = S1[4 * g4 + 3] * er.w;
            v2u o; o.x = cvt_pk_bf16(T0[4 * g4], T0[4 * g4 + 1]); o.y = cvt_pk_bf16(T0[4 * g4 + 2], T0[4 * g4 + 3]); *(LAS v2u*)(ST + (vb0 * 32 + r32) * 272 + kk * 2) = o;
            o.x = cvt_pk_bf16(T1[4 * g4], T1[4 * g4 + 1]); o.y = cvt_pk_bf16(T1[4 * g4 + 2], T1[4 * g4 + 3]); *(LAS v2u*)(ST + (vb0 * 32 + 32 + r32) * 272 + kk * 2) = o; }
        LBAR();
#pragma unroll
        for (int st = 0; st < 4; ++st) { const bf16x8v kf = *(const LAS bf16x8v*)(KT + (kb * 32 + r32) * 144 + st * 32 + hi * 16);
            const bf16x8v va = *(const LAS bf16x8v*)(VT + (vb0 * 32 + r32) * 144 + st * 32 + hi * 16), vc = *(const LAS bf16x8v*)(VT + (vb0 * 32 + 32 + r32) * 144 + st * 32 + hi * 16);
            T0 = __builtin_amdgcn_mfma_f32_32x32x16_bf16(kf, va, T0, 0, 0, 0); T1 = __builtin_amdgcn_mfma_f32_32x32x16_bf16(kf, vc, T1, 0, 0, 0); }
#pragma unroll
        for (int g4 = 0; g4 < 4; ++g4) { const f32x4 eg = *(const LAS f32x4*)(EW + wave * 64 + 32 + 8 * g4 + 4 * hi);
            S0[4 * g4] = T0[4 * g4] * eg.x; S0[4 * g4 + 1] = T0[4 * g4 + 1] * eg.y; S0[4 * g4 + 2] = T0[4 * g4 + 2] * eg.z; S0[4 * g4 + 3] = T0[4 * g4 + 3] * eg.w;
            S1[4 * g4] = T1[4 * g4] * eg.x; S1[4 * g4 + 1] = T1[4 * g4 + 1] * eg.y; S1[4 * g4 + 2] = T1[4 * g4 + 2] * eg.z; S1[4 * g4 + 3] = T1[4 * g4 + 3] * eg.w; }
        asm volatile("" ::: "memory");
        {
            bf16x8v qf[8];
#pragma unroll
            for (int ks = 0; ks < 8; ++ks) qf[ks] = *(const LAS bf16x8v*)(QN + (ib * 32 + r32) * 272 + ks * 32 + hi * 16);
            asm volatile("" ::: "memory");
            f32x16 O;
#pragma unroll
            for (int r = 0; r < 16; ++r) O[r] = 0.f;
#pragma unroll
            for (int ks = 0; ks < 8; ++ks) { const bf16x8v sf = *(const LAS bf16x8v*)(ST + (vbo * 32 + r32) * 272 + ks * 32 + hi * 16); O = __builtin_amdgcn_mfma_f32_32x32x16_bf16(qf[ks], sf, O, 0, 0, 0); }
            asm volatile("" ::: "memory");
#pragma unroll 1
            for (int sb = 0; sb <= ib; ++sb) {
                f32x16 X;
#pragma unroll
                for (int r = 0; r < 16; ++r) X[r] = 0.f;
#pragma unroll
                for (int ks = 0; ks < 8; ++ks) { const bf16x8v kf = *(const LAS bf16x8v*)(KN + (sb * 32 + r32) * 272 + ks * 32 + hi * 16); X = __builtin_amdgcn_mfma_f32_32x32x16_bf16(kf, qf[ks], X, 0, 0, 0); }
                if (sb == ib) {
#pragma unroll
                    for (int r = 0; r < 16; ++r) { const int srow = (r & 3) + 8 * (r >> 2) + 4 * hi; if (srow > r32) X[r] = 0.f; }
                }
                asm volatile("" ::: "memory");
#pragma unroll
                for (int st = 0; st < 2; ++st) { v4u pw;
#pragma unroll
                    for (int q = 0; q < 4; ++q) pw[q] = cvt_pk_bf16(X[8 * st + 2 * q], X[8 * st + 2 * q + 1]);
                    const bf16x8v vf = *(const LAS bf16x8v*)(VT + (vbo * 32 + r32) * 144 + (sb * 32 + st * 16) * 2 + hi * 16);
                    O = __builtin_amdgcn_mfma_f32_32x32x16_bf16(__builtin_bit_cast(bf16x8v, pw), vf, O, 0, 0, 0); }
                asm volatile("" ::: "memory");
            }
            asm volatile("s_waitcnt vmcnt(0)" ::: "memory");
            const int rb = HG_BASE(ch); float* op = OO + (size_t)rb * HW + hh * HK + vbo * 32 + r32;
#pragma unroll
            for (int r = 0; r < 16; ++r) { const int i = ib * 32 + (r & 3) + 8 * (r >> 2) + 4 * hi; op[(size_t)(dir ? 63 - i : i) * HW] = O[r]; }
        }
        LBAR();
    }
    asm volatile("s_waitcnt vmcnt(0)" ::: "memory");
#undef LBAR
#undef HG_DMA
#undef HG_VLD
#undef HG_BASE
}

__device__ __forceinline__ void e8_phase(Frame& F, int j, int nrows) {
    fresh(F);
    unsigned char* ws = F.ws;
    const float* OF = (const float*)(ws + WS_OF); const float* OB = (const float*)(ws + WS_OB); const bf16* HG = (const bf16*)(ws + WS_HQ) + 4 * HSEG; bf16* MIX = (bf16*)(ws + WS_MIX);
    const float* gn = F.in[14] + j * HK;
    const int rpw = (nrows + F.G - 1) / F.G, rbase = (int)blockIdx.x * rpw, rend = (rbase + rpw < nrows) ? rbase + rpw : nrows;
    const int col = 8 * F.lane, vv = col & 127; const f32x4 g0 = *(const f32x4*)(gn + vv), g1 = *(const f32x4*)(gn + vv + 4);
    for (int r0 = rbase + F.wave; r0 < rend; r0 += 2 * NWAVES) {
        f32x4 a0[2], a1[2], b0[2], b1[2]; v4u hg[2];
#pragma unroll
        for (int q = 0; q < 2; ++q) { const int row = r0 + q * NWAVES; if (row < rend) {
            a0[q] = *(const f32x4*)(OF + (size_t)row * HW + col); a1[q] = *(const f32x4*)(OF + (size_t)row * HW + col + 4); b0[q] = *(const f32x4*)(OB + (size_t)row * HW + col); b1[q] = *(const f32x4*)(OB + (size_t)row * HW + col + 4);
            hg[q] = *(const v4u*)(HG + (size_t)row * HW + col); } }
#pragma unroll
        for (int q = 0; q < 2; ++q) { const int row = r0 + q * NWAVES; if (row < rend) {
            f32x4 x0 = a0[q] + b0[q], x1 = a1[q] + b1[q];
            float s = (x0.x * x0.x + x0.y * x0.y) + (x0.z * x0.z + x0.w * x0.w) + (x1.x * x1.x + x1.y * x1.y) + (x1.z * x1.z + x1.w * x1.w);
            s += shx(s, F.lane, 1); s += shx(s, F.lane, 2); s += shx(s, F.lane, 4); s += shx(s, F.lane, 8);
            const float rstd = rsqrtf(s * (1.0f / HK) + EPS);
            x0 = x0 * rstd * g0; x1 = x1 * rstd * g1; const v4u h = hg[q];
            v4u o; o.x = pg8::cvt_pk_bf16(x0.x * siluf_(bflo(h.x)), x0.y * siluf_(bfhi(h.x))); o.y = pg8::cvt_pk_bf16(x0.z * siluf_(bflo(h.y)), x0.w * siluf_(bfhi(h.y)));
            o.z = pg8::cvt_pk_bf16(x1.x * siluf_(bflo(h.z)), x1.y * siluf_(bfhi(h.z))); o.w = pg8::cvt_pk_bf16(x1.z * siluf_(bflo(h.w)), x1.w * siluf_(bfhi(h.w)));
            *(v4u*)(MIX + (size_t)row * DM + HW + col) = o; } }
    }
}

__device__ __forceinline__ void o12_phase(Frame& F, int nrows, const bf16* hb, const float* gn, const float* modl) {
    fresh(F);
    bf16* P = (bf16*)(F.ws + WS_POOLED);
    LAS unsigned char* XN = F.lds + RING_OFF;
    const int rpw = (nrows + F.G - 1) / F.G, rbase = (int)blockIdx.x * rpw, rend = (rbase + rpw < nrows) ? rbase + rpw : nrows;
    for (int r0 = rbase; r0 < rend; r0 += 32) {
        for (int sl = F.wave; sl < 48; sl += NWAVES) {
            const int row = r0 - 8 + sl; if (row < 0 || row >= nrows) continue;
            f32x4 v[4]; float s = 0.f;
#pragma unroll
            for (int j = 0; j < 4; ++j) { const v2u w = *(const v2u*)(hb + (size_t)row * DM + 4 * F.lane + 256 * j); v[j] = (f32x4){bflo(w.x), bfhi(w.x), bflo(w.y), bfhi(w.y)}; s += (v[j].x * v[j].x + v[j].y * v[j].y) + (v[j].z * v[j].z + v[j].w * v[j].w); }
            const float rstd = rsqrtf(wave_sum(s, F.lane) * (1.0f / DM) + EPS);
#pragma unroll
            for (int j = 0; j < 4; ++j) { v2u o; o.x = pg8::cvt_pk_bf16(v[j].x * rstd, v[j].y * rstd); o.y = pg8::cvt_pk_bf16(v[j].z * rstd, v[j].w * rstd); *(LAS v2u*)(XN + sl * 2048 + (4 * F.lane + 256 * j) * 2) = o; }
        }
        __syncthreads();
#pragma unroll 1
        for (int q = 0; q < 4; ++q) {
            const int t = r0 + F.wave * 4 + q; if (t >= rend) break;
            const bool lat = t < M; const int T = lat ? SEQ : CTXL; const int tt = lat ? t % SEQ : (t - M) % CTXL; const int bidx = lat ? t / SEQ : NB;
            const int sc0 = t - r0 + 8;
            const float* scp = modl + bidx * NMOD + DM;
#pragma unroll
            for (int g = 0; g < 4; ++g) {
                const int hw = 1 << g, col = 256 * g + 4 * F.lane;
                float s0 = 0.f, s1 = 0.f, s2 = 0.f, s3 = 0.f; int cnt = 0;
#pragma unroll
                for (int d = -hw; d < hw; ++d) { const bool ok = (tt + d >= 0) && (tt + d < T); const v2u x = *(const LAS v2u*)(XN + (sc0 + d) * 2048 + col * 2);
                    s0 += ok ? bflo(x.x) : 0.f; s1 += ok ? bfhi(x.x) : 0.f; s2 += ok ? bflo(x.y) : 0.f; s3 += ok ? bfhi(x.y) : 0.f; cnt += ok ? 1 : 0; }
                const v2u xc = *(const LAS v2u*)(XN + sc0 * 2048 + col * 2); const float ic = 1.0f / (float)cnt;
                const f32x4 gv = *(const f32x4*)(gn + col), sv = *(const f32x4*)(scp + col);
                v2u o; o.x = pg8::cvt_pk_bf16(gv.x * (sv.x + 1.0f) * (s0 * ic - bflo(xc.x)), gv.y * (sv.y + 1.0f) * (s1 * ic - bfhi(xc.x)));
                o.y = pg8::cvt_pk_bf16(gv.z * (sv.z + 1.0f) * (s2 * ic - bflo(xc.y)), gv.w * (sv.w + 1.0f) * (s3 * ic - bfhi(xc.y)));
                *(v2u*)(P + ((size_t)g * MT + t) * 256 + 4 * F.lane) = o;
            }
        }
        __syncthreads();
    }
}

__device__ __forceinline__ void o5_phase(Frame& F, int nrows) {
    fresh(F);
    unsigned char* ws = F.ws;
    const int* CNT = (const int*)(ws + WS_CNT); int* TST = (int*)(ws + WS_TST); const int* EIDX = (const int*)(ws + WS_EIDX); int* POS = (int*)(ws + WS_POS);
    const bf16* U = (const bf16*)(ws + WS_U); bf16* VG = (bf16*)(ws + WS_VG);
    LAS int* lc = (LAS int*)(F.lds + RING_OFF);
    LAS int* lbase = lc + 512 * 8;
    LAS int* lpos = lbase + 32;
    const int rpw = (nrows + F.G - 1) / F.G;
    for (int e = F.tid; e < F.G * 8; e += 512) lc[e] = CNT[e];
    __syncthreads();
    {
        const int e = F.wave; int c4[4]; int sum = 0;
#pragma unroll
        for (int q = 0; q < 4; ++q) { const int w = 4 * F.lane + q; c4[q] = (w < F.G) ? lc[w * 8 + e] : 0; sum += c4[q]; }
        int incl = sum;
#pragma unroll
        for (int o = 1; o < 64; o <<= 1) { const int t = __builtin_amdgcn_ds_bpermute((F.lane >= o ? F.lane - o : F.lane) << 2, incl); if (F.lane >= o) incl += t; }
        const int total = __builtin_amdgcn_readlane(incl, 63); int excl = incl - sum;
        const int myq = (int)blockIdx.x & 3; int pre = excl;
#pragma unroll
        for (int q = 0; q < 3; ++q) if (q < myq) pre += c4[q];
        if (F.lane == ((int)blockIdx.x >> 2)) { lbase[e] = pre; lbase[8 + e] = total; }
    }
    __syncthreads();
    if (F.tid == 0) {
        int ts = 0;
        for (int e = 0; e < 8; ++e) { const int pre = lbase[e], tot = lbase[8 + e]; lbase[e] = ts * 256 + pre; if (blockIdx.x == 0) TST[e] = ts; ts += (tot + 255) >> 8; }
        if (blockIdx.x == 0) TST[8] = ts;
    }
    __syncthreads();
    if (F.wave == 0) {
        int run[8];
#pragma unroll
        for (int e = 0; e < 8; ++e) run[e] = lbase[e];
        const int npairs = 2 * rpw;
        for (int c0 = 0; c0 < npairs; c0 += 64) {
            const int pl = c0 + F.lane; const int row = (int)blockIdx.x * rpw + (pl >> 1); const bool ok = pl < npairs && row < nrows;
            const int e = ok ? EIDX[2 * row + (pl & 1)] : -1; int mypos = 0;
#pragma unroll
            for (int x = 0; x < 8; ++x) { const unsigned long long mk = __ballot(e == x); const int below = __popcll(mk & ((1ull << F.lane) - 1ull)); if (e == x) mypos = run[x] + below; run[x] += __popcll(mk); }
            if (ok) { lpos[pl] = mypos; POS[2 * row + (pl & 1)] = mypos; }
        }
    }
    __syncthreads();
    for (int pl0 = F.wave * 4; pl0 < 2 * rpw; pl0 += NWAVES * 4) {
        v4u a[4], b[4]; int p[4];
#pragma unroll
        for (int q = 0; q < 4; ++q) { const int pl = pl0 + q; const int row = (int)blockIdx.x * rpw + (pl >> 1); p[q] = -1;
            if (pl < 2 * rpw && row < nrows) { p[q] = lpos[pl]; a[q] = *(const v4u*)(U + (size_t)row * DM + 8 * F.lane); b[q] = *(const v4u*)(U + (size_t)row * DM + 512 + 8 * F.lane); } }
#pragma unroll
        for (int q = 0; q < 4; ++q) if (p[q] >= 0) { *(v4u*)(VG + (size_t)p[q] * DM + 8 * F.lane) = a[q]; *(v4u*)(VG + (size_t)p[q] * DM + 512 + 8 * F.lane) = b[q]; }
    }
    __syncthreads();
}

__global__ void __launch_bounds__(NWAVES * 64, 2) mega_fwd(Args args) {
    extern __shared__ __attribute__((aligned(16))) unsigned char lds[];
    Frame F;
    F.lds = (LAS unsigned char*)lds;
    F.wave = __builtin_amdgcn_readfirstlane((int)threadIdx.x >> 6); fresh(F);
    F.G = gridDim.x; { const int bx = blockIdx.x; F.vcu = (F.G % 8 == 0) ? (bx % 8) * (F.G / 8) + bx / 8 : bx; }
    F.in = args.in; F.out = args.out; F.ws = args.ws;
    unsigned char* ws = args.ws;
    volatile LAS unsigned* MISC = (volatile LAS unsigned*)(F.lds + MISC_OFF);
    for (int u = F.tid; u < (LDS_BYTES - LDSCTL_OFF) / 4; u += NWAVES * 64) ((LAS unsigned*)(F.lds + LDSCTL_OFF))[u] = 0u;
    __syncthreads();
    XcdBarrier bar = xcd_barrier_post((unsigned*)(ws + WS_CTL) + CW_BAR, MISC + 8, F.wave);
#define GRID_BAR() do { xcd_barrier(bar); if (DUPMASK & 4096) xcd_barrier(bar); } while (0)
#ifndef ONLY
#define ONLY 0
#endif
#define PH(n) (ONLY == 0 || ONLY == (n))
#define REP(bit) for (int rep_ = 0; rep_ < ((DUPMASK & (bit)) ? 2 : 1); ++rep_)
    LAS unsigned char* ring = F.lds + RING_OFF;
    const float* MODV = (const float*)(ws + WS_MODV);
    bf16* HB = (bf16*)(ws + WS_HB);
    bf16* U = (bf16*)(ws + WS_U);

#if PH(20)
    REP(8192) p0_prologue(F);
#endif
    GRID_BAR();

    for (int lp = 0; lp < 2; ++lp) {
        const int le = 2 * lp, lo = 2 * lp + 1, j = lp;
        const bool ctx_out = (lp == 0);
        const int nro = ctx_out ? MT : M;
        const float* modE = MODV + (size_t)le * 17 * NMOD; const float* modO = MODV + (size_t)lo * 17 * NMOD;
#if PH(1)
        {
            RowArgs A{}; A.xin_l = args.in[0]; A.xin_c = args.in[2]; A.hb = HB; A.hbo = HB; A.g = args.in[6] + (size_t)(le * 2 + 0) * DM; A.modl = modE; A.shoff = 0; A.scoff = DM; A.U = U;
            A.Y = (const bf16*)(ws + WS_VG); A.pos = (const int*)(ws + WS_POS); A.gate = (const float*)(ws + WS_GATE); A.modprev = MODV + (size_t)(le - 1) * 17 * NMOD;
            if (lp == 0) row_phase<false, 1, false, true>(F, A, MT); else row_phase<true, 1, false, false>(F, A, MT);
        }
#endif
        GRID_BAR();
#if PH(2)
        {
            pg8::Gemm g{U, (const bf16*)(ws + WS_WIN) + (size_t)j * INP * DM, DM, DM, DM}; pg8::InOrder S; S.init(ctx_out, F.G, (int)blockIdx.x);
            EpiIn E{(bf16*)(ws + WS_CQ), (bf16*)(ws + WS_KRR), (bf16*)(ws + WS_CKV), (bf16*)(ws + WS_HQ), (float*)(ws + WS_RSQ), (float*)(ws + WS_RSKV), (const float*)(ws + WS_ROPE), args.in[13], j};
            REP(8) pg8::gemm_phase<EpiIn, pg8::InOrder, true>(ring, g, S, E, F.wave);
        }
#endif
        GRID_BAR();
#if PH(4)
        {
            pg8::Gemm g{(const bf16*)(ws + WS_CQ), (const bf16*)(ws + WS_WUQ) + (size_t)j * 768 * QL, QL, QL, QL}; pg8::StaticOrder S; S.init(nro, 768, F.G, (int)blockIdx.x);
            EpiQ E{(bf16*)(ws + WS_QB), (const float*)(ws + WS_RSQ)};
            REP(8) pg8::gemm_phase<EpiQ, pg8::StaticOrder, true>(ring, g, S, E, F.wave);
        }
        {
            pg8::Gemm g{(const bf16*)(ws + WS_CKV), (const bf16*)(ws + WS_WUKV) + (size_t)j * 1024 * KVL, KVL, KVL, KVL}; pg8::StaticOrder S; S.init(MT, 1024, F.G, (int)blockIdx.x);
            EpiKV E{(bf16*)(ws + WS_KN), (bf16*)(ws + WS_VV), (const float*)(ws + WS_RSKV)};
            REP(8) pg8::gemm_phase<EpiKV, pg8::StaticOrder, true>(ring, g, S, E, F.wave);
        }
#endif
        GRID_BAR();
#if PH(6)
        REP(3) mix_phase(F, j, ctx_out);
#endif
        GRID_BAR();
#if PH(8)
        REP(4 | 64) e8_phase(F, j, nro);
#endif
        GRID_BAR();
#if PH(9)
        {
            pg8::Gemm g{(const bf16*)(ws + WS_MIX), (const bf16*)(ws + WS_WOUT) + (size_t)j * DM * DM, DM, DM, DM}; pg8::StaticOrder S; S.init(nro, DM, F.G, (int)blockIdx.x);
            if (lp == 0) { EpiResid<true> E{args.in[0], args.in[2], HB, modE, 2 * DM}; pg8::gemm_phase<EpiResid<true>, pg8::StaticOrder, true>(ring, g, S, E, F.wave); }
            else { EpiResid<false> E{nullptr, nullptr, HB, modE, 2 * DM}; pg8::gemm_phase<EpiResid<false>, pg8::StaticOrder, true>(ring, g, S, E, F.wave); }
        }
#endif
        GRID_BAR();
#if PH(10)
        {
            RowArgs A{}; A.hb = HB; A.g = args.in[6] + (size_t)(le * 2 + 1) * DM; A.modl = modE; A.shoff = 3 * DM; A.scoff = 4 * DM; A.U = U;
            REP(4 | 128) row_phase<false, 1, false, false>(F, A, nro);
        }
#endif
        GRID_BAR();
#if PH(11)
        {
            pg8::Gemm g{U, (const bf16*)(ws + WS_WGU) + (size_t)j * 2 * DFF * DM, DM, DM, DM}; pg8::StaticOrder S; S.init(nro, 2 * DFF, F.G, (int)blockIdx.x);
            EpiGateUp E{(bf16*)(ws + WS_HID), DFF, 2 * DFF / 256, 0};
            REP(8) pg8::gemm_phase<EpiGateUp, pg8::StaticOrder, true>(ring, g, S, E, F.wave);
        }
#endif
        GRID_BAR();
#if PH(12)
        {
            pg8::Gemm g{(const bf16*)(ws + WS_HID), (const bf16*)(ws + WS_WDN) + (size_t)j * DM * DFF, DFF, DFF, DFF}; pg8::StaticOrder S; S.init(nro, DM, F.G, (int)blockIdx.x);
            EpiResid<false> E{nullptr, nullptr, HB, modE, 5 * DM};
            pg8::gemm_phase<EpiResid<false>, pg8::StaticOrder, true>(ring, g, S, E, F.wave);
        }
#endif
        GRID_BAR();
#if PH(13)
        {
            REP(2048) o12_phase(F, nro, HB, args.in[6] + (size_t)(lo * 2 + 0) * DM, modO);
            REP(16) for (int e = 0; e < NE; ++e) {
                conv_matrix(F, args.in[23] + ((size_t)j * NE + e) * DM * DFE, DM, DFE, (bf16*)(ws + WS_MWGU) + (size_t)e * 2 * DFE * DM, DM, 2, 0, nullptr, 1.f);
                conv_matrix(F, args.in[24] + ((size_t)j * NE + e) * DM * DFE, DM, DFE, (bf16*)(ws + WS_MWGU) + (size_t)e * 2 * DFE * DM, DM, 2, 128, nullptr, 1.f);
                conv_matrix(F, args.in[25] + ((size_t)j * NE + e) * DFE * DM, DFE, DM, (bf16*)(ws + WS_MWDN) + (size_t)e * DM * DFE, DFE, 0, 0, nullptr, 1.f);
            }
        }
#endif
        GRID_BAR();
#if PH(15)
        {
            pg8::Gemm g{(const bf16*)(ws + WS_POOLED), (const bf16*)(ws + WS_WPOOL) + (size_t)j * 4 * 65536, 256, 256, 256};
            pg8::PoolOrder S{nro / 256, MT / 256, F.G, (int)blockIdx.x};
            EpiPool E{HB, modO, args.in[20] + (size_t)j * DM, args.in[21] + (size_t)j * DM, MT / 256};
            pg8::gemm_phase<EpiPool, pg8::PoolOrder, true>(ring, g, S, E, F.wave);
        }
#endif
        GRID_BAR();
#if PH(16)
        {
            RowArgs A{}; A.hb = HB; A.g = args.in[6] + (size_t)(lo * 2 + 1) * DM; A.modl = modO; A.shoff = 3 * DM; A.scoff = 4 * DM; A.U = U;
            A.router = args.in[22] + (size_t)j * DM * NE; A.eidx = (int*)(ws + WS_EIDX); A.gout = (float*)(ws + WS_GATE); A.cnt = (int*)(ws + WS_CNT);
            REP(4 | 512) row_phase<false, 1, true, false>(F, A, nro);
        }
#endif
        GRID_BAR();
#if PH(17)
        REP(4 | 1024) o5_phase(F, nro);
#endif
        GRID_BAR();
#if PH(18)
        {
            const int* TST = (const int*)(ws + WS_TST);
            const int ts1 = TST[1], ts2 = TST[2], ts3 = TST[3], ts4 = TST[4], ts5 = TST[5], ts6 = TST[6], ts7 = TST[7], nT = TST[8];
            const int rem = nT % MOE_CH, nseg = nT / MOE_CH + 1;
            for (int p = 0; p <= nseg; ++p) {
                int n7 = 0;
                if (p >= 1) {
                    const int sg = p - 1; const int t0 = sg == 0 ? 0 : rem + (sg - 1) * MOE_CH, nrt = sg == 0 ? rem : MOE_CH; n7 = nrt * (DM / 256);
                    const bf16* hb = (const bf16*)(ws + WS_HIDM) + (size_t)((sg == 0 || ((sg - 1) & 1)) ? MOE_CH : 0) * 256 * DFE;
                    pg8::Gemm g{hb - (size_t)t0 * 256 * DFE, (const bf16*)(ws + WS_MWDN), DFE, DFE, DFE};
                    pg8::MoeOrder S{t0, nrt, DM / 256, F.G, (int)blockIdx.x, ts1, ts2, ts3, ts4, ts5, ts6, ts7, 0, 0};
                    EpiY E{(bf16*)(ws + WS_VG), DM / 256};
                    REP(8) pg8::gemm_phase<EpiY, pg8::MoeOrder, true>(ring, g, S, E, F.wave);
                }
                if (p < nseg) {
                    const int sg = p; const int t0 = sg == 0 ? 0 : rem + (sg - 1) * MOE_CH, nrt = sg == 0 ? rem : MOE_CH;
                    bf16* hb = (bf16*)(ws + WS_HIDM) + (size_t)((sg == 0 || ((sg - 1) & 1)) ? MOE_CH : 0) * 256 * DFE;
                    pg8::Gemm g{(const bf16*)(ws + WS_VG), (const bf16*)(ws + WS_MWGU), DM, DM, DM};
                    pg8::MoeOrder S{t0, nrt, 2 * DFE / 256, F.G, (int)blockIdx.x, ts1, ts2, ts3, ts4, ts5, ts6, ts7, n7 % F.G, 4};
                    EpiGateUp E{hb, DFE, 2 * DFE / 256, t0 * 256};
                    REP(8) pg8::gemm_phase<EpiGateUp, pg8::MoeOrder, true>(ring, g, S, E, F.wave);
                }
                GRID_BAR();
            }
        }
#endif
    }
#if PH(19)
    {
        RowArgs A{}; A.hb = HB; A.fout = args.out; A.g = args.in[7];
        A.Y = (const bf16*)(ws + WS_VG); A.pos = (const int*)(ws + WS_POS); A.gate = (const float*)(ws + WS_GATE); A.modprev = MODV + (size_t)3 * 17 * NMOD;
        row_phase<true, 2, false, false>(F, A, M);
        if (xb_ld((unsigned*)(ws + WS_CTL) + CW_BAR + XB_TMO) != 0u) { __syncthreads(); const float qn = __builtin_nanf(""); for (int i = F.tid; i < 1024; i += 512) args.out[(size_t)blockIdx.x * 1024 + i] = qn; }
    }
#endif
}

extern "C" void kernel_launch(void* const* d_in, const int* in_sizes, int n_in, void* d_out, int out_size, void* d_ws, size_t ws_size, hipStream_t stream) {
    static int grid = 0;
    if (grid == 0) {
        if (n_in != 26 || out_size != M * DM || ws_size < WS_END) { fprintf(stderr, "kernel_launch: unexpected shapes (n_in %d out %d ws %zu)\n", n_in, out_size, ws_size); grid = -1; return; }
        int dev = 0, cus = 0, per_cu = 0;
        if (hipGetDevice(&dev) != hipSuccess || hipDeviceGetAttribute(&cus, hipDeviceAttributeMultiprocessorCount, dev) != hipSuccess) { grid = -1; return; }
        if (hipFuncSetAttribute((const void*)mega_fwd, hipFuncAttributeMaxDynamicSharedMemorySize, LDS_BYTES) != hipSuccess) { grid = -1; return; }
        if (hipOccupancyMaxActiveBlocksPerMultiprocessor(&per_cu, (const void*)mega_fwd, NWAVES * 64, LDS_BYTES) != hipSuccess || per_cu < 1) fprintf(stderr, "kernel_launch: occupancy query says %d\n", per_cu);
        (void)hipGetLastError();
        grid = cus > 256 ? 256 : cus;
    }
    if (grid < 0) return;
    if (hipMemsetAsync((char*)d_ws + WS_CTL, 0, CTL_ZERO_BYTES, stream) != hipSuccess) return;
    Args a{};
    for (int i = 0; i < 26; ++i) a.in[i] = (const float*)d_in[i];
    a.out = (float*)d_out; a.ws = (unsigned char*)d_ws;
    hipLaunchKernelGGL(mega_fwd, dim3(grid), dim3(NWAVES * 64), LDS_BYTES, stream, a);
}
```

```cpp
#include <hip/hip_runtime.h>
#ifndef DUPMASK
#define DUPMASK 0
#endif
#include <cstdio>
#include <cstdint>

__device__ __forceinline__ int lane_now() { int l; asm volatile("v_mbcnt_lo_u32_b32 %0, -1, 0\n\tv_mbcnt_hi_u32_b32 %0, -1, %0" : "=v"(l)); return l; }
namespace pg8 {
#define PG8_LAS __attribute__((address_space(3)))
typedef unsigned short bf16_t;
typedef short bf16x8 __attribute__((ext_vector_type(8)));
typedef float f32x4 __attribute__((ext_vector_type(4)));
typedef unsigned u32x4 __attribute__((ext_vector_type(4)));
constexpr int BM = 256, BK = 64, HALF = 128, HTB = HALF * BK * 2, STAGE_BYTES = 8 * HTB, NXCD = 8, WGM = 8;

__host__ __device__ __forceinline__ int lds_byte(int r, int c) { const int st = (r >> 4) * 2 + (c >> 5), rr = r & 15, cc = c & 31, ob = rr * 64 + cc * 2; return st * 1024 + (ob ^ (((ob >> 9) & 1) << 5)); }
__host__ __device__ __forceinline__ void stage_rc(int b, int& R, int& C) { const int st = b / 1024, sb = b % 1024, swz = sb ^ (((sb >> 9) & 1) << 5); R = (st >> 1) * 16 + swz / 64; C = (st & 1) * 32 + (swz % 64) / 2; }
__host__ __device__ __forceinline__ int perm32(int rho) { const int n = rho >> 4, i = rho & 15; return 8 * (i >> 2) + 4 * n + (i & 3); }

struct Unit { int pm, pn; };
struct Gemm { const bf16_t* A; const bf16_t* Bt; int lda, ldb, K; };

struct StaticOrder {
    int nM, nN, nwg, G, c;
    __device__ void init(int M, int N, int G_, int c_) { nM = M / BM; nN = N / BM; nwg = nM * nN; G = G_; c = c_; }
    __device__ bool next(int i, Unit& u) const {
        const long L = (long)i * G + c; if (L >= nwg) return false;
        int wgid = (int)L; { const int q = nwg / NXCD, r = nwg % NXCD, xcd = wgid % NXCD, off = wgid / NXCD; wgid = (xcd < r ? xcd * (q + 1) : r * (q + 1) + (xcd - r) * q) + off; }
        const int nig = WGM * nN, gid = wgid / nig, fm = gid * WGM, gsz = (nM - fm) < WGM ? (nM - fm) : WGM;
        u.pm = fm + ((wgid % nig) % gsz); u.pn = (wgid % nig) / gsz; return true;
    }
};
struct InOrder {
    StaticOrder lat; int nlat, nctx_ct, G, c;
    __device__ void init(bool full, int G_, int c_) { lat.init(32768, 3328, G_, c_); nlat = lat.nwg; nctx_ct = full ? 13 : 8; G = G_; c = c_; }
    __device__ bool next(int i, Unit& u) const {
        const int L = i * G + c; if (L < nlat) return lat.next(i, u);
        const int x = L - nlat; if (x >= 16 * nctx_ct) return false;
        const int rt = (nctx_ct == 13) ? x / 13 : x >> 3, q = x - rt * nctx_ct; u.pm = 128 + rt; u.pn = (nctx_ct == 13) ? q : (q < 2 ? q + 1 : q + 3); return true;
    }
};
struct PoolOrder {
    int nrt, talloc, G, c;
    __device__ bool next(int i, Unit& u) const { const int L = i * G + c; if (L >= 4 * nrt) return false; const int g = L / nrt, rt = L - g * nrt; u.pm = g * talloc + rt; u.pn = g; return true; }
};
struct MoeOrder {
    int t0, nrt, nct, G, c; int ts1, ts2, ts3, ts4, ts5, ts6, ts7;
    int skipw, skipr;
    __device__ bool next(int i, Unit& u) const {
        const int nwg = nrt * nct; const int r_ = i + (c < skipw ? skipr : 0);
        const int L = (r_ < skipr) ? r_ * (G - skipw) + (c - skipw) : skipr * (G - skipw) + (r_ - skipr) * G + c; if (L >= nwg) return false;
        int wgid = L; { const int q = nwg / NXCD, r = nwg % NXCD, xcd = wgid % NXCD, off = wgid / NXCD; wgid = (xcd < r ? xcd * (q + 1) : r * (q + 1) + (xcd - r) * q) + off; }
        const int nig = WGM * nct, gid = wgid / nig, fm = gid * WGM, gsz = (nrt - fm) < WGM ? (nrt - fm) : WGM;
        const int rt = t0 + fm + ((wgid % nig) % gsz), ct = (wgid % nig) / gsz;
        const int e = (rt >= ts1) + (rt >= ts2) + (rt >= ts3) + (rt >= ts4) + (rt >= ts5) + (rt >= ts6) + (rt >= ts7);
        u.pm = rt; u.pn = e * nct + ct; return true;
    }
};

__device__ __forceinline__ unsigned cvt_pk_bf16(float lo, float hi) { unsigned r; asm volatile("v_cvt_pk_bf16_f32 %0, %1, %2" : "=v"(r) : "v"(lo), "v"(hi)); return r; }

template <class Epi, class Sched, bool ALIGN_EPI>
__device__ __forceinline__ void gemm_phase(PG8_LAS unsigned char* lds, const Gemm g, const Sched& S, const Epi& E, const int wid) {
    const int lane_ = lane_now();
    const int lane = lane_, tid = wid * 64 + lane, wr = wid >> 2, wc = wid & 3, fr = lane & 15, fq = lane >> 4;
    int K_ = g.K; asm volatile("" : "+s"(K_));
    const int K = K_, nt = K / BK;
    unsigned voffA[2], voffB[2];
#pragma unroll
    for (int i = 0; i < 2; ++i) { int R, C; stage_rc(tid * 16 + i * 8192, R, C); const int Rb = Epi::PERM ? ((R & ~31) + perm32(R & 31)) : R;
        voffA[i] = (unsigned)(R * g.lda + C) * 2u; voffB[i] = (unsigned)(Rb * g.ldb + C) * 2u; }
    const size_t kstep = (size_t)(BK * 2);
    const size_t hstepA = (size_t)HALF * g.lda * 2, hstepB = (size_t)HALF * g.ldb * 2;
    const size_t tstepA = 2 * hstepA, tstepB = 2 * hstepB;
    const unsigned ldsw = (unsigned)wid * 1024u;
    const int aoff = lds_byte(wr * 64 + fr, fq * 8), boff = lds_byte(wc * 32 + fr, fq * 8);
#define PG8_SA(b, h) (((b) * 2 + (h)) * HTB)
#define PG8_SB(b, h) ((4 + (b) * 2 + (h)) * HTB)
#define PG8_STAGE(bufoff, gbase, voff) do { _Pragma("unroll") for (int _i = 0; _i < 2; ++_i) \
        __builtin_amdgcn_global_load_lds((const unsigned*)((const char*)(gbase) + (voff)[_i]), (PG8_LAS unsigned*)(lds + (bufoff) + ldsw + _i * 8192), 16, 0, 0); } while (0)
#define PG8_LDA(dst, b, h) do { _Pragma("unroll") for (int m = 0; m < 4; ++m) _Pragma("unroll") for (int k = 0; k < 2; ++k) dst[m][k] = *(const PG8_LAS bf16x8*)(lds + PG8_SA(b, h) + aoff + m * 2048 + k * 1024); } while (0)
#define PG8_LDB(dst, b, h) do { _Pragma("unroll") for (int n = 0; n < 2; ++n) _Pragma("unroll") for (int k = 0; k < 2; ++k) dst[n][k] = *(const PG8_LAS bf16x8*)(lds + PG8_SB(b, h) + boff + n * 2048 + k * 1024); } while (0)
#define PG8_MMA(ai, bj, At, Bt) do { __builtin_amdgcn_s_setprio(1); _Pragma("unroll") for (int m = 0; m < 4; ++m) _Pragma("unroll") for (int n = 0; n < 2; ++n) _Pragma("unroll") for (int k = 0; k < 2; ++k) \
        acc[ai][bj][m][n] = __builtin_amdgcn_mfma_f32_16x16x32_bf16(Bt[n][k], At[m][k], acc[ai][bj][m][n], 0, 0, 0); __builtin_amdgcn_s_setprio(0); } while (0)
#define PG8_WAIT_V(n) asm volatile("s_waitcnt vmcnt(" #n ")" ::: "memory")
#define PG8_WAIT_L(n) asm volatile("s_waitcnt lgkmcnt(" #n ")" ::: "memory")
#define PG8_BAR __builtin_amdgcn_s_barrier()
#define PG8_SCHED __builtin_amdgcn_sched_barrier(0)
    Unit cur, nxt; int ui = 0;
    if (!S.next(0, cur)) return;
    f32x4 acc[2][2][4][2];
#pragma unroll
    for (int a = 0; a < 2; ++a)
#pragma unroll
        for (int b = 0; b < 2; ++b)
#pragma unroll
            for (int m = 0; m < 4; ++m)
#pragma unroll
                for (int n = 0; n < 2; ++n) acc[a][b][m][n] = (f32x4){0.f, 0.f, 0.f, 0.f};
    bf16x8 At[4][2], B0[2][2], B1[2][2];
    const char* cA = (const char*)g.A + (size_t)cur.pm * tstepA; const char* cB = (const char*)g.Bt + (size_t)cur.pn * tstepB;
    PG8_STAGE(PG8_SB(0, 0), cB, voffB); PG8_STAGE(PG8_SB(0, 1), cB + hstepB, voffB); PG8_STAGE(PG8_SA(0, 0), cA, voffA); PG8_STAGE(PG8_SA(0, 1), cA + hstepA, voffA);
    if (wr == 1) PG8_BAR;
    PG8_WAIT_V(2); PG8_BAR;
    PG8_STAGE(PG8_SB(1, 0), cB + kstep, voffB); PG8_STAGE(PG8_SA(1, 0), cA + kstep, voffA); PG8_STAGE(PG8_SB(1, 1), cB + hstepB + kstep, voffB);
    PG8_WAIT_V(6); PG8_BAR;
    for (;;) {
        const bool has_next = S.next(ui + 1, nxt);
        const char* nA = has_next ? (const char*)g.A + (size_t)nxt.pm * tstepA : cA; const char* nB = has_next ? (const char*)g.Bt + (size_t)nxt.pn * tstepB : cB;
#pragma unroll 1
        for (int t = 0; t < nt; t += 2) {
            const bool last = (t == nt - 2);
            const char* a1 = cA + (size_t)(t + 1) * kstep;
            const char* a2 = last ? nA : cA + (size_t)(t + 2) * kstep; const char* b2 = last ? nB : cB + (size_t)(t + 2) * kstep;
            const char* a3 = a2 + kstep; const char* b3 = b2 + kstep;
            PG8_LDB(B0, 0, 0); PG8_LDB(B1, 0, 1); PG8_SCHED; PG8_LDA(At, 0, 0); PG8_STAGE(PG8_SA(1, 1), a1 + hstepA, voffA);
            PG8_WAIT_V(8); PG8_WAIT_L(0); PG8_BAR; PG8_MMA(0, 0, At, B0); PG8_MMA(0, 1, At, B1); PG8_BAR; PG8_SCHED;
            PG8_LDA(At, 0, 1); PG8_STAGE(PG8_SB(0, 0), b2, voffB); PG8_STAGE(PG8_SB(0, 1), b2 + hstepB, voffB); PG8_STAGE(PG8_SA(0, 0), a2, voffA);
            PG8_WAIT_V(8); PG8_WAIT_L(0); PG8_BAR; PG8_MMA(1, 0, At, B0); PG8_MMA(1, 1, At, B1); PG8_BAR; PG8_SCHED;
            PG8_LDB(B0, 1, 0); PG8_LDB(B1, 1, 1); PG8_SCHED; PG8_LDA(At, 1, 0); PG8_STAGE(PG8_SA(0, 1), a2 + hstepA, voffA);
            PG8_WAIT_V(8); PG8_WAIT_L(0); PG8_BAR; PG8_MMA(0, 0, At, B0); PG8_MMA(0, 1, At, B1); PG8_BAR; PG8_SCHED;
            PG8_LDA(At, 1, 1); PG8_STAGE(PG8_SB(1, 0), b3, voffB); PG8_STAGE(PG8_SB(1, 1), b3 + hstepB, voffB); PG8_STAGE(PG8_SA(1, 0), a3, voffA);
            PG8_WAIT_V(8); PG8_WAIT_L(0); PG8_BAR; PG8_MMA(1, 0, At, B0); PG8_MMA(1, 1, At, B1); PG8_BAR; PG8_SCHED;
        }
        if constexpr (ALIGN_EPI) { if (wr == 0) PG8_BAR; }
        E(acc, cur, wr, wc, fr, fq);
        if (!has_next) break;
#pragma unroll
        for (int a = 0; a < 2; ++a)
#pragma unroll
            for (int b = 0; b < 2; ++b)
#pragma unroll
                for (int m = 0; m < 4; ++m)
#pragma unroll
                    for (int n = 0; n < 2; ++n) acc[a][b][m][n] = (f32x4){0.f, 0.f, 0.f, 0.f};
        cur = nxt; cA = nA; cB = nB; ++ui;
        if constexpr (ALIGN_EPI) { if (wr == 1) PG8_BAR; }
    }
    PG8_WAIT_V(0);
    if constexpr (!ALIGN_EPI) { if (wr == 0) PG8_BAR; }
    PG8_BAR;
#undef PG8_SA
#undef PG8_SB
#undef PG8_STAGE
#undef PG8_LDA
#undef PG8_LDB
#undef PG8_MMA
#undef PG8_WAIT_V
#undef PG8_WAIT_L
#undef PG8_BAR
#undef PG8_SCHED
}
}

constexpr int NWAVES = 8;
constexpr int DM = 1024, NB = 16, SEQ = 2048, CTXL = 256;
constexpr int M = NB * SEQ, MC = NB * CTXL, MT = M + MC;
constexpr int QL = 384, KVL = 256, ROPE = 32, HW = 512, NH = 8, QKD = 96, VD = 64;
constexpr int INW = 3232, INP = 3328;
constexpr int DFF = 2816, NE = 8, DFE = 3584, NMOD = 6 * DM;
constexpr int NHH = 4, HK = 128; constexpr int NKEY = SEQ + CTXL;
constexpr float EPS = 1e-6f;
constexpr int MAXT = 296;
constexpr int MOE_CH = 128;

constexpr size_t MiB = 1u << 20;
constexpr size_t WS_CTL = 0, CTL_ZERO_BYTES = 1 * MiB;
constexpr size_t WS_MODV = 1 * MiB;
constexpr size_t WS_ROPE = 3 * MiB;
constexpr size_t WS_CNT = 3 * MiB + 64 * 1024;
constexpr size_t WS_TST = 3 * MiB + 128 * 1024;
constexpr size_t WS_EIDX = 4 * MiB, WS_GATE = 4 * MiB + 512 * 1024, WS_POS = 5 * MiB;
constexpr size_t WS_RSQ = 6 * MiB, WS_RSKV = 7 * MiB + 256 * 1024;
constexpr size_t WS_WIN = 8 * MiB, WS_WUQ = 21 * MiB, WS_WUKV = 23 * MiB, WS_WOUT = 24 * MiB, WS_WGU = 28 * MiB, WS_WDN = 50 * MiB, WS_WPOOL = 61 * MiB;
constexpr size_t WS_HB = 62 * MiB;
constexpr size_t WS_U = 134 * MiB;
constexpr size_t WS_X = 206 * MiB;
constexpr size_t WS_CQ = WS_X, WS_CKV = 233 * MiB, WS_KRR = 251 * MiB, WS_HQ = 254 * MiB  ;
constexpr size_t WS_QB = 434 * MiB, WS_KN = 488 * MiB, WS_VV = 524 * MiB, WS_OF = 560 * MiB, WS_OB = 632 * MiB, WS_MIX = 704 * MiB, WS_HID = WS_X;
constexpr size_t WS_MWGU = WS_X, WS_MWDN = 318 * MiB, WS_VG = 374 * MiB, WS_POOLED = WS_VG  , WS_HIDM = 522 * MiB, WS_END = 970 * MiB;
constexpr size_t HSEG = (size_t)MT * HW;
static_assert(WS_WPOOL + (size_t)2 * 4 * 65536 * 2 <= WS_HB && WS_HB + (size_t)MT * DM * 2 <= WS_U && WS_U + (size_t)MT * DM * 2 <= WS_X && WS_KRR + (size_t)MT * ROPE * 2 <= WS_HQ && WS_HQ + 5 * HSEG * 2 <= WS_QB && WS_MIX + (size_t)MT * DM * 2 <= WS_END && WS_HID + (size_t)MT * DFF * 2 <= WS_QB, "ws map even");
static_assert(WS_HIDM + (size_t)2 * MOE_CH * 256 * DFE * 2 <= WS_END && WS_VG + (size_t)MAXT * 256 * DM * 2 <= WS_HIDM && WS_MWDN + (size_t)NE * DM * DFE * 2 <= WS_VG && WS_MWGU + (size_t)NE * 2 * DFE * DM * 2 <= WS_MWDN, "ws map odd");
constexpr int CW_BAR = 4096;

constexpr int RING_OFF = 0, RING_BYTES = 143360;
constexpr int LDSCTL_OFF = RING_BYTES, MISC_OFF = LDSCTL_OFF + 320;
constexpr int LDS_BYTES = 147456;

#define GAS __attribute__((address_space(1)))
#define LAS __attribute__((address_space(3)))
typedef unsigned short bf16;
typedef unsigned v4u __attribute__((ext_vector_type(4)));
typedef unsigned v2u __attribute__((ext_vector_type(2)));
typedef float f32x4 __attribute__((ext_vector_type(4)));
typedef GAS unsigned gu32;
#define RLX_AGENT __ATOMIC_RELAXED, __HIP_MEMORY_SCOPE_AGENT
#define LDS_WAIT() asm volatile("s_waitcnt lgkmcnt(0)" ::: "memory")
__device__ __forceinline__ unsigned f2bf(float f) { unsigned u = __builtin_bit_cast(unsigned, f); return (u + 0x7fffu + ((u >> 16) & 1u)) >> 16; }
__device__ __forceinline__ unsigned pk2(float lo, float hi) { return f2bf(lo) | (f2bf(hi) << 16); }
__device__ __forceinline__ float bf2f(unsigned short b) { return __uint_as_float((unsigned)b << 16); }
__device__ __forceinline__ float bflo(unsigned w) { return __uint_as_float(w << 16); }
__device__ __forceinline__ float bfhi(unsigned w) { return __uint_as_float(w & 0xffff0000u); }
__device__ __forceinline__ float sigmoidf_(float x) { return 1.0f / (1.0f + __expf(-x)); }
__device__ __forceinline__ float siluf_(float x) { return x * __builtin_amdgcn_rcpf(1.0f + __expf(-x)); }

#define XB_TMO      128
#define XB_XCNT(j)  (256  + 64 * (j))
#define XB_XSUB(j)  (1280 + 64 * (j))
#define XB_XGEN(j)  (2304 + 64 * (j))
#define XB_TOP      3328
#define XB_TOPGEN   3392
#define XCD_BAR_WORDS 3456
#define XB_SPIN_CAP (1u << 22)
__device__ __forceinline__ unsigned xb_ld(unsigned* p)              { return __hip_atomic_load(p, __ATOMIC_RELAXED, __HIP_MEMORY_SCOPE_AGENT); }
__device__ __forceinline__ unsigned xb_add(unsigned* p, unsigned v) { return __hip_atomic_fetch_add(p, v, __ATOMIC_RELAXED, __HIP_MEMORY_SCOPE_AGENT); }
__device__ __forceinline__ unsigned xb_xcc_id() { return (unsigned)__builtin_amdgcn_s_getreg((3 << 11) | 20) & 0xFu; }
#define XB_SPIN(cond, bar) do { unsigned _sp = 0; while (cond) { __builtin_amdgcn_s_sleep(1); \
    if ((++_sp & 255u) == 0u) { if (xb_ld(&(bar)[XB_TMO])) break; if (_sp > XB_SPIN_CAP) { atomicAdd(&(bar)[XB_TMO], 1u); break; } } } } while (0)
struct XcdBarrier { unsigned* bar; unsigned x; volatile LAS unsigned* st; int wave; };
__device__ __forceinline__ bool xb_leader(int wave) { return wave == 0 && lane_now() == 0; }
__device__ __forceinline__ XcdBarrier xcd_barrier_post(unsigned* bar, volatile LAS unsigned* st, int wave) {
    XcdBarrier b; b.bar = bar; b.x = xb_xcc_id(); b.st = st; b.wave = wave;
    if (xb_leader(wave)) (void)xb_add(&bar[XB_XCNT(b.x)], 1u);
    return b;
}
__device__ __forceinline__ void xcd_barrier_complete(unsigned* bar, unsigned x, unsigned& nloc, unsigned& nx) {
    const unsigned G = gridDim.x * gridDim.y * gridDim.z;
    unsigned sum, cnt, mine, sp = 0u;
    for (;;) {
        sum = 0u; cnt = 0u; mine = 0u;
#pragma unroll
        for (unsigned j = 0; j < 16; ++j) { const unsigned c = xb_ld(&bar[XB_XCNT(j)]); sum += c; cnt += (c > 0u) ? 1u : 0u; mine = (j == x) ? c : mine; }
        if (sum == G) break;
        __builtin_amdgcn_s_sleep(1);
        if ((++sp & 255u) == 0u) { if (xb_ld(&bar[XB_TMO])) break; if (sp > XB_SPIN_CAP) { atomicAdd(&bar[XB_TMO], 1u); break; } }
    }
    nloc = mine > 0u ? mine : 1u; nx = cnt > 0u ? cnt : 1u;
}
__device__ __forceinline__ void xcd_barrier(const XcdBarrier& b) {
    asm volatile("s_waitcnt vmcnt(0)" ::: "memory");
    __syncthreads();
    if (xb_leader(b.wave)) {
        unsigned* bar = b.bar; asm volatile("" : "+s"(bar));
        __builtin_amdgcn_s_waitcnt(0);
        unsigned nloc = b.st[0], nx = b.st[1];
        if (nloc == 0u) { xcd_barrier_complete(bar, b.x, nloc, nx); b.st[0] = nloc; b.st[1] = nx; }
        const unsigned old = xb_add(&bar[XB_XSUB(b.x)], 1u);
        const unsigned gen = old / nloc;
        if (old + 1u == (gen + 1u) * nloc) {
            __builtin_amdgcn_fence(__ATOMIC_RELEASE, "agent");
            asm volatile("s_waitcnt vmcnt(0)" ::: "memory");
            const unsigned og = xb_add(&bar[XB_TOP], 1u);
            const unsigned tg = og / nx;
            if (og + 1u == (tg + 1u) * nx) xb_add(&bar[XB_TOPGEN], 1u);
            else XB_SPIN(xb_ld(&bar[XB_TOPGEN]) == tg, bar);
            __builtin_amdgcn_fence(__ATOMIC_ACQUIRE, "agent");
            xb_add(&bar[XB_XGEN(b.x)], 1u);
            asm volatile("s_waitcnt vmcnt(0)" ::: "memory");
        } else {
            XB_SPIN(xb_ld(&bar[XB_XGEN(b.x)]) == gen, bar);
            __builtin_amdgcn_fence(__ATOMIC_ACQUIRE, "agent");
            asm volatile("s_waitcnt vmcnt(0)" ::: "memory");
        }
    }
    __syncthreads();
}

struct Args { const float* in[26]; float* out; unsigned char* ws; };
struct Frame {
    LAS unsigned char* lds;
    int tid, lane, wave, G, vcu;
    const float* const* in; float* out; unsigned char* ws;
};
__device__ __forceinline__ float shx(float v, int lane, int m) { return __int_as_float(__builtin_amdgcn_ds_bpermute((lane ^ m) << 2, __float_as_int(v))); }
__device__ __forceinline__ float wave_sum(float v, int lane) {
#pragma unroll
    for (int o = 1; o < 64; o <<= 1) v += shx(v, lane, o);
    return v;
}

__device__ __forceinline__ void fresh(Frame& F) { const int l = lane_now(); F.lane = l; F.tid = F.wave * 64 + l; }

__device__ __forceinline__ void conv_item(const float* W, int ldw, bf16* WT, int ldd, int k0, int n0, int drow0, const float* kscale, float gscale, LAS float* scr, int lane) {
    float wv[32];
#pragma unroll
    for (int i = 0; i < 32; ++i) { const int kk = 2 * i + (lane >> 5); wv[i] = W[(size_t)(k0 + kk) * ldw + n0 + (lane & 31)]; }
#pragma unroll
    for (int i = 0; i < 32; ++i) { const int kk = 2 * i + (lane >> 5); float w = wv[i]; if (kscale) w *= kscale[k0 + kk]; scr[kk * 33 + (lane & 31)] = w * gscale; }
    LDS_WAIT(); asm volatile("" ::: "memory");
    const int c = lane & 7;
#pragma unroll
    for (int j = 0; j < 4; ++j) { const int n = (lane >> 3) + 8 * j; const LAS float* s = scr + (8 * c) * 33 + n;
        v4u o; o.x = pk2(s[0 * 33], s[1 * 33]); o.y = pk2(s[2 * 33], s[3 * 33]); o.z = pk2(s[4 * 33], s[5 * 33]); o.w = pk2(s[6 * 33], s[7 * 33]);
        *(v4u*)(WT + (size_t)(drow0 + n) * ldd + k0 + 8 * c) = o; }
    LDS_WAIT(); asm volatile("" ::: "memory");
}
__device__ __forceinline__ int conv_rowmap(int mode, int n0, int off) {
    if (mode == 0) return n0 + off;
    if (mode == 1) { if (n0 < 384) return n0; if (n0 < 640) return 512 + (n0 - 384); if (n0 < 672) return 384; return 768 + (n0 - 672); }
    return 256 * (n0 >> 7) + (n0 & 127) + off;
}
__device__ __forceinline__ void conv_matrix(Frame& F, const float* W, int K, int N, bf16* WT, int ldd, int mode, int off, const float* kscale, float gscale) {
    LAS float* scr = (LAS float*)(F.lds + RING_OFF + F.wave * 16384);
    const int gw = F.vcu * NWAVES + F.wave, NGW = F.G * NWAVES;
    const int nblk = N / 32, nitems = (K / 64) * nblk;
    for (int it = gw; it < nitems; it += NGW) { const int kb = it / nblk, nb = it % nblk; conv_item(W, N, WT, ldd, 64 * kb, 32 * nb, conv_rowmap(mode, 32 * nb, off), kscale, gscale, scr, F.lane); }
}

__device__ __forceinline__ int row_bidx(int row) { return row < M ? row / SEQ : NB; }

struct RowArgs {
    const float* xin_l; const float* xin_c;
    const bf16* hb; bf16* hbo;
    float* fout;
    const float* g;
    const float* modl;
    int shoff, scoff;
    bf16* U;
    const bf16* Y; const int* pos; const float* gate; const float* modprev;
    const float* router; int* eidx; float* gout; int* cnt;
};
template <bool COMBINE, int OUTMODE, bool ROUTER, bool INF32>
__device__ __forceinline__ void row_phase(Frame& F, const RowArgs& A, int nrows) {
    fresh(F);
    const int rpw = (nrows + F.G - 1) / F.G;
    LAS int* lcnt = (LAS int*)(F.lds + RING_OFF);
    if (ROUTER) { if (F.tid < 8) lcnt[F.tid] = 0; __syncthreads(); }
    const int rbase = (int)blockIdx.x * rpw, rend = (rbase + rpw < nrows) ? rbase + rpw : nrows;
#define ROWLOAD(dst, r_) do { if (INF32) { const float* hr_ = ((r_) < M) ? A.xin_l + (size_t)(r_) * DM : A.xin_c + (size_t)((r_) - M) * DM; \
            _Pragma("unroll") for (int j = 0; j < 4; ++j) dst[j] = *(const f32x4*)(hr_ + 4 * F.lane + 256 * j); } \
        else { _Pragma("unroll") for (int j = 0; j < 4; ++j) { const v2u w_ = *(const v2u*)(A.hb + (size_t)(r_) * DM + 4 * F.lane + 256 * j); dst[j] = (f32x4){bflo(w_.x), bfhi(w_.x), bflo(w_.y), bfhi(w_.y)}; } } } while (0)
    f32x4 rw[16][2];
    if (ROUTER) {
#pragma unroll
        for (int j = 0; j < 4; ++j)
#pragma unroll
            for (int q = 0; q < 4; ++q) { const int col = 4 * F.lane + 256 * j + q; rw[4 * j + q][0] = *(const f32x4*)(A.router + (size_t)col * 8); rw[4 * j + q][1] = *(const f32x4*)(A.router + (size_t)col * 8 + 4); }
    }
    int row = rbase + F.wave;
    f32x4 v[4], vn[4];
    if (row < rend) ROWLOAD(v, row);
    for (; row < rend; row += NWAVES) {
        const bool lat = row < M; const int bidx = lat ? row / SEQ : NB;
        const int rnext = row + NWAVES;
        if (rnext < rend) ROWLOAD(vn, rnext);
        if (COMBINE) {
            const int pa = A.pos[2 * row], pb = A.pos[2 * row + 1]; const float ga = A.gate[2 * row], gb = A.gate[2 * row + 1];
            const float* g2 = A.modprev + bidx * NMOD + 5 * DM;
#pragma unroll
            for (int j = 0; j < 4; ++j) { const int col = 4 * F.lane + 256 * j;
                const v2u ya = *(const v2u*)(A.Y + (size_t)pa * DM + col), yb = *(const v2u*)(A.Y + (size_t)pb * DM + col); const f32x4 gv = *(const f32x4*)(g2 + col);
                v[j].x += gv.x * (ga * bflo(ya.x) + gb * bflo(yb.x)); v[j].y += gv.y * (ga * bfhi(ya.x) + gb * bfhi(yb.x));
                v[j].z += gv.z * (ga * bflo(ya.y) + gb * bflo(yb.y)); v[j].w += gv.w * (ga * bfhi(ya.y) + gb * bfhi(yb.y)); }
            if (OUTMODE != 2) {
#pragma unroll
                for (int j = 0; j < 4; ++j) { v2u o; o.x = pg8::cvt_pk_bf16(v[j].x, v[j].y); o.y = pg8::cvt_pk_bf16(v[j].z, v[j].w); *(v2u*)(A.hbo + (size_t)row * DM + 4 * F.lane + 256 * j) = o;
                    v[j] = (f32x4){bflo(o.x), bfhi(o.x), bflo(o.y), bfhi(o.y)}; }
            }
        }
        float s = 0.f;
#pragma unroll
        for (int j = 0; j < 4; ++j) s += (v[j].x * v[j].x + v[j].y * v[j].y) + (v[j].z * v[j].z + v[j].w * v[j].w);
        const float rstd = rsqrtf(wave_sum(s, F.lane) * (1.0f / DM) + EPS);
        if (OUTMODE == 2) {
            float* ho = A.fout + (size_t)row * DM;
#pragma unroll
            for (int j = 0; j < 4; ++j) { const int col = 4 * F.lane + 256 * j; const f32x4 gv = *(const f32x4*)(A.g + col); *(f32x4*)(ho + col) = v[j] * rstd * gv; }
        } else {
            const float* sh = A.modl + bidx * NMOD + A.shoff; const float* sc = A.modl + bidx * NMOD + A.scoff;
            float lg[8];
            if (ROUTER) {
#pragma unroll
                for (int e = 0; e < 8; ++e) lg[e] = 0.f;
            }
#pragma unroll
            for (int j = 0; j < 4; ++j) { const int col = 4 * F.lane + 256 * j; const f32x4 gv = *(const f32x4*)(A.g + col), shv = *(const f32x4*)(sh + col), scv = *(const f32x4*)(sc + col);
                f32x4 y = v[j] * rstd * gv * (scv + 1.0f) + shv;
                v2u o; o.x = pg8::cvt_pk_bf16(y.x, y.y); o.y = pg8::cvt_pk_bf16(y.z, y.w); *(v2u*)(A.U + (size_t)row * DM + col) = o;
                if (ROUTER) {
#pragma unroll
                    for (int q = 0; q < 4; ++q) { const f32x4 r0 = rw[4 * j + q][0], r1 = rw[4 * j + q][1]; const float yy = y[q];
                        lg[0] += yy * r0.x; lg[1] += yy * r0.y; lg[2] += yy * r0.z; lg[3] += yy * r0.w; lg[4] += yy * r1.x; lg[5] += yy * r1.y; lg[6] += yy * r1.z; lg[7] += yy * r1.w; } }
            }
            if (ROUTER) {
                const int b5 = F.lane >> 5, b4 = (F.lane >> 4) & 1, b3 = (F.lane >> 3) & 1; float a4[4], c2[2];
#pragma unroll
                for (int q = 0; q < 4; ++q) { const float mine = b5 ? lg[4 + q] : lg[q], oth = b5 ? lg[q] : lg[4 + q]; a4[q] = mine + shx(oth, F.lane, 32); }
#pragma unroll
                for (int q = 0; q < 2; ++q) { const float mine = b4 ? a4[2 + q] : a4[q], oth = b4 ? a4[q] : a4[2 + q]; c2[q] = mine + shx(oth, F.lane, 16); }
                float d1 = (b3 ? c2[1] : c2[0]) + shx(b3 ? c2[0] : c2[1], F.lane, 8);
                d1 += shx(d1, F.lane, 4); d1 += shx(d1, F.lane, 2); d1 += shx(d1, F.lane, 1);
#pragma unroll
                for (int e = 0; e < 8; ++e) lg[e] = __int_as_float(__builtin_amdgcn_readlane(__float_as_int(d1), 8 * e));
                int i0 = 0; float v0 = lg[0];
#pragma unroll
                for (int e = 1; e < 8; ++e) if (lg[e] > v0) { v0 = lg[e]; i0 = e; }
                int i1 = -1; float v1 = -INFINITY;
#pragma unroll
                for (int e = 0; e < 8; ++e) if (e != i0 && lg[e] > v1) { v1 = lg[e]; i1 = e; }
                const float g0 = 1.0f / (1.0f + __expf(v1 - v0));
                if (F.lane == 0) { A.eidx[2 * row] = i0; A.eidx[2 * row + 1] = i1; A.gout[2 * row] = g0; A.gout[2 * row + 1] = 1.0f - g0; atomicAdd((int*)&lcnt[i0], 1); atomicAdd((int*)&lcnt[i1], 1); }
            }
        }
#pragma unroll
        for (int j = 0; j < 4; ++j) v[j] = vn[j];
    }
#undef ROWLOAD
    if (ROUTER) { __syncthreads(); if (F.tid < 8) A.cnt[blockIdx.x * 8 + F.tid] = lcnt[F.tid]; __syncthreads(); }
}

using pg8::Unit; using pg8::cvt_pk_bf16;
__device__ __forceinline__ v4u pack8(const f32x4& a, const f32x4& b) { v4u w; w.x = cvt_pk_bf16(a[0], a[1]); w.y = cvt_pk_bf16(a[2], a[3]); w.z = cvt_pk_bf16(b[0], b[1]); w.w = cvt_pk_bf16(b[2], b[3]); return w; }
struct EpiIn {
    static constexpr bool PERM = true;
    bf16 *CQ, *KRR, *CKV, *H5; float* ssq_q; float* ssq_kv; const float* TC; const float* LBj; int jlayer;
    __device__ __forceinline__ void operator()(const f32x4 (&acc)[2][2][4][2], const Unit& u, int wr, int wc, int fr, int fq) const {
        const int row0 = u.pm * 256 + wr * 64 + fr; const int lane = fr + 16 * fq;
#pragma unroll
        for (int bj = 0; bj < 2; ++bj) {
            const int col = u.pn * 256 + bj * 128 + wc * 32 + 8 * fq;
            bf16* base; int ld;
            if (col < 384) { base = CQ + col; ld = QL; }
            else if (col < 512) { base = nullptr; ld = 0; }
            else if (col < 768) { base = CKV + (col - 512); ld = KVL; }
            else { const int c2 = col - 768; base = H5 + (size_t)(c2 >> 9) * HSEG + (c2 & 511); ld = HW; }
            const int hsel = (col >= 768) ? ((col - 768) >> 9) : 3;
            if (hsel <= 2) {
                f32x4 lb0 = (f32x4){0.f, 0.f, 0.f, 0.f}, lb1 = lb0; if (hsel >= 1 && jlayer == 1) { const float* l0_ = LBj + (hsel - 1) * HW + ((col - 768) & 511); const float* l1_ = l0_ + 2 * HW; const f32x4 a0 = *(const f32x4*)l0_, a1 = *(const f32x4*)(l0_ + 4), b0 = *(const f32x4*)l1_, b1 = *(const f32x4*)(l1_ + 4);
#pragma unroll
                    for (int q = 0; q < 4; ++q) { lb0[q] = 1.0f / (1.0f + __expf(a0[q] - b0[q])); lb1[q] = 1.0f / (1.0f + __expf(a1[q] - b1[q])); } }
#pragma unroll
                for (int ai = 0; ai < 2; ++ai)
#pragma unroll
                    for (int m = 0; m < 4; ++m) { const int row = row0 + ai * 128 + m * 16; f32x4 o[2];
#pragma unroll
                        for (int n = 0; n < 2; ++n)
#pragma unroll
                            for (int q = 0; q < 4; ++q) { const float x = acc[ai][bj][m][n][q]; const float sg = __builtin_amdgcn_rcpf(1.0f + __expf(-x)); const float lbv = n ? lb1[q] : lb0[q];
                                o[n][q] = (hsel == 0) ? x * sg : __logf(lbv + (1.0f - lbv) * sg); }
                        *(v4u*)(base + (size_t)row * ld) = pack8(o[0], o[1]); }
            } else if (base) {
#pragma unroll
                for (int ai = 0; ai < 2; ++ai)
#pragma unroll
                    for (int m = 0; m < 4; ++m) { const int row = row0 + ai * 128 + m * 16; *(v4u*)(base + (size_t)row * ld) = pack8(acc[ai][bj][m][0], acc[ai][bj][m][1]); }
            }
        }
        if (u.pn <= 2) {
            const int nb = (u.pn == 1) ? 1 : 2; float* dst = (u.pn == 2) ? ssq_kv : ssq_q;
#pragma unroll
            for (int ai = 0; ai < 2; ++ai)
#pragma unroll
                for (int m = 0; m < 4; ++m) { float ss = 0.f;
#pragma unroll
                    for (int bj = 0; bj < 2; ++bj) if (bj < nb) {
#pragma unroll
                        for (int n = 0; n < 2; ++n) { const f32x4 x = acc[ai][bj][m][n]; ss += (x[0] * x[0] + x[1] * x[1]) + (x[2] * x[2] + x[3] * x[3]); } }
                    ss += shx(ss, lane, 16); ss += shx(ss, lane, 32);
                    if (fq == 0) { const int row = row0 + ai * 128 + m * 16; if (u.pn == 2) dst[row * 4 + wc] = ss; else dst[row * 8 + u.pn * 4 + wc] = ss; } }
            if (u.pn == 1 && wc == 0) {
                const int a = fq >> 1, half = fq & 1;
#pragma unroll
                for (int ai = 0; ai < 2; ++ai)
#pragma unroll
                    for (int m = 0; m < 4; ++m) { const int row = row0 + ai * 128 + m * 16; f32x4 o[2];
                        const bool lat = row < M; const int t = row % SEQ; const int p = a ? (t & 63) : (t >> 6);
#pragma unroll
                        for (int n = 0; n < 2; ++n)
#pragma unroll
                            for (int q = 0; q < 4; ++q) { const float x = acc[ai][1][m][n][q]; const float pr = shx(x, lane, 16); const float c = TC[p * 8 + 4 * n + q], sn = TC[512 + p * 8 + 4 * n + q];
                                o[n][q] = lat ? (half ? x * c + pr * sn : x * c - pr * sn) : x; }
                        *(v4u*)(KRR + (size_t)row * ROPE + 8 * fq) = pack8(o[0], o[1]); }
            }
        }
    }
};
struct EpiQ {
    static constexpr bool PERM = true;
    bf16* O; const float* rs;
    __device__ __forceinline__ void operator()(const f32x4 (&acc)[2][2][4][2], const Unit& u, int wr, int wc, int fr, int fq) const {
        const int row0 = u.pm * 256 + wr * 64 + fr;
#pragma unroll
        for (int ai = 0; ai < 2; ++ai)
#pragma unroll
            for (int m = 0; m < 4; ++m) { const int row = row0 + ai * 128 + m * 16; const f32x4 p0 = *(const f32x4*)(rs + (size_t)row * 8), p1 = *(const f32x4*)(rs + (size_t)row * 8 + 4); const float sc = rsqrtf((((p0.x + p0.y) + (p0.z + p0.w)) + ((p1.x + p1.y) + (p1.z + p1.w))) * (1.0f / QL) + EPS);
#pragma unroll
                for (int bj = 0; bj < 2; ++bj) { const int col = u.pn * 256 + bj * 128 + wc * 32 + 8 * fq; *(v4u*)(O + (size_t)row * 768 + col) = pack8(acc[ai][bj][m][0] * sc, acc[ai][bj][m][1] * sc); } }
    }
};
struct EpiKV {
    static constexpr bool PERM = true;
    bf16* KNp; bf16* VTp; const float* rs;
    __device__ __forceinline__ void operator()(const f32x4 (&acc)[2][2][4][2], const Unit& u, int wr, int wc, int fr, int fq) const {
        const int row0 = u.pm * 256 + wr * 64 + fr;
#pragma unroll
        for (int ai = 0; ai < 2; ++ai)
#pragma unroll
            for (int m = 0; m < 4; ++m) { const int row = row0 + ai * 128 + m * 16; const f32x4 p0 = *(const f32x4*)(rs + (size_t)row * 4); const float sc = rsqrtf(((p0.x + p0.y) + (p0.z + p0.w)) * (1.0f / KVL) + EPS);
                const bool lat = row < M; const int b = lat ? row / SEQ : (row - M) / CTXL; const int key = lat ? row % SEQ : SEQ + (row - M) % CTXL;
                const int kpos = (key & ~12) | ((key & 4) << 1) | ((key & 8) >> 1);
#pragma unroll
                for (int bj = 0; bj < 2; ++bj) { const int col = u.pn * 256 + bj * 128 + wc * 32 + 8 * fq; const int hh = col >> 7, w = col & 127;
                    if (w < 64) { *(v4u*)(KNp + (size_t)row * HW + hh * 64 + w) = pack8(acc[ai][bj][m][0] * sc, acc[ai][bj][m][1] * sc); }
                    else { bf16* dst = VTp + ((size_t)((b * NH + hh) * VD + (w - 64))) * NKEY + kpos;
#pragma unroll
                        for (int n = 0; n < 2; ++n)
#pragma unroll
                            for (int q = 0; q < 4; ++q) dst[(size_t)(4 * n + q) * NKEY] = (bf16)f2bf(acc[ai][bj][m][n][q] * sc); } } }
    }
};
template <bool INF32>
struct EpiResid {
    static constexpr bool PERM = true;
    const float* xin_l; const float* xin_c; bf16* hb; const float* modl; int goff;
    __device__ __forceinline__ void operator()(const f32x4 (&acc)[2][2][4][2], const Unit& u, int wr, int wc, int fr, int fq) const {
        const int rowt = u.pm * 256; const bool lat = rowt < M; const int bidx = lat ? rowt / SEQ : NB;
        const float* gate = modl + bidx * NMOD + goff;
        const float* xi = lat ? xin_l + (size_t)rowt * DM : xin_c + (size_t)(rowt - M) * DM;
        bf16* ho = hb + (size_t)rowt * DM;
        const unsigned off0 = (unsigned)((wr * 64 + fr) * DM + u.pn * 256 + wc * 32 + 8 * fq);
#pragma unroll
        for (int bj = 0; bj < 2; ++bj) { const f32x4 g0 = *(const f32x4*)(gate + (off0 & 1023u) + bj * 128), g1 = *(const f32x4*)(gate + (off0 & 1023u) + bj * 128 + 4);
#pragma unroll
            for (int ai = 0; ai < 2; ++ai) {
                if (INF32) { f32x4 h0[4], h1[4];
#pragma unroll
                    for (int m = 0; m < 4; ++m) { const unsigned off = off0 + (unsigned)((ai * 128 + m * 16) * DM + bj * 128); h0[m] = *(const f32x4*)(xi + off); h1[m] = *(const f32x4*)(xi + off + 4); }
#pragma unroll
                    for (int m = 0; m < 4; ++m) { const unsigned off = off0 + (unsigned)((ai * 128 + m * 16) * DM + bj * 128); *(v4u*)(ho + off) = pack8(h0[m] + g0 * acc[ai][bj][m][0], h1[m] + g1 * acc[ai][bj][m][1]); }
                } else { v4u hv[4];
#pragma unroll
                    for (int m = 0; m < 4; ++m) { const unsigned off = off0 + (unsigned)((ai * 128 + m * 16) * DM + bj * 128); hv[m] = *(const v4u*)(ho + off); }
#pragma unroll
                    for (int m = 0; m < 4; ++m) { const unsigned off = off0 + (unsigned)((ai * 128 + m * 16) * DM + bj * 128); const v4u w = hv[m];
                        const f32x4 a0 = (f32x4){bflo(w.x), bfhi(w.x), bflo(w.y), bfhi(w.y)}, a1 = (f32x4){bflo(w.z), bfhi(w.z), bflo(w.w), bfhi(w.w)};
                        *(v4u*)(ho + off) = pack8(a0 + g0 * acc[ai][bj][m][0], a1 + g1 * acc[ai][bj][m][1]); }
                }
                asm volatile("" ::: "memory"); } }
    }
};
struct EpiPool {
    static constexpr bool PERM = true;
    bf16* hb; const float* modl; const float* bias; const float* scale; int talloc;
    __device__ __forceinline__ void operator()(const f32x4 (&acc)[2][2][4][2], const Unit& u, int wr, int wc, int fr, int fq) const {
        const int g = u.pn, rowt = (u.pm - g * talloc) * 256; const bool lat = rowt < M; const int bidx = lat ? rowt / SEQ : NB;
        const float* gate = modl + bidx * NMOD + 2 * DM;
        bf16* ho = hb + (size_t)rowt * DM;
        const int col0 = g * 256 + wc * 32 + 8 * fq;
#pragma unroll
        for (int bj = 0; bj < 2; ++bj) { const int c = col0 + bj * 128;
            v4u hv[2][4];
#pragma unroll
            for (int ai = 0; ai < 2; ++ai)
#pragma unroll
                for (int m = 0; m < 4; ++m) hv[ai][m] = *(const v4u*)(ho + (size_t)(ai * 128 + wr * 64 + m * 16 + fr) * DM + c);
            const f32x4 gm0 = *(const f32x4*)(gate + c) * *(const f32x4*)(scale + c), gm1 = *(const f32x4*)(gate + c + 4) * *(const f32x4*)(scale + c + 4);
            const f32x4 gb0 = gm0 * *(const f32x4*)(bias + c), gb1 = gm1 * *(const f32x4*)(bias + c + 4);
#pragma unroll
            for (int ai = 0; ai < 2; ++ai)
#pragma unroll
                for (int m = 0; m < 4; ++m) { const v4u w = hv[ai][m]; const f32x4 a0 = (f32x4){bflo(w.x), bfhi(w.x), bflo(w.y), bfhi(w.y)}, a1 = (f32x4){bflo(w.z), bfhi(w.z), bflo(w.w), bfhi(w.w)};
                    *(v4u*)(ho + (size_t)(ai * 128 + wr * 64 + m * 16 + fr) * DM + c) = pack8(a0 + gm0 * acc[ai][bj][m][0] + gb0, a1 + gm1 * acc[ai][bj][m][1] + gb1); }
            asm volatile("" ::: "memory"); }
    }
};
struct EpiGateUp {
    static constexpr bool PERM = true;
    bf16* H; int ldh, nct, rowsub;
    __device__ __forceinline__ void operator()(const f32x4 (&acc)[2][2][4][2], const Unit& u, int wr, int wc, int fr, int fq) const {
        const int row0 = u.pm * 256 + wr * 64 + fr - rowsub; const int ct = u.pn % nct; const int col = ct * 128 + wc * 32 + 8 * fq;
#pragma unroll
        for (int ai = 0; ai < 2; ++ai)
#pragma unroll
            for (int m = 0; m < 4; ++m) { const int row = row0 + ai * 128 + m * 16; f32x4 o[2];
#pragma unroll
                for (int n = 0; n < 2; ++n)
#pragma unroll
                    for (int q = 0; q < 4; ++q) { const float gv = acc[ai][0][m][n][q], uv = acc[ai][1][m][n][q]; o[n][q] = gv * uv * __builtin_amdgcn_rcpf(1.0f + __expf(-gv)); }
                *(v4u*)(H + (size_t)row * ldh + col) = pack8(o[0], o[1]); }
    }
};
struct EpiY {
    static constexpr bool PERM = true;
    bf16* Y; int nct;
    __device__ __forceinline__ void operator()(const f32x4 (&acc)[2][2][4][2], const Unit& u, int wr, int wc, int fr, int fq) const {
        const int row0 = u.pm * 256 + wr * 64 + fr; const int ct = u.pn % nct;
#pragma unroll
        for (int ai = 0; ai < 2; ++ai)
#pragma unroll
            for (int m = 0; m < 4; ++m) { const int row = row0 + ai * 128 + m * 16;
#pragma unroll
                for (int bj = 0; bj < 2; ++bj) { const int col = ct * 256 + bj * 128 + wc * 32 + 8 * fq; *(v4u*)(Y + (size_t)row * DM + col) = pack8(acc[ai][bj][m][0], acc[ai][bj][m][1]); } }
    }
};

__device__ __forceinline__ void p0_prologue(Frame& F) {
    fresh(F);
    unsigned char* ws = F.ws;
    const float qscale = 0.10206207261596577f * 1.4426950408889634f;
    for (int j = 0; j < 2; ++j) {
        conv_matrix(F, F.in[8] + (size_t)j * DM * INW, DM, INW, (bf16*)(ws + WS_WIN) + (size_t)j * INP * DM, DM, 1, 0, nullptr, 1.f);
        conv_matrix(F, F.in[11] + (size_t)j * QL * 768, QL, 768, (bf16*)(ws + WS_WUQ) + (size_t)j * 768 * QL, QL, 0, 0, F.in[9] + j * QL, qscale);
        conv_matrix(F, F.in[12] + (size_t)j * KVL * 1024, KVL, 1024, (bf16*)(ws + WS_WUKV) + (size_t)j * 1024 * KVL, KVL, 0, 0, F.in[10] + j * KVL, 1.f);
        conv_matrix(F, F.in[15] + (size_t)j * DM * DM, DM, DM, (bf16*)(ws + WS_WOUT) + (size_t)j * DM * DM, DM, 0, 0, nullptr, 1.f);
        conv_matrix(F, F.in[16] + (size_t)j * DM * DFF, DM, DFF, (bf16*)(ws + WS_WGU) + (size_t)j * 2 * DFF * DM, DM, 2, 0, nullptr, 1.f);
        conv_matrix(F, F.in[17] + (size_t)j * DM * DFF, DM, DFF, (bf16*)(ws + WS_WGU) + (size_t)j * 2 * DFF * DM, DM, 2, 128, nullptr, 1.f);
        conv_matrix(F, F.in[18] + (size_t)j * DFF * DM, DFF, DM, (bf16*)(ws + WS_WDN) + (size_t)j * DM * DFF, DFF, 0, 0, nullptr, 1.f);
        for (int g = 0; g < 4; ++g)
            conv_matrix(F, F.in[19] + (size_t)(j * 4 + g) * 65536, 256, 256, (bf16*)(ws + WS_WPOOL) + (size_t)(j * 4 + g) * 65536, 256, 0, 0, nullptr, 1.f);
    }
    __syncthreads();
    if (blockIdx.x == 0 && F.tid < 8) {
        float* TC = (float*)(ws + WS_ROPE); float* TS = TC + 512;
        double th = 1.0; for (int i = 0; i < F.tid; ++i) th *= 0.31622776601683794;
        const double x2 = th * th; double s = th, c = 1.0, ts = th, tc = 1.0;
        for (int n = 1; n <= 12; ++n) { tc *= -x2 / (double)((2 * n - 1) * (2 * n)); c += tc; ts *= -x2 / (double)((2 * n) * (2 * n + 1)); s += ts; }
        double cp = 1.0, sp = 0.0;
        for (int p = 0; p < 64; ++p) { TC[p * 8 + F.tid] = (float)cp; TS[p * 8 + F.tid] = (float)sp; const double ncp = cp * c - sp * s; sp = sp * c + cp * s; cp = ncp; }
    }
    {
        LAS float* sc = (LAS float*)(F.lds + RING_OFF);
        LAS float* red = sc + 17 * 1024;
        const int nitems = 4 * (NMOD / 64);
        if ((int)blockIdx.x < nitems) {
            for (int e = F.tid; e < 17 * 1024; e += 512) { const int r = e >> 10, k = e & 1023; const float x = (r < 16) ? F.in[1][r * 1024 + k] : F.in[3][k]; sc[e] = siluf_(x); }
            __syncthreads();
            for (int it = blockIdx.x; it < nitems; it += F.G) {
                const int l = it / (NMOD / 64), c0 = (it % (NMOD / 64)) * 64;
                const float* W = F.in[4] + (size_t)l * DM * NMOD + c0 + F.lane;
                float acc[17];
#pragma unroll
                for (int r = 0; r < 17; ++r) acc[r] = 0.f;
                const int kb = F.wave * 128;
                for (int k = 0; k < 128; k += 4) {
                    const float w0 = W[(size_t)(kb + k) * NMOD], w1 = W[(size_t)(kb + k + 1) * NMOD], w2 = W[(size_t)(kb + k + 2) * NMOD], w3 = W[(size_t)(kb + k + 3) * NMOD];
#pragma unroll
                    for (int r = 0; r < 17; ++r) { const f32x4 s4 = *(const LAS f32x4*)(sc + r * 1024 + kb + k); acc[r] += s4.x * w0 + s4.y * w1 + s4.z * w2 + s4.w * w3; }
                }
#pragma unroll
                for (int r = 0; r < 17; ++r) red[(F.wave * 17 + r) * 64 + F.lane] = acc[r];
                __syncthreads();
                for (int o = F.tid; o < 17 * 64; o += 512) { const int r = o >> 6, cc = o & 63; float s = 0.f;
#pragma unroll
                    for (int w = 0; w < 8; ++w) s += red[(w * 17 + r) * 64 + cc];
                    ((float*)(ws + WS_MODV))[(size_t)(l * 17 + r) * NMOD + c0 + cc] = s + F.in[5][l * NMOD + c0 + cc]; }
                __syncthreads();
            }
        }
    }
}

typedef short bf16x8v __attribute__((ext_vector_type(8)));
typedef float f32x16 __attribute__((ext_vector_type(16)));
__device__ __forceinline__ void attn_unit(Frame& F, int b, int h, int qrow0, bool rope_q, int t_lo, int t_hi) {
    unsigned char* ws = F.ws;
    const bf16* QB = (const bf16*)(ws + WS_QB); const bf16* KN = (const bf16*)(ws + WS_KN); const bf16* KRR = (const bf16*)(ws + WS_KRR); const bf16* VT = (const bf16*)(ws + WS_VV);
    bf16* MIX = (bf16*)(ws + WS_MIX); const float* TC = (const float*)(ws + WS_ROPE); const float* TS = TC + 512;
    const int lane = F.lane, wave = F.wave, r32 = lane & 31, hi = lane >> 5;
    LAS unsigned char* ring = F.lds + RING_OFF;
    const int qrow = qrow0 + wave * 32 + r32;
    bf16x8v qr[6];
#pragma unroll
    for (int d0 = 0; d0 < 6; ++d0) qr[d0] = *(const bf16x8v*)(QB + (size_t)qrow * 768 + h * QKD + 16 * d0 + 8 * hi);
    if (rope_q) { const int t = qrow % SEQ;
#pragma unroll
        for (int a = 0; a < 2; ++a) { const int p = a ? (t & 63) : (t >> 6); const v4u w = __builtin_bit_cast(v4u, qr[4 + a]); float x[8], y[8];
            x[0] = bflo(w.x); x[1] = bfhi(w.x); x[2] = bflo(w.y); x[3] = bfhi(w.y); x[4] = bflo(w.z); x[5] = bfhi(w.z); x[6] = bflo(w.w); x[7] = bfhi(w.w);
#pragma unroll
            for (int jj = 0; jj < 8; ++jj) { const float pr = shx(x[jj], lane, 32); const float c = TC[p * 8 + jj], sn = TS[p * 8 + jj]; y[jj] = hi ? x[jj] * c + pr * sn : x[jj] * c - pr * sn; }
            v4u o; o.x = pk2(y[0], y[1]); o.y = pk2(y[2], y[3]); o.z = pk2(y[4], y[5]); o.w = pk2(y[6], y[7]); qr[4 + a] = __builtin_bit_cast(bf16x8v, o); } }
    const int bh = b * NH + h;
    const bf16* vsrc = VT + ((size_t)(bh * VD + lane)) * NKEY + 8 * wave;
#define ATT_DMA(t, buf) do { const int t_ = (t); const int r0_ = t_ < SEQ / 64 ? b * SEQ + 64 * t_ : M + b * CTXL + 64 * (t_ - SEQ / 64); \
        LAS unsigned char* kb_ = ring + (buf) * 20480; LAS unsigned char* vb_ = kb_ + 12288; \
        __builtin_amdgcn_global_load_lds((const unsigned*)(KN + (size_t)(r0_ + lane) * HW + h * 64 + 8 * wave), (LAS unsigned*)(kb_ + wave * 1024), 16, 0, 0); \
        __builtin_amdgcn_global_load_lds((const unsigned*)(KRR + (size_t)(r0_ + lane) * ROPE + 8 * (wave & 3)), (LAS unsigned*)(kb_ + (8 + (wave & 3)) * 1024), 16, 0, 0);     \
        __builtin_amdgcn_global_load_lds((const unsigned*)(vsrc + 64 * t_), (LAS unsigned*)(vb_ + wave * 1024), 16, 0, 0); } while (0)
    f32x16 o0, o1;
#pragma unroll
    for (int r = 0; r < 16; ++r) { o0[r] = 0.f; o1[r] = 0.f; }
    constexpr float ATT_THR = 8.0f;
    float m_run = 0.f, l_run = 0.f;
    asm volatile("s_waitcnt vmcnt(0)" ::: "memory");
    ATT_DMA(t_lo, 0); if (t_lo + 1 < t_hi) ATT_DMA(t_lo + 1, 1); if (t_lo + 2 < t_hi) ATT_DMA(t_lo + 2, 2);
    for (int t = t_lo; t < t_hi; ++t) {
        const int buf = (t - t_lo) & 3; const int rem = t_hi - 1 - t;
        if (rem >= 2) asm volatile("s_waitcnt vmcnt(6)" ::: "memory"); else if (rem == 1) asm volatile("s_waitcnt vmcnt(3)" ::: "memory"); else asm volatile("s_waitcnt vmcnt(0)" ::: "memory");
        asm volatile("s_waitcnt lgkmcnt(0)" ::: "memory"); __builtin_amdgcn_s_barrier(); asm volatile("" ::: "memory");
        if (t + 3 < t_hi) ATT_DMA(t + 3, (buf + 3) & 3);
        const LAS unsigned char* kb = ring + buf * 20480 + hi * 1024 + r32 * 16; const LAS unsigned char* vb = ring + buf * 20480 + 12288 + hi * 1024 + r32 * 16;
        bf16x8v kf[12], vf[8];
#pragma unroll
        for (int d0 = 0; d0 < 6; ++d0) { kf[2 * d0] = *(const LAS bf16x8v*)(kb + d0 * 2048); kf[2 * d0 + 1] = *(const LAS bf16x8v*)(kb + d0 * 2048 + 512); }
#pragma unroll
        for (int s4 = 0; s4 < 4; ++s4) { vf[2 * s4] = *(const LAS bf16x8v*)(vb + s4 * 2048); vf[2 * s4 + 1] = *(const LAS bf16x8v*)(vb + s4 * 2048 + 512); }
        f32x16 p0, p1; const float negm = -m_run;
#pragma unroll
        for (int r = 0; r < 16; ++r) { p0[r] = negm; p1[r] = negm; }
#pragma unroll
        for (int d0 = 0; d0 < 6; ++d0) { p0 = __builtin_amdgcn_mfma_f32_32x32x16_bf16(kf[2 * d0], qr[d0], p0, 0, 0, 0); p1 = __builtin_amdgcn_mfma_f32_32x32x16_bf16(kf[2 * d0 + 1], qr[d0], p1, 0, 0, 0); }
        float ma = __builtin_fmaxf(__builtin_fmaxf(p0[0], p0[1]), p1[0]), mb = __builtin_fmaxf(__builtin_fmaxf(p0[2], p0[3]), p1[1]); ma = __builtin_fmaxf(__builtin_fmaxf(ma, p1[2]), p1[3]);
#pragma unroll
        for (int r = 4; r < 16; r += 4) { ma = __builtin_fmaxf(__builtin_fmaxf(ma, p0[r]), p0[r + 1]); mb = __builtin_fmaxf(__builtin_fmaxf(mb, p0[r + 2]), p0[r + 3]); ma = __builtin_fmaxf(__builtin_fmaxf(ma, p1[r]), p1[r + 1]); mb = __builtin_fmaxf(__builtin_fmaxf(mb, p1[r + 2]), p1[r + 3]); }
        float mt = __builtin_fmaxf(ma, mb);
        { auto rr = __builtin_amdgcn_permlane32_swap(__float_as_uint(mt), __float_as_uint(mt), false, false); mt = __builtin_fmaxf(__uint_as_float(rr[0]), __uint_as_float(rr[1])); }
        const bool first = (t == t_lo);
        if (first || __any(mt > ATT_THR)) {
            const float dl = first ? mt : __builtin_fmaxf(mt, 0.f); m_run += dl; const float alpha = __builtin_amdgcn_exp2f(-dl); l_run *= alpha;
#pragma unroll
            for (int r = 0; r < 16; ++r) { p0[r] -= dl; p1[r] -= dl; o0[r] *= alpha; o1[r] *= alpha; }
        }
        float ps0 = 0.f, ps1 = 0.f;
#pragma unroll
        for (int r = 0; r < 16; ++r) { p0[r] = __builtin_amdgcn_exp2f(p0[r]); p1[r] = __builtin_amdgcn_exp2f(p1[r]); ps0 += p0[r]; ps1 += p1[r]; }
        l_run += ps0 + ps1;
        v4u pw[4];
#pragma unroll
        for (int q = 0; q < 4; ++q) { pw[0][q] = cvt_pk_bf16(p0[2 * q], p0[2 * q + 1]); pw[1][q] = cvt_pk_bf16(p0[8 + 2 * q], p0[8 + 2 * q + 1]); pw[2][q] = cvt_pk_bf16(p1[2 * q], p1[2 * q + 1]); pw[3][q] = cvt_pk_bf16(p1[8 + 2 * q], p1[8 + 2 * q + 1]); }
#pragma unroll
        for (int s4 = 0; s4 < 4; ++s4) { const bf16x8v pa = __builtin_bit_cast(bf16x8v, pw[s4]);
            o0 = __builtin_amdgcn_mfma_f32_32x32x16_bf16(vf[2 * s4], pa, o0, 0, 0, 0); o1 = __builtin_amdgcn_mfma_f32_32x32x16_bf16(vf[2 * s4 + 1], pa, o1, 0, 0, 0); }
    }
    { auto rr = __builtin_amdgcn_permlane32_swap(__float_as_uint(l_run), __float_as_uint(l_run), false, false); l_run = __uint_as_float(rr[0]) + __uint_as_float(rr[1]); }
    const float rl = 1.0f / l_run;
    bf16* orow = MIX + (size_t)qrow * DM + h * VD;
#pragma unroll
    for (int g = 0; g < 4; ++g) { v2u a, c2; a.x = pk2(o0[4 * g] * rl, o0[4 * g + 1] * rl); a.y = pk2(o0[4 * g + 2] * rl, o0[4 * g + 3] * rl); c2.x = pk2(o1[4 * g] * rl, o1[4 * g + 1] * rl); c2.y = pk2(o1[4 * g + 2] * rl, o1[4 * g + 3] * rl);
        *(v2u*)(orow + 8 * g + 4 * hi) = a; *(v2u*)(orow + 32 + 8 * g + 4 * hi) = c2; }
    asm volatile("s_waitcnt vmcnt(0) lgkmcnt(0)" ::: "memory"); __builtin_amdgcn_s_barrier(); asm volatile("" ::: "memory");
#undef ATT_DMA
}
__device__ __forceinline__ void hgrn_item(Frame& F, int j, int it);
__device__ __forceinline__ void mix_phase(Frame& F, int j, bool ctx_out) {
    fresh(F);
    const int npair = F.G >> 1;
    for (int P = F.vcu >> 1; P < NB * NH; P += npair) {
        const int b = P >> 3, h = P & 7;
        if ((F.vcu & 1) == 0) {
            hgrn_item(F, j, P);
            for (int qb = 6; qb < 8; ++qb) attn_unit(F, b, h, b * SEQ + qb * 256, true, 0, NKEY / 64);
        } else {
            for (int qb = 0; qb < 6; ++qb) attn_unit(F, b, h, b * SEQ + qb * 256, true, 0, NKEY / 64);
            if (ctx_out) attn_unit(F, b, h, M + b * CTXL, false, SEQ / 64, NKEY / 64);
        }
    }
    __syncthreads();
}

__device__ __forceinline__ int hgrn_row(int b, int dir, int ig) { return (ig < CTXL) ? (M + b * CTXL + (dir ? CTXL - 1 - ig : ig)) : (b * SEQ + (dir ? SEQ - 1 - (ig - CTXL) : (ig - CTXL))); }
__device__ __forceinline__ void hgrn_item(Frame& F, int j, int it) {
    unsigned char* ws = F.ws;
    const bf16* HQ = (const bf16*)(ws + WS_HQ); const bf16* HFF = HQ + HSEG; const bf16* HFB = HQ + 2 * HSEG; const bf16* HI = HQ + 3 * HSEG;
    LAS unsigned char* ring = F.lds + RING_OFF;
    LAS unsigned char* QN = ring; LAS unsigned char* KN = ring + 17408; LAS unsigned char* KT = ring + 34816; LAS unsigned char* VT = ring + 53248; LAS unsigned char* ST = ring + 71680;
    LAS float* TOT = (LAS float*)(ring + 106496); LAS unsigned char* RQ = ring + 108544; LAS unsigned char* RF = ring + 124928; LAS float* EW = (LAS float*)(ring + 141312);
    const int lane0 = F.lane, wave = F.wave;
    const int part = wave >> 1;
    const int kb = wave >> 1, vb0 = 2 * (wave & 1);
    const int ib = wave >> 2, vbo = wave & 3;
    const int dir = it & 1, hh = (it >> 1) & 3, b = it >> 3;
    const bf16* HF = dir ? HFB : HFF; float* OO = (float*)(ws + (dir ? WS_OB : WS_OF));
    f32x16 S0, S1;
#pragma unroll
    for (int r = 0; r < 16; ++r) { S0[r] = 0.f; S1[r] = 0.f; }
#define LBAR() do { asm volatile("s_waitcnt lgkmcnt(0)" ::: "memory"); __builtin_amdgcn_s_barrier(); asm volatile("" ::: "memory"); } while (0)
#define HG_BASE(c_) ((c_) < CTXL / 64 ? M + b * CTXL + (dir ? CTXL - 64 - 64 * (c_) : 64 * (c_)) : b * SEQ + (dir ? SEQ - 64 - 64 * ((c_) - CTXL / 64) : 64 * ((c_) - CTXL / 64)))
#define HG_DMA(c_) do { const int rb_ = HG_BASE(c_); \
        _Pragma("unroll") for (int p_ = 0; p_ < 2; ++p_) { const int pc_ = wave * 2 + p_; const size_t go_ = (size_t)(rb_ + 4 * pc_ + (lane >> 4)) * HW + hh * HK + 8 * (lane & 15); \
            __builtin_amdgcn_global_load_lds((const unsigned*)(HQ + go_), (LAS unsigned*)(RQ + pc_ * 1024), 16, 0, 0); __builtin_amdgcn_global_load_lds((const unsigned*)(HF + go_), (LAS unsigned*)(RF + pc_ * 1024), 16, 0, 0); } } while (0)
#define HG_VLD(c_) do { const size_t go_ = (size_t)(HG_BASE(c_) + (dir ? 63 - lane : lane)) * HW + hh * HK + 16 * wave; rv0 = *(const v4u*)(HI + go_); rv1 = *(const v4u*)(HI + go_ + 8); } while (0)
    v4u rv0, rv1;
    { const int lane = lane0; HG_DMA(0); HG_VLD(0); }
    asm volatile("s_waitcnt vmcnt(0)" ::: "memory"); LBAR();
    for (int ch = 0; ch < NKEY / 64; ++ch) {
        int lane_ = lane0; asm volatile("" : "+v"(lane_));
        const int lane = lane_, r32 = lane & 31, hi = lane >> 5, k = (wave & 1) * 64 + lane;
        const int pos = (lane & ~12) | ((lane & 4) << 1) | ((lane & 8) >> 1);
        float qv[16], kin[16], pf[16]; float run = 0.f, prod = 1.f;
#pragma unroll
        for (int ii = 0; ii < 16; ++ii) { const int i = 16 * part + ii, mr = dir ? 63 - i : i; qv[ii] = bf2f(*(const LAS bf16*)(RQ + mr * 256 + k * 2)); const float a = bf2f(*(const LAS bf16*)(RF + mr * 256 + k * 2));
            const float f = __expf(a); kin[ii] = 1.0f - f; prod *= f; pf[ii] = prod; run += a; }
        TOT[part * 128 + k] = run;
        { LAS bf16* vt = (LAS bf16*)(VT + (16 * wave) * 144 + pos * 2);
          vt[0 * 72] = (bf16)(rv0.x & 0xffffu); vt[1 * 72] = (bf16)(rv0.x >> 16); vt[2 * 72] = (bf16)(rv0.y & 0xffffu); vt[3 * 72] = (bf16)(rv0.y >> 16);
          vt[4 * 72] = (bf16)(rv0.z & 0xffffu); vt[5 * 72] = (bf16)(rv0.z >> 16); vt[6 * 72] = (bf16)(rv0.w & 0xffffu); vt[7 * 72] = (bf16)(rv0.w >> 16);
          vt[8 * 72] = (bf16)(rv1.x & 0xffffu); vt[9 * 72] = (bf16)(rv1.x >> 16); vt[10 * 72] = (bf16)(rv1.y & 0xffffu); vt[11 * 72] = (bf16)(rv1.y >> 16);
          vt[12 * 72] = (bf16)(rv1.z & 0xffffu); vt[13 * 72] = (bf16)(rv1.z >> 16); vt[14 * 72] = (bf16)(rv1.w & 0xffffu); vt[15 * 72] = (bf16)(rv1.w >> 16); }
        LBAR();
        if (ch + 1 < NKEY / 64) { HG_DMA(ch + 1); HG_VLD(ch + 1); }
        { const float t0 = TOT[k], t1 = TOT[128 + k], t2 = TOT[256 + k];
          const float base = (part > 0 ? t0 : 0.f) + (part > 1 ? t1 : 0.f) + (part > 2 ? t2 : 0.f); const float rr = t0 + t1;
          unsigned kt[8];
          const float E0 = __expf(base - rr);
#pragma unroll
          for (int ii = 0; ii < 16; ii += 2) { const float e0 = E0 * pf[ii], e1 = E0 * pf[ii + 1]; const float q0 = qv[ii] * e0, q1 = qv[ii + 1] * e1, k0 = kin[ii] * __builtin_amdgcn_rcpf(e0), k1 = kin[ii + 1] * __builtin_amdgcn_rcpf(e1);
              const unsigned qp = cvt_pk_bf16(q0, q1), kp = cvt_pk_bf16(k0, k1);
              *(LAS bf16*)(QN + (16 * part + ii) * 272 + k * 2) = (bf16)(qp & 0xffffu); *(LAS bf16*)(QN + (16 * part + ii + 1) * 272 + k * 2) = (bf16)(qp >> 16);
              *(LAS bf16*)(KN + (16 * part + ii) * 272 + k * 2) = (bf16)(kp & 0xffffu); *(LAS bf16*)(KN + (16 * part + ii + 1) * 272 + k * 2) = (bf16)(kp >> 16);
              kt[ii >> 1] = kp; }
          *(LAS v4u*)(KT + k * 144 + part * 32) = (v4u){kt[0], kt[1], kt[4], kt[5]}; *(LAS v4u*)(KT + k * 144 + part * 32 + 16) = (v4u){kt[2], kt[3], kt[6], kt[7]}; }
        { const int kx = kb * 32 + r32; const float v_ = hi ? (TOT[256 + kx] + TOT[384 + kx]) : (TOT[kx] + TOT[128 + kx]); EW[wave * 64 + lane] = __expf(v_); asm volatile("s_waitcnt lgkmcnt(0)" ::: "memory"); }
        f32x16 T0, T1;
#pragma unroll
        for (int g4 = 0; g4 < 4; ++g4) { const int kk = kb * 32 + 8 * g4 + 4 * hi; const f32x4 er = *(const LAS f32x4*)(EW + wave * 64 + 8 * g4 + 4 * hi);
            T0[4 * g4] = S0[4 * g4] * er.x; T0[4 * g4 + 1] = S0[4 * g4 + 1] * er.y; T0[4 * g4 + 2] = S0[4 * g4 + 2] * er.z; T0[4 * g4 + 3] = S0[4 * g4 + 3] * er.w;
            T1[4 * g4] = S1[4 * g4] * er.x; T1[4 * g4 + 1] = S1[4 * g4 + 1] * er.y; T1[4 * g4 + 2] = S1[4 * g4 + 2] * er.z; T1[4 * g4 + 3] = S1[4 * g4 + 3] * er.w;
            v2u o; o.x = cvt_pk_bf16(T0[4 * g4], T0[4 * g4 + 1]); o.y = cvt_pk_bf16(T0[4 * g4 + 2], T0[4 * g4 + 3]); *(LAS v2u*)(ST + (vb0 * 32 + r32) * 272 + kk * 2) = o;
            o.x = cvt_pk_bf16(T1[4 * g4], T1[4 * g4 + 1]); o.y = cvt_pk_bf16(T1[4 * g4 + 2], T1[4 * g4 + 3]); *(LAS v2u*)(ST + (vb0 * 32 + 32 + r32) * 272 + kk * 2) = o; }
        LBAR();
#pragma unroll
        for (int st = 0; st < 4; ++st) { const bf16x8v kf = *(const LAS bf16x8v*)(KT + (kb * 32 + r32) * 144 + st * 32 + hi * 16);
            const bf16x8v va = *(const LAS bf16x8v*)(VT + (vb0 * 32 + r32) * 144 + st * 32 + hi * 16), vc = *(const LAS bf16x8v*)(VT + (vb0 * 32 + 32 + r32) * 144 + st * 32 + hi * 16);
            T0 = __builtin_amdgcn_mfma_f32_32x32x16_bf16(kf, va, T0, 0, 0, 0); T1 = __builtin_amdgcn_mfma_f32_32x32x16_bf16(kf, vc, T1, 0, 0, 0); }
#pragma unroll
        for (int g4 = 0; g4 < 4; ++g4) { const f32x4 eg = *(const LAS f32x4*)(EW + wave * 64 + 32 + 8 * g4 + 4 * hi);
            S0[4 * g4] = T0[4 * g4] * eg.x; S0[4 * g4 + 1] = T0[4 * g4 + 1] * eg.y; S0[4 * g4 + 2] = T0[4 * g4 + 2] * eg.z; S0[4 * g4 + 3] = T0[4 * g4 + 3] * eg.w;
            S1[4 * g4] = T1[4 * g4] * eg.x; S1[4 * g4 + 1] = T1[4 * g4 + 1] * eg.y; S1[4 * g4 + 2] = T1[4 * g4 + 2] * eg.z; S1[4 * g4 + 3] = T1[4 * g4 + 3] * eg.w; }
        asm volatile("" ::: "memory");
        {
            bf16x8v qf[8];
#pragma unroll
            for (int ks = 0; ks < 8; ++ks) qf[ks] = *(const LAS bf16x8v*)(QN + (ib * 32 + r32) * 272 + ks * 32 + hi * 16);
            asm volatile("" ::: "memory");
            f32x16 O;
#pragma unroll
            for (int r = 0; r < 16; ++r) O[r] = 0.f;
#pragma unroll
            for (int ks = 0; ks < 8; ++ks) { const bf16x8v sf = *(const LAS bf16x8v*)(ST + (vbo * 32 + r32) * 272 + ks * 32 + hi * 16); O = __builtin_amdgcn_mfma_f32_32x32x16_bf16(qf[ks], sf, O, 0, 0, 0); }
            asm volatile("" ::: "memory");
#pragma unroll 1
            for (int sb = 0; sb <= ib; ++sb) {
                f32x16 X;
#pragma unroll
                for (int r = 0; r < 16; ++r) X[r] = 0.f;
#pragma unroll
                for (int ks = 0; ks < 8; ++ks) { const bf16x8v kf = *(const LAS bf16x8v*)(KN + (sb * 32 + r32) * 272 + ks * 32 + hi * 16); X = __builtin_amdgcn_mfma_f32_32x32x16_bf16(kf, qf[ks], X, 0, 0, 0); }
                if (sb == ib) {
#pragma unroll
                    for (int r = 0; r < 16; ++r) { const int srow = (r & 3) + 8 * (r >> 2) + 4 * hi; if (srow > r32) X[r] = 0.f; }
                }
                asm volatile("" ::: "memory");
#pragma unroll
                for (int st = 0; st < 2; ++st) { v4u pw;
#pragma unroll
                    for (int q = 0; q < 4; ++q) pw[q] = cvt_pk_bf16(X[8 * st + 2 * q], X[8 * st + 2 * q + 1]);
                    const bf16x8v vf = *(const LAS bf16x8v*)(VT + (vbo * 32 + r32) * 144 + (sb * 32 + st * 16) * 2 + hi * 16);
                    O = __builtin_amdgcn_mfma_f32_32x32x16_bf16(__builtin_bit_cast(bf16x8v, pw), vf, O, 0, 0, 0); }
                asm volatile("" ::: "memory");
            }
            asm volatile("s_waitcnt vmcnt(0)" ::: "memory");
            const int rb = HG_BASE(ch); float* op = OO + (size_t)rb * HW + hh * HK + vbo * 32 + r32;
#pragma unroll
            for (int r = 0; r < 16; ++r) { const int i = ib * 32 + (r & 3) + 8 * (r >> 2) + 4 * hi; op[(size_t)(dir ? 63 - i : i) * HW] = O[r]; }
        }
        LBAR();
    }
    asm volatile("s_waitcnt vmcnt(0)" ::: "memory");
#undef LBAR
#undef HG_DMA
#undef HG_VLD
#undef HG_BASE
}

__device__ __forceinline__ void e8_phase(Frame& F, int j, int nrows) {
    fresh(F);
    unsigned char* ws = F.ws;
    const float* OF = (const float*)(ws + WS_OF); const float* OB = (const float*)(ws + WS_OB); const bf16* HG = (const bf16*)(ws + WS_HQ) + 4 * HSEG; bf16* MIX = (bf16*)(ws + WS_MIX);
    const float* gn = F.in[14] + j * HK;
    const int rpw = (nrows + F.G - 1) / F.G, rbase = (int)blockIdx.x * rpw, rend = (rbase + rpw < nrows) ? rbase + rpw : nrows;
    const int col = 8 * F.lane, vv = col & 127; const f32x4 g0 = *(const f32x4*)(gn + vv), g1 = *(const f32x4*)(gn + vv + 4);
    for (int r0 = rbase + F.wave; r0 < rend; r0 += 2 * NWAVES) {
        f32x4 a0[2], a1[2], b0[2], b1[2]; v4u hg[2];
#pragma unroll
        for (int q = 0; q < 2; ++q) { const int row = r0 + q * NWAVES; if (row < rend) {
            a0[q] = *(const f32x4*)(OF + (size_t)row * HW + col); a1[q] = *(const f32x4*)(OF + (size_t)row * HW + col + 4); b0[q] = *(const f32x4*)(OB + (size_t)row * HW + col); b1[q] = *(const f32x4*)(OB + (size_t)row * HW + col + 4);
            hg[q] = *(const v4u*)(HG + (size_t)row * HW + col); } }
#pragma unroll
        for (int q = 0; q < 2; ++q) { const int row = r0 + q * NWAVES; if (row < rend) {
            f32x4 x0 = a0[q] + b0[q], x1 = a1[q] + b1[q];
            float s = (x0.x * x0.x + x0.y * x0.y) + (x0.z * x0.z + x0.w * x0.w) + (x1.x * x1.x + x1.y * x1.y) + (x1.z * x1.z + x1.w * x1.w);
            s += shx(s, F.lane, 1); s += shx(s, F.lane, 2); s += shx(s, F.lane, 4); s += shx(s, F.lane, 8);
            const float rstd = rsqrtf(s * (1.0f / HK) + EPS);
            x0 = x0 * rstd * g0; x1 = x1 * rstd * g1; const v4u h = hg[q];
            v4u o; o.x = pg8::cvt_pk_bf16(x0.x * siluf_(bflo(h.x)), x0.y * siluf_(bfhi(h.x))); o.y = pg8::cvt_pk_bf16(x0.z * siluf_(bflo(h.y)), x0.w * siluf_(bfhi(h.y)));
            o.z = pg8::cvt_pk_bf16(x1.x * siluf_(bflo(h.z)), x1.y * siluf_(bfhi(h.z))); o.w = pg8::cvt_pk_bf16(x1.z * siluf_(bflo(h.w)), x1.w * siluf_(bfhi(h.w)));
            *(v4u*)(MIX + (size_t)row * DM + HW + col) = o; } }
    }
}

__device__ __forceinline__ void o12_phase(Frame& F, int nrows, const bf16* hb, const float* gn, const float* modl) {
    fresh(F);
    bf16* P = (bf16*)(F.ws + WS_POOLED);
    LAS unsigned char* XN = F.lds + RING_OFF;
    const int rpw = (nrows + F.G - 1) / F.G, rbase = (int)blockIdx.x * rpw, rend = (rbase + rpw < nrows) ? rbase + rpw : nrows;
    for (int r0 = rbase; r0 < rend; r0 += 32) {
        for (int sl = F.wave; sl < 48; sl += NWAVES) {
            const int row = r0 - 8 + sl; if (row < 0 || row >= nrows) continue;
            f32x4 v[4]; float s = 0.f;
#pragma unroll
            for (int j = 0; j < 4; ++j) { const v2u w = *(const v2u*)(hb + (size_t)row * DM + 4 * F.lane + 256 * j); v[j] = (f32x4){bflo(w.x), bfhi(w.x), bflo(w.y), bfhi(w.y)}; s += (v[j].x * v[j].x + v[j].y * v[j].y) + (v[j].z * v[j].z + v[j].w * v[j].w); }
            const float rstd = rsqrtf(wave_sum(s, F.lane) * (1.0f / DM) + EPS);
#pragma unroll
            for (int j = 0; j < 4; ++j) { v2u o; o.x = pg8::cvt_pk_bf16(v[j].x * rstd, v[j].y * rstd); o.y = pg8::cvt_pk_bf16(v[j].z * rstd, v[j].w * rstd); *(LAS v2u*)(XN + sl * 2048 + (4 * F.lane + 256 * j) * 2) = o; }
        }
        __syncthreads();
#pragma unroll 1
        for (int q = 0; q < 4; ++q) {
            const int t = r0 + F.wave * 4 + q; if (t >= rend) break;
            const bool lat = t < M; const int T = lat ? SEQ : CTXL; const int tt = lat ? t % SEQ : (t - M) % CTXL; const int bidx = lat ? t / SEQ : NB;
            const int sc0 = t - r0 + 8;
            const float* scp = modl + bidx * NMOD + DM;
#pragma unroll
            for (int g = 0; g < 4; ++g) {
                const int hw = 1 << g, col = 256 * g + 4 * F.lane;
                float s0 = 0.f, s1 = 0.f, s2 = 0.f, s3 = 0.f; int cnt = 0;
#pragma unroll
                for (int d = -hw; d < hw; ++d) { const bool ok = (tt + d >= 0) && (tt + d < T); const v2u x = *(const LAS v2u*)(XN + (sc0 + d) * 2048 + col * 2);
                    s0 += ok ? bflo(x.x) : 0.f; s1 += ok ? bfhi(x.x) : 0.f; s2 += ok ? bflo(x.y) : 0.f; s3 += ok ? bfhi(x.y) : 0.f; cnt += ok ? 1 : 0; }
                const v2u xc = *(const LAS v2u*)(XN + sc0 * 2048 + col * 2); const float ic = 1.0f / (float)cnt;
                const f32x4 gv = *(const f32x4*)(gn + col), sv = *(const f32x4*)(scp + col);
                v2u o; o.x = pg8::cvt_pk_bf16(gv.x * (sv.x + 1.0f) * (s0 * ic - bflo(xc.x)), gv.y * (sv.y + 1.0f) * (s1 * ic - bfhi(xc.x)));
                o.y = pg8::cvt_pk_bf16(gv.z * (sv.z + 1.0f) * (s2 * ic - bflo(xc.y)), gv.w * (sv.w + 1.0f) * (s3 * ic - bfhi(xc.y)));
                *(v2u*)(P + ((size_t)g * MT + t) * 256 + 4 * F.lane) = o;
            }
        }
        __syncthreads();
    }
}

__device__ __forceinline__ void o5_phase(Frame& F, int nrows) {
    fresh(F);
    unsigned char* ws = F.ws;
    const int* CNT = (const int*)(ws + WS_CNT); int* TST = (int*)(ws + WS_TST); const int* EIDX = (const int*)(ws + WS_EIDX); int* POS = (int*)(ws + WS_POS);
    const bf16* U = (const bf16*)(ws + WS_U); bf16* VG = (bf16*)(ws + WS_VG);
    LAS int* lc = (LAS int*)(F.lds + RING_OFF);
    LAS int* lbase = lc + 512 * 8;
    LAS int* lpos = lbase + 32;
    const int rpw = (nrows + F.G - 1) / F.G;
    for (int e = F.tid; e < F.G * 8; e += 512) lc[e] = CNT[e];
    __syncthreads();
    {
        const int e = F.wave; int c4[4]; int sum = 0;
#pragma unroll
        for (int q = 0; q < 4; ++q) { const int w = 4 * F.lane + q; c4[q] = (w < F.G) ? lc[w * 8 + e] : 0; sum += c4[q]; }
        int incl = sum;
#pragma unroll
        for (int o = 1; o < 64; o <<= 1) { const int t = __builtin_amdgcn_ds_bpermute((F.lane >= o ? F.lane - o : F.lane) << 2, incl); if (F.lane >= o) incl += t; }
        const int total = __builtin_amdgcn_readlane(incl, 63); int excl = incl - sum;
        const int myq = (int)blockIdx.x & 3; int pre = excl;
#pragma unroll
        for (int q = 0; q < 3; ++q) if (q < myq) pre += c4[q];
        if (F.lane == ((int)blockIdx.x >> 2)) { lbase[e] = pre; lbase[8 + e] = total; }
    }
    __syncthreads();
    if (F.tid == 0) {
        int ts = 0;
        for (int e = 0; e < 8; ++e) { const int pre = lbase[e], tot = lbase[8 + e]; lbase[e] = ts * 256 + pre; if (blockIdx.x == 0) TST[e] = ts; ts += (tot + 255) >> 8; }
        if (blockIdx.x == 0) TST[8] = ts;
    }
    __syncthreads();
    if (F.wave == 0) {
        int run[8];
#pragma unroll
        for (int e = 0; e < 8; ++e) run[e] = lbase[e];
        const int npairs = 2 * rpw;
        for (int c0 = 0; c0 < npairs; c0 += 64) {
            const int pl = c0 + F.lane; const int row = (int)blockIdx.x * rpw + (pl >> 1); const bool ok = pl < npairs && row < nrows;
            const int e = ok ? EIDX[2 * row + (pl & 1)] : -1; int mypos = 0;
#pragma unroll
            for (int x = 0; x < 8; ++x) { const unsigned long long mk = __ballot(e == x); const int below = __popcll(mk & ((1ull << F.lane) - 1ull)); if (e == x) mypos = run[x] + below; run[x] += __popcll(mk); }
            if (ok) { lpos[pl] = mypos; POS[2 * row + (pl & 1)] = mypos; }
        }
    }
    __syncthreads();
    for (int pl0 = F.wave * 4; pl0 < 2 * rpw; pl0 += NWAVES * 4) {
        v4u a[4], b[4]; int p[4];
#pragma unroll
        for (int q = 0; q < 4; ++q) { const int pl = pl0 + q; const int row = (int)blockIdx.x * rpw + (pl >> 1); p[q] = -1;
            if (pl < 2 * rpw && row < nrows) { p[q] = lpos[pl]; a[q] = *(const v4u*)(U + (size_t)row * DM + 8 * F.lane); b[q] = *(const v4u*)(U + (size_t)row * DM + 512 + 8 * F.lane); } }
#pragma unroll
        for (int q = 0; q < 4; ++q) if (p[q] >= 0) { *(v4u*)(VG + (size_t)p[q] * DM + 8 * F.lane) = a[q]; *(v4u*)(VG + (size_t)p[q] * DM + 512 + 8 * F.lane) = b[q]; }
    }
    __syncthreads();
}

__global__ void __launch_bounds__(NWAVES * 64, 2) mega_fwd(Args args) {
    extern __shared__ __attribute__((aligned(16))) unsigned char lds[];
    Frame F;
    F.lds = (LAS unsigned char*)lds;
    F.wave = __builtin_amdgcn_readfirstlane((int)threadIdx.x >> 6); fresh(F);
    F.G = gridDim.x; { const int bx = blockIdx.x; F.vcu = (F.G % 8 == 0) ? (bx % 8) * (F.G / 8) + bx / 8 : bx; }
    F.in = args.in; F.out = args.out; F.ws = args.ws;
    unsigned char* ws = args.ws;
    volatile LAS unsigned* MISC = (volatile LAS unsigned*)(F.lds + MISC_OFF);
    for (int u = F.tid; u < (LDS_BYTES - LDSCTL_OFF) / 4; u += NWAVES * 64) ((LAS unsigned*)(F.lds + LDSCTL_OFF))[u] = 0u;
    __syncthreads();
    XcdBarrier bar = xcd_barrier_post((unsigned*)(ws + WS_CTL) + CW_BAR, MISC + 8, F.wave);
#define GRID_BAR() do { xcd_barrier(bar); if (DUPMASK & 4096) xcd_barrier(bar); } while (0)
#ifndef ONLY
#define ONLY 0
#endif
#define PH(n) (ONLY == 0 || ONLY == (n))
#define REP(bit) for (int rep_ = 0; rep_ < ((DUPMASK & (bit)) ? 2 : 1); ++rep_)
    LAS unsigned char* ring = F.lds + RING_OFF;
    const float* MODV = (const float*)(ws + WS_MODV);
    bf16* HB = (bf16*)(ws + WS_HB);
    bf16* U = (bf16*)(ws + WS_U);

#if PH(20)
    REP(8192) p0_prologue(F);
#endif
    GRID_BAR();

    for (int lp = 0; lp < 2; ++lp) {
        const int le = 2 * lp, lo = 2 * lp + 1, j = lp;
        const bool ctx_out = (lp == 0);
        const int nro = ctx_out ? MT : M;
        const float* modE = MODV + (size_t)le * 17 * NMOD; const float* modO = MODV + (size_t)lo * 17 * NMOD;
#if PH(1)
        {
            RowArgs A{}; A.xin_l = args.in[0]; A.xin_c = args.in[2]; A.hb = HB; A.hbo = HB; A.g = args.in[6] + (size_t)(le * 2 + 0) * DM; A.modl = modE; A.shoff = 0; A.scoff = DM; A.U = U;
            A.Y = (const bf16*)(ws + WS_VG); A.pos = (const int*)(ws + WS_POS); A.gate = (const float*)(ws + WS_GATE); A.modprev = MODV + (size_t)(le - 1) * 17 * NMOD;
            if (lp == 0) row_phase<false, 1, false, true>(F, A, MT); else row_phase<true, 1, false, false>(F, A, MT);
        }
#endif
        GRID_BAR();
#if PH(2)
        {
            pg8::Gemm g{U, (const bf16*)(ws + WS_WIN) + (size_t)j * INP * DM, DM, DM, DM}; pg8::InOrder S; S.init(ctx_out, F.G, (int)blockIdx.x);
            EpiIn E{(bf16*)(ws + WS_CQ), (bf16*)(ws + WS_KRR), (bf16*)(ws + WS_CKV), (bf16*)(ws + WS_HQ), (float*)(ws + WS_RSQ), (float*)(ws + WS_RSKV), (const float*)(ws + WS_ROPE), args.in[13], j};
            REP(8) pg8::gemm_phase<EpiIn, pg8::InOrder, true>(ring, g, S, E, F.wave);
        }
#endif
        GRID_BAR();
#if PH(4)
        {
            pg8::Gemm g{(const bf16*)(ws + WS_CQ), (const bf16*)(ws + WS_WUQ) + (size_t)j * 768 * QL, QL, QL, QL}; pg8::StaticOrder S; S.init(nro, 768, F.G, (int)blockIdx.x);
            EpiQ E{(bf16*)(ws + WS_QB), (const float*)(ws + WS_RSQ)};
            REP(8) pg8::gemm_phase<EpiQ, pg8::StaticOrder, true>(ring, g, S, E, F.wave);
        }
        {
            pg8::Gemm g{(const bf16*)(ws + WS_CKV), (const bf16*)(ws + WS_WUKV) + (size_t)j * 1024 * KVL, KVL, KVL, KVL}; pg8::StaticOrder S; S.init(MT, 1024, F.G, (int)blockIdx.x);
            EpiKV E{(bf16*)(ws + WS_KN), (bf16*)(ws + WS_VV), (const float*)(ws + WS_RSKV)};
            REP(8) pg8::gemm_phase<EpiKV, pg8::StaticOrder, true>(ring, g, S, E, F.wave);
        }
#endif
        GRID_BAR();
#if PH(6)
        REP(3) mix_phase(F, j, ctx_out);
#endif
        GRID_BAR();
#if PH(8)
        REP(4 | 64) e8_phase(F, j, nro);
#endif
        GRID_BAR();
#if PH(9)
        {
            pg8::Gemm g{(const bf16*)(ws + WS_MIX), (const bf16*)(ws + WS_WOUT) + (size_t)j * DM * DM, DM, DM, DM}; pg8::StaticOrder S; S.init(nro, DM, F.G, (int)blockIdx.x);
            if (lp == 0) { EpiResid<true> E{args.in[0], args.in[2], HB, modE, 2 * DM}; pg8::gemm_phase<EpiResid<true>, pg8::StaticOrder, true>(ring, g, S, E, F.wave); }
            else { EpiResid<false> E{nullptr, nullptr, HB, modE, 2 * DM}; pg8::gemm_phase<EpiResid<false>, pg8::StaticOrder, true>(ring, g, S, E, F.wave); }
        }
#endif
        GRID_BAR();
#if PH(10)
        {
            RowArgs A{}; A.hb = HB; A.g = args.in[6] + (size_t)(le * 2 + 1) * DM; A.modl = modE; A.shoff = 3 * DM; A.scoff = 4 * DM; A.U = U;
            REP(4 | 128) row_phase<false, 1, false, false>(F, A, nro);
        }
#endif
        GRID_BAR();
#if PH(11)
        {
            pg8::Gemm g{U, (const bf16*)(ws + WS_WGU) + (size_t)j * 2 * DFF * DM, DM, DM, DM}; pg8::StaticOrder S; S.init(nro, 2 * DFF, F.G, (int)blockIdx.x);
            EpiGateUp E{(bf16*)(ws + WS_HID), DFF, 2 * DFF / 256, 0};
            REP(8) pg8::gemm_phase<EpiGateUp, pg8::StaticOrder, true>(ring, g, S, E, F.wave);
        }
#endif
        GRID_BAR();
#if PH(12)
        {
            pg8::Gemm g{(const bf16*)(ws + WS_HID), (const bf16*)(ws + WS_WDN) + (size_t)j * DM * DFF, DFF, DFF, DFF}; pg8::StaticOrder S; S.init(nro, DM, F.G, (int)blockIdx.x);
            EpiResid<false> E{nullptr, nullptr, HB, modE, 5 * DM};
            pg8::gemm_phase<EpiResid<false>, pg8::StaticOrder, true>(ring, g, S, E, F.wave);
        }
#endif
        GRID_BAR();
#if PH(13)
        {
            REP(2048) o12_phase(F, nro, HB, args.in[6] + (size_t)(lo * 2 + 0) * DM, modO);
            REP(16) for (int e = 0; e < NE; ++e) {
                conv_matrix(F, args.in[23] + ((size_t)j * NE + e) * DM * DFE, DM, DFE, (bf16*)(ws + WS_MWGU) + (size_t)e * 2 * DFE * DM, DM, 2, 0, nullptr, 1.f);
                conv_matrix(F, args.in[24] + ((size_t)j * NE + e) * DM * DFE, DM, DFE, (bf16*)(ws + WS_MWGU) + (size_t)e * 2 * DFE * DM, DM, 2, 128, nullptr, 1.f);
                conv_matrix(F, args.in[25] + ((size_t)j * NE + e) * DFE * DM, DFE, DM, (bf16*)(ws + WS_MWDN) + (size_t)e * DM * DFE, DFE, 0, 0, nullptr, 1.f);
            }
        }
#endif
        GRID_BAR();
#if PH(15)
        {
            pg8::Gemm g{(const bf16*)(ws + WS_POOLED), (const bf16*)(ws + WS_WPOOL) + (size_t)j * 4 * 65536, 256, 256, 256};
            pg8::PoolOrder S{nro / 256, MT / 256, F.G, (int)blockIdx.x};
            EpiPool E{HB, modO, args.in[20] + (size_t)j * DM, args.in[21] + (size_t)j * DM, MT / 256};
            pg8::gemm_phase<EpiPool, pg8::PoolOrder, true>(ring, g, S, E, F.wave);
        }
#endif
        GRID_BAR();
#if PH(16)
        {
            RowArgs A{}; A.hb = HB; A.g = args.in[6] + (size_t)(lo * 2 + 1) * DM; A.modl = modO; A.shoff = 3 * DM; A.scoff = 4 * DM; A.U = U;
            A.router = args.in[22] + (size_t)j * DM * NE; A.eidx = (int*)(ws + WS_EIDX); A.gout = (float*)(ws + WS_GATE); A.cnt = (int*)(ws + WS_CNT);
            REP(4 | 512) row_phase<false, 1, true, false>(F, A, nro);
        }
#endif
        GRID_BAR();
#if PH(17)
        REP(4 | 1024) o5_phase(F, nro);
#endif
        GRID_BAR();
#if PH(18)
        {
            const int* TST = (const int*)(ws + WS_TST);
            const int ts1 = TST[1], ts2 = TST[2], ts3 = TST[3], ts4 = TST[4], ts5 = TST[5], ts6 = TST[6], ts7 = TST[7], nT = TST[8];
            const int rem = nT % MOE_CH, nseg = nT / MOE_CH + 1;
            for (int p = 0; p <= nseg; ++p) {
                int n7 = 0;
                if (p >= 1) {
                    const int sg = p - 1; const int t0 = sg == 0 ? 0 : rem + (sg - 1) * MOE_CH, nrt = sg == 0 ? rem : MOE_CH; n7 = nrt * (DM / 256);
                    const bf16* hb = (const bf16*)(ws + WS_HIDM) + (size_t)((sg == 0 || ((sg - 1) & 1)) ? MOE_CH : 0) * 256 * DFE;
                    pg8::Gemm g{hb - (size_t)t0 * 256 * DFE, (const bf16*)(ws + WS_MWDN), DFE, DFE, DFE};
                    pg8::MoeOrder S{t0, nrt, DM / 256, F.G, (int)blockIdx.x, ts1, ts2, ts3, ts4, ts5, ts6, ts7, 0, 0};
                    EpiY E{(bf16*)(ws + WS_VG), DM / 256};
                    REP(8) pg8::gemm_phase<EpiY, pg8::MoeOrder, true>(ring, g, S, E, F.wave);
                }
                if (p < nseg) {
                    const int sg = p; const int t0 = sg == 0 ? 0 : rem + (sg - 1) * MOE_CH, nrt = sg == 0 ? rem : MOE_CH;
                    bf16* hb = (bf16*)(ws + WS_HIDM) + (size_t)((sg == 0 || ((sg - 1) & 1)) ? MOE_CH : 0) * 256 * DFE;
                    pg8::Gemm g{(const bf16*)(ws + WS_VG), (const bf16*)(ws + WS_MWGU), DM, DM, DM};
                    pg8::MoeOrder S{t0, nrt, 2 * DFE / 256, F.G, (int)blockIdx.x, ts1, ts2, ts3, ts4, ts5, ts6, ts7, n7 % F.G, 4};
                    EpiGateUp E{hb, DFE, 2 * DFE / 256, t0 * 256};
                    REP(8) pg8::gemm_phase<EpiGateUp, pg8::MoeOrder, true>(ring, g, S, E, F.wave);
                }
                GRID_BAR();
            }
        }
#endif
    }
#if PH(19)
    {
        RowArgs A{}; A.hb = HB; A.fout = args.out; A.g = args.in[7];
        A.Y = (const bf16*)(ws + WS_VG); A.pos = (const int*)(ws + WS_POS); A.gate = (const float*)(ws + WS_GATE); A.modprev = MODV + (size_t)3 * 17 * NMOD;
        row_phase<true, 2, false, false>(F, A, M);
        if (xb_ld((unsigned*)(ws + WS_CTL) + CW_BAR + XB_TMO) != 0u) { __syncthreads(); const float qn = __builtin_nanf(""); for (int i = F.tid; i < 1024; i += 512) args.out[(size_t)blockIdx.x * 1024 + i] = qn; }
    }
#endif
}

extern "C" void kernel_launch(void* const* d_in, const int* in_sizes, int n_in, void* d_out, int out_size, void* d_ws, size_t ws_size, hipStream_t stream) {
    static int grid = 0;
    if (grid == 0) {
        if (n_in != 26 || out_size != M * DM || ws_size < WS_END) { fprintf(stderr, "kernel_launch: unexpected shapes (n_in %d out %d ws %zu)\n", n_in, out_size, ws_size); grid = -1; return; }
        int dev = 0, cus = 0, per_cu = 0;
        if (hipGetDevice(&dev) != hipSuccess || hipDeviceGetAttribute(&cus, hipDeviceAttributeMultiprocessorCount, dev) != hipSuccess) { grid = -1; return; }
        if (hipFuncSetAttribute((const void*)mega_fwd, hipFuncAttributeMaxDynamicSharedMemorySize, LDS_BYTES) != hipSuccess) { grid = -1; return; }
        if (hipOccupancyMaxActiveBlocksPerMultiprocessor(&per_cu, (const void*)mega_fwd, NWAVES * 64, LDS_BYTES) != hipSuccess || per_cu < 1) fprintf(stderr, "kernel_launch: occupancy query says %d\n", per_cu);
        (void)hipGetLastError();
        grid = cus > 256 ? 256 : cus;
    }
    if (grid < 0) return;
    if (hipMemsetAsync((char*)d_ws + WS_CTL, 0, CTL_ZERO_BYTES, stream) != hipSuccess) return;
    Args a{};
    for (int i = 0; i < 26; ++i) a.in[i] = (const float*)d_in[i];
    a.out = (float*)d_out; a.ws = (unsigned char*)d_ws;
    hipLaunchKernelGGL(mega_fwd, dim3(grid), dim3(NWAVES * 64), LDS_BYTES, stream, a);
}
```

```cpp
#include <hip/hip_runtime.h>
#ifndef DUPMASK
#define DUPMASK 0
#endif
#include <cstdio>
#include <cstdint>

__device__ __forceinline__ int lane_now() { int l; asm volatile("v_mbcnt_lo_u32_b32 %0, -1, 0\n\tv_mbcnt_hi_u32_b32 %0, -1, %0" : "=v"(l)); return l; }
namespace pg8 {
#define PG8_LAS __attribute__((address_space(3)))
typedef unsigned short bf16_t;
typedef short bf16x8 __attribute__((ext_vector_type(8)));
typedef int v4i_t __attribute__((ext_vector_type(4)));
typedef int v8i_t __attribute__((ext_vector_type(8)));
typedef float f32x4 __attribute__((ext_vector_type(4)));
typedef unsigned u32x4 __attribute__((ext_vector_type(4)));
constexpr int BM = 256, BK = 64, HALF = 128, HTB = HALF * BK * 2, STAGE_BYTES = 8 * HTB, NXCD = 8, WGM = 8;

__host__ __device__ __forceinline__ int lds_byte(int r, int c) { const int st = (r >> 4) * 2 + (c >> 5), rr = r & 15, cc = c & 31, ob = rr * 64 + cc * 2; return st * 1024 + (ob ^ (((ob >> 9) & 1) << 5)); }
__host__ __device__ __forceinline__ void stage_rc(int b, int& R, int& C) { const int st = b / 1024, sb = b % 1024, swz = sb ^ (((sb >> 9) & 1) << 5); R = (st >> 1) * 16 + swz / 64; C = (st & 1) * 32 + (swz % 64) / 2; }
__host__ __device__ __forceinline__ int perm32(int rho) { const int n = rho >> 4, i = rho & 15; return 8 * (i >> 2) + 4 * n + (i & 3); }

struct Unit { int pm, pn; };
struct Gemm { const bf16_t* A; const bf16_t* Bt; int lda, ldb, K; const int* idx; };

struct StaticOrder {
    int nM, nN, nwg, G, c;
    __device__ void init(int M, int N, int G_, int c_) { nM = M / BM; nN = N / BM; nwg = nM * nN; G = G_; c = c_; }
    __device__ bool next(int i, Unit& u) const {
        const long L = (long)i * G + c; if (L >= nwg) return false;
        int wgid = (int)L; { const int q = nwg / NXCD, r = nwg % NXCD, xcd = wgid % NXCD, off = wgid / NXCD; wgid = (xcd < r ? xcd * (q + 1) : r * (q + 1) + (xcd - r) * q) + off; }
        const int nig = WGM * nN, gid = wgid / nig, fm = gid * WGM, gsz = (nM - fm) < WGM ? (nM - fm) : WGM;
        u.pm = fm + ((wgid % nig) % gsz); u.pn = (wgid % nig) / gsz; return true;
    }
};
struct InOrder {
    StaticOrder lat; int nlat, nctx_ct, G, c;
    __device__ void init(bool full, int G_, int c_) { lat.init(32768, 3328, G_, c_); nlat = lat.nwg; nctx_ct = full ? 13 : 8; G = G_; c = c_; }
    __device__ bool next(int i, Unit& u) const {
        const int L = i * G + c; if (L < nlat) return lat.next(i, u);
        const int x = L - nlat; if (x >= 16 * nctx_ct) return false;
        const int rt = (nctx_ct == 13) ? x / 13 : x >> 3, q = x - rt * nctx_ct; u.pm = 128 + rt; u.pn = (nctx_ct == 13) ? q : (q < 2 ? q + 1 : q + 3); return true;
    }
};
struct PoolOrder {
    int nrt, talloc, G, c;
    __device__ bool next(int i, Unit& u) const { const int L = i * G + c; if (L >= 4 * nrt) return false; const int g = L / nrt, rt = L - g * nrt; u.pm = g * talloc + rt; u.pn = g; return true; }
};
struct MoeOrder {
    int t0, nrt, nct, G, c; int ts1, ts2, ts3, ts4, ts5, ts6, ts7;
    int skipw, skipr;
    __device__ bool next(int i, Unit& u) const {
        const int nwg = nrt * nct; const int r_ = i + (c < skipw ? skipr : 0);
        const int L = (r_ < skipr) ? r_ * (G - skipw) + (c - skipw) : skipr * (G - skipw) + (r_ - skipr) * G + c; if (L >= nwg) return false;
        int wgid = L; { const int q = nwg / NXCD, r = nwg % NXCD, xcd = wgid % NXCD, off = wgid / NXCD; wgid = (xcd < r ? xcd * (q + 1) : r * (q + 1) + (xcd - r) * q) + off; }
        const int nig = WGM * nct, gid = wgid / nig, fm = gid * WGM, gsz = (nrt - fm) < WGM ? (nrt - fm) : WGM;
        const int rt = t0 + fm + ((wgid % nig) % gsz), ct = (wgid % nig) / gsz;
        const int e = (rt >= ts1) + (rt >= ts2) + (rt >= ts3) + (rt >= ts4) + (rt >= ts5) + (rt >= ts6) + (rt >= ts7);
        u.pm = rt; u.pn = e * nct + ct; return true;
    }
};

typedef float f32x2_cv __attribute__((ext_vector_type(2))); typedef __bf16 bf16x2_cv __attribute__((ext_vector_type(2)));
__device__ __forceinline__ unsigned cvt_pk_bf16(float lo, float hi) { const f32x2_cv v = {lo, hi}; const bf16x2_cv b = __builtin_convertvector(v, bf16x2_cv); return __builtin_bit_cast(unsigned, b); }

template <class Epi, class Sched, bool ALIGN_EPI, bool GATHER = false, bool FP8 = false>
__device__ __forceinline__ void gemm_phase(PG8_LAS unsigned char* lds, const Gemm g, const Sched& S, const Epi& E, const int wid) {
    const int lane_ = lane_now();
    const int lane = lane_, tid = wid * 64 + lane, wr = wid >> 2, wc = wid & 3, fr = lane & 15, fq = lane >> 4;
    int K_ = g.K; asm volatile("" : "+s"(K_));
    const int K = K_, nt = K / BK;
    unsigned voffA[2], voffB[2]; int RA0 = 0, CA0 = 0;
#pragma unroll
    for (int i = 0; i < 2; ++i) { int R, C; stage_rc(tid * 16 + i * 8192, R, C); const int Rb = Epi::PERM ? ((R & ~31) + perm32(R & 31)) : R; if (i == 0) { RA0 = R; CA0 = C; }
        voffA[i] = (unsigned)(R * g.lda + C) * 2u; voffB[i] = (unsigned)(Rb * g.ldb + C) * 2u; }
    unsigned gc[2][2]; PG8_LAS int* IB = (PG8_LAS int*)(lds + STAGE_BYTES);
#define PG8_GLOAD(dst, pm_) do { _Pragma("unroll") for (int h_ = 0; h_ < 2; ++h_) _Pragma("unroll") for (int i_ = 0; i_ < 2; ++i_) \
        dst[h_][i_] = ((unsigned)g.idx[(pm_) * 256 + h_ * 128 + i_ * 64 + RA0] * (unsigned)g.lda + (unsigned)CA0) * 2u; } while (0)
#define PG8_GNEXT(h_) do { if (last && has_next) { _Pragma("unroll") for (int i_ = 0; i_ < 2; ++i_) gc[h_][i_] = ((unsigned)IB[(h_) * 128 + i_ * 64 + RA0] * (unsigned)g.lda + (unsigned)CA0) * 2u; } } while (0)
    const size_t kstep = (size_t)(BK * 2);
    const size_t hstepA = (size_t)HALF * g.lda * 2, hstepB = (size_t)HALF * g.ldb * 2;
    const size_t tstepA = 2 * hstepA, tstepB = 2 * hstepB;
    const unsigned ldsw = (unsigned)wid * 1024u;
    const int aoff = lds_byte(wr * 64 + fr, fq * 8), boff = lds_byte(wc * 32 + fr, fq * 8);
#define PG8_SA(b, h) (((b) * 2 + (h)) * HTB)
#define PG8_SB(b, h) ((4 + (b) * 2 + (h)) * HTB)
#define PG8_STAGE(bufoff, gbase, voff) do { _Pragma("unroll") for (int _i = 0; _i < 2; ++_i) \
        __builtin_amdgcn_global_load_lds((const unsigned*)((const char*)(gbase) + (voff)[_i]), (PG8_LAS unsigned*)(lds + (bufoff) + ldsw + _i * 8192), 16, 0, 0); } while (0)
#define PG8_STAGEG(bufoff, gbase, o0_, o1_) do { __builtin_amdgcn_global_load_lds((const unsigned*)((const char*)(gbase) + (o0_)), (PG8_LAS unsigned*)(lds + (bufoff) + ldsw), 16, 0, 0); \
        __builtin_amdgcn_global_load_lds((const unsigned*)((const char*)(gbase) + (o1_)), (PG8_LAS unsigned*)(lds + (bufoff) + ldsw + 8192), 16, 0, 0); } while (0)
#define PG8_LDA(dst, b, h) do { if constexpr (FP8) { _Pragma("unroll") for (int m = 0; m < 4; ++m) { const PG8_LAS v4i_t* p_ = (const PG8_LAS v4i_t*)(lds + PG8_SA(b, h) + aoff + m * 2048); dst##8[m] = __builtin_shufflevector(p_[0], p_[64], 0, 1, 2, 3, 4, 5, 6, 7); } } \
        else { _Pragma("unroll") for (int m = 0; m < 4; ++m) _Pragma("unroll") for (int k = 0; k < 2; ++k) dst[m][k] = *(const PG8_LAS bf16x8*)(lds + PG8_SA(b, h) + aoff + m * 2048 + k * 1024); } } while (0)
#define PG8_LDB(dst, b, h) do { if constexpr (FP8) { _Pragma("unroll") for (int n = 0; n < 2; ++n) { const PG8_LAS v4i_t* p_ = (const PG8_LAS v4i_t*)(lds + PG8_SB(b, h) + boff + n * 2048); dst##8[n] = __builtin_shufflevector(p_[0], p_[64], 0, 1, 2, 3, 4, 5, 6, 7); } } \
        else { _Pragma("unroll") for (int n = 0; n < 2; ++n) _Pragma("unroll") for (int k = 0; k < 2; ++k) dst[n][k] = *(const PG8_LAS bf16x8*)(lds + PG8_SB(b, h) + boff + n * 2048 + k * 1024); } } while (0)
#define PG8_MMA(ai, bj, At, Bt) do { __builtin_amdgcn_s_setprio(1); \
        if constexpr (FP8) { _Pragma("unroll") for (int m = 0; m < 4; ++m) _Pragma("unroll") for (int n = 0; n < 2; ++n) \
            asm volatile("v_mfma_f32_16x16x128_f8f6f4 %0, %1, %2, %0" : "+v"(acc[ai][bj][m][n]) : "v"(Bt##8[n]), "v"(At##8[m])); } \
        else { _Pragma("unroll") for (int m = 0; m < 4; ++m) _Pragma("unroll") for (int n = 0; n < 2; ++n) _Pragma("unroll") for (int k = 0; k < 2; ++k) \
            acc[ai][bj][m][n] = __builtin_amdgcn_mfma_f32_16x16x32_bf16(Bt[n][k], At[m][k], acc[ai][bj][m][n], 0, 0, 0); } \
        __builtin_amdgcn_s_setprio(0); } while (0)
#define PG8_WAIT_V(n) asm volatile("s_waitcnt vmcnt(" #n ")" ::: "memory")
#define PG8_WAIT_L(n) asm volatile("s_waitcnt lgkmcnt(" #n ")" ::: "memory")
#define PG8_BAR __builtin_amdgcn_s_barrier()
#define PG8_SCHED __builtin_amdgcn_sched_barrier(0)
    Unit cur, nxt; int ui = 0;
    if (!S.next(0, cur)) return;
    f32x4 acc[2][2][4][2];
#pragma unroll
    for (int a = 0; a < 2; ++a)
#pragma unroll
        for (int b = 0; b < 2; ++b)
#pragma unroll
            for (int m = 0; m < 4; ++m)
#pragma unroll
                for (int n = 0; n < 2; ++n) acc[a][b][m][n] = (f32x4){0.f, 0.f, 0.f, 0.f};
    bf16x8 At[4][2], B0[2][2], B1[2][2]; v8i_t At8[4], B08[2], B18[2];
    const char* cA = GATHER ? (const char*)g.A : (const char*)g.A + (size_t)cur.pm * tstepA; const char* cB = (const char*)g.Bt + (size_t)cur.pn * tstepB;
    if constexpr (GATHER) { PG8_GLOAD(gc, cur.pm); }
    PG8_STAGE(PG8_SB(0, 0), cB, voffB); PG8_STAGE(PG8_SB(0, 1), cB + hstepB, voffB);
    if constexpr (GATHER) { PG8_STAGEG(PG8_SA(0, 0), cA, gc[0][0], gc[0][1]); PG8_STAGEG(PG8_SA(0, 1), cA, gc[1][0], gc[1][1]); }
    else { PG8_STAGE(PG8_SA(0, 0), cA, voffA); PG8_STAGE(PG8_SA(0, 1), cA + hstepA, voffA); }
    if (wr == 1) PG8_BAR;
    PG8_WAIT_V(2); PG8_BAR;
    PG8_STAGE(PG8_SB(1, 0), cB + kstep, voffB); if constexpr (GATHER) { PG8_STAGEG(PG8_SA(1, 0), cA + kstep, gc[0][0], gc[0][1]); } else { PG8_STAGE(PG8_SA(1, 0), cA + kstep, voffA); } PG8_STAGE(PG8_SB(1, 1), cB + hstepB + kstep, voffB);
    PG8_WAIT_V(6); PG8_BAR;
    for (;;) {
        const bool has_next = S.next(ui + 1, nxt);
        const char* nA = GATHER ? cA : (has_next ? (const char*)g.A + (size_t)nxt.pm * tstepA : cA); const char* nB = has_next ? (const char*)g.Bt + (size_t)nxt.pn * tstepB : cB;
        if constexpr (GATHER) { if (has_next && wid == 0) __builtin_amdgcn_global_load_lds((const unsigned*)(g.idx + (size_t)nxt.pm * 256 + lane * 4), (PG8_LAS unsigned*)IB, 16, 0, 0); }
#pragma unroll 1
        for (int t = 0; t < nt; t += 2) {
            const bool last = (t == nt - 2);
            const char* a1 = cA + (size_t)(t + 1) * kstep;
            const char* a2 = last ? nA : cA + (size_t)(t + 2) * kstep; const char* b2 = last ? nB : cB + (size_t)(t + 2) * kstep;
            const char* a3 = a2 + kstep; const char* b3 = b2 + kstep;
            PG8_LDB(B0, 0, 0); PG8_LDB(B1, 0, 1); PG8_SCHED; PG8_LDA(At, 0, 0); if constexpr (GATHER) { PG8_GNEXT(0); PG8_STAGEG(PG8_SA(1, 1), a1, gc[1][0], gc[1][1]); PG8_GNEXT(1); } else { PG8_STAGE(PG8_SA(1, 1), a1 + hstepA, voffA); }
            PG8_WAIT_V(8); PG8_WAIT_L(0); PG8_BAR; PG8_MMA(0, 0, At, B0); PG8_MMA(0, 1, At, B1); PG8_BAR; PG8_SCHED;
            PG8_LDA(At, 0, 1); PG8_STAGE(PG8_SB(0, 0), b2, voffB); PG8_STAGE(PG8_SB(0, 1), b2 + hstepB, voffB); if constexpr (GATHER) { PG8_STAGEG(PG8_SA(0, 0), a2, gc[0][0], gc[0][1]); } else { PG8_STAGE(PG8_SA(0, 0), a2, voffA); }
            PG8_WAIT_V(8); PG8_WAIT_L(0); PG8_BAR; PG8_MMA(1, 0, At, B0); PG8_MMA(1, 1, At, B1); PG8_BAR; PG8_SCHED;
            PG8_LDB(B0, 1, 0); PG8_LDB(B1, 1, 1); PG8_SCHED; PG8_LDA(At, 1, 0); if constexpr (GATHER) { PG8_STAGEG(PG8_SA(0, 1), a2, gc[1][0], gc[1][1]); } else { PG8_STAGE(PG8_SA(0, 1), a2 + hstepA, voffA); }
            PG8_WAIT_V(8); PG8_WAIT_L(0); PG8_BAR; PG8_MMA(0, 0, At, B0); PG8_MMA(0, 1, At, B1); PG8_BAR; PG8_SCHED;
            PG8_LDA(At, 1, 1); PG8_STAGE(PG8_SB(1, 0), b3, voffB); PG8_STAGE(PG8_SB(1, 1), b3 + hstepB, voffB); if constexpr (GATHER) { PG8_STAGEG(PG8_SA(1, 0), a3, gc[0][0], gc[0][1]); } else { PG8_STAGE(PG8_SA(1, 0), a3, voffA); }
            PG8_WAIT_V(8); PG8_WAIT_L(0); PG8_BAR; PG8_MMA(1, 0, At, B0); PG8_MMA(1, 1, At, B1); PG8_BAR; PG8_SCHED;
        }
        if constexpr (FP8) { asm volatile("s_nop 15\n\ts_nop 15" ::: "memory"); PG8_SCHED; }
        if constexpr (ALIGN_EPI) { if (wr == 0) PG8_BAR; }
        E(acc, cur, wr, wc, fr, fq);
        if (!has_next) break;
#pragma unroll
        for (int a = 0; a < 2; ++a)
#pragma unroll
            for (int b = 0; b < 2; ++b)
#pragma unroll
                for (int m = 0; m < 4; ++m)
#pragma unroll
                    for (int n = 0; n < 2; ++n) acc[a][b][m][n] = (f32x4){0.f, 0.f, 0.f, 0.f};
        cur = nxt; cA = nA; cB = nB; ++ui;
        if constexpr (ALIGN_EPI) { if (wr == 1) PG8_BAR; }
    }
    PG8_WAIT_V(0);
    if constexpr (!ALIGN_EPI) { if (wr == 0) PG8_BAR; }
    PG8_BAR;
#undef PG8_SA
#undef PG8_SB
#undef PG8_STAGE
#undef PG8_STAGEG
#undef PG8_GLOAD
#undef PG8_GNEXT
#undef PG8_LDA
#undef PG8_LDB
#undef PG8_MMA
#undef PG8_WAIT_V
#undef PG8_WAIT_L
#undef PG8_BAR
#undef PG8_SCHED
}
}

constexpr int NWAVES = 8;
constexpr int DM = 1024, NB = 16, SEQ = 2048, CTXL = 256;
constexpr int M = NB * SEQ, MC = NB * CTXL, MT = M + MC;
constexpr int QL = 384, KVL = 256, ROPE = 32, HW = 512, NH = 8, QKD = 96, VD = 64;
constexpr int INW = 3232, INP = 3328;
constexpr int DFF = 2816, NE = 8, DFE = 3584, NMOD = 6 * DM;
constexpr int NHH = 4, HK = 128; constexpr int NKEY = SEQ + CTXL;
constexpr float EPS = 1e-6f;
constexpr int MAXT = 296;
constexpr int MOE_CH = 128;

constexpr size_t MiB = 1u << 20;
constexpr size_t WS_CTL = 0, CTL_ZERO_BYTES = 1 * MiB;
constexpr size_t WS_MODV = 1 * MiB;
constexpr size_t WS_ROPE = 3 * MiB;
constexpr size_t WS_CNT = 3 * MiB + 64 * 1024;
constexpr size_t WS_TST = 3 * MiB + 128 * 1024;
constexpr size_t WS_EIDX = 4 * MiB, WS_GATE = 4 * MiB + 512 * 1024, WS_POS = 5 * MiB, WS_IDX = 5 * MiB + 512 * 1024;
constexpr size_t WS_RSQ = 6 * MiB, WS_RSKV = 7 * MiB + 256 * 1024;
constexpr size_t WS_WSTAT = 3 * MiB + 160 * 1024;
constexpr size_t WS_RS = WS_RSQ, WS_RSU = WS_RSKV;
constexpr size_t WS_WIN = 8 * MiB, WS_WUQ = 21 * MiB, WS_WUKV = 23 * MiB, WS_WOUT = 24 * MiB, WS_WGU = 28 * MiB, WS_WDN = 50 * MiB, WS_WPOOL = 61 * MiB;
constexpr size_t WS_HB = 62 * MiB;
constexpr size_t WS_U = 134 * MiB;
constexpr size_t WS_X = 206 * MiB;
constexpr size_t WS_CQ = WS_X, WS_CKV = 233 * MiB, WS_KRR = 251 * MiB, WS_HQ = 254 * MiB  ;
constexpr size_t WS_QB = 434 * MiB, WS_KN = 488 * MiB, WS_VV = 524 * MiB, WS_OF = 560 * MiB, WS_OB = 632 * MiB, WS_MIX = 704 * MiB, WS_HID = WS_X;
constexpr size_t WS_MWGU = 780 * MiB, WS_MWDN = 840 * MiB  , WS_VG = 374 * MiB, WS_POOLED = WS_VG  , WS_HIDM = 522 * MiB, WS_END = 970 * MiB;
constexpr size_t HSEG = (size_t)MT * HW;
static_assert(WS_WPOOL + (size_t)2 * 4 * 65536 * 2 <= WS_HB && WS_HB + (size_t)MT * DM * 2 <= WS_U && WS_U + (size_t)MT * DM * 2 <= WS_X && WS_KRR + (size_t)MT * ROPE * 2 <= WS_HQ && WS_HQ + 5 * HSEG * 2 <= WS_QB && WS_MIX + (size_t)MT * DM * 2 <= WS_END && WS_HID + (size_t)MT * DFF * 2 <= WS_QB, "ws map even");
static_assert(WS_HIDM + (size_t)2 * MOE_CH * 256 * DFE * 2 <= WS_END && WS_VG + (size_t)MAXT * 256 * DM * 2 <= WS_HIDM && WS_MWDN + (size_t)NE * DM * DFE <= WS_END && WS_MWGU + (size_t)NE * 2 * DFE * DM <= WS_MWDN && WS_MIX + (size_t)MT * DM * 2 <= WS_MWGU && WS_HIDM + (size_t)2 * MOE_CH * 256 * DFE <= WS_MWGU, "ws map odd");
constexpr int CW_BAR = 4096;

constexpr int RING_OFF = 0, RING_BYTES = 143360;
constexpr int LDSCTL_OFF = RING_BYTES, MISC_OFF = LDSCTL_OFF + 320;
constexpr int LDS_BYTES = 147456;

#define GAS __attribute__((address_space(1)))
#define LAS __attribute__((address_space(3)))
typedef unsigned short bf16;
typedef unsigned v4u __attribute__((ext_vector_type(4)));
typedef unsigned v2u __attribute__((ext_vector_type(2)));
typedef float f32x4 __attribute__((ext_vector_type(4)));
typedef float f32x2 __attribute__((ext_vector_type(2)));
typedef GAS unsigned gu32;
#define RLX_AGENT __ATOMIC_RELAXED, __HIP_MEMORY_SCOPE_AGENT
#define LDS_WAIT() asm volatile("s_waitcnt lgkmcnt(0)" ::: "memory")
__device__ __forceinline__ unsigned f2bf(float f) { unsigned u = __builtin_bit_cast(unsigned, f); return (u + 0x7fffu + ((u >> 16) & 1u)) >> 16; }
__device__ __forceinline__ unsigned pk2(float lo, float hi) { return f2bf(lo) | (f2bf(hi) << 16); }
__device__ __forceinline__ float bf2f(unsigned short b) { return __uint_as_float((unsigned)b << 16); }
__device__ __forceinline__ float bflo(unsigned w) { return __uint_as_float(w << 16); }
__device__ __forceinline__ float bfhi(unsigned w) { return __uint_as_float(w & 0xffff0000u); }
__device__ __forceinline__ float sigmoidf_(float x) { return 1.0f / (1.0f + __expf(-x)); }
__device__ __forceinline__ float siluf_(float x) { return x * __builtin_amdgcn_rcpf(1.0f + __expf(-x)); }

#define XB_TMO      128
#define XB_XCNT(j)  (256  + 64 * (j))
#define XB_XSUB(j)  (1280 + 64 * (j))
#define XB_XGEN(j)  (2304 + 64 * (j))
#define XB_TOP      3328
#define XB_TOPGEN   3392
#define XCD_BAR_WORDS 3456
#define XB_SPIN_CAP (1u << 22)
__device__ __forceinline__ unsigned xb_ld(unsigned* p)              { return __hip_atomic_load(p, __ATOMIC_RELAXED, __HIP_MEMORY_SCOPE_AGENT); }
__device__ __forceinline__ unsigned xb_add(unsigned* p, unsigned v) { return __hip_atomic_fetch_add(p, v, __ATOMIC_RELAXED, __HIP_MEMORY_SCOPE_AGENT); }
__device__ __forceinline__ unsigned xb_xcc_id() { return (unsigned)__builtin_amdgcn_s_getreg((3 << 11) | 20) & 0xFu; }
#define XB_SPIN(cond, bar) do { unsigned _sp = 0; while (cond) { __builtin_amdgcn_s_sleep(1); \
    if ((++_sp & 255u) == 0u) { if (xb_ld(&(bar)[XB_TMO])) break; if (_sp > XB_SPIN_CAP) { atomicAdd(&(bar)[XB_TMO], 1u); break; } } } } while (0)
struct XcdBarrier { unsigned* bar; unsigned x; volatile LAS unsigned* st; int wave; };
__device__ __forceinline__ bool xb_leader(int wave) { return wave == 0 && lane_now() == 0; }
__device__ __forceinline__ XcdBarrier xcd_barrier_post(unsigned* bar, volatile LAS unsigned* st, int wave) {
    XcdBarrier b; b.bar = bar; b.x = xb_xcc_id(); b.st = st; b.wave = wave;
    if (xb_leader(wave)) (void)xb_add(&bar[XB_XCNT(b.x)], 1u);
    return b;
}
__device__ __forceinline__ void xcd_barrier_complete(unsigned* bar, unsigned x, unsigned& nloc, unsigned& nx) {
    const unsigned G = gridDim.x * gridDim.y * gridDim.z;
    unsigned sum, cnt, mine, sp = 0u;
    for (;;) {
        sum = 0u; cnt = 0u; mine = 0u;
#pragma unroll
        for (unsigned j = 0; j < 16; ++j) { const unsigned c = xb_ld(&bar[XB_XCNT(j)]); sum += c; cnt += (c > 0u) ? 1u : 0u; mine = (j == x) ? c : mine; }
        if (sum == G) break;
        __builtin_amdgcn_s_sleep(1);
        if ((++sp & 255u) == 0u) { if (xb_ld(&bar[XB_TMO])) break; if (sp > XB_SPIN_CAP) { atomicAdd(&bar[XB_TMO], 1u); break; } }
    }
    nloc = mine > 0u ? mine : 1u; nx = cnt > 0u ? cnt : 1u;
}
__device__ __forceinline__ void xcd_barrier(const XcdBarrier& b) {
    asm volatile("s_waitcnt vmcnt(0)" ::: "memory");
    __syncthreads();
    if (xb_leader(b.wave)) {
        unsigned* bar = b.bar; asm volatile("" : "+s"(bar));
        __builtin_amdgcn_s_waitcnt(0);
        unsigned nloc = b.st[0], nx = b.st[1];
        if (nloc == 0u) { xcd_barrier_complete(bar, b.x, nloc, nx); b.st[0] = nloc; b.st[1] = nx; }
        const unsigned old = xb_add(&bar[XB_XSUB(b.x)], 1u);
        const unsigned gen = old / nloc;
        if (old + 1u == (gen + 1u) * nloc) {
            __builtin_amdgcn_fence(__ATOMIC_RELEASE, "agent");
            asm volatile("s_waitcnt vmcnt(0)" ::: "memory");
            const unsigned og = xb_add(&bar[XB_TOP], 1u);
            const unsigned tg = og / nx;
            if (og + 1u == (tg + 1u) * nx) xb_add(&bar[XB_TOPGEN], 1u);
            else XB_SPIN(xb_ld(&bar[XB_TOPGEN]) == tg, bar);
            __builtin_amdgcn_fence(__ATOMIC_ACQUIRE, "agent");
            xb_add(&bar[XB_XGEN(b.x)], 1u);
            asm volatile("s_waitcnt vmcnt(0)" ::: "memory");
        } else {
            XB_SPIN(xb_ld(&bar[XB_XGEN(b.x)]) == gen, bar);
            __builtin_amdgcn_fence(__ATOMIC_ACQUIRE, "agent");
            asm volatile("s_waitcnt vmcnt(0)" ::: "memory");
        }
    }
    __syncthreads();
}

struct Args { const float* in[26]; float* out; unsigned char* ws; };
struct Frame {
    LAS unsigned char* lds;
    int tid, lane, wave, G, vcu;
    const float* const* in; float* out; unsigned char* ws;
};
__device__ __forceinline__ float shx(float v, int lane, int m) { return __int_as_float(__builtin_amdgcn_ds_bpermute((lane ^ m) << 2, __float_as_int(v))); }
__device__ __forceinline__ float wave_sum(float v, int lane) {
#pragma unroll
    for (int o = 1; o < 64; o <<= 1) v += shx(v, lane, o);
    return v;
}

__device__ __forceinline__ float wave_max(float v, int lane) {
#pragma unroll
    for (int m = 32; m >= 1; m >>= 1) v = fmaxf(v, shx(v, lane, m));
    return v;
}
__device__ __forceinline__ float clamp448(float x) { return __builtin_amdgcn_fmed3f(x, -448.0f, 448.0f); }
__device__ __forceinline__ unsigned pk4_fp8(float a, float b, float c, float d) { int p = __builtin_amdgcn_cvt_pk_fp8_f32(a, b, 0, false); p = __builtin_amdgcn_cvt_pk_fp8_f32(c, d, p, true); return (unsigned)p; }
__device__ __forceinline__ void fresh(Frame& F) { const int l = lane_now(); F.lane = l; F.tid = F.wave * 64 + l; }

__device__ __forceinline__ void conv_item(const float* W, int ldw, bf16* WT, int ldd, int k0, int n0, int drow0, const float* kscale, float gscale, LAS float* scr, int lane) {
    float wv[32];
#pragma unroll
    for (int i = 0; i < 32; ++i) { const int kk = 2 * i + (lane >> 5); wv[i] = W[(size_t)(k0 + kk) * ldw + n0 + (lane & 31)]; }
#pragma unroll
    for (int i = 0; i < 32; ++i) { const int kk = 2 * i + (lane >> 5); float w = wv[i]; if (kscale) w *= kscale[k0 + kk]; scr[kk * 33 + (lane & 31)] = w * gscale; }
    LDS_WAIT(); asm volatile("" ::: "memory");
    const int c = lane & 7;
#pragma unroll
    for (int j = 0; j < 4; ++j) { const int n = (lane >> 3) + 8 * j; const LAS float* s = scr + (8 * c) * 33 + n;
        v4u o; o.x = pk2(s[0 * 33], s[1 * 33]); o.y = pk2(s[2 * 33], s[3 * 33]); o.z = pk2(s[4 * 33], s[5 * 33]); o.w = pk2(s[6 * 33], s[7 * 33]);
        *(v4u*)(WT + (size_t)(drow0 + n) * ldd + k0 + 8 * c) = o; }
    LDS_WAIT(); asm volatile("" ::: "memory");
}
__device__ __forceinline__ int conv_rowmap(int mode, int n0, int off) {
    if (mode == 0) return n0 + off;
    if (mode == 1) { if (n0 < 384) return n0; if (n0 < 640) return 512 + (n0 - 384); if (n0 < 672) return 384; return 768 + (n0 - 672); }
    return 256 * (n0 >> 7) + (n0 & 127) + off;
}
__device__ __forceinline__ void conv_matrix(Frame& F, const float* W, int K, int N, bf16* WT, int ldd, int mode, int off, const float* kscale, float gscale) {
    LAS float* scr = (LAS float*)(F.lds + RING_OFF + F.wave * 16384);
    const int gw = F.vcu * NWAVES + F.wave, NGW = F.G * NWAVES;
    const int nblk = N / 32, nitems = (K / 64) * nblk;
    for (int it = gw; it < nitems; it += NGW) { const int kb = it / nblk, nb = it % nblk; conv_item(W, N, WT, ldd, 64 * kb, 32 * nb, conv_rowmap(mode, 32 * nb, off), kscale, gscale, scr, F.lane); }
}

__device__ __forceinline__ void conv_item8(const float* W, int ldw, unsigned char* WT, int ldd, int k0, int n0, int drow0, float gscale, LAS float* scr, int lane) {
    float wv[32];
#pragma unroll
    for (int i = 0; i < 32; ++i) { const int kk = 2 * i + (lane >> 5); wv[i] = W[(size_t)(k0 + kk) * ldw + n0 + (lane & 31)]; }
#pragma unroll
    for (int i = 0; i < 32; ++i) { const int kk = 2 * i + (lane >> 5); scr[kk * 33 + (lane & 31)] = clamp448(wv[i] * gscale); }
    LDS_WAIT(); asm volatile("" ::: "memory");
    const int c = lane & 3;
#pragma unroll
    for (int j = 0; j < 2; ++j) { const int n = (lane >> 2) + 16 * j; const LAS float* s = scr + (16 * c) * 33 + n;
        v4u o; o.x = pk4_fp8(s[0 * 33], s[1 * 33], s[2 * 33], s[3 * 33]); o.y = pk4_fp8(s[4 * 33], s[5 * 33], s[6 * 33], s[7 * 33]);
        o.z = pk4_fp8(s[8 * 33], s[9 * 33], s[10 * 33], s[11 * 33]); o.w = pk4_fp8(s[12 * 33], s[13 * 33], s[14 * 33], s[15 * 33]);
        *(v4u*)(WT + (size_t)(drow0 + n) * ldd + k0 + 16 * c) = o; }
    LDS_WAIT(); asm volatile("" ::: "memory");
}
__device__ __forceinline__ void conv_matrix8(Frame& F, const float* W, int K, int N, unsigned char* WT, int ldd, int mode, int off, float gscale) {
    LAS float* scr = (LAS float*)(F.lds + RING_OFF + F.wave * 16384);
    const int gw = F.vcu * NWAVES + F.wave, NGW = F.G * NWAVES;
    const int nblk = N / 32, nitems = (K / 64) * nblk;
    for (int it = gw; it < nitems; it += NGW) { const int kb = it / nblk, nb = it % nblk; conv_item8(W, N, WT, ldd, 64 * kb, 32 * nb, conv_rowmap(mode, 32 * nb, off), gscale, scr, F.lane); }
}

__device__ __forceinline__ void ffn_weights8(Frame& F) {
    fresh(F);
    unsigned char* ws = F.ws; const float* st = (const float*)(ws + WS_WSTAT) + 96;
    conv_matrix8(F, F.in[18], DFF, DM, ws + WS_WDN, DFF, 0, 0, 1.0f / st[4]);
    for (int j = 1; j < 2; ++j) {
        conv_matrix8(F, F.in[16] + (size_t)j * DM * DFF, DM, DFF, ws + WS_WGU + (size_t)j * 2 * DFF * DM * 2, DM, 2, 0, 1.0f / st[j * 6 + 0]);
        conv_matrix8(F, F.in[17] + (size_t)j * DM * DFF, DM, DFF, ws + WS_WGU + (size_t)j * 2 * DFF * DM * 2, DM, 2, 128, 1.0f / st[j * 6 + 2]);
        conv_matrix8(F, F.in[18] + (size_t)j * DFF * DM, DFF, DM, ws + WS_WDN + (size_t)j * DM * DFF * 2, DFF, 0, 0, 1.0f / st[j * 6 + 4]);
    }
    __syncthreads();
}

constexpr int CONV_ITEMS = 24 * 1792, CONV_MIX = 10, CONV_O5 = 5;
__device__ __forceinline__ void conv_items(Frame& F, const float* const* in, int j, int start, int stride, int n, int scr_base = 0, int scr_stride = 16384) {
    unsigned char* ws = F.ws;
    LAS float* scr = (LAS float*)(F.lds + RING_OFF + scr_base + F.wave * scr_stride);
    const float* st = (const float*)(ws + WS_WSTAT) + j * 48;
    for (int t = 0; t < n; ++t) { const int gi = start + t * stride; if (gi >= CONV_ITEMS) break;
        const int m = gi / 1792, it = gi - m * 1792, e = m / 3, wh = m - 3 * e;
        if (wh < 2) { const int kb = it / 112, nb = it - kb * 112;
            conv_item8(in[23 + wh] + ((size_t)j * NE + e) * DM * DFE, DFE, ws + WS_MWGU + (size_t)e * 2 * DFE * DM, DM, 64 * kb, 32 * nb, conv_rowmap(2, 32 * nb, wh ? 128 : 0), 1.0f / st[e * 6 + 2 * wh], scr, F.lane); }
        else { const int kb = it >> 5, nb = it & 31;
            conv_item8(in[25] + ((size_t)j * NE + e) * DFE * DM, DM, ws + WS_MWDN + (size_t)e * DM * DFE, DFE, 64 * kb, 32 * nb, 32 * nb, 1.0f / st[e * 6 + 4], scr, F.lane); } }
}

__device__ __forceinline__ int row_bidx(int row) { return row < M ? row / SEQ : NB; }

struct RowArgs {
    const float* xin_l; const float* xin_c;
    const bf16* hb; bf16* hbo;
    float* fout;
    const float* g;
    const float* modl;
    int shoff, scoff;
    bf16* U;
    const bf16* Y; const int* pos; const float* gate; const float* modprev;
    const float* router; int* eidx; float* gout; int* cnt;
    int hid_only;
    unsigned char* U8; float* rsu; f32x4* rs; const float* st;
};
template <bool COMBINE, int OUTMODE, bool ROUTER, bool INF32, bool F8OUT = false>
__device__ __forceinline__ void row_phase(Frame& F, const RowArgs& A, int nrows) {
    fresh(F);
    const int rpw = (nrows + F.G - 1) / F.G;
    LAS int* lcnt = (LAS int*)(F.lds + RING_OFF);
    if (ROUTER) { if (F.tid < 8) lcnt[F.tid] = 0; __syncthreads(); }
    int bid = (int)blockIdx.x; asm volatile("" : "+s"(bid));
    const int rbase = bid * rpw, rend = (rbase + rpw < nrows) ? rbase + rpw : nrows;
#define ROWLOAD(dst, r_) do { if (INF32) { const float* hr_ = ((r_) < M) ? A.xin_l + (size_t)(r_) * DM : A.xin_c + (size_t)((r_) - M) * DM; \
            _Pragma("unroll") for (int j = 0; j < 4; ++j) dst[j] = *(const f32x4*)(hr_ + 4 * F.lane + 256 * j); } \
        else { _Pragma("unroll") for (int j = 0; j < 4; ++j) { const v2u w_ = *(const v2u*)(A.hb + (size_t)(r_) * DM + 4 * F.lane + 256 * j); dst[j] = (f32x4){bflo(w_.x), bfhi(w_.x), bflo(w_.y), bfhi(w_.y)}; } } } while (0)
    LAS float* LV = (LAS float*)(F.lds + RING_OFF + 1024);
    const int lb0 = ROUTER ? (rbase < M ? rbase / SEQ : NB) : 0;
    if (ROUTER) { const int lb1 = (rend - 1) < M ? (rend - 1) / SEQ : NB;
        for (int e = F.tid; e < 1024; e += 512) { LV[e] = A.g[e]; LV[1024 + e] = A.modl[lb0 * NMOD + A.shoff + e]; LV[2048 + e] = A.modl[lb0 * NMOD + A.scoff + e];
            LV[3072 + e] = A.modl[lb1 * NMOD + A.shoff + e]; LV[4096 + e] = A.modl[lb1 * NMOD + A.scoff + e]; }
        __syncthreads(); }
    f32x4 rw[16][2];
    if (ROUTER) {
#pragma unroll
        for (int j = 0; j < 4; ++j)
#pragma unroll
            for (int q = 0; q < 4; ++q) { const int col = 4 * F.lane + 256 * j + q; rw[4 * j + q][0] = *(const f32x4*)(A.router + (size_t)col * 8); rw[4 * j + q][1] = *(const f32x4*)(A.router + (size_t)col * 8 + 4); }
    }
    int row = rbase + F.wave;
    f32x4 v[4], vn[4];
    if (row < rend) ROWLOAD(v, row);
    float ga = 0.f, gb = 0.f, gan = 0.f, gbn = 0.f; int pan = 0, pbn = 0; v2u ya[4], yb[4], yan[4], ybn[4];
#define YLOAD(da, db, pa_, pb_) do { _Pragma("unroll") for (int j = 0; j < 4; ++j) { da[j] = *(const v2u*)(A.Y + (size_t)(pa_) * DM + 4 * F.lane + 256 * j); db[j] = *(const v2u*)(A.Y + (size_t)(pb_) * DM + 4 * F.lane + 256 * j); } } while (0)
    if (COMBINE) {
        if (row < rend) { const int pa = A.pos[2 * row], pb = A.pos[2 * row + 1]; ga = A.gate[2 * row]; gb = A.gate[2 * row + 1];
            if (row + NWAVES < rend) { pan = A.pos[2 * (row + NWAVES)]; pbn = A.pos[2 * (row + NWAVES) + 1]; gan = A.gate[2 * (row + NWAVES)]; gbn = A.gate[2 * (row + NWAVES) + 1]; }
            YLOAD(ya, yb, pa, pb); }
    }
    for (; row < rend; row += NWAVES) {
        const bool lat = row < M; const int bidx = lat ? row / SEQ : NB;
        const int rnext = row + NWAVES;
        if (rnext < rend) ROWLOAD(vn, rnext);
        int pnn0 = 0, pnn1 = 0; float gnn0 = 0.f, gnn1 = 0.f;
        if (COMBINE) {
            if (rnext < rend) YLOAD(yan, ybn, pan, pbn);
            const int rnn = rnext + NWAVES;
            if (rnn < rend) { pnn0 = A.pos[2 * rnn]; pnn1 = A.pos[2 * rnn + 1]; gnn0 = A.gate[2 * rnn]; gnn1 = A.gate[2 * rnn + 1]; }
        }
        f32x4 gvv[4], shv4[4], scv4[4], g2v[4];
#pragma unroll
        for (int j = 0; j < 4; ++j) { const int col = 4 * F.lane + 256 * j; if (ROUTER) continue;
            gvv[j] = *(const f32x4*)(A.g + col);
            if (OUTMODE != 2) { shv4[j] = *(const f32x4*)(A.modl + bidx * NMOD + A.shoff + col); scv4[j] = *(const f32x4*)(A.modl + bidx * NMOD + A.scoff + col); }
            if (COMBINE) g2v[j] = *(const f32x4*)(A.modprev + bidx * NMOD + 5 * DM + col); }
        if (COMBINE) {
#pragma unroll
            for (int j = 0; j < 4; ++j) { const v2u wa = ya[j], wb = yb[j]; const f32x4 gv = g2v[j];
                v[j].x += gv.x * (ga * bflo(wa.x) + gb * bflo(wb.x)); v[j].y += gv.y * (ga * bfhi(wa.x) + gb * bfhi(wb.x));
                v[j].z += gv.z * (ga * bflo(wa.y) + gb * bflo(wb.y)); v[j].w += gv.w * (ga * bfhi(wa.y) + gb * bfhi(wb.y)); }
            if (OUTMODE != 2) {
#pragma unroll
                for (int j = 0; j < 4; ++j) { v2u o; o.x = pg8::cvt_pk_bf16(v[j].x, v[j].y); o.y = pg8::cvt_pk_bf16(v[j].z, v[j].w); *(v2u*)(A.hbo + (size_t)row * DM + 4 * F.lane + 256 * j) = o;
                    v[j] = (f32x4){bflo(o.x), bfhi(o.x), bflo(o.y), bfhi(o.y)}; }
            }
        }
        float s = 0.f;
#pragma unroll
        for (int j = 0; j < 4; ++j) s += (v[j].x * v[j].x + v[j].y * v[j].y) + (v[j].z * v[j].z + v[j].w * v[j].w);
        const float rstd = rsqrtf(wave_sum(s, F.lane) * (1.0f / DM) + EPS);
        if (OUTMODE == 2) {
            float* ho = A.fout + (size_t)row * DM;
#pragma unroll
            for (int j = 0; j < 4; ++j) { const int col = 4 * F.lane + 256 * j; *(f32x4*)(ho + col) = v[j] * rstd * gvv[j]; }
        } else {
            float lg[8];
            if (ROUTER) {
#pragma unroll
                for (int e = 0; e < 8; ++e) lg[e] = 0.f;
            }
#pragma unroll
            for (int j = 0; j < 4; ++j) { const int col = 4 * F.lane + 256 * j;
                if (ROUTER) { const LAS float* lv = LV + (bidx != lb0 ? 2048 : 0); gvv[j] = *(const LAS f32x4*)(LV + col); shv4[j] = *(const LAS f32x4*)(lv + 1024 + col); scv4[j] = *(const LAS f32x4*)(lv + 2048 + col); }
                f32x4 y = v[j] * rstd * gvv[j] * (scv4[j] + 1.0f) + shv4[j];
                if (!ROUTER && !F8OUT) { v2u o; o.x = pg8::cvt_pk_bf16(y.x, y.y); o.y = pg8::cvt_pk_bf16(y.z, y.w); *(v2u*)(A.U + (size_t)row * DM + col) = o; }
                else v[j] = y;
                if (ROUTER) {
#pragma unroll
                    for (int q = 0; q < 4; ++q) { const f32x4 r0 = rw[4 * j + q][0], r1 = rw[4 * j + q][1]; const float yy = y[q];
                        lg[0] += yy * r0.x; lg[1] += yy * r0.y; lg[2] += yy * r0.z; lg[3] += yy * r0.w; lg[4] += yy * r1.x; lg[5] += yy * r1.y; lg[6] += yy * r1.z; lg[7] += yy * r1.w; } }
            }
            if (ROUTER || F8OUT) {
                float am = 0.f, ss = 0.f;
#pragma unroll
                for (int j = 0; j < 4; ++j) { am = fmaxf(fmaxf(am, fmaxf(fabsf(v[j].x), fabsf(v[j].y))), fmaxf(fabsf(v[j].z), fabsf(v[j].w))); ss += (v[j].x * v[j].x + v[j].y * v[j].y) + (v[j].z * v[j].z + v[j].w * v[j].w); }
                am = fmaxf(wave_max(am, F.lane), 1e-30f); ss = wave_sum(ss, F.lane);
                const float inv = 256.0f / am;
                if (!ROUTER && A.hid_only) {
#pragma unroll
                    for (int j = 0; j < 4; ++j) { v2u o; o.x = pg8::cvt_pk_bf16(v[j].x, v[j].y); o.y = pg8::cvt_pk_bf16(v[j].z, v[j].w); *(v2u*)(A.U + (size_t)row * DM + 4 * F.lane + 256 * j) = o; }
                    if (F.lane == 0) { const float sh = fmaxf(0.0625f * ss * A.st[1] * A.st[3], 1e-30f); A.rs[row] = (f32x4){1.0f, 1.0f, 1.0f / sh, sh * A.st[4]}; }
                } else {
#pragma unroll
                for (int j = 0; j < 4; ++j) *(unsigned*)(A.U8 + (size_t)row * DM + 4 * F.lane + 256 * j) = pk4_fp8(v[j].x * inv, v[j].y * inv, v[j].z * inv, v[j].w * inv);
                }
                if (ROUTER) { if (F.lane == 0) { A.rsu[2 * row] = am * (1.0f / 256.0f); A.rsu[2 * row + 1] = ss; } }
                else if (!A.hid_only && F.lane == 0) { const float sa = am * (1.0f / 256.0f); const float sh = fmaxf(0.0625f * ss * A.st[1] * A.st[3], 1e-30f);
                    A.rs[row] = (f32x4){sa * A.st[0], sa * A.st[2], 1.0f / sh, sh * A.st[4]}; }
            }
            if (ROUTER) {
                const int b5 = F.lane >> 5, b4 = (F.lane >> 4) & 1, b3 = (F.lane >> 3) & 1; float a4[4], c2[2];
#pragma unroll
                for (int q = 0; q < 4; ++q) { const float mine = b5 ? lg[4 + q] : lg[q], oth = b5 ? lg[q] : lg[4 + q]; a4[q] = mine + shx(oth, F.lane, 32); }
#pragma unroll
                for (int q = 0; q < 2; ++q) { const float mine = b4 ? a4[2 + q] : a4[q], oth = b4 ? a4[q] : a4[2 + q]; c2[q] = mine + shx(oth, F.lane, 16); }
                float d1 = (b3 ? c2[1] : c2[0]) + shx(b3 ? c2[0] : c2[1], F.lane, 8);
                d1 += shx(d1, F.lane, 4); d1 += shx(d1, F.lane, 2); d1 += shx(d1, F.lane, 1);
#pragma unroll
                for (int e = 0; e < 8; ++e) lg[e] = __int_as_float(__builtin_amdgcn_readlane(__float_as_int(d1), 8 * e));
                int i0 = 0; float v0 = lg[0];
#pragma unroll
                for (int e = 1; e < 8; ++e) if (lg[e] > v0) { v0 = lg[e]; i0 = e; }
                int i1 = -1; float v1 = -INFINITY;
#pragma unroll
                for (int e = 0; e < 8; ++e) if (e != i0 && lg[e] > v1) { v1 = lg[e]; i1 = e; }
                const float g0 = 1.0f / (1.0f + __expf(v1 - v0));
                if (F.lane == 0) { A.eidx[2 * row] = i0; A.eidx[2 * row + 1] = i1; A.gout[2 * row] = g0; A.gout[2 * row + 1] = 1.0f - g0; atomicAdd((int*)&lcnt[i0], 1); atomicAdd((int*)&lcnt[i1], 1); }
            }
        }
#pragma unroll
        for (int j = 0; j < 4; ++j) v[j] = vn[j];
        if (COMBINE) {
#pragma unroll
            for (int j = 0; j < 4; ++j) { ya[j] = yan[j]; yb[j] = ybn[j]; }
            ga = gan; gb = gbn; pan = pnn0; pbn = pnn1; gan = gnn0; gbn = gnn1; }
    }
#undef ROWLOAD
#undef YLOAD
    if (ROUTER) { __syncthreads(); if (F.tid < 8) A.cnt[blockIdx.x * 8 + F.tid] = lcnt[F.tid]; __syncthreads(); }
}

using pg8::Unit; using pg8::cvt_pk_bf16;
__device__ __forceinline__ v4u pack8(const f32x4& a, const f32x4& b) { v4u w; w.x = cvt_pk_bf16(a[0], a[1]); w.y = cvt_pk_bf16(a[2], a[3]); w.z = cvt_pk_bf16(b[0], b[1]); w.w = cvt_pk_bf16(b[2], b[3]); return w; }
struct EpiIn {
    static constexpr bool PERM = true;
    bf16 *CQ, *KRR, *CKV, *H5; float* ssq_q; float* ssq_kv; const float* TC; const float* LBj; int jlayer;
    __device__ __forceinline__ void operator()(const f32x4 (&acc)[2][2][4][2], const Unit& u, int wr, int wc, int fr, int fq) const {
        const int row0 = u.pm * 256 + wr * 64 + fr; const int lane = fr + 16 * fq;
#pragma unroll
        for (int bj = 0; bj < 2; ++bj) {
            const int col = u.pn * 256 + bj * 128 + wc * 32 + 8 * fq;
            bf16* base; int ld;
            if (col < 384) { base = CQ + col; ld = QL; }
            else if (col < 512) { base = nullptr; ld = 0; }
            else if (col < 768) { base = CKV + (col - 512); ld = KVL; }
            else { const int c2 = col - 768; base = H5 + (size_t)(c2 >> 9) * HSEG + (c2 & 511); ld = HW; }
            const int hsel = (col >= 768) ? ((col - 768) >> 9) : 3;
            if (hsel <= 2) {
                f32x4 lb0 = (f32x4){0.f, 0.f, 0.f, 0.f}, lb1 = lb0; if (hsel >= 1 && jlayer == 1) { const float* l0_ = LBj + (hsel - 1) * HW + ((col - 768) & 511); const float* l1_ = l0_ + 2 * HW; const f32x4 a0 = *(const f32x4*)l0_, a1 = *(const f32x4*)(l0_ + 4), b0 = *(const f32x4*)l1_, b1 = *(const f32x4*)(l1_ + 4);
#pragma unroll
                    for (int q = 0; q < 4; ++q) { lb0[q] = 1.0f / (1.0f + __expf(a0[q] - b0[q])); lb1[q] = 1.0f / (1.0f + __expf(a1[q] - b1[q])); } }
#pragma unroll
                for (int ai = 0; ai < 2; ++ai)
#pragma unroll
                    for (int m = 0; m < 4; ++m) { const int row = row0 + ai * 128 + m * 16; f32x4 o[2];
#pragma unroll
                        for (int n = 0; n < 2; ++n)
#pragma unroll
                            for (int q = 0; q < 4; ++q) { const float x = acc[ai][bj][m][n][q]; const float sg = __builtin_amdgcn_rcpf(1.0f + __expf(-x)); const float lbv = n ? lb1[q] : lb0[q];
                                o[n][q] = (hsel == 0) ? x * sg : __logf(lbv + (1.0f - lbv) * sg); }
                        *(v4u*)(base + (size_t)row * ld) = pack8(o[0], o[1]); }
            } else if (base) {
#pragma unroll
                for (int ai = 0; ai < 2; ++ai)
#pragma unroll
                    for (int m = 0; m < 4; ++m) { const int row = row0 + ai * 128 + m * 16; *(v4u*)(base + (size_t)row * ld) = pack8(acc[ai][bj][m][0], acc[ai][bj][m][1]); }
            }
        }
        if (u.pn <= 2) {
            const int nb = (u.pn == 1) ? 1 : 2; float* dst = (u.pn == 2) ? ssq_kv : ssq_q;
#pragma unroll
            for (int ai = 0; ai < 2; ++ai)
#pragma unroll
                for (int m = 0; m < 4; ++m) { float ss = 0.f;
#pragma unroll
                    for (int bj = 0; bj < 2; ++bj) if (bj < nb) {
#pragma unroll
                        for (int n = 0; n < 2; ++n) { const f32x4 x = acc[ai][bj][m][n]; ss += (x[0] * x[0] + x[1] * x[1]) + (x[2] * x[2] + x[3] * x[3]); } }
                    ss += shx(ss, lane, 16); ss += shx(ss, lane, 32);
                    if (fq == 0) { const int row = row0 + ai * 128 + m * 16; if (u.pn == 2) dst[row * 4 + wc] = ss; else dst[row * 8 + u.pn * 4 + wc] = ss; } }
            if (u.pn == 1 && wc == 0) {
                const int a = fq >> 1, half = fq & 1;
#pragma unroll
                for (int ai = 0; ai < 2; ++ai)
#pragma unroll
                    for (int m = 0; m < 4; ++m) { const int row = row0 + ai * 128 + m * 16; f32x4 o[2];
                        const bool lat = row < M; const int t = row % SEQ; const int p = a ? (t & 63) : (t >> 6);
#pragma unroll
                        for (int n = 0; n < 2; ++n)
#pragma unroll
                            for (int q = 0; q < 4; ++q) { const float x = acc[ai][1][m][n][q]; const float pr = shx(x, lane, 16); const float c = TC[p * 8 + 4 * n + q], sn = TC[512 + p * 8 + 4 * n + q];
                                o[n][q] = lat ? (half ? x * c + pr * sn : x * c - pr * sn) : x; }
                        *(v4u*)(KRR + (size_t)row * ROPE + 8 * fq) = pack8(o[0], o[1]); }
            }
        }
    }
};
struct EpiQ {
    static constexpr bool PERM = true;
    bf16* O; const float* rs;
    __device__ __forceinline__ void operator()(const f32x4 (&acc)[2][2][4][2], const Unit& u, int wr, int wc, int fr, int fq) const {
        const int row0 = u.pm * 256 + wr * 64 + fr;
#pragma unroll
        for (int ai = 0; ai < 2; ++ai)
#pragma unroll
            for (int m = 0; m < 4; ++m) { const int row = row0 + ai * 128 + m * 16; const f32x4 p0 = *(const f32x4*)(rs + (size_t)row * 8), p1 = *(const f32x4*)(rs + (size_t)row * 8 + 4); const float sc = rsqrtf((((p0.x + p0.y) + (p0.z + p0.w)) + ((p1.x + p1.y) + (p1.z + p1.w))) * (1.0f / QL) + EPS);
#pragma unroll
                for (int bj = 0; bj < 2; ++bj) { const int col = u.pn * 256 + bj * 128 + wc * 32 + 8 * fq; *(v4u*)(O + (size_t)row * 768 + col) = pack8(acc[ai][bj][m][0] * sc, acc[ai][bj][m][1] * sc); } }
    }
};
struct EpiKV {
    static constexpr bool PERM = true;
    bf16* KNp; bf16* VTp; const float* rs;
    __device__ __forceinline__ void operator()(const f32x4 (&acc)[2][2][4][2], const Unit& u, int wr, int wc, int fr, int fq) const {
        const int row0 = u.pm * 256 + wr * 64 + fr;
#pragma unroll
        for (int ai = 0; ai < 2; ++ai)
#pragma unroll
            for (int m = 0; m < 4; ++m) { const int row = row0 + ai * 128 + m * 16; const f32x4 p0 = *(const f32x4*)(rs + (size_t)row * 4); const float sc = rsqrtf(((p0.x + p0.y) + (p0.z + p0.w)) * (1.0f / KVL) + EPS);
                const bool lat = row < M; const int b = lat ? row / SEQ : (row - M) / CTXL; const int key = lat ? row % SEQ : SEQ + (row - M) % CTXL;
                const int kpos = (key & ~12) | ((key & 4) << 1) | ((key & 8) >> 1);
#pragma unroll
                for (int bj = 0; bj < 2; ++bj) { const int col = u.pn * 256 + bj * 128 + wc * 32 + 8 * fq; const int hh = col >> 7, w = col & 127;
                    if (w < 64) { *(v4u*)(KNp + (size_t)row * HW + hh * 64 + w) = pack8(acc[ai][bj][m][0] * sc, acc[ai][bj][m][1] * sc); }
                    else { bf16* dst = VTp + ((size_t)((b * NH + hh) * VD + (w - 64))) * NKEY + kpos;
#pragma unroll
                        for (int n = 0; n < 2; ++n)
#pragma unroll
                            for (int q = 0; q < 4; ++q) dst[(size_t)(4 * n + q) * NKEY] = (bf16)f2bf(acc[ai][bj][m][n][q] * sc); } } }
    }
};
template <bool INF32, bool SC = false>
struct EpiResid {
    static constexpr bool PERM = true;
    const float* xin_l; const float* xin_c; bf16* hb; const float* modl; int goff; const f32x4* RS;
    __device__ __forceinline__ void operator()(const f32x4 (&acc)[2][2][4][2], const Unit& u, int wr, int wc, int fr, int fq) const {
        const int rowt = u.pm * 256; const bool lat = rowt < M; const int bidx = lat ? rowt / SEQ : NB;
        const float* gate = modl + bidx * NMOD + goff;
        const float* xi = lat ? xin_l + (size_t)rowt * DM : xin_c + (size_t)(rowt - M) * DM;
        bf16* ho = hb + (size_t)rowt * DM;
        float scv[2][4];
        if (SC) { const float* rp = (const float*)(RS + rowt + wr * 64 + fr) + 3;
#pragma unroll
            for (int ai = 0; ai < 2; ++ai)
#pragma unroll
                for (int m = 0; m < 4; ++m) scv[ai][m] = rp[(ai * 128 + m * 16) * 4]; }
        const unsigned off0 = (unsigned)((wr * 64 + fr) * DM + u.pn * 256 + wc * 32 + 8 * fq);
#pragma unroll
        for (int bj = 0; bj < 2; ++bj) { const f32x4 g0 = *(const f32x4*)(gate + (off0 & 1023u) + bj * 128), g1 = *(const f32x4*)(gate + (off0 & 1023u) + bj * 128 + 4);
#pragma unroll
            for (int ai = 0; ai < 2; ++ai) {
                if (INF32) { f32x4 h0[4], h1[4];
#pragma unroll
                    for (int m = 0; m < 4; ++m) { const unsigned off = off0 + (unsigned)((ai * 128 + m * 16) * DM + bj * 128); h0[m] = *(const f32x4*)(xi + off); h1[m] = *(const f32x4*)(xi + off + 4); }
#pragma unroll
                    for (int m = 0; m < 4; ++m) { const unsigned off = off0 + (unsigned)((ai * 128 + m * 16) * DM + bj * 128); *(v4u*)(ho + off) = pack8(h0[m] + g0 * acc[ai][bj][m][0], h1[m] + g1 * acc[ai][bj][m][1]); }
                } else { v4u hv[4];
#pragma unroll
                    for (int m = 0; m < 4; ++m) { const unsigned off = off0 + (unsigned)((ai * 128 + m * 16) * DM + bj * 128); hv[m] = *(const v4u*)(ho + off); }
#pragma unroll
                    for (int m = 0; m < 4; ++m) { const unsigned off = off0 + (unsigned)((ai * 128 + m * 16) * DM + bj * 128); const v4u w = hv[m];
                        const f32x4 a0 = (f32x4){bflo(w.x), bfhi(w.x), bflo(w.y), bfhi(w.y)}, a1 = (f32x4){bflo(w.z), bfhi(w.z), bflo(w.w), bfhi(w.w)};
                        if (SC) *(v4u*)(ho + off) = pack8(a0 + (g0 * scv[ai][m]) * acc[ai][bj][m][0], a1 + (g1 * scv[ai][m]) * acc[ai][bj][m][1]);
                        else *(v4u*)(ho + off) = pack8(a0 + g0 * acc[ai][bj][m][0], a1 + g1 * acc[ai][bj][m][1]); }
                }
                asm volatile("" ::: "memory"); } }
    }
};
struct EpiPool {
    static constexpr bool PERM = true;
    bf16* hb; const float* modl; const float* bias; const float* scale; int talloc;
    __device__ __forceinline__ void operator()(const f32x4 (&acc)[2][2][4][2], const Unit& u, int wr, int wc, int fr, int fq) const {
        const int g = u.pn, rowt = (u.pm - g * talloc) * 256; const bool lat = rowt < M; const int bidx = lat ? rowt / SEQ : NB;
        const float* gate = modl + bidx * NMOD + 2 * DM;
        bf16* ho = hb + (size_t)rowt * DM;
        const int col0 = g * 256 + wc * 32 + 8 * fq;
#pragma unroll
        for (int bj = 0; bj < 2; ++bj) { const int c = col0 + bj * 128;
            v4u hv[2][4];
#pragma unroll
            for (int ai = 0; ai < 2; ++ai)
#pragma unroll
                for (int m = 0; m < 4; ++m) hv[ai][m] = *(const v4u*)(ho + (size_t)(ai * 128 + wr * 64 + m * 16 + fr) * DM + c);
            const f32x4 gm0 = *(const f32x4*)(gate + c) * *(const f32x4*)(scale + c), gm1 = *(const f32x4*)(gate + c + 4) * *(const f32x4*)(scale + c + 4);
            const f32x4 gb0 = gm0 * *(const f32x4*)(bias + c), gb1 = gm1 * *(const f32x4*)(bias + c + 4);
#pragma unroll
            for (int ai = 0; ai < 2; ++ai)
#pragma unroll
                for (int m = 0; m < 4; ++m) { const v4u w = hv[ai][m]; const f32x4 a0 = (f32x4){bflo(w.x), bfhi(w.x), bflo(w.y), bfhi(w.y)}, a1 = (f32x4){bflo(w.z), bfhi(w.z), bflo(w.w), bfhi(w.w)};
                    *(v4u*)(ho + (size_t)(ai * 128 + wr * 64 + m * 16 + fr) * DM + c) = pack8(a0 + gm0 * acc[ai][bj][m][0] + gb0, a1 + gm1 * acc[ai][bj][m][1] + gb1); }
            asm volatile("" ::: "memory"); }
    }
};
struct EpiGateUp {
    static constexpr bool PERM = true;
    bf16* H; int ldh, nct, rowsub;
    __device__ __forceinline__ void operator()(const f32x4 (&acc)[2][2][4][2], const Unit& u, int wr, int wc, int fr, int fq) const {
        const int row0 = u.pm * 256 + wr * 64 + fr - rowsub; const int ct = u.pn % nct; const int col = ct * 128 + wc * 32 + 8 * fq;
#pragma unroll
        for (int ai = 0; ai < 2; ++ai)
#pragma unroll
            for (int m = 0; m < 4; ++m) { const int row = row0 + ai * 128 + m * 16; f32x4 o[2];
#pragma unroll
                for (int n = 0; n < 2; ++n)
#pragma unroll
                    for (int q = 0; q < 4; q += 2) { const f32x2 ag = {acc[ai][0][m][n][q], acc[ai][0][m][n][q + 1]}, au = {acc[ai][1][m][n][q], acc[ai][1][m][n][q + 1]};
                        const f32x2 t = ag * -1.4426950408889634f; const f32x2 d = (f32x2){__builtin_amdgcn_exp2f(t.x), __builtin_amdgcn_exp2f(t.y)} + 1.0f;
                        const f32x2 p = (ag * au) * (f32x2){__builtin_amdgcn_rcpf(d.x), __builtin_amdgcn_rcpf(d.y)};
                        o[n][q] = p.x; o[n][q + 1] = p.y; }
                *(v4u*)(H + (size_t)row * ldh + col) = pack8(o[0], o[1]); }
    }
};
struct EpiGateUp8 {
    static constexpr bool PERM = true;
    unsigned char* H; int ldh, nct, rowsub; const f32x4* RS;
    __device__ __forceinline__ void operator()(const f32x4 (&acc)[2][2][4][2], const Unit& u, int wr, int wc, int fr, int fq) const {
        const int pos0 = u.pm * 256 + wr * 64 + fr; const int ct = u.pn % nct; const int col = ct * 128 + wc * 32 + 8 * fq;
        const f32x4* rp = RS + pos0; f32x4 rsv[2][4];
#pragma unroll
        for (int ai = 0; ai < 2; ++ai)
#pragma unroll
            for (int m = 0; m < 4; ++m) rsv[ai][m] = rp[ai * 128 + m * 16];
#pragma unroll
        for (int ai = 0; ai < 2; ++ai)
#pragma unroll
            for (int m = 0; m < 4; ++m) { const int pos = pos0 + ai * 128 + m * 16; const f32x4 rs = rsv[ai][m]; f32x4 o[2];
                const float c1 = -1.4426950408889634f * rs.x, c2 = rs.x * rs.y * rs.z;
#pragma unroll
                for (int n = 0; n < 2; ++n)
#pragma unroll
                    for (int q = 0; q < 4; q += 2) { const f32x2 ag = {acc[ai][0][m][n][q], acc[ai][0][m][n][q + 1]}, au = {acc[ai][1][m][n][q], acc[ai][1][m][n][q + 1]};
                        const f32x2 t = ag * c1; const f32x2 d = (f32x2){__builtin_amdgcn_exp2f(t.x), __builtin_amdgcn_exp2f(t.y)} + 1.0f;
                        const f32x2 p = ((ag * au) * c2) * (f32x2){__builtin_amdgcn_rcpf(d.x), __builtin_amdgcn_rcpf(d.y)};
                        o[n][q] = clamp448(p.x); o[n][q + 1] = clamp448(p.y); }
                v2u w; w.x = pk4_fp8(o[0][0], o[0][1], o[0][2], o[0][3]); w.y = pk4_fp8(o[1][0], o[1][1], o[1][2], o[1][3]);
                *(v2u*)(H + (size_t)(pos - rowsub) * ldh + col) = w; }
    }
};
struct EpiY8 {
    static constexpr bool PERM = true;
    bf16* Y; int nct; const f32x4* RS;
    __device__ __forceinline__ void operator()(const f32x4 (&acc)[2][2][4][2], const Unit& u, int wr, int wc, int fr, int fq) const {
        const int row0 = u.pm * 256 + wr * 64 + fr; const int ct = u.pn % nct;
        const float* rp = (const float*)(RS + row0) + 3; float scv[2][4];
#pragma unroll
        for (int ai = 0; ai < 2; ++ai)
#pragma unroll
            for (int m = 0; m < 4; ++m) scv[ai][m] = rp[(ai * 128 + m * 16) * 4];
#pragma unroll
        for (int ai = 0; ai < 2; ++ai)
#pragma unroll
            for (int m = 0; m < 4; ++m) { const int row = row0 + ai * 128 + m * 16; const float sc = scv[ai][m];
#pragma unroll
                for (int bj = 0; bj < 2; ++bj) { const int col = ct * 256 + bj * 128 + wc * 32 + 8 * fq; *(v4u*)(Y + (size_t)row * DM + col) = pack8(acc[ai][bj][m][0] * sc, acc[ai][bj][m][1] * sc); } }
    }
};
struct EpiY {
    static constexpr bool PERM = true;
    bf16* Y; int nct;
    __device__ __forceinline__ void operator()(const f32x4 (&acc)[2][2][4][2], const Unit& u, int wr, int wc, int fr, int fq) const {
        const int row0 = u.pm * 256 + wr * 64 + fr; const int ct = u.pn % nct;
#pragma unroll
        for (int ai = 0; ai < 2; ++ai)
#pragma unroll
            for (int m = 0; m < 4; ++m) { const int row = row0 + ai * 128 + m * 16;
#pragma unroll
                for (int bj = 0; bj < 2; ++bj) { const int col = ct * 256 + bj * 128 + wc * 32 + 8 * fq; *(v4u*)(Y + (size_t)row * DM + col) = pack8(acc[ai][bj][m][0], acc[ai][bj][m][1]); } }
    }
};

__device__ __forceinline__ void p0_prologue(Frame& F) {
    fresh(F);
    unsigned char* ws = F.ws;
    const float qscale = 0.10206207261596577f * 1.4426950408889634f;
    for (int j = 0; j < 2; ++j) {
        conv_matrix(F, F.in[8] + (size_t)j * DM * INW, DM, INW, (bf16*)(ws + WS_WIN) + (size_t)j * INP * DM, DM, 1, 0, nullptr, 1.f);
        conv_matrix(F, F.in[11] + (size_t)j * QL * 768, QL, 768, (bf16*)(ws + WS_WUQ) + (size_t)j * 768 * QL, QL, 0, 0, F.in[9] + j * QL, qscale);
        conv_matrix(F, F.in[12] + (size_t)j * KVL * 1024, KVL, 1024, (bf16*)(ws + WS_WUKV) + (size_t)j * 1024 * KVL, KVL, 0, 0, F.in[10] + j * KVL, 1.f);
        conv_matrix(F, F.in[15] + (size_t)j * DM * DM, DM, DM, (bf16*)(ws + WS_WOUT) + (size_t)j * DM * DM, DM, 0, 0, nullptr, 1.f);
        if (j == 0) {
            conv_matrix(F, F.in[16] + (size_t)j * DM * DFF, DM, DFF, (bf16*)(ws + WS_WGU) + (size_t)j * 2 * DFF * DM, DM, 2, 0, nullptr, 1.f);
            conv_matrix(F, F.in[17] + (size_t)j * DM * DFF, DM, DFF, (bf16*)(ws + WS_WGU) + (size_t)j * 2 * DFF * DM, DM, 2, 128, nullptr, 1.f);
        }
        for (int g = 0; g < 4; ++g)
            conv_matrix(F, F.in[19] + (size_t)(j * 4 + g) * 65536, 256, 256, (bf16*)(ws + WS_WPOOL) + (size_t)(j * 4 + g) * 65536, 256, 0, 0, nullptr, 1.f);
    }
    __syncthreads();
    if (blockIdx.x == 0 && F.tid < 8) {
        float* TC = (float*)(ws + WS_ROPE); float* TS = TC + 512;
        double th = 1.0; for (int i = 0; i < F.tid; ++i) th *= 0.31622776601683794;
        const double x2 = th * th; double s = th, c = 1.0, ts = th, tc = 1.0;
        for (int n = 1; n <= 12; ++n) { tc *= -x2 / (double)((2 * n - 1) * (2 * n)); c += tc; ts *= -x2 / (double)((2 * n) * (2 * n + 1)); s += ts; }
        double cp = 1.0, sp = 0.0;
        for (int p = 0; p < 64; ++p) { TC[p * 8 + F.tid] = (float)cp; TS[p * 8 + F.tid] = (float)sp; const double ncp = cp * c - sp * s; sp = sp * c + cp * s; cp = ncp; }
    }
    {
        LAS float* sc = (LAS float*)(F.lds + RING_OFF);
        LAS float* red = sc + 17 * 1024;
        const int nitems = 4 * (NMOD / 64);
        if ((int)blockIdx.x < nitems) {
            for (int e = F.tid; e < 17 * 1024; e += 512) { const int r = e >> 10, k = e & 1023; const float x = (r < 16) ? F.in[1][r * 1024 + k] : F.in[3][k]; sc[e] = siluf_(x); }
            __syncthreads();
            for (int it = blockIdx.x; it < nitems; it += F.G) {
                const int l = it / (NMOD / 64), c0 = (it % (NMOD / 64)) * 64;
                const float* W = F.in[4] + (size_t)l * DM * NMOD + c0 + F.lane;
                float acc[17];
#pragma unroll
                for (int r = 0; r < 17; ++r) acc[r] = 0.f;
                const int kb = F.wave * 128;
                for (int k = 0; k < 128; k += 4) {
                    const float w0 = W[(size_t)(kb + k) * NMOD], w1 = W[(size_t)(kb + k + 1) * NMOD], w2 = W[(size_t)(kb + k + 2) * NMOD], w3 = W[(size_t)(kb + k + 3) * NMOD];
#pragma unroll
                    for (int r = 0; r < 17; ++r) { const f32x4 s4 = *(const LAS f32x4*)(sc + r * 1024 + kb + k); acc[r] += s4.x * w0 + s4.y * w1 + s4.z * w2 + s4.w * w3; }
                }
#pragma unroll
                for (int r = 0; r < 17; ++r) red[(F.wave * 17 + r) * 64 + F.lane] = acc[r];
                __syncthreads();
                for (int o = F.tid; o < 17 * 64; o += 512) { const int r = o >> 6, cc = o & 63; float s = 0.f;
#pragma unroll
                    for (int w = 0; w < 8; ++w) s += red[(w * 17 + r) * 64 + cc];
                    ((float*)(ws + WS_MODV))[(size_t)(l * 17 + r) * NMOD + c0 + cc] = s + F.in[5][l * NMOD + c0 + cc]; }
                __syncthreads();
            }
        }
    }
    if ((int)blockIdx.x < 54) {
        const int mi = blockIdx.x, jj = mi / 24, r = mi % 24, e = r / 3, wh = r % 3;
        const bool dense = mi >= 48; const int dj = (mi - 48) / 3, dw = (mi - 48) % 3;
        const float* W = dense ? F.in[16 + dw] + (size_t)dj * DM * DFF : F.in[23 + wh] + ((size_t)jj * NE + e) * DM * DFE;
        const int sstep = dense ? 175 : 223;
        LAS float* red = (LAS float*)(F.lds + RING_OFF);
        __syncthreads();
        float am = 0.f, ss = 0.f;
#pragma unroll 8
        for (int i = 0; i < 32; ++i) { const float w = W[(size_t)(F.tid + 512 * i) * sstep]; am = fmaxf(am, fabsf(w)); ss += w * w; }
        am = wave_max(am, F.lane); ss = wave_sum(ss, F.lane);
        if (F.lane == 0) { red[F.wave] = am; red[8 + F.wave] = ss; }
        __syncthreads();
        if (F.tid == 0) { float a = 0.f, q = 0.f;
            for (int w = 0; w < 8; ++w) { a = fmaxf(a, red[w]); q += red[8 + w]; }
            float* ST = (float*)(ws + WS_WSTAT) + mi * 2; ST[0] = fmaxf(a, 1e-30f) * (1.0f / 64.0f); ST[1] = sqrtf(q * (1.0f / 16384.0f)); }
        __syncthreads();
    }
}

typedef short bf16x8v __attribute__((ext_vector_type(8)));
typedef float f32x16 __attribute__((ext_vector_type(16)));
__device__ __forceinline__ void attn_unit(Frame& F, int b, int h, int qrow0, bool rope_q, int t_lo, int t_hi) {
    unsigned char* ws = F.ws;
    const bf16* QB = (const bf16*)(ws + WS_QB); const bf16* KN = (const bf16*)(ws + WS_KN); const bf16* KRR = (const bf16*)(ws + WS_KRR); const bf16* VT = (const bf16*)(ws + WS_VV);
    bf16* MIX = (bf16*)(ws + WS_MIX); const float* TC = (const float*)(ws + WS_ROPE); const float* TS = TC + 512;
    const int lane = F.lane, wave = F.wave, r32 = lane & 31, hi = lane >> 5;
    LAS unsigned char* ring = F.lds + RING_OFF;
    const int qrow = qrow0 + wave * 32 + r32;
    bf16x8v qr[6];
#pragma unroll
    for (int d0 = 0; d0 < 6; ++d0) qr[d0] = *(const bf16x8v*)(QB + (size_t)qrow * 768 + h * QKD + 16 * d0 + 8 * hi);
    if (rope_q) { const int t = qrow % SEQ;
#pragma unroll
        for (int a = 0; a < 2; ++a) { const int p = a ? (t & 63) : (t >> 6); const v4u w = __builtin_bit_cast(v4u, qr[4 + a]); float x[8], y[8];
            x[0] = bflo(w.x); x[1] = bfhi(w.x); x[2] = bflo(w.y); x[3] = bfhi(w.y); x[4] = bflo(w.z); x[5] = bfhi(w.z); x[6] = bflo(w.w); x[7] = bfhi(w.w);
#pragma unroll
            for (int jj = 0; jj < 8; ++jj) { const float pr = shx(x[jj], lane, 32); const float c = TC[p * 8 + jj], sn = TS[p * 8 + jj]; y[jj] = hi ? x[jj] * c + pr * sn : x[jj] * c - pr * sn; }
            v4u o; o.x = pk2(y[0], y[1]); o.y = pk2(y[2], y[3]); o.z = pk2(y[4], y[5]); o.w = pk2(y[6], y[7]); qr[4 + a] = __builtin_bit_cast(bf16x8v, o); } }
    const int bh = b * NH + h;
    const bf16* vsrc = VT + ((size_t)(bh * VD + lane)) * NKEY + 8 * wave;
#define ATT_DMA(t, buf) do { const int t_ = (t); const int r0_ = t_ < SEQ / 64 ? b * SEQ + 64 * t_ : M + b * CTXL + 64 * (t_ - SEQ / 64); \
        LAS unsigned char* kb_ = ring + (buf) * 20480; LAS unsigned char* vb_ = kb_ + 12288; \
        __builtin_amdgcn_global_load_lds((const unsigned*)(KN + (size_t)(r0_ + lane) * HW + h * 64 + 8 * wave), (LAS unsigned*)(kb_ + wave * 1024), 16, 0, 0); \
        __builtin_amdgcn_global_load_lds((const unsigned*)(KRR + (size_t)(r0_ + lane) * ROPE + 8 * (wave & 3)), (LAS unsigned*)(kb_ + (8 + (wave & 3)) * 1024), 16, 0, 0);     \
        __builtin_amdgcn_global_load_lds((const unsigned*)(vsrc + 64 * t_), (LAS unsigned*)(vb_ + wave * 1024), 16, 0, 0); } while (0)
    f32x16 o0, o1;
#pragma unroll
    for (int r = 0; r < 16; ++r) { o0[r] = 0.f; o1[r] = 0.f; }
    constexpr float ATT_THR = 8.0f;
    float m_run = 0.f, l_run = 0.f;
    asm volatile("s_waitcnt vmcnt(0)" ::: "memory");
    ATT_DMA(t_lo, 0); if (t_lo + 1 < t_hi) ATT_DMA(t_lo + 1, 1); if (t_lo + 2 < t_hi) ATT_DMA(t_lo + 2, 2);
    for (int t = t_lo; t < t_hi; ++t) {
        const int buf = (t - t_lo) & 3; const int rem = t_hi - 1 - t;
        if (rem >= 2) asm volatile("s_waitcnt vmcnt(6)" ::: "memory"); else if (rem == 1) asm volatile("s_waitcnt vmcnt(3)" ::: "memory"); else asm volatile("s_waitcnt vmcnt(0)" ::: "memory");
        asm volatile("s_waitcnt lgkmcnt(0)" ::: "memory"); __builtin_amdgcn_s_barrier(); asm volatile("" ::: "memory");
        if (t + 3 < t_hi) ATT_DMA(t + 3, (buf + 3) & 3);
        const LAS unsigned char* kb = ring + buf * 20480 + hi * 1024 + r32 * 16; const LAS unsigned char* vb = ring + buf * 20480 + 12288 + hi * 1024 + r32 * 16;
        bf16x8v kf[12], vf[8];
#pragma unroll
        for (int d0 = 0; d0 < 6; ++d0) { kf[2 * d0] = *(const LAS bf16x8v*)(kb + d0 * 2048); kf[2 * d0 + 1] = *(const LAS bf16x8v*)(kb + d0 * 2048 + 512); }
#pragma unroll
        for (int s4 = 0; s4 < 4; ++s4) { vf[2 * s4] = *(const LAS bf16x8v*)(vb + s4 * 2048); vf[2 * s4 + 1] = *(const LAS bf16x8v*)(vb + s4 * 2048 + 512); }
        f32x16 p0, p1; const float negm = -m_run;
#pragma unroll
        for (int r = 0; r < 16; ++r) { p0[r] = negm; p1[r] = negm; }
#pragma unroll
        for (int d0 = 0; d0 < 6; ++d0) { p0 = __builtin_amdgcn_mfma_f32_32x32x16_bf16(kf[2 * d0], qr[d0], p0, 0, 0, 0); p1 = __builtin_amdgcn_mfma_f32_32x32x16_bf16(kf[2 * d0 + 1], qr[d0], p1, 0, 0, 0); }
        float ma = __builtin_fmaxf(__builtin_fmaxf(p0[0], p0[1]), p1[0]), mb = __builtin_fmaxf(__builtin_fmaxf(p0[2], p0[3]), p1[1]); ma = __builtin_fmaxf(__builtin_fmaxf(ma, p1[2]), p1[3]);
#pragma unroll
        for (int r = 4; r < 16; r += 4) { ma = __builtin_fmaxf(__builtin_fmaxf(ma, p0[r]), p0[r + 1]); mb = __builtin_fmaxf(__builtin_fmaxf(mb, p0[r + 2]), p0[r + 3]); ma = __builtin_fmaxf(__builtin_fmaxf(ma, p1[r]), p1[r + 1]); mb = __builtin_fmaxf(__builtin_fmaxf(mb, p1[r + 2]), p1[r + 3]); }
        float mt = __builtin_fmaxf(ma, mb);
        { auto rr = __builtin_amdgcn_permlane32_swap(__float_as_uint(mt), __float_as_uint(mt), false, false); mt = __builtin_fmaxf(__uint_as_float(rr[0]), __uint_as_float(rr[1])); }
        const bool first = (t == t_lo);
        if (first || __any(mt > ATT_THR)) {
            const float dl = first ? mt : __builtin_fmaxf(mt, 0.f); m_run += dl; const float alpha = __builtin_amdgcn_exp2f(-dl); l_run *= alpha;
#pragma unroll
            for (int r = 0; r < 16; ++r) { p0[r] -= dl; p1[r] -= dl; o0[r] *= alpha; o1[r] *= alpha; }
        }
        float ps0 = 0.f, ps1 = 0.f;
#pragma unroll
        for (int r = 0; r < 16; ++r) { p0[r] = __builtin_amdgcn_exp2f(p0[r]); p1[r] = __builtin_amdgcn_exp2f(p1[r]); ps0 += p0[r]; ps1 += p1[r]; }
        l_run += ps0 + ps1;
        v4u pw[4];
#pragma unroll
        for (int q = 0; q < 4; ++q) { pw[0][q] = cvt_pk_bf16(p0[2 * q], p0[2 * q + 1]); pw[1][q] = cvt_pk_bf16(p0[8 + 2 * q], p0[8 + 2 * q + 1]); pw[2][q] = cvt_pk_bf16(p1[2 * q], p1[2 * q + 1]); pw[3][q] = cvt_pk_bf16(p1[8 + 2 * q], p1[8 + 2 * q + 1]); }
#pragma unroll
        for (int s4 = 0; s4 < 4; ++s4) { const bf16x8v pa = __builtin_bit_cast(bf16x8v, pw[s4]);
            o0 = __builtin_amdgcn_mfma_f32_32x32x16_bf16(vf[2 * s4], pa, o0, 0, 0, 0); o1 = __builtin_amdgcn_mfma_f32_32x32x16_bf16(vf[2 * s4 + 1], pa, o1, 0, 0, 0); }
    }
    { auto rr = __builtin_amdgcn_permlane32_swap(__float_as_uint(l_run), __float_as_uint(l_run), false, false); l_run = __uint_as_float(rr[0]) + __uint_as_float(rr[1]); }
    const float rl = 1.0f / l_run;
    bf16* orow = MIX + (size_t)qrow * DM + h * VD;
#pragma unroll
    for (int g = 0; g < 4; ++g) { v2u a, c2; a.x = pk2(o0[4 * g] * rl, o0[4 * g + 1] * rl); a.y = pk2(o0[4 * g + 2] * rl, o0[4 * g + 3] * rl); c2.x = pk2(o1[4 * g] * rl, o1[4 * g + 1] * rl); c2.y = pk2(o1[4 * g + 2] * rl, o1[4 * g + 3] * rl);
        *(v2u*)(orow + 8 * g + 4 * hi) = a; *(v2u*)(orow + 32 + 8 * g + 4 * hi) = c2; }
    asm volatile("s_waitcnt vmcnt(0) lgkmcnt(0)" ::: "memory"); __builtin_amdgcn_s_barrier(); asm volatile("" ::: "memory");
#undef ATT_DMA
}
__device__ __forceinline__ void hgrn_item(Frame& F, int j, int it);
__device__ __forceinline__ void mix_phase(Frame& F, int j, bool ctx_out) {
    fresh(F);
    const int npair = F.G >> 1;
    for (int P = F.vcu >> 1; P < NB * NH; P += npair) {
        const int b = P >> 3, h = P & 7;
        if ((F.vcu & 1) == 0) {
            hgrn_item(F, j, P);
            for (int qb = 6; qb < 8; ++qb) attn_unit(F, b, h, b * SEQ + qb * 256, true, 0, NKEY / 64);
            if (ctx_out) attn_unit(F, b, h, M + b * CTXL, false, SEQ / 64, NKEY / 64);
            if (npair >= NB * NH) { fresh(F); conv_items(F, F.in, j, (P * NWAVES + F.wave) * CONV_MIX, 1, CONV_MIX); }
        } else {
            for (int qb = 0; qb < 6; ++qb) attn_unit(F, b, h, b * SEQ + qb * 256, true, 0, NKEY / 64);
        }
    }
    __syncthreads();
}

__device__ __forceinline__ int hgrn_row(int b, int dir, int ig) { return (ig < CTXL) ? (M + b * CTXL + (dir ? CTXL - 1 - ig : ig)) : (b * SEQ + (dir ? SEQ - 1 - (ig - CTXL) : (ig - CTXL))); }
__device__ __forceinline__ void hgrn_item(Frame& F, int j, int it) {
    unsigned char* ws = F.ws;
    const bf16* HQ = (const bf16*)(ws + WS_HQ); const bf16* HFF = HQ + HSEG; const bf16* HFB = HQ + 2 * HSEG; const bf16* HI = HQ + 3 * HSEG;
    LAS unsigned char* ring = F.lds + RING_OFF;
    LAS unsigned char* QN = ring; LAS unsigned char* KN = ring + 17408; LAS unsigned char* KT = ring + 34816; LAS unsigned char* VT = ring + 53248; LAS unsigned char* ST = ring + 71680;
    LAS float* TOT = (LAS float*)(ring + 106496); LAS unsigned char* RQ = ring + 108544; LAS unsigned char* RF = ring + 124928; LAS float* EW = (LAS float*)(ring + 141312);
    const int lane0 = F.lane, wave = F.wave;
    const int part = wave >> 1;
    const int kb = wave >> 1, vb0 = 2 * (wave & 1);
    const int ib = wave >> 2, vbo = wave & 3;
    const int dir = it & 1, hh = (it >> 1) & 3, b = it >> 3;
    const bf16* HF = dir ? HFB : HFF; float* OO = (float*)(ws + (dir ? WS_OB : WS_OF));
    f32x16 S0, S1;
#pragma unroll
    for (int r = 0; r < 16; ++r) { S0[r] = 0.f; S1[r] = 0.f; }
#define LBAR() do { asm volatile("s_waitcnt lgkmcnt(0)" ::: "memory"); __builtin_amdgcn_s_barrier(); asm volatile("" ::: "memory"); } while (0)
#define HG_BASE(c_) ((c_) < CTXL / 64 ? M + b * CTXL + (dir ? CTXL - 64 - 64 * (c_) : 64 * (c_)) : b * SEQ + (dir ? SEQ - 64 - 64 * ((c_) - CTXL / 64) : 64 * ((c_) - CTXL / 64)))
#define HG_DMA(c_) do { const int rb_ = HG_BASE(c_); \
        _Pragma("unroll") for (int p_ = 0; p_ < 2; ++p_) { const int pc_ = wave * 2 + p_; const size_t go_ = (size_t)(rb_ + 4 * pc_ + (lane >> 4)) * HW + hh * HK + 8 * (lane & 15); \
            __builtin_amdgcn_global_load_lds((const unsigned*)(HQ + go_), (LAS unsigned*)(RQ + pc_ * 1024), 16, 0, 0); __builtin_amdgcn_global_load_lds((const unsigned*)(HF + go_), (LAS unsigned*)(RF + pc_ * 1024), 16, 0, 0); } } while (0)
#define HG_VLD(c_) do { const size_t go_ = (size_t)(HG_BASE(c_) + (dir ? 63 - lane : lane)) * HW + hh * HK + 16 * wave; rv0 = *(const v4u*)(HI + go_); rv1 = *(const v4u*)(HI + go_ + 8); } while (0)
    v4u rv0, rv1;
    { const int lane = lane0; HG_DMA(0); HG_VLD(0); }
    asm volatile("s_waitcnt vmcnt(0)" ::: "memory"); LBAR();
    for (int ch = 0; ch < NKEY / 64; ++ch) {
        int lane_ = lane0; asm volatile("" : "+v"(lane_));
        const int lane = lane_, r32 = lane & 31, hi = lane >> 5, k = (wave & 1) * 64 + lane;
        const int pos = (lane & ~12) | ((lane & 4) << 1) | ((lane & 8) >> 1);
        float qv[16], kin[16], pf[16]; float run = 0.f, prod = 1.f;
#pragma unroll
        for (int ii = 0; ii < 16; ++ii) { const int i = 16 * part + ii, mr = dir ? 63 - i : i; qv[ii] = bf2f(*(const LAS bf16*)(RQ + mr * 256 + k * 2)); const float a = bf2f(*(const LAS bf16*)(RF + mr * 256 + k * 2));
            const float f = __expf(a); kin[ii] = 1.0f - f; prod *= f; pf[ii] = prod; run += a; }
        TOT[part * 128 + k] = run;
        { LAS bf16* vt = (LAS bf16*)(VT + (16 * wave) * 144 + pos * 2);
          vt[0 * 72] = (bf16)(rv0.x & 0xffffu); vt[1 * 72] = (bf16)(rv0.x >> 16); vt[2 * 72] = (bf16)(rv0.y & 0xffffu); vt[3 * 72] = (bf16)(rv0.y >> 16);
          vt[4 * 72] = (bf16)(rv0.z & 0xffffu); vt[5 * 72] = (bf16)(rv0.z >> 16); vt[6 * 72] = (bf16)(rv0.w & 0xffffu); vt[7 * 72] = (bf16)(rv0.w >> 16);
          vt[8 * 72] = (bf16)(rv1.x & 0xffffu); vt[9 * 72] = (bf16)(rv1.x >> 16); vt[10 * 72] = (bf16)(rv1.y & 0xffffu); vt[11 * 72] = (bf16)(rv1.y >> 16);
          vt[12 * 72] = (bf16)(rv1.z & 0xffffu); vt[13 * 72] = (bf16)(rv1.z >> 16); vt[14 * 72] = (bf16)(rv1.w & 0xffffu); vt[15 * 72] = (bf16)(rv1.w >> 16); }
        LBAR();
        if (ch + 1 < NKEY / 64) { HG_DMA(ch + 1); HG_VLD(ch + 1); }
        { const float t0 = TOT[k], t1 = TOT[128 + k], t2 = TOT[256 + k];
          const float base = (part > 0 ? t0 : 0.f) + (part > 1 ? t1 : 0.f) + (part > 2 ? t2 : 0.f); const float rr = t0 + t1;
          unsigned kt[8];
          const float E0 = __expf(fminf(base - rr, 80.f));
#pragma unroll
          for (int ii = 0; ii < 16; ii += 2) { const float e0 = E0 * pf[ii], e1 = E0 * pf[ii + 1]; const float q0 = qv[ii] * e0, q1 = qv[ii + 1] * e1, k0 = kin[ii] * __builtin_amdgcn_rcpf(e0), k1 = kin[ii + 1] * __builtin_amdgcn_rcpf(e1);
              const unsigned qp = cvt_pk_bf16(q0, q1), kp = cvt_pk_bf16(k0, k1);
              *(LAS bf16*)(QN + (16 * part + ii) * 272 + k * 2) = (bf16)(qp & 0xffffu); *(LAS bf16*)(QN + (16 * part + ii + 1) * 272 + k * 2) = (bf16)(qp >> 16);
              *(LAS bf16*)(KN + (16 * part + ii) * 272 + k * 2) = (bf16)(kp & 0xffffu); *(LAS bf16*)(KN + (16 * part + ii + 1) * 272 + k * 2) = (bf16)(kp >> 16);
              kt[ii >> 1] = kp; }
          *(LAS v4u*)(KT + k * 144 + part * 32) = (v4u){kt[0], kt[1], kt[4], kt[5]}; *(LAS v4u*)(KT + k * 144 + part * 32 + 16) = (v4u){kt[2], kt[3], kt[6], kt[7]}; }
        { const int kx = kb * 32 + r32; const float v_ = hi ? (TOT[256 + kx] + TOT[384 + kx]) : (TOT[kx] + TOT[128 + kx]); EW[wave * 64 + lane] = __expf(v_); asm volatile("s_waitcnt lgkmcnt(0)" ::: "memory"); }
        f32x16 T0, T1;
#pragma unroll
        for (int g4 = 0; g4 < 4; ++g4) { const int kk = kb * 32 + 8 * g4 + 4 * hi; const f32x4 er = *(const LAS f32x4*)(EW + wave * 64 + 8 * g4 + 4 * hi);
            T0[4 * g4] = S0[4 * g4] * er.x; T0[4 * g4 + 1] = S0[4 * g4 + 1] * er.y; T0[4 * g4 + 2] = S0[4 * g4 + 2] * er.z; T0[4 * g4 + 3] = S0[4 * g4 + 3] * er.w;
            T1[4 * g4] = S1[4 * g4] * er.x; T1[4 * g4 + 1] = S1[4 * g4 + 1] * er.y; T1[4 * g4 + 2] = S1[4 * g4 + 2] * er.z; T1[4 * g4 + 3] = S1[4 * g4 + 3] * er.w;
            v2u o; o.x = cvt_pk_bf16(T0[4 * g4], T0[4 * g4 + 1]); o.y = cvt_pk_bf16(T0[4 * g4 + 2], T0[4 * g4 + 3]); *(LAS v2u*)(ST + (vb0 * 32 + r32) * 272 + kk * 2) = o;
            o.x = cvt_pk_bf16(T1[4 * g4], T1[4 * g4 + 1]); o.y = cvt_pk_bf16(T1[4 * g4 + 2], T1[4 * g4 + 3]); *(LAS v2u*)(ST + (vb0 * 32 + 32 + r32) * 272 + kk * 2) = o; }
        LBAR();
#pragma unroll
        for (int st = 0; st < 4; ++st) { const bf16x8v kf = *(const LAS bf16x8v*)(KT + (kb * 32 + r32) * 144 + st * 32 + hi * 16);
            const bf16x8v va = *(const LAS bf16x8v*)(VT + (vb0 * 32 + r32) * 144 + st * 32 + hi * 16), vc = *(const LAS bf16x8v*)(VT + (vb0 * 32 + 32 + r32) * 144 + st * 32 + hi * 16);
            T0 = __builtin_amdgcn_mfma_f32_32x32x16_bf16(kf, va, T0, 0, 0, 0); T1 = __builtin_amdgcn_mfma_f32_32x32x16_bf16(kf, vc, T1, 0, 0, 0); }
#pragma unroll
        for (int g4 = 0; g4 < 4; ++g4) { const f32x4 eg = *(const LAS f32x4*)(EW + wave * 64 + 32 + 8 * g4 + 4 * hi);
            S0[4 * g4] = T0[4 * g4] * eg.x; S0[4 * g4 + 1] = T0[4 * g4 + 1] * eg.y; S0[4 * g4 + 2] = T0[4 * g4 + 2] * eg.z; S0[4 * g4 + 3] = T0[4 * g4 + 3] * eg.w;
            S1[4 * g4] = T1[4 * g4] * eg.x; S1[4 * g4 + 1] = T1[4 * g4 + 1] * eg.y; S1[4 * g4 + 2] = T1[4 * g4 + 2] * eg.z; S1[4 * g4 + 3] = T1[4 * g4 + 3] * eg.w; }
        asm volatile("" ::: "memory");
        {
            bf16x8v qf[8];
#pragma unroll
            for (int ks = 0; ks < 8; ++ks) qf[ks] = *(const LAS bf16x8v*)(QN + (ib * 32 + r32) * 272 + ks * 32 + hi * 16);
            asm volatile("" ::: "memory");
            f32x16 O;
#pragma unroll
            for (int r = 0; r < 16; ++r) O[r] = 0.f;
#pragma unroll
            for (int ks = 0; ks < 8; ++ks) { const bf16x8v sf = *(const LAS bf16x8v*)(ST + (vbo * 32 + r32) * 272 + ks * 32 + hi * 16); O = __builtin_amdgcn_mfma_f32_32x32x16_bf16(qf[ks], sf, O, 0, 0, 0); }
            asm volatile("" ::: "memory");
#pragma unroll 1
            for (int sb = 0; sb <= ib; ++sb) {
                f32x16 X;
#pragma unroll
                for (int r = 0; r < 16; ++r) X[r] = 0.f;
#pragma unroll
                for (int ks = 0; ks < 8; ++ks) { const bf16x8v kf = *(const LAS bf16x8v*)(KN + (sb * 32 + r32) * 272 + ks * 32 + hi * 16); X = __builtin_amdgcn_mfma_f32_32x32x16_bf16(kf, qf[ks], X, 0, 0, 0); }
                if (sb == ib) {
#pragma unroll
                    for (int r = 0; r < 16; ++r) { const int srow = (r & 3) + 8 * (r >> 2) + 4 * hi; if (srow > r32) X[r] = 0.f; }
                }
                asm volatile("" ::: "memory");
#pragma unroll
                for (int st = 0; st < 2; ++st) { v4u pw;
#pragma unroll
                    for (int q = 0; q < 4; ++q) pw[q] = cvt_pk_bf16(X[8 * st + 2 * q], X[8 * st + 2 * q + 1]);
                    const bf16x8v vf = *(const LAS bf16x8v*)(VT + (vbo * 32 + r32) * 144 + (sb * 32 + st * 16) * 2 + hi * 16);
                    O = __builtin_amdgcn_mfma_f32_32x32x16_bf16(__builtin_bit_cast(bf16x8v, pw), vf, O, 0, 0, 0); }
                asm volatile("" ::: "memory");
            }
            asm volatile("s_waitcnt vmcnt(0)" ::: "memory");
            const int rb = HG_BASE(ch); float* op = OO + (size_t)rb * HW + hh * HK + vbo * 32 + r32;
#pragma unroll
            for (int r = 0; r < 16; ++r) { const int i = ib * 32 + (r & 3) + 8 * (r >> 2) + 4 * hi; op[(size_t)(dir ? 63 - i : i) * HW] = O[r]; }
        }
        LBAR();
    }
    asm volatile("s_waitcnt vmcnt(0)" ::: "memory");
#undef LBAR
#undef HG_DMA
#undef HG_VLD
#undef HG_BASE
}

__device__ __forceinline__ void e8_phase(Frame& F, int j, int nrows) {
    fresh(F);
    unsigned char* ws = F.ws;
    const float* OF = (const float*)(ws + WS_OF); const float* OB = (const float*)(ws + WS_OB); const bf16* HG = (const bf16*)(ws + WS_HQ) + 4 * HSEG; bf16* MIX = (bf16*)(ws + WS_MIX);
    const float* gn = F.in[14] + j * HK;
    const int rpw = (nrows + F.G - 1) / F.G, rbase = (int)blockIdx.x * rpw, rend = (rbase + rpw < nrows) ? rbase + rpw : nrows;
    const int col = 8 * F.lane, vv = col & 127; const f32x4 g0 = *(const f32x4*)(gn + vv), g1 = *(const f32x4*)(gn + vv + 4);
    for (int r0 = rbase + F.wave; r0 < rend; r0 += 2 * NWAVES) {
        f32x4 a0[2], a1[2], b0[2], b1[2]; v4u hg[2];
#pragma unroll
        for (int q = 0; q < 2; ++q) { const int row = r0 + q * NWAVES; if (row < rend) {
            a0[q] = *(const f32x4*)(OF + (size_t)row * HW + col); a1[q] = *(const f32x4*)(OF + (size_t)row * HW + col + 4); b0[q] = *(const f32x4*)(OB + (size_t)row * HW + col); b1[q] = *(const f32x4*)(OB + (size_t)row * HW + col + 4);
            hg[q] = *(const v4u*)(HG + (size_t)row * HW + col); } }
#pragma unroll
        for (int q = 0; q < 2; ++q) { const int row = r0 + q * NWAVES; if (row < rend) {
            f32x4 x0 = a0[q] + b0[q], x1 = a1[q] + b1[q];
            float s = (x0.x * x0.x + x0.y * x0.y) + (x0.z * x0.z + x0.w * x0.w) + (x1.x * x1.x + x1.y * x1.y) + (x1.z * x1.z + x1.w * x1.w);
            s += shx(s, F.lane, 1); s += shx(s, F.lane, 2); s += shx(s, F.lane, 4); s += shx(s, F.lane, 8);
            const float rstd = rsqrtf(s * (1.0f / HK) + EPS);
            x0 = x0 * rstd * g0; x1 = x1 * rstd * g1; const v4u h = hg[q];
            v4u o; o.x = pg8::cvt_pk_bf16(x0.x * siluf_(bflo(h.x)), x0.y * siluf_(bfhi(h.x))); o.y = pg8::cvt_pk_bf16(x0.z * siluf_(bflo(h.y)), x0.w * siluf_(bfhi(h.y)));
            o.z = pg8::cvt_pk_bf16(x1.x * siluf_(bflo(h.z)), x1.y * siluf_(bfhi(h.z))); o.w = pg8::cvt_pk_bf16(x1.z * siluf_(bflo(h.w)), x1.w * siluf_(bfhi(h.w)));
            *(v4u*)(MIX + (size_t)row * DM + HW + col) = o; } }
    }
}

__device__ __forceinline__ void o12_phase(Frame& F, int nrows, const bf16* hb, const float* gn, const float* modl) {
    fresh(F);
    bf16* P = (bf16*)(F.ws + WS_POOLED);
    LAS unsigned char* XN = F.lds + RING_OFF;
    const int rpw = (nrows + F.G - 1) / F.G, rbase = (int)blockIdx.x * rpw, rend = (rbase + rpw < nrows) ? rbase + rpw : nrows;
    for (int r0 = rbase; r0 < rend; r0 += 32) {
        for (int sl = F.wave; sl < 48; sl += NWAVES) {
            const int row = r0 - 8 + sl; if (row < 0 || row >= nrows) continue;
            f32x4 v[4]; float s = 0.f;
#pragma unroll
            for (int j = 0; j < 4; ++j) { const v2u w = *(const v2u*)(hb + (size_t)row * DM + 4 * F.lane + 256 * j); v[j] = (f32x4){bflo(w.x), bfhi(w.x), bflo(w.y), bfhi(w.y)}; s += (v[j].x * v[j].x + v[j].y * v[j].y) + (v[j].z * v[j].z + v[j].w * v[j].w); }
            const float rstd = rsqrtf(wave_sum(s, F.lane) * (1.0f / DM) + EPS);
#pragma unroll
            for (int j = 0; j < 4; ++j) { v2u o; o.x = pg8::cvt_pk_bf16(v[j].x * rstd, v[j].y * rstd); o.y = pg8::cvt_pk_bf16(v[j].z * rstd, v[j].w * rstd); *(LAS v2u*)(XN + sl * 2048 + (4 * F.lane + 256 * j) * 2) = o; }
        }
        __syncthreads();
#pragma unroll 1
        for (int q = 0; q < 4; ++q) {
            const int t = r0 + F.wave * 4 + q; if (t >= rend) break;
            const bool lat = t < M; const int T = lat ? SEQ : CTXL; const int tt = lat ? t % SEQ : (t - M) % CTXL; const int bidx = lat ? t / SEQ : NB;
            const int sc0 = t - r0 + 8;
            const float* scp = modl + bidx * NMOD + DM;
#pragma unroll
            for (int g = 0; g < 4; ++g) {
                const int hw = 1 << g, col = 256 * g + 4 * F.lane;
                float s0 = 0.f, s1 = 0.f, s2 = 0.f, s3 = 0.f; int cnt = 0;
#pragma unroll
                for (int d = -hw; d < hw; ++d) { const bool ok = (tt + d >= 0) && (tt + d < T); const v2u x = *(const LAS v2u*)(XN + (sc0 + d) * 2048 + col * 2);
                    s0 += ok ? bflo(x.x) : 0.f; s1 += ok ? bfhi(x.x) : 0.f; s2 += ok ? bflo(x.y) : 0.f; s3 += ok ? bfhi(x.y) : 0.f; cnt += ok ? 1 : 0; }
                const v2u xc = *(const LAS v2u*)(XN + sc0 * 2048 + col * 2); const float ic = 1.0f / (float)cnt;
                const f32x4 gv = *(const f32x4*)(gn + col), sv = *(const f32x4*)(scp + col);
                v2u o; o.x = pg8::cvt_pk_bf16(gv.x * (sv.x + 1.0f) * (s0 * ic - bflo(xc.x)), gv.y * (sv.y + 1.0f) * (s1 * ic - bfhi(xc.x)));
                o.y = pg8::cvt_pk_bf16(gv.z * (sv.z + 1.0f) * (s2 * ic - bflo(xc.y)), gv.w * (sv.w + 1.0f) * (s3 * ic - bfhi(xc.y)));
                *(v2u*)(P + ((size_t)g * MT + t) * 256 + 4 * F.lane) = o;
            }
        }
        __syncthreads();
    }
}

__device__ __forceinline__ void o5_phase(Frame& F, int nrows, int j, const float* const* in) {
    fresh(F);
    unsigned char* ws = F.ws;
    const int* CNT = (const int*)(ws + WS_CNT); int* TST = (int*)(ws + WS_TST); const int* EIDX = (const int*)(ws + WS_EIDX); int* POS = (int*)(ws + WS_POS);
    int* IDX = (int*)(ws + WS_IDX); f32x4* RS = (f32x4*)(ws + WS_RS); const float* RSU = (const float*)(ws + WS_RSU); const float* ST = (const float*)(ws + WS_WSTAT) + j * 48;
    LAS int* lc = (LAS int*)(F.lds + RING_OFF);
    LAS int* lbase = lc + 512 * 8;
    const int rpw = (nrows + F.G - 1) / F.G;
    for (int e = F.tid; e < F.G * 8; e += 512) lc[e] = CNT[e];
    __syncthreads();
    {
        const int e = F.wave; int c4[4]; int sum = 0;
#pragma unroll
        for (int q = 0; q < 4; ++q) { const int w = 4 * F.lane + q; c4[q] = (w < F.G) ? lc[w * 8 + e] : 0; sum += c4[q]; }
        int incl = sum;
#pragma unroll
        for (int o = 1; o < 64; o <<= 1) { const int t = __builtin_amdgcn_ds_bpermute((F.lane >= o ? F.lane - o : F.lane) << 2, incl); if (F.lane >= o) incl += t; }
        const int total = __builtin_amdgcn_readlane(incl, 63); int excl = incl - sum;
        const int myq = (int)blockIdx.x & 3; int pre = excl;
#pragma unroll
        for (int q = 0; q < 3; ++q) if (q < myq) pre += c4[q];
        if (F.lane == ((int)blockIdx.x >> 2)) { lbase[e] = pre; lbase[8 + e] = total; }
    }
    __syncthreads();
    if (F.tid == 0) {
        int ts = 0;
        for (int e = 0; e < 8; ++e) { const int pre = lbase[e], tot = lbase[8 + e]; lbase[e] = ts * 256 + pre; lbase[16 + e] = ts * 256; if (blockIdx.x == 0) TST[e] = ts; ts += (tot + 255) >> 8; }
        if (blockIdx.x == 0) TST[8] = ts;
    }
    __syncthreads();
    if (F.wave == 0) {
        int run[8];
#pragma unroll
        for (int e = 0; e < 8; ++e) run[e] = lbase[e];
        const int npairs = 2 * rpw;
        for (int c0 = 0; c0 < npairs; c0 += 64) {
            const int pl = c0 + F.lane; const int row = (int)blockIdx.x * rpw + (pl >> 1); const bool ok = pl < npairs && row < nrows;
            const int e = ok ? EIDX[2 * row + (pl & 1)] : -1; int mypos = 0;
#pragma unroll
            for (int x = 0; x < 8; ++x) { const unsigned long long mk = __ballot(e == x); const int below = __popcll(mk & ((1ull << F.lane) - 1ull)); if (e == x) mypos = run[x] + below; run[x] += __popcll(mk); }
            if (ok) { POS[2 * row + (pl & 1)] = mypos; IDX[mypos] = row;
                const float sa = RSU[2 * row], n2 = RSU[2 * row + 1]; const float* se = ST + e * 6;
                const float sh = fmaxf(0.0625f * n2 * se[1] * se[3], 1e-30f);
                RS[mypos] = (f32x4){sa * se[0], sa * se[2], 1.0f / sh, sh * se[4]}; }
        }
    } else {
        const int mixdone = (F.G % 2 == 0 && F.G / 2 >= NB * NH) ? NB * NH * NWAVES * CONV_MIX : 0;
        conv_items(F, in, j, mixdone + (F.vcu * (NWAVES - 1) + (F.wave - 1)) * CONV_O5, 1, CONV_O5, 32768, 8448);
    }
    if ((int)blockIdx.x < 8) { const int e = blockIdx.x; const int tot = lbase[8 + e]; const int p0 = lbase[16 + e] + tot, p1 = lbase[16 + e] + ((tot + 255) & ~255);
        for (int p = p0 + F.tid; p < p1; p += 512) { IDX[p] = 0; RS[p] = (f32x4){0.f, 0.f, 0.f, 0.f}; } }
    __syncthreads();
}

__global__ void __launch_bounds__(NWAVES * 64, 2) mega_fwd(Args args) {
    extern __shared__ __attribute__((aligned(16))) unsigned char lds[];
    Frame F;
    F.lds = (LAS unsigned char*)lds;
    F.wave = __builtin_amdgcn_readfirstlane((int)threadIdx.x >> 6); fresh(F);
    F.G = gridDim.x; { const int bx = blockIdx.x; F.vcu = (F.G % 8 == 0) ? (bx % 8) * (F.G / 8) + bx / 8 : bx; }
    F.in = args.in; F.out = args.out; F.ws = args.ws;
    unsigned char* ws = args.ws;
    volatile LAS unsigned* MISC = (volatile LAS unsigned*)(F.lds + MISC_OFF);
    for (int u = F.tid; u < (LDS_BYTES - LDSCTL_OFF) / 4; u += NWAVES * 64) ((LAS unsigned*)(F.lds + LDSCTL_OFF))[u] = 0u;
    __syncthreads();
    XcdBarrier bar = xcd_barrier_post((unsigned*)(ws + WS_CTL) + CW_BAR, MISC + 8, F.wave);
#define GRID_BAR() do { xcd_barrier(bar); if (DUPMASK & 4096) xcd_barrier(bar); } while (0)
#ifndef ONLY
#define ONLY 0
#endif
#define PH(n) (ONLY == 0 || ONLY == (n))
#define REP(bit) for (int rep_ = 0; rep_ < ((DUPMASK & (bit)) ? 2 : 1); ++rep_)
    LAS unsigned char* ring = F.lds + RING_OFF;
    const float* MODV = (const float*)(ws + WS_MODV);
    bf16* HB = (bf16*)(ws + WS_HB);
    bf16* U = (bf16*)(ws + WS_U);

#if PH(20)
    REP(8192) p0_prologue(F);
#endif
    GRID_BAR();

    for (int lp = 0; lp < 2; ++lp) {
        const int le = 2 * lp, lo = 2 * lp + 1, j = lp;
        const bool ctx_out = (lp == 0);
        const int nro = ctx_out ? MT : M;
        const float* modE = MODV + (size_t)le * 17 * NMOD; const float* modO = MODV + (size_t)lo * 17 * NMOD;
#if PH(1)
        {
            RowArgs A{}; A.xin_l = args.in[0]; A.xin_c = args.in[2]; A.hb = HB; A.hbo = HB; A.g = args.in[6] + (size_t)(le * 2 + 0) * DM; A.modl = modE; A.shoff = 0; A.scoff = DM; A.U = U;
            A.Y = (const bf16*)(ws + WS_VG); A.pos = (const int*)(ws + WS_POS); A.gate = (const float*)(ws + WS_GATE); A.modprev = MODV + (size_t)(le - 1) * 17 * NMOD;
            if (lp == 0) { row_phase<false, 1, false, true>(F, A, MT); ffn_weights8(F); } else row_phase<true, 1, false, false>(F, A, MT);
        }
#endif
        GRID_BAR();
#if PH(2)
        {
            pg8::Gemm g{U, (const bf16*)(ws + WS_WIN) + (size_t)j * INP * DM, DM, DM, DM}; pg8::InOrder S; S.init(ctx_out, F.G, (int)blockIdx.x);
            EpiIn E{(bf16*)(ws + WS_CQ), (bf16*)(ws + WS_KRR), (bf16*)(ws + WS_CKV), (bf16*)(ws + WS_HQ), (float*)(ws + WS_RSQ), (float*)(ws + WS_RSKV), (const float*)(ws + WS_ROPE), args.in[13], j};
            REP(8) pg8::gemm_phase<EpiIn, pg8::InOrder, true>(ring, g, S, E, F.wave);
        }
#endif
        GRID_BAR();
#if PH(4)
        {
            pg8::Gemm g{(const bf16*)(ws + WS_CQ), (const bf16*)(ws + WS_WUQ) + (size_t)j * 768 * QL, QL, QL, QL}; pg8::StaticOrder S; S.init(nro, 768, F.G, (int)blockIdx.x);
            EpiQ E{(bf16*)(ws + WS_QB), (const float*)(ws + WS_RSQ)};
            REP(8) pg8::gemm_phase<EpiQ, pg8::StaticOrder, true>(ring, g, S, E, F.wave);
        }
        {
            pg8::Gemm g{(const bf16*)(ws + WS_CKV), (const bf16*)(ws + WS_WUKV) + (size_t)j * 1024 * KVL, KVL, KVL, KVL}; pg8::StaticOrder S;
            S.init(MT, 1024, F.G, ((int)blockIdx.x + (((MT / 256) * 4) % F.G) / 8 * 8) % F.G);
            EpiKV E{(bf16*)(ws + WS_KN), (bf16*)(ws + WS_VV), (const float*)(ws + WS_RSKV)};
            REP(8) pg8::gemm_phase<EpiKV, pg8::StaticOrder, true>(ring, g, S, E, F.wave);
        }
#endif
        GRID_BAR();
#if PH(6)
        REP(3) mix_phase(F, j, ctx_out);
#endif
        GRID_BAR();
#if PH(8)
        REP(4 | 64) e8_phase(F, j, nro);
#endif
        GRID_BAR();
#if PH(9)
        {
            pg8::Gemm g{(const bf16*)(ws + WS_MIX), (const bf16*)(ws + WS_WOUT) + (size_t)j * DM * DM, DM, DM, DM}; pg8::StaticOrder S; S.init(nro, DM, F.G, (int)blockIdx.x);
            if (lp == 0) { EpiResid<true> E{args.in[0], args.in[2], HB, modE, 2 * DM}; pg8::gemm_phase<EpiResid<true>, pg8::StaticOrder, true>(ring, g, S, E, F.wave); }
            else { EpiResid<false> E{nullptr, nullptr, HB, modE, 2 * DM}; pg8::gemm_phase<EpiResid<false>, pg8::StaticOrder, true>(ring, g, S, E, F.wave); }
        }
#endif
        GRID_BAR();
#if PH(10)
        {
            RowArgs A{}; A.hb = HB; A.g = args.in[6] + (size_t)(le * 2 + 1) * DM; A.modl = modE; A.shoff = 3 * DM; A.scoff = 4 * DM; A.U = U;
            A.U8 = ws + WS_U; A.rs = (f32x4*)(ws + WS_RS); A.st = (const float*)(ws + WS_WSTAT) + 96 + j * 6;
            A.hid_only = (lp == 0);
            row_phase<false, 1, false, false, true>(F, A, nro);
        }
#endif
        GRID_BAR();
#if PH(11)
        {
            pg8::StaticOrder S; S.init(nro, 2 * DFF, F.G, (int)blockIdx.x);
            if (lp == 0) {
                pg8::Gemm g{U, (const bf16*)(ws + WS_WGU) + (size_t)j * 2 * DFF * DM, DM, DM, DM};
                EpiGateUp8 E{ws + WS_HID, DFF, 2 * DFF / 256, 0, (const f32x4*)(ws + WS_RS)};
                pg8::gemm_phase<EpiGateUp8, pg8::StaticOrder, true>(ring, g, S, E, F.wave);
            } else {
                pg8::Gemm g{(const bf16*)(ws + WS_U), (const bf16*)(ws + WS_WGU + (size_t)j * 2 * DFF * DM * 2), DM / 2, DM / 2, DM / 2};
                EpiGateUp8 E{ws + WS_HID, DFF, 2 * DFF / 256, 0, (const f32x4*)(ws + WS_RS)};
                pg8::gemm_phase<EpiGateUp8, pg8::StaticOrder, true, false, true>(ring, g, S, E, F.wave);
            }
        }
#endif
        GRID_BAR();
#if PH(12)
        {
            pg8::StaticOrder S; S.init(nro, DM, F.G, (int)blockIdx.x);
            if (lp == 0) {
                pg8::Gemm g{(const bf16*)(ws + WS_HID), (const bf16*)(ws + WS_WDN), DFF / 2, DFF / 2, DFF / 2};
                EpiResid<false, true> E{nullptr, nullptr, HB, modE, 5 * DM, (const f32x4*)(ws + WS_RS)};
                pg8::gemm_phase<EpiResid<false, true>, pg8::StaticOrder, true, false, true>(ring, g, S, E, F.wave);
            } else {
                pg8::Gemm g{(const bf16*)(ws + WS_HID), (const bf16*)(ws + WS_WDN + (size_t)j * DM * DFF * 2), DFF / 2, DFF / 2, DFF / 2};
                EpiResid<false, true> E{nullptr, nullptr, HB, modE, 5 * DM, (const f32x4*)(ws + WS_RS)};
                pg8::gemm_phase<EpiResid<false, true>, pg8::StaticOrder, true, false, true>(ring, g, S, E, F.wave);
            }
        }
#endif
        GRID_BAR();
#if PH(13)
        {
            REP(2048) o12_phase(F, nro, HB, args.in[6] + (size_t)(lo * 2 + 0) * DM, modO);
            {
                const int done = ((F.G % 2 == 0 && F.G / 2 >= NB * NH) ? NB * NH * NWAVES * CONV_MIX : 0) + F.G * (NWAVES - 1) * CONV_O5;
                fresh(F); conv_items(F, args.in, j, done + F.vcu * NWAVES + F.wave, F.G * NWAVES, 1 << 30); }
        }
#endif
        GRID_BAR();
#if PH(15)
        {
            pg8::Gemm g{(const bf16*)(ws + WS_POOLED), (const bf16*)(ws + WS_WPOOL) + (size_t)j * 4 * 65536, 256, 256, 256};
            pg8::PoolOrder S{nro / 256, MT / 256, F.G, (int)blockIdx.x};
            EpiPool E{HB, modO, args.in[20] + (size_t)j * DM, args.in[21] + (size_t)j * DM, MT / 256};
            pg8::gemm_phase<EpiPool, pg8::PoolOrder, true>(ring, g, S, E, F.wave);
        }
#endif
        GRID_BAR();
#if PH(16)
        {
            RowArgs A{}; A.hb = HB; A.g = args.in[6] + (size_t)(lo * 2 + 1) * DM; A.modl = modO; A.shoff = 3 * DM; A.scoff = 4 * DM; A.U = U;
            A.router = args.in[22] + (size_t)j * DM * NE; A.eidx = (int*)(ws + WS_EIDX); A.gout = (float*)(ws + WS_GATE); A.cnt = (int*)(ws + WS_CNT);
            A.U8 = ws + WS_U; A.rsu = (float*)(ws + WS_RSU);
            REP(4 | 512) row_phase<false, 1, true, false>(F, A, nro);
        }
#endif
        GRID_BAR();
#if PH(17)
        REP(4 | 1024) o5_phase(F, nro, j, args.in);
#endif
        GRID_BAR();
#if PH(18)
        {
            const int* TST = (const int*)(ws + WS_TST);
            const int ts1 = TST[1], ts2 = TST[2], ts3 = TST[3], ts4 = TST[4], ts5 = TST[5], ts6 = TST[6], ts7 = TST[7], nT = TST[8];
            const int rem = nT % MOE_CH, nseg = nT / MOE_CH + 1;
            for (int p = 0; p <= nseg; ++p) {
                int n7 = 0;
                if (p >= 1) {
                    const int sg = p - 1; const int t0 = sg == 0 ? 0 : rem + (sg - 1) * MOE_CH, nrt = sg == 0 ? rem : MOE_CH; n7 = nrt * (DM / 256);
                    const bf16* hb = (const bf16*)(ws + WS_HIDM) + (size_t)((sg == 0 || ((sg - 1) & 1)) ? MOE_CH : 0) * 256 * (DFE / 2);
                    pg8::Gemm g{hb - (size_t)t0 * 256 * (DFE / 2), (const bf16*)(ws + WS_MWDN), DFE / 2, DFE / 2, DFE / 2};
                    pg8::MoeOrder S{t0, nrt, DM / 256, F.G, (int)blockIdx.x, ts1, ts2, ts3, ts4, ts5, ts6, ts7, 0, 0};
                    EpiY8 E{(bf16*)(ws + WS_VG), DM / 256, (const f32x4*)(ws + WS_RS)};
                    REP(8) pg8::gemm_phase<EpiY8, pg8::MoeOrder, true, false, true>(ring, g, S, E, F.wave);
                }
                if (p < nseg) {
                    const int sg = p; const int t0 = sg == 0 ? 0 : rem + (sg - 1) * MOE_CH, nrt = sg == 0 ? rem : MOE_CH;
                    unsigned char* hb = ws + WS_HIDM + (size_t)((sg == 0 || ((sg - 1) & 1)) ? MOE_CH : 0) * 256 * DFE;
                    pg8::Gemm g{(const bf16*)(ws + WS_U), (const bf16*)(ws + WS_MWGU), DM / 2, DM / 2, DM / 2, (const int*)(ws + WS_IDX)};
                    pg8::MoeOrder S{t0, nrt, 2 * DFE / 256, F.G, (int)blockIdx.x, ts1, ts2, ts3, ts4, ts5, ts6, ts7, n7 % F.G, 4};
                    EpiGateUp8 E{hb, DFE, 2 * DFE / 256, t0 * 256, (const f32x4*)(ws + WS_RS)};
                    REP(8) pg8::gemm_phase<EpiGateUp8, pg8::MoeOrder, true, true, true>(ring, g, S, E, F.wave);
                }
                GRID_BAR();
            }
        }
#endif
    }
#if PH(19)
    {
        RowArgs A{}; A.hb = HB; A.fout = args.out; A.g = args.in[7];
        A.Y = (const bf16*)(ws + WS_VG); A.pos = (const int*)(ws + WS_POS); A.gate = (const float*)(ws + WS_GATE); A.modprev = MODV + (size_t)3 * 17 * NMOD;
        row_phase<true, 2, false, false>(F, A, M);
        if (xb_ld((unsigned*)(ws + WS_CTL) + CW_BAR + XB_TMO) != 0u) { __syncthreads(); const float qn = __builtin_nanf(""); for (int i = F.tid; i < 1024; i += 512) args.out[(size_t)blockIdx.x * 1024 + i] = qn; }
    }
#endif
}

extern "C" void kernel_launch(void* const* d_in, const int* in_sizes, int n_in, void* d_out, int out_size, void* d_ws, size_t ws_size, hipStream_t stream) {
    static int grid = 0;
    if (grid == 0) {
        if (n_in != 26 || out_size != M * DM || ws_size < WS_END) { fprintf(stderr, "kernel_launch: unexpected shapes (n_in %d out %d ws %zu)\n", n_in, out_size, ws_size); grid = -1; return; }
        int dev = 0, cus = 0, per_cu = 0;
        if (hipGetDevice(&dev) != hipSuccess || hipDeviceGetAttribute(&cus, hipDeviceAttributeMultiprocessorCount, dev) != hipSuccess) { grid = -1; return; }
        if (hipFuncSetAttribute((const void*)mega_fwd, hipFuncAttributeMaxDynamicSharedMemorySize, LDS_BYTES) != hipSuccess) { grid = -1; return; }
        if (hipOccupancyMaxActiveBlocksPerMultiprocessor(&per_cu, (const void*)mega_fwd, NWAVES * 64, LDS_BYTES) != hipSuccess || per_cu < 1) fprintf(stderr, "kernel_launch: occupancy query says %d\n", per_cu);
        (void)hipGetLastError();
        grid = cus > 256 ? 256 : cus;
    }
    if (grid < 0) return;
    if (hipMemsetAsync((char*)d_ws + WS_CTL, 0, CTL_ZERO_BYTES, stream) != hipSuccess) return;
    Args a{};
    for (int i = 0; i < 26; ++i) a.in[i] = (const float*)d_in[i];
    a.out = (float*)d_out; a.ws = (unsigned char*)d_ws;
    hipLaunchKernelGGL(mega_fwd, dim3(grid), dim3(NWAVES * 64), LDS_BYTES, stream, a);
}
```

```cpp
#include <hip/hip_runtime.h>
#ifndef DUPMASK
#define DUPMASK 0
#endif
#include <cstdio>
#include <cstdint>

__device__ __forceinline__ int lane_now() { int l; asm volatile("v_mbcnt_lo_u32_b32 %0, -1, 0\n\tv_mbcnt_hi_u32_b32 %0, -1, %0" : "=v"(l)); return l; }
namespace pg8 {
#define PG8_LAS __attribute__((address_space(3)))
typedef unsigned short bf16_t;
typedef short bf16x8 __attribute__((ext_vector_type(8)));
typedef int v4i_t __attribute__((ext_vector_type(4)));
typedef int v8i_t __attribute__((ext_vector_type(8)));
typedef float f32x4 __attribute__((ext_vector_type(4)));
typedef unsigned u32x4 __attribute__((ext_vector_type(4)));
constexpr int BM = 256, BK = 64, HALF = 128, HTB = HALF * BK * 2, STAGE_BYTES = 8 * HTB, NXCD = 8, WGM = 8;

__host__ __device__ __forceinline__ int lds_byte(int r, int c) { const int st = (r >> 4) * 2 + (c >> 5), rr = r & 15, cc = c & 31, ob = rr * 64 + cc * 2; return st * 1024 + (ob ^ (((ob >> 9) & 1) << 5)); }
__host__ __device__ __forceinline__ void stage_rc(int b, int& R, int& C) { const int st = b / 1024, sb = b % 1024, swz = sb ^ (((sb >> 9) & 1) << 5); R = (st >> 1) * 16 + swz / 64; C = (st & 1) * 32 + (swz % 64) / 2; }
__host__ __device__ __forceinline__ int perm32(int rho) { const int n = rho >> 4, i = rho & 15; return 8 * (i >> 2) + 4 * n + (i & 3); }

struct Unit { int pm, pn; };
struct Gemm { const bf16_t* A; const bf16_t* Bt; int lda, ldb, K; const int* idx; };

struct StaticOrder {
    int nM, nN, nwg, G, c;
    __device__ void init(int M, int N, int G_, int c_) { nM = M / BM; nN = N / BM; nwg = nM * nN; G = G_; c = c_; }
    __device__ bool next(int i, Unit& u) const {
        const long L = (long)i * G + c; if (L >= nwg) return false;
        int wgid = (int)L; { const int q = nwg / NXCD, r = nwg % NXCD, xcd = wgid % NXCD, off = wgid / NXCD; wgid = (xcd < r ? xcd * (q + 1) : r * (q + 1) + (xcd - r) * q) + off; }
        const int nig = WGM * nN, gid = wgid / nig, fm = gid * WGM, gsz = (nM - fm) < WGM ? (nM - fm) : WGM;
        u.pm = fm + ((wgid % nig) % gsz); u.pn = (wgid % nig) / gsz; return true;
    }
};
struct InOrder {
    StaticOrder lat; int nlat, nctx_ct, G, c;
    __device__ void init(bool full, int G_, int c_) { lat.init(32768, 3328, G_, c_); nlat = lat.nwg; nctx_ct = full ? 13 : 8; G = G_; c = c_; }
    __device__ bool next(int i, Unit& u) const {
        const int L = i * G + c; if (L < nlat) return lat.next(i, u);
        const int x = L - nlat; if (x >= 16 * nctx_ct) return false;
        const int rt = (nctx_ct == 13) ? x / 13 : x >> 3, q = x - rt * nctx_ct; u.pm = 128 + rt; u.pn = (nctx_ct == 13) ? q : (q < 2 ? q + 1 : q + 3); return true;
    }
};
struct PoolOrder {
    int nrt, talloc, G, c;
    __device__ bool next(int i, Unit& u) const { const int L = i * G + c; if (L >= 4 * nrt) return false; const int g = L / nrt, rt = L - g * nrt; u.pm = g * talloc + rt; u.pn = g; return true; }
};
struct MoeOrder {
    int t0, nrt, nct, G, c; int ts1, ts2, ts3, ts4, ts5, ts6, ts7;
    int skipw, skipr;
    __device__ bool next(int i, Unit& u) const {
        const int nwg = nrt * nct; const int r_ = i + (c < skipw ? skipr : 0);
        const int L = (r_ < skipr) ? r_ * (G - skipw) + (c - skipw) : skipr * (G - skipw) + (r_ - skipr) * G + c; if (L >= nwg) return false;
        int wgid = L; { const int q = nwg / NXCD, r = nwg % NXCD, xcd = wgid % NXCD, off = wgid / NXCD; wgid = (xcd < r ? xcd * (q + 1) : r * (q + 1) + (xcd - r) * q) + off; }
        const int nig = WGM * nct, gid = wgid / nig, fm = gid * WGM, gsz = (nrt - fm) < WGM ? (nrt - fm) : WGM;
        const int rt = t0 + fm + ((wgid % nig) % gsz), ct = (wgid % nig) / gsz;
        const int e = (rt >= ts1) + (rt >= ts2) + (rt >= ts3) + (rt >= ts4) + (rt >= ts5) + (rt >= ts6) + (rt >= ts7);
        u.pm = rt; u.pn = e * nct + ct; return true;
    }
};

typedef float f32x2_cv __attribute__((ext_vector_type(2))); typedef __bf16 bf16x2_cv __attribute__((ext_vector_type(2)));
__device__ __forceinline__ unsigned cvt_pk_bf16(float lo, float hi) { const f32x2_cv v = {lo, hi}; const bf16x2_cv b = __builtin_convertvector(v, bf16x2_cv); return __builtin_bit_cast(unsigned, b); }

template <class Epi, class Sched, bool ALIGN_EPI, bool GATHER = false, bool FP8 = false>
__device__ __forceinline__ void gemm_phase(PG8_LAS unsigned char* lds, const Gemm g, const Sched& S, const Epi& E, const int wid) {
    const int lane_ = lane_now();
    const int lane = lane_, tid = wid * 64 + lane, wr = wid >> 2, wc = wid & 3, fr = lane & 15, fq = lane >> 4;
    int K_ = g.K; asm volatile("" : "+s"(K_));
    const int K = K_, nt = K / BK;
    unsigned voffA[2], voffB[2]; int RA0 = 0, CA0 = 0;
#pragma unroll
    for (int i = 0; i < 2; ++i) { int R, C; stage_rc(tid * 16 + i * 8192, R, C); const int Rb = Epi::PERM ? ((R & ~31) + perm32(R & 31)) : R; if (i == 0) { RA0 = R; CA0 = C; }
        voffA[i] = (unsigned)(R * g.lda + C) * 2u; voffB[i] = (unsigned)(Rb * g.ldb + C) * 2u; }
    unsigned gc[2][2]; PG8_LAS int* IB = (PG8_LAS int*)(lds + STAGE_BYTES);
#define PG8_GLOAD(dst, pm_) do { _Pragma("unroll") for (int h_ = 0; h_ < 2; ++h_) _Pragma("unroll") for (int i_ = 0; i_ < 2; ++i_) \
        dst[h_][i_] = ((unsigned)g.idx[(pm_) * 256 + h_ * 128 + i_ * 64 + RA0] * (unsigned)g.lda + (unsigned)CA0) * 2u; } while (0)
#define PG8_GNEXT(h_) do { if (last && has_next) { _Pragma("unroll") for (int i_ = 0; i_ < 2; ++i_) gc[h_][i_] = ((unsigned)IB[(h_) * 128 + i_ * 64 + RA0] * (unsigned)g.lda + (unsigned)CA0) * 2u; } } while (0)
    const size_t kstep = (size_t)(BK * 2);
    const size_t hstepA = (size_t)HALF * g.lda * 2, hstepB = (size_t)HALF * g.ldb * 2;
    const size_t tstepA = 2 * hstepA, tstepB = 2 * hstepB;
    const unsigned ldsw = (unsigned)wid * 1024u;
    const int aoff = lds_byte(wr * 64 + fr, fq * 8), boff = lds_byte(wc * 32 + fr, fq * 8);
#define PG8_SA(b, h) (((b) * 2 + (h)) * HTB)
#define PG8_SB(b, h) ((4 + (b) * 2 + (h)) * HTB)
#define PG8_STAGE(bufoff, gbase, voff) do { _Pragma("unroll") for (int _i = 0; _i < 2; ++_i) \
        __builtin_amdgcn_global_load_lds((const unsigned*)((const char*)(gbase) + (voff)[_i]), (PG8_LAS unsigned*)(lds + (bufoff) + ldsw + _i * 8192), 16, 0, 0); } while (0)
#define PG8_STAGEG(bufoff, gbase, o0_, o1_) do { __builtin_amdgcn_global_load_lds((const unsigned*)((const char*)(gbase) + (o0_)), (PG8_LAS unsigned*)(lds + (bufoff) + ldsw), 16, 0, 0); \
        __builtin_amdgcn_global_load_lds((const unsigned*)((const char*)(gbase) + (o1_)), (PG8_LAS unsigned*)(lds + (bufoff) + ldsw + 8192), 16, 0, 0); } while (0)
#define PG8_LDA(dst, b, h) do { if constexpr (FP8) { _Pragma("unroll") for (int m = 0; m < 4; ++m) { const PG8_LAS v4i_t* p_ = (const PG8_LAS v4i_t*)(lds + PG8_SA(b, h) + aoff + m * 2048); dst##8[m] = __builtin_shufflevector(p_[0], p_[64], 0, 1, 2, 3, 4, 5, 6, 7); } } \
        else { _Pragma("unroll") for (int m = 0; m < 4; ++m) _Pragma("unroll") for (int k = 0; k < 2; ++k) dst[m][k] = *(const PG8_LAS bf16x8*)(lds + PG8_SA(b, h) + aoff + m * 2048 + k * 1024); } } while (0)
#define PG8_LDB(dst, b, h) do { if constexpr (FP8) { _Pragma("unroll") for (int n = 0; n < 2; ++n) { const PG8_LAS v4i_t* p_ = (const PG8_LAS v4i_t*)(lds + PG8_SB(b, h) + boff + n * 2048); dst##8[n] = __builtin_shufflevector(p_[0], p_[64], 0, 1, 2, 3, 4, 5, 6, 7); } } \
        else { _Pragma("unroll") for (int n = 0; n < 2; ++n) _Pragma("unroll") for (int k = 0; k < 2; ++k) dst[n][k] = *(const PG8_LAS bf16x8*)(lds + PG8_SB(b, h) + boff + n * 2048 + k * 1024); } } while (0)
#define PG8_MMA(ai, bj, At, Bt) do { __builtin_amdgcn_s_setprio(1); \
        if constexpr (FP8) { _Pragma("unroll") for (int m = 0; m < 4; ++m) _Pragma("unroll") for (int n = 0; n < 2; ++n) \
            asm volatile("v_mfma_f32_16x16x128_f8f6f4 %0, %1, %2, %0" : "+v"(acc[ai][bj][m][n]) : "v"(Bt##8[n]), "v"(At##8[m])); } \
        else { _Pragma("unroll") for (int m = 0; m < 4; ++m) _Pragma("unroll") for (int n = 0; n < 2; ++n) _Pragma("unroll") for (int k = 0; k < 2; ++k) \
            acc[ai][bj][m][n] = __builtin_amdgcn_mfma_f32_16x16x32_bf16(Bt[n][k], At[m][k], acc[ai][bj][m][n], 0, 0, 0); } \
        __builtin_amdgcn_s_setprio(0); } while (0)
#define PG8_WAIT_V(n) asm volatile("s_waitcnt vmcnt(" #n ")" ::: "memory")
#define PG8_WAIT_L(n) asm volatile("s_waitcnt lgkmcnt(" #n ")" ::: "memory")
#define PG8_BAR __builtin_amdgcn_s_barrier()
#define PG8_SCHED __builtin_amdgcn_sched_barrier(0)
    Unit cur, nxt; int ui = 0;
    if (!S.next(0, cur)) return;
    f32x4 acc[2][2][4][2];
#pragma unroll
    for (int a = 0; a < 2; ++a)
#pragma unroll
        for (int b = 0; b < 2; ++b)
#pragma unroll
            for (int m = 0; m < 4; ++m)
#pragma unroll
                for (int n = 0; n < 2; ++n) acc[a][b][m][n] = (f32x4){0.f, 0.f, 0.f, 0.f};
    bf16x8 At[4][2], B0[2][2], B1[2][2]; v8i_t At8[4], B08[2], B18[2];
    const char* cA = GATHER ? (const char*)g.A : (const char*)g.A + (size_t)cur.pm * tstepA; const char* cB = (const char*)g.Bt + (size_t)cur.pn * tstepB;
    if constexpr (GATHER) { PG8_GLOAD(gc, cur.pm); }
    PG8_STAGE(PG8_SB(0, 0), cB, voffB); PG8_STAGE(PG8_SB(0, 1), cB + hstepB, voffB);
    if constexpr (GATHER) { PG8_STAGEG(PG8_SA(0, 0), cA, gc[0][0], gc[0][1]); PG8_STAGEG(PG8_SA(0, 1), cA, gc[1][0], gc[1][1]); }
    else { PG8_STAGE(PG8_SA(0, 0), cA, voffA); PG8_STAGE(PG8_SA(0, 1), cA + hstepA, voffA); }
    if (wr == 1) PG8_BAR;
    PG8_WAIT_V(2); PG8_BAR;
    PG8_STAGE(PG8_SB(1, 0), cB + kstep, voffB); if constexpr (GATHER) { PG8_STAGEG(PG8_SA(1, 0), cA + kstep, gc[0][0], gc[0][1]); } else { PG8_STAGE(PG8_SA(1, 0), cA + kstep, voffA); } PG8_STAGE(PG8_SB(1, 1), cB + hstepB + kstep, voffB);
    PG8_WAIT_V(6); PG8_BAR;
    for (;;) {
        const bool has_next = S.next(ui + 1, nxt);
        const char* nA = GATHER ? cA : (has_next ? (const char*)g.A + (size_t)nxt.pm * tstepA : cA); const char* nB = has_next ? (const char*)g.Bt + (size_t)nxt.pn * tstepB : cB;
        if constexpr (GATHER) { if (has_next && wid == 0) __builtin_amdgcn_global_load_lds((const unsigned*)(g.idx + (size_t)nxt.pm * 256 + lane * 4), (PG8_LAS unsigned*)IB, 16, 0, 0); }
#pragma unroll 1
        for (int t = 0; t < nt; t += 2) {
            const bool last = (t == nt - 2);
            const char* a1 = cA + (size_t)(t + 1) * kstep;
            const char* a2 = last ? nA : cA + (size_t)(t + 2) * kstep; const char* b2 = last ? nB : cB + (size_t)(t + 2) * kstep;
            const char* a3 = a2 + kstep; const char* b3 = b2 + kstep;
            PG8_LDB(B0, 0, 0); PG8_LDB(B1, 0, 1); PG8_SCHED; PG8_LDA(At, 0, 0); if constexpr (GATHER) { PG8_GNEXT(0); PG8_STAGEG(PG8_SA(1, 1), a1, gc[1][0], gc[1][1]); PG8_GNEXT(1); } else { PG8_STAGE(PG8_SA(1, 1), a1 + hstepA, voffA); }
            PG8_WAIT_V(8); PG8_WAIT_L(0); PG8_BAR; PG8_MMA(0, 0, At, B0); PG8_MMA(0, 1, At, B1); PG8_BAR; PG8_SCHED;
            PG8_LDA(At, 0, 1); PG8_STAGE(PG8_SB(0, 0), b2, voffB); PG8_STAGE(PG8_SB(0, 1), b2 + hstepB, voffB); if constexpr (GATHER) { PG8_STAGEG(PG8_SA(0, 0), a2, gc[0][0], gc[0][1]); } else { PG8_STAGE(PG8_SA(0, 0), a2, voffA); }
            PG8_WAIT_V(8); PG8_WAIT_L(0); PG8_BAR; PG8_MMA(1, 0, At, B0); PG8_MMA(1, 1, At, B1); PG8_BAR; PG8_SCHED;
            PG8_LDB(B0, 1, 0); PG8_LDB(B1, 1, 1); PG8_SCHED; PG8_LDA(At, 1, 0); if constexpr (GATHER) { PG8_STAGEG(PG8_SA(0, 1), a2, gc[1][0], gc[1][1]); } else { PG8_STAGE(PG8_SA(0, 1), a2 + hstepA, voffA); }
            PG8_WAIT_V(8); PG8_WAIT_L(0); PG8_BAR; PG8_MMA(0, 0, At, B0); PG8_MMA(0, 1, At, B1); PG8_BAR; PG8_SCHED;
            PG8_LDA(At, 1, 1); PG8_STAGE(PG8_SB(1, 0), b3, voffB); PG8_STAGE(PG8_SB(1, 1), b3 + hstepB, voffB); if constexpr (GATHER) { PG8_STAGEG(PG8_SA(1, 0), a3, gc[0][0], gc[0][1]); } else { PG8_STAGE(PG8_SA(1, 0), a3, voffA); }
            PG8_WAIT_V(8); PG8_WAIT_L(0); PG8_BAR; PG8_MMA(1, 0, At, B0); PG8_MMA(1, 1, At, B1); PG8_BAR; PG8_SCHED;
        }
        if constexpr (FP8) { asm volatile("s_nop 15\n\ts_nop 15" ::: "memory"); PG8_SCHED; }
        if constexpr (ALIGN_EPI) { if (wr == 0) PG8_BAR; }
        E(acc, cur, wr, wc, fr, fq);
        if (!has_next) break;
#pragma unroll
        for (int a = 0; a < 2; ++a)
#pragma unroll
            for (int b = 0; b < 2; ++b)
#pragma unroll
                for (int m = 0; m < 4; ++m)
#pragma unroll
                    for (int n = 0; n < 2; ++n) acc[a][b][m][n] = (f32x4){0.f, 0.f, 0.f, 0.f};
        cur = nxt; cA = nA; cB = nB; ++ui;
        if constexpr (ALIGN_EPI) { if (wr == 1) PG8_BAR; }
    }
    PG8_WAIT_V(0);
    if constexpr (!ALIGN_EPI) { if (wr == 0) PG8_BAR; }
    PG8_BAR;
#undef PG8_SA
#undef PG8_SB
#undef PG8_STAGE
#undef PG8_STAGEG
#undef PG8_GLOAD
#undef PG8_GNEXT
#undef PG8_LDA
#undef PG8_LDB
#undef PG8_MMA
#undef PG8_WAIT_V
#undef PG8_WAIT_L
#undef PG8_BAR
#undef PG8_SCHED
}
}

constexpr int NWAVES = 8;
constexpr int DM = 1024, NB = 16, SEQ = 2048, CTXL = 256;
constexpr int M = NB * SEQ, MC = NB * CTXL, MT = M + MC;
constexpr int QL = 384, KVL = 256, ROPE = 32, HW = 512, NH = 8, QKD = 96, VD = 64;
constexpr int INW = 3232, INP = 3328;
constexpr int DFF = 2816, NE = 8, DFE = 3584, NMOD = 6 * DM;
constexpr int NHH = 4, HK = 128; constexpr int NKEY = SEQ + CTXL;
constexpr float EPS = 1e-6f;
constexpr int MAXT = 296;
constexpr int MOE_CH = 128;

constexpr size_t MiB = 1u << 20;
constexpr size_t WS_CTL = 0, CTL_ZERO_BYTES = 1 * MiB;
constexpr size_t WS_MODV = 1 * MiB;
constexpr size_t WS_ROPE = 3 * MiB;
constexpr size_t WS_CNT = 3 * MiB + 64 * 1024;
constexpr size_t WS_TST = 3 * MiB + 128 * 1024;
constexpr size_t WS_EIDX = 4 * MiB, WS_GATE = 4 * MiB + 512 * 1024, WS_POS = 5 * MiB, WS_IDX = 5 * MiB + 512 * 1024;
constexpr size_t WS_RSQ = 6 * MiB, WS_RSKV = 7 * MiB + 256 * 1024;
constexpr size_t WS_WSTAT = 3 * MiB + 160 * 1024;
constexpr size_t WS_RS = WS_RSQ, WS_RSU = WS_RSKV;
constexpr size_t WS_WIN = 8 * MiB, WS_WUQ = 21 * MiB, WS_WUKV = 23 * MiB, WS_WOUT = 24 * MiB, WS_WGU = 28 * MiB, WS_WDN = 50 * MiB, WS_WPOOL = 61 * MiB;
constexpr size_t WS_HB = 62 * MiB;
constexpr size_t WS_U = 134 * MiB;
constexpr size_t WS_X = 206 * MiB;
constexpr size_t WS_CQ = WS_X, WS_CKV = 233 * MiB, WS_KRR = 251 * MiB, WS_HQ = 254 * MiB  ;
constexpr size_t WS_QB = 434 * MiB, WS_KN = 488 * MiB, WS_VV = 524 * MiB, WS_OF = 560 * MiB, WS_OB = 632 * MiB, WS_MIX = 704 * MiB, WS_HID = WS_X;
constexpr size_t WS_MWGU = 780 * MiB, WS_MWDN = 840 * MiB  , WS_VG = 374 * MiB, WS_POOLED = WS_VG  , WS_HIDM = 522 * MiB, WS_END = 970 * MiB;
constexpr size_t HSEG = (size_t)MT * HW;
static_assert(WS_WPOOL + (size_t)2 * 4 * 65536 * 2 <= WS_HB && WS_HB + (size_t)MT * DM * 2 <= WS_U && WS_U + (size_t)MT * DM * 2 <= WS_X && WS_KRR + (size_t)MT * ROPE * 2 <= WS_HQ && WS_HQ + 5 * HSEG * 2 <= WS_QB && WS_MIX + (size_t)MT * DM * 2 <= WS_END && WS_HID + (size_t)MT * DFF * 2 <= WS_QB, "ws map even");
static_assert(WS_HIDM + (size_t)2 * MOE_CH * 256 * DFE * 2 <= WS_END && WS_VG + (size_t)MAXT * 256 * DM * 2 <= WS_HIDM && WS_MWDN + (size_t)NE * DM * DFE <= WS_END && WS_MWGU + (size_t)NE * 2 * DFE * DM <= WS_MWDN && WS_MIX + (size_t)MT * DM * 2 <= WS_MWGU && WS_HIDM + (size_t)2 * MOE_CH * 256 * DFE <= WS_MWGU, "ws map odd");
constexpr int CW_BAR = 4096;

constexpr int RING_OFF = 0, RING_BYTES = 143360;
constexpr int LDSCTL_OFF = RING_BYTES, MISC_OFF = LDSCTL_OFF + 320;
constexpr int LDS_BYTES = 147456;

#define GAS __attribute__((address_space(1)))
#define LAS __attribute__((address_space(3)))
typedef unsigned short bf16;
typedef unsigned v4u __attribute__((ext_vector_type(4)));
typedef unsigned v2u __attribute__((ext_vector_type(2)));
typedef float f32x4 __attribute__((ext_vector_type(4)));
typedef float f32x2 __attribute__((ext_vector_type(2)));
typedef GAS unsigned gu32;
#define RLX_AGENT __ATOMIC_RELAXED, __HIP_MEMORY_SCOPE_AGENT
#define LDS_WAIT() asm volatile("s_waitcnt lgkmcnt(0)" ::: "memory")
__device__ __forceinline__ unsigned f2bf(float f) { unsigned u = __builtin_bit_cast(unsigned, f); return (u + 0x7fffu + ((u >> 16) & 1u)) >> 16; }
__device__ __forceinline__ unsigned pk2(float lo, float hi) { return f2bf(lo) | (f2bf(hi) << 16); }
__device__ __forceinline__ float bf2f(unsigned short b) { return __uint_as_float((unsigned)b << 16); }
__device__ __forceinline__ float bflo(unsigned w) { return __uint_as_float(w << 16); }
__device__ __forceinline__ float bfhi(unsigned w) { return __uint_as_float(w & 0xffff0000u); }
__device__ __forceinline__ float sigmoidf_(float x) { return 1.0f / (1.0f + __expf(-x)); }
__device__ __forceinline__ float siluf_(float x) { return x * __builtin_amdgcn_rcpf(1.0f + __expf(-x)); }

#define XB_TMO      128
#define XB_XCNT(j)  (256  + 64 * (j))
#define XB_XSUB(j)  (1280 + 64 * (j))
#define XB_XGEN(j)  (2304 + 64 * (j))
#define XB_TOP      3328
#define XB_TOPGEN   3392
#define XCD_BAR_WORDS 3456
#define XB_SPIN_CAP (1u << 22)
__device__ __forceinline__ unsigned xb_ld(unsigned* p)              { return __hip_atomic_load(p, __ATOMIC_RELAXED, __HIP_MEMORY_SCOPE_AGENT); }
__device__ __forceinline__ unsigned xb_add(unsigned* p, unsigned v) { return __hip_atomic_fetch_add(p, v, __ATOMIC_RELAXED, __HIP_MEMORY_SCOPE_AGENT); }
__device__ __forceinline__ unsigned xb_xcc_id() { return (unsigned)__builtin_amdgcn_s_getreg((3 << 11) | 20) & 0xFu; }
#define XB_SPIN(cond, bar) do { unsigned _sp = 0; while (cond) { __builtin_amdgcn_s_sleep(1); \
    if ((++_sp & 255u) == 0u) { if (xb_ld(&(bar)[XB_TMO])) break; if (_sp > XB_SPIN_CAP) { atomicAdd(&(bar)[XB_TMO], 1u); break; } } } } while (0)
struct XcdBarrier { unsigned* bar; unsigned x; volatile LAS unsigned* st; int wave; };
__device__ __forceinline__ bool xb_leader(int wave) { return wave == 0 && lane_now() == 0; }
__device__ __forceinline__ XcdBarrier xcd_barrier_post(unsigned* bar, volatile LAS unsigned* st, int wave) {
    XcdBarrier b; b.bar = bar; b.x = xb_xcc_id(); b.st = st; b.wave = wave;
    if (xb_leader(wave)) (void)xb_add(&bar[XB_XCNT(b.x)], 1u);
    return b;
}
__device__ __forceinline__ void xcd_barrier_complete(unsigned* bar, unsigned x, unsigned& nloc, unsigned& nx) {
    const unsigned G = gridDim.x * gridDim.y * gridDim.z;
    unsigned sum, cnt, mine, sp = 0u;
    for (;;) {
        sum = 0u; cnt = 0u; mine = 0u;
#pragma unroll
        for (unsigned j = 0; j < 16; ++j) { const unsigned c = xb_ld(&bar[XB_XCNT(j)]); sum += c; cnt += (c > 0u) ? 1u : 0u; mine = (j == x) ? c : mine; }
        if (sum == G) break;
        __builtin_amdgcn_s_sleep(1);
        if ((++sp & 255u) == 0u) { if (xb_ld(&bar[XB_TMO])) break; if (sp > XB_SPIN_CAP) { atomicAdd(&bar[XB_TMO], 1u); break; } }
    }
    nloc = mine > 0u ? mine : 1u; nx = cnt > 0u ? cnt : 1u;
}
__device__ __forceinline__ void xcd_barrier(const XcdBarrier& b) {
    asm volatile("s_waitcnt vmcnt(0)" ::: "memory");
    __syncthreads();
    if (xb_leader(b.wave)) {
        unsigned* bar = b.bar; asm volatile("" : "+s"(bar));
        __builtin_amdgcn_s_waitcnt(0);
        unsigned nloc = b.st[0], nx = b.st[1];
        if (nloc == 0u) { xcd_barrier_complete(bar, b.x, nloc, nx); b.st[0] = nloc; b.st[1] = nx; }
        const unsigned old = xb_add(&bar[XB_XSUB(b.x)], 1u);
        const unsigned gen = old / nloc;
        if (old + 1u == (gen + 1u) * nloc) {
            __builtin_amdgcn_fence(__ATOMIC_RELEASE, "agent");
            asm volatile("s_waitcnt vmcnt(0)" ::: "memory");
            const unsigned og = xb_add(&bar[XB_TOP], 1u);
            const unsigned tg = og / nx;
            if (og + 1u == (tg + 1u) * nx) xb_add(&bar[XB_TOPGEN], 1u);
            else XB_SPIN(xb_ld(&bar[XB_TOPGEN]) == tg, bar);
            __builtin_amdgcn_fence(__ATOMIC_ACQUIRE, "agent");
            xb_add(&bar[XB_XGEN(b.x)], 1u);
            asm volatile("s_waitcnt vmcnt(0)" ::: "memory");
        } else {
            XB_SPIN(xb_ld(&bar[XB_XGEN(b.x)]) == gen, bar);
            __builtin_amdgcn_fence(__ATOMIC_ACQUIRE, "agent");
            asm volatile("s_waitcnt vmcnt(0)" ::: "memory");
        }
    }
    __syncthreads();
}

struct Args { const float* in[26]; float* out; unsigned char* ws; };
struct Frame {
    LAS unsigned char* lds;
    int tid, lane, wave, G, vcu;
    const float* const* in; float* out; unsigned char* ws;
};
__device__ __forceinline__ float shx(float v, int lane, int m) { return __int_as_float(__builtin_amdgcn_ds_bpermute((lane ^ m) << 2, __float_as_int(v))); }
__device__ __forceinline__ float wave_sum(float v, int lane) {
#pragma unroll
    for (int o = 1; o < 64; o <<= 1) v += shx(v, lane, o);
    return v;
}

__device__ __forceinline__ float wave_max(float v, int lane) {
#pragma unroll
    for (int m = 32; m >= 1; m >>= 1) v = fmaxf(v, shx(v, lane, m));
    return v;
}
__device__ __forceinline__ float clamp448(float x) { return __builtin_amdgcn_fmed3f(x, -448.0f, 448.0f); }
__device__ __forceinline__ unsigned pk4_fp8(float a, float b, float c, float d) { int p = __builtin_amdgcn_cvt_pk_fp8_f32(a, b, 0, false); p = __builtin_amdgcn_cvt_pk_fp8_f32(c, d, p, true); return (unsigned)p; }
__device__ __forceinline__ void fresh(Frame& F) { const int l = lane_now(); F.lane = l; F.tid = F.wave * 64 + l; }

__device__ __forceinline__ void conv_item(const float* W, int ldw, bf16* WT, int ldd, int k0, int n0, int drow0, const float* kscale, float gscale, LAS float* scr, int lane) {
    float wv[32];
#pragma unroll
    for (int i = 0; i < 32; ++i) { const int kk = 2 * i + (lane >> 5); wv[i] = W[(size_t)(k0 + kk) * ldw + n0 + (lane & 31)]; }
#pragma unroll
    for (int i = 0; i < 32; ++i) { const int kk = 2 * i + (lane >> 5); float w = wv[i]; if (kscale) w *= kscale[k0 + kk]; scr[kk * 33 + (lane & 31)] = w * gscale; }
    LDS_WAIT(); asm volatile("" ::: "memory");
    const int c = lane & 7;
#pragma unroll
    for (int j = 0; j < 4; ++j) { const int n = (lane >> 3) + 8 * j; const LAS float* s = scr + (8 * c) * 33 + n;
        v4u o; o.x = pk2(s[0 * 33], s[1 * 33]); o.y = pk2(s[2 * 33], s[3 * 33]); o.z = pk2(s[4 * 33], s[5 * 33]); o.w = pk2(s[6 * 33], s[7 * 33]);
        *(v4u*)(WT + (size_t)(drow0 + n) * ldd + k0 + 8 * c) = o; }
    LDS_WAIT(); asm volatile("" ::: "memory");
}
__device__ __forceinline__ int conv_rowmap(int mode, int n0, int off) {
    if (mode == 0) return n0 + off;
    if (mode == 1) { if (n0 < 384) return n0; if (n0 < 640) return 512 + (n0 - 384); if (n0 < 672) return 384; return 768 + (n0 - 672); }
    return 256 * (n0 >> 7) + (n0 & 127) + off;
}
__device__ __forceinline__ void conv_matrix(Frame& F, const float* W, int K, int N, bf16* WT, int ldd, int mode, int off, const float* kscale, float gscale) {
    LAS float* scr = (LAS float*)(F.lds + RING_OFF + F.wave * 16384);
    const int gw = F.vcu * NWAVES + F.wave, NGW = F.G * NWAVES;
    const int nblk = N / 32, nitems = (K / 64) * nblk;
    for (int it = gw; it < nitems; it += NGW) { const int kb = it / nblk, nb = it % nblk; conv_item(W, N, WT, ldd, 64 * kb, 32 * nb, conv_rowmap(mode, 32 * nb, off), kscale, gscale, scr, F.lane); }
}

__device__ __forceinline__ void conv_item8(const float* W, int ldw, unsigned char* WT, int ldd, int k0, int n0, int drow0, float gscale, LAS float* scr, int lane) {
    float wv[32];
#pragma unroll
    for (int i = 0; i < 32; ++i) { const int kk = 2 * i + (lane >> 5); wv[i] = W[(size_t)(k0 + kk) * ldw + n0 + (lane & 31)]; }
#pragma unroll
    for (int i = 0; i < 32; ++i) { const int kk = 2 * i + (lane >> 5); scr[kk * 33 + (lane & 31)] = clamp448(wv[i] * gscale); }
    LDS_WAIT(); asm volatile("" ::: "memory");
    const int c = lane & 3;
#pragma unroll
    for (int j = 0; j < 2; ++j) { const int n = (lane >> 2) + 16 * j; const LAS float* s = scr + (16 * c) * 33 + n;
        v4u o; o.x = pk4_fp8(s[0 * 33], s[1 * 33], s[2 * 33], s[3 * 33]); o.y = pk4_fp8(s[4 * 33], s[5 * 33], s[6 * 33], s[7 * 33]);
        o.z = pk4_fp8(s[8 * 33], s[9 * 33], s[10 * 33], s[11 * 33]); o.w = pk4_fp8(s[12 * 33], s[13 * 33], s[14 * 33], s[15 * 33]);
        *(v4u*)(WT + (size_t)(drow0 + n) * ldd + k0 + 16 * c) = o; }
    LDS_WAIT(); asm volatile("" ::: "memory");
}
__device__ __forceinline__ void conv_matrix8(Frame& F, const float* W, int K, int N, unsigned char* WT, int ldd, int mode, int off, float gscale) {
    LAS float* scr = (LAS float*)(F.lds + RING_OFF + F.wave * 16384);
    const int gw = F.vcu * NWAVES + F.wave, NGW = F.G * NWAVES;
    const int nblk = N / 32, nitems = (K / 64) * nblk;
    for (int it = gw; it < nitems; it += NGW) { const int kb = it / nblk, nb = it % nblk; conv_item8(W, N, WT, ldd, 64 * kb, 32 * nb, conv_rowmap(mode, 32 * nb, off), gscale, scr, F.lane); }
}

__device__ __forceinline__ void ffn_weights8(Frame& F) {
    fresh(F);
    unsigned char* ws = F.ws; const float* st = (const float*)(ws + WS_WSTAT) + 96;
    conv_matrix8(F, F.in[18], DFF, DM, ws + WS_WDN, DFF, 0, 0, 1.0f / st[4]);
    for (int j = 1; j < 2; ++j) {
        conv_matrix8(F, F.in[16] + (size_t)j * DM * DFF, DM, DFF, ws + WS_WGU + (size_t)j * 2 * DFF * DM * 2, DM, 2, 0, 1.0f / st[j * 6 + 0]);
        conv_matrix8(F, F.in[17] + (size_t)j * DM * DFF, DM, DFF, ws + WS_WGU + (size_t)j * 2 * DFF * DM * 2, DM, 2, 128, 1.0f / st[j * 6 + 2]);
        conv_matrix8(F, F.in[18] + (size_t)j * DFF * DM, DFF, DM, ws + WS_WDN + (size_t)j * DM * DFF * 2, DFF, 0, 0, 1.0f / st[j * 6 + 4]);
    }
    __syncthreads();
}

constexpr int CONV_ITEMS = 24 * 1792, CONV_MIX = 10;
__device__ __forceinline__ void conv_items(Frame& F, const float* const* in, int j, int start, int stride, int n) {
    unsigned char* ws = F.ws;
    LAS float* scr = (LAS float*)(F.lds + RING_OFF + F.wave * 16384);
    const float* st = (const float*)(ws + WS_WSTAT) + j * 48;
    for (int t = 0; t < n; ++t) { const int gi = start + t * stride; if (gi >= CONV_ITEMS) break;
        const int m = gi / 1792, it = gi - m * 1792, e = m / 3, wh = m - 3 * e;
        if (wh < 2) { const int kb = it / 112, nb = it - kb * 112;
            conv_item8(in[23 + wh] + ((size_t)j * NE + e) * DM * DFE, DFE, ws + WS_MWGU + (size_t)e * 2 * DFE * DM, DM, 64 * kb, 32 * nb, conv_rowmap(2, 32 * nb, wh ? 128 : 0), 1.0f / st[e * 6 + 2 * wh], scr, F.lane); }
        else { const int kb = it >> 5, nb = it & 31;
            conv_item8(in[25] + ((size_t)j * NE + e) * DFE * DM, DM, ws + WS_MWDN + (size_t)e * DM * DFE, DFE, 64 * kb, 32 * nb, 32 * nb, 1.0f / st[e * 6 + 4], scr, F.lane); } }
}

__device__ __forceinline__ int row_bidx(int row) { return row < M ? row / SEQ : NB; }

struct RowArgs {
    const float* xin_l; const float* xin_c;
    const bf16* hb; bf16* hbo;
    float* fout;
    const float* g;
    const float* modl;
    int shoff, scoff;
    bf16* U;
    const bf16* Y; const int* pos; const float* gate; const float* modprev;
    const float* router; int* eidx; float* gout; int* cnt;
    int hid_only;
    unsigned char* U8; float* rsu; f32x4* rs; const float* st;
};
template <bool COMBINE, int OUTMODE, bool ROUTER, bool INF32, bool F8OUT = false>
__device__ __forceinline__ void row_phase(Frame& F, const RowArgs& A, int nrows) {
    fresh(F);
    const int rpw = (nrows + F.G - 1) / F.G;
    LAS int* lcnt = (LAS int*)(F.lds + RING_OFF);
    if (ROUTER) { if (F.tid < 8) lcnt[F.tid] = 0; __syncthreads(); }
    int bid = (int)blockIdx.x; asm volatile("" : "+s"(bid));
    const int rbase = bid * rpw, rend = (rbase + rpw < nrows) ? rbase + rpw : nrows;
#define ROWLOAD(dst, r_) do { if (INF32) { const float* hr_ = ((r_) < M) ? A.xin_l + (size_t)(r_) * DM : A.xin_c + (size_t)((r_) - M) * DM; \
            _Pragma("unroll") for (int j = 0; j < 4; ++j) dst[j] = *(const f32x4*)(hr_ + 4 * F.lane + 256 * j); } \
        else { _Pragma("unroll") for (int j = 0; j < 4; ++j) { const v2u w_ = *(const v2u*)(A.hb + (size_t)(r_) * DM + 4 * F.lane + 256 * j); dst[j] = (f32x4){bflo(w_.x), bfhi(w_.x), bflo(w_.y), bfhi(w_.y)}; } } } while (0)
    LAS float* LV = (LAS float*)(F.lds + RING_OFF + 1024);
    const int lb0 = ROUTER ? (rbase < M ? rbase / SEQ : NB) : 0;
    if (ROUTER) { const int lb1 = (rend - 1) < M ? (rend - 1) / SEQ : NB;
        for (int e = F.tid; e < 1024; e += 512) { LV[e] = A.g[e]; LV[1024 + e] = A.modl[lb0 * NMOD + A.shoff + e]; LV[2048 + e] = A.modl[lb0 * NMOD + A.scoff + e];
            LV[3072 + e] = A.modl[lb1 * NMOD + A.shoff + e]; LV[4096 + e] = A.modl[lb1 * NMOD + A.scoff + e]; }
        __syncthreads(); }
    f32x4 rw[16][2];
    if (ROUTER) {
#pragma unroll
        for (int j = 0; j < 4; ++j)
#pragma unroll
            for (int q = 0; q < 4; ++q) { const int col = 4 * F.lane + 256 * j + q; rw[4 * j + q][0] = *(const f32x4*)(A.router + (size_t)col * 8); rw[4 * j + q][1] = *(const f32x4*)(A.router + (size_t)col * 8 + 4); }
    }
    int row = rbase + F.wave;
    f32x4 v[4], vn[4];
    if (row < rend) ROWLOAD(v, row);
    float ga = 0.f, gb = 0.f, gan = 0.f, gbn = 0.f; int pan = 0, pbn = 0; v2u ya[4], yb[4], yan[4], ybn[4];
#define YLOAD(da, db, pa_, pb_) do { _Pragma("unroll") for (int j = 0; j < 4; ++j) { da[j] = *(const v2u*)(A.Y + (size_t)(pa_) * DM + 4 * F.lane + 256 * j); db[j] = *(const v2u*)(A.Y + (size_t)(pb_) * DM + 4 * F.lane + 256 * j); } } while (0)
    if (COMBINE) {
        if (row < rend) { const int pa = A.pos[2 * row], pb = A.pos[2 * row + 1]; ga = A.gate[2 * row]; gb = A.gate[2 * row + 1];
            if (row + NWAVES < rend) { pan = A.pos[2 * (row + NWAVES)]; pbn = A.pos[2 * (row + NWAVES) + 1]; gan = A.gate[2 * (row + NWAVES)]; gbn = A.gate[2 * (row + NWAVES) + 1]; }
            YLOAD(ya, yb, pa, pb); }
    }
    for (; row < rend; row += NWAVES) {
        const bool lat = row < M; const int bidx = lat ? row / SEQ : NB;
        const int rnext = row + NWAVES;
        if (rnext < rend) ROWLOAD(vn, rnext);
        int pnn0 = 0, pnn1 = 0; float gnn0 = 0.f, gnn1 = 0.f;
        if (COMBINE) {
            if (rnext < rend) YLOAD(yan, ybn, pan, pbn);
            const int rnn = rnext + NWAVES;
            if (rnn < rend) { pnn0 = A.pos[2 * rnn]; pnn1 = A.pos[2 * rnn + 1]; gnn0 = A.gate[2 * rnn]; gnn1 = A.gate[2 * rnn + 1]; }
        }
        f32x4 gvv[4], shv4[4], scv4[4], g2v[4];
#pragma unroll
        for (int j = 0; j < 4; ++j) { const int col = 4 * F.lane + 256 * j; if (ROUTER) continue;
            gvv[j] = *(const f32x4*)(A.g + col);
            if (OUTMODE != 2) { shv4[j] = *(const f32x4*)(A.modl + bidx * NMOD + A.shoff + col); scv4[j] = *(const f32x4*)(A.modl + bidx * NMOD + A.scoff + col); }
            if (COMBINE) g2v[j] = *(const f32x4*)(A.modprev + bidx * NMOD + 5 * DM + col); }
        if (COMBINE) {
#pragma unroll
            for (int j = 0; j < 4; ++j) { const v2u wa = ya[j], wb = yb[j]; const f32x4 gv = g2v[j];
                v[j].x += gv.x * (ga * bflo(wa.x) + gb * bflo(wb.x)); v[j].y += gv.y * (ga * bfhi(wa.x) + gb * bfhi(wb.x));
                v[j].z += gv.z * (ga * bflo(wa.y) + gb * bflo(wb.y)); v[j].w += gv.w * (ga * bfhi(wa.y) + gb * bfhi(wb.y)); }
            if (OUTMODE != 2) {
#pragma unroll
                for (int j = 0; j < 4; ++j) { v2u o; o.x = pg8::cvt_pk_bf16(v[j].x, v[j].y); o.y = pg8::cvt_pk_bf16(v[j].z, v[j].w); *(v2u*)(A.hbo + (size_t)row * DM + 4 * F.lane + 256 * j) = o;
                    v[j] = (f32x4){bflo(o.x), bfhi(o.x), bflo(o.y), bfhi(o.y)}; }
            }
        }
        float s = 0.f;
#pragma unroll
        for (int j = 0; j < 4; ++j) s += (v[j].x * v[j].x + v[j].y * v[j].y) + (v[j].z * v[j].z + v[j].w * v[j].w);
        const float rstd = rsqrtf(wave_sum(s, F.lane) * (1.0f / DM) + EPS);
        if (OUTMODE == 2) {
            float* ho = A.fout + (size_t)row * DM;
#pragma unroll
            for (int j = 0; j < 4; ++j) { const int col = 4 * F.lane + 256 * j; *(f32x4*)(ho + col) = v[j] * rstd * gvv[j]; }
        } else {
            float lg[8];
            if (ROUTER) {
#pragma unroll
                for (int e = 0; e < 8; ++e) lg[e] = 0.f;
            }
#pragma unroll
            for (int j = 0; j < 4; ++j) { const int col = 4 * F.lane + 256 * j;
                if (ROUTER) { const LAS float* lv = LV + (bidx != lb0 ? 2048 : 0); gvv[j] = *(const LAS f32x4*)(LV + col); shv4[j] = *(const LAS f32x4*)(lv + 1024 + col); scv4[j] = *(const LAS f32x4*)(lv + 2048 + col); }
                f32x4 y = v[j] * rstd * gvv[j] * (scv4[j] + 1.0f) + shv4[j];
                if (!ROUTER && !F8OUT) { v2u o; o.x = pg8::cvt_pk_bf16(y.x, y.y); o.y = pg8::cvt_pk_bf16(y.z, y.w); *(v2u*)(A.U + (size_t)row * DM + col) = o; }
                else v[j] = y;
                if (ROUTER) {
#pragma unroll
                    for (int q = 0; q < 4; ++q) { const f32x4 r0 = rw[4 * j + q][0], r1 = rw[4 * j + q][1]; const float yy = y[q];
                        lg[0] += yy * r0.x; lg[1] += yy * r0.y; lg[2] += yy * r0.z; lg[3] += yy * r0.w; lg[4] += yy * r1.x; lg[5] += yy * r1.y; lg[6] += yy * r1.z; lg[7] += yy * r1.w; } }
            }
            if (ROUTER || F8OUT) {
                float am = 0.f, ss = 0.f;
#pragma unroll
                for (int j = 0; j < 4; ++j) { am = fmaxf(fmaxf(am, fmaxf(fabsf(v[j].x), fabsf(v[j].y))), fmaxf(fabsf(v[j].z), fabsf(v[j].w))); ss += (v[j].x * v[j].x + v[j].y * v[j].y) + (v[j].z * v[j].z + v[j].w * v[j].w); }
                am = fmaxf(wave_max(am, F.lane), 1e-30f); ss = wave_sum(ss, F.lane);
                const float inv = 256.0f / am;
                if (!ROUTER && A.hid_only) {
#pragma unroll
                    for (int j = 0; j < 4; ++j) { v2u o; o.x = pg8::cvt_pk_bf16(v[j].x, v[j].y); o.y = pg8::cvt_pk_bf16(v[j].z, v[j].w); *(v2u*)(A.U + (size_t)row * DM + 4 * F.lane + 256 * j) = o; }
                    if (F.lane == 0) { const float sh = fmaxf(0.0625f * ss * A.st[1] * A.st[3], 1e-30f); A.rs[row] = (f32x4){1.0f, 1.0f, 1.0f / sh, sh * A.st[4]}; }
                } else {
#pragma unroll
                for (int j = 0; j < 4; ++j) *(unsigned*)(A.U8 + (size_t)row * DM + 4 * F.lane + 256 * j) = pk4_fp8(v[j].x * inv, v[j].y * inv, v[j].z * inv, v[j].w * inv);
                }
                if (ROUTER) { if (F.lane == 0) { A.rsu[2 * row] = am * (1.0f / 256.0f); A.rsu[2 * row + 1] = ss; } }
                else if (!A.hid_only && F.lane == 0) { const float sa = am * (1.0f / 256.0f); const float sh = fmaxf(0.0625f * ss * A.st[1] * A.st[3], 1e-30f);
                    A.rs[row] = (f32x4){sa * A.st[0], sa * A.st[2], 1.0f / sh, sh * A.st[4]}; }
            }
            if (ROUTER) {
                const int b5 = F.lane >> 5, b4 = (F.lane >> 4) & 1, b3 = (F.lane >> 3) & 1; float a4[4], c2[2];
#pragma unroll
                for (int q = 0; q < 4; ++q) { const float mine = b5 ? lg[4 + q] : lg[q], oth = b5 ? lg[q] : lg[4 + q]; a4[q] = mine + shx(oth, F.lane, 32); }
#pragma unroll
                for (int q = 0; q < 2; ++q) { const float mine = b4 ? a4[2 + q] : a4[q], oth = b4 ? a4[q] : a4[2 + q]; c2[q] = mine + shx(oth, F.lane, 16); }
                float d1 = (b3 ? c2[1] : c2[0]) + shx(b3 ? c2[0] : c2[1], F.lane, 8);
                d1 += shx(d1, F.lane, 4); d1 += shx(d1, F.lane, 2); d1 += shx(d1, F.lane, 1);
#pragma unroll
                for (int e = 0; e < 8; ++e) lg[e] = __int_as_float(__builtin_amdgcn_readlane(__float_as_int(d1), 8 * e));
                int i0 = 0; float v0 = lg[0];
#pragma unroll
                for (int e = 1; e < 8; ++e) if (lg[e] > v0) { v0 = lg[e]; i0 = e; }
                int i1 = -1; float v1 = -INFINITY;
#pragma unroll
                for (int e = 0; e < 8; ++e) if (e != i0 && lg[e] > v1) { v1 = lg[e]; i1 = e; }
                const float g0 = 1.0f / (1.0f + __expf(v1 - v0));
                if (F.lane == 0) { A.eidx[2 * row] = i0; A.eidx[2 * row + 1] = i1; A.gout[2 * row] = g0; A.gout[2 * row + 1] = 1.0f - g0; atomicAdd((int*)&lcnt[i0], 1); atomicAdd((int*)&lcnt[i1], 1); }
            }
        }
#pragma unroll
        for (int j = 0; j < 4; ++j) v[j] = vn[j];
        if (COMBINE) {
#pragma unroll
            for (int j = 0; j < 4; ++j) { ya[j] = yan[j]; yb[j] = ybn[j]; }
            ga = gan; gb = gbn; pan = pnn0; pbn = pnn1; gan = gnn0; gbn = gnn1; }
    }
#undef ROWLOAD
#undef YLOAD
    if (ROUTER) { __syncthreads(); if (F.tid < 8) A.cnt[blockIdx.x * 8 + F.tid] = lcnt[F.tid]; __syncthreads(); }
}

using pg8::Unit; using pg8::cvt_pk_bf16;
__device__ __forceinline__ v4u pack8(const f32x4& a, const f32x4& b) { v4u w; w.x = cvt_pk_bf16(a[0], a[1]); w.y = cvt_pk_bf16(a[2], a[3]); w.z = cvt_pk_bf16(b[0], b[1]); w.w = cvt_pk_bf16(b[2], b[3]); return w; }
struct EpiIn {
    static constexpr bool PERM = true;
    bf16 *CQ, *KRR, *CKV, *H5; float* ssq_q; float* ssq_kv; const float* TC; const float* LBj; int jlayer;
    __device__ __forceinline__ void operator()(const f32x4 (&acc)[2][2][4][2], const Unit& u, int wr, int wc, int fr, int fq) const {
        const int row0 = u.pm * 256 + wr * 64 + fr; const int lane = fr + 16 * fq;
#pragma unroll
        for (int bj = 0; bj < 2; ++bj) {
            const int col = u.pn * 256 + bj * 128 + wc * 32 + 8 * fq;
            bf16* base; int ld;
            if (col < 384) { base = CQ + col; ld = QL; }
            else if (col < 512) { base = nullptr; ld = 0; }
            else if (col < 768) { base = CKV + (col - 512); ld = KVL; }
            else { const int c2 = col - 768; base = H5 + (size_t)(c2 >> 9) * HSEG + (c2 & 511); ld = HW; }
            const int hsel = (col >= 768) ? ((col - 768) >> 9) : 3;
            if (hsel <= 2) {
                f32x4 lb0 = (f32x4){0.f, 0.f, 0.f, 0.f}, lb1 = lb0; if (hsel >= 1 && jlayer == 1) { const float* l0_ = LBj + (hsel - 1) * HW + ((col - 768) & 511); const float* l1_ = l0_ + 2 * HW; const f32x4 a0 = *(const f32x4*)l0_, a1 = *(const f32x4*)(l0_ + 4), b0 = *(const f32x4*)l1_, b1 = *(const f32x4*)(l1_ + 4);
#pragma unroll
                    for (int q = 0; q < 4; ++q) { lb0[q] = 1.0f / (1.0f + __expf(a0[q] - b0[q])); lb1[q] = 1.0f / (1.0f + __expf(a1[q] - b1[q])); } }
#pragma unroll
                for (int ai = 0; ai < 2; ++ai)
#pragma unroll
                    for (int m = 0; m < 4; ++m) { const int row = row0 + ai * 128 + m * 16; f32x4 o[2];
#pragma unroll
                        for (int n = 0; n < 2; ++n)
#pragma unroll
                            for (int q = 0; q < 4; ++q) { const float x = acc[ai][bj][m][n][q]; const float sg = __builtin_amdgcn_rcpf(1.0f + __expf(-x)); const float lbv = n ? lb1[q] : lb0[q];
                                o[n][q] = (hsel == 0) ? x * sg : __logf(lbv + (1.0f - lbv) * sg); }
                        *(v4u*)(base + (size_t)row * ld) = pack8(o[0], o[1]); }
            } else if (base) {
#pragma unroll
                for (int ai = 0; ai < 2; ++ai)
#pragma unroll
                    for (int m = 0; m < 4; ++m) { const int row = row0 + ai * 128 + m * 16; *(v4u*)(base + (size_t)row * ld) = pack8(acc[ai][bj][m][0], acc[ai][bj][m][1]); }
            }
        }
        if (u.pn <= 2) {
            const int nb = (u.pn == 1) ? 1 : 2; float* dst = (u.pn == 2) ? ssq_kv : ssq_q;
#pragma unroll
            for (int ai = 0; ai < 2; ++ai)
#pragma unroll
                for (int m = 0; m < 4; ++m) { float ss = 0.f;
#pragma unroll
                    for (int bj = 0; bj < 2; ++bj) if (bj < nb) {
#pragma unroll
                        for (int n = 0; n < 2; ++n) { const f32x4 x = acc[ai][bj][m][n]; ss += (x[0] * x[0] + x[1] * x[1]) + (x[2] * x[2] + x[3] * x[3]); } }
                    ss += shx(ss, lane, 16); ss += shx(ss, lane, 32);
                    if (fq == 0) { const int row = row0 + ai * 128 + m * 16; if (u.pn == 2) dst[row * 4 + wc] = ss; else dst[row * 8 + u.pn * 4 + wc] = ss; } }
            if (u.pn == 1 && wc == 0) {
                const int a = fq >> 1, half = fq & 1;
#pragma unroll
                for (int ai = 0; ai < 2; ++ai)
#pragma unroll
                    for (int m = 0; m < 4; ++m) { const int row = row0 + ai * 128 + m * 16; f32x4 o[2];
                        const bool lat = row < M; const int t = row % SEQ; const int p = a ? (t & 63) : (t >> 6);
#pragma unroll
                        for (int n = 0; n < 2; ++n)
#pragma unroll
                            for (int q = 0; q < 4; ++q) { const float x = acc[ai][1][m][n][q]; const float pr = shx(x, lane, 16); const float c = TC[p * 8 + 4 * n + q], sn = TC[512 + p * 8 + 4 * n + q];
                                o[n][q] = lat ? (half ? x * c + pr * sn : x * c - pr * sn) : x; }
                        *(v4u*)(KRR + (size_t)row * ROPE + 8 * fq) = pack8(o[0], o[1]); }
            }
        }
    }
};
struct EpiQ {
    static constexpr bool PERM = true;
    bf16* O; const float* rs;
    __device__ __forceinline__ void operator()(const f32x4 (&acc)[2][2][4][2], const Unit& u, int wr, int wc, int fr, int fq) const {
        const int row0 = u.pm * 256 + wr * 64 + fr;
#pragma unroll
        for (int ai = 0; ai < 2; ++ai)
#pragma unroll
            for (int m = 0; m < 4; ++m) { const int row = row0 + ai * 128 + m * 16; const f32x4 p0 = *(const f32x4*)(rs + (size_t)row * 8), p1 = *(const f32x4*)(rs + (size_t)row * 8 + 4); const float sc = rsqrtf((((p0.x + p0.y) + (p0.z + p0.w)) + ((p1.x + p1.y) + (p1.z + p1.w))) * (1.0f / QL) + EPS);
#pragma unroll
                for (int bj = 0; bj < 2; ++bj) { const int col = u.pn * 256 + bj * 128 + wc * 32 + 8 * fq; *(v4u*)(O + (size_t)row * 768 + col) = pack8(acc[ai][bj][m][0] * sc, acc[ai][bj][m][1] * sc); } }
    }
};
struct EpiKV {
    static constexpr bool PERM = true;
    bf16* KNp; bf16* VTp; const float* rs;
    __device__ __forceinline__ void operator()(const f32x4 (&acc)[2][2][4][2], const Unit& u, int wr, int wc, int fr, int fq) const {
        const int row0 = u.pm * 256 + wr * 64 + fr;
#pragma unroll
        for (int ai = 0; ai < 2; ++ai)
#pragma unroll
            for (int m = 0; m < 4; ++m) { const int row = row0 + ai * 128 + m * 16; const f32x4 p0 = *(const f32x4*)(rs + (size_t)row * 4); const float sc = rsqrtf(((p0.x + p0.y) + (p0.z + p0.w)) * (1.0f / KVL) + EPS);
                const bool lat = row < M; const int b = lat ? row / SEQ : (row - M) / CTXL; const int key = lat ? row % SEQ : SEQ + (row - M) % CTXL;
                const int kpos = (key & ~12) | ((key & 4) << 1) | ((key & 8) >> 1);
#pragma unroll
                for (int bj = 0; bj < 2; ++bj) { const int col = u.pn * 256 + bj * 128 + wc * 32 + 8 * fq; const int hh = col >> 7, w = col & 127;
                    if (w < 64) { *(v4u*)(KNp + (size_t)row * HW + hh * 64 + w) = pack8(acc[ai][bj][m][0] * sc, acc[ai][bj][m][1] * sc); }
                    else { bf16* dst = VTp + ((size_t)((b * NH + hh) * VD + (w - 64))) * NKEY + kpos;
#pragma unroll
                        for (int n = 0; n < 2; ++n)
#pragma unroll
                            for (int q = 0; q < 4; ++q) dst[(size_t)(4 * n + q) * NKEY] = (bf16)f2bf(acc[ai][bj][m][n][q] * sc); } } }
    }
};
template <bool INF32, bool SC = false>
struct EpiResid {
    static constexpr bool PERM = true;
    const float* xin_l; const float* xin_c; bf16* hb; const float* modl; int goff; const f32x4* RS;
    __device__ __forceinline__ void operator()(const f32x4 (&acc)[2][2][4][2], const Unit& u, int wr, int wc, int fr, int fq) const {
        const int rowt = u.pm * 256; const bool lat = rowt < M; const int bidx = lat ? rowt / SEQ : NB;
        const float* gate = modl + bidx * NMOD + goff;
        const float* xi = lat ? xin_l + (size_t)rowt * DM : xin_c + (size_t)(rowt - M) * DM;
        bf16* ho = hb + (size_t)rowt * DM;
        float scv[2][4];
        if (SC) { const float* rp = (const float*)(RS + rowt + wr * 64 + fr) + 3;
#pragma unroll
            for (int ai = 0; ai < 2; ++ai)
#pragma unroll
                for (int m = 0; m < 4; ++m) scv[ai][m] = rp[(ai * 128 + m * 16) * 4]; }
        const unsigned off0 = (unsigned)((wr * 64 + fr) * DM + u.pn * 256 + wc * 32 + 8 * fq);
#pragma unroll
        for (int bj = 0; bj < 2; ++bj) { const f32x4 g0 = *(const f32x4*)(gate + (off0 & 1023u) + bj * 128), g1 = *(const f32x4*)(gate + (off0 & 1023u) + bj * 128 + 4);
#pragma unroll
            for (int ai = 0; ai < 2; ++ai) {
                if (INF32) { f32x4 h0[4], h1[4];
#pragma unroll
                    for (int m = 0; m < 4; ++m) { const unsigned off = off0 + (unsigned)((ai * 128 + m * 16) * DM + bj * 128); h0[m] = *(const f32x4*)(xi + off); h1[m] = *(const f32x4*)(xi + off + 4); }
#pragma unroll
                    for (int m = 0; m < 4; ++m) { const unsigned off = off0 + (unsigned)((ai * 128 + m * 16) * DM + bj * 128); *(v4u*)(ho + off) = pack8(h0[m] + g0 * acc[ai][bj][m][0], h1[m] + g1 * acc[ai][bj][m][1]); }
                } else { v4u hv[4];
#pragma unroll
                    for (int m = 0; m < 4; ++m) { const unsigned off = off0 + (unsigned)((ai * 128 + m * 16) * DM + bj * 128); hv[m] = *(const v4u*)(ho + off); }
#pragma unroll
                    for (int m = 0; m < 4; ++m) { const unsigned off = off0 + (unsigned)((ai * 128 + m * 16) * DM + bj * 128); const v4u w = hv[m];
                        const f32x4 a0 = (f32x4){bflo(w.x), bfhi(w.x), bflo(w.y), bfhi(w.y)}, a1 = (f32x4){bflo(w.z), bfhi(w.z), bflo(w.w), bfhi(w.w)};
                        if (SC) *(v4u*)(ho + off) = pack8(a0 + (g0 * scv[ai][m]) * acc[ai][bj][m][0], a1 + (g1 * scv[ai][m]) * acc[ai][bj][m][1]);
                        else *(v4u*)(ho + off) = pack8(a0 + g0 * acc[ai][bj][m][0], a1 + g1 * acc[ai][bj][m][1]); }
                }
                asm volatile("" ::: "memory"); } }
    }
};
struct EpiPool {
    static constexpr bool PERM = true;
    bf16* hb; const float* modl; const float* bias; const float* scale; int talloc;
    __device__ __forceinline__ void operator()(const f32x4 (&acc)[2][2][4][2], const Unit& u, int wr, int wc, int fr, int fq) const {
        const int g = u.pn, rowt = (u.pm - g * talloc) * 256; const bool lat = rowt < M; const int bidx = lat ? rowt / SEQ : NB;
        const float* gate = modl + bidx * NMOD + 2 * DM;
        bf16* ho = hb + (size_t)rowt * DM;
        const int col0 = g * 256 + wc * 32 + 8 * fq;
#pragma unroll
        for (int bj = 0; bj < 2; ++bj) { const int c = col0 + bj * 128;
            v4u hv[2][4];
#pragma unroll
            for (int ai = 0; ai < 2; ++ai)
#pragma unroll
                for (int m = 0; m < 4; ++m) hv[ai][m] = *(const v4u*)(ho + (size_t)(ai * 128 + wr * 64 + m * 16 + fr) * DM + c);
            const f32x4 gm0 = *(const f32x4*)(gate + c) * *(const f32x4*)(scale + c), gm1 = *(const f32x4*)(gate + c + 4) * *(const f32x4*)(scale + c + 4);
            const f32x4 gb0 = gm0 * *(const f32x4*)(bias + c), gb1 = gm1 * *(const f32x4*)(bias + c + 4);
#pragma unroll
            for (int ai = 0; ai < 2; ++ai)
#pragma unroll
                for (int m = 0; m < 4; ++m) { const v4u w = hv[ai][m]; const f32x4 a0 = (f32x4){bflo(w.x), bfhi(w.x), bflo(w.y), bfhi(w.y)}, a1 = (f32x4){bflo(w.z), bfhi(w.z), bflo(w.w), bfhi(w.w)};
                    *(v4u*)(ho + (size_t)(ai * 128 + wr * 64 + m * 16 + fr) * DM + c) = pack8(a0 + gm0 * acc[ai][bj][m][0] + gb0, a1 + gm1 * acc[ai][bj][m][1] + gb1); }
            asm volatile("" ::: "memory"); }
    }
};
struct EpiGateUp {
    static constexpr bool PERM = true;
    bf16* H; int ldh, nct, rowsub;
    __device__ __forceinline__ void operator()(const f32x4 (&acc)[2][2][4][2], const Unit& u, int wr, int wc, int fr, int fq) const {
        const int row0 = u.pm * 256 + wr * 64 + fr - rowsub; const int ct = u.pn % nct; const int col = ct * 128 + wc * 32 + 8 * fq;
#pragma unroll
        for (int ai = 0; ai < 2; ++ai)
#pragma unroll
            for (int m = 0; m < 4; ++m) { const int row = row0 + ai * 128 + m * 16; f32x4 o[2];
#pragma unroll
                for (int n = 0; n < 2; ++n)
#pragma unroll
                    for (int q = 0; q < 4; q += 2) { const f32x2 ag = {acc[ai][0][m][n][q], acc[ai][0][m][n][q + 1]}, au = {acc[ai][1][m][n][q], acc[ai][1][m][n][q + 1]};
                        const f32x2 t = ag * -1.4426950408889634f; const f32x2 d = (f32x2){__builtin_amdgcn_exp2f(t.x), __builtin_amdgcn_exp2f(t.y)} + 1.0f;
                        const f32x2 p = (ag * au) * (f32x2){__builtin_amdgcn_rcpf(d.x), __builtin_amdgcn_rcpf(d.y)};
                        o[n][q] = p.x; o[n][q + 1] = p.y; }
                *(v4u*)(H + (size_t)row * ldh + col) = pack8(o[0], o[1]); }
    }
};
struct EpiGateUp8 {
    static constexpr bool PERM = true;
    unsigned char* H; int ldh, nct, rowsub; const f32x4* RS;
    __device__ __forceinline__ void operator()(const f32x4 (&acc)[2][2][4][2], const Unit& u, int wr, int wc, int fr, int fq) const {
        const int pos0 = u.pm * 256 + wr * 64 + fr; const int ct = u.pn % nct; const int col = ct * 128 + wc * 32 + 8 * fq;
        const f32x4* rp = RS + pos0; f32x4 rsv[2][4];
#pragma unroll
        for (int ai = 0; ai < 2; ++ai)
#pragma unroll
            for (int m = 0; m < 4; ++m) rsv[ai][m] = rp[ai * 128 + m * 16];
#pragma unroll
        for (int ai = 0; ai < 2; ++ai)
#pragma unroll
            for (int m = 0; m < 4; ++m) { const int pos = pos0 + ai * 128 + m * 16; const f32x4 rs = rsv[ai][m]; f32x4 o[2];
                const float c1 = -1.4426950408889634f * rs.x, c2 = rs.x * rs.y * rs.z;
#pragma unroll
                for (int n = 0; n < 2; ++n)
#pragma unroll
                    for (int q = 0; q < 4; q += 2) { const f32x2 ag = {acc[ai][0][m][n][q], acc[ai][0][m][n][q + 1]}, au = {acc[ai][1][m][n][q], acc[ai][1][m][n][q + 1]};
                        const f32x2 t = ag * c1; const f32x2 d = (f32x2){__builtin_amdgcn_exp2f(t.x), __builtin_amdgcn_exp2f(t.y)} + 1.0f;
                        const f32x2 p = ((ag * au) * c2) * (f32x2){__builtin_amdgcn_rcpf(d.x), __builtin_amdgcn_rcpf(d.y)};
                        o[n][q] = clamp448(p.x); o[n][q + 1] = clamp448(p.y); }
                v2u w; w.x = pk4_fp8(o[0][0], o[0][1], o[0][2], o[0][3]); w.y = pk4_fp8(o[1][0], o[1][1], o[1][2], o[1][3]);
                *(v2u*)(H + (size_t)(pos - rowsub) * ldh + col) = w; }
    }
};
struct EpiY8 {
    static constexpr bool PERM = true;
    bf16* Y; int nct; const f32x4* RS;
    __device__ __forceinline__ void operator()(const f32x4 (&acc)[2][2][4][2], const Unit& u, int wr, int wc, int fr, int fq) const {
        const int row0 = u.pm * 256 + wr * 64 + fr; const int ct = u.pn % nct;
        const float* rp = (const float*)(RS + row0) + 3; float scv[2][4];
#pragma unroll
        for (int ai = 0; ai < 2; ++ai)
#pragma unroll
            for (int m = 0; m < 4; ++m) scv[ai][m] = rp[(ai * 128 + m * 16) * 4];
#pragma unroll
        for (int ai = 0; ai < 2; ++ai)
#pragma unroll
            for (int m = 0; m < 4; ++m) { const int row = row0 + ai * 128 + m * 16; const float sc = scv[ai][m];
#pragma unroll
                for (int bj = 0; bj < 2; ++bj) { const int col = ct * 256 + bj * 128 + wc * 32 + 8 * fq; *(v4u*)(Y + (size_t)row * DM + col) = pack8(acc[ai][bj][m][0] * sc, acc[ai][bj][m][1] * sc); } }
    }
};
struct EpiY {
    static constexpr bool PERM = true;
    bf16* Y; int nct;
    __device__ __forceinline__ void operator()(const f32x4 (&acc)[2][2][4][2], const Unit& u, int wr, int wc, int fr, int fq) const {
        const int row0 = u.pm * 256 + wr * 64 + fr; const int ct = u.pn % nct;
#pragma unroll
        for (int ai = 0; ai < 2; ++ai)
#pragma unroll
            for (int m = 0; m < 4; ++m) { const int row = row0 + ai * 128 + m * 16;
#pragma unroll
                for (int bj = 0; bj < 2; ++bj) { const int col = ct * 256 + bj * 128 + wc * 32 + 8 * fq; *(v4u*)(Y + (size_t)row * DM + col) = pack8(acc[ai][bj][m][0], acc[ai][bj][m][1]); } }
    }
};

__device__ __forceinline__ void p0_prologue(Frame& F) {
    fresh(F);
    unsigned char* ws = F.ws;
    const float qscale = 0.10206207261596577f * 1.4426950408889634f;
    for (int j = 0; j < 2; ++j) {
        conv_matrix(F, F.in[8] + (size_t)j * DM * INW, DM, INW, (bf16*)(ws + WS_WIN) + (size_t)j * INP * DM, DM, 1, 0, nullptr, 1.f);
        conv_matrix(F, F.in[11] + (size_t)j * QL * 768, QL, 768, (bf16*)(ws + WS_WUQ) + (size_t)j * 768 * QL, QL, 0, 0, F.in[9] + j * QL, qscale);
        conv_matrix(F, F.in[12] + (size_t)j * KVL * 1024, KVL, 1024, (bf16*)(ws + WS_WUKV) + (size_t)j * 1024 * KVL, KVL, 0, 0, F.in[10] + j * KVL, 1.f);
        conv_matrix(F, F.in[15] + (size_t)j * DM * DM, DM, DM, (bf16*)(ws + WS_WOUT) + (size_t)j * DM * DM, DM, 0, 0, nullptr, 1.f);
        if (j == 0) {
            conv_matrix(F, F.in[16] + (size_t)j * DM * DFF, DM, DFF, (bf16*)(ws + WS_WGU) + (size_t)j * 2 * DFF * DM, DM, 2, 0, nullptr, 1.f);
            conv_matrix(F, F.in[17] + (size_t)j * DM * DFF, DM, DFF, (bf16*)(ws + WS_WGU) + (size_t)j * 2 * DFF * DM, DM, 2, 128, nullptr, 1.f);
        }
        for (int g = 0; g < 4; ++g)
            conv_matrix(F, F.in[19] + (size_t)(j * 4 + g) * 65536, 256, 256, (bf16*)(ws + WS_WPOOL) + (size_t)(j * 4 + g) * 65536, 256, 0, 0, nullptr, 1.f);
    }
    __syncthreads();
    if (blockIdx.x == 0 && F.tid < 8) {
        float* TC = (float*)(ws + WS_ROPE); float* TS = TC + 512;
        double th = 1.0; for (int i = 0; i < F.tid; ++i) th *= 0.31622776601683794;
        const double x2 = th * th; double s = th, c = 1.0, ts = th, tc = 1.0;
        for (int n = 1; n <= 12; ++n) { tc *= -x2 / (double)((2 * n - 1) * (2 * n)); c += tc; ts *= -x2 / (double)((2 * n) * (2 * n + 1)); s += ts; }
        double cp = 1.0, sp = 0.0;
        for (int p = 0; p < 64; ++p) { TC[p * 8 + F.tid] = (float)cp; TS[p * 8 + F.tid] = (float)sp; const double ncp = cp * c - sp * s; sp = sp * c + cp * s; cp = ncp; }
    }
    {
        LAS float* sc = (LAS float*)(F.lds + RING_OFF);
        LAS float* red = sc + 17 * 1024;
        const int nitems = 4 * (NMOD / 64);
        if ((int)blockIdx.x < nitems) {
            for (int e = F.tid; e < 17 * 1024; e += 512) { const int r = e >> 10, k = e & 1023; const float x = (r < 16) ? F.in[1][r * 1024 + k] : F.in[3][k]; sc[e] = siluf_(x); }
            __syncthreads();
            for (int it = blockIdx.x; it < nitems; it += F.G) {
                const int l = it / (NMOD / 64), c0 = (it % (NMOD / 64)) * 64;
                const float* W = F.in[4] + (size_t)l * DM * NMOD + c0 + F.lane;
                float acc[17];
#pragma unroll
                for (int r = 0; r < 17; ++r) acc[r] = 0.f;
                const int kb = F.wave * 128;
                for (int k = 0; k < 128; k += 4) {
                    const float w0 = W[(size_t)(kb + k) * NMOD], w1 = W[(size_t)(kb + k + 1) * NMOD], w2 = W[(size_t)(kb + k + 2) * NMOD], w3 = W[(size_t)(kb + k + 3) * NMOD];
#pragma unroll
                    for (int r = 0; r < 17; ++r) { const f32x4 s4 = *(const LAS f32x4*)(sc + r * 1024 + kb + k); acc[r] += s4.x * w0 + s4.y * w1 + s4.z * w2 + s4.w * w3; }
                }
#pragma unroll
                for (int r = 0; r < 17; ++r) red[(F.wave * 17 + r) * 64 + F.lane] = acc[r];
                __syncthreads();
                for (int o = F.tid; o < 17 * 64; o += 512) { const int r = o >> 6, cc = o & 63; float s = 0.f;
#pragma unroll
                    for (int w = 0; w < 8; ++w) s += red[(w * 17 + r) * 64 + cc];
                    ((float*)(ws + WS_MODV))[(size_t)(l * 17 + r) * NMOD + c0 + cc] = s + F.in[5][l * NMOD + c0 + cc]; }
                __syncthreads();
            }
        }
    }
    if ((int)blockIdx.x < 54) {
        const int mi = blockIdx.x, jj = mi / 24, r = mi % 24, e = r / 3, wh = r % 3;
        const bool dense = mi >= 48; const int dj = (mi - 48) / 3, dw = (mi - 48) % 3;
        const float* W = dense ? F.in[16 + dw] + (size_t)dj * DM * DFF : F.in[23 + wh] + ((size_t)jj * NE + e) * DM * DFE;
        const int sstep = dense ? 175 : 223;
        LAS float* red = (LAS float*)(F.lds + RING_OFF);
        __syncthreads();
        float am = 0.f, ss = 0.f;
#pragma unroll 8
        for (int i = 0; i < 32; ++i) { const float w = W[(size_t)(F.tid + 512 * i) * sstep]; am = fmaxf(am, fabsf(w)); ss += w * w; }
        am = wave_max(am, F.lane); ss = wave_sum(ss, F.lane);
        if (F.lane == 0) { red[F.wave] = am; red[8 + F.wave] = ss; }
        __syncthreads();
        if (F.tid == 0) { float a = 0.f, q = 0.f;
            for (int w = 0; w < 8; ++w) { a = fmaxf(a, red[w]); q += red[8 + w]; }
            float* ST = (float*)(ws + WS_WSTAT) + mi * 2; ST[0] = fmaxf(a, 1e-30f) * (1.0f / 64.0f); ST[1] = sqrtf(q * (1.0f / 16384.0f)); }
        __syncthreads();
    }
}

typedef short bf16x8v __attribute__((ext_vector_type(8)));
typedef float f32x16 __attribute__((ext_vector_type(16)));
__device__ __forceinline__ void attn_unit(Frame& F, int b, int h, int qrow0, bool rope_q, int t_lo, int t_hi) {
    unsigned char* ws = F.ws;
    const bf16* QB = (const bf16*)(ws + WS_QB); const bf16* KN = (const bf16*)(ws + WS_KN); const bf16* KRR = (const bf16*)(ws + WS_KRR); const bf16* VT = (const bf16*)(ws + WS_VV);
    bf16* MIX = (bf16*)(ws + WS_MIX); const float* TC = (const float*)(ws + WS_ROPE); const float* TS = TC + 512;
    const int lane = F.lane, wave = F.wave, r32 = lane & 31, hi = lane >> 5;
    LAS unsigned char* ring = F.lds + RING_OFF;
    const int qrow = qrow0 + wave * 32 + r32;
    bf16x8v qr[6];
#pragma unroll
    for (int d0 = 0; d0 < 6; ++d0) qr[d0] = *(const bf16x8v*)(QB + (size_t)qrow * 768 + h * QKD + 16 * d0 + 8 * hi);
    if (rope_q) { const int t = qrow % SEQ;
#pragma unroll
        for (int a = 0; a < 2; ++a) { const int p = a ? (t & 63) : (t >> 6); const v4u w = __builtin_bit_cast(v4u, qr[4 + a]); float x[8], y[8];
            x[0] = bflo(w.x); x[1] = bfhi(w.x); x[2] = bflo(w.y); x[3] = bfhi(w.y); x[4] = bflo(w.z); x[5] = bfhi(w.z); x[6] = bflo(w.w); x[7] = bfhi(w.w);
#pragma unroll
            for (int jj = 0; jj < 8; ++jj) { const float pr = shx(x[jj], lane, 32); const float c = TC[p * 8 + jj], sn = TS[p * 8 + jj]; y[jj] = hi ? x[jj] * c + pr * sn : x[jj] * c - pr * sn; }
            v4u o; o.x = pk2(y[0], y[1]); o.y = pk2(y[2], y[3]); o.z = pk2(y[4], y[5]); o.w = pk2(y[6], y[7]); qr[4 + a] = __builtin_bit_cast(bf16x8v, o); } }
    const int bh = b * NH + h;
    const bf16* vsrc = VT + ((size_t)(bh * VD + lane)) * NKEY + 8 * wave;
#define ATT_DMA(t, buf) do { const int t_ = (t); const int r0_ = t_ < SEQ / 64 ? b * SEQ + 64 * t_ : M + b * CTXL + 64 * (t_ - SEQ / 64); \
        LAS unsigned char* kb_ = ring + (buf) * 20480; LAS unsigned char* vb_ = kb_ + 12288; \
        __builtin_amdgcn_global_load_lds((const unsigned*)(KN + (size_t)(r0_ + lane) * HW + h * 64 + 8 * wave), (LAS unsigned*)(kb_ + wave * 1024), 16, 0, 0); \
        __builtin_amdgcn_global_load_lds((const unsigned*)(KRR + (size_t)(r0_ + lane) * ROPE + 8 * (wave & 3)), (LAS unsigned*)(kb_ + (8 + (wave & 3)) * 1024), 16, 0, 0);     \
        __builtin_amdgcn_global_load_lds((const unsigned*)(vsrc + 64 * t_), (LAS unsigned*)(vb_ + wave * 1024), 16, 0, 0); } while (0)
    f32x16 o0, o1;
#pragma unroll
    for (int r = 0; r < 16; ++r) { o0[r] = 0.f; o1[r] = 0.f; }
    constexpr float ATT_THR = 8.0f;
    float m_run = 0.f, l_run = 0.f;
    asm volatile("s_waitcnt vmcnt(0)" ::: "memory");
    ATT_DMA(t_lo, 0); if (t_lo + 1 < t_hi) ATT_DMA(t_lo + 1, 1); if (t_lo + 2 < t_hi) ATT_DMA(t_lo + 2, 2);
    for (int t = t_lo; t < t_hi; ++t) {
        const int buf = (t - t_lo) & 3; const int rem = t_hi - 1 - t;
        if (rem >= 2) asm volatile("s_waitcnt vmcnt(6)" ::: "memory"); else if (rem == 1) asm volatile("s_waitcnt vmcnt(3)" ::: "memory"); else asm volatile("s_waitcnt vmcnt(0)" ::: "memory");
        asm volatile("s_waitcnt lgkmcnt(0)" ::: "memory"); __builtin_amdgcn_s_barrier(); asm volatile("" ::: "memory");
        if (t + 3 < t_hi) ATT_DMA(t + 3, (buf + 3) & 3);
        const LAS unsigned char* kb = ring + buf * 20480 + hi * 1024 + r32 * 16; const LAS unsigned char* vb = ring + buf * 20480 + 12288 + hi * 1024 + r32 * 16;
        bf16x8v kf[12], vf[8];
#pragma unroll
        for (int d0 = 0; d0 < 6; ++d0) { kf[2 * d0] = *(const LAS bf16x8v*)(kb + d0 * 2048); kf[2 * d0 + 1] = *(const LAS bf16x8v*)(kb + d0 * 2048 + 512); }
#pragma unroll
        for (int s4 = 0; s4 < 4; ++s4) { vf[2 * s4] = *(const LAS bf16x8v*)(vb + s4 * 2048); vf[2 * s4 + 1] = *(const LAS bf16x8v*)(vb + s4 * 2048 + 512); }
        f32x16 p0, p1; const float negm = -m_run;
#pragma unroll
        for (int r = 0; r < 16; ++r) { p0[r] = negm; p1[r] = negm; }
#pragma unroll
        for (int d0 = 0; d0 < 6; ++d0) { p0 = __builtin_amdgcn_mfma_f32_32x32x16_bf16(kf[2 * d0], qr[d0], p0, 0, 0, 0); p1 = __builtin_amdgcn_mfma_f32_32x32x16_bf16(kf[2 * d0 + 1], qr[d0], p1, 0, 0, 0); }
        float ma = __builtin_fmaxf(__builtin_fmaxf(p0[0], p0[1]), p1[0]), mb = __builtin_fmaxf(__builtin_fmaxf(p0[2], p0[3]), p1[1]); ma = __builtin_fmaxf(__builtin_fmaxf(ma, p1[2]), p1[3]);
#pragma unroll
        for (int r = 4; r < 16; r += 4) { ma = __builtin_fmaxf(__builtin_fmaxf(ma, p0[r]), p0[r + 1]); mb = __builtin_fmaxf(__builtin_fmaxf(mb, p0[r + 2]), p0[r + 3]); ma = __builtin_fmaxf(__builtin_fmaxf(ma, p1[r]), p1[r + 1]); mb = __builtin_fmaxf(__builtin_fmaxf(mb, p1[r + 2]), p1[r + 3]); }
        float mt = __builtin_fmaxf(ma, mb);
        { auto rr = __builtin_amdgcn_permlane32_swap(__float_as_uint(mt), __float_as_uint(mt), false, false); mt = __builtin_fmaxf(__uint_as_float(rr[0]), __uint_as_float(rr[1])); }
        const bool first = (t == t_lo);
        if (first || __any(mt > ATT_THR)) {
            const float dl = first ? mt : __builtin_fmaxf(mt, 0.f); m_run += dl; const float alpha = __builtin_amdgcn_exp2f(-dl); l_run *= alpha;
#pragma unroll
            for (int r = 0; r < 16; ++r) { p0[r] -= dl; p1[r] -= dl; o0[r] *= alpha; o1[r] *= alpha; }
        }
        float ps0 = 0.f, ps1 = 0.f;
#pragma unroll
        for (int r = 0; r < 16; ++r) { p0[r] = __builtin_amdgcn_exp2f(p0[r]); p1[r] = __builtin_amdgcn_exp2f(p1[r]); ps0 += p0[r]; ps1 += p1[r]; }
        l_run += ps0 + ps1;
        v4u pw[4];
#pragma unroll
        for (int q = 0; q < 4; ++q) { pw[0][q] = cvt_pk_bf16(p0[2 * q], p0[2 * q + 1]); pw[1][q] = cvt_pk_bf16(p0[8 + 2 * q], p0[8 + 2 * q + 1]); pw[2][q] = cvt_pk_bf16(p1[2 * q], p1[2 * q + 1]); pw[3][q] = cvt_pk_bf16(p1[8 + 2 * q], p1[8 + 2 * q + 1]); }
#pragma unroll
        for (int s4 = 0; s4 < 4; ++s4) { const bf16x8v pa = __builtin_bit_cast(bf16x8v, pw[s4]);
            o0 = __builtin_amdgcn_mfma_f32_32x32x16_bf16(vf[2 * s4], pa, o0, 0, 0, 0); o1 = __builtin_amdgcn_mfma_f32_32x32x16_bf16(vf[2 * s4 + 1], pa, o1, 0, 0, 0); }
    }
    { auto rr = __builtin_amdgcn_permlane32_swap(__float_as_uint(l_run), __float_as_uint(l_run), false, false); l_run = __uint_as_float(rr[0]) + __uint_as_float(rr[1]); }
    const float rl = 1.0f / l_run;
    bf16* orow = MIX + (size_t)qrow * DM + h * VD;
#pragma unroll
    for (int g = 0; g < 4; ++g) { v2u a, c2; a.x = pk2(o0[4 * g] * rl, o0[4 * g + 1] * rl); a.y = pk2(o0[4 * g + 2] * rl, o0[4 * g + 3] * rl); c2.x = pk2(o1[4 * g] * rl, o1[4 * g + 1] * rl); c2.y = pk2(o1[4 * g + 2] * rl, o1[4 * g + 3] * rl);
        *(v2u*)(orow + 8 * g + 4 * hi) = a; *(v2u*)(orow + 32 + 8 * g + 4 * hi) = c2; }
    asm volatile("s_waitcnt vmcnt(0) lgkmcnt(0)" ::: "memory"); __builtin_amdgcn_s_barrier(); asm volatile("" ::: "memory");
#undef ATT_DMA
}
__device__ __forceinline__ void hgrn_item(Frame& F, int j, int it);
__device__ __forceinline__ void mix_phase(Frame& F, int j, bool ctx_out) {
    fresh(F);
    const int npair = F.G >> 1;
    for (int P = F.vcu >> 1; P < NB * NH; P += npair) {
        const int b = P >> 3, h = P & 7;
        if ((F.vcu & 1) == 0) {
            hgrn_item(F, j, P);
            for (int qb = 6; qb < 8; ++qb) attn_unit(F, b, h, b * SEQ + qb * 256, true, 0, NKEY / 64);
            if (ctx_out) attn_unit(F, b, h, M + b * CTXL, false, SEQ / 64, NKEY / 64);
            if (npair >= NB * NH) { fresh(F); conv_items(F, F.in, j, (P * NWAVES + F.wave) * CONV_MIX, 1, CONV_MIX); }
        } else {
            for (int qb = 0; qb < 6; ++qb) attn_unit(F, b, h, b * SEQ + qb * 256, true, 0, NKEY / 64);
        }
    }
    __syncthreads();
}

__device__ __forceinline__ int hgrn_row(int b, int dir, int ig) { return (ig < CTXL) ? (M + b * CTXL + (dir ? CTXL - 1 - ig : ig)) : (b * SEQ + (dir ? SEQ - 1 - (ig - CTXL) : (ig - CTXL))); }
__device__ __forceinline__ void hgrn_item(Frame& F, int j, int it) {
    unsigned char* ws = F.ws;
    const bf16* HQ = (const bf16*)(ws + WS_HQ); const bf16* HFF = HQ + HSEG; const bf16* HFB = HQ + 2 * HSEG; const bf16* HI = HQ + 3 * HSEG;
    LAS unsigned char* ring = F.lds + RING_OFF;
    LAS unsigned char* QN = ring; LAS unsigned char* KN = ring + 17408; LAS unsigned char* KT = ring + 34816; LAS unsigned char* VT = ring + 53248; LAS unsigned char* ST = ring + 71680;
    LAS float* TOT = (LAS float*)(ring + 106496); LAS unsigned char* RQ = ring + 108544; LAS unsigned char* RF = ring + 124928; LAS float* EW = (LAS float*)(ring + 141312);
    const int lane0 = F.lane, wave = F.wave;
    const int part = wave >> 1;
    const int kb = wave >> 1, vb0 = 2 * (wave & 1);
    const int ib = wave >> 2, vbo = wave & 3;
    const int dir = it & 1, hh = (it >> 1) & 3, b = it >> 3;
    const bf16* HF = dir ? HFB : HFF; bf16* OO = (bf16*)(ws + (dir ? WS_OB : WS_OF));
    f32x16 S0, S1;
#pragma unroll
    for (int r = 0; r < 16; ++r) { S0[r] = 0.f; S1[r] = 0.f; }
#define LBAR() do { asm volatile("s_waitcnt lgkmcnt(0)" ::: "memory"); __builtin_amdgcn_s_barrier(); asm volatile("" ::: "memory"); } while (0)
#define HG_BASE(c_) ((c_) < CTXL / 64 ? M + b * CTXL + (dir ? CTXL - 64 - 64 * (c_) : 64 * (c_)) : b * SEQ + (dir ? SEQ - 64 - 64 * ((c_) - CTXL / 64) : 64 * ((c_) - CTXL / 64)))
#define HG_DMA(c_) do { const int rb_ = HG_BASE(c_); \
        _Pragma("unroll") for (int p_ = 0; p_ < 2; ++p_) { const int pc_ = wave * 2 + p_; const size_t go_ = (size_t)(rb_ + 4 * pc_ + (lane >> 4)) * HW + hh * HK + 8 * (lane & 15); \
            __builtin_amdgcn_global_load_lds((const unsigned*)(HQ + go_), (LAS unsigned*)(RQ + pc_ * 1024), 16, 0, 0); __builtin_amdgcn_global_load_lds((const unsigned*)(HF + go_), (LAS unsigned*)(RF + pc_ * 1024), 16, 0, 0); } } while (0)
#define HG_VLD(c_) do { const size_t go_ = (size_t)(HG_BASE(c_) + (dir ? 63 - lane : lane)) * HW + hh * HK + 16 * wave; rv0 = *(const v4u*)(HI + go_); rv1 = *(const v4u*)(HI + go_ + 8); } while (0)
    v4u rv0, rv1;
    { const int lane = lane0; HG_DMA(0); HG_VLD(0); }
    asm volatile("s_waitcnt vmcnt(0)" ::: "memory"); LBAR();
    for (int ch = 0; ch < NKEY / 64; ++ch) {
        int lane_ = lane0; asm volatile("" : "+v"(lane_));
        const int lane = lane_, r32 = lane & 31, hi = lane >> 5, k = (wave & 1) * 64 + lane;
        const int pos = (lane & ~12) | ((lane & 4) << 1) | ((lane & 8) >> 1);
        float qv[16], kin[16], pf[16]; float run = 0.f, prod = 1.f;
#pragma unroll
        for (int ii = 0; ii < 16; ++ii) { const int i = 16 * part + ii, mr = dir ? 63 - i : i; qv[ii] = bf2f(*(const LAS bf16*)(RQ + mr * 256 + k * 2)); const float a = bf2f(*(const LAS bf16*)(RF + mr * 256 + k * 2));
            const float f = __expf(a); kin[ii] = 1.0f - f; prod *= f; pf[ii] = prod; run += a; }
        TOT[part * 128 + k] = run;
        { LAS bf16* vt = (LAS bf16*)(VT + (16 * wave) * 144 + pos * 2);
          vt[0 * 72] = (bf16)(rv0.x & 0xffffu); vt[1 * 72] = (bf16)(rv0.x >> 16); vt[2 * 72] = (bf16)(rv0.y & 0xffffu); vt[3 * 72] = (bf16)(rv0.y >> 16);
          vt[4 * 72] = (bf16)(rv0.z & 0xffffu); vt[5 * 72] = (bf16)(rv0.z >> 16); vt[6 * 72] = (bf16)(rv0.w & 0xffffu); vt[7 * 72] = (bf16)(rv0.w >> 16);
          vt[8 * 72] = (bf16)(rv1.x & 0xffffu); vt[9 * 72] = (bf16)(rv1.x >> 16); vt[10 * 72] = (bf16)(rv1.y & 0xffffu); vt[11 * 72] = (bf16)(rv1.y >> 16);
          vt[12 * 72] = (bf16)(rv1.z & 0xffffu); vt[13 * 72] = (bf16)(rv1.z >> 16); vt[14 * 72] = (bf16)(rv1.w & 0xffffu); vt[15 * 72] = (bf16)(rv1.w >> 16); }
        LBAR();
        if (ch + 1 < NKEY / 64) { HG_DMA(ch + 1); HG_VLD(ch + 1); }
        { const float t0 = TOT[k], t1 = TOT[128 + k], t2 = TOT[256 + k];
          const float base = (part > 0 ? t0 : 0.f) + (part > 1 ? t1 : 0.f) + (part > 2 ? t2 : 0.f); const float rr = t0 + t1;
          unsigned kt[8];
          const float E0 = __expf(fminf(base - rr, 80.f));
#pragma unroll
          for (int ii = 0; ii < 16; ii += 2) { const float e0 = E0 * pf[ii], e1 = E0 * pf[ii + 1]; const float q0 = qv[ii] * e0, q1 = qv[ii + 1] * e1, k0 = kin[ii] * __builtin_amdgcn_rcpf(e0), k1 = kin[ii + 1] * __builtin_amdgcn_rcpf(e1);
              const unsigned qp = cvt_pk_bf16(q0, q1), kp = cvt_pk_bf16(k0, k1);
              *(LAS bf16*)(QN + (16 * part + ii) * 272 + k * 2) = (bf16)(qp & 0xffffu); *(LAS bf16*)(QN + (16 * part + ii + 1) * 272 + k * 2) = (bf16)(qp >> 16);
              *(LAS bf16*)(KN + (16 * part + ii) * 272 + k * 2) = (bf16)(kp & 0xffffu); *(LAS bf16*)(KN + (16 * part + ii + 1) * 272 + k * 2) = (bf16)(kp >> 16);
              kt[ii >> 1] = kp; }
          *(LAS v4u*)(KT + k * 144 + part * 32) = (v4u){kt[0], kt[1], kt[4], kt[5]}; *(LAS v4u*)(KT + k * 144 + part * 32 + 16) = (v4u){kt[2], kt[3], kt[6], kt[7]}; }
        { const int kx = kb * 32 + r32; const float v_ = hi ? (TOT[256 + kx] + TOT[384 + kx]) : (TOT[kx] + TOT[128 + kx]); EW[wave * 64 + lane] = __expf(v_); asm volatile("s_waitcnt lgkmcnt(0)" ::: "memory"); }
        f32x16 T0, T1;
#pragma unroll
        for (int g4 = 0; g4 < 4; ++g4) { const int kk = kb * 32 + 8 * g4 + 4 * hi; const f32x4 er = *(const LAS f32x4*)(EW + wave * 64 + 8 * g4 + 4 * hi);
            T0[4 * g4] = S0[4 * g4] * er.x; T0[4 * g4 + 1] = S0[4 * g4 + 1] * er.y; T0[4 * g4 + 2] = S0[4 * g4 + 2] * er.z; T0[4 * g4 + 3] = S0[4 * g4 + 3] * er.w;
            T1[4 * g4] = S1[4 * g4] * er.x; T1[4 * g4 + 1] = S1[4 * g4 + 1] * er.y; T1[4 * g4 + 2] = S1[4 * g4 + 2] * er.z; T1[4 * g4 + 3] = S1[4 * g4 + 3] * er.w;
            v2u o; o.x = cvt_pk_bf16(T0[4 * g4], T0[4 * g4 + 1]); o.y = cvt_pk_bf16(T0[4 * g4 + 2], T0[4 * g4 + 3]); *(LAS v2u*)(ST + (vb0 * 32 + r32) * 272 + kk * 2) = o;
            o.x = cvt_pk_bf16(T1[4 * g4], T1[4 * g4 + 1]); o.y = cvt_pk_bf16(T1[4 * g4 + 2], T1[4 * g4 + 3]); *(LAS v2u*)(ST + (vb0 * 32 + 32 + r32) * 272 + kk * 2) = o; }
        LBAR();
#pragma unroll
        for (int st = 0; st < 4; ++st) { const bf16x8v kf = *(const LAS bf16x8v*)(KT + (kb * 32 + r32) * 144 + st * 32 + hi * 16);
            const bf16x8v va = *(const LAS bf16x8v*)(VT + (vb0 * 32 + r32) * 144 + st * 32 + hi * 16), vc = *(const LAS bf16x8v*)(VT + (vb0 * 32 + 32 + r32) * 144 + st * 32 + hi * 16);
            T0 = __builtin_amdgcn_mfma_f32_32x32x16_bf16(kf, va, T0, 0, 0, 0); T1 = __builtin_amdgcn_mfma_f32_32x32x16_bf16(kf, vc, T1, 0, 0, 0); }
#pragma unroll
        for (int g4 = 0; g4 < 4; ++g4) { const f32x4 eg = *(const LAS f32x4*)(EW + wave * 64 + 32 + 8 * g4 + 4 * hi);
            S0[4 * g4] = T0[4 * g4] * eg.x; S0[4 * g4 + 1] = T0[4 * g4 + 1] * eg.y; S0[4 * g4 + 2] = T0[4 * g4 + 2] * eg.z; S0[4 * g4 + 3] = T0[4 * g4 + 3] * eg.w;
            S1[4 * g4] = T1[4 * g4] * eg.x; S1[4 * g4 + 1] = T1[4 * g4 + 1] * eg.y; S1[4 * g4 + 2] = T1[4 * g4 + 2] * eg.z; S1[4 * g4 + 3] = T1[4 * g4 + 3] * eg.w; }
        asm volatile("" ::: "memory");
        {
            bf16x8v qf[8];
#pragma unroll
            for (int ks = 0; ks < 8; ++ks) qf[ks] = *(const LAS bf16x8v*)(QN + (ib * 32 + r32) * 272 + ks * 32 + hi * 16);
            asm volatile("" ::: "memory");
            f32x16 O;
#pragma unroll
            for (int r = 0; r < 16; ++r) O[r] = 0.f;
#pragma unroll
            for (int ks = 0; ks < 8; ++ks) { const bf16x8v sf = *(const LAS bf16x8v*)(ST + (vbo * 32 + r32) * 272 + ks * 32 + hi * 16); O = __builtin_amdgcn_mfma_f32_32x32x16_bf16(qf[ks], sf, O, 0, 0, 0); }
            asm volatile("" ::: "memory");
#pragma unroll 1
            for (int sb = 0; sb <= ib; ++sb) {
                f32x16 X;
#pragma unroll
                for (int r = 0; r < 16; ++r) X[r] = 0.f;
#pragma unroll
                for (int ks = 0; ks < 8; ++ks) { const bf16x8v kf = *(const LAS bf16x8v*)(KN + (sb * 32 + r32) * 272 + ks * 32 + hi * 16); X = __builtin_amdgcn_mfma_f32_32x32x16_bf16(kf, qf[ks], X, 0, 0, 0); }
                if (sb == ib) {
#pragma unroll
                    for (int r = 0; r < 16; ++r) { const int srow = (r & 3) + 8 * (r >> 2) + 4 * hi; if (srow > r32) X[r] = 0.f; }
                }
                asm volatile("" ::: "memory");
#pragma unroll
                for (int st = 0; st < 2; ++st) { v4u pw;
#pragma unroll
                    for (int q = 0; q < 4; ++q) pw[q] = cvt_pk_bf16(X[8 * st + 2 * q], X[8 * st + 2 * q + 1]);
                    const bf16x8v vf = *(const LAS bf16x8v*)(VT + (vbo * 32 + r32) * 144 + (sb * 32 + st * 16) * 2 + hi * 16);
                    O = __builtin_amdgcn_mfma_f32_32x32x16_bf16(__builtin_bit_cast(bf16x8v, pw), vf, O, 0, 0, 0); }
                asm volatile("" ::: "memory");
            }
            asm volatile("s_waitcnt vmcnt(0)" ::: "memory");
            const int rb = HG_BASE(ch); bf16* op = OO + (size_t)rb * HW + hh * HK + vbo * 32 + r32;
#pragma unroll
            for (int r = 0; r < 16; ++r) { const int i = ib * 32 + (r & 3) + 8 * (r >> 2) + 4 * hi; op[(size_t)(dir ? 63 - i : i) * HW] = (bf16)f2bf(O[r]); }
        }
        LBAR();
    }
    asm volatile("s_waitcnt vmcnt(0)" ::: "memory");
#undef LBAR
#undef HG_DMA
#undef HG_VLD
#undef HG_BASE
}

__device__ __forceinline__ void e8_phase(Frame& F, int j, int nrows) {
    fresh(F);
    unsigned char* ws = F.ws;
    const bf16* OF = (const bf16*)(ws + WS_OF); const bf16* OB = (const bf16*)(ws + WS_OB); const bf16* HG = (const bf16*)(ws + WS_HQ) + 4 * HSEG; bf16* MIX = (bf16*)(ws + WS_MIX);
    const float* gn = F.in[14] + j * HK;
    const int rpw = (nrows + F.G - 1) / F.G, rbase = (int)blockIdx.x * rpw, rend = (rbase + rpw < nrows) ? rbase + rpw : nrows;
    const int col = 8 * F.lane, vv = col & 127; const f32x4 g0 = *(const f32x4*)(gn + vv), g1 = *(const f32x4*)(gn + vv + 4);
    for (int r0 = rbase + F.wave; r0 < rend; r0 += 2 * NWAVES) {
        f32x4 a0[2], a1[2], b0[2], b1[2]; v4u hg[2];
#pragma unroll
        for (int q = 0; q < 2; ++q) { const int row = r0 + q * NWAVES; if (row < rend) {
            { const v4u wa = *(const v4u*)(OF + (size_t)row * HW + col), wb = *(const v4u*)(OB + (size_t)row * HW + col);
              a0[q] = (f32x4){bflo(wa.x), bfhi(wa.x), bflo(wa.y), bfhi(wa.y)}; a1[q] = (f32x4){bflo(wa.z), bfhi(wa.z), bflo(wa.w), bfhi(wa.w)};
              b0[q] = (f32x4){bflo(wb.x), bfhi(wb.x), bflo(wb.y), bfhi(wb.y)}; b1[q] = (f32x4){bflo(wb.z), bfhi(wb.z), bflo(wb.w), bfhi(wb.w)}; }
            hg[q] = *(const v4u*)(HG + (size_t)row * HW + col); } }
#pragma unroll
        for (int q = 0; q < 2; ++q) { const int row = r0 + q * NWAVES; if (row < rend) {
            f32x4 x0 = a0[q] + b0[q], x1 = a1[q] + b1[q];
            float s = (x0.x * x0.x + x0.y * x0.y) + (x0.z * x0.z + x0.w * x0.w) + (x1.x * x1.x + x1.y * x1.y) + (x1.z * x1.z + x1.w * x1.w);
            s += shx(s, F.lane, 1); s += shx(s, F.lane, 2); s += shx(s, F.lane, 4); s += shx(s, F.lane, 8);
            const float rstd = rsqrtf(s * (1.0f / HK) + EPS);
            x0 = x0 * rstd * g0; x1 = x1 * rstd * g1; const v4u h = hg[q];
            v4u o; o.x = pg8::cvt_pk_bf16(x0.x * siluf_(bflo(h.x)), x0.y * siluf_(bfhi(h.x))); o.y = pg8::cvt_pk_bf16(x0.z * siluf_(bflo(h.y)), x0.w * siluf_(bfhi(h.y)));
            o.z = pg8::cvt_pk_bf16(x1.x * siluf_(bflo(h.z)), x1.y * siluf_(bfhi(h.z))); o.w = pg8::cvt_pk_bf16(x1.z * siluf_(bflo(h.w)), x1.w * siluf_(bfhi(h.w)));
            *(v4u*)(MIX + (size_t)row * DM + HW + col) = o; } }
    }
}

__device__ __forceinline__ void o12_phase(Frame& F, int nrows, const bf16* hb, const float* gn, const float* modl) {
    fresh(F);
    bf16* P = (bf16*)(F.ws + WS_POOLED);
    LAS unsigned char* XN = F.lds + RING_OFF;
    const int rpw = (nrows + F.G - 1) / F.G, rbase = (int)blockIdx.x * rpw, rend = (rbase + rpw < nrows) ? rbase + rpw : nrows;
    for (int r0 = rbase; r0 < rend; r0 += 32) {
        for (int sl = F.wave; sl < 48; sl += NWAVES) {
            const int row = r0 - 8 + sl; if (row < 0 || row >= nrows) continue;
            f32x4 v[4]; float s = 0.f;
#pragma unroll
            for (int j = 0; j < 4; ++j) { const v2u w = *(const v2u*)(hb + (size_t)row * DM + 4 * F.lane + 256 * j); v[j] = (f32x4){bflo(w.x), bfhi(w.x), bflo(w.y), bfhi(w.y)}; s += (v[j].x * v[j].x + v[j].y * v[j].y) + (v[j].z * v[j].z + v[j].w * v[j].w); }
            const float rstd = rsqrtf(wave_sum(s, F.lane) * (1.0f / DM) + EPS);
#pragma unroll
            for (int j = 0; j < 4; ++j) { v2u o; o.x = pg8::cvt_pk_bf16(v[j].x * rstd, v[j].y * rstd); o.y = pg8::cvt_pk_bf16(v[j].z * rstd, v[j].w * rstd); *(LAS v2u*)(XN + sl * 2048 + (4 * F.lane + 256 * j) * 2) = o; }
        }
        __syncthreads();
#pragma unroll 1
        for (int q = 0; q < 4; ++q) {
            const int t = r0 + F.wave * 4 + q; if (t >= rend) break;
            const bool lat = t < M; const int T = lat ? SEQ : CTXL; const int tt = lat ? t % SEQ : (t - M) % CTXL; const int bidx = lat ? t / SEQ : NB;
            const int sc0 = t - r0 + 8;
            const float* scp = modl + bidx * NMOD + DM;
#pragma unroll
            for (int g = 0; g < 4; ++g) {
                const int hw = 1 << g, col = 256 * g + 4 * F.lane;
                float s0 = 0.f, s1 = 0.f, s2 = 0.f, s3 = 0.f; int cnt = 0;
#pragma unroll
                for (int d = -hw; d < hw; ++d) { const bool ok = (tt + d >= 0) && (tt + d < T); const v2u x = *(const LAS v2u*)(XN + (sc0 + d) * 2048 + col * 2);
                    s0 += ok ? bflo(x.x) : 0.f; s1 += ok ? bfhi(x.x) : 0.f; s2 += ok ? bflo(x.y) : 0.f; s3 += ok ? bfhi(x.y) : 0.f; cnt += ok ? 1 : 0; }
                const v2u xc = *(const LAS v2u*)(XN + sc0 * 2048 + col * 2); const float ic = 1.0f / (float)cnt;
                const f32x4 gv = *(const f32x4*)(gn + col), sv = *(const f32x4*)(scp + col);
                v2u o; o.x = pg8::cvt_pk_bf16(gv.x * (sv.x + 1.0f) * (s0 * ic - bflo(xc.x)), gv.y * (sv.y + 1.0f) * (s1 * ic - bfhi(xc.x)));
                o.y = pg8::cvt_pk_bf16(gv.z * (sv.z + 1.0f) * (s2 * ic - bflo(xc.y)), gv.w * (sv.w + 1.0f) * (s3 * ic - bfhi(xc.y)));
                *(v2u*)(P + ((size_t)g * MT + t) * 256 + 4 * F.lane) = o;
            }
        }
        __syncthreads();
    }
}

__device__ __forceinline__ void o5_phase(Frame& F, int nrows, int j) {
    fresh(F);
    unsigned char* ws = F.ws;
    const int* CNT = (const int*)(ws + WS_CNT); int* TST = (int*)(ws + WS_TST); const int* EIDX = (const int*)(ws + WS_EIDX); int* POS = (int*)(ws + WS_POS);
    int* IDX = (int*)(ws + WS_IDX); f32x4* RS = (f32x4*)(ws + WS_RS); const float* RSU = (const float*)(ws + WS_RSU); const float* ST = (const float*)(ws + WS_WSTAT) + j * 48;
    LAS int* lc = (LAS int*)(F.lds + RING_OFF);
    LAS int* lbase = lc + 512 * 8;
    const int rpw = (nrows + F.G - 1) / F.G;
    for (int e = F.tid; e < F.G * 8; e += 512) lc[e] = CNT[e];
    __syncthreads();
    {
        const int e = F.wave; int c4[4]; int sum = 0;
#pragma unroll
        for (int q = 0; q < 4; ++q) { const int w = 4 * F.lane + q; c4[q] = (w < F.G) ? lc[w * 8 + e] : 0; sum += c4[q]; }
        int incl = sum;
#pragma unroll
        for (int o = 1; o < 64; o <<= 1) { const int t = __builtin_amdgcn_ds_bpermute((F.lane >= o ? F.lane - o : F.lane) << 2, incl); if (F.lane >= o) incl += t; }
        const int total = __builtin_amdgcn_readlane(incl, 63); int excl = incl - sum;
        const int myq = (int)blockIdx.x & 3; int pre = excl;
#pragma unroll
        for (int q = 0; q < 3; ++q) if (q < myq) pre += c4[q];
        if (F.lane == ((int)blockIdx.x >> 2)) { lbase[e] = pre; lbase[8 + e] = total; }
    }
    __syncthreads();
    if (F.tid == 0) {
        int ts = 0;
        for (int e = 0; e < 8; ++e) { const int pre = lbase[e], tot = lbase[8 + e]; lbase[e] = ts * 256 + pre; lbase[16 + e] = ts * 256; if (blockIdx.x == 0) TST[e] = ts; ts += (tot + 255) >> 8; }
        if (blockIdx.x == 0) TST[8] = ts;
    }
    __syncthreads();
    if (F.wave == 0) {
        int run[8];
#pragma unroll
        for (int e = 0; e < 8; ++e) run[e] = lbase[e];
        const int npairs = 2 * rpw;
        for (int c0 = 0; c0 < npairs; c0 += 64) {
            const int pl = c0 + F.lane; const int row = (int)blockIdx.x * rpw + (pl >> 1); const bool ok = pl < npairs && row < nrows;
            const int e = ok ? EIDX[2 * row + (pl & 1)] : -1; int mypos = 0;
#pragma unroll
            for (int x = 0; x < 8; ++x) { const unsigned long long mk = __ballot(e == x); const int below = __popcll(mk & ((1ull << F.lane) - 1ull)); if (e == x) mypos = run[x] + below; run[x] += __popcll(mk); }
            if (ok) { POS[2 * row + (pl & 1)] = mypos; IDX[mypos] = row;
                const float sa = RSU[2 * row], n2 = RSU[2 * row + 1]; const float* se = ST + e * 6;
                const float sh = fmaxf(0.0625f * n2 * se[1] * se[3], 1e-30f);
                RS[mypos] = (f32x4){sa * se[0], sa * se[2], 1.0f / sh, sh * se[4]}; }
        }
    }
    if ((int)blockIdx.x < 8) { const int e = blockIdx.x; const int tot = lbase[8 + e]; const int p0 = lbase[16 + e] + tot, p1 = lbase[16 + e] + ((tot + 255) & ~255);
        for (int p = p0 + F.tid; p < p1; p += 512) { IDX[p] = 0; RS[p] = (f32x4){0.f, 0.f, 0.f, 0.f}; } }
    __syncthreads();
}

__global__ void __launch_bounds__(NWAVES * 64, 2) mega_fwd(Args args) {
    extern __shared__ __attribute__((aligned(16))) unsigned char lds[];
    Frame F;
    F.lds = (LAS unsigned char*)lds;
    F.wave = __builtin_amdgcn_readfirstlane((int)threadIdx.x >> 6); fresh(F);
    F.G = gridDim.x; { const int bx = blockIdx.x; F.vcu = (F.G % 8 == 0) ? (bx % 8) * (F.G / 8) + bx / 8 : bx; }
    F.in = args.in; F.out = args.out; F.ws = args.ws;
    unsigned char* ws = args.ws;
    volatile LAS unsigned* MISC = (volatile LAS unsigned*)(F.lds + MISC_OFF);
    for (int u = F.tid; u < (LDS_BYTES - LDSCTL_OFF) / 4; u += NWAVES * 64) ((LAS unsigned*)(F.lds + LDSCTL_OFF))[u] = 0u;
    __syncthreads();
    XcdBarrier bar = xcd_barrier_post((unsigned*)(ws + WS_CTL) + CW_BAR, MISC + 8, F.wave);
#define GRID_BAR() do { xcd_barrier(bar); if (DUPMASK & 4096) xcd_barrier(bar); } while (0)
#ifndef ONLY
#define ONLY 0
#endif
#define PH(n) (ONLY == 0 || ONLY == (n))
#define REP(bit) for (int rep_ = 0; rep_ < ((DUPMASK & (bit)) ? 2 : 1); ++rep_)
    LAS unsigned char* ring = F.lds + RING_OFF;
    const float* MODV = (const float*)(ws + WS_MODV);
    bf16* HB = (bf16*)(ws + WS_HB);
    bf16* U = (bf16*)(ws + WS_U);

#if PH(20)
    REP(8192) p0_prologue(F);
#endif
    GRID_BAR();

    for (int lp = 0; lp < 2; ++lp) {
        const int le = 2 * lp, lo = 2 * lp + 1, j = lp;
        const bool ctx_out = (lp == 0);
        const int nro = ctx_out ? MT : M;
        const float* modE = MODV + (size_t)le * 17 * NMOD; const float* modO = MODV + (size_t)lo * 17 * NMOD;
#if PH(1)
        {
            RowArgs A{}; A.xin_l = args.in[0]; A.xin_c = args.in[2]; A.hb = HB; A.hbo = HB; A.g = args.in[6] + (size_t)(le * 2 + 0) * DM; A.modl = modE; A.shoff = 0; A.scoff = DM; A.U = U;
            A.Y = (const bf16*)(ws + WS_VG); A.pos = (const int*)(ws + WS_POS); A.gate = (const float*)(ws + WS_GATE); A.modprev = MODV + (size_t)(le - 1) * 17 * NMOD;
            if (lp == 0) { row_phase<false, 1, false, true>(F, A, MT); ffn_weights8(F); } else row_phase<true, 1, false, false>(F, A, MT);
        }
#endif
        GRID_BAR();
#if PH(2)
        {
            pg8::Gemm g{U, (const bf16*)(ws + WS_WIN) + (size_t)j * INP * DM, DM, DM, DM}; pg8::InOrder S; S.init(ctx_out, F.G, (int)blockIdx.x);
            EpiIn E{(bf16*)(ws + WS_CQ), (bf16*)(ws + WS_KRR), (bf16*)(ws + WS_CKV), (bf16*)(ws + WS_HQ), (float*)(ws + WS_RSQ), (float*)(ws + WS_RSKV), (const float*)(ws + WS_ROPE), args.in[13], j};
            REP(8) pg8::gemm_phase<EpiIn, pg8::InOrder, true>(ring, g, S, E, F.wave);
        }
#endif
        GRID_BAR();
#if PH(4)
        {
            pg8::Gemm g{(const bf16*)(ws + WS_CQ), (const bf16*)(ws + WS_WUQ) + (size_t)j * 768 * QL, QL, QL, QL}; pg8::StaticOrder S; S.init(nro, 768, F.G, (int)blockIdx.x);
            EpiQ E{(bf16*)(ws + WS_QB), (const float*)(ws + WS_RSQ)};
            REP(8) pg8::gemm_phase<EpiQ, pg8::StaticOrder, true>(ring, g, S, E, F.wave);
        }
        {
            pg8::Gemm g{(const bf16*)(ws + WS_CKV), (const bf16*)(ws + WS_WUKV) + (size_t)j * 1024 * KVL, KVL, KVL, KVL}; pg8::StaticOrder S;
            S.init(MT, 1024, F.G, ((int)blockIdx.x + (((MT / 256) * 4) % F.G) / 8 * 8) % F.G);
            EpiKV E{(bf16*)(ws + WS_KN), (bf16*)(ws + WS_VV), (const float*)(ws + WS_RSKV)};
            REP(8) pg8::gemm_phase<EpiKV, pg8::StaticOrder, true>(ring, g, S, E, F.wave);
        }
#endif
        GRID_BAR();
#if PH(6)
        REP(3) mix_phase(F, j, ctx_out);
#endif
        GRID_BAR();
#if PH(8)
        REP(4 | 64) e8_phase(F, j, nro);
#endif
        GRID_BAR();
#if PH(9)
        {
            pg8::Gemm g{(const bf16*)(ws + WS_MIX), (const bf16*)(ws + WS_WOUT) + (size_t)j * DM * DM, DM, DM, DM}; pg8::StaticOrder S; S.init(nro, DM, F.G, (int)blockIdx.x);
            if (lp == 0) { EpiResid<true> E{args.in[0], args.in[2], HB, modE, 2 * DM}; pg8::gemm_phase<EpiResid<true>, pg8::StaticOrder, true>(ring, g, S, E, F.wave); }
            else { EpiResid<false> E{nullptr, nullptr, HB, modE, 2 * DM}; pg8::gemm_phase<EpiResid<false>, pg8::StaticOrder, true>(ring, g, S, E, F.wave); }
        }
#endif
        GRID_BAR();
#if PH(10)
        {
            RowArgs A{}; A.hb = HB; A.g = args.in[6] + (size_t)(le * 2 + 1) * DM; A.modl = modE; A.shoff = 3 * DM; A.scoff = 4 * DM; A.U = U;
            A.U8 = ws + WS_U; A.rs = (f32x4*)(ws + WS_RS); A.st = (const float*)(ws + WS_WSTAT) + 96 + j * 6;
            A.hid_only = (lp == 0);
            row_phase<false, 1, false, false, true>(F, A, nro);
        }
#endif
        GRID_BAR();
#if PH(11)
        {
            pg8::StaticOrder S; S.init(nro, 2 * DFF, F.G, (int)blockIdx.x);
            if (lp == 0) {
                pg8::Gemm g{U, (const bf16*)(ws + WS_WGU) + (size_t)j * 2 * DFF * DM, DM, DM, DM};
                EpiGateUp8 E{ws + WS_HID, DFF, 2 * DFF / 256, 0, (const f32x4*)(ws + WS_RS)};
                pg8::gemm_phase<EpiGateUp8, pg8::StaticOrder, true>(ring, g, S, E, F.wave);
            } else {
                pg8::Gemm g{(const bf16*)(ws + WS_U), (const bf16*)(ws + WS_WGU + (size_t)j * 2 * DFF * DM * 2), DM / 2, DM / 2, DM / 2};
                EpiGateUp8 E{ws + WS_HID, DFF, 2 * DFF / 256, 0, (const f32x4*)(ws + WS_RS)};
                pg8::gemm_phase<EpiGateUp8, pg8::StaticOrder, true, false, true>(ring, g, S, E, F.wave);
            }
        }
#endif
        GRID_BAR();
#if PH(12)
        {
            pg8::StaticOrder S; S.init(nro, DM, F.G, (int)blockIdx.x);
            if (lp == 0) {
                pg8::Gemm g{(const bf16*)(ws + WS_HID), (const bf16*)(ws + WS_WDN), DFF / 2, DFF / 2, DFF / 2};
                EpiResid<false, true> E{nullptr, nullptr, HB, modE, 5 * DM, (const f32x4*)(ws + WS_RS)};
                pg8::gemm_phase<EpiResid<false, true>, pg8::StaticOrder, true, false, true>(ring, g, S, E, F.wave);
            } else {
                pg8::Gemm g{(const bf16*)(ws + WS_HID), (const bf16*)(ws + WS_WDN + (size_t)j * DM * DFF * 2), DFF / 2, DFF / 2, DFF / 2};
                EpiResid<false, true> E{nullptr, nullptr, HB, modE, 5 * DM, (const f32x4*)(ws + WS_RS)};
                pg8::gemm_phase<EpiResid<false, true>, pg8::StaticOrder, true, false, true>(ring, g, S, E, F.wave);
            }
        }
#endif
        GRID_BAR();
#if PH(13)
        {
            REP(2048) o12_phase(F, nro, HB, args.in[6] + (size_t)(lo * 2 + 0) * DM, modO);
            {
                const int done = (F.G % 2 == 0 && F.G / 2 >= NB * NH) ? NB * NH * NWAVES * CONV_MIX : 0;
                fresh(F); conv_items(F, args.in, j, done + F.vcu * NWAVES + F.wave, F.G * NWAVES, 1 << 30); }
        }
#endif
        GRID_BAR();
#if PH(15)
        {
            pg8::Gemm g{(const bf16*)(ws + WS_POOLED), (const bf16*)(ws + WS_WPOOL) + (size_t)j * 4 * 65536, 256, 256, 256};
            pg8::PoolOrder S{nro / 256, MT / 256, F.G, (int)blockIdx.x};
            EpiPool E{HB, modO, args.in[20] + (size_t)j * DM, args.in[21] + (size_t)j * DM, MT / 256};
            pg8::gemm_phase<EpiPool, pg8::PoolOrder, true>(ring, g, S, E, F.wave);
        }
#endif
        GRID_BAR();
#if PH(16)
        {
            RowArgs A{}; A.hb = HB; A.g = args.in[6] + (size_t)(lo * 2 + 1) * DM; A.modl = modO; A.shoff = 3 * DM; A.scoff = 4 * DM; A.U = U;
            A.router = args.in[22] + (size_t)j * DM * NE; A.eidx = (int*)(ws + WS_EIDX); A.gout = (float*)(ws + WS_GATE); A.cnt = (int*)(ws + WS_CNT);
            A.U8 = ws + WS_U; A.rsu = (float*)(ws + WS_RSU);
            REP(4 | 512) row_phase<false, 1, true, false>(F, A, nro);
        }
#endif
        GRID_BAR();
#if PH(17)
        REP(4 | 1024) o5_phase(F, nro, j);
#endif
        GRID_BAR();
#if PH(18)
        {
            const int* TST = (const int*)(ws + WS_TST);
            const int ts1 = TST[1], ts2 = TST[2], ts3 = TST[3], ts4 = TST[4], ts5 = TST[5], ts6 = TST[6], ts7 = TST[7], nT = TST[8];
            const int rem = nT % MOE_CH, nseg = nT / MOE_CH + 1;
            for (int p = 0; p <= nseg; ++p) {
                int n7 = 0;
                if (p >= 1) {
                    const int sg = p - 1; const int t0 = sg == 0 ? 0 : rem + (sg - 1) * MOE_CH, nrt = sg == 0 ? rem : MOE_CH; n7 = nrt * (DM / 256);
                    const bf16* hb = (const bf16*)(ws + WS_HIDM) + (size_t)((sg == 0 || ((sg - 1) & 1)) ? MOE_CH : 0) * 256 * (DFE / 2);
                    pg8::Gemm g{hb - (size_t)t0 * 256 * (DFE / 2), (const bf16*)(ws + WS_MWDN), DFE / 2, DFE / 2, DFE / 2};
                    pg8::MoeOrder S{t0, nrt, DM / 256, F.G, (int)blockIdx.x, ts1, ts2, ts3, ts4, ts5, ts6, ts7, 0, 0};
                    EpiY8 E{(bf16*)(ws + WS_VG), DM / 256, (const f32x4*)(ws + WS_RS)};
                    REP(8) pg8::gemm_phase<EpiY8, pg8::MoeOrder, true, false, true>(ring, g, S, E, F.wave);
                }
                if (p < nseg) {
                    const int sg = p; const int t0 = sg == 0 ? 0 : rem + (sg - 1) * MOE_CH, nrt = sg == 0 ? rem : MOE_CH;
                    unsigned char* hb = ws + WS_HIDM + (size_t)((sg == 0 || ((sg - 1) & 1)) ? MOE_CH : 0) * 256 * DFE;
                    pg8::Gemm g{(const bf16*)(ws + WS_U), (const bf16*)(ws + WS_MWGU), DM / 2, DM / 2, DM / 2, (const int*)(ws + WS_IDX)};
                    pg8::MoeOrder S{t0, nrt, 2 * DFE / 256, F.G, (int)blockIdx.x, ts1, ts2, ts3, ts4, ts5, ts6, ts7, n7 % F.G, 4};
                    EpiGateUp8 E{hb, DFE, 2 * DFE / 256, t0 * 256, (const f32x4*)(ws + WS_RS)};
                    REP(8) pg8::gemm_phase<EpiGateUp8, pg8::MoeOrder, true, true, true>(ring, g, S, E, F.wave);
                }
                GRID_BAR();
            }
        }
#endif
    }
#if PH(19)
    {
        RowArgs A{}; A.hb = HB; A.fout = args.out; A.g = args.in[7];
        A.Y = (const bf16*)(ws + WS_VG); A.pos = (const int*)(ws + WS_POS); A.gate = (const float*)(ws + WS_GATE); A.modprev = MODV + (size_t)3 * 17 * NMOD;
        row_phase<true, 2, false, false>(F, A, M);
        if (xb_ld((unsigned*)(ws + WS_CTL) + CW_BAR + XB_TMO) != 0u) { __syncthreads(); const float qn = __builtin_nanf(""); for (int i = F.tid; i < 1024; i += 512) args.out[(size_t)blockIdx.x * 1024 + i] = qn; }
    }
#endif
}

extern "C" void kernel_launch(void* const* d_in, const int* in_sizes, int n_in, void* d_out, int out_size, void* d_ws, size_t ws_size, hipStream_t stream) {
    static int grid = 0;
    if (grid == 0) {
        if (n_in != 26 || out_size != M * DM || ws_size < WS_END) { fprintf(stderr, "kernel_launch: unexpected shapes (n_in %d out %d ws %zu)\n", n_in, out_size, ws_size); grid = -1; return; }
        int dev = 0, cus = 0, per_cu = 0;
        if (hipGetDevice(&dev) != hipSuccess || hipDeviceGetAttribute(&cus, hipDeviceAttributeMultiprocessorCount, dev) != hipSuccess) { grid = -1; return; }
        if (hipFuncSetAttribute((const void*)mega_fwd, hipFuncAttributeMaxDynamicSharedMemorySize, LDS_BYTES) != hipSuccess) { grid = -1; return; }
        if (hipOccupancyMaxActiveBlocksPerMultiprocessor(&per_cu, (const void*)mega_fwd, NWAVES * 64, LDS_BYTES) != hipSuccess || per_cu < 1) fprintf(stderr, "kernel_launch: occupancy query says %d\n", per_cu);
        (void)hipGetLastError();
        grid = cus > 256 ? 256 : cus;
    }
    if (grid < 0) return;
    if (hipMemsetAsync((char*)d_ws + WS_CTL, 0, CTL_ZERO_BYTES, stream) != hipSuccess) return;
    Args a{};
    for (int i = 0; i < 26; ++i) a.in[i] = (const float*)d_in[i];
    a.out = (float*)d_out; a.ws = (unsigned char*)d_ws;
    hipLaunchKernelGGL(mega_fwd, dim3(grid), dim3(NWAVES * 64), LDS_BYTES, stream, a);
}
```

```cpp
#include <hip/hip_runtime.h>
#ifndef DUPMASK
#define DUPMASK 0
#endif
#include <cstdio>
#include <cstdint>

__device__ __forceinline__ int lane_now() { int l; asm volatile("v_mbcnt_lo_u32_b32 %0, -1, 0\n\tv_mbcnt_hi_u32_b32 %0, -1, %0" : "=v"(l)); return l; }
namespace pg8 {
#define PG8_LAS __attribute__((address_space(3)))
typedef unsigned short bf16_t;
typedef short bf16x8 __attribute__((ext_vector_type(8)));
typedef int v4i_t __attribute__((ext_vector_type(4)));
typedef int v8i_t __attribute__((ext_vector_type(8)));
typedef float f32x4 __attribute__((ext_vector_type(4)));
typedef unsigned u32x4 __attribute__((ext_vector_type(4)));
constexpr int BM = 256, BK = 64, HALF = 128, HTB = HALF * BK * 2, STAGE_BYTES = 8 * HTB, NXCD = 8, WGM = 8;

__host__ __device__ __forceinline__ int lds_byte(int r, int c) { const int st = (r >> 4) * 2 + (c >> 5), rr = r & 15, cc = c & 31, ob = rr * 64 + cc * 2; return st * 1024 + (ob ^ (((ob >> 9) & 1) << 5)); }
__host__ __device__ __forceinline__ void stage_rc(int b, int& R, int& C) { const int st = b / 1024, sb = b % 1024, swz = sb ^ (((sb >> 9) & 1) << 5); R = (st >> 1) * 16 + swz / 64; C = (st & 1) * 32 + (swz % 64) / 2; }
__host__ __device__ __forceinline__ int perm32(int rho) { const int n = rho >> 4, i = rho & 15; return 8 * (i >> 2) + 4 * n + (i & 3); }

struct Unit { int pm, pn; };
struct Gemm { const bf16_t* A; const bf16_t* Bt; int lda, ldb, K; const int* idx; };

struct StaticOrder {
    int nM, nN, nwg, G, c;
    __device__ void init(int M, int N, int G_, int c_) { nM = M / BM; nN = N / BM; nwg = nM * nN; G = G_; c = c_; }
    __device__ bool next(int i, Unit& u) const {
        const long L = (long)i * G + c; if (L >= nwg) return false;
        int wgid = (int)L; { const int q = nwg / NXCD, r = nwg % NXCD, xcd = wgid % NXCD, off = wgid / NXCD; wgid = (xcd < r ? xcd * (q + 1) : r * (q + 1) + (xcd - r) * q) + off; }
        const int nig = WGM * nN, gid = wgid / nig, fm = gid * WGM, gsz = (nM - fm) < WGM ? (nM - fm) : WGM;
        u.pm = fm + ((wgid % nig) % gsz); u.pn = (wgid % nig) / gsz; return true;
    }
};
struct InOrder {
    StaticOrder lat; int nlat, nctx_ct, G, c;
    __device__ void init(bool full, int G_, int c_) { lat.init(32768, 3328, G_, c_); nlat = lat.nwg; nctx_ct = full ? 13 : 8; G = G_; c = c_; }
    __device__ bool next(int i, Unit& u) const {
        const int L = i * G + c; if (L < nlat) return lat.next(i, u);
        const int x = L - nlat; if (x >= 16 * nctx_ct) return false;
        const int rt = (nctx_ct == 13) ? x / 13 : x >> 3, q = x - rt * nctx_ct; u.pm = 128 + rt; u.pn = (nctx_ct == 13) ? q : (q < 2 ? q + 1 : q + 3); return true;
    }
};
struct PoolOrder {
    int nrt, talloc, G, c;
    __device__ bool next(int i, Unit& u) const { const int L = i * G + c; if (L >= 4 * nrt) return false; const int g = L / nrt, rt = L - g * nrt; u.pm = g * talloc + rt; u.pn = g; return true; }
};
struct MoeOrder {
    int t0, nrt, nct, G, c; int ts1, ts2, ts3, ts4, ts5, ts6, ts7;
    int skipw, skipr;
    __device__ bool next(int i, Unit& u) const {
        const int nwg = nrt * nct; const int r_ = i + (c < skipw ? skipr : 0);
        const int L = (r_ < skipr) ? r_ * (G - skipw) + (c - skipw) : skipr * (G - skipw) + (r_ - skipr) * G + c; if (L >= nwg) return false;
        int wgid = L; { const int q = nwg / NXCD, r = nwg % NXCD, xcd = wgid % NXCD, off = wgid / NXCD; wgid = (xcd < r ? xcd * (q + 1) : r * (q + 1) + (xcd - r) * q) + off; }
        const int nig = WGM * nct, gid = wgid / nig, fm = gid * WGM, gsz = (nrt - fm) < WGM ? (nrt - fm) : WGM;
        const int rt = t0 + fm + ((wgid % nig) % gsz), ct = (wgid % nig) / gsz;
        const int e = (rt >= ts1) + (rt >= ts2) + (rt >= ts3) + (rt >= ts4) + (rt >= ts5) + (rt >= ts6) + (rt >= ts7);
        u.pm = rt; u.pn = e * nct + ct; return true;
    }
};

typedef float f32x2_cv __attribute__((ext_vector_type(2))); typedef __bf16 bf16x2_cv __attribute__((ext_vector_type(2)));
__device__ __forceinline__ unsigned cvt_pk_bf16(float lo, float hi) { const f32x2_cv v = {lo, hi}; const bf16x2_cv b = __builtin_convertvector(v, bf16x2_cv); return __builtin_bit_cast(unsigned, b); }

template <class Epi, class Sched, bool ALIGN_EPI, bool GATHER = false, bool FP8 = false>
__device__ __forceinline__ void gemm_phase(PG8_LAS unsigned char* lds, const Gemm g, const Sched& S, const Epi& E, const int wid) {
    const int lane_ = lane_now();
    const int lane = lane_, tid = wid * 64 + lane, wr = wid >> 2, wc = wid & 3, fr = lane & 15, fq = lane >> 4;
    int K_ = g.K; asm volatile("" : "+s"(K_));
    const int K = K_, nt = K / BK;
    unsigned voffA[2], voffB[2]; int RA0 = 0, CA0 = 0;
#pragma unroll
    for (int i = 0; i < 2; ++i) { int R, C; stage_rc(tid * 16 + i * 8192, R, C); const int Rb = Epi::PERM ? ((R & ~31) + perm32(R & 31)) : R; if (i == 0) { RA0 = R; CA0 = C; }
        voffA[i] = (unsigned)(R * g.lda + C) * 2u; voffB[i] = (unsigned)(Rb * g.ldb + C) * 2u; }
    unsigned gc[2][2]; PG8_LAS int* IB = (PG8_LAS int*)(lds + STAGE_BYTES);
#define PG8_GLOAD(dst, pm_) do { _Pragma("unroll") for (int h_ = 0; h_ < 2; ++h_) _Pragma("unroll") for (int i_ = 0; i_ < 2; ++i_) \
        dst[h_][i_] = ((unsigned)g.idx[(pm_) * 256 + h_ * 128 + i_ * 64 + RA0] * (unsigned)g.lda + (unsigned)CA0) * 2u; } while (0)
#define PG8_GNEXT(h_) do { if (last && has_next) { _Pragma("unroll") for (int i_ = 0; i_ < 2; ++i_) gc[h_][i_] = ((unsigned)IB[(h_) * 128 + i_ * 64 + RA0] * (unsigned)g.lda + (unsigned)CA0) * 2u; } } while (0)
    const size_t kstep = (size_t)(BK * 2);
    const size_t hstepA = (size_t)HALF * g.lda * 2, hstepB = (size_t)HALF * g.ldb * 2;
    const size_t tstepA = 2 * hstepA, tstepB = 2 * hstepB;
    const unsigned ldsw = (unsigned)wid * 1024u;
    const int aoff = lds_byte(wr * 64 + fr, fq * 8), boff = lds_byte(wc * 32 + fr, fq * 8);
#define PG8_SA(b, h) (((b) * 2 + (h)) * HTB)
#define PG8_SB(b, h) ((4 + (b) * 2 + (h)) * HTB)
#define PG8_STAGE(bufoff, gbase, voff) do { _Pragma("unroll") for (int _i = 0; _i < 2; ++_i) \
        __builtin_amdgcn_global_load_lds((const unsigned*)((const char*)(gbase) + (voff)[_i]), (PG8_LAS unsigned*)(lds + (bufoff) + ldsw + _i * 8192), 16, 0, 0); } while (0)
#define PG8_STAGEG(bufoff, gbase, o0_, o1_) do { __builtin_amdgcn_global_load_lds((const unsigned*)((const char*)(gbase) + (o0_)), (PG8_LAS unsigned*)(lds + (bufoff) + ldsw), 16, 0, 0); \
        __builtin_amdgcn_global_load_lds((const unsigned*)((const char*)(gbase) + (o1_)), (PG8_LAS unsigned*)(lds + (bufoff) + ldsw + 8192), 16, 0, 0); } while (0)
#define PG8_LDA(dst, b, h) do { if constexpr (FP8) { _Pragma("unroll") for (int m = 0; m < 4; ++m) { const PG8_LAS v4i_t* p_ = (const PG8_LAS v4i_t*)(lds + PG8_SA(b, h) + aoff + m * 2048); dst##8[m] = __builtin_shufflevector(p_[0], p_[64], 0, 1, 2, 3, 4, 5, 6, 7); } } \
        else { _Pragma("unroll") for (int m = 0; m < 4; ++m) _Pragma("unroll") for (int k = 0; k < 2; ++k) dst[m][k] = *(const PG8_LAS bf16x8*)(lds + PG8_SA(b, h) + aoff + m * 2048 + k * 1024); } } while (0)
#define PG8_LDB(dst, b, h) do { if constexpr (FP8) { _Pragma("unroll") for (int n = 0; n < 2; ++n) { const PG8_LAS v4i_t* p_ = (const PG8_LAS v4i_t*)(lds + PG8_SB(b, h) + boff + n * 2048); dst##8[n] = __builtin_shufflevector(p_[0], p_[64], 0, 1, 2, 3, 4, 5, 6, 7); } } \
        else { _Pragma("unroll") for (int n = 0; n < 2; ++n) _Pragma("unroll") for (int k = 0; k < 2; ++k) dst[n][k] = *(const PG8_LAS bf16x8*)(lds + PG8_SB(b, h) + boff + n * 2048 + k * 1024); } } while (0)
#define PG8_MMA(ai, bj, At, Bt) do { __builtin_amdgcn_s_setprio(1); \
        if constexpr (FP8) { _Pragma("unroll") for (int m = 0; m < 4; ++m) _Pragma("unroll") for (int n = 0; n < 2; ++n) \
            asm volatile("v_mfma_f32_16x16x128_f8f6f4 %0, %1, %2, %0" : "+v"(acc[ai][bj][m][n]) : "v"(Bt##8[n]), "v"(At##8[m])); } \
        else { _Pragma("unroll") for (int m = 0; m < 4; ++m) _Pragma("unroll") for (int n = 0; n < 2; ++n) _Pragma("unroll") for (int k = 0; k < 2; ++k) \
            acc[ai][bj][m][n] = __builtin_amdgcn_mfma_f32_16x16x32_bf16(Bt[n][k], At[m][k], acc[ai][bj][m][n], 0, 0, 0); } \
        __builtin_amdgcn_s_setprio(0); } while (0)
#define PG8_WAIT_V(n) asm volatile("s_waitcnt vmcnt(" #n ")" ::: "memory")
#define PG8_WAIT_L(n) asm volatile("s_waitcnt lgkmcnt(" #n ")" ::: "memory")
#define PG8_BAR __builtin_amdgcn_s_barrier()
#define PG8_SCHED __builtin_amdgcn_sched_barrier(0)
    Unit cur, nxt; int ui = 0;
    if (!S.next(0, cur)) return;
    f32x4 acc[2][2][4][2];
#pragma unroll
    for (int a = 0; a < 2; ++a)
#pragma unroll
        for (int b = 0; b < 2; ++b)
#pragma unroll
            for (int m = 0; m < 4; ++m)
#pragma unroll
                for (int n = 0; n < 2; ++n) acc[a][b][m][n] = (f32x4){0.f, 0.f, 0.f, 0.f};
    bf16x8 At[4][2], B0[2][2], B1[2][2]; v8i_t At8[4], B08[2], B18[2];
    const char* cA = GATHER ? (const char*)g.A : (const char*)g.A + (size_t)cur.pm * tstepA; const char* cB = (const char*)g.Bt + (size_t)cur.pn * tstepB;
    if constexpr (GATHER) { PG8_GLOAD(gc, cur.pm); }
    PG8_STAGE(PG8_SB(0, 0), cB, voffB); PG8_STAGE(PG8_SB(0, 1), cB + hstepB, voffB);
    if constexpr (GATHER) { PG8_STAGEG(PG8_SA(0, 0), cA, gc[0][0], gc[0][1]); PG8_STAGEG(PG8_SA(0, 1), cA, gc[1][0], gc[1][1]); }
    else { PG8_STAGE(PG8_SA(0, 0), cA, voffA); PG8_STAGE(PG8_SA(0, 1), cA + hstepA, voffA); }
    if (wr == 1) PG8_BAR;
    PG8_WAIT_V(2); PG8_BAR;
    PG8_STAGE(PG8_SB(1, 0), cB + kstep, voffB); if constexpr (GATHER) { PG8_STAGEG(PG8_SA(1, 0), cA + kstep, gc[0][0], gc[0][1]); } else { PG8_STAGE(PG8_SA(1, 0), cA + kstep, voffA); } PG8_STAGE(PG8_SB(1, 1), cB + hstepB + kstep, voffB);
    PG8_WAIT_V(6); PG8_BAR;
    for (;;) {
        const bool has_next = S.next(ui + 1, nxt);
        const char* nA = GATHER ? cA : (has_next ? (const char*)g.A + (size_t)nxt.pm * tstepA : cA); const char* nB = has_next ? (const char*)g.Bt + (size_t)nxt.pn * tstepB : cB;
        if constexpr (GATHER) { if (has_next && wid == 0) __builtin_amdgcn_global_load_lds((const unsigned*)(g.idx + (size_t)nxt.pm * 256 + lane * 4), (PG8_LAS unsigned*)IB, 16, 0, 0); }
#pragma unroll 1
        for (int t = 0; t < nt; t += 2) {
            const bool last = (t == nt - 2);
            const char* a1 = cA + (size_t)(t + 1) * kstep;
            const char* a2 = last ? nA : cA + (size_t)(t + 2) * kstep; const char* b2 = last ? nB : cB + (size_t)(t + 2) * kstep;
            const char* a3 = a2 + kstep; const char* b3 = b2 + kstep;
            PG8_LDB(B0, 0, 0); PG8_LDB(B1, 0, 1); PG8_SCHED; PG8_LDA(At, 0, 0); if constexpr (GATHER) { PG8_GNEXT(0); PG8_STAGEG(PG8_SA(1, 1), a1, gc[1][0], gc[1][1]); PG8_GNEXT(1); } else { PG8_STAGE(PG8_SA(1, 1), a1 + hstepA, voffA); }
            PG8_WAIT_V(8); PG8_WAIT_L(0); PG8_BAR; PG8_MMA(0, 0, At, B0); PG8_MMA(0, 1, At, B1); PG8_BAR; PG8_SCHED;
            PG8_LDA(At, 0, 1); PG8_STAGE(PG8_SB(0, 0), b2, voffB); PG8_STAGE(PG8_SB(0, 1), b2 + hstepB, voffB); if constexpr (GATHER) { PG8_STAGEG(PG8_SA(0, 0), a2, gc[0][0], gc[0][1]); } else { PG8_STAGE(PG8_SA(0, 0), a2, voffA); }
            PG8_WAIT_V(8); PG8_WAIT_L(0); PG8_BAR; PG8_MMA(1, 0, At, B0); PG8_MMA(1, 1, At, B1); PG8_BAR; PG8_SCHED;
            PG8_LDB(B0, 1, 0); PG8_LDB(B1, 1, 1); PG8_SCHED; PG8_LDA(At, 1, 0); if constexpr (GATHER) { PG8_STAGEG(PG8_SA(0, 1), a2, gc[1][0], gc[1][1]); } else { PG8_STAGE(PG8_SA(0, 1), a2 + hstepA, voffA); }
            PG8_WAIT_V(8); PG8_WAIT_L(0); PG8_BAR; PG8_MMA(0, 0, At, B0); PG8_MMA(0, 1, At, B1); PG8_BAR; PG8_SCHED;
            PG8_LDA(At, 1, 1); PG8_STAGE(PG8_SB(1, 0), b3, voffB); PG8_STAGE(PG8_SB(1, 1), b3 + hstepB, voffB); if constexpr (GATHER) { PG8_STAGEG(PG8_SA(1, 0), a3, gc[0][0], gc[0][1]); } else { PG8_STAGE(PG8_SA(1, 0), a3, voffA); }
            PG8_WAIT_V(8); PG8_WAIT_L(0); PG8_BAR; PG8_MMA(1, 0, At, B0); PG8_MMA(1, 1, At, B1); PG8_BAR; PG8_SCHED;
        }
        if constexpr (FP8) { asm volatile("s_nop 15\n\ts_nop 15" ::: "memory"); PG8_SCHED; }
        if constexpr (ALIGN_EPI) { if (wr == 0) PG8_BAR; }
        E(acc, cur, wr, wc, fr, fq);
        if (!has_next) break;
#pragma unroll
        for (int a = 0; a < 2; ++a)
#pragma unroll
            for (int b = 0; b < 2; ++b)
#pragma unroll
                for (int m = 0; m < 4; ++m)
#pragma unroll
                    for (int n = 0; n < 2; ++n) acc[a][b][m][n] = (f32x4){0.f, 0.f, 0.f, 0.f};
        cur = nxt; cA = nA; cB = nB; ++ui;
        if constexpr (ALIGN_EPI) { if (wr == 1) PG8_BAR; }
    }
    PG8_WAIT_V(0);
    if constexpr (!ALIGN_EPI) { if (wr == 0) PG8_BAR; }
    PG8_BAR;
#undef PG8_SA
#undef PG8_SB
#undef PG8_STAGE
#undef PG8_STAGEG
#undef PG8_GLOAD
#undef PG8_GNEXT
#undef PG8_LDA
#undef PG8_LDB
#undef PG8_MMA
#undef PG8_WAIT_V
#undef PG8_WAIT_L
#undef PG8_BAR
#undef PG8_SCHED
}
}

constexpr int NWAVES = 8;
constexpr int DM = 1024, NB = 16, SEQ = 2048, CTXL = 256;
constexpr int M = NB * SEQ, MC = NB * CTXL, MT = M + MC;
constexpr int QL = 384, KVL = 256, ROPE = 32, HW = 512, NH = 8, QKD = 96, VD = 64;
constexpr int INW = 3232, INP = 3328;
constexpr int DFF = 2816, NE = 8, DFE = 3584, NMOD = 6 * DM;
constexpr int NHH = 4, HK = 128; constexpr int NKEY = SEQ + CTXL;
constexpr float EPS = 1e-6f;
constexpr int MAXT = 296;
constexpr int MOE_CH = 128;

constexpr size_t MiB = 1u << 20;
constexpr size_t WS_CTL = 0, CTL_ZERO_BYTES = 1 * MiB;
constexpr size_t WS_MODV = 1 * MiB;
constexpr size_t WS_ROPE = 3 * MiB;
constexpr size_t WS_CNT = 3 * MiB + 64 * 1024;
constexpr size_t WS_TST = 3 * MiB + 128 * 1024;
constexpr size_t WS_EIDX = 4 * MiB, WS_GATE = 4 * MiB + 512 * 1024, WS_POS = 5 * MiB, WS_IDX = 5 * MiB + 512 * 1024;
constexpr size_t WS_RSQ = 6 * MiB, WS_RSKV = 7 * MiB + 256 * 1024;
constexpr size_t WS_WSTAT = 3 * MiB + 160 * 1024;
constexpr size_t WS_RS = WS_RSQ, WS_RSU = WS_RSKV;
constexpr size_t WS_WIN = 8 * MiB, WS_WUQ = 21 * MiB, WS_WUKV = 23 * MiB, WS_WOUT = 24 * MiB, WS_WGU = 28 * MiB, WS_WDN = 50 * MiB, WS_WPOOL = 61 * MiB;
constexpr size_t WS_HB = 62 * MiB;
constexpr size_t WS_U = 134 * MiB;
constexpr size_t WS_X = 206 * MiB;
constexpr size_t WS_CQ = WS_X, WS_CKV = 233 * MiB, WS_KRR = 251 * MiB, WS_HQ = 254 * MiB  ;
constexpr size_t WS_QB = 434 * MiB, WS_KN = 488 * MiB, WS_VV = 524 * MiB, WS_OF = 560 * MiB, WS_OB = 632 * MiB, WS_MIX = 704 * MiB, WS_HID = WS_X;
constexpr size_t WS_MWGU = 780 * MiB, WS_MWDN = 840 * MiB  , WS_VG = 374 * MiB, WS_POOLED = WS_VG  , WS_HIDM = 522 * MiB, WS_END = 970 * MiB;
constexpr size_t HSEG = (size_t)MT * HW;
static_assert(WS_WPOOL + (size_t)2 * 4 * 65536 * 2 <= WS_HB && WS_HB + (size_t)MT * DM * 2 <= WS_U && WS_U + (size_t)MT * DM * 2 <= WS_X && WS_KRR + (size_t)MT * ROPE * 2 <= WS_HQ && WS_HQ + 5 * HSEG * 2 <= WS_QB && WS_MIX + (size_t)MT * DM * 2 <= WS_END && WS_HID + (size_t)MT * DFF * 2 <= WS_QB, "ws map even");
static_assert(WS_HIDM + (size_t)2 * MOE_CH * 256 * DFE * 2 <= WS_END && WS_VG + (size_t)MAXT * 256 * DM * 2 <= WS_HIDM && WS_MWDN + (size_t)NE * DM * DFE <= WS_END && WS_MWGU + (size_t)NE * 2 * DFE * DM <= WS_MWDN && WS_MIX + (size_t)MT * DM * 2 <= WS_MWGU && WS_HIDM + (size_t)2 * MOE_CH * 256 * DFE <= WS_MWGU, "ws map odd");
constexpr int CW_BAR = 4096;

constexpr int RING_OFF = 0, RING_BYTES = 143360;
constexpr int LDSCTL_OFF = RING_BYTES, MISC_OFF = LDSCTL_OFF + 320;
constexpr int LDS_BYTES = 147456;

#define GAS __attribute__((address_space(1)))
#define LAS __attribute__((address_space(3)))
typedef unsigned short bf16;
typedef unsigned v4u __attribute__((ext_vector_type(4)));
typedef unsigned v2u __attribute__((ext_vector_type(2)));
typedef float f32x4 __attribute__((ext_vector_type(4)));
typedef float f32x2 __attribute__((ext_vector_type(2)));
typedef GAS unsigned gu32;
#define RLX_AGENT __ATOMIC_RELAXED, __HIP_MEMORY_SCOPE_AGENT
#define LDS_WAIT() asm volatile("s_waitcnt lgkmcnt(0)" ::: "memory")
__device__ __forceinline__ unsigned f2bf(float f) { unsigned u = __builtin_bit_cast(unsigned, f); return (u + 0x7fffu + ((u >> 16) & 1u)) >> 16; }
__device__ __forceinline__ unsigned pk2(float lo, float hi) { return f2bf(lo) | (f2bf(hi) << 16); }
__device__ __forceinline__ float bf2f(unsigned short b) { return __uint_as_float((unsigned)b << 16); }
__device__ __forceinline__ float bflo(unsigned w) { return __uint_as_float(w << 16); }
__device__ __forceinline__ float bfhi(unsigned w) { return __uint_as_float(w & 0xffff0000u); }
__device__ __forceinline__ float sigmoidf_(float x) { return 1.0f / (1.0f + __expf(-x)); }
__device__ __forceinline__ float siluf_(float x) { return x * __builtin_amdgcn_rcpf(1.0f + __expf(-x)); }

#define XB_TMO      128
#define XB_XCNT(j)  (256  + 64 * (j))
#define XB_XSUB(j)  (1280 + 64 * (j))
#define XB_XGEN(j)  (2304 + 64 * (j))
#define XB_TOP      3328
#define XB_TOPGEN   3392
#define XCD_BAR_WORDS 3456
#define XB_SPIN_CAP (1u << 22)
__device__ __forceinline__ unsigned xb_ld(unsigned* p)              { return __hip_atomic_load(p, __ATOMIC_RELAXED, __HIP_MEMORY_SCOPE_AGENT); }
__device__ __forceinline__ unsigned xb_add(unsigned* p, unsigned v) { return __hip_atomic_fetch_add(p, v, __ATOMIC_RELAXED, __HIP_MEMORY_SCOPE_AGENT); }
__device__ __forceinline__ unsigned xb_xcc_id() { return (unsigned)__builtin_amdgcn_s_getreg((3 << 11) | 20) & 0xFu; }
#define XB_SPIN(cond, bar) do { unsigned _sp = 0; while (cond) { __builtin_amdgcn_s_sleep(1); \
    if ((++_sp & 255u) == 0u) { if (xb_ld(&(bar)[XB_TMO])) break; if (_sp > XB_SPIN_CAP) { atomicAdd(&(bar)[XB_TMO], 1u); break; } } } } while (0)
struct XcdBarrier { unsigned* bar; unsigned x; volatile LAS unsigned* st; int wave; };
__device__ __forceinline__ bool xb_leader(int wave) { return wave == 0 && lane_now() == 0; }
__device__ __forceinline__ XcdBarrier xcd_barrier_post(unsigned* bar, volatile LAS unsigned* st, int wave) {
    XcdBarrier b; b.bar = bar; b.x = xb_xcc_id(); b.st = st; b.wave = wave;
    if (xb_leader(wave)) (void)xb_add(&bar[XB_XCNT(b.x)], 1u);
    return b;
}
__device__ __forceinline__ void xcd_barrier_complete(unsigned* bar, unsigned x, unsigned& nloc, unsigned& nx) {
    const unsigned G = gridDim.x * gridDim.y * gridDim.z;
    unsigned sum, cnt, mine, sp = 0u;
    for (;;) {
        sum = 0u; cnt = 0u; mine = 0u;
#pragma unroll
        for (unsigned j = 0; j < 16; ++j) { const unsigned c = xb_ld(&bar[XB_XCNT(j)]); sum += c; cnt += (c > 0u) ? 1u : 0u; mine = (j == x) ? c : mine; }
        if (sum == G) break;
        __builtin_amdgcn_s_sleep(1);
        if ((++sp & 255u) == 0u) { if (xb_ld(&bar[XB_TMO])) break; if (sp > XB_SPIN_CAP) { atomicAdd(&bar[XB_TMO], 1u); break; } }
    }
    nloc = mine > 0u ? mine : 1u; nx = cnt > 0u ? cnt : 1u;
}
__device__ __forceinline__ void xcd_barrier(const XcdBarrier& b) {
    asm volatile("s_waitcnt vmcnt(0)" ::: "memory");
    __syncthreads();
    if (xb_leader(b.wave)) {
        unsigned* bar = b.bar; asm volatile("" : "+s"(bar));
        __builtin_amdgcn_s_waitcnt(0);
        unsigned nloc = b.st[0], nx = b.st[1];
        if (nloc == 0u) { xcd_barrier_complete(bar, b.x, nloc, nx); b.st[0] = nloc; b.st[1] = nx; }
        const unsigned old = xb_add(&bar[XB_XSUB(b.x)], 1u);
        const unsigned gen = old / nloc;
        if (old + 1u == (gen + 1u) * nloc) {
            __builtin_amdgcn_fence(__ATOMIC_RELEASE, "agent");
            asm volatile("s_waitcnt vmcnt(0)" ::: "memory");
            const unsigned og = xb_add(&bar[XB_TOP], 1u);
            const unsigned tg = og / nx;
            if (og + 1u == (tg + 1u) * nx) xb_add(&bar[XB_TOPGEN], 1u);
            else XB_SPIN(xb_ld(&bar[XB_TOPGEN]) == tg, bar);
            __builtin_amdgcn_fence(__ATOMIC_ACQUIRE, "agent");
            xb_add(&bar[XB_XGEN(b.x)], 1u);
            asm volatile("s_waitcnt vmcnt(0)" ::: "memory");
        } else {
            XB_SPIN(xb_ld(&bar[XB_XGEN(b.x)]) == gen, bar);
            __builtin_amdgcn_fence(__ATOMIC_ACQUIRE, "agent");
            asm volatile("s_waitcnt vmcnt(0)" ::: "memory");
        }
    }
    __syncthreads();
}

struct Args { const float* in[26]; float* out; unsigned char* ws; };
struct Frame {
    LAS unsigned char* lds;
    int tid, lane, wave, G, vcu;
    const float* const* in; float* out; unsigned char* ws;
};
__device__ __forceinline__ float shx(float v, int lane, int m) { return __int_as_float(__builtin_amdgcn_ds_bpermute((lane ^ m) << 2, __float_as_int(v))); }
__device__ __forceinline__ float wave_sum(float v, int lane) {
#pragma unroll
    for (int o = 1; o < 64; o <<= 1) v += shx(v, lane, o);
    return v;
}

__device__ __forceinline__ float wave_max(float v, int lane) {
#pragma unroll
    for (int m = 32; m >= 1; m >>= 1) v = fmaxf(v, shx(v, lane, m));
    return v;
}
__device__ __forceinline__ float clamp448(float x) { return __builtin_amdgcn_fmed3f(x, -448.0f, 448.0f); }
__device__ __forceinline__ unsigned pk4_fp8(float a, float b, float c, float d) { int p = __builtin_amdgcn_cvt_pk_fp8_f32(a, b, 0, false); p = __builtin_amdgcn_cvt_pk_fp8_f32(c, d, p, true); return (unsigned)p; }
__device__ __forceinline__ void fresh(Frame& F) { const int l = lane_now(); F.lane = l; F.tid = F.wave * 64 + l; }

__device__ __forceinline__ void conv_item(const float* W, int ldw, bf16* WT, int ldd, int k0, int n0, int drow0, const float* kscale, float gscale, LAS float* scr, int lane) {
    float wv[32];
#pragma unroll
    for (int i = 0; i < 32; ++i) { const int kk = 2 * i + (lane >> 5); wv[i] = W[(size_t)(k0 + kk) * ldw + n0 + (lane & 31)]; }
#pragma unroll
    for (int i = 0; i < 32; ++i) { const int kk = 2 * i + (lane >> 5); float w = wv[i]; if (kscale) w *= kscale[k0 + kk]; scr[kk * 33 + (lane & 31)] = w * gscale; }
    LDS_WAIT(); asm volatile("" ::: "memory");
    const int c = lane & 7;
#pragma unroll
    for (int j = 0; j < 4; ++j) { const int n = (lane >> 3) + 8 * j; const LAS float* s = scr + (8 * c) * 33 + n;
        v4u o; o.x = pk2(s[0 * 33], s[1 * 33]); o.y = pk2(s[2 * 33], s[3 * 33]); o.z = pk2(s[4 * 33], s[5 * 33]); o.w = pk2(s[6 * 33], s[7 * 33]);
        *(v4u*)(WT + (size_t)(drow0 + n) * ldd + k0 + 8 * c) = o; }
    LDS_WAIT(); asm volatile("" ::: "memory");
}
__device__ __forceinline__ int conv_rowmap(int mode, int n0, int off) {
    if (mode == 0) return n0 + off;
    if (mode == 1) { if (n0 < 384) return n0; if (n0 < 640) return 512 + (n0 - 384); if (n0 < 672) return 384; return 768 + (n0 - 672); }
    return 256 * (n0 >> 7) + (n0 & 127) + off;
}
__device__ __forceinline__ void conv_matrix(Frame& F, const float* W, int K, int N, bf16* WT, int ldd, int mode, int off, const float* kscale, float gscale) {
    LAS float* scr = (LAS float*)(F.lds + RING_OFF + F.wave * 16384);
    const int gw = F.vcu * NWAVES + F.wave, NGW = F.G * NWAVES;
    const int nblk = N / 32, nitems = (K / 64) * nblk;
    for (int it = gw; it < nitems; it += NGW) { const int kb = it / nblk, nb = it % nblk; conv_item(W, N, WT, ldd, 64 * kb, 32 * nb, conv_rowmap(mode, 32 * nb, off), kscale, gscale, scr, F.lane); }
}

__device__ __forceinline__ void conv_item8(const float* W, int ldw, unsigned char* WT, int ldd, int k0, int n0, int drow0, float gscale, LAS float* scr, int lane) {
    float wv[32];
#pragma unroll
    for (int i = 0; i < 32; ++i) { const int kk = 2 * i + (lane >> 5); wv[i] = W[(size_t)(k0 + kk) * ldw + n0 + (lane & 31)]; }
#pragma unroll
    for (int i = 0; i < 32; ++i) { const int kk = 2 * i + (lane >> 5); scr[kk * 33 + (lane & 31)] = clamp448(wv[i] * gscale); }
    LDS_WAIT(); asm volatile("" ::: "memory");
    const int c = lane & 3;
#pragma unroll
    for (int j = 0; j < 2; ++j) { const int n = (lane >> 2) + 16 * j; const LAS float* s = scr + (16 * c) * 33 + n;
        v4u o; o.x = pk4_fp8(s[0 * 33], s[1 * 33], s[2 * 33], s[3 * 33]); o.y = pk4_fp8(s[4 * 33], s[5 * 33], s[6 * 33], s[7 * 33]);
        o.z = pk4_fp8(s[8 * 33], s[9 * 33], s[10 * 33], s[11 * 33]); o.w = pk4_fp8(s[12 * 33], s[13 * 33], s[14 * 33], s[15 * 33]);
        *(v4u*)(WT + (size_t)(drow0 + n) * ldd + k0 + 16 * c) = o; }
    LDS_WAIT(); asm volatile("" ::: "memory");
}
__device__ __forceinline__ void conv_matrix8(Frame& F, const float* W, int K, int N, unsigned char* WT, int ldd, int mode, int off, float gscale) {
    LAS float* scr = (LAS float*)(F.lds + RING_OFF + F.wave * 16384);
    const int gw = F.vcu * NWAVES + F.wave, NGW = F.G * NWAVES;
    const int nblk = N / 32, nitems = (K / 64) * nblk;
    for (int it = gw; it < nitems; it += NGW) { const int kb = it / nblk, nb = it % nblk; conv_item8(W, N, WT, ldd, 64 * kb, 32 * nb, conv_rowmap(mode, 32 * nb, off), gscale, scr, F.lane); }
}

__device__ __forceinline__ void ffn_weights8(Frame& F) {
    fresh(F);
    unsigned char* ws = F.ws; const float* st = (const float*)(ws + WS_WSTAT) + 96;
    for (int j = 0; j < 2; ++j) {
        conv_matrix8(F, F.in[16] + (size_t)j * DM * DFF, DM, DFF, ws + WS_WGU + (size_t)j * 2 * DFF * DM * 2, DM, 2, 0, 1.0f / st[j * 6 + 0]);
        conv_matrix8(F, F.in[17] + (size_t)j * DM * DFF, DM, DFF, ws + WS_WGU + (size_t)j * 2 * DFF * DM * 2, DM, 2, 128, 1.0f / st[j * 6 + 2]);
        conv_matrix8(F, F.in[18] + (size_t)j * DFF * DM, DFF, DM, ws + WS_WDN + (size_t)j * DM * DFF * 2, DFF, 0, 0, 1.0f / st[j * 6 + 4]);
    }
    __syncthreads();
}

constexpr int CONV_ITEMS = 24 * 1792, CONV_MIX = 10;
__device__ __forceinline__ void conv_items(Frame& F, const float* const* in, int j, int start, int stride, int n) {
    unsigned char* ws = F.ws;
    LAS float* scr = (LAS float*)(F.lds + RING_OFF + F.wave * 16384);
    const float* st = (const float*)(ws + WS_WSTAT) + j * 48;
    for (int t = 0; t < n; ++t) { const int gi = start + t * stride; if (gi >= CONV_ITEMS) break;
        const int m = gi / 1792, it = gi - m * 1792, e = m / 3, wh = m - 3 * e;
        if (wh < 2) { const int kb = it / 112, nb = it - kb * 112;
            conv_item8(in[23 + wh] + ((size_t)j * NE + e) * DM * DFE, DFE, ws + WS_MWGU + (size_t)e * 2 * DFE * DM, DM, 64 * kb, 32 * nb, conv_rowmap(2, 32 * nb, wh ? 128 : 0), 1.0f / st[e * 6 + 2 * wh], scr, F.lane); }
        else { const int kb = it >> 5, nb = it & 31;
            conv_item8(in[25] + ((size_t)j * NE + e) * DFE * DM, DM, ws + WS_MWDN + (size_t)e * DM * DFE, DFE, 64 * kb, 32 * nb, 32 * nb, 1.0f / st[e * 6 + 4], scr, F.lane); } }
}

__device__ __forceinline__ int row_bidx(int row) { return row < M ? row / SEQ : NB; }

struct RowArgs {
    const float* xin_l; const float* xin_c;
    const bf16* hb; bf16* hbo;
    float* fout;
    const float* g;
    const float* modl;
    int shoff, scoff;
    bf16* U;
    const bf16* Y; const int* pos; const float* gate; const float* modprev;
    const float* router; int* eidx; float* gout; int* cnt;
    unsigned char* U8; float* rsu; f32x4* rs; const float* st;
};
template <bool COMBINE, int OUTMODE, bool ROUTER, bool INF32, bool F8OUT = false>
__device__ __forceinline__ void row_phase(Frame& F, const RowArgs& A, int nrows) {
    fresh(F);
    const int rpw = (nrows + F.G - 1) / F.G;
    LAS int* lcnt = (LAS int*)(F.lds + RING_OFF);
    if (ROUTER) { if (F.tid < 8) lcnt[F.tid] = 0; __syncthreads(); }
    int bid = (int)blockIdx.x; asm volatile("" : "+s"(bid));
    const int rbase = bid * rpw, rend = (rbase + rpw < nrows) ? rbase + rpw : nrows;
#define ROWLOAD(dst, r_) do { if (INF32) { const float* hr_ = ((r_) < M) ? A.xin_l + (size_t)(r_) * DM : A.xin_c + (size_t)((r_) - M) * DM; \
            _Pragma("unroll") for (int j = 0; j < 4; ++j) dst[j] = *(const f32x4*)(hr_ + 4 * F.lane + 256 * j); } \
        else { _Pragma("unroll") for (int j = 0; j < 4; ++j) { const v2u w_ = *(const v2u*)(A.hb + (size_t)(r_) * DM + 4 * F.lane + 256 * j); dst[j] = (f32x4){bflo(w_.x), bfhi(w_.x), bflo(w_.y), bfhi(w_.y)}; } } } while (0)
    LAS float* LV = (LAS float*)(F.lds + RING_OFF + 1024);
    const int lb0 = ROUTER ? (rbase < M ? rbase / SEQ : NB) : 0;
    if (ROUTER) { const int lb1 = (rend - 1) < M ? (rend - 1) / SEQ : NB;
        for (int e = F.tid; e < 1024; e += 512) { LV[e] = A.g[e]; LV[1024 + e] = A.modl[lb0 * NMOD + A.shoff + e]; LV[2048 + e] = A.modl[lb0 * NMOD + A.scoff + e];
            LV[3072 + e] = A.modl[lb1 * NMOD + A.shoff + e]; LV[4096 + e] = A.modl[lb1 * NMOD + A.scoff + e]; }
        __syncthreads(); }
    f32x4 rw[16][2];
    if (ROUTER) {
#pragma unroll
        for (int j = 0; j < 4; ++j)
#pragma unroll
            for (int q = 0; q < 4; ++q) { const int col = 4 * F.lane + 256 * j + q; rw[4 * j + q][0] = *(const f32x4*)(A.router + (size_t)col * 8); rw[4 * j + q][1] = *(const f32x4*)(A.router + (size_t)col * 8 + 4); }
    }
    int row = rbase + F.wave;
    f32x4 v[4], vn[4];
    if (row < rend) ROWLOAD(v, row);
    float ga = 0.f, gb = 0.f, gan = 0.f, gbn = 0.f; int pan = 0, pbn = 0; v2u ya[4], yb[4], yan[4], ybn[4];
#define YLOAD(da, db, pa_, pb_) do { _Pragma("unroll") for (int j = 0; j < 4; ++j) { da[j] = *(const v2u*)(A.Y + (size_t)(pa_) * DM + 4 * F.lane + 256 * j); db[j] = *(const v2u*)(A.Y + (size_t)(pb_) * DM + 4 * F.lane + 256 * j); } } while (0)
    if (COMBINE) {
        if (row < rend) { const int pa = A.pos[2 * row], pb = A.pos[2 * row + 1]; ga = A.gate[2 * row]; gb = A.gate[2 * row + 1];
            if (row + NWAVES < rend) { pan = A.pos[2 * (row + NWAVES)]; pbn = A.pos[2 * (row + NWAVES) + 1]; gan = A.gate[2 * (row + NWAVES)]; gbn = A.gate[2 * (row + NWAVES) + 1]; }
            YLOAD(ya, yb, pa, pb); }
    }
    for (; row < rend; row += NWAVES) {
        const bool lat = row < M; const int bidx = lat ? row / SEQ : NB;
        const int rnext = row + NWAVES;
        if (rnext < rend) ROWLOAD(vn, rnext);
        int pnn0 = 0, pnn1 = 0; float gnn0 = 0.f, gnn1 = 0.f;
        if (COMBINE) {
            if (rnext < rend) YLOAD(yan, ybn, pan, pbn);
            const int rnn = rnext + NWAVES;
            if (rnn < rend) { pnn0 = A.pos[2 * rnn]; pnn1 = A.pos[2 * rnn + 1]; gnn0 = A.gate[2 * rnn]; gnn1 = A.gate[2 * rnn + 1]; }
        }
        f32x4 gvv[4], shv4[4], scv4[4], g2v[4];
#pragma unroll
        for (int j = 0; j < 4; ++j) { const int col = 4 * F.lane + 256 * j; if (ROUTER) continue;
            gvv[j] = *(const f32x4*)(A.g + col);
            if (OUTMODE != 2) { shv4[j] = *(const f32x4*)(A.modl + bidx * NMOD + A.shoff + col); scv4[j] = *(const f32x4*)(A.modl + bidx * NMOD + A.scoff + col); }
            if (COMBINE) g2v[j] = *(const f32x4*)(A.modprev + bidx * NMOD + 5 * DM + col); }
        if (COMBINE) {
#pragma unroll
            for (int j = 0; j < 4; ++j) { const v2u wa = ya[j], wb = yb[j]; const f32x4 gv = g2v[j];
                v[j].x += gv.x * (ga * bflo(wa.x) + gb * bflo(wb.x)); v[j].y += gv.y * (ga * bfhi(wa.x) + gb * bfhi(wb.x));
                v[j].z += gv.z * (ga * bflo(wa.y) + gb * bflo(wb.y)); v[j].w += gv.w * (ga * bfhi(wa.y) + gb * bfhi(wb.y)); }
            if (OUTMODE != 2) {
#pragma unroll
                for (int j = 0; j < 4; ++j) { v2u o; o.x = pg8::cvt_pk_bf16(v[j].x, v[j].y); o.y = pg8::cvt_pk_bf16(v[j].z, v[j].w); *(v2u*)(A.hbo + (size_t)row * DM + 4 * F.lane + 256 * j) = o;
                    v[j] = (f32x4){bflo(o.x), bfhi(o.x), bflo(o.y), bfhi(o.y)}; }
            }
        }
        float s = 0.f;
#pragma unroll
        for (int j = 0; j < 4; ++j) s += (v[j].x * v[j].x + v[j].y * v[j].y) + (v[j].z * v[j].z + v[j].w * v[j].w);
        const float rstd = rsqrtf(wave_sum(s, F.lane) * (1.0f / DM) + EPS);
        if (OUTMODE == 2) {
            float* ho = A.fout + (size_t)row * DM;
#pragma unroll
            for (int j = 0; j < 4; ++j) { const int col = 4 * F.lane + 256 * j; *(f32x4*)(ho + col) = v[j] * rstd * gvv[j]; }
        } else {
            float lg[8];
            if (ROUTER) {
#pragma unroll
                for (int e = 0; e < 8; ++e) lg[e] = 0.f;
            }
#pragma unroll
            for (int j = 0; j < 4; ++j) { const int col = 4 * F.lane + 256 * j;
                if (ROUTER) { const LAS float* lv = LV + (bidx != lb0 ? 2048 : 0); gvv[j] = *(const LAS f32x4*)(LV + col); shv4[j] = *(const LAS f32x4*)(lv + 1024 + col); scv4[j] = *(const LAS f32x4*)(lv + 2048 + col); }
                f32x4 y = v[j] * rstd * gvv[j] * (scv4[j] + 1.0f) + shv4[j];
                if (!ROUTER && !F8OUT) { v2u o; o.x = pg8::cvt_pk_bf16(y.x, y.y); o.y = pg8::cvt_pk_bf16(y.z, y.w); *(v2u*)(A.U + (size_t)row * DM + col) = o; }
                else v[j] = y;
                if (ROUTER) {
#pragma unroll
                    for (int q = 0; q < 4; ++q) { const f32x4 r0 = rw[4 * j + q][0], r1 = rw[4 * j + q][1]; const float yy = y[q];
                        lg[0] += yy * r0.x; lg[1] += yy * r0.y; lg[2] += yy * r0.z; lg[3] += yy * r0.w; lg[4] += yy * r1.x; lg[5] += yy * r1.y; lg[6] += yy * r1.z; lg[7] += yy * r1.w; } }
            }
            if (ROUTER || F8OUT) {
                float am = 0.f, ss = 0.f;
#pragma unroll
                for (int j = 0; j < 4; ++j) { am = fmaxf(fmaxf(am, fmaxf(fabsf(v[j].x), fabsf(v[j].y))), fmaxf(fabsf(v[j].z), fabsf(v[j].w))); ss += (v[j].x * v[j].x + v[j].y * v[j].y) + (v[j].z * v[j].z + v[j].w * v[j].w); }
                am = fmaxf(wave_max(am, F.lane), 1e-30f); ss = wave_sum(ss, F.lane);
                const float inv = 256.0f / am;
#pragma unroll
                for (int j = 0; j < 4; ++j) *(unsigned*)(A.U8 + (size_t)row * DM + 4 * F.lane + 256 * j) = pk4_fp8(v[j].x * inv, v[j].y * inv, v[j].z * inv, v[j].w * inv);
                if (ROUTER) { if (F.lane == 0) { A.rsu[2 * row] = am * (1.0f / 256.0f); A.rsu[2 * row + 1] = ss; } }
                else if (F.lane == 0) { const float sa = am * (1.0f / 256.0f); const float sh = fmaxf(0.0625f * ss * A.st[1] * A.st[3], 1e-30f);
                    A.rs[row] = (f32x4){sa * A.st[0], sa * A.st[2], 1.0f / sh, sh * A.st[4]}; }
            }
            if (ROUTER) {
                const int b5 = F.lane >> 5, b4 = (F.lane >> 4) & 1, b3 = (F.lane >> 3) & 1; float a4[4], c2[2];
#pragma unroll
                for (int q = 0; q < 4; ++q) { const float mine = b5 ? lg[4 + q] : lg[q], oth = b5 ? lg[q] : lg[4 + q]; a4[q] = mine + shx(oth, F.lane, 32); }
#pragma unroll
                for (int q = 0; q < 2; ++q) { const float mine = b4 ? a4[2 + q] : a4[q], oth = b4 ? a4[q] : a4[2 + q]; c2[q] = mine + shx(oth, F.lane, 16); }
                float d1 = (b3 ? c2[1] : c2[0]) + shx(b3 ? c2[0] : c2[1], F.lane, 8);
                d1 += shx(d1, F.lane, 4); d1 += shx(d1, F.lane, 2); d1 += shx(d1, F.lane, 1);
#pragma unroll
                for (int e = 0; e < 8; ++e) lg[e] = __int_as_float(__builtin_amdgcn_readlane(__float_as_int(d1), 8 * e));
                int i0 = 0; float v0 = lg[0];
#pragma unroll
                for (int e = 1; e < 8; ++e) if (lg[e] > v0) { v0 = lg[e]; i0 = e; }
                int i1 = -1; float v1 = -INFINITY;
#pragma unroll
                for (int e = 0; e < 8; ++e) if (e != i0 && lg[e] > v1) { v1 = lg[e]; i1 = e; }
                const float g0 = 1.0f / (1.0f + __expf(v1 - v0));
                if (F.lane == 0) { A.eidx[2 * row] = i0; A.eidx[2 * row + 1] = i1; A.gout[2 * row] = g0; A.gout[2 * row + 1] = 1.0f - g0; atomicAdd((int*)&lcnt[i0], 1); atomicAdd((int*)&lcnt[i1], 1); }
            }
        }
#pragma unroll
        for (int j = 0; j < 4; ++j) v[j] = vn[j];
        if (COMBINE) {
#pragma unroll
            for (int j = 0; j < 4; ++j) { ya[j] = yan[j]; yb[j] = ybn[j]; }
            ga = gan; gb = gbn; pan = pnn0; pbn = pnn1; gan = gnn0; gbn = gnn1; }
    }
#undef ROWLOAD
#undef YLOAD
    if (ROUTER) { __syncthreads(); if (F.tid < 8) A.cnt[blockIdx.x * 8 + F.tid] = lcnt[F.tid]; __syncthreads(); }
}

using pg8::Unit; using pg8::cvt_pk_bf16;
__device__ __forceinline__ v4u pack8(const f32x4& a, const f32x4& b) { v4u w; w.x = cvt_pk_bf16(a[0], a[1]); w.y = cvt_pk_bf16(a[2], a[3]); w.z = cvt_pk_bf16(b[0], b[1]); w.w = cvt_pk_bf16(b[2], b[3]); return w; }
struct EpiIn {
    static constexpr bool PERM = true;
    bf16 *CQ, *KRR, *CKV, *H5; float* ssq_q; float* ssq_kv; const float* TC; const float* LBj; int jlayer;
    __device__ __forceinline__ void operator()(const f32x4 (&acc)[2][2][4][2], const Unit& u, int wr, int wc, int fr, int fq) const {
        const int row0 = u.pm * 256 + wr * 64 + fr; const int lane = fr + 16 * fq;
#pragma unroll
        for (int bj = 0; bj < 2; ++bj) {
            const int col = u.pn * 256 + bj * 128 + wc * 32 + 8 * fq;
            bf16* base; int ld;
            if (col < 384) { base = CQ + col; ld = QL; }
            else if (col < 512) { base = nullptr; ld = 0; }
            else if (col < 768) { base = CKV + (col - 512); ld = KVL; }
            else { const int c2 = col - 768; base = H5 + (size_t)(c2 >> 9) * HSEG + (c2 & 511); ld = HW; }
            const int hsel = (col >= 768) ? ((col - 768) >> 9) : 3;
            if (hsel <= 2) {
                f32x4 lb0 = (f32x4){0.f, 0.f, 0.f, 0.f}, lb1 = lb0; if (hsel >= 1 && jlayer == 1) { const float* l0_ = LBj + (hsel - 1) * HW + ((col - 768) & 511); const float* l1_ = l0_ + 2 * HW; const f32x4 a0 = *(const f32x4*)l0_, a1 = *(const f32x4*)(l0_ + 4), b0 = *(const f32x4*)l1_, b1 = *(const f32x4*)(l1_ + 4);
#pragma unroll
                    for (int q = 0; q < 4; ++q) { lb0[q] = 1.0f / (1.0f + __expf(a0[q] - b0[q])); lb1[q] = 1.0f / (1.0f + __expf(a1[q] - b1[q])); } }
#pragma unroll
                for (int ai = 0; ai < 2; ++ai)
#pragma unroll
                    for (int m = 0; m < 4; ++m) { const int row = row0 + ai * 128 + m * 16; f32x4 o[2];
#pragma unroll
                        for (int n = 0; n < 2; ++n)
#pragma unroll
                            for (int q = 0; q < 4; ++q) { const float x = acc[ai][bj][m][n][q]; const float sg = __builtin_amdgcn_rcpf(1.0f + __expf(-x)); const float lbv = n ? lb1[q] : lb0[q];
                                o[n][q] = (hsel == 0) ? x * sg : __logf(lbv + (1.0f - lbv) * sg); }
                        *(v4u*)(base + (size_t)row * ld) = pack8(o[0], o[1]); }
            } else if (base) {
#pragma unroll
                for (int ai = 0; ai < 2; ++ai)
#pragma unroll
                    for (int m = 0; m < 4; ++m) { const int row = row0 + ai * 128 + m * 16; *(v4u*)(base + (size_t)row * ld) = pack8(acc[ai][bj][m][0], acc[ai][bj][m][1]); }
            }
        }
        if (u.pn <= 2) {
            const int nb = (u.pn == 1) ? 1 : 2; float* dst = (u.pn == 2) ? ssq_kv : ssq_q;
#pragma unroll
            for (int ai = 0; ai < 2; ++ai)
#pragma unroll
                for (int m = 0; m < 4; ++m) { float ss = 0.f;
#pragma unroll
                    for (int bj = 0; bj < 2; ++bj) if (bj < nb) {
#pragma unroll
                        for (int n = 0; n < 2; ++n) { const f32x4 x = acc[ai][bj][m][n]; ss += (x[0] * x[0] + x[1] * x[1]) + (x[2] * x[2] + x[3] * x[3]); } }
                    ss += shx(ss, lane, 16); ss += shx(ss, lane, 32);
                    if (fq == 0) { const int row = row0 + ai * 128 + m * 16; if (u.pn == 2) dst[row * 4 + wc] = ss; else dst[row * 8 + u.pn * 4 + wc] = ss; } }
            if (u.pn == 1 && wc == 0) {
                const int a = fq >> 1, half = fq & 1;
#pragma unroll
                for (int ai = 0; ai < 2; ++ai)
#pragma unroll
                    for (int m = 0; m < 4; ++m) { const int row = row0 + ai * 128 + m * 16; f32x4 o[2];
                        const bool lat = row < M; const int t = row % SEQ; const int p = a ? (t & 63) : (t >> 6);
#pragma unroll
                        for (int n = 0; n < 2; ++n)
#pragma unroll
                            for (int q = 0; q < 4; ++q) { const float x = acc[ai][1][m][n][q]; const float pr = shx(x, lane, 16); const float c = TC[p * 8 + 4 * n + q], sn = TC[512 + p * 8 + 4 * n + q];
                                o[n][q] = lat ? (half ? x * c + pr * sn : x * c - pr * sn) : x; }
                        *(v4u*)(KRR + (size_t)row * ROPE + 8 * fq) = pack8(o[0], o[1]); }
            }
        }
    }
};
struct EpiQ {
    static constexpr bool PERM = true;
    bf16* O; const float* rs;
    __device__ __forceinline__ void operator()(const f32x4 (&acc)[2][2][4][2], const Unit& u, int wr, int wc, int fr, int fq) const {
        const int row0 = u.pm * 256 + wr * 64 + fr;
#pragma unroll
        for (int ai = 0; ai < 2; ++ai)
#pragma unroll
            for (int m = 0; m < 4; ++m) { const int row = row0 + ai * 128 + m * 16; const f32x4 p0 = *(const f32x4*)(rs + (size_t)row * 8), p1 = *(const f32x4*)(rs + (size_t)row * 8 + 4); const float sc = rsqrtf((((p0.x + p0.y) + (p0.z + p0.w)) + ((p1.x + p1.y) + (p1.z + p1.w))) * (1.0f / QL) + EPS);
#pragma unroll
                for (int bj = 0; bj < 2; ++bj) { const int col = u.pn * 256 + bj * 128 + wc * 32 + 8 * fq; *(v4u*)(O + (size_t)row * 768 + col) = pack8(acc[ai][bj][m][0] * sc, acc[ai][bj][m][1] * sc); } }
    }
};
struct EpiKV {
    static constexpr bool PERM = true;
    bf16* KNp; bf16* VTp; const float* rs;
    __device__ __forceinline__ void operator()(const f32x4 (&acc)[2][2][4][2], const Unit& u, int wr, int wc, int fr, int fq) const {
        const int row0 = u.pm * 256 + wr * 64 + fr;
#pragma unroll
        for (int ai = 0; ai < 2; ++ai)
#pragma unroll
            for (int m = 0; m < 4; ++m) { const int row = row0 + ai * 128 + m * 16; const f32x4 p0 = *(const f32x4*)(rs + (size_t)row * 4); const float sc = rsqrtf(((p0.x + p0.y) + (p0.z + p0.w)) * (1.0f / KVL) + EPS);
                const bool lat = row < M; const int b = lat ? row / SEQ : (row - M) / CTXL; const int key = lat ? row % SEQ : SEQ + (row - M) % CTXL;
                const int kpos = (key & ~12) | ((key & 4) << 1) | ((key & 8) >> 1);
#pragma unroll
                for (int bj = 0; bj < 2; ++bj) { const int col = u.pn * 256 + bj * 128 + wc * 32 + 8 * fq; const int hh = col >> 7, w = col & 127;
                    if (w < 64) { *(v4u*)(KNp + (size_t)row * HW + hh * 64 + w) = pack8(acc[ai][bj][m][0] * sc, acc[ai][bj][m][1] * sc); }
                    else { bf16* dst = VTp + ((size_t)((b * NH + hh) * VD + (w - 64))) * NKEY + kpos;
#pragma unroll
                        for (int n = 0; n < 2; ++n)
#pragma unroll
                            for (int q = 0; q < 4; ++q) dst[(size_t)(4 * n + q) * NKEY] = (bf16)f2bf(acc[ai][bj][m][n][q] * sc); } } }
    }
};
template <bool INF32, bool SC = false>
struct EpiResid {
    static constexpr bool PERM = true;
    const float* xin_l; const float* xin_c; bf16* hb; const float* modl; int goff; const f32x4* RS;
    __device__ __forceinline__ void operator()(const f32x4 (&acc)[2][2][4][2], const Unit& u, int wr, int wc, int fr, int fq) const {
        const int rowt = u.pm * 256; const bool lat = rowt < M; const int bidx = lat ? rowt / SEQ : NB;
        const float* gate = modl + bidx * NMOD + goff;
        const float* xi = lat ? xin_l + (size_t)rowt * DM : xin_c + (size_t)(rowt - M) * DM;
        bf16* ho = hb + (size_t)rowt * DM;
        float scv[2][4];
        if (SC) { const float* rp = (const float*)(RS + rowt + wr * 64 + fr) + 3;
#pragma unroll
            for (int ai = 0; ai < 2; ++ai)
#pragma unroll
                for (int m = 0; m < 4; ++m) scv[ai][m] = rp[(ai * 128 + m * 16) * 4]; }
        const unsigned off0 = (unsigned)((wr * 64 + fr) * DM + u.pn * 256 + wc * 32 + 8 * fq);
#pragma unroll
        for (int bj = 0; bj < 2; ++bj) { const f32x4 g0 = *(const f32x4*)(gate + (off0 & 1023u) + bj * 128), g1 = *(const f32x4*)(gate + (off0 & 1023u) + bj * 128 + 4);
#pragma unroll
            for (int ai = 0; ai < 2; ++ai) {
                if (INF32) { f32x4 h0[4], h1[4];
#pragma unroll
                    for (int m = 0; m < 4; ++m) { const unsigned off = off0 + (unsigned)((ai * 128 + m * 16) * DM + bj * 128); h0[m] = *(const f32x4*)(xi + off); h1[m] = *(const f32x4*)(xi + off + 4); }
#pragma unroll
                    for (int m = 0; m < 4; ++m) { const unsigned off = off0 + (unsigned)((ai * 128 + m * 16) * DM + bj * 128); *(v4u*)(ho + off) = pack8(h0[m] + g0 * acc[ai][bj][m][0], h1[m] + g1 * acc[ai][bj][m][1]); }
                } else { v4u hv[4];
#pragma unroll
                    for (int m = 0; m < 4; ++m) { const unsigned off = off0 + (unsigned)((ai * 128 + m * 16) * DM + bj * 128); hv[m] = *(const v4u*)(ho + off); }
#pragma unroll
                    for (int m = 0; m < 4; ++m) { const unsigned off = off0 + (unsigned)((ai * 128 + m * 16) * DM + bj * 128); const v4u w = hv[m];
                        const f32x4 a0 = (f32x4){bflo(w.x), bfhi(w.x), bflo(w.y), bfhi(w.y)}, a1 = (f32x4){bflo(w.z), bfhi(w.z), bflo(w.w), bfhi(w.w)};
                        if (SC) *(v4u*)(ho + off) = pack8(a0 + (g0 * scv[ai][m]) * acc[ai][bj][m][0], a1 + (g1 * scv[ai][m]) * acc[ai][bj][m][1]);
                        else *(v4u*)(ho + off) = pack8(a0 + g0 * acc[ai][bj][m][0], a1 + g1 * acc[ai][bj][m][1]); }
                }
                asm volatile("" ::: "memory"); } }
    }
};
struct EpiPool {
    static constexpr bool PERM = true;
    bf16* hb; const float* modl; const float* bias; const float* scale; int talloc;
    __device__ __forceinline__ void operator()(const f32x4 (&acc)[2][2][4][2], const Unit& u, int wr, int wc, int fr, int fq) const {
        const int g = u.pn, rowt = (u.pm - g * talloc) * 256; const bool lat = rowt < M; const int bidx = lat ? rowt / SEQ : NB;
        const float* gate = modl + bidx * NMOD + 2 * DM;
        bf16* ho = hb + (size_t)rowt * DM;
        const int col0 = g * 256 + wc * 32 + 8 * fq;
#pragma unroll
        for (int bj = 0; bj < 2; ++bj) { const int c = col0 + bj * 128;
            v4u hv[2][4];
#pragma unroll
            for (int ai = 0; ai < 2; ++ai)
#pragma unroll
                for (int m = 0; m < 4; ++m) hv[ai][m] = *(const v4u*)(ho + (size_t)(ai * 128 + wr * 64 + m * 16 + fr) * DM + c);
            const f32x4 gm0 = *(const f32x4*)(gate + c) * *(const f32x4*)(scale + c), gm1 = *(const f32x4*)(gate + c + 4) * *(const f32x4*)(scale + c + 4);
            const f32x4 gb0 = gm0 * *(const f32x4*)(bias + c), gb1 = gm1 * *(const f32x4*)(bias + c + 4);
#pragma unroll
            for (int ai = 0; ai < 2; ++ai)
#pragma unroll
                for (int m = 0; m < 4; ++m) { const v4u w = hv[ai][m]; const f32x4 a0 = (f32x4){bflo(w.x), bfhi(w.x), bflo(w.y), bfhi(w.y)}, a1 = (f32x4){bflo(w.z), bfhi(w.z), bflo(w.w), bfhi(w.w)};
                    *(v4u*)(ho + (size_t)(ai * 128 + wr * 64 + m * 16 + fr) * DM + c) = pack8(a0 + gm0 * acc[ai][bj][m][0] + gb0, a1 + gm1 * acc[ai][bj][m][1] + gb1); }
            asm volatile("" ::: "memory"); }
    }
};
struct EpiGateUp {
    static constexpr bool PERM = true;
    bf16* H; int ldh, nct, rowsub;
    __device__ __forceinline__ void operator()(const f32x4 (&acc)[2][2][4][2], const Unit& u, int wr, int wc, int fr, int fq) const {
        const int row0 = u.pm * 256 + wr * 64 + fr - rowsub; const int ct = u.pn % nct; const int col = ct * 128 + wc * 32 + 8 * fq;
#pragma unroll
        for (int ai = 0; ai < 2; ++ai)
#pragma unroll
            for (int m = 0; m < 4; ++m) { const int row = row0 + ai * 128 + m * 16; f32x4 o[2];
#pragma unroll
                for (int n = 0; n < 2; ++n)
#pragma unroll
                    for (int q = 0; q < 4; q += 2) { const f32x2 ag = {acc[ai][0][m][n][q], acc[ai][0][m][n][q + 1]}, au = {acc[ai][1][m][n][q], acc[ai][1][m][n][q + 1]};
                        const f32x2 t = ag * -1.4426950408889634f; const f32x2 d = (f32x2){__builtin_amdgcn_exp2f(t.x), __builtin_amdgcn_exp2f(t.y)} + 1.0f;
                        const f32x2 p = (ag * au) * (f32x2){__builtin_amdgcn_rcpf(d.x), __builtin_amdgcn_rcpf(d.y)};
                        o[n][q] = p.x; o[n][q + 1] = p.y; }
                *(v4u*)(H + (size_t)row * ldh + col) = pack8(o[0], o[1]); }
    }
};
struct EpiGateUp8 {
    static constexpr bool PERM = true;
    unsigned char* H; int ldh, nct, rowsub; const f32x4* RS;
    __device__ __forceinline__ void operator()(const f32x4 (&acc)[2][2][4][2], const Unit& u, int wr, int wc, int fr, int fq) const {
        const int pos0 = u.pm * 256 + wr * 64 + fr; const int ct = u.pn % nct; const int col = ct * 128 + wc * 32 + 8 * fq;
        const f32x4* rp = RS + pos0; f32x4 rsv[2][4];
#pragma unroll
        for (int ai = 0; ai < 2; ++ai)
#pragma unroll
            for (int m = 0; m < 4; ++m) rsv[ai][m] = rp[ai * 128 + m * 16];
#pragma unroll
        for (int ai = 0; ai < 2; ++ai)
#pragma unroll
            for (int m = 0; m < 4; ++m) { const int pos = pos0 + ai * 128 + m * 16; const f32x4 rs = rsv[ai][m]; f32x4 o[2];
                const float c1 = -1.4426950408889634f * rs.x, c2 = rs.x * rs.y * rs.z;
#pragma unroll
                for (int n = 0; n < 2; ++n)
#pragma unroll
                    for (int q = 0; q < 4; q += 2) { const f32x2 ag = {acc[ai][0][m][n][q], acc[ai][0][m][n][q + 1]}, au = {acc[ai][1][m][n][q], acc[ai][1][m][n][q + 1]};
                        const f32x2 t = ag * c1; const f32x2 d = (f32x2){__builtin_amdgcn_exp2f(t.x), __builtin_amdgcn_exp2f(t.y)} + 1.0f;
                        const f32x2 p = ((ag * au) * c2) * (f32x2){__builtin_amdgcn_rcpf(d.x), __builtin_amdgcn_rcpf(d.y)};
                        o[n][q] = clamp448(p.x); o[n][q + 1] = clamp448(p.y); }
                v2u w; w.x = pk4_fp8(o[0][0], o[0][1], o[0][2], o[0][3]); w.y = pk4_fp8(o[1][0], o[1][1], o[1][2], o[1][3]);
                *(v2u*)(H + (size_t)(pos - rowsub) * ldh + col) = w; }
    }
};
struct EpiY8 {
    static constexpr bool PERM = true;
    bf16* Y; int nct; const f32x4* RS;
    __device__ __forceinline__ void operator()(const f32x4 (&acc)[2][2][4][2], const Unit& u, int wr, int wc, int fr, int fq) const {
        const int row0 = u.pm * 256 + wr * 64 + fr; const int ct = u.pn % nct;
        const float* rp = (const float*)(RS + row0) + 3; float scv[2][4];
#pragma unroll
        for (int ai = 0; ai < 2; ++ai)
#pragma unroll
            for (int m = 0; m < 4; ++m) scv[ai][m] = rp[(ai * 128 + m * 16) * 4];
#pragma unroll
        for (int ai = 0; ai < 2; ++ai)
#pragma unroll
            for (int m = 0; m < 4; ++m) { const int row = row0 + ai * 128 + m * 16; const float sc = scv[ai][m];
#pragma unroll
                for (int bj = 0; bj < 2; ++bj) { const int col = ct * 256 + bj * 128 + wc * 32 + 8 * fq; *(v4u*)(Y + (size_t)row * DM + col) = pack8(acc[ai][bj][m][0] * sc, acc[ai][bj][m][1] * sc); } }
    }
};
struct EpiY {
    static constexpr bool PERM = true;
    bf16* Y; int nct;
    __device__ __forceinline__ void operator()(const f32x4 (&acc)[2][2][4][2], const Unit& u, int wr, int wc, int fr, int fq) const {
        const int row0 = u.pm * 256 + wr * 64 + fr; const int ct = u.pn % nct;
#pragma unroll
        for (int ai = 0; ai < 2; ++ai)
#pragma unroll
            for (int m = 0; m < 4; ++m) { const int row = row0 + ai * 128 + m * 16;
#pragma unroll
                for (int bj = 0; bj < 2; ++bj) { const int col = ct * 256 + bj * 128 + wc * 32 + 8 * fq; *(v4u*)(Y + (size_t)row * DM + col) = pack8(acc[ai][bj][m][0], acc[ai][bj][m][1]); } }
    }
};

__device__ __forceinline__ void p0_prologue(Frame& F) {
    fresh(F);
    unsigned char* ws = F.ws;
    const float qscale = 0.10206207261596577f * 1.4426950408889634f;
    for (int j = 0; j < 2; ++j) {
        conv_matrix(F, F.in[8] + (size_t)j * DM * INW, DM, INW, (bf16*)(ws + WS_WIN) + (size_t)j * INP * DM, DM, 1, 0, nullptr, 1.f);
        conv_matrix(F, F.in[11] + (size_t)j * QL * 768, QL, 768, (bf16*)(ws + WS_WUQ) + (size_t)j * 768 * QL, QL, 0, 0, F.in[9] + j * QL, qscale);
        conv_matrix(F, F.in[12] + (size_t)j * KVL * 1024, KVL, 1024, (bf16*)(ws + WS_WUKV) + (size_t)j * 1024 * KVL, KVL, 0, 0, F.in[10] + j * KVL, 1.f);
        conv_matrix(F, F.in[15] + (size_t)j * DM * DM, DM, DM, (bf16*)(ws + WS_WOUT) + (size_t)j * DM * DM, DM, 0, 0, nullptr, 1.f);
        for (int g = 0; g < 4; ++g)
            conv_matrix(F, F.in[19] + (size_t)(j * 4 + g) * 65536, 256, 256, (bf16*)(ws + WS_WPOOL) + (size_t)(j * 4 + g) * 65536, 256, 0, 0, nullptr, 1.f);
    }
    __syncthreads();
    if (blockIdx.x == 0 && F.tid < 8) {
        float* TC = (float*)(ws + WS_ROPE); float* TS = TC + 512;
        double th = 1.0; for (int i = 0; i < F.tid; ++i) th *= 0.31622776601683794;
        const double x2 = th * th; double s = th, c = 1.0, ts = th, tc = 1.0;
        for (int n = 1; n <= 12; ++n) { tc *= -x2 / (double)((2 * n - 1) * (2 * n)); c += tc; ts *= -x2 / (double)((2 * n) * (2 * n + 1)); s += ts; }
        double cp = 1.0, sp = 0.0;
        for (int p = 0; p < 64; ++p) { TC[p * 8 + F.tid] = (float)cp; TS[p * 8 + F.tid] = (float)sp; const double ncp = cp * c - sp * s; sp = sp * c + cp * s; cp = ncp; }
    }
    {
        LAS float* sc = (LAS float*)(F.lds + RING_OFF);
        LAS float* red = sc + 17 * 1024;
        const int nitems = 4 * (NMOD / 64);
        if ((int)blockIdx.x < nitems) {
            for (int e = F.tid; e < 17 * 1024; e += 512) { const int r = e >> 10, k = e & 1023; const float x = (r < 16) ? F.in[1][r * 1024 + k] : F.in[3][k]; sc[e] = siluf_(x); }
            __syncthreads();
            for (int it = blockIdx.x; it < nitems; it += F.G) {
                const int l = it / (NMOD / 64), c0 = (it % (NMOD / 64)) * 64;
                const float* W = F.in[4] + (size_t)l * DM * NMOD + c0 + F.lane;
                float acc[17];
#pragma unroll
                for (int r = 0; r < 17; ++r) acc[r] = 0.f;
                const int kb = F.wave * 128;
                for (int k = 0; k < 128; k += 4) {
                    const float w0 = W[(size_t)(kb + k) * NMOD], w1 = W[(size_t)(kb + k + 1) * NMOD], w2 = W[(size_t)(kb + k + 2) * NMOD], w3 = W[(size_t)(kb + k + 3) * NMOD];
#pragma unroll
                    for (int r = 0; r < 17; ++r) { const f32x4 s4 = *(const LAS f32x4*)(sc + r * 1024 + kb + k); acc[r] += s4.x * w0 + s4.y * w1 + s4.z * w2 + s4.w * w3; }
                }
#pragma unroll
                for (int r = 0; r < 17; ++r) red[(F.wave * 17 + r) * 64 + F.lane] = acc[r];
                __syncthreads();
                for (int o = F.tid; o < 17 * 64; o += 512) { const int r = o >> 6, cc = o & 63; float s = 0.f;
#pragma unroll
                    for (int w = 0; w < 8; ++w) s += red[(w * 17 + r) * 64 + cc];
                    ((float*)(ws + WS_MODV))[(size_t)(l * 17 + r) * NMOD + c0 + cc] = s + F.in[5][l * NMOD + c0 + cc]; }
                __syncthreads();
            }
        }
    }
    if ((int)blockIdx.x < 54) {
        const int mi = blockIdx.x, jj = mi / 24, r = mi % 24, e = r / 3, wh = r % 3;
        const bool dense = mi >= 48; const int dj = (mi - 48) / 3, dw = (mi - 48) % 3;
        const float* W = dense ? F.in[16 + dw] + (size_t)dj * DM * DFF : F.in[23 + wh] + ((size_t)jj * NE + e) * DM * DFE;
        const int sstep = dense ? 175 : 223;
        LAS float* red = (LAS float*)(F.lds + RING_OFF);
        __syncthreads();
        float am = 0.f, ss = 0.f;
#pragma unroll 8
        for (int i = 0; i < 32; ++i) { const float w = W[(size_t)(F.tid + 512 * i) * sstep]; am = fmaxf(am, fabsf(w)); ss += w * w; }
        am = wave_max(am, F.lane); ss = wave_sum(ss, F.lane);
        if (F.lane == 0) { red[F.wave] = am; red[8 + F.wave] = ss; }
        __syncthreads();
        if (F.tid == 0) { float a = 0.f, q = 0.f;
            for (int w = 0; w < 8; ++w) { a = fmaxf(a, red[w]); q += red[8 + w]; }
            float* ST = (float*)(ws + WS_WSTAT) + mi * 2; ST[0] = fmaxf(a, 1e-30f) * (1.0f / 64.0f); ST[1] = sqrtf(q * (1.0f / 16384.0f)); }
        __syncthreads();
    }
}

typedef short bf16x8v __attribute__((ext_vector_type(8)));
typedef float f32x16 __attribute__((ext_vector_type(16)));
__device__ __forceinline__ void attn_unit(Frame& F, int b, int h, int qrow0, bool rope_q, int t_lo, int t_hi) {
    unsigned char* ws = F.ws;
    const bf16* QB = (const bf16*)(ws + WS_QB); const bf16* KN = (const bf16*)(ws + WS_KN); const bf16* KRR = (const bf16*)(ws + WS_KRR); const bf16* VT = (const bf16*)(ws + WS_VV);
    bf16* MIX = (bf16*)(ws + WS_MIX); const float* TC = (const float*)(ws + WS_ROPE); const float* TS = TC + 512;
    const int lane = F.lane, wave = F.wave, r32 = lane & 31, hi = lane >> 5;
    LAS unsigned char* ring = F.lds + RING_OFF;
    const int qrow = qrow0 + wave * 32 + r32;
    bf16x8v qr[6];
#pragma unroll
    for (int d0 = 0; d0 < 6; ++d0) qr[d0] = *(const bf16x8v*)(QB + (size_t)qrow * 768 + h * QKD + 16 * d0 + 8 * hi);
    if (rope_q) { const int t = qrow % SEQ;
#pragma unroll
        for (int a = 0; a < 2; ++a) { const int p = a ? (t & 63) : (t >> 6); const v4u w = __builtin_bit_cast(v4u, qr[4 + a]); float x[8], y[8];
            x[0] = bflo(w.x); x[1] = bfhi(w.x); x[2] = bflo(w.y); x[3] = bfhi(w.y); x[4] = bflo(w.z); x[5] = bfhi(w.z); x[6] = bflo(w.w); x[7] = bfhi(w.w);
#pragma unroll
            for (int jj = 0; jj < 8; ++jj) { const float pr = shx(x[jj], lane, 32); const float c = TC[p * 8 + jj], sn = TS[p * 8 + jj]; y[jj] = hi ? x[jj] * c + pr * sn : x[jj] * c - pr * sn; }
            v4u o; o.x = pk2(y[0], y[1]); o.y = pk2(y[2], y[3]); o.z = pk2(y[4], y[5]); o.w = pk2(y[6], y[7]); qr[4 + a] = __builtin_bit_cast(bf16x8v, o); } }
    const int bh = b * NH + h;
    const bf16* vsrc = VT + ((size_t)(bh * VD + lane)) * NKEY + 8 * wave;
#define ATT_DMA(t, buf) do { const int t_ = (t); const int r0_ = t_ < SEQ / 64 ? b * SEQ + 64 * t_ : M + b * CTXL + 64 * (t_ - SEQ / 64); \
        LAS unsigned char* kb_ = ring + (buf) * 20480; LAS unsigned char* vb_ = kb_ + 12288; \
        __builtin_amdgcn_global_load_lds((const unsigned*)(KN + (size_t)(r0_ + lane) * HW + h * 64 + 8 * wave), (LAS unsigned*)(kb_ + wave * 1024), 16, 0, 0); \
        __builtin_amdgcn_global_load_lds((const unsigned*)(KRR + (size_t)(r0_ + lane) * ROPE + 8 * (wave & 3)), (LAS unsigned*)(kb_ + (8 + (wave & 3)) * 1024), 16, 0, 0);     \
        __builtin_amdgcn_global_load_lds((const unsigned*)(vsrc + 64 * t_), (LAS unsigned*)(vb_ + wave * 1024), 16, 0, 0); } while (0)
    f32x16 o0, o1;
#pragma unroll
    for (int r = 0; r < 16; ++r) { o0[r] = 0.f; o1[r] = 0.f; }
    constexpr float ATT_THR = 8.0f;
    float m_run = 0.f, l_run = 0.f;
    asm volatile("s_waitcnt vmcnt(0)" ::: "memory");
    ATT_DMA(t_lo, 0); if (t_lo + 1 < t_hi) ATT_DMA(t_lo + 1, 1); if (t_lo + 2 < t_hi) ATT_DMA(t_lo + 2, 2);
    for (int t = t_lo; t < t_hi; ++t) {
        const int buf = (t - t_lo) & 3; const int rem = t_hi - 1 - t;
        if (rem >= 2) asm volatile("s_waitcnt vmcnt(6)" ::: "memory"); else if (rem == 1) asm volatile("s_waitcnt vmcnt(3)" ::: "memory"); else asm volatile("s_waitcnt vmcnt(0)" ::: "memory");
        asm volatile("s_waitcnt lgkmcnt(0)" ::: "memory"); __builtin_amdgcn_s_barrier(); asm volatile("" ::: "memory");
        if (t + 3 < t_hi) ATT_DMA(t + 3, (buf + 3) & 3);
        const LAS unsigned char* kb = ring + buf * 20480 + hi * 1024 + r32 * 16; const LAS unsigned char* vb = ring + buf * 20480 + 12288 + hi * 1024 + r32 * 16;
        bf16x8v kf[12], vf[8];
#pragma unroll
        for (int d0 = 0; d0 < 6; ++d0) { kf[2 * d0] = *(const LAS bf16x8v*)(kb + d0 * 2048); kf[2 * d0 + 1] = *(const LAS bf16x8v*)(kb + d0 * 2048 + 512); }
#pragma unroll
        for (int s4 = 0; s4 < 4; ++s4) { vf[2 * s4] = *(const LAS bf16x8v*)(vb + s4 * 2048); vf[2 * s4 + 1] = *(const LAS bf16x8v*)(vb + s4 * 2048 + 512); }
        f32x16 p0, p1; const float negm = -m_run;
#pragma unroll
        for (int r = 0; r < 16; ++r) { p0[r] = negm; p1[r] = negm; }
#pragma unroll
        for (int d0 = 0; d0 < 6; ++d0) { p0 = __builtin_amdgcn_mfma_f32_32x32x16_bf16(kf[2 * d0], qr[d0], p0, 0, 0, 0); p1 = __builtin_amdgcn_mfma_f32_32x32x16_bf16(kf[2 * d0 + 1], qr[d0], p1, 0, 0, 0); }
        float ma = __builtin_fmaxf(__builtin_fmaxf(p0[0], p0[1]), p1[0]), mb = __builtin_fmaxf(__builtin_fmaxf(p0[2], p0[3]), p1[1]); ma = __builtin_fmaxf(__builtin_fmaxf(ma, p1[2]), p1[3]);
#pragma unroll
        for (int r = 4; r < 16; r += 4) { ma = __builtin_fmaxf(__builtin_fmaxf(ma, p0[r]), p0[r + 1]); mb = __builtin_fmaxf(__builtin_fmaxf(mb, p0[r + 2]), p0[r + 3]); ma = __builtin_fmaxf(__builtin_fmaxf(ma, p1[r]), p1[r + 1]); mb = __builtin_fmaxf(__builtin_fmaxf(mb, p1[r + 2]), p1[r + 3]); }
        float mt = __builtin_fmaxf(ma, mb);
        { auto rr = __builtin_amdgcn_permlane32_swap(__float_as_uint(mt), __float_as_uint(mt), false, false); mt = __builtin_fmaxf(__uint_as_float(rr[0]), __uint_as_float(rr[1])); }
        const bool first = (t == t_lo);
        if (first || __any(mt > ATT_THR)) {
            const float dl = first ? mt : __builtin_fmaxf(mt, 0.f); m_run += dl; const float alpha = __builtin_amdgcn_exp2f(-dl); l_run *= alpha;
#pragma unroll
            for (int r = 0; r < 16; ++r) { p0[r] -= dl; p1[r] -= dl; o0[r] *= alpha; o1[r] *= alpha; }
        }
        float ps0 = 0.f, ps1 = 0.f;
#pragma unroll
        for (int r = 0; r < 16; ++r) { p0[r] = __builtin_amdgcn_exp2f(p0[r]); p1[r] = __builtin_amdgcn_exp2f(p1[r]); ps0 += p0[r]; ps1 += p1[r]; }
        l_run += ps0 + ps1;
        v4u pw[4];
#pragma unroll
        for (int q = 0; q < 4; ++q) { pw[0][q] = cvt_pk_bf16(p0[2 * q], p0[2 * q + 1]); pw[1][q] = cvt_pk_bf16(p0[8 + 2 * q], p0[8 + 2 * q + 1]); pw[2][q] = cvt_pk_bf16(p1[2 * q], p1[2 * q + 1]); pw[3][q] = cvt_pk_bf16(p1[8 + 2 * q], p1[8 + 2 * q + 1]); }
#pragma unroll
        for (int s4 = 0; s4 < 4; ++s4) { const bf16x8v pa = __builtin_bit_cast(bf16x8v, pw[s4]);
            o0 = __builtin_amdgcn_mfma_f32_32x32x16_bf16(vf[2 * s4], pa, o0, 0, 0, 0); o1 = __builtin_amdgcn_mfma_f32_32x32x16_bf16(vf[2 * s4 + 1], pa, o1, 0, 0, 0); }
    }
    { auto rr = __builtin_amdgcn_permlane32_swap(__float_as_uint(l_run), __float_as_uint(l_run), false, false); l_run = __uint_as_float(rr[0]) + __uint_as_float(rr[1]); }
    const float rl = 1.0f / l_run;
    bf16* orow = MIX + (size_t)qrow * DM + h * VD;
#pragma unroll
    for (int g = 0; g < 4; ++g) { v2u a, c2; a.x = pk2(o0[4 * g] * rl, o0[4 * g + 1] * rl); a.y = pk2(o0[4 * g + 2] * rl, o0[4 * g + 3] * rl); c2.x = pk2(o1[4 * g] * rl, o1[4 * g + 1] * rl); c2.y = pk2(o1[4 * g + 2] * rl, o1[4 * g + 3] * rl);
        *(v2u*)(orow + 8 * g + 4 * hi) = a; *(v2u*)(orow + 32 + 8 * g + 4 * hi) = c2; }
    asm volatile("s_waitcnt vmcnt(0) lgkmcnt(0)" ::: "memory"); __builtin_amdgcn_s_barrier(); asm volatile("" ::: "memory");
#undef ATT_DMA
}
__device__ __forceinline__ void hgrn_item(Frame& F, int j, int it);
__device__ __forceinline__ void mix_phase(Frame& F, int j, bool ctx_out) {
    fresh(F);
    const int npair = F.G >> 1;
    for (int P = F.vcu >> 1; P < NB * NH; P += npair) {
        const int b = P >> 3, h = P & 7;
        if ((F.vcu & 1) == 0) {
            hgrn_item(F, j, P);
            for (int qb = 6; qb < 8; ++qb) attn_unit(F, b, h, b * SEQ + qb * 256, true, 0, NKEY / 64);
            if (ctx_out) attn_unit(F, b, h, M + b * CTXL, false, SEQ / 64, NKEY / 64);
            if (npair >= NB * NH) { fresh(F); conv_items(F, F.in, j, (P * NWAVES + F.wave) * CONV_MIX, 1, CONV_MIX); }
        } else {
            for (int qb = 0; qb < 6; ++qb) attn_unit(F, b, h, b * SEQ + qb * 256, true, 0, NKEY / 64);
        }
    }
    __syncthreads();
}

__device__ __forceinline__ int hgrn_row(int b, int dir, int ig) { return (ig < CTXL) ? (M + b * CTXL + (dir ? CTXL - 1 - ig : ig)) : (b * SEQ + (dir ? SEQ - 1 - (ig - CTXL) : (ig - CTXL))); }
__device__ __forceinline__ void hgrn_item(Frame& F, int j, int it) {
    unsigned char* ws = F.ws;
    const bf16* HQ = (const bf16*)(ws + WS_HQ); const bf16* HFF = HQ + HSEG; const bf16* HFB = HQ + 2 * HSEG; const bf16* HI = HQ + 3 * HSEG;
    LAS unsigned char* ring = F.lds + RING_OFF;
    LAS unsigned char* QN = ring; LAS unsigned char* KN = ring + 17408; LAS unsigned char* KT = ring + 34816; LAS unsigned char* VT = ring + 53248; LAS unsigned char* ST = ring + 71680;
    LAS float* TOT = (LAS float*)(ring + 106496); LAS unsigned char* RQ = ring + 108544; LAS unsigned char* RF = ring + 124928; LAS float* EW = (LAS float*)(ring + 141312);
    const int lane0 = F.lane, wave = F.wave;
    const int part = wave >> 1;
    const int kb = wave >> 1, vb0 = 2 * (wave & 1);
    const int ib = wave >> 2, vbo = wave & 3;
    const int dir = it & 1, hh = (it >> 1) & 3, b = it >> 3;
    const bf16* HF = dir ? HFB : HFF; bf16* OO = (bf16*)(ws + (dir ? WS_OB : WS_OF));
    f32x16 S0, S1;
#pragma unroll
    for (int r = 0; r < 16; ++r) { S0[r] = 0.f; S1[r] = 0.f; }
#define LBAR() do { asm volatile("s_waitcnt lgkmcnt(0)" ::: "memory"); __builtin_amdgcn_s_barrier(); asm volatile("" ::: "memory"); } while (0)
#define HG_BASE(c_) ((c_) < CTXL / 64 ? M + b * CTXL + (dir ? CTXL - 64 - 64 * (c_) : 64 * (c_)) : b * SEQ + (dir ? SEQ - 64 - 64 * ((c_) - CTXL / 64) : 64 * ((c_) - CTXL / 64)))
#define HG_DMA(c_) do { const int rb_ = HG_BASE(c_); \
        _Pragma("unroll") for (int p_ = 0; p_ < 2; ++p_) { const int pc_ = wave * 2 + p_; const size_t go_ = (size_t)(rb_ + 4 * pc_ + (lane >> 4)) * HW + hh * HK + 8 * (lane & 15); \
            __builtin_amdgcn_global_load_lds((const unsigned*)(HQ + go_), (LAS unsigned*)(RQ + pc_ * 1024), 16, 0, 0); __builtin_amdgcn_global_load_lds((const unsigned*)(HF + go_), (LAS unsigned*)(RF + pc_ * 1024), 16, 0, 0); } } while (0)
#define HG_VLD(c_) do { const size_t go_ = (size_t)(HG_BASE(c_) + (dir ? 63 - lane : lane)) * HW + hh * HK + 16 * wave; rv0 = *(const v4u*)(HI + go_); rv1 = *(const v4u*)(HI + go_ + 8); } while (0)
    v4u rv0, rv1;
    { const int lane = lane0; HG_DMA(0); HG_VLD(0); }
    asm volatile("s_waitcnt vmcnt(0)" ::: "memory"); LBAR();
    for (int ch = 0; ch < NKEY / 64; ++ch) {
        int lane_ = lane0; asm volatile("" : "+v"(lane_));
        const int lane = lane_, r32 = lane & 31, hi = lane >> 5, k = (wave & 1) * 64 + lane;
        const int pos = (lane & ~12) | ((lane & 4) << 1) | ((lane & 8) >> 1);
        float qv[16], kin[16], pf[16]; float run = 0.f, prod = 1.f;
#pragma unroll
        for (int ii = 0; ii < 16; ++ii) { const int i = 16 * part + ii, mr = dir ? 63 - i : i; qv[ii] = bf2f(*(const LAS bf16*)(RQ + mr * 256 + k * 2)); const float a = bf2f(*(const LAS bf16*)(RF + mr * 256 + k * 2));
            const float f = __expf(a); kin[ii] = 1.0f - f; prod *= f; pf[ii] = prod; run += a; }
        TOT[part * 128 + k] = run;
        { LAS bf16* vt = (LAS bf16*)(VT + (16 * wave) * 144 + pos * 2);
          vt[0 * 72] = (bf16)(rv0.x & 0xffffu); vt[1 * 72] = (bf16)(rv0.x >> 16); vt[2 * 72] = (bf16)(rv0.y & 0xffffu); vt[3 * 72] = (bf16)(rv0.y >> 16);
          vt[4 * 72] = (bf16)(rv0.z & 0xffffu); vt[5 * 72] = (bf16)(rv0.z >> 16); vt[6 * 72] = (bf16)(rv0.w & 0xffffu); vt[7 * 72] = (bf16)(rv0.w >> 16);
          vt[8 * 72] = (bf16)(rv1.x & 0xffffu); vt[9 * 72] = (bf16)(rv1.x >> 16); vt[10 * 72] = (bf16)(rv1.y & 0xffffu); vt[11 * 72] = (bf16)(rv1.y >> 16);
          vt[12 * 72] = (bf16)(rv1.z & 0xffffu); vt[13 * 72] = (bf16)(rv1.z >> 16); vt[14 * 72] = (bf16)(rv1.w & 0xffffu); vt[15 * 72] = (bf16)(rv1.w >> 16); }
        LBAR();
        if (ch + 1 < NKEY / 64) { HG_DMA(ch + 1); HG_VLD(ch + 1); }
        { const float t0 = TOT[k], t1 = TOT[128 + k], t2 = TOT[256 + k];
          const float base = (part > 0 ? t0 : 0.f) + (part > 1 ? t1 : 0.f) + (part > 2 ? t2 : 0.f); const float rr = t0 + t1;
          unsigned kt[8];
          const float E0 = __expf(fminf(base - rr, 80.f));
#pragma unroll
          for (int ii = 0; ii < 16; ii += 2) { const float e0 = E0 * pf[ii], e1 = E0 * pf[ii + 1]; const float q0 = qv[ii] * e0, q1 = qv[ii + 1] * e1, k0 = kin[ii] * __builtin_amdgcn_rcpf(e0), k1 = kin[ii + 1] * __builtin_amdgcn_rcpf(e1);
              const unsigned qp = cvt_pk_bf16(q0, q1), kp = cvt_pk_bf16(k0, k1);
              *(LAS bf16*)(QN + (16 * part + ii) * 272 + k * 2) = (bf16)(qp & 0xffffu); *(LAS bf16*)(QN + (16 * part + ii + 1) * 272 + k * 2) = (bf16)(qp >> 16);
              *(LAS bf16*)(KN + (16 * part + ii) * 272 + k * 2) = (bf16)(kp & 0xffffu); *(LAS bf16*)(KN + (16 * part + ii + 1) * 272 + k * 2) = (bf16)(kp >> 16);
              kt[ii >> 1] = kp; }
          *(LAS v4u*)(KT + k * 144 + part * 32) = (v4u){kt[0], kt[1], kt[4], kt[5]}; *(LAS v4u*)(KT + k * 144 + part * 32 + 16) = (v4u){kt[2], kt[3], kt[6], kt[7]}; }
        { const int kx = kb * 32 + r32; const float v_ = hi ? (TOT[256 + kx] + TOT[384 + kx]) : (TOT[kx] + TOT[128 + kx]); EW[wave * 64 + lane] = __expf(v_); asm volatile("s_waitcnt lgkmcnt(0)" ::: "memory"); }
        f32x16 T0, T1;
#pragma unroll
        for (int g4 = 0; g4 < 4; ++g4) { const int kk = kb * 32 + 8 * g4 + 4 * hi; const f32x4 er = *(const LAS f32x4*)(EW + wave * 64 + 8 * g4 + 4 * hi);
            T0[4 * g4] = S0[4 * g4] * er.x; T0[4 * g4 + 1] = S0[4 * g4 + 1] * er.y; T0[4 * g4 + 2] = S0[4 * g4 + 2] * er.z; T0[4 * g4 + 3] = S0[4 * g4 + 3] * er.w;
            T1[4 * g4] = S1[4 * g4] * er.x; T1[4 * g4 + 1] = S1[4 * g4 + 1] * er.y; T1[4 * g4 + 2] = S1[4 * g4 + 2] * er.z; T1[4 * g4 + 3] = S1[4 * g4 + 3] * er.w;
            v2u o; o.x = cvt_pk_bf16(T0[4 * g4], T0[4 * g4 + 1]); o.y = cvt_pk_bf16(T0[4 * g4 + 2], T0[4 * g4 + 3]); *(LAS v2u*)(ST + (vb0 * 32 + r32) * 272 + kk * 2) = o;
            o.x = cvt_pk_bf16(T1[4 * g4], T1[4 * g4 + 1]); o.y = cvt_pk_bf16(T1[4 * g4 + 2], T1[4 * g4 + 3]); *(LAS v2u*)(ST + (vb0 * 32 + 32 + r32) * 272 + kk * 2) = o; }
        LBAR();
#pragma unroll
        for (int st = 0; st < 4; ++st) { const bf16x8v kf = *(const LAS bf16x8v*)(KT + (kb * 32 + r32) * 144 + st * 32 + hi * 16);
            const bf16x8v va = *(const LAS bf16x8v*)(VT + (vb0 * 32 + r32) * 144 + st * 32 + hi * 16), vc = *(const LAS bf16x8v*)(VT + (vb0 * 32 + 32 + r32) * 144 + st * 32 + hi * 16);
            T0 = __builtin_amdgcn_mfma_f32_32x32x16_bf16(kf, va, T0, 0, 0, 0); T1 = __builtin_amdgcn_mfma_f32_32x32x16_bf16(kf, vc, T1, 0, 0, 0); }
#pragma unroll
        for (int g4 = 0; g4 < 4; ++g4) { const f32x4 eg = *(const LAS f32x4*)(EW + wave * 64 + 32 + 8 * g4 + 4 * hi);
            S0[4 * g4] = T0[4 * g4] * eg.x; S0[4 * g4 + 1] = T0[4 * g4 + 1] * eg.y; S0[4 * g4 + 2] = T0[4 * g4 + 2] * eg.z; S0[4 * g4 + 3] = T0[4 * g4 + 3] * eg.w;
            S1[4 * g4] = T1[4 * g4] * eg.x; S1[4 * g4 + 1] = T1[4 * g4 + 1] * eg.y; S1[4 * g4 + 2] = T1[4 * g4 + 2] * eg.z; S1[4 * g4 + 3] = T1[4 * g4 + 3] * eg.w; }
        asm volatile("" ::: "memory");
        {
            bf16x8v qf[8];
#pragma unroll
            for (int ks = 0; ks < 8; ++ks) qf[ks] = *(const LAS bf16x8v*)(QN + (ib * 32 + r32) * 272 + ks * 32 + hi * 16);
            asm volatile("" ::: "memory");
            f32x16 O;
#pragma unroll
            for (int r = 0; r < 16; ++r) O[r] = 0.f;
#pragma unroll
            for (int ks = 0; ks < 8; ++ks) { const bf16x8v sf = *(const LAS bf16x8v*)(ST + (vbo * 32 + r32) * 272 + ks * 32 + hi * 16); O = __builtin_amdgcn_mfma_f32_32x32x16_bf16(qf[ks], sf, O, 0, 0, 0); }
            asm volatile("" ::: "memory");
#pragma unroll 1
            for (int sb = 0; sb <= ib; ++sb) {
                f32x16 X;
#pragma unroll
                for (int r = 0; r < 16; ++r) X[r] = 0.f;
#pragma unroll
                for (int ks = 0; ks < 8; ++ks) { const bf16x8v kf = *(const LAS bf16x8v*)(KN + (sb * 32 + r32) * 272 + ks * 32 + hi * 16); X = __builtin_amdgcn_mfma_f32_32x32x16_bf16(kf, qf[ks], X, 0, 0, 0); }
                if (sb == ib) {
#pragma unroll
                    for (int r = 0; r < 16; ++r) { const int srow = (r & 3) + 8 * (r >> 2) + 4 * hi; if (srow > r32) X[r] = 0.f; }
                }
                asm volatile("" ::: "memory");
#pragma unroll
                for (int st = 0; st < 2; ++st) { v4u pw;
#pragma unroll
                    for (int q = 0; q < 4; ++q) pw[q] = cvt_pk_bf16(X[8 * st + 2 * q], X[8 * st + 2 * q + 1]);
                    const bf16x8v vf = *(const LAS bf16x8v*)(VT + (vbo * 32 + r32) * 144 + (sb * 32 + st * 16) * 2 + hi * 16);
                    O = __builtin_amdgcn_mfma_f32_32x32x16_bf16(__builtin_bit_cast(bf16x8v, pw), vf, O, 0, 0, 0); }
                asm volatile("" ::: "memory");
            }
            asm volatile("s_waitcnt vmcnt(0)" ::: "memory");
            const int rb = HG_BASE(ch); bf16* op = OO + (size_t)rb * HW + hh * HK + vbo * 32 + r32;
#pragma unroll
            for (int r = 0; r < 16; ++r) { const int i = ib * 32 + (r & 3) + 8 * (r >> 2) + 4 * hi; op[(size_t)(dir ? 63 - i : i) * HW] = (bf16)f2bf(O[r]); }
        }
        LBAR();
    }
    asm volatile("s_waitcnt vmcnt(0)" ::: "memory");
#undef LBAR
#undef HG_DMA
#undef HG_VLD
#undef HG_BASE
}

__device__ __forceinline__ void e8_phase(Frame& F, int j, int nrows) {
    fresh(F);
    unsigned char* ws = F.ws;
    const bf16* OF = (const bf16*)(ws + WS_OF); const bf16* OB = (const bf16*)(ws + WS_OB); const bf16* HG = (const bf16*)(ws + WS_HQ) + 4 * HSEG; bf16* MIX = (bf16*)(ws + WS_MIX);
    const float* gn = F.in[14] + j * HK;
    const int rpw = (nrows + F.G - 1) / F.G, rbase = (int)blockIdx.x * rpw, rend = (rbase + rpw < nrows) ? rbase + rpw : nrows;
    const int col = 8 * F.lane, vv = col & 127; const f32x4 g0 = *(const f32x4*)(gn + vv), g1 = *(const f32x4*)(gn + vv + 4);
    for (int r0 = rbase + F.wave; r0 < rend; r0 += 2 * NWAVES) {
        f32x4 a0[2], a1[2], b0[2], b1[2]; v4u hg[2];
#pragma unroll
        for (int q = 0; q < 2; ++q) { const int row = r0 + q * NWAVES; if (row < rend) {
            { const v4u wa = *(const v4u*)(OF + (size_t)row * HW + col), wb = *(const v4u*)(OB + (size_t)row * HW + col);
              a0[q] = (f32x4){bflo(wa.x), bfhi(wa.x), bflo(wa.y), bfhi(wa.y)}; a1[q] = (f32x4){bflo(wa.z), bfhi(wa.z), bflo(wa.w), bfhi(wa.w)};
              b0[q] = (f32x4){bflo(wb.x), bfhi(wb.x), bflo(wb.y), bfhi(wb.y)}; b1[q] = (f32x4){bflo(wb.z), bfhi(wb.z), bflo(wb.w), bfhi(wb.w)}; }
            hg[q] = *(const v4u*)(HG + (size_t)row * HW + col); } }
#pragma unroll
        for (int q = 0; q < 2; ++q) { const int row = r0 + q * NWAVES; if (row < rend) {
            f32x4 x0 = a0[q] + b0[q], x1 = a1[q] + b1[q];
            float s = (x0.x * x0.x + x0.y * x0.y) + (x0.z * x0.z + x0.w * x0.w) + (x1.x * x1.x + x1.y * x1.y) + (x1.z * x1.z + x1.w * x1.w);
            s += shx(s, F.lane, 1); s += shx(s, F.lane, 2); s += shx(s, F.lane, 4); s += shx(s, F.lane, 8);
            const float rstd = rsqrtf(s * (1.0f / HK) + EPS);
            x0 = x0 * rstd * g0; x1 = x1 * rstd * g1; const v4u h = hg[q];
            v4u o; o.x = pg8::cvt_pk_bf16(x0.x * siluf_(bflo(h.x)), x0.y * siluf_(bfhi(h.x))); o.y = pg8::cvt_pk_bf16(x0.z * siluf_(bflo(h.y)), x0.w * siluf_(bfhi(h.y)));
            o.z = pg8::cvt_pk_bf16(x1.x * siluf_(bflo(h.z)), x1.y * siluf_(bfhi(h.z))); o.w = pg8::cvt_pk_bf16(x1.z * siluf_(bflo(h.w)), x1.w * siluf_(bfhi(h.w)));
            *(v4u*)(MIX + (size_t)row * DM + HW + col) = o; } }
    }
}

__device__ __forceinline__ void o12_phase(Frame& F, int nrows, const bf16* hb, const float* gn, const float* modl) {
    fresh(F);
    bf16* P = (bf16*)(F.ws + WS_POOLED);
    LAS unsigned char* XN = F.lds + RING_OFF;
    const int rpw = (nrows + F.G - 1) / F.G, rbase = (int)blockIdx.x * rpw, rend = (rbase + rpw < nrows) ? rbase + rpw : nrows;
    for (int r0 = rbase; r0 < rend; r0 += 32) {
        for (int sl = F.wave; sl < 48; sl += NWAVES) {
            const int row = r0 - 8 + sl; if (row < 0 || row >= nrows) continue;
            f32x4 v[4]; float s = 0.f;
#pragma unroll
            for (int j = 0; j < 4; ++j) { const v2u w = *(const v2u*)(hb + (size_t)row * DM + 4 * F.lane + 256 * j); v[j] = (f32x4){bflo(w.x), bfhi(w.x), bflo(w.y), bfhi(w.y)}; s += (v[j].x * v[j].x + v[j].y * v[j].y) + (v[j].z * v[j].z + v[j].w * v[j].w); }
            const float rstd = rsqrtf(wave_sum(s, F.lane) * (1.0f / DM) + EPS);
#pragma unroll
            for (int j = 0; j < 4; ++j) { v2u o; o.x = pg8::cvt_pk_bf16(v[j].x * rstd, v[j].y * rstd); o.y = pg8::cvt_pk_bf16(v[j].z * rstd, v[j].w * rstd); *(LAS v2u*)(XN + sl * 2048 + (4 * F.lane + 256 * j) * 2) = o; }
        }
        __syncthreads();
#pragma unroll 1
        for (int q = 0; q < 4; ++q) {
            const int t = r0 + F.wave * 4 + q; if (t >= rend) break;
            const bool lat = t < M; const int T = lat ? SEQ : CTXL; const int tt = lat ? t % SEQ : (t - M) % CTXL; const int bidx = lat ? t / SEQ : NB;
            const int sc0 = t - r0 + 8;
            const float* scp = modl + bidx * NMOD + DM;
#pragma unroll
            for (int g = 0; g < 4; ++g) {
                const int hw = 1 << g, col = 256 * g + 4 * F.lane;
                float s0 = 0.f, s1 = 0.f, s2 = 0.f, s3 = 0.f; int cnt = 0;
#pragma unroll
                for (int d = -hw; d < hw; ++d) { const bool ok = (tt + d >= 0) && (tt + d < T); const v2u x = *(const LAS v2u*)(XN + (sc0 + d) * 2048 + col * 2);
                    s0 += ok ? bflo(x.x) : 0.f; s1 += ok ? bfhi(x.x) : 0.f; s2 += ok ? bflo(x.y) : 0.f; s3 += ok ? bfhi(x.y) : 0.f; cnt += ok ? 1 : 0; }
                const v2u xc = *(const LAS v2u*)(XN + sc0 * 2048 + col * 2); const float ic = 1.0f / (float)cnt;
                const f32x4 gv = *(const f32x4*)(gn + col), sv = *(const f32x4*)(scp + col);
                v2u o; o.x = pg8::cvt_pk_bf16(gv.x * (sv.x + 1.0f) * (s0 * ic - bflo(xc.x)), gv.y * (sv.y + 1.0f) * (s1 * ic - bfhi(xc.x)));
                o.y = pg8::cvt_pk_bf16(gv.z * (sv.z + 1.0f) * (s2 * ic - bflo(xc.y)), gv.w * (sv.w + 1.0f) * (s3 * ic - bfhi(xc.y)));
                *(v2u*)(P + ((size_t)g * MT + t) * 256 + 4 * F.lane) = o;
            }
        }
        __syncthreads();
    }
}

__device__ __forceinline__ void o5_phase(Frame& F, int nrows, int j) {
    fresh(F);
    unsigned char* ws = F.ws;
    const int* CNT = (const int*)(ws + WS_CNT); int* TST = (int*)(ws + WS_TST); const int* EIDX = (const int*)(ws + WS_EIDX); int* POS = (int*)(ws + WS_POS);
    int* IDX = (int*)(ws + WS_IDX); f32x4* RS = (f32x4*)(ws + WS_RS); const float* RSU = (const float*)(ws + WS_RSU); const float* ST = (const float*)(ws + WS_WSTAT) + j * 48;
    LAS int* lc = (LAS int*)(F.lds + RING_OFF);
    LAS int* lbase = lc + 512 * 8;
    const int rpw = (nrows + F.G - 1) / F.G;
    for (int e = F.tid; e < F.G * 8; e += 512) lc[e] = CNT[e];
    __syncthreads();
    {
        const int e = F.wave; int c4[4]; int sum = 0;
#pragma unroll
        for (int q = 0; q < 4; ++q) { const int w = 4 * F.lane + q; c4[q] = (w < F.G) ? lc[w * 8 + e] : 0; sum += c4[q]; }
        int incl = sum;
#pragma unroll
        for (int o = 1; o < 64; o <<= 1) { const int t = __builtin_amdgcn_ds_bpermute((F.lane >= o ? F.lane - o : F.lane) << 2, incl); if (F.lane >= o) incl += t; }
        const int total = __builtin_amdgcn_readlane(incl, 63); int excl = incl - sum;
        const int myq = (int)blockIdx.x & 3; int pre = excl;
#pragma unroll
        for (int q = 0; q < 3; ++q) if (q < myq) pre += c4[q];
        if (F.lane == ((int)blockIdx.x >> 2)) { lbase[e] = pre; lbase[8 + e] = total; }
    }
    __syncthreads();
    if (F.tid == 0) {
        int ts = 0;
        for (int e = 0; e < 8; ++e) { const int pre = lbase[e], tot = lbase[8 + e]; lbase[e] = ts * 256 + pre; lbase[16 + e] = ts * 256; if (blockIdx.x == 0) TST[e] = ts; ts += (tot + 255) >> 8; }
        if (blockIdx.x == 0) TST[8] = ts;
    }
    __syncthreads();
    if (F.wave == 0) {
        int run[8];
#pragma unroll
        for (int e = 0; e < 8; ++e) run[e] = lbase[e];
        const int npairs = 2 * rpw;
        for (int c0 = 0; c0 < npairs; c0 += 64) {
            const int pl = c0 + F.lane; const int row = (int)blockIdx.x * rpw + (pl >> 1); const bool ok = pl < npairs && row < nrows;
            const int e = ok ? EIDX[2 * row + (pl & 1)] : -1; int mypos = 0;
#pragma unroll
            for (int x = 0; x < 8; ++x) { const unsigned long long mk = __ballot(e == x); const int below = __popcll(mk & ((1ull << F.lane) - 1ull)); if (e == x) mypos = run[x] + below; run[x] += __popcll(mk); }
            if (ok) { POS[2 * row + (pl & 1)] = mypos; IDX[mypos] = row;
                const float sa = RSU[2 * row], n2 = RSU[2 * row + 1]; const float* se = ST + e * 6;
                const float sh = fmaxf(0.0625f * n2 * se[1] * se[3], 1e-30f);
                RS[mypos] = (f32x4){sa * se[0], sa * se[2], 1.0f / sh, sh * se[4]}; }
        }
    }
    if ((int)blockIdx.x < 8) { const int e = blockIdx.x; const int tot = lbase[8 + e]; const int p0 = lbase[16 + e] + tot, p1 = lbase[16 + e] + ((tot + 255) & ~255);
        for (int p = p0 + F.tid; p < p1; p += 512) { IDX[p] = 0; RS[p] = (f32x4){0.f, 0.f, 0.f, 0.f}; } }
    __syncthreads();
}

__global__ void __launch_bounds__(NWAVES * 64, 2) mega_fwd(Args args) {
    extern __shared__ __attribute__((aligned(16))) unsigned char lds[];
    Frame F;
    F.lds = (LAS unsigned char*)lds;
    F.wave = __builtin_amdgcn_readfirstlane((int)threadIdx.x >> 6); fresh(F);
    F.G = gridDim.x; { const int bx = blockIdx.x; F.vcu = (F.G % 8 == 0) ? (bx % 8) * (F.G / 8) + bx / 8 : bx; }
    F.in = args.in; F.out = args.out; F.ws = args.ws;
    unsigned char* ws = args.ws;
    volatile LAS unsigned* MISC = (volatile LAS unsigned*)(F.lds + MISC_OFF);
    for (int u = F.tid; u < (LDS_BYTES - LDSCTL_OFF) / 4; u += NWAVES * 64) ((LAS unsigned*)(F.lds + LDSCTL_OFF))[u] = 0u;
    __syncthreads();
    XcdBarrier bar = xcd_barrier_post((unsigned*)(ws + WS_CTL) + CW_BAR, MISC + 8, F.wave);
#define GRID_BAR() do { xcd_barrier(bar); if (DUPMASK & 4096) xcd_barrier(bar); } while (0)
#ifndef ONLY
#define ONLY 0
#endif
#define PH(n) (ONLY == 0 || ONLY == (n))
#define REP(bit) for (int rep_ = 0; rep_ < ((DUPMASK & (bit)) ? 2 : 1); ++rep_)
    LAS unsigned char* ring = F.lds + RING_OFF;
    const float* MODV = (const float*)(ws + WS_MODV);
    bf16* HB = (bf16*)(ws + WS_HB);
    bf16* U = (bf16*)(ws + WS_U);

#if PH(20)
    REP(8192) p0_prologue(F);
#endif
    GRID_BAR();

    for (int lp = 0; lp < 2; ++lp) {
        const int le = 2 * lp, lo = 2 * lp + 1, j = lp;
        const bool ctx_out = (lp == 0);
        const int nro = ctx_out ? MT : M;
        const float* modE = MODV + (size_t)le * 17 * NMOD; const float* modO = MODV + (size_t)lo * 17 * NMOD;
#if PH(1)
        {
            RowArgs A{}; A.xin_l = args.in[0]; A.xin_c = args.in[2]; A.hb = HB; A.hbo = HB; A.g = args.in[6] + (size_t)(le * 2 + 0) * DM; A.modl = modE; A.shoff = 0; A.scoff = DM; A.U = U;
            A.Y = (const bf16*)(ws + WS_VG); A.pos = (const int*)(ws + WS_POS); A.gate = (const float*)(ws + WS_GATE); A.modprev = MODV + (size_t)(le - 1) * 17 * NMOD;
            if (lp == 0) { row_phase<false, 1, false, true>(F, A, MT); ffn_weights8(F); } else row_phase<true, 1, false, false>(F, A, MT);
        }
#endif
        GRID_BAR();
#if PH(2)
        {
            pg8::Gemm g{U, (const bf16*)(ws + WS_WIN) + (size_t)j * INP * DM, DM, DM, DM}; pg8::InOrder S; S.init(ctx_out, F.G, (int)blockIdx.x);
            EpiIn E{(bf16*)(ws + WS_CQ), (bf16*)(ws + WS_KRR), (bf16*)(ws + WS_CKV), (bf16*)(ws + WS_HQ), (float*)(ws + WS_RSQ), (float*)(ws + WS_RSKV), (const float*)(ws + WS_ROPE), args.in[13], j};
            REP(8) pg8::gemm_phase<EpiIn, pg8::InOrder, true>(ring, g, S, E, F.wave);
        }
#endif
        GRID_BAR();
#if PH(4)
        {
            pg8::Gemm g{(const bf16*)(ws + WS_CQ), (const bf16*)(ws + WS_WUQ) + (size_t)j * 768 * QL, QL, QL, QL}; pg8::StaticOrder S; S.init(nro, 768, F.G, (int)blockIdx.x);
            EpiQ E{(bf16*)(ws + WS_QB), (const float*)(ws + WS_RSQ)};
            REP(8) pg8::gemm_phase<EpiQ, pg8::StaticOrder, true>(ring, g, S, E, F.wave);
        }
        {
            pg8::Gemm g{(const bf16*)(ws + WS_CKV), (const bf16*)(ws + WS_WUKV) + (size_t)j * 1024 * KVL, KVL, KVL, KVL}; pg8::StaticOrder S;
            S.init(MT, 1024, F.G, ((int)blockIdx.x + (((MT / 256) * 4) % F.G) / 8 * 8) % F.G);
            EpiKV E{(bf16*)(ws + WS_KN), (bf16*)(ws + WS_VV), (const float*)(ws + WS_RSKV)};
            REP(8) pg8::gemm_phase<EpiKV, pg8::StaticOrder, true>(ring, g, S, E, F.wave);
        }
#endif
        GRID_BAR();
#if PH(6)
        REP(3) mix_phase(F, j, ctx_out);
#endif
        GRID_BAR();
#if PH(8)
        REP(4 | 64) e8_phase(F, j, nro);
#endif
        GRID_BAR();
#if PH(9)
        {
            pg8::Gemm g{(const bf16*)(ws + WS_MIX), (const bf16*)(ws + WS_WOUT) + (size_t)j * DM * DM, DM, DM, DM}; pg8::StaticOrder S; S.init(nro, DM, F.G, (int)blockIdx.x);
            if (lp == 0) { EpiResid<true> E{args.in[0], args.in[2], HB, modE, 2 * DM}; pg8::gemm_phase<EpiResid<true>, pg8::StaticOrder, true>(ring, g, S, E, F.wave); }
            else { EpiResid<false> E{nullptr, nullptr, HB, modE, 2 * DM}; pg8::gemm_phase<EpiResid<false>, pg8::StaticOrder, true>(ring, g, S, E, F.wave); }
        }
#endif
        GRID_BAR();
#if PH(10)
        {
            RowArgs A{}; A.hb = HB; A.g = args.in[6] + (size_t)(le * 2 + 1) * DM; A.modl = modE; A.shoff = 3 * DM; A.scoff = 4 * DM; A.U = U;
            A.U8 = ws + WS_U; A.rs = (f32x4*)(ws + WS_RS); A.st = (const float*)(ws + WS_WSTAT) + 96 + j * 6;
            row_phase<false, 1, false, false, true>(F, A, nro);
        }
#endif
        GRID_BAR();
#if PH(11)
        {
            pg8::StaticOrder S; S.init(nro, 2 * DFF, F.G, (int)blockIdx.x);
            {
                pg8::Gemm g{(const bf16*)(ws + WS_U), (const bf16*)(ws + WS_WGU + (size_t)j * 2 * DFF * DM * 2), DM / 2, DM / 2, DM / 2};
                EpiGateUp8 E{ws + WS_HID, DFF, 2 * DFF / 256, 0, (const f32x4*)(ws + WS_RS)};
                pg8::gemm_phase<EpiGateUp8, pg8::StaticOrder, true, false, true>(ring, g, S, E, F.wave);
            }
        }
#endif
        GRID_BAR();
#if PH(12)
        {
            pg8::StaticOrder S; S.init(nro, DM, F.G, (int)blockIdx.x);
            {
                pg8::Gemm g{(const bf16*)(ws + WS_HID), (const bf16*)(ws + WS_WDN + (size_t)j * DM * DFF * 2), DFF / 2, DFF / 2, DFF / 2};
                EpiResid<false, true> E{nullptr, nullptr, HB, modE, 5 * DM, (const f32x4*)(ws + WS_RS)};
                pg8::gemm_phase<EpiResid<false, true>, pg8::StaticOrder, true, false, true>(ring, g, S, E, F.wave);
            }
        }
#endif
        GRID_BAR();
#if PH(13)
        {
            REP(2048) o12_phase(F, nro, HB, args.in[6] + (size_t)(lo * 2 + 0) * DM, modO);
            {
                const int done = (F.G % 2 == 0 && F.G / 2 >= NB * NH) ? NB * NH * NWAVES * CONV_MIX : 0;
                fresh(F); conv_items(F, args.in, j, done + F.vcu * NWAVES + F.wave, F.G * NWAVES, 1 << 30); }
        }
#endif
        GRID_BAR();
#if PH(15)
        {
            pg8::Gemm g{(const bf16*)(ws + WS_POOLED), (const bf16*)(ws + WS_WPOOL) + (size_t)j * 4 * 65536, 256, 256, 256};
            pg8::PoolOrder S{nro / 256, MT / 256, F.G, (int)blockIdx.x};
            EpiPool E{HB, modO, args.in[20] + (size_t)j * DM, args.in[21] + (size_t)j * DM, MT / 256};
            pg8::gemm_phase<EpiPool, pg8::PoolOrder, true>(ring, g, S, E, F.wave);
        }
#endif
        GRID_BAR();
#if PH(16)
        {
            RowArgs A{}; A.hb = HB; A.g = args.in[6] + (size_t)(lo * 2 + 1) * DM; A.modl = modO; A.shoff = 3 * DM; A.scoff = 4 * DM; A.U = U;
            A.router = args.in[22] + (size_t)j * DM * NE; A.eidx = (int*)(ws + WS_EIDX); A.gout = (float*)(ws + WS_GATE); A.cnt = (int*)(ws + WS_CNT);
            A.U8 = ws + WS_U; A.rsu = (float*)(ws + WS_RSU);
            REP(4 | 512) row_phase<false, 1, true, false>(F, A, nro);
        }
#endif
        GRID_BAR();
#if PH(17)
        REP(4 | 1024) o5_phase(F, nro, j);
#endif
        GRID_BAR();
#if PH(18)
        {
            const int* TST = (const int*)(ws + WS_TST);
            const int ts1 = TST[1], ts2 = TST[2], ts3 = TST[3], ts4 = TST[4], ts5 = TST[5], ts6 = TST[6], ts7 = TST[7], nT = TST[8];
            const int rem = nT % MOE_CH, nseg = nT / MOE_CH + 1;
            for (int p = 0; p <= nseg; ++p) {
                int n7 = 0;
                if (p >= 1) {
                    const int sg = p - 1; const int t0 = sg == 0 ? 0 : rem + (sg - 1) * MOE_CH, nrt = sg == 0 ? rem : MOE_CH; n7 = nrt * (DM / 256);
                    const bf16* hb = (const bf16*)(ws + WS_HIDM) + (size_t)((sg == 0 || ((sg - 1) & 1)) ? MOE_CH : 0) * 256 * (DFE / 2);
                    pg8::Gemm g{hb - (size_t)t0 * 256 * (DFE / 2), (const bf16*)(ws + WS_MWDN), DFE / 2, DFE / 2, DFE / 2};
                    pg8::MoeOrder S{t0, nrt, DM / 256, F.G, (int)blockIdx.x, ts1, ts2, ts3, ts4, ts5, ts6, ts7, 0, 0};
                    EpiY8 E{(bf16*)(ws + WS_VG), DM / 256, (const f32x4*)(ws + WS_RS)};
                    REP(8) pg8::gemm_phase<EpiY8, pg8::MoeOrder, true, false, true>(ring, g, S, E, F.wave);
                }
                if (p < nseg) {
                    const int sg = p; const int t0 = sg == 0 ? 0 : rem + (sg - 1) * MOE_CH, nrt = sg == 0 ? rem : MOE_CH;
                    unsigned char* hb = ws + WS_HIDM + (size_t)((sg == 0 || ((sg - 1) & 1)) ? MOE_CH : 0) * 256 * DFE;
                    pg8::Gemm g{(const bf16*)(ws + WS_U), (const bf16*)(ws + WS_MWGU), DM / 2, DM / 2, DM / 2, (const int*)(ws + WS_IDX)};
                    pg8::MoeOrder S{t0, nrt, 2 * DFE / 256, F.G, (int)blockIdx.x, ts1, ts2, ts3, ts4, ts5, ts6, ts7, n7 % F.G, 4};
                    EpiGateUp8 E{hb, DFE, 2 * DFE / 256, t0 * 256, (const f32x4*)(ws + WS_RS)};
                    REP(8) pg8::gemm_phase<EpiGateUp8, pg8::MoeOrder, true, true, true>(ring, g, S, E, F.wave);
                }
                GRID_BAR();
            }
        }
#endif
    }
#if PH(19)
    {
        RowArgs A{}; A.hb = HB; A.fout = args.out; A.g = args.in[7];
        A.Y = (const bf16*)(ws + WS_VG); A.pos = (const int*)(ws + WS_POS); A.gate = (const float*)(ws + WS_GATE); A.modprev = MODV + (size_t)3 * 17 * NMOD;
        row_phase<true, 2, false, false>(F, A, M);
        if (xb_ld((unsigned*)(ws + WS_CTL) + CW_BAR + XB_TMO) != 0u) { __syncthreads(); const float qn = __builtin_nanf(""); for (int i = F.tid; i < 1024; i += 512) args.out[(size_t)blockIdx.x * 1024 + i] = qn; }
    }
#endif
}

extern "C" void kernel_launch(void* const* d_in, const int* in_sizes, int n_in, void* d_out, int out_size, void* d_ws, size_t ws_size, hipStream_t stream) {
    static int grid = 0;
    if (grid == 0) {
        if (n_in != 26 || out_size != M * DM || ws_size < WS_END) { fprintf(stderr, "kernel_launch: unexpected shapes (n_in %d out %d ws %zu)\n", n_in, out_size, ws_size); grid = -1; return; }
        int dev = 0, cus = 0, per_cu = 0;
        if (hipGetDevice(&dev) != hipSuccess || hipDeviceGetAttribute(&cus, hipDeviceAttributeMultiprocessorCount, dev) != hipSuccess) { grid = -1; return; }
        if (hipFuncSetAttribute((const void*)mega_fwd, hipFuncAttributeMaxDynamicSharedMemorySize, LDS_BYTES) != hipSuccess) { grid = -1; return; }
        if (hipOccupancyMaxActiveBlocksPerMultiprocessor(&per_cu, (const void*)mega_fwd, NWAVES * 64, LDS_BYTES) != hipSuccess || per_cu < 1) fprintf(stderr, "kernel_launch: occupancy query says %d\n", per_cu);
        (void)hipGetLastError();
        grid = cus > 256 ? 256 : cus;
    }
    if (grid < 0) return;
    if (hipMemsetAsync((char*)d_ws + WS_CTL, 0, CTL_ZERO_BYTES, stream) != hipSuccess) return;
    Args a{};
    for (int i = 0; i < 26; ++i) a.in[i] = (const float*)d_in[i];
    a.out = (float*)d_out; a.ws = (unsigned char*)d_ws;
    hipLaunchKernelGGL(mega_fwd, dim3(grid), dim3(NWAVES * 64), LDS_BYTES, stream, a);
}
```
